# Optimizing an MI355X kernel written in HIP

```python
import jax, jax.numpy as jnp
from jax import lax
import numpy as np

D_MODEL = 1024
BATCH = 8
SEQ = 4096
DEPTH = 1

NSA_HEADS = 8
NSA_KV_GROUPS = 2
NSA_HEAD_DIM = 64
NSA_WIDTH = NSA_HEADS * NSA_HEAD_DIM
NSA_BRANCHES = 3
CMP_STRIDE = 16
CMP_LEN = 2 * CMP_STRIDE
CMP_HIDDEN = 256
SEL_BLOCK = 64
SEL_TOPN = 16
SEL_QCHUNK = 64
WINDOW = 512
WIN_QBLOCK = 128

HGRN_WIDTH = D_MODEL - NSA_WIDTH
HGRN_EXPAND = 128
HGRN_HEADS = HGRN_WIDTH // HGRN_EXPAND
HGRN_DK = HGRN_EXPAND
HGRN_DV = HGRN_WIDTH // HGRN_HEADS
HGRN_CHUNK = 64

MIX_WIDTH = NSA_WIDTH + HGRN_WIDTH

MOE_GROUPS = 4
EXPERTS_PER_GROUP = 8
N_EXPERTS = MOE_GROUPS * EXPERTS_PER_GROUP
MOE_TOPK = 2
EXPERT_FF = 512
MOE_BLOCK = 256

RMS_EPS = 1e-6
NEG_INF = -1e30

KV_DIM = NSA_KV_GROUPS * NSA_HEAD_DIM
IN_SPLITS = (NSA_WIDTH,) + (KV_DIM,) * (2 * NSA_BRANCHES) + (NSA_HEADS * NSA_BRANCHES,) + (HGRN_WIDTH,) * 4
IN_COLS = sum(IN_SPLITS)

kernel_name = 'hybrid_nsa_hgrn2_hmoe'


def rmsnorm(x, g):
    xf = x.astype(jnp.float32)
    y = xf * lax.rsqrt(jnp.mean(xf * xf, axis=-1, keepdims=True) + RMS_EPS)
    return (y * g.astype(jnp.float32)).astype(x.dtype)


def nsa_mixer(q, kc_raw, vc_raw, ks_raw, vs_raw, kw_raw, vw_raw, gate_logits,
              g_q, g_k, pos_k, pos_v, wk1, wk2, wv1, wv2):
    B, S = q.shape[0], q.shape[1]
    G, R, DH = NSA_KV_GROUPS, NSA_HEADS // NSA_KV_GROUPS, NSA_HEAD_DIM
    dt = q.dtype
    scale = DH ** -0.5
    qn = rmsnorm(q, g_q).reshape(B, S, G, R, DH).transpose(0, 2, 3, 1, 4)
    t_pos = jnp.arange(S)

    def to_groups(t):
        return t.reshape(B, S, G, DH).transpose(0, 2, 1, 3)

    nc = S // CMP_STRIDE - 1

    def compress(t, pos, w1, w2):
        ch = to_groups(t).reshape(B, G, S // CMP_STRIDE, CMP_STRIDE, DH)
        blk = jnp.concatenate([ch[:, :, :-1], ch[:, :, 1:]], axis=3) + pos
        hid = jax.nn.silu(blk.reshape(B, G, nc, CMP_LEN * DH) @ w1)
        return hid @ w2

    kc = rmsnorm(compress(kc_raw, pos_k, wk1, wk2), g_k[0])
    vc = compress(vc_raw, pos_v, wv1, wv2)
    s_c = jnp.einsum('bgrsd,bgcd->bgrsc', qn, kc).astype(jnp.float32) * scale
    mask_c = (jnp.arange(nc) * CMP_STRIDE + CMP_LEN - 1)[None, :] <= t_pos[:, None]
    p_c = jax.nn.softmax(jnp.where(mask_c, s_c, NEG_INF), axis=-1) * mask_c
    o_c = jnp.einsum('bgrsc,bgcd->bgrsd', p_c.astype(dt), vc)

    ns = S // SEL_BLOCK
    top_n = min(SEL_TOPN, ns)
    cs = np.arange(nc)[:, None] * CMP_STRIDE
    js = np.arange(ns)[None, :] * SEL_BLOCK
    overlap = np.clip(np.minimum(cs + CMP_LEN, js + SEL_BLOCK) - np.maximum(cs, js), 0, None)
    overlap = jnp.asarray(overlap / CMP_LEN, dtype=jnp.float32)
    imp = jnp.einsum('bgrsc,cj->bgsj', p_c, overlap)
    cur_blk = t_pos // SEL_BLOCK
    jb = jnp.arange(ns)
    valid = jb[None, :] <= cur_blk[:, None]
    forced = (jb[None, :] == cur_blk[:, None]) | (jb[None, :] == 0)
    imp = jnp.where(forced, jnp.inf, jnp.where(valid, imp, -jnp.inf))
    _, sel_idx = lax.top_k(imp, top_n)

    ks_blk = rmsnorm(to_groups(ks_raw), g_k[1]).reshape(B, G, ns, SEL_BLOCK, DH)
    vs_blk = to_groups(vs_raw).reshape(B, G, ns, SEL_BLOCK, DH)
    nqc = S // SEL_QCHUNK
    q_ch = qn.reshape(B, G, R, nqc, SEL_QCHUNK, DH).transpose(3, 0, 1, 2, 4, 5)
    i_ch = sel_idx.reshape(B, G, nqc, SEL_QCHUNK, top_n).transpose(2, 0, 1, 3, 4)
    gather = jax.vmap(jax.vmap(lambda blocks, ix: blocks[ix]))
    n_keys = top_n * SEL_BLOCK

    def sel_chunk(args):
        qb, ib, ci = args
        kg = gather(ks_blk, ib).reshape(B, G, SEL_QCHUNK, n_keys, DH)
        vg = gather(vs_blk, ib).reshape(B, G, SEL_QCHUNK, n_keys, DH)
        kpos = (ib[..., None] * SEL_BLOCK + jnp.arange(SEL_BLOCK)).reshape(B, G, SEL_QCHUNK, n_keys)
        tq = ci * SEL_QCHUNK + jnp.arange(SEL_QCHUNK)
        m = kpos <= tq[None, None, :, None]
        s = jnp.einsum('bgrqd,bgqkd->bgrqk', qb, kg).astype(jnp.float32) * scale
        p = jax.nn.softmax(jnp.where(m[:, :, None], s, NEG_INF), axis=-1)
        return jnp.einsum('bgrqk,bgqkd->bgrqd', p.astype(dt), vg)

    o_s = lax.map(sel_chunk, (q_ch, i_ch, jnp.arange(nqc)))
    o_s = o_s.transpose(1, 2, 3, 0, 4, 5).reshape(B, G, R, S, DH)

    nqb = S // WIN_QBLOCK
    n_band = WINDOW // WIN_QBLOCK + 1
    band = n_band * WIN_QBLOCK

    def banded(t):
        tp = jnp.pad(t, ((0, 0), (0, 0), (WINDOW, 0), (0, 0)))
        tp = tp.reshape(B, G, (S + WINDOW) // WIN_QBLOCK, WIN_QBLOCK, DH)
        bands = jnp.concatenate([tp[:, :, i:i + nqb] for i in range(n_band)], axis=3)
        return bands.transpose(2, 0, 1, 3, 4)

    kw_band = banded(rmsnorm(to_groups(kw_raw), g_k[2]))
    vw_band = banded(to_groups(vw_raw))
    qi = jnp.arange(WIN_QBLOCK)[:, None]
    mi = jnp.arange(band)[None, :]
    rel_ok = (mi >= qi + 1) & (mi <= qi + WINDOW)
    pos_ok = (jnp.arange(nqb)[:, None] * WIN_QBLOCK - WINDOW + jnp.arange(band)[None, :]) >= 0
    mask_w = rel_ok[None] & pos_ok[:, None, :]
    q_wb = qn.reshape(B, G, R, nqb, WIN_QBLOCK, DH).transpose(3, 0, 1, 2, 4, 5)

    def win_block(args):
        qb, kb, vb, mb = args
        s = jnp.einsum('bgrqd,bgkd->bgrqk', qb, kb).astype(jnp.float32) * scale
        p = jax.nn.softmax(jnp.where(mb, s, NEG_INF), axis=-1)
        return jnp.einsum('bgrqk,bgkd->bgrqd', p.astype(dt), vb)

    o_w = lax.map(win_block, (q_wb, kw_band, vw_band, mask_w))
    o_w = o_w.transpose(1, 2, 3, 0, 4, 5).reshape(B, G, R, S, DH)

    gates = jax.nn.sigmoid(gate_logits.astype(jnp.float32)).astype(dt)
    gates = gates.reshape(B, S, G, R, NSA_BRANCHES).transpose(4, 0, 2, 3, 1)[..., None]
    o = gates[0] * o_c + gates[1] * o_s + gates[2] * o_w
    return o.transpose(0, 3, 1, 2, 4).reshape(B, S, NSA_WIDTH)


def hgrn2_mixer(q, f, i, g, lb, g_norm):
    B, S = q.shape[0], q.shape[1]
    H, K, V, C = HGRN_HEADS, HGRN_DK, HGRN_DV, HGRN_CHUNK
    dt = q.dtype

    def heads(t, d):
        return t.reshape(B, S, H, d).transpose(0, 2, 1, 3).astype(jnp.float32)

    lbh = lb.astype(jnp.float32).reshape(H, 1, K)
    qf = jax.nn.silu(heads(q, K))
    fg = lbh + (1.0 - lbh) * jax.nn.sigmoid(heads(f, K))
    kf = 1.0 - fg
    logf = jnp.log(fg)
    vf = heads(i, V)
    nch = S // C

    def chunk(t):
        return t.reshape(B, H, nch, C, t.shape[-1]).transpose(2, 0, 1, 3, 4)

    causal = jnp.tril(jnp.ones((C, C), dtype=bool))[:, :, None]

    def step(state, xs):
        qc, kc, vc, lc = xs
        a = jnp.cumsum(lc, axis=2)
        decay = jnp.exp(jnp.where(causal, a[:, :, :, None, :] - a[:, :, None, :, :], -jnp.inf))
        attn = jnp.einsum('bhtk,bhsk,bhtsk->bhts', qc, kc, decay)
        out = attn @ vc + jnp.einsum('bhtk,bhkv->bhtv', qc * jnp.exp(a), state)
        a_last = a[:, :, -1:, :]
        new_state = jnp.exp(a_last[:, :, 0, :, None]) * state + jnp.einsum('bhsk,bhsv->bhkv', kc * jnp.exp(a_last - a), vc)
        return new_state, out

    _, o = lax.scan(step, jnp.zeros((B, H, K, V), jnp.float32), (chunk(qf), chunk(kf), chunk(vf), chunk(logf)))
    o = o.transpose(1, 3, 0, 2, 4).reshape(B, S // C * 0 + nch, C, H, V) if False else o.transpose(1, 0, 3, 2, 4).reshape(B, S, H, V)
    o = rmsnorm(o, g_norm).reshape(B, S, HGRN_WIDTH) * jax.nn.silu(g.astype(jnp.float32))
    return o.astype(dt)


def hier_moe(x, w_group, b_group, w_expert, b_expert, w1, w3, w2):
    B, S, D = x.shape
    N = B * S
    xt = x.reshape(N, D)
    pg = jax.nn.softmax((xt @ w_group).astype(jnp.float32) + b_group.astype(jnp.float32), axis=-1)
    pg_top, g_idx = lax.top_k(pg, 1)
    le = ((xt @ w_expert).astype(jnp.float32) + b_expert.astype(jnp.float32)).reshape(N, MOE_GROUPS, EXPERTS_PER_GROUP)
    le = jnp.take_along_axis(le, jnp.broadcast_to(g_idx[:, :, None], (N, 1, EXPERTS_PER_GROUP)), axis=1)[:, 0]
    pe = jax.nn.softmax(le, axis=-1)
    pe_top, e_loc = lax.top_k(pe, MOE_TOPK)
    w_tok = pg_top * pe_top / jnp.sum(pe_top, axis=-1, keepdims=True)
    e_id = g_idx * EXPERTS_PER_GROUP + e_loc

    n_asg = N * MOE_TOPK
    e_flat = e_id.reshape(n_asg)
    w_flat = w_tok.reshape(n_asg)
    tok = jnp.repeat(jnp.arange(N), MOE_TOPK)
    order = jnp.argsort(e_flat)
    e_s, tok_s, w_s = e_flat[order], tok[order], w_flat[order]
    counts = jnp.bincount(e_flat, length=N_EXPERTS)
    start = jnp.cumsum(counts) - counts
    padded = (counts + MOE_BLOCK - 1) // MOE_BLOCK * MOE_BLOCK
    pend = jnp.cumsum(padded)
    pstart = pend - padded
    dest = pstart[e_s] + jnp.arange(n_asg) - start[e_s]
    P = n_asg + N_EXPERTS * MOE_BLOCK
    nblk = P // MOE_BLOCK
    x_pad = jnp.zeros((P, D), x.dtype).at[dest].set(xt[tok_s])
    blk_e = jnp.minimum(jnp.sum(jnp.arange(nblk)[:, None] * MOE_BLOCK >= pend[None, :], axis=1), N_EXPERTS - 1)

    def expert_block(args):
        xb, e = args
        return (jax.nn.silu(xb @ w1[e]) * (xb @ w3[e])) @ w2[e]

    y_pad = lax.map(expert_block, (x_pad.reshape(nblk, MOE_BLOCK, D), blk_e)).reshape(P, D)
    y = jax.ops.segment_sum(y_pad[dest] * w_s[:, None].astype(x.dtype), tok_s, num_segments=N)
    return y.reshape(B, S, D)


def setup_inputs(seed: int = 0) -> dict:
    key = jax.random.key(seed)
    ks = jax.random.split(key, 24)
    nrm = lambda k, shape, s: jax.random.normal(k, shape, jnp.float32) * s
    DH = NSA_HEAD_DIM
    return {
        'x': nrm(ks[0], (BATCH, SEQ, D_MODEL), 1.0),
        'attn_norm_g': 1.0 + nrm(ks[1], (DEPTH, D_MODEL), 0.02),
        'ffn_norm_g': 1.0 + nrm(ks[2], (DEPTH, D_MODEL), 0.02),
        'w_in': nrm(ks[3], (DEPTH, D_MODEL, IN_COLS), D_MODEL ** -0.5),
        'w_out': nrm(ks[4], (DEPTH, MIX_WIDTH, D_MODEL), MIX_WIDTH ** -0.5),
        'nsa_q_norm_g': 1.0 + nrm(ks[5], (DEPTH, DH), 0.02),
        'nsa_k_norm_g': 1.0 + nrm(ks[6], (DEPTH, NSA_BRANCHES, DH), 0.02),
        'cmp_pos_k': nrm(ks[7], (DEPTH, CMP_LEN, DH), 0.1),
        'cmp_pos_v': nrm(ks[8], (DEPTH, CMP_LEN, DH), 0.1),
        'cmp_wk1': nrm(ks[9], (DEPTH, CMP_LEN * DH, CMP_HIDDEN), (CMP_LEN * DH) ** -0.5),
        'cmp_wk2': nrm(ks[10], (DEPTH, CMP_HIDDEN, DH), CMP_HIDDEN ** -0.5),
        'cmp_wv1': nrm(ks[11], (DEPTH, CMP_LEN * DH, CMP_HIDDEN), (CMP_LEN * DH) ** -0.5),
        'cmp_wv2': nrm(ks[12], (DEPTH, CMP_HIDDEN, DH), CMP_HIDDEN ** -0.5),
        'nsa_out_norm_g': 1.0 + nrm(ks[13], (DEPTH, NSA_WIDTH), 0.02),
        'hgrn_lb_logits': nrm(ks[14], (DEPTH + 1, HGRN_WIDTH), 0.5),
        'hgrn_out_norm_g': 1.0 + nrm(ks[15], (DEPTH, HGRN_DV), 0.02),
        'moe_w_group': nrm(ks[16], (DEPTH, D_MODEL, MOE_GROUPS), D_MODEL ** -0.5),
        'moe_b_group': nrm(ks[17], (DEPTH, MOE_GROUPS), 0.01),
        'moe_w_expert': nrm(ks[18], (DEPTH, D_MODEL, N_EXPERTS), D_MODEL ** -0.5),
        'moe_b_expert': nrm(ks[19], (DEPTH, N_EXPERTS), 0.01),
        'moe_w1': nrm(ks[20], (DEPTH, N_EXPERTS, D_MODEL, EXPERT_FF), D_MODEL ** -0.5),
        'moe_w3': nrm(ks[21], (DEPTH, N_EXPERTS, D_MODEL, EXPERT_FF), D_MODEL ** -0.5),
        'moe_w2': nrm(ks[22], (DEPTH, N_EXPERTS, EXPERT_FF, D_MODEL), EXPERT_FF ** -0.5),
    }


def reference(x, attn_norm_g, ffn_norm_g, w_in, w_out, nsa_q_norm_g, nsa_k_norm_g,
              cmp_pos_k, cmp_pos_v, cmp_wk1, cmp_wk2, cmp_wv1, cmp_wv2, nsa_out_norm_g,
              hgrn_lb_logits, hgrn_out_norm_g, moe_w_group, moe_b_group, moe_w_expert,
              moe_b_expert, moe_w1, moe_w3, moe_w2):
    B, S, _ = x.shape
    split_at = np.cumsum(IN_SPLITS)[:-1].tolist()
    lb_all = jnp.cumsum(jax.nn.softmax(hgrn_lb_logits.astype(jnp.float32), axis=0), axis=0)
    h = x
    for layer in range(DEPTH):
        n = rmsnorm(h, attn_norm_g[layer])
        parts = jnp.split(n @ w_in[layer], split_at, axis=-1)
        q = parts[0].reshape(B, S, NSA_HEADS, NSA_HEAD_DIM)
        gate_logits = parts[7].reshape(B, S, NSA_HEADS, NSA_BRANCHES)
        o_nsa = nsa_mixer(q, parts[1], parts[2], parts[3], parts[4], parts[5], parts[6], gate_logits,
                          nsa_q_norm_g[layer], nsa_k_norm_g[layer], cmp_pos_k[layer], cmp_pos_v[layer],
                          cmp_wk1[layer], cmp_wk2[layer], cmp_wv1[layer], cmp_wv2[layer])
        o_nsa = rmsnorm(o_nsa, nsa_out_norm_g[layer])
        o_hgrn = hgrn2_mixer(parts[8], parts[9], parts[10], parts[11], lb_all[layer], hgrn_out_norm_g[layer])
        mixed = jnp.concatenate([o_nsa, o_hgrn.astype(o_nsa.dtype)], axis=-1)
        h = h + mixed @ w_out[layer]
        h = h + hier_moe(rmsnorm(h, ffn_norm_g[layer]), moe_w_group[layer], moe_b_group[layer],
                         moe_w_expert[layer], moe_b_expert[layer], moe_w1[layer], moe_w3[layer], moe_w2[layer])
    return h
```

```cpp
#include <hip/hip_runtime.h>
#include <hip/hip_cooperative_groups.h>
#include <cstdio>
#include <cstdint>
#include <cstring>
namespace cg = cooperative_groups;

#ifndef N_LAUNCH_MODE
#define N_LAUNCH_MODE 0
#endif

#define DEV __device__ __forceinline__
typedef unsigned short bf16_t;
typedef short bf16x8 __attribute__((ext_vector_type(8)));
typedef float f32x4 __attribute__((ext_vector_type(4)));
typedef float f32x2 __attribute__((ext_vector_type(2)));
typedef float f32x16 __attribute__((ext_vector_type(16)));
typedef unsigned u32x4 __attribute__((ext_vector_type(4)));
typedef unsigned u32x2 __attribute__((ext_vector_type(2)));

constexpr int NT = 512;
constexpr int BATCH = 8, SEQ = 4096, DM = 1024, NTOK = BATCH * SEQ;
constexpr int IN_COLS = 3352, INP = 3584;
constexpr int NC = 255;
constexpr float RMS_EPS = 1e-6f;
constexpr float QSCALE = 0.125f * 1.4426950408889634f;
constexpr int NBIN = 112;
constexpr int BINCAP = NTOK;

constexpr size_t MiB = 1ull << 20;
constexpr size_t WS_CTL    = 0;
constexpr size_t WS_RSTD1  = 1 * MiB;
constexpr size_t WS_RSTD2  = WS_RSTD1 + 128 * 1024;
constexpr size_t WS_ROWSS  = WS_RSTD2 + 128 * 1024;
constexpr size_t WS_TOKW   = WS_ROWSS + 128 * 1024;
constexpr size_t WS_LB     = WS_TOKW + 256 * 1024;
constexpr size_t WS_CBIAS  = WS_LB + 4096;
constexpr size_t WS_SELM   = 2 * MiB;
constexpr size_t WS_GATES  = 3 * MiB;
constexpr size_t WS_KCMP   = 6 * MiB;
constexpr size_t WS_VCMP   = WS_KCMP + 512 * 1024;
constexpr size_t WS_CW2T   = 7 * MiB;
constexpr size_t WS_HID    = 8 * MiB;
constexpr size_t WS_CW1T   = 12 * MiB;
constexpr size_t WS_WOUTT  = 14 * MiB;
constexpr size_t WS_WINT   = 16 * MiB;
constexpr size_t WS_R1     = 24 * MiB;
constexpr size_t WS_Q      = 88 * MiB;
constexpr size_t WS_KC     = 120 * MiB;
constexpr size_t WS_VC     = 128 * MiB;
constexpr size_t WS_KS     = 136 * MiB;
constexpr size_t WS_KW     = 144 * MiB;
constexpr size_t WS_VST    = 152 * MiB;
constexpr size_t WS_VWT    = 160 * MiB;
constexpr size_t WS_OC     = 168 * MiB;
constexpr size_t WS_W13T   = 200 * MiB;
constexpr size_t WS_W2T    = 264 * MiB;
constexpr size_t WS_HQ     = 296 * MiB;
constexpr size_t WS_HV     = 328 * MiB;
constexpr size_t WS_HG     = 360 * MiB;
constexpr size_t WS_HLOGF  = 392 * MiB;
constexpr size_t WS_END    = 456 * MiB;
constexpr size_t WS_BINL   = WS_HQ;
constexpr size_t WS_HBUF   = WS_HQ + 16 * MiB;

struct Params {
    const float *x, *attn_g, *ffn_g, *w_in, *w_out, *g_q, *g_k, *pos_k, *pos_v, *wk1, *wk2, *wv1, *wv2, *g_nsa, *lb_logits, *g_hn,
        *w_group, *b_group, *w_expert, *b_expert, *w1, *w3, *w2;
    float* out;
    unsigned char* ws;
};

DEV unsigned pk2(float lo, float hi) { unsigned r; asm("v_cvt_pk_bf16_f32 %0, %1, %2" : "=v"(r) : "v"(lo), "v"(hi)); return r; }
DEV bf16_t f2bf(float f) { return (bf16_t)(pk2(f, 0.f) & 0xffffu); }
DEV float bf2f(bf16_t b) { return __uint_as_float(((unsigned)b) << 16); }
DEV float bflo(unsigned u) { return __uint_as_float(u << 16); }
DEV float bfhi(unsigned u) { return __uint_as_float(u & 0xffff0000u); }
DEV float sigmoidf_(float v) { return 1.f / (1.f + __expf(-v)); }
DEV float siluf_(float v) { return v / (1.f + __expf(-v)); }
DEV float wave_sum(float v) {
#pragma unroll
    for (int o = 1; o < 64; o <<= 1) v += __shfl_xor(v, o);
    return v;
}
DEV float wave_max(float v) {
#pragma unroll
    for (int o = 1; o < 64; o <<= 1) v = fmaxf(v, __shfl_xor(v, o));
    return v;
}
DEV int vblock() { const int G = gridDim.x, b = blockIdx.x; return (G % 8 == 0) ? (b % 8) * (G / 8) + b / 8 : b; }

template <class SRC>
DEV void convert_tile(float* tl, const SRC& src, bf16_t* dst, int ldd, int n0, int k0) {
    const int tid = threadIdx.x;
    {
        const int n = tid & 63;
#pragma unroll
        for (int i = 0; i < 8; ++i) { const int kk = (tid >> 6) + 8 * i; tl[kk * 65 + n] = src.get(n0 + n, k0 + kk); }
    }
    __syncthreads();
    {
        const int n = tid >> 3, kc = tid & 7;
        const float* s = tl + (kc * 8) * 65 + n;
        u32x4 o;
        o.x = pk2(s[0 * 65], s[1 * 65]); o.y = pk2(s[2 * 65], s[3 * 65]); o.z = pk2(s[4 * 65], s[5 * 65]); o.w = pk2(s[6 * 65], s[7 * 65]);
        *(u32x4*)(dst + (size_t)(n0 + n) * ldd + k0 + kc * 8) = o;
    }
    __syncthreads();
}
struct SrcWin { const float* w; const float* g;
    DEV float get(int n, int k) const { int col; if (n < 1280) col = n; else if (n < 3328) col = n + 24; else if (n < 3352) col = 1280 + (n - 3328); else return 0.f;
        return w[(size_t)k * IN_COLS + col] * g[k]; } };
struct SrcWout { const float* w; const float* g;
    DEV float get(int n, int k) const { const float v = w[(size_t)k * DM + n]; return k < 512 ? v * g[k] : v; } };
struct SrcPlain { const float* w; int ld;
    DEV float get(int n, int k) const { return w[(size_t)k * ld + n]; } };
struct SrcW13 { const float* w1; const float* w3; const float* g;
    DEV float get(int n, int k) const { const uintptr_t a = (uintptr_t)w1, b = (uintptr_t)w3; const float* w = (const float*)(a + ((b - a) & (uintptr_t)(0 - (long long)(n & 1))));
        return w[(size_t)k * 512 + (n >> 1)] * g[k]; } };

DEV void phase_prologue(const Params& p, unsigned char* lds) {
    float* tl = (float*)lds;
    const int tid = threadIdx.x, lane = tid & 63, wid = tid >> 6;
    const int vb = vblock(), G = gridDim.x;
    unsigned char* ws = p.ws;
    constexpr int I_WIN = (INP / 64) * (DM / 64);
    constexpr int I_WOUT = 16 * 16;
    constexpr int I_CW1 = 2 * 4 * 32;
    constexpr int I_CW2 = 2 * 1 * 4;
    constexpr int I_W13 = 32 * 16 * 16;
    constexpr int I_W2 = 32 * 16 * 8;
    constexpr int I_ALL = I_WIN + I_WOUT + I_CW1 + I_CW2 + I_W13 + I_W2;
    for (int it = vb; it < I_ALL; it += G) {
        int r = it;
        if (r < I_WIN) { SrcWin s{p.w_in, p.attn_g}; convert_tile(tl, s, (bf16_t*)(ws + WS_WINT), DM, (r / 16) * 64, (r % 16) * 64); continue; } r -= I_WIN;
        if (r < I_WOUT) { SrcWout s{p.w_out, p.g_nsa}; convert_tile(tl, s, (bf16_t*)(ws + WS_WOUTT), DM, (r / 16) * 64, (r % 16) * 64); continue; } r -= I_WOUT;
        if (r < I_CW1) { const int z = r / 128, q = r % 128; SrcPlain s{z ? p.wv1 : p.wk1, 256};
            convert_tile(tl, s, (bf16_t*)(ws + WS_CW1T) + (size_t)z * 256 * 2048, 2048, (q / 32) * 64, (q % 32) * 64); continue; } r -= I_CW1;
        if (r < I_CW2) { const int z = r / 4, q = r % 4; SrcPlain s{z ? p.wv2 : p.wk2, 64};
            convert_tile(tl, s, (bf16_t*)(ws + WS_CW2T) + (size_t)z * 64 * 256, 256, 0, q * 64); continue; } r -= I_CW2;
        if (r < I_W13) { const int e = r / 256, q = r % 256; SrcW13 s{p.w1 + (size_t)e * 1024 * 512, p.w3 + (size_t)e * 1024 * 512, p.ffn_g};
            convert_tile(tl, s, (bf16_t*)(ws + WS_W13T) + (size_t)e * 1024 * 1024, 1024, (q / 16) * 64, (q % 16) * 64); continue; } r -= I_W13;
        { const int e = r / 128, q = r % 128; SrcPlain s{p.w2 + (size_t)e * 512 * 1024, 1024};
            convert_tile(tl, s, (bf16_t*)(ws + WS_W2T) + (size_t)e * 1024 * 512, 512, (q / 8) * 64, (q % 8) * 64); }
    }
    {
        bf16_t* xb = (bf16_t*)(ws + WS_R1); float* rstd1 = (float*)(ws + WS_RSTD1);
        const int gw = vb * 8 + wid, NGW = G * 8;
        for (int m = gw; m < NTOK; m += NGW) {
            const f32x4* xr = (const f32x4*)(p.x + (size_t)m * DM) + lane;
            f32x4 v[4]; float s = 0.f;
#pragma unroll
            for (int j = 0; j < 4; ++j) { v[j] = xr[64 * j]; s += (v[j].x * v[j].x + v[j].y * v[j].y) + (v[j].z * v[j].z + v[j].w * v[j].w); }
            s = wave_sum(s);
            if (lane == 0) rstd1[m] = rsqrtf(s * (1.f / DM) + RMS_EPS);
            u32x2* o = (u32x2*)(xb + (size_t)m * DM) + lane;
#pragma unroll
            for (int j = 0; j < 4; ++j) { u32x2 w; w.x = pk2(v[j].x, v[j].y); w.y = pk2(v[j].z, v[j].w); o[64 * j] = w; }
        }
    }
    {
        const int gt = vb * NT + tid, NG = G * NT;
        float* rowss = (float*)(ws + WS_ROWSS);
        for (int i = gt; i < NTOK; i += NG) rowss[i] = 0.f;
        int* bincnt = (int*)(ws + WS_CTL);
        if (gt < 128) bincnt[gt] = 0;
        if (gt < 512) { const float l0 = p.lb_logits[gt], l1 = p.lb_logits[512 + gt]; ((float*)(ws + WS_LB))[gt] = 1.f / (1.f + __expf(l1 - l0)); }
        if (blockIdx.x == (unsigned)(G - 1)) {
            const int z = tid >> 8, j = tid & 255; const float* pos = z ? p.pos_v : p.pos_k; const float* w = z ? p.wv1 : p.wk1;
            float a = 0.f;
            for (int k = 0; k < 2048; ++k) a += pos[k] * w[(size_t)k * 256 + j];
            ((float*)(ws + WS_CBIAS))[z * 256 + j] = a;
        }
    }
}

constexpr int G_A_BYTES = 128 * 128, G_B_BYTES = 256 * 128, G_STAGE = G_A_BYTES + G_B_BYTES, G_LDS = 2 * G_STAGE;
DEV int swz(int row, int chunk) { return row * 128 + ((chunk ^ ((row >> 1) & 7)) << 4); }
template <class AL, class BL, class EP>
DEV void gemm_tile(unsigned char* lds, const AL& al, const BL& bl, int nk, const EP& ep) {
    const int tid = threadIdx.x, lane = tid & 63, wid = tid >> 6, wr = wid >> 2, wc = wid & 3;
    const int frow = lane & 15, fq = lane >> 4;
    const bf16_t* aptr[2]; int aoff[2], boff[4], brow[4];
#pragma unroll
    for (int i = 0; i < 2; ++i) { const int q = tid + NT * i, row = q >> 3, ch = q & 7; aptr[i] = al.row(row) + ch * 8; aoff[i] = swz(row, ch); }
#pragma unroll
    for (int i = 0; i < 4; ++i) { const int q = tid + NT * i, row = q >> 3, ch = q & 7; brow[i] = row; boff[i] = G_A_BYTES + swz(row, ch) ; }
    const int bch8 = (tid & 7) * 8;
    u32x4 ra[2], rb[4];
#pragma unroll
    for (int i = 0; i < 2; ++i) ra[i] = *(const u32x4*)(aptr[i]);
#pragma unroll
    for (int i = 0; i < 4; ++i) rb[i] = *(const u32x4*)(bl.ptr(brow[i], 0) + bch8);
#pragma unroll
    for (int i = 0; i < 2; ++i) *(u32x4*)(lds + aoff[i]) = ra[i];
#pragma unroll
    for (int i = 0; i < 4; ++i) *(u32x4*)(lds + boff[i]) = rb[i];
    __syncthreads();
    f32x4 acc[4][4];
#pragma unroll
    for (int m = 0; m < 4; ++m)
#pragma unroll
        for (int n = 0; n < 4; ++n) acc[m][n] = (f32x4){0.f, 0.f, 0.f, 0.f};
    const int sx = (frow >> 1) & 7;
    for (int kt = 0; kt < nk; ++kt) {
        const bool more = (kt + 1 < nk);
        if (more) {
#pragma unroll
            for (int i = 0; i < 2; ++i) ra[i] = *(const u32x4*)(aptr[i] + (kt + 1) * 64);
#pragma unroll
            for (int i = 0; i < 4; ++i) rb[i] = *(const u32x4*)(bl.ptr(brow[i], kt + 1) + bch8);
        }
        const unsigned char* base = lds + (kt & 1) * G_STAGE;
#pragma unroll
        for (int ks = 0; ks < 2; ++ks) {
            const int co = ((ks * 4 + fq) ^ sx) << 4;
            bf16x8 af[4], bfr[4];
#pragma unroll
            for (int m = 0; m < 4; ++m) af[m] = *(const bf16x8*)(base + (wr * 64 + m * 16 + frow) * 128 + co);
#pragma unroll
            for (int n = 0; n < 4; ++n) bfr[n] = *(const bf16x8*)(base + G_A_BYTES + (wc * 64 + n * 16 + frow) * 128 + co);
#pragma unroll
            for (int m = 0; m < 4; ++m)
#pragma unroll
                for (int n = 0; n < 4; ++n) acc[m][n] = __builtin_amdgcn_mfma_f32_16x16x32_bf16(bfr[n], af[m], acc[m][n], 0, 0, 0);
        }
        if (more) {
            unsigned char* nb = lds + ((kt + 1) & 1) * G_STAGE;
#pragma unroll
            for (int i = 0; i < 2; ++i) *(u32x4*)(nb + aoff[i]) = ra[i];
#pragma unroll
            for (int i = 0; i < 4; ++i) *(u32x4*)(nb + boff[i]) = rb[i];
        }
        __syncthreads();
    }
    ep(acc, wr, wc, lane);
}

struct ARows { const bf16_t* base; size_t ld; DEV const bf16_t* row(int r) const { return base + (size_t)r * ld; } };
struct BRows { const bf16_t* base; size_t ld; DEV const bf16_t* ptr(int n, int kt) const { return base + (size_t)n * ld + kt * 64; } };

struct EpiInproj {
    const Params& p; int m0, ntile;
    DEV void operator()(f32x4 (&acc)[4][4], int wr, int wc, int lane) const {
        const int frow = lane & 15, fq = lane >> 4;
        const int seg = ntile * 4 + wc;
        if (seg > 52) return;
        unsigned char* ws = p.ws;
        const float* rstd1 = (const float*)(ws + WS_RSTD1);
        int rows[4];
#pragma unroll
        for (int m = 0; m < 4; ++m) { rows[m] = m0 + wr * 64 + m * 16 + frow; const float rs = rstd1[rows[m]];
#pragma unroll
            for (int n = 0; n < 4; ++n) acc[m][n] = acc[m][n] * rs; }
        const bool is_q = seg < 8, is_ks = (seg == 12 || seg == 13), is_kw = (seg == 16 || seg == 17);
        if (is_q || is_ks || is_kw) {
            const float* gw = is_q ? p.g_q : (is_ks ? p.g_k + 64 : p.g_k + 128);
            bf16_t* dst; int hh, nh;
            if (is_q) { dst = (bf16_t*)(ws + WS_Q); hh = seg; nh = 8; } else if (is_ks) { dst = (bf16_t*)(ws + WS_KS); hh = seg - 12; nh = 2; } else { dst = (bf16_t*)(ws + WS_KW); hh = seg - 16; nh = 2; }
            f32x4 gv[4];
#pragma unroll
            for (int n = 0; n < 4; ++n) gv[n] = *(const f32x4*)(gw + n * 16 + fq * 4);
#pragma unroll
            for (int m = 0; m < 4; ++m) {
                float ss = 0.f;
#pragma unroll
                for (int n = 0; n < 4; ++n) { const f32x4 v = acc[m][n]; ss += (v.x * v.x + v.y * v.y) + (v.z * v.z + v.w * v.w); }
                ss += __shfl_xor(ss, 16); ss += __shfl_xor(ss, 32);
                float r = rsqrtf(ss * (1.f / 64.f) + RMS_EPS); if (is_q) r *= QSCALE;
                const int b = rows[m] >> 12, s = rows[m] & 4095;
                bf16_t* o = dst + ((size_t)(b * nh + hh) * SEQ + s) * 64 + fq * 4;
#pragma unroll
                for (int n = 0; n < 4; ++n) { const f32x4 v = acc[m][n] * gv[n] * r; u32x2 w; w.x = pk2(v.x, v.y); w.y = pk2(v.z, v.w); *(u32x2*)(o + n * 16) = w; }
            }
            return;
        }
        if (seg == 8 || seg == 9 || seg == 10 || seg == 11) {
            bf16_t* dst = (bf16_t*)(ws + (seg < 10 ? WS_KC : WS_VC)); const int g = seg & 1;
#pragma unroll
            for (int m = 0; m < 4; ++m) { const int b = rows[m] >> 12, s = rows[m] & 4095; bf16_t* o = dst + ((size_t)(b * 2 + g) * SEQ + s) * 64 + fq * 4;
#pragma unroll
                for (int n = 0; n < 4; ++n) { const f32x4 v = acc[m][n]; u32x2 w; w.x = pk2(v.x, v.y); w.y = pk2(v.z, v.w); *(u32x2*)(o + n * 16) = w; } }
            return;
        }
        if (seg == 14 || seg == 15 || seg == 18 || seg == 19) {
            bf16_t* dst = (bf16_t*)(ws + (seg < 16 ? WS_VST : WS_VWT)); const int g = seg & 1;
#pragma unroll
            for (int m = 0; m < 4; ++m) { const int b = rows[m] >> 12, s = rows[m] & 4095; bf16_t* o = dst + (size_t)(b * 2 + g) * 64 * SEQ + s;
#pragma unroll
                for (int n = 0; n < 4; ++n) { const f32x4 v = acc[m][n]; const int d = n * 16 + fq * 4;
                    o[(size_t)(d + 0) * SEQ] = f2bf(v.x); o[(size_t)(d + 1) * SEQ] = f2bf(v.y); o[(size_t)(d + 2) * SEQ] = f2bf(v.z); o[(size_t)(d + 3) * SEQ] = f2bf(v.w); } }
            return;
        }
        if (seg < 52) {
            const int kind = (seg - 20) >> 3, cb = ((seg - 20) & 7) * 64 + fq * 4;
            if (kind == 1) {
                const float* lb = (const float*)(ws + WS_LB); float* dst = (float*)(ws + WS_HLOGF);
#pragma unroll
                for (int m = 0; m < 4; ++m)
#pragma unroll
                    for (int n = 0; n < 4; ++n) { const int c = cb + n * 16; const f32x4 l = *(const f32x4*)(lb + c); const f32x4 v = acc[m][n]; f32x4 o;
                        o.x = __logf(l.x + (1.f - l.x) * sigmoidf_(v.x)); o.y = __logf(l.y + (1.f - l.y) * sigmoidf_(v.y));
                        o.z = __logf(l.z + (1.f - l.z) * sigmoidf_(v.z)); o.w = __logf(l.w + (1.f - l.w) * sigmoidf_(v.w));
                        *(f32x4*)(dst + (size_t)rows[m] * 512 + c) = o; }
            } else {
                bf16_t* dst = (bf16_t*)(ws + (kind == 0 ? WS_HQ : (kind == 2 ? WS_HV : WS_HG)));
#pragma unroll
                for (int m = 0; m < 4; ++m)
#pragma unroll
                    for (int n = 0; n < 4; ++n) { f32x4 v = acc[m][n];
                        if (kind != 2) { v.x = siluf_(v.x); v.y = siluf_(v.y); v.z = siluf_(v.z); v.w = siluf_(v.w); }
                        u32x2 w; w.x = pk2(v.x, v.y); w.y = pk2(v.z, v.w); *(u32x2*)(dst + (size_t)rows[m] * 512 + cb + n * 16) = w; }
            }
            return;
        }
        {
            float* dst = (float*)(ws + WS_GATES);
#pragma unroll
            for (int m = 0; m < 4; ++m)
#pragma unroll
                for (int n = 0; n < 2; ++n) { const int c = n * 16 + fq * 4; if (c < 24) { const f32x4 v = acc[m][n]; f32x4 o; o.x = sigmoidf_(v.x); o.y = sigmoidf_(v.y); o.z = sigmoidf_(v.z); o.w = sigmoidf_(v.w);
                        *(f32x4*)(dst + (size_t)rows[m] * 24 + c) = o; } }
        }
    }
};
DEV void phase_inproj(const Params& p, unsigned char* lds) {
    const int vb = vblock(), G = gridDim.x;
    constexpr int NMT = NTOK / 128, NNT = INP / 256, U = NMT * NNT;
    for (int u = vb; u < U; u += G) {
        const int grp = u / (16 * NNT), rem = u % (16 * NNT), nt = rem / 16, mt = grp * 16 + rem % 16;
        ARows al{(const bf16_t*)(p.ws + WS_R1) + (size_t)mt * 128 * DM, DM};
        BRows bl{(const bf16_t*)(p.ws + WS_WINT) + (size_t)nt * 256 * DM, DM};
        EpiInproj ep{p, mt * 128, nt};
        gemm_tile(lds, al, bl, DM / 64, ep);
    }
}

struct ACmp { const bf16_t* src; int rbase;
    DEV const bf16_t* row(int r) const { int rr = rbase + r; if (rr > 4079) rr = 4079; const int bg = rr / NC, c = rr % NC; return src + ((size_t)bg * SEQ + 16 * c) * 64; } };
struct EpiCmpA { const Params& p; int z, rbase;
    DEV void operator()(f32x4 (&acc)[4][4], int wr, int wc, int lane) const {
        const int frow = lane & 15, fq = lane >> 4;
        const float* cb = (const float*)(p.ws + WS_CBIAS) + z * 256; bf16_t* hid = (bf16_t*)(p.ws + WS_HID) + (size_t)z * 4096 * 256;
#pragma unroll
        for (int m = 0; m < 4; ++m) { const int rr = rbase + wr * 64 + m * 16 + frow;
#pragma unroll
            for (int n = 0; n < 4; ++n) { const int c = wc * 64 + n * 16 + fq * 4; const f32x4 b = *(const f32x4*)(cb + c); f32x4 v = acc[m][n] + b;
                u32x2 w; w.x = pk2(siluf_(v.x), siluf_(v.y)); w.y = pk2(siluf_(v.z), siluf_(v.w)); *(u32x2*)(hid + (size_t)rr * 256 + c) = w; } }
    } };
DEV void phase_cmp_a(const Params& p, unsigned char* lds) {
    const int vb = vblock(), G = gridDim.x;
    for (int u = vb; u < 64; u += G) {
        const int z = u >> 5, rbase = (u & 31) * 128;
        ACmp al{(const bf16_t*)(p.ws + (z ? WS_VC : WS_KC)), rbase};
        BRows bl{(const bf16_t*)(p.ws + WS_CW1T) + (size_t)z * 256 * 2048, 2048};
        EpiCmpA ep{p, z, rbase};
        gemm_tile(lds, al, bl, 2048 / 64, ep);
    }
}
struct BClamp64 { const bf16_t* base; size_t ld; DEV const bf16_t* ptr(int n, int kt) const { return base + (size_t)(n & 63) * ld + kt * 64; } };
struct EpiCmpB { const Params& p; int z, rbase;
    DEV void operator()(f32x4 (&acc)[4][4], int wr, int wc, int lane) const {
        if (wc != 0) return;
        const int frow = lane & 15, fq = lane >> 4;
        bf16_t* dst = (bf16_t*)(p.ws + (z ? WS_VCMP : WS_KCMP));
#pragma unroll
        for (int m = 0; m < 4; ++m) { const int rr = rbase + wr * 64 + m * 16 + frow;
            float r = 1.f;
            if (z == 0) { float ss = 0.f;
#pragma unroll
                for (int n = 0; n < 4; ++n) { const f32x4 v = acc[m][n]; ss += (v.x * v.x + v.y * v.y) + (v.z * v.z + v.w * v.w); }
                ss += __shfl_xor(ss, 16); ss += __shfl_xor(ss, 32); r = rsqrtf(ss * (1.f / 64.f) + RMS_EPS); }
            if (rr < 4080) { const int bg = rr / NC, c = rr % NC;
#pragma unroll
                for (int n = 0; n < 4; ++n) { const int d = n * 16 + fq * 4; f32x4 v = acc[m][n] * r;
                    if (z == 0) { const f32x4 g = *(const f32x4*)(p.g_k + d); v = v * g; }
                    u32x2 w; w.x = pk2(v.x, v.y); w.y = pk2(v.z, v.w); *(u32x2*)(dst + ((size_t)bg * 256 + c) * 64 + d) = w; } }
        }
    } };
DEV void phase_cmp_b(const Params& p, unsigned char* lds) {
    const int vb = vblock(), G = gridDim.x;
    for (int u = vb; u < 64; u += G) {
        const int z = u >> 5, rbase = (u & 31) * 128;
        ARows al{(const bf16_t*)(p.ws + WS_HID) + ((size_t)z * 4096 + rbase) * 256, 256};
        BClamp64 bl{(const bf16_t*)(p.ws + WS_CW2T) + (size_t)z * 64 * 256, 256};
        EpiCmpB ep{p, z, rbase};
        gemm_tile(lds, al, bl, 256 / 64, ep);
    }
}

constexpr int CA_KS = 0, CA_VS = 256 * 132, CA_QS = CA_VS + 256 * 128, CA_PB = CA_QS + 8 * 4 * 64 * 4, CA_LDS = CA_PB + 8 * 256 * 4 * 4;
DEV void phase_cmp_attn(const Params& p, unsigned char* lds) {
    const int tid = threadIdx.x, lane = tid & 63, wid = tid >> 6;
    const int vb = vblock(), G = gridDim.x;
    unsigned char* ws = p.ws;
    const bf16_t* Q = (const bf16_t*)(ws + WS_Q);
    const float* gates = (const float*)(ws + WS_GATES);
    bf16_t* OC = (bf16_t*)(ws + WS_OC);
    unsigned long long* selm = (unsigned long long*)(ws + WS_SELM);
    float* qs = (float*)(lds + CA_QS) + wid * 256;
    float* pb = (float*)(lds + CA_PB) + wid * 1024;
    for (int it = vb; it < 1024; it += G) {
        const int rnd = it / G, pos = it % G; int sidx = (rnd & 1) ? (rnd * G + (G - 1 - pos)) : (rnd * G + pos); if (G != 256) sidx = it;
        const int ci = 63 - (sidx >> 4), bg = sidx & 15, b = bg >> 1, g = bg & 1;
        const int nvis = min(NC, 4 * ci + 3);
        __syncthreads();
        {
            const bf16_t* kc = (const bf16_t*)(ws + WS_KCMP) + (size_t)bg * 256 * 64; const bf16_t* vc = (const bf16_t*)(ws + WS_VCMP) + (size_t)bg * 256 * 64;
            for (int idx = tid; idx < nvis * 32; idx += NT) { const int c = idx >> 5, d2 = idx & 31;
                *(unsigned*)(lds + CA_KS + c * 132 + d2 * 4) = *(const unsigned*)(kc + c * 64 + d2 * 2);
                *(unsigned*)(lds + CA_VS + c * 128 + d2 * 4) = *(const unsigned*)(vc + c * 64 + d2 * 2); }
        }
        __syncthreads();
        for (int tt = 0; tt < 8; ++tt) {
            const int t = ci * 64 + wid * 8 + tt; const size_t tok = (size_t)b * SEQ + t;
            const int nv = t >= 31 ? min(NC, (t - 31) / 16 + 1) : 0;
            const int cur = t >> 6;
            float oacc[4] = {0.f, 0.f, 0.f, 0.f};
            float imp = 0.f;
            if (nv > 0) {
                asm volatile("s_waitcnt lgkmcnt(0)" ::: "memory");
#pragma unroll
                for (int r = 0; r < 4; ++r) qs[r * 64 + lane] = bf2f(Q[((size_t)(b * 8 + g * 4 + r) * SEQ + t) * 64 + lane]);
                asm volatile("s_waitcnt lgkmcnt(0)" ::: "memory");
                const int nj = (nv + 63) >> 6;
                float sc[4][4];
#pragma unroll
                for (int j = 0; j < 4; ++j)
#pragma unroll
                    for (int r = 0; r < 4; ++r) sc[j][r] = 0.f;
                for (int d2 = 0; d2 < 32; ++d2) {
                    f32x2 qq[4];
#pragma unroll
                    for (int r = 0; r < 4; ++r) qq[r] = *(const f32x2*)(qs + r * 64 + 2 * d2);
#pragma unroll
                    for (int j = 0; j < 4; ++j) if (j < nj) {
                        const unsigned kk = *(const unsigned*)(lds + CA_KS + (lane + 64 * j) * 132 + d2 * 4); const float k0 = bflo(kk), k1 = bfhi(kk);
#pragma unroll
                        for (int r = 0; r < 4; ++r) sc[j][r] += qq[r].x * k0 + qq[r].y * k1;
                    }
                }
                float mx[4], sm[4];
#pragma unroll
                for (int r = 0; r < 4; ++r) { float m = -1e30f;
#pragma unroll
                    for (int j = 0; j < 4; ++j) if (lane + 64 * j < nv) m = fmaxf(m, sc[j][r]);
                    mx[r] = wave_max(m); }
#pragma unroll
                for (int r = 0; r < 4; ++r) { float s = 0.f;
#pragma unroll
                    for (int j = 0; j < 4; ++j) { const float e = (lane + 64 * j < nv) ? exp2f(sc[j][r] - mx[r]) : 0.f; sc[j][r] = e; s += e; }
                    sm[r] = 1.f / wave_sum(s); }
#pragma unroll
                for (int j = 0; j < 4; ++j) { f32x4 pv; pv.x = sc[j][0] * sm[0]; pv.y = sc[j][1] * sm[1]; pv.z = sc[j][2] * sm[2]; pv.w = sc[j][3] * sm[3]; *(f32x4*)(pb + (lane + 64 * j) * 4) = pv; }
                asm volatile("s_waitcnt lgkmcnt(0)" ::: "memory");
                {
                    const int c0 = 4 * lane;
                    f32x4 a = *(const f32x4*)(pb + (c0) * 4), b1 = *(const f32x4*)(pb + (c0 + 1) * 4), c2 = *(const f32x4*)(pb + (c0 + 2) * 4), d3 = *(const f32x4*)(pb + (c0 + 3) * 4);
                    f32x4 pm = (f32x4){0.f, 0.f, 0.f, 0.f}; if (lane > 0) pm = *(const f32x4*)(pb + (c0 - 1) * 4);
                    const f32x4 s4 = (a + b1 + c2) + (pm + d3) * 0.5f;
                    imp = (s4.x + s4.y) + (s4.z + s4.w);
                }
                for (int c = 0; c < nv; ++c) { const f32x4 pp = *(const f32x4*)(pb + c * 4); const float v = bf2f(*(const bf16_t*)(lds + CA_VS + c * 128 + lane * 2));
                    oacc[0] += pp.x * v; oacc[1] += pp.y * v; oacc[2] += pp.z * v; oacc[3] += pp.w * v; }
            }
            {
                const float INF = __builtin_inff();
                const float v = (lane == 0 || lane == cur) ? INF : (lane < cur ? imp : -INF);
                int rank = 0;
                for (int i = 0; i <= cur; ++i) { const float vi = __uint_as_float(__builtin_amdgcn_readlane(__float_as_uint(v), i)); rank += ((vi > v) || (vi == v && i < lane)) ? 1 : 0; }
                const bool sel = (lane <= cur) && (rank < 16);
                const unsigned long long mask = __ballot(sel);
                if (lane == 0) selm[(size_t)bg * SEQ + t] = mask;
            }
#pragma unroll
            for (int r = 0; r < 4; ++r) { const int h = g * 4 + r; const float gt = gates[tok * 24 + h * 3 + 0]; OC[tok * 512 + h * 64 + lane] = f2bf(gt * oacc[r]); }
        }
    }
}

constexpr int FA_KB = 64 * 128, FA_VB = 64 * 136, FA_STAGE = FA_KB + FA_VB, FA_LDS = 2 * FA_STAGE + 1024;
template <bool SEL>
DEV void fa_branch(unsigned char* lds, const bf16_t* Kb, const bf16_t* VTb, int ci, int bg, const bf16x8 (&qf)[4], int t, unsigned long long mymask, unsigned long long need,
                   f32x16 (&ot)[2], float& m_run, float& l_run) {
    const int tid = threadIdx.x, lane = tid & 63;
    const int r31 = lane & 31, hh = lane >> 5;
    const int lrow = tid >> 3, lch = tid & 7;
    const bf16_t* kg = Kb + ((size_t)bg * SEQ + lrow) * 64 + lch * 8;
    const bf16_t* vg = VTb + ((size_t)bg * 64 + lrow) * SEQ + lch * 8;
    const int koff = lrow * 128 + ((lch ^ ((lrow >> 1) & 7)) << 4), voff = FA_KB + lrow * 136 + lch * 16;
    int jlo, jhi; unsigned long long todo;
    if (SEL) { todo = need; jlo = 0; jhi = ci; } else { jlo = ci >= 8 ? ci - 8 : 0; jhi = ci; todo = 0; }
    int j = jlo;
    if (SEL) { if (todo == 0) return; j = __builtin_ctzll(todo); todo &= todo - 1; }
    u32x4 rk = *(const u32x4*)(kg + (size_t)j * 64 * 64), rv = *(const u32x4*)(vg + (size_t)j * 64);
    __syncthreads();
    *(u32x4*)(lds + koff) = rk; { u32x2 a, b2; a.x = rv.x; a.y = rv.y; b2.x = rv.z; b2.y = rv.w; *(u32x2*)(lds + voff) = a; *(u32x2*)(lds + voff + 8) = b2; }
    __syncthreads();
    int st = 0;
    for (;;) {
        int jn; bool more;
        if (SEL) { more = (todo != 0); jn = more ? __builtin_ctzll(todo) : 0; todo &= todo - 1; } else { jn = j + 1; more = (jn <= jhi); }
        if (more) { rk = *(const u32x4*)(kg + (size_t)jn * 64 * 64); rv = *(const u32x4*)(vg + (size_t)jn * 64); }
        const unsigned char* base = lds + st * FA_STAGE;
        f32x16 sacc[2];
#pragma unroll
        for (int kt2 = 0; kt2 < 2; ++kt2) {
#pragma unroll
            for (int i = 0; i < 16; ++i) sacc[kt2][i] = 0.f;
            const int row = 32 * kt2 + r31; const int sx = (row >> 1) & 7;
#pragma unroll
            for (int s = 0; s < 4; ++s) { const bf16x8 kf = *(const bf16x8*)(base + row * 128 + (((2 * s + hh) ^ sx) << 4));
                sacc[kt2] = __builtin_amdgcn_mfma_f32_32x32x16_bf16(kf, qf[s], sacc[kt2], 0, 0, 0); }
        }
        const bool bit = SEL ? ((mymask >> j) & 1ull) != 0 : true;
        float mx = -1e30f;
#pragma unroll
        for (int kt2 = 0; kt2 < 2; ++kt2)
#pragma unroll
            for (int i = 0; i < 16; ++i) { const int key = 64 * j + 32 * kt2 + (i & 3) + 8 * (i >> 2) + 4 * hh;
                const bool ok = SEL ? (bit && key <= t) : (key <= t && t - key < 512);
                const float v = ok ? sacc[kt2][i] : -1e30f; sacc[kt2][i] = v; mx = fmaxf(mx, v); }
        mx = fmaxf(mx, __shfl_xor(mx, 32));
        const float m_new = fmaxf(m_run, mx);
        const float alpha = exp2f(m_run - m_new);
        m_run = m_new;
        float rs = 0.f;
#pragma unroll
        for (int kt2 = 0; kt2 < 2; ++kt2)
#pragma unroll
            for (int i = 0; i < 16; ++i) { const float v = sacc[kt2][i]; const float e = (v > -5e29f) ? exp2f(v - m_new) : 0.f; sacc[kt2][i] = e; rs += e; }
        l_run = l_run * alpha + rs;
#pragma unroll
        for (int dt = 0; dt < 2; ++dt)
#pragma unroll
            for (int i = 0; i < 16; ++i) ot[dt][i] *= alpha;
#pragma unroll
        for (int kt2 = 0; kt2 < 2; ++kt2)
#pragma unroll
            for (int s2 = 0; s2 < 2; ++s2) {
                bf16x8 pf; { u32x4 w; w.x = pk2(sacc[kt2][8 * s2 + 0], sacc[kt2][8 * s2 + 1]); w.y = pk2(sacc[kt2][8 * s2 + 2], sacc[kt2][8 * s2 + 3]);
                    w.z = pk2(sacc[kt2][8 * s2 + 4], sacc[kt2][8 * s2 + 5]); w.w = pk2(sacc[kt2][8 * s2 + 6], sacc[kt2][8 * s2 + 7]); pf = __builtin_bit_cast(bf16x8, w); }
#pragma unroll
                for (int dt = 0; dt < 2; ++dt) {
                    const unsigned char* va = base + FA_KB + (32 * dt + r31) * 136 + (32 * kt2 + 16 * s2 + 4 * hh) * 2;
                    const u32x2 lo = *(const u32x2*)(va), hi = *(const u32x2*)(va + 16);
                    u32x4 w; w.x = lo.x; w.y = lo.y; w.z = hi.x; w.w = hi.y;
                    ot[dt] = __builtin_amdgcn_mfma_f32_32x32x16_bf16(__builtin_bit_cast(bf16x8, w), pf, ot[dt], 0, 0, 0);
                }
            }
        if (!more) break;
        { unsigned char* nb = lds + (st ^ 1) * FA_STAGE; *(u32x4*)(nb + koff) = rk; u32x2 a, b2; a.x = rv.x; a.y = rv.y; b2.x = rv.z; b2.y = rv.w; *(u32x2*)(nb + voff) = a; *(u32x2*)(nb + voff + 8) = b2; }
        __syncthreads();
        st ^= 1; j = jn;
    }
}
DEV void phase_flash(const Params& p, unsigned char* lds) {
    const int tid = threadIdx.x, lane = tid & 63, wid = tid >> 6;
    const int vb = vblock(), G = gridDim.x;
    unsigned char* ws = p.ws;
    const int r31 = lane & 31, hh = lane >> 5;
    unsigned long long* red = (unsigned long long*)(lds + 2 * FA_STAGE);
    for (int it = vb; it < 1024; it += G) {
        const int rnd = it / G, pos = it % G; int sidx = (rnd & 1) ? (rnd * G + (G - 1 - pos)) : (rnd * G + pos); if (G != 256) sidx = it;
        const int ci = 63 - (sidx >> 4), bg = sidx & 15, b = bg >> 1, g = bg & 1;
        const int head = g * 4 + (wid >> 1);
        const int t = ci * 64 + (wid & 1) * 32 + r31;
        const size_t tok = (size_t)b * SEQ + t;
        bf16x8 qf[4];
        { const bf16_t* qp = (const bf16_t*)(ws + WS_Q) + ((size_t)(b * 8 + head) * SEQ + t) * 64 + 8 * hh;
#pragma unroll
            for (int s = 0; s < 4; ++s) qf[s] = *(const bf16x8*)(qp + 16 * s); }
        const unsigned long long mymask = ((const unsigned long long*)(ws + WS_SELM))[(size_t)bg * SEQ + t];
        unsigned long long orm = mymask;
#pragma unroll
        for (int o = 1; o < 32; o <<= 1) { const unsigned lo = __shfl_xor((unsigned)orm, o), hi = __shfl_xor((unsigned)(orm >> 32), o); orm |= ((unsigned long long)hi << 32) | lo; }
        __syncthreads();
        if (wid < 2 && lane == 0) red[wid] = orm;
        __syncthreads();
        const unsigned long long need = red[0] | red[1];
        f32x16 oc[2];
        {
            f32x16 ot[2]; float m_run = -1e30f, l_run = 0.f;
#pragma unroll
            for (int dt = 0; dt < 2; ++dt)
#pragma unroll
                for (int i = 0; i < 16; ++i) ot[dt][i] = 0.f;
            fa_branch<true>(lds, (const bf16_t*)(ws + WS_KS), (const bf16_t*)(ws + WS_VST), ci, bg, qf, t, mymask, need, ot, m_run, l_run);
            const float lt = l_run + __shfl_xor(l_run, 32);
            const float sc = ((const float*)(ws + WS_GATES))[tok * 24 + head * 3 + 1] / lt;
#pragma unroll
            for (int dt = 0; dt < 2; ++dt)
#pragma unroll
                for (int i = 0; i < 16; ++i) oc[dt][i] = ot[dt][i] * sc;
        }
        {
            f32x16 ot[2]; float m_run = -1e30f, l_run = 0.f;
#pragma unroll
            for (int dt = 0; dt < 2; ++dt)
#pragma unroll
                for (int i = 0; i < 16; ++i) ot[dt][i] = 0.f;
            fa_branch<false>(lds, (const bf16_t*)(ws + WS_KW), (const bf16_t*)(ws + WS_VWT), ci, bg, qf, t, 0ull, 0ull, ot, m_run, l_run);
            const float lt = l_run + __shfl_xor(l_run, 32);
            const float sc = ((const float*)(ws + WS_GATES))[tok * 24 + head * 3 + 2] / lt;
#pragma unroll
            for (int dt = 0; dt < 2; ++dt)
#pragma unroll
                for (int i = 0; i < 16; ++i) oc[dt][i] += ot[dt][i] * sc;
        }
        {
            const bf16_t* ocp = (const bf16_t*)(ws + WS_OC) + tok * 512 + head * 64;
            bf16_t* mix = (bf16_t*)(ws + WS_R1) + tok * 1024 + head * 64;
            float ss = 0.f;
#pragma unroll
            for (int dt = 0; dt < 2; ++dt)
#pragma unroll
                for (int g4 = 0; g4 < 4; ++g4) { const int d0 = 32 * dt + 8 * g4 + 4 * hh; const u32x2 c = *(const u32x2*)(ocp + d0);
                    const float v0 = oc[dt][4 * g4 + 0] + bflo(c.x), v1 = oc[dt][4 * g4 + 1] + bfhi(c.x), v2 = oc[dt][4 * g4 + 2] + bflo(c.y), v3 = oc[dt][4 * g4 + 3] + bfhi(c.y);
                    ss += (v0 * v0 + v1 * v1) + (v2 * v2 + v3 * v3);
                    u32x2 w; w.x = pk2(v0, v1); w.y = pk2(v2, v3); *(u32x2*)(mix + d0) = w; }
            ss += __shfl_xor(ss, 32);
            if (hh == 0) atomicAdd((float*)(ws + WS_ROWSS) + tok, ss);
        }
    }
}

DEV void phase_hgrn_naive(const Params& p, unsigned char* lds) {
    const int tid = threadIdx.x;
    unsigned char* ws = p.ws;
    float* lq = (float*)lds; float* lf = lq + 8 * 512;
    const bf16_t* HQ = (const bf16_t*)(ws + WS_HQ); const float* HL = (const float*)(ws + WS_HLOGF); const bf16_t* HV = (const bf16_t*)(ws + WS_HV);
    bf16_t* mix = (bf16_t*)(ws + WS_R1);
    for (int b = blockIdx.x; b < BATCH; b += gridDim.x) {
        float st[128];
#pragma unroll
        for (int k = 0; k < 128; ++k) st[k] = 0.f;
        const int h = tid >> 7;
        for (int t0 = 0; t0 < SEQ; t0 += 8) {
            __syncthreads();
#pragma unroll
            for (int i = 0; i < 8; ++i) { const size_t gi = ((size_t)b * SEQ + t0 + i) * 512 + tid; lq[i * 512 + tid] = bf2f(HQ[gi]); lf[i * 512 + tid] = __expf(HL[gi]); }
            __syncthreads();
            for (int i = 0; i < 8; ++i) {
                const size_t row = (size_t)b * SEQ + t0 + i;
                const float vt = bf2f(HV[row * 512 + tid]);
                float o = 0.f;
                const f32x4* q4 = (const f32x4*)(lq + i * 512 + h * 128); const f32x4* f4 = (const f32x4*)(lf + i * 512 + h * 128);
#pragma unroll
                for (int k4 = 0; k4 < 32; ++k4) { const f32x4 q = q4[k4], f = f4[k4];
                    st[4 * k4 + 0] = f.x * st[4 * k4 + 0] + (1.f - f.x) * vt; o += q.x * st[4 * k4 + 0];
                    st[4 * k4 + 1] = f.y * st[4 * k4 + 1] + (1.f - f.y) * vt; o += q.y * st[4 * k4 + 1];
                    st[4 * k4 + 2] = f.z * st[4 * k4 + 2] + (1.f - f.z) * vt; o += q.z * st[4 * k4 + 2];
                    st[4 * k4 + 3] = f.w * st[4 * k4 + 3] + (1.f - f.w) * vt; o += q.w * st[4 * k4 + 3]; }
                mix[row * 1024 + 512 + tid] = f2bf(o);
            }
        }
    }
}

DEV void phase_normalize(const Params& p, unsigned char* lds) {
    const int tid = threadIdx.x, lane = tid & 63, wid = tid >> 6;
    const int vb = vblock(), G = gridDim.x;
    unsigned char* ws = p.ws;
    bf16_t* mix = (bf16_t*)(ws + WS_R1); const float* rowss = (const float*)(ws + WS_ROWSS); const bf16_t* HG = (const bf16_t*)(ws + WS_HG);
    for (int m = vb * 8 + wid; m < NTOK; m += G * 8) {
        {
            const float r = rsqrtf(rowss[m] * (1.f / 512.f) + RMS_EPS);
            u32x4* pp = (u32x4*)(mix + (size_t)m * 1024) + lane; u32x4 v = *pp;
            v.x = pk2(bflo(v.x) * r, bfhi(v.x) * r); v.y = pk2(bflo(v.y) * r, bfhi(v.y) * r); v.z = pk2(bflo(v.z) * r, bfhi(v.z) * r); v.w = pk2(bflo(v.w) * r, bfhi(v.w) * r);
            *pp = v;
        }
        {
            u32x4* pp = (u32x4*)(mix + (size_t)m * 1024 + 512) + lane; const u32x4 v = *pp; const u32x4 gg = *((const u32x4*)(HG + (size_t)m * 512) + lane);
            float x[8] = {bflo(v.x), bfhi(v.x), bflo(v.y), bfhi(v.y), bflo(v.z), bfhi(v.z), bflo(v.w), bfhi(v.w)};
            const float gt[8] = {bflo(gg.x), bfhi(gg.x), bflo(gg.y), bfhi(gg.y), bflo(gg.z), bfhi(gg.z), bflo(gg.w), bfhi(gg.w)};
            float ss = 0.f;
#pragma unroll
            for (int i = 0; i < 8; ++i) ss += x[i] * x[i];
            ss += __shfl_xor(ss, 1); ss += __shfl_xor(ss, 2); ss += __shfl_xor(ss, 4); ss += __shfl_xor(ss, 8);
            const float r = rsqrtf(ss * (1.f / 128.f) + RMS_EPS);
            const float* gn = p.g_hn + (lane & 15) * 8;
#pragma unroll
            for (int i = 0; i < 8; ++i) x[i] = x[i] * r * gn[i] * gt[i];
            u32x4 o; o.x = pk2(x[0], x[1]); o.y = pk2(x[2], x[3]); o.z = pk2(x[4], x[5]); o.w = pk2(x[6], x[7]);
            *pp = o;
        }
    }
}

struct EpiOut { const Params& p; int m0, n0;
    DEV void operator()(f32x4 (&acc)[4][4], int wr, int wc, int lane) const {
        const int frow = lane & 15, fq = lane >> 4;
#pragma unroll
        for (int m = 0; m < 4; ++m) { const size_t row = m0 + wr * 64 + m * 16 + frow;
#pragma unroll
            for (int n = 0; n < 4; ++n) { const int c = n0 + wc * 64 + n * 16 + fq * 4; const f32x4 xv = *(const f32x4*)(p.x + row * DM + c); *(f32x4*)(p.out + row * DM + c) = xv + acc[m][n]; } }
    } };
DEV void phase_outproj(const Params& p, unsigned char* lds) {
    const int vb = vblock(), G = gridDim.x;
    constexpr int U = (NTOK / 128) * 4;
    for (int u = vb; u < U; u += G) {
        const int mt = u >> 2, nt = u & 3;
        ARows al{(const bf16_t*)(p.ws + WS_R1) + (size_t)mt * 128 * DM, DM};
        BRows bl{(const bf16_t*)(p.ws + WS_WOUTT) + (size_t)nt * 256 * DM, DM};
        EpiOut ep{p, mt * 128, nt * 256};
        gemm_tile(lds, al, bl, DM / 64, ep);
    }
}

constexpr int RT_HS = 0, RT_WS = 128 * 33 * 4, RT_LG = RT_WS + 32 * 36 * 4, RT_RS = RT_LG + 128 * 37 * 4, RT_HIST = RT_RS + 512, RT_BASE = RT_HIST + 512, RT_LDS = RT_BASE + 512;
DEV void phase_router(const Params& p, unsigned char* lds) {
    const int tid = threadIdx.x;
    const int vb = vblock(), G = gridDim.x;
    unsigned char* ws = p.ws;
    float* hs = (float*)(lds + RT_HS); float* wsm = (float*)(lds + RT_WS); float* lg = (float*)(lds + RT_LG); float* rsd = (float*)(lds + RT_RS);
    int* hist = (int*)(lds + RT_HIST); int* basep = (int*)(lds + RT_BASE);
    bf16_t* hb = (bf16_t*)(ws + WS_R1);
    const int tok = tid & 127, cgp = tid >> 7;
    for (int it = vb; it < NTOK / 128; it += G) {
        const size_t row0 = (size_t)it * 128;
        float acc[9]; float ssq[4] = {0.f, 0.f, 0.f, 0.f};
#pragma unroll
        for (int c = 0; c < 9; ++c) acc[c] = 0.f;
        if (tid < 128) hist[tid] = 0;
        for (int kc = 0; kc < 32; ++kc) {
            __syncthreads();
#pragma unroll
            for (int i = 0; i < 4; ++i) { const int idx = tid + NT * i, tk = idx >> 4, kp = idx & 15; const size_t gi = (row0 + tk) * DM + kc * 32 + 2 * kp;
                const f32x2 v = *(const f32x2*)(p.out + gi); hs[tk * 33 + 2 * kp] = v.x; hs[tk * 33 + 2 * kp + 1] = v.y; ssq[i] += v.x * v.x + v.y * v.y; *(unsigned*)(hb + gi) = pk2(v.x, v.y); }
            for (int idx = tid; idx < 32 * 36; idx += NT) { const int kk = idx / 36, c = idx % 36, k = kc * 32 + kk;
                wsm[idx] = (c < 4 ? p.w_group[k * 4 + c] : p.w_expert[k * 32 + (c - 4)]) * p.ffn_g[k]; }
            __syncthreads();
#pragma unroll 8
            for (int kk = 0; kk < 32; ++kk) { const float hv = hs[tok * 33 + kk];
#pragma unroll
                for (int c = 0; c < 9; ++c) acc[c] += hv * wsm[kk * 36 + cgp * 9 + c]; }
        }
#pragma unroll
        for (int i = 0; i < 4; ++i) { float s = ssq[i]; s += __shfl_xor(s, 1); s += __shfl_xor(s, 2); s += __shfl_xor(s, 4); s += __shfl_xor(s, 8);
            if ((tid & 15) == 0) rsd[(tid + NT * i) >> 4] = rsqrtf(s * (1.f / DM) + RMS_EPS); }
#pragma unroll
        for (int c = 0; c < 9; ++c) lg[tok * 37 + cgp * 9 + c] = acc[c];
        __syncthreads();
        int bin = 0, slot = 0;
        if (tid < 128) {
            const float rs = rsd[tid];
            ((float*)(ws + WS_RSTD2))[row0 + tid] = rs;
            float gl[4]; int gi = 0; float gm = -1e30f;
#pragma unroll
            for (int c = 0; c < 4; ++c) { gl[c] = lg[tid * 37 + c] * rs + p.b_group[c]; if (gl[c] > gm) { gm = gl[c]; gi = c; } }
            float gs = 0.f;
#pragma unroll
            for (int c = 0; c < 4; ++c) gs += __expf(gl[c] - gm);
            const float pg = 1.f / gs;
            float el[8]; int i0 = 0; float m0 = -1e30f;
#pragma unroll
            for (int c = 0; c < 8; ++c) { el[c] = lg[tid * 37 + 4 + gi * 8 + c] * rs + p.b_expert[gi * 8 + c]; if (el[c] > m0) { m0 = el[c]; i0 = c; } }
            int i1 = 0; float m1 = -1e30f;
#pragma unroll
            for (int c = 0; c < 8; ++c) if (c != i0 && el[c] > m1) { m1 = el[c]; i1 = c; }
            const float e1 = __expf(m1 - m0); const float w0 = pg / (1.f + e1), w1 = pg * e1 / (1.f + e1);
            const int a = min(i0, i1), bb = max(i0, i1);
            bin = gi * 28 + (7 * a - (a * (a - 1)) / 2) + (bb - a - 1);
            f32x2 tw; tw.x = (i0 < i1) ? w0 : w1; tw.y = (i0 < i1) ? w1 : w0;
            ((f32x2*)(ws + WS_TOKW))[row0 + tid] = tw;
            slot = atomicAdd(&hist[bin], 1);
        }
        __syncthreads();
        if (tid < NBIN) { const int h = hist[tid]; basep[tid] = h ? atomicAdd((int*)(ws + WS_CTL) + tid, h) : 0; }
        __syncthreads();
        if (tid < 128) ((int*)(ws + WS_BINL))[(size_t)bin * BINCAP + basep[bin] + slot] = (int)(row0 + tid);
        __syncthreads();
    }
}

DEV void moe_tiles(const Params& p, int* tstart  ) {
    const int tid = threadIdx.x;
    __syncthreads();
    if (tid == 0) { const int* cnt = (const int*)(p.ws + WS_CTL); int s = 0; for (int i = 0; i < NBIN; ++i) { tstart[i] = s; s += (cnt[i] + 127) >> 7; } tstart[NBIN] = s; }
    __syncthreads();
}
DEV void bin_experts(int bin, int& ea, int& eb) { const int gi = bin / 28; int pi = bin % 28, a = 0; while (pi >= 7 - a) { pi -= 7 - a; ++a; } ea = gi * 8 + a; eb = gi * 8 + a + 1 + pi; }
struct AGather { const bf16_t* hb; const int* list; int n;
    DEV const bf16_t* row(int r) const { const int t = list[r < n ? r : 0]; return hb + (size_t)t * DM; } };
struct EpiMoe1 { const Params& p; const int* list; int n; size_t hrow0; int nt;
    DEV void operator()(f32x4 (&acc)[4][4], int wr, int wc, int lane) const {
        const int frow = lane & 15, fq = lane >> 4;
        bf16_t* hbuf = (bf16_t*)(p.ws + WS_HBUF);
#pragma unroll
        for (int m = 0; m < 4; ++m) { const int r = wr * 64 + m * 16 + frow; if (r >= n) continue;
            const int t = list[r]; const float rs = ((const float*)(p.ws + WS_RSTD2))[t]; const f32x2 tw = ((const f32x2*)(p.ws + WS_TOKW))[t]; const float w = nt < 4 ? tw.x : tw.y;
#pragma unroll
            for (int n2 = 0; n2 < 4; ++n2) { const f32x4 v = acc[m][n2] * rs; const int f = ((nt & 3) * 256 + wc * 64 + n2 * 16 + fq * 4) >> 1;
                *(unsigned*)(hbuf + (hrow0 + r) * 1024 + (nt < 4 ? 0 : 512) + f) = pk2(siluf_(v.x) * v.y * w, siluf_(v.z) * v.w * w); } }
    } };
DEV void phase_moe1(const Params& p, unsigned char* lds) {
    const int vb = vblock(), G = gridDim.x;
    int* tstart = (int*)(lds + G_LDS);
    moe_tiles(p, tstart);
    const int T = tstart[NBIN], U = T * 8;
    for (int u = vb; u < U; u += G) {
        const int tile = u >> 3, nt = u & 7;
        int bin = 0; while (tstart[bin + 1] <= tile) ++bin;
        const int mt = tile - tstart[bin]; int ea, eb; bin_experts(bin, ea, eb);
        const int cnt = ((const int*)(p.ws + WS_CTL))[bin]; const int n = min(128, cnt - mt * 128);
        const int* list = (const int*)(p.ws + WS_BINL) + (size_t)bin * BINCAP + mt * 128;
        AGather al{(const bf16_t*)(p.ws + WS_R1), list, n};
        BRows bl{(const bf16_t*)(p.ws + WS_W13T) + ((size_t)(nt < 4 ? ea : eb) * 1024 + (nt & 3) * 256) * 1024, 1024};
        EpiMoe1 ep{p, list, n, (size_t)tile * 128, nt};
        gemm_tile(lds, al, bl, DM / 64, ep);
    }
}
struct BPair { const bf16_t* wa; const bf16_t* wb; DEV const bf16_t* ptr(int n, int kt) const { return kt < 8 ? wa + (size_t)n * 512 + kt * 64 : wb + (size_t)n * 512 + (kt - 8) * 64; } };
struct EpiMoe2 { const Params& p; const int* list; int n; int n0;
    DEV void operator()(f32x4 (&acc)[4][4], int wr, int wc, int lane) const {
        const int frow = lane & 15, fq = lane >> 4;
#pragma unroll
        for (int m = 0; m < 4; ++m) { const int r = wr * 64 + m * 16 + frow; if (r >= n) continue; const size_t t = list[r];
#pragma unroll
            for (int n2 = 0; n2 < 4; ++n2) { float* o = p.out + t * DM + n0 + wc * 64 + n2 * 16 + fq * 4; *(f32x4*)o = *(const f32x4*)o + acc[m][n2]; } }
    } };
DEV void phase_moe2(const Params& p, unsigned char* lds) {
    const int vb = vblock(), G = gridDim.x;
    int* tstart = (int*)(lds + G_LDS);
    moe_tiles(p, tstart);
    const int T = tstart[NBIN], U = T * 4;
    for (int u = vb; u < U; u += G) {
        const int tile = u >> 2, nt = u & 3;
        int bin = 0; while (tstart[bin + 1] <= tile) ++bin;
        const int mt = tile - tstart[bin]; int ea, eb; bin_experts(bin, ea, eb);
        const int cnt = ((const int*)(p.ws + WS_CTL))[bin]; const int n = min(128, cnt - mt * 128);
        const int* list = (const int*)(p.ws + WS_BINL) + (size_t)bin * BINCAP + mt * 128;
        ARows al{(const bf16_t*)(p.ws + WS_HBUF) + (size_t)tile * 128 * 1024, 1024};
        BPair bl{(const bf16_t*)(p.ws + WS_W2T) + ((size_t)ea * 1024 + nt * 256) * 512, (const bf16_t*)(p.ws + WS_W2T) + ((size_t)eb * 1024 + nt * 256) * 512};
        EpiMoe2 ep{p, list, n, nt * 256};
        gemm_tile(lds, al, bl, 16, ep);
    }
}

constexpr int LDS_BYTES = 112 * 1024;
constexpr int N_PHASES = 11;
__global__ void __launch_bounds__(NT) mega(Params p, int lo, int hi) {
    extern __shared__ __attribute__((aligned(16))) unsigned char lds[];
#define RUN_PHASE(k, call) do { if (lo <= (k) && (k) < hi) { call; if ((k) + 1 < hi) cg::this_grid().sync(); } } while (0)
    RUN_PHASE(0, phase_prologue(p, lds));
    RUN_PHASE(1, phase_inproj(p, lds));
    RUN_PHASE(2, phase_cmp_a(p, lds));
    RUN_PHASE(3, phase_cmp_b(p, lds));
    RUN_PHASE(4, phase_cmp_attn(p, lds));
    RUN_PHASE(5, phase_flash(p, lds));
    RUN_PHASE(6, phase_hgrn_naive(p, lds));
    RUN_PHASE(7, phase_normalize(p, lds));
    RUN_PHASE(8, phase_outproj(p, lds));
    RUN_PHASE(9, phase_router(p, lds));
    RUN_PHASE(10, phase_moe1(p, lds));
    RUN_PHASE(11, phase_moe2(p, lds));
#undef RUN_PHASE
}

extern "C" void kernel_launch(void* const* d_in, const int* in_sizes, int n_in, void* d_out, int out_size, void* d_ws, size_t ws_size, hipStream_t stream) {
    static int grid = 0;
    if (grid == 0) {
        int dev = 0, cus = 0, per_cu = 0;
        hipGetDevice(&dev);
        hipDeviceGetAttribute(&cus, hipDeviceAttributeMultiprocessorCount, dev);
        hipFuncSetAttribute((const void*)mega, hipFuncAttributeMaxDynamicSharedMemorySize, LDS_BYTES);
        hipOccupancyMaxActiveBlocksPerMultiprocessor(&per_cu, (const void*)mega, NT, LDS_BYTES);
        if (per_cu < 1) per_cu = 1;
        grid = cus;
        if (ws_size < WS_END) fprintf(stderr, "kernel_launch: workspace too small: %zu < %zu\n", ws_size, (size_t)WS_END);
        fprintf(stderr, "kernel_launch: cus %d per_cu %d grid %d ws %zu\n", cus, per_cu, grid, ws_size);
    }
    Params p{};
    const float** pp = (const float**)&p;
    for (int i = 0; i < 23; ++i) pp[i] = (const float*)d_in[i];
    p.out = (float*)d_out; p.ws = (unsigned char*)d_ws;
#if N_LAUNCH_MODE == 1
    int lo = 0, hi = N_PHASES + 1;
    void* args[] = {&p, &lo, &hi};
    hipError_t e = hipLaunchCooperativeKernel((const void*)mega, dim3(grid), dim3(NT), args, LDS_BYTES, stream);
    if (e != hipSuccess) fprintf(stderr, "cooperative launch failed: %s\n", hipGetErrorString(e));
#else
    for (int ph = 0; ph <= N_PHASES; ++ph) hipLaunchKernelGGL(mega, dim3(grid), dim3(NT), LDS_BYTES, stream, p, ph, ph + 1);
#endif
}
```

```cpp
#include <hip/hip_runtime.h>
#include <hip/hip_cooperative_groups.h>
#include <cstdio>
#include <cstdint>
#include <cstring>
namespace cg = cooperative_groups;

#ifndef N_LAUNCH_MODE
#define N_LAUNCH_MODE 1
#endif

#define DEV __device__ __forceinline__
typedef unsigned short bf16_t;
typedef short bf16x8 __attribute__((ext_vector_type(8)));
typedef float f32x4 __attribute__((ext_vector_type(4)));
typedef float f32x2 __attribute__((ext_vector_type(2)));
typedef float f32x16 __attribute__((ext_vector_type(16)));
typedef unsigned u32x4 __attribute__((ext_vector_type(4)));
typedef unsigned u32x2 __attribute__((ext_vector_type(2)));

constexpr int NT = 512;
constexpr int BATCH = 8, SEQ = 4096, DM = 1024, NTOK = BATCH * SEQ;
constexpr int IN_COLS = 3352, INP = 3584;
constexpr int NC = 255;
constexpr float RMS_EPS = 1e-6f;
constexpr float QSCALE = 0.125f * 1.4426950408889634f;
constexpr int NBIN = 112;
constexpr int BINCAP = NTOK;

constexpr size_t MiB = 1ull << 20;
constexpr size_t WS_CTL    = 0;
constexpr size_t WS_RSTD1  = 1 * MiB;
constexpr size_t WS_RSTD2  = WS_RSTD1 + 128 * 1024;
constexpr size_t WS_ROWSS  = WS_RSTD2 + 128 * 1024;
constexpr size_t WS_TOKW   = WS_ROWSS + 128 * 1024;
constexpr size_t WS_LB     = WS_TOKW + 256 * 1024;
constexpr size_t WS_CBIAS  = WS_LB + 4096;
constexpr size_t WS_SELM   = 2 * MiB;
constexpr size_t WS_GATES  = 3 * MiB;
constexpr size_t WS_KCMP   = 6 * MiB;
constexpr size_t WS_VCMP   = WS_KCMP + 512 * 1024;
constexpr size_t WS_CW2T   = 7 * MiB;
constexpr size_t WS_HID    = 8 * MiB;
constexpr size_t WS_CW1T   = 12 * MiB;
constexpr size_t WS_WOUTT  = 14 * MiB;
constexpr size_t WS_WINT   = 16 * MiB;
constexpr size_t WS_R1     = 24 * MiB;
constexpr size_t WS_Q      = 88 * MiB;
constexpr size_t WS_KC     = 120 * MiB;
constexpr size_t WS_VC     = 128 * MiB;
constexpr size_t WS_KS     = 136 * MiB;
constexpr size_t WS_KW     = 144 * MiB;
constexpr size_t WS_VST    = 152 * MiB;
constexpr size_t WS_VWT    = 160 * MiB;
constexpr size_t WS_OC     = 168 * MiB;
constexpr size_t WS_W13T   = 200 * MiB;
constexpr size_t WS_W2T    = 264 * MiB;
constexpr size_t WS_HQ     = 296 * MiB;
constexpr size_t WS_HV     = 328 * MiB;
constexpr size_t WS_HG     = 360 * MiB;
constexpr size_t WS_HLOGF  = 392 * MiB;
constexpr size_t WS_DBUF   = 456 * MiB;
constexpr size_t WS_END    = 457 * MiB;
constexpr size_t WS_UBUF   = WS_W13T;
constexpr size_t WS_BINL   = WS_HQ;
constexpr size_t WS_HBUF   = WS_HQ + 16 * MiB;

struct Params {
    const float *x, *attn_g, *ffn_g, *w_in, *w_out, *g_q, *g_k, *pos_k, *pos_v, *wk1, *wk2, *wv1, *wv2, *g_nsa, *lb_logits, *g_hn,
        *w_group, *b_group, *w_expert, *b_expert, *w1, *w3, *w2;
    float* out;
    unsigned char* ws;
};

DEV unsigned pk2(float lo, float hi) { unsigned r; asm("v_cvt_pk_bf16_f32 %0, %1, %2" : "=v"(r) : "v"(lo), "v"(hi)); return r; }
DEV bf16_t f2bf(float f) { return (bf16_t)(pk2(f, 0.f) & 0xffffu); }
DEV float bf2f(bf16_t b) { return __uint_as_float(((unsigned)b) << 16); }
DEV float bflo(unsigned u) { return __uint_as_float(u << 16); }
DEV float bfhi(unsigned u) { return __uint_as_float(u & 0xffff0000u); }
DEV float sigmoidf_(float v) { return 1.f / (1.f + __expf(-v)); }
DEV float siluf_(float v) { return v / (1.f + __expf(-v)); }
DEV float wave_sum(float v) {
#pragma unroll
    for (int o = 1; o < 64; o <<= 1) v += __shfl_xor(v, o);
    return v;
}
DEV float wave_max(float v) {
#pragma unroll
    for (int o = 1; o < 64; o <<= 1) v = fmaxf(v, __shfl_xor(v, o));
    return v;
}
DEV int vblock() { const int G = gridDim.x, b = blockIdx.x; return (G % 8 == 0) ? (b % 8) * (G / 8) + b / 8 : b; }

template <class SRC>
DEV void convert_tile(float* tl, const SRC& src, bf16_t* dst, int ldd, int n0, int k0) {
    const int tid = threadIdx.x;
    {
        const int n = tid & 63;
#pragma unroll
        for (int i = 0; i < 8; ++i) { const int kk = (tid >> 6) + 8 * i; tl[kk * 65 + n] = src.get(n0 + n, k0 + kk); }
    }
    __syncthreads();
    {
        const int n = tid >> 3, kc = tid & 7;
        const float* s = tl + (kc * 8) * 65 + n;
        u32x4 o;
        o.x = pk2(s[0 * 65], s[1 * 65]); o.y = pk2(s[2 * 65], s[3 * 65]); o.z = pk2(s[4 * 65], s[5 * 65]); o.w = pk2(s[6 * 65], s[7 * 65]);
        *(u32x4*)(dst + (size_t)(n0 + n) * ldd + k0 + kc * 8) = o;
    }
    __syncthreads();
}
struct SrcWin { const float* w; const float* g;
    DEV float get(int n, int k) const { int col; if (n < 1280) col = n; else if (n < 3328) col = n + 24; else if (n < 3352) col = 1280 + (n - 3328); else return 0.f;
        return w[(size_t)k * IN_COLS + col] * g[k]; } };
struct SrcWout { const float* w; const float* g;
    DEV float get(int n, int k) const { const float v = w[(size_t)k * DM + n]; return k < 512 ? v * g[k] : v; } };
struct SrcPlain { const float* w; int ld;
    DEV float get(int n, int k) const { return w[(size_t)k * ld + n]; } };
struct SrcW13 { const float* w1; const float* w3; const float* g;
    DEV float get(int n, int k) const { const uintptr_t a = (uintptr_t)w1, b = (uintptr_t)w3; const float* w = (const float*)(a + ((b - a) & (uintptr_t)(0 - (long long)(n & 1))));
        return w[(size_t)k * 512 + (n >> 1)] * g[k]; } };

DEV void phase_prologue(const Params& p, unsigned char* lds) {
    float* tl = (float*)lds;
    const int tid = threadIdx.x, lane = tid & 63, wid = tid >> 6;
    const int vb = vblock(), G = gridDim.x;
    unsigned char* ws = p.ws;
    constexpr int I_WIN = (INP / 64) * (DM / 64);
    constexpr int I_WOUT = 16 * 16;
    constexpr int I_CW1 = 2 * 4 * 32;
    constexpr int I_CW2 = 2 * 1 * 4;
    constexpr int I_W13 = 32 * 16 * 16;
    constexpr int I_W2 = 32 * 16 * 8;
    constexpr int I_ALL = I_WIN + I_WOUT + I_CW1 + I_CW2 + I_W2;
    for (int it = vb; it < I_ALL; it += G) {
        int r = it;
        if (r < I_WIN) { SrcWin s{p.w_in, p.attn_g}; convert_tile(tl, s, (bf16_t*)(ws + WS_WINT), DM, (r / 16) * 64, (r % 16) * 64); continue; } r -= I_WIN;
        if (r < I_WOUT) { SrcWout s{p.w_out, p.g_nsa}; convert_tile(tl, s, (bf16_t*)(ws + WS_WOUTT), DM, (r / 16) * 64, (r % 16) * 64); continue; } r -= I_WOUT;
        if (r < I_CW1) { const int z = r / 128, q = r % 128; SrcPlain s{z ? p.wv1 : p.wk1, 256};
            convert_tile(tl, s, (bf16_t*)(ws + WS_CW1T) + (size_t)z * 256 * 2048, 2048, (q / 32) * 64, (q % 32) * 64); continue; } r -= I_CW1;
        if (r < I_CW2) { const int z = r / 4, q = r % 4; SrcPlain s{z ? p.wv2 : p.wk2, 64};
            convert_tile(tl, s, (bf16_t*)(ws + WS_CW2T) + (size_t)z * 64 * 256, 256, 0, q * 64); continue; } r -= I_CW2;
        { const int e = r / 128, q = r % 128; SrcPlain s{p.w2 + (size_t)e * 512 * 1024, 1024};
            convert_tile(tl, s, (bf16_t*)(ws + WS_W2T) + (size_t)e * 1024 * 512, 512, (q / 8) * 64, (q % 8) * 64); }
    }
    {
        bf16_t* xb = (bf16_t*)(ws + WS_R1); float* rstd1 = (float*)(ws + WS_RSTD1);
        const int gw = vb * 8 + wid, NGW = G * 8;
        for (int m = gw; m < NTOK; m += NGW) {
            const f32x4* xr = (const f32x4*)(p.x + (size_t)m * DM) + lane;
            f32x4 v[4]; float s = 0.f;
#pragma unroll
            for (int j = 0; j < 4; ++j) { v[j] = xr[64 * j]; s += (v[j].x * v[j].x + v[j].y * v[j].y) + (v[j].z * v[j].z + v[j].w * v[j].w); }
            s = wave_sum(s);
            if (lane == 0) rstd1[m] = rsqrtf(s * (1.f / DM) + RMS_EPS);
            u32x2* o = (u32x2*)(xb + (size_t)m * DM) + lane;
#pragma unroll
            for (int j = 0; j < 4; ++j) { u32x2 w; w.x = pk2(v[j].x, v[j].y); w.y = pk2(v[j].z, v[j].w); o[64 * j] = w; }
        }
    }
    {
        const int gt = vb * NT + tid, NG = G * NT;
        float* rowss = (float*)(ws + WS_ROWSS);
        for (int i = gt; i < NTOK; i += NG) rowss[i] = 0.f;
        int* bincnt = (int*)(ws + WS_CTL);
        if (gt < 128) bincnt[gt] = 0;
        if (gt < 512) { const float l0 = p.lb_logits[gt], l1 = p.lb_logits[512 + gt]; ((float*)(ws + WS_LB))[gt] = 1.f / (1.f + __expf(l1 - l0)); }
        if (blockIdx.x == (unsigned)(G - 1)) {
            const int z = tid >> 8, j = tid & 255; const float* pos = z ? p.pos_v : p.pos_k; const float* w = z ? p.wv1 : p.wk1;
            float a = 0.f;
            for (int k = 0; k < 2048; ++k) a += pos[k] * w[(size_t)k * 256 + j];
            ((float*)(ws + WS_CBIAS))[z * 256 + j] = a;
        }
    }
}

constexpr int G_A_BYTES = 128 * 128, G_B_BYTES = 256 * 128, G_STAGE = G_A_BYTES + G_B_BYTES, G_LDS = 2 * G_STAGE;
DEV int swz(int row, int chunk) { return row * 128 + ((chunk ^ ((row >> 1) & 7)) << 4); }
template <class AL, class BL, class EP>
DEV void gemm_tile(unsigned char* lds, const AL& al, const BL& bl, int nk, const EP& ep) {
    const int tid = threadIdx.x, lane = tid & 63, wid = tid >> 6, wr = wid >> 2, wc = wid & 3;
    const int frow = lane & 15, fq = lane >> 4;
    const bf16_t* aptr[2]; int aoff[2], boff[4], brow[4];
#pragma unroll
    for (int i = 0; i < 2; ++i) { const int q = tid + NT * i, row = q >> 3, ch = q & 7; aptr[i] = al.row(row) + ch * 8; aoff[i] = swz(row, ch); }
#pragma unroll
    for (int i = 0; i < 4; ++i) { const int q = tid + NT * i, row = q >> 3, ch = q & 7; brow[i] = row; boff[i] = G_A_BYTES + swz(row, ch) ; }
    const int bch8 = (tid & 7) * 8;
    u32x4 ra[2], rb[4];
#pragma unroll
    for (int i = 0; i < 2; ++i) ra[i] = *(const u32x4*)(aptr[i]);
#pragma unroll
    for (int i = 0; i < 4; ++i) rb[i] = *(const u32x4*)(bl.ptr(brow[i], 0) + bch8);
#pragma unroll
    for (int i = 0; i < 2; ++i) *(u32x4*)(lds + aoff[i]) = ra[i];
#pragma unroll
    for (int i = 0; i < 4; ++i) *(u32x4*)(lds + boff[i]) = rb[i];
    __syncthreads();
    f32x4 acc[4][4];
#pragma unroll
    for (int m = 0; m < 4; ++m)
#pragma unroll
        for (int n = 0; n < 4; ++n) acc[m][n] = (f32x4){0.f, 0.f, 0.f, 0.f};
    const int sx = (frow >> 1) & 7;
    for (int kt = 0; kt < nk; ++kt) {
        const bool more = (kt + 1 < nk);
        if (more) {
#pragma unroll
            for (int i = 0; i < 2; ++i) ra[i] = *(const u32x4*)(aptr[i] + (kt + 1) * 64);
#pragma unroll
            for (int i = 0; i < 4; ++i) rb[i] = *(const u32x4*)(bl.ptr(brow[i], kt + 1) + bch8);
        }
        const unsigned char* base = lds + (kt & 1) * G_STAGE;
#pragma unroll
        for (int ks = 0; ks < 2; ++ks) {
            const int co = ((ks * 4 + fq) ^ sx) << 4;
            bf16x8 af[4], bfr[4];
#pragma unroll
            for (int m = 0; m < 4; ++m) af[m] = *(const bf16x8*)(base + (wr * 64 + m * 16 + frow) * 128 + co);
#pragma unroll
            for (int n = 0; n < 4; ++n) bfr[n] = *(const bf16x8*)(base + G_A_BYTES + (wc * 64 + n * 16 + frow) * 128 + co);
#pragma unroll
            for (int m = 0; m < 4; ++m)
#pragma unroll
                for (int n = 0; n < 4; ++n) acc[m][n] = __builtin_amdgcn_mfma_f32_16x16x32_bf16(bfr[n], af[m], acc[m][n], 0, 0, 0);
        }
        if (more) {
            unsigned char* nb = lds + ((kt + 1) & 1) * G_STAGE;
#pragma unroll
            for (int i = 0; i < 2; ++i) *(u32x4*)(nb + aoff[i]) = ra[i];
#pragma unroll
            for (int i = 0; i < 4; ++i) *(u32x4*)(nb + boff[i]) = rb[i];
        }
        __syncthreads();
    }
    ep(acc, wr, wc, lane);
}

struct ARows { const bf16_t* base; size_t ld; DEV const bf16_t* row(int r) const { return base + (size_t)r * ld; } };
struct BRows { const bf16_t* base; size_t ld; DEV const bf16_t* ptr(int n, int kt) const { return base + (size_t)n * ld + kt * 64; } };

struct EpiInproj {
    const Params& p; int m0, ntile;
    DEV void operator()(f32x4 (&acc)[4][4], int wr, int wc, int lane) const {
        const int frow = lane & 15, fq = lane >> 4;
        const int seg = ntile * 4 + wc;
        if (seg > 52) return;
        unsigned char* ws = p.ws;
        const float* rstd1 = (const float*)(ws + WS_RSTD1);
        int rows[4];
#pragma unroll
        for (int m = 0; m < 4; ++m) { rows[m] = m0 + wr * 64 + m * 16 + frow; const float rs = rstd1[rows[m]];
#pragma unroll
            for (int n = 0; n < 4; ++n) acc[m][n] = acc[m][n] * rs; }
        const bool is_q = seg < 8, is_ks = (seg == 12 || seg == 13), is_kw = (seg == 16 || seg == 17);
        if (is_q || is_ks || is_kw) {
            const float* gw = is_q ? p.g_q : (is_ks ? p.g_k + 64 : p.g_k + 128);
            bf16_t* dst; int hh, nh;
            if (is_q) { dst = (bf16_t*)(ws + WS_Q); hh = seg; nh = 8; } else if (is_ks) { dst = (bf16_t*)(ws + WS_KS); hh = seg - 12; nh = 2; } else { dst = (bf16_t*)(ws + WS_KW); hh = seg - 16; nh = 2; }
            f32x4 gv[4];
#pragma unroll
            for (int n = 0; n < 4; ++n) gv[n] = *(const f32x4*)(gw + n * 16 + fq * 4);
#pragma unroll
            for (int m = 0; m < 4; ++m) {
                float ss = 0.f;
#pragma unroll
                for (int n = 0; n < 4; ++n) { const f32x4 v = acc[m][n]; ss += (v.x * v.x + v.y * v.y) + (v.z * v.z + v.w * v.w); }
                ss += __shfl_xor(ss, 16); ss += __shfl_xor(ss, 32);
                float r = rsqrtf(ss * (1.f / 64.f) + RMS_EPS); if (is_q) r *= QSCALE;
                const int b = rows[m] >> 12, s = rows[m] & 4095;
                bf16_t* o = dst + ((size_t)(b * nh + hh) * SEQ + s) * 64 + fq * 4;
#pragma unroll
                for (int n = 0; n < 4; ++n) { const f32x4 v = acc[m][n] * gv[n] * r; u32x2 w; w.x = pk2(v.x, v.y); w.y = pk2(v.z, v.w); *(u32x2*)(o + n * 16) = w; }
            }
            return;
        }
        if (seg == 8 || seg == 9 || seg == 10 || seg == 11) {
            bf16_t* dst = (bf16_t*)(ws + (seg < 10 ? WS_KC : WS_VC)); const int g = seg & 1;
#pragma unroll
            for (int m = 0; m < 4; ++m) { const int b = rows[m] >> 12, s = rows[m] & 4095; bf16_t* o = dst + ((size_t)(b * 2 + g) * SEQ + s) * 64 + fq * 4;
#pragma unroll
                for (int n = 0; n < 4; ++n) { const f32x4 v = acc[m][n]; u32x2 w; w.x = pk2(v.x, v.y); w.y = pk2(v.z, v.w); *(u32x2*)(o + n * 16) = w; } }
            return;
        }
        if (seg == 14 || seg == 15 || seg == 18 || seg == 19) {
            bf16_t* dst = (bf16_t*)(ws + (seg < 16 ? WS_VST : WS_VWT)); const int g = seg & 1;
#pragma unroll
            for (int m = 0; m < 4; ++m) { const int b = rows[m] >> 12, s = rows[m] & 4095; bf16_t* o = dst + (size_t)(b * 2 + g) * 64 * SEQ + s;
#pragma unroll
                for (int n = 0; n < 4; ++n) { const f32x4 v = acc[m][n]; const int d = n * 16 + fq * 4;
                    o[(size_t)(d + 0) * SEQ] = f2bf(v.x); o[(size_t)(d + 1) * SEQ] = f2bf(v.y); o[(size_t)(d + 2) * SEQ] = f2bf(v.z); o[(size_t)(d + 3) * SEQ] = f2bf(v.w); } }
            return;
        }
        if (seg < 52) {
            const int kind = (seg - 20) >> 3, cb = ((seg - 20) & 7) * 64 + fq * 4;
            if (kind == 1) {
                const float* lb = (const float*)(ws + WS_LB); float* dst = (float*)(ws + WS_HLOGF);
#pragma unroll
                for (int m = 0; m < 4; ++m)
#pragma unroll
                    for (int n = 0; n < 4; ++n) { const int c = cb + n * 16; const f32x4 l = *(const f32x4*)(lb + c); const f32x4 v = acc[m][n]; f32x4 o;
                        o.x = __logf(l.x + (1.f - l.x) * sigmoidf_(v.x)); o.y = __logf(l.y + (1.f - l.y) * sigmoidf_(v.y));
                        o.z = __logf(l.z + (1.f - l.z) * sigmoidf_(v.z)); o.w = __logf(l.w + (1.f - l.w) * sigmoidf_(v.w));
                        *(f32x4*)(dst + (size_t)rows[m] * 512 + c) = o; }
            } else {
                bf16_t* dst = (bf16_t*)(ws + (kind == 0 ? WS_HQ : (kind == 2 ? WS_HV : WS_HG)));
#pragma unroll
                for (int m = 0; m < 4; ++m)
#pragma unroll
                    for (int n = 0; n < 4; ++n) { f32x4 v = acc[m][n];
                        if (kind != 2) { v.x = siluf_(v.x); v.y = siluf_(v.y); v.z = siluf_(v.z); v.w = siluf_(v.w); }
                        u32x2 w; w.x = pk2(v.x, v.y); w.y = pk2(v.z, v.w); *(u32x2*)(dst + (size_t)rows[m] * 512 + cb + n * 16) = w; }
            }
            return;
        }
        {
            float* dst = (float*)(ws + WS_GATES);
#pragma unroll
            for (int m = 0; m < 4; ++m)
#pragma unroll
                for (int n = 0; n < 2; ++n) { const int c = n * 16 + fq * 4; if (c < 24) { const f32x4 v = acc[m][n]; f32x4 o; o.x = sigmoidf_(v.x); o.y = sigmoidf_(v.y); o.z = sigmoidf_(v.z); o.w = sigmoidf_(v.w);
                        *(f32x4*)(dst + (size_t)rows[m] * 24 + c) = o; } }
        }
    }
};
DEV void phase_inproj(const Params& p, unsigned char* lds) {
    const int vb = vblock(), G = gridDim.x;
    constexpr int NMT = NTOK / 128, NNT = INP / 256, U = NMT * NNT;
    for (int u = vb; u < U; u += G) {
        const int grp = u / (16 * NNT), rem = u % (16 * NNT), nt = rem / 16, mt = grp * 16 + rem % 16;
        ARows al{(const bf16_t*)(p.ws + WS_R1) + (size_t)mt * 128 * DM, DM};
        BRows bl{(const bf16_t*)(p.ws + WS_WINT) + (size_t)nt * 256 * DM, DM};
        EpiInproj ep{p, mt * 128, nt};
        gemm_tile(lds, al, bl, DM / 64, ep);
    }
}

struct ACmp { const bf16_t* src; int rbase;
    DEV const bf16_t* row(int r) const { int rr = rbase + r; if (rr > 4079) rr = 4079; const int bg = rr / NC, c = rr % NC; return src + ((size_t)bg * SEQ + 16 * c) * 64; } };
struct EpiCmpA { const Params& p; int z, rbase;
    DEV void operator()(f32x4 (&acc)[4][4], int wr, int wc, int lane) const {
        const int frow = lane & 15, fq = lane >> 4;
        const float* cb = (const float*)(p.ws + WS_CBIAS) + z * 256; bf16_t* hid = (bf16_t*)(p.ws + WS_HID) + (size_t)z * 4096 * 256;
#pragma unroll
        for (int m = 0; m < 4; ++m) { const int rr = rbase + wr * 64 + m * 16 + frow;
#pragma unroll
            for (int n = 0; n < 4; ++n) { const int c = wc * 64 + n * 16 + fq * 4; const f32x4 b = *(const f32x4*)(cb + c); f32x4 v = acc[m][n] + b;
                u32x2 w; w.x = pk2(siluf_(v.x), siluf_(v.y)); w.y = pk2(siluf_(v.z), siluf_(v.w)); *(u32x2*)(hid + (size_t)rr * 256 + c) = w; } }
    } };
DEV void phase_cmp_a(const Params& p, unsigned char* lds) {
    const int vb = vblock(), G = gridDim.x;
    for (int u = vb; u < 64; u += G) {
        const int z = u >> 5, rbase = (u & 31) * 128;
        ACmp al{(const bf16_t*)(p.ws + (z ? WS_VC : WS_KC)), rbase};
        BRows bl{(const bf16_t*)(p.ws + WS_CW1T) + (size_t)z * 256 * 2048, 2048};
        EpiCmpA ep{p, z, rbase};
        gemm_tile(lds, al, bl, 2048 / 64, ep);
    }
}
struct BClamp64 { const bf16_t* base; size_t ld; DEV const bf16_t* ptr(int n, int kt) const { return base + (size_t)(n & 63) * ld + kt * 64; } };
struct EpiCmpB { const Params& p; int z, rbase;
    DEV void operator()(f32x4 (&acc)[4][4], int wr, int wc, int lane) const {
        if (wc != 0) return;
        const int frow = lane & 15, fq = lane >> 4;
        bf16_t* dst = (bf16_t*)(p.ws + (z ? WS_VCMP : WS_KCMP));
#pragma unroll
        for (int m = 0; m < 4; ++m) { const int rr = rbase + wr * 64 + m * 16 + frow;
            float r = 1.f;
            if (z == 0) { float ss = 0.f;
#pragma unroll
                for (int n = 0; n < 4; ++n) { const f32x4 v = acc[m][n]; ss += (v.x * v.x + v.y * v.y) + (v.z * v.z + v.w * v.w); }
                ss += __shfl_xor(ss, 16); ss += __shfl_xor(ss, 32); r = rsqrtf(ss * (1.f / 64.f) + RMS_EPS); }
            if (rr < 4080) { const int bg = rr / NC, c = rr % NC;
#pragma unroll
                for (int n = 0; n < 4; ++n) { const int d = n * 16 + fq * 4; f32x4 v = acc[m][n] * r;
                    if (z == 0) { const f32x4 g = *(const f32x4*)(p.g_k + d); v = v * g; }
                    u32x2 w; w.x = pk2(v.x, v.y); w.y = pk2(v.z, v.w); *(u32x2*)(dst + ((size_t)bg * 256 + c) * 64 + d) = w; } }
        }
    } };
DEV void phase_cmp_b(const Params& p, unsigned char* lds) {
    const int vb = vblock(), G = gridDim.x;
    for (int u = vb; u < 64; u += G) {
        const int z = u >> 5, rbase = (u & 31) * 128;
        ARows al{(const bf16_t*)(p.ws + WS_HID) + ((size_t)z * 4096 + rbase) * 256, 256};
        BClamp64 bl{(const bf16_t*)(p.ws + WS_CW2T) + (size_t)z * 64 * 256, 256};
        EpiCmpB ep{p, z, rbase};
        gemm_tile(lds, al, bl, 256 / 64, ep);
    }
}

constexpr int CA_KS = 0, CA_VS = 256 * 132, CA_QS = CA_VS + 256 * 128, CA_PB = CA_QS + 8 * 4 * 64 * 4, CA_LDS = CA_PB + 8 * 256 * 4 * 4;
DEV void phase_cmp_attn(const Params& p, unsigned char* lds) {
    const int tid = threadIdx.x, lane = tid & 63, wid = tid >> 6;
    const int vb = vblock(), G = gridDim.x;
    unsigned char* ws = p.ws;
    const bf16_t* Q = (const bf16_t*)(ws + WS_Q);
    const float* gates = (const float*)(ws + WS_GATES);
    bf16_t* OC = (bf16_t*)(ws + WS_OC);
    unsigned long long* selm = (unsigned long long*)(ws + WS_SELM);
    float* qs = (float*)(lds + CA_QS) + wid * 256;
    float* pb = (float*)(lds + CA_PB) + wid * 1024;
    for (int it = vb; it < 1024; it += G) {
        const int rnd = it / G, pos = it % G; int sidx = (rnd & 1) ? (rnd * G + (G - 1 - pos)) : (rnd * G + pos); if (G != 256) sidx = it;
        const int ci = 63 - (sidx >> 4), bg = sidx & 15, b = bg >> 1, g = bg & 1;
        const int nvis = min(NC, 4 * ci + 3);
        __syncthreads();
        {
            const bf16_t* kc = (const bf16_t*)(ws + WS_KCMP) + (size_t)bg * 256 * 64; const bf16_t* vc = (const bf16_t*)(ws + WS_VCMP) + (size_t)bg * 256 * 64;
            for (int idx = tid; idx < nvis * 32; idx += NT) { const int c = idx >> 5, d2 = idx & 31;
                *(unsigned*)(lds + CA_KS + c * 132 + d2 * 4) = *(const unsigned*)(kc + c * 64 + d2 * 2);
                *(unsigned*)(lds + CA_VS + c * 128 + d2 * 4) = *(const unsigned*)(vc + c * 64 + d2 * 2); }
        }
        __syncthreads();
        for (int tt = 0; tt < 8; ++tt) {
            const int t = ci * 64 + wid * 8 + tt; const size_t tok = (size_t)b * SEQ + t;
            const int nv = t >= 31 ? min(NC, (t - 31) / 16 + 1) : 0;
            const int cur = t >> 6;
            float oacc[4] = {0.f, 0.f, 0.f, 0.f};
            float imp = 0.f;
            if (nv > 0) {
                asm volatile("s_waitcnt lgkmcnt(0)" ::: "memory");
#pragma unroll
                for (int r = 0; r < 4; ++r) qs[r * 64 + lane] = bf2f(Q[((size_t)(b * 8 + g * 4 + r) * SEQ + t) * 64 + lane]);
                asm volatile("s_waitcnt lgkmcnt(0)" ::: "memory");
                const int nj = (nv + 63) >> 6;
                float sc[4][4];
#pragma unroll
                for (int j = 0; j < 4; ++j)
#pragma unroll
                    for (int r = 0; r < 4; ++r) sc[j][r] = 0.f;
                for (int d2 = 0; d2 < 32; ++d2) {
                    f32x2 qq[4];
#pragma unroll
                    for (int r = 0; r < 4; ++r) qq[r] = *(const f32x2*)(qs + r * 64 + 2 * d2);
#pragma unroll
                    for (int j = 0; j < 4; ++j) if (j < nj) {
                        const unsigned kk = *(const unsigned*)(lds + CA_KS + (lane + 64 * j) * 132 + d2 * 4); const float k0 = bflo(kk), k1 = bfhi(kk);
#pragma unroll
                        for (int r = 0; r < 4; ++r) sc[j][r] += qq[r].x * k0 + qq[r].y * k1;
                    }
                }
                float mx[4], sm[4];
#pragma unroll
                for (int r = 0; r < 4; ++r) { float m = -1e30f;
#pragma unroll
                    for (int j = 0; j < 4; ++j) if (lane + 64 * j < nv) m = fmaxf(m, sc[j][r]);
                    mx[r] = wave_max(m); }
#pragma unroll
                for (int r = 0; r < 4; ++r) { float s = 0.f;
#pragma unroll
                    for (int j = 0; j < 4; ++j) { const float e = (lane + 64 * j < nv) ? exp2f(sc[j][r] - mx[r]) : 0.f; sc[j][r] = e; s += e; }
                    sm[r] = 1.f / wave_sum(s); }
#pragma unroll
                for (int j = 0; j < 4; ++j) { f32x4 pv; pv.x = sc[j][0] * sm[0]; pv.y = sc[j][1] * sm[1]; pv.z = sc[j][2] * sm[2]; pv.w = sc[j][3] * sm[3]; *(f32x4*)(pb + (lane + 64 * j) * 4) = pv; }
                asm volatile("s_waitcnt lgkmcnt(0)" ::: "memory");
                {
                    const int c0 = 4 * lane;
                    f32x4 a = *(const f32x4*)(pb + (c0) * 4), b1 = *(const f32x4*)(pb + (c0 + 1) * 4), c2 = *(const f32x4*)(pb + (c0 + 2) * 4), d3 = *(const f32x4*)(pb + (c0 + 3) * 4);
                    f32x4 pm = (f32x4){0.f, 0.f, 0.f, 0.f}; if (lane > 0) pm = *(const f32x4*)(pb + (c0 - 1) * 4);
                    const f32x4 s4 = (a + b1 + c2) + (pm + d3) * 0.5f;
                    imp = (s4.x + s4.y) + (s4.z + s4.w);
                }
                for (int c = 0; c < nv; ++c) { const f32x4 pp = *(const f32x4*)(pb + c * 4); const float v = bf2f(*(const bf16_t*)(lds + CA_VS + c * 128 + lane * 2));
                    oacc[0] += pp.x * v; oacc[1] += pp.y * v; oacc[2] += pp.z * v; oacc[3] += pp.w * v; }
            }
            {
                const float INF = __builtin_inff();
                const float v = (lane == 0 || lane == cur) ? INF : (lane < cur ? imp : -INF);
                int rank = 0;
                for (int i = 0; i <= cur; ++i) { const float vi = __uint_as_float(__builtin_amdgcn_readlane(__float_as_uint(v), i)); rank += ((vi > v) || (vi == v && i < lane)) ? 1 : 0; }
                const bool sel = (lane <= cur) && (rank < 16);
                const unsigned long long mask = __ballot(sel);
                if (lane == 0) selm[(size_t)bg * SEQ + t] = mask;
            }
#pragma unroll
            for (int r = 0; r < 4; ++r) { const int h = g * 4 + r; const float gt = gates[tok * 24 + h * 3 + 0]; OC[tok * 512 + h * 64 + lane] = f2bf(gt * oacc[r]); }
        }
    }
}

constexpr int FA_KB = 64 * 128, FA_VB = 64 * 136, FA_STAGE = FA_KB + FA_VB, FA_LDS = 2 * FA_STAGE + 1024;
template <bool SEL>
DEV void fa_branch(unsigned char* lds, const bf16_t* Kb, const bf16_t* VTb, int ci, int bg, const bf16x8 (&qf)[4], int t, unsigned long long mymask, unsigned long long need,
                   f32x16 (&ot)[2], float& m_run, float& l_run) {
    const int tid = threadIdx.x, lane = tid & 63;
    const int r31 = lane & 31, hh = lane >> 5;
    const int lrow = tid >> 3, lch = tid & 7;
    const bf16_t* kg = Kb + ((size_t)bg * SEQ + lrow) * 64 + lch * 8;
    const bf16_t* vg = VTb + ((size_t)bg * 64 + lrow) * SEQ + lch * 8;
    const int koff = lrow * 128 + ((lch ^ ((lrow >> 1) & 7)) << 4), voff = FA_KB + lrow * 136 + lch * 16;
    int jlo, jhi; unsigned long long todo;
    if (SEL) { todo = need; jlo = 0; jhi = ci; } else { jlo = ci >= 8 ? ci - 8 : 0; jhi = ci; todo = 0; }
    int j = jlo;
    if (SEL) { if (todo == 0) return; j = __builtin_ctzll(todo); todo &= todo - 1; }
    u32x4 rk = *(const u32x4*)(kg + (size_t)j * 64 * 64), rv = *(const u32x4*)(vg + (size_t)j * 64);
    __syncthreads();
    *(u32x4*)(lds + koff) = rk; { u32x2 a, b2; a.x = rv.x; a.y = rv.y; b2.x = rv.z; b2.y = rv.w; *(u32x2*)(lds + voff) = a; *(u32x2*)(lds + voff + 8) = b2; }
    __syncthreads();
    int st = 0;
    for (;;) {
        int jn; bool more;
        if (SEL) { more = (todo != 0); jn = more ? __builtin_ctzll(todo) : 0; todo &= todo - 1; } else { jn = j + 1; more = (jn <= jhi); }
        if (more) { rk = *(const u32x4*)(kg + (size_t)jn * 64 * 64); rv = *(const u32x4*)(vg + (size_t)jn * 64); }
        const unsigned char* base = lds + st * FA_STAGE;
        f32x16 sacc[2];
#pragma unroll
        for (int kt2 = 0; kt2 < 2; ++kt2) {
#pragma unroll
            for (int i = 0; i < 16; ++i) sacc[kt2][i] = 0.f;
            const int row = 32 * kt2 + r31; const int sx = (row >> 1) & 7;
#pragma unroll
            for (int s = 0; s < 4; ++s) { const bf16x8 kf = *(const bf16x8*)(base + row * 128 + (((2 * s + hh) ^ sx) << 4));
                sacc[kt2] = __builtin_amdgcn_mfma_f32_32x32x16_bf16(kf, qf[s], sacc[kt2], 0, 0, 0); }
        }
        const bool bit = SEL ? ((mymask >> j) & 1ull) != 0 : true;
        float mx = -1e30f;
#pragma unroll
        for (int kt2 = 0; kt2 < 2; ++kt2)
#pragma unroll
            for (int i = 0; i < 16; ++i) { const int key = 64 * j + 32 * kt2 + (i & 3) + 8 * (i >> 2) + 4 * hh;
                const bool ok = SEL ? (bit && key <= t) : (key <= t && t - key < 512);
                const float v = ok ? sacc[kt2][i] : -1e30f; sacc[kt2][i] = v; mx = fmaxf(mx, v); }
        mx = fmaxf(mx, __shfl_xor(mx, 32));
        const float m_new = fmaxf(m_run, mx);
        const float alpha = exp2f(m_run - m_new);
        m_run = m_new;
        float rs = 0.f;
#pragma unroll
        for (int kt2 = 0; kt2 < 2; ++kt2)
#pragma unroll
            for (int i = 0; i < 16; ++i) { const float v = sacc[kt2][i]; const float e = (v > -5e29f) ? exp2f(v - m_new) : 0.f; sacc[kt2][i] = e; rs += e; }
        l_run = l_run * alpha + rs;
#pragma unroll
        for (int dt = 0; dt < 2; ++dt)
#pragma unroll
            for (int i = 0; i < 16; ++i) ot[dt][i] *= alpha;
#pragma unroll
        for (int kt2 = 0; kt2 < 2; ++kt2)
#pragma unroll
            for (int s2 = 0; s2 < 2; ++s2) {
                bf16x8 pf; { u32x4 w; w.x = pk2(sacc[kt2][8 * s2 + 0], sacc[kt2][8 * s2 + 1]); w.y = pk2(sacc[kt2][8 * s2 + 2], sacc[kt2][8 * s2 + 3]);
                    w.z = pk2(sacc[kt2][8 * s2 + 4], sacc[kt2][8 * s2 + 5]); w.w = pk2(sacc[kt2][8 * s2 + 6], sacc[kt2][8 * s2 + 7]); pf = __builtin_bit_cast(bf16x8, w); }
#pragma unroll
                for (int dt = 0; dt < 2; ++dt) {
                    const unsigned char* va = base + FA_KB + (32 * dt + r31) * 136 + (32 * kt2 + 16 * s2 + 4 * hh) * 2;
                    const u32x2 lo = *(const u32x2*)(va), hi = *(const u32x2*)(va + 16);
                    u32x4 w; w.x = lo.x; w.y = lo.y; w.z = hi.x; w.w = hi.y;
                    ot[dt] = __builtin_amdgcn_mfma_f32_32x32x16_bf16(__builtin_bit_cast(bf16x8, w), pf, ot[dt], 0, 0, 0);
                }
            }
        if (!more) break;
        { unsigned char* nb = lds + (st ^ 1) * FA_STAGE; *(u32x4*)(nb + koff) = rk; u32x2 a, b2; a.x = rv.x; a.y = rv.y; b2.x = rv.z; b2.y = rv.w; *(u32x2*)(nb + voff) = a; *(u32x2*)(nb + voff + 8) = b2; }
        __syncthreads();
        st ^= 1; j = jn;
    }
}
DEV void phase_flash(const Params& p, unsigned char* lds) {
    const int tid = threadIdx.x, lane = tid & 63, wid = tid >> 6;
    const int vb = vblock(), G = gridDim.x;
    unsigned char* ws = p.ws;
    const int r31 = lane & 31, hh = lane >> 5;
    unsigned long long* red = (unsigned long long*)(lds + 2 * FA_STAGE);
    for (int it = vb; it < 1024; it += G) {
        const int rnd = it / G, pos = it % G; int sidx = (rnd & 1) ? (rnd * G + (G - 1 - pos)) : (rnd * G + pos); if (G != 256) sidx = it;
        const int ci = 63 - (sidx >> 4), bg = sidx & 15, b = bg >> 1, g = bg & 1;
        const int head = g * 4 + (wid >> 1);
        const int t = ci * 64 + (wid & 1) * 32 + r31;
        const size_t tok = (size_t)b * SEQ + t;
        bf16x8 qf[4];
        { const bf16_t* qp = (const bf16_t*)(ws + WS_Q) + ((size_t)(b * 8 + head) * SEQ + t) * 64 + 8 * hh;
#pragma unroll
            for (int s = 0; s < 4; ++s) qf[s] = *(const bf16x8*)(qp + 16 * s); }
        const unsigned long long mymask = ((const unsigned long long*)(ws + WS_SELM))[(size_t)bg * SEQ + t];
        unsigned long long orm = mymask;
#pragma unroll
        for (int o = 1; o < 32; o <<= 1) { const unsigned lo = __shfl_xor((unsigned)orm, o), hi = __shfl_xor((unsigned)(orm >> 32), o); orm |= ((unsigned long long)hi << 32) | lo; }
        __syncthreads();
        if (wid < 2 && lane == 0) red[wid] = orm;
        __syncthreads();
        const unsigned long long need = red[0] | red[1];
        f32x16 oc[2];
        {
            f32x16 ot[2]; float m_run = -1e30f, l_run = 0.f;
#pragma unroll
            for (int dt = 0; dt < 2; ++dt)
#pragma unroll
                for (int i = 0; i < 16; ++i) ot[dt][i] = 0.f;
            fa_branch<true>(lds, (const bf16_t*)(ws + WS_KS), (const bf16_t*)(ws + WS_VST), ci, bg, qf, t, mymask, need, ot, m_run, l_run);
            const float lt = l_run + __shfl_xor(l_run, 32);
            const float sc = ((const float*)(ws + WS_GATES))[tok * 24 + head * 3 + 1] / lt;
#pragma unroll
            for (int dt = 0; dt < 2; ++dt)
#pragma unroll
                for (int i = 0; i < 16; ++i) oc[dt][i] = ot[dt][i] * sc;
        }
        {
            f32x16 ot[2]; float m_run = -1e30f, l_run = 0.f;
#pragma unroll
            for (int dt = 0; dt < 2; ++dt)
#pragma unroll
                for (int i = 0; i < 16; ++i) ot[dt][i] = 0.f;
            fa_branch<false>(lds, (const bf16_t*)(ws + WS_KW), (const bf16_t*)(ws + WS_VWT), ci, bg, qf, t, 0ull, 0ull, ot, m_run, l_run);
            const float lt = l_run + __shfl_xor(l_run, 32);
            const float sc = ((const float*)(ws + WS_GATES))[tok * 24 + head * 3 + 2] / lt;
#pragma unroll
            for (int dt = 0; dt < 2; ++dt)
#pragma unroll
                for (int i = 0; i < 16; ++i) oc[dt][i] += ot[dt][i] * sc;
        }
        {
            const bf16_t* ocp = (const bf16_t*)(ws + WS_OC) + tok * 512 + head * 64;
            bf16_t* mix = (bf16_t*)(ws + WS_R1) + tok * 1024 + head * 64;
            float ss = 0.f;
#pragma unroll
            for (int dt = 0; dt < 2; ++dt)
#pragma unroll
                for (int g4 = 0; g4 < 4; ++g4) { const int d0 = 32 * dt + 8 * g4 + 4 * hh; const u32x2 c = *(const u32x2*)(ocp + d0);
                    const float v0 = oc[dt][4 * g4 + 0] + bflo(c.x), v1 = oc[dt][4 * g4 + 1] + bfhi(c.x), v2 = oc[dt][4 * g4 + 2] + bflo(c.y), v3 = oc[dt][4 * g4 + 3] + bfhi(c.y);
                    ss += (v0 * v0 + v1 * v1) + (v2 * v2 + v3 * v3);
                    u32x2 w; w.x = pk2(v0, v1); w.y = pk2(v2, v3); *(u32x2*)(mix + d0) = w; }
            ss += __shfl_xor(ss, 32);
            if (hh == 0) atomicAdd((float*)(ws + WS_ROWSS) + tok, ss);
        }
    }
}

DEV int swz256(int row, int chunk) { return row * 256 + ((chunk ^ (row & 15)) << 4); }
DEV void hgrn_cumsum(const Params& p, int bh, int c, float* segs, f32x2 (&lf)[8], f32x2 (&a)[8], f32x2& r, f32x2& alast) {
    const int tid = threadIdx.x, k2 = tid & 63, tq = tid >> 6;
    const int b = bh >> 2, h = bh & 3;
    const float* HL = (const float*)(p.ws + WS_HLOGF) + ((size_t)b * SEQ + c * 64 + tq * 8) * 512 + h * 128 + 2 * k2;
#pragma unroll
    for (int i = 0; i < 8; ++i) lf[i] = *(const f32x2*)(HL + (size_t)i * 512);
    f32x2 run = (f32x2){0.f, 0.f};
#pragma unroll
    for (int i = 0; i < 8; ++i) { run = run + lf[i]; a[i] = run; }
    *(f32x2*)(segs + tq * 128 + 2 * k2) = run;
    __syncthreads();
    f32x2 off = (f32x2){0.f, 0.f}, tot = off, rr = off;
#pragma unroll
    for (int q = 0; q < 8; ++q) { const f32x2 s = *(const f32x2*)(segs + q * 128 + 2 * k2); if (q < tq) off = off + s; if (q < 4) rr = rr + s; tot = tot + s; }
#pragma unroll
    for (int i = 0; i < 8; ++i) a[i] = a[i] + off;
    r = rr; alast = tot;
}
DEV void hgrn_stage_vt(const Params& p, int bh, int c, unsigned char* vt) {
    const int tid = threadIdx.x, k2 = tid & 63, tq = tid >> 6;
    const int b = bh >> 2, h = bh & 3;
    const bf16_t* HV = (const bf16_t*)(p.ws + WS_HV) + ((size_t)b * SEQ + c * 64 + tq * 8) * 512 + h * 128 + 2 * k2;
    unsigned vv[8];
#pragma unroll
    for (int i = 0; i < 8; ++i) vv[i] = *(const unsigned*)(HV + (size_t)i * 512);
    u32x4 lo, hi;
    lo.x = (vv[0] & 0xffffu) | (vv[1] << 16); lo.y = (vv[2] & 0xffffu) | (vv[3] << 16); lo.z = (vv[4] & 0xffffu) | (vv[5] << 16); lo.w = (vv[6] & 0xffffu) | (vv[7] << 16);
    hi.x = (vv[0] >> 16) | (vv[1] & 0xffff0000u); hi.y = (vv[2] >> 16) | (vv[3] & 0xffff0000u); hi.z = (vv[4] >> 16) | (vv[5] & 0xffff0000u); hi.w = (vv[6] >> 16) | (vv[7] & 0xffff0000u);
    *(u32x4*)(vt + swz(2 * k2, tq)) = lo; *(u32x4*)(vt + swz(2 * k2 + 1, tq)) = hi;
}
constexpr int H1_KT = 0, H1_VT = 16384, H1_SEG = 32768, H1_EK = H1_SEG + 4096;
DEV void phase_hgrn_a1(const Params& p, unsigned char* lds) {
    const int tid = threadIdx.x, lane = tid & 63, wid = tid >> 6, k2 = tid & 63, tq = tid >> 6;
    const int vb = vblock(), G = gridDim.x;
    const int frow = lane & 15, fq = lane >> 4, wr = wid >> 1, wc = wid & 1;
    float* segs = (float*)(lds + H1_SEG); float* ek = (float*)(lds + H1_EK);
    bf16_t* ubuf = (bf16_t*)(p.ws + WS_UBUF); float* dbuf = (float*)(p.ws + WS_DBUF);
    for (int item = vb; item < 2048; item += G) {
        const int bh = item >> 6, c = item & 63;
        __syncthreads();
        f32x2 lf[8], a[8], r, al;
        hgrn_cumsum(p, bh, c, segs, lf, a, r, al);
        {
            float kx[8], ky[8];
#pragma unroll
            for (int i = 0; i < 8; ++i) { kx[i] = (1.f - __expf(lf[i].x)) * __expf(fminf(r.x - a[i].x, 80.f)); ky[i] = (1.f - __expf(lf[i].y)) * __expf(fminf(r.y - a[i].y, 80.f)); }
            u32x4 w0, w1;
            w0.x = pk2(kx[0], kx[1]); w0.y = pk2(kx[2], kx[3]); w0.z = pk2(kx[4], kx[5]); w0.w = pk2(kx[6], kx[7]);
            w1.x = pk2(ky[0], ky[1]); w1.y = pk2(ky[2], ky[3]); w1.z = pk2(ky[4], ky[5]); w1.w = pk2(ky[6], ky[7]);
            *(u32x4*)(lds + H1_KT + swz(2 * k2, tq)) = w0; *(u32x4*)(lds + H1_KT + swz(2 * k2 + 1, tq)) = w1;
        }
        hgrn_stage_vt(p, bh, c, lds + H1_VT);
        if (tq == 7) { ek[2 * k2] = __expf(al.x - r.x); ek[2 * k2 + 1] = __expf(al.y - r.y); f32x2 d; d.x = __expf(al.x); d.y = __expf(al.y); *(f32x2*)(dbuf + (size_t)item * 128 + 2 * k2) = d; }
        __syncthreads();
        f32x4 acc[2][4];
#pragma unroll
        for (int m = 0; m < 2; ++m)
#pragma unroll
            for (int n = 0; n < 4; ++n) acc[m][n] = (f32x4){0.f, 0.f, 0.f, 0.f};
        const int sx = (frow >> 1) & 7;
#pragma unroll
        for (int ks = 0; ks < 2; ++ks) {
            const int co = ((ks * 4 + fq) ^ sx) << 4;
            bf16x8 af[2], bfr[4];
#pragma unroll
            for (int m = 0; m < 2; ++m) af[m] = *(const bf16x8*)(lds + H1_VT + (32 * wr + 16 * m + frow) * 128 + co);
#pragma unroll
            for (int n = 0; n < 4; ++n) bfr[n] = *(const bf16x8*)(lds + H1_KT + (64 * wc + 16 * n + frow) * 128 + co);
#pragma unroll
            for (int m = 0; m < 2; ++m)
#pragma unroll
                for (int n = 0; n < 4; ++n) acc[m][n] = __builtin_amdgcn_mfma_f32_16x16x32_bf16(bfr[n], af[m], acc[m][n], 0, 0, 0);
        }
#pragma unroll
        for (int m = 0; m < 2; ++m) { const int v = 32 * wr + 16 * m + frow;
#pragma unroll
            for (int n = 0; n < 4; ++n) { const int k0 = 64 * wc + 16 * n + 4 * fq; const f32x4 e = *(const f32x4*)(ek + k0); const f32x4 o = acc[m][n] * e;
                u32x2 w; w.x = pk2(o.x, o.y); w.y = pk2(o.z, o.w); *(u32x2*)(ubuf + ((size_t)item * 128 + v) * 128 + k0) = w; } }
    }
}
DEV void phase_hgrn_a2(const Params& p, unsigned char* lds) {
    const int G = gridDim.x;
    bf16_t* ubuf = (bf16_t*)(p.ws + WS_UBUF); const float* dbuf = (const float*)(p.ws + WS_DBUF);
    for (int gid = blockIdx.x * NT + threadIdx.x; gid < 131072; gid += G * NT) {
        const int bh = gid >> 12, v = (gid >> 5) & 127, k4 = gid & 31;
        bf16_t* u = ubuf + ((size_t)bh * 64 * 128 + v) * 128 + 4 * k4;
        const float* d = dbuf + (size_t)bh * 64 * 128 + 4 * k4;
        f32x4 S = (f32x4){0.f, 0.f, 0.f, 0.f};
        for (int c0 = 0; c0 < 64; c0 += 8) {
            u32x2 uu[8]; f32x4 dd[8];
#pragma unroll
            for (int j = 0; j < 8; ++j) { uu[j] = *(const u32x2*)(u + (size_t)(c0 + j) * 16384); dd[j] = *(const f32x4*)(d + (size_t)(c0 + j) * 128); }
#pragma unroll
            for (int j = 0; j < 8; ++j) { u32x2 w; w.x = pk2(S.x, S.y); w.y = pk2(S.z, S.w); *(u32x2*)(u + (size_t)(c0 + j) * 16384) = w;
                S.x = dd[j].x * S.x + bflo(uu[j].x); S.y = dd[j].y * S.y + bfhi(uu[j].x); S.z = dd[j].z * S.z + bflo(uu[j].y); S.w = dd[j].w * S.w + bfhi(uu[j].y); }
        }
    }
}
constexpr int H3_QH = 0, H3_QA = 16384, H3_KH = 32768, H3_VT = 49152, H3_PP = 65536, H3_ST = 73728, H3_SEG = 106496, H3_RED = 110592;
DEV void phase_hgrn_a3(const Params& p, unsigned char* lds) {
    const int tid = threadIdx.x, lane = tid & 63, wid = tid >> 6, k2 = tid & 63, tq = tid >> 6;
    const int vb = vblock(), G = gridDim.x;
    const int frow = lane & 15, fq = lane >> 4;
    float* segs = (float*)(lds + H3_SEG); float* red = (float*)(lds + H3_RED);
    const bf16_t* ubuf = (const bf16_t*)(p.ws + WS_UBUF);
    for (int item = vb; item < 2048; item += G) {
        const int bh = item >> 6, c = item & 63, b = bh >> 2, h = bh & 3;
        __syncthreads();
        f32x2 lf[8], a[8], r, al;
        hgrn_cumsum(p, bh, c, segs, lf, a, r, al);
        {
            const bf16_t* HQ = (const bf16_t*)(p.ws + WS_HQ) + ((size_t)b * SEQ + c * 64 + tq * 8) * 512 + h * 128 + 2 * k2;
            unsigned qq[8];
#pragma unroll
            for (int i = 0; i < 8; ++i) qq[i] = *(const unsigned*)(HQ + (size_t)i * 512);
#pragma unroll
            for (int i = 0; i < 8; ++i) { const int t = 8 * tq + i; const float q0 = bflo(qq[i]), q1 = bfhi(qq[i]);
                const int off = swz256(t, k2 >> 2) + (k2 & 3) * 4;
                *(unsigned*)(lds + H3_QH + off) = pk2(q0 * __expf(fminf(a[i].x - r.x, 80.f)), q1 * __expf(fminf(a[i].y - r.y, 80.f)));
                *(unsigned*)(lds + H3_QA + off) = pk2(q0 * __expf(a[i].x), q1 * __expf(a[i].y));
                *(unsigned*)(lds + H3_KH + off) = pk2((1.f - __expf(lf[i].x)) * __expf(fminf(r.x - a[i].x, 80.f)), (1.f - __expf(lf[i].y)) * __expf(fminf(r.y - a[i].y, 80.f))); }
        }
        hgrn_stage_vt(p, bh, c, lds + H3_VT);
        {
            const bf16_t* st = ubuf + (size_t)item * 16384;
#pragma unroll
            for (int i = 0; i < 4; ++i) { const int q = tid + NT * i, v = q >> 4, ch = q & 15; *(u32x4*)(lds + H3_ST + swz256(v, ch)) = *(const u32x4*)(st + v * 128 + ch * 8); }
        }
        __syncthreads();
        {
            const int wr = wid >> 1, wc = wid & 1;
            f32x4 acc[2];
            acc[0] = (f32x4){0.f, 0.f, 0.f, 0.f}; acc[1] = acc[0];
            if (32 * wc <= 16 * wr + 15) {
#pragma unroll
                for (int ks = 0; ks < 4; ++ks) {
                    const int co = ((ks * 4 + fq) ^ frow) << 4;
                    const bf16x8 af = *(const bf16x8*)(lds + H3_QH + (16 * wr + frow) * 256 + co);
#pragma unroll
                    for (int n = 0; n < 2; ++n) { const bf16x8 bfr = *(const bf16x8*)(lds + H3_KH + (32 * wc + 16 * n + frow) * 256 + co);
                        acc[n] = __builtin_amdgcn_mfma_f32_16x16x32_bf16(bfr, af, acc[n], 0, 0, 0); }
                }
            }
            const int t = 16 * wr + frow;
#pragma unroll
            for (int n = 0; n < 2; ++n) { const int s0 = 32 * wc + 16 * n + 4 * fq; f32x4 v = acc[n];
                v.x = (s0 + 0 <= t) ? v.x : 0.f; v.y = (s0 + 1 <= t) ? v.y : 0.f; v.z = (s0 + 2 <= t) ? v.z : 0.f; v.w = (s0 + 3 <= t) ? v.w : 0.f;
                u32x2 w; w.x = pk2(v.x, v.y); w.y = pk2(v.z, v.w);
                *(u32x2*)(lds + H3_PP + t * 128 + ((((s0 >> 3)) ^ ((t >> 1) & 7)) << 4) + (s0 & 7) * 2) = w; }
        }
        __syncthreads();
        {
            const int wr = wid >> 2, wc = wid & 3;
            f32x4 acc[2][2];
#pragma unroll
            for (int m = 0; m < 2; ++m)
#pragma unroll
                for (int n = 0; n < 2; ++n) acc[m][n] = (f32x4){0.f, 0.f, 0.f, 0.f};
            const int sx = (frow >> 1) & 7;
#pragma unroll
            for (int ks = 0; ks < 2; ++ks) {
                const int co = ((ks * 4 + fq) ^ sx) << 4;
                bf16x8 af[2], bfr[2];
#pragma unroll
                for (int m = 0; m < 2; ++m) af[m] = *(const bf16x8*)(lds + H3_PP + (32 * wr + 16 * m + frow) * 128 + co);
#pragma unroll
                for (int n = 0; n < 2; ++n) bfr[n] = *(const bf16x8*)(lds + H3_VT + (32 * wc + 16 * n + frow) * 128 + co);
#pragma unroll
                for (int m = 0; m < 2; ++m)
#pragma unroll
                    for (int n = 0; n < 2; ++n) acc[m][n] = __builtin_amdgcn_mfma_f32_16x16x32_bf16(bfr[n], af[m], acc[m][n], 0, 0, 0);
            }
#pragma unroll
            for (int ks = 0; ks < 4; ++ks) {
                const int co = ((ks * 4 + fq) ^ frow) << 4;
                bf16x8 af[2], bfr[2];
#pragma unroll
                for (int m = 0; m < 2; ++m) af[m] = *(const bf16x8*)(lds + H3_QA + (32 * wr + 16 * m + frow) * 256 + co);
#pragma unroll
                for (int n = 0; n < 2; ++n) bfr[n] = *(const bf16x8*)(lds + H3_ST + (32 * wc + 16 * n + frow) * 256 + co);
#pragma unroll
                for (int m = 0; m < 2; ++m)
#pragma unroll
                    for (int n = 0; n < 2; ++n) acc[m][n] = __builtin_amdgcn_mfma_f32_16x16x32_bf16(bfr[n], af[m], acc[m][n], 0, 0, 0);
            }
#pragma unroll
            for (int m = 0; m < 2; ++m) { float ss = 0.f;
#pragma unroll
                for (int n = 0; n < 2; ++n) { const f32x4 v = acc[m][n]; ss += (v.x * v.x + v.y * v.y) + (v.z * v.z + v.w * v.w); }
                ss += __shfl_xor(ss, 16); ss += __shfl_xor(ss, 32);
                if (fq == 0) red[(32 * wr + 16 * m + frow) * 4 + wc] = ss; }
            __syncthreads();
#pragma unroll
            for (int m = 0; m < 2; ++m) { const int t = 32 * wr + 16 * m + frow; const f32x4 q4 = *(const f32x4*)(red + t * 4);
                const float rs = rsqrtf(((q4.x + q4.y) + (q4.z + q4.w)) * (1.f / 128.f) + RMS_EPS);
                const size_t row = (size_t)b * SEQ + c * 64 + t;
#pragma unroll
                for (int n = 0; n < 2; ++n) { const int v0 = 32 * wc + 16 * n + 4 * fq; const f32x4 gn = *(const f32x4*)(p.g_hn + v0);
                    const u32x2 gg = *(const u32x2*)((const bf16_t*)(p.ws + WS_HG) + row * 512 + h * 128 + v0);
                    const f32x4 o = acc[m][n];
                    u32x2 w; w.x = pk2(o.x * rs * gn.x * bflo(gg.x), o.y * rs * gn.y * bfhi(gg.x)); w.y = pk2(o.z * rs * gn.z * bflo(gg.y), o.w * rs * gn.w * bfhi(gg.y));
                    *(u32x2*)((bf16_t*)(p.ws + WS_R1) + row * 1024 + 512 + h * 128 + v0) = w; } }
        }
    }
}

DEV void phase_normalize(const Params& p, unsigned char* lds) {
    const int tid = threadIdx.x, lane = tid & 63, wid = tid >> 6;
    const int vb = vblock(), G = gridDim.x;
    unsigned char* ws = p.ws;
    bf16_t* mix = (bf16_t*)(ws + WS_R1); const float* rowss = (const float*)(ws + WS_ROWSS); const bf16_t* HG = (const bf16_t*)(ws + WS_HG);
    for (int m = vb * 8 + wid; m < NTOK; m += G * 8) {
        {
            const float r = rsqrtf(rowss[m] * (1.f / 512.f) + RMS_EPS);
            u32x4* pp = (u32x4*)(mix + (size_t)m * 1024) + lane; u32x4 v = *pp;
            v.x = pk2(bflo(v.x) * r, bfhi(v.x) * r); v.y = pk2(bflo(v.y) * r, bfhi(v.y) * r); v.z = pk2(bflo(v.z) * r, bfhi(v.z) * r); v.w = pk2(bflo(v.w) * r, bfhi(v.w) * r);
            *pp = v;
        }
    }
    __syncthreads();
    {
        float* tl = (float*)lds;
        for (int r = vb; r < 32 * 16 * 16; r += G) { const int e = r / 256, q = r % 256; SrcW13 s{p.w1 + (size_t)e * 1024 * 512, p.w3 + (size_t)e * 1024 * 512, p.ffn_g};
            convert_tile(tl, s, (bf16_t*)(ws + WS_W13T) + (size_t)e * 1024 * 1024, 1024, (q / 16) * 64, (q % 16) * 64); }
    }
}

struct EpiOut { const Params& p; int m0, n0;
    DEV void operator()(f32x4 (&acc)[4][4], int wr, int wc, int lane) const {
        const int frow = lane & 15, fq = lane >> 4;
#pragma unroll
        for (int m = 0; m < 4; ++m) { const size_t row = m0 + wr * 64 + m * 16 + frow;
#pragma unroll
            for (int n = 0; n < 4; ++n) { const int c = n0 + wc * 64 + n * 16 + fq * 4; const f32x4 xv = *(const f32x4*)(p.x + row * DM + c); *(f32x4*)(p.out + row * DM + c) = xv + acc[m][n]; } }
    } };
DEV void phase_outproj(const Params& p, unsigned char* lds) {
    const int vb = vblock(), G = gridDim.x;
    constexpr int U = (NTOK / 128) * 4;
    for (int u = vb; u < U; u += G) {
        const int mt = u >> 2, nt = u & 3;
        ARows al{(const bf16_t*)(p.ws + WS_R1) + (size_t)mt * 128 * DM, DM};
        BRows bl{(const bf16_t*)(p.ws + WS_WOUTT) + (size_t)nt * 256 * DM, DM};
        EpiOut ep{p, mt * 128, nt * 256};
        gemm_tile(lds, al, bl, DM / 64, ep);
    }
}

constexpr int RT_HS = 0, RT_WS = 128 * 33 * 4, RT_LG = RT_WS + 32 * 36 * 4, RT_RS = RT_LG + 128 * 37 * 4, RT_HIST = RT_RS + 512, RT_BASE = RT_HIST + 512, RT_LDS = RT_BASE + 512;
DEV void phase_router(const Params& p, unsigned char* lds) {
    const int tid = threadIdx.x;
    const int vb = vblock(), G = gridDim.x;
    unsigned char* ws = p.ws;
    float* hs = (float*)(lds + RT_HS); float* wsm = (float*)(lds + RT_WS); float* lg = (float*)(lds + RT_LG); float* rsd = (float*)(lds + RT_RS);
    int* hist = (int*)(lds + RT_HIST); int* basep = (int*)(lds + RT_BASE);
    bf16_t* hb = (bf16_t*)(ws + WS_R1);
    const int tok = tid & 127, cgp = tid >> 7;
    for (int it = vb; it < NTOK / 128; it += G) {
        const size_t row0 = (size_t)it * 128;
        float acc[9]; float ssq[4] = {0.f, 0.f, 0.f, 0.f};
#pragma unroll
        for (int c = 0; c < 9; ++c) acc[c] = 0.f;
        if (tid < 128) hist[tid] = 0;
        for (int kc = 0; kc < 32; ++kc) {
            __syncthreads();
#pragma unroll
            for (int i = 0; i < 4; ++i) { const int idx = tid + NT * i, tk = idx >> 4, kp = idx & 15; const size_t gi = (row0 + tk) * DM + kc * 32 + 2 * kp;
                const f32x2 v = *(const f32x2*)(p.out + gi); hs[tk * 33 + 2 * kp] = v.x; hs[tk * 33 + 2 * kp + 1] = v.y; ssq[i] += v.x * v.x + v.y * v.y; *(unsigned*)(hb + gi) = pk2(v.x, v.y); }
            for (int idx = tid; idx < 32 * 36; idx += NT) { const int kk = idx / 36, c = idx % 36, k = kc * 32 + kk;
                wsm[idx] = (c < 4 ? p.w_group[k * 4 + c] : p.w_expert[k * 32 + (c - 4)]) * p.ffn_g[k]; }
            __syncthreads();
#pragma unroll 8
            for (int kk = 0; kk < 32; ++kk) { const float hv = hs[tok * 33 + kk];
#pragma unroll
                for (int c = 0; c < 9; ++c) acc[c] += hv * wsm[kk * 36 + cgp * 9 + c]; }
        }
#pragma unroll
        for (int i = 0; i < 4; ++i) { float s = ssq[i]; s += __shfl_xor(s, 1); s += __shfl_xor(s, 2); s += __shfl_xor(s, 4); s += __shfl_xor(s, 8);
            if ((tid & 15) == 0) rsd[(tid + NT * i) >> 4] = rsqrtf(s * (1.f / DM) + RMS_EPS); }
#pragma unroll
        for (int c = 0; c < 9; ++c) lg[tok * 37 + cgp * 9 + c] = acc[c];
        __syncthreads();
        int bin = 0, slot = 0;
        if (tid < 128) {
            const float rs = rsd[tid];
            ((float*)(ws + WS_RSTD2))[row0 + tid] = rs;
            float gl[4]; int gi = 0; float gm = -1e30f;
#pragma unroll
            for (int c = 0; c < 4; ++c) { gl[c] = lg[tid * 37 + c] * rs + p.b_group[c]; if (gl[c] > gm) { gm = gl[c]; gi = c; } }
            float gs = 0.f;
#pragma unroll
            for (int c = 0; c < 4; ++c) gs += __expf(gl[c] - gm);
            const float pg = 1.f / gs;
            float el[8]; int i0 = 0; float m0 = -1e30f;
#pragma unroll
            for (int c = 0; c < 8; ++c) { el[c] = lg[tid * 37 + 4 + gi * 8 + c] * rs + p.b_expert[gi * 8 + c]; if (el[c] > m0) { m0 = el[c]; i0 = c; } }
            int i1 = 0; float m1 = -1e30f;
#pragma unroll
            for (int c = 0; c < 8; ++c) if (c != i0 && el[c] > m1) { m1 = el[c]; i1 = c; }
            const float e1 = __expf(m1 - m0); const float w0 = pg / (1.f + e1), w1 = pg * e1 / (1.f + e1);
            const int a = min(i0, i1), bb = max(i0, i1);
            bin = gi * 28 + (7 * a - (a * (a - 1)) / 2) + (bb - a - 1);
            f32x2 tw; tw.x = (i0 < i1) ? w0 : w1; tw.y = (i0 < i1) ? w1 : w0;
            ((f32x2*)(ws + WS_TOKW))[row0 + tid] = tw;
            slot = atomicAdd(&hist[bin], 1);
        }
        __syncthreads();
        if (tid < NBIN) { const int h = hist[tid]; basep[tid] = h ? atomicAdd((int*)(ws + WS_CTL) + tid, h) : 0; }
        __syncthreads();
        if (tid < 128) ((int*)(ws + WS_BINL))[(size_t)bin * BINCAP + basep[bin] + slot] = (int)(row0 + tid);
        __syncthreads();
    }
}

DEV void moe_tiles(const Params& p, int* tstart  ) {
    const int tid = threadIdx.x;
    __syncthreads();
    if (tid == 0) { const int* cnt = (const int*)(p.ws + WS_CTL); int s = 0; for (int i = 0; i < NBIN; ++i) { tstart[i] = s; s += (cnt[i] + 127) >> 7; } tstart[NBIN] = s; }
    __syncthreads();
}
DEV void bin_experts(int bin, int& ea, int& eb) { const int gi = bin / 28; int pi = bin % 28, a = 0; while (pi >= 7 - a) { pi -= 7 - a; ++a; } ea = gi * 8 + a; eb = gi * 8 + a + 1 + pi; }
struct AGather { const bf16_t* hb; const int* list; int n;
    DEV const bf16_t* row(int r) const { const int t = list[r < n ? r : 0]; return hb + (size_t)t * DM; } };
struct EpiMoe1 { const Params& p; const int* list; int n; size_t hrow0; int nt;
    DEV void operator()(f32x4 (&acc)[4][4], int wr, int wc, int lane) const {
        const int frow = lane & 15, fq = lane >> 4;
        bf16_t* hbuf = (bf16_t*)(p.ws + WS_HBUF);
#pragma unroll
        for (int m = 0; m < 4; ++m) { const int r = wr * 64 + m * 16 + frow; if (r >= n) continue;
            const int t = list[r]; const float rs = ((const float*)(p.ws + WS_RSTD2))[t]; const f32x2 tw = ((const f32x2*)(p.ws + WS_TOKW))[t]; const float w = nt < 4 ? tw.x : tw.y;
#pragma unroll
            for (int n2 = 0; n2 < 4; ++n2) { const f32x4 v = acc[m][n2] * rs; const int f = ((nt & 3) * 256 + wc * 64 + n2 * 16 + fq * 4) >> 1;
                *(unsigned*)(hbuf + (hrow0 + r) * 1024 + (nt < 4 ? 0 : 512) + f) = pk2(siluf_(v.x) * v.y * w, siluf_(v.z) * v.w * w); } }
    } };
DEV void phase_moe1(const Params& p, unsigned char* lds) {
    const int vb = vblock(), G = gridDim.x;
    int* tstart = (int*)(lds + G_LDS);
    moe_tiles(p, tstart);
    const int T = tstart[NBIN], U = T * 8;
    for (int u = vb; u < U; u += G) {
        const int tile = u >> 3, nt = u & 7;
        int bin = 0; while (tstart[bin + 1] <= tile) ++bin;
        const int mt = tile - tstart[bin]; int ea, eb; bin_experts(bin, ea, eb);
        const int cnt = ((const int*)(p.ws + WS_CTL))[bin]; const int n = min(128, cnt - mt * 128);
        const int* list = (const int*)(p.ws + WS_BINL) + (size_t)bin * BINCAP + mt * 128;
        AGather al{(const bf16_t*)(p.ws + WS_R1), list, n};
        BRows bl{(const bf16_t*)(p.ws + WS_W13T) + ((size_t)(nt < 4 ? ea : eb) * 1024 + (nt & 3) * 256) * 1024, 1024};
        EpiMoe1 ep{p, list, n, (size_t)tile * 128, nt};
        gemm_tile(lds, al, bl, DM / 64, ep);
    }
}
struct BPair { const bf16_t* wa; const bf16_t* wb; DEV const bf16_t* ptr(int n, int kt) const { return kt < 8 ? wa + (size_t)n * 512 + kt * 64 : wb + (size_t)n * 512 + (kt - 8) * 64; } };
struct EpiMoe2 { const Params& p; const int* list; int n; int n0;
    DEV void operator()(f32x4 (&acc)[4][4], int wr, int wc, int lane) const {
        const int frow = lane & 15, fq = lane >> 4;
#pragma unroll
        for (int m = 0; m < 4; ++m) { const int r = wr * 64 + m * 16 + frow; if (r >= n) continue; const size_t t = list[r];
#pragma unroll
            for (int n2 = 0; n2 < 4; ++n2) { float* o = p.out + t * DM + n0 + wc * 64 + n2 * 16 + fq * 4; *(f32x4*)o = *(const f32x4*)o + acc[m][n2]; } }
    } };
DEV void phase_moe2(const Params& p, unsigned char* lds) {
    const int vb = vblock(), G = gridDim.x;
    int* tstart = (int*)(lds + G_LDS);
    moe_tiles(p, tstart);
    const int T = tstart[NBIN], U = T * 4;
    for (int u = vb; u < U; u += G) {
        const int tile = u >> 2, nt = u & 3;
        int bin = 0; while (tstart[bin + 1] <= tile) ++bin;
        const int mt = tile - tstart[bin]; int ea, eb; bin_experts(bin, ea, eb);
        const int cnt = ((const int*)(p.ws + WS_CTL))[bin]; const int n = min(128, cnt - mt * 128);
        const int* list = (const int*)(p.ws + WS_BINL) + (size_t)bin * BINCAP + mt * 128;
        ARows al{(const bf16_t*)(p.ws + WS_HBUF) + (size_t)tile * 128 * 1024, 1024};
        BPair bl{(const bf16_t*)(p.ws + WS_W2T) + ((size_t)ea * 1024 + nt * 256) * 512, (const bf16_t*)(p.ws + WS_W2T) + ((size_t)eb * 1024 + nt * 256) * 512};
        EpiMoe2 ep{p, list, n, nt * 256};
        gemm_tile(lds, al, bl, 16, ep);
    }
}

constexpr int LDS_BYTES = 112 * 1024;
constexpr int N_PHASES = 13;
__global__ void __launch_bounds__(NT) mega(Params p, int lo, int hi) {
    extern __shared__ __attribute__((aligned(16))) unsigned char lds[];
#ifndef PROBE_REPEAT
#define PROBE_REPEAT -1
#endif
#define RUN_PHASE(k, call) do { if (lo <= (k) && (k) < hi) { call; \
        if ((k) == PROBE_REPEAT) { cg::this_grid().sync(); \
            if ((k) == 5) { float* rz = (float*)(p.ws + WS_ROWSS); for (int i = blockIdx.x * NT + threadIdx.x; i < NTOK; i += gridDim.x * NT) rz[i] = 0.f; cg::this_grid().sync(); } \
            if ((k) == 11) { if (blockIdx.x == 0 && threadIdx.x < 128) ((int*)(p.ws + WS_CTL))[threadIdx.x] = 0; cg::this_grid().sync(); } \
            call; } \
        if ((k) + 1 < hi) cg::this_grid().sync(); } } while (0)
    RUN_PHASE(0, phase_prologue(p, lds));
    RUN_PHASE(1, phase_inproj(p, lds));
    RUN_PHASE(2, phase_cmp_a(p, lds));
    RUN_PHASE(3, phase_cmp_b(p, lds));
    RUN_PHASE(4, phase_cmp_attn(p, lds));
    RUN_PHASE(5, phase_flash(p, lds));
    RUN_PHASE(6, phase_hgrn_a1(p, lds));
    RUN_PHASE(7, phase_hgrn_a2(p, lds));
    RUN_PHASE(8, phase_hgrn_a3(p, lds));
    RUN_PHASE(9, phase_normalize(p, lds));
    RUN_PHASE(10, phase_outproj(p, lds));
    RUN_PHASE(11, phase_router(p, lds));
    RUN_PHASE(12, phase_moe1(p, lds));
    RUN_PHASE(13, phase_moe2(p, lds));
#undef RUN_PHASE
}

extern "C" void kernel_launch(void* const* d_in, const int* in_sizes, int n_in, void* d_out, int out_size, void* d_ws, size_t ws_size, hipStream_t stream) {
    static int grid = 0;
    if (grid == 0) {
        int dev = 0, cus = 0, per_cu = 0;
        hipGetDevice(&dev);
        hipDeviceGetAttribute(&cus, hipDeviceAttributeMultiprocessorCount, dev);
        hipFuncSetAttribute((const void*)mega, hipFuncAttributeMaxDynamicSharedMemorySize, LDS_BYTES);
        hipOccupancyMaxActiveBlocksPerMultiprocessor(&per_cu, (const void*)mega, NT, LDS_BYTES);
        if (per_cu < 1) per_cu = 1;
        grid = cus;
        if (ws_size < WS_END) fprintf(stderr, "kernel_launch: workspace too small: %zu < %zu\n", ws_size, (size_t)WS_END);
        fprintf(stderr, "kernel_launch: cus %d per_cu %d grid %d ws %zu\n", cus, per_cu, grid, ws_size);
    }
    Params p{};
    const float** pp = (const float**)&p;
    for (int i = 0; i < 23; ++i) pp[i] = (const float*)d_in[i];
    p.out = (float*)d_out; p.ws = (unsigned char*)d_ws;
#if N_LAUNCH_MODE == 1
    int lo = 0, hi = N_PHASES + 1;
    void* args[] = {&p, &lo, &hi};
    hipError_t e = hipLaunchCooperativeKernel((const void*)mega, dim3(grid), dim3(NT), args, LDS_BYTES, stream);
    if (e != hipSuccess) fprintf(stderr, "cooperative launch failed: %s\n", hipGetErrorString(e));
#else
    for (int ph = 0; ph <= N_PHASES; ++ph) hipLaunchKernelGGL(mega, dim3(grid), dim3(NT), LDS_BYTES, stream, p, ph, ph + 1);
#endif
}
```

```cpp
#include <hip/hip_runtime.h>
#include <hip/hip_cooperative_groups.h>
#include <cstdio>
#include <cstdint>
#include <cstring>
namespace cg = cooperative_groups;

#ifndef N_LAUNCH_MODE
#define N_LAUNCH_MODE 1
#endif

#define DEV __device__ __forceinline__
typedef unsigned short bf16_t;
typedef short bf16x8 __attribute__((ext_vector_type(8)));
typedef float f32x4 __attribute__((ext_vector_type(4)));
typedef float f32x2 __attribute__((ext_vector_type(2)));
typedef float f32x16 __attribute__((ext_vector_type(16)));
typedef unsigned u32x4 __attribute__((ext_vector_type(4)));
typedef unsigned u32x2 __attribute__((ext_vector_type(2)));

constexpr int NT = 512;
constexpr int BATCH = 8, SEQ = 4096, DM = 1024, NTOK = BATCH * SEQ;
constexpr int IN_COLS = 3352, INP = 3584;
constexpr int NC = 255;
constexpr float RMS_EPS = 1e-6f;
constexpr float QSCALE = 0.125f * 1.4426950408889634f;
constexpr int NBIN = 112;
constexpr int BINCAP = NTOK;

constexpr size_t MiB = 1ull << 20;
constexpr size_t WS_CTL    = 0;
constexpr size_t WS_RSTD1  = 1 * MiB;
constexpr size_t WS_RSTD2  = WS_RSTD1 + 128 * 1024;
constexpr size_t WS_ROWSS  = WS_RSTD2 + 128 * 1024;
constexpr size_t WS_TOKW   = WS_ROWSS + 128 * 1024;
constexpr size_t WS_LB     = WS_TOKW + 256 * 1024;
constexpr size_t WS_CBIAS  = WS_LB + 4096;
constexpr size_t WS_SELM   = 2 * MiB;
constexpr size_t WS_GATES  = 3 * MiB;
constexpr size_t WS_KCMP   = 6 * MiB;
constexpr size_t WS_VCMP   = WS_KCMP + 512 * 1024;
constexpr size_t WS_CW2T   = 7 * MiB;
constexpr size_t WS_HID    = 8 * MiB;
constexpr size_t WS_CW1T   = 12 * MiB;
constexpr size_t WS_WOUTT  = 14 * MiB;
constexpr size_t WS_WINT   = 16 * MiB;
constexpr size_t WS_R1     = 24 * MiB;
constexpr size_t WS_Q      = 88 * MiB;
constexpr size_t WS_KC     = 120 * MiB;
constexpr size_t WS_VC     = 128 * MiB;
constexpr size_t WS_KS     = 136 * MiB;
constexpr size_t WS_KW     = 144 * MiB;
constexpr size_t WS_VST    = 152 * MiB;
constexpr size_t WS_VWT    = 160 * MiB;
constexpr size_t WS_OC     = 168 * MiB;
constexpr size_t WS_W13T   = 200 * MiB;
constexpr size_t WS_W2T    = 264 * MiB;
constexpr size_t WS_HQ     = 296 * MiB;
constexpr size_t WS_HV     = 328 * MiB;
constexpr size_t WS_HG     = 360 * MiB;
constexpr size_t WS_HLOGF  = 392 * MiB;
constexpr size_t WS_DBUF   = 456 * MiB;
constexpr size_t WS_END    = 457 * MiB;
constexpr size_t WS_UBUF   = WS_W13T;
constexpr size_t WS_BINL   = WS_HQ;
constexpr size_t WS_HBUF   = WS_HQ + 16 * MiB;

struct Params {
    const float *x, *attn_g, *ffn_g, *w_in, *w_out, *g_q, *g_k, *pos_k, *pos_v, *wk1, *wk2, *wv1, *wv2, *g_nsa, *lb_logits, *g_hn,
        *w_group, *b_group, *w_expert, *b_expert, *w1, *w3, *w2;
    float* out;
    unsigned char* ws;
};

DEV unsigned pk2(float lo, float hi) { unsigned r; asm("v_cvt_pk_bf16_f32 %0, %1, %2" : "=v"(r) : "v"(lo), "v"(hi)); return r; }
DEV bf16_t f2bf(float f) { return (bf16_t)(pk2(f, 0.f) & 0xffffu); }
DEV float bf2f(bf16_t b) { return __uint_as_float(((unsigned)b) << 16); }
DEV float bflo(unsigned u) { return __uint_as_float(u << 16); }
DEV float bfhi(unsigned u) { return __uint_as_float(u & 0xffff0000u); }
DEV float sigmoidf_(float v) { return 1.f / (1.f + __expf(-v)); }
DEV float siluf_(float v) { return v / (1.f + __expf(-v)); }
DEV float wave_sum(float v) {
#pragma unroll
    for (int o = 1; o < 64; o <<= 1) v += __shfl_xor(v, o);
    return v;
}
DEV float wave_max(float v) {
#pragma unroll
    for (int o = 1; o < 64; o <<= 1) v = fmaxf(v, __shfl_xor(v, o));
    return v;
}
DEV int vblock() { const int G = gridDim.x, b = blockIdx.x; return (G % 8 == 0) ? (b % 8) * (G / 8) + b / 8 : b; }

template <class SRC>
DEV void convert_tile(float* tl, const SRC& src, bf16_t* dst, int ldd, int n0, int k0) {
    const int tid = threadIdx.x;
    {
        const int n = tid & 63;
#pragma unroll
        for (int i = 0; i < 8; ++i) { const int kk = (tid >> 6) + 8 * i; tl[kk * 65 + n] = src.get(n0 + n, k0 + kk); }
    }
    __syncthreads();
    {
        const int n = tid >> 3, kc = tid & 7;
        const float* s = tl + (kc * 8) * 65 + n;
        u32x4 o;
        o.x = pk2(s[0 * 65], s[1 * 65]); o.y = pk2(s[2 * 65], s[3 * 65]); o.z = pk2(s[4 * 65], s[5 * 65]); o.w = pk2(s[6 * 65], s[7 * 65]);
        *(u32x4*)(dst + (size_t)(n0 + n) * ldd + k0 + kc * 8) = o;
    }
    __syncthreads();
}
struct SrcWin { const float* w; const float* g;
    DEV float get(int n, int k) const { int col; if (n < 1280) col = n; else if (n < 3328) col = n + 24; else if (n < 3352) col = 1280 + (n - 3328); else return 0.f;
        return w[(size_t)k * IN_COLS + col] * g[k]; } };
struct SrcWout { const float* w; const float* g;
    DEV float get(int n, int k) const { const float v = w[(size_t)k * DM + n]; return k < 512 ? v * g[k] : v; } };
struct SrcPlain { const float* w; int ld;
    DEV float get(int n, int k) const { return w[(size_t)k * ld + n]; } };
struct SrcW13 { const float* w1; const float* w3; const float* g;
    DEV float get(int n, int k) const { const uintptr_t a = (uintptr_t)w1, b = (uintptr_t)w3; const float* w = (const float*)(a + ((b - a) & (uintptr_t)(0 - (long long)(n & 1))));
        return w[(size_t)k * 512 + (n >> 1)] * g[k]; } };

DEV void phase_prologue(const Params& p, unsigned char* lds) {
    float* tl = (float*)lds;
    const int tid = threadIdx.x, lane = tid & 63, wid = tid >> 6;
    const int vb = vblock(), G = gridDim.x;
    unsigned char* ws = p.ws;
    constexpr int I_WIN = (INP / 64) * (DM / 64);
    constexpr int I_WOUT = 16 * 16;
    constexpr int I_CW1 = 2 * 4 * 32;
    constexpr int I_CW2 = 2 * 1 * 4;
    constexpr int I_W13 = 32 * 16 * 16;
    constexpr int I_W2 = 32 * 16 * 8;
    constexpr int I_ALL = I_WIN + I_WOUT + I_CW1 + I_CW2 + I_W2;
    for (int it = vb; it < I_ALL; it += G) {
        int r = it;
        if (r < I_WIN) { SrcWin s{p.w_in, p.attn_g}; convert_tile(tl, s, (bf16_t*)(ws + WS_WINT), DM, (r / 16) * 64, (r % 16) * 64); continue; } r -= I_WIN;
        if (r < I_WOUT) { SrcWout s{p.w_out, p.g_nsa}; convert_tile(tl, s, (bf16_t*)(ws + WS_WOUTT), DM, (r / 16) * 64, (r % 16) * 64); continue; } r -= I_WOUT;
        if (r < I_CW1) { const int z = r / 128, q = r % 128; SrcPlain s{z ? p.wv1 : p.wk1, 256};
            convert_tile(tl, s, (bf16_t*)(ws + WS_CW1T) + (size_t)z * 256 * 2048, 2048, (q / 32) * 64, (q % 32) * 64); continue; } r -= I_CW1;
        if (r < I_CW2) { const int z = r / 4, q = r % 4; SrcPlain s{z ? p.wv2 : p.wk2, 64};
            convert_tile(tl, s, (bf16_t*)(ws + WS_CW2T) + (size_t)z * 64 * 256, 256, 0, q * 64); continue; } r -= I_CW2;
        { const int e = r / 128, q = r % 128; SrcPlain s{p.w2 + (size_t)e * 512 * 1024, 1024};
            convert_tile(tl, s, (bf16_t*)(ws + WS_W2T) + (size_t)e * 1024 * 512, 512, (q / 8) * 64, (q % 8) * 64); }
    }
    {
        bf16_t* xb = (bf16_t*)(ws + WS_R1); float* rstd1 = (float*)(ws + WS_RSTD1);
        const int gw = vb * 8 + wid, NGW = G * 8;
        for (int m = gw; m < NTOK; m += NGW) {
            const f32x4* xr = (const f32x4*)(p.x + (size_t)m * DM) + lane;
            f32x4 v[4]; float s = 0.f;
#pragma unroll
            for (int j = 0; j < 4; ++j) { v[j] = xr[64 * j]; s += (v[j].x * v[j].x + v[j].y * v[j].y) + (v[j].z * v[j].z + v[j].w * v[j].w); }
            s = wave_sum(s);
            if (lane == 0) rstd1[m] = rsqrtf(s * (1.f / DM) + RMS_EPS);
            u32x2* o = (u32x2*)(xb + (size_t)m * DM) + lane;
#pragma unroll
            for (int j = 0; j < 4; ++j) { u32x2 w; w.x = pk2(v[j].x, v[j].y); w.y = pk2(v[j].z, v[j].w); o[64 * j] = w; }
        }
    }
    {
        const int gt = vb * NT + tid, NG = G * NT;
        float* rowss = (float*)(ws + WS_ROWSS);
        for (int i = gt; i < NTOK; i += NG) rowss[i] = 0.f;
        int* bincnt = (int*)(ws + WS_CTL);
        if (gt < 128) bincnt[gt] = 0;
        if (gt < 512) { const float l0 = p.lb_logits[gt], l1 = p.lb_logits[512 + gt]; ((float*)(ws + WS_LB))[gt] = 1.f / (1.f + __expf(l1 - l0)); }
        if (blockIdx.x == (unsigned)(G - 1)) {
            const int z = tid >> 8, j = tid & 255; const float* pos = z ? p.pos_v : p.pos_k; const float* w = z ? p.wv1 : p.wk1;
            float a = 0.f;
            for (int k = 0; k < 2048; ++k) a += pos[k] * w[(size_t)k * 256 + j];
            ((float*)(ws + WS_CBIAS))[z * 256 + j] = a;
        }
    }
}

constexpr int G_A_BYTES = 128 * 128, G_B_BYTES = 256 * 128, G_STAGE = G_A_BYTES + G_B_BYTES, G_LDS = 2 * G_STAGE;
DEV int swz(int row, int chunk) { return row * 128 + ((chunk ^ ((row >> 1) & 7)) << 4); }
template <class AL, class BL, class EP>
DEV void gemm_tile(unsigned char* lds, const AL& al, const BL& bl, int nk, const EP& ep) {
    const int tid = threadIdx.x, lane = tid & 63, wid = tid >> 6, wr = wid >> 2, wc = wid & 3;
    const int frow = lane & 15, fq = lane >> 4;
    const bf16_t* aptr[2]; int aoff[2], boff[4], brow[4];
#pragma unroll
    for (int i = 0; i < 2; ++i) { const int q = tid + NT * i, row = q >> 3, ch = q & 7; aptr[i] = al.row(row) + ch * 8; aoff[i] = swz(row, ch); }
#pragma unroll
    for (int i = 0; i < 4; ++i) { const int q = tid + NT * i, row = q >> 3, ch = q & 7; brow[i] = row; boff[i] = G_A_BYTES + swz(row, ch) ; }
    const int bch8 = (tid & 7) * 8;
    u32x4 ra[2], rb[4];
#pragma unroll
    for (int i = 0; i < 2; ++i) ra[i] = *(const u32x4*)(aptr[i]);
#pragma unroll
    for (int i = 0; i < 4; ++i) rb[i] = *(const u32x4*)(bl.ptr(brow[i], 0) + bch8);
#pragma unroll
    for (int i = 0; i < 2; ++i) *(u32x4*)(lds + aoff[i]) = ra[i];
#pragma unroll
    for (int i = 0; i < 4; ++i) *(u32x4*)(lds + boff[i]) = rb[i];
    __syncthreads();
    f32x4 acc[4][4];
#pragma unroll
    for (int m = 0; m < 4; ++m)
#pragma unroll
        for (int n = 0; n < 4; ++n) acc[m][n] = (f32x4){0.f, 0.f, 0.f, 0.f};
    const int sx = (frow >> 1) & 7;
    for (int kt = 0; kt < nk; ++kt) {
        const bool more = (kt + 1 < nk);
        if (more) {
#pragma unroll
            for (int i = 0; i < 2; ++i) ra[i] = *(const u32x4*)(aptr[i] + (kt + 1) * 64);
#pragma unroll
            for (int i = 0; i < 4; ++i) rb[i] = *(const u32x4*)(bl.ptr(brow[i], kt + 1) + bch8);
        }
        const unsigned char* base = lds + (kt & 1) * G_STAGE;
#pragma unroll
        for (int ks = 0; ks < 2; ++ks) {
            const int co = ((ks * 4 + fq) ^ sx) << 4;
            bf16x8 af[4], bfr[4];
#pragma unroll
            for (int m = 0; m < 4; ++m) af[m] = *(const bf16x8*)(base + (wr * 64 + m * 16 + frow) * 128 + co);
#pragma unroll
            for (int n = 0; n < 4; ++n) bfr[n] = *(const bf16x8*)(base + G_A_BYTES + (wc * 64 + n * 16 + frow) * 128 + co);
#pragma unroll
            for (int m = 0; m < 4; ++m)
#pragma unroll
                for (int n = 0; n < 4; ++n) acc[m][n] = __builtin_amdgcn_mfma_f32_16x16x32_bf16(bfr[n], af[m], acc[m][n], 0, 0, 0);
        }
        if (more) {
            unsigned char* nb = lds + ((kt + 1) & 1) * G_STAGE;
#pragma unroll
            for (int i = 0; i < 2; ++i) *(u32x4*)(nb + aoff[i]) = ra[i];
#pragma unroll
            for (int i = 0; i < 4; ++i) *(u32x4*)(nb + boff[i]) = rb[i];
        }
        __syncthreads();
    }
    ep(acc, wr, wc, lane);
}

struct ARows { const bf16_t* base; size_t ld; DEV const bf16_t* row(int r) const { return base + (size_t)r * ld; } };
struct BRows { const bf16_t* base; size_t ld; DEV const bf16_t* ptr(int n, int kt) const { return base + (size_t)n * ld + kt * 64; } };

struct EpiInproj {
    const Params& p; int m0, ntile;
    DEV void operator()(f32x4 (&acc)[4][4], int wr, int wc, int lane) const {
        const int frow = lane & 15, fq = lane >> 4;
        const int seg = ntile * 4 + wc;
        if (seg > 52) return;
        unsigned char* ws = p.ws;
        const float* rstd1 = (const float*)(ws + WS_RSTD1);
        int rows[4];
#pragma unroll
        for (int m = 0; m < 4; ++m) { rows[m] = m0 + wr * 64 + m * 16 + frow; const float rs = rstd1[rows[m]];
#pragma unroll
            for (int n = 0; n < 4; ++n) acc[m][n] = acc[m][n] * rs; }
        const bool is_q = seg < 8, is_ks = (seg == 12 || seg == 13), is_kw = (seg == 16 || seg == 17);
        if (is_q || is_ks || is_kw) {
            const float* gw = is_q ? p.g_q : (is_ks ? p.g_k + 64 : p.g_k + 128);
            bf16_t* dst; int hh, nh;
            if (is_q) { dst = (bf16_t*)(ws + WS_Q); hh = seg; nh = 8; } else if (is_ks) { dst = (bf16_t*)(ws + WS_KS); hh = seg - 12; nh = 2; } else { dst = (bf16_t*)(ws + WS_KW); hh = seg - 16; nh = 2; }
            f32x4 gv[4];
#pragma unroll
            for (int n = 0; n < 4; ++n) gv[n] = *(const f32x4*)(gw + n * 16 + fq * 4);
#pragma unroll
            for (int m = 0; m < 4; ++m) {
                float ss = 0.f;
#pragma unroll
                for (int n = 0; n < 4; ++n) { const f32x4 v = acc[m][n]; ss += (v.x * v.x + v.y * v.y) + (v.z * v.z + v.w * v.w); }
                ss += __shfl_xor(ss, 16); ss += __shfl_xor(ss, 32);
                float r = rsqrtf(ss * (1.f / 64.f) + RMS_EPS); if (is_q) r *= QSCALE;
                const int b = rows[m] >> 12, s = rows[m] & 4095;
                bf16_t* o = dst + ((size_t)(b * nh + hh) * SEQ + s) * 64 + fq * 4;
#pragma unroll
                for (int n = 0; n < 4; ++n) { const f32x4 v = acc[m][n] * gv[n] * r; u32x2 w; w.x = pk2(v.x, v.y); w.y = pk2(v.z, v.w); *(u32x2*)(o + n * 16) = w; }
            }
            return;
        }
        if (seg == 8 || seg == 9 || seg == 10 || seg == 11) {
            bf16_t* dst = (bf16_t*)(ws + (seg < 10 ? WS_KC : WS_VC)); const int g = seg & 1;
#pragma unroll
            for (int m = 0; m < 4; ++m) { const int b = rows[m] >> 12, s = rows[m] & 4095; bf16_t* o = dst + ((size_t)(b * 2 + g) * SEQ + s) * 64 + fq * 4;
#pragma unroll
                for (int n = 0; n < 4; ++n) { const f32x4 v = acc[m][n]; u32x2 w; w.x = pk2(v.x, v.y); w.y = pk2(v.z, v.w); *(u32x2*)(o + n * 16) = w; } }
            return;
        }
        if (seg == 14 || seg == 15 || seg == 18 || seg == 19) {
            bf16_t* dst = (bf16_t*)(ws + (seg < 16 ? WS_VST : WS_VWT)); const int g = seg & 1;
#pragma unroll
            for (int m = 0; m < 4; ++m) { const int b = rows[m] >> 12, s = rows[m] & 4095; bf16_t* o = dst + (size_t)(b * 2 + g) * 64 * SEQ + s;
#pragma unroll
                for (int n = 0; n < 4; ++n) { const f32x4 v = acc[m][n]; const int d = n * 16 + fq * 4;
                    o[(size_t)(d + 0) * SEQ] = f2bf(v.x); o[(size_t)(d + 1) * SEQ] = f2bf(v.y); o[(size_t)(d + 2) * SEQ] = f2bf(v.z); o[(size_t)(d + 3) * SEQ] = f2bf(v.w); } }
            return;
        }
        if (seg < 52) {
            const int kind = (seg - 20) >> 3, cb = ((seg - 20) & 7) * 64 + fq * 4;
            if (kind == 1) {
                const float* lb = (const float*)(ws + WS_LB); float* dst = (float*)(ws + WS_HLOGF);
#pragma unroll
                for (int m = 0; m < 4; ++m)
#pragma unroll
                    for (int n = 0; n < 4; ++n) { const int c = cb + n * 16; const f32x4 l = *(const f32x4*)(lb + c); const f32x4 v = acc[m][n]; f32x4 o;
                        o.x = __logf(l.x + (1.f - l.x) * sigmoidf_(v.x)); o.y = __logf(l.y + (1.f - l.y) * sigmoidf_(v.y));
                        o.z = __logf(l.z + (1.f - l.z) * sigmoidf_(v.z)); o.w = __logf(l.w + (1.f - l.w) * sigmoidf_(v.w));
                        *(f32x4*)(dst + (size_t)rows[m] * 512 + c) = o; }
            } else {
                bf16_t* dst = (bf16_t*)(ws + (kind == 0 ? WS_HQ : (kind == 2 ? WS_HV : WS_HG)));
#pragma unroll
                for (int m = 0; m < 4; ++m)
#pragma unroll
                    for (int n = 0; n < 4; ++n) { f32x4 v = acc[m][n];
                        if (kind != 2) { v.x = siluf_(v.x); v.y = siluf_(v.y); v.z = siluf_(v.z); v.w = siluf_(v.w); }
                        u32x2 w; w.x = pk2(v.x, v.y); w.y = pk2(v.z, v.w); *(u32x2*)(dst + (size_t)rows[m] * 512 + cb + n * 16) = w; }
            }
            return;
        }
        {
            float* dst = (float*)(ws + WS_GATES);
#pragma unroll
            for (int m = 0; m < 4; ++m)
#pragma unroll
                for (int n = 0; n < 2; ++n) { const int c = n * 16 + fq * 4; if (c < 24) { const f32x4 v = acc[m][n]; f32x4 o; o.x = sigmoidf_(v.x); o.y = sigmoidf_(v.y); o.z = sigmoidf_(v.z); o.w = sigmoidf_(v.w);
                        *(f32x4*)(dst + (size_t)rows[m] * 24 + c) = o; } }
        }
    }
};
DEV void phase_inproj(const Params& p, unsigned char* lds) {
    const int vb = vblock(), G = gridDim.x;
    constexpr int NMT = NTOK / 128, NNT = INP / 256, U = NMT * NNT;
    for (int u = vb; u < U; u += G) {
        const int grp = u / (16 * NNT), rem = u % (16 * NNT), nt = rem / 16, mt = grp * 16 + rem % 16;
        ARows al{(const bf16_t*)(p.ws + WS_R1) + (size_t)mt * 128 * DM, DM};
        BRows bl{(const bf16_t*)(p.ws + WS_WINT) + (size_t)nt * 256 * DM, DM};
        EpiInproj ep{p, mt * 128, nt};
        gemm_tile(lds, al, bl, DM / 64, ep);
    }
}

struct ACmp { const bf16_t* src; int rbase;
    DEV const bf16_t* row(int r) const { int rr = rbase + r; if (rr > 4079) rr = 4079; const int bg = rr / NC, c = rr % NC; return src + ((size_t)bg * SEQ + 16 * c) * 64; } };
struct EpiCmpA { const Params& p; int z, rbase;
    DEV void operator()(f32x4 (&acc)[4][4], int wr, int wc, int lane) const {
        const int frow = lane & 15, fq = lane >> 4;
        const float* cb = (const float*)(p.ws + WS_CBIAS) + z * 256; bf16_t* hid = (bf16_t*)(p.ws + WS_HID) + (size_t)z * 4096 * 256;
#pragma unroll
        for (int m = 0; m < 4; ++m) { const int rr = rbase + wr * 64 + m * 16 + frow;
#pragma unroll
            for (int n = 0; n < 4; ++n) { const int c = wc * 64 + n * 16 + fq * 4; const f32x4 b = *(const f32x4*)(cb + c); f32x4 v = acc[m][n] + b;
                u32x2 w; w.x = pk2(siluf_(v.x), siluf_(v.y)); w.y = pk2(siluf_(v.z), siluf_(v.w)); *(u32x2*)(hid + (size_t)rr * 256 + c) = w; } }
    } };
DEV void phase_cmp_a(const Params& p, unsigned char* lds) {
    const int vb = vblock(), G = gridDim.x;
    for (int u = vb; u < 64; u += G) {
        const int z = u >> 5, rbase = (u & 31) * 128;
        ACmp al{(const bf16_t*)(p.ws + (z ? WS_VC : WS_KC)), rbase};
        BRows bl{(const bf16_t*)(p.ws + WS_CW1T) + (size_t)z * 256 * 2048, 2048};
        EpiCmpA ep{p, z, rbase};
        gemm_tile(lds, al, bl, 2048 / 64, ep);
    }
}
struct BClamp64 { const bf16_t* base; size_t ld; DEV const bf16_t* ptr(int n, int kt) const { return base + (size_t)(n & 63) * ld + kt * 64; } };
struct EpiCmpB { const Params& p; int z, rbase;
    DEV void operator()(f32x4 (&acc)[4][4], int wr, int wc, int lane) const {
        if (wc != 0) return;
        const int frow = lane & 15, fq = lane >> 4;
        bf16_t* dst = (bf16_t*)(p.ws + (z ? WS_VCMP : WS_KCMP));
#pragma unroll
        for (int m = 0; m < 4; ++m) { const int rr = rbase + wr * 64 + m * 16 + frow;
            float r = 1.f;
            if (z == 0) { float ss = 0.f;
#pragma unroll
                for (int n = 0; n < 4; ++n) { const f32x4 v = acc[m][n]; ss += (v.x * v.x + v.y * v.y) + (v.z * v.z + v.w * v.w); }
                ss += __shfl_xor(ss, 16); ss += __shfl_xor(ss, 32); r = rsqrtf(ss * (1.f / 64.f) + RMS_EPS); }
            if (rr < 4080) { const int bg = rr / NC, c = rr % NC;
#pragma unroll
                for (int n = 0; n < 4; ++n) { const int d = n * 16 + fq * 4; f32x4 v = acc[m][n] * r;
                    if (z == 0) { const f32x4 g = *(const f32x4*)(p.g_k + d); v = v * g; }
                    u32x2 w; w.x = pk2(v.x, v.y); w.y = pk2(v.z, v.w); *(u32x2*)(dst + ((size_t)bg * 256 + c) * 64 + d) = w; } }
        }
    } };
DEV void phase_cmp_b(const Params& p, unsigned char* lds) {
    const int vb = vblock(), G = gridDim.x;
    for (int u = vb; u < 64; u += G) {
        const int z = u >> 5, rbase = (u & 31) * 128;
        ARows al{(const bf16_t*)(p.ws + WS_HID) + ((size_t)z * 4096 + rbase) * 256, 256};
        BClamp64 bl{(const bf16_t*)(p.ws + WS_CW2T) + (size_t)z * 64 * 256, 256};
        EpiCmpB ep{p, z, rbase};
        gemm_tile(lds, al, bl, 256 / 64, ep);
    }
}

constexpr int CA_KS = 0, CA_VS = 256 * 132, CA_QS = CA_VS + 256 * 128, CA_PB = CA_QS + 8 * 4 * 64 * 4, CA_LDS = CA_PB + 8 * 256 * 4 * 4;
DEV void phase_cmp_attn(const Params& p, unsigned char* lds) {
    const int tid = threadIdx.x, lane = tid & 63, wid = tid >> 6;
    const int vb = vblock(), G = gridDim.x;
    unsigned char* ws = p.ws;
    const bf16_t* Q = (const bf16_t*)(ws + WS_Q);
    const float* gates = (const float*)(ws + WS_GATES);
    bf16_t* OC = (bf16_t*)(ws + WS_OC);
    unsigned long long* selm = (unsigned long long*)(ws + WS_SELM);
    float* qs = (float*)(lds + CA_QS) + wid * 256;
    float* pb = (float*)(lds + CA_PB) + wid * 1024;
    for (int it = vb; it < 1024; it += G) {
        const int rnd = it / G, pos = it % G; int sidx = (rnd & 1) ? (rnd * G + (G - 1 - pos)) : (rnd * G + pos); if (G != 256) sidx = it;
        const int ci = 63 - (sidx >> 4), bg = sidx & 15, b = bg >> 1, g = bg & 1;
        const int nvis = min(NC, 4 * ci + 3);
        __syncthreads();
        {
            const bf16_t* kc = (const bf16_t*)(ws + WS_KCMP) + (size_t)bg * 256 * 64; const bf16_t* vc = (const bf16_t*)(ws + WS_VCMP) + (size_t)bg * 256 * 64;
            for (int idx = tid; idx < nvis * 32; idx += NT) { const int c = idx >> 5, d2 = idx & 31;
                *(unsigned*)(lds + CA_KS + c * 132 + d2 * 4) = *(const unsigned*)(kc + c * 64 + d2 * 2);
                *(unsigned*)(lds + CA_VS + c * 128 + d2 * 4) = *(const unsigned*)(vc + c * 64 + d2 * 2); }
        }
        __syncthreads();
        for (int tt = 0; tt < 8; ++tt) {
            const int t = ci * 64 + wid * 8 + tt; const size_t tok = (size_t)b * SEQ + t;
            const int nv = t >= 31 ? min(NC, (t - 31) / 16 + 1) : 0;
            const int cur = t >> 6;
            float oacc[4] = {0.f, 0.f, 0.f, 0.f};
            float imp = 0.f;
            if (nv > 0) {
                asm volatile("s_waitcnt lgkmcnt(0)" ::: "memory");
#pragma unroll
                for (int r = 0; r < 4; ++r) qs[r * 64 + lane] = bf2f(Q[((size_t)(b * 8 + g * 4 + r) * SEQ + t) * 64 + lane]);
                asm volatile("s_waitcnt lgkmcnt(0)" ::: "memory");
                const int nj = (nv + 63) >> 6;
                float sc[4][4];
#pragma unroll
                for (int j = 0; j < 4; ++j)
#pragma unroll
                    for (int r = 0; r < 4; ++r) sc[j][r] = 0.f;
                for (int d2 = 0; d2 < 32; ++d2) {
                    f32x2 qq[4];
#pragma unroll
                    for (int r = 0; r < 4; ++r) qq[r] = *(const f32x2*)(qs + r * 64 + 2 * d2);
#pragma unroll
                    for (int j = 0; j < 4; ++j) if (j < nj) {
                        const unsigned kk = *(const unsigned*)(lds + CA_KS + (lane + 64 * j) * 132 + d2 * 4); const float k0 = bflo(kk), k1 = bfhi(kk);
#pragma unroll
                        for (int r = 0; r < 4; ++r) sc[j][r] += qq[r].x * k0 + qq[r].y * k1;
                    }
                }
                float mx[4], sm[4];
#pragma unroll
                for (int r = 0; r < 4; ++r) { float m = -1e30f;
#pragma unroll
                    for (int j = 0; j < 4; ++j) if (lane + 64 * j < nv) m = fmaxf(m, sc[j][r]);
                    mx[r] = wave_max(m); }
#pragma unroll
                for (int r = 0; r < 4; ++r) { float s = 0.f;
#pragma unroll
                    for (int j = 0; j < 4; ++j) { const float e = (lane + 64 * j < nv) ? exp2f(sc[j][r] - mx[r]) : 0.f; sc[j][r] = e; s += e; }
                    sm[r] = 1.f / wave_sum(s); }
#pragma unroll
                for (int j = 0; j < 4; ++j) { f32x4 pv; pv.x = sc[j][0] * sm[0]; pv.y = sc[j][1] * sm[1]; pv.z = sc[j][2] * sm[2]; pv.w = sc[j][3] * sm[3]; *(f32x4*)(pb + (lane + 64 * j) * 4) = pv; }
                asm volatile("s_waitcnt lgkmcnt(0)" ::: "memory");
                {
                    const int c0 = 4 * lane;
                    f32x4 a = *(const f32x4*)(pb + (c0) * 4), b1 = *(const f32x4*)(pb + (c0 + 1) * 4), c2 = *(const f32x4*)(pb + (c0 + 2) * 4), d3 = *(const f32x4*)(pb + (c0 + 3) * 4);
                    f32x4 pm = (f32x4){0.f, 0.f, 0.f, 0.f}; if (lane > 0) pm = *(const f32x4*)(pb + (c0 - 1) * 4);
                    const f32x4 s4 = (a + b1 + c2) + (pm + d3) * 0.5f;
                    imp = (s4.x + s4.y) + (s4.z + s4.w);
                }
                for (int c = 0; c < nv; ++c) { const f32x4 pp = *(const f32x4*)(pb + c * 4); const float v = bf2f(*(const bf16_t*)(lds + CA_VS + c * 128 + lane * 2));
                    oacc[0] += pp.x * v; oacc[1] += pp.y * v; oacc[2] += pp.z * v; oacc[3] += pp.w * v; }
            }
            {
                const float INF = __builtin_inff();
                const float v = (lane == 0 || lane == cur) ? INF : (lane < cur ? imp : -INF);
                int rank = 0;
                for (int i = 0; i <= cur; ++i) { const float vi = __uint_as_float(__builtin_amdgcn_readlane(__float_as_uint(v), i)); rank += ((vi > v) || (vi == v && i < lane)) ? 1 : 0; }
                const bool sel = (lane <= cur) && (rank < 16);
                const unsigned long long mask = __ballot(sel);
                if (lane == 0) selm[(size_t)bg * SEQ + t] = mask;
            }
#pragma unroll
            for (int r = 0; r < 4; ++r) { const int h = g * 4 + r; const float gt = gates[tok * 24 + h * 3 + 0]; OC[tok * 512 + h * 64 + lane] = f2bf(gt * oacc[r]); }
        }
    }
}

constexpr int FA_KB = 64 * 128, FA_VB = 64 * 136, FA_STAGE = FA_KB + FA_VB, FA_LDS = 2 * FA_STAGE + 1024;
template <bool SEL>
DEV void fa_branch(unsigned char* lds, const bf16_t* Kb, const bf16_t* VTb, int ci, int bg, const bf16x8 (&qf)[4], int t, unsigned long long mymask, unsigned long long need,
                   f32x16 (&ot)[2], float& m_run, float& l_run) {
    const int tid = threadIdx.x, lane = tid & 63;
    const int r31 = lane & 31, hh = lane >> 5;
    const int lrow = tid >> 3, lch = tid & 7;
    const bf16_t* kg = Kb + ((size_t)bg * SEQ + lrow) * 64 + lch * 8;
    const bf16_t* vg = VTb + ((size_t)bg * 64 + lrow) * SEQ + lch * 8;
    const int koff = lrow * 128 + ((lch ^ ((lrow >> 1) & 7)) << 4), voff = FA_KB + lrow * 136 + lch * 16;
    int jlo, jhi; unsigned long long todo;
    if (SEL) { todo = need; jlo = 0; jhi = ci; } else { jlo = ci >= 8 ? ci - 8 : 0; jhi = ci; todo = 0; }
    int j = jlo;
    if (SEL) { if (todo == 0) return; j = __builtin_ctzll(todo); todo &= todo - 1; }
    u32x4 rk = *(const u32x4*)(kg + (size_t)j * 64 * 64), rv = *(const u32x4*)(vg + (size_t)j * 64);
    __syncthreads();
    *(u32x4*)(lds + koff) = rk; { u32x2 a, b2; a.x = rv.x; a.y = rv.y; b2.x = rv.z; b2.y = rv.w; *(u32x2*)(lds + voff) = a; *(u32x2*)(lds + voff + 8) = b2; }
    __syncthreads();
    int st = 0;
    for (;;) {
        int jn; bool more;
        if (SEL) { more = (todo != 0); jn = more ? __builtin_ctzll(todo) : 0; todo &= todo - 1; } else { jn = j + 1; more = (jn <= jhi); }
        if (more) { rk = *(const u32x4*)(kg + (size_t)jn * 64 * 64); rv = *(const u32x4*)(vg + (size_t)jn * 64); }
        const unsigned char* base = lds + st * FA_STAGE;
        f32x16 sacc[2];
#pragma unroll
        for (int kt2 = 0; kt2 < 2; ++kt2) {
#pragma unroll
            for (int i = 0; i < 16; ++i) sacc[kt2][i] = 0.f;
            const int row = 32 * kt2 + r31; const int sx = (row >> 1) & 7;
#pragma unroll
            for (int s = 0; s < 4; ++s) { const bf16x8 kf = *(const bf16x8*)(base + row * 128 + (((2 * s + hh) ^ sx) << 4));
                sacc[kt2] = __builtin_amdgcn_mfma_f32_32x32x16_bf16(kf, qf[s], sacc[kt2], 0, 0, 0); }
        }
        const bool bit = SEL ? ((mymask >> j) & 1ull) != 0 : true;
        float mx = -1e30f;
#pragma unroll
        for (int kt2 = 0; kt2 < 2; ++kt2)
#pragma unroll
            for (int i = 0; i < 16; ++i) { const int key = 64 * j + 32 * kt2 + (i & 3) + 8 * (i >> 2) + 4 * hh;
                const bool ok = SEL ? (bit && key <= t) : (key <= t && t - key < 512);
                const float v = ok ? sacc[kt2][i] : -1e30f; sacc[kt2][i] = v; mx = fmaxf(mx, v); }
        mx = fmaxf(mx, __shfl_xor(mx, 32));
        const float m_new = fmaxf(m_run, mx);
        const float alpha = exp2f(m_run - m_new);
        m_run = m_new;
        float rs = 0.f;
#pragma unroll
        for (int kt2 = 0; kt2 < 2; ++kt2)
#pragma unroll
            for (int i = 0; i < 16; ++i) { const float v = sacc[kt2][i]; const float e = (v > -5e29f) ? exp2f(v - m_new) : 0.f; sacc[kt2][i] = e; rs += e; }
        l_run = l_run * alpha + rs;
#pragma unroll
        for (int dt = 0; dt < 2; ++dt)
#pragma unroll
            for (int i = 0; i < 16; ++i) ot[dt][i] *= alpha;
#pragma unroll
        for (int kt2 = 0; kt2 < 2; ++kt2)
#pragma unroll
            for (int s2 = 0; s2 < 2; ++s2) {
                bf16x8 pf; { u32x4 w; w.x = pk2(sacc[kt2][8 * s2 + 0], sacc[kt2][8 * s2 + 1]); w.y = pk2(sacc[kt2][8 * s2 + 2], sacc[kt2][8 * s2 + 3]);
                    w.z = pk2(sacc[kt2][8 * s2 + 4], sacc[kt2][8 * s2 + 5]); w.w = pk2(sacc[kt2][8 * s2 + 6], sacc[kt2][8 * s2 + 7]); pf = __builtin_bit_cast(bf16x8, w); }
#pragma unroll
                for (int dt = 0; dt < 2; ++dt) {
                    const unsigned char* va = base + FA_KB + (32 * dt + r31) * 136 + (32 * kt2 + 16 * s2 + 4 * hh) * 2;
                    const u32x2 lo = *(const u32x2*)(va), hi = *(const u32x2*)(va + 16);
                    u32x4 w; w.x = lo.x; w.y = lo.y; w.z = hi.x; w.w = hi.y;
                    ot[dt] = __builtin_amdgcn_mfma_f32_32x32x16_bf16(__builtin_bit_cast(bf16x8, w), pf, ot[dt], 0, 0, 0);
                }
            }
        if (!more) break;
        { unsigned char* nb = lds + (st ^ 1) * FA_STAGE; *(u32x4*)(nb + koff) = rk; u32x2 a, b2; a.x = rv.x; a.y = rv.y; b2.x = rv.z; b2.y = rv.w; *(u32x2*)(nb + voff) = a; *(u32x2*)(nb + voff + 8) = b2; }
        __syncthreads();
        st ^= 1; j = jn;
    }
}
DEV void phase_flash(const Params& p, unsigned char* lds) {
    const int tid = threadIdx.x, lane = tid & 63, wid = tid >> 6;
    const int vb = vblock(), G = gridDim.x;
    unsigned char* ws = p.ws;
    const int r31 = lane & 31, hh = lane >> 5;
    unsigned long long* red = (unsigned long long*)(lds + 2 * FA_STAGE);
    for (int it = vb; it < 1024; it += G) {
        const int rnd = it / G, pos = it % G; int sidx = (rnd & 1) ? (rnd * G + (G - 1 - pos)) : (rnd * G + pos); if (G != 256) sidx = it;
        const int ci = 63 - (sidx >> 4), bg = sidx & 15, b = bg >> 1, g = bg & 1;
        const int head = g * 4 + (wid >> 1);
        const int t = ci * 64 + (wid & 1) * 32 + r31;
        const size_t tok = (size_t)b * SEQ + t;
        bf16x8 qf[4];
        { const bf16_t* qp = (const bf16_t*)(ws + WS_Q) + ((size_t)(b * 8 + head) * SEQ + t) * 64 + 8 * hh;
#pragma unroll
            for (int s = 0; s < 4; ++s) qf[s] = *(const bf16x8*)(qp + 16 * s); }
        const unsigned long long mymask = ((const unsigned long long*)(ws + WS_SELM))[(size_t)bg * SEQ + t];
        unsigned long long orm = mymask;
#pragma unroll
        for (int o = 1; o < 32; o <<= 1) { const unsigned lo = __shfl_xor((unsigned)orm, o), hi = __shfl_xor((unsigned)(orm >> 32), o); orm |= ((unsigned long long)hi << 32) | lo; }
        __syncthreads();
        if (wid < 2 && lane == 0) red[wid] = orm;
        __syncthreads();
        const unsigned long long need = red[0] | red[1];
        f32x16 oc[2];
        {
            f32x16 ot[2]; float m_run = -1e30f, l_run = 0.f;
#pragma unroll
            for (int dt = 0; dt < 2; ++dt)
#pragma unroll
                for (int i = 0; i < 16; ++i) ot[dt][i] = 0.f;
            fa_branch<true>(lds, (const bf16_t*)(ws + WS_KS), (const bf16_t*)(ws + WS_VST), ci, bg, qf, t, mymask, need, ot, m_run, l_run);
            const float lt = l_run + __shfl_xor(l_run, 32);
            const float sc = ((const float*)(ws + WS_GATES))[tok * 24 + head * 3 + 1] / lt;
#pragma unroll
            for (int dt = 0; dt < 2; ++dt)
#pragma unroll
                for (int i = 0; i < 16; ++i) oc[dt][i] = ot[dt][i] * sc;
        }
        {
            f32x16 ot[2]; float m_run = -1e30f, l_run = 0.f;
#pragma unroll
            for (int dt = 0; dt < 2; ++dt)
#pragma unroll
                for (int i = 0; i < 16; ++i) ot[dt][i] = 0.f;
            fa_branch<false>(lds, (const bf16_t*)(ws + WS_KW), (const bf16_t*)(ws + WS_VWT), ci, bg, qf, t, 0ull, 0ull, ot, m_run, l_run);
            const float lt = l_run + __shfl_xor(l_run, 32);
            const float sc = ((const float*)(ws + WS_GATES))[tok * 24 + head * 3 + 2] / lt;
#pragma unroll
            for (int dt = 0; dt < 2; ++dt)
#pragma unroll
                for (int i = 0; i < 16; ++i) oc[dt][i] += ot[dt][i] * sc;
        }
        {
            const bf16_t* ocp = (const bf16_t*)(ws + WS_OC) + tok * 512 + head * 64;
            bf16_t* mix = (bf16_t*)(ws + WS_R1) + tok * 1024 + head * 64;
            float ss = 0.f;
#pragma unroll
            for (int dt = 0; dt < 2; ++dt)
#pragma unroll
                for (int g4 = 0; g4 < 4; ++g4) { const int d0 = 32 * dt + 8 * g4 + 4 * hh; const u32x2 c = *(const u32x2*)(ocp + d0);
                    const float v0 = oc[dt][4 * g4 + 0] + bflo(c.x), v1 = oc[dt][4 * g4 + 1] + bfhi(c.x), v2 = oc[dt][4 * g4 + 2] + bflo(c.y), v3 = oc[dt][4 * g4 + 3] + bfhi(c.y);
                    ss += (v0 * v0 + v1 * v1) + (v2 * v2 + v3 * v3);
                    u32x2 w; w.x = pk2(v0, v1); w.y = pk2(v2, v3); *(u32x2*)(mix + d0) = w; }
            ss += __shfl_xor(ss, 32);
            if (hh == 0) atomicAdd((float*)(ws + WS_ROWSS) + tok, ss);
        }
    }
}

DEV int swz256(int row, int chunk) { return row * 256 + ((chunk ^ (row & 15)) << 4); }
DEV void hgrn_cumsum(const Params& p, int bh, int c, float* segs, f32x2 (&lf)[8], f32x2 (&a)[8], f32x2& r, f32x2& alast) {
    const int tid = threadIdx.x, k2 = tid & 63, tq = tid >> 6;
    const int b = bh >> 2, h = bh & 3;
    const float* HL = (const float*)(p.ws + WS_HLOGF) + ((size_t)b * SEQ + c * 64 + tq * 8) * 512 + h * 128 + 2 * k2;
#pragma unroll
    for (int i = 0; i < 8; ++i) lf[i] = *(const f32x2*)(HL + (size_t)i * 512);
    f32x2 run = (f32x2){0.f, 0.f};
#pragma unroll
    for (int i = 0; i < 8; ++i) { run = run + lf[i]; a[i] = run; }
    *(f32x2*)(segs + tq * 128 + 2 * k2) = run;
    __syncthreads();
    f32x2 off = (f32x2){0.f, 0.f}, tot = off, rr = off;
#pragma unroll
    for (int q = 0; q < 8; ++q) { const f32x2 s = *(const f32x2*)(segs + q * 128 + 2 * k2); if (q < tq) off = off + s; if (q < 4) rr = rr + s; tot = tot + s; }
#pragma unroll
    for (int i = 0; i < 8; ++i) a[i] = a[i] + off;
    r = rr; alast = tot;
}
DEV void hgrn_stage_vt(const Params& p, int bh, int c, unsigned char* vt) {
    const int tid = threadIdx.x, k2 = tid & 63, tq = tid >> 6;
    const int b = bh >> 2, h = bh & 3;
    const bf16_t* HV = (const bf16_t*)(p.ws + WS_HV) + ((size_t)b * SEQ + c * 64 + tq * 8) * 512 + h * 128 + 2 * k2;
    unsigned vv[8];
#pragma unroll
    for (int i = 0; i < 8; ++i) vv[i] = *(const unsigned*)(HV + (size_t)i * 512);
    u32x4 lo, hi;
    lo.x = (vv[0] & 0xffffu) | (vv[1] << 16); lo.y = (vv[2] & 0xffffu) | (vv[3] << 16); lo.z = (vv[4] & 0xffffu) | (vv[5] << 16); lo.w = (vv[6] & 0xffffu) | (vv[7] << 16);
    hi.x = (vv[0] >> 16) | (vv[1] & 0xffff0000u); hi.y = (vv[2] >> 16) | (vv[3] & 0xffff0000u); hi.z = (vv[4] >> 16) | (vv[5] & 0xffff0000u); hi.w = (vv[6] >> 16) | (vv[7] & 0xffff0000u);
    *(u32x4*)(vt + swz(2 * k2, tq)) = lo; *(u32x4*)(vt + swz(2 * k2 + 1, tq)) = hi;
}
constexpr int H1_KT = 0, H1_VT = 16384, H1_SEG = 32768, H1_EK = H1_SEG + 4096;
DEV void phase_hgrn_a1(const Params& p, unsigned char* lds) {
    const int tid = threadIdx.x, lane = tid & 63, wid = tid >> 6, k2 = tid & 63, tq = tid >> 6;
    const int vb = vblock(), G = gridDim.x;
    const int frow = lane & 15, fq = lane >> 4, wr = wid >> 1, wc = wid & 1;
    float* segs = (float*)(lds + H1_SEG); float* ek = (float*)(lds + H1_EK);
    bf16_t* ubuf = (bf16_t*)(p.ws + WS_UBUF); float* dbuf = (float*)(p.ws + WS_DBUF);
    for (int item = vb; item < 2048; item += G) {
        const int bh = item >> 6, c = item & 63;
        __syncthreads();
        f32x2 lf[8], a[8], r, al;
        hgrn_cumsum(p, bh, c, segs, lf, a, r, al);
        {
            float kx[8], ky[8];
#pragma unroll
            for (int i = 0; i < 8; ++i) { kx[i] = (1.f - __expf(lf[i].x)) * __expf(fminf(r.x - a[i].x, 80.f)); ky[i] = (1.f - __expf(lf[i].y)) * __expf(fminf(r.y - a[i].y, 80.f)); }
            u32x4 w0, w1;
            w0.x = pk2(kx[0], kx[1]); w0.y = pk2(kx[2], kx[3]); w0.z = pk2(kx[4], kx[5]); w0.w = pk2(kx[6], kx[7]);
            w1.x = pk2(ky[0], ky[1]); w1.y = pk2(ky[2], ky[3]); w1.z = pk2(ky[4], ky[5]); w1.w = pk2(ky[6], ky[7]);
            *(u32x4*)(lds + H1_KT + swz(2 * k2, tq)) = w0; *(u32x4*)(lds + H1_KT + swz(2 * k2 + 1, tq)) = w1;
        }
        hgrn_stage_vt(p, bh, c, lds + H1_VT);
        if (tq == 7) { ek[2 * k2] = __expf(al.x - r.x); ek[2 * k2 + 1] = __expf(al.y - r.y); f32x2 d; d.x = __expf(al.x); d.y = __expf(al.y); *(f32x2*)(dbuf + (size_t)item * 128 + 2 * k2) = d; }
        __syncthreads();
        f32x4 acc[2][4];
#pragma unroll
        for (int m = 0; m < 2; ++m)
#pragma unroll
            for (int n = 0; n < 4; ++n) acc[m][n] = (f32x4){0.f, 0.f, 0.f, 0.f};
        const int sx = (frow >> 1) & 7;
#pragma unroll
        for (int ks = 0; ks < 2; ++ks) {
            const int co = ((ks * 4 + fq) ^ sx) << 4;
            bf16x8 af[2], bfr[4];
#pragma unroll
            for (int m = 0; m < 2; ++m) af[m] = *(const bf16x8*)(lds + H1_VT + (32 * wr + 16 * m + frow) * 128 + co);
#pragma unroll
            for (int n = 0; n < 4; ++n) bfr[n] = *(const bf16x8*)(lds + H1_KT + (64 * wc + 16 * n + frow) * 128 + co);
#pragma unroll
            for (int m = 0; m < 2; ++m)
#pragma unroll
                for (int n = 0; n < 4; ++n) acc[m][n] = __builtin_amdgcn_mfma_f32_16x16x32_bf16(bfr[n], af[m], acc[m][n], 0, 0, 0);
        }
#pragma unroll
        for (int m = 0; m < 2; ++m) { const int v = 32 * wr + 16 * m + frow;
#pragma unroll
            for (int n = 0; n < 4; ++n) { const int k0 = 64 * wc + 16 * n + 4 * fq; const f32x4 e = *(const f32x4*)(ek + k0); const f32x4 o = acc[m][n] * e;
                u32x2 w; w.x = pk2(o.x, o.y); w.y = pk2(o.z, o.w); *(u32x2*)(ubuf + ((size_t)item * 128 + v) * 128 + k0) = w; } }
    }
}
DEV void phase_hgrn_a2(const Params& p, unsigned char* lds) {
    const int G = gridDim.x;
    bf16_t* ubuf = (bf16_t*)(p.ws + WS_UBUF); const float* dbuf = (const float*)(p.ws + WS_DBUF);
    for (int gid = blockIdx.x * NT + threadIdx.x; gid < 131072; gid += G * NT) {
        const int bh = gid >> 12, v = (gid >> 5) & 127, k4 = gid & 31;
        bf16_t* u = ubuf + ((size_t)bh * 64 * 128 + v) * 128 + 4 * k4;
        const float* d = dbuf + (size_t)bh * 64 * 128 + 4 * k4;
        f32x4 S = (f32x4){0.f, 0.f, 0.f, 0.f};
        for (int c0 = 0; c0 < 64; c0 += 8) {
            u32x2 uu[8]; f32x4 dd[8];
#pragma unroll
            for (int j = 0; j < 8; ++j) { uu[j] = *(const u32x2*)(u + (size_t)(c0 + j) * 16384); dd[j] = *(const f32x4*)(d + (size_t)(c0 + j) * 128); }
#pragma unroll
            for (int j = 0; j < 8; ++j) { u32x2 w; w.x = pk2(S.x, S.y); w.y = pk2(S.z, S.w); *(u32x2*)(u + (size_t)(c0 + j) * 16384) = w;
                S.x = dd[j].x * S.x + bflo(uu[j].x); S.y = dd[j].y * S.y + bfhi(uu[j].x); S.z = dd[j].z * S.z + bflo(uu[j].y); S.w = dd[j].w * S.w + bfhi(uu[j].y); }
        }
    }
}
constexpr int H3_QH = 0, H3_QA = 16384, H3_KH = 32768, H3_VT = 49152, H3_PP = 65536, H3_ST = 73728, H3_SEG = 106496, H3_RED = 110592;
DEV void phase_hgrn_a3(const Params& p, unsigned char* lds) {
    const int tid = threadIdx.x, lane = tid & 63, wid = tid >> 6, k2 = tid & 63, tq = tid >> 6;
    const int vb = vblock(), G = gridDim.x;
    const int frow = lane & 15, fq = lane >> 4;
    float* segs = (float*)(lds + H3_SEG); float* red = (float*)(lds + H3_RED);
    const bf16_t* ubuf = (const bf16_t*)(p.ws + WS_UBUF);
    for (int item = vb; item < 2048; item += G) {
        const int bh = item >> 6, c = item & 63, b = bh >> 2, h = bh & 3;
        __syncthreads();
        f32x2 lf[8], a[8], r, al;
        hgrn_cumsum(p, bh, c, segs, lf, a, r, al);
        {
            const bf16_t* HQ = (const bf16_t*)(p.ws + WS_HQ) + ((size_t)b * SEQ + c * 64 + tq * 8) * 512 + h * 128 + 2 * k2;
            unsigned qq[8];
#pragma unroll
            for (int i = 0; i < 8; ++i) qq[i] = *(const unsigned*)(HQ + (size_t)i * 512);
#pragma unroll
            for (int i = 0; i < 8; ++i) { const int t = 8 * tq + i; const float q0 = bflo(qq[i]), q1 = bfhi(qq[i]);
                const int off = swz256(t, k2 >> 2) + (k2 & 3) * 4;
                *(unsigned*)(lds + H3_QH + off) = pk2(q0 * __expf(fminf(a[i].x - r.x, 80.f)), q1 * __expf(fminf(a[i].y - r.y, 80.f)));
                *(unsigned*)(lds + H3_QA + off) = pk2(q0 * __expf(a[i].x), q1 * __expf(a[i].y));
                *(unsigned*)(lds + H3_KH + off) = pk2((1.f - __expf(lf[i].x)) * __expf(fminf(r.x - a[i].x, 80.f)), (1.f - __expf(lf[i].y)) * __expf(fminf(r.y - a[i].y, 80.f))); }
        }
        hgrn_stage_vt(p, bh, c, lds + H3_VT);
        {
            const bf16_t* st = ubuf + (size_t)item * 16384;
#pragma unroll
            for (int i = 0; i < 4; ++i) { const int q = tid + NT * i, v = q >> 4, ch = q & 15; *(u32x4*)(lds + H3_ST + swz256(v, ch)) = *(const u32x4*)(st + v * 128 + ch * 8); }
        }
        __syncthreads();
        {
            const int wr = wid >> 1, wc = wid & 1;
            f32x4 acc[2];
            acc[0] = (f32x4){0.f, 0.f, 0.f, 0.f}; acc[1] = acc[0];
            if (32 * wc <= 16 * wr + 15) {
#pragma unroll
                for (int ks = 0; ks < 4; ++ks) {
                    const int co = ((ks * 4 + fq) ^ frow) << 4;
                    const bf16x8 af = *(const bf16x8*)(lds + H3_QH + (16 * wr + frow) * 256 + co);
#pragma unroll
                    for (int n = 0; n < 2; ++n) { const bf16x8 bfr = *(const bf16x8*)(lds + H3_KH + (32 * wc + 16 * n + frow) * 256 + co);
                        acc[n] = __builtin_amdgcn_mfma_f32_16x16x32_bf16(bfr, af, acc[n], 0, 0, 0); }
                }
            }
            const int t = 16 * wr + frow;
#pragma unroll
            for (int n = 0; n < 2; ++n) { const int s0 = 32 * wc + 16 * n + 4 * fq; f32x4 v = acc[n];
                v.x = (s0 + 0 <= t) ? v.x : 0.f; v.y = (s0 + 1 <= t) ? v.y : 0.f; v.z = (s0 + 2 <= t) ? v.z : 0.f; v.w = (s0 + 3 <= t) ? v.w : 0.f;
                u32x2 w; w.x = pk2(v.x, v.y); w.y = pk2(v.z, v.w);
                *(u32x2*)(lds + H3_PP + t * 128 + ((((s0 >> 3)) ^ ((t >> 1) & 7)) << 4) + (s0 & 7) * 2) = w; }
        }
        __syncthreads();
        {
            const int wr = wid >> 2, wc = wid & 3;
            f32x4 acc[2][2];
#pragma unroll
            for (int m = 0; m < 2; ++m)
#pragma unroll
                for (int n = 0; n < 2; ++n) acc[m][n] = (f32x4){0.f, 0.f, 0.f, 0.f};
            const int sx = (frow >> 1) & 7;
#pragma unroll
            for (int ks = 0; ks < 2; ++ks) {
                const int co = ((ks * 4 + fq) ^ sx) << 4;
                bf16x8 af[2], bfr[2];
#pragma unroll
                for (int m = 0; m < 2; ++m) af[m] = *(const bf16x8*)(lds + H3_PP + (32 * wr + 16 * m + frow) * 128 + co);
#pragma unroll
                for (int n = 0; n < 2; ++n) bfr[n] = *(const bf16x8*)(lds + H3_VT + (32 * wc + 16 * n + frow) * 128 + co);
#pragma unroll
                for (int m = 0; m < 2; ++m)
#pragma unroll
                    for (int n = 0; n < 2; ++n) acc[m][n] = __builtin_amdgcn_mfma_f32_16x16x32_bf16(bfr[n], af[m], acc[m][n], 0, 0, 0);
            }
#pragma unroll
            for (int ks = 0; ks < 4; ++ks) {
                const int co = ((ks * 4 + fq) ^ frow) << 4;
                bf16x8 af[2], bfr[2];
#pragma unroll
                for (int m = 0; m < 2; ++m) af[m] = *(const bf16x8*)(lds + H3_QA + (32 * wr + 16 * m + frow) * 256 + co);
#pragma unroll
                for (int n = 0; n < 2; ++n) bfr[n] = *(const bf16x8*)(lds + H3_ST + (32 * wc + 16 * n + frow) * 256 + co);
#pragma unroll
                for (int m = 0; m < 2; ++m)
#pragma unroll
                    for (int n = 0; n < 2; ++n) acc[m][n] = __builtin_amdgcn_mfma_f32_16x16x32_bf16(bfr[n], af[m], acc[m][n], 0, 0, 0);
            }
#pragma unroll
            for (int m = 0; m < 2; ++m) { float ss = 0.f;
#pragma unroll
                for (int n = 0; n < 2; ++n) { const f32x4 v = acc[m][n]; ss += (v.x * v.x + v.y * v.y) + (v.z * v.z + v.w * v.w); }
                ss += __shfl_xor(ss, 16); ss += __shfl_xor(ss, 32);
                if (fq == 0) red[(32 * wr + 16 * m + frow) * 4 + wc] = ss; }
            __syncthreads();
#pragma unroll
            for (int m = 0; m < 2; ++m) { const int t = 32 * wr + 16 * m + frow; const f32x4 q4 = *(const f32x4*)(red + t * 4);
                const float rs = rsqrtf(((q4.x + q4.y) + (q4.z + q4.w)) * (1.f / 128.f) + RMS_EPS);
                const size_t row = (size_t)b * SEQ + c * 64 + t;
#pragma unroll
                for (int n = 0; n < 2; ++n) { const int v0 = 32 * wc + 16 * n + 4 * fq; const f32x4 gn = *(const f32x4*)(p.g_hn + v0);
                    const u32x2 gg = *(const u32x2*)((const bf16_t*)(p.ws + WS_HG) + row * 512 + h * 128 + v0);
                    const f32x4 o = acc[m][n];
                    u32x2 w; w.x = pk2(o.x * rs * gn.x * bflo(gg.x), o.y * rs * gn.y * bfhi(gg.x)); w.y = pk2(o.z * rs * gn.z * bflo(gg.y), o.w * rs * gn.w * bfhi(gg.y));
                    *(u32x2*)((bf16_t*)(p.ws + WS_R1) + row * 1024 + 512 + h * 128 + v0) = w; } }
        }
    }
}

DEV void phase_normalize(const Params& p, unsigned char* lds) {
    const int tid = threadIdx.x, lane = tid & 63, wid = tid >> 6;
    const int vb = vblock(), G = gridDim.x;
    unsigned char* ws = p.ws;
    bf16_t* mix = (bf16_t*)(ws + WS_R1); const float* rowss = (const float*)(ws + WS_ROWSS); const bf16_t* HG = (const bf16_t*)(ws + WS_HG);
    for (int m = vb * 8 + wid; m < NTOK; m += G * 8) {
        {
            const float r = rsqrtf(rowss[m] * (1.f / 512.f) + RMS_EPS);
            u32x4* pp = (u32x4*)(mix + (size_t)m * 1024) + lane; u32x4 v = *pp;
            v.x = pk2(bflo(v.x) * r, bfhi(v.x) * r); v.y = pk2(bflo(v.y) * r, bfhi(v.y) * r); v.z = pk2(bflo(v.z) * r, bfhi(v.z) * r); v.w = pk2(bflo(v.w) * r, bfhi(v.w) * r);
            *pp = v;
        }
    }
    __syncthreads();
    {
        float* tl = (float*)lds;
        for (int r = vb; r < 32 * 16 * 16; r += G) { const int e = r / 256, q = r % 256; SrcW13 s{p.w1 + (size_t)e * 1024 * 512, p.w3 + (size_t)e * 1024 * 512, p.ffn_g};
            convert_tile(tl, s, (bf16_t*)(ws + WS_W13T) + (size_t)e * 1024 * 1024, 1024, (q / 16) * 64, (q % 16) * 64); }
    }
}

struct EpiOut { const Params& p; int m0, n0;
    DEV void operator()(f32x4 (&acc)[4][4], int wr, int wc, int lane) const {
        const int frow = lane & 15, fq = lane >> 4;
#pragma unroll
        for (int m = 0; m < 4; ++m) { const size_t row = m0 + wr * 64 + m * 16 + frow;
#pragma unroll
            for (int n = 0; n < 4; ++n) { const int c = n0 + wc * 64 + n * 16 + fq * 4; const f32x4 xv = *(const f32x4*)(p.x + row * DM + c); *(f32x4*)(p.out + row * DM + c) = xv + acc[m][n]; } }
    } };
DEV void phase_outproj(const Params& p, unsigned char* lds) {
    const int vb = vblock(), G = gridDim.x;
    constexpr int U = (NTOK / 128) * 4;
    for (int u = vb; u < U; u += G) {
        const int mt = u >> 2, nt = u & 3;
        ARows al{(const bf16_t*)(p.ws + WS_R1) + (size_t)mt * 128 * DM, DM};
        BRows bl{(const bf16_t*)(p.ws + WS_WOUTT) + (size_t)nt * 256 * DM, DM};
        EpiOut ep{p, mt * 128, nt * 256};
        gemm_tile(lds, al, bl, DM / 64, ep);
    }
}

constexpr int RT_HS = 0, RT_WS = 128 * 33 * 4, RT_LG = RT_WS + 32 * 36 * 4, RT_RS = RT_LG + 128 * 37 * 4, RT_HIST = RT_RS + 512, RT_BASE = RT_HIST + 512, RT_LDS = RT_BASE + 512;
DEV void phase_router(const Params& p, unsigned char* lds) {
    const int tid = threadIdx.x;
    const int vb = vblock(), G = gridDim.x;
    unsigned char* ws = p.ws;
    float* hs = (float*)(lds + RT_HS); float* wsm = (float*)(lds + RT_WS); float* lg = (float*)(lds + RT_LG); float* rsd = (float*)(lds + RT_RS);
    int* hist = (int*)(lds + RT_HIST); int* basep = (int*)(lds + RT_BASE);
    bf16_t* hb = (bf16_t*)(ws + WS_R1);
    const int tok = tid & 127, cgp = tid >> 7;
    for (int it = vb; it < NTOK / 128; it += G) {
        const size_t row0 = (size_t)it * 128;
        float acc[9]; float ssq[4] = {0.f, 0.f, 0.f, 0.f};
#pragma unroll
        for (int c = 0; c < 9; ++c) acc[c] = 0.f;
        if (tid < 128) hist[tid] = 0;
        for (int kc = 0; kc < 32; ++kc) {
            __syncthreads();
#pragma unroll
            for (int i = 0; i < 4; ++i) { const int idx = tid + NT * i, tk = idx >> 4, kp = idx & 15; const size_t gi = (row0 + tk) * DM + kc * 32 + 2 * kp;
                const f32x2 v = *(const f32x2*)(p.out + gi); hs[tk * 33 + 2 * kp] = v.x; hs[tk * 33 + 2 * kp + 1] = v.y; ssq[i] += v.x * v.x + v.y * v.y; *(unsigned*)(hb + gi) = pk2(v.x, v.y); }
            for (int idx = tid; idx < 32 * 36; idx += NT) { const int kk = idx / 36, c = idx % 36, k = kc * 32 + kk;
                wsm[idx] = (c < 4 ? p.w_group[k * 4 + c] : p.w_expert[k * 32 + (c - 4)]) * p.ffn_g[k]; }
            __syncthreads();
#pragma unroll 8
            for (int kk = 0; kk < 32; ++kk) { const float hv = hs[tok * 33 + kk];
#pragma unroll
                for (int c = 0; c < 9; ++c) acc[c] += hv * wsm[kk * 36 + cgp * 9 + c]; }
        }
#pragma unroll
        for (int i = 0; i < 4; ++i) { float s = ssq[i]; s += __shfl_xor(s, 1); s += __shfl_xor(s, 2); s += __shfl_xor(s, 4); s += __shfl_xor(s, 8);
            if ((tid & 15) == 0) rsd[(tid + NT * i) >> 4] = rsqrtf(s * (1.f / DM) + RMS_EPS); }
#pragma unroll
        for (int c = 0; c < 9; ++c) lg[tok * 37 + cgp * 9 + c] = acc[c];
        __syncthreads();
        int bin = 0, slot = 0;
        if (tid < 128) {
            const float rs = rsd[tid];
            ((float*)(ws + WS_RSTD2))[row0 + tid] = rs;
            float gl[4]; int gi = 0; float gm = -1e30f;
#pragma unroll
            for (int c = 0; c < 4; ++c) { gl[c] = lg[tid * 37 + c] * rs + p.b_group[c]; if (gl[c] > gm) { gm = gl[c]; gi = c; } }
            float gs = 0.f;
#pragma unroll
            for (int c = 0; c < 4; ++c) gs += __expf(gl[c] - gm);
            const float pg = 1.f / gs;
            float el[8]; int i0 = 0; float m0 = -1e30f;
#pragma unroll
            for (int c = 0; c < 8; ++c) { el[c] = lg[tid * 37 + 4 + gi * 8 + c] * rs + p.b_expert[gi * 8 + c]; if (el[c] > m0) { m0 = el[c]; i0 = c; } }
            int i1 = 0; float m1 = -1e30f;
#pragma unroll
            for (int c = 0; c < 8; ++c) if (c != i0 && el[c] > m1) { m1 = el[c]; i1 = c; }
            const float e1 = __expf(m1 - m0); const float w0 = pg / (1.f + e1), w1 = pg * e1 / (1.f + e1);
            const int a = min(i0, i1), bb = max(i0, i1);
            bin = gi * 28 + (7 * a - (a * (a - 1)) / 2) + (bb - a - 1);
            f32x2 tw; tw.x = (i0 < i1) ? w0 : w1; tw.y = (i0 < i1) ? w1 : w0;
            ((f32x2*)(ws + WS_TOKW))[row0 + tid] = tw;
            slot = atomicAdd(&hist[bin], 1);
        }
        __syncthreads();
        if (tid < NBIN) { const int h = hist[tid]; basep[tid] = h ? atomicAdd((int*)(ws + WS_CTL) + tid, h) : 0; }
        __syncthreads();
        if (tid < 128) ((int*)(ws + WS_BINL))[(size_t)bin * BINCAP + basep[bin] + slot] = (int)(row0 + tid);
        __syncthreads();
    }
}

DEV void moe_tiles(const Params& p, int* tstart  ) {
    const int tid = threadIdx.x;
    __syncthreads();
    if (tid == 0) { const int* cnt = (const int*)(p.ws + WS_CTL); int s = 0; for (int i = 0; i < NBIN; ++i) { tstart[i] = s; s += (cnt[i] + 127) >> 7; } tstart[NBIN] = s; }
    __syncthreads();
}
DEV void bin_experts(int bin, int& ea, int& eb) { const int gi = bin / 28; int pi = bin % 28, a = 0; while (pi >= 7 - a) { pi -= 7 - a; ++a; } ea = gi * 8 + a; eb = gi * 8 + a + 1 + pi; }
struct AGather { const bf16_t* hb; const int* list; int n;
    DEV const bf16_t* row(int r) const { const int t = list[r < n ? r : 0]; return hb + (size_t)t * DM; } };
struct EpiMoe1 { const Params& p; const int* list; int n; size_t hrow0; int nt;
    DEV void operator()(f32x4 (&acc)[4][4], int wr, int wc, int lane) const {
        const int frow = lane & 15, fq = lane >> 4;
        bf16_t* hbuf = (bf16_t*)(p.ws + WS_HBUF);
#pragma unroll
        for (int m = 0; m < 4; ++m) { const int r = wr * 64 + m * 16 + frow; if (r >= n) continue;
            const int t = list[r]; const float rs = ((const float*)(p.ws + WS_RSTD2))[t]; const f32x2 tw = ((const f32x2*)(p.ws + WS_TOKW))[t]; const float w = nt < 4 ? tw.x : tw.y;
#pragma unroll
            for (int n2 = 0; n2 < 4; ++n2) { const f32x4 v = acc[m][n2] * rs; const int f = ((nt & 3) * 256 + wc * 64 + n2 * 16 + fq * 4) >> 1;
                *(unsigned*)(hbuf + (hrow0 + r) * 1024 + (nt < 4 ? 0 : 512) + f) = pk2(siluf_(v.x) * v.y * w, siluf_(v.z) * v.w * w); } }
    } };
DEV void phase_moe1(const Params& p, unsigned char* lds) {
    const int vb = vblock(), G = gridDim.x;
    int* tstart = (int*)(lds + G_LDS);
    moe_tiles(p, tstart);
    const int T = tstart[NBIN], U = T * 8;
    for (int u = vb; u < U; u += G) {
        const int tile = u >> 3, nt = u & 7;
        int bin = 0; while (tstart[bin + 1] <= tile) ++bin;
        const int mt = tile - tstart[bin]; int ea, eb; bin_experts(bin, ea, eb);
        const int cnt = ((const int*)(p.ws + WS_CTL))[bin]; const int n = min(128, cnt - mt * 128);
        const int* list = (const int*)(p.ws + WS_BINL) + (size_t)bin * BINCAP + mt * 128;
        AGather al{(const bf16_t*)(p.ws + WS_R1), list, n};
        BRows bl{(const bf16_t*)(p.ws + WS_W13T) + ((size_t)(nt < 4 ? ea : eb) * 1024 + (nt & 3) * 256) * 1024, 1024};
        EpiMoe1 ep{p, list, n, (size_t)tile * 128, nt};
        gemm_tile(lds, al, bl, DM / 64, ep);
    }
}
struct BPair { const bf16_t* wa; const bf16_t* wb; DEV const bf16_t* ptr(int n, int kt) const { return kt < 8 ? wa + (size_t)n * 512 + kt * 64 : wb + (size_t)n * 512 + (kt - 8) * 64; } };
struct EpiMoe2 { const Params& p; const int* list; int n; int n0;
    DEV void operator()(f32x4 (&acc)[4][4], int wr, int wc, int lane) const {
        const int frow = lane & 15, fq = lane >> 4;
#pragma unroll
        for (int m = 0; m < 4; ++m) { const int r = wr * 64 + m * 16 + frow; if (r >= n) continue; const size_t t = list[r];
#pragma unroll
            for (int n2 = 0; n2 < 4; ++n2) { float* o = p.out + t * DM + n0 + wc * 64 + n2 * 16 + fq * 4; *(f32x4*)o = *(const f32x4*)o + acc[m][n2]; } }
    } };
DEV void phase_moe2(const Params& p, unsigned char* lds) {
    const int vb = vblock(), G = gridDim.x;
    int* tstart = (int*)(lds + G_LDS);
    moe_tiles(p, tstart);
    const int T = tstart[NBIN], U = T * 4;
    for (int u = vb; u < U; u += G) {
        const int tile = u >> 2, nt = u & 3;
        int bin = 0; while (tstart[bin + 1] <= tile) ++bin;
        const int mt = tile - tstart[bin]; int ea, eb; bin_experts(bin, ea, eb);
        const int cnt = ((const int*)(p.ws + WS_CTL))[bin]; const int n = min(128, cnt - mt * 128);
        const int* list = (const int*)(p.ws + WS_BINL) + (size_t)bin * BINCAP + mt * 128;
        ARows al{(const bf16_t*)(p.ws + WS_HBUF) + (size_t)tile * 128 * 1024, 1024};
        BPair bl{(const bf16_t*)(p.ws + WS_W2T) + ((size_t)ea * 1024 + nt * 256) * 512, (const bf16_t*)(p.ws + WS_W2T) + ((size_t)eb * 1024 + nt * 256) * 512};
        EpiMoe2 ep{p, list, n, nt * 256};
        gemm_tile(lds, al, bl, 16, ep);
    }
}

#define XB_TMO      128
#define XB_XCNT(j)  (256  + 64 * (j))
#define XB_XSUB(j)  (1280 + 64 * (j))
#define XB_XGEN(j)  (2304 + 64 * (j))
#define XB_TOP      3328
#define XB_TOPGEN   3392
#define XCD_BAR_WORDS 3456
#define XB_SPIN_CAP (1u << 20)
#define LAS __attribute__((address_space(3)))
constexpr size_t WS_BAR = WS_CTL + 4096;
DEV unsigned xb_ld(unsigned* p) { return __hip_atomic_load(p, __ATOMIC_RELAXED, __HIP_MEMORY_SCOPE_AGENT); }
DEV unsigned xb_add(unsigned* p, unsigned v) { return __hip_atomic_fetch_add(p, v, __ATOMIC_RELAXED, __HIP_MEMORY_SCOPE_AGENT); }
DEV unsigned xb_xcc_id() { return (unsigned)__builtin_amdgcn_s_getreg((3 << 11) | 20) & 0xFu; }
#define XB_SPIN(cond, bar) do { unsigned _sp = 0; while (cond) { __builtin_amdgcn_s_sleep(1); \
    if ((++_sp & 255u) == 0u) { if (xb_ld(&(bar)[XB_TMO])) break; if (_sp > XB_SPIN_CAP) { atomicAdd(&(bar)[XB_TMO], 1u); break; } } } } while (0)
struct XcdBarrier { unsigned* bar; unsigned x; volatile LAS unsigned* st; };
DEV XcdBarrier xcd_barrier_post(unsigned* bar, volatile LAS unsigned* st) {
    XcdBarrier b; b.bar = bar; b.x = xb_xcc_id(); b.st = st;
    if (threadIdx.x == 0) (void)xb_add(&bar[XB_XCNT(b.x)], 1u);
    return b;
}
DEV void xcd_barrier_complete(unsigned* bar, unsigned x, unsigned& nloc, unsigned& nx) {
    const unsigned G = gridDim.x * gridDim.y * gridDim.z;
    unsigned sum, cnt, mine, sp = 0u;
    for (;;) {
        sum = 0u; cnt = 0u; mine = 0u;
#pragma unroll
        for (unsigned j = 0; j < 16; ++j) { const unsigned c = xb_ld(&bar[XB_XCNT(j)]); sum += c; cnt += (c > 0u) ? 1u : 0u; mine = (j == x) ? c : mine; }
        if (sum == G) break;
        __builtin_amdgcn_s_sleep(1);
        if ((++sp & 255u) == 0u) { if (xb_ld(&bar[XB_TMO])) break; if (sp > XB_SPIN_CAP) { atomicAdd(&bar[XB_TMO], 1u); break; } }
    }
    nloc = mine > 0u ? mine : 1u; nx = cnt > 0u ? cnt : 1u;
}
DEV void xcd_barrier(const XcdBarrier& b) {
    asm volatile("s_waitcnt vmcnt(0)" ::: "memory");
    __syncthreads();
    if (threadIdx.x == 0) {
        unsigned* bar = b.bar;
        __builtin_amdgcn_s_waitcnt(0);
        unsigned nloc = b.st[0], nx = b.st[1];
        if (nloc == 0u) { xcd_barrier_complete(bar, b.x, nloc, nx); b.st[0] = nloc; b.st[1] = nx; }
        const unsigned old = xb_add(&bar[XB_XSUB(b.x)], 1u);
        const unsigned gen = old / nloc;
        if (old + 1u == (gen + 1u) * nloc) {
            __builtin_amdgcn_fence(__ATOMIC_RELEASE, "agent");
            asm volatile("s_waitcnt vmcnt(0)" ::: "memory");
            const unsigned og = xb_add(&bar[XB_TOP], 1u);
            const unsigned tg = og / nx;
            if (og + 1u == (tg + 1u) * nx) xb_add(&bar[XB_TOPGEN], 1u);
            else XB_SPIN(xb_ld(&bar[XB_TOPGEN]) == tg, bar);
            __builtin_amdgcn_fence(__ATOMIC_ACQUIRE, "agent");
            xb_add(&bar[XB_XGEN(b.x)], 1u);
            asm volatile("s_waitcnt vmcnt(0)" ::: "memory");
        } else {
            XB_SPIN(xb_ld(&bar[XB_XGEN(b.x)]) == gen, bar);
            __builtin_amdgcn_fence(__ATOMIC_ACQUIRE, "agent");
            asm volatile("s_waitcnt vmcnt(0)" ::: "memory");
        }
    }
    __syncthreads();
}

constexpr int LDS_BYTES = 112 * 1024;
constexpr int N_PHASES = 13;
__global__ void __launch_bounds__(NT) mega(Params p, int lo, int hi) {
    extern __shared__ __attribute__((aligned(16))) unsigned char lds[];
    volatile LAS unsigned* xst = (volatile LAS unsigned*)(lds + LDS_BYTES - 16);
    if (threadIdx.x < 4) xst[threadIdx.x] = 0u;
    __syncthreads();
    XcdBarrier xbar; xbar.bar = (unsigned*)(p.ws + WS_BAR); xbar.x = 0; xbar.st = xst;
    if (hi - lo > 1) xbar = xcd_barrier_post((unsigned*)(p.ws + WS_BAR), xst);
#define GRID_SYNC() xcd_barrier(xbar)
#ifndef PROBE_REPEAT
#define PROBE_REPEAT -1
#endif
#define RUN_PHASE(k, call) do { if (lo <= (k) && (k) < hi) { call; \
        if ((k) == PROBE_REPEAT) { GRID_SYNC(); \
            if ((k) == 5) { float* rz = (float*)(p.ws + WS_ROWSS); for (int i = blockIdx.x * NT + threadIdx.x; i < NTOK; i += gridDim.x * NT) rz[i] = 0.f; GRID_SYNC(); } \
            if ((k) == 11) { if (blockIdx.x == 0 && threadIdx.x < 128) ((int*)(p.ws + WS_CTL))[threadIdx.x] = 0; GRID_SYNC(); } \
            call; } \
        if ((k) + 1 < hi) GRID_SYNC(); } } while (0)
    RUN_PHASE(0, phase_prologue(p, lds));
    RUN_PHASE(1, phase_inproj(p, lds));
    RUN_PHASE(2, phase_cmp_a(p, lds));
    RUN_PHASE(3, phase_cmp_b(p, lds));
    RUN_PHASE(4, phase_cmp_attn(p, lds));
    RUN_PHASE(5, phase_flash(p, lds));
    RUN_PHASE(6, phase_hgrn_a1(p, lds));
    RUN_PHASE(7, phase_hgrn_a2(p, lds));
    RUN_PHASE(8, phase_hgrn_a3(p, lds));
    RUN_PHASE(9, phase_normalize(p, lds));
    RUN_PHASE(10, phase_outproj(p, lds));
    RUN_PHASE(11, phase_router(p, lds));
    RUN_PHASE(12, phase_moe1(p, lds));
    RUN_PHASE(13, phase_moe2(p, lds));
#undef RUN_PHASE
}

extern "C" void kernel_launch(void* const* d_in, const int* in_sizes, int n_in, void* d_out, int out_size, void* d_ws, size_t ws_size, hipStream_t stream) {
    static int grid = 0;
    if (grid == 0) {
        int dev = 0, cus = 0, per_cu = 0;
        hipGetDevice(&dev);
        hipDeviceGetAttribute(&cus, hipDeviceAttributeMultiprocessorCount, dev);
        hipFuncSetAttribute((const void*)mega, hipFuncAttributeMaxDynamicSharedMemorySize, LDS_BYTES);
        hipOccupancyMaxActiveBlocksPerMultiprocessor(&per_cu, (const void*)mega, NT, LDS_BYTES);
        if (per_cu < 1) per_cu = 1;
        grid = cus;
        if (ws_size < WS_END) fprintf(stderr, "kernel_launch: workspace too small: %zu < %zu\n", ws_size, (size_t)WS_END);
        fprintf(stderr, "kernel_launch: cus %d per_cu %d grid %d ws %zu\n", cus, per_cu, grid, ws_size);
    }
    Params p{};
    const float** pp = (const float**)&p;
    for (int i = 0; i < 23; ++i) pp[i] = (const float*)d_in[i];
    p.out = (float*)d_out; p.ws = (unsigned char*)d_ws;
#if N_LAUNCH_MODE == 1
    (void)hipMemsetAsync((unsigned char*)d_ws + WS_BAR, 0, XCD_BAR_WORDS * 4, stream);
    int lo = 0, hi = N_PHASES + 1;
    void* args[] = {&p, &lo, &hi};
    hipError_t e = hipLaunchCooperativeKernel((const void*)mega, dim3(grid), dim3(NT), args, LDS_BYTES, stream);
    if (e != hipSuccess) fprintf(stderr, "cooperative launch failed: %s\n", hipGetErrorString(e));
#else
    for (int ph = 0; ph <= N_PHASES; ++ph) hipLaunchKernelGGL(mega, dim3(grid), dim3(NT), LDS_BYTES, stream, p, ph, ph + 1);
#endif
}
```

```cpp
#include <hip/hip_runtime.h>
#include <hip/hip_cooperative_groups.h>
#include <cstdio>
#include <cstdint>
#include <cstring>
namespace cg = cooperative_groups;

#ifndef N_LAUNCH_MODE
#define N_LAUNCH_MODE 1
#endif

#define DEV __device__ __forceinline__
typedef unsigned short bf16_t;
typedef short bf16x8 __attribute__((ext_vector_type(8)));
typedef float f32x4 __attribute__((ext_vector_type(4)));
typedef float f32x2 __attribute__((ext_vector_type(2)));
typedef float f32x16 __attribute__((ext_vector_type(16)));
typedef unsigned u32x4 __attribute__((ext_vector_type(4)));
typedef unsigned u32x2 __attribute__((ext_vector_type(2)));

constexpr int NT = 512;
constexpr int BATCH = 8, SEQ = 4096, DM = 1024, NTOK = BATCH * SEQ;
constexpr int IN_COLS = 3352, INP = 3584;
constexpr int NC = 255;
constexpr float RMS_EPS = 1e-6f;
constexpr float QSCALE = 0.125f * 1.4426950408889634f;
constexpr int NBIN = 112;
constexpr int BINCAP = NTOK;

constexpr size_t MiB = 1ull << 20;
constexpr size_t WS_CTL    = 0;
constexpr size_t WS_RSTD1  = 1 * MiB;
constexpr size_t WS_RSTD2  = WS_RSTD1 + 128 * 1024;
constexpr size_t WS_ROWSS  = WS_RSTD2 + 128 * 1024;
constexpr size_t WS_TOKW   = WS_ROWSS + 128 * 1024;
constexpr size_t WS_LB     = WS_TOKW + 256 * 1024;
constexpr size_t WS_CBIAS  = WS_LB + 4096;
constexpr size_t WS_SELM   = 2 * MiB;
constexpr size_t WS_GATES  = 3 * MiB;
constexpr size_t WS_KCMP   = 6 * MiB;
constexpr size_t WS_VCMP   = WS_KCMP + 512 * 1024;
constexpr size_t WS_CW2T   = 7 * MiB;
constexpr size_t WS_HID    = 8 * MiB;
constexpr size_t WS_CW1T   = 12 * MiB;
constexpr size_t WS_WOUTT  = 14 * MiB;
constexpr size_t WS_WINT   = 16 * MiB;
constexpr size_t WS_R1     = 24 * MiB;
constexpr size_t WS_Q      = 88 * MiB;
constexpr size_t WS_KC     = 120 * MiB;
constexpr size_t WS_VC     = 128 * MiB;
constexpr size_t WS_KS     = 136 * MiB;
constexpr size_t WS_KW     = 144 * MiB;
constexpr size_t WS_VST    = 152 * MiB;
constexpr size_t WS_VWT    = 160 * MiB;
constexpr size_t WS_OC     = 168 * MiB;
constexpr size_t WS_W13T   = 200 * MiB;
constexpr size_t WS_W2T    = 264 * MiB;
constexpr size_t WS_HQ     = 296 * MiB;
constexpr size_t WS_HV     = 328 * MiB;
constexpr size_t WS_HG     = 360 * MiB;
constexpr size_t WS_HLOGF  = 392 * MiB;
constexpr size_t WS_DBUF   = 456 * MiB;
constexpr size_t WS_END    = 457 * MiB;
constexpr size_t WS_UBUF   = WS_W13T;
constexpr size_t WS_BINL   = WS_HQ;
constexpr size_t WS_HBUF   = WS_HQ + 16 * MiB;

struct Params {
    const float *x, *attn_g, *ffn_g, *w_in, *w_out, *g_q, *g_k, *pos_k, *pos_v, *wk1, *wk2, *wv1, *wv2, *g_nsa, *lb_logits, *g_hn,
        *w_group, *b_group, *w_expert, *b_expert, *w1, *w3, *w2;
    float* out;
    unsigned char* ws;
};

typedef __bf16 bf16x2_t __attribute__((ext_vector_type(2)));
DEV unsigned pk2(float lo, float hi) { f32x2 f = {lo, hi}; return __builtin_bit_cast(unsigned, __builtin_convertvector(f, bf16x2_t)); }
DEV bf16_t f2bf(float f) { return (bf16_t)(pk2(f, 0.f) & 0xffffu); }
DEV float bf2f(bf16_t b) { return __uint_as_float(((unsigned)b) << 16); }
DEV float bflo(unsigned u) { return __uint_as_float(u << 16); }
DEV float bfhi(unsigned u) { return __uint_as_float(u & 0xffff0000u); }
DEV float sigmoidf_(float v) { return 1.f / (1.f + __expf(-v)); }
DEV float siluf_(float v) { return v / (1.f + __expf(-v)); }
DEV float wave_sum(float v) {
#pragma unroll
    for (int o = 1; o < 64; o <<= 1) v += __shfl_xor(v, o);
    return v;
}
DEV float wave_max(float v) {
#pragma unroll
    for (int o = 1; o < 64; o <<= 1) v = fmaxf(v, __shfl_xor(v, o));
    return v;
}
DEV int vblock() { const int G = gridDim.x, b = blockIdx.x; return (G % 8 == 0) ? (b % 8) * (G / 8) + b / 8 : b; }

template <class SRC>
DEV void convert_tile(float* tl, const SRC& src, bf16_t* dst, int ldd, int n0, int k0) {
    const int tid = threadIdx.x;
    {
        const int n = tid & 63;
#pragma unroll
        for (int i = 0; i < 8; ++i) { const int kk = (tid >> 6) + 8 * i; tl[kk * 65 + n] = src.get(n0 + n, k0 + kk); }
    }
    __syncthreads();
    {
        const int n = tid >> 3, kc = tid & 7;
        const float* s = tl + (kc * 8) * 65 + n;
        u32x4 o;
        o.x = pk2(s[0 * 65], s[1 * 65]); o.y = pk2(s[2 * 65], s[3 * 65]); o.z = pk2(s[4 * 65], s[5 * 65]); o.w = pk2(s[6 * 65], s[7 * 65]);
        *(u32x4*)(dst + (size_t)(n0 + n) * ldd + k0 + kc * 8) = o;
    }
    __syncthreads();
}
struct SrcWin { const float* w; const float* g;
    DEV float get(int n, int k) const { int col; if (n < 1280) col = n; else if (n < 3328) col = n + 24; else if (n < 3352) col = 1280 + (n - 3328); else return 0.f;
        return w[(size_t)k * IN_COLS + col] * g[k]; } };
struct SrcWout { const float* w; const float* g;
    DEV float get(int n, int k) const { const float v = w[(size_t)k * DM + n]; return k < 512 ? v * g[k] : v; } };
struct SrcPlain { const float* w; int ld;
    DEV float get(int n, int k) const { return w[(size_t)k * ld + n]; } };
struct SrcW13 { const float* w1; const float* w3; const float* g;
    DEV float get(int n, int k) const { const uintptr_t a = (uintptr_t)w1, b = (uintptr_t)w3; const float* w = (const float*)(a + ((b - a) & (uintptr_t)(0 - (long long)(n & 1))));
        return w[(size_t)k * 512 + (n >> 1)] * g[k]; } };

DEV void phase_prologue(const Params& p, unsigned char* lds) {
    float* tl = (float*)lds;
    const int tid = threadIdx.x, lane = tid & 63, wid = tid >> 6;
    const int vb = vblock(), G = gridDim.x;
    unsigned char* ws = p.ws;
    constexpr int I_WIN = (INP / 64) * (DM / 64);
    constexpr int I_WOUT = 16 * 16;
    constexpr int I_CW1 = 2 * 4 * 32;
    constexpr int I_CW2 = 2 * 1 * 4;
    constexpr int I_W13 = 32 * 16 * 16;
    constexpr int I_W2 = 32 * 16 * 8;
    constexpr int I_ALL = I_WIN + I_WOUT + I_CW1 + I_CW2 + I_W2;
    for (int it = vb; it < I_ALL; it += G) {
        int r = it;
        if (r < I_WIN) { SrcWin s{p.w_in, p.attn_g}; convert_tile(tl, s, (bf16_t*)(ws + WS_WINT), DM, (r / 16) * 64, (r % 16) * 64); continue; } r -= I_WIN;
        if (r < I_WOUT) { SrcWout s{p.w_out, p.g_nsa}; convert_tile(tl, s, (bf16_t*)(ws + WS_WOUTT), DM, (r / 16) * 64, (r % 16) * 64); continue; } r -= I_WOUT;
        if (r < I_CW1) { const int z = r / 128, q = r % 128; SrcPlain s{z ? p.wv1 : p.wk1, 256};
            convert_tile(tl, s, (bf16_t*)(ws + WS_CW1T) + (size_t)z * 256 * 2048, 2048, (q / 32) * 64, (q % 32) * 64); continue; } r -= I_CW1;
        if (r < I_CW2) { const int z = r / 4, q = r % 4; SrcPlain s{z ? p.wv2 : p.wk2, 64};
            convert_tile(tl, s, (bf16_t*)(ws + WS_CW2T) + (size_t)z * 64 * 256, 256, 0, q * 64); continue; } r -= I_CW2;
        { const int e = r / 128, q = r % 128; SrcPlain s{p.w2 + (size_t)e * 512 * 1024, 1024};
            convert_tile(tl, s, (bf16_t*)(ws + WS_W2T) + (size_t)e * 1024 * 512, 512, (q / 8) * 64, (q % 8) * 64); }
    }
    {
        bf16_t* xb = (bf16_t*)(ws + WS_R1); float* rstd1 = (float*)(ws + WS_RSTD1);
        const int gw = vb * 8 + wid, NGW = G * 8;
        for (int m = gw; m < NTOK; m += NGW) {
            const f32x4* xr = (const f32x4*)(p.x + (size_t)m * DM) + lane;
            f32x4 v[4]; float s = 0.f;
#pragma unroll
            for (int j = 0; j < 4; ++j) { v[j] = xr[64 * j]; s += (v[j].x * v[j].x + v[j].y * v[j].y) + (v[j].z * v[j].z + v[j].w * v[j].w); }
            s = wave_sum(s);
            if (lane == 0) rstd1[m] = rsqrtf(s * (1.f / DM) + RMS_EPS);
            u32x2* o = (u32x2*)(xb + (size_t)m * DM) + lane;
#pragma unroll
            for (int j = 0; j < 4; ++j) { u32x2 w; w.x = pk2(v[j].x, v[j].y); w.y = pk2(v[j].z, v[j].w); o[64 * j] = w; }
        }
    }
    {
        const int gt = vb * NT + tid, NG = G * NT;
        float* rowss = (float*)(ws + WS_ROWSS);
        for (int i = gt; i < NTOK; i += NG) rowss[i] = 0.f;
        int* bincnt = (int*)(ws + WS_CTL);
        if (gt < 128) bincnt[gt] = 0;
        if (gt < 512) { const float l0 = p.lb_logits[gt], l1 = p.lb_logits[512 + gt]; ((float*)(ws + WS_LB))[gt] = 1.f / (1.f + __expf(l1 - l0)); }
        if (blockIdx.x == (unsigned)(G - 1)) {
            const int z = tid >> 8, j = tid & 255; const float* pos = z ? p.pos_v : p.pos_k; const float* w = z ? p.wv1 : p.wk1;
            float a = 0.f;
            for (int k = 0; k < 2048; ++k) a += pos[k] * w[(size_t)k * 256 + j];
            ((float*)(ws + WS_CBIAS))[z * 256 + j] = a;
        }
    }
}

constexpr int G_A_BYTES = 128 * 128, G_B_BYTES = 256 * 128, G_STAGE = G_A_BYTES + G_B_BYTES, G_LDS = 2 * G_STAGE;
DEV int swz(int row, int chunk) { return row * 128 + ((chunk ^ ((row >> 1) & 7)) << 4); }
template <class AL, class BL, class EP>
DEV void gemm_tile(unsigned char* lds, const AL& al, const BL& bl, int nk, const EP& ep) {
    const int tid = threadIdx.x, lane = tid & 63, wid = tid >> 6, wr = wid >> 2, wc = wid & 3;
    const int frow = lane & 15, fq = lane >> 4;
    const bf16_t* aptr[2]; int aoff[2], boff[4], brow[4];
#pragma unroll
    for (int i = 0; i < 2; ++i) { const int q = tid + NT * i, row = q >> 3, ch = q & 7; aptr[i] = al.row(row) + ch * 8; aoff[i] = swz(row, ch); }
#pragma unroll
    for (int i = 0; i < 4; ++i) { const int q = tid + NT * i, row = q >> 3, ch = q & 7; brow[i] = row; boff[i] = G_A_BYTES + swz(row, ch) ; }
    const int bch8 = (tid & 7) * 8;
    u32x4 ra[2], rb[4];
#pragma unroll
    for (int i = 0; i < 2; ++i) ra[i] = *(const u32x4*)(aptr[i]);
#pragma unroll
    for (int i = 0; i < 4; ++i) rb[i] = *(const u32x4*)(bl.ptr(brow[i], 0) + bch8);
#pragma unroll
    for (int i = 0; i < 2; ++i) *(u32x4*)(lds + aoff[i]) = ra[i];
#pragma unroll
    for (int i = 0; i < 4; ++i) *(u32x4*)(lds + boff[i]) = rb[i];
    __syncthreads();
    f32x4 acc[4][4];
#pragma unroll
    for (int m = 0; m < 4; ++m)
#pragma unroll
        for (int n = 0; n < 4; ++n) acc[m][n] = (f32x4){0.f, 0.f, 0.f, 0.f};
    const int sx = (frow >> 1) & 7;
    for (int kt = 0; kt < nk; ++kt) {
        const bool more = (kt + 1 < nk);
        if (more) {
#pragma unroll
            for (int i = 0; i < 2; ++i) ra[i] = *(const u32x4*)(aptr[i] + (kt + 1) * 64);
#pragma unroll
            for (int i = 0; i < 4; ++i) rb[i] = *(const u32x4*)(bl.ptr(brow[i], kt + 1) + bch8);
        }
        const unsigned char* base = lds + (kt & 1) * G_STAGE;
#pragma unroll
        for (int ks = 0; ks < 2; ++ks) {
            const int co = ((ks * 4 + fq) ^ sx) << 4;
            bf16x8 af[4], bfr[4];
#pragma unroll
            for (int m = 0; m < 4; ++m) af[m] = *(const bf16x8*)(base + (wr * 64 + m * 16 + frow) * 128 + co);
#pragma unroll
            for (int n = 0; n < 4; ++n) bfr[n] = *(const bf16x8*)(base + G_A_BYTES + (wc * 64 + n * 16 + frow) * 128 + co);
#pragma unroll
            for (int m = 0; m < 4; ++m)
#pragma unroll
                for (int n = 0; n < 4; ++n) acc[m][n] = __builtin_amdgcn_mfma_f32_16x16x32_bf16(bfr[n], af[m], acc[m][n], 0, 0, 0);
        }
        if (more) {
            unsigned char* nb = lds + ((kt + 1) & 1) * G_STAGE;
#pragma unroll
            for (int i = 0; i < 2; ++i) *(u32x4*)(nb + aoff[i]) = ra[i];
#pragma unroll
            for (int i = 0; i < 4; ++i) *(u32x4*)(nb + boff[i]) = rb[i];
        }
        __syncthreads();
    }
    ep(acc, wr, wc, lane);
}

struct ARows { const bf16_t* base; size_t ld; DEV const bf16_t* row(int r) const { return base + (size_t)r * ld; } };
struct BRows { const bf16_t* base; size_t ld; DEV const bf16_t* ptr(int n, int kt) const { return base + (size_t)n * ld + kt * 64; } };

struct EpiInproj {
    const Params& p; int m0, ntile;
    DEV void operator()(f32x4 (&acc)[4][4], int wr, int wc, int lane) const {
        const int frow = lane & 15, fq = lane >> 4;
        const int seg = ntile * 4 + wc;
        if (seg > 52) return;
        unsigned char* ws = p.ws;
        const float* rstd1 = (const float*)(ws + WS_RSTD1);
        int rows[4];
#pragma unroll
        for (int m = 0; m < 4; ++m) { rows[m] = m0 + wr * 64 + m * 16 + frow; const float rs = rstd1[rows[m]];
#pragma unroll
            for (int n = 0; n < 4; ++n) acc[m][n] = acc[m][n] * rs; }
        const bool is_q = seg < 8, is_ks = (seg == 12 || seg == 13), is_kw = (seg == 16 || seg == 17);
        if (is_q || is_ks || is_kw) {
            const float* gw = is_q ? p.g_q : (is_ks ? p.g_k + 64 : p.g_k + 128);
            bf16_t* dst; int hh, nh;
            if (is_q) { dst = (bf16_t*)(ws + WS_Q); hh = seg; nh = 8; } else if (is_ks) { dst = (bf16_t*)(ws + WS_KS); hh = seg - 12; nh = 2; } else { dst = (bf16_t*)(ws + WS_KW); hh = seg - 16; nh = 2; }
            f32x4 gv[4];
#pragma unroll
            for (int n = 0; n < 4; ++n) gv[n] = *(const f32x4*)(gw + n * 16 + fq * 4);
#pragma unroll
            for (int m = 0; m < 4; ++m) {
                float ss = 0.f;
#pragma unroll
                for (int n = 0; n < 4; ++n) { const f32x4 v = acc[m][n]; ss += (v.x * v.x + v.y * v.y) + (v.z * v.z + v.w * v.w); }
                ss += __shfl_xor(ss, 16); ss += __shfl_xor(ss, 32);
                float r = rsqrtf(ss * (1.f / 64.f) + RMS_EPS); if (is_q) r *= QSCALE;
                const int b = rows[m] >> 12, s = rows[m] & 4095;
                bf16_t* o = dst + ((size_t)(b * nh + hh) * SEQ + s) * 64 + fq * 4;
#pragma unroll
                for (int n = 0; n < 4; ++n) { const f32x4 v = acc[m][n] * gv[n] * r; u32x2 w; w.x = pk2(v.x, v.y); w.y = pk2(v.z, v.w); *(u32x2*)(o + n * 16) = w; }
            }
            return;
        }
        if (seg == 8 || seg == 9 || seg == 10 || seg == 11) {
            bf16_t* dst = (bf16_t*)(ws + (seg < 10 ? WS_KC : WS_VC)); const int g = seg & 1;
#pragma unroll
            for (int m = 0; m < 4; ++m) { const int b = rows[m] >> 12, s = rows[m] & 4095; bf16_t* o = dst + ((size_t)(b * 2 + g) * SEQ + s) * 64 + fq * 4;
#pragma unroll
                for (int n = 0; n < 4; ++n) { const f32x4 v = acc[m][n]; u32x2 w; w.x = pk2(v.x, v.y); w.y = pk2(v.z, v.w); *(u32x2*)(o + n * 16) = w; } }
            return;
        }
        if (seg == 14 || seg == 15 || seg == 18 || seg == 19) {
            bf16_t* dst = (bf16_t*)(ws + (seg < 16 ? WS_VST : WS_VWT)); const int g = seg & 1;
#pragma unroll
            for (int m = 0; m < 4; ++m) { const int b = rows[m] >> 12, s = rows[m] & 4095; bf16_t* o = dst + (size_t)(b * 2 + g) * 64 * SEQ + s;
#pragma unroll
                for (int n = 0; n < 4; ++n) { const f32x4 v = acc[m][n]; const int d = n * 16 + fq * 4;
                    o[(size_t)(d + 0) * SEQ] = f2bf(v.x); o[(size_t)(d + 1) * SEQ] = f2bf(v.y); o[(size_t)(d + 2) * SEQ] = f2bf(v.z); o[(size_t)(d + 3) * SEQ] = f2bf(v.w); } }
            return;
        }
        if (seg < 52) {
            const int kind = (seg - 20) >> 3, cb = ((seg - 20) & 7) * 64 + fq * 4;
            if (kind == 1) {
                const float* lb = (const float*)(ws + WS_LB); float* dst = (float*)(ws + WS_HLOGF);
#pragma unroll
                for (int m = 0; m < 4; ++m)
#pragma unroll
                    for (int n = 0; n < 4; ++n) { const int c = cb + n * 16; const f32x4 l = *(const f32x4*)(lb + c); const f32x4 v = acc[m][n]; f32x4 o;
                        o.x = __logf(l.x + (1.f - l.x) * sigmoidf_(v.x)); o.y = __logf(l.y + (1.f - l.y) * sigmoidf_(v.y));
                        o.z = __logf(l.z + (1.f - l.z) * sigmoidf_(v.z)); o.w = __logf(l.w + (1.f - l.w) * sigmoidf_(v.w));
                        *(f32x4*)(dst + (size_t)rows[m] * 512 + c) = o; }
            } else {
                bf16_t* dst = (bf16_t*)(ws + (kind == 0 ? WS_HQ : (kind == 2 ? WS_HV : WS_HG)));
#pragma unroll
                for (int m = 0; m < 4; ++m)
#pragma unroll
                    for (int n = 0; n < 4; ++n) { f32x4 v = acc[m][n];
                        if (kind != 2) { v.x = siluf_(v.x); v.y = siluf_(v.y); v.z = siluf_(v.z); v.w = siluf_(v.w); }
                        u32x2 w; w.x = pk2(v.x, v.y); w.y = pk2(v.z, v.w); *(u32x2*)(dst + (size_t)rows[m] * 512 + cb + n * 16) = w; }
            }
            return;
        }
        {
            float* dst = (float*)(ws + WS_GATES);
#pragma unroll
            for (int m = 0; m < 4; ++m)
#pragma unroll
                for (int n = 0; n < 2; ++n) { const int c = n * 16 + fq * 4; if (c < 24) { const f32x4 v = acc[m][n]; f32x4 o; o.x = sigmoidf_(v.x); o.y = sigmoidf_(v.y); o.z = sigmoidf_(v.z); o.w = sigmoidf_(v.w);
                        *(f32x4*)(dst + (size_t)rows[m] * 24 + c) = o; } }
        }
    }
};
DEV void phase_inproj(const Params& p, unsigned char* lds) {
    const int vb = vblock(), G = gridDim.x;
    constexpr int NMT = NTOK / 128, NNT = INP / 256, U = NMT * NNT;
    for (int u = vb; u < U; u += G) {
        const int grp = u / (16 * NNT), rem = u % (16 * NNT), nt = rem / 16, mt = grp * 16 + rem % 16;
        ARows al{(const bf16_t*)(p.ws + WS_R1) + (size_t)mt * 128 * DM, DM};
        BRows bl{(const bf16_t*)(p.ws + WS_WINT) + (size_t)nt * 256 * DM, DM};
        EpiInproj ep{p, mt * 128, nt};
        gemm_tile(lds, al, bl, DM / 64, ep);
    }
}

struct ACmp { const bf16_t* src; int bg, c0;
    DEV const bf16_t* row(int r) const { int c = c0 + r; if (c > NC - 1) c = NC - 1; return src + ((size_t)bg * SEQ + 16 * c) * 64; } };
struct EpiCmpA { const Params& p; int z, rbase;
    DEV void operator()(f32x4 (&acc)[4][4], int wr, int wc, int lane) const {
        const int frow = lane & 15, fq = lane >> 4;
        const float* cb = (const float*)(p.ws + WS_CBIAS) + z * 256; bf16_t* hid = (bf16_t*)(p.ws + WS_HID) + (size_t)z * 4096 * 256;
#pragma unroll
        for (int m = 0; m < 4; ++m) { const int rr = rbase + wr * 64 + m * 16 + frow;
#pragma unroll
            for (int n = 0; n < 4; ++n) { const int c = wc * 64 + n * 16 + fq * 4; const f32x4 b = *(const f32x4*)(cb + c); f32x4 v = acc[m][n] + b;
                u32x2 w; w.x = pk2(siluf_(v.x), siluf_(v.y)); w.y = pk2(siluf_(v.z), siluf_(v.w)); *(u32x2*)(hid + (size_t)rr * 256 + c) = w; } }
    } };
DEV void phase_cmp_a(const Params& p, unsigned char* lds) {
    const int vb = vblock(), G = gridDim.x;
    for (int u = vb; u < 64; u += G) {
        const int z = u >> 5, rbase = (u & 31) * 128;
        ACmp al{(const bf16_t*)(p.ws + (z ? WS_VC : WS_KC)), (u & 31) >> 1, (u & 1) * 128};
        BRows bl{(const bf16_t*)(p.ws + WS_CW1T) + (size_t)z * 256 * 2048, 2048};
        EpiCmpA ep{p, z, rbase};
        gemm_tile(lds, al, bl, 2048 / 64, ep);
    }
}
struct BClamp64 { const bf16_t* base; size_t ld; DEV const bf16_t* ptr(int n, int kt) const { return base + (size_t)(n & 63) * ld + kt * 64; } };
struct EpiCmpB { const Params& p; int z, rbase;
    DEV void operator()(f32x4 (&acc)[4][4], int wr, int wc, int lane) const {
        if (wc != 0) return;
        const int frow = lane & 15, fq = lane >> 4;
        bf16_t* dst = (bf16_t*)(p.ws + (z ? WS_VCMP : WS_KCMP));
#pragma unroll
        for (int m = 0; m < 4; ++m) { const int rr = rbase + wr * 64 + m * 16 + frow;
            float r = 1.f;
            if (z == 0) { float ss = 0.f;
#pragma unroll
                for (int n = 0; n < 4; ++n) { const f32x4 v = acc[m][n]; ss += (v.x * v.x + v.y * v.y) + (v.z * v.z + v.w * v.w); }
                ss += __shfl_xor(ss, 16); ss += __shfl_xor(ss, 32); r = rsqrtf(ss * (1.f / 64.f) + RMS_EPS); }
            const int bg = rr >> 8, c = rr & 255;
            if (c < NC) {
#pragma unroll
                for (int n = 0; n < 4; ++n) { const int d = n * 16 + fq * 4; f32x4 v = acc[m][n] * r;
                    if (z == 0) { const f32x4 g = *(const f32x4*)(p.g_k + d); v = v * g;
                        u32x2 w; w.x = pk2(v.x, v.y); w.y = pk2(v.z, v.w); *(u32x2*)(dst + ((size_t)bg * 256 + c) * 64 + d) = w; }
                    else { bf16_t* o = dst + ((size_t)bg * 64 + d) * 256 + c; o[0] = f2bf(v.x); o[256] = f2bf(v.y); o[512] = f2bf(v.z); o[768] = f2bf(v.w); } } }
        }
    } };
DEV void phase_cmp_b(const Params& p, unsigned char* lds) {
    const int vb = vblock(), G = gridDim.x;
    for (int u = vb; u < 64; u += G) {
        const int z = u >> 5, rbase = (u & 31) * 128;
        ARows al{(const bf16_t*)(p.ws + WS_HID) + ((size_t)z * 4096 + rbase) * 256, 256};
        BClamp64 bl{(const bf16_t*)(p.ws + WS_CW2T) + (size_t)z * 64 * 256, 256};
        EpiCmpB ep{p, z, rbase};
        gemm_tile(lds, al, bl, 256 / 64, ep);
    }
}

constexpr int CM_K = 0, CM_V = 32768, CM_VSTR = 520, CM_IMP = CM_V + 64 * CM_VSTR, CM_LDS = CM_IMP + 16384;
DEV void cm_scores(const unsigned char* kbase, int kt, const bf16x8 (&qf)[4], int r31, int hh, f32x16 (&sacc)[2]) {
#pragma unroll
    for (int kt2 = 0; kt2 < 2; ++kt2) {
#pragma unroll
        for (int i = 0; i < 16; ++i) sacc[kt2][i] = 0.f;
        const int row = 64 * kt + 32 * kt2 + r31; const int sx = (row >> 1) & 7;
#pragma unroll
        for (int s = 0; s < 4; ++s) { const bf16x8 kf = *(const bf16x8*)(kbase + row * 128 + (((2 * s + hh) ^ sx) << 4));
            sacc[kt2] = __builtin_amdgcn_mfma_f32_32x32x16_bf16(kf, qf[s], sacc[kt2], 0, 0, 0); }
    }
}
DEV void phase_cmp_attn(const Params& p, unsigned char* lds) {
    const int tid = threadIdx.x, lane = tid & 63, wid = tid >> 6;
    const int vb = vblock(), G = gridDim.x;
    unsigned char* ws = p.ws;
    const int r31 = lane & 31, hh = lane >> 5;
    float* impl = (float*)(lds + CM_IMP);
    for (int it = vb; it < 1024; it += G) {
        const int rnd = it / G, pos = it % G; int sidx = (rnd & 1) ? (rnd * G + (G - 1 - pos)) : (rnd * G + pos); if (G != 256) sidx = it;
        const int ci = 63 - (sidx >> 4), bg = sidx & 15, b = bg >> 1, g = bg & 1;
        const int nvis = min(NC, 4 * ci + 3), ntile = (nvis + 63) >> 6;
        const int head = g * 4 + (wid >> 1);
        const int tokl = (wid & 1) * 32 + r31, t = ci * 64 + tokl;
        const size_t tok = (size_t)b * SEQ + t;
        const int nv = t >= 31 ? min(NC, (t - 31) / 16 + 1) : 0;
        __syncthreads();
        {
            const bf16_t* kc = (const bf16_t*)(ws + WS_KCMP) + (size_t)bg * 256 * 64; const bf16_t* vt = (const bf16_t*)(ws + WS_VCMP) + (size_t)bg * 64 * 256;
            const int nch = ntile * 512;
            for (int idx = tid; idx < nch; idx += NT) { const int row = idx >> 3, ch = idx & 7; *(u32x4*)(lds + CM_K + swz(row, ch)) = *(const u32x4*)(kc + row * 64 + ch * 8); }
            const int cpr = ntile * 8;
            for (int idx = tid; idx < nch; idx += NT) { const int d = idx / cpr, ck = idx % cpr; const u32x4 v = *(const u32x4*)(vt + d * 256 + ck * 8);
                u32x2 a, c2; a.x = v.x; a.y = v.y; c2.x = v.z; c2.y = v.w; unsigned char* o = lds + CM_V + d * CM_VSTR + ck * 16; *(u32x2*)o = a; *(u32x2*)(o + 8) = c2; }
#pragma unroll
            for (int i = 0; i < 8; ++i) impl[tid + NT * i] = 0.f;
        }
        bf16x8 qf[4];
        { const bf16_t* qp = (const bf16_t*)(ws + WS_Q) + ((size_t)(b * 8 + head) * SEQ + t) * 64 + 8 * hh;
#pragma unroll
            for (int s = 0; s < 4; ++s) qf[s] = *(const bf16x8*)(qp + 16 * s); }
        __syncthreads();
        float m_run = -1e30f, l_run = 0.f;
        for (int kt = 0; kt < ntile; ++kt) {
            f32x16 sacc[2];
            cm_scores(lds + CM_K, kt, qf, r31, hh, sacc);
            float mx = -1e30f;
#pragma unroll
            for (int kt2 = 0; kt2 < 2; ++kt2)
#pragma unroll
                for (int i = 0; i < 16; ++i) { const int c = 64 * kt + 32 * kt2 + (i & 3) + 8 * (i >> 2) + 4 * hh; const float v = (c < nv) ? sacc[kt2][i] : -1e30f; sacc[kt2][i] = v; mx = fmaxf(mx, v); }
            const float m_new = fmaxf(m_run, mx); float rs = 0.f;
#pragma unroll
            for (int kt2 = 0; kt2 < 2; ++kt2)
#pragma unroll
                for (int i = 0; i < 16; ++i) { const float v = sacc[kt2][i]; rs += (v > -5e29f) ? exp2f(v - m_new) : 0.f; }
            l_run = l_run * exp2f(m_run - m_new) + rs; m_run = m_new;
        }
        float M, invL;
        { const float mo = __shfl_xor(m_run, 32), lo = __shfl_xor(l_run, 32); M = fmaxf(m_run, mo); const float L = l_run * exp2f(m_run - M) + lo * exp2f(mo - M); invL = L > 0.f ? 1.f / L : 0.f; }
        f32x16 ot[2];
#pragma unroll
        for (int dt = 0; dt < 2; ++dt)
#pragma unroll
            for (int i = 0; i < 16; ++i) ot[dt][i] = 0.f;
        float own[32], spl[32];
#pragma unroll
        for (int i = 0; i < 32; ++i) { own[i] = 0.f; spl[i] = 0.f; }
#pragma unroll
        for (int kt = 0; kt < 4; ++kt) if (kt < ntile) {
            f32x16 sacc[2];
            cm_scores(lds + CM_K, kt, qf, r31, hh, sacc);
#pragma unroll
            for (int kt2 = 0; kt2 < 2; ++kt2)
#pragma unroll
                for (int i = 0; i < 16; ++i) { const int c = 64 * kt + 32 * kt2 + (i & 3) + 8 * (i >> 2) + 4 * hh; sacc[kt2][i] = (c < nv) ? exp2f(sacc[kt2][i] - M) : 0.f; }
#pragma unroll
            for (int kt2 = 0; kt2 < 2; ++kt2)
#pragma unroll
                for (int g4 = 0; g4 < 4; ++g4) { const int Gi = 8 * kt + 4 * kt2 + g4; const float e3 = 0.5f * sacc[kt2][4 * g4 + 3];
                    own[Gi] = ((sacc[kt2][4 * g4] + sacc[kt2][4 * g4 + 1]) + (sacc[kt2][4 * g4 + 2] + e3)) * invL; spl[Gi] = e3 * invL; }
#pragma unroll
            for (int kt2 = 0; kt2 < 2; ++kt2)
#pragma unroll
                for (int s2 = 0; s2 < 2; ++s2) {
                    bf16x8 pf; { u32x4 w; w.x = pk2(sacc[kt2][8 * s2 + 0], sacc[kt2][8 * s2 + 1]); w.y = pk2(sacc[kt2][8 * s2 + 2], sacc[kt2][8 * s2 + 3]);
                        w.z = pk2(sacc[kt2][8 * s2 + 4], sacc[kt2][8 * s2 + 5]); w.w = pk2(sacc[kt2][8 * s2 + 6], sacc[kt2][8 * s2 + 7]); pf = __builtin_bit_cast(bf16x8, w); }
#pragma unroll
                    for (int dt = 0; dt < 2; ++dt) {
                        const unsigned char* va = lds + CM_V + (32 * dt + r31) * CM_VSTR + (64 * kt + 32 * kt2 + 16 * s2 + 4 * hh) * 2;
                        const u32x2 lo = *(const u32x2*)(va), hi = *(const u32x2*)(va + 16);
                        u32x4 w; w.x = lo.x; w.y = lo.y; w.z = hi.x; w.w = hi.y;
                        ot[dt] = __builtin_amdgcn_mfma_f32_32x32x16_bf16(__builtin_bit_cast(bf16x8, w), pf, ot[dt], 0, 0, 0);
                    }
                }
        }
        {
            const float sc = ((const float*)(ws + WS_GATES))[tok * 24 + head * 3 + 0] * invL;
            bf16_t* ocp = (bf16_t*)(ws + WS_OC) + tok * 512 + head * 64;
#pragma unroll
            for (int dt = 0; dt < 2; ++dt)
#pragma unroll
                for (int g4 = 0; g4 < 4; ++g4) { const int d0 = 32 * dt + 8 * g4 + 4 * hh;
                    u32x2 w; w.x = pk2(ot[dt][4 * g4 + 0] * sc, ot[dt][4 * g4 + 1] * sc); w.y = pk2(ot[dt][4 * g4 + 2] * sc, ot[dt][4 * g4 + 3] * sc); *(u32x2*)(ocp + d0) = w; }
        }
        {
            float tot[32];
#pragma unroll
            for (int Gi = 0; Gi < 32; ++Gi) { const float os = __shfl_xor(spl[Gi], 32); const float op = (Gi > 0) ? __shfl_xor(spl[Gi > 0 ? Gi - 1 : 0], 32) : 0.f; tot[Gi] = own[Gi] + (hh ? os : op); }
            for (int r = 0; r < 4; ++r) {
                if ((wid >> 1) == r) {
#pragma unroll
                    for (int Gi = 0; Gi < 32; ++Gi) if (Gi < 8 * ntile) impl[tokl * 64 + 2 * Gi + hh] += tot[Gi];
                }
                __syncthreads();
            }
        }
        for (int tt = 0; tt < 8; ++tt) {
            const int tl = wid * 8 + tt, cur = ci;
            const float imp = impl[tl * 64 + lane];
            const float INF = __builtin_inff();
            const float v = (lane == 0 || lane == cur) ? INF : (lane < cur ? imp : -INF);
            int rank = 0;
            for (int i = 0; i <= cur; ++i) { const float vi = __uint_as_float(__builtin_amdgcn_readlane(__float_as_uint(v), i)); rank += ((vi > v) || (vi == v && i < lane)) ? 1 : 0; }
            const bool sel = (lane <= cur) && (rank < 16);
            const unsigned long long mask = __ballot(sel);
            if (lane == 0) ((unsigned long long*)(ws + WS_SELM))[(size_t)bg * SEQ + ci * 64 + tl] = mask;
        }
    }
}

constexpr int FA_KB = 64 * 128, FA_VB = 64 * 136, FA_STAGE = FA_KB + FA_VB, FA_LDS = 2 * FA_STAGE + 1024;
template <bool SEL>
DEV void fa_branch(unsigned char* lds, const bf16_t* Kb, const bf16_t* VTb, int ci, int bg, const bf16x8 (&qf)[4], int t, unsigned long long mymask, unsigned long long need,
                   f32x16 (&ot)[2], float& m_run, float& l_run) {
    const int tid = threadIdx.x, lane = tid & 63;
    const int r31 = lane & 31, hh = lane >> 5;
    const int lrow = tid >> 3, lch = tid & 7;
    const bf16_t* kg = Kb + ((size_t)bg * SEQ + lrow) * 64 + lch * 8;
    const bf16_t* vg = VTb + ((size_t)bg * 64 + lrow) * SEQ + lch * 8;
    const int koff = lrow * 128 + ((lch ^ ((lrow >> 1) & 7)) << 4), voff = FA_KB + lrow * 136 + lch * 16;
    int jlo, jhi; unsigned long long todo;
    if (SEL) { todo = need; jlo = 0; jhi = ci; } else { jlo = ci >= 8 ? ci - 8 : 0; jhi = ci; todo = 0; }
    int j = jlo;
    if (SEL) { if (todo == 0) return; j = __builtin_ctzll(todo); todo &= todo - 1; }
    u32x4 rk = *(const u32x4*)(kg + (size_t)j * 64 * 64), rv = *(const u32x4*)(vg + (size_t)j * 64);
    __syncthreads();
    *(u32x4*)(lds + koff) = rk; { u32x2 a, b2; a.x = rv.x; a.y = rv.y; b2.x = rv.z; b2.y = rv.w; *(u32x2*)(lds + voff) = a; *(u32x2*)(lds + voff + 8) = b2; }
    __syncthreads();
    int st = 0;
    for (;;) {
        int jn; bool more;
        if (SEL) { more = (todo != 0); jn = more ? __builtin_ctzll(todo) : 0; todo &= todo - 1; } else { jn = j + 1; more = (jn <= jhi); }
        if (more) { rk = *(const u32x4*)(kg + (size_t)jn * 64 * 64); rv = *(const u32x4*)(vg + (size_t)jn * 64); }
        const unsigned char* base = lds + st * FA_STAGE;
        f32x16 sacc[2];
#pragma unroll
        for (int kt2 = 0; kt2 < 2; ++kt2) {
#pragma unroll
            for (int i = 0; i < 16; ++i) sacc[kt2][i] = 0.f;
            const int row = 32 * kt2 + r31; const int sx = (row >> 1) & 7;
#pragma unroll
            for (int s = 0; s < 4; ++s) { const bf16x8 kf = *(const bf16x8*)(base + row * 128 + (((2 * s + hh) ^ sx) << 4));
                sacc[kt2] = __builtin_amdgcn_mfma_f32_32x32x16_bf16(kf, qf[s], sacc[kt2], 0, 0, 0); }
        }
        const bool bit = SEL ? ((mymask >> j) & 1ull) != 0 : true;
        float mx = -1e30f;
#pragma unroll
        for (int kt2 = 0; kt2 < 2; ++kt2)
#pragma unroll
            for (int i = 0; i < 16; ++i) { const int key = 64 * j + 32 * kt2 + (i & 3) + 8 * (i >> 2) + 4 * hh;
                const bool ok = SEL ? (bit && key <= t) : (key <= t && t - key < 512);
                const float v = ok ? sacc[kt2][i] : -1e30f; sacc[kt2][i] = v; mx = fmaxf(mx, v); }
        mx = fmaxf(mx, __shfl_xor(mx, 32));
        const float m_new = fmaxf(m_run, mx);
        const float alpha = exp2f(m_run - m_new);
        m_run = m_new;
        float rs = 0.f;
#pragma unroll
        for (int kt2 = 0; kt2 < 2; ++kt2)
#pragma unroll
            for (int i = 0; i < 16; ++i) { const float v = sacc[kt2][i]; const float e = (v > -5e29f) ? exp2f(v - m_new) : 0.f; sacc[kt2][i] = e; rs += e; }
        l_run = l_run * alpha + rs;
#pragma unroll
        for (int dt = 0; dt < 2; ++dt)
#pragma unroll
            for (int i = 0; i < 16; ++i) ot[dt][i] *= alpha;
#pragma unroll
        for (int kt2 = 0; kt2 < 2; ++kt2)
#pragma unroll
            for (int s2 = 0; s2 < 2; ++s2) {
                bf16x8 pf; { u32x4 w; w.x = pk2(sacc[kt2][8 * s2 + 0], sacc[kt2][8 * s2 + 1]); w.y = pk2(sacc[kt2][8 * s2 + 2], sacc[kt2][8 * s2 + 3]);
                    w.z = pk2(sacc[kt2][8 * s2 + 4], sacc[kt2][8 * s2 + 5]); w.w = pk2(sacc[kt2][8 * s2 + 6], sacc[kt2][8 * s2 + 7]); pf = __builtin_bit_cast(bf16x8, w); }
#pragma unroll
                for (int dt = 0; dt < 2; ++dt) {
                    const unsigned char* va = base + FA_KB + (32 * dt + r31) * 136 + (32 * kt2 + 16 * s2 + 4 * hh) * 2;
                    const u32x2 lo = *(const u32x2*)(va), hi = *(const u32x2*)(va + 16);
                    u32x4 w; w.x = lo.x; w.y = lo.y; w.z = hi.x; w.w = hi.y;
                    ot[dt] = __builtin_amdgcn_mfma_f32_32x32x16_bf16(__builtin_bit_cast(bf16x8, w), pf, ot[dt], 0, 0, 0);
                }
            }
        if (!more) break;
        { unsigned char* nb = lds + (st ^ 1) * FA_STAGE; *(u32x4*)(nb + koff) = rk; u32x2 a, b2; a.x = rv.x; a.y = rv.y; b2.x = rv.z; b2.y = rv.w; *(u32x2*)(nb + voff) = a; *(u32x2*)(nb + voff + 8) = b2; }
        __syncthreads();
        st ^= 1; j = jn;
    }
}
DEV void phase_flash(const Params& p, unsigned char* lds) {
    const int tid = threadIdx.x, lane = tid & 63, wid = tid >> 6;
    const int vb = vblock(), G = gridDim.x;
    unsigned char* ws = p.ws;
    const int r31 = lane & 31, hh = lane >> 5;
    unsigned long long* red = (unsigned long long*)(lds + 2 * FA_STAGE);
    for (int it = vb; it < 1024; it += G) {
        const int rnd = it / G, pos = it % G; int sidx = (rnd & 1) ? (rnd * G + (G - 1 - pos)) : (rnd * G + pos); if (G != 256) sidx = it;
        const int ci = 63 - (sidx >> 4), bg = sidx & 15, b = bg >> 1, g = bg & 1;
        const int head = g * 4 + (wid >> 1);
        const int t = ci * 64 + (wid & 1) * 32 + r31;
        const size_t tok = (size_t)b * SEQ + t;
        bf16x8 qf[4];
        { const bf16_t* qp = (const bf16_t*)(ws + WS_Q) + ((size_t)(b * 8 + head) * SEQ + t) * 64 + 8 * hh;
#pragma unroll
            for (int s = 0; s < 4; ++s) qf[s] = *(const bf16x8*)(qp + 16 * s); }
        const unsigned long long mymask = ((const unsigned long long*)(ws + WS_SELM))[(size_t)bg * SEQ + t];
        unsigned long long orm = mymask;
#pragma unroll
        for (int o = 1; o < 32; o <<= 1) { const unsigned lo = __shfl_xor((unsigned)orm, o), hi = __shfl_xor((unsigned)(orm >> 32), o); orm |= ((unsigned long long)hi << 32) | lo; }
        __syncthreads();
        if (wid < 2 && lane == 0) red[wid] = orm;
        __syncthreads();
        const unsigned long long need = red[0] | red[1];
        f32x16 oc[2];
        {
            f32x16 ot[2]; float m_run = -1e30f, l_run = 0.f;
#pragma unroll
            for (int dt = 0; dt < 2; ++dt)
#pragma unroll
                for (int i = 0; i < 16; ++i) ot[dt][i] = 0.f;
            fa_branch<true>(lds, (const bf16_t*)(ws + WS_KS), (const bf16_t*)(ws + WS_VST), ci, bg, qf, t, mymask, need, ot, m_run, l_run);
            const float lt = l_run + __shfl_xor(l_run, 32);
            const float sc = ((const float*)(ws + WS_GATES))[tok * 24 + head * 3 + 1] / lt;
#pragma unroll
            for (int dt = 0; dt < 2; ++dt)
#pragma unroll
                for (int i = 0; i < 16; ++i) oc[dt][i] = ot[dt][i] * sc;
        }
        {
            f32x16 ot[2]; float m_run = -1e30f, l_run = 0.f;
#pragma unroll
            for (int dt = 0; dt < 2; ++dt)
#pragma unroll
                for (int i = 0; i < 16; ++i) ot[dt][i] = 0.f;
            fa_branch<false>(lds, (const bf16_t*)(ws + WS_KW), (const bf16_t*)(ws + WS_VWT), ci, bg, qf, t, 0ull, 0ull, ot, m_run, l_run);
            const float lt = l_run + __shfl_xor(l_run, 32);
            const float sc = ((const float*)(ws + WS_GATES))[tok * 24 + head * 3 + 2] / lt;
#pragma unroll
            for (int dt = 0; dt < 2; ++dt)
#pragma unroll
                for (int i = 0; i < 16; ++i) oc[dt][i] += ot[dt][i] * sc;
        }
        {
            const bf16_t* ocp = (const bf16_t*)(ws + WS_OC) + tok * 512 + head * 64;
            bf16_t* mix = (bf16_t*)(ws + WS_R1) + tok * 1024 + head * 64;
            float ss = 0.f;
#pragma unroll
            for (int dt = 0; dt < 2; ++dt)
#pragma unroll
                for (int g4 = 0; g4 < 4; ++g4) { const int d0 = 32 * dt + 8 * g4 + 4 * hh; const u32x2 c = *(const u32x2*)(ocp + d0);
                    const float v0 = oc[dt][4 * g4 + 0] + bflo(c.x), v1 = oc[dt][4 * g4 + 1] + bfhi(c.x), v2 = oc[dt][4 * g4 + 2] + bflo(c.y), v3 = oc[dt][4 * g4 + 3] + bfhi(c.y);
                    ss += (v0 * v0 + v1 * v1) + (v2 * v2 + v3 * v3);
                    u32x2 w; w.x = pk2(v0, v1); w.y = pk2(v2, v3); *(u32x2*)(mix + d0) = w; }
            ss += __shfl_xor(ss, 32);
            if (hh == 0) atomicAdd((float*)(ws + WS_ROWSS) + tok, ss);
        }
    }
}

DEV int swz256(int row, int chunk) { return row * 256 + ((chunk ^ (row & 15)) << 4); }
DEV void hgrn_cumsum(const Params& p, int bh, int c, float* segs, f32x2 (&lf)[8], f32x2 (&a)[8], f32x2& r, f32x2& alast) {
    const int tid = threadIdx.x, k2 = tid & 63, tq = tid >> 6;
    const int b = bh >> 2, h = bh & 3;
    const float* HL = (const float*)(p.ws + WS_HLOGF) + ((size_t)b * SEQ + c * 64 + tq * 8) * 512 + h * 128 + 2 * k2;
#pragma unroll
    for (int i = 0; i < 8; ++i) lf[i] = *(const f32x2*)(HL + (size_t)i * 512);
    f32x2 run = (f32x2){0.f, 0.f};
#pragma unroll
    for (int i = 0; i < 8; ++i) { run = run + lf[i]; a[i] = run; }
    *(f32x2*)(segs + tq * 128 + 2 * k2) = run;
    __syncthreads();
    f32x2 off = (f32x2){0.f, 0.f}, tot = off, rr = off;
#pragma unroll
    for (int q = 0; q < 8; ++q) { const f32x2 s = *(const f32x2*)(segs + q * 128 + 2 * k2); if (q < tq) off = off + s; if (q < 4) rr = rr + s; tot = tot + s; }
#pragma unroll
    for (int i = 0; i < 8; ++i) a[i] = a[i] + off;
    r = rr; alast = tot;
}
DEV void hgrn_stage_vt(const Params& p, int bh, int c, unsigned char* vt) {
    const int tid = threadIdx.x, k2 = tid & 63, tq = tid >> 6;
    const int b = bh >> 2, h = bh & 3;
    const bf16_t* HV = (const bf16_t*)(p.ws + WS_HV) + ((size_t)b * SEQ + c * 64 + tq * 8) * 512 + h * 128 + 2 * k2;
    unsigned vv[8];
#pragma unroll
    for (int i = 0; i < 8; ++i) vv[i] = *(const unsigned*)(HV + (size_t)i * 512);
    u32x4 lo, hi;
    lo.x = (vv[0] & 0xffffu) | (vv[1] << 16); lo.y = (vv[2] & 0xffffu) | (vv[3] << 16); lo.z = (vv[4] & 0xffffu) | (vv[5] << 16); lo.w = (vv[6] & 0xffffu) | (vv[7] << 16);
    hi.x = (vv[0] >> 16) | (vv[1] & 0xffff0000u); hi.y = (vv[2] >> 16) | (vv[3] & 0xffff0000u); hi.z = (vv[4] >> 16) | (vv[5] & 0xffff0000u); hi.w = (vv[6] >> 16) | (vv[7] & 0xffff0000u);
    *(u32x4*)(vt + swz(2 * k2, tq)) = lo; *(u32x4*)(vt + swz(2 * k2 + 1, tq)) = hi;
}
constexpr int H1_KT = 0, H1_VT = 16384, H1_SEG = 32768, H1_EK = H1_SEG + 4096;
DEV void phase_hgrn_a1(const Params& p, unsigned char* lds) {
    const int tid = threadIdx.x, lane = tid & 63, wid = tid >> 6, k2 = tid & 63, tq = tid >> 6;
    const int vb = vblock(), G = gridDim.x;
    const int frow = lane & 15, fq = lane >> 4, wr = wid >> 1, wc = wid & 1;
    float* segs = (float*)(lds + H1_SEG); float* ek = (float*)(lds + H1_EK);
    bf16_t* ubuf = (bf16_t*)(p.ws + WS_UBUF); float* dbuf = (float*)(p.ws + WS_DBUF);
    for (int item = vb; item < 2048; item += G) {
        const int bh = item >> 6, c = item & 63;
        __syncthreads();
        f32x2 lf[8], a[8], r, al;
        hgrn_cumsum(p, bh, c, segs, lf, a, r, al);
        {
            float kx[8], ky[8];
#pragma unroll
            for (int i = 0; i < 8; ++i) { kx[i] = (1.f - __expf(lf[i].x)) * __expf(fminf(r.x - a[i].x, 80.f)); ky[i] = (1.f - __expf(lf[i].y)) * __expf(fminf(r.y - a[i].y, 80.f)); }
            u32x4 w0, w1;
            w0.x = pk2(kx[0], kx[1]); w0.y = pk2(kx[2], kx[3]); w0.z = pk2(kx[4], kx[5]); w0.w = pk2(kx[6], kx[7]);
            w1.x = pk2(ky[0], ky[1]); w1.y = pk2(ky[2], ky[3]); w1.z = pk2(ky[4], ky[5]); w1.w = pk2(ky[6], ky[7]);
            *(u32x4*)(lds + H1_KT + swz(2 * k2, tq)) = w0; *(u32x4*)(lds + H1_KT + swz(2 * k2 + 1, tq)) = w1;
        }
        hgrn_stage_vt(p, bh, c, lds + H1_VT);
        if (tq == 7) { ek[2 * k2] = __expf(al.x - r.x); ek[2 * k2 + 1] = __expf(al.y - r.y); f32x2 d; d.x = __expf(al.x); d.y = __expf(al.y); *(f32x2*)(dbuf + (size_t)item * 128 + 2 * k2) = d; }
        __syncthreads();
        f32x4 acc[2][4];
#pragma unroll
        for (int m = 0; m < 2; ++m)
#pragma unroll
            for (int n = 0; n < 4; ++n) acc[m][n] = (f32x4){0.f, 0.f, 0.f, 0.f};
        const int sx = (frow >> 1) & 7;
#pragma unroll
        for (int ks = 0; ks < 2; ++ks) {
            const int co = ((ks * 4 + fq) ^ sx) << 4;
            bf16x8 af[2], bfr[4];
#pragma unroll
            for (int m = 0; m < 2; ++m) af[m] = *(const bf16x8*)(lds + H1_VT + (32 * wr + 16 * m + frow) * 128 + co);
#pragma unroll
            for (int n = 0; n < 4; ++n) bfr[n] = *(const bf16x8*)(lds + H1_KT + (64 * wc + 16 * n + frow) * 128 + co);
#pragma unroll
            for (int m = 0; m < 2; ++m)
#pragma unroll
                for (int n = 0; n < 4; ++n) acc[m][n] = __builtin_amdgcn_mfma_f32_16x16x32_bf16(bfr[n], af[m], acc[m][n], 0, 0, 0);
        }
#pragma unroll
        for (int m = 0; m < 2; ++m) { const int v = 32 * wr + 16 * m + frow;
#pragma unroll
            for (int n = 0; n < 4; ++n) { const int k0 = 64 * wc + 16 * n + 4 * fq; const f32x4 e = *(const f32x4*)(ek + k0); const f32x4 o = acc[m][n] * e;
                u32x2 w; w.x = pk2(o.x, o.y); w.y = pk2(o.z, o.w); *(u32x2*)(ubuf + ((size_t)item * 128 + v) * 128 + k0) = w; } }
    }
}
DEV void phase_hgrn_a2(const Params& p, unsigned char* lds) {
    const int G = gridDim.x;
    bf16_t* ubuf = (bf16_t*)(p.ws + WS_UBUF); const float* dbuf = (const float*)(p.ws + WS_DBUF);
    for (int gid = blockIdx.x * NT + threadIdx.x; gid < 131072; gid += G * NT) {
        const int bh = gid >> 12, v = (gid >> 5) & 127, k4 = gid & 31;
        bf16_t* u = ubuf + ((size_t)bh * 64 * 128 + v) * 128 + 4 * k4;
        const float* d = dbuf + (size_t)bh * 64 * 128 + 4 * k4;
        f32x4 S = (f32x4){0.f, 0.f, 0.f, 0.f};
        for (int c0 = 0; c0 < 64; c0 += 8) {
            u32x2 uu[8]; f32x4 dd[8];
#pragma unroll
            for (int j = 0; j < 8; ++j) { uu[j] = *(const u32x2*)(u + (size_t)(c0 + j) * 16384); dd[j] = *(const f32x4*)(d + (size_t)(c0 + j) * 128); }
#pragma unroll
            for (int j = 0; j < 8; ++j) { u32x2 w; w.x = pk2(S.x, S.y); w.y = pk2(S.z, S.w); *(u32x2*)(u + (size_t)(c0 + j) * 16384) = w;
                S.x = dd[j].x * S.x + bflo(uu[j].x); S.y = dd[j].y * S.y + bfhi(uu[j].x); S.z = dd[j].z * S.z + bflo(uu[j].y); S.w = dd[j].w * S.w + bfhi(uu[j].y); }
        }
    }
}
constexpr int H3_QH = 0, H3_QA = 16384, H3_KH = 32768, H3_VT = 49152, H3_PP = 65536, H3_ST = 73728, H3_SEG = 106496, H3_RED = 110592;
DEV void phase_hgrn_a3(const Params& p, unsigned char* lds) {
    const int tid = threadIdx.x, lane = tid & 63, wid = tid >> 6, k2 = tid & 63, tq = tid >> 6;
    const int vb = vblock(), G = gridDim.x;
    const int frow = lane & 15, fq = lane >> 4;
    float* segs = (float*)(lds + H3_SEG); float* red = (float*)(lds + H3_RED);
    const bf16_t* ubuf = (const bf16_t*)(p.ws + WS_UBUF);
    for (int item = vb; item < 2048; item += G) {
        const int bh = item >> 6, c = item & 63, b = bh >> 2, h = bh & 3;
        __syncthreads();
        f32x2 lf[8], a[8], r, al;
        hgrn_cumsum(p, bh, c, segs, lf, a, r, al);
        {
            const bf16_t* HQ = (const bf16_t*)(p.ws + WS_HQ) + ((size_t)b * SEQ + c * 64 + tq * 8) * 512 + h * 128 + 2 * k2;
            unsigned qq[8];
#pragma unroll
            for (int i = 0; i < 8; ++i) qq[i] = *(const unsigned*)(HQ + (size_t)i * 512);
#pragma unroll
            for (int i = 0; i < 8; ++i) { const int t = 8 * tq + i; const float q0 = bflo(qq[i]), q1 = bfhi(qq[i]);
                const int off = swz256(t, k2 >> 2) + (k2 & 3) * 4;
                *(unsigned*)(lds + H3_QH + off) = pk2(q0 * __expf(fminf(a[i].x - r.x, 80.f)), q1 * __expf(fminf(a[i].y - r.y, 80.f)));
                *(unsigned*)(lds + H3_QA + off) = pk2(q0 * __expf(a[i].x), q1 * __expf(a[i].y));
                *(unsigned*)(lds + H3_KH + off) = pk2((1.f - __expf(lf[i].x)) * __expf(fminf(r.x - a[i].x, 80.f)), (1.f - __expf(lf[i].y)) * __expf(fminf(r.y - a[i].y, 80.f))); }
        }
        hgrn_stage_vt(p, bh, c, lds + H3_VT);
        {
            const bf16_t* st = ubuf + (size_t)item * 16384;
#pragma unroll
            for (int i = 0; i < 4; ++i) { const int q = tid + NT * i, v = q >> 4, ch = q & 15; *(u32x4*)(lds + H3_ST + swz256(v, ch)) = *(const u32x4*)(st + v * 128 + ch * 8); }
        }
        __syncthreads();
        {
            const int wr = wid >> 1, wc = wid & 1;
            f32x4 acc[2];
            acc[0] = (f32x4){0.f, 0.f, 0.f, 0.f}; acc[1] = acc[0];
            if (32 * wc <= 16 * wr + 15) {
#pragma unroll
                for (int ks = 0; ks < 4; ++ks) {
                    const int co = ((ks * 4 + fq) ^ frow) << 4;
                    const bf16x8 af = *(const bf16x8*)(lds + H3_QH + (16 * wr + frow) * 256 + co);
#pragma unroll
                    for (int n = 0; n < 2; ++n) { const bf16x8 bfr = *(const bf16x8*)(lds + H3_KH + (32 * wc + 16 * n + frow) * 256 + co);
                        acc[n] = __builtin_amdgcn_mfma_f32_16x16x32_bf16(bfr, af, acc[n], 0, 0, 0); }
                }
            }
            const int t = 16 * wr + frow;
#pragma unroll
            for (int n = 0; n < 2; ++n) { const int s0 = 32 * wc + 16 * n + 4 * fq; f32x4 v = acc[n];
                v.x = (s0 + 0 <= t) ? v.x : 0.f; v.y = (s0 + 1 <= t) ? v.y : 0.f; v.z = (s0 + 2 <= t) ? v.z : 0.f; v.w = (s0 + 3 <= t) ? v.w : 0.f;
                u32x2 w; w.x = pk2(v.x, v.y); w.y = pk2(v.z, v.w);
                *(u32x2*)(lds + H3_PP + t * 128 + ((((s0 >> 3)) ^ ((t >> 1) & 7)) << 4) + (s0 & 7) * 2) = w; }
        }
        __syncthreads();
        {
            const int wr = wid >> 2, wc = wid & 3;
            f32x4 acc[2][2];
#pragma unroll
            for (int m = 0; m < 2; ++m)
#pragma unroll
                for (int n = 0; n < 2; ++n) acc[m][n] = (f32x4){0.f, 0.f, 0.f, 0.f};
            const int sx = (frow >> 1) & 7;
#pragma unroll
            for (int ks = 0; ks < 2; ++ks) {
                const int co = ((ks * 4 + fq) ^ sx) << 4;
                bf16x8 af[2], bfr[2];
#pragma unroll
                for (int m = 0; m < 2; ++m) af[m] = *(const bf16x8*)(lds + H3_PP + (32 * wr + 16 * m + frow) * 128 + co);
#pragma unroll
                for (int n = 0; n < 2; ++n) bfr[n] = *(const bf16x8*)(lds + H3_VT + (32 * wc + 16 * n + frow) * 128 + co);
#pragma unroll
                for (int m = 0; m < 2; ++m)
#pragma unroll
                    for (int n = 0; n < 2; ++n) acc[m][n] = __builtin_amdgcn_mfma_f32_16x16x32_bf16(bfr[n], af[m], acc[m][n], 0, 0, 0);
            }
#pragma unroll
            for (int ks = 0; ks < 4; ++ks) {
                const int co = ((ks * 4 + fq) ^ frow) << 4;
                bf16x8 af[2], bfr[2];
#pragma unroll
                for (int m = 0; m < 2; ++m) af[m] = *(const bf16x8*)(lds + H3_QA + (32 * wr + 16 * m + frow) * 256 + co);
#pragma unroll
                for (int n = 0; n < 2; ++n) bfr[n] = *(const bf16x8*)(lds + H3_ST + (32 * wc + 16 * n + frow) * 256 + co);
#pragma unroll
                for (int m = 0; m < 2; ++m)
#pragma unroll
                    for (int n = 0; n < 2; ++n) acc[m][n] = __builtin_amdgcn_mfma_f32_16x16x32_bf16(bfr[n], af[m], acc[m][n], 0, 0, 0);
            }
#pragma unroll
            for (int m = 0; m < 2; ++m) { float ss = 0.f;
#pragma unroll
                for (int n = 0; n < 2; ++n) { const f32x4 v = acc[m][n]; ss += (v.x * v.x + v.y * v.y) + (v.z * v.z + v.w * v.w); }
                ss += __shfl_xor(ss, 16); ss += __shfl_xor(ss, 32);
                if (fq == 0) red[(32 * wr + 16 * m + frow) * 4 + wc] = ss; }
            __syncthreads();
#pragma unroll
            for (int m = 0; m < 2; ++m) { const int t = 32 * wr + 16 * m + frow; const f32x4 q4 = *(const f32x4*)(red + t * 4);
                const float rs = rsqrtf(((q4.x + q4.y) + (q4.z + q4.w)) * (1.f / 128.f) + RMS_EPS);
                const size_t row = (size_t)b * SEQ + c * 64 + t;
#pragma unroll
                for (int n = 0; n < 2; ++n) { const int v0 = 32 * wc + 16 * n + 4 * fq; const f32x4 gn = *(const f32x4*)(p.g_hn + v0);
                    const u32x2 gg = *(const u32x2*)((const bf16_t*)(p.ws + WS_HG) + row * 512 + h * 128 + v0);
                    const f32x4 o = acc[m][n];
                    u32x2 w; w.x = pk2(o.x * rs * gn.x * bflo(gg.x), o.y * rs * gn.y * bfhi(gg.x)); w.y = pk2(o.z * rs * gn.z * bflo(gg.y), o.w * rs * gn.w * bfhi(gg.y));
                    *(u32x2*)((bf16_t*)(p.ws + WS_R1) + row * 1024 + 512 + h * 128 + v0) = w; } }
        }
    }
}

DEV void phase_normalize(const Params& p, unsigned char* lds) {
    const int tid = threadIdx.x, lane = tid & 63, wid = tid >> 6;
    const int vb = vblock(), G = gridDim.x;
    unsigned char* ws = p.ws;
    bf16_t* mix = (bf16_t*)(ws + WS_R1); const float* rowss = (const float*)(ws + WS_ROWSS); const bf16_t* HG = (const bf16_t*)(ws + WS_HG);
    for (int m = vb * 8 + wid; m < NTOK; m += G * 8) {
        {
            const float r = rsqrtf(rowss[m] * (1.f / 512.f) + RMS_EPS);
            u32x4* pp = (u32x4*)(mix + (size_t)m * 1024) + lane; u32x4 v = *pp;
            v.x = pk2(bflo(v.x) * r, bfhi(v.x) * r); v.y = pk2(bflo(v.y) * r, bfhi(v.y) * r); v.z = pk2(bflo(v.z) * r, bfhi(v.z) * r); v.w = pk2(bflo(v.w) * r, bfhi(v.w) * r);
            *pp = v;
        }
    }
    __syncthreads();
    {
        float* tl = (float*)lds;
        for (int r = vb; r < 32 * 16 * 16; r += G) { const int e = r / 256, q = r % 256; SrcW13 s{p.w1 + (size_t)e * 1024 * 512, p.w3 + (size_t)e * 1024 * 512, p.ffn_g};
            convert_tile(tl, s, (bf16_t*)(ws + WS_W13T) + (size_t)e * 1024 * 1024, 1024, (q / 16) * 64, (q % 16) * 64); }
    }
}

struct EpiOut { const Params& p; int m0, n0;
    DEV void operator()(f32x4 (&acc)[4][4], int wr, int wc, int lane) const {
        const int frow = lane & 15, fq = lane >> 4;
#pragma unroll
        for (int m = 0; m < 4; ++m) { const size_t row = m0 + wr * 64 + m * 16 + frow;
#pragma unroll
            for (int n = 0; n < 4; ++n) { const int c = n0 + wc * 64 + n * 16 + fq * 4; const f32x4 xv = *(const f32x4*)(p.x + row * DM + c); *(f32x4*)(p.out + row * DM + c) = xv + acc[m][n]; } }
    } };
DEV void phase_outproj(const Params& p, unsigned char* lds) {
    const int vb = vblock(), G = gridDim.x;
    constexpr int U = (NTOK / 128) * 4;
    for (int u = vb; u < U; u += G) {
        const int mt = u >> 2, nt = u & 3;
        ARows al{(const bf16_t*)(p.ws + WS_R1) + (size_t)mt * 128 * DM, DM};
        BRows bl{(const bf16_t*)(p.ws + WS_WOUTT) + (size_t)nt * 256 * DM, DM};
        EpiOut ep{p, mt * 128, nt * 256};
        gemm_tile(lds, al, bl, DM / 64, ep);
    }
}

constexpr int RT_HS = 0, RT_WS = 128 * 33 * 4, RT_LG = RT_WS + 32 * 36 * 4, RT_RS = RT_LG + 128 * 37 * 4, RT_HIST = RT_RS + 512, RT_BASE = RT_HIST + 512, RT_LDS = RT_BASE + 512;
DEV void phase_router(const Params& p, unsigned char* lds) {
    const int tid = threadIdx.x;
    const int vb = vblock(), G = gridDim.x;
    unsigned char* ws = p.ws;
    float* hs = (float*)(lds + RT_HS); float* wsm = (float*)(lds + RT_WS); float* lg = (float*)(lds + RT_LG); float* rsd = (float*)(lds + RT_RS);
    int* hist = (int*)(lds + RT_HIST); int* basep = (int*)(lds + RT_BASE);
    bf16_t* hb = (bf16_t*)(ws + WS_R1);
    const int tok = tid & 127, cgp = tid >> 7;
    for (int it = vb; it < NTOK / 128; it += G) {
        const size_t row0 = (size_t)it * 128;
        float acc[9]; float ssq[4] = {0.f, 0.f, 0.f, 0.f};
#pragma unroll
        for (int c = 0; c < 9; ++c) acc[c] = 0.f;
        if (tid < 128) hist[tid] = 0;
        for (int kc = 0; kc < 32; ++kc) {
            __syncthreads();
#pragma unroll
            for (int i = 0; i < 4; ++i) { const int idx = tid + NT * i, tk = idx >> 4, kp = idx & 15; const size_t gi = (row0 + tk) * DM + kc * 32 + 2 * kp;
                const f32x2 v = *(const f32x2*)(p.out + gi); hs[tk * 33 + 2 * kp] = v.x; hs[tk * 33 + 2 * kp + 1] = v.y; ssq[i] += v.x * v.x + v.y * v.y; *(unsigned*)(hb + gi) = pk2(v.x, v.y); }
            for (int idx = tid; idx < 32 * 36; idx += NT) { const int kk = idx / 36, c = idx % 36, k = kc * 32 + kk;
                wsm[idx] = (c < 4 ? p.w_group[k * 4 + c] : p.w_expert[k * 32 + (c - 4)]) * p.ffn_g[k]; }
            __syncthreads();
#pragma unroll 8
            for (int kk = 0; kk < 32; ++kk) { const float hv = hs[tok * 33 + kk];
#pragma unroll
                for (int c = 0; c < 9; ++c) acc[c] += hv * wsm[kk * 36 + cgp * 9 + c]; }
        }
#pragma unroll
        for (int i = 0; i < 4; ++i) { float s = ssq[i]; s += __shfl_xor(s, 1); s += __shfl_xor(s, 2); s += __shfl_xor(s, 4); s += __shfl_xor(s, 8);
            if ((tid & 15) == 0) rsd[(tid + NT * i) >> 4] = rsqrtf(s * (1.f / DM) + RMS_EPS); }
#pragma unroll
        for (int c = 0; c < 9; ++c) lg[tok * 37 + cgp * 9 + c] = acc[c];
        __syncthreads();
        int bin = 0, slot = 0;
        if (tid < 128) {
            const float rs = rsd[tid];
            ((float*)(ws + WS_RSTD2))[row0 + tid] = rs;
            float gl[4]; int gi = 0; float gm = -1e30f;
#pragma unroll
            for (int c = 0; c < 4; ++c) { gl[c] = lg[tid * 37 + c] * rs + p.b_group[c]; if (gl[c] > gm) { gm = gl[c]; gi = c; } }
            float gs = 0.f;
#pragma unroll
            for (int c = 0; c < 4; ++c) gs += __expf(gl[c] - gm);
            const float pg = 1.f / gs;
            float el[8]; int i0 = 0; float m0 = -1e30f;
#pragma unroll
            for (int c = 0; c < 8; ++c) { el[c] = lg[tid * 37 + 4 + gi * 8 + c] * rs + p.b_expert[gi * 8 + c]; if (el[c] > m0) { m0 = el[c]; i0 = c; } }
            int i1 = 0; float m1 = -1e30f;
#pragma unroll
            for (int c = 0; c < 8; ++c) if (c != i0 && el[c] > m1) { m1 = el[c]; i1 = c; }
            const float e1 = __expf(m1 - m0); const float w0 = pg / (1.f + e1), w1 = pg * e1 / (1.f + e1);
            const int a = min(i0, i1), bb = max(i0, i1);
            bin = gi * 28 + (7 * a - (a * (a - 1)) / 2) + (bb - a - 1);
            f32x2 tw; tw.x = (i0 < i1) ? w0 : w1; tw.y = (i0 < i1) ? w1 : w0;
            ((f32x2*)(ws + WS_TOKW))[row0 + tid] = tw;
            slot = atomicAdd(&hist[bin], 1);
        }
        __syncthreads();
        if (tid < NBIN) { const int h = hist[tid]; basep[tid] = h ? atomicAdd((int*)(ws + WS_CTL) + tid, h) : 0; }
        __syncthreads();
        if (tid < 128) ((int*)(ws + WS_BINL))[(size_t)bin * BINCAP + basep[bin] + slot] = (int)(row0 + tid);
        __syncthreads();
    }
}

DEV void moe_tiles(const Params& p, int* tstart  ) {
    const int tid = threadIdx.x;
    __syncthreads();
    if (tid == 0) { const int* cnt = (const int*)(p.ws + WS_CTL); int s = 0; for (int i = 0; i < NBIN; ++i) { tstart[i] = s; s += (cnt[i] + 127) >> 7; } tstart[NBIN] = s; }
    __syncthreads();
}
DEV void bin_experts(int bin, int& ea, int& eb) { const int gi = bin / 28; int pi = bin % 28, a = 0; while (pi >= 7 - a) { pi -= 7 - a; ++a; } ea = gi * 8 + a; eb = gi * 8 + a + 1 + pi; }
struct AGather { const bf16_t* hb; const int* list; int n;
    DEV const bf16_t* row(int r) const { const int t = list[r < n ? r : 0]; return hb + (size_t)t * DM; } };
struct EpiMoe1 { const Params& p; const int* list; int n; size_t hrow0; int nt;
    DEV void operator()(f32x4 (&acc)[4][4], int wr, int wc, int lane) const {
        const int frow = lane & 15, fq = lane >> 4;
        bf16_t* hbuf = (bf16_t*)(p.ws + WS_HBUF);
#pragma unroll
        for (int m = 0; m < 4; ++m) { const int r = wr * 64 + m * 16 + frow; if (r >= n) continue;
            const int t = list[r]; const float rs = ((const float*)(p.ws + WS_RSTD2))[t]; const f32x2 tw = ((const f32x2*)(p.ws + WS_TOKW))[t]; const float w = nt < 4 ? tw.x : tw.y;
#pragma unroll
            for (int n2 = 0; n2 < 4; ++n2) { const f32x4 v = acc[m][n2] * rs; const int f = ((nt & 3) * 256 + wc * 64 + n2 * 16 + fq * 4) >> 1;
                *(unsigned*)(hbuf + (hrow0 + r) * 1024 + (nt < 4 ? 0 : 512) + f) = pk2(siluf_(v.x) * v.y * w, siluf_(v.z) * v.w * w); } }
    } };
DEV void phase_moe1(const Params& p, unsigned char* lds) {
    const int vb = vblock(), G = gridDim.x;
    int* tstart = (int*)(lds + G_LDS);
    moe_tiles(p, tstart);
    const int T = tstart[NBIN], U = T * 8;
    for (int u = vb; u < U; u += G) {
        const int tile = u >> 3, nt = u & 7;
        int bin = 0; while (tstart[bin + 1] <= tile) ++bin;
        const int mt = tile - tstart[bin]; int ea, eb; bin_experts(bin, ea, eb);
        const int cnt = ((const int*)(p.ws + WS_CTL))[bin]; const int n = min(128, cnt - mt * 128);
        const int* list = (const int*)(p.ws + WS_BINL) + (size_t)bin * BINCAP + mt * 128;
        AGather al{(const bf16_t*)(p.ws + WS_R1), list, n};
        BRows bl{(const bf16_t*)(p.ws + WS_W13T) + ((size_t)(nt < 4 ? ea : eb) * 1024 + (nt & 3) * 256) * 1024, 1024};
        EpiMoe1 ep{p, list, n, (size_t)tile * 128, nt};
        gemm_tile(lds, al, bl, DM / 64, ep);
    }
}
struct BPair { const bf16_t* wa; const bf16_t* wb; DEV const bf16_t* ptr(int n, int kt) const { return kt < 8 ? wa + (size_t)n * 512 + kt * 64 : wb + (size_t)n * 512 + (kt - 8) * 64; } };
struct EpiMoe2 { const Params& p; const int* list; int n; int n0;
    DEV void operator()(f32x4 (&acc)[4][4], int wr, int wc, int lane) const {
        const int frow = lane & 15, fq = lane >> 4;
#pragma unroll
        for (int m = 0; m < 4; ++m) { const int r = wr * 64 + m * 16 + frow; if (r >= n) continue; const size_t t = list[r];
#pragma unroll
            for (int n2 = 0; n2 < 4; ++n2) { float* o = p.out + t * DM + n0 + wc * 64 + n2 * 16 + fq * 4; *(f32x4*)o = *(const f32x4*)o + acc[m][n2]; } }
    } };
DEV void phase_moe2(const Params& p, unsigned char* lds) {
    const int vb = vblock(), G = gridDim.x;
    int* tstart = (int*)(lds + G_LDS);
    moe_tiles(p, tstart);
    const int T = tstart[NBIN], U = T * 4;
    for (int u = vb; u < U; u += G) {
        const int tile = u >> 2, nt = u & 3;
        int bin = 0; while (tstart[bin + 1] <= tile) ++bin;
        const int mt = tile - tstart[bin]; int ea, eb; bin_experts(bin, ea, eb);
        const int cnt = ((const int*)(p.ws + WS_CTL))[bin]; const int n = min(128, cnt - mt * 128);
        const int* list = (const int*)(p.ws + WS_BINL) + (size_t)bin * BINCAP + mt * 128;
        ARows al{(const bf16_t*)(p.ws + WS_HBUF) + (size_t)tile * 128 * 1024, 1024};
        BPair bl{(const bf16_t*)(p.ws + WS_W2T) + ((size_t)ea * 1024 + nt * 256) * 512, (const bf16_t*)(p.ws + WS_W2T) + ((size_t)eb * 1024 + nt * 256) * 512};
        EpiMoe2 ep{p, list, n, nt * 256};
        gemm_tile(lds, al, bl, 16, ep);
    }
}

#define XB_TMO      128
#define XB_XCNT(j)  (256  + 64 * (j))
#define XB_XSUB(j)  (1280 + 64 * (j))
#define XB_XGEN(j)  (2304 + 64 * (j))
#define XB_TOP      3328
#define XB_TOPGEN   3392
#define XCD_BAR_WORDS 3456
#define XB_SPIN_CAP (1u << 20)
#define LAS __attribute__((address_space(3)))
constexpr size_t WS_BAR = WS_CTL + 4096;
DEV unsigned xb_ld(unsigned* p) { return __hip_atomic_load(p, __ATOMIC_RELAXED, __HIP_MEMORY_SCOPE_AGENT); }
DEV unsigned xb_add(unsigned* p, unsigned v) { return __hip_atomic_fetch_add(p, v, __ATOMIC_RELAXED, __HIP_MEMORY_SCOPE_AGENT); }
DEV unsigned xb_xcc_id() { return (unsigned)__builtin_amdgcn_s_getreg((3 << 11) | 20) & 0xFu; }
#define XB_SPIN(cond, bar) do { unsigned _sp = 0; while (cond) { __builtin_amdgcn_s_sleep(1); \
    if ((++_sp & 255u) == 0u) { if (xb_ld(&(bar)[XB_TMO])) break; if (_sp > XB_SPIN_CAP) { atomicAdd(&(bar)[XB_TMO], 1u); break; } } } } while (0)
struct XcdBarrier { unsigned* bar; unsigned x; volatile LAS unsigned* st; };
DEV XcdBarrier xcd_barrier_post(unsigned* bar, volatile LAS unsigned* st) {
    XcdBarrier b; b.bar = bar; b.x = xb_xcc_id(); b.st = st;
    if (threadIdx.x == 0) (void)xb_add(&bar[XB_XCNT(b.x)], 1u);
    return b;
}
DEV void xcd_barrier_complete(unsigned* bar, unsigned x, unsigned& nloc, unsigned& nx) {
    const unsigned G = gridDim.x * gridDim.y * gridDim.z;
    unsigned sum, cnt, mine, sp = 0u;
    for (;;) {
        sum = 0u; cnt = 0u; mine = 0u;
#pragma unroll
        for (unsigned j = 0; j < 16; ++j) { const unsigned c = xb_ld(&bar[XB_XCNT(j)]); sum += c; cnt += (c > 0u) ? 1u : 0u; mine = (j == x) ? c : mine; }
        if (sum == G) break;
        __builtin_amdgcn_s_sleep(1);
        if ((++sp & 255u) == 0u) { if (xb_ld(&bar[XB_TMO])) break; if (sp > XB_SPIN_CAP) { atomicAdd(&bar[XB_TMO], 1u); break; } }
    }
    nloc = mine > 0u ? mine : 1u; nx = cnt > 0u ? cnt : 1u;
}
DEV void xcd_barrier(const XcdBarrier& b) {
    asm volatile("s_waitcnt vmcnt(0)" ::: "memory");
    __syncthreads();
    if (threadIdx.x == 0) {
        unsigned* bar = b.bar;
        __builtin_amdgcn_s_waitcnt(0);
        unsigned nloc = b.st[0], nx = b.st[1];
        if (nloc == 0u) { xcd_barrier_complete(bar, b.x, nloc, nx); b.st[0] = nloc; b.st[1] = nx; }
        const unsigned old = xb_add(&bar[XB_XSUB(b.x)], 1u);
        const unsigned gen = old / nloc;
        if (old + 1u == (gen + 1u) * nloc) {
            __builtin_amdgcn_fence(__ATOMIC_RELEASE, "agent");
            asm volatile("s_waitcnt vmcnt(0)" ::: "memory");
            const unsigned og = xb_add(&bar[XB_TOP], 1u);
            const unsigned tg = og / nx;
            if (og + 1u == (tg + 1u) * nx) xb_add(&bar[XB_TOPGEN], 1u);
            else XB_SPIN(xb_ld(&bar[XB_TOPGEN]) == tg, bar);
            __builtin_amdgcn_fence(__ATOMIC_ACQUIRE, "agent");
            xb_add(&bar[XB_XGEN(b.x)], 1u);
            asm volatile("s_waitcnt vmcnt(0)" ::: "memory");
        } else {
            XB_SPIN(xb_ld(&bar[XB_XGEN(b.x)]) == gen, bar);
            __builtin_amdgcn_fence(__ATOMIC_ACQUIRE, "agent");
            asm volatile("s_waitcnt vmcnt(0)" ::: "memory");
        }
    }
    __syncthreads();
}

constexpr int LDS_BYTES = 112 * 1024;
constexpr int N_PHASES = 13;
__global__ void __launch_bounds__(NT) mega(Params p, int lo, int hi) {
    extern __shared__ __attribute__((aligned(16))) unsigned char lds[];
    volatile LAS unsigned* xst = (volatile LAS unsigned*)(lds + LDS_BYTES - 16);
    if (threadIdx.x < 4) xst[threadIdx.x] = 0u;
    __syncthreads();
    XcdBarrier xbar; xbar.bar = (unsigned*)(p.ws + WS_BAR); xbar.x = 0; xbar.st = xst;
    if (hi - lo > 1) xbar = xcd_barrier_post((unsigned*)(p.ws + WS_BAR), xst);
#define GRID_SYNC() xcd_barrier(xbar)
#ifndef PROBE_REPEAT
#define PROBE_REPEAT -1
#endif
#define RUN_PHASE(k, call) do { if (lo <= (k) && (k) < hi) { call; \
        if ((k) == PROBE_REPEAT) { GRID_SYNC(); \
            if ((k) == 5) { float* rz = (float*)(p.ws + WS_ROWSS); for (int i = blockIdx.x * NT + threadIdx.x; i < NTOK; i += gridDim.x * NT) rz[i] = 0.f; GRID_SYNC(); } \
            if ((k) == 11) { if (blockIdx.x == 0 && threadIdx.x < 128) ((int*)(p.ws + WS_CTL))[threadIdx.x] = 0; GRID_SYNC(); } \
            call; } \
        if ((k) + 1 < hi) GRID_SYNC(); } } while (0)
    RUN_PHASE(0, phase_prologue(p, lds));
    RUN_PHASE(1, phase_inproj(p, lds));
    RUN_PHASE(2, phase_cmp_a(p, lds));
    RUN_PHASE(3, phase_cmp_b(p, lds));
    RUN_PHASE(4, phase_cmp_attn(p, lds));
    RUN_PHASE(5, phase_flash(p, lds));
    RUN_PHASE(6, phase_hgrn_a1(p, lds));
    RUN_PHASE(7, phase_hgrn_a2(p, lds));
    RUN_PHASE(8, phase_hgrn_a3(p, lds));
    RUN_PHASE(9, phase_normalize(p, lds));
    RUN_PHASE(10, phase_outproj(p, lds));
    RUN_PHASE(11, phase_router(p, lds));
    RUN_PHASE(12, phase_moe1(p, lds));
    RUN_PHASE(13, phase_moe2(p, lds));
#undef RUN_PHASE
}

extern "C" void kernel_launch(void* const* d_in, const int* in_sizes, int n_in, void* d_out, int out_size, void* d_ws, size_t ws_size, hipStream_t stream) {
    static int grid = 0;
    if (grid == 0) {
        int dev = 0, cus = 0, per_cu = 0;
        hipGetDevice(&dev);
        hipDeviceGetAttribute(&cus, hipDeviceAttributeMultiprocessorCount, dev);
        hipFuncSetAttribute((const void*)mega, hipFuncAttributeMaxDynamicSharedMemorySize, LDS_BYTES);
        hipOccupancyMaxActiveBlocksPerMultiprocessor(&per_cu, (const void*)mega, NT, LDS_BYTES);
        if (per_cu < 1) per_cu = 1;
        grid = cus;
        if (ws_size < WS_END) fprintf(stderr, "kernel_launch: workspace too small: %zu < %zu\n", ws_size, (size_t)WS_END);
        fprintf(stderr, "kernel_launch: cus %d per_cu %d grid %d ws %zu\n", cus, per_cu, grid, ws_size);
    }
    Params p{};
    const float** pp = (const float**)&p;
    for (int i = 0; i < 23; ++i) pp[i] = (const float*)d_in[i];
    p.out = (float*)d_out; p.ws = (unsigned char*)d_ws;
#if N_LAUNCH_MODE == 1
    (void)hipMemsetAsync((unsigned char*)d_ws + WS_BAR, 0, XCD_BAR_WORDS * 4, stream);
    int lo = 0, hi = N_PHASES + 1;
    void* args[] = {&p, &lo, &hi};
    hipError_t e = hipLaunchCooperativeKernel((const void*)mega, dim3(grid), dim3(NT), args, LDS_BYTES, stream);
    if (e != hipSuccess) fprintf(stderr, "cooperative launch failed: %s\n", hipGetErrorString(e));
#else
    for (int ph = 0; ph <= N_PHASES; ++ph) hipLaunchKernelGGL(mega, dim3(grid), dim3(NT), LDS_BYTES, stream, p, ph, ph + 1);
#endif
}
```

```cpp
#include <hip/hip_runtime.h>
#include <hip/hip_cooperative_groups.h>
#include <cstdio>
#include <cstdint>
#include <cstring>
namespace cg = cooperative_groups;

#ifndef N_LAUNCH_MODE
#define N_LAUNCH_MODE 1
#endif

#define DEV __device__ __forceinline__
typedef unsigned short bf16_t;
typedef short bf16x8 __attribute__((ext_vector_type(8)));
typedef float f32x4 __attribute__((ext_vector_type(4)));
typedef float f32x2 __attribute__((ext_vector_type(2)));
typedef float f32x16 __attribute__((ext_vector_type(16)));
typedef unsigned u32x4 __attribute__((ext_vector_type(4)));
typedef unsigned u32x2 __attribute__((ext_vector_type(2)));

constexpr int NT = 512;
constexpr int BATCH = 8, SEQ = 4096, DM = 1024, NTOK = BATCH * SEQ;
constexpr int IN_COLS = 3352, INP = 3584;
constexpr int NC = 255;
constexpr float RMS_EPS = 1e-6f;
constexpr float QSCALE = 0.125f * 1.4426950408889634f;
constexpr int NBIN = 112;
constexpr int BINCAP = NTOK;

constexpr size_t MiB = 1ull << 20;
constexpr size_t WS_CTL    = 0;
constexpr size_t WS_RSTD1  = 1 * MiB;
constexpr size_t WS_RSTD2  = WS_RSTD1 + 128 * 1024;
constexpr size_t WS_ROWSS  = WS_RSTD2 + 128 * 1024;
constexpr size_t WS_TOKW   = WS_ROWSS + 128 * 1024;
constexpr size_t WS_LB     = WS_TOKW + 256 * 1024;
constexpr size_t WS_CBIAS  = WS_LB + 4096;
constexpr size_t WS_SELM   = 2 * MiB;
constexpr size_t WS_GATES  = 3 * MiB;
constexpr size_t WS_KCMP   = 6 * MiB;
constexpr size_t WS_VCMP   = WS_KCMP + 512 * 1024;
constexpr size_t WS_CW2T   = 7 * MiB;
constexpr size_t WS_HID    = 8 * MiB;
constexpr size_t WS_CW1T   = 12 * MiB;
constexpr size_t WS_WOUTT  = 14 * MiB;
constexpr size_t WS_WINT   = 16 * MiB;
constexpr size_t WS_R1     = 24 * MiB;
constexpr size_t WS_Q      = 88 * MiB;
constexpr size_t WS_KC     = 120 * MiB;
constexpr size_t WS_VC     = 128 * MiB;
constexpr size_t WS_KS     = 136 * MiB;
constexpr size_t WS_KW     = 144 * MiB;
constexpr size_t WS_VST    = 152 * MiB;
constexpr size_t WS_VWT    = 160 * MiB;
constexpr size_t WS_OC     = 168 * MiB;
constexpr size_t WS_W13T   = 200 * MiB;
constexpr size_t WS_W2T    = 264 * MiB;
constexpr size_t WS_HQ     = 296 * MiB;
constexpr size_t WS_HV     = 328 * MiB;
constexpr size_t WS_HG     = 360 * MiB;
constexpr size_t WS_HLOGF  = 392 * MiB;
constexpr size_t WS_DBUF   = 456 * MiB;
constexpr size_t WS_END    = 457 * MiB;
constexpr size_t WS_UBUF   = WS_W13T;
constexpr size_t WS_BINL   = WS_HQ;
constexpr size_t WS_HBUF   = WS_HQ + 16 * MiB;

struct Params {
    const float *x, *attn_g, *ffn_g, *w_in, *w_out, *g_q, *g_k, *pos_k, *pos_v, *wk1, *wk2, *wv1, *wv2, *g_nsa, *lb_logits, *g_hn,
        *w_group, *b_group, *w_expert, *b_expert, *w1, *w3, *w2;
    float* out;
    unsigned char* ws;
};

typedef __bf16 bf16x2_t __attribute__((ext_vector_type(2)));
DEV unsigned pk2(float lo, float hi) { f32x2 f = {lo, hi}; return __builtin_bit_cast(unsigned, __builtin_convertvector(f, bf16x2_t)); }
DEV bf16_t f2bf(float f) { return (bf16_t)(pk2(f, 0.f) & 0xffffu); }
DEV float bf2f(bf16_t b) { return __uint_as_float(((unsigned)b) << 16); }
DEV float bflo(unsigned u) { return __uint_as_float(u << 16); }
DEV float bfhi(unsigned u) { return __uint_as_float(u & 0xffff0000u); }
DEV float sigmoidf_(float v) { return 1.f / (1.f + __expf(-v)); }
DEV float siluf_(float v) { return v / (1.f + __expf(-v)); }
DEV float wave_sum(float v) {
#pragma unroll
    for (int o = 1; o < 64; o <<= 1) v += __shfl_xor(v, o);
    return v;
}
DEV float wave_max(float v) {
#pragma unroll
    for (int o = 1; o < 64; o <<= 1) v = fmaxf(v, __shfl_xor(v, o));
    return v;
}
DEV int vblock() { const int G = gridDim.x, b = blockIdx.x; return (G % 8 == 0) ? (b % 8) * (G / 8) + b / 8 : b; }

namespace pg8 {
#define PG8_LAS __attribute__((address_space(3)))
constexpr int BM = 256, BK = 64, HALF = 128, HTB = HALF * BK * 2, STAGE_BYTES = 8 * HTB, NXCD = 8, WGM = 8;
__host__ __device__ __forceinline__ int lds_byte(int r, int c) { const int st = (r >> 4) * 2 + (c >> 5), rr = r & 15, cc = c & 31, ob = rr * 64 + cc * 2; return st * 1024 + (ob ^ (((ob >> 9) & 1) << 5)); }
__host__ __device__ __forceinline__ void stage_rc(int b, int& R, int& C) { const int st = b / 1024, sb = b % 1024, swz = sb ^ (((sb >> 9) & 1) << 5); R = (st >> 1) * 16 + swz / 64; C = (st & 1) * 32 + (swz % 64) / 2; }
struct Unit { int pm, pn; };
struct Gemm { const bf16_t* A; const bf16_t* Bt; int M, N, K; };
struct StaticOrder {
    int nM, nN, nwg, G, c;
    __host__ __device__ void init(int M, int N, int G_, int c_) { nM = M / BM; nN = N / BM; nwg = nM * nN; G = G_; c = c_; }
    __host__ __device__ bool next(int i, Unit& u) const {
        const long L = (long)i * G + c; if (L >= nwg) return false;
        int wgid = (int)L; { const int q = nwg / NXCD, r = nwg % NXCD, xcd = wgid % NXCD, off = wgid / NXCD; wgid = (xcd < r ? xcd * (q + 1) : r * (q + 1) + (xcd - r) * q) + off; }
        const int nig = WGM * nN, gid = wgid / nig, fm = gid * WGM, gsz = (nM - fm) < WGM ? (nM - fm) : WGM;
        u.pm = fm + ((wgid % nig) % gsz); u.pn = (wgid % nig) / gsz; return true;
    }
};
template <class Epi, class Sched>
__device__ __forceinline__ void gemm_phase(PG8_LAS unsigned char* lds, const Gemm g, const Sched& S, const Epi& E) {
    const int tid = threadIdx.x, wid = __builtin_amdgcn_readfirstlane(tid >> 6), lane = tid & 63, wr = wid >> 2, wc = wid & 3, fr = lane & 15, fq = lane >> 4;
    const int K = g.K, nt = K / BK;
    unsigned voffA[2];
#pragma unroll
    for (int i = 0; i < 2; ++i) { int R, C; stage_rc(tid * 16 + i * 8192, R, C); voffA[i] = (unsigned)(R * K + C) * 2u; }
    const size_t kstep = (size_t)(BK * 2);
    const size_t hstep = (size_t)HALF * K * 2;
    const size_t tstep = 2 * hstep;
    const unsigned ldsw = (unsigned)wid * 1024u;
    const int aoff = lds_byte(wr * 64 + fr, fq * 8), boff = lds_byte(wc * 32 + fr, fq * 8);
#define PG8_SA(b, h) (((b) * 2 + (h)) * HTB)
#define PG8_SB(b, h) ((4 + (b) * 2 + (h)) * HTB)
#define PG8_STAGE(bufoff, gbase, voff) do { _Pragma("unroll") for (int _i = 0; _i < 2; ++_i) \
        __builtin_amdgcn_global_load_lds((const unsigned*)((const char*)(gbase) + (voff)[_i]), (PG8_LAS unsigned*)(lds + (bufoff) + ldsw + _i * 8192), 16, 0, 0); } while (0)
#define PG8_LDA(dst, b, h) do { _Pragma("unroll") for (int m = 0; m < 4; ++m) _Pragma("unroll") for (int k = 0; k < 2; ++k) dst[m][k] = *(const PG8_LAS bf16x8*)(lds + PG8_SA(b, h) + aoff + m * 2048 + k * 1024); } while (0)
#define PG8_LDB(dst, b, h) do { _Pragma("unroll") for (int n = 0; n < 2; ++n) _Pragma("unroll") for (int k = 0; k < 2; ++k) dst[n][k] = *(const PG8_LAS bf16x8*)(lds + PG8_SB(b, h) + boff + n * 2048 + k * 1024); } while (0)
#define PG8_MMA(ai, bj, At, Bt) do { __builtin_amdgcn_s_setprio(1); _Pragma("unroll") for (int m = 0; m < 4; ++m) _Pragma("unroll") for (int n = 0; n < 2; ++n) _Pragma("unroll") for (int k = 0; k < 2; ++k) \
        acc[ai][bj][m][n] = __builtin_amdgcn_mfma_f32_16x16x32_bf16(Bt[n][k], At[m][k], acc[ai][bj][m][n], 0, 0, 0); __builtin_amdgcn_s_setprio(0); } while (0)
#define PG8_WAIT_V(n) asm volatile("s_waitcnt vmcnt(" #n ")" ::: "memory")
#define PG8_WAIT_L(n) asm volatile("s_waitcnt lgkmcnt(" #n ")" ::: "memory")
#define PG8_BAR __builtin_amdgcn_s_barrier()
#define PG8_SCHED __builtin_amdgcn_sched_barrier(0)
    Unit cur, nxt; int ui = 0;
    if (!S.next(0, cur)) return;
    f32x4 acc[2][2][4][2];
#pragma unroll
    for (int a = 0; a < 2; ++a)
#pragma unroll
        for (int b = 0; b < 2; ++b)
#pragma unroll
            for (int m = 0; m < 4; ++m)
#pragma unroll
                for (int n = 0; n < 2; ++n) acc[a][b][m][n] = (f32x4){0.f, 0.f, 0.f, 0.f};
    bf16x8 At[4][2], B0[2][2], B1[2][2];
    const char* cA = (const char*)g.A + (size_t)cur.pm * tstep; const char* cB = (const char*)g.Bt + (size_t)cur.pn * tstep;
    PG8_STAGE(PG8_SB(0, 0), cB, voffA); PG8_STAGE(PG8_SA(0, 0), cA, voffA); PG8_STAGE(PG8_SB(0, 1), cB + hstep, voffA); PG8_STAGE(PG8_SA(0, 1), cA + hstep, voffA);
    if (wr == 1) PG8_BAR;
    PG8_WAIT_V(4); PG8_BAR;
    PG8_STAGE(PG8_SB(1, 0), cB + kstep, voffA); PG8_STAGE(PG8_SA(1, 0), cA + kstep, voffA); PG8_STAGE(PG8_SB(1, 1), cB + hstep + kstep, voffA);
    PG8_WAIT_V(6); PG8_BAR;
    for (;;) {
        const bool has_next = S.next(ui + 1, nxt);
        const char* nA = has_next ? (const char*)g.A + (size_t)nxt.pm * tstep : cA; const char* nB = has_next ? (const char*)g.Bt + (size_t)nxt.pn * tstep : cB;
        for (int t = 0; t < nt; t += 2) {
            const bool last = (t == nt - 2);
            const char* a1 = cA + (size_t)(t + 1) * kstep;
            const char* a2 = last ? nA : cA + (size_t)(t + 2) * kstep; const char* b2 = last ? nB : cB + (size_t)(t + 2) * kstep;
            const char* a3 = a2 + kstep; const char* b3 = b2 + kstep;
            PG8_LDB(B0, 0, 0); PG8_SCHED; PG8_LDA(At, 0, 0); PG8_STAGE(PG8_SA(1, 1), a1 + hstep, voffA);
            PG8_WAIT_L(8); PG8_BAR; PG8_WAIT_L(0); PG8_MMA(0, 0, At, B0); PG8_BAR; PG8_SCHED;
            PG8_LDB(B1, 0, 1); PG8_STAGE(PG8_SB(0, 0), b2, voffA);
            PG8_BAR; PG8_WAIT_L(0); PG8_MMA(0, 1, At, B1); PG8_BAR;
            PG8_LDA(At, 0, 1); PG8_STAGE(PG8_SA(0, 0), a2, voffA);
            PG8_BAR; PG8_WAIT_L(0); PG8_MMA(1, 0, At, B0); PG8_BAR; PG8_SCHED;
            PG8_STAGE(PG8_SB(0, 1), b2 + hstep, voffA);
            PG8_WAIT_V(6); PG8_BAR; PG8_MMA(1, 1, At, B1); PG8_BAR;
            PG8_LDB(B0, 1, 0); PG8_SCHED; PG8_LDA(At, 1, 0); PG8_STAGE(PG8_SA(0, 1), a2 + hstep, voffA);
            PG8_WAIT_L(8); PG8_BAR; PG8_WAIT_L(0); PG8_MMA(0, 0, At, B0); PG8_BAR; PG8_SCHED;
            PG8_LDB(B1, 1, 1); PG8_STAGE(PG8_SB(1, 0), b3, voffA);
            PG8_BAR; PG8_WAIT_L(0); PG8_MMA(0, 1, At, B1); PG8_BAR;
            PG8_LDA(At, 1, 1); PG8_STAGE(PG8_SA(1, 0), a3, voffA);
            PG8_BAR; PG8_WAIT_L(0); PG8_MMA(1, 0, At, B0); PG8_BAR; PG8_SCHED;
            PG8_STAGE(PG8_SB(1, 1), b3 + hstep, voffA);
            PG8_WAIT_V(6); PG8_BAR; PG8_MMA(1, 1, At, B1); PG8_BAR;
        }
        E(acc, cur, wr, wc, fr, fq);
        if (!has_next) break;
#pragma unroll
        for (int a = 0; a < 2; ++a)
#pragma unroll
            for (int b = 0; b < 2; ++b)
#pragma unroll
                for (int m = 0; m < 4; ++m)
#pragma unroll
                    for (int n = 0; n < 2; ++n) acc[a][b][m][n] = (f32x4){0.f, 0.f, 0.f, 0.f};
        cur = nxt; cA = nA; cB = nB; ++ui;
    }
    PG8_WAIT_V(0);
    if (wr == 0) PG8_BAR;
    PG8_BAR;
#undef PG8_SA
#undef PG8_SB
#undef PG8_STAGE
#undef PG8_LDA
#undef PG8_LDB
#undef PG8_MMA
#undef PG8_WAIT_V
#undef PG8_WAIT_L
#undef PG8_BAR
#undef PG8_SCHED
}
__host__ __device__ __forceinline__ int logcol(int p) { return (p & ~255) + 64 * ((p >> 5) & 3) + 32 * ((p >> 7) & 1) + (p & 31); }
}

template <class SRC>
DEV void convert_tile(float* tl, const SRC& src, bf16_t* dst, int ldd, int n0, int k0) {
    const int tid = threadIdx.x;
    {
        const int n = tid & 63;
#pragma unroll
        for (int i = 0; i < 8; ++i) { const int kk = (tid >> 6) + 8 * i; tl[kk * 65 + n] = src.get(n0 + n, k0 + kk); }
    }
    __syncthreads();
    {
        const int n = tid >> 3, kc = tid & 7;
        const float* s = tl + (kc * 8) * 65 + n;
        u32x4 o;
        o.x = pk2(s[0 * 65], s[1 * 65]); o.y = pk2(s[2 * 65], s[3 * 65]); o.z = pk2(s[4 * 65], s[5 * 65]); o.w = pk2(s[6 * 65], s[7 * 65]);
        *(u32x4*)(dst + (size_t)(n0 + n) * ldd + k0 + kc * 8) = o;
    }
    __syncthreads();
}
struct SrcWin { const float* w; const float* g;
    DEV float get(int np, int k) const { const int n = pg8::logcol(np); int col; if (n < 1280) col = n; else if (n < 3328) col = n + 24; else if (n < 3352) col = 1280 + (n - 3328); else return 0.f;
        return w[(size_t)k * IN_COLS + col] * g[k]; } };
struct SrcWout { const float* w; const float* g;
    DEV float get(int np, int k) const { const int n = pg8::logcol(np); const float v = w[(size_t)k * DM + n]; return k < 512 ? v * g[k] : v; } };
struct SrcPlain { const float* w; int ld;
    DEV float get(int n, int k) const { return w[(size_t)k * ld + n]; } };
struct SrcW13 { const float* w1; const float* w3; const float* g;
    DEV float get(int n, int k) const { const uintptr_t a = (uintptr_t)w1, b = (uintptr_t)w3; const float* w = (const float*)(a + ((b - a) & (uintptr_t)(0 - (long long)(n & 1))));
        return w[(size_t)k * 512 + (n >> 1)] * g[k]; } };

DEV void phase_prologue(const Params& p, unsigned char* lds) {
    float* tl = (float*)lds;
    const int tid = threadIdx.x, lane = tid & 63, wid = tid >> 6;
    const int vb = vblock(), G = gridDim.x;
    unsigned char* ws = p.ws;
    constexpr int I_WIN = (INP / 64) * (DM / 64);
    constexpr int I_WOUT = 16 * 16;
    constexpr int I_CW1 = 2 * 4 * 32;
    constexpr int I_CW2 = 2 * 1 * 4;
    constexpr int I_W13 = 32 * 16 * 16;
    constexpr int I_W2 = 32 * 16 * 8;
    constexpr int I_ALL = I_WIN + I_WOUT + I_CW1 + I_CW2 + I_W2;
    for (int it = vb; it < I_ALL; it += G) {
        int r = it;
        if (r < I_WIN) { SrcWin s{p.w_in, p.attn_g}; convert_tile(tl, s, (bf16_t*)(ws + WS_WINT), DM, (r / 16) * 64, (r % 16) * 64); continue; } r -= I_WIN;
        if (r < I_WOUT) { SrcWout s{p.w_out, p.g_nsa}; convert_tile(tl, s, (bf16_t*)(ws + WS_WOUTT), DM, (r / 16) * 64, (r % 16) * 64); continue; } r -= I_WOUT;
        if (r < I_CW1) { const int z = r / 128, q = r % 128; SrcPlain s{z ? p.wv1 : p.wk1, 256};
            convert_tile(tl, s, (bf16_t*)(ws + WS_CW1T) + (size_t)z * 256 * 2048, 2048, (q / 32) * 64, (q % 32) * 64); continue; } r -= I_CW1;
        if (r < I_CW2) { const int z = r / 4, q = r % 4; SrcPlain s{z ? p.wv2 : p.wk2, 64};
            convert_tile(tl, s, (bf16_t*)(ws + WS_CW2T) + (size_t)z * 64 * 256, 256, 0, q * 64); continue; } r -= I_CW2;
        { const int e = r / 128, q = r % 128; SrcPlain s{p.w2 + (size_t)e * 512 * 1024, 1024};
            convert_tile(tl, s, (bf16_t*)(ws + WS_W2T) + (size_t)e * 1024 * 512, 512, (q / 8) * 64, (q % 8) * 64); }
    }
    {
        bf16_t* xb = (bf16_t*)(ws + WS_R1); float* rstd1 = (float*)(ws + WS_RSTD1);
        const int gw = vb * 8 + wid, NGW = G * 8;
        for (int m = gw; m < NTOK; m += NGW) {
            const f32x4* xr = (const f32x4*)(p.x + (size_t)m * DM) + lane;
            f32x4 v[4]; float s = 0.f;
#pragma unroll
            for (int j = 0; j < 4; ++j) { v[j] = xr[64 * j]; s += (v[j].x * v[j].x + v[j].y * v[j].y) + (v[j].z * v[j].z + v[j].w * v[j].w); }
            s = wave_sum(s);
            if (lane == 0) rstd1[m] = rsqrtf(s * (1.f / DM) + RMS_EPS);
            u32x2* o = (u32x2*)(xb + (size_t)m * DM) + lane;
#pragma unroll
            for (int j = 0; j < 4; ++j) { u32x2 w; w.x = pk2(v[j].x, v[j].y); w.y = pk2(v[j].z, v[j].w); o[64 * j] = w; }
        }
    }
    {
        const int gt = vb * NT + tid, NG = G * NT;
        float* rowss = (float*)(ws + WS_ROWSS);
        for (int i = gt; i < NTOK; i += NG) rowss[i] = 0.f;
        int* bincnt = (int*)(ws + WS_CTL);
        if (gt < 128) bincnt[gt] = 0;
        if (gt < 512) { const float l0 = p.lb_logits[gt], l1 = p.lb_logits[512 + gt]; ((float*)(ws + WS_LB))[gt] = 1.f / (1.f + __expf(l1 - l0)); }
        if (blockIdx.x == (unsigned)(G - 1)) {
            const int z = tid >> 8, j = tid & 255; const float* pos = z ? p.pos_v : p.pos_k; const float* w = z ? p.wv1 : p.wk1;
            float a = 0.f;
            for (int k = 0; k < 2048; ++k) a += pos[k] * w[(size_t)k * 256 + j];
            ((float*)(ws + WS_CBIAS))[z * 256 + j] = a;
        }
    }
}

constexpr int G_A_BYTES = 128 * 128, G_B_BYTES = 256 * 128, G_STAGE = G_A_BYTES + G_B_BYTES, G_LDS = 2 * G_STAGE;
DEV int swz(int row, int chunk) { return row * 128 + ((chunk ^ ((row >> 1) & 7)) << 4); }
template <class AL, class BL, class EP>
DEV void gemm_tile(unsigned char* lds, const AL& al, const BL& bl, int nk, const EP& ep) {
    const int tid = threadIdx.x, lane = tid & 63, wid = tid >> 6, wr = wid >> 2, wc = wid & 3;
    const int frow = lane & 15, fq = lane >> 4;
    const bf16_t* aptr[2]; int aoff[2], boff[4], brow[4];
#pragma unroll
    for (int i = 0; i < 2; ++i) { const int q = tid + NT * i, row = q >> 3, ch = q & 7; aptr[i] = al.row(row) + ch * 8; aoff[i] = swz(row, ch); }
#pragma unroll
    for (int i = 0; i < 4; ++i) { const int q = tid + NT * i, row = q >> 3, ch = q & 7; brow[i] = row; boff[i] = G_A_BYTES + swz(row, ch) ; }
    const int bch8 = (tid & 7) * 8;
    u32x4 ra[2], rb[4];
#pragma unroll
    for (int i = 0; i < 2; ++i) ra[i] = *(const u32x4*)(aptr[i]);
#pragma unroll
    for (int i = 0; i < 4; ++i) rb[i] = *(const u32x4*)(bl.ptr(brow[i], 0) + bch8);
#pragma unroll
    for (int i = 0; i < 2; ++i) *(u32x4*)(lds + aoff[i]) = ra[i];
#pragma unroll
    for (int i = 0; i < 4; ++i) *(u32x4*)(lds + boff[i]) = rb[i];
    __syncthreads();
    f32x4 acc[4][4];
#pragma unroll
    for (int m = 0; m < 4; ++m)
#pragma unroll
        for (int n = 0; n < 4; ++n) acc[m][n] = (f32x4){0.f, 0.f, 0.f, 0.f};
    const int sx = (frow >> 1) & 7;
    for (int kt = 0; kt < nk; ++kt) {
        const bool more = (kt + 1 < nk);
        if (more) {
#pragma unroll
            for (int i = 0; i < 2; ++i) ra[i] = *(const u32x4*)(aptr[i] + (kt + 1) * 64);
#pragma unroll
            for (int i = 0; i < 4; ++i) rb[i] = *(const u32x4*)(bl.ptr(brow[i], kt + 1) + bch8);
        }
        const unsigned char* base = lds + (kt & 1) * G_STAGE;
#pragma unroll
        for (int ks = 0; ks < 2; ++ks) {
            const int co = ((ks * 4 + fq) ^ sx) << 4;
            bf16x8 af[4], bfr[4];
#pragma unroll
            for (int m = 0; m < 4; ++m) af[m] = *(const bf16x8*)(base + (wr * 64 + m * 16 + frow) * 128 + co);
#pragma unroll
            for (int n = 0; n < 4; ++n) bfr[n] = *(const bf16x8*)(base + G_A_BYTES + (wc * 64 + n * 16 + frow) * 128 + co);
#pragma unroll
            for (int m = 0; m < 4; ++m)
#pragma unroll
                for (int n = 0; n < 4; ++n) acc[m][n] = __builtin_amdgcn_mfma_f32_16x16x32_bf16(bfr[n], af[m], acc[m][n], 0, 0, 0);
        }
        if (more) {
            unsigned char* nb = lds + ((kt + 1) & 1) * G_STAGE;
#pragma unroll
            for (int i = 0; i < 2; ++i) *(u32x4*)(nb + aoff[i]) = ra[i];
#pragma unroll
            for (int i = 0; i < 4; ++i) *(u32x4*)(nb + boff[i]) = rb[i];
        }
        __syncthreads();
    }
    ep(acc, wr, wc, lane);
}

struct ARows { const bf16_t* base; size_t ld; DEV const bf16_t* row(int r) const { return base + (size_t)r * ld; } };
struct BRows { const bf16_t* base; size_t ld; DEV const bf16_t* ptr(int n, int kt) const { return base + (size_t)n * ld + kt * 64; } };

DEV void inproj_row(const Params& p, int seg, int row, f32x4 (&v)[4], int fq) {
    unsigned char* ws = p.ws;
    const float rs = ((const float*)(ws + WS_RSTD1))[row];
#pragma unroll
    for (int n = 0; n < 4; ++n) v[n] = v[n] * rs;
    const int b = row >> 12, s = row & 4095;
    const bool is_q = seg < 8, is_ks = (seg == 12 || seg == 13), is_kw = (seg == 16 || seg == 17);
    if (is_q || is_ks || is_kw) {
        const float* gw = is_q ? p.g_q : (is_ks ? p.g_k + 64 : p.g_k + 128);
        bf16_t* dst; int hh, nh;
        if (is_q) { dst = (bf16_t*)(ws + WS_Q); hh = seg; nh = 8; } else if (is_ks) { dst = (bf16_t*)(ws + WS_KS); hh = seg - 12; nh = 2; } else { dst = (bf16_t*)(ws + WS_KW); hh = seg - 16; nh = 2; }
        float ss = 0.f;
#pragma unroll
        for (int n = 0; n < 4; ++n) ss += (v[n].x * v[n].x + v[n].y * v[n].y) + (v[n].z * v[n].z + v[n].w * v[n].w);
        ss += __shfl_xor(ss, 16); ss += __shfl_xor(ss, 32);
        float r = rsqrtf(ss * (1.f / 64.f) + RMS_EPS); if (is_q) r *= QSCALE;
        bf16_t* o = dst + ((size_t)(b * nh + hh) * SEQ + s) * 64 + fq * 4;
#pragma unroll
        for (int n = 0; n < 4; ++n) { const f32x4 g = *(const f32x4*)(gw + n * 16 + fq * 4); const f32x4 x = v[n] * g * r; u32x2 w; w.x = pk2(x.x, x.y); w.y = pk2(x.z, x.w); *(u32x2*)(o + n * 16) = w; }
        return;
    }
    if (seg >= 8 && seg < 12) {
        bf16_t* o = (bf16_t*)(ws + (seg < 10 ? WS_KC : WS_VC)) + ((size_t)(b * 2 + (seg & 1)) * SEQ + s) * 64 + fq * 4;
#pragma unroll
        for (int n = 0; n < 4; ++n) { u32x2 w; w.x = pk2(v[n].x, v[n].y); w.y = pk2(v[n].z, v[n].w); *(u32x2*)(o + n * 16) = w; }
        return;
    }
    if (seg == 14 || seg == 15 || seg == 18 || seg == 19) {
        bf16_t* o = (bf16_t*)(ws + (seg < 16 ? WS_VST : WS_VWT)) + (size_t)(b * 2 + (seg & 1)) * 64 * SEQ + s;
#pragma unroll
        for (int n = 0; n < 4; ++n) { const int d = n * 16 + fq * 4;
            o[(size_t)(d + 0) * SEQ] = f2bf(v[n].x); o[(size_t)(d + 1) * SEQ] = f2bf(v[n].y); o[(size_t)(d + 2) * SEQ] = f2bf(v[n].z); o[(size_t)(d + 3) * SEQ] = f2bf(v[n].w); }
        return;
    }
    if (seg < 52) {
        const int kind = (seg - 20) >> 3, cb = ((seg - 20) & 7) * 64 + fq * 4;
        if (kind == 1) {
            const float* lb = (const float*)(ws + WS_LB); float* dst = (float*)(ws + WS_HLOGF) + (size_t)row * 512;
#pragma unroll
            for (int n = 0; n < 4; ++n) { const int c = cb + n * 16; const f32x4 l = *(const f32x4*)(lb + c); f32x4 o;
                o.x = __logf(l.x + (1.f - l.x) * sigmoidf_(v[n].x)); o.y = __logf(l.y + (1.f - l.y) * sigmoidf_(v[n].y));
                o.z = __logf(l.z + (1.f - l.z) * sigmoidf_(v[n].z)); o.w = __logf(l.w + (1.f - l.w) * sigmoidf_(v[n].w));
                *(f32x4*)(dst + c) = o; }
        } else {
            bf16_t* dst = (bf16_t*)(ws + (kind == 0 ? WS_HQ : (kind == 2 ? WS_HV : WS_HG))) + (size_t)row * 512 + cb;
#pragma unroll
            for (int n = 0; n < 4; ++n) { f32x4 x = v[n];
                if (kind != 2) { x.x = siluf_(x.x); x.y = siluf_(x.y); x.z = siluf_(x.z); x.w = siluf_(x.w); }
                u32x2 w; w.x = pk2(x.x, x.y); w.y = pk2(x.z, x.w); *(u32x2*)(dst + n * 16) = w; }
        }
        return;
    }
    {
        float* dst = (float*)(ws + WS_GATES) + (size_t)row * 24;
#pragma unroll
        for (int n = 0; n < 2; ++n) { const int c = n * 16 + fq * 4; if (c < 24) { f32x4 o; o.x = sigmoidf_(v[n].x); o.y = sigmoidf_(v[n].y); o.z = sigmoidf_(v[n].z); o.w = sigmoidf_(v[n].w); *(f32x4*)(dst + c) = o; } }
    }
}
struct EpiInproj8 { const Params& p;
    DEV void operator()(const f32x4 (&acc)[2][2][4][2], const pg8::Unit& u, int wr, int wc, int fr, int fq) const {
        const int seg = u.pn * 4 + wc;
        if (seg > 52) return;
#pragma unroll
        for (int ai = 0; ai < 2; ++ai)
#pragma unroll
            for (int m = 0; m < 4; ++m) { f32x4 v[4] = {acc[ai][0][m][0], acc[ai][0][m][1], acc[ai][1][m][0], acc[ai][1][m][1]};
                inproj_row(p, seg, u.pm * 256 + ai * 128 + wr * 64 + m * 16 + fr, v, fq); }
    } };
DEV void phase_inproj(const Params& p, unsigned char* lds) {
    pg8::Gemm g{(const bf16_t*)(p.ws + WS_R1), (const bf16_t*)(p.ws + WS_WINT), NTOK, INP, DM};
    pg8::StaticOrder S; S.init(NTOK, INP, (int)gridDim.x, (int)blockIdx.x);
    EpiInproj8 E{p};
    pg8::gemm_phase(( PG8_LAS unsigned char*)lds, g, S, E);
}

struct ACmp { const bf16_t* src; int bg, c0;
    DEV const bf16_t* row(int r) const { int c = c0 + r; if (c > NC - 1) c = NC - 1; return src + ((size_t)bg * SEQ + 16 * c) * 64; } };
struct EpiCmpA { const Params& p; int z, rbase;
    DEV void operator()(f32x4 (&acc)[4][4], int wr, int wc, int lane) const {
        const int frow = lane & 15, fq = lane >> 4;
        const float* cb = (const float*)(p.ws + WS_CBIAS) + z * 256; bf16_t* hid = (bf16_t*)(p.ws + WS_HID) + (size_t)z * 4096 * 256;
#pragma unroll
        for (int m = 0; m < 4; ++m) { const int rr = rbase + wr * 64 + m * 16 + frow;
#pragma unroll
            for (int n = 0; n < 4; ++n) { const int c = wc * 64 + n * 16 + fq * 4; const f32x4 b = *(const f32x4*)(cb + c); f32x4 v = acc[m][n] + b;
                u32x2 w; w.x = pk2(siluf_(v.x), siluf_(v.y)); w.y = pk2(siluf_(v.z), siluf_(v.w)); *(u32x2*)(hid + (size_t)rr * 256 + c) = w; } }
    } };
DEV void phase_cmp_a(const Params& p, unsigned char* lds) {
    const int vb = vblock(), G = gridDim.x;
    for (int u = vb; u < 64; u += G) {
        const int z = u >> 5, rbase = (u & 31) * 128;
        ACmp al{(const bf16_t*)(p.ws + (z ? WS_VC : WS_KC)), (u & 31) >> 1, (u & 1) * 128};
        BRows bl{(const bf16_t*)(p.ws + WS_CW1T) + (size_t)z * 256 * 2048, 2048};
        EpiCmpA ep{p, z, rbase};
        gemm_tile(lds, al, bl, 2048 / 64, ep);
    }
}
struct BClamp64 { const bf16_t* base; size_t ld; DEV const bf16_t* ptr(int n, int kt) const { return base + (size_t)(n & 63) * ld + kt * 64; } };
struct EpiCmpB { const Params& p; int z, rbase;
    DEV void operator()(f32x4 (&acc)[4][4], int wr, int wc, int lane) const {
        if (wc != 0) return;
        const int frow = lane & 15, fq = lane >> 4;
        bf16_t* dst = (bf16_t*)(p.ws + (z ? WS_VCMP : WS_KCMP));
#pragma unroll
        for (int m = 0; m < 4; ++m) { const int rr = rbase + wr * 64 + m * 16 + frow;
            float r = 1.f;
            if (z == 0) { float ss = 0.f;
#pragma unroll
                for (int n = 0; n < 4; ++n) { const f32x4 v = acc[m][n]; ss += (v.x * v.x + v.y * v.y) + (v.z * v.z + v.w * v.w); }
                ss += __shfl_xor(ss, 16); ss += __shfl_xor(ss, 32); r = rsqrtf(ss * (1.f / 64.f) + RMS_EPS); }
            const int bg = rr >> 8, c = rr & 255;
            if (c < NC) {
#pragma unroll
                for (int n = 0; n < 4; ++n) { const int d = n * 16 + fq * 4; f32x4 v = acc[m][n] * r;
                    if (z == 0) { const f32x4 g = *(const f32x4*)(p.g_k + d); v = v * g;
                        u32x2 w; w.x = pk2(v.x, v.y); w.y = pk2(v.z, v.w); *(u32x2*)(dst + ((size_t)bg * 256 + c) * 64 + d) = w; }
                    else { bf16_t* o = dst + ((size_t)bg * 64 + d) * 256 + c; o[0] = f2bf(v.x); o[256] = f2bf(v.y); o[512] = f2bf(v.z); o[768] = f2bf(v.w); } } }
        }
    } };
DEV void phase_cmp_b(const Params& p, unsigned char* lds) {
    const int vb = vblock(), G = gridDim.x;
    for (int u = vb; u < 64; u += G) {
        const int z = u >> 5, rbase = (u & 31) * 128;
        ARows al{(const bf16_t*)(p.ws + WS_HID) + ((size_t)z * 4096 + rbase) * 256, 256};
        BClamp64 bl{(const bf16_t*)(p.ws + WS_CW2T) + (size_t)z * 64 * 256, 256};
        EpiCmpB ep{p, z, rbase};
        gemm_tile(lds, al, bl, 256 / 64, ep);
    }
}

constexpr int CM_K = 0, CM_V = 32768, CM_VSTR = 520, CM_IMP = CM_V + 64 * CM_VSTR, CM_LDS = CM_IMP + 16384;
DEV void cm_scores(const unsigned char* kbase, int kt, const bf16x8 (&qf)[4], int r31, int hh, f32x16 (&sacc)[2]) {
#pragma unroll
    for (int kt2 = 0; kt2 < 2; ++kt2) {
#pragma unroll
        for (int i = 0; i < 16; ++i) sacc[kt2][i] = 0.f;
        const int row = 64 * kt + 32 * kt2 + r31; const int sx = (row >> 1) & 7;
#pragma unroll
        for (int s = 0; s < 4; ++s) { const bf16x8 kf = *(const bf16x8*)(kbase + row * 128 + (((2 * s + hh) ^ sx) << 4));
            sacc[kt2] = __builtin_amdgcn_mfma_f32_32x32x16_bf16(kf, qf[s], sacc[kt2], 0, 0, 0); }
    }
}
DEV void phase_cmp_attn(const Params& p, unsigned char* lds) {
    const int tid = threadIdx.x, lane = tid & 63, wid = tid >> 6;
    const int vb = vblock(), G = gridDim.x;
    unsigned char* ws = p.ws;
    const int r31 = lane & 31, hh = lane >> 5;
    float* impl = (float*)(lds + CM_IMP);
    for (int it = vb; it < 1024; it += G) {
        const int rnd = it / G, pos = it % G; int sidx = (rnd & 1) ? (rnd * G + (G - 1 - pos)) : (rnd * G + pos); if (G != 256) sidx = it;
        const int ci = 63 - (sidx >> 4), bg = sidx & 15, b = bg >> 1, g = bg & 1;
        const int nvis = min(NC, 4 * ci + 3), ntile = (nvis + 63) >> 6;
        const int head = g * 4 + (wid >> 1);
        const int tokl = (wid & 1) * 32 + r31, t = ci * 64 + tokl;
        const size_t tok = (size_t)b * SEQ + t;
        const int nv = t >= 31 ? min(NC, (t - 31) / 16 + 1) : 0;
        __syncthreads();
        {
            const bf16_t* kc = (const bf16_t*)(ws + WS_KCMP) + (size_t)bg * 256 * 64; const bf16_t* vt = (const bf16_t*)(ws + WS_VCMP) + (size_t)bg * 64 * 256;
            const int nch = ntile * 512;
            for (int idx = tid; idx < nch; idx += NT) { const int row = idx >> 3, ch = idx & 7; *(u32x4*)(lds + CM_K + swz(row, ch)) = *(const u32x4*)(kc + row * 64 + ch * 8); }
            const int cpr = ntile * 8;
            for (int idx = tid; idx < nch; idx += NT) { const int d = idx / cpr, ck = idx % cpr; const u32x4 v = *(const u32x4*)(vt + d * 256 + ck * 8);
                u32x2 a, c2; a.x = v.x; a.y = v.y; c2.x = v.z; c2.y = v.w; unsigned char* o = lds + CM_V + d * CM_VSTR + ck * 16; *(u32x2*)o = a; *(u32x2*)(o + 8) = c2; }
#pragma unroll
            for (int i = 0; i < 8; ++i) impl[tid + NT * i] = 0.f;
        }
        bf16x8 qf[4];
        { const bf16_t* qp = (const bf16_t*)(ws + WS_Q) + ((size_t)(b * 8 + head) * SEQ + t) * 64 + 8 * hh;
#pragma unroll
            for (int s = 0; s < 4; ++s) qf[s] = *(const bf16x8*)(qp + 16 * s); }
        __syncthreads();
        float m_run = -1e30f, l_run = 0.f;
        for (int kt = 0; kt < ntile; ++kt) {
            f32x16 sacc[2];
            cm_scores(lds + CM_K, kt, qf, r31, hh, sacc);
            float mx = -1e30f;
#pragma unroll
            for (int kt2 = 0; kt2 < 2; ++kt2)
#pragma unroll
                for (int i = 0; i < 16; ++i) { const int c = 64 * kt + 32 * kt2 + (i & 3) + 8 * (i >> 2) + 4 * hh; const float v = (c < nv) ? sacc[kt2][i] : -1e30f; sacc[kt2][i] = v; mx = fmaxf(mx, v); }
            const float m_new = fmaxf(m_run, mx); float rs = 0.f;
#pragma unroll
            for (int kt2 = 0; kt2 < 2; ++kt2)
#pragma unroll
                for (int i = 0; i < 16; ++i) { const float v = sacc[kt2][i]; rs += (v > -5e29f) ? exp2f(v - m_new) : 0.f; }
            l_run = l_run * exp2f(m_run - m_new) + rs; m_run = m_new;
        }
        float M, invL;
        { const float mo = __shfl_xor(m_run, 32), lo = __shfl_xor(l_run, 32); M = fmaxf(m_run, mo); const float L = l_run * exp2f(m_run - M) + lo * exp2f(mo - M); invL = L > 0.f ? 1.f / L : 0.f; }
        f32x16 ot[2];
#pragma unroll
        for (int dt = 0; dt < 2; ++dt)
#pragma unroll
            for (int i = 0; i < 16; ++i) ot[dt][i] = 0.f;
        float own[32], spl[32];
#pragma unroll
        for (int i = 0; i < 32; ++i) { own[i] = 0.f; spl[i] = 0.f; }
#pragma unroll
        for (int kt = 0; kt < 4; ++kt) if (kt < ntile) {
            f32x16 sacc[2];
            cm_scores(lds + CM_K, kt, qf, r31, hh, sacc);
#pragma unroll
            for (int kt2 = 0; kt2 < 2; ++kt2)
#pragma unroll
                for (int i = 0; i < 16; ++i) { const int c = 64 * kt + 32 * kt2 + (i & 3) + 8 * (i >> 2) + 4 * hh; sacc[kt2][i] = (c < nv) ? exp2f(sacc[kt2][i] - M) : 0.f; }
#pragma unroll
            for (int kt2 = 0; kt2 < 2; ++kt2)
#pragma unroll
                for (int g4 = 0; g4 < 4; ++g4) { const int Gi = 8 * kt + 4 * kt2 + g4; const float e3 = 0.5f * sacc[kt2][4 * g4 + 3];
                    own[Gi] = ((sacc[kt2][4 * g4] + sacc[kt2][4 * g4 + 1]) + (sacc[kt2][4 * g4 + 2] + e3)) * invL; spl[Gi] = e3 * invL; }
#pragma unroll
            for (int kt2 = 0; kt2 < 2; ++kt2)
#pragma unroll
                for (int s2 = 0; s2 < 2; ++s2) {
                    bf16x8 pf; { u32x4 w; w.x = pk2(sacc[kt2][8 * s2 + 0], sacc[kt2][8 * s2 + 1]); w.y = pk2(sacc[kt2][8 * s2 + 2], sacc[kt2][8 * s2 + 3]);
                        w.z = pk2(sacc[kt2][8 * s2 + 4], sacc[kt2][8 * s2 + 5]); w.w = pk2(sacc[kt2][8 * s2 + 6], sacc[kt2][8 * s2 + 7]); pf = __builtin_bit_cast(bf16x8, w); }
#pragma unroll
                    for (int dt = 0; dt < 2; ++dt) {
                        const unsigned char* va = lds + CM_V + (32 * dt + r31) * CM_VSTR + (64 * kt + 32 * kt2 + 16 * s2 + 4 * hh) * 2;
                        const u32x2 lo = *(const u32x2*)(va), hi = *(const u32x2*)(va + 16);
                        u32x4 w; w.x = lo.x; w.y = lo.y; w.z = hi.x; w.w = hi.y;
                        ot[dt] = __builtin_amdgcn_mfma_f32_32x32x16_bf16(__builtin_bit_cast(bf16x8, w), pf, ot[dt], 0, 0, 0);
                    }
                }
        }
        {
            const float sc = ((const float*)(ws + WS_GATES))[tok * 24 + head * 3 + 0] * invL;
            bf16_t* ocp = (bf16_t*)(ws + WS_OC) + tok * 512 + head * 64;
#pragma unroll
            for (int dt = 0; dt < 2; ++dt)
#pragma unroll
                for (int g4 = 0; g4 < 4; ++g4) { const int d0 = 32 * dt + 8 * g4 + 4 * hh;
                    u32x2 w; w.x = pk2(ot[dt][4 * g4 + 0] * sc, ot[dt][4 * g4 + 1] * sc); w.y = pk2(ot[dt][4 * g4 + 2] * sc, ot[dt][4 * g4 + 3] * sc); *(u32x2*)(ocp + d0) = w; }
        }
        {
            float tot[32];
#pragma unroll
            for (int Gi = 0; Gi < 32; ++Gi) { const float os = __shfl_xor(spl[Gi], 32); const float op = (Gi > 0) ? __shfl_xor(spl[Gi > 0 ? Gi - 1 : 0], 32) : 0.f; tot[Gi] = own[Gi] + (hh ? os : op); }
            for (int r = 0; r < 4; ++r) {
                if ((wid >> 1) == r) {
#pragma unroll
                    for (int Gi = 0; Gi < 32; ++Gi) if (Gi < 8 * ntile) impl[tokl * 64 + 2 * Gi + hh] += tot[Gi];
                }
                __syncthreads();
            }
        }
        for (int tt = 0; tt < 8; ++tt) {
            const int tl = wid * 8 + tt, cur = ci;
            const float imp = impl[tl * 64 + lane];
            const float INF = __builtin_inff();
            const float v = (lane == 0 || lane == cur) ? INF : (lane < cur ? imp : -INF);
            int rank = 0;
            for (int i = 0; i <= cur; ++i) { const float vi = __uint_as_float(__builtin_amdgcn_readlane(__float_as_uint(v), i)); rank += ((vi > v) || (vi == v && i < lane)) ? 1 : 0; }
            const bool sel = (lane <= cur) && (rank < 16);
            const unsigned long long mask = __ballot(sel);
            if (lane == 0) ((unsigned long long*)(ws + WS_SELM))[(size_t)bg * SEQ + ci * 64 + tl] = mask;
        }
    }
}

constexpr int FA_KB = 64 * 128, FA_VB = 64 * 136, FA_STAGE = FA_KB + FA_VB, FA_LDS = 2 * FA_STAGE + 1024;
template <bool SEL>
DEV void fa_branch(unsigned char* lds, const bf16_t* Kb, const bf16_t* VTb, int ci, int bg, const bf16x8 (&qf)[4], int t, unsigned long long mymask, unsigned long long need,
                   f32x16 (&ot)[2], float& m_run, float& l_run) {
    const int tid = threadIdx.x, lane = tid & 63;
    const int r31 = lane & 31, hh = lane >> 5;
    const int lrow = tid >> 3, lch = tid & 7;
    const bf16_t* kg = Kb + ((size_t)bg * SEQ + lrow) * 64 + lch * 8;
    const bf16_t* vg = VTb + ((size_t)bg * 64 + lrow) * SEQ + lch * 8;
    const int koff = lrow * 128 + ((lch ^ ((lrow >> 1) & 7)) << 4), voff = FA_KB + lrow * 136 + lch * 16;
    int jlo, jhi; unsigned long long todo;
    if (SEL) { todo = need; jlo = 0; jhi = ci; } else { jlo = ci >= 8 ? ci - 8 : 0; jhi = ci; todo = 0; }
    int j = jlo;
    if (SEL) { if (todo == 0) return; j = __builtin_ctzll(todo); todo &= todo - 1; }
    u32x4 rk = *(const u32x4*)(kg + (size_t)j * 64 * 64), rv = *(const u32x4*)(vg + (size_t)j * 64);
    __syncthreads();
    *(u32x4*)(lds + koff) = rk; { u32x2 a, b2; a.x = rv.x; a.y = rv.y; b2.x = rv.z; b2.y = rv.w; *(u32x2*)(lds + voff) = a; *(u32x2*)(lds + voff + 8) = b2; }
    __syncthreads();
    int st = 0;
    for (;;) {
        int jn; bool more;
        if (SEL) { more = (todo != 0); jn = more ? __builtin_ctzll(todo) : 0; todo &= todo - 1; } else { jn = j + 1; more = (jn <= jhi); }
        if (more) { rk = *(const u32x4*)(kg + (size_t)jn * 64 * 64); rv = *(const u32x4*)(vg + (size_t)jn * 64); }
        const unsigned char* base = lds + st * FA_STAGE;
        f32x16 sacc[2];
#pragma unroll
        for (int kt2 = 0; kt2 < 2; ++kt2) {
#pragma unroll
            for (int i = 0; i < 16; ++i) sacc[kt2][i] = 0.f;
            const int row = 32 * kt2 + r31; const int sx = (row >> 1) & 7;
#pragma unroll
            for (int s = 0; s < 4; ++s) { const bf16x8 kf = *(const bf16x8*)(base + row * 128 + (((2 * s + hh) ^ sx) << 4));
                sacc[kt2] = __builtin_amdgcn_mfma_f32_32x32x16_bf16(kf, qf[s], sacc[kt2], 0, 0, 0); }
        }
        const bool bit = SEL ? ((mymask >> j) & 1ull) != 0 : true;
        float mx = -1e30f;
#pragma unroll
        for (int kt2 = 0; kt2 < 2; ++kt2)
#pragma unroll
            for (int i = 0; i < 16; ++i) { const int key = 64 * j + 32 * kt2 + (i & 3) + 8 * (i >> 2) + 4 * hh;
                const bool ok = SEL ? (bit && key <= t) : (key <= t && t - key < 512);
                const float v = ok ? sacc[kt2][i] : -1e30f; sacc[kt2][i] = v; mx = fmaxf(mx, v); }
        mx = fmaxf(mx, __shfl_xor(mx, 32));
        const float m_new = fmaxf(m_run, mx);
        const float alpha = exp2f(m_run - m_new);
        m_run = m_new;
        float rs = 0.f;
#pragma unroll
        for (int kt2 = 0; kt2 < 2; ++kt2)
#pragma unroll
            for (int i = 0; i < 16; ++i) { const float v = sacc[kt2][i]; const float e = (v > -5e29f) ? exp2f(v - m_new) : 0.f; sacc[kt2][i] = e; rs += e; }
        l_run = l_run * alpha + rs;
#pragma unroll
        for (int dt = 0; dt < 2; ++dt)
#pragma unroll
            for (int i = 0; i < 16; ++i) ot[dt][i] *= alpha;
#pragma unroll
        for (int kt2 = 0; kt2 < 2; ++kt2)
#pragma unroll
            for (int s2 = 0; s2 < 2; ++s2) {
                bf16x8 pf; { u32x4 w; w.x = pk2(sacc[kt2][8 * s2 + 0], sacc[kt2][8 * s2 + 1]); w.y = pk2(sacc[kt2][8 * s2 + 2], sacc[kt2][8 * s2 + 3]);
                    w.z = pk2(sacc[kt2][8 * s2 + 4], sacc[kt2][8 * s2 + 5]); w.w = pk2(sacc[kt2][8 * s2 + 6], sacc[kt2][8 * s2 + 7]); pf = __builtin_bit_cast(bf16x8, w); }
#pragma unroll
                for (int dt = 0; dt < 2; ++dt) {
                    const unsigned char* va = base + FA_KB + (32 * dt + r31) * 136 + (32 * kt2 + 16 * s2 + 4 * hh) * 2;
                    const u32x2 lo = *(const u32x2*)(va), hi = *(const u32x2*)(va + 16);
                    u32x4 w; w.x = lo.x; w.y = lo.y; w.z = hi.x; w.w = hi.y;
                    ot[dt] = __builtin_amdgcn_mfma_f32_32x32x16_bf16(__builtin_bit_cast(bf16x8, w), pf, ot[dt], 0, 0, 0);
                }
            }
        if (!more) break;
        { unsigned char* nb = lds + (st ^ 1) * FA_STAGE; *(u32x4*)(nb + koff) = rk; u32x2 a, b2; a.x = rv.x; a.y = rv.y; b2.x = rv.z; b2.y = rv.w; *(u32x2*)(nb + voff) = a; *(u32x2*)(nb + voff + 8) = b2; }
        __syncthreads();
        st ^= 1; j = jn;
    }
}
DEV void phase_flash(const Params& p, unsigned char* lds) {
    const int tid = threadIdx.x, lane = tid & 63, wid = tid >> 6;
    const int vb = vblock(), G = gridDim.x;
    unsigned char* ws = p.ws;
    const int r31 = lane & 31, hh = lane >> 5;
    unsigned long long* red = (unsigned long long*)(lds + 2 * FA_STAGE);
    for (int it = vb; it < 1024; it += G) {
        const int rnd = it / G, pos = it % G; int sidx = (rnd & 1) ? (rnd * G + (G - 1 - pos)) : (rnd * G + pos); if (G != 256) sidx = it;
        const int ci = 63 - (sidx >> 4), bg = sidx & 15, b = bg >> 1, g = bg & 1;
        const int head = g * 4 + (wid >> 1);
        const int t = ci * 64 + (wid & 1) * 32 + r31;
        const size_t tok = (size_t)b * SEQ + t;
        bf16x8 qf[4];
        { const bf16_t* qp = (const bf16_t*)(ws + WS_Q) + ((size_t)(b * 8 + head) * SEQ + t) * 64 + 8 * hh;
#pragma unroll
            for (int s = 0; s < 4; ++s) qf[s] = *(const bf16x8*)(qp + 16 * s); }
        const unsigned long long mymask = ((const unsigned long long*)(ws + WS_SELM))[(size_t)bg * SEQ + t];
        unsigned long long orm = mymask;
#pragma unroll
        for (int o = 1; o < 32; o <<= 1) { const unsigned lo = __shfl_xor((unsigned)orm, o), hi = __shfl_xor((unsigned)(orm >> 32), o); orm |= ((unsigned long long)hi << 32) | lo; }
        __syncthreads();
        if (wid < 2 && lane == 0) red[wid] = orm;
        __syncthreads();
        const unsigned long long need = red[0] | red[1];
        f32x16 oc[2];
        {
            f32x16 ot[2]; float m_run = -1e30f, l_run = 0.f;
#pragma unroll
            for (int dt = 0; dt < 2; ++dt)
#pragma unroll
                for (int i = 0; i < 16; ++i) ot[dt][i] = 0.f;
            fa_branch<true>(lds, (const bf16_t*)(ws + WS_KS), (const bf16_t*)(ws + WS_VST), ci, bg, qf, t, mymask, need, ot, m_run, l_run);
            const float lt = l_run + __shfl_xor(l_run, 32);
            const float sc = ((const float*)(ws + WS_GATES))[tok * 24 + head * 3 + 1] / lt;
#pragma unroll
            for (int dt = 0; dt < 2; ++dt)
#pragma unroll
                for (int i = 0; i < 16; ++i) oc[dt][i] = ot[dt][i] * sc;
        }
        {
            f32x16 ot[2]; float m_run = -1e30f, l_run = 0.f;
#pragma unroll
            for (int dt = 0; dt < 2; ++dt)
#pragma unroll
                for (int i = 0; i < 16; ++i) ot[dt][i] = 0.f;
            fa_branch<false>(lds, (const bf16_t*)(ws + WS_KW), (const bf16_t*)(ws + WS_VWT), ci, bg, qf, t, 0ull, 0ull, ot, m_run, l_run);
            const float lt = l_run + __shfl_xor(l_run, 32);
            const float sc = ((const float*)(ws + WS_GATES))[tok * 24 + head * 3 + 2] / lt;
#pragma unroll
            for (int dt = 0; dt < 2; ++dt)
#pragma unroll
                for (int i = 0; i < 16; ++i) oc[dt][i] += ot[dt][i] * sc;
        }
        {
            const bf16_t* ocp = (const bf16_t*)(ws + WS_OC) + tok * 512 + head * 64;
            bf16_t* mix = (bf16_t*)(ws + WS_R1) + tok * 1024 + head * 64;
            float ss = 0.f;
#pragma unroll
            for (int dt = 0; dt < 2; ++dt)
#pragma unroll
                for (int g4 = 0; g4 < 4; ++g4) { const int d0 = 32 * dt + 8 * g4 + 4 * hh; const u32x2 c = *(const u32x2*)(ocp + d0);
                    const float v0 = oc[dt][4 * g4 + 0] + bflo(c.x), v1 = oc[dt][4 * g4 + 1] + bfhi(c.x), v2 = oc[dt][4 * g4 + 2] + bflo(c.y), v3 = oc[dt][4 * g4 + 3] + bfhi(c.y);
                    ss += (v0 * v0 + v1 * v1) + (v2 * v2 + v3 * v3);
                    u32x2 w; w.x = pk2(v0, v1); w.y = pk2(v2, v3); *(u32x2*)(mix + d0) = w; }
            ss += __shfl_xor(ss, 32);
            if (hh == 0) atomicAdd((float*)(ws + WS_ROWSS) + tok, ss);
        }
    }
}

DEV int swz256(int row, int chunk) { return row * 256 + ((chunk ^ (row & 15)) << 4); }
DEV void hgrn_cumsum(const Params& p, int bh, int c, float* segs, f32x2 (&lf)[8], f32x2 (&a)[8], f32x2& r, f32x2& alast) {
    const int tid = threadIdx.x, k2 = tid & 63, tq = tid >> 6;
    const int b = bh >> 2, h = bh & 3;
    const float* HL = (const float*)(p.ws + WS_HLOGF) + ((size_t)b * SEQ + c * 64 + tq * 8) * 512 + h * 128 + 2 * k2;
#pragma unroll
    for (int i = 0; i < 8; ++i) lf[i] = *(const f32x2*)(HL + (size_t)i * 512);
    f32x2 run = (f32x2){0.f, 0.f};
#pragma unroll
    for (int i = 0; i < 8; ++i) { run = run + lf[i]; a[i] = run; }
    *(f32x2*)(segs + tq * 128 + 2 * k2) = run;
    __syncthreads();
    f32x2 off = (f32x2){0.f, 0.f}, tot = off, rr = off;
#pragma unroll
    for (int q = 0; q < 8; ++q) { const f32x2 s = *(const f32x2*)(segs + q * 128 + 2 * k2); if (q < tq) off = off + s; if (q < 4) rr = rr + s; tot = tot + s; }
#pragma unroll
    for (int i = 0; i < 8; ++i) a[i] = a[i] + off;
    r = rr; alast = tot;
}
DEV void hgrn_stage_vt(const Params& p, int bh, int c, unsigned char* vt) {
    const int tid = threadIdx.x, k2 = tid & 63, tq = tid >> 6;
    const int b = bh >> 2, h = bh & 3;
    const bf16_t* HV = (const bf16_t*)(p.ws + WS_HV) + ((size_t)b * SEQ + c * 64 + tq * 8) * 512 + h * 128 + 2 * k2;
    unsigned vv[8];
#pragma unroll
    for (int i = 0; i < 8; ++i) vv[i] = *(const unsigned*)(HV + (size_t)i * 512);
    u32x4 lo, hi;
    lo.x = (vv[0] & 0xffffu) | (vv[1] << 16); lo.y = (vv[2] & 0xffffu) | (vv[3] << 16); lo.z = (vv[4] & 0xffffu) | (vv[5] << 16); lo.w = (vv[6] & 0xffffu) | (vv[7] << 16);
    hi.x = (vv[0] >> 16) | (vv[1] & 0xffff0000u); hi.y = (vv[2] >> 16) | (vv[3] & 0xffff0000u); hi.z = (vv[4] >> 16) | (vv[5] & 0xffff0000u); hi.w = (vv[6] >> 16) | (vv[7] & 0xffff0000u);
    *(u32x4*)(vt + swz(2 * k2, tq)) = lo; *(u32x4*)(vt + swz(2 * k2 + 1, tq)) = hi;
}
constexpr int H1_KT = 0, H1_VT = 16384, H1_SEG = 32768, H1_EK = H1_SEG + 4096;
DEV void phase_hgrn_a1(const Params& p, unsigned char* lds) {
    const int tid = threadIdx.x, lane = tid & 63, wid = tid >> 6, k2 = tid & 63, tq = tid >> 6;
    const int vb = vblock(), G = gridDim.x;
    const int frow = lane & 15, fq = lane >> 4, wr = wid >> 1, wc = wid & 1;
    float* segs = (float*)(lds + H1_SEG); float* ek = (float*)(lds + H1_EK);
    bf16_t* ubuf = (bf16_t*)(p.ws + WS_UBUF); float* dbuf = (float*)(p.ws + WS_DBUF);
    for (int item = vb; item < 2048; item += G) {
        const int bh = item >> 6, c = item & 63;
        __syncthreads();
        f32x2 lf[8], a[8], r, al;
        hgrn_cumsum(p, bh, c, segs, lf, a, r, al);
        {
            float kx[8], ky[8];
#pragma unroll
            for (int i = 0; i < 8; ++i) { kx[i] = (1.f - __expf(lf[i].x)) * __expf(fminf(r.x - a[i].x, 80.f)); ky[i] = (1.f - __expf(lf[i].y)) * __expf(fminf(r.y - a[i].y, 80.f)); }
            u32x4 w0, w1;
            w0.x = pk2(kx[0], kx[1]); w0.y = pk2(kx[2], kx[3]); w0.z = pk2(kx[4], kx[5]); w0.w = pk2(kx[6], kx[7]);
            w1.x = pk2(ky[0], ky[1]); w1.y = pk2(ky[2], ky[3]); w1.z = pk2(ky[4], ky[5]); w1.w = pk2(ky[6], ky[7]);
            *(u32x4*)(lds + H1_KT + swz(2 * k2, tq)) = w0; *(u32x4*)(lds + H1_KT + swz(2 * k2 + 1, tq)) = w1;
        }
        hgrn_stage_vt(p, bh, c, lds + H1_VT);
        if (tq == 7) { ek[2 * k2] = __expf(al.x - r.x); ek[2 * k2 + 1] = __expf(al.y - r.y); f32x2 d; d.x = __expf(al.x); d.y = __expf(al.y); *(f32x2*)(dbuf + (size_t)item * 128 + 2 * k2) = d; }
        __syncthreads();
        f32x4 acc[2][4];
#pragma unroll
        for (int m = 0; m < 2; ++m)
#pragma unroll
            for (int n = 0; n < 4; ++n) acc[m][n] = (f32x4){0.f, 0.f, 0.f, 0.f};
        const int sx = (frow >> 1) & 7;
#pragma unroll
        for (int ks = 0; ks < 2; ++ks) {
            const int co = ((ks * 4 + fq) ^ sx) << 4;
            bf16x8 af[2], bfr[4];
#pragma unroll
            for (int m = 0; m < 2; ++m) af[m] = *(const bf16x8*)(lds + H1_VT + (32 * wr + 16 * m + frow) * 128 + co);
#pragma unroll
            for (int n = 0; n < 4; ++n) bfr[n] = *(const bf16x8*)(lds + H1_KT + (64 * wc + 16 * n + frow) * 128 + co);
#pragma unroll
            for (int m = 0; m < 2; ++m)
#pragma unroll
                for (int n = 0; n < 4; ++n) acc[m][n] = __builtin_amdgcn_mfma_f32_16x16x32_bf16(bfr[n], af[m], acc[m][n], 0, 0, 0);
        }
#pragma unroll
        for (int m = 0; m < 2; ++m) { const int v = 32 * wr + 16 * m + frow;
#pragma unroll
            for (int n = 0; n < 4; ++n) { const int k0 = 64 * wc + 16 * n + 4 * fq; const f32x4 e = *(const f32x4*)(ek + k0); const f32x4 o = acc[m][n] * e;
                u32x2 w; w.x = pk2(o.x, o.y); w.y = pk2(o.z, o.w); *(u32x2*)(ubuf + ((size_t)item * 128 + v) * 128 + k0) = w; } }
    }
}
DEV void phase_hgrn_a2(const Params& p, unsigned char* lds) {
    const int G = gridDim.x;
    bf16_t* ubuf = (bf16_t*)(p.ws + WS_UBUF); const float* dbuf = (const float*)(p.ws + WS_DBUF);
    for (int gid = blockIdx.x * NT + threadIdx.x; gid < 131072; gid += G * NT) {
        const int bh = gid >> 12, v = (gid >> 5) & 127, k4 = gid & 31;
        bf16_t* u = ubuf + ((size_t)bh * 64 * 128 + v) * 128 + 4 * k4;
        const float* d = dbuf + (size_t)bh * 64 * 128 + 4 * k4;
        f32x4 S = (f32x4){0.f, 0.f, 0.f, 0.f};
        for (int c0 = 0; c0 < 64; c0 += 8) {
            u32x2 uu[8]; f32x4 dd[8];
#pragma unroll
            for (int j = 0; j < 8; ++j) { uu[j] = *(const u32x2*)(u + (size_t)(c0 + j) * 16384); dd[j] = *(const f32x4*)(d + (size_t)(c0 + j) * 128); }
#pragma unroll
            for (int j = 0; j < 8; ++j) { u32x2 w; w.x = pk2(S.x, S.y); w.y = pk2(S.z, S.w); *(u32x2*)(u + (size_t)(c0 + j) * 16384) = w;
                S.x = dd[j].x * S.x + bflo(uu[j].x); S.y = dd[j].y * S.y + bfhi(uu[j].x); S.z = dd[j].z * S.z + bflo(uu[j].y); S.w = dd[j].w * S.w + bfhi(uu[j].y); }
        }
    }
}
constexpr int H3_QH = 0, H3_QA = 16384, H3_KH = 32768, H3_VT = 49152, H3_PP = 65536, H3_ST = 73728, H3_SEG = 106496, H3_RED = 110592;
DEV void phase_hgrn_a3(const Params& p, unsigned char* lds) {
    const int tid = threadIdx.x, lane = tid & 63, wid = tid >> 6, k2 = tid & 63, tq = tid >> 6;
    const int vb = vblock(), G = gridDim.x;
    const int frow = lane & 15, fq = lane >> 4;
    float* segs = (float*)(lds + H3_SEG); float* red = (float*)(lds + H3_RED);
    const bf16_t* ubuf = (const bf16_t*)(p.ws + WS_UBUF);
    for (int item = vb; item < 2048; item += G) {
        const int bh = item >> 6, c = item & 63, b = bh >> 2, h = bh & 3;
        __syncthreads();
        f32x2 lf[8], a[8], r, al;
        hgrn_cumsum(p, bh, c, segs, lf, a, r, al);
        {
            const bf16_t* HQ = (const bf16_t*)(p.ws + WS_HQ) + ((size_t)b * SEQ + c * 64 + tq * 8) * 512 + h * 128 + 2 * k2;
            unsigned qq[8];
#pragma unroll
            for (int i = 0; i < 8; ++i) qq[i] = *(const unsigned*)(HQ + (size_t)i * 512);
#pragma unroll
            for (int i = 0; i < 8; ++i) { const int t = 8 * tq + i; const float q0 = bflo(qq[i]), q1 = bfhi(qq[i]);
                const int off = swz256(t, k2 >> 2) + (k2 & 3) * 4;
                *(unsigned*)(lds + H3_QH + off) = pk2(q0 * __expf(fminf(a[i].x - r.x, 80.f)), q1 * __expf(fminf(a[i].y - r.y, 80.f)));
                *(unsigned*)(lds + H3_QA + off) = pk2(q0 * __expf(a[i].x), q1 * __expf(a[i].y));
                *(unsigned*)(lds + H3_KH + off) = pk2((1.f - __expf(lf[i].x)) * __expf(fminf(r.x - a[i].x, 80.f)), (1.f - __expf(lf[i].y)) * __expf(fminf(r.y - a[i].y, 80.f))); }
        }
        hgrn_stage_vt(p, bh, c, lds + H3_VT);
        {
            const bf16_t* st = ubuf + (size_t)item * 16384;
#pragma unroll
            for (int i = 0; i < 4; ++i) { const int q = tid + NT * i, v = q >> 4, ch = q & 15; *(u32x4*)(lds + H3_ST + swz256(v, ch)) = *(const u32x4*)(st + v * 128 + ch * 8); }
        }
        __syncthreads();
        {
            const int wr = wid >> 1, wc = wid & 1;
            f32x4 acc[2];
            acc[0] = (f32x4){0.f, 0.f, 0.f, 0.f}; acc[1] = acc[0];
            if (32 * wc <= 16 * wr + 15) {
#pragma unroll
                for (int ks = 0; ks < 4; ++ks) {
                    const int co = ((ks * 4 + fq) ^ frow) << 4;
                    const bf16x8 af = *(const bf16x8*)(lds + H3_QH + (16 * wr + frow) * 256 + co);
#pragma unroll
                    for (int n = 0; n < 2; ++n) { const bf16x8 bfr = *(const bf16x8*)(lds + H3_KH + (32 * wc + 16 * n + frow) * 256 + co);
                        acc[n] = __builtin_amdgcn_mfma_f32_16x16x32_bf16(bfr, af, acc[n], 0, 0, 0); }
                }
            }
            const int t = 16 * wr + frow;
#pragma unroll
            for (int n = 0; n < 2; ++n) { const int s0 = 32 * wc + 16 * n + 4 * fq; f32x4 v = acc[n];
                v.x = (s0 + 0 <= t) ? v.x : 0.f; v.y = (s0 + 1 <= t) ? v.y : 0.f; v.z = (s0 + 2 <= t) ? v.z : 0.f; v.w = (s0 + 3 <= t) ? v.w : 0.f;
                u32x2 w; w.x = pk2(v.x, v.y); w.y = pk2(v.z, v.w);
                *(u32x2*)(lds + H3_PP + t * 128 + ((((s0 >> 3)) ^ ((t >> 1) & 7)) << 4) + (s0 & 7) * 2) = w; }
        }
        __syncthreads();
        {
            const int wr = wid >> 2, wc = wid & 3;
            f32x4 acc[2][2];
#pragma unroll
            for (int m = 0; m < 2; ++m)
#pragma unroll
                for (int n = 0; n < 2; ++n) acc[m][n] = (f32x4){0.f, 0.f, 0.f, 0.f};
            const int sx = (frow >> 1) & 7;
#pragma unroll
            for (int ks = 0; ks < 2; ++ks) {
                const int co = ((ks * 4 + fq) ^ sx) << 4;
                bf16x8 af[2], bfr[2];
#pragma unroll
                for (int m = 0; m < 2; ++m) af[m] = *(const bf16x8*)(lds + H3_PP + (32 * wr + 16 * m + frow) * 128 + co);
#pragma unroll
                for (int n = 0; n < 2; ++n) bfr[n] = *(const bf16x8*)(lds + H3_VT + (32 * wc + 16 * n + frow) * 128 + co);
#pragma unroll
                for (int m = 0; m < 2; ++m)
#pragma unroll
                    for (int n = 0; n < 2; ++n) acc[m][n] = __builtin_amdgcn_mfma_f32_16x16x32_bf16(bfr[n], af[m], acc[m][n], 0, 0, 0);
            }
#pragma unroll
            for (int ks = 0; ks < 4; ++ks) {
                const int co = ((ks * 4 + fq) ^ frow) << 4;
                bf16x8 af[2], bfr[2];
#pragma unroll
                for (int m = 0; m < 2; ++m) af[m] = *(const bf16x8*)(lds + H3_QA + (32 * wr + 16 * m + frow) * 256 + co);
#pragma unroll
                for (int n = 0; n < 2; ++n) bfr[n] = *(const bf16x8*)(lds + H3_ST + (32 * wc + 16 * n + frow) * 256 + co);
#pragma unroll
                for (int m = 0; m < 2; ++m)
#pragma unroll
                    for (int n = 0; n < 2; ++n) acc[m][n] = __builtin_amdgcn_mfma_f32_16x16x32_bf16(bfr[n], af[m], acc[m][n], 0, 0, 0);
            }
#pragma unroll
            for (int m = 0; m < 2; ++m) { float ss = 0.f;
#pragma unroll
                for (int n = 0; n < 2; ++n) { const f32x4 v = acc[m][n]; ss += (v.x * v.x + v.y * v.y) + (v.z * v.z + v.w * v.w); }
                ss += __shfl_xor(ss, 16); ss += __shfl_xor(ss, 32);
                if (fq == 0) red[(32 * wr + 16 * m + frow) * 4 + wc] = ss; }
            __syncthreads();
#pragma unroll
            for (int m = 0; m < 2; ++m) { const int t = 32 * wr + 16 * m + frow; const f32x4 q4 = *(const f32x4*)(red + t * 4);
                const float rs = rsqrtf(((q4.x + q4.y) + (q4.z + q4.w)) * (1.f / 128.f) + RMS_EPS);
                const size_t row = (size_t)b * SEQ + c * 64 + t;
#pragma unroll
                for (int n = 0; n < 2; ++n) { const int v0 = 32 * wc + 16 * n + 4 * fq; const f32x4 gn = *(const f32x4*)(p.g_hn + v0);
                    const u32x2 gg = *(const u32x2*)((const bf16_t*)(p.ws + WS_HG) + row * 512 + h * 128 + v0);
                    const f32x4 o = acc[m][n];
                    u32x2 w; w.x = pk2(o.x * rs * gn.x * bflo(gg.x), o.y * rs * gn.y * bfhi(gg.x)); w.y = pk2(o.z * rs * gn.z * bflo(gg.y), o.w * rs * gn.w * bfhi(gg.y));
                    *(u32x2*)((bf16_t*)(p.ws + WS_R1) + row * 1024 + 512 + h * 128 + v0) = w; } }
        }
    }
}

DEV void phase_normalize(const Params& p, unsigned char* lds) {
    const int tid = threadIdx.x, lane = tid & 63, wid = tid >> 6;
    const int vb = vblock(), G = gridDim.x;
    unsigned char* ws = p.ws;
    bf16_t* mix = (bf16_t*)(ws + WS_R1); const float* rowss = (const float*)(ws + WS_ROWSS); const bf16_t* HG = (const bf16_t*)(ws + WS_HG);
    for (int m = vb * 8 + wid; m < NTOK; m += G * 8) {
        {
            const float r = rsqrtf(rowss[m] * (1.f / 512.f) + RMS_EPS);
            u32x4* pp = (u32x4*)(mix + (size_t)m * 1024) + lane; u32x4 v = *pp;
            v.x = pk2(bflo(v.x) * r, bfhi(v.x) * r); v.y = pk2(bflo(v.y) * r, bfhi(v.y) * r); v.z = pk2(bflo(v.z) * r, bfhi(v.z) * r); v.w = pk2(bflo(v.w) * r, bfhi(v.w) * r);
            *pp = v;
        }
    }
    __syncthreads();
    {
        float* tl = (float*)lds;
        for (int r = vb; r < 32 * 16 * 16; r += G) { const int e = r / 256, q = r % 256; SrcW13 s{p.w1 + (size_t)e * 1024 * 512, p.w3 + (size_t)e * 1024 * 512, p.ffn_g};
            convert_tile(tl, s, (bf16_t*)(ws + WS_W13T) + (size_t)e * 1024 * 1024, 1024, (q / 16) * 64, (q % 16) * 64); }
    }
}

struct EpiOut8 { const Params& p;
    DEV void operator()(const f32x4 (&acc)[2][2][4][2], const pg8::Unit& u, int wr, int wc, int fr, int fq) const {
#pragma unroll
        for (int ai = 0; ai < 2; ++ai)
#pragma unroll
            for (int m = 0; m < 4; ++m) { const size_t row = (size_t)u.pm * 256 + ai * 128 + wr * 64 + m * 16 + fr;
#pragma unroll
                for (int bj = 0; bj < 2; ++bj)
#pragma unroll
                    for (int n = 0; n < 2; ++n) { const int c = u.pn * 256 + 64 * wc + 32 * bj + 16 * n + 4 * fq; const f32x4 xv = *(const f32x4*)(p.x + row * DM + c); *(f32x4*)(p.out + row * DM + c) = xv + acc[ai][bj][m][n]; } }
    } };
DEV void phase_outproj(const Params& p, unsigned char* lds) {
    pg8::Gemm g{(const bf16_t*)(p.ws + WS_R1), (const bf16_t*)(p.ws + WS_WOUTT), NTOK, DM, DM};
    pg8::StaticOrder S; S.init(NTOK, DM, (int)gridDim.x, (int)blockIdx.x);
    EpiOut8 E{p};
    pg8::gemm_phase((PG8_LAS unsigned char*)lds, g, S, E);
}

constexpr int RT_HS = 0, RT_WS = 128 * 33 * 4, RT_LG = RT_WS + 32 * 36 * 4, RT_RS = RT_LG + 128 * 37 * 4, RT_HIST = RT_RS + 512, RT_BASE = RT_HIST + 512, RT_LDS = RT_BASE + 512;
DEV void phase_router(const Params& p, unsigned char* lds) {
    const int tid = threadIdx.x;
    const int vb = vblock(), G = gridDim.x;
    unsigned char* ws = p.ws;
    float* hs = (float*)(lds + RT_HS); float* wsm = (float*)(lds + RT_WS); float* lg = (float*)(lds + RT_LG); float* rsd = (float*)(lds + RT_RS);
    int* hist = (int*)(lds + RT_HIST); int* basep = (int*)(lds + RT_BASE);
    bf16_t* hb = (bf16_t*)(ws + WS_R1);
    const int tok = tid & 127, cgp = tid >> 7;
    for (int it = vb; it < NTOK / 128; it += G) {
        const size_t row0 = (size_t)it * 128;
        float acc[9]; float ssq[4] = {0.f, 0.f, 0.f, 0.f};
#pragma unroll
        for (int c = 0; c < 9; ++c) acc[c] = 0.f;
        if (tid < 128) hist[tid] = 0;
        for (int kc = 0; kc < 32; ++kc) {
            __syncthreads();
#pragma unroll
            for (int i = 0; i < 4; ++i) { const int idx = tid + NT * i, tk = idx >> 4, kp = idx & 15; const size_t gi = (row0 + tk) * DM + kc * 32 + 2 * kp;
                const f32x2 v = *(const f32x2*)(p.out + gi); hs[tk * 33 + 2 * kp] = v.x; hs[tk * 33 + 2 * kp + 1] = v.y; ssq[i] += v.x * v.x + v.y * v.y; *(unsigned*)(hb + gi) = pk2(v.x, v.y); }
            for (int idx = tid; idx < 32 * 36; idx += NT) { const int kk = idx / 36, c = idx % 36, k = kc * 32 + kk;
                wsm[idx] = (c < 4 ? p.w_group[k * 4 + c] : p.w_expert[k * 32 + (c - 4)]) * p.ffn_g[k]; }
            __syncthreads();
#pragma unroll 8
            for (int kk = 0; kk < 32; ++kk) { const float hv = hs[tok * 33 + kk];
#pragma unroll
                for (int c = 0; c < 9; ++c) acc[c] += hv * wsm[kk * 36 + cgp * 9 + c]; }
        }
#pragma unroll
        for (int i = 0; i < 4; ++i) { float s = ssq[i]; s += __shfl_xor(s, 1); s += __shfl_xor(s, 2); s += __shfl_xor(s, 4); s += __shfl_xor(s, 8);
            if ((tid & 15) == 0) rsd[(tid + NT * i) >> 4] = rsqrtf(s * (1.f / DM) + RMS_EPS); }
#pragma unroll
        for (int c = 0; c < 9; ++c) lg[tok * 37 + cgp * 9 + c] = acc[c];
        __syncthreads();
        int bin = 0, slot = 0;
        if (tid < 128) {
            const float rs = rsd[tid];
            ((float*)(ws + WS_RSTD2))[row0 + tid] = rs;
            float gl[4]; int gi = 0; float gm = -1e30f;
#pragma unroll
            for (int c = 0; c < 4; ++c) { gl[c] = lg[tid * 37 + c] * rs + p.b_group[c]; if (gl[c] > gm) { gm = gl[c]; gi = c; } }
            float gs = 0.f;
#pragma unroll
            for (int c = 0; c < 4; ++c) gs += __expf(gl[c] - gm);
            const float pg = 1.f / gs;
            float el[8]; int i0 = 0; float m0 = -1e30f;
#pragma unroll
            for (int c = 0; c < 8; ++c) { el[c] = lg[tid * 37 + 4 + gi * 8 + c] * rs + p.b_expert[gi * 8 + c]; if (el[c] > m0) { m0 = el[c]; i0 = c; } }
            int i1 = 0; float m1 = -1e30f;
#pragma unroll
            for (int c = 0; c < 8; ++c) if (c != i0 && el[c] > m1) { m1 = el[c]; i1 = c; }
            const float e1 = __expf(m1 - m0); const float w0 = pg / (1.f + e1), w1 = pg * e1 / (1.f + e1);
            const int a = min(i0, i1), bb = max(i0, i1);
            bin = gi * 28 + (7 * a - (a * (a - 1)) / 2) + (bb - a - 1);
            f32x2 tw; tw.x = (i0 < i1) ? w0 : w1; tw.y = (i0 < i1) ? w1 : w0;
            ((f32x2*)(ws + WS_TOKW))[row0 + tid] = tw;
            slot = atomicAdd(&hist[bin], 1);
        }
        __syncthreads();
        if (tid < NBIN) { const int h = hist[tid]; basep[tid] = h ? atomicAdd((int*)(ws + WS_CTL) + tid, h) : 0; }
        __syncthreads();
        if (tid < 128) ((int*)(ws + WS_BINL))[(size_t)bin * BINCAP + basep[bin] + slot] = (int)(row0 + tid);
        __syncthreads();
    }
}

DEV void moe_tiles(const Params& p, int* tstart  ) {
    const int tid = threadIdx.x;
    __syncthreads();
    if (tid == 0) { const int* cnt = (const int*)(p.ws + WS_CTL); int s = 0; for (int i = 0; i < NBIN; ++i) { tstart[i] = s; s += (cnt[i] + 127) >> 7; } tstart[NBIN] = s; }
    __syncthreads();
}
DEV void bin_experts(int bin, int& ea, int& eb) { const int gi = bin / 28; int pi = bin % 28, a = 0; while (pi >= 7 - a) { pi -= 7 - a; ++a; } ea = gi * 8 + a; eb = gi * 8 + a + 1 + pi; }
struct AGather { const bf16_t* hb; const int* list; int n;
    DEV const bf16_t* row(int r) const { const int t = list[r < n ? r : 0]; return hb + (size_t)t * DM; } };
struct EpiMoe1 { const Params& p; const int* list; int n; size_t hrow0; int nt;
    DEV void operator()(f32x4 (&acc)[4][4], int wr, int wc, int lane) const {
        const int frow = lane & 15, fq = lane >> 4;
        bf16_t* hbuf = (bf16_t*)(p.ws + WS_HBUF);
#pragma unroll
        for (int m = 0; m < 4; ++m) { const int r = wr * 64 + m * 16 + frow; if (r >= n) continue;
            const int t = list[r]; const float rs = ((const float*)(p.ws + WS_RSTD2))[t]; const f32x2 tw = ((const f32x2*)(p.ws + WS_TOKW))[t]; const float w = nt < 4 ? tw.x : tw.y;
#pragma unroll
            for (int n2 = 0; n2 < 4; ++n2) { const f32x4 v = acc[m][n2] * rs; const int f = ((nt & 3) * 256 + wc * 64 + n2 * 16 + fq * 4) >> 1;
                *(unsigned*)(hbuf + (hrow0 + r) * 1024 + (nt < 4 ? 0 : 512) + f) = pk2(siluf_(v.x) * v.y * w, siluf_(v.z) * v.w * w); } }
    } };
DEV void phase_moe1(const Params& p, unsigned char* lds) {
    const int vb = vblock(), G = gridDim.x;
    int* tstart = (int*)(lds + G_LDS);
    moe_tiles(p, tstart);
    const int T = tstart[NBIN], U = T * 8;
    for (int u = vb; u < U; u += G) {
        const int tile = u >> 3, nt = u & 7;
        int bin = 0; while (tstart[bin + 1] <= tile) ++bin;
        const int mt = tile - tstart[bin]; int ea, eb; bin_experts(bin, ea, eb);
        const int cnt = ((const int*)(p.ws + WS_CTL))[bin]; const int n = min(128, cnt - mt * 128);
        const int* list = (const int*)(p.ws + WS_BINL) + (size_t)bin * BINCAP + mt * 128;
        AGather al{(const bf16_t*)(p.ws + WS_R1), list, n};
        BRows bl{(const bf16_t*)(p.ws + WS_W13T) + ((size_t)(nt < 4 ? ea : eb) * 1024 + (nt & 3) * 256) * 1024, 1024};
        EpiMoe1 ep{p, list, n, (size_t)tile * 128, nt};
        gemm_tile(lds, al, bl, DM / 64, ep);
    }
}
struct BPair { const bf16_t* wa; const bf16_t* wb; DEV const bf16_t* ptr(int n, int kt) const { return kt < 8 ? wa + (size_t)n * 512 + kt * 64 : wb + (size_t)n * 512 + (kt - 8) * 64; } };
struct EpiMoe2 { const Params& p; const int* list; int n; int n0;
    DEV void operator()(f32x4 (&acc)[4][4], int wr, int wc, int lane) const {
        const int frow = lane & 15, fq = lane >> 4;
#pragma unroll
        for (int m = 0; m < 4; ++m) { const int r = wr * 64 + m * 16 + frow; if (r >= n) continue; const size_t t = list[r];
#pragma unroll
            for (int n2 = 0; n2 < 4; ++n2) { float* o = p.out + t * DM + n0 + wc * 64 + n2 * 16 + fq * 4; *(f32x4*)o = *(const f32x4*)o + acc[m][n2]; } }
    } };
DEV void phase_moe2(const Params& p, unsigned char* lds) {
    const int vb = vblock(), G = gridDim.x;
    int* tstart = (int*)(lds + G_LDS);
    moe_tiles(p, tstart);
    const int T = tstart[NBIN], U = T * 4;
    for (int u = vb; u < U; u += G) {
        const int tile = u >> 2, nt = u & 3;
        int bin = 0; while (tstart[bin + 1] <= tile) ++bin;
        const int mt = tile - tstart[bin]; int ea, eb; bin_experts(bin, ea, eb);
        const int cnt = ((const int*)(p.ws + WS_CTL))[bin]; const int n = min(128, cnt - mt * 128);
        const int* list = (const int*)(p.ws + WS_BINL) + (size_t)bin * BINCAP + mt * 128;
        ARows al{(const bf16_t*)(p.ws + WS_HBUF) + (size_t)tile * 128 * 1024, 1024};
        BPair bl{(const bf16_t*)(p.ws + WS_W2T) + ((size_t)ea * 1024 + nt * 256) * 512, (const bf16_t*)(p.ws + WS_W2T) + ((size_t)eb * 1024 + nt * 256) * 512};
        EpiMoe2 ep{p, list, n, nt * 256};
        gemm_tile(lds, al, bl, 16, ep);
    }
}

#define XB_TMO      128
#define XB_XCNT(j)  (256  + 64 * (j))
#define XB_XSUB(j)  (1280 + 64 * (j))
#define XB_XGEN(j)  (2304 + 64 * (j))
#define XB_TOP      3328
#define XB_TOPGEN   3392
#define XCD_BAR_WORDS 3456
#define XB_SPIN_CAP (1u << 20)
#define LAS __attribute__((address_space(3)))
constexpr size_t WS_BAR = WS_CTL + 4096;
DEV unsigned xb_ld(unsigned* p) { return __hip_atomic_load(p, __ATOMIC_RELAXED, __HIP_MEMORY_SCOPE_AGENT); }
DEV unsigned xb_add(unsigned* p, unsigned v) { return __hip_atomic_fetch_add(p, v, __ATOMIC_RELAXED, __HIP_MEMORY_SCOPE_AGENT); }
DEV unsigned xb_xcc_id() { return (unsigned)__builtin_amdgcn_s_getreg((3 << 11) | 20) & 0xFu; }
#define XB_SPIN(cond, bar) do { unsigned _sp = 0; while (cond) { __builtin_amdgcn_s_sleep(1); \
    if ((++_sp & 255u) == 0u) { if (xb_ld(&(bar)[XB_TMO])) break; if (_sp > XB_SPIN_CAP) { atomicAdd(&(bar)[XB_TMO], 1u); break; } } } } while (0)
struct XcdBarrier { unsigned* bar; unsigned x; volatile LAS unsigned* st; };
DEV XcdBarrier xcd_barrier_post(unsigned* bar, volatile LAS unsigned* st) {
    XcdBarrier b; b.bar = bar; b.x = xb_xcc_id(); b.st = st;
    if (threadIdx.x == 0) (void)xb_add(&bar[XB_XCNT(b.x)], 1u);
    return b;
}
DEV void xcd_barrier_complete(unsigned* bar, unsigned x, unsigned& nloc, unsigned& nx) {
    const unsigned G = gridDim.x * gridDim.y * gridDim.z;
    unsigned sum, cnt, mine, sp = 0u;
    for (;;) {
        sum = 0u; cnt = 0u; mine = 0u;
#pragma unroll
        for (unsigned j = 0; j < 16; ++j) { const unsigned c = xb_ld(&bar[XB_XCNT(j)]); sum += c; cnt += (c > 0u) ? 1u : 0u; mine = (j == x) ? c : mine; }
        if (sum == G) break;
        __builtin_amdgcn_s_sleep(1);
        if ((++sp & 255u) == 0u) { if (xb_ld(&bar[XB_TMO])) break; if (sp > XB_SPIN_CAP) { atomicAdd(&bar[XB_TMO], 1u); break; } }
    }
    nloc = mine > 0u ? mine : 1u; nx = cnt > 0u ? cnt : 1u;
}
DEV void xcd_barrier(const XcdBarrier& b) {
    asm volatile("s_waitcnt vmcnt(0)" ::: "memory");
    __syncthreads();
    if (threadIdx.x == 0) {
        unsigned* bar = b.bar;
        __builtin_amdgcn_s_waitcnt(0);
        unsigned nloc = b.st[0], nx = b.st[1];
        if (nloc == 0u) { xcd_barrier_complete(bar, b.x, nloc, nx); b.st[0] = nloc; b.st[1] = nx; }
        const unsigned old = xb_add(&bar[XB_XSUB(b.x)], 1u);
        const unsigned gen = old / nloc;
        if (old + 1u == (gen + 1u) * nloc) {
            __builtin_amdgcn_fence(__ATOMIC_RELEASE, "agent");
            asm volatile("s_waitcnt vmcnt(0)" ::: "memory");
            const unsigned og = xb_add(&bar[XB_TOP], 1u);
            const unsigned tg = og / nx;
            if (og + 1u == (tg + 1u) * nx) xb_add(&bar[XB_TOPGEN], 1u);
            else XB_SPIN(xb_ld(&bar[XB_TOPGEN]) == tg, bar);
            __builtin_amdgcn_fence(__ATOMIC_ACQUIRE, "agent");
            xb_add(&bar[XB_XGEN(b.x)], 1u);
            asm volatile("s_waitcnt vmcnt(0)" ::: "memory");
        } else {
            XB_SPIN(xb_ld(&bar[XB_XGEN(b.x)]) == gen, bar);
            __builtin_amdgcn_fence(__ATOMIC_ACQUIRE, "agent");
            asm volatile("s_waitcnt vmcnt(0)" ::: "memory");
        }
    }
    __syncthreads();
}

constexpr int LDS_BYTES = 144 * 1024;
constexpr int N_PHASES = 13;
__global__ void __launch_bounds__(NT) mega(Params p, int lo, int hi) {
    extern __shared__ __attribute__((aligned(16))) unsigned char lds[];
    volatile LAS unsigned* xst = (volatile LAS unsigned*)(lds + LDS_BYTES - 16);
    if (threadIdx.x < 4) xst[threadIdx.x] = 0u;
    __syncthreads();
    XcdBarrier xbar; xbar.bar = (unsigned*)(p.ws + WS_BAR); xbar.x = 0; xbar.st = xst;
    if (hi - lo > 1) xbar = xcd_barrier_post((unsigned*)(p.ws + WS_BAR), xst);
#define GRID_SYNC() xcd_barrier(xbar)
#ifndef PROBE_REPEAT
#define PROBE_REPEAT -1
#endif
#define RUN_PHASE(k, call) do { if (lo <= (k) && (k) < hi) { call; \
        if ((k) == PROBE_REPEAT) { GRID_SYNC(); \
            if ((k) == 5) { float* rz = (float*)(p.ws + WS_ROWSS); for (int i = blockIdx.x * NT + threadIdx.x; i < NTOK; i += gridDim.x * NT) rz[i] = 0.f; GRID_SYNC(); } \
            if ((k) == 11) { if (blockIdx.x == 0 && threadIdx.x < 128) ((int*)(p.ws + WS_CTL))[threadIdx.x] = 0; GRID_SYNC(); } \
            call; } \
        if ((k) + 1 < hi) GRID_SYNC(); } } while (0)
    RUN_PHASE(0, phase_prologue(p, lds));
    RUN_PHASE(1, phase_inproj(p, lds));
    RUN_PHASE(2, phase_cmp_a(p, lds));
    RUN_PHASE(3, phase_cmp_b(p, lds));
    RUN_PHASE(4, phase_cmp_attn(p, lds));
    RUN_PHASE(5, phase_flash(p, lds));
    RUN_PHASE(6, phase_hgrn_a1(p, lds));
    RUN_PHASE(7, phase_hgrn_a2(p, lds));
    RUN_PHASE(8, phase_hgrn_a3(p, lds));
    RUN_PHASE(9, phase_normalize(p, lds));
    RUN_PHASE(10, phase_outproj(p, lds));
    RUN_PHASE(11, phase_router(p, lds));
    RUN_PHASE(12, phase_moe1(p, lds));
    RUN_PHASE(13, phase_moe2(p, lds));
#undef RUN_PHASE
}

extern "C" void kernel_launch(void* const* d_in, const int* in_sizes, int n_in, void* d_out, int out_size, void* d_ws, size_t ws_size, hipStream_t stream) {
    static int grid = 0;
    if (grid == 0) {
        int dev = 0, cus = 0, per_cu = 0;
        hipGetDevice(&dev);
        hipDeviceGetAttribute(&cus, hipDeviceAttributeMultiprocessorCount, dev);
        hipFuncSetAttribute((const void*)mega, hipFuncAttributeMaxDynamicSharedMemorySize, LDS_BYTES);
        hipOccupancyMaxActiveBlocksPerMultiprocessor(&per_cu, (const void*)mega, NT, LDS_BYTES);
        if (per_cu < 1) per_cu = 1;
        grid = cus;
        if (ws_size < WS_END) fprintf(stderr, "kernel_launch: workspace too small: %zu < %zu\n", ws_size, (size_t)WS_END);
        fprintf(stderr, "kernel_launch: cus %d per_cu %d grid %d ws %zu\n", cus, per_cu, grid, ws_size);
    }
    Params p{};
    const float** pp = (const float**)&p;
    for (int i = 0; i < 23; ++i) pp[i] = (const float*)d_in[i];
    p.out = (float*)d_out; p.ws = (unsigned char*)d_ws;
#if N_LAUNCH_MODE == 1
    (void)hipMemsetAsync((unsigned char*)d_ws + WS_BAR, 0, XCD_BAR_WORDS * 4, stream);
    int lo = 0, hi = N_PHASES + 1;
    void* args[] = {&p, &lo, &hi};
    hipError_t e = hipLaunchCooperativeKernel((const void*)mega, dim3(grid), dim3(NT), args, LDS_BYTES, stream);
    if (e != hipSuccess) fprintf(stderr, "cooperative launch failed: %s\n", hipGetErrorString(e));
#else
    for (int ph = 0; ph <= N_PHASES; ++ph) hipLaunchKernelGGL(mega, dim3(grid), dim3(NT), LDS_BYTES, stream, p, ph, ph + 1);
#endif
}
```

```cpp
#include <hip/hip_runtime.h>
#include <hip/hip_cooperative_groups.h>
#include <cstdio>
#include <cstdint>
#include <cstring>
namespace cg = cooperative_groups;

#ifndef N_LAUNCH_MODE
#define N_LAUNCH_MODE 1
#endif

#define DEV __device__ __forceinline__
typedef unsigned short bf16_t;
typedef short bf16x8 __attribute__((ext_vector_type(8)));
typedef float f32x4 __attribute__((ext_vector_type(4)));
typedef float f32x2 __attribute__((ext_vector_type(2)));
typedef float f32x16 __attribute__((ext_vector_type(16)));
typedef unsigned u32x4 __attribute__((ext_vector_type(4)));
typedef unsigned u32x2 __attribute__((ext_vector_type(2)));

constexpr int NT = 512;
constexpr int BATCH = 8, SEQ = 4096, DM = 1024, NTOK = BATCH * SEQ;
constexpr int IN_COLS = 3352, INP = 3584;
constexpr int NC = 255;
constexpr float RMS_EPS = 1e-6f;
constexpr float QSCALE = 0.125f * 1.4426950408889634f;
constexpr int NBIN = 112;
constexpr int BINCAP = NTOK;

constexpr size_t MiB = 1ull << 20;
constexpr size_t WS_CTL    = 0;
constexpr size_t WS_RSTD1  = 1 * MiB;
constexpr size_t WS_RSTD2  = WS_RSTD1 + 128 * 1024;
constexpr size_t WS_ROWSS  = WS_RSTD2 + 128 * 1024;
constexpr size_t WS_TOKW   = WS_ROWSS + 128 * 1024;
constexpr size_t WS_LB     = WS_TOKW + 256 * 1024;
constexpr size_t WS_CBIAS  = WS_LB + 4096;
constexpr size_t WS_SELM   = 2 * MiB;
constexpr size_t WS_GATES  = 3 * MiB;
constexpr size_t WS_KCMP   = 6 * MiB;
constexpr size_t WS_VCMP   = WS_KCMP + 512 * 1024;
constexpr size_t WS_CW2T   = 7 * MiB;
constexpr size_t WS_RW     = 7 * MiB + 128 * 1024;
constexpr size_t WS_HID    = 8 * MiB;
constexpr size_t WS_CW1T   = 12 * MiB;
constexpr size_t WS_WOUTT  = 14 * MiB;
constexpr size_t WS_WINT   = 16 * MiB;
constexpr size_t WS_R1     = 24 * MiB;
constexpr size_t WS_Q      = 88 * MiB;
constexpr size_t WS_KC     = 120 * MiB;
constexpr size_t WS_VC     = 128 * MiB;
constexpr size_t WS_KS     = 136 * MiB;
constexpr size_t WS_KW     = 144 * MiB;
constexpr size_t WS_VST    = 152 * MiB;
constexpr size_t WS_VWT    = 160 * MiB;
constexpr size_t WS_OC     = 168 * MiB;
constexpr size_t WS_W13T   = 200 * MiB;
constexpr size_t WS_W2T    = 264 * MiB;
constexpr size_t WS_HQ     = 296 * MiB;
constexpr size_t WS_HV     = 328 * MiB;
constexpr size_t WS_HG     = 360 * MiB;
constexpr size_t WS_HLOGF  = 392 * MiB;
constexpr size_t WS_DBUF   = 456 * MiB;
constexpr size_t WS_END    = 457 * MiB;
constexpr size_t WS_UBUF   = WS_W13T;
constexpr size_t WS_BINL   = WS_HQ;
constexpr size_t WS_HBUF   = WS_HQ + 16 * MiB;

struct Params {
    const float *x, *attn_g, *ffn_g, *w_in, *w_out, *g_q, *g_k, *pos_k, *pos_v, *wk1, *wk2, *wv1, *wv2, *g_nsa, *lb_logits, *g_hn,
        *w_group, *b_group, *w_expert, *b_expert, *w1, *w3, *w2;
    float* out;
    unsigned char* ws;
};

typedef __bf16 bf16x2_t __attribute__((ext_vector_type(2)));
DEV unsigned pk2(float lo, float hi) { f32x2 f = {lo, hi}; return __builtin_bit_cast(unsigned, __builtin_convertvector(f, bf16x2_t)); }
DEV bf16_t f2bf(float f) { return (bf16_t)(pk2(f, 0.f) & 0xffffu); }
DEV float bf2f(bf16_t b) { return __uint_as_float(((unsigned)b) << 16); }
DEV float bflo(unsigned u) { return __uint_as_float(u << 16); }
DEV float bfhi(unsigned u) { return __uint_as_float(u & 0xffff0000u); }
DEV float sigmoidf_(float v) { return 1.f / (1.f + __expf(-v)); }
DEV float siluf_(float v) { return v / (1.f + __expf(-v)); }
DEV float wave_sum(float v) {
#pragma unroll
    for (int o = 1; o < 64; o <<= 1) v += __shfl_xor(v, o);
    return v;
}
DEV float wave_max(float v) {
#pragma unroll
    for (int o = 1; o < 64; o <<= 1) v = fmaxf(v, __shfl_xor(v, o));
    return v;
}
DEV int vblock() { const int G = gridDim.x, b = blockIdx.x; return (G % 8 == 0) ? (b % 8) * (G / 8) + b / 8 : b; }

namespace pg8 {
#define PG8_LAS __attribute__((address_space(3)))
constexpr int BM = 256, BK = 64, HALF = 128, HTB = HALF * BK * 2, STAGE_BYTES = 8 * HTB, NXCD = 8, WGM = 8;
__host__ __device__ __forceinline__ int lds_byte(int r, int c) { const int st = (r >> 4) * 2 + (c >> 5), rr = r & 15, cc = c & 31, ob = rr * 64 + cc * 2; return st * 1024 + (ob ^ (((ob >> 9) & 1) << 5)); }
__host__ __device__ __forceinline__ void stage_rc(int b, int& R, int& C) { const int st = b / 1024, sb = b % 1024, swz = sb ^ (((sb >> 9) & 1) << 5); R = (st >> 1) * 16 + swz / 64; C = (st & 1) * 32 + (swz % 64) / 2; }
struct Unit { int pm, pn; };
struct Gemm { const bf16_t* A; const bf16_t* Bt; int M, N, K; };
struct StaticOrder {
    int nM, nN, nwg, G, c;
    __host__ __device__ void init(int M, int N, int G_, int c_) { nM = M / BM; nN = N / BM; nwg = nM * nN; G = G_; c = c_; }
    __host__ __device__ bool next(int i, Unit& u) const {
        const long L = (long)i * G + c; if (L >= nwg) return false;
        int wgid = (int)L; { const int q = nwg / NXCD, r = nwg % NXCD, xcd = wgid % NXCD, off = wgid / NXCD; wgid = (xcd < r ? xcd * (q + 1) : r * (q + 1) + (xcd - r) * q) + off; }
        const int nig = WGM * nN, gid = wgid / nig, fm = gid * WGM, gsz = (nM - fm) < WGM ? (nM - fm) : WGM;
        u.pm = fm + ((wgid % nig) % gsz); u.pn = (wgid % nig) / gsz; return true;
    }
};
template <class Epi, class Sched>
__device__ __forceinline__ void gemm_phase(PG8_LAS unsigned char* lds, const Gemm g, const Sched& S, const Epi& E) {
    const int tid = threadIdx.x, wid = __builtin_amdgcn_readfirstlane(tid >> 6), lane = tid & 63, wr = wid >> 2, wc = wid & 3, fr = lane & 15, fq = lane >> 4;
    const int K = g.K, nt = K / BK;
    unsigned voffA[2];
#pragma unroll
    for (int i = 0; i < 2; ++i) { int R, C; stage_rc(tid * 16 + i * 8192, R, C); voffA[i] = (unsigned)(R * K + C) * 2u; }
    const size_t kstep = (size_t)(BK * 2);
    const size_t hstep = (size_t)HALF * K * 2;
    const size_t tstep = 2 * hstep;
    const unsigned ldsw = (unsigned)wid * 1024u;
    const int aoff = lds_byte(wr * 64 + fr, fq * 8), boff = lds_byte(wc * 32 + fr, fq * 8);
#define PG8_SA(b, h) (((b) * 2 + (h)) * HTB)
#define PG8_SB(b, h) ((4 + (b) * 2 + (h)) * HTB)
#define PG8_STAGE(bufoff, gbase, voff) do { _Pragma("unroll") for (int _i = 0; _i < 2; ++_i) \
        __builtin_amdgcn_global_load_lds((const unsigned*)((const char*)(gbase) + (voff)[_i]), (PG8_LAS unsigned*)(lds + (bufoff) + ldsw + _i * 8192), 16, 0, 0); } while (0)
#define PG8_LDA(dst, b, h) do { _Pragma("unroll") for (int m = 0; m < 4; ++m) _Pragma("unroll") for (int k = 0; k < 2; ++k) dst[m][k] = *(const PG8_LAS bf16x8*)(lds + PG8_SA(b, h) + aoff + m * 2048 + k * 1024); } while (0)
#define PG8_LDB(dst, b, h) do { _Pragma("unroll") for (int n = 0; n < 2; ++n) _Pragma("unroll") for (int k = 0; k < 2; ++k) dst[n][k] = *(const PG8_LAS bf16x8*)(lds + PG8_SB(b, h) + boff + n * 2048 + k * 1024); } while (0)
#define PG8_MMA(ai, bj, At, Bt) do { __builtin_amdgcn_s_setprio(1); _Pragma("unroll") for (int m = 0; m < 4; ++m) _Pragma("unroll") for (int n = 0; n < 2; ++n) _Pragma("unroll") for (int k = 0; k < 2; ++k) \
        acc[ai][bj][m][n] = __builtin_amdgcn_mfma_f32_16x16x32_bf16(Bt[n][k], At[m][k], acc[ai][bj][m][n], 0, 0, 0); __builtin_amdgcn_s_setprio(0); } while (0)
#define PG8_WAIT_V(n) asm volatile("s_waitcnt vmcnt(" #n ")" ::: "memory")
#define PG8_WAIT_L(n) asm volatile("s_waitcnt lgkmcnt(" #n ")" ::: "memory")
#define PG8_BAR __builtin_amdgcn_s_barrier()
#define PG8_SCHED __builtin_amdgcn_sched_barrier(0)
    Unit cur, nxt; int ui = 0;
    if (!S.next(0, cur)) return;
    f32x4 acc[2][2][4][2];
#pragma unroll
    for (int a = 0; a < 2; ++a)
#pragma unroll
        for (int b = 0; b < 2; ++b)
#pragma unroll
            for (int m = 0; m < 4; ++m)
#pragma unroll
                for (int n = 0; n < 2; ++n) acc[a][b][m][n] = (f32x4){0.f, 0.f, 0.f, 0.f};
    bf16x8 At[4][2], B0[2][2], B1[2][2];
    const char* cA = (const char*)g.A + (size_t)cur.pm * tstep; const char* cB = (const char*)g.Bt + (size_t)cur.pn * tstep;
    PG8_STAGE(PG8_SB(0, 0), cB, voffA); PG8_STAGE(PG8_SA(0, 0), cA, voffA); PG8_STAGE(PG8_SB(0, 1), cB + hstep, voffA); PG8_STAGE(PG8_SA(0, 1), cA + hstep, voffA);
    if (wr == 1) PG8_BAR;
    PG8_WAIT_V(4); PG8_BAR;
    PG8_STAGE(PG8_SB(1, 0), cB + kstep, voffA); PG8_STAGE(PG8_SA(1, 0), cA + kstep, voffA); PG8_STAGE(PG8_SB(1, 1), cB + hstep + kstep, voffA);
    PG8_WAIT_V(6); PG8_BAR;
    for (;;) {
        const bool has_next = S.next(ui + 1, nxt);
        const char* nA = has_next ? (const char*)g.A + (size_t)nxt.pm * tstep : cA; const char* nB = has_next ? (const char*)g.Bt + (size_t)nxt.pn * tstep : cB;
        for (int t = 0; t < nt; t += 2) {
            const bool last = (t == nt - 2);
            const char* a1 = cA + (size_t)(t + 1) * kstep;
            const char* a2 = last ? nA : cA + (size_t)(t + 2) * kstep; const char* b2 = last ? nB : cB + (size_t)(t + 2) * kstep;
            const char* a3 = a2 + kstep; const char* b3 = b2 + kstep;
            PG8_LDB(B0, 0, 0); PG8_SCHED; PG8_LDA(At, 0, 0); PG8_STAGE(PG8_SA(1, 1), a1 + hstep, voffA);
            PG8_WAIT_L(8); PG8_BAR; PG8_WAIT_L(0); PG8_MMA(0, 0, At, B0); PG8_BAR; PG8_SCHED;
            PG8_LDB(B1, 0, 1); PG8_STAGE(PG8_SB(0, 0), b2, voffA);
            PG8_BAR; PG8_WAIT_L(0); PG8_MMA(0, 1, At, B1); PG8_BAR;
            PG8_LDA(At, 0, 1); PG8_STAGE(PG8_SA(0, 0), a2, voffA);
            PG8_BAR; PG8_WAIT_L(0); PG8_MMA(1, 0, At, B0); PG8_BAR; PG8_SCHED;
            PG8_STAGE(PG8_SB(0, 1), b2 + hstep, voffA);
            PG8_WAIT_V(6); PG8_BAR; PG8_MMA(1, 1, At, B1); PG8_BAR;
            PG8_LDB(B0, 1, 0); PG8_SCHED; PG8_LDA(At, 1, 0); PG8_STAGE(PG8_SA(0, 1), a2 + hstep, voffA);
            PG8_WAIT_L(8); PG8_BAR; PG8_WAIT_L(0); PG8_MMA(0, 0, At, B0); PG8_BAR; PG8_SCHED;
            PG8_LDB(B1, 1, 1); PG8_STAGE(PG8_SB(1, 0), b3, voffA);
            PG8_BAR; PG8_WAIT_L(0); PG8_MMA(0, 1, At, B1); PG8_BAR;
            PG8_LDA(At, 1, 1); PG8_STAGE(PG8_SA(1, 0), a3, voffA);
            PG8_BAR; PG8_WAIT_L(0); PG8_MMA(1, 0, At, B0); PG8_BAR; PG8_SCHED;
            PG8_STAGE(PG8_SB(1, 1), b3 + hstep, voffA);
            PG8_WAIT_V(6); PG8_BAR; PG8_MMA(1, 1, At, B1); PG8_BAR;
        }
        E(acc, cur, wr, wc, fr, fq);
        if (!has_next) break;
#pragma unroll
        for (int a = 0; a < 2; ++a)
#pragma unroll
            for (int b = 0; b < 2; ++b)
#pragma unroll
                for (int m = 0; m < 4; ++m)
#pragma unroll
                    for (int n = 0; n < 2; ++n) acc[a][b][m][n] = (f32x4){0.f, 0.f, 0.f, 0.f};
        cur = nxt; cA = nA; cB = nB; ++ui;
    }
    PG8_WAIT_V(0);
    if (wr == 0) PG8_BAR;
    PG8_BAR;
#undef PG8_SA
#undef PG8_SB
#undef PG8_STAGE
#undef PG8_LDA
#undef PG8_LDB
#undef PG8_MMA
#undef PG8_WAIT_V
#undef PG8_WAIT_L
#undef PG8_BAR
#undef PG8_SCHED
}
__host__ __device__ __forceinline__ int logcol(int p) { return (p & ~255) + 64 * ((p >> 5) & 3) + 32 * ((p >> 7) & 1) + (p & 31); }
}

template <class SRC>
DEV void convert_tile(float* tl, const SRC& src, bf16_t* dst, int ldd, int n0, int k0) {
    const int tid = threadIdx.x;
    {
        const int n = tid & 63;
#pragma unroll
        for (int i = 0; i < 8; ++i) { const int kk = (tid >> 6) + 8 * i; tl[kk * 65 + n] = src.get(n0 + n, k0 + kk); }
    }
    __syncthreads();
    {
        const int n = tid >> 3, kc = tid & 7;
        const float* s = tl + (kc * 8) * 65 + n;
        u32x4 o;
        o.x = pk2(s[0 * 65], s[1 * 65]); o.y = pk2(s[2 * 65], s[3 * 65]); o.z = pk2(s[4 * 65], s[5 * 65]); o.w = pk2(s[6 * 65], s[7 * 65]);
        *(u32x4*)(dst + (size_t)(n0 + n) * ldd + k0 + kc * 8) = o;
    }
    __syncthreads();
}
struct SrcWin { const float* w; const float* g;
    DEV float get(int np, int k) const { const int n = pg8::logcol(np); int col; if (n < 1280) col = n; else if (n < 3328) col = n + 24; else if (n < 3352) col = 1280 + (n - 3328); else return 0.f;
        return w[(size_t)k * IN_COLS + col] * g[k]; } };
struct SrcWout { const float* w; const float* g;
    DEV float get(int np, int k) const { const int n = pg8::logcol(np); const float v = w[(size_t)k * DM + n]; return k < 512 ? v * g[k] : v; } };
struct SrcPlain { const float* w; int ld;
    DEV float get(int n, int k) const { return w[(size_t)k * ld + n]; } };
struct SrcW13 { const float* w1; const float* w3; const float* g;
    DEV float get(int n, int k) const { const uintptr_t a = (uintptr_t)w1, b = (uintptr_t)w3; const float* w = (const float*)(a + ((b - a) & (uintptr_t)(0 - (long long)(n & 1))));
        return w[(size_t)k * 512 + (n >> 1)] * g[k]; } };

DEV void phase_prologue(const Params& p, unsigned char* lds) {
    float* tl = (float*)lds;
    const int tid = threadIdx.x, lane = tid & 63, wid = tid >> 6;
    const int vb = vblock(), G = gridDim.x;
    unsigned char* ws = p.ws;
    constexpr int I_WIN = (INP / 64) * (DM / 64);
    constexpr int I_WOUT = 16 * 16;
    constexpr int I_CW1 = 2 * 4 * 32;
    constexpr int I_CW2 = 2 * 1 * 4;
    constexpr int I_W13 = 32 * 16 * 16;
    constexpr int I_W2 = 32 * 16 * 8;
    constexpr int I_ALL = I_WIN + I_WOUT + I_CW1 + I_CW2 + I_W2;
    for (int it = vb; it < I_ALL; it += G) {
        int r = it;
        if (r < I_WIN) { SrcWin s{p.w_in, p.attn_g}; convert_tile(tl, s, (bf16_t*)(ws + WS_WINT), DM, (r / 16) * 64, (r % 16) * 64); continue; } r -= I_WIN;
        if (r < I_WOUT) { SrcWout s{p.w_out, p.g_nsa}; convert_tile(tl, s, (bf16_t*)(ws + WS_WOUTT), DM, (r / 16) * 64, (r % 16) * 64); continue; } r -= I_WOUT;
        if (r < I_CW1) { const int z = r / 128, q = r % 128; SrcPlain s{z ? p.wv1 : p.wk1, 256};
            convert_tile(tl, s, (bf16_t*)(ws + WS_CW1T) + (size_t)z * 256 * 2048, 2048, (q / 32) * 64, (q % 32) * 64); continue; } r -= I_CW1;
        if (r < I_CW2) { const int z = r / 4, q = r % 4; SrcPlain s{z ? p.wv2 : p.wk2, 64};
            convert_tile(tl, s, (bf16_t*)(ws + WS_CW2T) + (size_t)z * 64 * 256, 256, 0, q * 64); continue; } r -= I_CW2;
        { const int e = r / 128, q = r % 128; SrcPlain s{p.w2 + (size_t)e * 512 * 1024, 1024};
            convert_tile(tl, s, (bf16_t*)(ws + WS_W2T) + (size_t)e * 1024 * 512, 512, (q / 8) * 64, (q % 8) * 64); }
    }
    {
        bf16_t* xb = (bf16_t*)(ws + WS_R1); float* rstd1 = (float*)(ws + WS_RSTD1);
        const int gw = vb * 8 + wid, NGW = G * 8;
        for (int m = gw; m < NTOK; m += NGW) {
            const f32x4* xr = (const f32x4*)(p.x + (size_t)m * DM) + lane;
            f32x4 v[4]; float s = 0.f;
#pragma unroll
            for (int j = 0; j < 4; ++j) { v[j] = xr[64 * j]; s += (v[j].x * v[j].x + v[j].y * v[j].y) + (v[j].z * v[j].z + v[j].w * v[j].w); }
            s = wave_sum(s);
            if (lane == 0) rstd1[m] = rsqrtf(s * (1.f / DM) + RMS_EPS);
            u32x2* o = (u32x2*)(xb + (size_t)m * DM) + lane;
#pragma unroll
            for (int j = 0; j < 4; ++j) { u32x2 w; w.x = pk2(v[j].x, v[j].y); w.y = pk2(v[j].z, v[j].w); o[64 * j] = w; }
        }
    }
    {
        const int gt = vb * NT + tid, NG = G * NT;
        float* rowss = (float*)(ws + WS_ROWSS);
        for (int i = gt; i < NTOK; i += NG) rowss[i] = 0.f;
        int* bincnt = (int*)(ws + WS_CTL);
        if (gt < 128) bincnt[gt] = 0;
        if (gt < 512) { const float l0 = p.lb_logits[gt], l1 = p.lb_logits[512 + gt]; ((float*)(ws + WS_LB))[gt] = 1.f / (1.f + __expf(l1 - l0)); }
        for (int i = gt; i < 48 * 1024; i += NG) { const int c = i >> 10, k = i & 1023;
            const float w = (c < 4 ? p.w_group[k * 4 + c] : (c < 36 ? p.w_expert[k * 32 + (c - 4)] : 0.f)) * p.ffn_g[k];
            const bf16_t hi = f2bf(w); const bf16_t lo = f2bf(w - bf2f(hi));
            ((bf16_t*)(ws + WS_RW))[i] = hi; ((bf16_t*)(ws + WS_RW))[48 * 1024 + i] = lo; }
        if (blockIdx.x == (unsigned)(G - 1)) {
            const int z = tid >> 8, j = tid & 255; const float* pos = z ? p.pos_v : p.pos_k; const float* w = z ? p.wv1 : p.wk1;
            float a = 0.f;
            for (int k = 0; k < 2048; ++k) a += pos[k] * w[(size_t)k * 256 + j];
            ((float*)(ws + WS_CBIAS))[z * 256 + j] = a;
        }
    }
}

constexpr int G_A_BYTES = 128 * 128, G_B_BYTES = 256 * 128, G_STAGE = G_A_BYTES + G_B_BYTES, G_LDS = 2 * G_STAGE;
DEV int swz(int row, int chunk) { return row * 128 + ((chunk ^ ((row >> 1) & 7)) << 4); }
template <class AL, class BL, class EP>
DEV void gemm_tile(unsigned char* lds, const AL& al, const BL& bl, int nk, const EP& ep) {
    const int tid = threadIdx.x, lane = tid & 63, wid = tid >> 6, wr = wid >> 2, wc = wid & 3;
    const int frow = lane & 15, fq = lane >> 4;
    const bf16_t* aptr[2]; int aoff[2], boff[4], brow[4];
#pragma unroll
    for (int i = 0; i < 2; ++i) { const int q = tid + NT * i, row = q >> 3, ch = q & 7; aptr[i] = al.row(row) + ch * 8; aoff[i] = swz(row, ch); }
#pragma unroll
    for (int i = 0; i < 4; ++i) { const int q = tid + NT * i, row = q >> 3, ch = q & 7; brow[i] = row; boff[i] = G_A_BYTES + swz(row, ch) ; }
    const int bch8 = (tid & 7) * 8;
    u32x4 ra[2], rb[4];
#pragma unroll
    for (int i = 0; i < 2; ++i) ra[i] = *(const u32x4*)(aptr[i]);
#pragma unroll
    for (int i = 0; i < 4; ++i) rb[i] = *(const u32x4*)(bl.ptr(brow[i], 0) + bch8);
#pragma unroll
    for (int i = 0; i < 2; ++i) *(u32x4*)(lds + aoff[i]) = ra[i];
#pragma unroll
    for (int i = 0; i < 4; ++i) *(u32x4*)(lds + boff[i]) = rb[i];
    __syncthreads();
    f32x4 acc[4][4];
#pragma unroll
    for (int m = 0; m < 4; ++m)
#pragma unroll
        for (int n = 0; n < 4; ++n) acc[m][n] = (f32x4){0.f, 0.f, 0.f, 0.f};
    const int sx = (frow >> 1) & 7;
    for (int kt = 0; kt < nk; ++kt) {
        const bool more = (kt + 1 < nk);
        if (more) {
#pragma unroll
            for (int i = 0; i < 2; ++i) ra[i] = *(const u32x4*)(aptr[i] + (kt + 1) * 64);
#pragma unroll
            for (int i = 0; i < 4; ++i) rb[i] = *(const u32x4*)(bl.ptr(brow[i], kt + 1) + bch8);
        }
        const unsigned char* base = lds + (kt & 1) * G_STAGE;
#pragma unroll
        for (int ks = 0; ks < 2; ++ks) {
            const int co = ((ks * 4 + fq) ^ sx) << 4;
            bf16x8 af[4], bfr[4];
#pragma unroll
            for (int m = 0; m < 4; ++m) af[m] = *(const bf16x8*)(base + (wr * 64 + m * 16 + frow) * 128 + co);
#pragma unroll
            for (int n = 0; n < 4; ++n) bfr[n] = *(const bf16x8*)(base + G_A_BYTES + (wc * 64 + n * 16 + frow) * 128 + co);
#pragma unroll
            for (int m = 0; m < 4; ++m)
#pragma unroll
                for (int n = 0; n < 4; ++n) acc[m][n] = __builtin_amdgcn_mfma_f32_16x16x32_bf16(bfr[n], af[m], acc[m][n], 0, 0, 0);
        }
        if (more) {
            unsigned char* nb = lds + ((kt + 1) & 1) * G_STAGE;
#pragma unroll
            for (int i = 0; i < 2; ++i) *(u32x4*)(nb + aoff[i]) = ra[i];
#pragma unroll
            for (int i = 0; i < 4; ++i) *(u32x4*)(nb + boff[i]) = rb[i];
        }
        __syncthreads();
    }
    ep(acc, wr, wc, lane);
}

struct ARows { const bf16_t* base; size_t ld; DEV const bf16_t* row(int r) const { return base + (size_t)r * ld; } };
struct BRows { const bf16_t* base; size_t ld; DEV const bf16_t* ptr(int n, int kt) const { return base + (size_t)n * ld + kt * 64; } };

DEV void inproj_row(const Params& p, int seg, int row, f32x4 (&v)[4], int fq) {
    unsigned char* ws = p.ws;
    const float rs = ((const float*)(ws + WS_RSTD1))[row];
#pragma unroll
    for (int n = 0; n < 4; ++n) v[n] = v[n] * rs;
    const int b = row >> 12, s = row & 4095;
    const bool is_q = seg < 8, is_ks = (seg == 12 || seg == 13), is_kw = (seg == 16 || seg == 17);
    if (is_q || is_ks || is_kw) {
        const float* gw = is_q ? p.g_q : (is_ks ? p.g_k + 64 : p.g_k + 128);
        bf16_t* dst; int hh, nh;
        if (is_q) { dst = (bf16_t*)(ws + WS_Q); hh = seg; nh = 8; } else if (is_ks) { dst = (bf16_t*)(ws + WS_KS); hh = seg - 12; nh = 2; } else { dst = (bf16_t*)(ws + WS_KW); hh = seg - 16; nh = 2; }
        float ss = 0.f;
#pragma unroll
        for (int n = 0; n < 4; ++n) ss += (v[n].x * v[n].x + v[n].y * v[n].y) + (v[n].z * v[n].z + v[n].w * v[n].w);
        ss += __shfl_xor(ss, 16); ss += __shfl_xor(ss, 32);
        float r = rsqrtf(ss * (1.f / 64.f) + RMS_EPS); if (is_q) r *= QSCALE;
        bf16_t* o = dst + ((size_t)(b * nh + hh) * SEQ + s) * 64 + fq * 4;
#pragma unroll
        for (int n = 0; n < 4; ++n) { const f32x4 g = *(const f32x4*)(gw + n * 16 + fq * 4); const f32x4 x = v[n] * g * r; u32x2 w; w.x = pk2(x.x, x.y); w.y = pk2(x.z, x.w); *(u32x2*)(o + n * 16) = w; }
        return;
    }
    if (seg >= 8 && seg < 12) {
        bf16_t* o = (bf16_t*)(ws + (seg < 10 ? WS_KC : WS_VC)) + ((size_t)(b * 2 + (seg & 1)) * SEQ + s) * 64 + fq * 4;
#pragma unroll
        for (int n = 0; n < 4; ++n) { u32x2 w; w.x = pk2(v[n].x, v[n].y); w.y = pk2(v[n].z, v[n].w); *(u32x2*)(o + n * 16) = w; }
        return;
    }
    if (seg == 14 || seg == 15 || seg == 18 || seg == 19) {
        bf16_t* o = (bf16_t*)(ws + (seg < 16 ? WS_VST : WS_VWT)) + (size_t)(b * 2 + (seg & 1)) * 64 * SEQ + s;
#pragma unroll
        for (int n = 0; n < 4; ++n) { const int d = n * 16 + fq * 4;
            o[(size_t)(d + 0) * SEQ] = f2bf(v[n].x); o[(size_t)(d + 1) * SEQ] = f2bf(v[n].y); o[(size_t)(d + 2) * SEQ] = f2bf(v[n].z); o[(size_t)(d + 3) * SEQ] = f2bf(v[n].w); }
        return;
    }
    if (seg < 52) {
        const int kind = (seg - 20) >> 3, cb = ((seg - 20) & 7) * 64 + fq * 4;
        if (kind == 1) {
            const float* lb = (const float*)(ws + WS_LB); float* dst = (float*)(ws + WS_HLOGF) + (size_t)row * 512;
#pragma unroll
            for (int n = 0; n < 4; ++n) { const int c = cb + n * 16; const f32x4 l = *(const f32x4*)(lb + c); f32x4 o;
                o.x = __logf(l.x + (1.f - l.x) * sigmoidf_(v[n].x)); o.y = __logf(l.y + (1.f - l.y) * sigmoidf_(v[n].y));
                o.z = __logf(l.z + (1.f - l.z) * sigmoidf_(v[n].z)); o.w = __logf(l.w + (1.f - l.w) * sigmoidf_(v[n].w));
                *(f32x4*)(dst + c) = o; }
        } else {
            bf16_t* dst = (bf16_t*)(ws + (kind == 0 ? WS_HQ : (kind == 2 ? WS_HV : WS_HG))) + (size_t)row * 512 + cb;
#pragma unroll
            for (int n = 0; n < 4; ++n) { f32x4 x = v[n];
                if (kind != 2) { x.x = siluf_(x.x); x.y = siluf_(x.y); x.z = siluf_(x.z); x.w = siluf_(x.w); }
                u32x2 w; w.x = pk2(x.x, x.y); w.y = pk2(x.z, x.w); *(u32x2*)(dst + n * 16) = w; }
        }
        return;
    }
    {
        float* dst = (float*)(ws + WS_GATES) + (size_t)row * 24;
#pragma unroll
        for (int n = 0; n < 2; ++n) { const int c = n * 16 + fq * 4; if (c < 24) { f32x4 o; o.x = sigmoidf_(v[n].x); o.y = sigmoidf_(v[n].y); o.z = sigmoidf_(v[n].z); o.w = sigmoidf_(v[n].w); *(f32x4*)(dst + c) = o; } }
    }
}
struct EpiInproj8 { const Params& p;
    DEV void operator()(const f32x4 (&acc)[2][2][4][2], const pg8::Unit& u, int wr, int wc, int fr, int fq) const {
        const int seg = u.pn * 4 + wc;
        if (seg > 52) return;
#pragma unroll
        for (int ai = 0; ai < 2; ++ai)
#pragma unroll
            for (int m = 0; m < 4; ++m) { f32x4 v[4] = {acc[ai][0][m][0], acc[ai][0][m][1], acc[ai][1][m][0], acc[ai][1][m][1]};
                inproj_row(p, seg, u.pm * 256 + ai * 128 + wr * 64 + m * 16 + fr, v, fq); }
    } };
DEV void phase_inproj(const Params& p, unsigned char* lds) {
    pg8::Gemm g{(const bf16_t*)(p.ws + WS_R1), (const bf16_t*)(p.ws + WS_WINT), NTOK, INP, DM};
    pg8::StaticOrder S; S.init(NTOK, INP, (int)gridDim.x, (int)blockIdx.x);
    EpiInproj8 E{p};
    pg8::gemm_phase(( PG8_LAS unsigned char*)lds, g, S, E);
}

struct ACmp { const bf16_t* src; int bg, c0;
    DEV const bf16_t* row(int r) const { int c = c0 + r; if (c > NC - 1) c = NC - 1; return src + ((size_t)bg * SEQ + 16 * c) * 64; } };
struct EpiCmpA { const Params& p; int z, rbase;
    DEV void operator()(f32x4 (&acc)[4][4], int wr, int wc, int lane) const {
        const int frow = lane & 15, fq = lane >> 4;
        const float* cb = (const float*)(p.ws + WS_CBIAS) + z * 256; bf16_t* hid = (bf16_t*)(p.ws + WS_HID) + (size_t)z * 4096 * 256;
#pragma unroll
        for (int m = 0; m < 4; ++m) { const int rr = rbase + wr * 64 + m * 16 + frow;
#pragma unroll
            for (int n = 0; n < 4; ++n) { const int c = wc * 64 + n * 16 + fq * 4; const f32x4 b = *(const f32x4*)(cb + c); f32x4 v = acc[m][n] + b;
                u32x2 w; w.x = pk2(siluf_(v.x), siluf_(v.y)); w.y = pk2(siluf_(v.z), siluf_(v.w)); *(u32x2*)(hid + (size_t)rr * 256 + c) = w; } }
    } };
DEV void phase_cmp_a(const Params& p, unsigned char* lds) {
    const int vb = vblock(), G = gridDim.x;
    for (int u = vb; u < 64; u += G) {
        const int z = u >> 5, rbase = (u & 31) * 128;
        ACmp al{(const bf16_t*)(p.ws + (z ? WS_VC : WS_KC)), (u & 31) >> 1, (u & 1) * 128};
        BRows bl{(const bf16_t*)(p.ws + WS_CW1T) + (size_t)z * 256 * 2048, 2048};
        EpiCmpA ep{p, z, rbase};
        gemm_tile(lds, al, bl, 2048 / 64, ep);
    }
}
struct BClamp64 { const bf16_t* base; size_t ld; DEV const bf16_t* ptr(int n, int kt) const { return base + (size_t)(n & 63) * ld + kt * 64; } };
struct EpiCmpB { const Params& p; int z, rbase;
    DEV void operator()(f32x4 (&acc)[4][4], int wr, int wc, int lane) const {
        if (wc != 0) return;
        const int frow = lane & 15, fq = lane >> 4;
        bf16_t* dst = (bf16_t*)(p.ws + (z ? WS_VCMP : WS_KCMP));
#pragma unroll
        for (int m = 0; m < 4; ++m) { const int rr = rbase + wr * 64 + m * 16 + frow;
            float r = 1.f;
            if (z == 0) { float ss = 0.f;
#pragma unroll
                for (int n = 0; n < 4; ++n) { const f32x4 v = acc[m][n]; ss += (v.x * v.x + v.y * v.y) + (v.z * v.z + v.w * v.w); }
                ss += __shfl_xor(ss, 16); ss += __shfl_xor(ss, 32); r = rsqrtf(ss * (1.f / 64.f) + RMS_EPS); }
            const int bg = rr >> 8, c = rr & 255;
            if (c < NC) {
#pragma unroll
                for (int n = 0; n < 4; ++n) { const int d = n * 16 + fq * 4; f32x4 v = acc[m][n] * r;
                    if (z == 0) { const f32x4 g = *(const f32x4*)(p.g_k + d); v = v * g;
                        u32x2 w; w.x = pk2(v.x, v.y); w.y = pk2(v.z, v.w); *(u32x2*)(dst + ((size_t)bg * 256 + c) * 64 + d) = w; }
                    else { bf16_t* o = dst + ((size_t)bg * 64 + d) * 256 + c; o[0] = f2bf(v.x); o[256] = f2bf(v.y); o[512] = f2bf(v.z); o[768] = f2bf(v.w); } } }
        }
    } };
DEV void phase_cmp_b(const Params& p, unsigned char* lds) {
    const int vb = vblock(), G = gridDim.x;
    for (int u = vb; u < 64; u += G) {
        const int z = u >> 5, rbase = (u & 31) * 128;
        ARows al{(const bf16_t*)(p.ws + WS_HID) + ((size_t)z * 4096 + rbase) * 256, 256};
        BClamp64 bl{(const bf16_t*)(p.ws + WS_CW2T) + (size_t)z * 64 * 256, 256};
        EpiCmpB ep{p, z, rbase};
        gemm_tile(lds, al, bl, 256 / 64, ep);
    }
}

constexpr int CM_K = 0, CM_V = 32768, CM_VSTR = 520, CM_IMP = CM_V + 64 * CM_VSTR, CM_LDS = CM_IMP + 16384;
DEV void cm_scores(const unsigned char* kbase, int kt, const bf16x8 (&qf)[4], int r31, int hh, f32x16 (&sacc)[2]) {
#pragma unroll
    for (int kt2 = 0; kt2 < 2; ++kt2) {
#pragma unroll
        for (int i = 0; i < 16; ++i) sacc[kt2][i] = 0.f;
        const int row = 64 * kt + 32 * kt2 + r31; const int sx = (row >> 1) & 7;
#pragma unroll
        for (int s = 0; s < 4; ++s) { const bf16x8 kf = *(const bf16x8*)(kbase + row * 128 + (((2 * s + hh) ^ sx) << 4));
            sacc[kt2] = __builtin_amdgcn_mfma_f32_32x32x16_bf16(kf, qf[s], sacc[kt2], 0, 0, 0); }
    }
}
DEV void phase_cmp_attn(const Params& p, unsigned char* lds) {
    const int tid = threadIdx.x, lane = tid & 63, wid = tid >> 6;
    const int vb = vblock(), G = gridDim.x;
    unsigned char* ws = p.ws;
    const int r31 = lane & 31, hh = lane >> 5;
    float* impl = (float*)(lds + CM_IMP);
    for (int it = vb; it < 1024; it += G) {
        const int rnd = it / G, pos = it % G; int sidx = (rnd & 1) ? (rnd * G + (G - 1 - pos)) : (rnd * G + pos); if (G != 256) sidx = it;
        const int ci = 63 - (sidx >> 4), bg = sidx & 15, b = bg >> 1, g = bg & 1;
        const int nvis = min(NC, 4 * ci + 3), ntile = (nvis + 63) >> 6;
        const int head = g * 4 + (wid >> 1);
        const int tokl = (wid & 1) * 32 + r31, t = ci * 64 + tokl;
        const size_t tok = (size_t)b * SEQ + t;
        const int nv = t >= 31 ? min(NC, (t - 31) / 16 + 1) : 0;
        __syncthreads();
        {
            const bf16_t* kc = (const bf16_t*)(ws + WS_KCMP) + (size_t)bg * 256 * 64; const bf16_t* vt = (const bf16_t*)(ws + WS_VCMP) + (size_t)bg * 64 * 256;
            const int nch = ntile * 512;
            for (int idx = tid; idx < nch; idx += NT) { const int row = idx >> 3, ch = idx & 7; *(u32x4*)(lds + CM_K + swz(row, ch)) = *(const u32x4*)(kc + row * 64 + ch * 8); }
            const int cpr = ntile * 8;
            for (int idx = tid; idx < nch; idx += NT) { const int d = idx / cpr, ck = idx % cpr; const u32x4 v = *(const u32x4*)(vt + d * 256 + ck * 8);
                u32x2 a, c2; a.x = v.x; a.y = v.y; c2.x = v.z; c2.y = v.w; unsigned char* o = lds + CM_V + d * CM_VSTR + ck * 16; *(u32x2*)o = a; *(u32x2*)(o + 8) = c2; }
#pragma unroll
            for (int i = 0; i < 8; ++i) impl[tid + NT * i] = 0.f;
        }
        bf16x8 qf[4];
        { const bf16_t* qp = (const bf16_t*)(ws + WS_Q) + ((size_t)(b * 8 + head) * SEQ + t) * 64 + 8 * hh;
#pragma unroll
            for (int s = 0; s < 4; ++s) qf[s] = *(const bf16x8*)(qp + 16 * s); }
        __syncthreads();
        float m_run = -1e30f, l_run = 0.f;
        for (int kt = 0; kt < ntile; ++kt) {
            f32x16 sacc[2];
            cm_scores(lds + CM_K, kt, qf, r31, hh, sacc);
            float mx = -1e30f;
#pragma unroll
            for (int kt2 = 0; kt2 < 2; ++kt2)
#pragma unroll
                for (int i = 0; i < 16; ++i) { const int c = 64 * kt + 32 * kt2 + (i & 3) + 8 * (i >> 2) + 4 * hh; const float v = (c < nv) ? sacc[kt2][i] : -1e30f; sacc[kt2][i] = v; mx = fmaxf(mx, v); }
            const float m_new = fmaxf(m_run, mx); float rs = 0.f;
#pragma unroll
            for (int kt2 = 0; kt2 < 2; ++kt2)
#pragma unroll
                for (int i = 0; i < 16; ++i) { const float v = sacc[kt2][i]; rs += (v > -5e29f) ? exp2f(v - m_new) : 0.f; }
            l_run = l_run * exp2f(m_run - m_new) + rs; m_run = m_new;
        }
        float M, invL;
        { const float mo = __shfl_xor(m_run, 32), lo = __shfl_xor(l_run, 32); M = fmaxf(m_run, mo); const float L = l_run * exp2f(m_run - M) + lo * exp2f(mo - M); invL = L > 0.f ? 1.f / L : 0.f; }
        f32x16 ot[2];
#pragma unroll
        for (int dt = 0; dt < 2; ++dt)
#pragma unroll
            for (int i = 0; i < 16; ++i) ot[dt][i] = 0.f;
        float own[32], spl[32];
#pragma unroll
        for (int i = 0; i < 32; ++i) { own[i] = 0.f; spl[i] = 0.f; }
#pragma unroll
        for (int kt = 0; kt < 4; ++kt) if (kt < ntile) {
            f32x16 sacc[2];
            cm_scores(lds + CM_K, kt, qf, r31, hh, sacc);
#pragma unroll
            for (int kt2 = 0; kt2 < 2; ++kt2)
#pragma unroll
                for (int i = 0; i < 16; ++i) { const int c = 64 * kt + 32 * kt2 + (i & 3) + 8 * (i >> 2) + 4 * hh; sacc[kt2][i] = (c < nv) ? exp2f(sacc[kt2][i] - M) : 0.f; }
#pragma unroll
            for (int kt2 = 0; kt2 < 2; ++kt2)
#pragma unroll
                for (int g4 = 0; g4 < 4; ++g4) { const int Gi = 8 * kt + 4 * kt2 + g4; const float e3 = 0.5f * sacc[kt2][4 * g4 + 3];
                    own[Gi] = ((sacc[kt2][4 * g4] + sacc[kt2][4 * g4 + 1]) + (sacc[kt2][4 * g4 + 2] + e3)) * invL; spl[Gi] = e3 * invL; }
#pragma unroll
            for (int kt2 = 0; kt2 < 2; ++kt2)
#pragma unroll
                for (int s2 = 0; s2 < 2; ++s2) {
                    bf16x8 pf; { u32x4 w; w.x = pk2(sacc[kt2][8 * s2 + 0], sacc[kt2][8 * s2 + 1]); w.y = pk2(sacc[kt2][8 * s2 + 2], sacc[kt2][8 * s2 + 3]);
                        w.z = pk2(sacc[kt2][8 * s2 + 4], sacc[kt2][8 * s2 + 5]); w.w = pk2(sacc[kt2][8 * s2 + 6], sacc[kt2][8 * s2 + 7]); pf = __builtin_bit_cast(bf16x8, w); }
#pragma unroll
                    for (int dt = 0; dt < 2; ++dt) {
                        const unsigned char* va = lds + CM_V + (32 * dt + r31) * CM_VSTR + (64 * kt + 32 * kt2 + 16 * s2 + 4 * hh) * 2;
                        const u32x2 lo = *(const u32x2*)(va), hi = *(const u32x2*)(va + 16);
                        u32x4 w; w.x = lo.x; w.y = lo.y; w.z = hi.x; w.w = hi.y;
                        ot[dt] = __builtin_amdgcn_mfma_f32_32x32x16_bf16(__builtin_bit_cast(bf16x8, w), pf, ot[dt], 0, 0, 0);
                    }
                }
        }
        {
            const float sc = ((const float*)(ws + WS_GATES))[tok * 24 + head * 3 + 0] * invL;
            bf16_t* ocp = (bf16_t*)(ws + WS_OC) + tok * 512 + head * 64;
#pragma unroll
            for (int dt = 0; dt < 2; ++dt)
#pragma unroll
                for (int g4 = 0; g4 < 4; ++g4) { const int d0 = 32 * dt + 8 * g4 + 4 * hh;
                    u32x2 w; w.x = pk2(ot[dt][4 * g4 + 0] * sc, ot[dt][4 * g4 + 1] * sc); w.y = pk2(ot[dt][4 * g4 + 2] * sc, ot[dt][4 * g4 + 3] * sc); *(u32x2*)(ocp + d0) = w; }
        }
        {
            float tot[32];
#pragma unroll
            for (int Gi = 0; Gi < 32; ++Gi) { const float os = __shfl_xor(spl[Gi], 32); const float op = (Gi > 0) ? __shfl_xor(spl[Gi > 0 ? Gi - 1 : 0], 32) : 0.f; tot[Gi] = own[Gi] + (hh ? os : op); }
            for (int r = 0; r < 4; ++r) {
                if ((wid >> 1) == r) {
#pragma unroll
                    for (int Gi = 0; Gi < 32; ++Gi) if (Gi < 8 * ntile) impl[tokl * 64 + 2 * Gi + hh] += tot[Gi];
                }
                __syncthreads();
            }
        }
        for (int tt = 0; tt < 8; ++tt) {
            const int tl = wid * 8 + tt, cur = ci;
            const float imp = impl[tl * 64 + lane];
            const float INF = __builtin_inff();
            const float v = (lane == 0 || lane == cur) ? INF : (lane < cur ? imp : -INF);
            int rank = 0;
            for (int i = 0; i <= cur; ++i) { const float vi = __uint_as_float(__builtin_amdgcn_readlane(__float_as_uint(v), i)); rank += ((vi > v) || (vi == v && i < lane)) ? 1 : 0; }
            const bool sel = (lane <= cur) && (rank < 16);
            const unsigned long long mask = __ballot(sel);
            if (lane == 0) ((unsigned long long*)(ws + WS_SELM))[(size_t)bg * SEQ + ci * 64 + tl] = mask;
        }
    }
}

constexpr int FA_KB = 64 * 128, FA_VB = 64 * 136, FA_STAGE = FA_KB + FA_VB, FA_LDS = 2 * FA_STAGE + 1024;
template <bool SEL>
DEV void fa_branch(unsigned char* lds, const bf16_t* Kb, const bf16_t* VTb, int ci, int bg, const bf16x8 (&qf)[4], int t, unsigned long long mymask, unsigned long long need,
                   f32x16 (&ot)[2], float& m_run, float& l_run) {
    const int tid = threadIdx.x, lane = tid & 63;
    const int r31 = lane & 31, hh = lane >> 5;
    const int lrow = tid >> 3, lch = tid & 7;
    const bf16_t* kg = Kb + ((size_t)bg * SEQ + lrow) * 64 + lch * 8;
    const bf16_t* vg = VTb + ((size_t)bg * 64 + lrow) * SEQ + lch * 8;
    const int koff = lrow * 128 + ((lch ^ ((lrow >> 1) & 7)) << 4), voff = FA_KB + lrow * 136 + lch * 16;
    int jlo, jhi; unsigned long long todo;
    if (SEL) { todo = need; jlo = 0; jhi = ci; } else { jlo = ci >= 8 ? ci - 8 : 0; jhi = ci; todo = 0; }
    int j = jlo;
    if (SEL) { if (todo == 0) return; j = __builtin_ctzll(todo); todo &= todo - 1; }
    u32x4 rk = *(const u32x4*)(kg + (size_t)j * 64 * 64), rv = *(const u32x4*)(vg + (size_t)j * 64);
    __syncthreads();
    *(u32x4*)(lds + koff) = rk; { u32x2 a, b2; a.x = rv.x; a.y = rv.y; b2.x = rv.z; b2.y = rv.w; *(u32x2*)(lds + voff) = a; *(u32x2*)(lds + voff + 8) = b2; }
    __syncthreads();
    int st = 0;
    for (;;) {
        int jn; bool more;
        if (SEL) { more = (todo != 0); jn = more ? __builtin_ctzll(todo) : 0; todo &= todo - 1; } else { jn = j + 1; more = (jn <= jhi); }
        if (more) { rk = *(const u32x4*)(kg + (size_t)jn * 64 * 64); rv = *(const u32x4*)(vg + (size_t)jn * 64); }
        const unsigned char* base = lds + st * FA_STAGE;
        f32x16 sacc[2];
#pragma unroll
        for (int kt2 = 0; kt2 < 2; ++kt2) {
#pragma unroll
            for (int i = 0; i < 16; ++i) sacc[kt2][i] = 0.f;
            const int row = 32 * kt2 + r31; const int sx = (row >> 1) & 7;
#pragma unroll
            for (int s = 0; s < 4; ++s) { const bf16x8 kf = *(const bf16x8*)(base + row * 128 + (((2 * s + hh) ^ sx) << 4));
                sacc[kt2] = __builtin_amdgcn_mfma_f32_32x32x16_bf16(kf, qf[s], sacc[kt2], 0, 0, 0); }
        }
        const bool bit = SEL ? ((mymask >> j) & 1ull) != 0 : true;
        const bool boundary = SEL ? (j == ci) : (j == ci || j + 8 <= ci);
        float mx = -1e30f;
        if (boundary) {
#pragma unroll
            for (int kt2 = 0; kt2 < 2; ++kt2)
#pragma unroll
                for (int i = 0; i < 16; ++i) { const int key = 64 * j + 32 * kt2 + (i & 3) + 8 * (i >> 2) + 4 * hh;
                    const bool ok = SEL ? (bit && key <= t) : (key <= t && t - key < 512);
                    const float v = ok ? sacc[kt2][i] : -__builtin_inff(); sacc[kt2][i] = v; mx = fmaxf(mx, v); }
        } else {
#pragma unroll
            for (int kt2 = 0; kt2 < 2; ++kt2)
#pragma unroll
                for (int i = 0; i < 16; ++i) mx = fmaxf(mx, sacc[kt2][i]);
            if (SEL && !bit) mx = -1e30f;
        }
        mx = fmaxf(mx, __shfl_xor(mx, 32));
        const float m_new = fmaxf(m_run, mx);
        if (__any(m_new > m_run)) {
            const float alpha = __builtin_amdgcn_exp2f(m_run - m_new);
            l_run *= alpha;
#pragma unroll
            for (int dt = 0; dt < 2; ++dt)
#pragma unroll
                for (int i = 0; i < 16; ++i) ot[dt][i] *= alpha;
            m_run = m_new;
        }
        const float m_use = (SEL && !bit) ? __builtin_inff() : m_run;
        float rs = 0.f;
#pragma unroll
        for (int kt2 = 0; kt2 < 2; ++kt2)
#pragma unroll
            for (int i = 0; i < 16; ++i) { const float e = __builtin_amdgcn_exp2f(sacc[kt2][i] - m_use); sacc[kt2][i] = e; rs += e; }
        l_run += rs;
#pragma unroll
        for (int kt2 = 0; kt2 < 2; ++kt2)
#pragma unroll
            for (int s2 = 0; s2 < 2; ++s2) {
                bf16x8 pf; { u32x4 w; w.x = pk2(sacc[kt2][8 * s2 + 0], sacc[kt2][8 * s2 + 1]); w.y = pk2(sacc[kt2][8 * s2 + 2], sacc[kt2][8 * s2 + 3]);
                    w.z = pk2(sacc[kt2][8 * s2 + 4], sacc[kt2][8 * s2 + 5]); w.w = pk2(sacc[kt2][8 * s2 + 6], sacc[kt2][8 * s2 + 7]); pf = __builtin_bit_cast(bf16x8, w); }
#pragma unroll
                for (int dt = 0; dt < 2; ++dt) {
                    const unsigned char* va = base + FA_KB + (32 * dt + r31) * 136 + (32 * kt2 + 16 * s2 + 4 * hh) * 2;
                    const u32x2 lo = *(const u32x2*)(va), hi = *(const u32x2*)(va + 16);
                    u32x4 w; w.x = lo.x; w.y = lo.y; w.z = hi.x; w.w = hi.y;
                    ot[dt] = __builtin_amdgcn_mfma_f32_32x32x16_bf16(__builtin_bit_cast(bf16x8, w), pf, ot[dt], 0, 0, 0);
                }
            }
        if (!more) break;
        { unsigned char* nb = lds + (st ^ 1) * FA_STAGE; *(u32x4*)(nb + koff) = rk; u32x2 a, b2; a.x = rv.x; a.y = rv.y; b2.x = rv.z; b2.y = rv.w; *(u32x2*)(nb + voff) = a; *(u32x2*)(nb + voff + 8) = b2; }
        __syncthreads();
        st ^= 1; j = jn;
    }
}
DEV void phase_flash(const Params& p, unsigned char* lds) {
    const int tid = threadIdx.x, lane = tid & 63, wid = tid >> 6;
    const int vb = vblock(), G = gridDim.x;
    unsigned char* ws = p.ws;
    const int r31 = lane & 31, hh = lane >> 5;
    unsigned long long* red = (unsigned long long*)(lds + 2 * FA_STAGE);
    for (int it = vb; it < 1024; it += G) {
        const int rnd = it / G, pos = it % G; int sidx = (rnd & 1) ? (rnd * G + (G - 1 - pos)) : (rnd * G + pos); if (G != 256) sidx = it;
        const int ci = 63 - (sidx >> 4), bg = sidx & 15, b = bg >> 1, g = bg & 1;
        const int head = g * 4 + (wid >> 1);
        const int t = ci * 64 + (wid & 1) * 32 + r31;
        const size_t tok = (size_t)b * SEQ + t;
        bf16x8 qf[4];
        { const bf16_t* qp = (const bf16_t*)(ws + WS_Q) + ((size_t)(b * 8 + head) * SEQ + t) * 64 + 8 * hh;
#pragma unroll
            for (int s = 0; s < 4; ++s) qf[s] = *(const bf16x8*)(qp + 16 * s); }
        const unsigned long long mymask = ((const unsigned long long*)(ws + WS_SELM))[(size_t)bg * SEQ + t];
        unsigned long long orm = mymask;
#pragma unroll
        for (int o = 1; o < 32; o <<= 1) { const unsigned lo = __shfl_xor((unsigned)orm, o), hi = __shfl_xor((unsigned)(orm >> 32), o); orm |= ((unsigned long long)hi << 32) | lo; }
        __syncthreads();
        if (wid < 2 && lane == 0) red[wid] = orm;
        __syncthreads();
        const unsigned long long need = red[0] | red[1];
        f32x16 oc[2];
        {
            f32x16 ot[2]; float m_run = -1e30f, l_run = 0.f;
#pragma unroll
            for (int dt = 0; dt < 2; ++dt)
#pragma unroll
                for (int i = 0; i < 16; ++i) ot[dt][i] = 0.f;
            fa_branch<true>(lds, (const bf16_t*)(ws + WS_KS), (const bf16_t*)(ws + WS_VST), ci, bg, qf, t, mymask, need, ot, m_run, l_run);
            const float lt = l_run + __shfl_xor(l_run, 32);
            const float sc = ((const float*)(ws + WS_GATES))[tok * 24 + head * 3 + 1] / lt;
#pragma unroll
            for (int dt = 0; dt < 2; ++dt)
#pragma unroll
                for (int i = 0; i < 16; ++i) oc[dt][i] = ot[dt][i] * sc;
        }
        {
            f32x16 ot[2]; float m_run = -1e30f, l_run = 0.f;
#pragma unroll
            for (int dt = 0; dt < 2; ++dt)
#pragma unroll
                for (int i = 0; i < 16; ++i) ot[dt][i] = 0.f;
            fa_branch<false>(lds, (const bf16_t*)(ws + WS_KW), (const bf16_t*)(ws + WS_VWT), ci, bg, qf, t, 0ull, 0ull, ot, m_run, l_run);
            const float lt = l_run + __shfl_xor(l_run, 32);
            const float sc = ((const float*)(ws + WS_GATES))[tok * 24 + head * 3 + 2] / lt;
#pragma unroll
            for (int dt = 0; dt < 2; ++dt)
#pragma unroll
                for (int i = 0; i < 16; ++i) oc[dt][i] += ot[dt][i] * sc;
        }
        {
            const bf16_t* ocp = (const bf16_t*)(ws + WS_OC) + tok * 512 + head * 64;
            bf16_t* mix = (bf16_t*)(ws + WS_R1) + tok * 1024 + head * 64;
            float ss = 0.f;
#pragma unroll
            for (int dt = 0; dt < 2; ++dt)
#pragma unroll
                for (int g4 = 0; g4 < 4; ++g4) { const int d0 = 32 * dt + 8 * g4 + 4 * hh; const u32x2 c = *(const u32x2*)(ocp + d0);
                    const float v0 = oc[dt][4 * g4 + 0] + bflo(c.x), v1 = oc[dt][4 * g4 + 1] + bfhi(c.x), v2 = oc[dt][4 * g4 + 2] + bflo(c.y), v3 = oc[dt][4 * g4 + 3] + bfhi(c.y);
                    ss += (v0 * v0 + v1 * v1) + (v2 * v2 + v3 * v3);
                    u32x2 w; w.x = pk2(v0, v1); w.y = pk2(v2, v3); *(u32x2*)(mix + d0) = w; }
            ss += __shfl_xor(ss, 32);
            if (hh == 0) atomicAdd((float*)(ws + WS_ROWSS) + tok, ss);
        }
    }
}

DEV int swz256(int row, int chunk) { return row * 256 + ((chunk ^ (row & 15)) << 4); }
DEV void hgrn_cumsum(const Params& p, int bh, int c, float* segs, f32x2 (&lf)[8], f32x2 (&a)[8], f32x2& r, f32x2& alast) {
    const int tid = threadIdx.x, k2 = tid & 63, tq = tid >> 6;
    const int b = bh >> 2, h = bh & 3;
    const float* HL = (const float*)(p.ws + WS_HLOGF) + ((size_t)b * SEQ + c * 64 + tq * 8) * 512 + h * 128 + 2 * k2;
#pragma unroll
    for (int i = 0; i < 8; ++i) lf[i] = *(const f32x2*)(HL + (size_t)i * 512);
    f32x2 run = (f32x2){0.f, 0.f};
#pragma unroll
    for (int i = 0; i < 8; ++i) { run = run + lf[i]; a[i] = run; }
    *(f32x2*)(segs + tq * 128 + 2 * k2) = run;
    __syncthreads();
    f32x2 off = (f32x2){0.f, 0.f}, tot = off, rr = off;
#pragma unroll
    for (int q = 0; q < 8; ++q) { const f32x2 s = *(const f32x2*)(segs + q * 128 + 2 * k2); if (q < tq) off = off + s; if (q < 4) rr = rr + s; tot = tot + s; }
#pragma unroll
    for (int i = 0; i < 8; ++i) a[i] = a[i] + off;
    r = rr; alast = tot;
}
DEV void hgrn_stage_vt(const Params& p, int bh, int c, unsigned char* vt) {
    const int tid = threadIdx.x, k2 = tid & 63, tq = tid >> 6;
    const int b = bh >> 2, h = bh & 3;
    const bf16_t* HV = (const bf16_t*)(p.ws + WS_HV) + ((size_t)b * SEQ + c * 64 + tq * 8) * 512 + h * 128 + 2 * k2;
    unsigned vv[8];
#pragma unroll
    for (int i = 0; i < 8; ++i) vv[i] = *(const unsigned*)(HV + (size_t)i * 512);
    u32x4 lo, hi;
    lo.x = (vv[0] & 0xffffu) | (vv[1] << 16); lo.y = (vv[2] & 0xffffu) | (vv[3] << 16); lo.z = (vv[4] & 0xffffu) | (vv[5] << 16); lo.w = (vv[6] & 0xffffu) | (vv[7] << 16);
    hi.x = (vv[0] >> 16) | (vv[1] & 0xffff0000u); hi.y = (vv[2] >> 16) | (vv[3] & 0xffff0000u); hi.z = (vv[4] >> 16) | (vv[5] & 0xffff0000u); hi.w = (vv[6] >> 16) | (vv[7] & 0xffff0000u);
    *(u32x4*)(vt + swz(2 * k2, tq)) = lo; *(u32x4*)(vt + swz(2 * k2 + 1, tq)) = hi;
}
constexpr int H1_KT = 0, H1_VT = 16384, H1_SEG = 32768, H1_EK = H1_SEG + 4096;
DEV void phase_hgrn_a1(const Params& p, unsigned char* lds) {
    const int tid = threadIdx.x, lane = tid & 63, wid = tid >> 6, k2 = tid & 63, tq = tid >> 6;
    const int vb = vblock(), G = gridDim.x;
    const int frow = lane & 15, fq = lane >> 4, wr = wid >> 1, wc = wid & 1;
    float* segs = (float*)(lds + H1_SEG); float* ek = (float*)(lds + H1_EK);
    bf16_t* ubuf = (bf16_t*)(p.ws + WS_UBUF); float* dbuf = (float*)(p.ws + WS_DBUF);
    for (int item = vb; item < 2048; item += G) {
        const int bh = item >> 6, c = item & 63;
        __syncthreads();
        f32x2 lf[8], a[8], r, al;
        hgrn_cumsum(p, bh, c, segs, lf, a, r, al);
        {
            float kx[8], ky[8];
#pragma unroll
            for (int i = 0; i < 8; ++i) { kx[i] = (1.f - __expf(lf[i].x)) * __expf(fminf(r.x - a[i].x, 80.f)); ky[i] = (1.f - __expf(lf[i].y)) * __expf(fminf(r.y - a[i].y, 80.f)); }
            u32x4 w0, w1;
            w0.x = pk2(kx[0], kx[1]); w0.y = pk2(kx[2], kx[3]); w0.z = pk2(kx[4], kx[5]); w0.w = pk2(kx[6], kx[7]);
            w1.x = pk2(ky[0], ky[1]); w1.y = pk2(ky[2], ky[3]); w1.z = pk2(ky[4], ky[5]); w1.w = pk2(ky[6], ky[7]);
            *(u32x4*)(lds + H1_KT + swz(2 * k2, tq)) = w0; *(u32x4*)(lds + H1_KT + swz(2 * k2 + 1, tq)) = w1;
        }
        hgrn_stage_vt(p, bh, c, lds + H1_VT);
        if (tq == 7) { ek[2 * k2] = __expf(al.x - r.x); ek[2 * k2 + 1] = __expf(al.y - r.y); f32x2 d; d.x = __expf(al.x); d.y = __expf(al.y); *(f32x2*)(dbuf + (size_t)item * 128 + 2 * k2) = d; }
        __syncthreads();
        f32x4 acc[2][4];
#pragma unroll
        for (int m = 0; m < 2; ++m)
#pragma unroll
            for (int n = 0; n < 4; ++n) acc[m][n] = (f32x4){0.f, 0.f, 0.f, 0.f};
        const int sx = (frow >> 1) & 7;
#pragma unroll
        for (int ks = 0; ks < 2; ++ks) {
            const int co = ((ks * 4 + fq) ^ sx) << 4;
            bf16x8 af[2], bfr[4];
#pragma unroll
            for (int m = 0; m < 2; ++m) af[m] = *(const bf16x8*)(lds + H1_VT + (32 * wr + 16 * m + frow) * 128 + co);
#pragma unroll
            for (int n = 0; n < 4; ++n) bfr[n] = *(const bf16x8*)(lds + H1_KT + (64 * wc + 16 * n + frow) * 128 + co);
#pragma unroll
            for (int m = 0; m < 2; ++m)
#pragma unroll
                for (int n = 0; n < 4; ++n) acc[m][n] = __builtin_amdgcn_mfma_f32_16x16x32_bf16(bfr[n], af[m], acc[m][n], 0, 0, 0);
        }
#pragma unroll
        for (int m = 0; m < 2; ++m) { const int v = 32 * wr + 16 * m + frow;
#pragma unroll
            for (int n = 0; n < 4; ++n) { const int k0 = 64 * wc + 16 * n + 4 * fq; const f32x4 e = *(const f32x4*)(ek + k0); const f32x4 o = acc[m][n] * e;
                u32x2 w; w.x = pk2(o.x, o.y); w.y = pk2(o.z, o.w); *(u32x2*)(ubuf + ((size_t)item * 128 + v) * 128 + k0) = w; } }
    }
}
DEV void phase_hgrn_a2(const Params& p, unsigned char* lds) {
    const int G = gridDim.x;
    bf16_t* ubuf = (bf16_t*)(p.ws + WS_UBUF); const float* dbuf = (const float*)(p.ws + WS_DBUF);
    for (int gid = blockIdx.x * NT + threadIdx.x; gid < 131072; gid += G * NT) {
        const int bh = gid >> 12, v = (gid >> 5) & 127, k4 = gid & 31;
        bf16_t* u = ubuf + ((size_t)bh * 64 * 128 + v) * 128 + 4 * k4;
        const float* d = dbuf + (size_t)bh * 64 * 128 + 4 * k4;
        f32x4 S = (f32x4){0.f, 0.f, 0.f, 0.f};
        for (int c0 = 0; c0 < 64; c0 += 8) {
            u32x2 uu[8]; f32x4 dd[8];
#pragma unroll
            for (int j = 0; j < 8; ++j) { uu[j] = *(const u32x2*)(u + (size_t)(c0 + j) * 16384); dd[j] = *(const f32x4*)(d + (size_t)(c0 + j) * 128); }
#pragma unroll
            for (int j = 0; j < 8; ++j) { u32x2 w; w.x = pk2(S.x, S.y); w.y = pk2(S.z, S.w); *(u32x2*)(u + (size_t)(c0 + j) * 16384) = w;
                S.x = dd[j].x * S.x + bflo(uu[j].x); S.y = dd[j].y * S.y + bfhi(uu[j].x); S.z = dd[j].z * S.z + bflo(uu[j].y); S.w = dd[j].w * S.w + bfhi(uu[j].y); }
        }
    }
}
constexpr int H3_QH = 0, H3_QA = 16384, H3_KH = 32768, H3_VT = 49152, H3_PP = 65536, H3_ST = 73728, H3_SEG = 106496, H3_RED = 110592;
DEV void phase_hgrn_a3(const Params& p, unsigned char* lds) {
    const int tid = threadIdx.x, lane = tid & 63, wid = tid >> 6, k2 = tid & 63, tq = tid >> 6;
    const int vb = vblock(), G = gridDim.x;
    const int frow = lane & 15, fq = lane >> 4;
    float* segs = (float*)(lds + H3_SEG); float* red = (float*)(lds + H3_RED);
    const bf16_t* ubuf = (const bf16_t*)(p.ws + WS_UBUF);
    for (int item = vb; item < 2048; item += G) {
        const int bh = item >> 6, c = item & 63, b = bh >> 2, h = bh & 3;
        __syncthreads();
        f32x2 lf[8], a[8], r, al;
        hgrn_cumsum(p, bh, c, segs, lf, a, r, al);
        {
            const bf16_t* HQ = (const bf16_t*)(p.ws + WS_HQ) + ((size_t)b * SEQ + c * 64 + tq * 8) * 512 + h * 128 + 2 * k2;
            unsigned qq[8];
#pragma unroll
            for (int i = 0; i < 8; ++i) qq[i] = *(const unsigned*)(HQ + (size_t)i * 512);
#pragma unroll
            for (int i = 0; i < 8; ++i) { const int t = 8 * tq + i; const float q0 = bflo(qq[i]), q1 = bfhi(qq[i]);
                const int off = swz256(t, k2 >> 2) + (k2 & 3) * 4;
                *(unsigned*)(lds + H3_QH + off) = pk2(q0 * __expf(fminf(a[i].x - r.x, 80.f)), q1 * __expf(fminf(a[i].y - r.y, 80.f)));
                *(unsigned*)(lds + H3_QA + off) = pk2(q0 * __expf(a[i].x), q1 * __expf(a[i].y));
                *(unsigned*)(lds + H3_KH + off) = pk2((1.f - __expf(lf[i].x)) * __expf(fminf(r.x - a[i].x, 80.f)), (1.f - __expf(lf[i].y)) * __expf(fminf(r.y - a[i].y, 80.f))); }
        }
        hgrn_stage_vt(p, bh, c, lds + H3_VT);
        {
            const bf16_t* st = ubuf + (size_t)item * 16384;
#pragma unroll
            for (int i = 0; i < 4; ++i) { const int q = tid + NT * i, v = q >> 4, ch = q & 15; *(u32x4*)(lds + H3_ST + swz256(v, ch)) = *(const u32x4*)(st + v * 128 + ch * 8); }
        }
        __syncthreads();
        {
            const int wr = wid >> 1, wc = wid & 1;
            f32x4 acc[2];
            acc[0] = (f32x4){0.f, 0.f, 0.f, 0.f}; acc[1] = acc[0];
            if (32 * wc <= 16 * wr + 15) {
#pragma unroll
                for (int ks = 0; ks < 4; ++ks) {
                    const int co = ((ks * 4 + fq) ^ frow) << 4;
                    const bf16x8 af = *(const bf16x8*)(lds + H3_QH + (16 * wr + frow) * 256 + co);
#pragma unroll
                    for (int n = 0; n < 2; ++n) { const bf16x8 bfr = *(const bf16x8*)(lds + H3_KH + (32 * wc + 16 * n + frow) * 256 + co);
                        acc[n] = __builtin_amdgcn_mfma_f32_16x16x32_bf16(bfr, af, acc[n], 0, 0, 0); }
                }
            }
            const int t = 16 * wr + frow;
#pragma unroll
            for (int n = 0; n < 2; ++n) { const int s0 = 32 * wc + 16 * n + 4 * fq; f32x4 v = acc[n];
                v.x = (s0 + 0 <= t) ? v.x : 0.f; v.y = (s0 + 1 <= t) ? v.y : 0.f; v.z = (s0 + 2 <= t) ? v.z : 0.f; v.w = (s0 + 3 <= t) ? v.w : 0.f;
                u32x2 w; w.x = pk2(v.x, v.y); w.y = pk2(v.z, v.w);
                *(u32x2*)(lds + H3_PP + t * 128 + ((((s0 >> 3)) ^ ((t >> 1) & 7)) << 4) + (s0 & 7) * 2) = w; }
        }
        __syncthreads();
        {
            const int wr = wid >> 2, wc = wid & 3;
            f32x4 acc[2][2];
#pragma unroll
            for (int m = 0; m < 2; ++m)
#pragma unroll
                for (int n = 0; n < 2; ++n) acc[m][n] = (f32x4){0.f, 0.f, 0.f, 0.f};
            const int sx = (frow >> 1) & 7;
#pragma unroll
            for (int ks = 0; ks < 2; ++ks) {
                const int co = ((ks * 4 + fq) ^ sx) << 4;
                bf16x8 af[2], bfr[2];
#pragma unroll
                for (int m = 0; m < 2; ++m) af[m] = *(const bf16x8*)(lds + H3_PP + (32 * wr + 16 * m + frow) * 128 + co);
#pragma unroll
                for (int n = 0; n < 2; ++n) bfr[n] = *(const bf16x8*)(lds + H3_VT + (32 * wc + 16 * n + frow) * 128 + co);
#pragma unroll
                for (int m = 0; m < 2; ++m)
#pragma unroll
                    for (int n = 0; n < 2; ++n) acc[m][n] = __builtin_amdgcn_mfma_f32_16x16x32_bf16(bfr[n], af[m], acc[m][n], 0, 0, 0);
            }
#pragma unroll
            for (int ks = 0; ks < 4; ++ks) {
                const int co = ((ks * 4 + fq) ^ frow) << 4;
                bf16x8 af[2], bfr[2];
#pragma unroll
                for (int m = 0; m < 2; ++m) af[m] = *(const bf16x8*)(lds + H3_QA + (32 * wr + 16 * m + frow) * 256 + co);
#pragma unroll
                for (int n = 0; n < 2; ++n) bfr[n] = *(const bf16x8*)(lds + H3_ST + (32 * wc + 16 * n + frow) * 256 + co);
#pragma unroll
                for (int m = 0; m < 2; ++m)
#pragma unroll
                    for (int n = 0; n < 2; ++n) acc[m][n] = __builtin_amdgcn_mfma_f32_16x16x32_bf16(bfr[n], af[m], acc[m][n], 0, 0, 0);
            }
#pragma unroll
            for (int m = 0; m < 2; ++m) { float ss = 0.f;
#pragma unroll
                for (int n = 0; n < 2; ++n) { const f32x4 v = acc[m][n]; ss += (v.x * v.x + v.y * v.y) + (v.z * v.z + v.w * v.w); }
                ss += __shfl_xor(ss, 16); ss += __shfl_xor(ss, 32);
                if (fq == 0) red[(32 * wr + 16 * m + frow) * 4 + wc] = ss; }
            __syncthreads();
#pragma unroll
            for (int m = 0; m < 2; ++m) { const int t = 32 * wr + 16 * m + frow; const f32x4 q4 = *(const f32x4*)(red + t * 4);
                const float rs = rsqrtf(((q4.x + q4.y) + (q4.z + q4.w)) * (1.f / 128.f) + RMS_EPS);
                const size_t row = (size_t)b * SEQ + c * 64 + t;
#pragma unroll
                for (int n = 0; n < 2; ++n) { const int v0 = 32 * wc + 16 * n + 4 * fq; const f32x4 gn = *(const f32x4*)(p.g_hn + v0);
                    const u32x2 gg = *(const u32x2*)((const bf16_t*)(p.ws + WS_HG) + row * 512 + h * 128 + v0);
                    const f32x4 o = acc[m][n];
                    u32x2 w; w.x = pk2(o.x * rs * gn.x * bflo(gg.x), o.y * rs * gn.y * bfhi(gg.x)); w.y = pk2(o.z * rs * gn.z * bflo(gg.y), o.w * rs * gn.w * bfhi(gg.y));
                    *(u32x2*)((bf16_t*)(p.ws + WS_R1) + row * 1024 + 512 + h * 128 + v0) = w; } }
        }
    }
}

DEV void phase_normalize(const Params& p, unsigned char* lds) {
    const int tid = threadIdx.x, lane = tid & 63, wid = tid >> 6;
    const int vb = vblock(), G = gridDim.x;
    unsigned char* ws = p.ws;
    bf16_t* mix = (bf16_t*)(ws + WS_R1); const float* rowss = (const float*)(ws + WS_ROWSS); const bf16_t* HG = (const bf16_t*)(ws + WS_HG);
    for (int m = vb * 8 + wid; m < NTOK; m += G * 8) {
        {
            const float r = rsqrtf(rowss[m] * (1.f / 512.f) + RMS_EPS);
            u32x4* pp = (u32x4*)(mix + (size_t)m * 1024) + lane; u32x4 v = *pp;
            v.x = pk2(bflo(v.x) * r, bfhi(v.x) * r); v.y = pk2(bflo(v.y) * r, bfhi(v.y) * r); v.z = pk2(bflo(v.z) * r, bfhi(v.z) * r); v.w = pk2(bflo(v.w) * r, bfhi(v.w) * r);
            *pp = v;
        }
    }
    __syncthreads();
    {
        float* tl = (float*)lds;
        for (int r = vb; r < 32 * 16 * 16; r += G) { const int e = r / 256, q = r % 256; SrcW13 s{p.w1 + (size_t)e * 1024 * 512, p.w3 + (size_t)e * 1024 * 512, p.ffn_g};
            convert_tile(tl, s, (bf16_t*)(ws + WS_W13T) + (size_t)e * 1024 * 1024, 1024, (q / 16) * 64, (q % 16) * 64); }
    }
}

struct EpiOut8 { const Params& p;
    DEV void operator()(const f32x4 (&acc)[2][2][4][2], const pg8::Unit& u, int wr, int wc, int fr, int fq) const {
#pragma unroll
        for (int ai = 0; ai < 2; ++ai)
#pragma unroll
            for (int m = 0; m < 4; ++m) { const size_t row = (size_t)u.pm * 256 + ai * 128 + wr * 64 + m * 16 + fr;
#pragma unroll
                for (int bj = 0; bj < 2; ++bj)
#pragma unroll
                    for (int n = 0; n < 2; ++n) { const int c = u.pn * 256 + 64 * wc + 32 * bj + 16 * n + 4 * fq; const f32x4 xv = *(const f32x4*)(p.x + row * DM + c); *(f32x4*)(p.out + row * DM + c) = xv + acc[ai][bj][m][n]; } }
    } };
DEV void phase_outproj(const Params& p, unsigned char* lds) {
    pg8::Gemm g{(const bf16_t*)(p.ws + WS_R1), (const bf16_t*)(p.ws + WS_WOUTT), NTOK, DM, DM};
    pg8::StaticOrder S; S.init(NTOK, DM, (int)gridDim.x, (int)blockIdx.x);
    EpiOut8 E{p};
    pg8::gemm_phase((PG8_LAS unsigned char*)lds, g, S, E);
}

constexpr int RT_W = 0, RT_LG = 49152, RT_RS = RT_LG + 128 * 49 * 4, RT_HIST = RT_RS + 512, RT_BASE = RT_HIST + 512, RT_LDS = RT_BASE + 512;
DEV void phase_router(const Params& p, unsigned char* lds) {
    const int tid = threadIdx.x, lane = tid & 63, wid = tid >> 6, frow = lane & 15, fq = lane >> 4;
    const int vb = vblock(), G = gridDim.x;
    unsigned char* ws = p.ws;
    float* lg = (float*)(lds + RT_LG); float* rsd = (float*)(lds + RT_RS);
    int* hist = (int*)(lds + RT_HIST); int* basep = (int*)(lds + RT_BASE);
    const bf16_t* rw = (const bf16_t*)(ws + WS_RW);
    for (int it = vb; it < NTOK / 128; it += G) {
        const size_t row0 = (size_t)it * 128;
        const size_t trow = row0 + 16 * wid + frow;
        const float* hrow = p.out + trow * DM + 8 * fq;
        bf16_t* hbrow = (bf16_t*)(ws + WS_R1) + trow * DM + 8 * fq;
        f32x4 acc[3]; float ss = 0.f;
#pragma unroll
        for (int nt = 0; nt < 3; ++nt) acc[nt] = (f32x4){0.f, 0.f, 0.f, 0.f};
        if (tid < 128) hist[tid] = 0;
        for (int kc = 0; kc < 4; ++kc) {
            __syncthreads();
#pragma unroll
            for (int i = 0; i < 6; ++i) { const int idx = tid + NT * i, r = idx >> 5, c = idx & 31;
                *(u32x4*)(lds + RT_W + r * 512 + ((c ^ (r & 15)) << 4)) = *(const u32x4*)(rw + (size_t)r * 1024 + kc * 256 + c * 8); }
            f32x4 xa[8][2];
#pragma unroll
            for (int ks = 0; ks < 8; ++ks) { xa[ks][0] = *(const f32x4*)(hrow + kc * 256 + 32 * ks); xa[ks][1] = *(const f32x4*)(hrow + kc * 256 + 32 * ks + 4); }
            __syncthreads();
#pragma unroll
            for (int ks = 0; ks < 8; ++ks) {
                const f32x4 a = xa[ks][0], b = xa[ks][1];
                ss += ((a.x * a.x + a.y * a.y) + (a.z * a.z + a.w * a.w)) + ((b.x * b.x + b.y * b.y) + (b.z * b.z + b.w * b.w));
                u32x4 hi; hi.x = pk2(a.x, a.y); hi.y = pk2(a.z, a.w); hi.z = pk2(b.x, b.y); hi.w = pk2(b.z, b.w);
                u32x4 lo; lo.x = pk2(a.x - bflo(hi.x), a.y - bfhi(hi.x)); lo.y = pk2(a.z - bflo(hi.y), a.w - bfhi(hi.y)); lo.z = pk2(b.x - bflo(hi.z), b.y - bfhi(hi.z)); lo.w = pk2(b.z - bflo(hi.w), b.w - bfhi(hi.w));
                *(u32x4*)(hbrow + kc * 256 + 32 * ks) = hi;
                const bf16x8 hh = __builtin_bit_cast(bf16x8, hi), hl = __builtin_bit_cast(bf16x8, lo);
                const int co = ((4 * ks + fq) ^ frow) << 4;
#pragma unroll
                for (int nt = 0; nt < 3; ++nt) {
                    const bf16x8 whi = *(const bf16x8*)(lds + RT_W + (16 * nt + frow) * 512 + co), wlo = *(const bf16x8*)(lds + RT_W + (48 + 16 * nt + frow) * 512 + co);
                    acc[nt] = __builtin_amdgcn_mfma_f32_16x16x32_bf16(whi, hh, acc[nt], 0, 0, 0);
                    acc[nt] = __builtin_amdgcn_mfma_f32_16x16x32_bf16(wlo, hh, acc[nt], 0, 0, 0);
                    acc[nt] = __builtin_amdgcn_mfma_f32_16x16x32_bf16(whi, hl, acc[nt], 0, 0, 0);
                }
            }
        }
        ss += __shfl_xor(ss, 16); ss += __shfl_xor(ss, 32);
        if (fq == 0) rsd[16 * wid + frow] = rsqrtf(ss * (1.f / DM) + RMS_EPS);
#pragma unroll
        for (int nt = 0; nt < 3; ++nt) { float* o = lg + (16 * wid + frow) * 49 + 16 * nt + 4 * fq; o[0] = acc[nt].x; o[1] = acc[nt].y; o[2] = acc[nt].z; o[3] = acc[nt].w; }
        __syncthreads();
        int bin = 0, slot = 0;
        if (tid < 128) {
            const float rs = rsd[tid];
            ((float*)(ws + WS_RSTD2))[row0 + tid] = rs;
            float gl[4]; int gi = 0; float gm = -1e30f;
#pragma unroll
            for (int c = 0; c < 4; ++c) { gl[c] = lg[tid * 49 + c] * rs + p.b_group[c]; if (gl[c] > gm) { gm = gl[c]; gi = c; } }
            float gs = 0.f;
#pragma unroll
            for (int c = 0; c < 4; ++c) gs += __expf(gl[c] - gm);
            const float pg = 1.f / gs;
            float el[8]; int i0 = 0; float m0 = -1e30f;
#pragma unroll
            for (int c = 0; c < 8; ++c) { el[c] = lg[tid * 49 + 4 + gi * 8 + c] * rs + p.b_expert[gi * 8 + c]; if (el[c] > m0) { m0 = el[c]; i0 = c; } }
            int i1 = 0; float m1 = -1e30f;
#pragma unroll
            for (int c = 0; c < 8; ++c) if (c != i0 && el[c] > m1) { m1 = el[c]; i1 = c; }
            const float e1 = __expf(m1 - m0); const float w0 = pg / (1.f + e1), w1 = pg * e1 / (1.f + e1);
            const int a = min(i0, i1), bb = max(i0, i1);
            bin = gi * 28 + (7 * a - (a * (a - 1)) / 2) + (bb - a - 1);
            f32x2 tw; tw.x = (i0 < i1) ? w0 : w1; tw.y = (i0 < i1) ? w1 : w0;
            ((f32x2*)(ws + WS_TOKW))[row0 + tid] = tw;
            slot = atomicAdd(&hist[bin], 1);
        }
        __syncthreads();
        if (tid < NBIN) { const int h = hist[tid]; basep[tid] = h ? atomicAdd((int*)(ws + WS_CTL) + tid, h) : 0; }
        __syncthreads();
        if (tid < 128) ((int*)(ws + WS_BINL))[(size_t)bin * BINCAP + basep[bin] + slot] = (int)(row0 + tid);
        __syncthreads();
    }
}

DEV void moe_tiles(const Params& p, int* tstart  ) {
    const int tid = threadIdx.x;
    __syncthreads();
    if (tid == 0) { const int* cnt = (const int*)(p.ws + WS_CTL); int s = 0; for (int i = 0; i < NBIN; ++i) { tstart[i] = s; s += (cnt[i] + 127) >> 7; } tstart[NBIN] = s; }
    __syncthreads();
}
DEV void bin_experts(int bin, int& ea, int& eb) { const int gi = bin / 28; int pi = bin % 28, a = 0; while (pi >= 7 - a) { pi -= 7 - a; ++a; } ea = gi * 8 + a; eb = gi * 8 + a + 1 + pi; }
struct AGather { const bf16_t* hb; const int* list; int n;
    DEV const bf16_t* row(int r) const { const int t = list[r < n ? r : 0]; return hb + (size_t)t * DM; } };
struct EpiMoe1 { const Params& p; const int* list; int n; size_t hrow0; int nt;
    DEV void operator()(f32x4 (&acc)[4][4], int wr, int wc, int lane) const {
        const int frow = lane & 15, fq = lane >> 4;
        bf16_t* hbuf = (bf16_t*)(p.ws + WS_HBUF);
#pragma unroll
        for (int m = 0; m < 4; ++m) { const int r = wr * 64 + m * 16 + frow; if (r >= n) continue;
            const int t = list[r]; const float rs = ((const float*)(p.ws + WS_RSTD2))[t]; const f32x2 tw = ((const f32x2*)(p.ws + WS_TOKW))[t]; const float w = nt < 4 ? tw.x : tw.y;
#pragma unroll
            for (int n2 = 0; n2 < 4; ++n2) { const f32x4 v = acc[m][n2] * rs; const int f = ((nt & 3) * 256 + wc * 64 + n2 * 16 + fq * 4) >> 1;
                *(unsigned*)(hbuf + (hrow0 + r) * 1024 + (nt < 4 ? 0 : 512) + f) = pk2(siluf_(v.x) * v.y * w, siluf_(v.z) * v.w * w); } }
    } };
DEV void phase_moe1(const Params& p, unsigned char* lds) {
    const int vb = vblock(), G = gridDim.x;
    int* tstart = (int*)(lds + G_LDS);
    moe_tiles(p, tstart);
    const int T = tstart[NBIN], U = T * 8;
    for (int u = vb; u < U; u += G) {
        const int tile = u >> 3, nt = u & 7;
        int bin = 0; while (tstart[bin + 1] <= tile) ++bin;
        const int mt = tile - tstart[bin]; int ea, eb; bin_experts(bin, ea, eb);
        const int cnt = ((const int*)(p.ws + WS_CTL))[bin]; const int n = min(128, cnt - mt * 128);
        const int* list = (const int*)(p.ws + WS_BINL) + (size_t)bin * BINCAP + mt * 128;
        AGather al{(const bf16_t*)(p.ws + WS_R1), list, n};
        BRows bl{(const bf16_t*)(p.ws + WS_W13T) + ((size_t)(nt < 4 ? ea : eb) * 1024 + (nt & 3) * 256) * 1024, 1024};
        EpiMoe1 ep{p, list, n, (size_t)tile * 128, nt};
        gemm_tile(lds, al, bl, DM / 64, ep);
    }
}
struct BPair { const bf16_t* wa; const bf16_t* wb; DEV const bf16_t* ptr(int n, int kt) const { return kt < 8 ? wa + (size_t)n * 512 + kt * 64 : wb + (size_t)n * 512 + (kt - 8) * 64; } };
struct EpiMoe2 { const Params& p; const int* list; int n; int n0;
    DEV void operator()(f32x4 (&acc)[4][4], int wr, int wc, int lane) const {
        const int frow = lane & 15, fq = lane >> 4;
#pragma unroll
        for (int m = 0; m < 4; ++m) { const int r = wr * 64 + m * 16 + frow; if (r >= n) continue; const size_t t = list[r];
#pragma unroll
            for (int n2 = 0; n2 < 4; ++n2) { float* o = p.out + t * DM + n0 + wc * 64 + n2 * 16 + fq * 4; *(f32x4*)o = *(const f32x4*)o + acc[m][n2]; } }
    } };
DEV void phase_moe2(const Params& p, unsigned char* lds) {
    const int vb = vblock(), G = gridDim.x;
    int* tstart = (int*)(lds + G_LDS);
    moe_tiles(p, tstart);
    const int T = tstart[NBIN], U = T * 4;
    for (int u = vb; u < U; u += G) {
        const int tile = u >> 2, nt = u & 3;
        int bin = 0; while (tstart[bin + 1] <= tile) ++bin;
        const int mt = tile - tstart[bin]; int ea, eb; bin_experts(bin, ea, eb);
        const int cnt = ((const int*)(p.ws + WS_CTL))[bin]; const int n = min(128, cnt - mt * 128);
        const int* list = (const int*)(p.ws + WS_BINL) + (size_t)bin * BINCAP + mt * 128;
        ARows al{(const bf16_t*)(p.ws + WS_HBUF) + (size_t)tile * 128 * 1024, 1024};
        BPair bl{(const bf16_t*)(p.ws + WS_W2T) + ((size_t)ea * 1024 + nt * 256) * 512, (const bf16_t*)(p.ws + WS_W2T) + ((size_t)eb * 1024 + nt * 256) * 512};
        EpiMoe2 ep{p, list, n, nt * 256};
        gemm_tile(lds, al, bl, 16, ep);
    }
}

#define XB_TMO      128
#define XB_XCNT(j)  (256  + 64 * (j))
#define XB_XSUB(j)  (1280 + 64 * (j))
#define XB_XGEN(j)  (2304 + 64 * (j))
#define XB_TOP      3328
#define XB_TOPGEN   3392
#define XCD_BAR_WORDS 3456
#define XB_SPIN_CAP (1u << 20)
#define LAS __attribute__((address_space(3)))
constexpr size_t WS_BAR = WS_CTL + 4096;
DEV unsigned xb_ld(unsigned* p) { return __hip_atomic_load(p, __ATOMIC_RELAXED, __HIP_MEMORY_SCOPE_AGENT); }
DEV unsigned xb_add(unsigned* p, unsigned v) { return __hip_atomic_fetch_add(p, v, __ATOMIC_RELAXED, __HIP_MEMORY_SCOPE_AGENT); }
DEV unsigned xb_xcc_id() { return (unsigned)__builtin_amdgcn_s_getreg((3 << 11) | 20) & 0xFu; }
#define XB_SPIN(cond, bar) do { unsigned _sp = 0; while (cond) { __builtin_amdgcn_s_sleep(1); \
    if ((++_sp & 255u) == 0u) { if (xb_ld(&(bar)[XB_TMO])) break; if (_sp > XB_SPIN_CAP) { atomicAdd(&(bar)[XB_TMO], 1u); break; } } } } while (0)
struct XcdBarrier { unsigned* bar; unsigned x; volatile LAS unsigned* st; };
DEV XcdBarrier xcd_barrier_post(unsigned* bar, volatile LAS unsigned* st) {
    XcdBarrier b; b.bar = bar; b.x = xb_xcc_id(); b.st = st;
    if (threadIdx.x == 0) (void)xb_add(&bar[XB_XCNT(b.x)], 1u);
    return b;
}
DEV void xcd_barrier_complete(unsigned* bar, unsigned x, unsigned& nloc, unsigned& nx) {
    const unsigned G = gridDim.x * gridDim.y * gridDim.z;
    unsigned sum, cnt, mine, sp = 0u;
    for (;;) {
        sum = 0u; cnt = 0u; mine = 0u;
#pragma unroll
        for (unsigned j = 0; j < 16; ++j) { const unsigned c = xb_ld(&bar[XB_XCNT(j)]); sum += c; cnt += (c > 0u) ? 1u : 0u; mine = (j == x) ? c : mine; }
        if (sum == G) break;
        __builtin_amdgcn_s_sleep(1);
        if ((++sp & 255u) == 0u) { if (xb_ld(&bar[XB_TMO])) break; if (sp > XB_SPIN_CAP) { atomicAdd(&bar[XB_TMO], 1u); break; } }
    }
    nloc = mine > 0u ? mine : 1u; nx = cnt > 0u ? cnt : 1u;
}
DEV void xcd_barrier(const XcdBarrier& b) {
    asm volatile("s_waitcnt vmcnt(0)" ::: "memory");
    __syncthreads();
    if (threadIdx.x == 0) {
        unsigned* bar = b.bar;
        __builtin_amdgcn_s_waitcnt(0);
        unsigned nloc = b.st[0], nx = b.st[1];
        if (nloc == 0u) { xcd_barrier_complete(bar, b.x, nloc, nx); b.st[0] = nloc; b.st[1] = nx; }
        const unsigned old = xb_add(&bar[XB_XSUB(b.x)], 1u);
        const unsigned gen = old / nloc;
        if (old + 1u == (gen + 1u) * nloc) {
            __builtin_amdgcn_fence(__ATOMIC_RELEASE, "agent");
            asm volatile("s_waitcnt vmcnt(0)" ::: "memory");
            const unsigned og = xb_add(&bar[XB_TOP], 1u);
            const unsigned tg = og / nx;
            if (og + 1u == (tg + 1u) * nx) xb_add(&bar[XB_TOPGEN], 1u);
            else XB_SPIN(xb_ld(&bar[XB_TOPGEN]) == tg, bar);
            __builtin_amdgcn_fence(__ATOMIC_ACQUIRE, "agent");
            xb_add(&bar[XB_XGEN(b.x)], 1u);
            asm volatile("s_waitcnt vmcnt(0)" ::: "memory");
        } else {
            XB_SPIN(xb_ld(&bar[XB_XGEN(b.x)]) == gen, bar);
            __builtin_amdgcn_fence(__ATOMIC_ACQUIRE, "agent");
            asm volatile("s_waitcnt vmcnt(0)" ::: "memory");
        }
    }
    __syncthreads();
}

constexpr int LDS_BYTES = 144 * 1024;
constexpr int N_PHASES = 13;
__global__ void __launch_bounds__(NT) mega(Params p, int lo, int hi) {
    extern __shared__ __attribute__((aligned(16))) unsigned char lds[];
    volatile LAS unsigned* xst = (volatile LAS unsigned*)(lds + LDS_BYTES - 16);
    if (threadIdx.x < 4) xst[threadIdx.x] = 0u;
    __syncthreads();
    XcdBarrier xbar; xbar.bar = (unsigned*)(p.ws + WS_BAR); xbar.x = 0; xbar.st = xst;
    if (hi - lo > 1) xbar = xcd_barrier_post((unsigned*)(p.ws + WS_BAR), xst);
#define GRID_SYNC() xcd_barrier(xbar)
#ifndef PROBE_REPEAT
#define PROBE_REPEAT -1
#endif
#define RUN_PHASE(k, call) do { if (lo <= (k) && (k) < hi) { call; \
        if ((k) == PROBE_REPEAT) { GRID_SYNC(); \
            if ((k) == 5) { float* rz = (float*)(p.ws + WS_ROWSS); for (int i = blockIdx.x * NT + threadIdx.x; i < NTOK; i += gridDim.x * NT) rz[i] = 0.f; GRID_SYNC(); } \
            if ((k) == 11) { if (blockIdx.x == 0 && threadIdx.x < 128) ((int*)(p.ws + WS_CTL))[threadIdx.x] = 0; GRID_SYNC(); } \
            call; } \
        if ((k) + 1 < hi) GRID_SYNC(); } } while (0)
    RUN_PHASE(0, phase_prologue(p, lds));
    RUN_PHASE(1, phase_inproj(p, lds));
    RUN_PHASE(2, phase_cmp_a(p, lds));
    RUN_PHASE(3, phase_cmp_b(p, lds));
    RUN_PHASE(4, phase_cmp_attn(p, lds));
    RUN_PHASE(5, phase_flash(p, lds));
    RUN_PHASE(6, phase_hgrn_a1(p, lds));
    RUN_PHASE(7, phase_hgrn_a2(p, lds));
    RUN_PHASE(8, phase_hgrn_a3(p, lds));
    RUN_PHASE(9, phase_normalize(p, lds));
    RUN_PHASE(10, phase_outproj(p, lds));
    RUN_PHASE(11, phase_router(p, lds));
    RUN_PHASE(12, phase_moe1(p, lds));
    RUN_PHASE(13, phase_moe2(p, lds));
#undef RUN_PHASE
}

extern "C" void kernel_launch(void* const* d_in, const int* in_sizes, int n_in, void* d_out, int out_size, void* d_ws, size_t ws_size, hipStream_t stream) {
    static int grid = 0;
    if (grid == 0) {
        int dev = 0, cus = 0, per_cu = 0;
        hipGetDevice(&dev);
        hipDeviceGetAttribute(&cus, hipDeviceAttributeMultiprocessorCount, dev);
        hipFuncSetAttribute((const void*)mega, hipFuncAttributeMaxDynamicSharedMemorySize, LDS_BYTES);
        hipOccupancyMaxActiveBlocksPerMultiprocessor(&per_cu, (const void*)mega, NT, LDS_BYTES);
        if (per_cu < 1) per_cu = 1;
        grid = cus;
        if (ws_size < WS_END) fprintf(stderr, "kernel_launch: workspace too small: %zu < %zu\n", ws_size, (size_t)WS_END);
        fprintf(stderr, "kernel_launch: cus %d per_cu %d grid %d ws %zu\n", cus, per_cu, grid, ws_size);
    }
    Params p{};
    const float** pp = (const float**)&p;
    for (int i = 0; i < 23; ++i) pp[i] = (const float*)d_in[i];
    p.out = (float*)d_out; p.ws = (unsigned char*)d_ws;
#if N_LAUNCH_MODE == 1
    (void)hipMemsetAsync((unsigned char*)d_ws + WS_BAR, 0, XCD_BAR_WORDS * 4, stream);
    int lo = 0, hi = N_PHASES + 1;
    void* args[] = {&p, &lo, &hi};
    hipError_t e = hipLaunchCooperativeKernel((const void*)mega, dim3(grid), dim3(NT), args, LDS_BYTES, stream);
    if (e != hipSuccess) fprintf(stderr, "cooperative launch failed: %s\n", hipGetErrorString(e));
#else
    for (int ph = 0; ph <= N_PHASES; ++ph) hipLaunchKernelGGL(mega, dim3(grid), dim3(NT), LDS_BYTES, stream, p, ph, ph + 1);
#endif
}
```

```cpp
#include <hip/hip_runtime.h>
#include <hip/hip_cooperative_groups.h>
#include <cstdio>
#include <cstdint>
#include <cstring>
namespace cg = cooperative_groups;

#ifndef N_LAUNCH_MODE
#define N_LAUNCH_MODE 1
#endif

#define DEV __device__ __forceinline__
typedef unsigned short bf16_t;
typedef short bf16x8 __attribute__((ext_vector_type(8)));
typedef float f32x4 __attribute__((ext_vector_type(4)));
typedef float f32x2 __attribute__((ext_vector_type(2)));
typedef float f32x16 __attribute__((ext_vector_type(16)));
typedef unsigned u32x4 __attribute__((ext_vector_type(4)));
typedef unsigned u32x2 __attribute__((ext_vector_type(2)));

constexpr int NT = 512;
constexpr int BATCH = 8, SEQ = 4096, DM = 1024, NTOK = BATCH * SEQ;
constexpr int IN_COLS = 3352, INP = 3584;
constexpr int NC = 255;
constexpr float RMS_EPS = 1e-6f;
constexpr float QSCALE = 0.125f * 1.4426950408889634f;
constexpr int NBIN = 112;
constexpr int BINCAP = NTOK;

constexpr size_t MiB = 1ull << 20;
constexpr size_t WS_CTL    = 0;
constexpr size_t WS_RSTD1  = 1 * MiB;
constexpr size_t WS_RSTD2  = WS_RSTD1 + 128 * 1024;
constexpr size_t WS_ROWSS  = WS_RSTD2 + 128 * 1024;
constexpr size_t WS_TOKW   = WS_ROWSS + 128 * 1024;
constexpr size_t WS_LB     = WS_TOKW + 256 * 1024;
constexpr size_t WS_CBIAS  = WS_LB + 4096;
constexpr size_t WS_SELM   = 2 * MiB;
constexpr size_t WS_GATES  = 3 * MiB;
constexpr size_t WS_KCMP   = 6 * MiB;
constexpr size_t WS_VCMP   = WS_KCMP + 512 * 1024;
constexpr size_t WS_CW2T   = 7 * MiB;
constexpr size_t WS_RW     = 7 * MiB + 128 * 1024;
constexpr size_t WS_HID    = 8 * MiB;
constexpr size_t WS_CW1T   = 12 * MiB;
constexpr size_t WS_WOUTT  = 14 * MiB;
constexpr size_t WS_WINT   = 16 * MiB;
constexpr size_t WS_R1     = 24 * MiB;
constexpr size_t WS_Q      = 88 * MiB;
constexpr size_t WS_KC     = 120 * MiB;
constexpr size_t WS_VC     = 128 * MiB;
constexpr size_t WS_KS     = 136 * MiB;
constexpr size_t WS_KW     = 144 * MiB;
constexpr size_t WS_VST    = 152 * MiB;
constexpr size_t WS_VWT    = 160 * MiB;
constexpr size_t WS_OC     = 168 * MiB;
constexpr size_t WS_W13T   = 200 * MiB;
constexpr size_t WS_W2T    = 264 * MiB;
constexpr size_t WS_HQ     = 296 * MiB;
constexpr size_t WS_HV     = 328 * MiB;
constexpr size_t WS_HG     = 360 * MiB;
constexpr size_t WS_HLOGF  = 392 * MiB;
constexpr size_t WS_DBUF   = 456 * MiB;
constexpr size_t WS_END    = 457 * MiB;
constexpr size_t WS_UBUF   = WS_W13T;
constexpr size_t WS_BINL   = WS_HQ;
constexpr size_t WS_HBUF   = WS_HQ + 16 * MiB;

struct Params {
    const float *x, *attn_g, *ffn_g, *w_in, *w_out, *g_q, *g_k, *pos_k, *pos_v, *wk1, *wk2, *wv1, *wv2, *g_nsa, *lb_logits, *g_hn,
        *w_group, *b_group, *w_expert, *b_expert, *w1, *w3, *w2;
    float* out;
    unsigned char* ws;
};

typedef __bf16 bf16x2_t __attribute__((ext_vector_type(2)));
DEV unsigned pk2(float lo, float hi) { f32x2 f = {lo, hi}; return __builtin_bit_cast(unsigned, __builtin_convertvector(f, bf16x2_t)); }
DEV bf16_t f2bf(float f) { return (bf16_t)(pk2(f, 0.f) & 0xffffu); }
DEV float bf2f(bf16_t b) { return __uint_as_float(((unsigned)b) << 16); }
DEV float bflo(unsigned u) { return __uint_as_float(u << 16); }
DEV float bfhi(unsigned u) { return __uint_as_float(u & 0xffff0000u); }
DEV float sigmoidf_(float v) { return 1.f / (1.f + __expf(-v)); }
DEV float siluf_(float v) { return v / (1.f + __expf(-v)); }
DEV float wave_sum(float v) {
#pragma unroll
    for (int o = 1; o < 64; o <<= 1) v += __shfl_xor(v, o);
    return v;
}
DEV float wave_max(float v) {
#pragma unroll
    for (int o = 1; o < 64; o <<= 1) v = fmaxf(v, __shfl_xor(v, o));
    return v;
}
DEV int vblock() { const int G = gridDim.x, b = blockIdx.x; return (G % 8 == 0) ? (b % 8) * (G / 8) + b / 8 : b; }

namespace pg8 {
#define PG8_LAS __attribute__((address_space(3)))
constexpr int BM = 256, BK = 64, HALF = 128, HTB = HALF * BK * 2, STAGE_BYTES = 8 * HTB, NXCD = 8, WGM = 8;
__host__ __device__ __forceinline__ int lds_byte(int r, int c) { const int st = (r >> 4) * 2 + (c >> 5), rr = r & 15, cc = c & 31, ob = rr * 64 + cc * 2; return st * 1024 + (ob ^ (((ob >> 9) & 1) << 5)); }
__host__ __device__ __forceinline__ void stage_rc(int b, int& R, int& C) { const int st = b / 1024, sb = b % 1024, swz = sb ^ (((sb >> 9) & 1) << 5); R = (st >> 1) * 16 + swz / 64; C = (st & 1) * 32 + (swz % 64) / 2; }
struct Unit { int pm, pn; };
struct Gemm { const bf16_t* A; const bf16_t* Bt; int M, N, K; };
struct StaticOrder {
    int nM, nN, nwg, G, c;
    __host__ __device__ void init(int M, int N, int G_, int c_) { nM = M / BM; nN = N / BM; nwg = nM * nN; G = G_; c = c_; }
    __host__ __device__ bool next(int i, Unit& u) const {
        const long L = (long)i * G + c; if (L >= nwg) return false;
        int wgid = (int)L; { const int q = nwg / NXCD, r = nwg % NXCD, xcd = wgid % NXCD, off = wgid / NXCD; wgid = (xcd < r ? xcd * (q + 1) : r * (q + 1) + (xcd - r) * q) + off; }
        const int nig = WGM * nN, gid = wgid / nig, fm = gid * WGM, gsz = (nM - fm) < WGM ? (nM - fm) : WGM;
        u.pm = fm + ((wgid % nig) % gsz); u.pn = (wgid % nig) / gsz; return true;
    }
};
template <class Epi, class Sched>
__device__ __forceinline__ void gemm_phase(PG8_LAS unsigned char* lds, const Gemm g, const Sched& S, const Epi& E) {
    const int tid = threadIdx.x, wid = __builtin_amdgcn_readfirstlane(tid >> 6), lane = tid & 63, wr = wid >> 2, wc = wid & 3, fr = lane & 15, fq = lane >> 4;
    const int K = g.K, nt = K / BK;
    unsigned voffA[2];
#pragma unroll
    for (int i = 0; i < 2; ++i) { int R, C; stage_rc(tid * 16 + i * 8192, R, C); voffA[i] = (unsigned)(R * K + C) * 2u; }
    const size_t kstep = (size_t)(BK * 2);
    const size_t hstep = (size_t)HALF * K * 2;
    const size_t tstep = 2 * hstep;
    const unsigned ldsw = (unsigned)wid * 1024u;
    const int aoff = lds_byte(wr * 64 + fr, fq * 8), boff = lds_byte(wc * 32 + fr, fq * 8);
#define PG8_SA(b, h) (((b) * 2 + (h)) * HTB)
#define PG8_SB(b, h) ((4 + (b) * 2 + (h)) * HTB)
#define PG8_STAGE(bufoff, gbase, voff) do { _Pragma("unroll") for (int _i = 0; _i < 2; ++_i) \
        __builtin_amdgcn_global_load_lds((const unsigned*)((const char*)(gbase) + (voff)[_i]), (PG8_LAS unsigned*)(lds + (bufoff) + ldsw + _i * 8192), 16, 0, 0); } while (0)
#define PG8_LDA(dst, b, h) do { _Pragma("unroll") for (int m = 0; m < 4; ++m) _Pragma("unroll") for (int k = 0; k < 2; ++k) dst[m][k] = *(const PG8_LAS bf16x8*)(lds + PG8_SA(b, h) + aoff + m * 2048 + k * 1024); } while (0)
#define PG8_LDB(dst, b, h) do { _Pragma("unroll") for (int n = 0; n < 2; ++n) _Pragma("unroll") for (int k = 0; k < 2; ++k) dst[n][k] = *(const PG8_LAS bf16x8*)(lds + PG8_SB(b, h) + boff + n * 2048 + k * 1024); } while (0)
#define PG8_MMA(ai, bj, At, Bt) do { __builtin_amdgcn_s_setprio(1); _Pragma("unroll") for (int m = 0; m < 4; ++m) _Pragma("unroll") for (int n = 0; n < 2; ++n) _Pragma("unroll") for (int k = 0; k < 2; ++k) \
        acc[ai][bj][m][n] = __builtin_amdgcn_mfma_f32_16x16x32_bf16(Bt[n][k], At[m][k], acc[ai][bj][m][n], 0, 0, 0); __builtin_amdgcn_s_setprio(0); } while (0)
#define PG8_WAIT_V(n) asm volatile("s_waitcnt vmcnt(" #n ")" ::: "memory")
#define PG8_WAIT_L(n) asm volatile("s_waitcnt lgkmcnt(" #n ")" ::: "memory")
#define PG8_BAR __builtin_amdgcn_s_barrier()
#define PG8_SCHED __builtin_amdgcn_sched_barrier(0)
    Unit cur, nxt; int ui = 0;
    if (!S.next(0, cur)) return;
    f32x4 acc[2][2][4][2];
#pragma unroll
    for (int a = 0; a < 2; ++a)
#pragma unroll
        for (int b = 0; b < 2; ++b)
#pragma unroll
            for (int m = 0; m < 4; ++m)
#pragma unroll
                for (int n = 0; n < 2; ++n) acc[a][b][m][n] = (f32x4){0.f, 0.f, 0.f, 0.f};
    bf16x8 At[4][2], B0[2][2], B1[2][2];
    const char* cA = (const char*)g.A + (size_t)cur.pm * tstep; const char* cB = (const char*)g.Bt + (size_t)cur.pn * tstep;
    PG8_STAGE(PG8_SB(0, 0), cB, voffA); PG8_STAGE(PG8_SA(0, 0), cA, voffA); PG8_STAGE(PG8_SB(0, 1), cB + hstep, voffA); PG8_STAGE(PG8_SA(0, 1), cA + hstep, voffA);
    if (wr == 1) PG8_BAR;
    PG8_WAIT_V(4); PG8_BAR;
    PG8_STAGE(PG8_SB(1, 0), cB + kstep, voffA); PG8_STAGE(PG8_SA(1, 0), cA + kstep, voffA); PG8_STAGE(PG8_SB(1, 1), cB + hstep + kstep, voffA);
    PG8_WAIT_V(6); PG8_BAR;
    for (;;) {
        const bool has_next = S.next(ui + 1, nxt);
        const char* nA = has_next ? (const char*)g.A + (size_t)nxt.pm * tstep : cA; const char* nB = has_next ? (const char*)g.Bt + (size_t)nxt.pn * tstep : cB;
        for (int t = 0; t < nt; t += 2) {
            const bool last = (t == nt - 2);
            const char* a1 = cA + (size_t)(t + 1) * kstep;
            const char* a2 = last ? nA : cA + (size_t)(t + 2) * kstep; const char* b2 = last ? nB : cB + (size_t)(t + 2) * kstep;
            const char* a3 = a2 + kstep; const char* b3 = b2 + kstep;
            PG8_LDB(B0, 0, 0); PG8_SCHED; PG8_LDA(At, 0, 0); PG8_STAGE(PG8_SA(1, 1), a1 + hstep, voffA);
            PG8_WAIT_L(8); PG8_BAR; PG8_WAIT_L(0); PG8_MMA(0, 0, At, B0); PG8_BAR; PG8_SCHED;
            PG8_LDB(B1, 0, 1); PG8_STAGE(PG8_SB(0, 0), b2, voffA);
            PG8_BAR; PG8_WAIT_L(0); PG8_MMA(0, 1, At, B1); PG8_BAR;
            PG8_LDA(At, 0, 1); PG8_STAGE(PG8_SA(0, 0), a2, voffA);
            PG8_BAR; PG8_WAIT_L(0); PG8_MMA(1, 0, At, B0); PG8_BAR; PG8_SCHED;
            PG8_STAGE(PG8_SB(0, 1), b2 + hstep, voffA);
            PG8_WAIT_V(6); PG8_BAR; PG8_MMA(1, 1, At, B1); PG8_BAR;
            PG8_LDB(B0, 1, 0); PG8_SCHED; PG8_LDA(At, 1, 0); PG8_STAGE(PG8_SA(0, 1), a2 + hstep, voffA);
            PG8_WAIT_L(8); PG8_BAR; PG8_WAIT_L(0); PG8_MMA(0, 0, At, B0); PG8_BAR; PG8_SCHED;
            PG8_LDB(B1, 1, 1); PG8_STAGE(PG8_SB(1, 0), b3, voffA);
            PG8_BAR; PG8_WAIT_L(0); PG8_MMA(0, 1, At, B1); PG8_BAR;
            PG8_LDA(At, 1, 1); PG8_STAGE(PG8_SA(1, 0), a3, voffA);
            PG8_BAR; PG8_WAIT_L(0); PG8_MMA(1, 0, At, B0); PG8_BAR; PG8_SCHED;
            PG8_STAGE(PG8_SB(1, 1), b3 + hstep, voffA);
            PG8_WAIT_V(6); PG8_BAR; PG8_MMA(1, 1, At, B1); PG8_BAR;
        }
        E(acc, cur, wr, wc, fr, fq);
        if (!has_next) break;
#pragma unroll
        for (int a = 0; a < 2; ++a)
#pragma unroll
            for (int b = 0; b < 2; ++b)
#pragma unroll
                for (int m = 0; m < 4; ++m)
#pragma unroll
                    for (int n = 0; n < 2; ++n) acc[a][b][m][n] = (f32x4){0.f, 0.f, 0.f, 0.f};
        cur = nxt; cA = nA; cB = nB; ++ui;
    }
    PG8_WAIT_V(0);
    if (wr == 0) PG8_BAR;
    PG8_BAR;
#undef PG8_SA
#undef PG8_SB
#undef PG8_STAGE
#undef PG8_LDA
#undef PG8_LDB
#undef PG8_MMA
#undef PG8_WAIT_V
#undef PG8_WAIT_L
#undef PG8_BAR
#undef PG8_SCHED
}
template <class Pol, class Epi>
__device__ __forceinline__ void gemm_phase2(PG8_LAS unsigned char* lds, const Pol& P, const Epi& E) {
    const int tid = threadIdx.x, wid = __builtin_amdgcn_readfirstlane(tid >> 6), lane = tid & 63, wr = wid >> 2, wc = wid & 3, fr = lane & 15, fq = lane >> 4;
    const int nt = P.nk();
    int R[2], C[2];
#pragma unroll
    for (int i = 0; i < 2; ++i) stage_rc(tid * 16 + i * 8192, R[i], C[i]);
    const unsigned ldsw = (unsigned)wid * 1024u;
    const int aoff = lds_byte(wr * 64 + fr, fq * 8), boff = lds_byte(wc * 32 + fr, fq * 8);
#define PG8_SA(b, h) (((b) * 2 + (h)) * HTB)
#define PG8_SB(b, h) ((4 + (b) * 2 + (h)) * HTB)
#define PG8_STAGE_A(bufoff, AS, h, kt) do { _Pragma("unroll") for (int _i = 0; _i < 2; ++_i) \
        __builtin_amdgcn_global_load_lds((const unsigned*)P.pa(AS, h, _i, kt), (PG8_LAS unsigned*)(lds + (bufoff) + ldsw + _i * 8192), 16, 0, 0); } while (0)
#define PG8_STAGE_B(bufoff, BS, h, kt) do { _Pragma("unroll") for (int _i = 0; _i < 2; ++_i) \
        __builtin_amdgcn_global_load_lds((const unsigned*)P.pb(BS, h, _i, kt), (PG8_LAS unsigned*)(lds + (bufoff) + ldsw + _i * 8192), 16, 0, 0); } while (0)
#define PG8_LDA(dst, b, h) do { _Pragma("unroll") for (int m = 0; m < 4; ++m) _Pragma("unroll") for (int k = 0; k < 2; ++k) dst[m][k] = *(const PG8_LAS bf16x8*)(lds + PG8_SA(b, h) + aoff + m * 2048 + k * 1024); } while (0)
#define PG8_LDB(dst, b, h) do { _Pragma("unroll") for (int n = 0; n < 2; ++n) _Pragma("unroll") for (int k = 0; k < 2; ++k) dst[n][k] = *(const PG8_LAS bf16x8*)(lds + PG8_SB(b, h) + boff + n * 2048 + k * 1024); } while (0)
#define PG8_MMA(ai, bj, At, Bt) do { __builtin_amdgcn_s_setprio(1); _Pragma("unroll") for (int m = 0; m < 4; ++m) _Pragma("unroll") for (int n = 0; n < 2; ++n) _Pragma("unroll") for (int k = 0; k < 2; ++k) \
        acc[ai][bj][m][n] = __builtin_amdgcn_mfma_f32_16x16x32_bf16(Bt[n][k], At[m][k], acc[ai][bj][m][n], 0, 0, 0); __builtin_amdgcn_s_setprio(0); } while (0)
#define PG8_WAIT_V(n) asm volatile("s_waitcnt vmcnt(" #n ")" ::: "memory")
#define PG8_WAIT_L(n) asm volatile("s_waitcnt lgkmcnt(" #n ")" ::: "memory")
#define PG8_BAR __builtin_amdgcn_s_barrier()
#define PG8_SCHED __builtin_amdgcn_sched_barrier(0)
    typename Pol::Unit cur, nxt; int ui = 0;
    if (!P.next(0, cur)) return;
    f32x4 acc[2][2][4][2];
#pragma unroll
    for (int a = 0; a < 2; ++a)
#pragma unroll
        for (int b = 0; b < 2; ++b)
#pragma unroll
            for (int m = 0; m < 4; ++m)
#pragma unroll
                for (int n = 0; n < 2; ++n) acc[a][b][m][n] = (f32x4){0.f, 0.f, 0.f, 0.f};
    bf16x8 At[4][2], B0[2][2], B1[2][2];
    typename Pol::AddrA aC, aN; typename Pol::AddrB bC, bN;
    P.addrA(cur, R, C, aC); P.addrB(cur, R, C, bC);
    PG8_STAGE_B(PG8_SB(0, 0), bC, 0, 0); PG8_STAGE_A(PG8_SA(0, 0), aC, 0, 0); PG8_STAGE_B(PG8_SB(0, 1), bC, 1, 0); PG8_STAGE_A(PG8_SA(0, 1), aC, 1, 0);
    if (wr == 1) PG8_BAR;
    PG8_WAIT_V(4); PG8_BAR;
    PG8_STAGE_B(PG8_SB(1, 0), bC, 0, 1); PG8_STAGE_A(PG8_SA(1, 0), aC, 0, 1); PG8_STAGE_B(PG8_SB(1, 1), bC, 1, 1);
    PG8_WAIT_V(6); PG8_BAR;
    for (;;) {
        const bool has_next = P.next(ui + 1, nxt);
        if (has_next) { P.addrA(nxt, R, C, aN); P.addrB(nxt, R, C, bN); } else { aN = aC; bN = bC; }
        const bool full = P.full(cur);
        for (int t = 0; t < nt; t += 2) {
            const bool last = (t == nt - 2);
            const typename Pol::AddrA a2 = last ? aN : aC; const typename Pol::AddrB b2 = last ? bN : bC;
            const int k2 = last ? 0 : t + 2, k3 = k2 + 1;
            PG8_LDB(B0, 0, 0); PG8_SCHED; PG8_LDA(At, 0, 0); PG8_STAGE_A(PG8_SA(1, 1), aC, 1, t + 1);
            PG8_WAIT_L(8); PG8_BAR; PG8_WAIT_L(0); PG8_MMA(0, 0, At, B0); PG8_BAR; PG8_SCHED;
            PG8_LDB(B1, 0, 1); PG8_STAGE_B(PG8_SB(0, 0), b2, 0, k2);
            PG8_BAR; PG8_WAIT_L(0); PG8_MMA(0, 1, At, B1); PG8_BAR;
            PG8_LDA(At, 0, 1); PG8_STAGE_A(PG8_SA(0, 0), a2, 0, k2);
            PG8_BAR; PG8_WAIT_L(0); if (full) PG8_MMA(1, 0, At, B0); PG8_BAR; PG8_SCHED;
            PG8_STAGE_B(PG8_SB(0, 1), b2, 1, k2);
            PG8_WAIT_V(6); PG8_BAR; if (full) PG8_MMA(1, 1, At, B1); PG8_BAR;
            PG8_LDB(B0, 1, 0); PG8_SCHED; PG8_LDA(At, 1, 0); PG8_STAGE_A(PG8_SA(0, 1), a2, 1, k2);
            PG8_WAIT_L(8); PG8_BAR; PG8_WAIT_L(0); PG8_MMA(0, 0, At, B0); PG8_BAR; PG8_SCHED;
            PG8_LDB(B1, 1, 1); PG8_STAGE_B(PG8_SB(1, 0), b2, 0, k3);
            PG8_BAR; PG8_WAIT_L(0); PG8_MMA(0, 1, At, B1); PG8_BAR;
            PG8_LDA(At, 1, 1); PG8_STAGE_A(PG8_SA(1, 0), a2, 0, k3);
            PG8_BAR; PG8_WAIT_L(0); if (full) PG8_MMA(1, 0, At, B0); PG8_BAR; PG8_SCHED;
            PG8_STAGE_B(PG8_SB(1, 1), b2, 1, k3);
            PG8_WAIT_V(6); PG8_BAR; if (full) PG8_MMA(1, 1, At, B1); PG8_BAR;
        }
        E(acc, cur, wr, wc, fr, fq);
        if (!has_next) break;
#pragma unroll
        for (int a = 0; a < 2; ++a)
#pragma unroll
            for (int b = 0; b < 2; ++b)
#pragma unroll
                for (int m = 0; m < 4; ++m)
#pragma unroll
                    for (int n = 0; n < 2; ++n) acc[a][b][m][n] = (f32x4){0.f, 0.f, 0.f, 0.f};
        cur = nxt; aC = aN; bC = bN; ++ui;
    }
    PG8_WAIT_V(0);
    if (wr == 0) PG8_BAR;
    PG8_BAR;
#undef PG8_SA
#undef PG8_SB
#undef PG8_STAGE_A
#undef PG8_STAGE_B
#undef PG8_LDA
#undef PG8_LDB
#undef PG8_MMA
#undef PG8_WAIT_V
#undef PG8_WAIT_L
#undef PG8_BAR
#undef PG8_SCHED
}
__host__ __device__ __forceinline__ int logcol(int p) { return (p & ~255) + 64 * ((p >> 5) & 3) + 32 * ((p >> 7) & 1) + (p & 31); }
}

template <class SRC>
DEV void convert_tile(float* tl, const SRC& src, bf16_t* dst, int ldd, int n0, int k0) {
    const int tid = threadIdx.x;
    {
        const int n = tid & 63;
#pragma unroll
        for (int i = 0; i < 8; ++i) { const int kk = (tid >> 6) + 8 * i; tl[kk * 65 + n] = src.get(n0 + n, k0 + kk); }
    }
    __syncthreads();
    {
        const int n = tid >> 3, kc = tid & 7;
        const float* s = tl + (kc * 8) * 65 + n;
        u32x4 o;
        o.x = pk2(s[0 * 65], s[1 * 65]); o.y = pk2(s[2 * 65], s[3 * 65]); o.z = pk2(s[4 * 65], s[5 * 65]); o.w = pk2(s[6 * 65], s[7 * 65]);
        *(u32x4*)(dst + (size_t)(n0 + n) * ldd + k0 + kc * 8) = o;
    }
    __syncthreads();
}
struct SrcWin { const float* w; const float* g;
    DEV float get(int np, int k) const { const int n = pg8::logcol(np); int col; if (n < 1280) col = n; else if (n < 3328) col = n + 24; else if (n < 3352) col = 1280 + (n - 3328); else return 0.f;
        return w[(size_t)k * IN_COLS + col] * g[k]; } };
struct SrcWout { const float* w; const float* g;
    DEV float get(int np, int k) const { const int n = pg8::logcol(np); const float v = w[(size_t)k * DM + n]; return k < 512 ? v * g[k] : v; } };
struct SrcPlain { const float* w; int ld;
    DEV float get(int n, int k) const { return w[(size_t)k * ld + n]; } };
struct SrcW13 { const float* w1; const float* w3; const float* g;
    DEV float get(int n, int k) const { const uintptr_t a = (uintptr_t)w1, b = (uintptr_t)w3; const float* w = (const float*)(a + ((b - a) & (uintptr_t)(0 - (long long)(n & 1))));
        return w[(size_t)k * 512 + (n >> 1)] * g[k]; } };

DEV void phase_prologue(const Params& p, unsigned char* lds) {
    float* tl = (float*)lds;
    const int tid = threadIdx.x, lane = tid & 63, wid = tid >> 6;
    const int vb = vblock(), G = gridDim.x;
    unsigned char* ws = p.ws;
    constexpr int I_WIN = (INP / 64) * (DM / 64);
    constexpr int I_WOUT = 16 * 16;
    constexpr int I_CW1 = 2 * 4 * 32;
    constexpr int I_CW2 = 2 * 1 * 4;
    constexpr int I_W13 = 32 * 16 * 16;
    constexpr int I_W2 = 32 * 16 * 8;
    constexpr int I_ALL = I_WIN + I_WOUT + I_CW1 + I_CW2 + I_W2;
    for (int it = vb; it < I_ALL; it += G) {
        int r = it;
        if (r < I_WIN) { SrcWin s{p.w_in, p.attn_g}; convert_tile(tl, s, (bf16_t*)(ws + WS_WINT), DM, (r / 16) * 64, (r % 16) * 64); continue; } r -= I_WIN;
        if (r < I_WOUT) { SrcWout s{p.w_out, p.g_nsa}; convert_tile(tl, s, (bf16_t*)(ws + WS_WOUTT), DM, (r / 16) * 64, (r % 16) * 64); continue; } r -= I_WOUT;
        if (r < I_CW1) { const int z = r / 128, q = r % 128; SrcPlain s{z ? p.wv1 : p.wk1, 256};
            convert_tile(tl, s, (bf16_t*)(ws + WS_CW1T) + (size_t)z * 256 * 2048, 2048, (q / 32) * 64, (q % 32) * 64); continue; } r -= I_CW1;
        if (r < I_CW2) { const int z = r / 4, q = r % 4; SrcPlain s{z ? p.wv2 : p.wk2, 64};
            convert_tile(tl, s, (bf16_t*)(ws + WS_CW2T) + (size_t)z * 64 * 256, 256, 0, q * 64); continue; } r -= I_CW2;
        { const int e = r / 128, q = r % 128; SrcPlain s{p.w2 + (size_t)e * 512 * 1024, 1024};
            convert_tile(tl, s, (bf16_t*)(ws + WS_W2T) + (size_t)e * 1024 * 512, 512, (q / 8) * 64, (q % 8) * 64); }
    }
    {
        bf16_t* xb = (bf16_t*)(ws + WS_R1); float* rstd1 = (float*)(ws + WS_RSTD1);
        const int gw = vb * 8 + wid, NGW = G * 8;
        for (int m = gw; m < NTOK; m += NGW) {
            const f32x4* xr = (const f32x4*)(p.x + (size_t)m * DM) + lane;
            f32x4 v[4]; float s = 0.f;
#pragma unroll
            for (int j = 0; j < 4; ++j) { v[j] = xr[64 * j]; s += (v[j].x * v[j].x + v[j].y * v[j].y) + (v[j].z * v[j].z + v[j].w * v[j].w); }
            s = wave_sum(s);
            if (lane == 0) rstd1[m] = rsqrtf(s * (1.f / DM) + RMS_EPS);
            u32x2* o = (u32x2*)(xb + (size_t)m * DM) + lane;
#pragma unroll
            for (int j = 0; j < 4; ++j) { u32x2 w; w.x = pk2(v[j].x, v[j].y); w.y = pk2(v[j].z, v[j].w); o[64 * j] = w; }
        }
    }
    {
        const int gt = vb * NT + tid, NG = G * NT;
        float* rowss = (float*)(ws + WS_ROWSS);
        for (int i = gt; i < NTOK; i += NG) rowss[i] = 0.f;
        int* bincnt = (int*)(ws + WS_CTL);
        if (gt < 128) bincnt[gt] = 0;
        if (gt < 512) { const float l0 = p.lb_logits[gt], l1 = p.lb_logits[512 + gt]; ((float*)(ws + WS_LB))[gt] = 1.f / (1.f + __expf(l1 - l0)); }
        for (int i = gt; i < 48 * 1024; i += NG) { const int c = i >> 10, k = i & 1023;
            const float w = (c < 4 ? p.w_group[k * 4 + c] : (c < 36 ? p.w_expert[k * 32 + (c - 4)] : 0.f)) * p.ffn_g[k];
            const bf16_t hi = f2bf(w); const bf16_t lo = f2bf(w - bf2f(hi));
            ((bf16_t*)(ws + WS_RW))[i] = hi; ((bf16_t*)(ws + WS_RW))[48 * 1024 + i] = lo; }
        if (blockIdx.x == (unsigned)(G - 1)) {
            const int z = tid >> 8, j = tid & 255; const float* pos = z ? p.pos_v : p.pos_k; const float* w = z ? p.wv1 : p.wk1;
            float a = 0.f;
            for (int k = 0; k < 2048; ++k) a += pos[k] * w[(size_t)k * 256 + j];
            ((float*)(ws + WS_CBIAS))[z * 256 + j] = a;
        }
    }
}

constexpr int G_A_BYTES = 128 * 128, G_B_BYTES = 256 * 128, G_STAGE = G_A_BYTES + G_B_BYTES, G_LDS = 2 * G_STAGE;
DEV int swz(int row, int chunk) { return row * 128 + ((chunk ^ ((row >> 1) & 7)) << 4); }
template <class AL, class BL, class EP>
DEV void gemm_tile(unsigned char* lds, const AL& al, const BL& bl, int nk, const EP& ep) {
    const int tid = threadIdx.x, lane = tid & 63, wid = tid >> 6, wr = wid >> 2, wc = wid & 3;
    const int frow = lane & 15, fq = lane >> 4;
    const bf16_t* aptr[2]; int aoff[2], boff[4], brow[4];
#pragma unroll
    for (int i = 0; i < 2; ++i) { const int q = tid + NT * i, row = q >> 3, ch = q & 7; aptr[i] = al.row(row) + ch * 8; aoff[i] = swz(row, ch); }
#pragma unroll
    for (int i = 0; i < 4; ++i) { const int q = tid + NT * i, row = q >> 3, ch = q & 7; brow[i] = row; boff[i] = G_A_BYTES + swz(row, ch) ; }
    const int bch8 = (tid & 7) * 8;
    u32x4 ra[2], rb[4];
#pragma unroll
    for (int i = 0; i < 2; ++i) ra[i] = *(const u32x4*)(aptr[i]);
#pragma unroll
    for (int i = 0; i < 4; ++i) rb[i] = *(const u32x4*)(bl.ptr(brow[i], 0) + bch8);
#pragma unroll
    for (int i = 0; i < 2; ++i) *(u32x4*)(lds + aoff[i]) = ra[i];
#pragma unroll
    for (int i = 0; i < 4; ++i) *(u32x4*)(lds + boff[i]) = rb[i];
    __syncthreads();
    f32x4 acc[4][4];
#pragma unroll
    for (int m = 0; m < 4; ++m)
#pragma unroll
        for (int n = 0; n < 4; ++n) acc[m][n] = (f32x4){0.f, 0.f, 0.f, 0.f};
    const int sx = (frow >> 1) & 7;
    for (int kt = 0; kt < nk; ++kt) {
        const bool more = (kt + 1 < nk);
        if (more) {
#pragma unroll
            for (int i = 0; i < 2; ++i) ra[i] = *(const u32x4*)(aptr[i] + (kt + 1) * 64);
#pragma unroll
            for (int i = 0; i < 4; ++i) rb[i] = *(const u32x4*)(bl.ptr(brow[i], kt + 1) + bch8);
        }
        const unsigned char* base = lds + (kt & 1) * G_STAGE;
#pragma unroll
        for (int ks = 0; ks < 2; ++ks) {
            const int co = ((ks * 4 + fq) ^ sx) << 4;
            bf16x8 af[4], bfr[4];
#pragma unroll
            for (int m = 0; m < 4; ++m) af[m] = *(const bf16x8*)(base + (wr * 64 + m * 16 + frow) * 128 + co);
#pragma unroll
            for (int n = 0; n < 4; ++n) bfr[n] = *(const bf16x8*)(base + G_A_BYTES + (wc * 64 + n * 16 + frow) * 128 + co);
#pragma unroll
            for (int m = 0; m < 4; ++m)
#pragma unroll
                for (int n = 0; n < 4; ++n) acc[m][n] = __builtin_amdgcn_mfma_f32_16x16x32_bf16(bfr[n], af[m], acc[m][n], 0, 0, 0);
        }
        if (more) {
            unsigned char* nb = lds + ((kt + 1) & 1) * G_STAGE;
#pragma unroll
            for (int i = 0; i < 2; ++i) *(u32x4*)(nb + aoff[i]) = ra[i];
#pragma unroll
            for (int i = 0; i < 4; ++i) *(u32x4*)(nb + boff[i]) = rb[i];
        }
        __syncthreads();
    }
    ep(acc, wr, wc, lane);
}

struct ARows { const bf16_t* base; size_t ld; DEV const bf16_t* row(int r) const { return base + (size_t)r * ld; } };
struct BRows { const bf16_t* base; size_t ld; DEV const bf16_t* ptr(int n, int kt) const { return base + (size_t)n * ld + kt * 64; } };

DEV void inproj_row(const Params& p, int seg, int row, f32x4 (&v)[4], int fq) {
    unsigned char* ws = p.ws;
    const float rs = ((const float*)(ws + WS_RSTD1))[row];
#pragma unroll
    for (int n = 0; n < 4; ++n) v[n] = v[n] * rs;
    const int b = row >> 12, s = row & 4095;
    const bool is_q = seg < 8, is_ks = (seg == 12 || seg == 13), is_kw = (seg == 16 || seg == 17);
    if (is_q || is_ks || is_kw) {
        const float* gw = is_q ? p.g_q : (is_ks ? p.g_k + 64 : p.g_k + 128);
        bf16_t* dst; int hh, nh;
        if (is_q) { dst = (bf16_t*)(ws + WS_Q); hh = seg; nh = 8; } else if (is_ks) { dst = (bf16_t*)(ws + WS_KS); hh = seg - 12; nh = 2; } else { dst = (bf16_t*)(ws + WS_KW); hh = seg - 16; nh = 2; }
        float ss = 0.f;
#pragma unroll
        for (int n = 0; n < 4; ++n) ss += (v[n].x * v[n].x + v[n].y * v[n].y) + (v[n].z * v[n].z + v[n].w * v[n].w);
        ss += __shfl_xor(ss, 16); ss += __shfl_xor(ss, 32);
        float r = rsqrtf(ss * (1.f / 64.f) + RMS_EPS); if (is_q) r *= QSCALE;
        bf16_t* o = dst + ((size_t)(b * nh + hh) * SEQ + s) * 64 + fq * 4;
#pragma unroll
        for (int n = 0; n < 4; ++n) { const f32x4 g = *(const f32x4*)(gw + n * 16 + fq * 4); const f32x4 x = v[n] * g * r; u32x2 w; w.x = pk2(x.x, x.y); w.y = pk2(x.z, x.w); *(u32x2*)(o + n * 16) = w; }
        return;
    }
    if (seg >= 8 && seg < 12) {
        bf16_t* o = (bf16_t*)(ws + (seg < 10 ? WS_KC : WS_VC)) + ((size_t)(b * 2 + (seg & 1)) * SEQ + s) * 64 + fq * 4;
#pragma unroll
        for (int n = 0; n < 4; ++n) { u32x2 w; w.x = pk2(v[n].x, v[n].y); w.y = pk2(v[n].z, v[n].w); *(u32x2*)(o + n * 16) = w; }
        return;
    }
    if (seg == 14 || seg == 15 || seg == 18 || seg == 19) {
        bf16_t* o = (bf16_t*)(ws + (seg < 16 ? WS_VST : WS_VWT)) + (size_t)(b * 2 + (seg & 1)) * 64 * SEQ + s;
#pragma unroll
        for (int n = 0; n < 4; ++n) { const int d = n * 16 + fq * 4;
            o[(size_t)(d + 0) * SEQ] = f2bf(v[n].x); o[(size_t)(d + 1) * SEQ] = f2bf(v[n].y); o[(size_t)(d + 2) * SEQ] = f2bf(v[n].z); o[(size_t)(d + 3) * SEQ] = f2bf(v[n].w); }
        return;
    }
    if (seg < 52) {
        const int kind = (seg - 20) >> 3, cb = ((seg - 20) & 7) * 64 + fq * 4;
        if (kind == 1) {
            const float* lb = (const float*)(ws + WS_LB); float* dst = (float*)(ws + WS_HLOGF) + (size_t)row * 512;
#pragma unroll
            for (int n = 0; n < 4; ++n) { const int c = cb + n * 16; const f32x4 l = *(const f32x4*)(lb + c); f32x4 o;
                o.x = __logf(l.x + (1.f - l.x) * sigmoidf_(v[n].x)); o.y = __logf(l.y + (1.f - l.y) * sigmoidf_(v[n].y));
                o.z = __logf(l.z + (1.f - l.z) * sigmoidf_(v[n].z)); o.w = __logf(l.w + (1.f - l.w) * sigmoidf_(v[n].w));
                *(f32x4*)(dst + c) = o; }
        } else {
            bf16_t* dst = (bf16_t*)(ws + (kind == 0 ? WS_HQ : (kind == 2 ? WS_HV : WS_HG))) + (size_t)row * 512 + cb;
#pragma unroll
            for (int n = 0; n < 4; ++n) { f32x4 x = v[n];
                if (kind != 2) { x.x = siluf_(x.x); x.y = siluf_(x.y); x.z = siluf_(x.z); x.w = siluf_(x.w); }
                u32x2 w; w.x = pk2(x.x, x.y); w.y = pk2(x.z, x.w); *(u32x2*)(dst + n * 16) = w; }
        }
        return;
    }
    {
        float* dst = (float*)(ws + WS_GATES) + (size_t)row * 24;
#pragma unroll
        for (int n = 0; n < 2; ++n) { const int c = n * 16 + fq * 4; if (c < 24) { f32x4 o; o.x = sigmoidf_(v[n].x); o.y = sigmoidf_(v[n].y); o.z = sigmoidf_(v[n].z); o.w = sigmoidf_(v[n].w); *(f32x4*)(dst + c) = o; } }
    }
}
struct EpiInproj8 { const Params& p;
    DEV void operator()(const f32x4 (&acc)[2][2][4][2], const pg8::Unit& u, int wr, int wc, int fr, int fq) const {
        const int seg = u.pn * 4 + wc;
        if (seg > 52) return;
#pragma unroll
        for (int ai = 0; ai < 2; ++ai)
#pragma unroll
            for (int m = 0; m < 4; ++m) { f32x4 v[4] = {acc[ai][0][m][0], acc[ai][0][m][1], acc[ai][1][m][0], acc[ai][1][m][1]};
                inproj_row(p, seg, u.pm * 256 + ai * 128 + wr * 64 + m * 16 + fr, v, fq); }
    } };
DEV void phase_inproj(const Params& p, unsigned char* lds) {
    pg8::Gemm g{(const bf16_t*)(p.ws + WS_R1), (const bf16_t*)(p.ws + WS_WINT), NTOK, INP, DM};
    pg8::StaticOrder S; S.init(NTOK, INP, (int)gridDim.x, (int)blockIdx.x);
    EpiInproj8 E{p};
    pg8::gemm_phase(( PG8_LAS unsigned char*)lds, g, S, E);
}

struct ACmp { const bf16_t* src; int bg, c0;
    DEV const bf16_t* row(int r) const { int c = c0 + r; if (c > NC - 1) c = NC - 1; return src + ((size_t)bg * SEQ + 16 * c) * 64; } };
struct EpiCmpA { const Params& p; int z, rbase;
    DEV void operator()(f32x4 (&acc)[4][4], int wr, int wc, int lane) const {
        const int frow = lane & 15, fq = lane >> 4;
        const float* cb = (const float*)(p.ws + WS_CBIAS) + z * 256; bf16_t* hid = (bf16_t*)(p.ws + WS_HID) + (size_t)z * 4096 * 256;
#pragma unroll
        for (int m = 0; m < 4; ++m) { const int rr = rbase + wr * 64 + m * 16 + frow;
#pragma unroll
            for (int n = 0; n < 4; ++n) { const int c = wc * 64 + n * 16 + fq * 4; const f32x4 b = *(const f32x4*)(cb + c); f32x4 v = acc[m][n] + b;
                u32x2 w; w.x = pk2(siluf_(v.x), siluf_(v.y)); w.y = pk2(siluf_(v.z), siluf_(v.w)); *(u32x2*)(hid + (size_t)rr * 256 + c) = w; } }
    } };
DEV void phase_cmp_a(const Params& p, unsigned char* lds) {
    const int vb = vblock(), G = gridDim.x;
    for (int u = vb; u < 64; u += G) {
        const int z = u >> 5, rbase = (u & 31) * 128;
        ACmp al{(const bf16_t*)(p.ws + (z ? WS_VC : WS_KC)), (u & 31) >> 1, (u & 1) * 128};
        BRows bl{(const bf16_t*)(p.ws + WS_CW1T) + (size_t)z * 256 * 2048, 2048};
        EpiCmpA ep{p, z, rbase};
        gemm_tile(lds, al, bl, 2048 / 64, ep);
    }
}
struct BClamp64 { const bf16_t* base; size_t ld; DEV const bf16_t* ptr(int n, int kt) const { return base + (size_t)(n & 63) * ld + kt * 64; } };
struct EpiCmpB { const Params& p; int z, rbase;
    DEV void operator()(f32x4 (&acc)[4][4], int wr, int wc, int lane) const {
        if (wc != 0) return;
        const int frow = lane & 15, fq = lane >> 4;
        bf16_t* dst = (bf16_t*)(p.ws + (z ? WS_VCMP : WS_KCMP));
#pragma unroll
        for (int m = 0; m < 4; ++m) { const int rr = rbase + wr * 64 + m * 16 + frow;
            float r = 1.f;
            if (z == 0) { float ss = 0.f;
#pragma unroll
                for (int n = 0; n < 4; ++n) { const f32x4 v = acc[m][n]; ss += (v.x * v.x + v.y * v.y) + (v.z * v.z + v.w * v.w); }
                ss += __shfl_xor(ss, 16); ss += __shfl_xor(ss, 32); r = rsqrtf(ss * (1.f / 64.f) + RMS_EPS); }
            const int bg = rr >> 8, c = rr & 255;
            if (c < NC) {
#pragma unroll
                for (int n = 0; n < 4; ++n) { const int d = n * 16 + fq * 4; f32x4 v = acc[m][n] * r;
                    if (z == 0) { const f32x4 g = *(const f32x4*)(p.g_k + d); v = v * g;
                        u32x2 w; w.x = pk2(v.x, v.y); w.y = pk2(v.z, v.w); *(u32x2*)(dst + ((size_t)bg * 256 + c) * 64 + d) = w; }
                    else { bf16_t* o = dst + ((size_t)bg * 64 + d) * 256 + c; o[0] = f2bf(v.x); o[256] = f2bf(v.y); o[512] = f2bf(v.z); o[768] = f2bf(v.w); } } }
        }
    } };
DEV void phase_cmp_b(const Params& p, unsigned char* lds) {
    const int vb = vblock(), G = gridDim.x;
    for (int u = vb; u < 64; u += G) {
        const int z = u >> 5, rbase = (u & 31) * 128;
        ARows al{(const bf16_t*)(p.ws + WS_HID) + ((size_t)z * 4096 + rbase) * 256, 256};
        BClamp64 bl{(const bf16_t*)(p.ws + WS_CW2T) + (size_t)z * 64 * 256, 256};
        EpiCmpB ep{p, z, rbase};
        gemm_tile(lds, al, bl, 256 / 64, ep);
    }
}

constexpr int CM_K = 0, CM_V = 32768, CM_VSTR = 520, CM_IMP = CM_V + 64 * CM_VSTR, CM_LDS = CM_IMP + 16384;
DEV void cm_scores(const unsigned char* kbase, int kt, const bf16x8 (&qf)[4], int r31, int hh, f32x16 (&sacc)[2]) {
#pragma unroll
    for (int kt2 = 0; kt2 < 2; ++kt2) {
#pragma unroll
        for (int i = 0; i < 16; ++i) sacc[kt2][i] = 0.f;
        const int row = 64 * kt + 32 * kt2 + r31; const int sx = (row >> 1) & 7;
#pragma unroll
        for (int s = 0; s < 4; ++s) { const bf16x8 kf = *(const bf16x8*)(kbase + row * 128 + (((2 * s + hh) ^ sx) << 4));
            sacc[kt2] = __builtin_amdgcn_mfma_f32_32x32x16_bf16(kf, qf[s], sacc[kt2], 0, 0, 0); }
    }
}
DEV void phase_cmp_attn(const Params& p, unsigned char* lds) {
    const int tid = threadIdx.x, lane = tid & 63, wid = tid >> 6;
    const int vb = vblock(), G = gridDim.x;
    unsigned char* ws = p.ws;
    const int r31 = lane & 31, hh = lane >> 5;
    float* impl = (float*)(lds + CM_IMP);
    for (int it = vb; it < 1024; it += G) {
        const int rnd = it / G, pos = it % G; int sidx = (rnd & 1) ? (rnd * G + (G - 1 - pos)) : (rnd * G + pos); if (G != 256) sidx = it;
        const int ci = 63 - (sidx >> 4), bg = sidx & 15, b = bg >> 1, g = bg & 1;
        const int nvis = min(NC, 4 * ci + 3), ntile = (nvis + 63) >> 6;
        const int head = g * 4 + (wid >> 1);
        const int tokl = (wid & 1) * 32 + r31, t = ci * 64 + tokl;
        const size_t tok = (size_t)b * SEQ + t;
        const int nv = t >= 31 ? min(NC, (t - 31) / 16 + 1) : 0;
        __syncthreads();
        {
            const bf16_t* kc = (const bf16_t*)(ws + WS_KCMP) + (size_t)bg * 256 * 64; const bf16_t* vt = (const bf16_t*)(ws + WS_VCMP) + (size_t)bg * 64 * 256;
            const int nch = ntile * 512;
            for (int idx = tid; idx < nch; idx += NT) { const int row = idx >> 3, ch = idx & 7; *(u32x4*)(lds + CM_K + swz(row, ch)) = *(const u32x4*)(kc + row * 64 + ch * 8); }
            const int cpr = ntile * 8;
            for (int idx = tid; idx < nch; idx += NT) { const int d = idx / cpr, ck = idx % cpr; const u32x4 v = *(const u32x4*)(vt + d * 256 + ck * 8);
                u32x2 a, c2; a.x = v.x; a.y = v.y; c2.x = v.z; c2.y = v.w; unsigned char* o = lds + CM_V + d * CM_VSTR + ck * 16; *(u32x2*)o = a; *(u32x2*)(o + 8) = c2; }
#pragma unroll
            for (int i = 0; i < 8; ++i) impl[tid + NT * i] = 0.f;
        }
        bf16x8 qf[4];
        { const bf16_t* qp = (const bf16_t*)(ws + WS_Q) + ((size_t)(b * 8 + head) * SEQ + t) * 64 + 8 * hh;
#pragma unroll
            for (int s = 0; s < 4; ++s) qf[s] = *(const bf16x8*)(qp + 16 * s); }
        __syncthreads();
        float m_run = -1e30f, l_run = 0.f;
        for (int kt = 0; kt < ntile; ++kt) {
            f32x16 sacc[2];
            cm_scores(lds + CM_K, kt, qf, r31, hh, sacc);
            float mx = -1e30f;
#pragma unroll
            for (int kt2 = 0; kt2 < 2; ++kt2)
#pragma unroll
                for (int i = 0; i < 16; ++i) { const int c = 64 * kt + 32 * kt2 + (i & 3) + 8 * (i >> 2) + 4 * hh; const float v = (c < nv) ? sacc[kt2][i] : -1e30f; sacc[kt2][i] = v; mx = fmaxf(mx, v); }
            const float m_new = fmaxf(m_run, mx); float rs = 0.f;
#pragma unroll
            for (int kt2 = 0; kt2 < 2; ++kt2)
#pragma unroll
                for (int i = 0; i < 16; ++i) { const float v = sacc[kt2][i]; rs += (v > -5e29f) ? exp2f(v - m_new) : 0.f; }
            l_run = l_run * exp2f(m_run - m_new) + rs; m_run = m_new;
        }
        float M, invL;
        { const float mo = __shfl_xor(m_run, 32), lo = __shfl_xor(l_run, 32); M = fmaxf(m_run, mo); const float L = l_run * exp2f(m_run - M) + lo * exp2f(mo - M); invL = L > 0.f ? 1.f / L : 0.f; }
        f32x16 ot[2];
#pragma unroll
        for (int dt = 0; dt < 2; ++dt)
#pragma unroll
            for (int i = 0; i < 16; ++i) ot[dt][i] = 0.f;
        float own[32], spl[32];
#pragma unroll
        for (int i = 0; i < 32; ++i) { own[i] = 0.f; spl[i] = 0.f; }
#pragma unroll
        for (int kt = 0; kt < 4; ++kt) if (kt < ntile) {
            f32x16 sacc[2];
            cm_scores(lds + CM_K, kt, qf, r31, hh, sacc);
#pragma unroll
            for (int kt2 = 0; kt2 < 2; ++kt2)
#pragma unroll
                for (int i = 0; i < 16; ++i) { const int c = 64 * kt + 32 * kt2 + (i & 3) + 8 * (i >> 2) + 4 * hh; sacc[kt2][i] = (c < nv) ? exp2f(sacc[kt2][i] - M) : 0.f; }
#pragma unroll
            for (int kt2 = 0; kt2 < 2; ++kt2)
#pragma unroll
                for (int g4 = 0; g4 < 4; ++g4) { const int Gi = 8 * kt + 4 * kt2 + g4; const float e3 = 0.5f * sacc[kt2][4 * g4 + 3];
                    own[Gi] = ((sacc[kt2][4 * g4] + sacc[kt2][4 * g4 + 1]) + (sacc[kt2][4 * g4 + 2] + e3)) * invL; spl[Gi] = e3 * invL; }
#pragma unroll
            for (int kt2 = 0; kt2 < 2; ++kt2)
#pragma unroll
                for (int s2 = 0; s2 < 2; ++s2) {
                    bf16x8 pf; { u32x4 w; w.x = pk2(sacc[kt2][8 * s2 + 0], sacc[kt2][8 * s2 + 1]); w.y = pk2(sacc[kt2][8 * s2 + 2], sacc[kt2][8 * s2 + 3]);
                        w.z = pk2(sacc[kt2][8 * s2 + 4], sacc[kt2][8 * s2 + 5]); w.w = pk2(sacc[kt2][8 * s2 + 6], sacc[kt2][8 * s2 + 7]); pf = __builtin_bit_cast(bf16x8, w); }
#pragma unroll
                    for (int dt = 0; dt < 2; ++dt) {
                        const unsigned char* va = lds + CM_V + (32 * dt + r31) * CM_VSTR + (64 * kt + 32 * kt2 + 16 * s2 + 4 * hh) * 2;
                        const u32x2 lo = *(const u32x2*)(va), hi = *(const u32x2*)(va + 16);
                        u32x4 w; w.x = lo.x; w.y = lo.y; w.z = hi.x; w.w = hi.y;
                        ot[dt] = __builtin_amdgcn_mfma_f32_32x32x16_bf16(__builtin_bit_cast(bf16x8, w), pf, ot[dt], 0, 0, 0);
                    }
                }
        }
        {
            const float sc = ((const float*)(ws + WS_GATES))[tok * 24 + head * 3 + 0] * invL;
            bf16_t* ocp = (bf16_t*)(ws + WS_OC) + tok * 512 + head * 64;
#pragma unroll
            for (int dt = 0; dt < 2; ++dt)
#pragma unroll
                for (int g4 = 0; g4 < 4; ++g4) { const int d0 = 32 * dt + 8 * g4 + 4 * hh;
                    u32x2 w; w.x = pk2(ot[dt][4 * g4 + 0] * sc, ot[dt][4 * g4 + 1] * sc); w.y = pk2(ot[dt][4 * g4 + 2] * sc, ot[dt][4 * g4 + 3] * sc); *(u32x2*)(ocp + d0) = w; }
        }
        {
            float tot[32];
#pragma unroll
            for (int Gi = 0; Gi < 32; ++Gi) { const float os = __shfl_xor(spl[Gi], 32); const float op = (Gi > 0) ? __shfl_xor(spl[Gi > 0 ? Gi - 1 : 0], 32) : 0.f; tot[Gi] = own[Gi] + (hh ? os : op); }
            for (int r = 0; r < 4; ++r) {
                if ((wid >> 1) == r) {
#pragma unroll
                    for (int Gi = 0; Gi < 32; ++Gi) if (Gi < 8 * ntile) impl[tokl * 64 + 2 * Gi + hh] += tot[Gi];
                }
                __syncthreads();
            }
        }
        for (int tt = 0; tt < 8; ++tt) {
            const int tl = wid * 8 + tt, cur = ci;
            const float imp = impl[tl * 64 + lane];
            const float INF = __builtin_inff();
            const float v = (lane == 0 || lane == cur) ? INF : (lane < cur ? imp : -INF);
            int rank = 0;
            for (int i = 0; i <= cur; ++i) { const float vi = __uint_as_float(__builtin_amdgcn_readlane(__float_as_uint(v), i)); rank += ((vi > v) || (vi == v && i < lane)) ? 1 : 0; }
            const bool sel = (lane <= cur) && (rank < 16);
            const unsigned long long mask = __ballot(sel);
            if (lane == 0) ((unsigned long long*)(ws + WS_SELM))[(size_t)bg * SEQ + ci * 64 + tl] = mask;
        }
    }
}

constexpr int FA_KB = 64 * 128, FA_VB = 64 * 136, FA_STAGE = FA_KB + FA_VB, FA_LDS = 2 * FA_STAGE + 1024;
template <bool SEL>
DEV void fa_branch(unsigned char* lds, const bf16_t* Kb, const bf16_t* VTb, int ci, int bg, const bf16x8 (&qf)[4], int t, unsigned long long mymask, unsigned long long need,
                   f32x16 (&ot)[2], float& m_run, float& l_run) {
    const int tid = threadIdx.x, lane = tid & 63;
    const int r31 = lane & 31, hh = lane >> 5;
    const int lrow = tid >> 3, lch = tid & 7;
    const bf16_t* kg = Kb + ((size_t)bg * SEQ + lrow) * 64 + lch * 8;
    const bf16_t* vg = VTb + ((size_t)bg * 64 + lrow) * SEQ + lch * 8;
    const int koff = lrow * 128 + ((lch ^ ((lrow >> 1) & 7)) << 4), voff = FA_KB + lrow * 136 + lch * 16;
    int jlo, jhi; unsigned long long todo;
    if (SEL) { todo = need; jlo = 0; jhi = ci; } else { jlo = ci >= 8 ? ci - 8 : 0; jhi = ci; todo = 0; }
    int j = jlo;
    if (SEL) { if (todo == 0) return; j = __builtin_ctzll(todo); todo &= todo - 1; }
    u32x4 rk = *(const u32x4*)(kg + (size_t)j * 64 * 64), rv = *(const u32x4*)(vg + (size_t)j * 64);
    __syncthreads();
    *(u32x4*)(lds + koff) = rk; { u32x2 a, b2; a.x = rv.x; a.y = rv.y; b2.x = rv.z; b2.y = rv.w; *(u32x2*)(lds + voff) = a; *(u32x2*)(lds + voff + 8) = b2; }
    __syncthreads();
    int st = 0;
    for (;;) {
        int jn; bool more;
        if (SEL) { more = (todo != 0); jn = more ? __builtin_ctzll(todo) : 0; todo &= todo - 1; } else { jn = j + 1; more = (jn <= jhi); }
        if (more) { rk = *(const u32x4*)(kg + (size_t)jn * 64 * 64); rv = *(const u32x4*)(vg + (size_t)jn * 64); }
        const unsigned char* base = lds + st * FA_STAGE;
        f32x16 sacc[2];
#pragma unroll
        for (int kt2 = 0; kt2 < 2; ++kt2) {
#pragma unroll
            for (int i = 0; i < 16; ++i) sacc[kt2][i] = 0.f;
            const int row = 32 * kt2 + r31; const int sx = (row >> 1) & 7;
#pragma unroll
            for (int s = 0; s < 4; ++s) { const bf16x8 kf = *(const bf16x8*)(base + row * 128 + (((2 * s + hh) ^ sx) << 4));
                sacc[kt2] = __builtin_amdgcn_mfma_f32_32x32x16_bf16(kf, qf[s], sacc[kt2], 0, 0, 0); }
        }
        const bool bit = SEL ? ((mymask >> j) & 1ull) != 0 : true;
        const bool boundary = SEL ? (j == ci) : (j == ci || j + 8 <= ci);
        float mx = -1e30f;
        if (boundary) {
#pragma unroll
            for (int kt2 = 0; kt2 < 2; ++kt2)
#pragma unroll
                for (int i = 0; i < 16; ++i) { const int key = 64 * j + 32 * kt2 + (i & 3) + 8 * (i >> 2) + 4 * hh;
                    const bool ok = SEL ? (bit && key <= t) : (key <= t && t - key < 512);
                    const float v = ok ? sacc[kt2][i] : -__builtin_inff(); sacc[kt2][i] = v; mx = fmaxf(mx, v); }
        } else {
#pragma unroll
            for (int kt2 = 0; kt2 < 2; ++kt2)
#pragma unroll
                for (int i = 0; i < 16; ++i) mx = fmaxf(mx, sacc[kt2][i]);
            if (SEL && !bit) mx = -1e30f;
        }
        mx = fmaxf(mx, __shfl_xor(mx, 32));
        const float m_new = fmaxf(m_run, mx);
        if (__any(m_new > m_run)) {
            const float alpha = __builtin_amdgcn_exp2f(m_run - m_new);
            l_run *= alpha;
#pragma unroll
            for (int dt = 0; dt < 2; ++dt)
#pragma unroll
                for (int i = 0; i < 16; ++i) ot[dt][i] *= alpha;
            m_run = m_new;
        }
        const float m_use = (SEL && !bit) ? __builtin_inff() : m_run;
        float rs = 0.f;
#pragma unroll
        for (int kt2 = 0; kt2 < 2; ++kt2)
#pragma unroll
            for (int i = 0; i < 16; ++i) { const float e = __builtin_amdgcn_exp2f(sacc[kt2][i] - m_use); sacc[kt2][i] = e; rs += e; }
        l_run += rs;
#pragma unroll
        for (int kt2 = 0; kt2 < 2; ++kt2)
#pragma unroll
            for (int s2 = 0; s2 < 2; ++s2) {
                bf16x8 pf; { u32x4 w; w.x = pk2(sacc[kt2][8 * s2 + 0], sacc[kt2][8 * s2 + 1]); w.y = pk2(sacc[kt2][8 * s2 + 2], sacc[kt2][8 * s2 + 3]);
                    w.z = pk2(sacc[kt2][8 * s2 + 4], sacc[kt2][8 * s2 + 5]); w.w = pk2(sacc[kt2][8 * s2 + 6], sacc[kt2][8 * s2 + 7]); pf = __builtin_bit_cast(bf16x8, w); }
#pragma unroll
                for (int dt = 0; dt < 2; ++dt) {
                    const unsigned char* va = base + FA_KB + (32 * dt + r31) * 136 + (32 * kt2 + 16 * s2 + 4 * hh) * 2;
                    const u32x2 lo = *(const u32x2*)(va), hi = *(const u32x2*)(va + 16);
                    u32x4 w; w.x = lo.x; w.y = lo.y; w.z = hi.x; w.w = hi.y;
                    ot[dt] = __builtin_amdgcn_mfma_f32_32x32x16_bf16(__builtin_bit_cast(bf16x8, w), pf, ot[dt], 0, 0, 0);
                }
            }
        if (!more) break;
        { unsigned char* nb = lds + (st ^ 1) * FA_STAGE; *(u32x4*)(nb + koff) = rk; u32x2 a, b2; a.x = rv.x; a.y = rv.y; b2.x = rv.z; b2.y = rv.w; *(u32x2*)(nb + voff) = a; *(u32x2*)(nb + voff + 8) = b2; }
        __syncthreads();
        st ^= 1; j = jn;
    }
}
DEV void phase_flash(const Params& p, unsigned char* lds) {
    const int tid = threadIdx.x, lane = tid & 63, wid = tid >> 6;
    const int vb = vblock(), G = gridDim.x;
    unsigned char* ws = p.ws;
    const int r31 = lane & 31, hh = lane >> 5;
    unsigned long long* red = (unsigned long long*)(lds + 2 * FA_STAGE);
    for (int it = vb; it < 1024; it += G) {
        const int rnd = it / G, pos = it % G; int sidx = (rnd & 1) ? (rnd * G + (G - 1 - pos)) : (rnd * G + pos); if (G != 256) sidx = it;
        const int ci = 63 - (sidx >> 4), bg = sidx & 15, b = bg >> 1, g = bg & 1;
        const int head = g * 4 + (wid >> 1);
        const int t = ci * 64 + (wid & 1) * 32 + r31;
        const size_t tok = (size_t)b * SEQ + t;
        bf16x8 qf[4];
        { const bf16_t* qp = (const bf16_t*)(ws + WS_Q) + ((size_t)(b * 8 + head) * SEQ + t) * 64 + 8 * hh;
#pragma unroll
            for (int s = 0; s < 4; ++s) qf[s] = *(const bf16x8*)(qp + 16 * s); }
        const unsigned long long mymask = ((const unsigned long long*)(ws + WS_SELM))[(size_t)bg * SEQ + t];
        unsigned long long orm = mymask;
#pragma unroll
        for (int o = 1; o < 32; o <<= 1) { const unsigned lo = __shfl_xor((unsigned)orm, o), hi = __shfl_xor((unsigned)(orm >> 32), o); orm |= ((unsigned long long)hi << 32) | lo; }
        __syncthreads();
        if (wid < 2 && lane == 0) red[wid] = orm;
        __syncthreads();
        const unsigned long long need = red[0] | red[1];
        f32x16 oc[2];
        {
            f32x16 ot[2]; float m_run = -1e30f, l_run = 0.f;
#pragma unroll
            for (int dt = 0; dt < 2; ++dt)
#pragma unroll
                for (int i = 0; i < 16; ++i) ot[dt][i] = 0.f;
            fa_branch<true>(lds, (const bf16_t*)(ws + WS_KS), (const bf16_t*)(ws + WS_VST), ci, bg, qf, t, mymask, need, ot, m_run, l_run);
            const float lt = l_run + __shfl_xor(l_run, 32);
            const float sc = ((const float*)(ws + WS_GATES))[tok * 24 + head * 3 + 1] / lt;
#pragma unroll
            for (int dt = 0; dt < 2; ++dt)
#pragma unroll
                for (int i = 0; i < 16; ++i) oc[dt][i] = ot[dt][i] * sc;
        }
        {
            f32x16 ot[2]; float m_run = -1e30f, l_run = 0.f;
#pragma unroll
            for (int dt = 0; dt < 2; ++dt)
#pragma unroll
                for (int i = 0; i < 16; ++i) ot[dt][i] = 0.f;
            fa_branch<false>(lds, (const bf16_t*)(ws + WS_KW), (const bf16_t*)(ws + WS_VWT), ci, bg, qf, t, 0ull, 0ull, ot, m_run, l_run);
            const float lt = l_run + __shfl_xor(l_run, 32);
            const float sc = ((const float*)(ws + WS_GATES))[tok * 24 + head * 3 + 2] / lt;
#pragma unroll
            for (int dt = 0; dt < 2; ++dt)
#pragma unroll
                for (int i = 0; i < 16; ++i) oc[dt][i] += ot[dt][i] * sc;
        }
        {
            const bf16_t* ocp = (const bf16_t*)(ws + WS_OC) + tok * 512 + head * 64;
            bf16_t* mix = (bf16_t*)(ws + WS_R1) + tok * 1024 + head * 64;
            float ss = 0.f;
#pragma unroll
            for (int dt = 0; dt < 2; ++dt)
#pragma unroll
                for (int g4 = 0; g4 < 4; ++g4) { const int d0 = 32 * dt + 8 * g4 + 4 * hh; const u32x2 c = *(const u32x2*)(ocp + d0);
                    const float v0 = oc[dt][4 * g4 + 0] + bflo(c.x), v1 = oc[dt][4 * g4 + 1] + bfhi(c.x), v2 = oc[dt][4 * g4 + 2] + bflo(c.y), v3 = oc[dt][4 * g4 + 3] + bfhi(c.y);
                    ss += (v0 * v0 + v1 * v1) + (v2 * v2 + v3 * v3);
                    u32x2 w; w.x = pk2(v0, v1); w.y = pk2(v2, v3); *(u32x2*)(mix + d0) = w; }
            ss += __shfl_xor(ss, 32);
            if (hh == 0) atomicAdd((float*)(ws + WS_ROWSS) + tok, ss);
        }
    }
}

DEV int swz256(int row, int chunk) { return row * 256 + ((chunk ^ (row & 15)) << 4); }
DEV void hgrn_cumsum(const Params& p, int bh, int c, float* segs, f32x2 (&lf)[8], f32x2 (&a)[8], f32x2& r, f32x2& alast) {
    const int tid = threadIdx.x, k2 = tid & 63, tq = tid >> 6;
    const int b = bh >> 2, h = bh & 3;
    const float* HL = (const float*)(p.ws + WS_HLOGF) + ((size_t)b * SEQ + c * 64 + tq * 8) * 512 + h * 128 + 2 * k2;
#pragma unroll
    for (int i = 0; i < 8; ++i) lf[i] = *(const f32x2*)(HL + (size_t)i * 512);
    f32x2 run = (f32x2){0.f, 0.f};
#pragma unroll
    for (int i = 0; i < 8; ++i) { run = run + lf[i]; a[i] = run; }
    *(f32x2*)(segs + tq * 128 + 2 * k2) = run;
    __syncthreads();
    f32x2 off = (f32x2){0.f, 0.f}, tot = off, rr = off;
#pragma unroll
    for (int q = 0; q < 8; ++q) { const f32x2 s = *(const f32x2*)(segs + q * 128 + 2 * k2); if (q < tq) off = off + s; if (q < 4) rr = rr + s; tot = tot + s; }
#pragma unroll
    for (int i = 0; i < 8; ++i) a[i] = a[i] + off;
    r = rr; alast = tot;
}
DEV void hgrn_stage_vt(const Params& p, int bh, int c, unsigned char* vt) {
    const int tid = threadIdx.x, k2 = tid & 63, tq = tid >> 6;
    const int b = bh >> 2, h = bh & 3;
    const bf16_t* HV = (const bf16_t*)(p.ws + WS_HV) + ((size_t)b * SEQ + c * 64 + tq * 8) * 512 + h * 128 + 2 * k2;
    unsigned vv[8];
#pragma unroll
    for (int i = 0; i < 8; ++i) vv[i] = *(const unsigned*)(HV + (size_t)i * 512);
    u32x4 lo, hi;
    lo.x = (vv[0] & 0xffffu) | (vv[1] << 16); lo.y = (vv[2] & 0xffffu) | (vv[3] << 16); lo.z = (vv[4] & 0xffffu) | (vv[5] << 16); lo.w = (vv[6] & 0xffffu) | (vv[7] << 16);
    hi.x = (vv[0] >> 16) | (vv[1] & 0xffff0000u); hi.y = (vv[2] >> 16) | (vv[3] & 0xffff0000u); hi.z = (vv[4] >> 16) | (vv[5] & 0xffff0000u); hi.w = (vv[6] >> 16) | (vv[7] & 0xffff0000u);
    *(u32x4*)(vt + swz(2 * k2, tq)) = lo; *(u32x4*)(vt + swz(2 * k2 + 1, tq)) = hi;
}
constexpr int H1_KT = 0, H1_VT = 16384, H1_SEG = 32768, H1_EK = H1_SEG + 4096;
DEV void phase_hgrn_a1(const Params& p, unsigned char* lds) {
    const int tid = threadIdx.x, lane = tid & 63, wid = tid >> 6, k2 = tid & 63, tq = tid >> 6;
    const int vb = vblock(), G = gridDim.x;
    const int frow = lane & 15, fq = lane >> 4, wr = wid >> 1, wc = wid & 1;
    float* segs = (float*)(lds + H1_SEG); float* ek = (float*)(lds + H1_EK);
    bf16_t* ubuf = (bf16_t*)(p.ws + WS_UBUF); float* dbuf = (float*)(p.ws + WS_DBUF);
    for (int item = vb; item < 2048; item += G) {
        const int bh = item >> 6, c = item & 63;
        __syncthreads();
        f32x2 lf[8], a[8], r, al;
        hgrn_cumsum(p, bh, c, segs, lf, a, r, al);
        {
            float kx[8], ky[8];
#pragma unroll
            for (int i = 0; i < 8; ++i) { kx[i] = (1.f - __expf(lf[i].x)) * __expf(fminf(r.x - a[i].x, 80.f)); ky[i] = (1.f - __expf(lf[i].y)) * __expf(fminf(r.y - a[i].y, 80.f)); }
            u32x4 w0, w1;
            w0.x = pk2(kx[0], kx[1]); w0.y = pk2(kx[2], kx[3]); w0.z = pk2(kx[4], kx[5]); w0.w = pk2(kx[6], kx[7]);
            w1.x = pk2(ky[0], ky[1]); w1.y = pk2(ky[2], ky[3]); w1.z = pk2(ky[4], ky[5]); w1.w = pk2(ky[6], ky[7]);
            *(u32x4*)(lds + H1_KT + swz(2 * k2, tq)) = w0; *(u32x4*)(lds + H1_KT + swz(2 * k2 + 1, tq)) = w1;
        }
        hgrn_stage_vt(p, bh, c, lds + H1_VT);
        if (tq == 7) { ek[2 * k2] = __expf(al.x - r.x); ek[2 * k2 + 1] = __expf(al.y - r.y); f32x2 d; d.x = __expf(al.x); d.y = __expf(al.y); *(f32x2*)(dbuf + (size_t)item * 128 + 2 * k2) = d; }
        __syncthreads();
        f32x4 acc[2][4];
#pragma unroll
        for (int m = 0; m < 2; ++m)
#pragma unroll
            for (int n = 0; n < 4; ++n) acc[m][n] = (f32x4){0.f, 0.f, 0.f, 0.f};
        const int sx = (frow >> 1) & 7;
#pragma unroll
        for (int ks = 0; ks < 2; ++ks) {
            const int co = ((ks * 4 + fq) ^ sx) << 4;
            bf16x8 af[2], bfr[4];
#pragma unroll
            for (int m = 0; m < 2; ++m) af[m] = *(const bf16x8*)(lds + H1_VT + (32 * wr + 16 * m + frow) * 128 + co);
#pragma unroll
            for (int n = 0; n < 4; ++n) bfr[n] = *(const bf16x8*)(lds + H1_KT + (64 * wc + 16 * n + frow) * 128 + co);
#pragma unroll
            for (int m = 0; m < 2; ++m)
#pragma unroll
                for (int n = 0; n < 4; ++n) acc[m][n] = __builtin_amdgcn_mfma_f32_16x16x32_bf16(bfr[n], af[m], acc[m][n], 0, 0, 0);
        }
#pragma unroll
        for (int m = 0; m < 2; ++m) { const int v = 32 * wr + 16 * m + frow;
#pragma unroll
            for (int n = 0; n < 4; ++n) { const int k0 = 64 * wc + 16 * n + 4 * fq; const f32x4 e = *(const f32x4*)(ek + k0); const f32x4 o = acc[m][n] * e;
                u32x2 w; w.x = pk2(o.x, o.y); w.y = pk2(o.z, o.w); *(u32x2*)(ubuf + ((size_t)item * 128 + v) * 128 + k0) = w; } }
    }
}
DEV void phase_hgrn_a2(const Params& p, unsigned char* lds) {
    const int G = gridDim.x;
    bf16_t* ubuf = (bf16_t*)(p.ws + WS_UBUF); const float* dbuf = (const float*)(p.ws + WS_DBUF);
    for (int gid = blockIdx.x * NT + threadIdx.x; gid < 131072; gid += G * NT) {
        const int bh = gid >> 12, v = (gid >> 5) & 127, k4 = gid & 31;
        bf16_t* u = ubuf + ((size_t)bh * 64 * 128 + v) * 128 + 4 * k4;
        const float* d = dbuf + (size_t)bh * 64 * 128 + 4 * k4;
        f32x4 S = (f32x4){0.f, 0.f, 0.f, 0.f};
        for (int c0 = 0; c0 < 64; c0 += 8) {
            u32x2 uu[8]; f32x4 dd[8];
#pragma unroll
            for (int j = 0; j < 8; ++j) { uu[j] = *(const u32x2*)(u + (size_t)(c0 + j) * 16384); dd[j] = *(const f32x4*)(d + (size_t)(c0 + j) * 128); }
#pragma unroll
            for (int j = 0; j < 8; ++j) { u32x2 w; w.x = pk2(S.x, S.y); w.y = pk2(S.z, S.w); *(u32x2*)(u + (size_t)(c0 + j) * 16384) = w;
                S.x = dd[j].x * S.x + bflo(uu[j].x); S.y = dd[j].y * S.y + bfhi(uu[j].x); S.z = dd[j].z * S.z + bflo(uu[j].y); S.w = dd[j].w * S.w + bfhi(uu[j].y); }
        }
    }
}
constexpr int H3_QH = 0, H3_QA = 16384, H3_KH = 32768, H3_VT = 49152, H3_PP = 65536, H3_ST = 73728, H3_SEG = 106496, H3_RED = 110592;
DEV void phase_hgrn_a3(const Params& p, unsigned char* lds) {
    const int tid = threadIdx.x, lane = tid & 63, wid = tid >> 6, k2 = tid & 63, tq = tid >> 6;
    const int vb = vblock(), G = gridDim.x;
    const int frow = lane & 15, fq = lane >> 4;
    float* segs = (float*)(lds + H3_SEG); float* red = (float*)(lds + H3_RED);
    const bf16_t* ubuf = (const bf16_t*)(p.ws + WS_UBUF);
    for (int item = vb; item < 2048; item += G) {
        const int bh = item >> 6, c = item & 63, b = bh >> 2, h = bh & 3;
        __syncthreads();
        f32x2 lf[8], a[8], r, al;
        hgrn_cumsum(p, bh, c, segs, lf, a, r, al);
        {
            const bf16_t* HQ = (const bf16_t*)(p.ws + WS_HQ) + ((size_t)b * SEQ + c * 64 + tq * 8) * 512 + h * 128 + 2 * k2;
            unsigned qq[8];
#pragma unroll
            for (int i = 0; i < 8; ++i) qq[i] = *(const unsigned*)(HQ + (size_t)i * 512);
#pragma unroll
            for (int i = 0; i < 8; ++i) { const int t = 8 * tq + i; const float q0 = bflo(qq[i]), q1 = bfhi(qq[i]);
                const int off = swz256(t, k2 >> 2) + (k2 & 3) * 4;
                *(unsigned*)(lds + H3_QH + off) = pk2(q0 * __expf(fminf(a[i].x - r.x, 80.f)), q1 * __expf(fminf(a[i].y - r.y, 80.f)));
                *(unsigned*)(lds + H3_QA + off) = pk2(q0 * __expf(a[i].x), q1 * __expf(a[i].y));
                *(unsigned*)(lds + H3_KH + off) = pk2((1.f - __expf(lf[i].x)) * __expf(fminf(r.x - a[i].x, 80.f)), (1.f - __expf(lf[i].y)) * __expf(fminf(r.y - a[i].y, 80.f))); }
        }
        hgrn_stage_vt(p, bh, c, lds + H3_VT);
        {
            const bf16_t* st = ubuf + (size_t)item * 16384;
#pragma unroll
            for (int i = 0; i < 4; ++i) { const int q = tid + NT * i, v = q >> 4, ch = q & 15; *(u32x4*)(lds + H3_ST + swz256(v, ch)) = *(const u32x4*)(st + v * 128 + ch * 8); }
        }
        __syncthreads();
        {
            const int wr = wid >> 1, wc = wid & 1;
            f32x4 acc[2];
            acc[0] = (f32x4){0.f, 0.f, 0.f, 0.f}; acc[1] = acc[0];
            if (32 * wc <= 16 * wr + 15) {
#pragma unroll
                for (int ks = 0; ks < 4; ++ks) {
                    const int co = ((ks * 4 + fq) ^ frow) << 4;
                    const bf16x8 af = *(const bf16x8*)(lds + H3_QH + (16 * wr + frow) * 256 + co);
#pragma unroll
                    for (int n = 0; n < 2; ++n) { const bf16x8 bfr = *(const bf16x8*)(lds + H3_KH + (32 * wc + 16 * n + frow) * 256 + co);
                        acc[n] = __builtin_amdgcn_mfma_f32_16x16x32_bf16(bfr, af, acc[n], 0, 0, 0); }
                }
            }
            const int t = 16 * wr + frow;
#pragma unroll
            for (int n = 0; n < 2; ++n) { const int s0 = 32 * wc + 16 * n + 4 * fq; f32x4 v = acc[n];
                v.x = (s0 + 0 <= t) ? v.x : 0.f; v.y = (s0 + 1 <= t) ? v.y : 0.f; v.z = (s0 + 2 <= t) ? v.z : 0.f; v.w = (s0 + 3 <= t) ? v.w : 0.f;
                u32x2 w; w.x = pk2(v.x, v.y); w.y = pk2(v.z, v.w);
                *(u32x2*)(lds + H3_PP + t * 128 + ((((s0 >> 3)) ^ ((t >> 1) & 7)) << 4) + (s0 & 7) * 2) = w; }
        }
        __syncthreads();
        {
            const int wr = wid >> 2, wc = wid & 3;
            f32x4 acc[2][2];
#pragma unroll
            for (int m = 0; m < 2; ++m)
#pragma unroll
                for (int n = 0; n < 2; ++n) acc[m][n] = (f32x4){0.f, 0.f, 0.f, 0.f};
            const int sx = (frow >> 1) & 7;
#pragma unroll
            for (int ks = 0; ks < 2; ++ks) {
                const int co = ((ks * 4 + fq) ^ sx) << 4;
                bf16x8 af[2], bfr[2];
#pragma unroll
                for (int m = 0; m < 2; ++m) af[m] = *(const bf16x8*)(lds + H3_PP + (32 * wr + 16 * m + frow) * 128 + co);
#pragma unroll
                for (int n = 0; n < 2; ++n) bfr[n] = *(const bf16x8*)(lds + H3_VT + (32 * wc + 16 * n + frow) * 128 + co);
#pragma unroll
                for (int m = 0; m < 2; ++m)
#pragma unroll
                    for (int n = 0; n < 2; ++n) acc[m][n] = __builtin_amdgcn_mfma_f32_16x16x32_bf16(bfr[n], af[m], acc[m][n], 0, 0, 0);
            }
#pragma unroll
            for (int ks = 0; ks < 4; ++ks) {
                const int co = ((ks * 4 + fq) ^ frow) << 4;
                bf16x8 af[2], bfr[2];
#pragma unroll
                for (int m = 0; m < 2; ++m) af[m] = *(const bf16x8*)(lds + H3_QA + (32 * wr + 16 * m + frow) * 256 + co);
#pragma unroll
                for (int n = 0; n < 2; ++n) bfr[n] = *(const bf16x8*)(lds + H3_ST + (32 * wc + 16 * n + frow) * 256 + co);
#pragma unroll
                for (int m = 0; m < 2; ++m)
#pragma unroll
                    for (int n = 0; n < 2; ++n) acc[m][n] = __builtin_amdgcn_mfma_f32_16x16x32_bf16(bfr[n], af[m], acc[m][n], 0, 0, 0);
            }
#pragma unroll
            for (int m = 0; m < 2; ++m) { float ss = 0.f;
#pragma unroll
                for (int n = 0; n < 2; ++n) { const f32x4 v = acc[m][n]; ss += (v.x * v.x + v.y * v.y) + (v.z * v.z + v.w * v.w); }
                ss += __shfl_xor(ss, 16); ss += __shfl_xor(ss, 32);
                if (fq == 0) red[(32 * wr + 16 * m + frow) * 4 + wc] = ss; }
            __syncthreads();
#pragma unroll
            for (int m = 0; m < 2; ++m) { const int t = 32 * wr + 16 * m + frow; const f32x4 q4 = *(const f32x4*)(red + t * 4);
                const float rs = rsqrtf(((q4.x + q4.y) + (q4.z + q4.w)) * (1.f / 128.f) + RMS_EPS);
                const size_t row = (size_t)b * SEQ + c * 64 + t;
#pragma unroll
                for (int n = 0; n < 2; ++n) { const int v0 = 32 * wc + 16 * n + 4 * fq; const f32x4 gn = *(const f32x4*)(p.g_hn + v0);
                    const u32x2 gg = *(const u32x2*)((const bf16_t*)(p.ws + WS_HG) + row * 512 + h * 128 + v0);
                    const f32x4 o = acc[m][n];
                    u32x2 w; w.x = pk2(o.x * rs * gn.x * bflo(gg.x), o.y * rs * gn.y * bfhi(gg.x)); w.y = pk2(o.z * rs * gn.z * bflo(gg.y), o.w * rs * gn.w * bfhi(gg.y));
                    *(u32x2*)((bf16_t*)(p.ws + WS_R1) + row * 1024 + 512 + h * 128 + v0) = w; } }
        }
    }
}

DEV void phase_normalize(const Params& p, unsigned char* lds) {
    const int tid = threadIdx.x, lane = tid & 63, wid = tid >> 6;
    const int vb = vblock(), G = gridDim.x;
    unsigned char* ws = p.ws;
    bf16_t* mix = (bf16_t*)(ws + WS_R1); const float* rowss = (const float*)(ws + WS_ROWSS); const bf16_t* HG = (const bf16_t*)(ws + WS_HG);
    for (int m = vb * 8 + wid; m < NTOK; m += G * 8) {
        {
            const float r = rsqrtf(rowss[m] * (1.f / 512.f) + RMS_EPS);
            u32x4* pp = (u32x4*)(mix + (size_t)m * 1024) + lane; u32x4 v = *pp;
            v.x = pk2(bflo(v.x) * r, bfhi(v.x) * r); v.y = pk2(bflo(v.y) * r, bfhi(v.y) * r); v.z = pk2(bflo(v.z) * r, bfhi(v.z) * r); v.w = pk2(bflo(v.w) * r, bfhi(v.w) * r);
            *pp = v;
        }
    }
    __syncthreads();
    {
        float* tl = (float*)lds;
        for (int r = vb; r < 32 * 16 * 16; r += G) { const int e = r / 256, q = r % 256; SrcW13 s{p.w1 + (size_t)e * 1024 * 512, p.w3 + (size_t)e * 1024 * 512, p.ffn_g};
            convert_tile(tl, s, (bf16_t*)(ws + WS_W13T) + (size_t)e * 1024 * 1024, 1024, (q / 16) * 64, (q % 16) * 64); }
    }
}

struct EpiOut8 { const Params& p;
    DEV void operator()(const f32x4 (&acc)[2][2][4][2], const pg8::Unit& u, int wr, int wc, int fr, int fq) const {
#pragma unroll
        for (int ai = 0; ai < 2; ++ai)
#pragma unroll
            for (int m = 0; m < 4; ++m) { const size_t row = (size_t)u.pm * 256 + ai * 128 + wr * 64 + m * 16 + fr;
#pragma unroll
                for (int bj = 0; bj < 2; ++bj)
#pragma unroll
                    for (int n = 0; n < 2; ++n) { const int c = u.pn * 256 + 64 * wc + 32 * bj + 16 * n + 4 * fq; const f32x4 xv = *(const f32x4*)(p.x + row * DM + c); *(f32x4*)(p.out + row * DM + c) = xv + acc[ai][bj][m][n]; } }
    } };
DEV void phase_outproj(const Params& p, unsigned char* lds) {
    pg8::Gemm g{(const bf16_t*)(p.ws + WS_R1), (const bf16_t*)(p.ws + WS_WOUTT), NTOK, DM, DM};
    pg8::StaticOrder S; S.init(NTOK, DM, (int)gridDim.x, (int)blockIdx.x);
    EpiOut8 E{p};
    pg8::gemm_phase((PG8_LAS unsigned char*)lds, g, S, E);
}

constexpr int RT_W = 0, RT_LG = 49152, RT_RS = RT_LG + 128 * 49 * 4, RT_HIST = RT_RS + 512, RT_BASE = RT_HIST + 512, RT_LDS = RT_BASE + 512;
DEV void phase_router(const Params& p, unsigned char* lds) {
    const int tid = threadIdx.x, lane = tid & 63, wid = tid >> 6, frow = lane & 15, fq = lane >> 4;
    const int vb = vblock(), G = gridDim.x;
    unsigned char* ws = p.ws;
    float* lg = (float*)(lds + RT_LG); float* rsd = (float*)(lds + RT_RS);
    int* hist = (int*)(lds + RT_HIST); int* basep = (int*)(lds + RT_BASE);
    const bf16_t* rw = (const bf16_t*)(ws + WS_RW);
    for (int it = vb; it < NTOK / 128; it += G) {
        const size_t row0 = (size_t)it * 128;
        const size_t trow = row0 + 16 * wid + frow;
        const float* hrow = p.out + trow * DM + 8 * fq;
        bf16_t* hbrow = (bf16_t*)(ws + WS_R1) + trow * DM + 8 * fq;
        f32x4 acc[3]; float ss = 0.f;
#pragma unroll
        for (int nt = 0; nt < 3; ++nt) acc[nt] = (f32x4){0.f, 0.f, 0.f, 0.f};
        if (tid < 128) hist[tid] = 0;
        for (int kc = 0; kc < 4; ++kc) {
            __syncthreads();
#pragma unroll
            for (int i = 0; i < 6; ++i) { const int idx = tid + NT * i, r = idx >> 5, c = idx & 31;
                *(u32x4*)(lds + RT_W + r * 512 + ((c ^ (r & 15)) << 4)) = *(const u32x4*)(rw + (size_t)r * 1024 + kc * 256 + c * 8); }
            f32x4 xa[8][2];
#pragma unroll
            for (int ks = 0; ks < 8; ++ks) { xa[ks][0] = *(const f32x4*)(hrow + kc * 256 + 32 * ks); xa[ks][1] = *(const f32x4*)(hrow + kc * 256 + 32 * ks + 4); }
            __syncthreads();
#pragma unroll
            for (int ks = 0; ks < 8; ++ks) {
                const f32x4 a = xa[ks][0], b = xa[ks][1];
                ss += ((a.x * a.x + a.y * a.y) + (a.z * a.z + a.w * a.w)) + ((b.x * b.x + b.y * b.y) + (b.z * b.z + b.w * b.w));
                u32x4 hi; hi.x = pk2(a.x, a.y); hi.y = pk2(a.z, a.w); hi.z = pk2(b.x, b.y); hi.w = pk2(b.z, b.w);
                u32x4 lo; lo.x = pk2(a.x - bflo(hi.x), a.y - bfhi(hi.x)); lo.y = pk2(a.z - bflo(hi.y), a.w - bfhi(hi.y)); lo.z = pk2(b.x - bflo(hi.z), b.y - bfhi(hi.z)); lo.w = pk2(b.z - bflo(hi.w), b.w - bfhi(hi.w));
                *(u32x4*)(hbrow + kc * 256 + 32 * ks) = hi;
                const bf16x8 hh = __builtin_bit_cast(bf16x8, hi), hl = __builtin_bit_cast(bf16x8, lo);
                const int co = ((4 * ks + fq) ^ frow) << 4;
#pragma unroll
                for (int nt = 0; nt < 3; ++nt) {
                    const bf16x8 whi = *(const bf16x8*)(lds + RT_W + (16 * nt + frow) * 512 + co), wlo = *(const bf16x8*)(lds + RT_W + (48 + 16 * nt + frow) * 512 + co);
                    acc[nt] = __builtin_amdgcn_mfma_f32_16x16x32_bf16(whi, hh, acc[nt], 0, 0, 0);
                    acc[nt] = __builtin_amdgcn_mfma_f32_16x16x32_bf16(wlo, hh, acc[nt], 0, 0, 0);
                    acc[nt] = __builtin_amdgcn_mfma_f32_16x16x32_bf16(whi, hl, acc[nt], 0, 0, 0);
                }
            }
        }
        ss += __shfl_xor(ss, 16); ss += __shfl_xor(ss, 32);
        if (fq == 0) rsd[16 * wid + frow] = rsqrtf(ss * (1.f / DM) + RMS_EPS);
#pragma unroll
        for (int nt = 0; nt < 3; ++nt) { float* o = lg + (16 * wid + frow) * 49 + 16 * nt + 4 * fq; o[0] = acc[nt].x; o[1] = acc[nt].y; o[2] = acc[nt].z; o[3] = acc[nt].w; }
        __syncthreads();
        int bin = 0, slot = 0;
        if (tid < 128) {
            const float rs = rsd[tid];
            ((float*)(ws + WS_RSTD2))[row0 + tid] = rs;
            float gl[4]; int gi = 0; float gm = -1e30f;
#pragma unroll
            for (int c = 0; c < 4; ++c) { gl[c] = lg[tid * 49 + c] * rs + p.b_group[c]; if (gl[c] > gm) { gm = gl[c]; gi = c; } }
            float gs = 0.f;
#pragma unroll
            for (int c = 0; c < 4; ++c) gs += __expf(gl[c] - gm);
            const float pg = 1.f / gs;
            float el[8]; int i0 = 0; float m0 = -1e30f;
#pragma unroll
            for (int c = 0; c < 8; ++c) { el[c] = lg[tid * 49 + 4 + gi * 8 + c] * rs + p.b_expert[gi * 8 + c]; if (el[c] > m0) { m0 = el[c]; i0 = c; } }
            int i1 = 0; float m1 = -1e30f;
#pragma unroll
            for (int c = 0; c < 8; ++c) if (c != i0 && el[c] > m1) { m1 = el[c]; i1 = c; }
            const float e1 = __expf(m1 - m0); const float w0 = pg / (1.f + e1), w1 = pg * e1 / (1.f + e1);
            const int a = min(i0, i1), bb = max(i0, i1);
            bin = gi * 28 + (7 * a - (a * (a - 1)) / 2) + (bb - a - 1);
            f32x2 tw; tw.x = (i0 < i1) ? w0 : w1; tw.y = (i0 < i1) ? w1 : w0;
            ((f32x2*)(ws + WS_TOKW))[row0 + tid] = tw;
            slot = atomicAdd(&hist[bin], 1);
        }
        __syncthreads();
        if (tid < NBIN) { const int h = hist[tid]; basep[tid] = h ? atomicAdd((int*)(ws + WS_CTL) + tid, h) : 0; }
        __syncthreads();
        if (tid < 128) ((int*)(ws + WS_BINL))[(size_t)bin * BINCAP + basep[bin] + slot] = (int)(row0 + tid);
        __syncthreads();
    }
}

constexpr int MOE_TS = pg8::STAGE_BYTES, MOE_TT = MOE_TS + 512;
DEV void moe_tiles(const Params& p, unsigned char* lds) {
    int* tstart = (int*)(lds + MOE_TS); int* tiletab = (int*)(lds + MOE_TT);
    const int tid = threadIdx.x;
    __syncthreads();
    if (tid == 0) { const int* cnt = (const int*)(p.ws + WS_CTL); int s = 0; for (int i = 0; i < NBIN; ++i) { tstart[i] = s; s += (cnt[i] + 255) >> 8; } tstart[NBIN] = s; }
    __syncthreads();
    if (tid < NBIN) for (int t = tstart[tid]; t < tstart[tid + 1]; ++t) tiletab[t] = tid;
    __syncthreads();
}
DEV void bin_experts(int bin, int& ea, int& eb) { const int gi = bin / 28; int pi = bin % 28, a = 0; while (pi >= 7 - a) { pi -= 7 - a; ++a; } ea = gi * 8 + a; eb = gi * 8 + a + 1 + pi; }
struct MoeUnit { int tile, nt, bin, mt, n; };
struct MoeSchedBase {
    const Params& p; const int* tstart; const int* tiletab; int NN, U, G, c;
    DEV bool next(int i, MoeUnit& u) const {
        const int L = i * G + c; if (L >= U) return false;
        u.tile = L / NN; u.nt = L % NN;
        u.bin = __builtin_amdgcn_readfirstlane(tiletab[u.tile]);
        u.mt = u.tile - __builtin_amdgcn_readfirstlane(tstart[u.bin]);
        const int cnt = ((const int*)(p.ws + WS_CTL))[u.bin];
        u.n = min(256, cnt - u.mt * 256);
        return true;
    }
    DEV bool full(const MoeUnit& u) const { return u.n > 128; }
};
struct PolMoe1 : MoeSchedBase {
    typedef MoeUnit Unit;
    struct AddrA { unsigned off[2][2]; };
    struct AddrB { const char* base; unsigned voff[2]; };
    DEV int nk() const { return 16; }
    DEV void addrA(const MoeUnit& u, const int (&R)[2], const int (&C)[2], AddrA& a) const {
        const int* list = (const int*)(p.ws + WS_BINL) + (size_t)u.bin * BINCAP + u.mt * 256;
#pragma unroll
        for (int h = 0; h < 2; ++h)
#pragma unroll
            for (int i = 0; i < 2; ++i) { int r = h * 128 + R[i]; if (r >= u.n) r = 0; a.off[h][i] = (unsigned)list[r] * 2048u + (unsigned)C[i] * 2u; }
    }
    DEV void addrB(const MoeUnit& u, const int (&R)[2], const int (&C)[2], AddrB& b) const {
        int ea, eb; bin_experts(u.bin, ea, eb); const int e = u.nt < 4 ? ea : eb;
        b.base = (const char*)(p.ws + WS_W13T) + ((size_t)e * 1024 + (u.nt & 3) * 256) * 2048;
#pragma unroll
        for (int i = 0; i < 2; ++i) b.voff[i] = (unsigned)(R[i] * 1024 + C[i]) * 2u;
    }
    DEV const char* pa(const AddrA& a, int h, int i, int kt) const { return (const char*)(p.ws + WS_R1) + a.off[h][i] + kt * 128; }
    DEV const char* pb(const AddrB& b, int h, int i, int kt) const { return b.base + (size_t)h * (128 * 2048) + b.voff[i] + kt * 128; }
};
struct EpiMoe1 { const Params& p;
    DEV void operator()(const f32x4 (&acc)[2][2][4][2], const MoeUnit& u, int wr, int wc, int fr, int fq) const {
        const int* list = (const int*)(p.ws + WS_BINL) + (size_t)u.bin * BINCAP + u.mt * 256;
        bf16_t* hbuf = (bf16_t*)(p.ws + WS_HBUF) + (size_t)u.tile * 256 * 1024 + (u.nt < 4 ? 0 : 512);
#pragma unroll
        for (int ai = 0; ai < 2; ++ai)
#pragma unroll
            for (int m = 0; m < 4; ++m) { const int r = ai * 128 + wr * 64 + m * 16 + fr; if (r >= u.n) continue;
                const int t = list[r]; const float rs = ((const float*)(p.ws + WS_RSTD2))[t]; const f32x2 tw = ((const f32x2*)(p.ws + WS_TOKW))[t]; const float w = u.nt < 4 ? tw.x : tw.y;
#pragma unroll
                for (int bj = 0; bj < 2; ++bj)
#pragma unroll
                    for (int n = 0; n < 2; ++n) { const f32x4 v = acc[ai][bj][m][n] * rs; const int f = ((u.nt & 3) * 256 + 128 * bj + 32 * wc + 16 * n + 4 * fq) >> 1;
                        *(unsigned*)(hbuf + (size_t)r * 1024 + f) = pk2(siluf_(v.x) * v.y * w, siluf_(v.z) * v.w * w); } }
    } };
DEV void phase_moe1(const Params& p, unsigned char* lds) {
    moe_tiles(p, lds);
    const int* tstart = (const int*)(lds + MOE_TS);
    PolMoe1 P{{p, tstart, (const int*)(lds + MOE_TT), 8, tstart[NBIN] * 8, (int)gridDim.x, vblock()}};
    EpiMoe1 E{p};
    pg8::gemm_phase2((PG8_LAS unsigned char*)lds, P, E);
}
struct PolMoe2 : MoeSchedBase {
    typedef MoeUnit Unit;
    struct AddrA { const char* base; unsigned voff[2]; };
    struct AddrB { const char* ba; const char* bb; unsigned voff[2]; };
    DEV int nk() const { return 16; }
    DEV void addrA(const MoeUnit& u, const int (&R)[2], const int (&C)[2], AddrA& a) const {
        a.base = (const char*)(p.ws + WS_HBUF) + (size_t)u.tile * 256 * 2048;
#pragma unroll
        for (int i = 0; i < 2; ++i) a.voff[i] = (unsigned)(R[i] * 1024 + C[i]) * 2u;
    }
    DEV void addrB(const MoeUnit& u, const int (&R)[2], const int (&C)[2], AddrB& b) const {
        int ea, eb; bin_experts(u.bin, ea, eb);
        b.ba = (const char*)(p.ws + WS_W2T) + ((size_t)ea * 1024 + u.nt * 256) * 1024; b.bb = (const char*)(p.ws + WS_W2T) + ((size_t)eb * 1024 + u.nt * 256) * 1024;
#pragma unroll
        for (int i = 0; i < 2; ++i) b.voff[i] = (unsigned)(R[i] * 512 + C[i]) * 2u;
    }
    DEV const char* pa(const AddrA& a, int h, int i, int kt) const { return a.base + (size_t)h * (128 * 2048) + a.voff[i] + kt * 128; }
    DEV const char* pb(const AddrB& b, int h, int i, int kt) const { return (kt < 8 ? b.ba + kt * 128 : b.bb + (kt - 8) * 128) + (size_t)h * (128 * 1024) + b.voff[i]; }
};
struct EpiMoe2 { const Params& p;
    DEV void operator()(const f32x4 (&acc)[2][2][4][2], const MoeUnit& u, int wr, int wc, int fr, int fq) const {
        const int* list = (const int*)(p.ws + WS_BINL) + (size_t)u.bin * BINCAP + u.mt * 256;
#pragma unroll
        for (int ai = 0; ai < 2; ++ai)
#pragma unroll
            for (int m = 0; m < 4; ++m) { const int r = ai * 128 + wr * 64 + m * 16 + fr; if (r >= u.n) continue; const size_t t = list[r];
#pragma unroll
                for (int bj = 0; bj < 2; ++bj)
#pragma unroll
                    for (int n = 0; n < 2; ++n) { float* o = p.out + t * DM + u.nt * 256 + 128 * bj + 32 * wc + 16 * n + 4 * fq; *(f32x4*)o = *(const f32x4*)o + acc[ai][bj][m][n]; } }
    } };
DEV void phase_moe2(const Params& p, unsigned char* lds) {
    moe_tiles(p, lds);
    const int* tstart = (const int*)(lds + MOE_TS);
    PolMoe2 P{{p, tstart, (const int*)(lds + MOE_TT), 4, tstart[NBIN] * 4, (int)gridDim.x, vblock()}};
    EpiMoe2 E{p};
    pg8::gemm_phase2((PG8_LAS unsigned char*)lds, P, E);
}

#define XB_TMO      128
#define XB_XCNT(j)  (256  + 64 * (j))
#define XB_XSUB(j)  (1280 + 64 * (j))
#define XB_XGEN(j)  (2304 + 64 * (j))
#define XB_TOP      3328
#define XB_TOPGEN   3392
#define XCD_BAR_WORDS 3456
#define XB_SPIN_CAP (1u << 20)
#define LAS __attribute__((address_space(3)))
constexpr size_t WS_BAR = WS_CTL + 4096;
DEV unsigned xb_ld(unsigned* p) { return __hip_atomic_load(p, __ATOMIC_RELAXED, __HIP_MEMORY_SCOPE_AGENT); }
DEV unsigned xb_add(unsigned* p, unsigned v) { return __hip_atomic_fetch_add(p, v, __ATOMIC_RELAXED, __HIP_MEMORY_SCOPE_AGENT); }
DEV unsigned xb_xcc_id() { return (unsigned)__builtin_amdgcn_s_getreg((3 << 11) | 20) & 0xFu; }
#define XB_SPIN(cond, bar) do { unsigned _sp = 0; while (cond) { __builtin_amdgcn_s_sleep(1); \
    if ((++_sp & 255u) == 0u) { if (xb_ld(&(bar)[XB_TMO])) break; if (_sp > XB_SPIN_CAP) { atomicAdd(&(bar)[XB_TMO], 1u); break; } } } } while (0)
struct XcdBarrier { unsigned* bar; unsigned x; volatile LAS unsigned* st; };
DEV XcdBarrier xcd_barrier_post(unsigned* bar, volatile LAS unsigned* st) {
    XcdBarrier b; b.bar = bar; b.x = xb_xcc_id(); b.st = st;
    if (threadIdx.x == 0) (void)xb_add(&bar[XB_XCNT(b.x)], 1u);
    return b;
}
DEV void xcd_barrier_complete(unsigned* bar, unsigned x, unsigned& nloc, unsigned& nx) {
    const unsigned G = gridDim.x * gridDim.y * gridDim.z;
    unsigned sum, cnt, mine, sp = 0u;
    for (;;) {
        sum = 0u; cnt = 0u; mine = 0u;
#pragma unroll
        for (unsigned j = 0; j < 16; ++j) { const unsigned c = xb_ld(&bar[XB_XCNT(j)]); sum += c; cnt += (c > 0u) ? 1u : 0u; mine = (j == x) ? c : mine; }
        if (sum == G) break;
        __builtin_amdgcn_s_sleep(1);
        if ((++sp & 255u) == 0u) { if (xb_ld(&bar[XB_TMO])) break; if (sp > XB_SPIN_CAP) { atomicAdd(&bar[XB_TMO], 1u); break; } }
    }
    nloc = mine > 0u ? mine : 1u; nx = cnt > 0u ? cnt : 1u;
}
DEV void xcd_barrier(const XcdBarrier& b) {
    asm volatile("s_waitcnt vmcnt(0)" ::: "memory");
    __syncthreads();
    if (threadIdx.x == 0) {
        unsigned* bar = b.bar;
        __builtin_amdgcn_s_waitcnt(0);
        unsigned nloc = b.st[0], nx = b.st[1];
        if (nloc == 0u) { xcd_barrier_complete(bar, b.x, nloc, nx); b.st[0] = nloc; b.st[1] = nx; }
        const unsigned old = xb_add(&bar[XB_XSUB(b.x)], 1u);
        const unsigned gen = old / nloc;
        if (old + 1u == (gen + 1u) * nloc) {
            __builtin_amdgcn_fence(__ATOMIC_RELEASE, "agent");
            asm volatile("s_waitcnt vmcnt(0)" ::: "memory");
            const unsigned og = xb_add(&bar[XB_TOP], 1u);
            const unsigned tg = og / nx;
            if (og + 1u == (tg + 1u) * nx) xb_add(&bar[XB_TOPGEN], 1u);
            else XB_SPIN(xb_ld(&bar[XB_TOPGEN]) == tg, bar);
            __builtin_amdgcn_fence(__ATOMIC_ACQUIRE, "agent");
            xb_add(&bar[XB_XGEN(b.x)], 1u);
            asm volatile("s_waitcnt vmcnt(0)" ::: "memory");
        } else {
            XB_SPIN(xb_ld(&bar[XB_XGEN(b.x)]) == gen, bar);
            __builtin_amdgcn_fence(__ATOMIC_ACQUIRE, "agent");
            asm volatile("s_waitcnt vmcnt(0)" ::: "memory");
        }
    }
    __syncthreads();
}

constexpr int LDS_BYTES = 144 * 1024;
constexpr int N_PHASES = 13;
__global__ void __launch_bounds__(NT) mega(Params p, int lo, int hi) {
    extern __shared__ __attribute__((aligned(16))) unsigned char lds[];
    volatile LAS unsigned* xst = (volatile LAS unsigned*)(lds + LDS_BYTES - 16);
    if (threadIdx.x < 4) xst[threadIdx.x] = 0u;
    __syncthreads();
    XcdBarrier xbar; xbar.bar = (unsigned*)(p.ws + WS_BAR); xbar.x = 0; xbar.st = xst;
    if (hi - lo > 1) xbar = xcd_barrier_post((unsigned*)(p.ws + WS_BAR), xst);
#define GRID_SYNC() xcd_barrier(xbar)
#ifndef PROBE_REPEAT
#define PROBE_REPEAT -1
#endif
#define RUN_PHASE(k, call) do { if (lo <= (k) && (k) < hi) { call; \
        if ((k) == PROBE_REPEAT) { GRID_SYNC(); \
            if ((k) == 5) { float* rz = (float*)(p.ws + WS_ROWSS); for (int i = blockIdx.x * NT + threadIdx.x; i < NTOK; i += gridDim.x * NT) rz[i] = 0.f; GRID_SYNC(); } \
            if ((k) == 11) { if (blockIdx.x == 0 && threadIdx.x < 128) ((int*)(p.ws + WS_CTL))[threadIdx.x] = 0; GRID_SYNC(); } \
            call; } \
        if ((k) + 1 < hi) GRID_SYNC(); } } while (0)
    RUN_PHASE(0, phase_prologue(p, lds));
    RUN_PHASE(1, phase_inproj(p, lds));
    RUN_PHASE(2, phase_cmp_a(p, lds));
    RUN_PHASE(3, phase_cmp_b(p, lds));
    RUN_PHASE(4, phase_cmp_attn(p, lds));
    RUN_PHASE(5, phase_flash(p, lds));
    RUN_PHASE(6, phase_hgrn_a1(p, lds));
    RUN_PHASE(7, phase_hgrn_a2(p, lds));
    RUN_PHASE(8, phase_hgrn_a3(p, lds));
    RUN_PHASE(9, phase_normalize(p, lds));
    RUN_PHASE(10, phase_outproj(p, lds));
    RUN_PHASE(11, phase_router(p, lds));
    RUN_PHASE(12, phase_moe1(p, lds));
    RUN_PHASE(13, phase_moe2(p, lds));
#undef RUN_PHASE
}

extern "C" void kernel_launch(void* const* d_in, const int* in_sizes, int n_in, void* d_out, int out_size, void* d_ws, size_t ws_size, hipStream_t stream) {
    static int grid = 0;
    if (grid == 0) {
        int dev = 0, cus = 0, per_cu = 0;
        hipGetDevice(&dev);
        hipDeviceGetAttribute(&cus, hipDeviceAttributeMultiprocessorCount, dev);
        hipFuncSetAttribute((const void*)mega, hipFuncAttributeMaxDynamicSharedMemorySize, LDS_BYTES);
        hipOccupancyMaxActiveBlocksPerMultiprocessor(&per_cu, (const void*)mega, NT, LDS_BYTES);
        if (per_cu < 1) per_cu = 1;
        grid = cus;
        if (ws_size < WS_END) fprintf(stderr, "kernel_launch: workspace too small: %zu < %zu\n", ws_size, (size_t)WS_END);
        fprintf(stderr, "kernel_launch: cus %d per_cu %d grid %d ws %zu\n", cus, per_cu, grid, ws_size);
    }
    Params p{};
    const float** pp = (const float**)&p;
    for (int i = 0; i < 23; ++i) pp[i] = (const float*)d_in[i];
    p.out = (float*)d_out; p.ws = (unsigned char*)d_ws;
#if N_LAUNCH_MODE == 1
    (void)hipMemsetAsync((unsigned char*)d_ws + WS_BAR, 0, XCD_BAR_WORDS * 4, stream);
    int lo = 0, hi = N_PHASES + 1;
    void* args[] = {&p, &lo, &hi};
    hipError_t e = hipLaunchCooperativeKernel((const void*)mega, dim3(grid), dim3(NT), args, LDS_BYTES, stream);
    if (e != hipSuccess) fprintf(stderr, "cooperative launch failed: %s\n", hipGetErrorString(e));
#else
    for (int ph = 0; ph <= N_PHASES; ++ph) hipLaunchKernelGGL(mega, dim3(grid), dim3(NT), LDS_BYTES, stream, p, ph, ph + 1);
#endif
}
```

```cpp
#include <hip/hip_runtime.h>
#include <hip/hip_cooperative_groups.h>
#include <cstdio>
#include <cstdint>
#include <cstring>
namespace cg = cooperative_groups;

#ifndef N_LAUNCH_MODE
#define N_LAUNCH_MODE 1
#endif

#define DEV __device__ __forceinline__
typedef unsigned short bf16_t;
typedef short bf16x8 __attribute__((ext_vector_type(8)));
typedef float f32x4 __attribute__((ext_vector_type(4)));
typedef float f32x2 __attribute__((ext_vector_type(2)));
typedef float f32x16 __attribute__((ext_vector_type(16)));
typedef unsigned u32x4 __attribute__((ext_vector_type(4)));
typedef unsigned u32x2 __attribute__((ext_vector_type(2)));

constexpr int NT = 512;
constexpr int BATCH = 8, SEQ = 4096, DM = 1024, NTOK = BATCH * SEQ;
constexpr int IN_COLS = 3352, INP = 3584;
constexpr int NC = 255;
constexpr float RMS_EPS = 1e-6f;
constexpr float QSCALE = 0.125f * 1.4426950408889634f;
constexpr int NBIN = 112;
constexpr int BINCAP = NTOK;

constexpr size_t MiB = 1ull << 20;
constexpr size_t WS_CTL    = 0;
constexpr size_t WS_RSTD1  = 1 * MiB;
constexpr size_t WS_RSTD2  = WS_RSTD1 + 128 * 1024;
constexpr size_t WS_ROWSS  = WS_RSTD2 + 128 * 1024;
constexpr size_t WS_TOKW   = WS_ROWSS + 128 * 1024;
constexpr size_t WS_LB     = WS_TOKW + 256 * 1024;
constexpr size_t WS_CBIAS  = WS_LB + 4096;
constexpr size_t WS_SELM   = 2 * MiB;
constexpr size_t WS_GATES  = 3 * MiB;
constexpr size_t WS_KCMP   = 6 * MiB;
constexpr size_t WS_VCMP   = WS_KCMP + 512 * 1024;
constexpr size_t WS_CW2T   = 7 * MiB;
constexpr size_t WS_RW     = 7 * MiB + 128 * 1024;
constexpr size_t WS_HID    = 8 * MiB;
constexpr size_t WS_CW1T   = 12 * MiB;
constexpr size_t WS_WOUTT  = 14 * MiB;
constexpr size_t WS_WINT   = 16 * MiB;
constexpr size_t WS_R1     = 24 * MiB;
constexpr size_t WS_Q      = 88 * MiB;
constexpr size_t WS_KC     = 120 * MiB;
constexpr size_t WS_VC     = 128 * MiB;
constexpr size_t WS_KS     = 136 * MiB;
constexpr size_t WS_KW     = 144 * MiB;
constexpr size_t WS_VST    = 152 * MiB;
constexpr size_t WS_VWT    = 160 * MiB;
constexpr size_t WS_OC     = 168 * MiB;
constexpr size_t WS_W13T   = 200 * MiB;
constexpr size_t WS_W2T    = 264 * MiB;
constexpr size_t WS_HQ     = 296 * MiB;
constexpr size_t WS_HV     = 328 * MiB;
constexpr size_t WS_HG     = 360 * MiB;
constexpr size_t WS_HLOGF  = 392 * MiB;
constexpr size_t WS_DBUF   = 456 * MiB;
constexpr size_t WS_END    = 457 * MiB;
constexpr size_t WS_UBUF   = WS_W13T;
constexpr size_t WS_BINL   = WS_HQ;
constexpr size_t WS_HBUF   = WS_HQ + 16 * MiB;

struct Params {
    const float *x, *attn_g, *ffn_g, *w_in, *w_out, *g_q, *g_k, *pos_k, *pos_v, *wk1, *wk2, *wv1, *wv2, *g_nsa, *lb_logits, *g_hn,
        *w_group, *b_group, *w_expert, *b_expert, *w1, *w3, *w2;
    float* out;
    unsigned char* ws;
};

typedef __bf16 bf16x2_t __attribute__((ext_vector_type(2)));
DEV unsigned pk2(float lo, float hi) { f32x2 f = {lo, hi}; return __builtin_bit_cast(unsigned, __builtin_convertvector(f, bf16x2_t)); }
DEV bf16_t f2bf(float f) { return (bf16_t)(pk2(f, 0.f) & 0xffffu); }
DEV float bf2f(bf16_t b) { return __uint_as_float(((unsigned)b) << 16); }
DEV float bflo(unsigned u) { return __uint_as_float(u << 16); }
DEV float bfhi(unsigned u) { return __uint_as_float(u & 0xffff0000u); }
DEV float sigmoidf_(float v) { return 1.f / (1.f + __expf(-v)); }
DEV float siluf_(float v) { return v / (1.f + __expf(-v)); }
DEV float wave_sum(float v) {
#pragma unroll
    for (int o = 1; o < 64; o <<= 1) v += __shfl_xor(v, o);
    return v;
}
DEV float wave_max(float v) {
#pragma unroll
    for (int o = 1; o < 64; o <<= 1) v = fmaxf(v, __shfl_xor(v, o));
    return v;
}
DEV int vblock() { const int G = gridDim.x, b = blockIdx.x; return (G % 8 == 0) ? (b % 8) * (G / 8) + b / 8 : b; }

namespace pg8 {
#define PG8_LAS __attribute__((address_space(3)))
constexpr int BM = 256, BK = 64, HALF = 128, HTB = HALF * BK * 2, STAGE_BYTES = 8 * HTB, NXCD = 8, WGM = 8;
__host__ __device__ __forceinline__ int lds_byte(int r, int c) { const int st = (r >> 4) * 2 + (c >> 5), rr = r & 15, cc = c & 31, ob = rr * 64 + cc * 2; return st * 1024 + (ob ^ (((ob >> 9) & 1) << 5)); }
__host__ __device__ __forceinline__ void stage_rc(int b, int& R, int& C) { const int st = b / 1024, sb = b % 1024, swz = sb ^ (((sb >> 9) & 1) << 5); R = (st >> 1) * 16 + swz / 64; C = (st & 1) * 32 + (swz % 64) / 2; }
struct Unit { int pm, pn; };
struct Gemm { const bf16_t* A; const bf16_t* Bt; int M, N, K; };
struct StaticOrder {
    int nM, nN, nwg, G, c;
    __host__ __device__ void init(int M, int N, int G_, int c_) { nM = M / BM; nN = N / BM; nwg = nM * nN; G = G_; c = c_; }
    __host__ __device__ bool next(int i, Unit& u) const {
        const long L = (long)i * G + c; if (L >= nwg) return false;
        int wgid = (int)L; { const int q = nwg / NXCD, r = nwg % NXCD, xcd = wgid % NXCD, off = wgid / NXCD; wgid = (xcd < r ? xcd * (q + 1) : r * (q + 1) + (xcd - r) * q) + off; }
        const int nig = WGM * nN, gid = wgid / nig, fm = gid * WGM, gsz = (nM - fm) < WGM ? (nM - fm) : WGM;
        u.pm = fm + ((wgid % nig) % gsz); u.pn = (wgid % nig) / gsz; return true;
    }
};
template <class Epi, class Sched>
__device__ __forceinline__ void gemm_phase(PG8_LAS unsigned char* lds, const Gemm g, const Sched& S, const Epi& E) {
    const int tid = threadIdx.x, wid = __builtin_amdgcn_readfirstlane(tid >> 6), lane = tid & 63, wr = wid >> 2, wc = wid & 3, fr = lane & 15, fq = lane >> 4;
    const int K = g.K, nt = K / BK;
    unsigned voffA[2];
#pragma unroll
    for (int i = 0; i < 2; ++i) { int R, C; stage_rc(tid * 16 + i * 8192, R, C); voffA[i] = (unsigned)(R * K + C) * 2u; }
    const size_t kstep = (size_t)(BK * 2);
    const size_t hstep = (size_t)HALF * K * 2;
    const size_t tstep = 2 * hstep;
    const unsigned ldsw = (unsigned)wid * 1024u;
    const int aoff = lds_byte(wr * 64 + fr, fq * 8), boff = lds_byte(wc * 32 + fr, fq * 8);
#define PG8_SA(b, h) (((b) * 2 + (h)) * HTB)
#define PG8_SB(b, h) ((4 + (b) * 2 + (h)) * HTB)
#define PG8_STAGE(bufoff, gbase, voff) do { _Pragma("unroll") for (int _i = 0; _i < 2; ++_i) \
        __builtin_amdgcn_global_load_lds((const unsigned*)((const char*)(gbase) + (voff)[_i]), (PG8_LAS unsigned*)(lds + (bufoff) + ldsw + _i * 8192), 16, 0, 0); } while (0)
#define PG8_LDA(dst, b, h) do { _Pragma("unroll") for (int m = 0; m < 4; ++m) _Pragma("unroll") for (int k = 0; k < 2; ++k) dst[m][k] = *(const PG8_LAS bf16x8*)(lds + PG8_SA(b, h) + aoff + m * 2048 + k * 1024); } while (0)
#define PG8_LDB(dst, b, h) do { _Pragma("unroll") for (int n = 0; n < 2; ++n) _Pragma("unroll") for (int k = 0; k < 2; ++k) dst[n][k] = *(const PG8_LAS bf16x8*)(lds + PG8_SB(b, h) + boff + n * 2048 + k * 1024); } while (0)
#define PG8_MMA(ai, bj, At, Bt) do { __builtin_amdgcn_s_setprio(1); _Pragma("unroll") for (int m = 0; m < 4; ++m) _Pragma("unroll") for (int n = 0; n < 2; ++n) _Pragma("unroll") for (int k = 0; k < 2; ++k) \
        acc[ai][bj][m][n] = __builtin_amdgcn_mfma_f32_16x16x32_bf16(Bt[n][k], At[m][k], acc[ai][bj][m][n], 0, 0, 0); __builtin_amdgcn_s_setprio(0); } while (0)
#define PG8_WAIT_V(n) asm volatile("s_waitcnt vmcnt(" #n ")" ::: "memory")
#define PG8_WAIT_L(n) asm volatile("s_waitcnt lgkmcnt(" #n ")" ::: "memory")
#define PG8_BAR __builtin_amdgcn_s_barrier()
#define PG8_SCHED __builtin_amdgcn_sched_barrier(0)
    Unit cur, nxt; int ui = 0;
    if (!S.next(0, cur)) return;
    f32x4 acc[2][2][4][2];
#pragma unroll
    for (int a = 0; a < 2; ++a)
#pragma unroll
        for (int b = 0; b < 2; ++b)
#pragma unroll
            for (int m = 0; m < 4; ++m)
#pragma unroll
                for (int n = 0; n < 2; ++n) acc[a][b][m][n] = (f32x4){0.f, 0.f, 0.f, 0.f};
    bf16x8 At[4][2], B0[2][2], B1[2][2];
    const char* cA = (const char*)g.A + (size_t)cur.pm * tstep; const char* cB = (const char*)g.Bt + (size_t)cur.pn * tstep;
    PG8_STAGE(PG8_SB(0, 0), cB, voffA); PG8_STAGE(PG8_SA(0, 0), cA, voffA); PG8_STAGE(PG8_SB(0, 1), cB + hstep, voffA); PG8_STAGE(PG8_SA(0, 1), cA + hstep, voffA);
    if (wr == 1) PG8_BAR;
    PG8_WAIT_V(4); PG8_BAR;
    PG8_STAGE(PG8_SB(1, 0), cB + kstep, voffA); PG8_STAGE(PG8_SA(1, 0), cA + kstep, voffA); PG8_STAGE(PG8_SB(1, 1), cB + hstep + kstep, voffA);
    PG8_WAIT_V(6); PG8_BAR;
    for (;;) {
        const bool has_next = S.next(ui + 1, nxt);
        const char* nA = has_next ? (const char*)g.A + (size_t)nxt.pm * tstep : cA; const char* nB = has_next ? (const char*)g.Bt + (size_t)nxt.pn * tstep : cB;
        for (int t = 0; t < nt; t += 2) {
            const bool last = (t == nt - 2);
            const char* a1 = cA + (size_t)(t + 1) * kstep;
            const char* a2 = last ? nA : cA + (size_t)(t + 2) * kstep; const char* b2 = last ? nB : cB + (size_t)(t + 2) * kstep;
            const char* a3 = a2 + kstep; const char* b3 = b2 + kstep;
            PG8_LDB(B0, 0, 0); PG8_SCHED; PG8_LDA(At, 0, 0); PG8_STAGE(PG8_SA(1, 1), a1 + hstep, voffA);
            PG8_WAIT_L(8); PG8_BAR; PG8_WAIT_L(0); PG8_MMA(0, 0, At, B0); PG8_BAR; PG8_SCHED;
            PG8_LDB(B1, 0, 1); PG8_STAGE(PG8_SB(0, 0), b2, voffA);
            PG8_BAR; PG8_WAIT_L(0); PG8_MMA(0, 1, At, B1); PG8_BAR;
            PG8_LDA(At, 0, 1); PG8_STAGE(PG8_SA(0, 0), a2, voffA);
            PG8_BAR; PG8_WAIT_L(0); PG8_MMA(1, 0, At, B0); PG8_BAR; PG8_SCHED;
            PG8_STAGE(PG8_SB(0, 1), b2 + hstep, voffA);
            PG8_WAIT_V(6); PG8_BAR; PG8_MMA(1, 1, At, B1); PG8_BAR;
            PG8_LDB(B0, 1, 0); PG8_SCHED; PG8_LDA(At, 1, 0); PG8_STAGE(PG8_SA(0, 1), a2 + hstep, voffA);
            PG8_WAIT_L(8); PG8_BAR; PG8_WAIT_L(0); PG8_MMA(0, 0, At, B0); PG8_BAR; PG8_SCHED;
            PG8_LDB(B1, 1, 1); PG8_STAGE(PG8_SB(1, 0), b3, voffA);
            PG8_BAR; PG8_WAIT_L(0); PG8_MMA(0, 1, At, B1); PG8_BAR;
            PG8_LDA(At, 1, 1); PG8_STAGE(PG8_SA(1, 0), a3, voffA);
            PG8_BAR; PG8_WAIT_L(0); PG8_MMA(1, 0, At, B0); PG8_BAR; PG8_SCHED;
            PG8_STAGE(PG8_SB(1, 1), b3 + hstep, voffA);
            PG8_WAIT_V(6); PG8_BAR; PG8_MMA(1, 1, At, B1); PG8_BAR;
        }
        E(acc, cur, wr, wc, fr, fq);
        if (!has_next) break;
#pragma unroll
        for (int a = 0; a < 2; ++a)
#pragma unroll
            for (int b = 0; b < 2; ++b)
#pragma unroll
                for (int m = 0; m < 4; ++m)
#pragma unroll
                    for (int n = 0; n < 2; ++n) acc[a][b][m][n] = (f32x4){0.f, 0.f, 0.f, 0.f};
        cur = nxt; cA = nA; cB = nB; ++ui;
    }
    PG8_WAIT_V(0);
    if (wr == 0) PG8_BAR;
    PG8_BAR;
#undef PG8_SA
#undef PG8_SB
#undef PG8_STAGE
#undef PG8_LDA
#undef PG8_LDB
#undef PG8_MMA
#undef PG8_WAIT_V
#undef PG8_WAIT_L
#undef PG8_BAR
#undef PG8_SCHED
}
template <class Pol, class Epi>
__device__ __forceinline__ void gemm_phase2(PG8_LAS unsigned char* lds, const Pol& P, const Epi& E) {
    const int tid = threadIdx.x, wid = __builtin_amdgcn_readfirstlane(tid >> 6), lane = tid & 63, wr = wid >> 2, wc = wid & 3, fr = lane & 15, fq = lane >> 4;
    const int nt = P.nk();
    int R[2], C[2];
#pragma unroll
    for (int i = 0; i < 2; ++i) stage_rc(tid * 16 + i * 8192, R[i], C[i]);
    const unsigned ldsw = (unsigned)wid * 1024u;
    const int aoff = lds_byte(wr * 64 + fr, fq * 8), boff = lds_byte(wc * 32 + fr, fq * 8);
#define PG8_SA(b, h) (((b) * 2 + (h)) * HTB)
#define PG8_SB(b, h) ((4 + (b) * 2 + (h)) * HTB)
#define PG8_STAGE_A(bufoff, AS, h, kt) do { _Pragma("unroll") for (int _i = 0; _i < 2; ++_i) \
        __builtin_amdgcn_global_load_lds((const unsigned*)P.pa(AS, h, _i, kt), (PG8_LAS unsigned*)(lds + (bufoff) + ldsw + _i * 8192), 16, 0, 0); } while (0)
#define PG8_STAGE_B(bufoff, BS, h, kt) do { _Pragma("unroll") for (int _i = 0; _i < 2; ++_i) \
        __builtin_amdgcn_global_load_lds((const unsigned*)P.pb(BS, h, _i, kt), (PG8_LAS unsigned*)(lds + (bufoff) + ldsw + _i * 8192), 16, 0, 0); } while (0)
#define PG8_LDA(dst, b, h) do { _Pragma("unroll") for (int m = 0; m < 4; ++m) _Pragma("unroll") for (int k = 0; k < 2; ++k) dst[m][k] = *(const PG8_LAS bf16x8*)(lds + PG8_SA(b, h) + aoff + m * 2048 + k * 1024); } while (0)
#define PG8_LDB(dst, b, h) do { _Pragma("unroll") for (int n = 0; n < 2; ++n) _Pragma("unroll") for (int k = 0; k < 2; ++k) dst[n][k] = *(const PG8_LAS bf16x8*)(lds + PG8_SB(b, h) + boff + n * 2048 + k * 1024); } while (0)
#define PG8_MMA(ai, bj, At, Bt) do { __builtin_amdgcn_s_setprio(1); _Pragma("unroll") for (int m = 0; m < 4; ++m) _Pragma("unroll") for (int n = 0; n < 2; ++n) _Pragma("unroll") for (int k = 0; k < 2; ++k) \
        acc[ai][bj][m][n] = __builtin_amdgcn_mfma_f32_16x16x32_bf16(Bt[n][k], At[m][k], acc[ai][bj][m][n], 0, 0, 0); __builtin_amdgcn_s_setprio(0); } while (0)
#define PG8_WAIT_V(n) asm volatile("s_waitcnt vmcnt(" #n ")" ::: "memory")
#define PG8_WAIT_L(n) asm volatile("s_waitcnt lgkmcnt(" #n ")" ::: "memory")
#define PG8_BAR __builtin_amdgcn_s_barrier()
#define PG8_SCHED __builtin_amdgcn_sched_barrier(0)
    typename Pol::Unit cur, nxt; int ui = 0;
    if (!P.next(0, cur)) return;
    f32x4 acc[2][2][4][2];
#pragma unroll
    for (int a = 0; a < 2; ++a)
#pragma unroll
        for (int b = 0; b < 2; ++b)
#pragma unroll
            for (int m = 0; m < 4; ++m)
#pragma unroll
                for (int n = 0; n < 2; ++n) acc[a][b][m][n] = (f32x4){0.f, 0.f, 0.f, 0.f};
    bf16x8 At[4][2], B0[2][2], B1[2][2];
    typename Pol::AddrA aC, aN; typename Pol::AddrB bC, bN;
    P.addrA(cur, R, C, aC); P.addrB(cur, R, C, bC);
    PG8_STAGE_B(PG8_SB(0, 0), bC, 0, 0); PG8_STAGE_A(PG8_SA(0, 0), aC, 0, 0); PG8_STAGE_B(PG8_SB(0, 1), bC, 1, 0); PG8_STAGE_A(PG8_SA(0, 1), aC, 1, 0);
    if (wr == 1) PG8_BAR;
    PG8_WAIT_V(4); PG8_BAR;
    PG8_STAGE_B(PG8_SB(1, 0), bC, 0, 1); PG8_STAGE_A(PG8_SA(1, 0), aC, 0, 1); PG8_STAGE_B(PG8_SB(1, 1), bC, 1, 1);
    PG8_WAIT_V(6); PG8_BAR;
    for (;;) {
        const bool has_next = P.next(ui + 1, nxt);
        if (has_next) { P.addrA(nxt, R, C, aN); P.addrB(nxt, R, C, bN); } else { aN = aC; bN = bC; }
        const bool full = P.full(cur);
        for (int t = 0; t < nt; t += 2) {
            const bool last = (t == nt - 2);
            const typename Pol::AddrA a2 = last ? aN : aC; const typename Pol::AddrB b2 = last ? bN : bC;
            const int k2 = last ? 0 : t + 2, k3 = k2 + 1;
            PG8_LDB(B0, 0, 0); PG8_SCHED; PG8_LDA(At, 0, 0); PG8_STAGE_A(PG8_SA(1, 1), aC, 1, t + 1);
            PG8_WAIT_L(8); PG8_BAR; PG8_WAIT_L(0); PG8_MMA(0, 0, At, B0); PG8_BAR; PG8_SCHED;
            PG8_LDB(B1, 0, 1); PG8_STAGE_B(PG8_SB(0, 0), b2, 0, k2);
            PG8_BAR; PG8_WAIT_L(0); PG8_MMA(0, 1, At, B1); PG8_BAR;
            PG8_LDA(At, 0, 1); PG8_STAGE_A(PG8_SA(0, 0), a2, 0, k2);
            PG8_BAR; PG8_WAIT_L(0); if (full) PG8_MMA(1, 0, At, B0); PG8_BAR; PG8_SCHED;
            PG8_STAGE_B(PG8_SB(0, 1), b2, 1, k2);
            PG8_WAIT_V(6); PG8_BAR; if (full) PG8_MMA(1, 1, At, B1); PG8_BAR;
            PG8_LDB(B0, 1, 0); PG8_SCHED; PG8_LDA(At, 1, 0); PG8_STAGE_A(PG8_SA(0, 1), a2, 1, k2);
            PG8_WAIT_L(8); PG8_BAR; PG8_WAIT_L(0); PG8_MMA(0, 0, At, B0); PG8_BAR; PG8_SCHED;
            PG8_LDB(B1, 1, 1); PG8_STAGE_B(PG8_SB(1, 0), b2, 0, k3);
            PG8_BAR; PG8_WAIT_L(0); PG8_MMA(0, 1, At, B1); PG8_BAR;
            PG8_LDA(At, 1, 1); PG8_STAGE_A(PG8_SA(1, 0), a2, 0, k3);
            PG8_BAR; PG8_WAIT_L(0); if (full) PG8_MMA(1, 0, At, B0); PG8_BAR; PG8_SCHED;
            PG8_STAGE_B(PG8_SB(1, 1), b2, 1, k3);
            PG8_WAIT_V(6); PG8_BAR; if (full) PG8_MMA(1, 1, At, B1); PG8_BAR;
        }
        E(acc, cur, wr, wc, fr, fq);
        if (!has_next) break;
#pragma unroll
        for (int a = 0; a < 2; ++a)
#pragma unroll
            for (int b = 0; b < 2; ++b)
#pragma unroll
                for (int m = 0; m < 4; ++m)
#pragma unroll
                    for (int n = 0; n < 2; ++n) acc[a][b][m][n] = (f32x4){0.f, 0.f, 0.f, 0.f};
        cur = nxt; aC = aN; bC = bN; ++ui;
    }
    PG8_WAIT_V(0);
    if (wr == 0) PG8_BAR;
    PG8_BAR;
#undef PG8_SA
#undef PG8_SB
#undef PG8_STAGE_A
#undef PG8_STAGE_B
#undef PG8_LDA
#undef PG8_LDB
#undef PG8_MMA
#undef PG8_WAIT_V
#undef PG8_WAIT_L
#undef PG8_BAR
#undef PG8_SCHED
}
__host__ __device__ __forceinline__ int logcol(int p) { return (p & ~255) + 64 * ((p >> 5) & 3) + 32 * ((p >> 7) & 1) + (p & 31); }
}

template <class SRC>
DEV void convert_tile(float* tl, const SRC& src, bf16_t* dst, int ldd, int n0, int k0) {
    const int tid = threadIdx.x;
    {
        const int n = tid & 63;
#pragma unroll
        for (int i = 0; i < 8; ++i) { const int kk = (tid >> 6) + 8 * i; tl[kk * 65 + n] = src.get(n0 + n, k0 + kk); }
    }
    __syncthreads();
    {
        const int n = tid >> 3, kc = tid & 7;
        const float* s = tl + (kc * 8) * 65 + n;
        u32x4 o;
        o.x = pk2(s[0 * 65], s[1 * 65]); o.y = pk2(s[2 * 65], s[3 * 65]); o.z = pk2(s[4 * 65], s[5 * 65]); o.w = pk2(s[6 * 65], s[7 * 65]);
        *(u32x4*)(dst + (size_t)(n0 + n) * ldd + k0 + kc * 8) = o;
    }
    __syncthreads();
}
struct SrcWin { const float* w; const float* g;
    DEV float get(int np, int k) const { const int n = pg8::logcol(np); int col; if (n < 1280) col = n; else if (n < 3328) col = n + 24; else if (n < 3352) col = 1280 + (n - 3328); else return 0.f;
        return w[(size_t)k * IN_COLS + col] * g[k]; } };
struct SrcWout { const float* w; const float* g;
    DEV float get(int np, int k) const { const int n = pg8::logcol(np); const float v = w[(size_t)k * DM + n]; return k < 512 ? v * g[k] : v; } };
struct SrcPlain { const float* w; int ld;
    DEV float get(int n, int k) const { return w[(size_t)k * ld + n]; } };
struct SrcW13 { const float* w1; const float* w3; const float* g;
    DEV float get(int n, int k) const { const uintptr_t a = (uintptr_t)w1, b = (uintptr_t)w3; const float* w = (const float*)(a + ((b - a) & (uintptr_t)(0 - (long long)(n & 1))));
        return w[(size_t)k * 512 + (n >> 1)] * g[k]; } };

template <class SRC>
DEV void convert_tile256(float* tl, const SRC& src, bf16_t* dst, int ldd, int n0, int k0) {
    const int tid = threadIdx.x;
    {
        const int q = tid & 63;
        f32x4 v[8];
#pragma unroll
        for (int i = 0; i < 8; ++i) v[i] = src.quad(n0, q, k0 + (tid >> 6) + 8 * i);
#pragma unroll
        for (int i = 0; i < 8; ++i) { float* o = tl + ((tid >> 6) + 8 * i) * 257; o[src.drow(q, 0)] = v[i].x; o[src.drow(q, 1)] = v[i].y; o[src.drow(q, 2)] = v[i].z; o[src.drow(q, 3)] = v[i].w; }
    }
    __syncthreads();
#pragma unroll
    for (int i = 0; i < 4; ++i) {
        const int idx = tid + NT * i, n = idx >> 3, kc = idx & 7;
        const float* s = tl + (kc * 8) * 257 + n;
        u32x4 o;
        o.x = pk2(s[0 * 257], s[1 * 257]); o.y = pk2(s[2 * 257], s[3 * 257]); o.z = pk2(s[4 * 257], s[5 * 257]); o.w = pk2(s[6 * 257], s[7 * 257]);
        *(u32x4*)(dst + (size_t)(n0 + n) * ldd + k0 + kc * 8) = o;
    }
    __syncthreads();
}
struct SrcWin4 { const float* w; const float* g;
    DEV int drow(int q, int e) const { return 4 * q + e; }
    DEV f32x4 quad(int n0, int q, int k) const { const int n = pg8::logcol(n0 + 4 * q); int col; if (n < 1280) col = n; else if (n < 3328) col = n + 24; else if (n < 3352) col = 1280 + (n - 3328); else return (f32x4){0.f, 0.f, 0.f, 0.f};
        return *(const f32x4*)(w + (size_t)k * IN_COLS + col) * g[k]; } };
struct SrcWout4 { const float* w; const float* g;
    DEV int drow(int q, int e) const { return 4 * q + e; }
    DEV f32x4 quad(int n0, int q, int k) const { const f32x4 v = *(const f32x4*)(w + (size_t)k * DM + pg8::logcol(n0 + 4 * q)); return k < 512 ? v * g[k] : v; } };
struct SrcPlain4 { const float* w; int ld;
    DEV int drow(int q, int e) const { return 4 * q + e; }
    DEV f32x4 quad(int n0, int q, int k) const { return *(const f32x4*)(w + (size_t)k * ld + n0 + 4 * q); } };
struct SrcW13_4 { const float* w1; const float* w3; const float* g;
    DEV int drow(int q, int e) const { return 8 * (q & 31) + 2 * e + (q >> 5); }
    DEV f32x4 quad(int n0, int q, int k) const { const uintptr_t a = (uintptr_t)w1, b = (uintptr_t)w3; const float* w = (const float*)(a + ((b - a) & (uintptr_t)(0 - (long long)(q >> 5))));
        return *(const f32x4*)(w + (size_t)k * 512 + (n0 >> 1) + 4 * (q & 31)) * g[k]; } };

DEV void phase_prologue(const Params& p, unsigned char* lds) {
    float* tl = (float*)lds;
    const int tid = threadIdx.x, lane = tid & 63, wid = tid >> 6;
    const int vb = vblock(), G = gridDim.x;
    unsigned char* ws = p.ws;
    constexpr int I_WIN = (INP / 256) * (DM / 64);
    constexpr int I_WOUT = 4 * 16;
    constexpr int I_CW1 = 2 * 32;
    constexpr int I_W2 = 32 * 4 * 8;
    constexpr int I_CW2 = 2 * 1 * 4;
    constexpr int I_ALL = I_WIN + I_WOUT + I_CW1 + I_W2 + I_CW2;
    for (int it = vb; it < I_ALL; it += G) {
        int r = it;
        if (r < I_WIN) { SrcWin4 s{p.w_in, p.attn_g}; convert_tile256(tl, s, (bf16_t*)(ws + WS_WINT), DM, (r / 16) * 256, (r % 16) * 64); continue; } r -= I_WIN;
        if (r < I_WOUT) { SrcWout4 s{p.w_out, p.g_nsa}; convert_tile256(tl, s, (bf16_t*)(ws + WS_WOUTT), DM, (r / 16) * 256, (r % 16) * 64); continue; } r -= I_WOUT;
        if (r < I_CW1) { const int z = r / 32, q = r % 32; SrcPlain4 s{z ? p.wv1 : p.wk1, 256};
            convert_tile256(tl, s, (bf16_t*)(ws + WS_CW1T) + (size_t)z * 256 * 2048, 2048, 0, q * 64); continue; } r -= I_CW1;
        if (r < I_W2) { const int e = r / 32, q = r % 32; SrcPlain4 s{p.w2 + (size_t)e * 512 * 1024, 1024};
            convert_tile256(tl, s, (bf16_t*)(ws + WS_W2T) + (size_t)e * 1024 * 512, 512, (q / 8) * 256, (q % 8) * 64); continue; } r -= I_W2;
        { const int z = r / 4, q = r % 4; SrcPlain s{z ? p.wv2 : p.wk2, 64};
            convert_tile(tl, s, (bf16_t*)(ws + WS_CW2T) + (size_t)z * 64 * 256, 256, 0, q * 64); }
    }
    {
        bf16_t* xb = (bf16_t*)(ws + WS_R1); float* rstd1 = (float*)(ws + WS_RSTD1);
        const int gw = vb * 8 + wid, NGW = G * 8;
        for (int m = gw; m < NTOK; m += NGW) {
            const f32x4* xr = (const f32x4*)(p.x + (size_t)m * DM) + lane;
            f32x4 v[4]; float s = 0.f;
#pragma unroll
            for (int j = 0; j < 4; ++j) { v[j] = xr[64 * j]; s += (v[j].x * v[j].x + v[j].y * v[j].y) + (v[j].z * v[j].z + v[j].w * v[j].w); }
            s = wave_sum(s);
            if (lane == 0) rstd1[m] = rsqrtf(s * (1.f / DM) + RMS_EPS);
            u32x2* o = (u32x2*)(xb + (size_t)m * DM) + lane;
#pragma unroll
            for (int j = 0; j < 4; ++j) { u32x2 w; w.x = pk2(v[j].x, v[j].y); w.y = pk2(v[j].z, v[j].w); o[64 * j] = w; }
        }
    }
    {
        const int gt = vb * NT + tid, NG = G * NT;
        float* rowss = (float*)(ws + WS_ROWSS);
        for (int i = gt; i < NTOK; i += NG) rowss[i] = 0.f;
        int* bincnt = (int*)(ws + WS_CTL);
        if (gt < 128) bincnt[gt] = 0;
        if (gt < 512) { const float l0 = p.lb_logits[gt], l1 = p.lb_logits[512 + gt]; ((float*)(ws + WS_LB))[gt] = 1.f / (1.f + __expf(l1 - l0)); }
        for (int i = gt; i < 48 * 1024; i += NG) { const int c = i >> 10, k = i & 1023;
            const float w = (c < 4 ? p.w_group[k * 4 + c] : (c < 36 ? p.w_expert[k * 32 + (c - 4)] : 0.f)) * p.ffn_g[k];
            const bf16_t hi = f2bf(w); const bf16_t lo = f2bf(w - bf2f(hi));
            ((bf16_t*)(ws + WS_RW))[i] = hi; ((bf16_t*)(ws + WS_RW))[48 * 1024 + i] = lo; }
        if (blockIdx.x == (unsigned)(G - 1)) {
            const int z = tid >> 8, j = tid & 255; const float* pos = z ? p.pos_v : p.pos_k; const float* w = z ? p.wv1 : p.wk1;
            float a = 0.f;
            for (int k = 0; k < 2048; ++k) a += pos[k] * w[(size_t)k * 256 + j];
            ((float*)(ws + WS_CBIAS))[z * 256 + j] = a;
        }
    }
}

constexpr int G_A_BYTES = 128 * 128, G_B_BYTES = 256 * 128, G_STAGE = G_A_BYTES + G_B_BYTES, G_LDS = 2 * G_STAGE;
DEV int swz(int row, int chunk) { return row * 128 + ((chunk ^ ((row >> 1) & 7)) << 4); }
template <class AL, class BL, class EP>
DEV void gemm_tile(unsigned char* lds, const AL& al, const BL& bl, int nk, const EP& ep) {
    const int tid = threadIdx.x, lane = tid & 63, wid = tid >> 6, wr = wid >> 2, wc = wid & 3;
    const int frow = lane & 15, fq = lane >> 4;
    const bf16_t* aptr[2]; int aoff[2], boff[4], brow[4];
#pragma unroll
    for (int i = 0; i < 2; ++i) { const int q = tid + NT * i, row = q >> 3, ch = q & 7; aptr[i] = al.row(row) + ch * 8; aoff[i] = swz(row, ch); }
#pragma unroll
    for (int i = 0; i < 4; ++i) { const int q = tid + NT * i, row = q >> 3, ch = q & 7; brow[i] = row; boff[i] = G_A_BYTES + swz(row, ch) ; }
    const int bch8 = (tid & 7) * 8;
    u32x4 ra[2], rb[4];
#pragma unroll
    for (int i = 0; i < 2; ++i) ra[i] = *(const u32x4*)(aptr[i]);
#pragma unroll
    for (int i = 0; i < 4; ++i) rb[i] = *(const u32x4*)(bl.ptr(brow[i], 0) + bch8);
#pragma unroll
    for (int i = 0; i < 2; ++i) *(u32x4*)(lds + aoff[i]) = ra[i];
#pragma unroll
    for (int i = 0; i < 4; ++i) *(u32x4*)(lds + boff[i]) = rb[i];
    __syncthreads();
    f32x4 acc[4][4];
#pragma unroll
    for (int m = 0; m < 4; ++m)
#pragma unroll
        for (int n = 0; n < 4; ++n) acc[m][n] = (f32x4){0.f, 0.f, 0.f, 0.f};
    const int sx = (frow >> 1) & 7;
    for (int kt = 0; kt < nk; ++kt) {
        const bool more = (kt + 1 < nk);
        if (more) {
#pragma unroll
            for (int i = 0; i < 2; ++i) ra[i] = *(const u32x4*)(aptr[i] + (kt + 1) * 64);
#pragma unroll
            for (int i = 0; i < 4; ++i) rb[i] = *(const u32x4*)(bl.ptr(brow[i], kt + 1) + bch8);
        }
        const unsigned char* base = lds + (kt & 1) * G_STAGE;
#pragma unroll
        for (int ks = 0; ks < 2; ++ks) {
            const int co = ((ks * 4 + fq) ^ sx) << 4;
            bf16x8 af[4], bfr[4];
#pragma unroll
            for (int m = 0; m < 4; ++m) af[m] = *(const bf16x8*)(base + (wr * 64 + m * 16 + frow) * 128 + co);
#pragma unroll
            for (int n = 0; n < 4; ++n) bfr[n] = *(const bf16x8*)(base + G_A_BYTES + (wc * 64 + n * 16 + frow) * 128 + co);
#pragma unroll
            for (int m = 0; m < 4; ++m)
#pragma unroll
                for (int n = 0; n < 4; ++n) acc[m][n] = __builtin_amdgcn_mfma_f32_16x16x32_bf16(bfr[n], af[m], acc[m][n], 0, 0, 0);
        }
        if (more) {
            unsigned char* nb = lds + ((kt + 1) & 1) * G_STAGE;
#pragma unroll
            for (int i = 0; i < 2; ++i) *(u32x4*)(nb + aoff[i]) = ra[i];
#pragma unroll
            for (int i = 0; i < 4; ++i) *(u32x4*)(nb + boff[i]) = rb[i];
        }
        __syncthreads();
    }
    ep(acc, wr, wc, lane);
}

struct ARows { const bf16_t* base; size_t ld; DEV const bf16_t* row(int r) const { return base + (size_t)r * ld; } };
struct BRows { const bf16_t* base; size_t ld; DEV const bf16_t* ptr(int n, int kt) const { return base + (size_t)n * ld + kt * 64; } };

DEV void inproj_row(const Params& p, int seg, int row, f32x4 (&v)[4], int fq) {
    unsigned char* ws = p.ws;
    const float rs = ((const float*)(ws + WS_RSTD1))[row];
#pragma unroll
    for (int n = 0; n < 4; ++n) v[n] = v[n] * rs;
    const int b = row >> 12, s = row & 4095;
    const bool is_q = seg < 8, is_ks = (seg == 12 || seg == 13), is_kw = (seg == 16 || seg == 17);
    if (is_q || is_ks || is_kw) {
        const float* gw = is_q ? p.g_q : (is_ks ? p.g_k + 64 : p.g_k + 128);
        bf16_t* dst; int hh, nh;
        if (is_q) { dst = (bf16_t*)(ws + WS_Q); hh = seg; nh = 8; } else if (is_ks) { dst = (bf16_t*)(ws + WS_KS); hh = seg - 12; nh = 2; } else { dst = (bf16_t*)(ws + WS_KW); hh = seg - 16; nh = 2; }
        float ss = 0.f;
#pragma unroll
        for (int n = 0; n < 4; ++n) ss += (v[n].x * v[n].x + v[n].y * v[n].y) + (v[n].z * v[n].z + v[n].w * v[n].w);
        ss += __shfl_xor(ss, 16); ss += __shfl_xor(ss, 32);
        float r = rsqrtf(ss * (1.f / 64.f) + RMS_EPS); if (is_q) r *= QSCALE;
        bf16_t* o = dst + ((size_t)(b * nh + hh) * SEQ + s) * 64 + fq * 4;
#pragma unroll
        for (int n = 0; n < 4; ++n) { const f32x4 g = *(const f32x4*)(gw + n * 16 + fq * 4); const f32x4 x = v[n] * g * r; u32x2 w; w.x = pk2(x.x, x.y); w.y = pk2(x.z, x.w); *(u32x2*)(o + n * 16) = w; }
        return;
    }
    if (seg >= 8 && seg < 12) {
        bf16_t* o = (bf16_t*)(ws + (seg < 10 ? WS_KC : WS_VC)) + ((size_t)(b * 2 + (seg & 1)) * SEQ + s) * 64 + fq * 4;
#pragma unroll
        for (int n = 0; n < 4; ++n) { u32x2 w; w.x = pk2(v[n].x, v[n].y); w.y = pk2(v[n].z, v[n].w); *(u32x2*)(o + n * 16) = w; }
        return;
    }
    if (seg == 14 || seg == 15 || seg == 18 || seg == 19) {
        bf16_t* o = (bf16_t*)(ws + (seg < 16 ? WS_VST : WS_VWT)) + (size_t)(b * 2 + (seg & 1)) * 64 * SEQ + s;
#pragma unroll
        for (int n = 0; n < 4; ++n) { const int d = n * 16 + fq * 4;
            o[(size_t)(d + 0) * SEQ] = f2bf(v[n].x); o[(size_t)(d + 1) * SEQ] = f2bf(v[n].y); o[(size_t)(d + 2) * SEQ] = f2bf(v[n].z); o[(size_t)(d + 3) * SEQ] = f2bf(v[n].w); }
        return;
    }
    if (seg < 52) {
        const int kind = (seg - 20) >> 3, cb = ((seg - 20) & 7) * 64 + fq * 4;
        if (kind == 1) {
            const float* lb = (const float*)(ws + WS_LB); float* dst = (float*)(ws + WS_HLOGF) + (size_t)row * 512;
#pragma unroll
            for (int n = 0; n < 4; ++n) { const int c = cb + n * 16; const f32x4 l = *(const f32x4*)(lb + c); f32x4 o;
                o.x = __logf(l.x + (1.f - l.x) * sigmoidf_(v[n].x)); o.y = __logf(l.y + (1.f - l.y) * sigmoidf_(v[n].y));
                o.z = __logf(l.z + (1.f - l.z) * sigmoidf_(v[n].z)); o.w = __logf(l.w + (1.f - l.w) * sigmoidf_(v[n].w));
                *(f32x4*)(dst + c) = o; }
        } else {
            bf16_t* dst = (bf16_t*)(ws + (kind == 0 ? WS_HQ : (kind == 2 ? WS_HV : WS_HG))) + (size_t)row * 512 + cb;
#pragma unroll
            for (int n = 0; n < 4; ++n) { f32x4 x = v[n];
                if (kind != 2) { x.x = siluf_(x.x); x.y = siluf_(x.y); x.z = siluf_(x.z); x.w = siluf_(x.w); }
                u32x2 w; w.x = pk2(x.x, x.y); w.y = pk2(x.z, x.w); *(u32x2*)(dst + n * 16) = w; }
        }
        return;
    }
    {
        float* dst = (float*)(ws + WS_GATES) + (size_t)row * 24;
#pragma unroll
        for (int n = 0; n < 2; ++n) { const int c = n * 16 + fq * 4; if (c < 24) { f32x4 o; o.x = sigmoidf_(v[n].x); o.y = sigmoidf_(v[n].y); o.z = sigmoidf_(v[n].z); o.w = sigmoidf_(v[n].w); *(f32x4*)(dst + c) = o; } }
    }
}
struct EpiInproj8 { const Params& p;
    DEV void operator()(const f32x4 (&acc)[2][2][4][2], const pg8::Unit& u, int wr, int wc, int fr, int fq) const {
        const int seg = u.pn * 4 + wc;
        if (seg > 52) return;
#pragma unroll
        for (int ai = 0; ai < 2; ++ai)
#pragma unroll
            for (int m = 0; m < 4; ++m) { f32x4 v[4] = {acc[ai][0][m][0], acc[ai][0][m][1], acc[ai][1][m][0], acc[ai][1][m][1]};
                inproj_row(p, seg, u.pm * 256 + ai * 128 + wr * 64 + m * 16 + fr, v, fq); }
    } };
DEV void phase_inproj(const Params& p, unsigned char* lds) {
    pg8::Gemm g{(const bf16_t*)(p.ws + WS_R1), (const bf16_t*)(p.ws + WS_WINT), NTOK, INP, DM};
    pg8::StaticOrder S; S.init(NTOK, INP, (int)gridDim.x, (int)blockIdx.x);
    EpiInproj8 E{p};
    pg8::gemm_phase(( PG8_LAS unsigned char*)lds, g, S, E);
}

struct ACmp { const bf16_t* src; int bg, c0;
    DEV const bf16_t* row(int r) const { int c = c0 + r; if (c > NC - 1) c = NC - 1; return src + ((size_t)bg * SEQ + 16 * c) * 64; } };
struct EpiCmpA { const Params& p; int z, rbase;
    DEV void operator()(f32x4 (&acc)[4][4], int wr, int wc, int lane) const {
        const int frow = lane & 15, fq = lane >> 4;
        const float* cb = (const float*)(p.ws + WS_CBIAS) + z * 256; bf16_t* hid = (bf16_t*)(p.ws + WS_HID) + (size_t)z * 4096 * 256;
#pragma unroll
        for (int m = 0; m < 4; ++m) { const int rr = rbase + wr * 64 + m * 16 + frow;
#pragma unroll
            for (int n = 0; n < 4; ++n) { const int c = wc * 64 + n * 16 + fq * 4; const f32x4 b = *(const f32x4*)(cb + c); f32x4 v = acc[m][n] + b;
                u32x2 w; w.x = pk2(siluf_(v.x), siluf_(v.y)); w.y = pk2(siluf_(v.z), siluf_(v.w)); *(u32x2*)(hid + (size_t)rr * 256 + c) = w; } }
    } };
DEV void phase_cmp_a(const Params& p, unsigned char* lds) {
    const int vb = vblock(), G = gridDim.x;
    for (int u = vb; u < 64; u += G) {
        const int z = u >> 5, rbase = (u & 31) * 128;
        ACmp al{(const bf16_t*)(p.ws + (z ? WS_VC : WS_KC)), (u & 31) >> 1, (u & 1) * 128};
        BRows bl{(const bf16_t*)(p.ws + WS_CW1T) + (size_t)z * 256 * 2048, 2048};
        EpiCmpA ep{p, z, rbase};
        gemm_tile(lds, al, bl, 2048 / 64, ep);
    }
}
struct BClamp64 { const bf16_t* base; size_t ld; DEV const bf16_t* ptr(int n, int kt) const { return base + (size_t)(n & 63) * ld + kt * 64; } };
struct EpiCmpB { const Params& p; int z, rbase;
    DEV void operator()(f32x4 (&acc)[4][4], int wr, int wc, int lane) const {
        if (wc != 0) return;
        const int frow = lane & 15, fq = lane >> 4;
        bf16_t* dst = (bf16_t*)(p.ws + (z ? WS_VCMP : WS_KCMP));
#pragma unroll
        for (int m = 0; m < 4; ++m) { const int rr = rbase + wr * 64 + m * 16 + frow;
            float r = 1.f;
            if (z == 0) { float ss = 0.f;
#pragma unroll
                for (int n = 0; n < 4; ++n) { const f32x4 v = acc[m][n]; ss += (v.x * v.x + v.y * v.y) + (v.z * v.z + v.w * v.w); }
                ss += __shfl_xor(ss, 16); ss += __shfl_xor(ss, 32); r = rsqrtf(ss * (1.f / 64.f) + RMS_EPS); }
            const int bg = rr >> 8, c = rr & 255;
            if (c < NC) {
#pragma unroll
                for (int n = 0; n < 4; ++n) { const int d = n * 16 + fq * 4; f32x4 v = acc[m][n] * r;
                    if (z == 0) { const f32x4 g = *(const f32x4*)(p.g_k + d); v = v * g;
                        u32x2 w; w.x = pk2(v.x, v.y); w.y = pk2(v.z, v.w); *(u32x2*)(dst + ((size_t)bg * 256 + c) * 64 + d) = w; }
                    else { bf16_t* o = dst + ((size_t)bg * 64 + d) * 256 + c; o[0] = f2bf(v.x); o[256] = f2bf(v.y); o[512] = f2bf(v.z); o[768] = f2bf(v.w); } } }
        }
    } };
DEV void phase_cmp_b(const Params& p, unsigned char* lds) {
    const int vb = vblock(), G = gridDim.x;
    for (int u = vb; u < 64; u += G) {
        const int z = u >> 5, rbase = (u & 31) * 128;
        ARows al{(const bf16_t*)(p.ws + WS_HID) + ((size_t)z * 4096 + rbase) * 256, 256};
        BClamp64 bl{(const bf16_t*)(p.ws + WS_CW2T) + (size_t)z * 64 * 256, 256};
        EpiCmpB ep{p, z, rbase};
        gemm_tile(lds, al, bl, 256 / 64, ep);
    }
}

constexpr int CM_K = 0, CM_V = 32768, CM_VSTR = 520, CM_IMP = CM_V + 64 * CM_VSTR, CM_LDS = CM_IMP + 4 * 16384;
DEV void cm_scores(const unsigned char* kbase, int kt, const bf16x8 (&qf)[4], int r31, int hh, f32x16 (&sacc)[2]) {
#pragma unroll
    for (int kt2 = 0; kt2 < 2; ++kt2) {
#pragma unroll
        for (int i = 0; i < 16; ++i) sacc[kt2][i] = 0.f;
        const int row = 64 * kt + 32 * kt2 + r31; const int sx = (row >> 1) & 7;
#pragma unroll
        for (int s = 0; s < 4; ++s) { const bf16x8 kf = *(const bf16x8*)(kbase + row * 128 + (((2 * s + hh) ^ sx) << 4));
            sacc[kt2] = __builtin_amdgcn_mfma_f32_32x32x16_bf16(kf, qf[s], sacc[kt2], 0, 0, 0); }
    }
}
DEV void phase_cmp_attn(const Params& p, unsigned char* lds) {
    const int tid = threadIdx.x, lane = tid & 63, wid = tid >> 6;
    const int vb = vblock(), G = gridDim.x;
    unsigned char* ws = p.ws;
    const int r31 = lane & 31, hh = lane >> 5;
    float* impl = (float*)(lds + CM_IMP);
    for (int it = vb; it < 1024; it += G) {
        const int rnd = it / G, pos = it % G; int sidx = (rnd & 1) ? (rnd * G + (G - 1 - pos)) : (rnd * G + pos); if (G != 256) sidx = it;
        const int ci = 63 - (sidx >> 4), bg = sidx & 15, b = bg >> 1, g = bg & 1;
        const int nvis = min(NC, 4 * ci + 3), ntile = (nvis + 63) >> 6;
        const int head = g * 4 + (wid >> 1);
        const int tokl = (wid & 1) * 32 + r31, t = ci * 64 + tokl;
        const size_t tok = (size_t)b * SEQ + t;
        const int nv = t >= 31 ? min(NC, (t - 31) / 16 + 1) : 0;
        __syncthreads();
        {
            const bf16_t* kc = (const bf16_t*)(ws + WS_KCMP) + (size_t)bg * 256 * 64; const bf16_t* vt = (const bf16_t*)(ws + WS_VCMP) + (size_t)bg * 64 * 256;
            const int cpr = ntile * 8;
            u32x4 rk[4], rv[4];
#pragma unroll
            for (int i = 0; i < 4; ++i) if (i < ntile) { const int idx = tid + NT * i; rk[i] = *(const u32x4*)(kc + (idx >> 3) * 64 + (idx & 7) * 8); const int d = idx / cpr, ck = idx % cpr; rv[i] = *(const u32x4*)(vt + d * 256 + ck * 8); }
#pragma unroll
            for (int i = 0; i < 4; ++i) if (i < ntile) { const int idx = tid + NT * i; *(u32x4*)(lds + CM_K + swz(idx >> 3, idx & 7)) = rk[i];
                const int d = idx / cpr, ck = idx % cpr; u32x2 a, c2; a.x = rv[i].x; a.y = rv[i].y; c2.x = rv[i].z; c2.y = rv[i].w; unsigned char* o = lds + CM_V + d * CM_VSTR + ck * 16; *(u32x2*)o = a; *(u32x2*)(o + 8) = c2; }
        }
        bf16x8 qf[4];
        { const bf16_t* qp = (const bf16_t*)(ws + WS_Q) + ((size_t)(b * 8 + head) * SEQ + t) * 64 + 8 * hh;
#pragma unroll
            for (int s = 0; s < 4; ++s) qf[s] = *(const bf16x8*)(qp + 16 * s); }
        __syncthreads();
        float m_run = -1e30f, l_run = 0.f;
        for (int kt = 0; kt < ntile; ++kt) {
            f32x16 sacc[2];
            cm_scores(lds + CM_K, kt, qf, r31, hh, sacc);
            float mx = -1e30f;
#pragma unroll
            for (int kt2 = 0; kt2 < 2; ++kt2)
#pragma unroll
                for (int i = 0; i < 16; ++i) { const int c = 64 * kt + 32 * kt2 + (i & 3) + 8 * (i >> 2) + 4 * hh; const float v = (c < nv) ? sacc[kt2][i] : -1e30f; sacc[kt2][i] = v; mx = fmaxf(mx, v); }
            const float m_new = fmaxf(m_run, mx); float rs = 0.f;
#pragma unroll
            for (int kt2 = 0; kt2 < 2; ++kt2)
#pragma unroll
                for (int i = 0; i < 16; ++i) { const float v = sacc[kt2][i]; rs += (v > -5e29f) ? __builtin_amdgcn_exp2f(v - m_new) : 0.f; }
            l_run = l_run * __builtin_amdgcn_exp2f(m_run - m_new) + rs; m_run = m_new;
        }
        float M, invL;
        { const float mo = __shfl_xor(m_run, 32), lo = __shfl_xor(l_run, 32); M = fmaxf(m_run, mo); const float L = l_run * __builtin_amdgcn_exp2f(m_run - M) + lo * __builtin_amdgcn_exp2f(mo - M); invL = L > 0.f ? 1.f / L : 0.f; }
        f32x16 ot[2];
#pragma unroll
        for (int dt = 0; dt < 2; ++dt)
#pragma unroll
            for (int i = 0; i < 16; ++i) ot[dt][i] = 0.f;
        float carry = 0.f;
#pragma unroll
        for (int kt = 0; kt < 4; ++kt) if (kt < ntile) {
            f32x16 sacc[2];
            cm_scores(lds + CM_K, kt, qf, r31, hh, sacc);
#pragma unroll
            for (int kt2 = 0; kt2 < 2; ++kt2)
#pragma unroll
                for (int i = 0; i < 16; ++i) { const int c = 64 * kt + 32 * kt2 + (i & 3) + 8 * (i >> 2) + 4 * hh; sacc[kt2][i] = (c < nv) ? __builtin_amdgcn_exp2f(sacc[kt2][i] - M) : 0.f; }
            {
                float own[8], xs[8];
#pragma unroll
                for (int kt2 = 0; kt2 < 2; ++kt2)
#pragma unroll
                    for (int g4 = 0; g4 < 4; ++g4) { const float e3 = 0.5f * sacc[kt2][4 * g4 + 3];
                        own[4 * kt2 + g4] = (sacc[kt2][4 * g4] + sacc[kt2][4 * g4 + 1]) + (sacc[kt2][4 * g4 + 2] + e3); xs[4 * kt2 + g4] = __shfl_xor(e3, 32); }
                float* io = impl + (wid >> 1) * 4096 + tokl * 64 + 16 * kt + hh;
#pragma unroll
                for (int gi = 0; gi < 8; ++gi) io[2 * gi] = (own[gi] + (hh ? xs[gi] : (gi > 0 ? xs[gi > 0 ? gi - 1 : 0] : carry))) * invL;
                carry = xs[7];
            }
#pragma unroll
            for (int kt2 = 0; kt2 < 2; ++kt2)
#pragma unroll
                for (int s2 = 0; s2 < 2; ++s2) {
                    bf16x8 pf; { u32x4 w; w.x = pk2(sacc[kt2][8 * s2 + 0], sacc[kt2][8 * s2 + 1]); w.y = pk2(sacc[kt2][8 * s2 + 2], sacc[kt2][8 * s2 + 3]);
                        w.z = pk2(sacc[kt2][8 * s2 + 4], sacc[kt2][8 * s2 + 5]); w.w = pk2(sacc[kt2][8 * s2 + 6], sacc[kt2][8 * s2 + 7]); pf = __builtin_bit_cast(bf16x8, w); }
#pragma unroll
                    for (int dt = 0; dt < 2; ++dt) {
                        const unsigned char* va = lds + CM_V + (32 * dt + r31) * CM_VSTR + (64 * kt + 32 * kt2 + 16 * s2 + 4 * hh) * 2;
                        const u32x2 lo = *(const u32x2*)(va), hi = *(const u32x2*)(va + 16);
                        u32x4 w; w.x = lo.x; w.y = lo.y; w.z = hi.x; w.w = hi.y;
                        ot[dt] = __builtin_amdgcn_mfma_f32_32x32x16_bf16(__builtin_bit_cast(bf16x8, w), pf, ot[dt], 0, 0, 0);
                    }
                }
        }
        {
            const float sc = ((const float*)(ws + WS_GATES))[tok * 24 + head * 3 + 0] * invL;
            bf16_t* ocp = (bf16_t*)(ws + WS_OC) + tok * 512 + head * 64;
#pragma unroll
            for (int dt = 0; dt < 2; ++dt)
#pragma unroll
                for (int g4 = 0; g4 < 4; ++g4) { const int d0 = 32 * dt + 8 * g4 + 4 * hh;
                    u32x2 w; w.x = pk2(ot[dt][4 * g4 + 0] * sc, ot[dt][4 * g4 + 1] * sc); w.y = pk2(ot[dt][4 * g4 + 2] * sc, ot[dt][4 * g4 + 3] * sc); *(u32x2*)(ocp + d0) = w; }
        }
        __syncthreads();
        for (int tt = 0; tt < 8; ++tt) {
            const int tl = wid * 8 + tt, cur = ci;
            unsigned long long mask;
            if (cur < 16) mask = (2ull << cur) - 1ull;
            else {
                const bool valid = lane <= cur;
                const float imp = (impl[tl * 64 + lane] + impl[4096 + tl * 64 + lane]) + (impl[8192 + tl * 64 + lane] + impl[12288 + tl * 64 + lane]);
                const unsigned key = (lane == 0 || lane == cur) ? 0x7F800000u : __float_as_uint(imp);
                unsigned T = 0u;
                for (int bit = 30; bit >= 0; --bit) { const unsigned cand = T | (1u << bit); if (__popcll(__ballot(valid && key >= cand)) >= 16) T = cand; }
                const unsigned long long gt = __ballot(valid && key > T), eq = __ballot(valid && key == T);
                const int need = 16 - __popcll(gt);
                const int below = __popcll(eq & ((1ull << lane) - 1ull));
                mask = gt | __ballot(valid && key == T && below < need);
            }
            if (lane == 0) ((unsigned long long*)(ws + WS_SELM))[(size_t)bg * SEQ + ci * 64 + tl] = mask;
        }
    }
}

constexpr int FA_KB = 64 * 128, FA_VB = 64 * 136, FA_STAGE = FA_KB + FA_VB, FA_LDS = 2 * FA_STAGE + 1024;
template <bool SEL>
DEV void fa_branch(unsigned char* lds, const bf16_t* Kb, const bf16_t* VTb, int ci, int bg, const bf16x8 (&qf)[4], int t, unsigned long long mymask, unsigned long long need,
                   f32x16 (&ot)[2], float& m_run, float& l_run) {
    const int tid = threadIdx.x, lane = tid & 63;
    const int r31 = lane & 31, hh = lane >> 5;
    const int lrow = tid >> 3, lch = tid & 7;
    const bf16_t* kg = Kb + ((size_t)bg * SEQ + lrow) * 64 + lch * 8;
    const bf16_t* vg = VTb + ((size_t)bg * 64 + lrow) * SEQ + lch * 8;
    const int koff = lrow * 128 + ((lch ^ ((lrow >> 1) & 7)) << 4), voff = FA_KB + lrow * 136 + lch * 16;
    int jlo, jhi; unsigned long long todo;
    if (SEL) { todo = need; jlo = 0; jhi = ci; } else { jlo = ci >= 8 ? ci - 8 : 0; jhi = ci; todo = 0; }
    int j = jlo;
    if (SEL) { if (todo == 0) return; j = __builtin_ctzll(todo); todo &= todo - 1; }
    u32x4 rk = *(const u32x4*)(kg + (size_t)j * 64 * 64), rv = *(const u32x4*)(vg + (size_t)j * 64);
    __syncthreads();
    *(u32x4*)(lds + koff) = rk; { u32x2 a, b2; a.x = rv.x; a.y = rv.y; b2.x = rv.z; b2.y = rv.w; *(u32x2*)(lds + voff) = a; *(u32x2*)(lds + voff + 8) = b2; }
    __syncthreads();
    int st = 0; bool seen = false;
    for (;;) {
        int jn; bool more;
        if (SEL) { more = (todo != 0); jn = more ? __builtin_ctzll(todo) : 0; todo &= todo - 1; } else { jn = j + 1; more = (jn <= jhi); }
        if (more) { rk = *(const u32x4*)(kg + (size_t)jn * 64 * 64); rv = *(const u32x4*)(vg + (size_t)jn * 64); }
        const unsigned char* base = lds + st * FA_STAGE;
        const bool bit = SEL ? ((mymask >> j) & 1ull) != 0 : true;
        const float cinit = (SEL && !bit) ? -__builtin_inff() : -m_run;
        f32x16 sacc[2];
#pragma unroll
        for (int kt2 = 0; kt2 < 2; ++kt2) {
#pragma unroll
            for (int i = 0; i < 16; ++i) sacc[kt2][i] = cinit;
            const int row = 32 * kt2 + r31; const int sx = (row >> 1) & 7;
#pragma unroll
            for (int s = 0; s < 4; ++s) { const bf16x8 kf = *(const bf16x8*)(base + row * 128 + (((2 * s + hh) ^ sx) << 4));
                sacc[kt2] = __builtin_amdgcn_mfma_f32_32x32x16_bf16(kf, qf[s], sacc[kt2], 0, 0, 0); }
        }
        const bool boundary = SEL ? (j == ci) : (j == ci || j + 8 <= ci);
        float mx = -__builtin_inff();
        if (boundary) {
#pragma unroll
            for (int kt2 = 0; kt2 < 2; ++kt2)
#pragma unroll
                for (int i = 0; i < 16; ++i) { const int key = 64 * j + 32 * kt2 + (i & 3) + 8 * (i >> 2) + 4 * hh;
                    const bool ok = SEL ? (key <= t) : (key <= t && t - key < 512);
                    const float v = ok ? sacc[kt2][i] : -__builtin_inff(); sacc[kt2][i] = v; mx = fmaxf(mx, v); }
        } else {
#pragma unroll
            for (int kt2 = 0; kt2 < 2; ++kt2)
#pragma unroll
                for (int i = 0; i < 16; ++i) mx = fmaxf(mx, sacc[kt2][i]);
        }
        mx = fmaxf(mx, __shfl_xor(mx, 32));
        const bool live = mx > -__builtin_inff();
        const bool need = (mx > 8.f) || (!seen && live && mx < -8.f);
        if (__any(need)) {
            const float d = need ? mx : 0.f;
            const float alpha = d > 0.f ? __builtin_amdgcn_exp2f(-d) : 1.f;
            m_run += d; l_run *= alpha;
#pragma unroll
            for (int dt = 0; dt < 2; ++dt)
#pragma unroll
                for (int i = 0; i < 16; ++i) ot[dt][i] *= alpha;
#pragma unroll
            for (int kt2 = 0; kt2 < 2; ++kt2)
#pragma unroll
                for (int i = 0; i < 16; ++i) sacc[kt2][i] -= d;
        }
        seen = seen || live;
        float rs = 0.f;
#pragma unroll
        for (int kt2 = 0; kt2 < 2; ++kt2)
#pragma unroll
            for (int i = 0; i < 16; ++i) { const float e = __builtin_amdgcn_exp2f(sacc[kt2][i]); sacc[kt2][i] = e; rs += e; }
        l_run += rs;
#pragma unroll
        for (int kt2 = 0; kt2 < 2; ++kt2)
#pragma unroll
            for (int s2 = 0; s2 < 2; ++s2) {
                bf16x8 pf; { u32x4 w; w.x = pk2(sacc[kt2][8 * s2 + 0], sacc[kt2][8 * s2 + 1]); w.y = pk2(sacc[kt2][8 * s2 + 2], sacc[kt2][8 * s2 + 3]);
                    w.z = pk2(sacc[kt2][8 * s2 + 4], sacc[kt2][8 * s2 + 5]); w.w = pk2(sacc[kt2][8 * s2 + 6], sacc[kt2][8 * s2 + 7]); pf = __builtin_bit_cast(bf16x8, w); }
#pragma unroll
                for (int dt = 0; dt < 2; ++dt) {
                    const unsigned char* va = base + FA_KB + (32 * dt + r31) * 136 + (32 * kt2 + 16 * s2 + 4 * hh) * 2;
                    const u32x2 lo = *(const u32x2*)(va), hi = *(const u32x2*)(va + 16);
                    u32x4 w; w.x = lo.x; w.y = lo.y; w.z = hi.x; w.w = hi.y;
                    ot[dt] = __builtin_amdgcn_mfma_f32_32x32x16_bf16(__builtin_bit_cast(bf16x8, w), pf, ot[dt], 0, 0, 0);
                }
            }
        if (!more) break;
        { unsigned char* nb = lds + (st ^ 1) * FA_STAGE; *(u32x4*)(nb + koff) = rk; u32x2 a, b2; a.x = rv.x; a.y = rv.y; b2.x = rv.z; b2.y = rv.w; *(u32x2*)(nb + voff) = a; *(u32x2*)(nb + voff + 8) = b2; }
        __syncthreads();
        st ^= 1; j = jn;
    }
}
DEV void phase_flash(const Params& p, unsigned char* lds) {
    const int tid = threadIdx.x, lane = tid & 63, wid = tid >> 6;
    const int vb = vblock(), G = gridDim.x;
    unsigned char* ws = p.ws;
    const int r31 = lane & 31, hh = lane >> 5;
    unsigned long long* red = (unsigned long long*)(lds + 2 * FA_STAGE);
    for (int it = vb; it < 1024; it += G) {
        const int rnd = it / G, pos = it % G; int sidx = (rnd & 1) ? (rnd * G + (G - 1 - pos)) : (rnd * G + pos); if (G != 256) sidx = it;
        const int ci = 63 - (sidx >> 4), bg = sidx & 15, b = bg >> 1, g = bg & 1;
        const int head = g * 4 + (wid >> 1);
        const int t = ci * 64 + (wid & 1) * 32 + r31;
        const size_t tok = (size_t)b * SEQ + t;
        bf16x8 qf[4];
        { const bf16_t* qp = (const bf16_t*)(ws + WS_Q) + ((size_t)(b * 8 + head) * SEQ + t) * 64 + 8 * hh;
#pragma unroll
            for (int s = 0; s < 4; ++s) qf[s] = *(const bf16x8*)(qp + 16 * s); }
        const unsigned long long mymask = ((const unsigned long long*)(ws + WS_SELM))[(size_t)bg * SEQ + t];
        unsigned long long orm = mymask;
#pragma unroll
        for (int o = 1; o < 32; o <<= 1) { const unsigned lo = __shfl_xor((unsigned)orm, o), hi = __shfl_xor((unsigned)(orm >> 32), o); orm |= ((unsigned long long)hi << 32) | lo; }
        __syncthreads();
        if (wid < 2 && lane == 0) red[wid] = orm;
        __syncthreads();
        const unsigned long long need = red[0] | red[1];
        f32x16 oc[2];
        {
            f32x16 ot[2]; float m_run = 0.f, l_run = 0.f;
#pragma unroll
            for (int dt = 0; dt < 2; ++dt)
#pragma unroll
                for (int i = 0; i < 16; ++i) ot[dt][i] = 0.f;
            fa_branch<true>(lds, (const bf16_t*)(ws + WS_KS), (const bf16_t*)(ws + WS_VST), ci, bg, qf, t, mymask, need, ot, m_run, l_run);
            const float lt = l_run + __shfl_xor(l_run, 32);
            const float sc = ((const float*)(ws + WS_GATES))[tok * 24 + head * 3 + 1] / lt;
#pragma unroll
            for (int dt = 0; dt < 2; ++dt)
#pragma unroll
                for (int i = 0; i < 16; ++i) oc[dt][i] = ot[dt][i] * sc;
        }
        {
            f32x16 ot[2]; float m_run = 0.f, l_run = 0.f;
#pragma unroll
            for (int dt = 0; dt < 2; ++dt)
#pragma unroll
                for (int i = 0; i < 16; ++i) ot[dt][i] = 0.f;
            fa_branch<false>(lds, (const bf16_t*)(ws + WS_KW), (const bf16_t*)(ws + WS_VWT), ci, bg, qf, t, 0ull, 0ull, ot, m_run, l_run);
            const float lt = l_run + __shfl_xor(l_run, 32);
            const float sc = ((const float*)(ws + WS_GATES))[tok * 24 + head * 3 + 2] / lt;
#pragma unroll
            for (int dt = 0; dt < 2; ++dt)
#pragma unroll
                for (int i = 0; i < 16; ++i) oc[dt][i] += ot[dt][i] * sc;
        }
        {
            const bf16_t* ocp = (const bf16_t*)(ws + WS_OC) + tok * 512 + head * 64;
            bf16_t* mix = (bf16_t*)(ws + WS_R1) + tok * 1024 + head * 64;
            float ss = 0.f;
#pragma unroll
            for (int dt = 0; dt < 2; ++dt)
#pragma unroll
                for (int g4 = 0; g4 < 4; ++g4) { const int d0 = 32 * dt + 8 * g4 + 4 * hh; const u32x2 c = *(const u32x2*)(ocp + d0);
                    const float v0 = oc[dt][4 * g4 + 0] + bflo(c.x), v1 = oc[dt][4 * g4 + 1] + bfhi(c.x), v2 = oc[dt][4 * g4 + 2] + bflo(c.y), v3 = oc[dt][4 * g4 + 3] + bfhi(c.y);
                    ss += (v0 * v0 + v1 * v1) + (v2 * v2 + v3 * v3);
                    u32x2 w; w.x = pk2(v0, v1); w.y = pk2(v2, v3); *(u32x2*)(mix + d0) = w; }
            ss += __shfl_xor(ss, 32);
            if (hh == 0) atomicAdd((float*)(ws + WS_ROWSS) + tok, ss);
        }
    }
}

DEV int swz256(int row, int chunk) { return row * 256 + ((chunk ^ (row & 15)) << 4); }
DEV void hgrn_cumsum(const Params& p, int bh, int c, float* segs, f32x2 (&lf)[8], f32x2 (&a)[8], f32x2& r, f32x2& alast) {
    const int tid = threadIdx.x, k2 = tid & 63, tq = tid >> 6;
    const int b = bh >> 2, h = bh & 3;
    const float* HL = (const float*)(p.ws + WS_HLOGF) + ((size_t)b * SEQ + c * 64 + tq * 8) * 512 + h * 128 + 2 * k2;
#pragma unroll
    for (int i = 0; i < 8; ++i) lf[i] = *(const f32x2*)(HL + (size_t)i * 512);
    f32x2 run = (f32x2){0.f, 0.f};
#pragma unroll
    for (int i = 0; i < 8; ++i) { run = run + lf[i]; a[i] = run; }
    *(f32x2*)(segs + tq * 128 + 2 * k2) = run;
    __syncthreads();
    f32x2 off = (f32x2){0.f, 0.f}, tot = off, rr = off;
#pragma unroll
    for (int q = 0; q < 8; ++q) { const f32x2 s = *(const f32x2*)(segs + q * 128 + 2 * k2); if (q < tq) off = off + s; if (q < 4) rr = rr + s; tot = tot + s; }
#pragma unroll
    for (int i = 0; i < 8; ++i) a[i] = a[i] + off;
    r = rr; alast = tot;
}
DEV void hgrn_stage_vt(const Params& p, int bh, int c, unsigned char* vt) {
    const int tid = threadIdx.x, k2 = tid & 63, tq = tid >> 6;
    const int b = bh >> 2, h = bh & 3;
    const bf16_t* HV = (const bf16_t*)(p.ws + WS_HV) + ((size_t)b * SEQ + c * 64 + tq * 8) * 512 + h * 128 + 2 * k2;
    unsigned vv[8];
#pragma unroll
    for (int i = 0; i < 8; ++i) vv[i] = *(const unsigned*)(HV + (size_t)i * 512);
    u32x4 lo, hi;
    lo.x = (vv[0] & 0xffffu) | (vv[1] << 16); lo.y = (vv[2] & 0xffffu) | (vv[3] << 16); lo.z = (vv[4] & 0xffffu) | (vv[5] << 16); lo.w = (vv[6] & 0xffffu) | (vv[7] << 16);
    hi.x = (vv[0] >> 16) | (vv[1] & 0xffff0000u); hi.y = (vv[2] >> 16) | (vv[3] & 0xffff0000u); hi.z = (vv[4] >> 16) | (vv[5] & 0xffff0000u); hi.w = (vv[6] >> 16) | (vv[7] & 0xffff0000u);
    *(u32x4*)(vt + swz(2 * k2, tq)) = lo; *(u32x4*)(vt + swz(2 * k2 + 1, tq)) = hi;
}
constexpr int H1_KT = 0, H1_VT = 16384, H1_SEG = 32768, H1_EK = H1_SEG + 4096;
DEV void phase_hgrn_a1(const Params& p, unsigned char* lds) {
    const int tid = threadIdx.x, lane = tid & 63, wid = tid >> 6, k2 = tid & 63, tq = tid >> 6;
    const int vb = vblock(), G = gridDim.x;
    const int frow = lane & 15, fq = lane >> 4, wr = wid >> 1, wc = wid & 1;
    float* segs = (float*)(lds + H1_SEG); float* ek = (float*)(lds + H1_EK);
    bf16_t* ubuf = (bf16_t*)(p.ws + WS_UBUF); float* dbuf = (float*)(p.ws + WS_DBUF);
    for (int item = vb; item < 2048; item += G) {
        const int bh = item >> 6, c = item & 63;
        __syncthreads();
        f32x2 lf[8], a[8], r, al;
        hgrn_cumsum(p, bh, c, segs, lf, a, r, al);
        {
            float kx[8], ky[8];
#pragma unroll
            for (int i = 0; i < 8; ++i) { kx[i] = (1.f - __expf(lf[i].x)) * __expf(fminf(r.x - a[i].x, 80.f)); ky[i] = (1.f - __expf(lf[i].y)) * __expf(fminf(r.y - a[i].y, 80.f)); }
            u32x4 w0, w1;
            w0.x = pk2(kx[0], kx[1]); w0.y = pk2(kx[2], kx[3]); w0.z = pk2(kx[4], kx[5]); w0.w = pk2(kx[6], kx[7]);
            w1.x = pk2(ky[0], ky[1]); w1.y = pk2(ky[2], ky[3]); w1.z = pk2(ky[4], ky[5]); w1.w = pk2(ky[6], ky[7]);
            *(u32x4*)(lds + H1_KT + swz(2 * k2, tq)) = w0; *(u32x4*)(lds + H1_KT + swz(2 * k2 + 1, tq)) = w1;
        }
        hgrn_stage_vt(p, bh, c, lds + H1_VT);
        if (tq == 7) { ek[2 * k2] = __expf(al.x - r.x); ek[2 * k2 + 1] = __expf(al.y - r.y); f32x2 d; d.x = __expf(al.x); d.y = __expf(al.y); *(f32x2*)(dbuf + (size_t)item * 128 + 2 * k2) = d; }
        __syncthreads();
        f32x4 acc[2][4];
#pragma unroll
        for (int m = 0; m < 2; ++m)
#pragma unroll
            for (int n = 0; n < 4; ++n) acc[m][n] = (f32x4){0.f, 0.f, 0.f, 0.f};
        const int sx = (frow >> 1) & 7;
#pragma unroll
        for (int ks = 0; ks < 2; ++ks) {
            const int co = ((ks * 4 + fq) ^ sx) << 4;
            bf16x8 af[2], bfr[4];
#pragma unroll
            for (int m = 0; m < 2; ++m) af[m] = *(const bf16x8*)(lds + H1_VT + (32 * wr + 16 * m + frow) * 128 + co);
#pragma unroll
            for (int n = 0; n < 4; ++n) bfr[n] = *(const bf16x8*)(lds + H1_KT + (64 * wc + 16 * n + frow) * 128 + co);
#pragma unroll
            for (int m = 0; m < 2; ++m)
#pragma unroll
                for (int n = 0; n < 4; ++n) acc[m][n] = __builtin_amdgcn_mfma_f32_16x16x32_bf16(bfr[n], af[m], acc[m][n], 0, 0, 0);
        }
#pragma unroll
        for (int m = 0; m < 2; ++m) { const int v = 32 * wr + 16 * m + frow;
#pragma unroll
            for (int n = 0; n < 4; ++n) { const int k0 = 64 * wc + 16 * n + 4 * fq; const f32x4 e = *(const f32x4*)(ek + k0); const f32x4 o = acc[m][n] * e;
                u32x2 w; w.x = pk2(o.x, o.y); w.y = pk2(o.z, o.w); *(u32x2*)(ubuf + ((size_t)item * 128 + v) * 128 + k0) = w; } }
    }
}
DEV void phase_hgrn_a2(const Params& p, unsigned char* lds) {
    const int G = gridDim.x;
    bf16_t* ubuf = (bf16_t*)(p.ws + WS_UBUF); const float* dbuf = (const float*)(p.ws + WS_DBUF);
    for (int gid = blockIdx.x * NT + threadIdx.x; gid < 131072; gid += G * NT) {
        const int bh = gid >> 12, v = (gid >> 5) & 127, k4 = gid & 31;
        bf16_t* u = ubuf + ((size_t)bh * 64 * 128 + v) * 128 + 4 * k4;
        const float* d = dbuf + (size_t)bh * 64 * 128 + 4 * k4;
        f32x4 S = (f32x4){0.f, 0.f, 0.f, 0.f};
        for (int c0 = 0; c0 < 64; c0 += 8) {
            u32x2 uu[8]; f32x4 dd[8];
#pragma unroll
            for (int j = 0; j < 8; ++j) { uu[j] = *(const u32x2*)(u + (size_t)(c0 + j) * 16384); dd[j] = *(const f32x4*)(d + (size_t)(c0 + j) * 128); }
#pragma unroll
            for (int j = 0; j < 8; ++j) { u32x2 w; w.x = pk2(S.x, S.y); w.y = pk2(S.z, S.w); *(u32x2*)(u + (size_t)(c0 + j) * 16384) = w;
                S.x = dd[j].x * S.x + bflo(uu[j].x); S.y = dd[j].y * S.y + bfhi(uu[j].x); S.z = dd[j].z * S.z + bflo(uu[j].y); S.w = dd[j].w * S.w + bfhi(uu[j].y); }
        }
    }
}
constexpr int H3_QH = 0, H3_QA = 16384, H3_KH = 32768, H3_VT = 49152, H3_PP = 65536, H3_ST = 73728, H3_SEG = 106496, H3_RED = 110592;
DEV void phase_hgrn_a3(const Params& p, unsigned char* lds) {
    const int tid = threadIdx.x, lane = tid & 63, wid = tid >> 6, k2 = tid & 63, tq = tid >> 6;
    const int vb = vblock(), G = gridDim.x;
    const int frow = lane & 15, fq = lane >> 4;
    float* segs = (float*)(lds + H3_SEG); float* red = (float*)(lds + H3_RED);
    const bf16_t* ubuf = (const bf16_t*)(p.ws + WS_UBUF);
    for (int item = vb; item < 2048; item += G) {
        const int bh = item >> 6, c = item & 63, b = bh >> 2, h = bh & 3;
        __syncthreads();
        f32x2 lf[8], a[8], r, al;
        hgrn_cumsum(p, bh, c, segs, lf, a, r, al);
        {
            const bf16_t* HQ = (const bf16_t*)(p.ws + WS_HQ) + ((size_t)b * SEQ + c * 64 + tq * 8) * 512 + h * 128 + 2 * k2;
            unsigned qq[8];
#pragma unroll
            for (int i = 0; i < 8; ++i) qq[i] = *(const unsigned*)(HQ + (size_t)i * 512);
#pragma unroll
            for (int i = 0; i < 8; ++i) { const int t = 8 * tq + i; const float q0 = bflo(qq[i]), q1 = bfhi(qq[i]);
                const int off = swz256(t, k2 >> 2) + (k2 & 3) * 4;
                *(unsigned*)(lds + H3_QH + off) = pk2(q0 * __expf(fminf(a[i].x - r.x, 80.f)), q1 * __expf(fminf(a[i].y - r.y, 80.f)));
                *(unsigned*)(lds + H3_QA + off) = pk2(q0 * __expf(a[i].x), q1 * __expf(a[i].y));
                *(unsigned*)(lds + H3_KH + off) = pk2((1.f - __expf(lf[i].x)) * __expf(fminf(r.x - a[i].x, 80.f)), (1.f - __expf(lf[i].y)) * __expf(fminf(r.y - a[i].y, 80.f))); }
        }
        hgrn_stage_vt(p, bh, c, lds + H3_VT);
        {
            const bf16_t* st = ubuf + (size_t)item * 16384;
#pragma unroll
            for (int i = 0; i < 4; ++i) { const int q = tid + NT * i, v = q >> 4, ch = q & 15; *(u32x4*)(lds + H3_ST + swz256(v, ch)) = *(const u32x4*)(st + v * 128 + ch * 8); }
        }
        __syncthreads();
        {
            const int wr = wid >> 1, wc = wid & 1;
            f32x4 acc[2];
            acc[0] = (f32x4){0.f, 0.f, 0.f, 0.f}; acc[1] = acc[0];
            if (32 * wc <= 16 * wr + 15) {
#pragma unroll
                for (int ks = 0; ks < 4; ++ks) {
                    const int co = ((ks * 4 + fq) ^ frow) << 4;
                    const bf16x8 af = *(const bf16x8*)(lds + H3_QH + (16 * wr + frow) * 256 + co);
#pragma unroll
                    for (int n = 0; n < 2; ++n) { const bf16x8 bfr = *(const bf16x8*)(lds + H3_KH + (32 * wc + 16 * n + frow) * 256 + co);
                        acc[n] = __builtin_amdgcn_mfma_f32_16x16x32_bf16(bfr, af, acc[n], 0, 0, 0); }
                }
            }
            const int t = 16 * wr + frow;
#pragma unroll
            for (int n = 0; n < 2; ++n) { const int s0 = 32 * wc + 16 * n + 4 * fq; f32x4 v = acc[n];
                v.x = (s0 + 0 <= t) ? v.x : 0.f; v.y = (s0 + 1 <= t) ? v.y : 0.f; v.z = (s0 + 2 <= t) ? v.z : 0.f; v.w = (s0 + 3 <= t) ? v.w : 0.f;
                u32x2 w; w.x = pk2(v.x, v.y); w.y = pk2(v.z, v.w);
                *(u32x2*)(lds + H3_PP + t * 128 + ((((s0 >> 3)) ^ ((t >> 1) & 7)) << 4) + (s0 & 7) * 2) = w; }
        }
        __syncthreads();
        {
            const int wr = wid >> 2, wc = wid & 3;
            f32x4 acc[2][2];
#pragma unroll
            for (int m = 0; m < 2; ++m)
#pragma unroll
                for (int n = 0; n < 2; ++n) acc[m][n] = (f32x4){0.f, 0.f, 0.f, 0.f};
            const int sx = (frow >> 1) & 7;
#pragma unroll
            for (int ks = 0; ks < 2; ++ks) {
                const int co = ((ks * 4 + fq) ^ sx) << 4;
                bf16x8 af[2], bfr[2];
#pragma unroll
                for (int m = 0; m < 2; ++m) af[m] = *(const bf16x8*)(lds + H3_PP + (32 * wr + 16 * m + frow) * 128 + co);
#pragma unroll
                for (int n = 0; n < 2; ++n) bfr[n] = *(const bf16x8*)(lds + H3_VT + (32 * wc + 16 * n + frow) * 128 + co);
#pragma unroll
                for (int m = 0; m < 2; ++m)
#pragma unroll
                    for (int n = 0; n < 2; ++n) acc[m][n] = __builtin_amdgcn_mfma_f32_16x16x32_bf16(bfr[n], af[m], acc[m][n], 0, 0, 0);
            }
#pragma unroll
            for (int ks = 0; ks < 4; ++ks) {
                const int co = ((ks * 4 + fq) ^ frow) << 4;
                bf16x8 af[2], bfr[2];
#pragma unroll
                for (int m = 0; m < 2; ++m) af[m] = *(const bf16x8*)(lds + H3_QA + (32 * wr + 16 * m + frow) * 256 + co);
#pragma unroll
                for (int n = 0; n < 2; ++n) bfr[n] = *(const bf16x8*)(lds + H3_ST + (32 * wc + 16 * n + frow) * 256 + co);
#pragma unroll
                for (int m = 0; m < 2; ++m)
#pragma unroll
                    for (int n = 0; n < 2; ++n) acc[m][n] = __builtin_amdgcn_mfma_f32_16x16x32_bf16(bfr[n], af[m], acc[m][n], 0, 0, 0);
            }
#pragma unroll
            for (int m = 0; m < 2; ++m) { float ss = 0.f;
#pragma unroll
                for (int n = 0; n < 2; ++n) { const f32x4 v = acc[m][n]; ss += (v.x * v.x + v.y * v.y) + (v.z * v.z + v.w * v.w); }
                ss += __shfl_xor(ss, 16); ss += __shfl_xor(ss, 32);
                if (fq == 0) red[(32 * wr + 16 * m + frow) * 4 + wc] = ss; }
            __syncthreads();
#pragma unroll
            for (int m = 0; m < 2; ++m) { const int t = 32 * wr + 16 * m + frow; const f32x4 q4 = *(const f32x4*)(red + t * 4);
                const float rs = rsqrtf(((q4.x + q4.y) + (q4.z + q4.w)) * (1.f / 128.f) + RMS_EPS);
                const size_t row = (size_t)b * SEQ + c * 64 + t;
#pragma unroll
                for (int n = 0; n < 2; ++n) { const int v0 = 32 * wc + 16 * n + 4 * fq; const f32x4 gn = *(const f32x4*)(p.g_hn + v0);
                    const u32x2 gg = *(const u32x2*)((const bf16_t*)(p.ws + WS_HG) + row * 512 + h * 128 + v0);
                    const f32x4 o = acc[m][n];
                    u32x2 w; w.x = pk2(o.x * rs * gn.x * bflo(gg.x), o.y * rs * gn.y * bfhi(gg.x)); w.y = pk2(o.z * rs * gn.z * bflo(gg.y), o.w * rs * gn.w * bfhi(gg.y));
                    *(u32x2*)((bf16_t*)(p.ws + WS_R1) + row * 1024 + 512 + h * 128 + v0) = w; } }
        }
    }
}

DEV void phase_normalize(const Params& p, unsigned char* lds) {
    const int tid = threadIdx.x, lane = tid & 63, wid = tid >> 6;
    const int vb = vblock(), G = gridDim.x;
    unsigned char* ws = p.ws;
    bf16_t* mix = (bf16_t*)(ws + WS_R1); const float* rowss = (const float*)(ws + WS_ROWSS); const bf16_t* HG = (const bf16_t*)(ws + WS_HG);
    for (int m = vb * 8 + wid; m < NTOK; m += G * 8) {
        {
            const float r = rsqrtf(rowss[m] * (1.f / 512.f) + RMS_EPS);
            u32x4* pp = (u32x4*)(mix + (size_t)m * 1024) + lane; u32x4 v = *pp;
            v.x = pk2(bflo(v.x) * r, bfhi(v.x) * r); v.y = pk2(bflo(v.y) * r, bfhi(v.y) * r); v.z = pk2(bflo(v.z) * r, bfhi(v.z) * r); v.w = pk2(bflo(v.w) * r, bfhi(v.w) * r);
            *pp = v;
        }
    }
    __syncthreads();
    {
        float* tl = (float*)lds;
        for (int r = vb; r < 32 * 4 * 16; r += G) { const int e = r / 64, q = r % 64; SrcW13_4 s{p.w1 + (size_t)e * 1024 * 512, p.w3 + (size_t)e * 1024 * 512, p.ffn_g};
            convert_tile256(tl, s, (bf16_t*)(ws + WS_W13T) + (size_t)e * 1024 * 1024, 1024, (q / 16) * 256, (q % 16) * 64); }
    }
}

struct EpiOut8 { const Params& p;
    DEV void operator()(const f32x4 (&acc)[2][2][4][2], const pg8::Unit& u, int wr, int wc, int fr, int fq) const {
#pragma unroll
        for (int ai = 0; ai < 2; ++ai)
#pragma unroll
            for (int m = 0; m < 4; ++m) { const size_t row = (size_t)u.pm * 256 + ai * 128 + wr * 64 + m * 16 + fr;
#pragma unroll
                for (int bj = 0; bj < 2; ++bj)
#pragma unroll
                    for (int n = 0; n < 2; ++n) { const int c = u.pn * 256 + 64 * wc + 32 * bj + 16 * n + 4 * fq; const f32x4 xv = *(const f32x4*)(p.x + row * DM + c); *(f32x4*)(p.out + row * DM + c) = xv + acc[ai][bj][m][n]; } }
    } };
DEV void phase_outproj(const Params& p, unsigned char* lds) {
    pg8::Gemm g{(const bf16_t*)(p.ws + WS_R1), (const bf16_t*)(p.ws + WS_WOUTT), NTOK, DM, DM};
    pg8::StaticOrder S; S.init(NTOK, DM, (int)gridDim.x, (int)blockIdx.x);
    EpiOut8 E{p};
    pg8::gemm_phase((PG8_LAS unsigned char*)lds, g, S, E);
}

constexpr int RT_W = 0, RT_LG = 49152, RT_RS = RT_LG + 128 * 49 * 4, RT_HIST = RT_RS + 512, RT_BASE = RT_HIST + 512, RT_LDS = RT_BASE + 512;
DEV void phase_router(const Params& p, unsigned char* lds) {
    const int tid = threadIdx.x, lane = tid & 63, wid = tid >> 6, frow = lane & 15, fq = lane >> 4;
    const int vb = vblock(), G = gridDim.x;
    unsigned char* ws = p.ws;
    float* lg = (float*)(lds + RT_LG); float* rsd = (float*)(lds + RT_RS);
    int* hist = (int*)(lds + RT_HIST); int* basep = (int*)(lds + RT_BASE);
    const bf16_t* rw = (const bf16_t*)(ws + WS_RW);
    for (int it = vb; it < NTOK / 128; it += G) {
        const size_t row0 = (size_t)it * 128;
        const size_t trow = row0 + 16 * wid + frow;
        const float* hrow = p.out + trow * DM + 8 * fq;
        bf16_t* hbrow = (bf16_t*)(ws + WS_R1) + trow * DM + 8 * fq;
        f32x4 acc[3]; float ss = 0.f;
#pragma unroll
        for (int nt = 0; nt < 3; ++nt) acc[nt] = (f32x4){0.f, 0.f, 0.f, 0.f};
        if (tid < 128) hist[tid] = 0;
        for (int kc = 0; kc < 4; ++kc) {
            __syncthreads();
#pragma unroll
            for (int i = 0; i < 6; ++i) { const int idx = tid + NT * i, r = idx >> 5, c = idx & 31;
                *(u32x4*)(lds + RT_W + r * 512 + ((c ^ (r & 15)) << 4)) = *(const u32x4*)(rw + (size_t)r * 1024 + kc * 256 + c * 8); }
            f32x4 xa[8][2];
#pragma unroll
            for (int ks = 0; ks < 8; ++ks) { xa[ks][0] = *(const f32x4*)(hrow + kc * 256 + 32 * ks); xa[ks][1] = *(const f32x4*)(hrow + kc * 256 + 32 * ks + 4); }
            __syncthreads();
#pragma unroll
            for (int ks = 0; ks < 8; ++ks) {
                const f32x4 a = xa[ks][0], b = xa[ks][1];
                ss += ((a.x * a.x + a.y * a.y) + (a.z * a.z + a.w * a.w)) + ((b.x * b.x + b.y * b.y) + (b.z * b.z + b.w * b.w));
                u32x4 hi; hi.x = pk2(a.x, a.y); hi.y = pk2(a.z, a.w); hi.z = pk2(b.x, b.y); hi.w = pk2(b.z, b.w);
                u32x4 lo; lo.x = pk2(a.x - bflo(hi.x), a.y - bfhi(hi.x)); lo.y = pk2(a.z - bflo(hi.y), a.w - bfhi(hi.y)); lo.z = pk2(b.x - bflo(hi.z), b.y - bfhi(hi.z)); lo.w = pk2(b.z - bflo(hi.w), b.w - bfhi(hi.w));
                *(u32x4*)(hbrow + kc * 256 + 32 * ks) = hi;
                const bf16x8 hh = __builtin_bit_cast(bf16x8, hi), hl = __builtin_bit_cast(bf16x8, lo);
                const int co = ((4 * ks + fq) ^ frow) << 4;
#pragma unroll
                for (int nt = 0; nt < 3; ++nt) {
                    const bf16x8 whi = *(const bf16x8*)(lds + RT_W + (16 * nt + frow) * 512 + co), wlo = *(const bf16x8*)(lds + RT_W + (48 + 16 * nt + frow) * 512 + co);
                    acc[nt] = __builtin_amdgcn_mfma_f32_16x16x32_bf16(whi, hh, acc[nt], 0, 0, 0);
                    acc[nt] = __builtin_amdgcn_mfma_f32_16x16x32_bf16(wlo, hh, acc[nt], 0, 0, 0);
                    acc[nt] = __builtin_amdgcn_mfma_f32_16x16x32_bf16(whi, hl, acc[nt], 0, 0, 0);
                }
            }
        }
        ss += __shfl_xor(ss, 16); ss += __shfl_xor(ss, 32);
        if (fq == 0) rsd[16 * wid + frow] = rsqrtf(ss * (1.f / DM) + RMS_EPS);
#pragma unroll
        for (int nt = 0; nt < 3; ++nt) { float* o = lg + (16 * wid + frow) * 49 + 16 * nt + 4 * fq; o[0] = acc[nt].x; o[1] = acc[nt].y; o[2] = acc[nt].z; o[3] = acc[nt].w; }
        __syncthreads();
        int bin = 0, slot = 0;
        if (tid < 128) {
            const float rs = rsd[tid];
            ((float*)(ws + WS_RSTD2))[row0 + tid] = rs;
            float gl[4]; int gi = 0; float gm = -1e30f;
#pragma unroll
            for (int c = 0; c < 4; ++c) { gl[c] = lg[tid * 49 + c] * rs + p.b_group[c]; if (gl[c] > gm) { gm = gl[c]; gi = c; } }
            float gs = 0.f;
#pragma unroll
            for (int c = 0; c < 4; ++c) gs += __expf(gl[c] - gm);
            const float pg = 1.f / gs;
            float el[8]; int i0 = 0; float m0 = -1e30f;
#pragma unroll
            for (int c = 0; c < 8; ++c) { el[c] = lg[tid * 49 + 4 + gi * 8 + c] * rs + p.b_expert[gi * 8 + c]; if (el[c] > m0) { m0 = el[c]; i0 = c; } }
            int i1 = 0; float m1 = -1e30f;
#pragma unroll
            for (int c = 0; c < 8; ++c) if (c != i0 && el[c] > m1) { m1 = el[c]; i1 = c; }
            const float e1 = __expf(m1 - m0); const float w0 = pg / (1.f + e1), w1 = pg * e1 / (1.f + e1);
            const int a = min(i0, i1), bb = max(i0, i1);
            bin = gi * 28 + (7 * a - (a * (a - 1)) / 2) + (bb - a - 1);
            f32x2 tw; tw.x = (i0 < i1) ? w0 : w1; tw.y = (i0 < i1) ? w1 : w0;
            ((f32x2*)(ws + WS_TOKW))[row0 + tid] = tw;
            slot = atomicAdd(&hist[bin], 1);
        }
        __syncthreads();
        if (tid < NBIN) { const int h = hist[tid]; basep[tid] = h ? atomicAdd((int*)(ws + WS_CTL) + tid, h) : 0; }
        __syncthreads();
        if (tid < 128) ((int*)(ws + WS_BINL))[(size_t)bin * BINCAP + basep[bin] + slot] = (int)(row0 + tid);
        __syncthreads();
    }
}

constexpr int MOE_TS = pg8::STAGE_BYTES, MOE_TT = MOE_TS + 512;
DEV void moe_tiles(const Params& p, unsigned char* lds) {
    int* tstart = (int*)(lds + MOE_TS); int* tiletab = (int*)(lds + MOE_TT);
    const int tid = threadIdx.x;
    __syncthreads();
    if (tid == 0) { const int* cnt = (const int*)(p.ws + WS_CTL); int s = 0; for (int i = 0; i < NBIN; ++i) { tstart[i] = s; s += (cnt[i] + 255) >> 8; } tstart[NBIN] = s; }
    __syncthreads();
    if (tid < NBIN) for (int t = tstart[tid]; t < tstart[tid + 1]; ++t) tiletab[t] = tid;
    __syncthreads();
}
DEV void bin_experts(int bin, int& ea, int& eb) { const int gi = bin / 28; int pi = bin % 28, a = 0; while (pi >= 7 - a) { pi -= 7 - a; ++a; } ea = gi * 8 + a; eb = gi * 8 + a + 1 + pi; }
struct MoeUnit { int tile, nt, bin, mt, n; };
struct MoeSchedBase {
    const Params& p; const int* tstart; const int* tiletab; int NN, U, G, c;
    DEV bool next(int i, MoeUnit& u) const {
        const int L = i * G + c; if (L >= U) return false;
        u.tile = L / NN; u.nt = L % NN;
        u.bin = __builtin_amdgcn_readfirstlane(tiletab[u.tile]);
        u.mt = u.tile - __builtin_amdgcn_readfirstlane(tstart[u.bin]);
        const int cnt = ((const int*)(p.ws + WS_CTL))[u.bin];
        u.n = min(256, cnt - u.mt * 256);
        return true;
    }
    DEV bool full(const MoeUnit& u) const { return u.n > 128; }
};
struct PolMoe1 : MoeSchedBase {
    typedef MoeUnit Unit;
    struct AddrA { unsigned off[2][2]; };
    struct AddrB { const char* base; unsigned voff[2]; };
    DEV int nk() const { return 16; }
    DEV void addrA(const MoeUnit& u, const int (&R)[2], const int (&C)[2], AddrA& a) const {
        const int* list = (const int*)(p.ws + WS_BINL) + (size_t)u.bin * BINCAP + u.mt * 256;
#pragma unroll
        for (int h = 0; h < 2; ++h)
#pragma unroll
            for (int i = 0; i < 2; ++i) { int r = h * 128 + R[i]; if (r >= u.n) r = 0; a.off[h][i] = (unsigned)list[r] * 2048u + (unsigned)C[i] * 2u; }
    }
    DEV void addrB(const MoeUnit& u, const int (&R)[2], const int (&C)[2], AddrB& b) const {
        int ea, eb; bin_experts(u.bin, ea, eb); const int e = u.nt < 4 ? ea : eb;
        b.base = (const char*)(p.ws + WS_W13T) + ((size_t)e * 1024 + (u.nt & 3) * 256) * 2048;
#pragma unroll
        for (int i = 0; i < 2; ++i) b.voff[i] = (unsigned)(R[i] * 1024 + C[i]) * 2u;
    }
    DEV const char* pa(const AddrA& a, int h, int i, int kt) const { return (const char*)(p.ws + WS_R1) + a.off[h][i] + kt * 128; }
    DEV const char* pb(const AddrB& b, int h, int i, int kt) const { return b.base + (size_t)h * (128 * 2048) + b.voff[i] + kt * 128; }
};
struct EpiMoe1 { const Params& p;
    DEV void operator()(const f32x4 (&acc)[2][2][4][2], const MoeUnit& u, int wr, int wc, int fr, int fq) const {
        const int* list = (const int*)(p.ws + WS_BINL) + (size_t)u.bin * BINCAP + u.mt * 256;
        bf16_t* hbuf = (bf16_t*)(p.ws + WS_HBUF) + (size_t)u.tile * 256 * 1024 + (u.nt < 4 ? 0 : 512);
#pragma unroll
        for (int ai = 0; ai < 2; ++ai)
#pragma unroll
            for (int m = 0; m < 4; ++m) { const int r = ai * 128 + wr * 64 + m * 16 + fr; if (r >= u.n) continue;
                const int t = list[r]; const float rs = ((const float*)(p.ws + WS_RSTD2))[t]; const f32x2 tw = ((const f32x2*)(p.ws + WS_TOKW))[t]; const float w = u.nt < 4 ? tw.x : tw.y;
#pragma unroll
                for (int bj = 0; bj < 2; ++bj)
#pragma unroll
                    for (int n = 0; n < 2; ++n) { const f32x4 v = acc[ai][bj][m][n] * rs; const int f = ((u.nt & 3) * 256 + 128 * bj + 32 * wc + 16 * n + 4 * fq) >> 1;
                        *(unsigned*)(hbuf + (size_t)r * 1024 + f) = pk2(siluf_(v.x) * v.y * w, siluf_(v.z) * v.w * w); } }
    } };
DEV void phase_moe1(const Params& p, unsigned char* lds) {
    moe_tiles(p, lds);
    const int* tstart = (const int*)(lds + MOE_TS);
    PolMoe1 P{{p, tstart, (const int*)(lds + MOE_TT), 8, tstart[NBIN] * 8, (int)gridDim.x, vblock()}};
    EpiMoe1 E{p};
    pg8::gemm_phase2((PG8_LAS unsigned char*)lds, P, E);
}
struct PolMoe2 : MoeSchedBase {
    typedef MoeUnit Unit;
    struct AddrA { const char* base; unsigned voff[2]; };
    struct AddrB { const char* ba; const char* bb; unsigned voff[2]; };
    DEV int nk() const { return 16; }
    DEV void addrA(const MoeUnit& u, const int (&R)[2], const int (&C)[2], AddrA& a) const {
        a.base = (const char*)(p.ws + WS_HBUF) + (size_t)u.tile * 256 * 2048;
#pragma unroll
        for (int i = 0; i < 2; ++i) a.voff[i] = (unsigned)(R[i] * 1024 + C[i]) * 2u;
    }
    DEV void addrB(const MoeUnit& u, const int (&R)[2], const int (&C)[2], AddrB& b) const {
        int ea, eb; bin_experts(u.bin, ea, eb);
        b.ba = (const char*)(p.ws + WS_W2T) + ((size_t)ea * 1024 + u.nt * 256) * 1024; b.bb = (const char*)(p.ws + WS_W2T) + ((size_t)eb * 1024 + u.nt * 256) * 1024;
#pragma unroll
        for (int i = 0; i < 2; ++i) b.voff[i] = (unsigned)(R[i] * 512 + C[i]) * 2u;
    }
    DEV const char* pa(const AddrA& a, int h, int i, int kt) const { return a.base + (size_t)h * (128 * 2048) + a.voff[i] + kt * 128; }
    DEV const char* pb(const AddrB& b, int h, int i, int kt) const { return (kt < 8 ? b.ba + kt * 128 : b.bb + (kt - 8) * 128) + (size_t)h * (128 * 1024) + b.voff[i]; }
};
struct EpiMoe2 { const Params& p;
    DEV void operator()(const f32x4 (&acc)[2][2][4][2], const MoeUnit& u, int wr, int wc, int fr, int fq) const {
        const int* list = (const int*)(p.ws + WS_BINL) + (size_t)u.bin * BINCAP + u.mt * 256;
#pragma unroll
        for (int ai = 0; ai < 2; ++ai)
#pragma unroll
            for (int m = 0; m < 4; ++m) { const int r = ai * 128 + wr * 64 + m * 16 + fr; if (r >= u.n) continue; const size_t t = list[r];
#pragma unroll
                for (int bj = 0; bj < 2; ++bj)
#pragma unroll
                    for (int n = 0; n < 2; ++n) { float* o = p.out + t * DM + u.nt * 256 + 128 * bj + 32 * wc + 16 * n + 4 * fq; *(f32x4*)o = *(const f32x4*)o + acc[ai][bj][m][n]; } }
    } };
DEV void phase_moe2(const Params& p, unsigned char* lds) {
    moe_tiles(p, lds);
    const int* tstart = (const int*)(lds + MOE_TS);
    PolMoe2 P{{p, tstart, (const int*)(lds + MOE_TT), 4, tstart[NBIN] * 4, (int)gridDim.x, vblock()}};
    EpiMoe2 E{p};
    pg8::gemm_phase2((PG8_LAS unsigned char*)lds, P, E);
}

#define XB_TMO      128
#define XB_XCNT(j)  (256  + 64 * (j))
#define XB_XSUB(j)  (1280 + 64 * (j))
#define XB_XGEN(j)  (2304 + 64 * (j))
#define XB_TOP      3328
#define XB_TOPGEN   3392
#define XCD_BAR_WORDS 3456
#define XB_SPIN_CAP (1u << 20)
#define LAS __attribute__((address_space(3)))
constexpr size_t WS_BAR = WS_CTL + 4096;
DEV unsigned xb_ld(unsigned* p) { return __hip_atomic_load(p, __ATOMIC_RELAXED, __HIP_MEMORY_SCOPE_AGENT); }
DEV unsigned xb_add(unsigned* p, unsigned v) { return __hip_atomic_fetch_add(p, v, __ATOMIC_RELAXED, __HIP_MEMORY_SCOPE_AGENT); }
DEV unsigned xb_xcc_id() { return (unsigned)__builtin_amdgcn_s_getreg((3 << 11) | 20) & 0xFu; }
#define XB_SPIN(cond, bar) do { unsigned _sp = 0; while (cond) { __builtin_amdgcn_s_sleep(1); \
    if ((++_sp & 255u) == 0u) { if (xb_ld(&(bar)[XB_TMO])) break; if (_sp > XB_SPIN_CAP) { atomicAdd(&(bar)[XB_TMO], 1u); break; } } } } while (0)
struct XcdBarrier { unsigned* bar; unsigned x; volatile LAS unsigned* st; };
DEV XcdBarrier xcd_barrier_post(unsigned* bar, volatile LAS unsigned* st) {
    XcdBarrier b; b.bar = bar; b.x = xb_xcc_id(); b.st = st;
    if (threadIdx.x == 0) (void)xb_add(&bar[XB_XCNT(b.x)], 1u);
    return b;
}
DEV void xcd_barrier_complete(unsigned* bar, unsigned x, unsigned& nloc, unsigned& nx) {
    const unsigned G = gridDim.x * gridDim.y * gridDim.z;
    unsigned sum, cnt, mine, sp = 0u;
    for (;;) {
        sum = 0u; cnt = 0u; mine = 0u;
#pragma unroll
        for (unsigned j = 0; j < 16; ++j) { const unsigned c = xb_ld(&bar[XB_XCNT(j)]); sum += c; cnt += (c > 0u) ? 1u : 0u; mine = (j == x) ? c : mine; }
        if (sum == G) break;
        __builtin_amdgcn_s_sleep(1);
        if ((++sp & 255u) == 0u) { if (xb_ld(&bar[XB_TMO])) break; if (sp > XB_SPIN_CAP) { atomicAdd(&bar[XB_TMO], 1u); break; } }
    }
    nloc = mine > 0u ? mine : 1u; nx = cnt > 0u ? cnt : 1u;
}
DEV void xcd_barrier(const XcdBarrier& b) {
    asm volatile("s_waitcnt vmcnt(0)" ::: "memory");
    __syncthreads();
    if (threadIdx.x == 0) {
        unsigned* bar = b.bar;
        __builtin_amdgcn_s_waitcnt(0);
        unsigned nloc = b.st[0], nx = b.st[1];
        if (nloc == 0u) { xcd_barrier_complete(bar, b.x, nloc, nx); b.st[0] = nloc; b.st[1] = nx; }
        const unsigned old = xb_add(&bar[XB_XSUB(b.x)], 1u);
        const unsigned gen = old / nloc;
        if (old + 1u == (gen + 1u) * nloc) {
            __builtin_amdgcn_fence(__ATOMIC_RELEASE, "agent");
            asm volatile("s_waitcnt vmcnt(0)" ::: "memory");
            const unsigned og = xb_add(&bar[XB_TOP], 1u);
            const unsigned tg = og / nx;
            if (og + 1u == (tg + 1u) * nx) xb_add(&bar[XB_TOPGEN], 1u);
            else XB_SPIN(xb_ld(&bar[XB_TOPGEN]) == tg, bar);
            __builtin_amdgcn_fence(__ATOMIC_ACQUIRE, "agent");
            xb_add(&bar[XB_XGEN(b.x)], 1u);
            asm volatile("s_waitcnt vmcnt(0)" ::: "memory");
        } else {
            XB_SPIN(xb_ld(&bar[XB_XGEN(b.x)]) == gen, bar);
            __builtin_amdgcn_fence(__ATOMIC_ACQUIRE, "agent");
            asm volatile("s_waitcnt vmcnt(0)" ::: "memory");
        }
    }
    __syncthreads();
}

constexpr int LDS_BYTES = 144 * 1024;
constexpr int N_PHASES = 13;
__global__ void __launch_bounds__(NT) mega(Params p, int lo, int hi) {
    extern __shared__ __attribute__((aligned(16))) unsigned char lds[];
    volatile LAS unsigned* xst = (volatile LAS unsigned*)(lds + LDS_BYTES - 16);
    if (threadIdx.x < 4) xst[threadIdx.x] = 0u;
    __syncthreads();
    XcdBarrier xbar; xbar.bar = (unsigned*)(p.ws + WS_BAR); xbar.x = 0; xbar.st = xst;
    if (hi - lo > 1) xbar = xcd_barrier_post((unsigned*)(p.ws + WS_BAR), xst);
#define GRID_SYNC() xcd_barrier(xbar)
#ifndef PROBE_REPEAT
#define PROBE_REPEAT -1
#endif
#define RUN_PHASE(k, call) do { if (lo <= (k) && (k) < hi) { call; \
        if ((k) == PROBE_REPEAT) { GRID_SYNC(); \
            if ((k) == 5) { float* rz = (float*)(p.ws + WS_ROWSS); for (int i = blockIdx.x * NT + threadIdx.x; i < NTOK; i += gridDim.x * NT) rz[i] = 0.f; GRID_SYNC(); } \
            if ((k) == 11) { if (blockIdx.x == 0 && threadIdx.x < 128) ((int*)(p.ws + WS_CTL))[threadIdx.x] = 0; GRID_SYNC(); } \
            call; } \
        if ((k) + 1 < hi) GRID_SYNC(); } } while (0)
    RUN_PHASE(0, phase_prologue(p, lds));
    RUN_PHASE(1, phase_inproj(p, lds));
    RUN_PHASE(2, phase_cmp_a(p, lds));
    RUN_PHASE(3, phase_cmp_b(p, lds));
    RUN_PHASE(4, phase_cmp_attn(p, lds));
    RUN_PHASE(5, phase_flash(p, lds));
    RUN_PHASE(6, phase_hgrn_a1(p, lds));
    RUN_PHASE(7, phase_hgrn_a2(p, lds));
    RUN_PHASE(8, phase_hgrn_a3(p, lds));
    RUN_PHASE(9, phase_normalize(p, lds));
    RUN_PHASE(10, phase_outproj(p, lds));
    RUN_PHASE(11, phase_router(p, lds));
    RUN_PHASE(12, phase_moe1(p, lds));
    RUN_PHASE(13, phase_moe2(p, lds));
#undef RUN_PHASE
}

extern "C" void kernel_launch(void* const* d_in, const int* in_sizes, int n_in, void* d_out, int out_size, void* d_ws, size_t ws_size, hipStream_t stream) {
    static int grid = 0;
    if (grid == 0) {
        int dev = 0, cus = 0, per_cu = 0;
        hipGetDevice(&dev);
        hipDeviceGetAttribute(&cus, hipDeviceAttributeMultiprocessorCount, dev);
        hipFuncSetAttribute((const void*)mega, hipFuncAttributeMaxDynamicSharedMemorySize, LDS_BYTES);
        hipOccupancyMaxActiveBlocksPerMultiprocessor(&per_cu, (const void*)mega, NT, LDS_BYTES);
        if (per_cu < 1) per_cu = 1;
        grid = cus;
        if (ws_size < WS_END) fprintf(stderr, "kernel_launch: workspace too small: %zu < %zu\n", ws_size, (size_t)WS_END);
        fprintf(stderr, "kernel_launch: cus %d per_cu %d grid %d ws %zu\n", cus, per_cu, grid, ws_size);
    }
    Params p{};
    const float** pp = (const float**)&p;
    for (int i = 0; i < 23; ++i) pp[i] = (const float*)d_in[i];
    p.out = (float*)d_out; p.ws = (unsigned char*)d_ws;
#if N_LAUNCH_MODE == 1
    (void)hipMemsetAsync((unsigned char*)d_ws + WS_BAR, 0, XCD_BAR_WORDS * 4, stream);
    int lo = 0, hi = N_PHASES + 1;
    void* args[] = {&p, &lo, &hi};
    hipError_t e = hipLaunchCooperativeKernel((const void*)mega, dim3(grid), dim3(NT), args, LDS_BYTES, stream);
    if (e != hipSuccess) fprintf(stderr, "cooperative launch failed: %s\n", hipGetErrorString(e));
#else
    for (int ph = 0; ph <= N_PHASES; ++ph) hipLaunchKernelGGL(mega, dim3(grid), dim3(NT), LDS_BYTES, stream, p, ph, ph + 1);
#endif
}
```

```cpp
#include <hip/hip_runtime.h>
#include <hip/hip_cooperative_groups.h>
#include <cstdio>
#include <cstdint>
#include <cstring>
namespace cg = cooperative_groups;

#ifndef N_LAUNCH_MODE
#define N_LAUNCH_MODE 1
#endif

#define DEV __device__ __forceinline__
typedef unsigned short bf16_t;
typedef short bf16x8 __attribute__((ext_vector_type(8)));
typedef float f32x4 __attribute__((ext_vector_type(4)));
typedef float f32x2 __attribute__((ext_vector_type(2)));
typedef float f32x16 __attribute__((ext_vector_type(16)));
typedef unsigned u32x4 __attribute__((ext_vector_type(4)));
typedef unsigned u32x2 __attribute__((ext_vector_type(2)));

constexpr int NT = 512;
constexpr int BATCH = 8, SEQ = 4096, DM = 1024, NTOK = BATCH * SEQ;
constexpr int IN_COLS = 3352, INP = 3584;
constexpr int NC = 255;
constexpr float RMS_EPS = 1e-6f;
constexpr float QSCALE = 0.125f * 1.4426950408889634f;
constexpr int NBIN = 112;
constexpr int BINCAP = NTOK;

constexpr size_t MiB = 1ull << 20;
constexpr size_t WS_CTL    = 0;
constexpr size_t WS_RSTD1  = 1 * MiB;
constexpr size_t WS_RSTD2  = WS_RSTD1 + 128 * 1024;
constexpr size_t WS_ROWSS  = WS_RSTD2 + 128 * 1024;
constexpr size_t WS_TOKW   = WS_ROWSS + 128 * 1024;
constexpr size_t WS_LB     = WS_TOKW + 256 * 1024;
constexpr size_t WS_CBIAS  = WS_LB + 4096;
constexpr size_t WS_SELM   = 2 * MiB;
constexpr size_t WS_GATES  = 3 * MiB;
constexpr size_t WS_KCMP   = 6 * MiB;
constexpr size_t WS_VCMP   = WS_KCMP + 512 * 1024;
constexpr size_t WS_CW2T   = 7 * MiB;
constexpr size_t WS_RW     = 7 * MiB + 128 * 1024;
constexpr size_t WS_HID    = 8 * MiB;
constexpr size_t WS_CW1T   = 12 * MiB;
constexpr size_t WS_WOUTT  = 14 * MiB;
constexpr size_t WS_WINT   = 16 * MiB;
constexpr size_t WS_R1     = 24 * MiB;
constexpr size_t WS_Q      = 88 * MiB;
constexpr size_t WS_KC     = 120 * MiB;
constexpr size_t WS_VC     = 128 * MiB;
constexpr size_t WS_KS     = 136 * MiB;
constexpr size_t WS_KW     = 144 * MiB;
constexpr size_t WS_VST    = 152 * MiB;
constexpr size_t WS_VWT    = 160 * MiB;
constexpr size_t WS_OC     = 168 * MiB;
constexpr size_t WS_W13T   = 200 * MiB;
constexpr size_t WS_W2T    = 264 * MiB;
constexpr size_t WS_HQ     = 296 * MiB;
constexpr size_t WS_HV     = 328 * MiB;
constexpr size_t WS_HG     = 360 * MiB;
constexpr size_t WS_HLOGF  = 392 * MiB;
constexpr size_t WS_DBUF   = 456 * MiB;
constexpr size_t WS_END    = 457 * MiB;
constexpr size_t WS_UBUF   = WS_W13T;
constexpr size_t WS_BINL   = WS_HQ;
constexpr size_t WS_HBUF   = WS_HQ + 16 * MiB;

struct Params {
    const float *x, *attn_g, *ffn_g, *w_in, *w_out, *g_q, *g_k, *pos_k, *pos_v, *wk1, *wk2, *wv1, *wv2, *g_nsa, *lb_logits, *g_hn,
        *w_group, *b_group, *w_expert, *b_expert, *w1, *w3, *w2;
    float* out;
    unsigned char* ws;
};

typedef __bf16 bf16x2_t __attribute__((ext_vector_type(2)));
DEV unsigned pk2(float lo, float hi) { f32x2 f = {lo, hi}; return __builtin_bit_cast(unsigned, __builtin_convertvector(f, bf16x2_t)); }
DEV bf16_t f2bf(float f) { return (bf16_t)(pk2(f, 0.f) & 0xffffu); }
DEV float bf2f(bf16_t b) { return __uint_as_float(((unsigned)b) << 16); }
DEV float bflo(unsigned u) { return __uint_as_float(u << 16); }
DEV float bfhi(unsigned u) { return __uint_as_float(u & 0xffff0000u); }
DEV float sigmoidf_(float v) { return 1.f / (1.f + __expf(-v)); }
DEV float siluf_(float v) { return v / (1.f + __expf(-v)); }
DEV float wave_sum(float v) {
#pragma unroll
    for (int o = 1; o < 64; o <<= 1) v += __shfl_xor(v, o);
    return v;
}
DEV float wave_max(float v) {
#pragma unroll
    for (int o = 1; o < 64; o <<= 1) v = fmaxf(v, __shfl_xor(v, o));
    return v;
}
DEV int vblock() { const int G = gridDim.x, b = blockIdx.x; return (G % 8 == 0) ? (b % 8) * (G / 8) + b / 8 : b; }

namespace pg8 {
#define PG8_LAS __attribute__((address_space(3)))
constexpr int BM = 256, BK = 64, HALF = 128, HTB = HALF * BK * 2, STAGE_BYTES = 8 * HTB, NXCD = 8, WGM = 8;
__host__ __device__ __forceinline__ int lds_byte(int r, int c) { const int st = (r >> 4) * 2 + (c >> 5), rr = r & 15, cc = c & 31, ob = rr * 64 + cc * 2; return st * 1024 + (ob ^ (((ob >> 9) & 1) << 5)); }
__host__ __device__ __forceinline__ void stage_rc(int b, int& R, int& C) { const int st = b / 1024, sb = b % 1024, swz = sb ^ (((sb >> 9) & 1) << 5); R = (st >> 1) * 16 + swz / 64; C = (st & 1) * 32 + (swz % 64) / 2; }
struct Unit { int pm, pn; };
struct Gemm { const bf16_t* A; const bf16_t* Bt; int M, N, K; };
struct StaticOrder {
    int nM, nN, nwg, G, c;
    __host__ __device__ void init(int M, int N, int G_, int c_) { nM = M / BM; nN = N / BM; nwg = nM * nN; G = G_; c = c_; }
    __host__ __device__ bool next(int i, Unit& u) const {
        const long L = (long)i * G + c; if (L >= nwg) return false;
        int wgid = (int)L; { const int q = nwg / NXCD, r = nwg % NXCD, xcd = wgid % NXCD, off = wgid / NXCD; wgid = (xcd < r ? xcd * (q + 1) : r * (q + 1) + (xcd - r) * q) + off; }
        const int nig = WGM * nN, gid = wgid / nig, fm = gid * WGM, gsz = (nM - fm) < WGM ? (nM - fm) : WGM;
        u.pm = fm + ((wgid % nig) % gsz); u.pn = (wgid % nig) / gsz; return true;
    }
};
template <class Epi, class Sched>
__device__ __forceinline__ void gemm_phase(PG8_LAS unsigned char* lds, const Gemm g, const Sched& S, const Epi& E) {
    const int tid = threadIdx.x, wid = __builtin_amdgcn_readfirstlane(tid >> 6), lane = tid & 63, wr = wid >> 2, wc = wid & 3, fr = lane & 15, fq = lane >> 4;
    const int K = g.K, nt = K / BK;
    unsigned voffA[2];
#pragma unroll
    for (int i = 0; i < 2; ++i) { int R, C; stage_rc(tid * 16 + i * 8192, R, C); voffA[i] = (unsigned)(R * K + C) * 2u; }
    const size_t kstep = (size_t)(BK * 2);
    const size_t hstep = (size_t)HALF * K * 2;
    const size_t tstep = 2 * hstep;
    const unsigned ldsw = (unsigned)wid * 1024u;
    const int aoff = lds_byte(wr * 64 + fr, fq * 8), boff = lds_byte(wc * 32 + fr, fq * 8);
#define PG8_SA(b, h) (((b) * 2 + (h)) * HTB)
#define PG8_SB(b, h) ((4 + (b) * 2 + (h)) * HTB)
#define PG8_STAGE(bufoff, gbase, voff) do { _Pragma("unroll") for (int _i = 0; _i < 2; ++_i) \
        __builtin_amdgcn_global_load_lds((const unsigned*)((const char*)(gbase) + (voff)[_i]), (PG8_LAS unsigned*)(lds + (bufoff) + ldsw + _i * 8192), 16, 0, 0); } while (0)
#define PG8_LDA(dst, b, h) do { _Pragma("unroll") for (int m = 0; m < 4; ++m) _Pragma("unroll") for (int k = 0; k < 2; ++k) dst[m][k] = *(const PG8_LAS bf16x8*)(lds + PG8_SA(b, h) + aoff + m * 2048 + k * 1024); } while (0)
#define PG8_LDB(dst, b, h) do { _Pragma("unroll") for (int n = 0; n < 2; ++n) _Pragma("unroll") for (int k = 0; k < 2; ++k) dst[n][k] = *(const PG8_LAS bf16x8*)(lds + PG8_SB(b, h) + boff + n * 2048 + k * 1024); } while (0)
#define PG8_MMA(ai, bj, At, Bt) do { __builtin_amdgcn_s_setprio(1); _Pragma("unroll") for (int m = 0; m < 4; ++m) _Pragma("unroll") for (int n = 0; n < 2; ++n) _Pragma("unroll") for (int k = 0; k < 2; ++k) \
        acc[ai][bj][m][n] = __builtin_amdgcn_mfma_f32_16x16x32_bf16(Bt[n][k], At[m][k], acc[ai][bj][m][n], 0, 0, 0); __builtin_amdgcn_s_setprio(0); } while (0)
#define PG8_WAIT_V(n) asm volatile("s_waitcnt vmcnt(" #n ")" ::: "memory")
#define PG8_WAIT_L(n) asm volatile("s_waitcnt lgkmcnt(" #n ")" ::: "memory")
#define PG8_BAR __builtin_amdgcn_s_barrier()
#define PG8_SCHED __builtin_amdgcn_sched_barrier(0)
    Unit cur, nxt; int ui = 0;
    if (!S.next(0, cur)) return;
    f32x4 acc[2][2][4][2];
#pragma unroll
    for (int a = 0; a < 2; ++a)
#pragma unroll
        for (int b = 0; b < 2; ++b)
#pragma unroll
            for (int m = 0; m < 4; ++m)
#pragma unroll
                for (int n = 0; n < 2; ++n) acc[a][b][m][n] = (f32x4){0.f, 0.f, 0.f, 0.f};
    bf16x8 At[4][2], B0[2][2], B1[2][2];
    const char* cA = (const char*)g.A + (size_t)cur.pm * tstep; const char* cB = (const char*)g.Bt + (size_t)cur.pn * tstep;
    PG8_STAGE(PG8_SB(0, 0), cB, voffA); PG8_STAGE(PG8_SA(0, 0), cA, voffA); PG8_STAGE(PG8_SB(0, 1), cB + hstep, voffA); PG8_STAGE(PG8_SA(0, 1), cA + hstep, voffA);
    if (wr == 1) PG8_BAR;
    PG8_WAIT_V(4); PG8_BAR;
    PG8_STAGE(PG8_SB(1, 0), cB + kstep, voffA); PG8_STAGE(PG8_SA(1, 0), cA + kstep, voffA); PG8_STAGE(PG8_SB(1, 1), cB + hstep + kstep, voffA);
    PG8_WAIT_V(6); PG8_BAR;
    for (;;) {
        const bool has_next = S.next(ui + 1, nxt);
        const char* nA = has_next ? (const char*)g.A + (size_t)nxt.pm * tstep : cA; const char* nB = has_next ? (const char*)g.Bt + (size_t)nxt.pn * tstep : cB;
        for (int t = 0; t < nt; t += 2) {
            const bool last = (t == nt - 2);
            const char* a1 = cA + (size_t)(t + 1) * kstep;
            const char* a2 = last ? nA : cA + (size_t)(t + 2) * kstep; const char* b2 = last ? nB : cB + (size_t)(t + 2) * kstep;
            const char* a3 = a2 + kstep; const char* b3 = b2 + kstep;
            PG8_LDB(B0, 0, 0); PG8_SCHED; PG8_LDA(At, 0, 0); PG8_STAGE(PG8_SA(1, 1), a1 + hstep, voffA);
            PG8_WAIT_L(8); PG8_BAR; PG8_WAIT_L(0); PG8_MMA(0, 0, At, B0); PG8_BAR; PG8_SCHED;
            PG8_LDB(B1, 0, 1); PG8_STAGE(PG8_SB(0, 0), b2, voffA);
            PG8_BAR; PG8_WAIT_L(0); PG8_MMA(0, 1, At, B1); PG8_BAR;
            PG8_LDA(At, 0, 1); PG8_STAGE(PG8_SA(0, 0), a2, voffA);
            PG8_BAR; PG8_WAIT_L(0); PG8_MMA(1, 0, At, B0); PG8_BAR; PG8_SCHED;
            PG8_STAGE(PG8_SB(0, 1), b2 + hstep, voffA);
            PG8_WAIT_V(6); PG8_BAR; PG8_MMA(1, 1, At, B1); PG8_BAR;
            PG8_LDB(B0, 1, 0); PG8_SCHED; PG8_LDA(At, 1, 0); PG8_STAGE(PG8_SA(0, 1), a2 + hstep, voffA);
            PG8_WAIT_L(8); PG8_BAR; PG8_WAIT_L(0); PG8_MMA(0, 0, At, B0); PG8_BAR; PG8_SCHED;
            PG8_LDB(B1, 1, 1); PG8_STAGE(PG8_SB(1, 0), b3, voffA);
            PG8_BAR; PG8_WAIT_L(0); PG8_MMA(0, 1, At, B1); PG8_BAR;
            PG8_LDA(At, 1, 1); PG8_STAGE(PG8_SA(1, 0), a3, voffA);
            PG8_BAR; PG8_WAIT_L(0); PG8_MMA(1, 0, At, B0); PG8_BAR; PG8_SCHED;
            PG8_STAGE(PG8_SB(1, 1), b3 + hstep, voffA);
            PG8_WAIT_V(6); PG8_BAR; PG8_MMA(1, 1, At, B1); PG8_BAR;
        }
        E(acc, cur, wr, wc, fr, fq);
        if (!has_next) break;
#pragma unroll
        for (int a = 0; a < 2; ++a)
#pragma unroll
            for (int b = 0; b < 2; ++b)
#pragma unroll
                for (int m = 0; m < 4; ++m)
#pragma unroll
                    for (int n = 0; n < 2; ++n) acc[a][b][m][n] = (f32x4){0.f, 0.f, 0.f, 0.f};
        cur = nxt; cA = nA; cB = nB; ++ui;
    }
    PG8_WAIT_V(0);
    if (wr == 0) PG8_BAR;
    PG8_BAR;
#undef PG8_SA
#undef PG8_SB
#undef PG8_STAGE
#undef PG8_LDA
#undef PG8_LDB
#undef PG8_MMA
#undef PG8_WAIT_V
#undef PG8_WAIT_L
#undef PG8_BAR
#undef PG8_SCHED
}
template <class Pol, class Epi>
__device__ __forceinline__ void gemm_phase2(PG8_LAS unsigned char* lds, const Pol& P, const Epi& E) {
    const int tid = threadIdx.x, wid = __builtin_amdgcn_readfirstlane(tid >> 6), lane = tid & 63, wr = wid >> 2, wc = wid & 3, fr = lane & 15, fq = lane >> 4;
    const int nt = P.nk();
    int R[2], C[2];
#pragma unroll
    for (int i = 0; i < 2; ++i) stage_rc(tid * 16 + i * 8192, R[i], C[i]);
    const unsigned ldsw = (unsigned)wid * 1024u;
    const int aoff = lds_byte(wr * 64 + fr, fq * 8), boff = lds_byte(wc * 32 + fr, fq * 8);
#define PG8_SA(b, h) (((b) * 2 + (h)) * HTB)
#define PG8_SB(b, h) ((4 + (b) * 2 + (h)) * HTB)
#define PG8_STAGE_A(bufoff, AS, h, kt) do { _Pragma("unroll") for (int _i = 0; _i < 2; ++_i) \
        __builtin_amdgcn_global_load_lds((const unsigned*)P.pa(AS, h, _i, kt), (PG8_LAS unsigned*)(lds + (bufoff) + ldsw + _i * 8192), 16, 0, 0); } while (0)
#define PG8_STAGE_B(bufoff, BS, h, kt) do { _Pragma("unroll") for (int _i = 0; _i < 2; ++_i) \
        __builtin_amdgcn_global_load_lds((const unsigned*)P.pb(BS, h, _i, kt), (PG8_LAS unsigned*)(lds + (bufoff) + ldsw + _i * 8192), 16, 0, 0); } while (0)
#define PG8_LDA(dst, b, h) do { _Pragma("unroll") for (int m = 0; m < 4; ++m) _Pragma("unroll") for (int k = 0; k < 2; ++k) dst[m][k] = *(const PG8_LAS bf16x8*)(lds + PG8_SA(b, h) + aoff + m * 2048 + k * 1024); } while (0)
#define PG8_LDB(dst, b, h) do { _Pragma("unroll") for (int n = 0; n < 2; ++n) _Pragma("unroll") for (int k = 0; k < 2; ++k) dst[n][k] = *(const PG8_LAS bf16x8*)(lds + PG8_SB(b, h) + boff + n * 2048 + k * 1024); } while (0)
#define PG8_MMA(ai, bj, At, Bt) do { __builtin_amdgcn_s_setprio(1); _Pragma("unroll") for (int m = 0; m < 4; ++m) _Pragma("unroll") for (int n = 0; n < 2; ++n) _Pragma("unroll") for (int k = 0; k < 2; ++k) \
        acc[ai][bj][m][n] = __builtin_amdgcn_mfma_f32_16x16x32_bf16(Bt[n][k], At[m][k], acc[ai][bj][m][n], 0, 0, 0); __builtin_amdgcn_s_setprio(0); } while (0)
#define PG8_WAIT_V(n) asm volatile("s_waitcnt vmcnt(" #n ")" ::: "memory")
#define PG8_WAIT_L(n) asm volatile("s_waitcnt lgkmcnt(" #n ")" ::: "memory")
#define PG8_BAR __builtin_amdgcn_s_barrier()
#define PG8_SCHED __builtin_amdgcn_sched_barrier(0)
    typename Pol::Unit cur, nxt; int ui = 0;
    if (!P.next(0, cur)) return;
    f32x4 acc[2][2][4][2];
#pragma unroll
    for (int a = 0; a < 2; ++a)
#pragma unroll
        for (int b = 0; b < 2; ++b)
#pragma unroll
            for (int m = 0; m < 4; ++m)
#pragma unroll
                for (int n = 0; n < 2; ++n) acc[a][b][m][n] = (f32x4){0.f, 0.f, 0.f, 0.f};
    bf16x8 At[4][2], B0[2][2], B1[2][2];
    typename Pol::AddrA aC, aN; typename Pol::AddrB bC, bN;
    P.addrA(cur, R, C, aC); P.addrB(cur, R, C, bC);
    PG8_STAGE_B(PG8_SB(0, 0), bC, 0, 0); PG8_STAGE_A(PG8_SA(0, 0), aC, 0, 0); PG8_STAGE_B(PG8_SB(0, 1), bC, 1, 0); PG8_STAGE_A(PG8_SA(0, 1), aC, 1, 0);
    if (wr == 1) PG8_BAR;
    PG8_WAIT_V(4); PG8_BAR;
    PG8_STAGE_B(PG8_SB(1, 0), bC, 0, 1); PG8_STAGE_A(PG8_SA(1, 0), aC, 0, 1); PG8_STAGE_B(PG8_SB(1, 1), bC, 1, 1);
    PG8_WAIT_V(6); PG8_BAR;
    for (;;) {
        const bool has_next = P.next(ui + 1, nxt);
        if (has_next) { P.addrA(nxt, R, C, aN); P.addrB(nxt, R, C, bN); } else { aN = aC; bN = bC; }
        const bool full = P.full(cur);
        for (int t = 0; t < nt; t += 2) {
            const bool last = (t == nt - 2);
            const typename Pol::AddrA a2 = last ? aN : aC; const typename Pol::AddrB b2 = last ? bN : bC;
            const int k2 = last ? 0 : t + 2, k3 = k2 + 1;
            PG8_LDB(B0, 0, 0); PG8_SCHED; PG8_LDA(At, 0, 0); PG8_STAGE_A(PG8_SA(1, 1), aC, 1, t + 1);
            PG8_WAIT_L(8); PG8_BAR; PG8_WAIT_L(0); PG8_MMA(0, 0, At, B0); PG8_BAR; PG8_SCHED;
            PG8_LDB(B1, 0, 1); PG8_STAGE_B(PG8_SB(0, 0), b2, 0, k2);
            PG8_BAR; PG8_WAIT_L(0); PG8_MMA(0, 1, At, B1); PG8_BAR;
            PG8_LDA(At, 0, 1); PG8_STAGE_A(PG8_SA(0, 0), a2, 0, k2);
            PG8_BAR; PG8_WAIT_L(0); if (full) PG8_MMA(1, 0, At, B0); PG8_BAR; PG8_SCHED;
            PG8_STAGE_B(PG8_SB(0, 1), b2, 1, k2);
            PG8_WAIT_V(6); PG8_BAR; if (full) PG8_MMA(1, 1, At, B1); PG8_BAR;
            PG8_LDB(B0, 1, 0); PG8_SCHED; PG8_LDA(At, 1, 0); PG8_STAGE_A(PG8_SA(0, 1), a2, 1, k2);
            PG8_WAIT_L(8); PG8_BAR; PG8_WAIT_L(0); PG8_MMA(0, 0, At, B0); PG8_BAR; PG8_SCHED;
            PG8_LDB(B1, 1, 1); PG8_STAGE_B(PG8_SB(1, 0), b2, 0, k3);
            PG8_BAR; PG8_WAIT_L(0); PG8_MMA(0, 1, At, B1); PG8_BAR;
            PG8_LDA(At, 1, 1); PG8_STAGE_A(PG8_SA(1, 0), a2, 0, k3);
            PG8_BAR; PG8_WAIT_L(0); if (full) PG8_MMA(1, 0, At, B0); PG8_BAR; PG8_SCHED;
            PG8_STAGE_B(PG8_SB(1, 1), b2, 1, k3);
            PG8_WAIT_V(6); PG8_BAR; if (full) PG8_MMA(1, 1, At, B1); PG8_BAR;
        }
        E(acc, cur, wr, wc, fr, fq);
        if (!has_next) break;
#pragma unroll
        for (int a = 0; a < 2; ++a)
#pragma unroll
            for (int b = 0; b < 2; ++b)
#pragma unroll
                for (int m = 0; m < 4; ++m)
#pragma unroll
                    for (int n = 0; n < 2; ++n) acc[a][b][m][n] = (f32x4){0.f, 0.f, 0.f, 0.f};
        cur = nxt; aC = aN; bC = bN; ++ui;
    }
    PG8_WAIT_V(0);
    if (wr == 0) PG8_BAR;
    PG8_BAR;
#undef PG8_SA
#undef PG8_SB
#undef PG8_STAGE_A
#undef PG8_STAGE_B
#undef PG8_LDA
#undef PG8_LDB
#undef PG8_MMA
#undef PG8_WAIT_V
#undef PG8_WAIT_L
#undef PG8_BAR
#undef PG8_SCHED
}
__host__ __device__ __forceinline__ int logcol(int p) { return (p & ~255) + 64 * ((p >> 5) & 3) + 32 * ((p >> 7) & 1) + (p & 31); }
}

template <class SRC>
DEV void convert_tile(float* tl, const SRC& src, bf16_t* dst, int ldd, int n0, int k0) {
    const int tid = threadIdx.x;
    {
        const int n = tid & 63;
#pragma unroll
        for (int i = 0; i < 8; ++i) { const int kk = (tid >> 6) + 8 * i; tl[kk * 65 + n] = src.get(n0 + n, k0 + kk); }
    }
    __syncthreads();
    {
        const int n = tid >> 3, kc = tid & 7;
        const float* s = tl + (kc * 8) * 65 + n;
        u32x4 o;
        o.x = pk2(s[0 * 65], s[1 * 65]); o.y = pk2(s[2 * 65], s[3 * 65]); o.z = pk2(s[4 * 65], s[5 * 65]); o.w = pk2(s[6 * 65], s[7 * 65]);
        *(u32x4*)(dst + (size_t)(n0 + n) * ldd + k0 + kc * 8) = o;
    }
    __syncthreads();
}
struct SrcWin { const float* w; const float* g;
    DEV float get(int np, int k) const { const int n = pg8::logcol(np); int col; if (n < 1280) col = n; else if (n < 3328) col = n + 24; else if (n < 3352) col = 1280 + (n - 3328); else return 0.f;
        return w[(size_t)k * IN_COLS + col] * g[k]; } };
struct SrcWout { const float* w; const float* g;
    DEV float get(int np, int k) const { const int n = pg8::logcol(np); const float v = w[(size_t)k * DM + n]; return k < 512 ? v * g[k] : v; } };
struct SrcPlain { const float* w; int ld;
    DEV float get(int n, int k) const { return w[(size_t)k * ld + n]; } };
struct SrcW13 { const float* w1; const float* w3; const float* g;
    DEV float get(int n, int k) const { const uintptr_t a = (uintptr_t)w1, b = (uintptr_t)w3; const float* w = (const float*)(a + ((b - a) & (uintptr_t)(0 - (long long)(n & 1))));
        return w[(size_t)k * 512 + (n >> 1)] * g[k]; } };

template <class SRC>
DEV void convert_tile256(float* tl, const SRC& src, bf16_t* dst, int ldd, int n0, int k0) {
    const int tid = threadIdx.x;
    {
        const int q = tid & 63;
        f32x4 v[8];
#pragma unroll
        for (int i = 0; i < 8; ++i) v[i] = src.quad(n0, q, k0 + (tid >> 6) + 8 * i);
#pragma unroll
        for (int i = 0; i < 8; ++i) { float* o = tl + ((tid >> 6) + 8 * i) * 257; o[src.drow(q, 0)] = v[i].x; o[src.drow(q, 1)] = v[i].y; o[src.drow(q, 2)] = v[i].z; o[src.drow(q, 3)] = v[i].w; }
    }
    __syncthreads();
#pragma unroll
    for (int i = 0; i < 4; ++i) {
        const int idx = tid + NT * i, n = idx >> 3, kc = idx & 7;
        const float* s = tl + (kc * 8) * 257 + n;
        u32x4 o;
        o.x = pk2(s[0 * 257], s[1 * 257]); o.y = pk2(s[2 * 257], s[3 * 257]); o.z = pk2(s[4 * 257], s[5 * 257]); o.w = pk2(s[6 * 257], s[7 * 257]);
        *(u32x4*)(dst + (size_t)(n0 + n) * ldd + k0 + kc * 8) = o;
    }
    __syncthreads();
}
struct SrcWin4 { const float* w; const float* g;
    DEV int drow(int q, int e) const { return 4 * q + e; }
    DEV f32x4 quad(int n0, int q, int k) const { const int n = pg8::logcol(n0 + 4 * q); int col; if (n < 1280) col = n; else if (n < 3328) col = n + 24; else if (n < 3352) col = 1280 + (n - 3328); else return (f32x4){0.f, 0.f, 0.f, 0.f};
        return *(const f32x4*)(w + (size_t)k * IN_COLS + col) * g[k]; } };
struct SrcWout4 { const float* w; const float* g;
    DEV int drow(int q, int e) const { return 4 * q + e; }
    DEV f32x4 quad(int n0, int q, int k) const { const f32x4 v = *(const f32x4*)(w + (size_t)k * DM + pg8::logcol(n0 + 4 * q)); return k < 512 ? v * g[k] : v; } };
struct SrcPlain4 { const float* w; int ld;
    DEV int drow(int q, int e) const { return 4 * q + e; }
    DEV f32x4 quad(int n0, int q, int k) const { return *(const f32x4*)(w + (size_t)k * ld + n0 + 4 * q); } };
struct SrcW13_4 { const float* w1; const float* w3; const float* g;
    DEV int drow(int q, int e) const { return 8 * (q & 31) + 2 * e + (q >> 5); }
    DEV f32x4 quad(int n0, int q, int k) const { const uintptr_t a = (uintptr_t)w1, b = (uintptr_t)w3; const float* w = (const float*)(a + ((b - a) & (uintptr_t)(0 - (long long)(q >> 5))));
        return *(const f32x4*)(w + (size_t)k * 512 + (n0 >> 1) + 4 * (q & 31)) * g[k]; } };

DEV void phase_prologue(const Params& p, unsigned char* lds) {
    float* tl = (float*)lds;
    const int tid = threadIdx.x, lane = tid & 63, wid = tid >> 6;
    const int vb = vblock(), G = gridDim.x;
    unsigned char* ws = p.ws;
    constexpr int I_WIN = (INP / 256) * (DM / 64);
    constexpr int I_WOUT = 4 * 16;
    constexpr int I_CW1 = 2 * 32;
    constexpr int I_W2 = 32 * 4 * 8;
    constexpr int I_CW2 = 2 * 1 * 4;
    constexpr int I_ALL = I_WIN + I_WOUT + I_CW1 + I_W2 + I_CW2;
    for (int it = vb; it < I_ALL; it += G) {
        int r = it;
        if (r < I_WIN) { SrcWin4 s{p.w_in, p.attn_g}; convert_tile256(tl, s, (bf16_t*)(ws + WS_WINT), DM, (r / 16) * 256, (r % 16) * 64); continue; } r -= I_WIN;
        if (r < I_WOUT) { SrcWout4 s{p.w_out, p.g_nsa}; convert_tile256(tl, s, (bf16_t*)(ws + WS_WOUTT), DM, (r / 16) * 256, (r % 16) * 64); continue; } r -= I_WOUT;
        if (r < I_CW1) { const int z = r / 32, q = r % 32; SrcPlain4 s{z ? p.wv1 : p.wk1, 256};
            convert_tile256(tl, s, (bf16_t*)(ws + WS_CW1T) + (size_t)z * 256 * 2048, 2048, 0, q * 64); continue; } r -= I_CW1;
        if (r < I_W2) { const int e = r / 32, q = r % 32; SrcPlain4 s{p.w2 + (size_t)e * 512 * 1024, 1024};
            convert_tile256(tl, s, (bf16_t*)(ws + WS_W2T) + (size_t)e * 1024 * 512, 512, (q / 8) * 256, (q % 8) * 64); continue; } r -= I_W2;
        { const int z = r / 4, q = r % 4; SrcPlain s{z ? p.wv2 : p.wk2, 64};
            convert_tile(tl, s, (bf16_t*)(ws + WS_CW2T) + (size_t)z * 64 * 256, 256, 0, q * 64); }
    }
    {
        bf16_t* xb = (bf16_t*)(ws + WS_R1); float* rstd1 = (float*)(ws + WS_RSTD1);
        const int gw = vb * 8 + wid, NGW = G * 8;
        for (int m = gw; m < NTOK; m += NGW) {
            const f32x4* xr = (const f32x4*)(p.x + (size_t)m * DM) + lane;
            f32x4 v[4]; float s = 0.f;
#pragma unroll
            for (int j = 0; j < 4; ++j) { v[j] = xr[64 * j]; s += (v[j].x * v[j].x + v[j].y * v[j].y) + (v[j].z * v[j].z + v[j].w * v[j].w); }
            s = wave_sum(s);
            if (lane == 0) rstd1[m] = rsqrtf(s * (1.f / DM) + RMS_EPS);
            u32x2* o = (u32x2*)(xb + (size_t)m * DM) + lane;
#pragma unroll
            for (int j = 0; j < 4; ++j) { u32x2 w; w.x = pk2(v[j].x, v[j].y); w.y = pk2(v[j].z, v[j].w); o[64 * j] = w; }
        }
    }
    {
        const int gt = vb * NT + tid, NG = G * NT;
        float* rowss = (float*)(ws + WS_ROWSS);
        for (int i = gt; i < NTOK; i += NG) rowss[i] = 0.f;
        int* bincnt = (int*)(ws + WS_CTL);
        if (gt < 128) bincnt[gt] = 0;
        if (gt < 512) { const float l0 = p.lb_logits[gt], l1 = p.lb_logits[512 + gt]; ((float*)(ws + WS_LB))[gt] = 1.f / (1.f + __expf(l1 - l0)); }
        for (int i = gt; i < 48 * 1024; i += NG) { const int c = i >> 10, k = i & 1023;
            const float w = (c < 4 ? p.w_group[k * 4 + c] : (c < 36 ? p.w_expert[k * 32 + (c - 4)] : 0.f)) * p.ffn_g[k];
            const bf16_t hi = f2bf(w); const bf16_t lo = f2bf(w - bf2f(hi));
            ((bf16_t*)(ws + WS_RW))[i] = hi; ((bf16_t*)(ws + WS_RW))[48 * 1024 + i] = lo; }
        if (blockIdx.x == (unsigned)(G - 1)) {
            const int z = tid >> 8, j = tid & 255; const float* pos = z ? p.pos_v : p.pos_k; const float* w = z ? p.wv1 : p.wk1;
            float a = 0.f;
            for (int k = 0; k < 2048; ++k) a += pos[k] * w[(size_t)k * 256 + j];
            ((float*)(ws + WS_CBIAS))[z * 256 + j] = a;
        }
    }
}

constexpr int G_A_BYTES = 128 * 128, G_B_BYTES = 256 * 128, G_STAGE = G_A_BYTES + G_B_BYTES, G_LDS = 2 * G_STAGE;
DEV int swz(int row, int chunk) { return row * 128 + ((chunk ^ ((row >> 1) & 7)) << 4); }
template <class AL, class BL, class EP>
DEV void gemm_tile(unsigned char* lds, const AL& al, const BL& bl, int nk, const EP& ep) {
    const int tid = threadIdx.x, lane = tid & 63, wid = tid >> 6, wr = wid >> 2, wc = wid & 3;
    const int frow = lane & 15, fq = lane >> 4;
    const bf16_t* aptr[2]; int aoff[2], boff[4], brow[4];
#pragma unroll
    for (int i = 0; i < 2; ++i) { const int q = tid + NT * i, row = q >> 3, ch = q & 7; aptr[i] = al.row(row) + ch * 8; aoff[i] = swz(row, ch); }
#pragma unroll
    for (int i = 0; i < 4; ++i) { const int q = tid + NT * i, row = q >> 3, ch = q & 7; brow[i] = row; boff[i] = G_A_BYTES + swz(row, ch) ; }
    const int bch8 = (tid & 7) * 8;
    u32x4 ra[2], rb[4];
#pragma unroll
    for (int i = 0; i < 2; ++i) ra[i] = *(const u32x4*)(aptr[i]);
#pragma unroll
    for (int i = 0; i < 4; ++i) rb[i] = *(const u32x4*)(bl.ptr(brow[i], 0) + bch8);
#pragma unroll
    for (int i = 0; i < 2; ++i) *(u32x4*)(lds + aoff[i]) = ra[i];
#pragma unroll
    for (int i = 0; i < 4; ++i) *(u32x4*)(lds + boff[i]) = rb[i];
    __syncthreads();
    f32x4 acc[4][4];
#pragma unroll
    for (int m = 0; m < 4; ++m)
#pragma unroll
        for (int n = 0; n < 4; ++n) acc[m][n] = (f32x4){0.f, 0.f, 0.f, 0.f};
    const int sx = (frow >> 1) & 7;
    for (int kt = 0; kt < nk; ++kt) {
        const bool more = (kt + 1 < nk);
        if (more) {
#pragma unroll
            for (int i = 0; i < 2; ++i) ra[i] = *(const u32x4*)(aptr[i] + (kt + 1) * 64);
#pragma unroll
            for (int i = 0; i < 4; ++i) rb[i] = *(const u32x4*)(bl.ptr(brow[i], kt + 1) + bch8);
        }
        const unsigned char* base = lds + (kt & 1) * G_STAGE;
#pragma unroll
        for (int ks = 0; ks < 2; ++ks) {
            const int co = ((ks * 4 + fq) ^ sx) << 4;
            bf16x8 af[4], bfr[4];
#pragma unroll
            for (int m = 0; m < 4; ++m) af[m] = *(const bf16x8*)(base + (wr * 64 + m * 16 + frow) * 128 + co);
#pragma unroll
            for (int n = 0; n < 4; ++n) bfr[n] = *(const bf16x8*)(base + G_A_BYTES + (wc * 64 + n * 16 + frow) * 128 + co);
#pragma unroll
            for (int m = 0; m < 4; ++m)
#pragma unroll
                for (int n = 0; n < 4; ++n) acc[m][n] = __builtin_amdgcn_mfma_f32_16x16x32_bf16(bfr[n], af[m], acc[m][n], 0, 0, 0);
        }
        if (more) {
            unsigned char* nb = lds + ((kt + 1) & 1) * G_STAGE;
#pragma unroll
            for (int i = 0; i < 2; ++i) *(u32x4*)(nb + aoff[i]) = ra[i];
#pragma unroll
            for (int i = 0; i < 4; ++i) *(u32x4*)(nb + boff[i]) = rb[i];
        }
        __syncthreads();
    }
    ep(acc, wr, wc, lane);
}

struct ARows { const bf16_t* base; size_t ld; DEV const bf16_t* row(int r) const { return base + (size_t)r * ld; } };
struct BRows { const bf16_t* base; size_t ld; DEV const bf16_t* ptr(int n, int kt) const { return base + (size_t)n * ld + kt * 64; } };

DEV void inproj_row(const Params& p, int seg, int row, f32x4 (&v)[4], int fq) {
    unsigned char* ws = p.ws;
    const float rs = ((const float*)(ws + WS_RSTD1))[row];
#pragma unroll
    for (int n = 0; n < 4; ++n) v[n] = v[n] * rs;
    const int b = row >> 12, s = row & 4095;
    const bool is_q = seg < 8, is_ks = (seg == 12 || seg == 13), is_kw = (seg == 16 || seg == 17);
    if (is_q || is_ks || is_kw) {
        const float* gw = is_q ? p.g_q : (is_ks ? p.g_k + 64 : p.g_k + 128);
        bf16_t* dst; int hh, nh;
        if (is_q) { dst = (bf16_t*)(ws + WS_Q); hh = seg; nh = 8; } else if (is_ks) { dst = (bf16_t*)(ws + WS_KS); hh = seg - 12; nh = 2; } else { dst = (bf16_t*)(ws + WS_KW); hh = seg - 16; nh = 2; }
        float ss = 0.f;
#pragma unroll
        for (int n = 0; n < 4; ++n) ss += (v[n].x * v[n].x + v[n].y * v[n].y) + (v[n].z * v[n].z + v[n].w * v[n].w);
        ss += __shfl_xor(ss, 16); ss += __shfl_xor(ss, 32);
        float r = rsqrtf(ss * (1.f / 64.f) + RMS_EPS); if (is_q) r *= QSCALE;
        bf16_t* o = dst + ((size_t)(b * nh + hh) * SEQ + s) * 64 + fq * 4;
#pragma unroll
        for (int n = 0; n < 4; ++n) { const f32x4 g = *(const f32x4*)(gw + n * 16 + fq * 4); const f32x4 x = v[n] * g * r; u32x2 w; w.x = pk2(x.x, x.y); w.y = pk2(x.z, x.w); *(u32x2*)(o + n * 16) = w; }
        return;
    }
    if (seg >= 8 && seg < 12) {
        bf16_t* o = (bf16_t*)(ws + (seg < 10 ? WS_KC : WS_VC)) + ((size_t)(b * 2 + (seg & 1)) * SEQ + s) * 64 + fq * 4;
#pragma unroll
        for (int n = 0; n < 4; ++n) { u32x2 w; w.x = pk2(v[n].x, v[n].y); w.y = pk2(v[n].z, v[n].w); *(u32x2*)(o + n * 16) = w; }
        return;
    }
    if (seg == 14 || seg == 15 || seg == 18 || seg == 19) {
        bf16_t* o = (bf16_t*)(ws + (seg < 16 ? WS_VST : WS_VWT)) + (size_t)(b * 2 + (seg & 1)) * 64 * SEQ + s;
#pragma unroll
        for (int n = 0; n < 4; ++n) { const int d = n * 16 + fq * 4;
            o[(size_t)(d + 0) * SEQ] = f2bf(v[n].x); o[(size_t)(d + 1) * SEQ] = f2bf(v[n].y); o[(size_t)(d + 2) * SEQ] = f2bf(v[n].z); o[(size_t)(d + 3) * SEQ] = f2bf(v[n].w); }
        return;
    }
    if (seg < 52) {
        const int kind = (seg - 20) >> 3, cb = ((seg - 20) & 7) * 64 + fq * 4;
        if (kind == 1) {
            const float* lb = (const float*)(ws + WS_LB); float* dst = (float*)(ws + WS_HLOGF) + (size_t)row * 512;
#pragma unroll
            for (int n = 0; n < 4; ++n) { const int c = cb + n * 16; const f32x4 l = *(const f32x4*)(lb + c); f32x4 o;
                o.x = __logf(l.x + (1.f - l.x) * sigmoidf_(v[n].x)); o.y = __logf(l.y + (1.f - l.y) * sigmoidf_(v[n].y));
                o.z = __logf(l.z + (1.f - l.z) * sigmoidf_(v[n].z)); o.w = __logf(l.w + (1.f - l.w) * sigmoidf_(v[n].w));
                *(f32x4*)(dst + c) = o; }
        } else {
            bf16_t* dst = (bf16_t*)(ws + (kind == 0 ? WS_HQ : (kind == 2 ? WS_HV : WS_HG))) + (size_t)row * 512 + cb;
#pragma unroll
            for (int n = 0; n < 4; ++n) { f32x4 x = v[n];
                if (kind != 2) { x.x = siluf_(x.x); x.y = siluf_(x.y); x.z = siluf_(x.z); x.w = siluf_(x.w); }
                u32x2 w; w.x = pk2(x.x, x.y); w.y = pk2(x.z, x.w); *(u32x2*)(dst + n * 16) = w; }
        }
        return;
    }
    {
        float* dst = (float*)(ws + WS_GATES) + (size_t)row * 24;
#pragma unroll
        for (int n = 0; n < 2; ++n) { const int c = n * 16 + fq * 4; if (c < 24) { f32x4 o; o.x = sigmoidf_(v[n].x); o.y = sigmoidf_(v[n].y); o.z = sigmoidf_(v[n].z); o.w = sigmoidf_(v[n].w); *(f32x4*)(dst + c) = o; } }
    }
}
struct EpiInproj8 { const Params& p;
    DEV void operator()(const f32x4 (&acc)[2][2][4][2], const pg8::Unit& u, int wr, int wc, int fr, int fq) const {
        const int seg = u.pn * 4 + wc;
        if (seg > 52) return;
#pragma unroll
        for (int ai = 0; ai < 2; ++ai)
#pragma unroll
            for (int m = 0; m < 4; ++m) { f32x4 v[4] = {acc[ai][0][m][0], acc[ai][0][m][1], acc[ai][1][m][0], acc[ai][1][m][1]};
                inproj_row(p, seg, u.pm * 256 + ai * 128 + wr * 64 + m * 16 + fr, v, fq); }
    } };
DEV void phase_inproj(const Params& p, unsigned char* lds) {
    pg8::Gemm g{(const bf16_t*)(p.ws + WS_R1), (const bf16_t*)(p.ws + WS_WINT), NTOK, INP, DM};
    pg8::StaticOrder S; S.init(NTOK, INP, (int)gridDim.x, (int)blockIdx.x);
    EpiInproj8 E{p};
    pg8::gemm_phase(( PG8_LAS unsigned char*)lds, g, S, E);
}

struct ACmp { const bf16_t* src; int bg, c0;
    DEV const bf16_t* row(int r) const { int c = c0 + r; if (c > NC - 1) c = NC - 1; return src + ((size_t)bg * SEQ + 16 * c) * 64; } };
struct EpiCmpA { const Params& p; int z, rbase;
    DEV void operator()(f32x4 (&acc)[4][4], int wr, int wc, int lane) const {
        const int frow = lane & 15, fq = lane >> 4;
        const float* cb = (const float*)(p.ws + WS_CBIAS) + z * 256; bf16_t* hid = (bf16_t*)(p.ws + WS_HID) + (size_t)z * 4096 * 256;
#pragma unroll
        for (int m = 0; m < 4; ++m) { const int rr = rbase + wr * 64 + m * 16 + frow;
#pragma unroll
            for (int n = 0; n < 4; ++n) { const int c = wc * 64 + n * 16 + fq * 4; const f32x4 b = *(const f32x4*)(cb + c); f32x4 v = acc[m][n] + b;
                u32x2 w; w.x = pk2(siluf_(v.x), siluf_(v.y)); w.y = pk2(siluf_(v.z), siluf_(v.w)); *(u32x2*)(hid + (size_t)rr * 256 + c) = w; } }
    } };
DEV void phase_cmp_a(const Params& p, unsigned char* lds) {
    const int vb = vblock(), G = gridDim.x;
    for (int u = vb; u < 64; u += G) {
        const int z = u >> 5, rbase = (u & 31) * 128;
        ACmp al{(const bf16_t*)(p.ws + (z ? WS_VC : WS_KC)), (u & 31) >> 1, (u & 1) * 128};
        BRows bl{(const bf16_t*)(p.ws + WS_CW1T) + (size_t)z * 256 * 2048, 2048};
        EpiCmpA ep{p, z, rbase};
        gemm_tile(lds, al, bl, 2048 / 64, ep);
    }
}
struct BClamp64 { const bf16_t* base; size_t ld; DEV const bf16_t* ptr(int n, int kt) const { return base + (size_t)(n & 63) * ld + kt * 64; } };
struct EpiCmpB { const Params& p; int z, rbase;
    DEV void operator()(f32x4 (&acc)[4][4], int wr, int wc, int lane) const {
        if (wc != 0) return;
        const int frow = lane & 15, fq = lane >> 4;
        bf16_t* dst = (bf16_t*)(p.ws + (z ? WS_VCMP : WS_KCMP));
#pragma unroll
        for (int m = 0; m < 4; ++m) { const int rr = rbase + wr * 64 + m * 16 + frow;
            float r = 1.f;
            if (z == 0) { float ss = 0.f;
#pragma unroll
                for (int n = 0; n < 4; ++n) { const f32x4 v = acc[m][n]; ss += (v.x * v.x + v.y * v.y) + (v.z * v.z + v.w * v.w); }
                ss += __shfl_xor(ss, 16); ss += __shfl_xor(ss, 32); r = rsqrtf(ss * (1.f / 64.f) + RMS_EPS); }
            const int bg = rr >> 8, c = rr & 255;
            if (c < NC) {
#pragma unroll
                for (int n = 0; n < 4; ++n) { const int d = n * 16 + fq * 4; f32x4 v = acc[m][n] * r;
                    if (z == 0) { const f32x4 g = *(const f32x4*)(p.g_k + d); v = v * g;
                        u32x2 w; w.x = pk2(v.x, v.y); w.y = pk2(v.z, v.w); *(u32x2*)(dst + ((size_t)bg * 256 + c) * 64 + d) = w; }
                    else { bf16_t* o = dst + ((size_t)bg * 64 + d) * 256 + c; o[0] = f2bf(v.x); o[256] = f2bf(v.y); o[512] = f2bf(v.z); o[768] = f2bf(v.w); } } }
        }
    } };
DEV void phase_cmp_b(const Params& p, unsigned char* lds) {
    const int vb = vblock(), G = gridDim.x;
    for (int u = vb; u < 64; u += G) {
        const int z = u >> 5, rbase = (u & 31) * 128;
        ARows al{(const bf16_t*)(p.ws + WS_HID) + ((size_t)z * 4096 + rbase) * 256, 256};
        BClamp64 bl{(const bf16_t*)(p.ws + WS_CW2T) + (size_t)z * 64 * 256, 256};
        EpiCmpB ep{p, z, rbase};
        gemm_tile(lds, al, bl, 256 / 64, ep);
    }
}

constexpr int CM_K = 0, CM_V = 32768, CM_VSTR = 520, CM_IMP = CM_V + 64 * CM_VSTR, CM_LDS = CM_IMP + 4 * 16384;
DEV void cm_scores(const unsigned char* kbase, int kt, const bf16x8 (&qf)[4], int r31, int hh, f32x16 (&sacc)[2]) {
#pragma unroll
    for (int kt2 = 0; kt2 < 2; ++kt2) {
#pragma unroll
        for (int i = 0; i < 16; ++i) sacc[kt2][i] = 0.f;
        const int row = 64 * kt + 32 * kt2 + r31; const int sx = (row >> 1) & 7;
#pragma unroll
        for (int s = 0; s < 4; ++s) { const bf16x8 kf = *(const bf16x8*)(kbase + row * 128 + (((2 * s + hh) ^ sx) << 4));
            sacc[kt2] = __builtin_amdgcn_mfma_f32_32x32x16_bf16(kf, qf[s], sacc[kt2], 0, 0, 0); }
    }
}
DEV void phase_cmp_attn(const Params& p, unsigned char* lds) {
    const int tid = threadIdx.x, lane = tid & 63, wid = tid >> 6;
    const int vb = vblock(), G = gridDim.x;
    unsigned char* ws = p.ws;
    const int r31 = lane & 31, hh = lane >> 5;
    float* impl = (float*)(lds + CM_IMP);
    for (int it = vb; it < 1024; it += G) {
        const int rnd = it / G, pos = it % G; int sidx = (rnd & 1) ? (rnd * G + (G - 1 - pos)) : (rnd * G + pos); if (G != 256) sidx = it;
        const int ci = 63 - (sidx >> 4), bg = sidx & 15, b = bg >> 1, g = bg & 1;
        const int nvis = min(NC, 4 * ci + 3), ntile = (nvis + 63) >> 6;
        const int head = g * 4 + (wid >> 1);
        const int tokl = (wid & 1) * 32 + r31, t = ci * 64 + tokl;
        const size_t tok = (size_t)b * SEQ + t;
        const int nv = t >= 31 ? min(NC, (t - 31) / 16 + 1) : 0;
        __syncthreads();
        {
            const bf16_t* kc = (const bf16_t*)(ws + WS_KCMP) + (size_t)bg * 256 * 64; const bf16_t* vt = (const bf16_t*)(ws + WS_VCMP) + (size_t)bg * 64 * 256;
            const int cpr = ntile * 8;
            u32x4 rk[4], rv[4];
#pragma unroll
            for (int i = 0; i < 4; ++i) if (i < ntile) { const int idx = tid + NT * i; rk[i] = *(const u32x4*)(kc + (idx >> 3) * 64 + (idx & 7) * 8); const int d = idx / cpr, ck = idx % cpr; rv[i] = *(const u32x4*)(vt + d * 256 + ck * 8); }
#pragma unroll
            for (int i = 0; i < 4; ++i) if (i < ntile) { const int idx = tid + NT * i; *(u32x4*)(lds + CM_K + swz(idx >> 3, idx & 7)) = rk[i];
                const int d = idx / cpr, ck = idx % cpr; u32x2 a, c2; a.x = rv[i].x; a.y = rv[i].y; c2.x = rv[i].z; c2.y = rv[i].w; unsigned char* o = lds + CM_V + d * CM_VSTR + ck * 16; *(u32x2*)o = a; *(u32x2*)(o + 8) = c2; }
        }
        bf16x8 qf[4];
        { const bf16_t* qp = (const bf16_t*)(ws + WS_Q) + ((size_t)(b * 8 + head) * SEQ + t) * 64 + 8 * hh;
#pragma unroll
            for (int s = 0; s < 4; ++s) qf[s] = *(const bf16x8*)(qp + 16 * s); }
        __syncthreads();
        float m_run = -1e30f, l_run = 0.f;
        for (int kt = 0; kt < ntile; ++kt) {
            f32x16 sacc[2];
            cm_scores(lds + CM_K, kt, qf, r31, hh, sacc);
            float mx = -1e30f;
#pragma unroll
            for (int kt2 = 0; kt2 < 2; ++kt2)
#pragma unroll
                for (int i = 0; i < 16; ++i) { const int c = 64 * kt + 32 * kt2 + (i & 3) + 8 * (i >> 2) + 4 * hh; const float v = (c < nv) ? sacc[kt2][i] : -1e30f; sacc[kt2][i] = v; mx = fmaxf(mx, v); }
            const float m_new = fmaxf(m_run, mx); float rs = 0.f;
#pragma unroll
            for (int kt2 = 0; kt2 < 2; ++kt2)
#pragma unroll
                for (int i = 0; i < 16; ++i) { const float v = sacc[kt2][i]; rs += (v > -5e29f) ? __builtin_amdgcn_exp2f(v - m_new) : 0.f; }
            l_run = l_run * __builtin_amdgcn_exp2f(m_run - m_new) + rs; m_run = m_new;
        }
        float M, invL;
        { const float mo = __shfl_xor(m_run, 32), lo = __shfl_xor(l_run, 32); M = fmaxf(m_run, mo); const float L = l_run * __builtin_amdgcn_exp2f(m_run - M) + lo * __builtin_amdgcn_exp2f(mo - M); invL = L > 0.f ? 1.f / L : 0.f; }
        f32x16 ot[2];
#pragma unroll
        for (int dt = 0; dt < 2; ++dt)
#pragma unroll
            for (int i = 0; i < 16; ++i) ot[dt][i] = 0.f;
        float carry = 0.f;
#pragma unroll
        for (int kt = 0; kt < 4; ++kt) if (kt < ntile) {
            f32x16 sacc[2];
            cm_scores(lds + CM_K, kt, qf, r31, hh, sacc);
#pragma unroll
            for (int kt2 = 0; kt2 < 2; ++kt2)
#pragma unroll
                for (int i = 0; i < 16; ++i) { const int c = 64 * kt + 32 * kt2 + (i & 3) + 8 * (i >> 2) + 4 * hh; sacc[kt2][i] = (c < nv) ? __builtin_amdgcn_exp2f(sacc[kt2][i] - M) : 0.f; }
            {
                float own[8], xs[8];
#pragma unroll
                for (int kt2 = 0; kt2 < 2; ++kt2)
#pragma unroll
                    for (int g4 = 0; g4 < 4; ++g4) { const float e3 = 0.5f * sacc[kt2][4 * g4 + 3];
                        own[4 * kt2 + g4] = (sacc[kt2][4 * g4] + sacc[kt2][4 * g4 + 1]) + (sacc[kt2][4 * g4 + 2] + e3); xs[4 * kt2 + g4] = __shfl_xor(e3, 32); }
                float* io = impl + (wid >> 1) * 4096 + tokl * 64 + 16 * kt + hh;
#pragma unroll
                for (int gi = 0; gi < 8; ++gi) io[2 * gi] = (own[gi] + (hh ? xs[gi] : (gi > 0 ? xs[gi > 0 ? gi - 1 : 0] : carry))) * invL;
                carry = xs[7];
            }
#pragma unroll
            for (int kt2 = 0; kt2 < 2; ++kt2)
#pragma unroll
                for (int s2 = 0; s2 < 2; ++s2) {
                    bf16x8 pf; { u32x4 w; w.x = pk2(sacc[kt2][8 * s2 + 0], sacc[kt2][8 * s2 + 1]); w.y = pk2(sacc[kt2][8 * s2 + 2], sacc[kt2][8 * s2 + 3]);
                        w.z = pk2(sacc[kt2][8 * s2 + 4], sacc[kt2][8 * s2 + 5]); w.w = pk2(sacc[kt2][8 * s2 + 6], sacc[kt2][8 * s2 + 7]); pf = __builtin_bit_cast(bf16x8, w); }
#pragma unroll
                    for (int dt = 0; dt < 2; ++dt) {
                        const unsigned char* va = lds + CM_V + (32 * dt + r31) * CM_VSTR + (64 * kt + 32 * kt2 + 16 * s2 + 4 * hh) * 2;
                        const u32x2 lo = *(const u32x2*)(va), hi = *(const u32x2*)(va + 16);
                        u32x4 w; w.x = lo.x; w.y = lo.y; w.z = hi.x; w.w = hi.y;
                        ot[dt] = __builtin_amdgcn_mfma_f32_32x32x16_bf16(__builtin_bit_cast(bf16x8, w), pf, ot[dt], 0, 0, 0);
                    }
                }
        }
        {
            const float sc = ((const float*)(ws + WS_GATES))[tok * 24 + head * 3 + 0] * invL;
            bf16_t* ocp = (bf16_t*)(ws + WS_OC) + tok * 512 + head * 64;
#pragma unroll
            for (int dt = 0; dt < 2; ++dt)
#pragma unroll
                for (int g4 = 0; g4 < 4; ++g4) { const int d0 = 32 * dt + 8 * g4 + 4 * hh;
                    u32x2 w; w.x = pk2(ot[dt][4 * g4 + 0] * sc, ot[dt][4 * g4 + 1] * sc); w.y = pk2(ot[dt][4 * g4 + 2] * sc, ot[dt][4 * g4 + 3] * sc); *(u32x2*)(ocp + d0) = w; }
        }
        __syncthreads();
        for (int tt = 0; tt < 8; ++tt) {
            const int tl = wid * 8 + tt, cur = ci;
            unsigned long long mask;
            if (cur < 16) mask = (2ull << cur) - 1ull;
            else {
                const bool valid = lane <= cur;
                const float imp = (impl[tl * 64 + lane] + impl[4096 + tl * 64 + lane]) + (impl[8192 + tl * 64 + lane] + impl[12288 + tl * 64 + lane]);
                const unsigned key = (lane == 0 || lane == cur) ? 0x7F800000u : __float_as_uint(imp);
                unsigned T = 0u;
                for (int bit = 30; bit >= 0; --bit) { const unsigned cand = T | (1u << bit); if (__popcll(__ballot(valid && key >= cand)) >= 16) T = cand; }
                const unsigned long long gt = __ballot(valid && key > T), eq = __ballot(valid && key == T);
                const int need = 16 - __popcll(gt);
                const int below = __popcll(eq & ((1ull << lane) - 1ull));
                mask = gt | __ballot(valid && key == T && below < need);
            }
            if (lane == 0) ((unsigned long long*)(ws + WS_SELM))[(size_t)bg * SEQ + ci * 64 + tl] = mask;
        }
    }
}

constexpr int FA_KB = 64 * 128, FA_VB = 64 * 136, FA_STAGE = FA_KB + FA_VB, FA_LDS = 2 * FA_STAGE + 1024;
template <bool SEL>
DEV void fa_branch(unsigned char* lds, const bf16_t* Kb, const bf16_t* VTb, int ci, int bg, const bf16x8 (&qf)[4], int t, unsigned long long mymask, unsigned long long need,
                   f32x16 (&ot)[2], float& m_run, float& l_run) {
    const int tid = threadIdx.x, lane = tid & 63;
    const int r31 = lane & 31, hh = lane >> 5;
    const int lrow = tid >> 3, lch = tid & 7;
    const bf16_t* kg = Kb + ((size_t)bg * SEQ + lrow) * 64 + lch * 8;
    const bf16_t* vg = VTb + ((size_t)bg * 64 + lrow) * SEQ + lch * 8;
    const int koff = lrow * 128 + ((lch ^ ((lrow >> 1) & 7)) << 4), voff = FA_KB + lrow * 136 + lch * 16;
    int jlo, jhi; unsigned long long todo;
    if (SEL) { todo = need; jlo = 0; jhi = ci; } else { jlo = ci >= 8 ? ci - 8 : 0; jhi = ci; todo = 0; }
    int j = jlo;
    if (SEL) { if (todo == 0) return; j = __builtin_ctzll(todo); todo &= todo - 1; }
    u32x4 rk = *(const u32x4*)(kg + (size_t)j * 64 * 64), rv = *(const u32x4*)(vg + (size_t)j * 64);
    __syncthreads();
    *(u32x4*)(lds + koff) = rk; { u32x2 a, b2; a.x = rv.x; a.y = rv.y; b2.x = rv.z; b2.y = rv.w; *(u32x2*)(lds + voff) = a; *(u32x2*)(lds + voff + 8) = b2; }
    __syncthreads();
    int st = 0; bool seen = false;
    for (;;) {
        int jn; bool more;
        if (SEL) { more = (todo != 0); jn = more ? __builtin_ctzll(todo) : 0; todo &= todo - 1; } else { jn = j + 1; more = (jn <= jhi); }
        if (more) { rk = *(const u32x4*)(kg + (size_t)jn * 64 * 64); rv = *(const u32x4*)(vg + (size_t)jn * 64); }
        const unsigned char* base = lds + st * FA_STAGE;
        const bool bit = SEL ? ((mymask >> j) & 1ull) != 0 : true;
        const float cinit = (SEL && !bit) ? -__builtin_inff() : -m_run;
        f32x16 sacc[2];
#pragma unroll
        for (int kt2 = 0; kt2 < 2; ++kt2) {
#pragma unroll
            for (int i = 0; i < 16; ++i) sacc[kt2][i] = cinit;
            const int row = 32 * kt2 + r31; const int sx = (row >> 1) & 7;
#pragma unroll
            for (int s = 0; s < 4; ++s) { const bf16x8 kf = *(const bf16x8*)(base + row * 128 + (((2 * s + hh) ^ sx) << 4));
                sacc[kt2] = __builtin_amdgcn_mfma_f32_32x32x16_bf16(kf, qf[s], sacc[kt2], 0, 0, 0); }
        }
        const bool boundary = SEL ? (j == ci) : (j == ci || j + 8 <= ci);
        float mx = -__builtin_inff();
        if (boundary) {
#pragma unroll
            for (int kt2 = 0; kt2 < 2; ++kt2)
#pragma unroll
                for (int i = 0; i < 16; ++i) { const int key = 64 * j + 32 * kt2 + (i & 3) + 8 * (i >> 2) + 4 * hh;
                    const bool ok = SEL ? (key <= t) : (key <= t && t - key < 512);
                    const float v = ok ? sacc[kt2][i] : -__builtin_inff(); sacc[kt2][i] = v; mx = fmaxf(mx, v); }
        } else {
#pragma unroll
            for (int kt2 = 0; kt2 < 2; ++kt2)
#pragma unroll
                for (int i = 0; i < 16; ++i) mx = fmaxf(mx, sacc[kt2][i]);
        }
        mx = fmaxf(mx, __shfl_xor(mx, 32));
        const bool live = mx > -__builtin_inff();
        const bool need = (mx > 8.f) || (!seen && live && mx < -8.f);
        if (__any(need)) {
            const float d = need ? mx : 0.f;
            const float alpha = d > 0.f ? __builtin_amdgcn_exp2f(-d) : 1.f;
            m_run += d; l_run *= alpha;
#pragma unroll
            for (int dt = 0; dt < 2; ++dt)
#pragma unroll
                for (int i = 0; i < 16; ++i) ot[dt][i] *= alpha;
#pragma unroll
            for (int kt2 = 0; kt2 < 2; ++kt2)
#pragma unroll
                for (int i = 0; i < 16; ++i) sacc[kt2][i] -= d;
        }
        seen = seen || live;
        float rs = 0.f;
#pragma unroll
        for (int kt2 = 0; kt2 < 2; ++kt2)
#pragma unroll
            for (int i = 0; i < 16; ++i) { const float e = __builtin_amdgcn_exp2f(sacc[kt2][i]); sacc[kt2][i] = e; rs += e; }
        l_run += rs;
#pragma unroll
        for (int kt2 = 0; kt2 < 2; ++kt2)
#pragma unroll
            for (int s2 = 0; s2 < 2; ++s2) {
                bf16x8 pf; { u32x4 w; w.x = pk2(sacc[kt2][8 * s2 + 0], sacc[kt2][8 * s2 + 1]); w.y = pk2(sacc[kt2][8 * s2 + 2], sacc[kt2][8 * s2 + 3]);
                    w.z = pk2(sacc[kt2][8 * s2 + 4], sacc[kt2][8 * s2 + 5]); w.w = pk2(sacc[kt2][8 * s2 + 6], sacc[kt2][8 * s2 + 7]); pf = __builtin_bit_cast(bf16x8, w); }
#pragma unroll
                for (int dt = 0; dt < 2; ++dt) {
                    const unsigned char* va = base + FA_KB + (32 * dt + r31) * 136 + (32 * kt2 + 16 * s2 + 4 * hh) * 2;
                    const u32x2 lo = *(const u32x2*)(va), hi = *(const u32x2*)(va + 16);
                    u32x4 w; w.x = lo.x; w.y = lo.y; w.z = hi.x; w.w = hi.y;
                    ot[dt] = __builtin_amdgcn_mfma_f32_32x32x16_bf16(__builtin_bit_cast(bf16x8, w), pf, ot[dt], 0, 0, 0);
                }
            }
        if (!more) break;
        { unsigned char* nb = lds + (st ^ 1) * FA_STAGE; *(u32x4*)(nb + koff) = rk; u32x2 a, b2; a.x = rv.x; a.y = rv.y; b2.x = rv.z; b2.y = rv.w; *(u32x2*)(nb + voff) = a; *(u32x2*)(nb + voff + 8) = b2; }
        __syncthreads();
        st ^= 1; j = jn;
    }
}
DEV void phase_flash(const Params& p, unsigned char* lds) {
    const int tid = threadIdx.x, lane = tid & 63, wid = tid >> 6;
    const int vb = vblock(), G = gridDim.x;
    unsigned char* ws = p.ws;
    const int r31 = lane & 31, hh = lane >> 5;
    unsigned long long* red = (unsigned long long*)(lds + 2 * FA_STAGE);
    for (int it = vb; it < 1024; it += G) {
        const int rnd = it / G, pos = it % G; int sidx = (rnd & 1) ? (rnd * G + (G - 1 - pos)) : (rnd * G + pos); if (G != 256) sidx = it;
        const int ci = 63 - (sidx >> 4), bg = sidx & 15, b = bg >> 1, g = bg & 1;
        const int head = g * 4 + (wid >> 1);
        const int t = ci * 64 + (wid & 1) * 32 + r31;
        const size_t tok = (size_t)b * SEQ + t;
        bf16x8 qf[4];
        { const bf16_t* qp = (const bf16_t*)(ws + WS_Q) + ((size_t)(b * 8 + head) * SEQ + t) * 64 + 8 * hh;
#pragma unroll
            for (int s = 0; s < 4; ++s) qf[s] = *(const bf16x8*)(qp + 16 * s); }
        const unsigned long long mymask = ((const unsigned long long*)(ws + WS_SELM))[(size_t)bg * SEQ + t];
        unsigned long long orm = mymask;
#pragma unroll
        for (int o = 1; o < 32; o <<= 1) { const unsigned lo = __shfl_xor((unsigned)orm, o), hi = __shfl_xor((unsigned)(orm >> 32), o); orm |= ((unsigned long long)hi << 32) | lo; }
        __syncthreads();
        if (wid < 2 && lane == 0) red[wid] = orm;
        __syncthreads();
        const unsigned long long need = red[0] | red[1];
        f32x16 oc[2];
        {
            f32x16 ot[2]; float m_run = 0.f, l_run = 0.f;
#pragma unroll
            for (int dt = 0; dt < 2; ++dt)
#pragma unroll
                for (int i = 0; i < 16; ++i) ot[dt][i] = 0.f;
            fa_branch<true>(lds, (const bf16_t*)(ws + WS_KS), (const bf16_t*)(ws + WS_VST), ci, bg, qf, t, mymask, need, ot, m_run, l_run);
            const float lt = l_run + __shfl_xor(l_run, 32);
            const float sc = ((const float*)(ws + WS_GATES))[tok * 24 + head * 3 + 1] / lt;
#pragma unroll
            for (int dt = 0; dt < 2; ++dt)
#pragma unroll
                for (int i = 0; i < 16; ++i) oc[dt][i] = ot[dt][i] * sc;
        }
        {
            f32x16 ot[2]; float m_run = 0.f, l_run = 0.f;
#pragma unroll
            for (int dt = 0; dt < 2; ++dt)
#pragma unroll
                for (int i = 0; i < 16; ++i) ot[dt][i] = 0.f;
            fa_branch<false>(lds, (const bf16_t*)(ws + WS_KW), (const bf16_t*)(ws + WS_VWT), ci, bg, qf, t, 0ull, 0ull, ot, m_run, l_run);
            const float lt = l_run + __shfl_xor(l_run, 32);
            const float sc = ((const float*)(ws + WS_GATES))[tok * 24 + head * 3 + 2] / lt;
#pragma unroll
            for (int dt = 0; dt < 2; ++dt)
#pragma unroll
                for (int i = 0; i < 16; ++i) oc[dt][i] += ot[dt][i] * sc;
        }
        {
            const bf16_t* ocp = (const bf16_t*)(ws + WS_OC) + tok * 512 + head * 64;
            bf16_t* mix = (bf16_t*)(ws + WS_R1) + tok * 1024 + head * 64;
            float ss = 0.f;
#pragma unroll
            for (int dt = 0; dt < 2; ++dt)
#pragma unroll
                for (int g4 = 0; g4 < 4; ++g4) { const int d0 = 32 * dt + 8 * g4 + 4 * hh; const u32x2 c = *(const u32x2*)(ocp + d0);
                    const float v0 = oc[dt][4 * g4 + 0] + bflo(c.x), v1 = oc[dt][4 * g4 + 1] + bfhi(c.x), v2 = oc[dt][4 * g4 + 2] + bflo(c.y), v3 = oc[dt][4 * g4 + 3] + bfhi(c.y);
                    ss += (v0 * v0 + v1 * v1) + (v2 * v2 + v3 * v3);
                    u32x2 w; w.x = pk2(v0, v1); w.y = pk2(v2, v3); *(u32x2*)(mix + d0) = w; }
            ss += __shfl_xor(ss, 32);
            if (hh == 0) atomicAdd((float*)(ws + WS_ROWSS) + tok, ss);
        }
    }
}

DEV int swz256(int row, int chunk) { return row * 256 + ((chunk ^ (row & 15)) << 4); }
DEV void hgrn_cumsum(const Params& p, int bh, int c, float* segs, f32x2 (&lf)[8], f32x2 (&a)[8], f32x2& r, f32x2& alast) {
    const int tid = threadIdx.x, k2 = tid & 63, tq = tid >> 6;
    const int b = bh >> 2, h = bh & 3;
    const float* HL = (const float*)(p.ws + WS_HLOGF) + ((size_t)b * SEQ + c * 64 + tq * 8) * 512 + h * 128 + 2 * k2;
#pragma unroll
    for (int i = 0; i < 8; ++i) lf[i] = *(const f32x2*)(HL + (size_t)i * 512);
    f32x2 run = (f32x2){0.f, 0.f};
#pragma unroll
    for (int i = 0; i < 8; ++i) { run = run + lf[i]; a[i] = run; }
    *(f32x2*)(segs + tq * 128 + 2 * k2) = run;
    __syncthreads();
    f32x2 off = (f32x2){0.f, 0.f}, tot = off, rr = off;
#pragma unroll
    for (int q = 0; q < 8; ++q) { const f32x2 s = *(const f32x2*)(segs + q * 128 + 2 * k2); if (q < tq) off = off + s; if (q < 4) rr = rr + s; tot = tot + s; }
#pragma unroll
    for (int i = 0; i < 8; ++i) a[i] = a[i] + off;
    r = rr; alast = tot;
}
DEV void hgrn_stage_vt(const Params& p, int bh, int c, unsigned char* vt) {
    const int tid = threadIdx.x, k2 = tid & 63, tq = tid >> 6;
    const int b = bh >> 2, h = bh & 3;
    const bf16_t* HV = (const bf16_t*)(p.ws + WS_HV) + ((size_t)b * SEQ + c * 64 + tq * 8) * 512 + h * 128 + 2 * k2;
    unsigned vv[8];
#pragma unroll
    for (int i = 0; i < 8; ++i) vv[i] = *(const unsigned*)(HV + (size_t)i * 512);
    u32x4 lo, hi;
    lo.x = (vv[0] & 0xffffu) | (vv[1] << 16); lo.y = (vv[2] & 0xffffu) | (vv[3] << 16); lo.z = (vv[4] & 0xffffu) | (vv[5] << 16); lo.w = (vv[6] & 0xffffu) | (vv[7] << 16);
    hi.x = (vv[0] >> 16) | (vv[1] & 0xffff0000u); hi.y = (vv[2] >> 16) | (vv[3] & 0xffff0000u); hi.z = (vv[4] >> 16) | (vv[5] & 0xffff0000u); hi.w = (vv[6] >> 16) | (vv[7] & 0xffff0000u);
    *(u32x4*)(vt + swz(2 * k2, tq)) = lo; *(u32x4*)(vt + swz(2 * k2 + 1, tq)) = hi;
}
constexpr int H1_KT = 0, H1_VT = 16384, H1_SEG = 32768, H1_EK = H1_SEG + 4096;
DEV void phase_hgrn_a1(const Params& p, unsigned char* lds, int vb0, int nb) {
    const int tid = threadIdx.x, lane = tid & 63, wid = tid >> 6, k2 = tid & 63, tq = tid >> 6;
    const int vb = vblock(), G = gridDim.x;
    const int frow = lane & 15, fq = lane >> 4, wr = wid >> 1, wc = wid & 1;
    float* segs = (float*)(lds + H1_SEG); float* ek = (float*)(lds + H1_EK);
    bf16_t* ubuf = (bf16_t*)(p.ws + WS_UBUF); float* dbuf = (float*)(p.ws + WS_DBUF);
    if (vb < vb0) return;
    for (int item = vb - vb0; item < 2048; item += nb) {
        const int bh = item >> 6, c = item & 63;
        __syncthreads();
        f32x2 lf[8], a[8], r, al;
        hgrn_cumsum(p, bh, c, segs, lf, a, r, al);
        {
            float kx[8], ky[8];
#pragma unroll
            for (int i = 0; i < 8; ++i) { kx[i] = (1.f - __expf(lf[i].x)) * __expf(fminf(r.x - a[i].x, 80.f)); ky[i] = (1.f - __expf(lf[i].y)) * __expf(fminf(r.y - a[i].y, 80.f)); }
            u32x4 w0, w1;
            w0.x = pk2(kx[0], kx[1]); w0.y = pk2(kx[2], kx[3]); w0.z = pk2(kx[4], kx[5]); w0.w = pk2(kx[6], kx[7]);
            w1.x = pk2(ky[0], ky[1]); w1.y = pk2(ky[2], ky[3]); w1.z = pk2(ky[4], ky[5]); w1.w = pk2(ky[6], ky[7]);
            *(u32x4*)(lds + H1_KT + swz(2 * k2, tq)) = w0; *(u32x4*)(lds + H1_KT + swz(2 * k2 + 1, tq)) = w1;
        }
        hgrn_stage_vt(p, bh, c, lds + H1_VT);
        if (tq == 7) { ek[2 * k2] = __expf(al.x - r.x); ek[2 * k2 + 1] = __expf(al.y - r.y); f32x2 d; d.x = __expf(al.x); d.y = __expf(al.y); *(f32x2*)(dbuf + (size_t)item * 128 + 2 * k2) = d; }
        __syncthreads();
        f32x4 acc[2][4];
#pragma unroll
        for (int m = 0; m < 2; ++m)
#pragma unroll
            for (int n = 0; n < 4; ++n) acc[m][n] = (f32x4){0.f, 0.f, 0.f, 0.f};
        const int sx = (frow >> 1) & 7;
#pragma unroll
        for (int ks = 0; ks < 2; ++ks) {
            const int co = ((ks * 4 + fq) ^ sx) << 4;
            bf16x8 af[2], bfr[4];
#pragma unroll
            for (int m = 0; m < 2; ++m) af[m] = *(const bf16x8*)(lds + H1_VT + (32 * wr + 16 * m + frow) * 128 + co);
#pragma unroll
            for (int n = 0; n < 4; ++n) bfr[n] = *(const bf16x8*)(lds + H1_KT + (64 * wc + 16 * n + frow) * 128 + co);
#pragma unroll
            for (int m = 0; m < 2; ++m)
#pragma unroll
                for (int n = 0; n < 4; ++n) acc[m][n] = __builtin_amdgcn_mfma_f32_16x16x32_bf16(bfr[n], af[m], acc[m][n], 0, 0, 0);
        }
#pragma unroll
        for (int m = 0; m < 2; ++m) { const int v = 32 * wr + 16 * m + frow;
#pragma unroll
            for (int n = 0; n < 4; ++n) { const int k0 = 64 * wc + 16 * n + 4 * fq; const f32x4 e = *(const f32x4*)(ek + k0); const f32x4 o = acc[m][n] * e;
                u32x2 w; w.x = pk2(o.x, o.y); w.y = pk2(o.z, o.w); *(u32x2*)(ubuf + ((size_t)item * 128 + v) * 128 + k0) = w; } }
    }
}
DEV void phase_hgrn_a2(const Params& p, unsigned char* lds) {
    const int G = gridDim.x;
    bf16_t* ubuf = (bf16_t*)(p.ws + WS_UBUF); const float* dbuf = (const float*)(p.ws + WS_DBUF);
    for (int gid = blockIdx.x * NT + threadIdx.x; gid < 131072; gid += G * NT) {
        const int bh = gid >> 12, v = (gid >> 5) & 127, k4 = gid & 31;
        bf16_t* u = ubuf + ((size_t)bh * 64 * 128 + v) * 128 + 4 * k4;
        const float* d = dbuf + (size_t)bh * 64 * 128 + 4 * k4;
        f32x4 S = (f32x4){0.f, 0.f, 0.f, 0.f};
        for (int c0 = 0; c0 < 64; c0 += 8) {
            u32x2 uu[8]; f32x4 dd[8];
#pragma unroll
            for (int j = 0; j < 8; ++j) { uu[j] = *(const u32x2*)(u + (size_t)(c0 + j) * 16384); dd[j] = *(const f32x4*)(d + (size_t)(c0 + j) * 128); }
#pragma unroll
            for (int j = 0; j < 8; ++j) { u32x2 w; w.x = pk2(S.x, S.y); w.y = pk2(S.z, S.w); *(u32x2*)(u + (size_t)(c0 + j) * 16384) = w;
                S.x = dd[j].x * S.x + bflo(uu[j].x); S.y = dd[j].y * S.y + bfhi(uu[j].x); S.z = dd[j].z * S.z + bflo(uu[j].y); S.w = dd[j].w * S.w + bfhi(uu[j].y); }
        }
    }
}
constexpr int H3_QH = 0, H3_QA = 16384, H3_KH = 32768, H3_VT = 49152, H3_PP = 65536, H3_ST = 73728, H3_SEG = 106496, H3_RED = 110592;
DEV void phase_hgrn_a3(const Params& p, unsigned char* lds) {
    const int tid = threadIdx.x, lane = tid & 63, wid = tid >> 6, k2 = tid & 63, tq = tid >> 6;
    const int vb = vblock(), G = gridDim.x;
    const int frow = lane & 15, fq = lane >> 4;
    float* segs = (float*)(lds + H3_SEG); float* red = (float*)(lds + H3_RED);
    const bf16_t* ubuf = (const bf16_t*)(p.ws + WS_UBUF);
    for (int item = vb; item < 2048; item += G) {
        const int bh = item >> 6, c = item & 63, b = bh >> 2, h = bh & 3;
        __syncthreads();
        f32x2 lf[8], a[8], r, al;
        hgrn_cumsum(p, bh, c, segs, lf, a, r, al);
        {
            const bf16_t* HQ = (const bf16_t*)(p.ws + WS_HQ) + ((size_t)b * SEQ + c * 64 + tq * 8) * 512 + h * 128 + 2 * k2;
            unsigned qq[8];
#pragma unroll
            for (int i = 0; i < 8; ++i) qq[i] = *(const unsigned*)(HQ + (size_t)i * 512);
#pragma unroll
            for (int i = 0; i < 8; ++i) { const int t = 8 * tq + i; const float q0 = bflo(qq[i]), q1 = bfhi(qq[i]);
                const int off = swz256(t, k2 >> 2) + (k2 & 3) * 4;
                *(unsigned*)(lds + H3_QH + off) = pk2(q0 * __expf(fminf(a[i].x - r.x, 80.f)), q1 * __expf(fminf(a[i].y - r.y, 80.f)));
                *(unsigned*)(lds + H3_QA + off) = pk2(q0 * __expf(a[i].x), q1 * __expf(a[i].y));
                *(unsigned*)(lds + H3_KH + off) = pk2((1.f - __expf(lf[i].x)) * __expf(fminf(r.x - a[i].x, 80.f)), (1.f - __expf(lf[i].y)) * __expf(fminf(r.y - a[i].y, 80.f))); }
        }
        hgrn_stage_vt(p, bh, c, lds + H3_VT);
        {
            const bf16_t* st = ubuf + (size_t)item * 16384;
#pragma unroll
            for (int i = 0; i < 4; ++i) { const int q = tid + NT * i, v = q >> 4, ch = q & 15; *(u32x4*)(lds + H3_ST + swz256(v, ch)) = *(const u32x4*)(st + v * 128 + ch * 8); }
        }
        __syncthreads();
        {
            const int wr = wid >> 1, wc = wid & 1;
            f32x4 acc[2];
            acc[0] = (f32x4){0.f, 0.f, 0.f, 0.f}; acc[1] = acc[0];
            if (32 * wc <= 16 * wr + 15) {
#pragma unroll
                for (int ks = 0; ks < 4; ++ks) {
                    const int co = ((ks * 4 + fq) ^ frow) << 4;
                    const bf16x8 af = *(const bf16x8*)(lds + H3_QH + (16 * wr + frow) * 256 + co);
#pragma unroll
                    for (int n = 0; n < 2; ++n) { const bf16x8 bfr = *(const bf16x8*)(lds + H3_KH + (32 * wc + 16 * n + frow) * 256 + co);
                        acc[n] = __builtin_amdgcn_mfma_f32_16x16x32_bf16(bfr, af, acc[n], 0, 0, 0); }
                }
            }
            const int t = 16 * wr + frow;
#pragma unroll
            for (int n = 0; n < 2; ++n) { const int s0 = 32 * wc + 16 * n + 4 * fq; f32x4 v = acc[n];
                v.x = (s0 + 0 <= t) ? v.x : 0.f; v.y = (s0 + 1 <= t) ? v.y : 0.f; v.z = (s0 + 2 <= t) ? v.z : 0.f; v.w = (s0 + 3 <= t) ? v.w : 0.f;
                u32x2 w; w.x = pk2(v.x, v.y); w.y = pk2(v.z, v.w);
                *(u32x2*)(lds + H3_PP + t * 128 + ((((s0 >> 3)) ^ ((t >> 1) & 7)) << 4) + (s0 & 7) * 2) = w; }
        }
        __syncthreads();
        {
            const int wr = wid >> 2, wc = wid & 3;
            f32x4 acc[2][2];
#pragma unroll
            for (int m = 0; m < 2; ++m)
#pragma unroll
                for (int n = 0; n < 2; ++n) acc[m][n] = (f32x4){0.f, 0.f, 0.f, 0.f};
            const int sx = (frow >> 1) & 7;
#pragma unroll
            for (int ks = 0; ks < 2; ++ks) {
                const int co = ((ks * 4 + fq) ^ sx) << 4;
                bf16x8 af[2], bfr[2];
#pragma unroll
                for (int m = 0; m < 2; ++m) af[m] = *(const bf16x8*)(lds + H3_PP + (32 * wr + 16 * m + frow) * 128 + co);
#pragma unroll
                for (int n = 0; n < 2; ++n) bfr[n] = *(const bf16x8*)(lds + H3_VT + (32 * wc + 16 * n + frow) * 128 + co);
#pragma unroll
                for (int m = 0; m < 2; ++m)
#pragma unroll
                    for (int n = 0; n < 2; ++n) acc[m][n] = __builtin_amdgcn_mfma_f32_16x16x32_bf16(bfr[n], af[m], acc[m][n], 0, 0, 0);
            }
#pragma unroll
            for (int ks = 0; ks < 4; ++ks) {
                const int co = ((ks * 4 + fq) ^ frow) << 4;
                bf16x8 af[2], bfr[2];
#pragma unroll
                for (int m = 0; m < 2; ++m) af[m] = *(const bf16x8*)(lds + H3_QA + (32 * wr + 16 * m + frow) * 256 + co);
#pragma unroll
                for (int n = 0; n < 2; ++n) bfr[n] = *(const bf16x8*)(lds + H3_ST + (32 * wc + 16 * n + frow) * 256 + co);
#pragma unroll
                for (int m = 0; m < 2; ++m)
#pragma unroll
                    for (int n = 0; n < 2; ++n) acc[m][n] = __builtin_amdgcn_mfma_f32_16x16x32_bf16(bfr[n], af[m], acc[m][n], 0, 0, 0);
            }
#pragma unroll
            for (int m = 0; m < 2; ++m) { float ss = 0.f;
#pragma unroll
                for (int n = 0; n < 2; ++n) { const f32x4 v = acc[m][n]; ss += (v.x * v.x + v.y * v.y) + (v.z * v.z + v.w * v.w); }
                ss += __shfl_xor(ss, 16); ss += __shfl_xor(ss, 32);
                if (fq == 0) red[(32 * wr + 16 * m + frow) * 4 + wc] = ss; }
            __syncthreads();
#pragma unroll
            for (int m = 0; m < 2; ++m) { const int t = 32 * wr + 16 * m + frow; const f32x4 q4 = *(const f32x4*)(red + t * 4);
                const float rs = rsqrtf(((q4.x + q4.y) + (q4.z + q4.w)) * (1.f / 128.f) + RMS_EPS);
                const size_t row = (size_t)b * SEQ + c * 64 + t;
#pragma unroll
                for (int n = 0; n < 2; ++n) { const int v0 = 32 * wc + 16 * n + 4 * fq; const f32x4 gn = *(const f32x4*)(p.g_hn + v0);
                    const u32x2 gg = *(const u32x2*)((const bf16_t*)(p.ws + WS_HG) + row * 512 + h * 128 + v0);
                    const f32x4 o = acc[m][n];
                    u32x2 w; w.x = pk2(o.x * rs * gn.x * bflo(gg.x), o.y * rs * gn.y * bfhi(gg.x)); w.y = pk2(o.z * rs * gn.z * bflo(gg.y), o.w * rs * gn.w * bfhi(gg.y));
                    *(u32x2*)((bf16_t*)(p.ws + WS_R1) + row * 1024 + 512 + h * 128 + v0) = w; } }
        }
    }
}

DEV void phase_normalize(const Params& p, unsigned char* lds) {
    const int tid = threadIdx.x, lane = tid & 63, wid = tid >> 6;
    const int vb = vblock(), G = gridDim.x;
    unsigned char* ws = p.ws;
    bf16_t* mix = (bf16_t*)(ws + WS_R1); const float* rowss = (const float*)(ws + WS_ROWSS); const bf16_t* HG = (const bf16_t*)(ws + WS_HG);
    for (int m = vb * 8 + wid; m < NTOK; m += G * 8) {
        {
            const float r = rsqrtf(rowss[m] * (1.f / 512.f) + RMS_EPS);
            u32x4* pp = (u32x4*)(mix + (size_t)m * 1024) + lane; u32x4 v = *pp;
            v.x = pk2(bflo(v.x) * r, bfhi(v.x) * r); v.y = pk2(bflo(v.y) * r, bfhi(v.y) * r); v.z = pk2(bflo(v.z) * r, bfhi(v.z) * r); v.w = pk2(bflo(v.w) * r, bfhi(v.w) * r);
            *pp = v;
        }
    }
    __syncthreads();
    {
        float* tl = (float*)lds;
        for (int r = vb; r < 32 * 4 * 16; r += G) { const int e = r / 64, q = r % 64; SrcW13_4 s{p.w1 + (size_t)e * 1024 * 512, p.w3 + (size_t)e * 1024 * 512, p.ffn_g};
            convert_tile256(tl, s, (bf16_t*)(ws + WS_W13T) + (size_t)e * 1024 * 1024, 1024, (q / 16) * 256, (q % 16) * 64); }
    }
}

struct EpiOut8 { const Params& p;
    DEV void operator()(const f32x4 (&acc)[2][2][4][2], const pg8::Unit& u, int wr, int wc, int fr, int fq) const {
#pragma unroll
        for (int ai = 0; ai < 2; ++ai)
#pragma unroll
            for (int m = 0; m < 4; ++m) { const size_t row = (size_t)u.pm * 256 + ai * 128 + wr * 64 + m * 16 + fr;
#pragma unroll
                for (int bj = 0; bj < 2; ++bj)
#pragma unroll
                    for (int n = 0; n < 2; ++n) { const int c = u.pn * 256 + 64 * wc + 32 * bj + 16 * n + 4 * fq; const f32x4 xv = *(const f32x4*)(p.x + row * DM + c); *(f32x4*)(p.out + row * DM + c) = xv + acc[ai][bj][m][n]; } }
    } };
DEV void phase_outproj(const Params& p, unsigned char* lds) {
    pg8::Gemm g{(const bf16_t*)(p.ws + WS_R1), (const bf16_t*)(p.ws + WS_WOUTT), NTOK, DM, DM};
    pg8::StaticOrder S; S.init(NTOK, DM, (int)gridDim.x, (int)blockIdx.x);
    EpiOut8 E{p};
    pg8::gemm_phase((PG8_LAS unsigned char*)lds, g, S, E);
}

constexpr int RT_W = 0, RT_LG = 49152, RT_RS = RT_LG + 128 * 49 * 4, RT_HIST = RT_RS + 512, RT_BASE = RT_HIST + 512, RT_LDS = RT_BASE + 512;
DEV void phase_router(const Params& p, unsigned char* lds) {
    const int tid = threadIdx.x, lane = tid & 63, wid = tid >> 6, frow = lane & 15, fq = lane >> 4;
    const int vb = vblock(), G = gridDim.x;
    unsigned char* ws = p.ws;
    float* lg = (float*)(lds + RT_LG); float* rsd = (float*)(lds + RT_RS);
    int* hist = (int*)(lds + RT_HIST); int* basep = (int*)(lds + RT_BASE);
    const bf16_t* rw = (const bf16_t*)(ws + WS_RW);
    for (int it = vb; it < NTOK / 128; it += G) {
        const size_t row0 = (size_t)it * 128;
        const size_t trow = row0 + 16 * wid + frow;
        const float* hrow = p.out + trow * DM + 8 * fq;
        bf16_t* hbrow = (bf16_t*)(ws + WS_R1) + trow * DM + 8 * fq;
        f32x4 acc[3]; float ss = 0.f;
#pragma unroll
        for (int nt = 0; nt < 3; ++nt) acc[nt] = (f32x4){0.f, 0.f, 0.f, 0.f};
        if (tid < 128) hist[tid] = 0;
        for (int kc = 0; kc < 4; ++kc) {
            __syncthreads();
#pragma unroll
            for (int i = 0; i < 6; ++i) { const int idx = tid + NT * i, r = idx >> 5, c = idx & 31;
                *(u32x4*)(lds + RT_W + r * 512 + ((c ^ (r & 15)) << 4)) = *(const u32x4*)(rw + (size_t)r * 1024 + kc * 256 + c * 8); }
            f32x4 xa[8][2];
#pragma unroll
            for (int ks = 0; ks < 8; ++ks) { xa[ks][0] = *(const f32x4*)(hrow + kc * 256 + 32 * ks); xa[ks][1] = *(const f32x4*)(hrow + kc * 256 + 32 * ks + 4); }
            __syncthreads();
#pragma unroll
            for (int ks = 0; ks < 8; ++ks) {
                const f32x4 a = xa[ks][0], b = xa[ks][1];
                ss += ((a.x * a.x + a.y * a.y) + (a.z * a.z + a.w * a.w)) + ((b.x * b.x + b.y * b.y) + (b.z * b.z + b.w * b.w));
                u32x4 hi; hi.x = pk2(a.x, a.y); hi.y = pk2(a.z, a.w); hi.z = pk2(b.x, b.y); hi.w = pk2(b.z, b.w);
                u32x4 lo; lo.x = pk2(a.x - bflo(hi.x), a.y - bfhi(hi.x)); lo.y = pk2(a.z - bflo(hi.y), a.w - bfhi(hi.y)); lo.z = pk2(b.x - bflo(hi.z), b.y - bfhi(hi.z)); lo.w = pk2(b.z - bflo(hi.w), b.w - bfhi(hi.w));
                *(u32x4*)(hbrow + kc * 256 + 32 * ks) = hi;
                const bf16x8 hh = __builtin_bit_cast(bf16x8, hi), hl = __builtin_bit_cast(bf16x8, lo);
                const int co = ((4 * ks + fq) ^ frow) << 4;
#pragma unroll
                for (int nt = 0; nt < 3; ++nt) {
                    const bf16x8 whi = *(const bf16x8*)(lds + RT_W + (16 * nt + frow) * 512 + co), wlo = *(const bf16x8*)(lds + RT_W + (48 + 16 * nt + frow) * 512 + co);
                    acc[nt] = __builtin_amdgcn_mfma_f32_16x16x32_bf16(whi, hh, acc[nt], 0, 0, 0);
                    acc[nt] = __builtin_amdgcn_mfma_f32_16x16x32_bf16(wlo, hh, acc[nt], 0, 0, 0);
                    acc[nt] = __builtin_amdgcn_mfma_f32_16x16x32_bf16(whi, hl, acc[nt], 0, 0, 0);
                }
            }
        }
        ss += __shfl_xor(ss, 16); ss += __shfl_xor(ss, 32);
        if (fq == 0) rsd[16 * wid + frow] = rsqrtf(ss * (1.f / DM) + RMS_EPS);
#pragma unroll
        for (int nt = 0; nt < 3; ++nt) { float* o = lg + (16 * wid + frow) * 49 + 16 * nt + 4 * fq; o[0] = acc[nt].x; o[1] = acc[nt].y; o[2] = acc[nt].z; o[3] = acc[nt].w; }
        __syncthreads();
        int bin = 0, slot = 0;
        if (tid < 128) {
            const float rs = rsd[tid];
            ((float*)(ws + WS_RSTD2))[row0 + tid] = rs;
            float gl[4]; int gi = 0; float gm = -1e30f;
#pragma unroll
            for (int c = 0; c < 4; ++c) { gl[c] = lg[tid * 49 + c] * rs + p.b_group[c]; if (gl[c] > gm) { gm = gl[c]; gi = c; } }
            float gs = 0.f;
#pragma unroll
            for (int c = 0; c < 4; ++c) gs += __expf(gl[c] - gm);
            const float pg = 1.f / gs;
            float el[8]; int i0 = 0; float m0 = -1e30f;
#pragma unroll
            for (int c = 0; c < 8; ++c) { el[c] = lg[tid * 49 + 4 + gi * 8 + c] * rs + p.b_expert[gi * 8 + c]; if (el[c] > m0) { m0 = el[c]; i0 = c; } }
            int i1 = 0; float m1 = -1e30f;
#pragma unroll
            for (int c = 0; c < 8; ++c) if (c != i0 && el[c] > m1) { m1 = el[c]; i1 = c; }
            const float e1 = __expf(m1 - m0); const float w0 = pg / (1.f + e1), w1 = pg * e1 / (1.f + e1);
            const int a = min(i0, i1), bb = max(i0, i1);
            bin = gi * 28 + (7 * a - (a * (a - 1)) / 2) + (bb - a - 1);
            f32x2 tw; tw.x = (i0 < i1) ? w0 : w1; tw.y = (i0 < i1) ? w1 : w0;
            ((f32x2*)(ws + WS_TOKW))[row0 + tid] = tw;
            slot = atomicAdd(&hist[bin], 1);
        }
        __syncthreads();
        if (tid < NBIN) { const int h = hist[tid]; basep[tid] = h ? atomicAdd((int*)(ws + WS_CTL) + tid, h) : 0; }
        __syncthreads();
        if (tid < 128) ((int*)(ws + WS_BINL))[(size_t)bin * BINCAP + basep[bin] + slot] = (int)(row0 + tid);
        __syncthreads();
    }
}

constexpr int MOE_TS = pg8::STAGE_BYTES, MOE_TT = MOE_TS + 512;
DEV void moe_tiles(const Params& p, unsigned char* lds) {
    int* tstart = (int*)(lds + MOE_TS); int* tiletab = (int*)(lds + MOE_TT);
    const int tid = threadIdx.x;
    __syncthreads();
    if (tid == 0) { const int* cnt = (const int*)(p.ws + WS_CTL); int s = 0; for (int i = 0; i < NBIN; ++i) { tstart[i] = s; s += (cnt[i] + 255) >> 8; } tstart[NBIN] = s; }
    __syncthreads();
    if (tid < NBIN) for (int t = tstart[tid]; t < tstart[tid + 1]; ++t) tiletab[t] = tid;
    __syncthreads();
}
DEV void bin_experts(int bin, int& ea, int& eb) { const int gi = bin / 28; int pi = bin % 28, a = 0; while (pi >= 7 - a) { pi -= 7 - a; ++a; } ea = gi * 8 + a; eb = gi * 8 + a + 1 + pi; }
struct MoeUnit { int tile, nt, bin, mt, n; };
struct MoeSchedBase {
    const Params& p; const int* tstart; const int* tiletab; int NN, U, G, c;
    DEV bool next(int i, MoeUnit& u) const {
        const int L = i * G + c; if (L >= U) return false;
        u.tile = L / NN; u.nt = L % NN;
        u.bin = __builtin_amdgcn_readfirstlane(tiletab[u.tile]);
        u.mt = u.tile - __builtin_amdgcn_readfirstlane(tstart[u.bin]);
        const int cnt = ((const int*)(p.ws + WS_CTL))[u.bin];
        u.n = min(256, cnt - u.mt * 256);
        return true;
    }
    DEV bool full(const MoeUnit& u) const { return u.n > 128; }
};
struct PolMoe1 : MoeSchedBase {
    typedef MoeUnit Unit;
    struct AddrA { unsigned off[2][2]; };
    struct AddrB { const char* base; unsigned voff[2]; };
    DEV int nk() const { return 16; }
    DEV void addrA(const MoeUnit& u, const int (&R)[2], const int (&C)[2], AddrA& a) const {
        const int* list = (const int*)(p.ws + WS_BINL) + (size_t)u.bin * BINCAP + u.mt * 256;
#pragma unroll
        for (int h = 0; h < 2; ++h)
#pragma unroll
            for (int i = 0; i < 2; ++i) { int r = h * 128 + R[i]; if (r >= u.n) r = 0; a.off[h][i] = (unsigned)list[r] * 2048u + (unsigned)C[i] * 2u; }
    }
    DEV void addrB(const MoeUnit& u, const int (&R)[2], const int (&C)[2], AddrB& b) const {
        int ea, eb; bin_experts(u.bin, ea, eb); const int e = u.nt < 4 ? ea : eb;
        b.base = (const char*)(p.ws + WS_W13T) + ((size_t)e * 1024 + (u.nt & 3) * 256) * 2048;
#pragma unroll
        for (int i = 0; i < 2; ++i) b.voff[i] = (unsigned)(R[i] * 1024 + C[i]) * 2u;
    }
    DEV const char* pa(const AddrA& a, int h, int i, int kt) const { return (const char*)(p.ws + WS_R1) + a.off[h][i] + kt * 128; }
    DEV const char* pb(const AddrB& b, int h, int i, int kt) const { return b.base + (size_t)h * (128 * 2048) + b.voff[i] + kt * 128; }
};
struct EpiMoe1 { const Params& p;
    DEV void operator()(const f32x4 (&acc)[2][2][4][2], const MoeUnit& u, int wr, int wc, int fr, int fq) const {
        const int* list = (const int*)(p.ws + WS_BINL) + (size_t)u.bin * BINCAP + u.mt * 256;
        bf16_t* hbuf = (bf16_t*)(p.ws + WS_HBUF) + (size_t)u.tile * 256 * 1024 + (u.nt < 4 ? 0 : 512);
#pragma unroll
        for (int ai = 0; ai < 2; ++ai)
#pragma unroll
            for (int m = 0; m < 4; ++m) { const int r = ai * 128 + wr * 64 + m * 16 + fr; if (r >= u.n) continue;
                const int t = list[r]; const float rs = ((const float*)(p.ws + WS_RSTD2))[t]; const f32x2 tw = ((const f32x2*)(p.ws + WS_TOKW))[t]; const float w = u.nt < 4 ? tw.x : tw.y;
#pragma unroll
                for (int bj = 0; bj < 2; ++bj)
#pragma unroll
                    for (int n = 0; n < 2; ++n) { const f32x4 v = acc[ai][bj][m][n] * rs; const int f = ((u.nt & 3) * 256 + 128 * bj + 32 * wc + 16 * n + 4 * fq) >> 1;
                        *(unsigned*)(hbuf + (size_t)r * 1024 + f) = pk2(siluf_(v.x) * v.y * w, siluf_(v.z) * v.w * w); } }
    } };
DEV void phase_moe1(const Params& p, unsigned char* lds) {
    moe_tiles(p, lds);
    const int* tstart = (const int*)(lds + MOE_TS);
    PolMoe1 P{{p, tstart, (const int*)(lds + MOE_TT), 8, tstart[NBIN] * 8, (int)gridDim.x, vblock()}};
    EpiMoe1 E{p};
    pg8::gemm_phase2((PG8_LAS unsigned char*)lds, P, E);
}
struct PolMoe2 : MoeSchedBase {
    typedef MoeUnit Unit;
    struct AddrA { const char* base; unsigned voff[2]; };
    struct AddrB { const char* ba; const char* bb; unsigned voff[2]; };
    DEV int nk() const { return 16; }
    DEV void addrA(const MoeUnit& u, const int (&R)[2], const int (&C)[2], AddrA& a) const {
        a.base = (const char*)(p.ws + WS_HBUF) + (size_t)u.tile * 256 * 2048;
#pragma unroll
        for (int i = 0; i < 2; ++i) a.voff[i] = (unsigned)(R[i] * 1024 + C[i]) * 2u;
    }
    DEV void addrB(const MoeUnit& u, const int (&R)[2], const int (&C)[2], AddrB& b) const {
        int ea, eb; bin_experts(u.bin, ea, eb);
        b.ba = (const char*)(p.ws + WS_W2T) + ((size_t)ea * 1024 + u.nt * 256) * 1024; b.bb = (const char*)(p.ws + WS_W2T) + ((size_t)eb * 1024 + u.nt * 256) * 1024;
#pragma unroll
        for (int i = 0; i < 2; ++i) b.voff[i] = (unsigned)(R[i] * 512 + C[i]) * 2u;
    }
    DEV const char* pa(const AddrA& a, int h, int i, int kt) const { return a.base + (size_t)h * (128 * 2048) + a.voff[i] + kt * 128; }
    DEV const char* pb(const AddrB& b, int h, int i, int kt) const { return (kt < 8 ? b.ba + kt * 128 : b.bb + (kt - 8) * 128) + (size_t)h * (128 * 1024) + b.voff[i]; }
};
struct EpiMoe2 { const Params& p;
    DEV void operator()(const f32x4 (&acc)[2][2][4][2], const MoeUnit& u, int wr, int wc, int fr, int fq) const {
        const int* list = (const int*)(p.ws + WS_BINL) + (size_t)u.bin * BINCAP + u.mt * 256;
#pragma unroll
        for (int ai = 0; ai < 2; ++ai)
#pragma unroll
            for (int m = 0; m < 4; ++m) { const int r = ai * 128 + wr * 64 + m * 16 + fr; if (r >= u.n) continue; const size_t t = list[r];
#pragma unroll
                for (int bj = 0; bj < 2; ++bj)
#pragma unroll
                    for (int n = 0; n < 2; ++n) { float* o = p.out + t * DM + u.nt * 256 + 128 * bj + 32 * wc + 16 * n + 4 * fq; *(f32x4*)o = *(const f32x4*)o + acc[ai][bj][m][n]; } }
    } };
DEV void phase_moe2(const Params& p, unsigned char* lds) {
    moe_tiles(p, lds);
    const int* tstart = (const int*)(lds + MOE_TS);
    PolMoe2 P{{p, tstart, (const int*)(lds + MOE_TT), 4, tstart[NBIN] * 4, (int)gridDim.x, vblock()}};
    EpiMoe2 E{p};
    pg8::gemm_phase2((PG8_LAS unsigned char*)lds, P, E);
}

#define XB_TMO      128
#define XB_XCNT(j)  (256  + 64 * (j))
#define XB_XSUB(j)  (1280 + 64 * (j))
#define XB_XGEN(j)  (2304 + 64 * (j))
#define XB_TOP      3328
#define XB_TOPGEN   3392
#define XCD_BAR_WORDS 3456
#define XB_SPIN_CAP (1u << 20)
#define LAS __attribute__((address_space(3)))
constexpr size_t WS_BAR = WS_CTL + 4096;
DEV unsigned xb_ld(unsigned* p) { return __hip_atomic_load(p, __ATOMIC_RELAXED, __HIP_MEMORY_SCOPE_AGENT); }
DEV unsigned xb_add(unsigned* p, unsigned v) { return __hip_atomic_fetch_add(p, v, __ATOMIC_RELAXED, __HIP_MEMORY_SCOPE_AGENT); }
DEV unsigned xb_xcc_id() { return (unsigned)__builtin_amdgcn_s_getreg((3 << 11) | 20) & 0xFu; }
#define XB_SPIN(cond, bar) do { unsigned _sp = 0; while (cond) { __builtin_amdgcn_s_sleep(1); \
    if ((++_sp & 255u) == 0u) { if (xb_ld(&(bar)[XB_TMO])) break; if (_sp > XB_SPIN_CAP) { atomicAdd(&(bar)[XB_TMO], 1u); break; } } } } while (0)
struct XcdBarrier { unsigned* bar; unsigned x; volatile LAS unsigned* st; };
DEV XcdBarrier xcd_barrier_post(unsigned* bar, volatile LAS unsigned* st) {
    XcdBarrier b; b.bar = bar; b.x = xb_xcc_id(); b.st = st;
    if (threadIdx.x == 0) (void)xb_add(&bar[XB_XCNT(b.x)], 1u);
    return b;
}
DEV void xcd_barrier_complete(unsigned* bar, unsigned x, unsigned& nloc, unsigned& nx) {
    const unsigned G = gridDim.x * gridDim.y * gridDim.z;
    unsigned sum, cnt, mine, sp = 0u;
    for (;;) {
        sum = 0u; cnt = 0u; mine = 0u;
#pragma unroll
        for (unsigned j = 0; j < 16; ++j) { const unsigned c = xb_ld(&bar[XB_XCNT(j)]); sum += c; cnt += (c > 0u) ? 1u : 0u; mine = (j == x) ? c : mine; }
        if (sum == G) break;
        __builtin_amdgcn_s_sleep(1);
        if ((++sp & 255u) == 0u) { if (xb_ld(&bar[XB_TMO])) break; if (sp > XB_SPIN_CAP) { atomicAdd(&bar[XB_TMO], 1u); break; } }
    }
    nloc = mine > 0u ? mine : 1u; nx = cnt > 0u ? cnt : 1u;
}
DEV void xcd_barrier(const XcdBarrier& b) {
    asm volatile("s_waitcnt vmcnt(0)" ::: "memory");
    __syncthreads();
    if (threadIdx.x == 0) {
        unsigned* bar = b.bar;
        __builtin_amdgcn_s_waitcnt(0);
        unsigned nloc = b.st[0], nx = b.st[1];
        if (nloc == 0u) { xcd_barrier_complete(bar, b.x, nloc, nx); b.st[0] = nloc; b.st[1] = nx; }
        const unsigned old = xb_add(&bar[XB_XSUB(b.x)], 1u);
        const unsigned gen = old / nloc;
        if (old + 1u == (gen + 1u) * nloc) {
            __builtin_amdgcn_fence(__ATOMIC_RELEASE, "agent");
            asm volatile("s_waitcnt vmcnt(0)" ::: "memory");
            const unsigned og = xb_add(&bar[XB_TOP], 1u);
            const unsigned tg = og / nx;
            if (og + 1u == (tg + 1u) * nx) xb_add(&bar[XB_TOPGEN], 1u);
            else XB_SPIN(xb_ld(&bar[XB_TOPGEN]) == tg, bar);
            __builtin_amdgcn_fence(__ATOMIC_ACQUIRE, "agent");
            xb_add(&bar[XB_XGEN(b.x)], 1u);
            asm volatile("s_waitcnt vmcnt(0)" ::: "memory");
        } else {
            XB_SPIN(xb_ld(&bar[XB_XGEN(b.x)]) == gen, bar);
            __builtin_amdgcn_fence(__ATOMIC_ACQUIRE, "agent");
            asm volatile("s_waitcnt vmcnt(0)" ::: "memory");
        }
    }
    __syncthreads();
}

constexpr int LDS_BYTES = 144 * 1024;
constexpr int N_PHASES = 10;
__global__ void __launch_bounds__(NT) mega(Params p, int lo, int hi) {
    extern __shared__ __attribute__((aligned(16))) unsigned char lds[];
    volatile LAS unsigned* xst = (volatile LAS unsigned*)(lds + LDS_BYTES - 16);
    if (threadIdx.x < 4) xst[threadIdx.x] = 0u;
    __syncthreads();
    XcdBarrier xbar; xbar.bar = (unsigned*)(p.ws + WS_BAR); xbar.x = 0; xbar.st = xst;
    if (hi - lo > 1) xbar = xcd_barrier_post((unsigned*)(p.ws + WS_BAR), xst);
#define GRID_SYNC() xcd_barrier(xbar)
#ifndef PROBE_REPEAT
#define PROBE_REPEAT -1
#endif
#define RUN_PHASE(k, call) do { if (lo <= (k) && (k) < hi) { call; \
        if ((k) == PROBE_REPEAT) { GRID_SYNC(); \
            if ((k) == 5) { float* rz = (float*)(p.ws + WS_ROWSS); for (int i = blockIdx.x * NT + threadIdx.x; i < NTOK; i += gridDim.x * NT) rz[i] = 0.f; GRID_SYNC(); } \
            if ((k) == 8) { if (blockIdx.x == 0 && threadIdx.x < 128) ((int*)(p.ws + WS_CTL))[threadIdx.x] = 0; GRID_SYNC(); } \
            call; } \
        if ((k) + 1 < hi) GRID_SYNC(); } } while (0)
    RUN_PHASE(0, phase_prologue(p, lds));
    RUN_PHASE(1, phase_inproj(p, lds));
    RUN_PHASE(2, { phase_cmp_a(p, lds); const int G_ = (int)gridDim.x; if (G_ > 128) phase_hgrn_a1(p, lds, 64, G_ - 64); else phase_hgrn_a1(p, lds, 0, G_); });
    RUN_PHASE(3, { phase_cmp_b(p, lds); phase_hgrn_a2(p, lds); });
    RUN_PHASE(4, { phase_cmp_attn(p, lds); phase_hgrn_a3(p, lds); });
    RUN_PHASE(5, phase_flash(p, lds));
    RUN_PHASE(6, phase_normalize(p, lds));
    RUN_PHASE(7, phase_outproj(p, lds));
    RUN_PHASE(8, phase_router(p, lds));
    RUN_PHASE(9, phase_moe1(p, lds));
    RUN_PHASE(10, phase_moe2(p, lds));
#undef RUN_PHASE
}

extern "C" void kernel_launch(void* const* d_in, const int* in_sizes, int n_in, void* d_out, int out_size, void* d_ws, size_t ws_size, hipStream_t stream) {
    static int grid = 0;
    if (grid == 0) {
        int dev = 0, cus = 0, per_cu = 0;
        hipGetDevice(&dev);
        hipDeviceGetAttribute(&cus, hipDeviceAttributeMultiprocessorCount, dev);
        hipFuncSetAttribute((const void*)mega, hipFuncAttributeMaxDynamicSharedMemorySize, LDS_BYTES);
        hipOccupancyMaxActiveBlocksPerMultiprocessor(&per_cu, (const void*)mega, NT, LDS_BYTES);
        if (per_cu < 1) per_cu = 1;
        grid = cus;
        if (ws_size < WS_END) fprintf(stderr, "kernel_launch: workspace too small: %zu < %zu\n", ws_size, (size_t)WS_END);
        fprintf(stderr, "kernel_launch: cus %d per_cu %d grid %d ws %zu\n", cus, per_cu, grid, ws_size);
    }
    Params p{};
    const float** pp = (const float**)&p;
    for (int i = 0; i < 23; ++i) pp[i] = (const float*)d_in[i];
    p.out = (float*)d_out; p.ws = (unsigned char*)d_ws;
#if N_LAUNCH_MODE == 1
    (void)hipMemsetAsync((unsigned char*)d_ws + WS_BAR, 0, XCD_BAR_WORDS * 4, stream);
    int lo = 0, hi = N_PHASES + 1;
    void* args[] = {&p, &lo, &hi};
    hipError_t e = hipLaunchCooperativeKernel((const void*)mega, dim3(grid), dim3(NT), args, LDS_BYTES, stream);
    if (e != hipSuccess) fprintf(stderr, "cooperative launch failed: %s\n", hipGetErrorString(e));
#else
    for (int ph = 0; ph <= N_PHASES; ++ph) hipLaunchKernelGGL(mega, dim3(grid), dim3(NT), LDS_BYTES, stream, p, ph, ph + 1);
#endif
}
```

```cpp
#include <hip/hip_runtime.h>
#include <hip/hip_cooperative_groups.h>
#include <cstdio>
#include <cstdint>
#include <cstring>
namespace cg = cooperative_groups;

#ifndef N_LAUNCH_MODE
#define N_LAUNCH_MODE 1
#endif

#define DEV __device__ __forceinline__
typedef unsigned short bf16_t;
typedef short bf16x8 __attribute__((ext_vector_type(8)));
typedef float f32x4 __attribute__((ext_vector_type(4)));
typedef float f32x2 __attribute__((ext_vector_type(2)));
typedef float f32x16 __attribute__((ext_vector_type(16)));
typedef unsigned u32x4 __attribute__((ext_vector_type(4)));
typedef unsigned u32x2 __attribute__((ext_vector_type(2)));

constexpr int NT = 512;
constexpr int BATCH = 8, SEQ = 4096, DM = 1024, NTOK = BATCH * SEQ;
constexpr int IN_COLS = 3352, INP = 3584;
constexpr int NC = 255;
constexpr float RMS_EPS = 1e-6f;
constexpr float QSCALE = 0.125f * 1.4426950408889634f;
constexpr int NBIN = 112;
constexpr int BINCAP = NTOK;

constexpr size_t MiB = 1ull << 20;
constexpr size_t WS_CTL    = 0;
constexpr size_t WS_RSTD1  = 1 * MiB;
constexpr size_t WS_RSTD2  = WS_RSTD1 + 128 * 1024;
constexpr size_t WS_ROWSS  = WS_RSTD2 + 128 * 1024;
constexpr size_t WS_TOKW   = WS_ROWSS + 128 * 1024;
constexpr size_t WS_LB     = WS_TOKW + 256 * 1024;
constexpr size_t WS_CBIAS  = WS_LB + 4096;
constexpr size_t WS_SELM   = 2 * MiB;
constexpr size_t WS_GATES  = 3 * MiB;
constexpr size_t WS_KCMP   = 6 * MiB;
constexpr size_t WS_VCMP   = WS_KCMP + 512 * 1024;
constexpr size_t WS_CW2T   = 7 * MiB;
constexpr size_t WS_RW     = 7 * MiB + 128 * 1024;
constexpr size_t WS_HID    = 8 * MiB;
constexpr size_t WS_CW1T   = 12 * MiB;
constexpr size_t WS_WOUTT  = 14 * MiB;
constexpr size_t WS_WINT   = 16 * MiB;
constexpr size_t WS_R1     = 24 * MiB;
constexpr size_t WS_Q      = 88 * MiB;
constexpr size_t WS_KC     = 120 * MiB;
constexpr size_t WS_VC     = 128 * MiB;
constexpr size_t WS_KS     = 136 * MiB;
constexpr size_t WS_KW     = 144 * MiB;
constexpr size_t WS_VST    = 152 * MiB;
constexpr size_t WS_VWT    = 160 * MiB;
constexpr size_t WS_OC     = 168 * MiB;
constexpr size_t WS_W13T   = 200 * MiB;
constexpr size_t WS_W2T    = 264 * MiB;
constexpr size_t WS_HQ     = 296 * MiB;
constexpr size_t WS_HV     = 328 * MiB;
constexpr size_t WS_HG     = 360 * MiB;
constexpr size_t WS_HLOGF  = 392 * MiB;
constexpr size_t WS_DBUF   = 456 * MiB;
constexpr size_t WS_END    = 457 * MiB;
constexpr size_t WS_UBUF   = WS_W13T;
constexpr size_t WS_BINL   = WS_HQ;
constexpr size_t WS_HBUF   = WS_HQ + 16 * MiB;
constexpr size_t WS_EL     = WS_HQ + 136 * MiB;
constexpr size_t WS_EW     = WS_HQ + 140 * MiB;
constexpr size_t WS_EDST   = WS_HQ + 144 * MiB;

struct Params {
    const float *x, *attn_g, *ffn_g, *w_in, *w_out, *g_q, *g_k, *pos_k, *pos_v, *wk1, *wk2, *wv1, *wv2, *g_nsa, *lb_logits, *g_hn,
        *w_group, *b_group, *w_expert, *b_expert, *w1, *w3, *w2;
    float* out;
    unsigned char* ws;
};

typedef __bf16 bf16x2_t __attribute__((ext_vector_type(2)));
DEV unsigned pk2(float lo, float hi) { f32x2 f = {lo, hi}; return __builtin_bit_cast(unsigned, __builtin_convertvector(f, bf16x2_t)); }
DEV bf16_t f2bf(float f) { return (bf16_t)(pk2(f, 0.f) & 0xffffu); }
DEV float bf2f(bf16_t b) { return __uint_as_float(((unsigned)b) << 16); }
DEV float bflo(unsigned u) { return __uint_as_float(u << 16); }
DEV float bfhi(unsigned u) { return __uint_as_float(u & 0xffff0000u); }
DEV float sigmoidf_(float v) { return __builtin_amdgcn_rcpf(1.f + __builtin_amdgcn_exp2f(-1.4426950408889634f * v)); }
DEV float siluf_(float v) { return v * __builtin_amdgcn_rcpf(1.f + __builtin_amdgcn_exp2f(-1.4426950408889634f * v)); }
DEV float wave_sum(float v) {
#pragma unroll
    for (int o = 1; o < 64; o <<= 1) v += __shfl_xor(v, o);
    return v;
}
DEV float wave_max(float v) {
#pragma unroll
    for (int o = 1; o < 64; o <<= 1) v = fmaxf(v, __shfl_xor(v, o));
    return v;
}
DEV int vblock() { const int G = gridDim.x, b = blockIdx.x; return (G % 8 == 0) ? (b % 8) * (G / 8) + b / 8 : b; }

namespace pg8 {
#define PG8_LAS __attribute__((address_space(3)))
constexpr int BM = 256, BK = 64, HALF = 128, HTB = HALF * BK * 2, STAGE_BYTES = 8 * HTB, NXCD = 8, WGM = 8;
__host__ __device__ __forceinline__ int lds_byte(int r, int c) { const int st = (r >> 4) * 2 + (c >> 5), rr = r & 15, cc = c & 31, ob = rr * 64 + cc * 2; return st * 1024 + (ob ^ (((ob >> 9) & 1) << 5)); }
__host__ __device__ __forceinline__ void stage_rc(int b, int& R, int& C) { const int st = b / 1024, sb = b % 1024, swz = sb ^ (((sb >> 9) & 1) << 5); R = (st >> 1) * 16 + swz / 64; C = (st & 1) * 32 + (swz % 64) / 2; }
struct Unit { int pm, pn; };
struct Gemm { const bf16_t* A; const bf16_t* Bt; int M, N, K; };
struct StaticOrder {
    int nM, nN, nwg, G, c;
    __host__ __device__ void init(int M, int N, int G_, int c_) { nM = M / BM; nN = N / BM; nwg = nM * nN; G = G_; c = c_; }
    __host__ __device__ bool next(int i, Unit& u) const {
        const long L = (long)i * G + c; if (L >= nwg) return false;
        int wgid = (int)L; { const int q = nwg / NXCD, r = nwg % NXCD, xcd = wgid % NXCD, off = wgid / NXCD; wgid = (xcd < r ? xcd * (q + 1) : r * (q + 1) + (xcd - r) * q) + off; }
        const int nig = WGM * nN, gid = wgid / nig, fm = gid * WGM, gsz = (nM - fm) < WGM ? (nM - fm) : WGM;
        u.pm = fm + ((wgid % nig) % gsz); u.pn = (wgid % nig) / gsz; return true;
    }
};
template <class Epi, class Sched>
__device__ __forceinline__ void gemm_phase(PG8_LAS unsigned char* lds, const Gemm g, const Sched& S, const Epi& E) {
    const int tid = threadIdx.x, wid = __builtin_amdgcn_readfirstlane(tid >> 6), lane = tid & 63, wr = wid >> 2, wc = wid & 3, fr = lane & 15, fq = lane >> 4;
    const int K = g.K, nt = K / BK;
    unsigned voffA[2];
#pragma unroll
    for (int i = 0; i < 2; ++i) { int R, C; stage_rc(tid * 16 + i * 8192, R, C); voffA[i] = (unsigned)(R * K + C) * 2u; }
    const size_t kstep = (size_t)(BK * 2);
    const size_t hstep = (size_t)HALF * K * 2;
    const size_t tstep = 2 * hstep;
    const unsigned ldsw = (unsigned)wid * 1024u;
    const int aoff = lds_byte(wr * 64 + fr, fq * 8), boff = lds_byte(wc * 32 + fr, fq * 8);
#define PG8_SA(b, h) (((b) * 2 + (h)) * HTB)
#define PG8_SB(b, h) ((4 + (b) * 2 + (h)) * HTB)
#define PG8_STAGE(bufoff, gbase, voff) do { _Pragma("unroll") for (int _i = 0; _i < 2; ++_i) \
        __builtin_amdgcn_global_load_lds((const unsigned*)((const char*)(gbase) + (voff)[_i]), (PG8_LAS unsigned*)(lds + (bufoff) + ldsw + _i * 8192), 16, 0, 0); } while (0)
#define PG8_LDA(dst, b, h) do { _Pragma("unroll") for (int m = 0; m < 4; ++m) _Pragma("unroll") for (int k = 0; k < 2; ++k) dst[m][k] = *(const PG8_LAS bf16x8*)(lds + PG8_SA(b, h) + aoff + m * 2048 + k * 1024); } while (0)
#define PG8_LDB(dst, b, h) do { _Pragma("unroll") for (int n = 0; n < 2; ++n) _Pragma("unroll") for (int k = 0; k < 2; ++k) dst[n][k] = *(const PG8_LAS bf16x8*)(lds + PG8_SB(b, h) + boff + n * 2048 + k * 1024); } while (0)
#define PG8_MMA(ai, bj, At, Bt) do { __builtin_amdgcn_s_setprio(1); _Pragma("unroll") for (int m = 0; m < 4; ++m) _Pragma("unroll") for (int n = 0; n < 2; ++n) _Pragma("unroll") for (int k = 0; k < 2; ++k) \
        acc[ai][bj][m][n] = __builtin_amdgcn_mfma_f32_16x16x32_bf16(Bt[n][k], At[m][k], acc[ai][bj][m][n], 0, 0, 0); __builtin_amdgcn_s_setprio(0); } while (0)
#define PG8_WAIT_V(n) asm volatile("s_waitcnt vmcnt(" #n ")" ::: "memory")
#define PG8_WAIT_L(n) asm volatile("s_waitcnt lgkmcnt(" #n ")" ::: "memory")
#define PG8_BAR __builtin_amdgcn_s_barrier()
#define PG8_SCHED __builtin_amdgcn_sched_barrier(0)
    Unit cur, nxt; int ui = 0;
    if (!S.next(0, cur)) return;
    f32x4 acc[2][2][4][2];
#pragma unroll
    for (int a = 0; a < 2; ++a)
#pragma unroll
        for (int b = 0; b < 2; ++b)
#pragma unroll
            for (int m = 0; m < 4; ++m)
#pragma unroll
                for (int n = 0; n < 2; ++n) acc[a][b][m][n] = (f32x4){0.f, 0.f, 0.f, 0.f};
    bf16x8 At[4][2], B0[2][2], B1[2][2];
    const char* cA = (const char*)g.A + (size_t)cur.pm * tstep; const char* cB = (const char*)g.Bt + (size_t)cur.pn * tstep;
    PG8_STAGE(PG8_SB(0, 0), cB, voffA); PG8_STAGE(PG8_SA(0, 0), cA, voffA); PG8_STAGE(PG8_SB(0, 1), cB + hstep, voffA); PG8_STAGE(PG8_SA(0, 1), cA + hstep, voffA);
    if (wr == 1) PG8_BAR;
    PG8_WAIT_V(4); PG8_BAR;
    PG8_STAGE(PG8_SB(1, 0), cB + kstep, voffA); PG8_STAGE(PG8_SA(1, 0), cA + kstep, voffA); PG8_STAGE(PG8_SB(1, 1), cB + hstep + kstep, voffA);
    PG8_WAIT_V(6); PG8_BAR;
    for (;;) {
        const bool has_next = S.next(ui + 1, nxt);
        const char* nA = has_next ? (const char*)g.A + (size_t)nxt.pm * tstep : cA; const char* nB = has_next ? (const char*)g.Bt + (size_t)nxt.pn * tstep : cB;
        for (int t = 0; t < nt; t += 2) {
            const bool last = (t == nt - 2);
            const char* a1 = cA + (size_t)(t + 1) * kstep;
            const char* a2 = last ? nA : cA + (size_t)(t + 2) * kstep; const char* b2 = last ? nB : cB + (size_t)(t + 2) * kstep;
            const char* a3 = a2 + kstep; const char* b3 = b2 + kstep;
            PG8_LDB(B0, 0, 0); PG8_SCHED; PG8_LDA(At, 0, 0); PG8_STAGE(PG8_SA(1, 1), a1 + hstep, voffA);
            PG8_WAIT_L(8); PG8_BAR; PG8_WAIT_L(0); PG8_MMA(0, 0, At, B0); PG8_BAR; PG8_SCHED;
            PG8_LDB(B1, 0, 1); PG8_STAGE(PG8_SB(0, 0), b2, voffA);
            PG8_BAR; PG8_WAIT_L(0); PG8_MMA(0, 1, At, B1); PG8_BAR;
            PG8_LDA(At, 0, 1); PG8_STAGE(PG8_SA(0, 0), a2, voffA);
            PG8_BAR; PG8_WAIT_L(0); PG8_MMA(1, 0, At, B0); PG8_BAR; PG8_SCHED;
            PG8_STAGE(PG8_SB(0, 1), b2 + hstep, voffA);
            PG8_WAIT_V(6); PG8_BAR; PG8_MMA(1, 1, At, B1); PG8_BAR;
            PG8_LDB(B0, 1, 0); PG8_SCHED; PG8_LDA(At, 1, 0); PG8_STAGE(PG8_SA(0, 1), a2 + hstep, voffA);
            PG8_WAIT_L(8); PG8_BAR; PG8_WAIT_L(0); PG8_MMA(0, 0, At, B0); PG8_BAR; PG8_SCHED;
            PG8_LDB(B1, 1, 1); PG8_STAGE(PG8_SB(1, 0), b3, voffA);
            PG8_BAR; PG8_WAIT_L(0); PG8_MMA(0, 1, At, B1); PG8_BAR;
            PG8_LDA(At, 1, 1); PG8_STAGE(PG8_SA(1, 0), a3, voffA);
            PG8_BAR; PG8_WAIT_L(0); PG8_MMA(1, 0, At, B0); PG8_BAR; PG8_SCHED;
            PG8_STAGE(PG8_SB(1, 1), b3 + hstep, voffA);
            PG8_WAIT_V(6); PG8_BAR; PG8_MMA(1, 1, At, B1); PG8_BAR;
        }
        E(acc, cur, wr, wc, fr, fq);
        if (!has_next) break;
#pragma unroll
        for (int a = 0; a < 2; ++a)
#pragma unroll
            for (int b = 0; b < 2; ++b)
#pragma unroll
                for (int m = 0; m < 4; ++m)
#pragma unroll
                    for (int n = 0; n < 2; ++n) acc[a][b][m][n] = (f32x4){0.f, 0.f, 0.f, 0.f};
        cur = nxt; cA = nA; cB = nB; ++ui;
    }
    PG8_WAIT_V(0);
    if (wr == 0) PG8_BAR;
    PG8_BAR;
#undef PG8_SA
#undef PG8_SB
#undef PG8_STAGE
#undef PG8_LDA
#undef PG8_LDB
#undef PG8_MMA
#undef PG8_WAIT_V
#undef PG8_WAIT_L
#undef PG8_BAR
#undef PG8_SCHED
}
template <class Pol, class Epi>
__device__ __forceinline__ void gemm_phase2(PG8_LAS unsigned char* lds, const Pol& P, const Epi& E) {
    const int tid = threadIdx.x, wid = __builtin_amdgcn_readfirstlane(tid >> 6), lane = tid & 63, wr = wid >> 2, wc = wid & 3, fr = lane & 15, fq = lane >> 4;
    const int nt = P.nk();
    const unsigned ldsw = (unsigned)wid * 1024u;
    const int aoff = lds_byte(wr * 64 + fr, fq * 8), boff = lds_byte(wc * 32 + fr, fq * 8);
#define PG8_SA(b, h) (((b) * 2 + (h)) * HTB)
#define PG8_SB(b, h) ((4 + (b) * 2 + (h)) * HTB)
#define PG8_STAGE_A(bufoff, AS, h, kt) do { _Pragma("unroll") for (int _i = 0; _i < 2; ++_i) \
        __builtin_amdgcn_global_load_lds((const unsigned*)P.pa(AS, h, _i, kt), (PG8_LAS unsigned*)(lds + (bufoff) + ldsw + _i * 8192), 16, 0, 0); } while (0)
#define PG8_STAGE_B(bufoff, BS, h, kt) do { _Pragma("unroll") for (int _i = 0; _i < 2; ++_i) \
        __builtin_amdgcn_global_load_lds((const unsigned*)P.pb(BS, h, _i, kt), (PG8_LAS unsigned*)(lds + (bufoff) + ldsw + _i * 8192), 16, 0, 0); } while (0)
#define PG8_LDA(dst, b, h) do { _Pragma("unroll") for (int m = 0; m < 4; ++m) _Pragma("unroll") for (int k = 0; k < 2; ++k) dst[m][k] = *(const PG8_LAS bf16x8*)(lds + PG8_SA(b, h) + aoff + m * 2048 + k * 1024); } while (0)
#define PG8_LDB(dst, b, h) do { _Pragma("unroll") for (int n = 0; n < 2; ++n) _Pragma("unroll") for (int k = 0; k < 2; ++k) dst[n][k] = *(const PG8_LAS bf16x8*)(lds + PG8_SB(b, h) + boff + n * 2048 + k * 1024); } while (0)
#define PG8_MMA(ai, bj, At, Bt) do { __builtin_amdgcn_s_setprio(1); _Pragma("unroll") for (int m = 0; m < 4; ++m) _Pragma("unroll") for (int n = 0; n < 2; ++n) _Pragma("unroll") for (int k = 0; k < 2; ++k) \
        acc[ai][bj][m][n] = __builtin_amdgcn_mfma_f32_16x16x32_bf16(Bt[n][k], At[m][k], acc[ai][bj][m][n], 0, 0, 0); __builtin_amdgcn_s_setprio(0); } while (0)
#define PG8_STAGE_A2(bufoff, h, kt) do { _Pragma("unroll") for (int _i = 0; _i < 2; ++_i) \
        __builtin_amdgcn_global_load_lds((const unsigned*)P.pa(a2, h, _i, kt), (PG8_LAS unsigned*)(lds + (bufoff) + ldsw + _i * 8192), 16, 0, 0); } while (0)
#define PG8_STAGE_B2(bufoff, h, kt) do { _Pragma("unroll") for (int _i = 0; _i < 2; ++_i) \
        __builtin_amdgcn_global_load_lds((const unsigned*)P.pb(b2, h, _i, kt), (PG8_LAS unsigned*)(lds + (bufoff) + ldsw + _i * 8192), 16, 0, 0); } while (0)
#define PG8_WAIT_V(n) asm volatile("s_waitcnt vmcnt(" #n ")" ::: "memory")
#define PG8_WAIT_L(n) asm volatile("s_waitcnt lgkmcnt(" #n ")" ::: "memory")
#define PG8_BAR __builtin_amdgcn_s_barrier()
#define PG8_SCHED __builtin_amdgcn_sched_barrier(0)
    typename Pol::Unit cur, nxt; int ui = 0;
    if (!P.next(0, cur)) return;
    f32x4 acc[2][2][4][2];
#pragma unroll
    for (int a = 0; a < 2; ++a)
#pragma unroll
        for (int b = 0; b < 2; ++b)
#pragma unroll
            for (int m = 0; m < 4; ++m)
#pragma unroll
                for (int n = 0; n < 2; ++n) acc[a][b][m][n] = (f32x4){0.f, 0.f, 0.f, 0.f};
    bf16x8 At[4][2], B0[2][2], B1[2][2];
    typename Pol::AddrA aC, aN; typename Pol::AddrB bC, bN;
    P.addrA(cur, aC); P.addrB(cur, bC);
    PG8_STAGE_B(PG8_SB(0, 0), bC, 0, 0); PG8_STAGE_A(PG8_SA(0, 0), aC, 0, 0); PG8_STAGE_B(PG8_SB(0, 1), bC, 1, 0); PG8_STAGE_A(PG8_SA(0, 1), aC, 1, 0);
    if (wr == 1) PG8_BAR;
    PG8_WAIT_V(4); PG8_BAR;
    PG8_STAGE_B(PG8_SB(1, 0), bC, 0, 1); PG8_STAGE_A(PG8_SA(1, 0), aC, 0, 1); PG8_STAGE_B(PG8_SB(1, 1), bC, 1, 1);
    PG8_WAIT_V(6); PG8_BAR;
    for (;;) {
        const bool has_next = P.next(ui + 1, nxt);
        if (has_next) { P.addrA(nxt, aN); P.addrB(nxt, bN); } else { aN = aC; bN = bC; }
        const bool full = P.full(cur);
        for (int t = 0; t < nt; t += 2) {
            const bool last = (t == nt - 2);
            const typename Pol::AddrA a2 = last ? aN : aC; const typename Pol::AddrB b2 = last ? bN : bC;
            const int k2 = last ? 0 : t + 2, k3 = k2 + 1;
            PG8_LDB(B0, 0, 0); PG8_SCHED; PG8_LDA(At, 0, 0); PG8_STAGE_A(PG8_SA(1, 1), aC, 1, t + 1);
            PG8_WAIT_L(8); PG8_BAR; PG8_WAIT_L(0); PG8_MMA(0, 0, At, B0); PG8_BAR; PG8_SCHED;
            PG8_LDB(B1, 0, 1); PG8_STAGE_B2(PG8_SB(0, 0), 0, k2);
            PG8_BAR; PG8_WAIT_L(0); PG8_MMA(0, 1, At, B1); PG8_BAR;
            PG8_LDA(At, 0, 1); PG8_STAGE_A2(PG8_SA(0, 0), 0, k2);
            PG8_BAR; PG8_WAIT_L(0); if (full) PG8_MMA(1, 0, At, B0); PG8_BAR; PG8_SCHED;
            PG8_STAGE_B2(PG8_SB(0, 1), 1, k2);
            PG8_WAIT_V(6); PG8_BAR; if (full) PG8_MMA(1, 1, At, B1); PG8_BAR;
            PG8_LDB(B0, 1, 0); PG8_SCHED; PG8_LDA(At, 1, 0); PG8_STAGE_A2(PG8_SA(0, 1), 1, k2);
            PG8_WAIT_L(8); PG8_BAR; PG8_WAIT_L(0); PG8_MMA(0, 0, At, B0); PG8_BAR; PG8_SCHED;
            PG8_LDB(B1, 1, 1); PG8_STAGE_B2(PG8_SB(1, 0), 0, k3);
            PG8_BAR; PG8_WAIT_L(0); PG8_MMA(0, 1, At, B1); PG8_BAR;
            PG8_LDA(At, 1, 1); PG8_STAGE_A2(PG8_SA(1, 0), 0, k3);
            PG8_BAR; PG8_WAIT_L(0); if (full) PG8_MMA(1, 0, At, B0); PG8_BAR; PG8_SCHED;
            PG8_STAGE_B2(PG8_SB(1, 1), 1, k3);
            PG8_WAIT_V(6); PG8_BAR; if (full) PG8_MMA(1, 1, At, B1); PG8_BAR;
        }
        E(acc, cur, wr, wc, fr, fq);
        if (!has_next) break;
#pragma unroll
        for (int a = 0; a < 2; ++a)
#pragma unroll
            for (int b = 0; b < 2; ++b)
#pragma unroll
                for (int m = 0; m < 4; ++m)
#pragma unroll
                    for (int n = 0; n < 2; ++n) acc[a][b][m][n] = (f32x4){0.f, 0.f, 0.f, 0.f};
        cur = nxt; aC = aN; bC = bN; ++ui;
    }
    PG8_WAIT_V(0);
    if (wr == 0) PG8_BAR;
    PG8_BAR;
#undef PG8_SA
#undef PG8_SB
#undef PG8_STAGE_A
#undef PG8_STAGE_B
#undef PG8_STAGE_A2
#undef PG8_STAGE_B2
#undef PG8_LDA
#undef PG8_LDB
#undef PG8_MMA
#undef PG8_WAIT_V
#undef PG8_WAIT_L
#undef PG8_BAR
#undef PG8_SCHED
}
__host__ __device__ __forceinline__ int logcol(int p) { return (p & ~255) + 64 * ((p >> 5) & 3) + 32 * ((p >> 7) & 1) + (p & 31); }
}

template <class SRC>
DEV void convert_tile(float* tl, const SRC& src, bf16_t* dst, int ldd, int n0, int k0) {
    const int tid = threadIdx.x;
    {
        const int n = tid & 63;
#pragma unroll
        for (int i = 0; i < 8; ++i) { const int kk = (tid >> 6) + 8 * i; tl[kk * 65 + n] = src.get(n0 + n, k0 + kk); }
    }
    __syncthreads();
    {
        const int n = tid >> 3, kc = tid & 7;
        const float* s = tl + (kc * 8) * 65 + n;
        u32x4 o;
        o.x = pk2(s[0 * 65], s[1 * 65]); o.y = pk2(s[2 * 65], s[3 * 65]); o.z = pk2(s[4 * 65], s[5 * 65]); o.w = pk2(s[6 * 65], s[7 * 65]);
        *(u32x4*)(dst + (size_t)(n0 + n) * ldd + k0 + kc * 8) = o;
    }
    __syncthreads();
}
struct SrcWin { const float* w; const float* g;
    DEV float get(int np, int k) const { const int n = pg8::logcol(np); int col; if (n < 1280) col = n; else if (n < 3328) col = n + 24; else if (n < 3352) col = 1280 + (n - 3328); else return 0.f;
        return w[(size_t)k * IN_COLS + col] * g[k]; } };
struct SrcWout { const float* w; const float* g;
    DEV float get(int np, int k) const { const int n = pg8::logcol(np); const float v = w[(size_t)k * DM + n]; return k < 512 ? v * g[k] : v; } };
struct SrcPlain { const float* w; int ld;
    DEV float get(int n, int k) const { return w[(size_t)k * ld + n]; } };
struct SrcW13 { const float* w1; const float* w3; const float* g;
    DEV float get(int n, int k) const { const uintptr_t a = (uintptr_t)w1, b = (uintptr_t)w3; const float* w = (const float*)(a + ((b - a) & (uintptr_t)(0 - (long long)(n & 1))));
        return w[(size_t)k * 512 + (n >> 1)] * g[k]; } };

template <class SRC>
DEV void convert_tile256(float* tl, const SRC& src, bf16_t* dst, int ldd, int n0, int k0) {
    const int tid = threadIdx.x;
    {
        const int q = tid & 63;
        f32x4 v[8];
#pragma unroll
        for (int i = 0; i < 8; ++i) v[i] = src.quad(n0, q, k0 + (tid >> 6) + 8 * i);
#pragma unroll
        for (int i = 0; i < 8; ++i) { float* o = tl + ((tid >> 6) + 8 * i) * 257; o[src.drow(q, 0)] = v[i].x; o[src.drow(q, 1)] = v[i].y; o[src.drow(q, 2)] = v[i].z; o[src.drow(q, 3)] = v[i].w; }
    }
    __syncthreads();
#pragma unroll
    for (int i = 0; i < 4; ++i) {
        const int idx = tid + NT * i, n = idx >> 3, kc = idx & 7;
        const float* s = tl + (kc * 8) * 257 + n;
        u32x4 o;
        o.x = pk2(s[0 * 257], s[1 * 257]); o.y = pk2(s[2 * 257], s[3 * 257]); o.z = pk2(s[4 * 257], s[5 * 257]); o.w = pk2(s[6 * 257], s[7 * 257]);
        *(u32x4*)(dst + (size_t)(n0 + n) * ldd + k0 + kc * 8) = o;
    }
    __syncthreads();
}
struct SrcWin4 { const float* w; const float* g;
    DEV int drow(int q, int e) const { return 4 * q + e; }
    DEV f32x4 quad(int n0, int q, int k) const { const int n = pg8::logcol(n0 + 4 * q); int col; if (n < 1280) col = n; else if (n < 3328) col = n + 24; else if (n < 3352) col = 1280 + (n - 3328); else return (f32x4){0.f, 0.f, 0.f, 0.f};
        return *(const f32x4*)(w + (size_t)k * IN_COLS + col) * g[k]; } };
struct SrcWout4 { const float* w; const float* g;
    DEV int drow(int q, int e) const { return 4 * q + e; }
    DEV f32x4 quad(int n0, int q, int k) const { const f32x4 v = *(const f32x4*)(w + (size_t)k * DM + pg8::logcol(n0 + 4 * q)); return k < 512 ? v * g[k] : v; } };
struct SrcPlain4 { const float* w; int ld;
    DEV int drow(int q, int e) const { return 4 * q + e; }
    DEV f32x4 quad(int n0, int q, int k) const { return *(const f32x4*)(w + (size_t)k * ld + n0 + 4 * q); } };
struct SrcW13_4 { const float* w1; const float* w3; const float* g;
    DEV int drow(int q, int e) const { return 8 * (q & 31) + 2 * e + (q >> 5); }
    DEV f32x4 quad(int n0, int q, int k) const { const uintptr_t a = (uintptr_t)w1, b = (uintptr_t)w3; const float* w = (const float*)(a + ((b - a) & (uintptr_t)(0 - (long long)(q >> 5))));
        return *(const f32x4*)(w + (size_t)k * 512 + (n0 >> 1) + 4 * (q & 31)) * g[k]; } };

DEV void phase_prologue(const Params& p, unsigned char* lds) {
    float* tl = (float*)lds;
    const int tid = threadIdx.x, lane = tid & 63, wid = tid >> 6;
    const int vb = vblock(), G = gridDim.x;
    unsigned char* ws = p.ws;
    constexpr int I_WIN = (INP / 256) * (DM / 64);
    constexpr int I_WOUT = 4 * 16;
    constexpr int I_CW1 = 2 * 32;
    constexpr int I_W2 = 32 * 4 * 8;
    constexpr int I_CW2 = 2 * 1 * 4;
    constexpr int I_ALL = I_WIN + I_WOUT + I_CW1 + I_W2 + I_CW2;
    for (int it = vb; it < I_ALL; it += G) {
        int r = it;
        if (r < I_WIN) { SrcWin4 s{p.w_in, p.attn_g}; convert_tile256(tl, s, (bf16_t*)(ws + WS_WINT), DM, (r / 16) * 256, (r % 16) * 64); continue; } r -= I_WIN;
        if (r < I_WOUT) { SrcWout4 s{p.w_out, p.g_nsa}; convert_tile256(tl, s, (bf16_t*)(ws + WS_WOUTT), DM, (r / 16) * 256, (r % 16) * 64); continue; } r -= I_WOUT;
        if (r < I_CW1) { const int z = r / 32, q = r % 32; SrcPlain4 s{z ? p.wv1 : p.wk1, 256};
            convert_tile256(tl, s, (bf16_t*)(ws + WS_CW1T) + (size_t)z * 256 * 2048, 2048, 0, q * 64); continue; } r -= I_CW1;
        if (r < I_W2) { const int e = r / 32, q = r % 32; SrcPlain4 s{p.w2 + (size_t)e * 512 * 1024, 1024};
            convert_tile256(tl, s, (bf16_t*)(ws + WS_W2T) + (size_t)e * 1024 * 512, 512, (q / 8) * 256, (q % 8) * 64); continue; } r -= I_W2;
        { const int z = r / 4, q = r % 4; SrcPlain s{z ? p.wv2 : p.wk2, 64};
            convert_tile(tl, s, (bf16_t*)(ws + WS_CW2T) + (size_t)z * 64 * 256, 256, 0, q * 64); }
    }
    {
        bf16_t* xb = (bf16_t*)(ws + WS_R1); float* rstd1 = (float*)(ws + WS_RSTD1);
        const int gw = vb * 8 + wid, NGW = G * 8;
        for (int m = gw; m < NTOK; m += NGW) {
            const f32x4* xr = (const f32x4*)(p.x + (size_t)m * DM) + lane;
            f32x4 v[4]; float s = 0.f;
#pragma unroll
            for (int j = 0; j < 4; ++j) { v[j] = xr[64 * j]; s += (v[j].x * v[j].x + v[j].y * v[j].y) + (v[j].z * v[j].z + v[j].w * v[j].w); }
            s = wave_sum(s);
            if (lane == 0) rstd1[m] = rsqrtf(s * (1.f / DM) + RMS_EPS);
            u32x2* o = (u32x2*)(xb + (size_t)m * DM) + lane;
#pragma unroll
            for (int j = 0; j < 4; ++j) { u32x2 w; w.x = pk2(v[j].x, v[j].y); w.y = pk2(v[j].z, v[j].w); o[64 * j] = w; }
        }
    }
    {
        const int gt = vb * NT + tid, NG = G * NT;
        float* rowss = (float*)(ws + WS_ROWSS);
        for (int i = gt; i < NTOK; i += NG) rowss[i] = 0.f;
        int* bincnt = (int*)(ws + WS_CTL);
        if (gt < 128) bincnt[gt] = 0;
        if (gt < 32) ((int*)(ws + WS_CTL + 512))[gt] = 0;
        if (gt < 512) { const float l0 = p.lb_logits[gt], l1 = p.lb_logits[512 + gt]; ((float*)(ws + WS_LB))[gt] = 1.f / (1.f + __expf(l1 - l0)); }
        for (int i = gt; i < 48 * 1024; i += NG) { const int c = i >> 10, k = i & 1023;
            const float w = (c < 4 ? p.w_group[k * 4 + c] : (c < 36 ? p.w_expert[k * 32 + (c - 4)] : 0.f)) * p.ffn_g[k];
            const bf16_t hi = f2bf(w); const bf16_t lo = f2bf(w - bf2f(hi));
            ((bf16_t*)(ws + WS_RW))[i] = hi; ((bf16_t*)(ws + WS_RW))[48 * 1024 + i] = lo; }
        if (blockIdx.x == (unsigned)(G - 1)) {
            const int z = tid >> 8, j = tid & 255; const float* pos = z ? p.pos_v : p.pos_k; const float* w = z ? p.wv1 : p.wk1;
            float a = 0.f;
            for (int k = 0; k < 2048; ++k) a += pos[k] * w[(size_t)k * 256 + j];
            ((float*)(ws + WS_CBIAS))[z * 256 + j] = a;
        }
    }
}

constexpr int G_A_BYTES = 128 * 128, G_B_BYTES = 256 * 128, G_STAGE = G_A_BYTES + G_B_BYTES, G_LDS = 2 * G_STAGE;
DEV int swz(int row, int chunk) { return row * 128 + ((chunk ^ ((row >> 1) & 7)) << 4); }
template <class AL, class BL, class EP>
DEV void gemm_tile(unsigned char* lds, const AL& al, const BL& bl, int nk, const EP& ep) {
    const int tid = threadIdx.x, lane = tid & 63, wid = tid >> 6, wr = wid >> 2, wc = wid & 3;
    const int frow = lane & 15, fq = lane >> 4;
    const bf16_t* aptr[2]; int aoff[2], boff[4], brow[4];
#pragma unroll
    for (int i = 0; i < 2; ++i) { const int q = tid + NT * i, row = q >> 3, ch = q & 7; aptr[i] = al.row(row) + ch * 8; aoff[i] = swz(row, ch); }
#pragma unroll
    for (int i = 0; i < 4; ++i) { const int q = tid + NT * i, row = q >> 3, ch = q & 7; brow[i] = row; boff[i] = G_A_BYTES + swz(row, ch) ; }
    const int bch8 = (tid & 7) * 8;
    u32x4 ra[2], rb[4];
#pragma unroll
    for (int i = 0; i < 2; ++i) ra[i] = *(const u32x4*)(aptr[i]);
#pragma unroll
    for (int i = 0; i < 4; ++i) rb[i] = *(const u32x4*)(bl.ptr(brow[i], 0) + bch8);
#pragma unroll
    for (int i = 0; i < 2; ++i) *(u32x4*)(lds + aoff[i]) = ra[i];
#pragma unroll
    for (int i = 0; i < 4; ++i) *(u32x4*)(lds + boff[i]) = rb[i];
    __syncthreads();
    f32x4 acc[4][4];
#pragma unroll
    for (int m = 0; m < 4; ++m)
#pragma unroll
        for (int n = 0; n < 4; ++n) acc[m][n] = (f32x4){0.f, 0.f, 0.f, 0.f};
    const int sx = (frow >> 1) & 7;
    for (int kt = 0; kt < nk; ++kt) {
        const bool more = (kt + 1 < nk);
        if (more) {
#pragma unroll
            for (int i = 0; i < 2; ++i) ra[i] = *(const u32x4*)(aptr[i] + (kt + 1) * 64);
#pragma unroll
            for (int i = 0; i < 4; ++i) rb[i] = *(const u32x4*)(bl.ptr(brow[i], kt + 1) + bch8);
        }
        const unsigned char* base = lds + (kt & 1) * G_STAGE;
#pragma unroll
        for (int ks = 0; ks < 2; ++ks) {
            const int co = ((ks * 4 + fq) ^ sx) << 4;
            bf16x8 af[4], bfr[4];
#pragma unroll
            for (int m = 0; m < 4; ++m) af[m] = *(const bf16x8*)(base + (wr * 64 + m * 16 + frow) * 128 + co);
#pragma unroll
            for (int n = 0; n < 4; ++n) bfr[n] = *(const bf16x8*)(base + G_A_BYTES + (wc * 64 + n * 16 + frow) * 128 + co);
#pragma unroll
            for (int m = 0; m < 4; ++m)
#pragma unroll
                for (int n = 0; n < 4; ++n) acc[m][n] = __builtin_amdgcn_mfma_f32_16x16x32_bf16(bfr[n], af[m], acc[m][n], 0, 0, 0);
        }
        if (more) {
            unsigned char* nb = lds + ((kt + 1) & 1) * G_STAGE;
#pragma unroll
            for (int i = 0; i < 2; ++i) *(u32x4*)(nb + aoff[i]) = ra[i];
#pragma unroll
            for (int i = 0; i < 4; ++i) *(u32x4*)(nb + boff[i]) = rb[i];
        }
        __syncthreads();
    }
    ep(acc, wr, wc, lane);
}

struct ARows { const bf16_t* base; size_t ld; DEV const bf16_t* row(int r) const { return base + (size_t)r * ld; } };
struct BRows { const bf16_t* base; size_t ld; DEV const bf16_t* ptr(int n, int kt) const { return base + (size_t)n * ld + kt * 64; } };

DEV void inproj_row(const Params& p, int seg, int row, f32x4 (&v)[4], int fq) {
    unsigned char* ws = p.ws;
    const float rs = ((const float*)(ws + WS_RSTD1))[row];
#pragma unroll
    for (int n = 0; n < 4; ++n) v[n] = v[n] * rs;
    const int b = row >> 12, s = row & 4095;
    const bool is_q = seg < 8, is_ks = (seg == 12 || seg == 13), is_kw = (seg == 16 || seg == 17);
    if (is_q || is_ks || is_kw) {
        const float* gw = is_q ? p.g_q : (is_ks ? p.g_k + 64 : p.g_k + 128);
        bf16_t* dst; int hh, nh;
        if (is_q) { dst = (bf16_t*)(ws + WS_Q); hh = seg; nh = 8; } else if (is_ks) { dst = (bf16_t*)(ws + WS_KS); hh = seg - 12; nh = 2; } else { dst = (bf16_t*)(ws + WS_KW); hh = seg - 16; nh = 2; }
        float ss = 0.f;
#pragma unroll
        for (int n = 0; n < 4; ++n) ss += (v[n].x * v[n].x + v[n].y * v[n].y) + (v[n].z * v[n].z + v[n].w * v[n].w);
        ss += __shfl_xor(ss, 16); ss += __shfl_xor(ss, 32);
        float r = rsqrtf(ss * (1.f / 64.f) + RMS_EPS); if (is_q) r *= QSCALE;
        bf16_t* o = dst + ((size_t)(b * nh + hh) * SEQ + s) * 64 + fq * 4;
#pragma unroll
        for (int n = 0; n < 4; ++n) { const f32x4 g = *(const f32x4*)(gw + n * 16 + fq * 4); const f32x4 x = v[n] * g * r; u32x2 w; w.x = pk2(x.x, x.y); w.y = pk2(x.z, x.w); *(u32x2*)(o + n * 16) = w; }
        return;
    }
    if (seg >= 8 && seg < 12) {
        bf16_t* o = (bf16_t*)(ws + (seg < 10 ? WS_KC : WS_VC)) + ((size_t)(b * 2 + (seg & 1)) * SEQ + s) * 64 + fq * 4;
#pragma unroll
        for (int n = 0; n < 4; ++n) { u32x2 w; w.x = pk2(v[n].x, v[n].y); w.y = pk2(v[n].z, v[n].w); *(u32x2*)(o + n * 16) = w; }
        return;
    }
    if (seg == 14 || seg == 15 || seg == 18 || seg == 19) {
        bf16_t* o = (bf16_t*)(ws + (seg < 16 ? WS_VST : WS_VWT)) + (size_t)(b * 2 + (seg & 1)) * 64 * SEQ + s;
#pragma unroll
        for (int n = 0; n < 4; ++n) { const int d = n * 16 + fq * 4;
            o[(size_t)(d + 0) * SEQ] = f2bf(v[n].x); o[(size_t)(d + 1) * SEQ] = f2bf(v[n].y); o[(size_t)(d + 2) * SEQ] = f2bf(v[n].z); o[(size_t)(d + 3) * SEQ] = f2bf(v[n].w); }
        return;
    }
    if (seg < 52) {
        const int kind = (seg - 20) >> 3, cb = ((seg - 20) & 7) * 64 + fq * 4;
        if (kind == 1) {
            const float* lb = (const float*)(ws + WS_LB); float* dst = (float*)(ws + WS_HLOGF) + (size_t)row * 512;
#pragma unroll
            for (int n = 0; n < 4; ++n) { const int c = cb + n * 16; const f32x4 l = *(const f32x4*)(lb + c); f32x4 o;
                o.x = __logf(l.x + (1.f - l.x) * sigmoidf_(v[n].x)); o.y = __logf(l.y + (1.f - l.y) * sigmoidf_(v[n].y));
                o.z = __logf(l.z + (1.f - l.z) * sigmoidf_(v[n].z)); o.w = __logf(l.w + (1.f - l.w) * sigmoidf_(v[n].w));
                *(f32x4*)(dst + c) = o; }
        } else {
            bf16_t* dst = (bf16_t*)(ws + (kind == 0 ? WS_HQ : (kind == 2 ? WS_HV : WS_HG))) + (size_t)row * 512 + cb;
#pragma unroll
            for (int n = 0; n < 4; ++n) { f32x4 x = v[n];
                if (kind != 2) { x.x = siluf_(x.x); x.y = siluf_(x.y); x.z = siluf_(x.z); x.w = siluf_(x.w); }
                u32x2 w; w.x = pk2(x.x, x.y); w.y = pk2(x.z, x.w); *(u32x2*)(dst + n * 16) = w; }
        }
        return;
    }
    {
        float* dst = (float*)(ws + WS_GATES) + (size_t)row * 24;
#pragma unroll
        for (int n = 0; n < 2; ++n) { const int c = n * 16 + fq * 4; if (c < 24) { f32x4 o; o.x = sigmoidf_(v[n].x); o.y = sigmoidf_(v[n].y); o.z = sigmoidf_(v[n].z); o.w = sigmoidf_(v[n].w); *(f32x4*)(dst + c) = o; } }
    }
}
struct EpiInproj8 { const Params& p;
    DEV void operator()(const f32x4 (&acc)[2][2][4][2], const pg8::Unit& u, int wr, int wc, int fr, int fq) const {
        const int seg = u.pn * 4 + wc;
        if (seg > 52) return;
#pragma unroll
        for (int ai = 0; ai < 2; ++ai)
#pragma unroll
            for (int m = 0; m < 4; ++m) { f32x4 v[4] = {acc[ai][0][m][0], acc[ai][0][m][1], acc[ai][1][m][0], acc[ai][1][m][1]};
                inproj_row(p, seg, u.pm * 256 + ai * 128 + wr * 64 + m * 16 + fr, v, fq); }
    } };
DEV void phase_inproj(const Params& p, unsigned char* lds) {
    pg8::Gemm g{(const bf16_t*)(p.ws + WS_R1), (const bf16_t*)(p.ws + WS_WINT), NTOK, INP, DM};
    pg8::StaticOrder S; S.init(NTOK, INP, (int)gridDim.x, (int)blockIdx.x);
    EpiInproj8 E{p};
    pg8::gemm_phase(( PG8_LAS unsigned char*)lds, g, S, E);
}

struct ACmp { const bf16_t* src; int bg, c0;
    DEV const bf16_t* row(int r) const { int c = c0 + r; if (c > NC - 1) c = NC - 1; return src + ((size_t)bg * SEQ + 16 * c) * 64; } };
struct EpiCmpA { const Params& p; int z, rbase;
    DEV void operator()(f32x4 (&acc)[4][4], int wr, int wc, int lane) const {
        const int frow = lane & 15, fq = lane >> 4;
        const float* cb = (const float*)(p.ws + WS_CBIAS) + z * 256; bf16_t* hid = (bf16_t*)(p.ws + WS_HID) + (size_t)z * 4096 * 256;
#pragma unroll
        for (int m = 0; m < 4; ++m) { const int rr = rbase + wr * 64 + m * 16 + frow;
#pragma unroll
            for (int n = 0; n < 4; ++n) { const int c = wc * 64 + n * 16 + fq * 4; const f32x4 b = *(const f32x4*)(cb + c); f32x4 v = acc[m][n] + b;
                u32x2 w; w.x = pk2(siluf_(v.x), siluf_(v.y)); w.y = pk2(siluf_(v.z), siluf_(v.w)); *(u32x2*)(hid + (size_t)rr * 256 + c) = w; } }
    } };
DEV void phase_cmp_a(const Params& p, unsigned char* lds) {
    const int vb = vblock(), G = gridDim.x;
    for (int u = vb; u < 64; u += G) {
        const int z = u >> 5, rbase = (u & 31) * 128;
        ACmp al{(const bf16_t*)(p.ws + (z ? WS_VC : WS_KC)), (u & 31) >> 1, (u & 1) * 128};
        BRows bl{(const bf16_t*)(p.ws + WS_CW1T) + (size_t)z * 256 * 2048, 2048};
        EpiCmpA ep{p, z, rbase};
        gemm_tile(lds, al, bl, 2048 / 64, ep);
    }
}
struct BClamp64 { const bf16_t* base; size_t ld; DEV const bf16_t* ptr(int n, int kt) const { return base + (size_t)(n & 63) * ld + kt * 64; } };
struct EpiCmpB { const Params& p; int z, rbase;
    DEV void operator()(f32x4 (&acc)[4][4], int wr, int wc, int lane) const {
        if (wc != 0) return;
        const int frow = lane & 15, fq = lane >> 4;
        bf16_t* dst = (bf16_t*)(p.ws + (z ? WS_VCMP : WS_KCMP));
#pragma unroll
        for (int m = 0; m < 4; ++m) { const int rr = rbase + wr * 64 + m * 16 + frow;
            float r = 1.f;
            if (z == 0) { float ss = 0.f;
#pragma unroll
                for (int n = 0; n < 4; ++n) { const f32x4 v = acc[m][n]; ss += (v.x * v.x + v.y * v.y) + (v.z * v.z + v.w * v.w); }
                ss += __shfl_xor(ss, 16); ss += __shfl_xor(ss, 32); r = rsqrtf(ss * (1.f / 64.f) + RMS_EPS); }
            const int bg = rr >> 8, c = rr & 255;
            if (c < NC) {
#pragma unroll
                for (int n = 0; n < 4; ++n) { const int d = n * 16 + fq * 4; f32x4 v = acc[m][n] * r;
                    if (z == 0) { const f32x4 g = *(const f32x4*)(p.g_k + d); v = v * g;
                        u32x2 w; w.x = pk2(v.x, v.y); w.y = pk2(v.z, v.w); *(u32x2*)(dst + ((size_t)bg * 256 + c) * 64 + d) = w; }
                    else { bf16_t* o = dst + ((size_t)bg * 64 + d) * 256 + c; o[0] = f2bf(v.x); o[256] = f2bf(v.y); o[512] = f2bf(v.z); o[768] = f2bf(v.w); } } }
        }
    } };
DEV void phase_cmp_b(const Params& p, unsigned char* lds) {
    const int vb = vblock(), G = gridDim.x;
    for (int u = vb; u < 64; u += G) {
        const int z = u >> 5, rbase = (u & 31) * 128;
        ARows al{(const bf16_t*)(p.ws + WS_HID) + ((size_t)z * 4096 + rbase) * 256, 256};
        BClamp64 bl{(const bf16_t*)(p.ws + WS_CW2T) + (size_t)z * 64 * 256, 256};
        EpiCmpB ep{p, z, rbase};
        gemm_tile(lds, al, bl, 256 / 64, ep);
    }
}

constexpr int CM_K = 0, CM_V = 32768, CM_VSTR = 520, CM_IMP = CM_V + 64 * CM_VSTR, CM_LDS = CM_IMP + 4 * 16384;
DEV void cm_scores(const unsigned char* kbase, int kt, const bf16x8 (&qf)[4], int r31, int hh, f32x16 (&sacc)[2]) {
#pragma unroll
    for (int kt2 = 0; kt2 < 2; ++kt2) {
#pragma unroll
        for (int i = 0; i < 16; ++i) sacc[kt2][i] = 0.f;
        const int row = 64 * kt + 32 * kt2 + r31; const int sx = (row >> 1) & 7;
#pragma unroll
        for (int s = 0; s < 4; ++s) { const bf16x8 kf = *(const bf16x8*)(kbase + row * 128 + (((2 * s + hh) ^ sx) << 4));
            sacc[kt2] = __builtin_amdgcn_mfma_f32_32x32x16_bf16(kf, qf[s], sacc[kt2], 0, 0, 0); }
    }
}
DEV void phase_cmp_attn(const Params& p, unsigned char* lds) {
    const int tid = threadIdx.x, lane = tid & 63, wid = tid >> 6;
    const int vb = vblock(), G = gridDim.x;
    unsigned char* ws = p.ws;
    const int r31 = lane & 31, hh = lane >> 5;
    float* impl = (float*)(lds + CM_IMP);
    for (int it = vb; it < 1024; it += G) {
        const int rnd = it / G, pos = it % G; int sidx = (rnd & 1) ? (rnd * G + (G - 1 - pos)) : (rnd * G + pos); if (G != 256) sidx = it;
        const int ci = 63 - (sidx >> 4), bg = sidx & 15, b = bg >> 1, g = bg & 1;
        const int nvis = min(NC, 4 * ci + 3), ntile = (nvis + 63) >> 6;
        const int head = g * 4 + (wid >> 1);
        const int tokl = (wid & 1) * 32 + r31, t = ci * 64 + tokl;
        const size_t tok = (size_t)b * SEQ + t;
        const int nv = t >= 31 ? min(NC, (t - 31) / 16 + 1) : 0;
        __syncthreads();
        {
            const bf16_t* kc = (const bf16_t*)(ws + WS_KCMP) + (size_t)bg * 256 * 64; const bf16_t* vt = (const bf16_t*)(ws + WS_VCMP) + (size_t)bg * 64 * 256;
            const int cpr = ntile * 8;
            u32x4 rk[4], rv[4];
#pragma unroll
            for (int i = 0; i < 4; ++i) if (i < ntile) { const int idx = tid + NT * i; rk[i] = *(const u32x4*)(kc + (idx >> 3) * 64 + (idx & 7) * 8); const int d = idx / cpr, ck = idx % cpr; rv[i] = *(const u32x4*)(vt + d * 256 + ck * 8); }
#pragma unroll
            for (int i = 0; i < 4; ++i) if (i < ntile) { const int idx = tid + NT * i; *(u32x4*)(lds + CM_K + swz(idx >> 3, idx & 7)) = rk[i];
                const int d = idx / cpr, ck = idx % cpr; u32x2 a, c2; a.x = rv[i].x; a.y = rv[i].y; c2.x = rv[i].z; c2.y = rv[i].w; unsigned char* o = lds + CM_V + d * CM_VSTR + ck * 16; *(u32x2*)o = a; *(u32x2*)(o + 8) = c2; }
        }
        bf16x8 qf[4];
        { const bf16_t* qp = (const bf16_t*)(ws + WS_Q) + ((size_t)(b * 8 + head) * SEQ + t) * 64 + 8 * hh;
#pragma unroll
            for (int s = 0; s < 4; ++s) qf[s] = *(const bf16x8*)(qp + 16 * s); }
        __syncthreads();
        float m_run = -1e30f, l_run = 0.f;
        for (int kt = 0; kt < ntile; ++kt) {
            f32x16 sacc[2];
            cm_scores(lds + CM_K, kt, qf, r31, hh, sacc);
            float mx = -1e30f;
#pragma unroll
            for (int kt2 = 0; kt2 < 2; ++kt2)
#pragma unroll
                for (int i = 0; i < 16; ++i) { const int c = 64 * kt + 32 * kt2 + (i & 3) + 8 * (i >> 2) + 4 * hh; const float v = (c < nv) ? sacc[kt2][i] : -1e30f; sacc[kt2][i] = v; mx = fmaxf(mx, v); }
            const float m_new = fmaxf(m_run, mx); float rs = 0.f;
#pragma unroll
            for (int kt2 = 0; kt2 < 2; ++kt2)
#pragma unroll
                for (int i = 0; i < 16; ++i) { const float v = sacc[kt2][i]; rs += (v > -5e29f) ? __builtin_amdgcn_exp2f(v - m_new) : 0.f; }
            l_run = l_run * __builtin_amdgcn_exp2f(m_run - m_new) + rs; m_run = m_new;
        }
        float M, invL;
        { const float mo = __shfl_xor(m_run, 32), lo = __shfl_xor(l_run, 32); M = fmaxf(m_run, mo); const float L = l_run * __builtin_amdgcn_exp2f(m_run - M) + lo * __builtin_amdgcn_exp2f(mo - M); invL = L > 0.f ? 1.f / L : 0.f; }
        f32x16 ot[2];
#pragma unroll
        for (int dt = 0; dt < 2; ++dt)
#pragma unroll
            for (int i = 0; i < 16; ++i) ot[dt][i] = 0.f;
        float carry = 0.f;
#pragma unroll
        for (int kt = 0; kt < 4; ++kt) if (kt < ntile) {
            f32x16 sacc[2];
            cm_scores(lds + CM_K, kt, qf, r31, hh, sacc);
#pragma unroll
            for (int kt2 = 0; kt2 < 2; ++kt2)
#pragma unroll
                for (int i = 0; i < 16; ++i) { const int c = 64 * kt + 32 * kt2 + (i & 3) + 8 * (i >> 2) + 4 * hh; sacc[kt2][i] = (c < nv) ? __builtin_amdgcn_exp2f(sacc[kt2][i] - M) : 0.f; }
            {
                float own[8], xs[8];
#pragma unroll
                for (int kt2 = 0; kt2 < 2; ++kt2)
#pragma unroll
                    for (int g4 = 0; g4 < 4; ++g4) { const float e3 = 0.5f * sacc[kt2][4 * g4 + 3];
                        own[4 * kt2 + g4] = (sacc[kt2][4 * g4] + sacc[kt2][4 * g4 + 1]) + (sacc[kt2][4 * g4 + 2] + e3); xs[4 * kt2 + g4] = __shfl_xor(e3, 32); }
                float* io = impl + (wid >> 1) * 4096 + tokl * 64 + 16 * kt + hh;
#pragma unroll
                for (int gi = 0; gi < 8; ++gi) io[2 * gi] = (own[gi] + (hh ? xs[gi] : (gi > 0 ? xs[gi > 0 ? gi - 1 : 0] : carry))) * invL;
                carry = xs[7];
            }
#pragma unroll
            for (int kt2 = 0; kt2 < 2; ++kt2)
#pragma unroll
                for (int s2 = 0; s2 < 2; ++s2) {
                    bf16x8 pf; { u32x4 w; w.x = pk2(sacc[kt2][8 * s2 + 0], sacc[kt2][8 * s2 + 1]); w.y = pk2(sacc[kt2][8 * s2 + 2], sacc[kt2][8 * s2 + 3]);
                        w.z = pk2(sacc[kt2][8 * s2 + 4], sacc[kt2][8 * s2 + 5]); w.w = pk2(sacc[kt2][8 * s2 + 6], sacc[kt2][8 * s2 + 7]); pf = __builtin_bit_cast(bf16x8, w); }
#pragma unroll
                    for (int dt = 0; dt < 2; ++dt) {
                        const unsigned char* va = lds + CM_V + (32 * dt + r31) * CM_VSTR + (64 * kt + 32 * kt2 + 16 * s2 + 4 * hh) * 2;
                        const u32x2 lo = *(const u32x2*)(va), hi = *(const u32x2*)(va + 16);
                        u32x4 w; w.x = lo.x; w.y = lo.y; w.z = hi.x; w.w = hi.y;
                        ot[dt] = __builtin_amdgcn_mfma_f32_32x32x16_bf16(__builtin_bit_cast(bf16x8, w), pf, ot[dt], 0, 0, 0);
                    }
                }
        }
        {
            const float sc = ((const float*)(ws + WS_GATES))[tok * 24 + head * 3 + 0] * invL;
            bf16_t* ocp = (bf16_t*)(ws + WS_OC) + tok * 512 + head * 64;
#pragma unroll
            for (int dt = 0; dt < 2; ++dt)
#pragma unroll
                for (int g4 = 0; g4 < 4; ++g4) { const int d0 = 32 * dt + 8 * g4 + 4 * hh;
                    u32x2 w; w.x = pk2(ot[dt][4 * g4 + 0] * sc, ot[dt][4 * g4 + 1] * sc); w.y = pk2(ot[dt][4 * g4 + 2] * sc, ot[dt][4 * g4 + 3] * sc); *(u32x2*)(ocp + d0) = w; }
        }
        __syncthreads();
        for (int tt = 0; tt < 8; ++tt) {
            const int tl = wid * 8 + tt, cur = ci;
            unsigned long long mask;
            if (cur < 16) mask = (2ull << cur) - 1ull;
            else {
                const bool valid = lane <= cur;
                const float imp = (impl[tl * 64 + lane] + impl[4096 + tl * 64 + lane]) + (impl[8192 + tl * 64 + lane] + impl[12288 + tl * 64 + lane]);
                const unsigned key = (lane == 0 || lane == cur) ? 0x7F800000u : __float_as_uint(imp);
                unsigned T = 0u;
                for (int bit = 30; bit >= 0; --bit) { const unsigned cand = T | (1u << bit); if (__popcll(__ballot(valid && key >= cand)) >= 16) T = cand; }
                const unsigned long long gt = __ballot(valid && key > T), eq = __ballot(valid && key == T);
                const int need = 16 - __popcll(gt);
                const int below = __popcll(eq & ((1ull << lane) - 1ull));
                mask = gt | __ballot(valid && key == T && below < need);
            }
            if (lane == 0) ((unsigned long long*)(ws + WS_SELM))[(size_t)bg * SEQ + ci * 64 + tl] = mask;
        }
    }
}

constexpr int FA_KB = 64 * 128, FA_VB = 64 * 136, FA_STAGE = FA_KB + FA_VB, FA_LDS = 2 * FA_STAGE + 1024;
template <bool SEL>
DEV void fa_branch(unsigned char* lds, const bf16_t* Kb, const bf16_t* VTb, int ci, int bg, const bf16x8 (&qf)[4], int t, unsigned long long mymask, unsigned long long need,
                   f32x16 (&ot)[2], float& m_run, float& l_run) {
    const int tid = threadIdx.x, lane = tid & 63;
    const int r31 = lane & 31, hh = lane >> 5;
    const int lrow = tid >> 3, lch = tid & 7;
    const bf16_t* kg = Kb + ((size_t)bg * SEQ + lrow) * 64 + lch * 8;
    const bf16_t* vg = VTb + ((size_t)bg * 64 + lrow) * SEQ + lch * 8;
    const int koff = lrow * 128 + ((lch ^ ((lrow >> 1) & 7)) << 4), voff = FA_KB + lrow * 136 + lch * 16;
    int jlo, jhi; unsigned long long todo;
    if (SEL) { todo = need; jlo = 0; jhi = ci; } else { jlo = ci >= 8 ? ci - 8 : 0; jhi = ci; todo = 0; }
    int j = jlo;
    if (SEL) { if (todo == 0) return; j = __builtin_ctzll(todo); todo &= todo - 1; }
    u32x4 rk = *(const u32x4*)(kg + (size_t)j * 64 * 64), rv = *(const u32x4*)(vg + (size_t)j * 64);
    __syncthreads();
    *(u32x4*)(lds + koff) = rk; { u32x2 a, b2; a.x = rv.x; a.y = rv.y; b2.x = rv.z; b2.y = rv.w; *(u32x2*)(lds + voff) = a; *(u32x2*)(lds + voff + 8) = b2; }
    __syncthreads();
    int st = 0; bool seen = false;
    for (;;) {
        int jn; bool more;
        if (SEL) { more = (todo != 0); jn = more ? __builtin_ctzll(todo) : 0; todo &= todo - 1; } else { jn = j + 1; more = (jn <= jhi); }
        if (more) { rk = *(const u32x4*)(kg + (size_t)jn * 64 * 64); rv = *(const u32x4*)(vg + (size_t)jn * 64); }
        const unsigned char* base = lds + st * FA_STAGE;
        const bool bit = SEL ? ((mymask >> j) & 1ull) != 0 : true;
        const float cinit = (SEL && !bit) ? -__builtin_inff() : -m_run;
        f32x16 sacc[2];
#pragma unroll
        for (int kt2 = 0; kt2 < 2; ++kt2) {
#pragma unroll
            for (int i = 0; i < 16; ++i) sacc[kt2][i] = cinit;
            const int row = 32 * kt2 + r31; const int sx = (row >> 1) & 7;
#pragma unroll
            for (int s = 0; s < 4; ++s) { const bf16x8 kf = *(const bf16x8*)(base + row * 128 + (((2 * s + hh) ^ sx) << 4));
                sacc[kt2] = __builtin_amdgcn_mfma_f32_32x32x16_bf16(kf, qf[s], sacc[kt2], 0, 0, 0); }
        }
        const bool boundary = SEL ? (j == ci) : (j == ci || j + 8 <= ci);
        float mx = -__builtin_inff();
        if (boundary) {
#pragma unroll
            for (int kt2 = 0; kt2 < 2; ++kt2)
#pragma unroll
                for (int i = 0; i < 16; ++i) { const int key = 64 * j + 32 * kt2 + (i & 3) + 8 * (i >> 2) + 4 * hh;
                    const bool ok = SEL ? (key <= t) : (key <= t && t - key < 512);
                    const float v = ok ? sacc[kt2][i] : -__builtin_inff(); sacc[kt2][i] = v; mx = fmaxf(mx, v); }
        } else {
#pragma unroll
            for (int kt2 = 0; kt2 < 2; ++kt2)
#pragma unroll
                for (int i = 0; i < 16; ++i) mx = fmaxf(mx, sacc[kt2][i]);
        }
        mx = fmaxf(mx, __shfl_xor(mx, 32));
        const bool live = mx > -__builtin_inff();
        const bool need = (mx > 8.f) || (!seen && live && mx < -8.f);
        if (__any(need)) {
            const float d = need ? mx : 0.f;
            const float alpha = d > 0.f ? __builtin_amdgcn_exp2f(-d) : 1.f;
            m_run += d; l_run *= alpha;
#pragma unroll
            for (int dt = 0; dt < 2; ++dt)
#pragma unroll
                for (int i = 0; i < 16; ++i) ot[dt][i] *= alpha;
#pragma unroll
            for (int kt2 = 0; kt2 < 2; ++kt2)
#pragma unroll
                for (int i = 0; i < 16; ++i) sacc[kt2][i] -= d;
        }
        seen = seen || live;
        float rs = 0.f;
#pragma unroll
        for (int kt2 = 0; kt2 < 2; ++kt2)
#pragma unroll
            for (int i = 0; i < 16; ++i) { const float e = __builtin_amdgcn_exp2f(sacc[kt2][i]); sacc[kt2][i] = e; rs += e; }
        l_run += rs;
#pragma unroll
        for (int kt2 = 0; kt2 < 2; ++kt2)
#pragma unroll
            for (int s2 = 0; s2 < 2; ++s2) {
                bf16x8 pf; { u32x4 w; w.x = pk2(sacc[kt2][8 * s2 + 0], sacc[kt2][8 * s2 + 1]); w.y = pk2(sacc[kt2][8 * s2 + 2], sacc[kt2][8 * s2 + 3]);
                    w.z = pk2(sacc[kt2][8 * s2 + 4], sacc[kt2][8 * s2 + 5]); w.w = pk2(sacc[kt2][8 * s2 + 6], sacc[kt2][8 * s2 + 7]); pf = __builtin_bit_cast(bf16x8, w); }
#pragma unroll
                for (int dt = 0; dt < 2; ++dt) {
                    const unsigned char* va = base + FA_KB + (32 * dt + r31) * 136 + (32 * kt2 + 16 * s2 + 4 * hh) * 2;
                    const u32x2 lo = *(const u32x2*)(va), hi = *(const u32x2*)(va + 16);
                    u32x4 w; w.x = lo.x; w.y = lo.y; w.z = hi.x; w.w = hi.y;
                    ot[dt] = __builtin_amdgcn_mfma_f32_32x32x16_bf16(__builtin_bit_cast(bf16x8, w), pf, ot[dt], 0, 0, 0);
                }
            }
        if (!more) break;
        { unsigned char* nb = lds + (st ^ 1) * FA_STAGE; *(u32x4*)(nb + koff) = rk; u32x2 a, b2; a.x = rv.x; a.y = rv.y; b2.x = rv.z; b2.y = rv.w; *(u32x2*)(nb + voff) = a; *(u32x2*)(nb + voff + 8) = b2; }
        __syncthreads();
        st ^= 1; j = jn;
    }
}
DEV void phase_flash(const Params& p, unsigned char* lds) {
    const int tid = threadIdx.x, lane = tid & 63, wid = tid >> 6;
    const int vb = vblock(), G = gridDim.x;
    unsigned char* ws = p.ws;
    const int r31 = lane & 31, hh = lane >> 5;
    unsigned long long* red = (unsigned long long*)(lds + 2 * FA_STAGE);
    for (int it = vb; it < 1024; it += G) {
        const int rnd = it / G, pos = it % G; int sidx = (rnd & 1) ? (rnd * G + (G - 1 - pos)) : (rnd * G + pos); if (G != 256) sidx = it;
        const int ci = 63 - (sidx >> 4), bg = sidx & 15, b = bg >> 1, g = bg & 1;
        const int head = g * 4 + (wid >> 1);
        const int t = ci * 64 + (wid & 1) * 32 + r31;
        const size_t tok = (size_t)b * SEQ + t;
        bf16x8 qf[4];
        { const bf16_t* qp = (const bf16_t*)(ws + WS_Q) + ((size_t)(b * 8 + head) * SEQ + t) * 64 + 8 * hh;
#pragma unroll
            for (int s = 0; s < 4; ++s) qf[s] = *(const bf16x8*)(qp + 16 * s); }
        const unsigned long long mymask = ((const unsigned long long*)(ws + WS_SELM))[(size_t)bg * SEQ + t];
        unsigned long long orm = mymask;
#pragma unroll
        for (int o = 1; o < 32; o <<= 1) { const unsigned lo = __shfl_xor((unsigned)orm, o), hi = __shfl_xor((unsigned)(orm >> 32), o); orm |= ((unsigned long long)hi << 32) | lo; }
        __syncthreads();
        if (wid < 2 && lane == 0) red[wid] = orm;
        __syncthreads();
        const unsigned long long need = red[0] | red[1];
        f32x16 oc[2];
        {
            f32x16 ot[2]; float m_run = 0.f, l_run = 0.f;
#pragma unroll
            for (int dt = 0; dt < 2; ++dt)
#pragma unroll
                for (int i = 0; i < 16; ++i) ot[dt][i] = 0.f;
            fa_branch<true>(lds, (const bf16_t*)(ws + WS_KS), (const bf16_t*)(ws + WS_VST), ci, bg, qf, t, mymask, need, ot, m_run, l_run);
            const float lt = l_run + __shfl_xor(l_run, 32);
            const float sc = ((const float*)(ws + WS_GATES))[tok * 24 + head * 3 + 1] / lt;
#pragma unroll
            for (int dt = 0; dt < 2; ++dt)
#pragma unroll
                for (int i = 0; i < 16; ++i) oc[dt][i] = ot[dt][i] * sc;
        }
        {
            f32x16 ot[2]; float m_run = 0.f, l_run = 0.f;
#pragma unroll
            for (int dt = 0; dt < 2; ++dt)
#pragma unroll
                for (int i = 0; i < 16; ++i) ot[dt][i] = 0.f;
            fa_branch<false>(lds, (const bf16_t*)(ws + WS_KW), (const bf16_t*)(ws + WS_VWT), ci, bg, qf, t, 0ull, 0ull, ot, m_run, l_run);
            const float lt = l_run + __shfl_xor(l_run, 32);
            const float sc = ((const float*)(ws + WS_GATES))[tok * 24 + head * 3 + 2] / lt;
#pragma unroll
            for (int dt = 0; dt < 2; ++dt)
#pragma unroll
                for (int i = 0; i < 16; ++i) oc[dt][i] += ot[dt][i] * sc;
        }
        {
            const bf16_t* ocp = (const bf16_t*)(ws + WS_OC) + tok * 512 + head * 64;
            bf16_t* mix = (bf16_t*)(ws + WS_R1) + tok * 1024 + head * 64;
            float ss = 0.f;
#pragma unroll
            for (int dt = 0; dt < 2; ++dt)
#pragma unroll
                for (int g4 = 0; g4 < 4; ++g4) { const int d0 = 32 * dt + 8 * g4 + 4 * hh; const u32x2 c = *(const u32x2*)(ocp + d0);
                    const float v0 = oc[dt][4 * g4 + 0] + bflo(c.x), v1 = oc[dt][4 * g4 + 1] + bfhi(c.x), v2 = oc[dt][4 * g4 + 2] + bflo(c.y), v3 = oc[dt][4 * g4 + 3] + bfhi(c.y);
                    ss += (v0 * v0 + v1 * v1) + (v2 * v2 + v3 * v3);
                    u32x2 w; w.x = pk2(v0, v1); w.y = pk2(v2, v3); *(u32x2*)(mix + d0) = w; }
            ss += __shfl_xor(ss, 32);
            if (hh == 0) atomicAdd((float*)(ws + WS_ROWSS) + tok, ss);
        }
    }
}

DEV int swz256(int row, int chunk) { return row * 256 + ((chunk ^ (row & 15)) << 4); }
DEV void hgrn_cumsum(const Params& p, int bh, int c, float* segs, f32x2 (&lf)[8], f32x2 (&a)[8], f32x2& r, f32x2& alast) {
    const int tid = threadIdx.x, k2 = tid & 63, tq = tid >> 6;
    const int b = bh >> 2, h = bh & 3;
    const float* HL = (const float*)(p.ws + WS_HLOGF) + ((size_t)b * SEQ + c * 64 + tq * 8) * 512 + h * 128 + 2 * k2;
#pragma unroll
    for (int i = 0; i < 8; ++i) lf[i] = *(const f32x2*)(HL + (size_t)i * 512);
    f32x2 run = (f32x2){0.f, 0.f};
#pragma unroll
    for (int i = 0; i < 8; ++i) { run = run + lf[i]; a[i] = run; }
    *(f32x2*)(segs + tq * 128 + 2 * k2) = run;
    __syncthreads();
    f32x2 off = (f32x2){0.f, 0.f}, tot = off, rr = off;
#pragma unroll
    for (int q = 0; q < 8; ++q) { const f32x2 s = *(const f32x2*)(segs + q * 128 + 2 * k2); if (q < tq) off = off + s; if (q < 4) rr = rr + s; tot = tot + s; }
#pragma unroll
    for (int i = 0; i < 8; ++i) a[i] = a[i] + off;
    r = rr; alast = tot;
}
DEV void hgrn_stage_vt(const Params& p, int bh, int c, unsigned char* vt) {
    const int tid = threadIdx.x, k2 = tid & 63, tq = tid >> 6;
    const int b = bh >> 2, h = bh & 3;
    const bf16_t* HV = (const bf16_t*)(p.ws + WS_HV) + ((size_t)b * SEQ + c * 64 + tq * 8) * 512 + h * 128 + 2 * k2;
    unsigned vv[8];
#pragma unroll
    for (int i = 0; i < 8; ++i) vv[i] = *(const unsigned*)(HV + (size_t)i * 512);
    u32x4 lo, hi;
    lo.x = (vv[0] & 0xffffu) | (vv[1] << 16); lo.y = (vv[2] & 0xffffu) | (vv[3] << 16); lo.z = (vv[4] & 0xffffu) | (vv[5] << 16); lo.w = (vv[6] & 0xffffu) | (vv[7] << 16);
    hi.x = (vv[0] >> 16) | (vv[1] & 0xffff0000u); hi.y = (vv[2] >> 16) | (vv[3] & 0xffff0000u); hi.z = (vv[4] >> 16) | (vv[5] & 0xffff0000u); hi.w = (vv[6] >> 16) | (vv[7] & 0xffff0000u);
    *(u32x4*)(vt + swz(2 * k2, tq)) = lo; *(u32x4*)(vt + swz(2 * k2 + 1, tq)) = hi;
}
constexpr int H1_KT = 0, H1_VT = 16384, H1_SEG = 32768, H1_EK = H1_SEG + 4096;
DEV void phase_hgrn_a1(const Params& p, unsigned char* lds, int vb0, int nb) {
    const int tid = threadIdx.x, lane = tid & 63, wid = tid >> 6, k2 = tid & 63, tq = tid >> 6;
    const int vb = vblock(), G = gridDim.x;
    const int frow = lane & 15, fq = lane >> 4, wr = wid >> 1, wc = wid & 1;
    float* segs = (float*)(lds + H1_SEG); float* ek = (float*)(lds + H1_EK);
    bf16_t* ubuf = (bf16_t*)(p.ws + WS_UBUF); float* dbuf = (float*)(p.ws + WS_DBUF);
    if (vb < vb0) return;
    for (int item = vb - vb0; item < 2048; item += nb) {
        const int bh = item >> 6, c = item & 63;
        __syncthreads();
        f32x2 lf[8], a[8], r, al;
        hgrn_cumsum(p, bh, c, segs, lf, a, r, al);
        {
            float kx[8], ky[8];
#pragma unroll
            for (int i = 0; i < 8; ++i) { kx[i] = (1.f - __expf(lf[i].x)) * __expf(fminf(r.x - a[i].x, 80.f)); ky[i] = (1.f - __expf(lf[i].y)) * __expf(fminf(r.y - a[i].y, 80.f)); }
            u32x4 w0, w1;
            w0.x = pk2(kx[0], kx[1]); w0.y = pk2(kx[2], kx[3]); w0.z = pk2(kx[4], kx[5]); w0.w = pk2(kx[6], kx[7]);
            w1.x = pk2(ky[0], ky[1]); w1.y = pk2(ky[2], ky[3]); w1.z = pk2(ky[4], ky[5]); w1.w = pk2(ky[6], ky[7]);
            *(u32x4*)(lds + H1_KT + swz(2 * k2, tq)) = w0; *(u32x4*)(lds + H1_KT + swz(2 * k2 + 1, tq)) = w1;
        }
        hgrn_stage_vt(p, bh, c, lds + H1_VT);
        if (tq == 7) { ek[2 * k2] = __expf(al.x - r.x); ek[2 * k2 + 1] = __expf(al.y - r.y); f32x2 d; d.x = __expf(al.x); d.y = __expf(al.y); *(f32x2*)(dbuf + (size_t)item * 128 + 2 * k2) = d; }
        __syncthreads();
        f32x4 acc[2][4];
#pragma unroll
        for (int m = 0; m < 2; ++m)
#pragma unroll
            for (int n = 0; n < 4; ++n) acc[m][n] = (f32x4){0.f, 0.f, 0.f, 0.f};
        const int sx = (frow >> 1) & 7;
#pragma unroll
        for (int ks = 0; ks < 2; ++ks) {
            const int co = ((ks * 4 + fq) ^ sx) << 4;
            bf16x8 af[2], bfr[4];
#pragma unroll
            for (int m = 0; m < 2; ++m) af[m] = *(const bf16x8*)(lds + H1_VT + (32 * wr + 16 * m + frow) * 128 + co);
#pragma unroll
            for (int n = 0; n < 4; ++n) bfr[n] = *(const bf16x8*)(lds + H1_KT + (64 * wc + 16 * n + frow) * 128 + co);
#pragma unroll
            for (int m = 0; m < 2; ++m)
#pragma unroll
                for (int n = 0; n < 4; ++n) acc[m][n] = __builtin_amdgcn_mfma_f32_16x16x32_bf16(bfr[n], af[m], acc[m][n], 0, 0, 0);
        }
#pragma unroll
        for (int m = 0; m < 2; ++m) { const int v = 32 * wr + 16 * m + frow;
#pragma unroll
            for (int n = 0; n < 4; ++n) { const int k0 = 64 * wc + 16 * n + 4 * fq; const f32x4 e = *(const f32x4*)(ek + k0); const f32x4 o = acc[m][n] * e;
                u32x2 w; w.x = pk2(o.x, o.y); w.y = pk2(o.z, o.w); *(u32x2*)(ubuf + ((size_t)item * 128 + v) * 128 + k0) = w; } }
    }
}
DEV void phase_hgrn_a2(const Params& p, unsigned char* lds) {
    const int G = gridDim.x;
    bf16_t* ubuf = (bf16_t*)(p.ws + WS_UBUF); const float* dbuf = (const float*)(p.ws + WS_DBUF);
    for (int gid = blockIdx.x * NT + threadIdx.x; gid < 131072; gid += G * NT) {
        const int bh = gid >> 12, v = (gid >> 5) & 127, k4 = gid & 31;
        bf16_t* u = ubuf + ((size_t)bh * 64 * 128 + v) * 128 + 4 * k4;
        const float* d = dbuf + (size_t)bh * 64 * 128 + 4 * k4;
        f32x4 S = (f32x4){0.f, 0.f, 0.f, 0.f};
        for (int c0 = 0; c0 < 64; c0 += 8) {
            u32x2 uu[8]; f32x4 dd[8];
#pragma unroll
            for (int j = 0; j < 8; ++j) { uu[j] = *(const u32x2*)(u + (size_t)(c0 + j) * 16384); dd[j] = *(const f32x4*)(d + (size_t)(c0 + j) * 128); }
#pragma unroll
            for (int j = 0; j < 8; ++j) { u32x2 w; w.x = pk2(S.x, S.y); w.y = pk2(S.z, S.w); *(u32x2*)(u + (size_t)(c0 + j) * 16384) = w;
                S.x = dd[j].x * S.x + bflo(uu[j].x); S.y = dd[j].y * S.y + bfhi(uu[j].x); S.z = dd[j].z * S.z + bflo(uu[j].y); S.w = dd[j].w * S.w + bfhi(uu[j].y); }
        }
    }
}
constexpr int H3_QH = 0, H3_QA = 16384, H3_KH = 32768, H3_VT = 49152, H3_PP = 65536, H3_ST = 73728, H3_SEG = 106496, H3_RED = 110592;
DEV void phase_hgrn_a3(const Params& p, unsigned char* lds) {
    const int tid = threadIdx.x, lane = tid & 63, wid = tid >> 6, k2 = tid & 63, tq = tid >> 6;
    const int vb = vblock(), G = gridDim.x;
    const int frow = lane & 15, fq = lane >> 4;
    float* segs = (float*)(lds + H3_SEG); float* red = (float*)(lds + H3_RED);
    const bf16_t* ubuf = (const bf16_t*)(p.ws + WS_UBUF);
    for (int item = vb; item < 2048; item += G) {
        const int bh = item >> 6, c = item & 63, b = bh >> 2, h = bh & 3;
        __syncthreads();
        f32x2 lf[8], a[8], r, al;
        hgrn_cumsum(p, bh, c, segs, lf, a, r, al);
        {
            const bf16_t* HQ = (const bf16_t*)(p.ws + WS_HQ) + ((size_t)b * SEQ + c * 64 + tq * 8) * 512 + h * 128 + 2 * k2;
            unsigned qq[8];
#pragma unroll
            for (int i = 0; i < 8; ++i) qq[i] = *(const unsigned*)(HQ + (size_t)i * 512);
#pragma unroll
            for (int i = 0; i < 8; ++i) { const int t = 8 * tq + i; const float q0 = bflo(qq[i]), q1 = bfhi(qq[i]);
                const int off = swz256(t, k2 >> 2) + (k2 & 3) * 4;
                *(unsigned*)(lds + H3_QH + off) = pk2(q0 * __expf(fminf(a[i].x - r.x, 80.f)), q1 * __expf(fminf(a[i].y - r.y, 80.f)));
                *(unsigned*)(lds + H3_QA + off) = pk2(q0 * __expf(a[i].x), q1 * __expf(a[i].y));
                *(unsigned*)(lds + H3_KH + off) = pk2((1.f - __expf(lf[i].x)) * __expf(fminf(r.x - a[i].x, 80.f)), (1.f - __expf(lf[i].y)) * __expf(fminf(r.y - a[i].y, 80.f))); }
        }
        hgrn_stage_vt(p, bh, c, lds + H3_VT);
        {
            const bf16_t* st = ubuf + (size_t)item * 16384;
#pragma unroll
            for (int i = 0; i < 4; ++i) { const int q = tid + NT * i, v = q >> 4, ch = q & 15; *(u32x4*)(lds + H3_ST + swz256(v, ch)) = *(const u32x4*)(st + v * 128 + ch * 8); }
        }
        __syncthreads();
        {
            const int wr = wid >> 1, wc = wid & 1;
            f32x4 acc[2];
            acc[0] = (f32x4){0.f, 0.f, 0.f, 0.f}; acc[1] = acc[0];
            if (32 * wc <= 16 * wr + 15) {
#pragma unroll
                for (int ks = 0; ks < 4; ++ks) {
                    const int co = ((ks * 4 + fq) ^ frow) << 4;
                    const bf16x8 af = *(const bf16x8*)(lds + H3_QH + (16 * wr + frow) * 256 + co);
#pragma unroll
                    for (int n = 0; n < 2; ++n) { const bf16x8 bfr = *(const bf16x8*)(lds + H3_KH + (32 * wc + 16 * n + frow) * 256 + co);
                        acc[n] = __builtin_amdgcn_mfma_f32_16x16x32_bf16(bfr, af, acc[n], 0, 0, 0); }
                }
            }
            const int t = 16 * wr + frow;
#pragma unroll
            for (int n = 0; n < 2; ++n) { const int s0 = 32 * wc + 16 * n + 4 * fq; f32x4 v = acc[n];
                v.x = (s0 + 0 <= t) ? v.x : 0.f; v.y = (s0 + 1 <= t) ? v.y : 0.f; v.z = (s0 + 2 <= t) ? v.z : 0.f; v.w = (s0 + 3 <= t) ? v.w : 0.f;
                u32x2 w; w.x = pk2(v.x, v.y); w.y = pk2(v.z, v.w);
                *(u32x2*)(lds + H3_PP + t * 128 + ((((s0 >> 3)) ^ ((t >> 1) & 7)) << 4) + (s0 & 7) * 2) = w; }
        }
        __syncthreads();
        {
            const int wr = wid >> 2, wc = wid & 3;
            f32x4 acc[2][2];
#pragma unroll
            for (int m = 0; m < 2; ++m)
#pragma unroll
                for (int n = 0; n < 2; ++n) acc[m][n] = (f32x4){0.f, 0.f, 0.f, 0.f};
            const int sx = (frow >> 1) & 7;
#pragma unroll
            for (int ks = 0; ks < 2; ++ks) {
                const int co = ((ks * 4 + fq) ^ sx) << 4;
                bf16x8 af[2], bfr[2];
#pragma unroll
                for (int m = 0; m < 2; ++m) af[m] = *(const bf16x8*)(lds + H3_PP + (32 * wr + 16 * m + frow) * 128 + co);
#pragma unroll
                for (int n = 0; n < 2; ++n) bfr[n] = *(const bf16x8*)(lds + H3_VT + (32 * wc + 16 * n + frow) * 128 + co);
#pragma unroll
                for (int m = 0; m < 2; ++m)
#pragma unroll
                    for (int n = 0; n < 2; ++n) acc[m][n] = __builtin_amdgcn_mfma_f32_16x16x32_bf16(bfr[n], af[m], acc[m][n], 0, 0, 0);
            }
#pragma unroll
            for (int ks = 0; ks < 4; ++ks) {
                const int co = ((ks * 4 + fq) ^ frow) << 4;
                bf16x8 af[2], bfr[2];
#pragma unroll
                for (int m = 0; m < 2; ++m) af[m] = *(const bf16x8*)(lds + H3_QA + (32 * wr + 16 * m + frow) * 256 + co);
#pragma unroll
                for (int n = 0; n < 2; ++n) bfr[n] = *(const bf16x8*)(lds + H3_ST + (32 * wc + 16 * n + frow) * 256 + co);
#pragma unroll
                for (int m = 0; m < 2; ++m)
#pragma unroll
                    for (int n = 0; n < 2; ++n) acc[m][n] = __builtin_amdgcn_mfma_f32_16x16x32_bf16(bfr[n], af[m], acc[m][n], 0, 0, 0);
            }
#pragma unroll
            for (int m = 0; m < 2; ++m) { float ss = 0.f;
#pragma unroll
                for (int n = 0; n < 2; ++n) { const f32x4 v = acc[m][n]; ss += (v.x * v.x + v.y * v.y) + (v.z * v.z + v.w * v.w); }
                ss += __shfl_xor(ss, 16); ss += __shfl_xor(ss, 32);
                if (fq == 0) red[(32 * wr + 16 * m + frow) * 4 + wc] = ss; }
            __syncthreads();
#pragma unroll
            for (int m = 0; m < 2; ++m) { const int t = 32 * wr + 16 * m + frow; const f32x4 q4 = *(const f32x4*)(red + t * 4);
                const float rs = rsqrtf(((q4.x + q4.y) + (q4.z + q4.w)) * (1.f / 128.f) + RMS_EPS);
                const size_t row = (size_t)b * SEQ + c * 64 + t;
#pragma unroll
                for (int n = 0; n < 2; ++n) { const int v0 = 32 * wc + 16 * n + 4 * fq; const f32x4 gn = *(const f32x4*)(p.g_hn + v0);
                    const u32x2 gg = *(const u32x2*)((const bf16_t*)(p.ws + WS_HG) + row * 512 + h * 128 + v0);
                    const f32x4 o = acc[m][n];
                    u32x2 w; w.x = pk2(o.x * rs * gn.x * bflo(gg.x), o.y * rs * gn.y * bfhi(gg.x)); w.y = pk2(o.z * rs * gn.z * bflo(gg.y), o.w * rs * gn.w * bfhi(gg.y));
                    *(u32x2*)((bf16_t*)(p.ws + WS_R1) + row * 1024 + 512 + h * 128 + v0) = w; } }
        }
    }
}

DEV void phase_normalize(const Params& p, unsigned char* lds) {
    const int tid = threadIdx.x, lane = tid & 63, wid = tid >> 6;
    const int vb = vblock(), G = gridDim.x;
    unsigned char* ws = p.ws;
    bf16_t* mix = (bf16_t*)(ws + WS_R1); const float* rowss = (const float*)(ws + WS_ROWSS); const bf16_t* HG = (const bf16_t*)(ws + WS_HG);
    for (int m = vb * 8 + wid; m < NTOK; m += G * 8) {
        {
            const float r = rsqrtf(rowss[m] * (1.f / 512.f) + RMS_EPS);
            u32x4* pp = (u32x4*)(mix + (size_t)m * 1024) + lane; u32x4 v = *pp;
            v.x = pk2(bflo(v.x) * r, bfhi(v.x) * r); v.y = pk2(bflo(v.y) * r, bfhi(v.y) * r); v.z = pk2(bflo(v.z) * r, bfhi(v.z) * r); v.w = pk2(bflo(v.w) * r, bfhi(v.w) * r);
            *pp = v;
        }
    }
    __syncthreads();
    {
        float* tl = (float*)lds;
        for (int r = vb; r < 32 * 4 * 16; r += G) { const int e = r / 64, q = r % 64; SrcW13_4 s{p.w1 + (size_t)e * 1024 * 512, p.w3 + (size_t)e * 1024 * 512, p.ffn_g};
            convert_tile256(tl, s, (bf16_t*)(ws + WS_W13T) + (size_t)e * 1024 * 1024, 1024, (q / 16) * 256, (q % 16) * 64); }
    }
}

struct EpiOut8 { const Params& p;
    DEV void operator()(const f32x4 (&acc)[2][2][4][2], const pg8::Unit& u, int wr, int wc, int fr, int fq) const {
#pragma unroll
        for (int ai = 0; ai < 2; ++ai)
#pragma unroll
            for (int m = 0; m < 4; ++m) { const size_t row = (size_t)u.pm * 256 + ai * 128 + wr * 64 + m * 16 + fr;
#pragma unroll
                for (int bj = 0; bj < 2; ++bj)
#pragma unroll
                    for (int n = 0; n < 2; ++n) { const int c = u.pn * 256 + 64 * wc + 32 * bj + 16 * n + 4 * fq; const f32x4 xv = *(const f32x4*)(p.x + row * DM + c); *(f32x4*)(p.out + row * DM + c) = xv + acc[ai][bj][m][n]; } }
    } };
DEV void phase_outproj(const Params& p, unsigned char* lds) {
    pg8::Gemm g{(const bf16_t*)(p.ws + WS_R1), (const bf16_t*)(p.ws + WS_WOUTT), NTOK, DM, DM};
    pg8::StaticOrder S; S.init(NTOK, DM, (int)gridDim.x, (int)blockIdx.x);
    EpiOut8 E{p};
    pg8::gemm_phase((PG8_LAS unsigned char*)lds, g, S, E);
}

constexpr int RT_W = 0, RT_LG = 49152, RT_RS = RT_LG + 128 * 49 * 4, RT_HIST = RT_RS + 512, RT_BASE = RT_HIST + 1024, RT_LDS = RT_BASE + 1024;
DEV void phase_router(const Params& p, unsigned char* lds) {
    const int tid = threadIdx.x, lane = tid & 63, wid = tid >> 6, frow = lane & 15, fq = lane >> 4;
    const int vb = vblock(), G = gridDim.x;
    unsigned char* ws = p.ws;
    float* lg = (float*)(lds + RT_LG); float* rsd = (float*)(lds + RT_RS);
    int* hist = (int*)(lds + RT_HIST); int* basep = (int*)(lds + RT_BASE);
    const bf16_t* rw = (const bf16_t*)(ws + WS_RW);
    for (int it = vb; it < NTOK / 128; it += G) {
        const size_t row0 = (size_t)it * 128;
        const size_t trow = row0 + 16 * wid + frow;
        const float* hrow = p.out + trow * DM + 8 * fq;
        bf16_t* hbrow = (bf16_t*)(ws + WS_R1) + trow * DM + 8 * fq;
        f32x4 acc[3]; float ss = 0.f;
#pragma unroll
        for (int nt = 0; nt < 3; ++nt) acc[nt] = (f32x4){0.f, 0.f, 0.f, 0.f};
        if (tid < 128) hist[tid] = 0;
        for (int kc = 0; kc < 4; ++kc) {
            __syncthreads();
#pragma unroll
            for (int i = 0; i < 6; ++i) { const int idx = tid + NT * i, r = idx >> 5, c = idx & 31;
                *(u32x4*)(lds + RT_W + r * 512 + ((c ^ (r & 15)) << 4)) = *(const u32x4*)(rw + (size_t)r * 1024 + kc * 256 + c * 8); }
            f32x4 xa[8][2];
#pragma unroll
            for (int ks = 0; ks < 8; ++ks) { xa[ks][0] = *(const f32x4*)(hrow + kc * 256 + 32 * ks); xa[ks][1] = *(const f32x4*)(hrow + kc * 256 + 32 * ks + 4); }
            __syncthreads();
#pragma unroll
            for (int ks = 0; ks < 8; ++ks) {
                const f32x4 a = xa[ks][0], b = xa[ks][1];
                ss += ((a.x * a.x + a.y * a.y) + (a.z * a.z + a.w * a.w)) + ((b.x * b.x + b.y * b.y) + (b.z * b.z + b.w * b.w));
                u32x4 hi; hi.x = pk2(a.x, a.y); hi.y = pk2(a.z, a.w); hi.z = pk2(b.x, b.y); hi.w = pk2(b.z, b.w);
                u32x4 lo; lo.x = pk2(a.x - bflo(hi.x), a.y - bfhi(hi.x)); lo.y = pk2(a.z - bflo(hi.y), a.w - bfhi(hi.y)); lo.z = pk2(b.x - bflo(hi.z), b.y - bfhi(hi.z)); lo.w = pk2(b.z - bflo(hi.w), b.w - bfhi(hi.w));
                *(u32x4*)(hbrow + kc * 256 + 32 * ks) = hi;
                const bf16x8 hh = __builtin_bit_cast(bf16x8, hi), hl = __builtin_bit_cast(bf16x8, lo);
                const int co = ((4 * ks + fq) ^ frow) << 4;
#pragma unroll
                for (int nt = 0; nt < 3; ++nt) {
                    const bf16x8 whi = *(const bf16x8*)(lds + RT_W + (16 * nt + frow) * 512 + co), wlo = *(const bf16x8*)(lds + RT_W + (48 + 16 * nt + frow) * 512 + co);
                    acc[nt] = __builtin_amdgcn_mfma_f32_16x16x32_bf16(whi, hh, acc[nt], 0, 0, 0);
                    acc[nt] = __builtin_amdgcn_mfma_f32_16x16x32_bf16(wlo, hh, acc[nt], 0, 0, 0);
                    acc[nt] = __builtin_amdgcn_mfma_f32_16x16x32_bf16(whi, hl, acc[nt], 0, 0, 0);
                }
            }
        }
        ss += __shfl_xor(ss, 16); ss += __shfl_xor(ss, 32);
        if (fq == 0) rsd[16 * wid + frow] = rsqrtf(ss * (1.f / DM) + RMS_EPS);
#pragma unroll
        for (int nt = 0; nt < 3; ++nt) { float* o = lg + (16 * wid + frow) * 49 + 16 * nt + 4 * fq; o[0] = acc[nt].x; o[1] = acc[nt].y; o[2] = acc[nt].z; o[3] = acc[nt].w; }
        __syncthreads();
        int bin = 0, slot = 0, ea = 0, eb = 0, sa = 0, sb = 0; float wa = 0.f, wb = 0.f;
        int* ehist = hist + 112; int* ebase = basep + 112;
        if (tid < 32) ehist[tid] = 0;
        __syncthreads();
        if (tid < 128) {
            const float rs = rsd[tid];
            ((float*)(ws + WS_RSTD2))[row0 + tid] = rs;
            float gl[4]; int gi = 0; float gm = -1e30f;
#pragma unroll
            for (int c = 0; c < 4; ++c) { gl[c] = lg[tid * 49 + c] * rs + p.b_group[c]; if (gl[c] > gm) { gm = gl[c]; gi = c; } }
            float gs = 0.f;
#pragma unroll
            for (int c = 0; c < 4; ++c) gs += __expf(gl[c] - gm);
            const float pg = 1.f / gs;
            float el[8]; int i0 = 0; float m0 = -1e30f;
#pragma unroll
            for (int c = 0; c < 8; ++c) { el[c] = lg[tid * 49 + 4 + gi * 8 + c] * rs + p.b_expert[gi * 8 + c]; if (el[c] > m0) { m0 = el[c]; i0 = c; } }
            int i1 = 0; float m1 = -1e30f;
#pragma unroll
            for (int c = 0; c < 8; ++c) if (c != i0 && el[c] > m1) { m1 = el[c]; i1 = c; }
            const float e1 = __expf(m1 - m0); const float w0 = pg / (1.f + e1), w1 = pg * e1 / (1.f + e1);
            const int a = min(i0, i1), bb = max(i0, i1);
            bin = gi * 28 + (7 * a - (a * (a - 1)) / 2) + (bb - a - 1);
            wa = (i0 < i1) ? w0 : w1; wb = (i0 < i1) ? w1 : w0; ea = gi * 8 + a; eb = gi * 8 + bb;
            slot = atomicAdd(&hist[bin], 1);
            sa = atomicAdd(&ehist[ea], 1); sb = atomicAdd(&ehist[eb], 1);
        }
        __syncthreads();
        if (tid < NBIN) { const int h = hist[tid]; basep[tid] = h ? atomicAdd((int*)(ws + WS_CTL) + tid, h) : 0; }
        else if (tid >= 128 && tid < 160) { const int e = tid - 128; const int h = ehist[e]; ebase[e] = h ? atomicAdd((int*)(ws + WS_CTL + 512) + e, h) : 0; }
        __syncthreads();
        if (tid < 128) {
            const int t = (int)(row0 + tid);
            ((int*)(ws + WS_BINL))[(size_t)bin * BINCAP + basep[bin] + slot] = t;
            sa += ebase[ea]; sb += ebase[eb];
            ((int*)(ws + WS_EL))[(size_t)ea * BINCAP + sa] = t; ((float*)(ws + WS_EW))[(size_t)ea * BINCAP + sa] = wa;
            ((int*)(ws + WS_EL))[(size_t)eb * BINCAP + sb] = t; ((float*)(ws + WS_EW))[(size_t)eb * BINCAP + sb] = wb;
            { const unsigned dpos = (unsigned)bin | ((unsigned)(basep[bin] + slot) << 7); ((unsigned*)(ws + WS_EDST))[(size_t)ea * BINCAP + sa] = dpos; ((unsigned*)(ws + WS_EDST))[(size_t)eb * BINCAP + sb] = dpos | (1u << 22); }
        }
        __syncthreads();
    }
}

constexpr int MOE_TS = pg8::STAGE_BYTES, MOE_TT = MOE_TS + 512, MOE_ES = MOE_TT + 1024, MOE_ET = MOE_ES + 256;
DEV void moe_tiles(const Params& p, unsigned char* lds) {
    int* tstart = (int*)(lds + MOE_TS); int* tiletab = (int*)(lds + MOE_TT); int* etstart = (int*)(lds + MOE_ES); int* etiletab = (int*)(lds + MOE_ET);
    const int tid = threadIdx.x;
    __syncthreads();
    if (tid == 0) { const int* cnt = (const int*)(p.ws + WS_CTL); int s = 0; for (int i = 0; i < NBIN; ++i) { tstart[i] = s; s += (cnt[i] + 255) >> 8; } tstart[NBIN] = s; }
    if (tid == 64) { const int* cnt = (const int*)(p.ws + WS_CTL + 512); int s = 0; for (int i = 0; i < 32; ++i) { etstart[i] = s; s += (cnt[i] + 255) >> 8; } etstart[32] = s; }
    __syncthreads();
    if (tid < NBIN) for (int t = tstart[tid]; t < tstart[tid + 1]; ++t) tiletab[t] = tid;
    if (tid >= 128 && tid < 160) for (int t = etstart[tid - 128]; t < etstart[tid - 127]; ++t) etiletab[t] = tid - 128;
    __syncthreads();
}
DEV void bin_experts(int bin, int& ea, int& eb) { const int gi = bin / 28; int pi = bin % 28, a = 0; while (pi >= 7 - a) { pi -= 7 - a; ++a; } ea = gi * 8 + a; eb = gi * 8 + a + 1 + pi; }
DEV void lane_rc(int i, int& R, int& C) { pg8::stage_rc((int)threadIdx.x * 16, R, C); R += 64 * i; }
struct MoeUnit { int tile, nt, bin, mt, n; };
struct PolMoe1 {
    typedef MoeUnit Unit;
    const Params& p; const int* etstart; const int* etiletab; int U, G, c;
    struct AddrA { unsigned off[2][2]; };
    struct AddrB { const char* base; };
    DEV int nk() const { return 16; }
    DEV bool next(int i, MoeUnit& u) const {
        const int L = i * G + c; if (L >= U) return false;
        u.tile = L >> 2; u.nt = L & 3;
        u.bin = __builtin_amdgcn_readfirstlane(etiletab[u.tile]);
        u.mt = u.tile - __builtin_amdgcn_readfirstlane(etstart[u.bin]);
        u.n = min(256, ((const int*)(p.ws + WS_CTL + 512))[u.bin] - u.mt * 256);
        return true;
    }
    DEV bool full(const MoeUnit& u) const { return u.n > 128; }
    DEV void addrA(const MoeUnit& u, AddrA& a) const {
        const int* list = (const int*)(p.ws + WS_EL) + (size_t)u.bin * BINCAP + u.mt * 256;
#pragma unroll
        for (int i = 0; i < 2; ++i) { int R, C; lane_rc(i, R, C);
#pragma unroll
            for (int h = 0; h < 2; ++h) { int r = h * 128 + R; if (r >= u.n) r = 0; a.off[h][i] = (unsigned)list[r] * 2048u + (unsigned)C * 2u; } }
    }
    DEV void addrB(const MoeUnit& u, AddrB& b) const { b.base = (const char*)(p.ws + WS_W13T) + ((size_t)u.bin * 1024 + u.nt * 256) * 2048; }
    DEV const char* pa(const AddrA& a, int h, int i, int kt) const { return (const char*)(p.ws + WS_R1) + a.off[h][i] + kt * 128; }
    DEV const char* pb(const AddrB& b, int h, int i, int kt) const { int R, C; lane_rc(i, R, C); return b.base + (size_t)h * (128 * 2048) + (unsigned)(R * 1024 + C) * 2u + kt * 128; }
};
struct EpiMoe1 { const Params& p; const int* tstart;
    DEV void operator()(const f32x4 (&acc)[2][2][4][2], const MoeUnit& u, int wr, int wc, int fr, int fq) const {
        const int* list = (const int*)(p.ws + WS_EL) + (size_t)u.bin * BINCAP + u.mt * 256;
        const float* wl = (const float*)(p.ws + WS_EW) + (size_t)u.bin * BINCAP + u.mt * 256;
        const unsigned* dl = (const unsigned*)(p.ws + WS_EDST) + (size_t)u.bin * BINCAP + u.mt * 256;
#pragma unroll
        for (int ai = 0; ai < 2; ++ai)
#pragma unroll
            for (int m = 0; m < 4; ++m) { const int r = ai * 128 + wr * 64 + m * 16 + fr; if (r >= u.n) continue;
                const float rs = ((const float*)(p.ws + WS_RSTD2))[list[r]]; const float w = wl[r]; const unsigned d = dl[r];
                bf16_t* hrow = (bf16_t*)(p.ws + WS_HBUF) + ((size_t)tstart[d & 127u] * 256 + ((d >> 7) & 32767u)) * 1024 + ((d >> 22) & 1u) * 512;
#pragma unroll
                for (int bj = 0; bj < 2; ++bj)
#pragma unroll
                    for (int n = 0; n < 2; ++n) { const f32x4 v = acc[ai][bj][m][n] * rs; const int f = (u.nt * 256 + 128 * bj + 32 * wc + 16 * n + 4 * fq) >> 1;
                        *(unsigned*)(hrow + f) = pk2(siluf_(v.x) * v.y * w, siluf_(v.z) * v.w * w); } }
    } };
DEV void phase_moe1(const Params& p, unsigned char* lds) {
    moe_tiles(p, lds);
    const int* etstart = (const int*)(lds + MOE_ES);
    PolMoe1 P{p, etstart, (const int*)(lds + MOE_ET), etstart[32] * 4, (int)gridDim.x, vblock()};
    EpiMoe1 E{p, (const int*)(lds + MOE_TS)};
    pg8::gemm_phase2(( PG8_LAS unsigned char*)lds, P, E);
}
struct PolMoe2 {
    typedef MoeUnit Unit;
    const Params& p; const int* tstart; const int* tiletab; int U, G, c;
    struct AddrA { const char* base; };
    struct AddrB { const char* ba; const char* bb; };
    DEV int nk() const { return 16; }
    DEV bool next(int i, MoeUnit& u) const {
        const int L = i * G + c; if (L >= U) return false;
        u.tile = L >> 2; u.nt = L & 3;
        u.bin = __builtin_amdgcn_readfirstlane(tiletab[u.tile]);
        u.mt = u.tile - __builtin_amdgcn_readfirstlane(tstart[u.bin]);
        u.n = min(256, ((const int*)(p.ws + WS_CTL))[u.bin] - u.mt * 256);
        return true;
    }
    DEV bool full(const MoeUnit& u) const { return u.n > 128; }
    DEV void addrA(const MoeUnit& u, AddrA& a) const { a.base = (const char*)(p.ws + WS_HBUF) + (size_t)u.tile * 256 * 2048; }
    DEV void addrB(const MoeUnit& u, AddrB& b) const {
        int ea, eb; bin_experts(u.bin, ea, eb);
        b.ba = (const char*)(p.ws + WS_W2T) + ((size_t)ea * 1024 + u.nt * 256) * 1024; b.bb = (const char*)(p.ws + WS_W2T) + ((size_t)eb * 1024 + u.nt * 256) * 1024;
    }
    DEV const char* pa(const AddrA& a, int h, int i, int kt) const { int R, C; lane_rc(i, R, C); return a.base + (size_t)h * (128 * 2048) + (unsigned)(R * 1024 + C) * 2u + kt * 128; }
    DEV const char* pb(const AddrB& b, int h, int i, int kt) const { int R, C; lane_rc(i, R, C); return (kt < 8 ? b.ba + kt * 128 : b.bb + (kt - 8) * 128) + (size_t)h * (128 * 1024) + (unsigned)(R * 512 + C) * 2u; }
};
struct EpiMoe2 { const Params& p;
    DEV void operator()(const f32x4 (&acc)[2][2][4][2], const MoeUnit& u, int wr, int wc, int fr, int fq) const {
        const int* list = (const int*)(p.ws + WS_BINL) + (size_t)u.bin * BINCAP + u.mt * 256;
#pragma unroll
        for (int ai = 0; ai < 2; ++ai)
#pragma unroll
            for (int m = 0; m < 4; ++m) { const int r = ai * 128 + wr * 64 + m * 16 + fr; if (r >= u.n) continue; const size_t t = list[r];
#pragma unroll
                for (int bj = 0; bj < 2; ++bj)
#pragma unroll
                    for (int n = 0; n < 2; ++n) { float* o = p.out + t * DM + u.nt * 256 + 128 * bj + 32 * wc + 16 * n + 4 * fq; *(f32x4*)o = *(const f32x4*)o + acc[ai][bj][m][n]; } }
    } };
DEV void phase_moe2(const Params& p, unsigned char* lds) {
    moe_tiles(p, lds);
    const int* tstart = (const int*)(lds + MOE_TS);
    PolMoe2 P{p, tstart, (const int*)(lds + MOE_TT), tstart[NBIN] * 4, (int)gridDim.x, vblock()};
    EpiMoe2 E{p};
    pg8::gemm_phase2((PG8_LAS unsigned char*)lds, P, E);
}

#define XB_TMO      128
#define XB_XCNT(j)  (256  + 64 * (j))
#define XB_XSUB(j)  (1280 + 64 * (j))
#define XB_XGEN(j)  (2304 + 64 * (j))
#define XB_TOP      3328
#define XB_TOPGEN   3392
#define XCD_BAR_WORDS 3456
#define XB_SPIN_CAP (1u << 20)
#define LAS __attribute__((address_space(3)))
constexpr size_t WS_BAR = WS_CTL + 4096;
DEV unsigned xb_ld(unsigned* p) { return __hip_atomic_load(p, __ATOMIC_RELAXED, __HIP_MEMORY_SCOPE_AGENT); }
DEV unsigned xb_add(unsigned* p, unsigned v) { return __hip_atomic_fetch_add(p, v, __ATOMIC_RELAXED, __HIP_MEMORY_SCOPE_AGENT); }
DEV unsigned xb_xcc_id() { return (unsigned)__builtin_amdgcn_s_getreg((3 << 11) | 20) & 0xFu; }
#define XB_SPIN(cond, bar) do { unsigned _sp = 0; while (cond) { __builtin_amdgcn_s_sleep(1); \
    if ((++_sp & 255u) == 0u) { if (xb_ld(&(bar)[XB_TMO])) break; if (_sp > XB_SPIN_CAP) { atomicAdd(&(bar)[XB_TMO], 1u); break; } } } } while (0)
struct XcdBarrier { unsigned* bar; unsigned x; volatile LAS unsigned* st; };
DEV XcdBarrier xcd_barrier_post(unsigned* bar, volatile LAS unsigned* st) {
    XcdBarrier b; b.bar = bar; b.x = xb_xcc_id(); b.st = st;
    if (threadIdx.x == 0) (void)xb_add(&bar[XB_XCNT(b.x)], 1u);
    return b;
}
DEV void xcd_barrier_complete(unsigned* bar, unsigned x, unsigned& nloc, unsigned& nx) {
    const unsigned G = gridDim.x * gridDim.y * gridDim.z;
    unsigned sum, cnt, mine, sp = 0u;
    for (;;) {
        sum = 0u; cnt = 0u; mine = 0u;
#pragma unroll
        for (unsigned j = 0; j < 16; ++j) { const unsigned c = xb_ld(&bar[XB_XCNT(j)]); sum += c; cnt += (c > 0u) ? 1u : 0u; mine = (j == x) ? c : mine; }
        if (sum == G) break;
        __builtin_amdgcn_s_sleep(1);
        if ((++sp & 255u) == 0u) { if (xb_ld(&bar[XB_TMO])) break; if (sp > XB_SPIN_CAP) { atomicAdd(&bar[XB_TMO], 1u); break; } }
    }
    nloc = mine > 0u ? mine : 1u; nx = cnt > 0u ? cnt : 1u;
}
DEV void xcd_barrier(const XcdBarrier& b) {
    asm volatile("s_waitcnt vmcnt(0)" ::: "memory");
    __syncthreads();
    if (threadIdx.x == 0) {
        unsigned* bar = b.bar;
        __builtin_amdgcn_s_waitcnt(0);
        unsigned nloc = b.st[0], nx = b.st[1];
        if (nloc == 0u) { xcd_barrier_complete(bar, b.x, nloc, nx); b.st[0] = nloc; b.st[1] = nx; }
        const unsigned old = xb_add(&bar[XB_XSUB(b.x)], 1u);
        const unsigned gen = old / nloc;
        if (old + 1u == (gen + 1u) * nloc) {
            __builtin_amdgcn_fence(__ATOMIC_RELEASE, "agent");
            asm volatile("s_waitcnt vmcnt(0)" ::: "memory");
            const unsigned og = xb_add(&bar[XB_TOP], 1u);
            const unsigned tg = og / nx;
            if (og + 1u == (tg + 1u) * nx) xb_add(&bar[XB_TOPGEN], 1u);
            else XB_SPIN(xb_ld(&bar[XB_TOPGEN]) == tg, bar);
            __builtin_amdgcn_fence(__ATOMIC_ACQUIRE, "agent");
            xb_add(&bar[XB_XGEN(b.x)], 1u);
            asm volatile("s_waitcnt vmcnt(0)" ::: "memory");
        } else {
            XB_SPIN(xb_ld(&bar[XB_XGEN(b.x)]) == gen, bar);
            __builtin_amdgcn_fence(__ATOMIC_ACQUIRE, "agent");
            asm volatile("s_waitcnt vmcnt(0)" ::: "memory");
        }
    }
    __syncthreads();
}

constexpr int LDS_BYTES = 144 * 1024;
constexpr int N_PHASES = 10;
__global__ void __launch_bounds__(NT) mega(Params p, int lo, int hi) {
    extern __shared__ __attribute__((aligned(16))) unsigned char lds[];
    volatile LAS unsigned* xst = (volatile LAS unsigned*)(lds + LDS_BYTES - 16);
    if (threadIdx.x < 4) xst[threadIdx.x] = 0u;
    __syncthreads();
    XcdBarrier xbar; xbar.bar = (unsigned*)(p.ws + WS_BAR); xbar.x = 0; xbar.st = xst;
    if (hi - lo > 1) xbar = xcd_barrier_post((unsigned*)(p.ws + WS_BAR), xst);
#define GRID_SYNC() xcd_barrier(xbar)
#ifndef PROBE_REPEAT
#define PROBE_REPEAT -1
#endif
#define RUN_PHASE(k, call) do { if (lo <= (k) && (k) < hi) { call; \
        if ((k) == PROBE_REPEAT) { GRID_SYNC(); \
            if ((k) == 5) { float* rz = (float*)(p.ws + WS_ROWSS); for (int i = blockIdx.x * NT + threadIdx.x; i < NTOK; i += gridDim.x * NT) rz[i] = 0.f; GRID_SYNC(); } \
            if ((k) == 8) { if (blockIdx.x == 0 && threadIdx.x < 128) ((int*)(p.ws + WS_CTL))[threadIdx.x] = 0; GRID_SYNC(); } \
            call; } \
        if ((k) + 1 < hi) GRID_SYNC(); } } while (0)
    RUN_PHASE(0, phase_prologue(p, lds));
    RUN_PHASE(1, phase_inproj(p, lds));
    RUN_PHASE(2, { phase_cmp_a(p, lds); const int G_ = (int)gridDim.x; if (G_ > 128) phase_hgrn_a1(p, lds, 64, G_ - 64); else phase_hgrn_a1(p, lds, 0, G_); });
    RUN_PHASE(3, { phase_cmp_b(p, lds); phase_hgrn_a2(p, lds); });
    RUN_PHASE(4, { phase_cmp_attn(p, lds); phase_hgrn_a3(p, lds); });
    RUN_PHASE(5, phase_flash(p, lds));
    RUN_PHASE(6, phase_normalize(p, lds));
    RUN_PHASE(7, phase_outproj(p, lds));
    RUN_PHASE(8, phase_router(p, lds));
    RUN_PHASE(9, phase_moe1(p, lds));
    RUN_PHASE(10, phase_moe2(p, lds));
#undef RUN_PHASE
}

extern "C" void kernel_launch(void* const* d_in, const int* in_sizes, int n_in, void* d_out, int out_size, void* d_ws, size_t ws_size, hipStream_t stream) {
    static int grid = 0;
    if (grid == 0) {
        int dev = 0, cus = 0, per_cu = 0;
        hipGetDevice(&dev);
        hipDeviceGetAttribute(&cus, hipDeviceAttributeMultiprocessorCount, dev);
        hipFuncSetAttribute((const void*)mega, hipFuncAttributeMaxDynamicSharedMemorySize, LDS_BYTES);
        hipOccupancyMaxActiveBlocksPerMultiprocessor(&per_cu, (const void*)mega, NT, LDS_BYTES);
        if (per_cu < 1) per_cu = 1;
        grid = cus;
        if (ws_size < WS_END) fprintf(stderr, "kernel_launch: workspace too small: %zu < %zu\n", ws_size, (size_t)WS_END);
        fprintf(stderr, "kernel_launch: cus %d per_cu %d grid %d ws %zu\n", cus, per_cu, grid, ws_size);
    }
    Params p{};
    const float** pp = (const float**)&p;
    for (int i = 0; i < 23; ++i) pp[i] = (const float*)d_in[i];
    p.out = (float*)d_out; p.ws = (unsigned char*)d_ws;
#if N_LAUNCH_MODE == 1
    (void)hipMemsetAsync((unsigned char*)d_ws + WS_BAR, 0, XCD_BAR_WORDS * 4, stream);
    int lo = 0, hi = N_PHASES + 1;
    void* args[] = {&p, &lo, &hi};
    hipError_t e = hipLaunchCooperativeKernel((const void*)mega, dim3(grid), dim3(NT), args, LDS_BYTES, stream);
    if (e != hipSuccess) fprintf(stderr, "cooperative launch failed: %s\n", hipGetErrorString(e));
#else
    for (int ph = 0; ph <= N_PHASES; ++ph) hipLaunchKernelGGL(mega, dim3(grid), dim3(NT), LDS_BYTES, stream, p, ph, ph + 1);
#endif
}
```

```cpp
#include <hip/hip_runtime.h>
#include <hip/hip_cooperative_groups.h>
#include <cstdio>
#include <cstdint>
#include <cstring>
namespace cg = cooperative_groups;

#ifndef N_LAUNCH_MODE
#define N_LAUNCH_MODE 1
#endif

#define DEV __device__ __forceinline__
typedef unsigned short bf16_t;
typedef short bf16x8 __attribute__((ext_vector_type(8)));
typedef float f32x4 __attribute__((ext_vector_type(4)));
typedef float f32x2 __attribute__((ext_vector_type(2)));
typedef float f32x16 __attribute__((ext_vector_type(16)));
typedef unsigned u32x4 __attribute__((ext_vector_type(4)));
typedef unsigned u32x2 __attribute__((ext_vector_type(2)));

constexpr int NT = 512;
constexpr int BATCH = 8, SEQ = 4096, DM = 1024, NTOK = BATCH * SEQ;
constexpr int IN_COLS = 3352, INP = 3584;
constexpr int NC = 255;
constexpr float RMS_EPS = 1e-6f;
constexpr float QSCALE = 0.125f * 1.4426950408889634f;
constexpr int NBIN = 112;
constexpr int BINCAP = NTOK;

constexpr size_t MiB = 1ull << 20;
constexpr size_t WS_CTL    = 0;
constexpr size_t WS_RSTD1  = 1 * MiB;
constexpr size_t WS_RSTD2  = WS_RSTD1 + 128 * 1024;
constexpr size_t WS_ROWSS  = WS_RSTD2 + 128 * 1024;
constexpr size_t WS_TOKW   = WS_ROWSS + 128 * 1024;
constexpr size_t WS_LB     = WS_TOKW + 256 * 1024;
constexpr size_t WS_CBIAS  = WS_LB + 4096;
constexpr size_t WS_SELM   = 2 * MiB;
constexpr size_t WS_GATES  = 3 * MiB;
constexpr size_t WS_KCMP   = 6 * MiB;
constexpr size_t WS_VCMP   = WS_KCMP + 512 * 1024;
constexpr size_t WS_CW2T   = 7 * MiB;
constexpr size_t WS_RW     = 7 * MiB + 128 * 1024;
constexpr size_t WS_HID    = 8 * MiB;
constexpr size_t WS_CW1T   = 12 * MiB;
constexpr size_t WS_WOUTT  = 14 * MiB;
constexpr size_t WS_WINT   = 16 * MiB;
constexpr size_t WS_R1     = 24 * MiB;
constexpr size_t WS_Q      = 88 * MiB;
constexpr size_t WS_KC     = 120 * MiB;
constexpr size_t WS_VC     = 128 * MiB;
constexpr size_t WS_KS     = 136 * MiB;
constexpr size_t WS_KW     = 144 * MiB;
constexpr size_t WS_VST    = 152 * MiB;
constexpr size_t WS_VWT    = 160 * MiB;
constexpr size_t WS_OC     = 168 * MiB;
constexpr size_t WS_W13T   = 200 * MiB;
constexpr size_t WS_W2T    = 264 * MiB;
constexpr size_t WS_HQ     = 296 * MiB;
constexpr size_t WS_HV     = 328 * MiB;
constexpr size_t WS_HG     = 360 * MiB;
constexpr size_t WS_HLOGF  = 392 * MiB;
constexpr size_t WS_DBUF   = 456 * MiB;
constexpr size_t WS_END    = 457 * MiB;
constexpr size_t WS_UBUF   = WS_W13T;
constexpr size_t WS_BINL   = WS_HQ;
constexpr size_t WS_HBUF   = WS_HQ + 16 * MiB;
constexpr size_t WS_EL     = WS_HQ + 136 * MiB;
constexpr size_t WS_EW     = WS_HQ + 140 * MiB;
constexpr size_t WS_EDST   = WS_HQ + 144 * MiB;

struct Params {
    const float *x, *attn_g, *ffn_g, *w_in, *w_out, *g_q, *g_k, *pos_k, *pos_v, *wk1, *wk2, *wv1, *wv2, *g_nsa, *lb_logits, *g_hn,
        *w_group, *b_group, *w_expert, *b_expert, *w1, *w3, *w2;
    float* out;
    unsigned char* ws;
};

typedef __bf16 bf16x2_t __attribute__((ext_vector_type(2)));
DEV unsigned pk2(float lo, float hi) { f32x2 f = {lo, hi}; return __builtin_bit_cast(unsigned, __builtin_convertvector(f, bf16x2_t)); }
DEV bf16_t f2bf(float f) { return (bf16_t)(pk2(f, 0.f) & 0xffffu); }
DEV float bf2f(bf16_t b) { return __uint_as_float(((unsigned)b) << 16); }
DEV float bflo(unsigned u) { return __uint_as_float(u << 16); }
DEV float bfhi(unsigned u) { return __uint_as_float(u & 0xffff0000u); }
DEV float sigmoidf_(float v) { return __builtin_amdgcn_rcpf(1.f + __builtin_amdgcn_exp2f(-1.4426950408889634f * v)); }
DEV float siluf_(float v) { return v * __builtin_amdgcn_rcpf(1.f + __builtin_amdgcn_exp2f(-1.4426950408889634f * v)); }
DEV float wave_sum(float v) {
#pragma unroll
    for (int o = 1; o < 64; o <<= 1) v += __shfl_xor(v, o);
    return v;
}
DEV float wave_max(float v) {
#pragma unroll
    for (int o = 1; o < 64; o <<= 1) v = fmaxf(v, __shfl_xor(v, o));
    return v;
}
DEV int vblock() { const int G = gridDim.x, b = blockIdx.x; return (G % 8 == 0) ? (b % 8) * (G / 8) + b / 8 : b; }

namespace pg8 {
#define PG8_LAS __attribute__((address_space(3)))
constexpr int BM = 256, BK = 64, HALF = 128, HTB = HALF * BK * 2, STAGE_BYTES = 8 * HTB, NXCD = 8, WGM = 8;
__host__ __device__ __forceinline__ int lds_byte(int r, int c) { const int st = (r >> 4) * 2 + (c >> 5), rr = r & 15, cc = c & 31, ob = rr * 64 + cc * 2; return st * 1024 + (ob ^ (((ob >> 9) & 1) << 5)); }
__host__ __device__ __forceinline__ void stage_rc(int b, int& R, int& C) { const int st = b / 1024, sb = b % 1024, swz = sb ^ (((sb >> 9) & 1) << 5); R = (st >> 1) * 16 + swz / 64; C = (st & 1) * 32 + (swz % 64) / 2; }
struct Unit { int pm, pn; };
struct Gemm { const bf16_t* A; const bf16_t* Bt; int M, N, K; };
struct StaticOrder {
    int nM, nN, nwg, G, c;
    __host__ __device__ void init(int M, int N, int G_, int c_) { nM = M / BM; nN = N / BM; nwg = nM * nN; G = G_; c = c_; }
    __host__ __device__ bool next(int i, Unit& u) const {
        const long L = (long)i * G + c; if (L >= nwg) return false;
        int wgid = (int)L; { const int q = nwg / NXCD, r = nwg % NXCD, xcd = wgid % NXCD, off = wgid / NXCD; wgid = (xcd < r ? xcd * (q + 1) : r * (q + 1) + (xcd - r) * q) + off; }
        const int nig = WGM * nN, gid = wgid / nig, fm = gid * WGM, gsz = (nM - fm) < WGM ? (nM - fm) : WGM;
        u.pm = fm + ((wgid % nig) % gsz); u.pn = (wgid % nig) / gsz; return true;
    }
};
template <class Epi, class Sched>
__device__ __forceinline__ void gemm_phase(PG8_LAS unsigned char* lds, const Gemm g, const Sched& S, const Epi& E) {
    const int tid = threadIdx.x, wid = __builtin_amdgcn_readfirstlane(tid >> 6), lane = tid & 63, wr = wid >> 2, wc = wid & 3, fr = lane & 15, fq = lane >> 4;
    const int K = g.K, nt = K / BK;
    unsigned voffA[2];
#pragma unroll
    for (int i = 0; i < 2; ++i) { int R, C; stage_rc(tid * 16 + i * 8192, R, C); voffA[i] = (unsigned)(R * K + C) * 2u; }
    const size_t kstep = (size_t)(BK * 2);
    const size_t hstep = (size_t)HALF * K * 2;
    const size_t tstep = 2 * hstep;
    const unsigned ldsw = (unsigned)wid * 1024u;
    const int aoff = lds_byte(wr * 64 + fr, fq * 8), boff = lds_byte(wc * 32 + fr, fq * 8);
#define PG8_SA(b, h) (((b) * 2 + (h)) * HTB)
#define PG8_SB(b, h) ((4 + (b) * 2 + (h)) * HTB)
#define PG8_STAGE(bufoff, gbase, voff) do { _Pragma("unroll") for (int _i = 0; _i < 2; ++_i) \
        __builtin_amdgcn_global_load_lds((const unsigned*)((const char*)(gbase) + (voff)[_i]), (PG8_LAS unsigned*)(lds + (bufoff) + ldsw + _i * 8192), 16, 0, 0); } while (0)
#define PG8_LDA(dst, b, h) do { _Pragma("unroll") for (int m = 0; m < 4; ++m) _Pragma("unroll") for (int k = 0; k < 2; ++k) dst[m][k] = *(const PG8_LAS bf16x8*)(lds + PG8_SA(b, h) + aoff + m * 2048 + k * 1024); } while (0)
#define PG8_LDB(dst, b, h) do { _Pragma("unroll") for (int n = 0; n < 2; ++n) _Pragma("unroll") for (int k = 0; k < 2; ++k) dst[n][k] = *(const PG8_LAS bf16x8*)(lds + PG8_SB(b, h) + boff + n * 2048 + k * 1024); } while (0)
#define PG8_MMA(ai, bj, At, Bt) do { __builtin_amdgcn_s_setprio(1); _Pragma("unroll") for (int m = 0; m < 4; ++m) _Pragma("unroll") for (int n = 0; n < 2; ++n) _Pragma("unroll") for (int k = 0; k < 2; ++k) \
        acc[ai][bj][m][n] = __builtin_amdgcn_mfma_f32_16x16x32_bf16(Bt[n][k], At[m][k], acc[ai][bj][m][n], 0, 0, 0); __builtin_amdgcn_s_setprio(0); } while (0)
#define PG8_WAIT_V(n) asm volatile("s_waitcnt vmcnt(" #n ")" ::: "memory")
#define PG8_WAIT_L(n) asm volatile("s_waitcnt lgkmcnt(" #n ")" ::: "memory")
#define PG8_BAR __builtin_amdgcn_s_barrier()
#define PG8_SCHED __builtin_amdgcn_sched_barrier(0)
    Unit cur, nxt; int ui = 0;
    if (!S.next(0, cur)) return;
    f32x4 acc[2][2][4][2];
#pragma unroll
    for (int a = 0; a < 2; ++a)
#pragma unroll
        for (int b = 0; b < 2; ++b)
#pragma unroll
            for (int m = 0; m < 4; ++m)
#pragma unroll
                for (int n = 0; n < 2; ++n) acc[a][b][m][n] = (f32x4){0.f, 0.f, 0.f, 0.f};
    bf16x8 At[4][2], B0[2][2], B1[2][2];
    const char* cA = (const char*)g.A + (size_t)cur.pm * tstep; const char* cB = (const char*)g.Bt + (size_t)cur.pn * tstep;
    PG8_STAGE(PG8_SB(0, 0), cB, voffA); PG8_STAGE(PG8_SA(0, 0), cA, voffA); PG8_STAGE(PG8_SB(0, 1), cB + hstep, voffA); PG8_STAGE(PG8_SA(0, 1), cA + hstep, voffA);
    if (wr == 1) PG8_BAR;
    PG8_WAIT_V(4); PG8_BAR;
    PG8_STAGE(PG8_SB(1, 0), cB + kstep, voffA); PG8_STAGE(PG8_SA(1, 0), cA + kstep, voffA); PG8_STAGE(PG8_SB(1, 1), cB + hstep + kstep, voffA);
    PG8_WAIT_V(6); PG8_BAR;
    for (;;) {
        const bool has_next = S.next(ui + 1, nxt);
        const char* nA = has_next ? (const char*)g.A + (size_t)nxt.pm * tstep : cA; const char* nB = has_next ? (const char*)g.Bt + (size_t)nxt.pn * tstep : cB;
        float midrs[2][4];
        if constexpr (Epi::MIDSCALE) {
#pragma unroll
            for (int a = 0; a < 2; ++a)
#pragma unroll
                for (int m = 0; m < 4; ++m) midrs[a][m] = E.rowscale(cur.pm * BM + a * HALF + wr * 64 + m * 16 + fr); }
        for (int t = 0; t < nt; t += 2) {
            const bool last = (t == nt - 2);
            if constexpr (Epi::MIDSCALE) { if (t == E.midk()) {
#pragma unroll
                for (int a = 0; a < 2; ++a)
#pragma unroll
                    for (int b = 0; b < 2; ++b)
#pragma unroll
                        for (int m = 0; m < 4; ++m)
#pragma unroll
                            for (int n = 0; n < 2; ++n) acc[a][b][m][n] = acc[a][b][m][n] * midrs[a][m]; } }
            const char* a1 = cA + (size_t)(t + 1) * kstep;
            const char* a2 = last ? nA : cA + (size_t)(t + 2) * kstep; const char* b2 = last ? nB : cB + (size_t)(t + 2) * kstep;
            const char* a3 = a2 + kstep; const char* b3 = b2 + kstep;
            PG8_LDB(B0, 0, 0); PG8_SCHED; PG8_LDA(At, 0, 0); PG8_STAGE(PG8_SA(1, 1), a1 + hstep, voffA);
            PG8_WAIT_L(8); PG8_BAR; PG8_WAIT_L(0); PG8_MMA(0, 0, At, B0); PG8_BAR; PG8_SCHED;
            PG8_LDB(B1, 0, 1); PG8_STAGE(PG8_SB(0, 0), b2, voffA);
            PG8_BAR; PG8_WAIT_L(0); PG8_MMA(0, 1, At, B1); PG8_BAR;
            PG8_LDA(At, 0, 1); PG8_STAGE(PG8_SA(0, 0), a2, voffA);
            PG8_BAR; PG8_WAIT_L(0); PG8_MMA(1, 0, At, B0); PG8_BAR; PG8_SCHED;
            PG8_STAGE(PG8_SB(0, 1), b2 + hstep, voffA);
            PG8_WAIT_V(6); PG8_BAR; PG8_MMA(1, 1, At, B1); PG8_BAR;
            PG8_LDB(B0, 1, 0); PG8_SCHED; PG8_LDA(At, 1, 0); PG8_STAGE(PG8_SA(0, 1), a2 + hstep, voffA);
            PG8_WAIT_L(8); PG8_BAR; PG8_WAIT_L(0); PG8_MMA(0, 0, At, B0); PG8_BAR; PG8_SCHED;
            PG8_LDB(B1, 1, 1); PG8_STAGE(PG8_SB(1, 0), b3, voffA);
            PG8_BAR; PG8_WAIT_L(0); PG8_MMA(0, 1, At, B1); PG8_BAR;
            PG8_LDA(At, 1, 1); PG8_STAGE(PG8_SA(1, 0), a3, voffA);
            PG8_BAR; PG8_WAIT_L(0); PG8_MMA(1, 0, At, B0); PG8_BAR; PG8_SCHED;
            PG8_STAGE(PG8_SB(1, 1), b3 + hstep, voffA);
            PG8_WAIT_V(6); PG8_BAR; PG8_MMA(1, 1, At, B1); PG8_BAR;
        }
        E(acc, cur, wr, wc, fr, fq);
        if (!has_next) break;
#pragma unroll
        for (int a = 0; a < 2; ++a)
#pragma unroll
            for (int b = 0; b < 2; ++b)
#pragma unroll
                for (int m = 0; m < 4; ++m)
#pragma unroll
                    for (int n = 0; n < 2; ++n) acc[a][b][m][n] = (f32x4){0.f, 0.f, 0.f, 0.f};
        cur = nxt; cA = nA; cB = nB; ++ui;
    }
    PG8_WAIT_V(0);
    if (wr == 0) PG8_BAR;
    PG8_BAR;
#undef PG8_SA
#undef PG8_SB
#undef PG8_STAGE
#undef PG8_LDA
#undef PG8_LDB
#undef PG8_MMA
#undef PG8_WAIT_V
#undef PG8_WAIT_L
#undef PG8_BAR
#undef PG8_SCHED
}
template <class Pol, class Epi>
__device__ __forceinline__ void gemm_phase2(PG8_LAS unsigned char* lds, const Pol& P, const Epi& E) {
    const int tid = threadIdx.x, wid = __builtin_amdgcn_readfirstlane(tid >> 6), lane = tid & 63, wr = wid >> 2, wc = wid & 3, fr = lane & 15, fq = lane >> 4;
    const int nt = P.nk();
    const unsigned ldsw = (unsigned)wid * 1024u;
    const int aoff = lds_byte(wr * 64 + fr, fq * 8), boff = lds_byte(wc * 32 + fr, fq * 8);
#define PG8_SA(b, h) (((b) * 2 + (h)) * HTB)
#define PG8_SB(b, h) ((4 + (b) * 2 + (h)) * HTB)
#define PG8_STAGE_A(bufoff, AS, h, kt) do { _Pragma("unroll") for (int _i = 0; _i < 2; ++_i) \
        __builtin_amdgcn_global_load_lds((const unsigned*)P.pa(AS, h, _i, kt), (PG8_LAS unsigned*)(lds + (bufoff) + ldsw + _i * 8192), 16, 0, 0); } while (0)
#define PG8_STAGE_B(bufoff, BS, h, kt) do { _Pragma("unroll") for (int _i = 0; _i < 2; ++_i) \
        __builtin_amdgcn_global_load_lds((const unsigned*)P.pb(BS, h, _i, kt), (PG8_LAS unsigned*)(lds + (bufoff) + ldsw + _i * 8192), 16, 0, 0); } while (0)
#define PG8_LDA(dst, b, h) do { _Pragma("unroll") for (int m = 0; m < 4; ++m) _Pragma("unroll") for (int k = 0; k < 2; ++k) dst[m][k] = *(const PG8_LAS bf16x8*)(lds + PG8_SA(b, h) + aoff + m * 2048 + k * 1024); } while (0)
#define PG8_LDB(dst, b, h) do { _Pragma("unroll") for (int n = 0; n < 2; ++n) _Pragma("unroll") for (int k = 0; k < 2; ++k) dst[n][k] = *(const PG8_LAS bf16x8*)(lds + PG8_SB(b, h) + boff + n * 2048 + k * 1024); } while (0)
#define PG8_MMA(ai, bj, At, Bt) do { __builtin_amdgcn_s_setprio(1); _Pragma("unroll") for (int m = 0; m < 4; ++m) _Pragma("unroll") for (int n = 0; n < 2; ++n) _Pragma("unroll") for (int k = 0; k < 2; ++k) \
        acc[ai][bj][m][n] = __builtin_amdgcn_mfma_f32_16x16x32_bf16(Bt[n][k], At[m][k], acc[ai][bj][m][n], 0, 0, 0); __builtin_amdgcn_s_setprio(0); } while (0)
#define PG8_STAGE_A2(bufoff, h, kt) do { _Pragma("unroll") for (int _i = 0; _i < 2; ++_i) \
        __builtin_amdgcn_global_load_lds((const unsigned*)P.pa(a2, h, _i, kt), (PG8_LAS unsigned*)(lds + (bufoff) + ldsw + _i * 8192), 16, 0, 0); } while (0)
#define PG8_STAGE_B2(bufoff, h, kt) do { _Pragma("unroll") for (int _i = 0; _i < 2; ++_i) \
        __builtin_amdgcn_global_load_lds((const unsigned*)P.pb(b2, h, _i, kt), (PG8_LAS unsigned*)(lds + (bufoff) + ldsw + _i * 8192), 16, 0, 0); } while (0)
#define PG8_WAIT_V(n) asm volatile("s_waitcnt vmcnt(" #n ")" ::: "memory")
#define PG8_WAIT_L(n) asm volatile("s_waitcnt lgkmcnt(" #n ")" ::: "memory")
#define PG8_BAR __builtin_amdgcn_s_barrier()
#define PG8_SCHED __builtin_amdgcn_sched_barrier(0)
    typename Pol::Unit cur, nxt; int ui = 0;
    if (!P.next(0, cur)) return;
    f32x4 acc[2][2][4][2];
#pragma unroll
    for (int a = 0; a < 2; ++a)
#pragma unroll
        for (int b = 0; b < 2; ++b)
#pragma unroll
            for (int m = 0; m < 4; ++m)
#pragma unroll
                for (int n = 0; n < 2; ++n) acc[a][b][m][n] = (f32x4){0.f, 0.f, 0.f, 0.f};
    bf16x8 At[4][2], B0[2][2], B1[2][2];
    typename Pol::AddrA aC, aN; typename Pol::AddrB bC, bN;
    P.addrA(cur, aC); P.addrB(cur, bC);
    PG8_STAGE_B(PG8_SB(0, 0), bC, 0, 0); PG8_STAGE_A(PG8_SA(0, 0), aC, 0, 0); PG8_STAGE_B(PG8_SB(0, 1), bC, 1, 0); PG8_STAGE_A(PG8_SA(0, 1), aC, 1, 0);
    if (wr == 1) PG8_BAR;
    PG8_WAIT_V(4); PG8_BAR;
    PG8_STAGE_B(PG8_SB(1, 0), bC, 0, 1); PG8_STAGE_A(PG8_SA(1, 0), aC, 0, 1); PG8_STAGE_B(PG8_SB(1, 1), bC, 1, 1);
    PG8_WAIT_V(6); PG8_BAR;
    for (;;) {
        const bool has_next = P.next(ui + 1, nxt);
        if (has_next) { P.addrA(nxt, aN); P.addrB(nxt, bN); } else { aN = aC; bN = bC; }
        const bool full = P.full(cur);
        for (int t = 0; t < nt; t += 2) {
            const bool last = (t == nt - 2);
            const typename Pol::AddrA a2 = last ? aN : aC; const typename Pol::AddrB b2 = last ? bN : bC;
            const int k2 = last ? 0 : t + 2, k3 = k2 + 1;
            PG8_LDB(B0, 0, 0); PG8_SCHED; PG8_LDA(At, 0, 0); PG8_STAGE_A(PG8_SA(1, 1), aC, 1, t + 1);
            PG8_WAIT_L(8); PG8_BAR; PG8_WAIT_L(0); PG8_MMA(0, 0, At, B0); PG8_BAR; PG8_SCHED;
            PG8_LDB(B1, 0, 1); PG8_STAGE_B2(PG8_SB(0, 0), 0, k2);
            PG8_BAR; PG8_WAIT_L(0); PG8_MMA(0, 1, At, B1); PG8_BAR;
            PG8_LDA(At, 0, 1); PG8_STAGE_A2(PG8_SA(0, 0), 0, k2);
            PG8_BAR; PG8_WAIT_L(0); if (full) PG8_MMA(1, 0, At, B0); PG8_BAR; PG8_SCHED;
            PG8_STAGE_B2(PG8_SB(0, 1), 1, k2);
            PG8_WAIT_V(6); PG8_BAR; if (full) PG8_MMA(1, 1, At, B1); PG8_BAR;
            PG8_LDB(B0, 1, 0); PG8_SCHED; PG8_LDA(At, 1, 0); PG8_STAGE_A2(PG8_SA(0, 1), 1, k2);
            PG8_WAIT_L(8); PG8_BAR; PG8_WAIT_L(0); PG8_MMA(0, 0, At, B0); PG8_BAR; PG8_SCHED;
            PG8_LDB(B1, 1, 1); PG8_STAGE_B2(PG8_SB(1, 0), 0, k3);
            PG8_BAR; PG8_WAIT_L(0); PG8_MMA(0, 1, At, B1); PG8_BAR;
            PG8_LDA(At, 1, 1); PG8_STAGE_A2(PG8_SA(1, 0), 0, k3);
            PG8_BAR; PG8_WAIT_L(0); if (full) PG8_MMA(1, 0, At, B0); PG8_BAR; PG8_SCHED;
            PG8_STAGE_B2(PG8_SB(1, 1), 1, k3);
            PG8_WAIT_V(6); PG8_BAR; if (full) PG8_MMA(1, 1, At, B1); PG8_BAR;
        }
        E(acc, cur, wr, wc, fr, fq);
        if (!has_next) break;
#pragma unroll
        for (int a = 0; a < 2; ++a)
#pragma unroll
            for (int b = 0; b < 2; ++b)
#pragma unroll
                for (int m = 0; m < 4; ++m)
#pragma unroll
                    for (int n = 0; n < 2; ++n) acc[a][b][m][n] = (f32x4){0.f, 0.f, 0.f, 0.f};
        cur = nxt; aC = aN; bC = bN; ++ui;
    }
    PG8_WAIT_V(0);
    if (wr == 0) PG8_BAR;
    PG8_BAR;
#undef PG8_SA
#undef PG8_SB
#undef PG8_STAGE_A
#undef PG8_STAGE_B
#undef PG8_STAGE_A2
#undef PG8_STAGE_B2
#undef PG8_LDA
#undef PG8_LDB
#undef PG8_MMA
#undef PG8_WAIT_V
#undef PG8_WAIT_L
#undef PG8_BAR
#undef PG8_SCHED
}
__host__ __device__ __forceinline__ int perm_lo(int x) { return (((x >> 2) & 3) << 3) | (((x >> 4) & 1) << 2) | (x & 3); }
__host__ __device__ __forceinline__ int inv_perm_lo(int y) { return (((y >> 2) & 1) << 4) | (((y >> 3) & 3) << 2) | (y & 3); }
__host__ __device__ __forceinline__ int logcol(int p) { return (p & ~255) + 64 * ((p >> 5) & 3) + 32 * ((p >> 7) & 1) + perm_lo(p & 31); }
}

template <class SRC>
DEV void convert_tile(float* tl, const SRC& src, bf16_t* dst, int ldd, int n0, int k0) {
    const int tid = threadIdx.x;
    {
        const int n = tid & 63;
#pragma unroll
        for (int i = 0; i < 8; ++i) { const int kk = (tid >> 6) + 8 * i; tl[kk * 65 + n] = src.get(n0 + n, k0 + kk); }
    }
    __syncthreads();
    {
        const int n = tid >> 3, kc = tid & 7;
        const float* s = tl + (kc * 8) * 65 + n;
        u32x4 o;
        o.x = pk2(s[0 * 65], s[1 * 65]); o.y = pk2(s[2 * 65], s[3 * 65]); o.z = pk2(s[4 * 65], s[5 * 65]); o.w = pk2(s[6 * 65], s[7 * 65]);
        *(u32x4*)(dst + (size_t)(n0 + n) * ldd + k0 + kc * 8) = o;
    }
    __syncthreads();
}
struct SrcWin { const float* w; const float* g;
    DEV float get(int np, int k) const { const int n = pg8::logcol(np); int col; if (n < 1280) col = n; else if (n < 3328) col = n + 24; else if (n < 3352) col = 1280 + (n - 3328); else return 0.f;
        return w[(size_t)k * IN_COLS + col] * g[k]; } };
struct SrcWout { const float* w; const float* g;
    DEV float get(int np, int k) const { const int n = pg8::logcol(np); const float v = w[(size_t)k * DM + n]; return k < 512 ? v * g[k] : v; } };
struct SrcPlain { const float* w; int ld;
    DEV float get(int n, int k) const { return w[(size_t)k * ld + n]; } };
struct SrcW13 { const float* w1; const float* w3; const float* g;
    DEV float get(int n, int k) const { const uintptr_t a = (uintptr_t)w1, b = (uintptr_t)w3; const float* w = (const float*)(a + ((b - a) & (uintptr_t)(0 - (long long)(n & 1))));
        return w[(size_t)k * 512 + (n >> 1)] * g[k]; } };

template <class SRC>
DEV void convert_tile256(float* tl, const SRC& src, bf16_t* dst, int ldd, int n0, int k0) {
    const int tid = threadIdx.x;
    {
        const int q = tid & 63;
        f32x4 v[8];
#pragma unroll
        for (int i = 0; i < 8; ++i) v[i] = src.quad(n0, q, k0 + (tid >> 6) + 8 * i);
#pragma unroll
        for (int i = 0; i < 8; ++i) { float* o = tl + ((tid >> 6) + 8 * i) * 257; o[src.drow(q, 0)] = v[i].x; o[src.drow(q, 1)] = v[i].y; o[src.drow(q, 2)] = v[i].z; o[src.drow(q, 3)] = v[i].w; }
    }
    __syncthreads();
#pragma unroll
    for (int i = 0; i < 4; ++i) {
        const int idx = tid + NT * i, n = idx >> 3, kc = idx & 7;
        const float* s = tl + (kc * 8) * 257 + n;
        u32x4 o;
        o.x = pk2(s[0 * 257], s[1 * 257]); o.y = pk2(s[2 * 257], s[3 * 257]); o.z = pk2(s[4 * 257], s[5 * 257]); o.w = pk2(s[6 * 257], s[7 * 257]);
        *(u32x4*)(dst + (size_t)(n0 + n) * ldd + k0 + kc * 8) = o;
    }
    __syncthreads();
}
struct SrcWin4 { const float* w; const float* g;
    DEV int drow(int q, int e) const { return 4 * q + e; }
    DEV f32x4 quad(int n0, int q, int k) const { const int n = pg8::logcol(n0 + 4 * q); int col; if (n < 1280) col = n; else if (n < 3328) col = n + 24; else if (n < 3352) col = 1280 + (n - 3328); else return (f32x4){0.f, 0.f, 0.f, 0.f};
        return *(const f32x4*)(w + (size_t)k * IN_COLS + col) * g[k]; } };
struct SrcWout4 { const float* w; const float* g;
    DEV int drow(int q, int e) const { return 4 * q + e; }
    DEV f32x4 quad(int n0, int q, int k) const { const f32x4 v = *(const f32x4*)(w + (size_t)k * DM + pg8::logcol(n0 + 4 * q)); return k < 512 ? v * g[k] : v; } };
struct SrcPlain4 { const float* w; int ld;
    DEV int drow(int q, int e) const { return 4 * q + e; }
    DEV f32x4 quad(int n0, int q, int k) const { return *(const f32x4*)(w + (size_t)k * ld + n0 + 4 * q); } };
struct SrcW13_4 { const float* w1; const float* w3; const float* g;
    DEV int drow(int q, int e) const { const int l = 8 * (q & 31) + 2 * e + (q >> 5); return (l & ~31) | pg8::inv_perm_lo(l & 31); }
    DEV f32x4 quad(int n0, int q, int k) const { const uintptr_t a = (uintptr_t)w1, b = (uintptr_t)w3; const float* w = (const float*)(a + ((b - a) & (uintptr_t)(0 - (long long)(q >> 5))));
        return *(const f32x4*)(w + (size_t)k * 512 + (n0 >> 1) + 4 * (q & 31)) * g[k]; } };

DEV void phase_prologue(const Params& p, unsigned char* lds) {
    float* tl = (float*)lds;
    const int tid = threadIdx.x, lane = tid & 63, wid = tid >> 6;
    const int vb = vblock(), G = gridDim.x;
    unsigned char* ws = p.ws;
    constexpr int I_WIN = (INP / 256) * (DM / 64);
    constexpr int I_WOUT = 4 * 16;
    constexpr int I_CW1 = 2 * 32;
    constexpr int I_W2 = 32 * 4 * 8;
    constexpr int I_CW2 = 2 * 1 * 4;
    constexpr int I_ALL = I_WIN + I_WOUT + I_CW1 + I_W2 + I_CW2;
    for (int it = vb; it < I_ALL; it += G) {
        int r = it;
        if (r < I_WIN) { SrcWin4 s{p.w_in, p.attn_g}; convert_tile256(tl, s, (bf16_t*)(ws + WS_WINT), DM, (r / 16) * 256, (r % 16) * 64); continue; } r -= I_WIN;
        if (r < I_WOUT) { SrcWout4 s{p.w_out, p.g_nsa}; convert_tile256(tl, s, (bf16_t*)(ws + WS_WOUTT), DM, (r / 16) * 256, (r % 16) * 64); continue; } r -= I_WOUT;
        if (r < I_CW1) { const int z = r / 32, q = r % 32; SrcPlain4 s{z ? p.wv1 : p.wk1, 256};
            convert_tile256(tl, s, (bf16_t*)(ws + WS_CW1T) + (size_t)z * 256 * 2048, 2048, 0, q * 64); continue; } r -= I_CW1;
        if (r < I_W2) { const int e = r / 32, q = r % 32; SrcPlain4 s{p.w2 + (size_t)e * 512 * 1024, 1024};
            convert_tile256(tl, s, (bf16_t*)(ws + WS_W2T) + (size_t)e * 1024 * 512, 512, (q / 8) * 256, (q % 8) * 64); continue; } r -= I_W2;
        { const int z = r / 4, q = r % 4; SrcPlain s{z ? p.wv2 : p.wk2, 64};
            convert_tile(tl, s, (bf16_t*)(ws + WS_CW2T) + (size_t)z * 64 * 256, 256, 0, q * 64); }
    }
    {
        bf16_t* xb = (bf16_t*)(ws + WS_R1); float* rstd1 = (float*)(ws + WS_RSTD1);
        const int gw = vb * 8 + wid, NGW = G * 8;
        for (int m = gw; m < NTOK; m += NGW) {
            const f32x4* xr = (const f32x4*)(p.x + (size_t)m * DM) + lane;
            f32x4 v[4]; float s = 0.f;
#pragma unroll
            for (int j = 0; j < 4; ++j) { v[j] = xr[64 * j]; s += (v[j].x * v[j].x + v[j].y * v[j].y) + (v[j].z * v[j].z + v[j].w * v[j].w); }
            s = wave_sum(s);
            if (lane == 0) rstd1[m] = rsqrtf(s * (1.f / DM) + RMS_EPS);
            u32x2* o = (u32x2*)(xb + (size_t)m * DM) + lane;
#pragma unroll
            for (int j = 0; j < 4; ++j) { u32x2 w; w.x = pk2(v[j].x, v[j].y); w.y = pk2(v[j].z, v[j].w); o[64 * j] = w; }
        }
    }
    {
        const int gt = vb * NT + tid, NG = G * NT;
        float* rowss = (float*)(ws + WS_ROWSS);
        for (int i = gt; i < NTOK; i += NG) rowss[i] = 0.f;
        int* bincnt = (int*)(ws + WS_CTL);
        if (gt < 128) bincnt[gt] = 0;
        if (gt < 32) ((int*)(ws + WS_CTL + 512))[gt] = 0;
        if (gt < 512) { const float l0 = p.lb_logits[gt], l1 = p.lb_logits[512 + gt]; ((float*)(ws + WS_LB))[gt] = 1.f / (1.f + __expf(l1 - l0)); }
        for (int i = gt; i < 48 * 1024; i += NG) { const int c = i >> 10, k = i & 1023;
            const float w = (c < 4 ? p.w_group[k * 4 + c] : (c < 36 ? p.w_expert[k * 32 + (c - 4)] : 0.f)) * p.ffn_g[k];
            const bf16_t hi = f2bf(w); const bf16_t lo = f2bf(w - bf2f(hi));
            ((bf16_t*)(ws + WS_RW))[i] = hi; ((bf16_t*)(ws + WS_RW))[48 * 1024 + i] = lo; }
        if (blockIdx.x == (unsigned)(G - 1)) {
            const int z = tid >> 8, j = tid & 255; const float* pos = z ? p.pos_v : p.pos_k; const float* w = z ? p.wv1 : p.wk1;
            float a = 0.f;
            for (int k = 0; k < 2048; ++k) a += pos[k] * w[(size_t)k * 256 + j];
            ((float*)(ws + WS_CBIAS))[z * 256 + j] = a;
        }
    }
}

constexpr int G_A_BYTES = 128 * 128, G_B_BYTES = 256 * 128, G_STAGE = G_A_BYTES + G_B_BYTES, G_LDS = 2 * G_STAGE;
DEV int swz(int row, int chunk) { return row * 128 + ((chunk ^ ((row >> 1) & 7)) << 4); }
template <class AL, class BL, class EP>
DEV void gemm_tile(unsigned char* lds, const AL& al, const BL& bl, int nk, const EP& ep) {
    const int tid = threadIdx.x, lane = tid & 63, wid = tid >> 6, wr = wid >> 2, wc = wid & 3;
    const int frow = lane & 15, fq = lane >> 4;
    const bf16_t* aptr[2]; int aoff[2], boff[4], brow[4];
#pragma unroll
    for (int i = 0; i < 2; ++i) { const int q = tid + NT * i, row = q >> 3, ch = q & 7; aptr[i] = al.row(row) + ch * 8; aoff[i] = swz(row, ch); }
#pragma unroll
    for (int i = 0; i < 4; ++i) { const int q = tid + NT * i, row = q >> 3, ch = q & 7; brow[i] = row; boff[i] = G_A_BYTES + swz(row, ch) ; }
    const int bch8 = (tid & 7) * 8;
    u32x4 ra[2], rb[4];
#pragma unroll
    for (int i = 0; i < 2; ++i) ra[i] = *(const u32x4*)(aptr[i]);
#pragma unroll
    for (int i = 0; i < 4; ++i) rb[i] = *(const u32x4*)(bl.ptr(brow[i], 0) + bch8);
#pragma unroll
    for (int i = 0; i < 2; ++i) *(u32x4*)(lds + aoff[i]) = ra[i];
#pragma unroll
    for (int i = 0; i < 4; ++i) *(u32x4*)(lds + boff[i]) = rb[i];
    __syncthreads();
    f32x4 acc[4][4];
#pragma unroll
    for (int m = 0; m < 4; ++m)
#pragma unroll
        for (int n = 0; n < 4; ++n) acc[m][n] = (f32x4){0.f, 0.f, 0.f, 0.f};
    const int sx = (frow >> 1) & 7;
    for (int kt = 0; kt < nk; ++kt) {
        const bool more = (kt + 1 < nk);
        if (more) {
#pragma unroll
            for (int i = 0; i < 2; ++i) ra[i] = *(const u32x4*)(aptr[i] + (kt + 1) * 64);
#pragma unroll
            for (int i = 0; i < 4; ++i) rb[i] = *(const u32x4*)(bl.ptr(brow[i], kt + 1) + bch8);
        }
        const unsigned char* base = lds + (kt & 1) * G_STAGE;
#pragma unroll
        for (int ks = 0; ks < 2; ++ks) {
            const int co = ((ks * 4 + fq) ^ sx) << 4;
            bf16x8 af[4], bfr[4];
#pragma unroll
            for (int m = 0; m < 4; ++m) af[m] = *(const bf16x8*)(base + (wr * 64 + m * 16 + frow) * 128 + co);
#pragma unroll
            for (int n = 0; n < 4; ++n) bfr[n] = *(const bf16x8*)(base + G_A_BYTES + (wc * 64 + n * 16 + frow) * 128 + co);
#pragma unroll
            for (int m = 0; m < 4; ++m)
#pragma unroll
                for (int n = 0; n < 4; ++n) acc[m][n] = __builtin_amdgcn_mfma_f32_16x16x32_bf16(bfr[n], af[m], acc[m][n], 0, 0, 0);
        }
        if (more) {
            unsigned char* nb = lds + ((kt + 1) & 1) * G_STAGE;
#pragma unroll
            for (int i = 0; i < 2; ++i) *(u32x4*)(nb + aoff[i]) = ra[i];
#pragma unroll
            for (int i = 0; i < 4; ++i) *(u32x4*)(nb + boff[i]) = rb[i];
        }
        __syncthreads();
    }
    ep(acc, wr, wc, lane);
}

struct ARows { const bf16_t* base; size_t ld; DEV const bf16_t* row(int r) const { return base + (size_t)r * ld; } };
struct BRows { const bf16_t* base; size_t ld; DEV const bf16_t* ptr(int n, int kt) const { return base + (size_t)n * ld + kt * 64; } };

DEV u32x4 pk8(const f32x4 a, const f32x4 b) { u32x4 w; w.x = pk2(a.x, a.y); w.y = pk2(a.z, a.w); w.z = pk2(b.x, b.y); w.w = pk2(b.z, b.w); return w; }
DEV void inproj_row(const Params& p, int seg, int row, f32x4 (&v)[2][2], int fq) {
    unsigned char* ws = p.ws;
    const float rs = ((const float*)(ws + WS_RSTD1))[row];
#pragma unroll
    for (int bj = 0; bj < 2; ++bj) { v[bj][0] = v[bj][0] * rs; v[bj][1] = v[bj][1] * rs; }
    const int b = row >> 12, s = row & 4095;
    const bool is_q = seg < 8, is_ks = (seg == 12 || seg == 13), is_kw = (seg == 16 || seg == 17);
    if (is_q || is_ks || is_kw) {
        const float* gw = is_q ? p.g_q : (is_ks ? p.g_k + 64 : p.g_k + 128);
        bf16_t* dst; int hh, nh;
        if (is_q) { dst = (bf16_t*)(ws + WS_Q); hh = seg; nh = 8; } else if (is_ks) { dst = (bf16_t*)(ws + WS_KS); hh = seg - 12; nh = 2; } else { dst = (bf16_t*)(ws + WS_KW); hh = seg - 16; nh = 2; }
        float ss = 0.f;
#pragma unroll
        for (int bj = 0; bj < 2; ++bj)
#pragma unroll
            for (int n = 0; n < 2; ++n) ss += (v[bj][n].x * v[bj][n].x + v[bj][n].y * v[bj][n].y) + (v[bj][n].z * v[bj][n].z + v[bj][n].w * v[bj][n].w);
        ss += __shfl_xor(ss, 16); ss += __shfl_xor(ss, 32);
        float r = rsqrtf(ss * (1.f / 64.f) + RMS_EPS); if (is_q) r *= QSCALE;
        bf16_t* o = dst + ((size_t)(b * nh + hh) * SEQ + s) * 64 + fq * 8;
#pragma unroll
        for (int bj = 0; bj < 2; ++bj) { const f32x4 g0 = *(const f32x4*)(gw + 32 * bj + 8 * fq), g1 = *(const f32x4*)(gw + 32 * bj + 8 * fq + 4);
            *(u32x4*)(o + 32 * bj) = pk8(v[bj][0] * g0 * r, v[bj][1] * g1 * r); }
        return;
    }
    if (seg >= 8 && seg < 12) {
        bf16_t* o = (bf16_t*)(ws + (seg < 10 ? WS_KC : WS_VC)) + ((size_t)(b * 2 + (seg & 1)) * SEQ + s) * 64 + fq * 8;
#pragma unroll
        for (int bj = 0; bj < 2; ++bj) *(u32x4*)(o + 32 * bj) = pk8(v[bj][0], v[bj][1]);
        return;
    }
    if (seg == 14 || seg == 15 || seg == 18 || seg == 19) {
        bf16_t* o = (bf16_t*)(ws + (seg < 16 ? WS_VST : WS_VWT)) + (size_t)(b * 2 + (seg & 1)) * 64 * SEQ + s;
#pragma unroll
        for (int bj = 0; bj < 2; ++bj)
#pragma unroll
            for (int n = 0; n < 2; ++n) { const int d = 32 * bj + 8 * fq + 4 * n; const f32x4 x = v[bj][n];
                o[(size_t)(d + 0) * SEQ] = f2bf(x.x); o[(size_t)(d + 1) * SEQ] = f2bf(x.y); o[(size_t)(d + 2) * SEQ] = f2bf(x.z); o[(size_t)(d + 3) * SEQ] = f2bf(x.w); }
        return;
    }
    if (seg < 52) {
        const int kind = (seg - 20) >> 3, cb = ((seg - 20) & 7) * 64 + fq * 8;
        if (kind == 1) {
            const float* lb = (const float*)(ws + WS_LB); float* dst = (float*)(ws + WS_HLOGF) + (size_t)row * 512;
#pragma unroll
            for (int bj = 0; bj < 2; ++bj)
#pragma unroll
                for (int n = 0; n < 2; ++n) { const int c = cb + 32 * bj + 4 * n; const f32x4 l = *(const f32x4*)(lb + c); const f32x4 x = v[bj][n]; f32x4 o;
                    o.x = __logf(l.x + (1.f - l.x) * sigmoidf_(x.x)); o.y = __logf(l.y + (1.f - l.y) * sigmoidf_(x.y));
                    o.z = __logf(l.z + (1.f - l.z) * sigmoidf_(x.z)); o.w = __logf(l.w + (1.f - l.w) * sigmoidf_(x.w));
                    *(f32x4*)(dst + c) = o; }
        } else {
            bf16_t* dst = (bf16_t*)(ws + (kind == 0 ? WS_HQ : (kind == 2 ? WS_HV : WS_HG))) + (size_t)row * 512 + cb;
#pragma unroll
            for (int bj = 0; bj < 2; ++bj) { f32x4 x0 = v[bj][0], x1 = v[bj][1];
                if (kind != 2) { x0.x = siluf_(x0.x); x0.y = siluf_(x0.y); x0.z = siluf_(x0.z); x0.w = siluf_(x0.w); x1.x = siluf_(x1.x); x1.y = siluf_(x1.y); x1.z = siluf_(x1.z); x1.w = siluf_(x1.w); }
                *(u32x4*)(dst + 32 * bj) = pk8(x0, x1); }
        }
        return;
    }
    {
        float* dst = (float*)(ws + WS_GATES) + (size_t)row * 24;
        if (fq < 3) {
#pragma unroll
            for (int n = 0; n < 2; ++n) { const f32x4 x = v[0][n]; f32x4 o; o.x = sigmoidf_(x.x); o.y = sigmoidf_(x.y); o.z = sigmoidf_(x.z); o.w = sigmoidf_(x.w); *(f32x4*)(dst + 8 * fq + 4 * n) = o; } }
    }
}
struct EpiInproj8 { const Params& p; static constexpr bool MIDSCALE = false; DEV float rowscale(int) const { return 1.f; } DEV int midk() const { return -1; }
    DEV void operator()(const f32x4 (&acc)[2][2][4][2], const pg8::Unit& u, int wr, int wc, int fr, int fq) const {
        const int seg = u.pn * 4 + wc;
        if (seg > 52) return;
#pragma unroll
        for (int ai = 0; ai < 2; ++ai)
#pragma unroll
            for (int m = 0; m < 4; ++m) { f32x4 v[2][2] = {{acc[ai][0][m][0], acc[ai][0][m][1]}, {acc[ai][1][m][0], acc[ai][1][m][1]}};
                inproj_row(p, seg, u.pm * 256 + ai * 128 + wr * 64 + m * 16 + fr, v, fq); }
    } };
DEV void phase_inproj(const Params& p, unsigned char* lds) {
    pg8::Gemm g{(const bf16_t*)(p.ws + WS_R1), (const bf16_t*)(p.ws + WS_WINT), NTOK, INP, DM};
    pg8::StaticOrder S; S.init(NTOK, INP, (int)gridDim.x, (int)blockIdx.x);
    EpiInproj8 E{p};
    pg8::gemm_phase(( PG8_LAS unsigned char*)lds, g, S, E);
}

struct ACmp { const bf16_t* src; int bg, c0;
    DEV const bf16_t* row(int r) const { int c = c0 + r; if (c > NC - 1) c = NC - 1; return src + ((size_t)bg * SEQ + 16 * c) * 64; } };
struct EpiCmpA { const Params& p; int z, rbase;
    DEV void operator()(f32x4 (&acc)[4][4], int wr, int wc, int lane) const {
        const int frow = lane & 15, fq = lane >> 4;
        const float* cb = (const float*)(p.ws + WS_CBIAS) + z * 256; bf16_t* hid = (bf16_t*)(p.ws + WS_HID) + (size_t)z * 4096 * 256;
#pragma unroll
        for (int m = 0; m < 4; ++m) { const int rr = rbase + wr * 64 + m * 16 + frow;
#pragma unroll
            for (int n = 0; n < 4; ++n) { const int c = wc * 64 + n * 16 + fq * 4; const f32x4 b = *(const f32x4*)(cb + c); f32x4 v = acc[m][n] + b;
                u32x2 w; w.x = pk2(siluf_(v.x), siluf_(v.y)); w.y = pk2(siluf_(v.z), siluf_(v.w)); *(u32x2*)(hid + (size_t)rr * 256 + c) = w; } }
    } };
DEV void phase_cmp_a(const Params& p, unsigned char* lds) {
    const int vb = vblock(), G = gridDim.x;
    for (int u = vb; u < 64; u += G) {
        const int z = u >> 5, rbase = (u & 31) * 128;
        ACmp al{(const bf16_t*)(p.ws + (z ? WS_VC : WS_KC)), (u & 31) >> 1, (u & 1) * 128};
        BRows bl{(const bf16_t*)(p.ws + WS_CW1T) + (size_t)z * 256 * 2048, 2048};
        EpiCmpA ep{p, z, rbase};
        gemm_tile(lds, al, bl, 2048 / 64, ep);
    }
}
struct BClamp64 { const bf16_t* base; size_t ld; DEV const bf16_t* ptr(int n, int kt) const { return base + (size_t)(n & 63) * ld + kt * 64; } };
struct EpiCmpB { const Params& p; int z, rbase;
    DEV void operator()(f32x4 (&acc)[4][4], int wr, int wc, int lane) const {
        if (wc != 0) return;
        const int frow = lane & 15, fq = lane >> 4;
        bf16_t* dst = (bf16_t*)(p.ws + (z ? WS_VCMP : WS_KCMP));
#pragma unroll
        for (int m = 0; m < 4; ++m) { const int rr = rbase + wr * 64 + m * 16 + frow;
            float r = 1.f;
            if (z == 0) { float ss = 0.f;
#pragma unroll
                for (int n = 0; n < 4; ++n) { const f32x4 v = acc[m][n]; ss += (v.x * v.x + v.y * v.y) + (v.z * v.z + v.w * v.w); }
                ss += __shfl_xor(ss, 16); ss += __shfl_xor(ss, 32); r = rsqrtf(ss * (1.f / 64.f) + RMS_EPS); }
            const int bg = rr >> 8, c = rr & 255;
            if (c < NC) {
#pragma unroll
                for (int n = 0; n < 4; ++n) { const int d = n * 16 + fq * 4; f32x4 v = acc[m][n] * r;
                    if (z == 0) { const f32x4 g = *(const f32x4*)(p.g_k + d); v = v * g;
                        u32x2 w; w.x = pk2(v.x, v.y); w.y = pk2(v.z, v.w); *(u32x2*)(dst + ((size_t)bg * 256 + c) * 64 + d) = w; }
                    else { bf16_t* o = dst + ((size_t)bg * 64 + d) * 256 + c; o[0] = f2bf(v.x); o[256] = f2bf(v.y); o[512] = f2bf(v.z); o[768] = f2bf(v.w); } } }
        }
    } };
DEV void phase_cmp_b(const Params& p, unsigned char* lds) {
    const int vb = vblock(), G = gridDim.x;
    for (int u = vb; u < 64; u += G) {
        const int z = u >> 5, rbase = (u & 31) * 128;
        ARows al{(const bf16_t*)(p.ws + WS_HID) + ((size_t)z * 4096 + rbase) * 256, 256};
        BClamp64 bl{(const bf16_t*)(p.ws + WS_CW2T) + (size_t)z * 64 * 256, 256};
        EpiCmpB ep{p, z, rbase};
        gemm_tile(lds, al, bl, 256 / 64, ep);
    }
}

constexpr int CM_K = 0, CM_V = 32768, CM_VSTR = 520, CM_IMP = CM_V + 64 * CM_VSTR, CM_LDS = CM_IMP + 4 * 16384;
DEV void cm_scores(const unsigned char* kbase, int kt, const bf16x8 (&qf)[4], int r31, int hh, f32x16 (&sacc)[2]) {
#pragma unroll
    for (int kt2 = 0; kt2 < 2; ++kt2) {
#pragma unroll
        for (int i = 0; i < 16; ++i) sacc[kt2][i] = 0.f;
        const int row = 64 * kt + 32 * kt2 + r31; const int sx = (row >> 1) & 7;
#pragma unroll
        for (int s = 0; s < 4; ++s) { const bf16x8 kf = *(const bf16x8*)(kbase + row * 128 + (((2 * s + hh) ^ sx) << 4));
            sacc[kt2] = __builtin_amdgcn_mfma_f32_32x32x16_bf16(kf, qf[s], sacc[kt2], 0, 0, 0); }
    }
}
DEV void phase_cmp_attn(const Params& p, unsigned char* lds) {
    const int tid = threadIdx.x, lane = tid & 63, wid = tid >> 6;
    const int vb = vblock(), G = gridDim.x;
    unsigned char* ws = p.ws;
    const int r31 = lane & 31, hh = lane >> 5;
    float* impl = (float*)(lds + CM_IMP);
    for (int it = vb; it < 1024; it += G) {
        const int rnd = it / G, pos = it % G; int sidx = (rnd & 1) ? (rnd * G + (G - 1 - pos)) : (rnd * G + pos); if (G != 256) sidx = it;
        const int ci = 63 - (sidx >> 4), bg = sidx & 15, b = bg >> 1, g = bg & 1;
        const int nvis = min(NC, 4 * ci + 3), ntile = (nvis + 63) >> 6;
        const int head = g * 4 + (wid >> 1);
        const int tokl = (wid & 1) * 32 + r31, t = ci * 64 + tokl;
        const size_t tok = (size_t)b * SEQ + t;
        const int nv = t >= 31 ? min(NC, (t - 31) / 16 + 1) : 0;
        __syncthreads();
        {
            const bf16_t* kc = (const bf16_t*)(ws + WS_KCMP) + (size_t)bg * 256 * 64; const bf16_t* vt = (const bf16_t*)(ws + WS_VCMP) + (size_t)bg * 64 * 256;
            const int cpr = ntile * 8;
            u32x4 rk[4], rv[4];
#pragma unroll
            for (int i = 0; i < 4; ++i) if (i < ntile) { const int idx = tid + NT * i; rk[i] = *(const u32x4*)(kc + (idx >> 3) * 64 + (idx & 7) * 8); const int d = idx / cpr, ck = idx % cpr; rv[i] = *(const u32x4*)(vt + d * 256 + ck * 8); }
#pragma unroll
            for (int i = 0; i < 4; ++i) if (i < ntile) { const int idx = tid + NT * i; *(u32x4*)(lds + CM_K + swz(idx >> 3, idx & 7)) = rk[i];
                const int d = idx / cpr, ck = idx % cpr; u32x2 a, c2; a.x = rv[i].x; a.y = rv[i].y; c2.x = rv[i].z; c2.y = rv[i].w; unsigned char* o = lds + CM_V + d * CM_VSTR + ck * 16; *(u32x2*)o = a; *(u32x2*)(o + 8) = c2; }
        }
        bf16x8 qf[4];
        { const bf16_t* qp = (const bf16_t*)(ws + WS_Q) + ((size_t)(b * 8 + head) * SEQ + t) * 64 + 8 * hh;
#pragma unroll
            for (int s = 0; s < 4; ++s) qf[s] = *(const bf16x8*)(qp + 16 * s); }
        __syncthreads();
        float m_run = -1e30f, l_run = 0.f;
        for (int kt = 0; kt < ntile; ++kt) {
            f32x16 sacc[2];
            cm_scores(lds + CM_K, kt, qf, r31, hh, sacc);
            float mx = -1e30f;
#pragma unroll
            for (int kt2 = 0; kt2 < 2; ++kt2)
#pragma unroll
                for (int i = 0; i < 16; ++i) { const int c = 64 * kt + 32 * kt2 + (i & 3) + 8 * (i >> 2) + 4 * hh; const float v = (c < nv) ? sacc[kt2][i] : -1e30f; sacc[kt2][i] = v; mx = fmaxf(mx, v); }
            const float m_new = fmaxf(m_run, mx); float rs = 0.f;
#pragma unroll
            for (int kt2 = 0; kt2 < 2; ++kt2)
#pragma unroll
                for (int i = 0; i < 16; ++i) { const float v = sacc[kt2][i]; rs += (v > -5e29f) ? __builtin_amdgcn_exp2f(v - m_new) : 0.f; }
            l_run = l_run * __builtin_amdgcn_exp2f(m_run - m_new) + rs; m_run = m_new;
        }
        float M, invL;
        { const float mo = __shfl_xor(m_run, 32), lo = __shfl_xor(l_run, 32); M = fmaxf(m_run, mo); const float L = l_run * __builtin_amdgcn_exp2f(m_run - M) + lo * __builtin_amdgcn_exp2f(mo - M); invL = L > 0.f ? 1.f / L : 0.f; }
        f32x16 ot[2];
#pragma unroll
        for (int dt = 0; dt < 2; ++dt)
#pragma unroll
            for (int i = 0; i < 16; ++i) ot[dt][i] = 0.f;
        float carry = 0.f;
#pragma unroll
        for (int kt = 0; kt < 4; ++kt) if (kt < ntile) {
            f32x16 sacc[2];
            cm_scores(lds + CM_K, kt, qf, r31, hh, sacc);
#pragma unroll
            for (int kt2 = 0; kt2 < 2; ++kt2)
#pragma unroll
                for (int i = 0; i < 16; ++i) { const int c = 64 * kt + 32 * kt2 + (i & 3) + 8 * (i >> 2) + 4 * hh; sacc[kt2][i] = (c < nv) ? __builtin_amdgcn_exp2f(sacc[kt2][i] - M) : 0.f; }
            {
                float own[8], xs[8];
#pragma unroll
                for (int kt2 = 0; kt2 < 2; ++kt2)
#pragma unroll
                    for (int g4 = 0; g4 < 4; ++g4) { const float e3 = 0.5f * sacc[kt2][4 * g4 + 3];
                        own[4 * kt2 + g4] = (sacc[kt2][4 * g4] + sacc[kt2][4 * g4 + 1]) + (sacc[kt2][4 * g4 + 2] + e3); xs[4 * kt2 + g4] = __shfl_xor(e3, 32); }
                float* io = impl + (wid >> 1) * 4096 + tokl * 64 + 16 * kt + hh;
#pragma unroll
                for (int gi = 0; gi < 8; ++gi) io[2 * gi] = (own[gi] + (hh ? xs[gi] : (gi > 0 ? xs[gi > 0 ? gi - 1 : 0] : carry))) * invL;
                carry = xs[7];
            }
#pragma unroll
            for (int kt2 = 0; kt2 < 2; ++kt2)
#pragma unroll
                for (int s2 = 0; s2 < 2; ++s2) {
                    bf16x8 pf; { u32x4 w; w.x = pk2(sacc[kt2][8 * s2 + 0], sacc[kt2][8 * s2 + 1]); w.y = pk2(sacc[kt2][8 * s2 + 2], sacc[kt2][8 * s2 + 3]);
                        w.z = pk2(sacc[kt2][8 * s2 + 4], sacc[kt2][8 * s2 + 5]); w.w = pk2(sacc[kt2][8 * s2 + 6], sacc[kt2][8 * s2 + 7]); pf = __builtin_bit_cast(bf16x8, w); }
#pragma unroll
                    for (int dt = 0; dt < 2; ++dt) {
                        const unsigned char* va = lds + CM_V + (32 * dt + r31) * CM_VSTR + (64 * kt + 32 * kt2 + 16 * s2 + 4 * hh) * 2;
                        const u32x2 lo = *(const u32x2*)(va), hi = *(const u32x2*)(va + 16);
                        u32x4 w; w.x = lo.x; w.y = lo.y; w.z = hi.x; w.w = hi.y;
                        ot[dt] = __builtin_amdgcn_mfma_f32_32x32x16_bf16(__builtin_bit_cast(bf16x8, w), pf, ot[dt], 0, 0, 0);
                    }
                }
        }
        {
            const float sc = ((const float*)(ws + WS_GATES))[tok * 24 + head * 3 + 0] * invL;
            bf16_t* ocp = (bf16_t*)(ws + WS_OC) + tok * 512 + head * 64;
#pragma unroll
            for (int dt = 0; dt < 2; ++dt)
#pragma unroll
                for (int g4 = 0; g4 < 4; ++g4) { const int d0 = 32 * dt + 8 * g4 + 4 * hh;
                    u32x2 w; w.x = pk2(ot[dt][4 * g4 + 0] * sc, ot[dt][4 * g4 + 1] * sc); w.y = pk2(ot[dt][4 * g4 + 2] * sc, ot[dt][4 * g4 + 3] * sc); *(u32x2*)(ocp + d0) = w; }
        }
        __syncthreads();
        for (int tt = 0; tt < 8; ++tt) {
            const int tl = wid * 8 + tt, cur = ci;
            unsigned long long mask;
            if (cur < 16) mask = (2ull << cur) - 1ull;
            else {
                const bool valid = lane <= cur;
                const float imp = (impl[tl * 64 + lane] + impl[4096 + tl * 64 + lane]) + (impl[8192 + tl * 64 + lane] + impl[12288 + tl * 64 + lane]);
                const unsigned key = (lane == 0 || lane == cur) ? 0x7F800000u : __float_as_uint(imp);
                unsigned T = 0u;
                for (int bit = 30; bit >= 0; --bit) { const unsigned cand = T | (1u << bit); if (__popcll(__ballot(valid && key >= cand)) >= 16) T = cand; }
                const unsigned long long gt = __ballot(valid && key > T), eq = __ballot(valid && key == T);
                const int need = 16 - __popcll(gt);
                const int below = __popcll(eq & ((1ull << lane) - 1ull));
                mask = gt | __ballot(valid && key == T && below < need);
            }
            if (lane == 0) ((unsigned long long*)(ws + WS_SELM))[(size_t)bg * SEQ + ci * 64 + tl] = mask;
        }
    }
}

constexpr int FA_KB = 64 * 128, FA_VB = 64 * 136, FA_STAGE = FA_KB + FA_VB, FA_LDS = 2 * FA_STAGE + 1024;
template <bool SEL>
DEV void fa_branch(unsigned char* lds, const bf16_t* Kb, const bf16_t* VTb, int ci, int bg, const bf16x8 (&qf)[4], int t, unsigned long long mymask, unsigned long long need,
                   f32x16 (&ot)[2], float& m_run, float& l_run) {
    const int tid = threadIdx.x, lane = tid & 63;
    const int r31 = lane & 31, hh = lane >> 5;
    const int lrow = tid >> 3, lch = tid & 7;
    const bf16_t* kg = Kb + ((size_t)bg * SEQ + lrow) * 64 + lch * 8;
    const bf16_t* vg = VTb + ((size_t)bg * 64 + lrow) * SEQ + lch * 8;
    const int koff = lrow * 128 + ((lch ^ ((lrow >> 1) & 7)) << 4), voff = FA_KB + lrow * 136 + lch * 16;
    int jlo, jhi; unsigned long long todo;
    if (SEL) { todo = need; jlo = 0; jhi = ci; } else { jlo = ci >= 8 ? ci - 8 : 0; jhi = ci; todo = 0; }
    int j = jlo;
    if (SEL) { if (todo == 0) return; j = __builtin_ctzll(todo); todo &= todo - 1; }
    u32x4 rk = *(const u32x4*)(kg + (size_t)j * 64 * 64), rv = *(const u32x4*)(vg + (size_t)j * 64);
    __syncthreads();
    *(u32x4*)(lds + koff) = rk; { u32x2 a, b2; a.x = rv.x; a.y = rv.y; b2.x = rv.z; b2.y = rv.w; *(u32x2*)(lds + voff) = a; *(u32x2*)(lds + voff + 8) = b2; }
    __syncthreads();
    int st = 0; bool seen = false;
    for (;;) {
        int jn; bool more;
        if (SEL) { more = (todo != 0); jn = more ? __builtin_ctzll(todo) : 0; todo &= todo - 1; } else { jn = j + 1; more = (jn <= jhi); }
        if (more) { rk = *(const u32x4*)(kg + (size_t)jn * 64 * 64); rv = *(const u32x4*)(vg + (size_t)jn * 64); }
        const unsigned char* base = lds + st * FA_STAGE;
        const bool bit = SEL ? ((mymask >> j) & 1ull) != 0 : true;
        const float cinit = (SEL && !bit) ? -__builtin_inff() : -m_run;
        f32x16 sacc[2];
#pragma unroll
        for (int kt2 = 0; kt2 < 2; ++kt2) {
#pragma unroll
            for (int i = 0; i < 16; ++i) sacc[kt2][i] = cinit;
            const int row = 32 * kt2 + r31; const int sx = (row >> 1) & 7;
#pragma unroll
            for (int s = 0; s < 4; ++s) { const bf16x8 kf = *(const bf16x8*)(base + row * 128 + (((2 * s + hh) ^ sx) << 4));
                sacc[kt2] = __builtin_amdgcn_mfma_f32_32x32x16_bf16(kf, qf[s], sacc[kt2], 0, 0, 0); }
        }
        const bool boundary = SEL ? (j == ci) : (j == ci || j + 8 <= ci);
        float mx = -__builtin_inff();
        if (boundary) {
#pragma unroll
            for (int kt2 = 0; kt2 < 2; ++kt2)
#pragma unroll
                for (int i = 0; i < 16; ++i) { const int key = 64 * j + 32 * kt2 + (i & 3) + 8 * (i >> 2) + 4 * hh;
                    const bool ok = SEL ? (key <= t) : (key <= t && t - key < 512);
                    const float v = ok ? sacc[kt2][i] : -__builtin_inff(); sacc[kt2][i] = v; mx = fmaxf(mx, v); }
        } else {
#pragma unroll
            for (int kt2 = 0; kt2 < 2; ++kt2)
#pragma unroll
                for (int i = 0; i < 16; ++i) mx = fmaxf(mx, sacc[kt2][i]);
        }
        mx = fmaxf(mx, __shfl_xor(mx, 32));
        const bool live = mx > -__builtin_inff();
        const bool need = (mx > 8.f) || (!seen && live && mx < -8.f);
        if (__any(need)) {
            const float d = need ? mx : 0.f;
            const float alpha = d > 0.f ? __builtin_amdgcn_exp2f(-d) : 1.f;
            m_run += d; l_run *= alpha;
#pragma unroll
            for (int dt = 0; dt < 2; ++dt)
#pragma unroll
                for (int i = 0; i < 16; ++i) ot[dt][i] *= alpha;
#pragma unroll
            for (int kt2 = 0; kt2 < 2; ++kt2)
#pragma unroll
                for (int i = 0; i < 16; ++i) sacc[kt2][i] -= d;
        }
        seen = seen || live;
        float rs = 0.f;
#pragma unroll
        for (int kt2 = 0; kt2 < 2; ++kt2)
#pragma unroll
            for (int i = 0; i < 16; ++i) { const float e = __builtin_amdgcn_exp2f(sacc[kt2][i]); sacc[kt2][i] = e; rs += e; }
        l_run += rs;
#pragma unroll
        for (int kt2 = 0; kt2 < 2; ++kt2)
#pragma unroll
            for (int s2 = 0; s2 < 2; ++s2) {
                bf16x8 pf; { u32x4 w; w.x = pk2(sacc[kt2][8 * s2 + 0], sacc[kt2][8 * s2 + 1]); w.y = pk2(sacc[kt2][8 * s2 + 2], sacc[kt2][8 * s2 + 3]);
                    w.z = pk2(sacc[kt2][8 * s2 + 4], sacc[kt2][8 * s2 + 5]); w.w = pk2(sacc[kt2][8 * s2 + 6], sacc[kt2][8 * s2 + 7]); pf = __builtin_bit_cast(bf16x8, w); }
#pragma unroll
                for (int dt = 0; dt < 2; ++dt) {
                    const unsigned char* va = base + FA_KB + (32 * dt + r31) * 136 + (32 * kt2 + 16 * s2 + 4 * hh) * 2;
                    const u32x2 lo = *(const u32x2*)(va), hi = *(const u32x2*)(va + 16);
                    u32x4 w; w.x = lo.x; w.y = lo.y; w.z = hi.x; w.w = hi.y;
                    ot[dt] = __builtin_amdgcn_mfma_f32_32x32x16_bf16(__builtin_bit_cast(bf16x8, w), pf, ot[dt], 0, 0, 0);
                }
            }
        if (!more) break;
        { unsigned char* nb = lds + (st ^ 1) * FA_STAGE; *(u32x4*)(nb + koff) = rk; u32x2 a, b2; a.x = rv.x; a.y = rv.y; b2.x = rv.z; b2.y = rv.w; *(u32x2*)(nb + voff) = a; *(u32x2*)(nb + voff + 8) = b2; }
        __syncthreads();
        st ^= 1; j = jn;
    }
}
DEV void phase_flash(const Params& p, unsigned char* lds) {
    const int tid = threadIdx.x, lane = tid & 63, wid = tid >> 6;
    const int vb = vblock(), G = gridDim.x;
    unsigned char* ws = p.ws;
    const int r31 = lane & 31, hh = lane >> 5;
    unsigned long long* red = (unsigned long long*)(lds + 2 * FA_STAGE);
    for (int it = vb; it < 1024; it += G) {
        const int rnd = it / G, pos = it % G; int sidx = (rnd & 1) ? (rnd * G + (G - 1 - pos)) : (rnd * G + pos); if (G != 256) sidx = it;
        const int ci = 63 - (sidx >> 4), bg = sidx & 15, b = bg >> 1, g = bg & 1;
        const int head = g * 4 + (wid >> 1);
        const int t = ci * 64 + (wid & 1) * 32 + r31;
        const size_t tok = (size_t)b * SEQ + t;
        bf16x8 qf[4];
        { const bf16_t* qp = (const bf16_t*)(ws + WS_Q) + ((size_t)(b * 8 + head) * SEQ + t) * 64 + 8 * hh;
#pragma unroll
            for (int s = 0; s < 4; ++s) qf[s] = *(const bf16x8*)(qp + 16 * s); }
        const unsigned long long mymask = ((const unsigned long long*)(ws + WS_SELM))[(size_t)bg * SEQ + t];
        unsigned long long orm = mymask;
#pragma unroll
        for (int o = 1; o < 32; o <<= 1) { const unsigned lo = __shfl_xor((unsigned)orm, o), hi = __shfl_xor((unsigned)(orm >> 32), o); orm |= ((unsigned long long)hi << 32) | lo; }
        __syncthreads();
        if (wid < 2 && lane == 0) red[wid] = orm;
        __syncthreads();
        const unsigned long long need = red[0] | red[1];
        f32x16 oc[2];
        {
            f32x16 ot[2]; float m_run = 0.f, l_run = 0.f;
#pragma unroll
            for (int dt = 0; dt < 2; ++dt)
#pragma unroll
                for (int i = 0; i < 16; ++i) ot[dt][i] = 0.f;
            fa_branch<true>(lds, (const bf16_t*)(ws + WS_KS), (const bf16_t*)(ws + WS_VST), ci, bg, qf, t, mymask, need, ot, m_run, l_run);
            const float lt = l_run + __shfl_xor(l_run, 32);
            const float sc = ((const float*)(ws + WS_GATES))[tok * 24 + head * 3 + 1] / lt;
#pragma unroll
            for (int dt = 0; dt < 2; ++dt)
#pragma unroll
                for (int i = 0; i < 16; ++i) oc[dt][i] = ot[dt][i] * sc;
        }
        {
            f32x16 ot[2]; float m_run = 0.f, l_run = 0.f;
#pragma unroll
            for (int dt = 0; dt < 2; ++dt)
#pragma unroll
                for (int i = 0; i < 16; ++i) ot[dt][i] = 0.f;
            fa_branch<false>(lds, (const bf16_t*)(ws + WS_KW), (const bf16_t*)(ws + WS_VWT), ci, bg, qf, t, 0ull, 0ull, ot, m_run, l_run);
            const float lt = l_run + __shfl_xor(l_run, 32);
            const float sc = ((const float*)(ws + WS_GATES))[tok * 24 + head * 3 + 2] / lt;
#pragma unroll
            for (int dt = 0; dt < 2; ++dt)
#pragma unroll
                for (int i = 0; i < 16; ++i) oc[dt][i] += ot[dt][i] * sc;
        }
        {
            const bf16_t* ocp = (const bf16_t*)(ws + WS_OC) + tok * 512 + head * 64;
            bf16_t* mix = (bf16_t*)(ws + WS_R1) + tok * 1024 + head * 64;
            float ss = 0.f;
#pragma unroll
            for (int dt = 0; dt < 2; ++dt)
#pragma unroll
                for (int g4 = 0; g4 < 4; ++g4) { const int d0 = 32 * dt + 8 * g4 + 4 * hh; const u32x2 c = *(const u32x2*)(ocp + d0);
                    const float v0 = oc[dt][4 * g4 + 0] + bflo(c.x), v1 = oc[dt][4 * g4 + 1] + bfhi(c.x), v2 = oc[dt][4 * g4 + 2] + bflo(c.y), v3 = oc[dt][4 * g4 + 3] + bfhi(c.y);
                    ss += (v0 * v0 + v1 * v1) + (v2 * v2 + v3 * v3);
                    u32x2 w; w.x = pk2(v0, v1); w.y = pk2(v2, v3); *(u32x2*)(mix + d0) = w; }
            ss += __shfl_xor(ss, 32);
            if (hh == 0) atomicAdd((float*)(ws + WS_ROWSS) + tok, ss);
        }
    }
}

DEV int swz256(int row, int chunk) { return row * 256 + ((chunk ^ (row & 15)) << 4); }
DEV void hgrn_cumsum(const Params& p, int bh, int c, float* segs, f32x2 (&lf)[8], f32x2 (&a)[8], f32x2& r, f32x2& alast) {
    const int tid = threadIdx.x, k2 = tid & 63, tq = tid >> 6;
    const int b = bh >> 2, h = bh & 3;
    const float* HL = (const float*)(p.ws + WS_HLOGF) + ((size_t)b * SEQ + c * 64 + tq * 8) * 512 + h * 128 + 2 * k2;
#pragma unroll
    for (int i = 0; i < 8; ++i) lf[i] = *(const f32x2*)(HL + (size_t)i * 512);
    f32x2 run = (f32x2){0.f, 0.f};
#pragma unroll
    for (int i = 0; i < 8; ++i) { run = run + lf[i]; a[i] = run; }
    *(f32x2*)(segs + tq * 128 + 2 * k2) = run;
    __syncthreads();
    f32x2 off = (f32x2){0.f, 0.f}, tot = off, rr = off;
#pragma unroll
    for (int q = 0; q < 8; ++q) { const f32x2 s = *(const f32x2*)(segs + q * 128 + 2 * k2); if (q < tq) off = off + s; if (q < 4) rr = rr + s; tot = tot + s; }
#pragma unroll
    for (int i = 0; i < 8; ++i) a[i] = a[i] + off;
    r = rr; alast = tot;
}
DEV void hgrn_stage_vt(const Params& p, int bh, int c, unsigned char* vt) {
    const int tid = threadIdx.x, k2 = tid & 63, tq = tid >> 6;
    const int b = bh >> 2, h = bh & 3;
    const bf16_t* HV = (const bf16_t*)(p.ws + WS_HV) + ((size_t)b * SEQ + c * 64 + tq * 8) * 512 + h * 128 + 2 * k2;
    unsigned vv[8];
#pragma unroll
    for (int i = 0; i < 8; ++i) vv[i] = *(const unsigned*)(HV + (size_t)i * 512);
    u32x4 lo, hi;
    lo.x = (vv[0] & 0xffffu) | (vv[1] << 16); lo.y = (vv[2] & 0xffffu) | (vv[3] << 16); lo.z = (vv[4] & 0xffffu) | (vv[5] << 16); lo.w = (vv[6] & 0xffffu) | (vv[7] << 16);
    hi.x = (vv[0] >> 16) | (vv[1] & 0xffff0000u); hi.y = (vv[2] >> 16) | (vv[3] & 0xffff0000u); hi.z = (vv[4] >> 16) | (vv[5] & 0xffff0000u); hi.w = (vv[6] >> 16) | (vv[7] & 0xffff0000u);
    *(u32x4*)(vt + swz(2 * k2, tq)) = lo; *(u32x4*)(vt + swz(2 * k2 + 1, tq)) = hi;
}
constexpr int H1_KT = 0, H1_VT = 16384, H1_SEG = 32768, H1_EK = H1_SEG + 4096;
DEV void phase_hgrn_a1(const Params& p, unsigned char* lds, int vb0, int nb) {
    const int tid = threadIdx.x, lane = tid & 63, wid = tid >> 6, k2 = tid & 63, tq = tid >> 6;
    const int vb = vblock(), G = gridDim.x;
    const int frow = lane & 15, fq = lane >> 4, wr = wid >> 1, wc = wid & 1;
    float* segs = (float*)(lds + H1_SEG); float* ek = (float*)(lds + H1_EK);
    bf16_t* ubuf = (bf16_t*)(p.ws + WS_UBUF); float* dbuf = (float*)(p.ws + WS_DBUF);
    if (vb < vb0) return;
    for (int item = vb - vb0; item < 2048; item += nb) {
        const int bh = item >> 6, c = item & 63;
        __syncthreads();
        f32x2 lf[8], a[8], r, al;
        hgrn_cumsum(p, bh, c, segs, lf, a, r, al);
        {
            float kx[8], ky[8];
#pragma unroll
            for (int i = 0; i < 8; ++i) { kx[i] = (1.f - __expf(lf[i].x)) * __expf(fminf(r.x - a[i].x, 80.f)); ky[i] = (1.f - __expf(lf[i].y)) * __expf(fminf(r.y - a[i].y, 80.f)); }
            u32x4 w0, w1;
            w0.x = pk2(kx[0], kx[1]); w0.y = pk2(kx[2], kx[3]); w0.z = pk2(kx[4], kx[5]); w0.w = pk2(kx[6], kx[7]);
            w1.x = pk2(ky[0], ky[1]); w1.y = pk2(ky[2], ky[3]); w1.z = pk2(ky[4], ky[5]); w1.w = pk2(ky[6], ky[7]);
            *(u32x4*)(lds + H1_KT + swz(2 * k2, tq)) = w0; *(u32x4*)(lds + H1_KT + swz(2 * k2 + 1, tq)) = w1;
        }
        hgrn_stage_vt(p, bh, c, lds + H1_VT);
        if (tq == 7) { ek[2 * k2] = __expf(al.x - r.x); ek[2 * k2 + 1] = __expf(al.y - r.y); f32x2 d; d.x = __expf(al.x); d.y = __expf(al.y); *(f32x2*)(dbuf + (size_t)item * 128 + 2 * k2) = d; }
        __syncthreads();
        f32x4 acc[2][4];
#pragma unroll
        for (int m = 0; m < 2; ++m)
#pragma unroll
            for (int n = 0; n < 4; ++n) acc[m][n] = (f32x4){0.f, 0.f, 0.f, 0.f};
        const int sx = (frow >> 1) & 7;
#pragma unroll
        for (int ks = 0; ks < 2; ++ks) {
            const int co = ((ks * 4 + fq) ^ sx) << 4;
            bf16x8 af[2], bfr[4];
#pragma unroll
            for (int m = 0; m < 2; ++m) af[m] = *(const bf16x8*)(lds + H1_VT + (32 * wr + 16 * m + frow) * 128 + co);
#pragma unroll
            for (int n = 0; n < 4; ++n) bfr[n] = *(const bf16x8*)(lds + H1_KT + (64 * wc + 16 * n + frow) * 128 + co);
#pragma unroll
            for (int m = 0; m < 2; ++m)
#pragma unroll
                for (int n = 0; n < 4; ++n) acc[m][n] = __builtin_amdgcn_mfma_f32_16x16x32_bf16(bfr[n], af[m], acc[m][n], 0, 0, 0);
        }
#pragma unroll
        for (int m = 0; m < 2; ++m) { const int v = 32 * wr + 16 * m + frow;
#pragma unroll
            for (int n = 0; n < 4; ++n) { const int k0 = 64 * wc + 16 * n + 4 * fq; const f32x4 e = *(const f32x4*)(ek + k0); const f32x4 o = acc[m][n] * e;
                u32x2 w; w.x = pk2(o.x, o.y); w.y = pk2(o.z, o.w); *(u32x2*)(ubuf + ((size_t)item * 128 + v) * 128 + k0) = w; } }
    }
}
DEV void phase_hgrn_a2(const Params& p, unsigned char* lds) {
    const int G = gridDim.x;
    bf16_t* ubuf = (bf16_t*)(p.ws + WS_UBUF); const float* dbuf = (const float*)(p.ws + WS_DBUF);
    for (int gid = blockIdx.x * NT + threadIdx.x; gid < 131072; gid += G * NT) {
        const int bh = gid >> 12, v = (gid >> 5) & 127, k4 = gid & 31;
        bf16_t* u = ubuf + ((size_t)bh * 64 * 128 + v) * 128 + 4 * k4;
        const float* d = dbuf + (size_t)bh * 64 * 128 + 4 * k4;
        f32x4 S = (f32x4){0.f, 0.f, 0.f, 0.f};
        for (int c0 = 0; c0 < 64; c0 += 8) {
            u32x2 uu[8]; f32x4 dd[8];
#pragma unroll
            for (int j = 0; j < 8; ++j) { uu[j] = *(const u32x2*)(u + (size_t)(c0 + j) * 16384); dd[j] = *(const f32x4*)(d + (size_t)(c0 + j) * 128); }
#pragma unroll
            for (int j = 0; j < 8; ++j) { u32x2 w; w.x = pk2(S.x, S.y); w.y = pk2(S.z, S.w); *(u32x2*)(u + (size_t)(c0 + j) * 16384) = w;
                S.x = dd[j].x * S.x + bflo(uu[j].x); S.y = dd[j].y * S.y + bfhi(uu[j].x); S.z = dd[j].z * S.z + bflo(uu[j].y); S.w = dd[j].w * S.w + bfhi(uu[j].y); }
        }
    }
}
constexpr int H3_QH = 0, H3_QA = 16384, H3_KH = 32768, H3_VT = 49152, H3_PP = 65536, H3_ST = 73728, H3_SEG = 106496, H3_RED = 110592;
DEV void phase_hgrn_a3(const Params& p, unsigned char* lds) {
    const int tid = threadIdx.x, lane = tid & 63, wid = tid >> 6, k2 = tid & 63, tq = tid >> 6;
    const int vb = vblock(), G = gridDim.x;
    const int frow = lane & 15, fq = lane >> 4;
    float* segs = (float*)(lds + H3_SEG); float* red = (float*)(lds + H3_RED);
    const bf16_t* ubuf = (const bf16_t*)(p.ws + WS_UBUF);
    for (int item = vb; item < 2048; item += G) {
        const int bh = item >> 6, c = item & 63, b = bh >> 2, h = bh & 3;
        __syncthreads();
        f32x2 lf[8], a[8], r, al;
        hgrn_cumsum(p, bh, c, segs, lf, a, r, al);
        {
            const bf16_t* HQ = (const bf16_t*)(p.ws + WS_HQ) + ((size_t)b * SEQ + c * 64 + tq * 8) * 512 + h * 128 + 2 * k2;
            unsigned qq[8];
#pragma unroll
            for (int i = 0; i < 8; ++i) qq[i] = *(const unsigned*)(HQ + (size_t)i * 512);
#pragma unroll
            for (int i = 0; i < 8; ++i) { const int t = 8 * tq + i; const float q0 = bflo(qq[i]), q1 = bfhi(qq[i]);
                const int off = swz256(t, k2 >> 2) + (k2 & 3) * 4;
                *(unsigned*)(lds + H3_QH + off) = pk2(q0 * __expf(fminf(a[i].x - r.x, 80.f)), q1 * __expf(fminf(a[i].y - r.y, 80.f)));
                *(unsigned*)(lds + H3_QA + off) = pk2(q0 * __expf(a[i].x), q1 * __expf(a[i].y));
                *(unsigned*)(lds + H3_KH + off) = pk2((1.f - __expf(lf[i].x)) * __expf(fminf(r.x - a[i].x, 80.f)), (1.f - __expf(lf[i].y)) * __expf(fminf(r.y - a[i].y, 80.f))); }
        }
        hgrn_stage_vt(p, bh, c, lds + H3_VT);
        {
            const bf16_t* st = ubuf + (size_t)item * 16384;
#pragma unroll
            for (int i = 0; i < 4; ++i) { const int q = tid + NT * i, v = q >> 4, ch = q & 15; *(u32x4*)(lds + H3_ST + swz256(v, ch)) = *(const u32x4*)(st + v * 128 + ch * 8); }
        }
        __syncthreads();
        {
            const int wr = wid >> 1, wc = wid & 1;
            f32x4 acc[2];
            acc[0] = (f32x4){0.f, 0.f, 0.f, 0.f}; acc[1] = acc[0];
            if (32 * wc <= 16 * wr + 15) {
#pragma unroll
                for (int ks = 0; ks < 4; ++ks) {
                    const int co = ((ks * 4 + fq) ^ frow) << 4;
                    const bf16x8 af = *(const bf16x8*)(lds + H3_QH + (16 * wr + frow) * 256 + co);
#pragma unroll
                    for (int n = 0; n < 2; ++n) { const bf16x8 bfr = *(const bf16x8*)(lds + H3_KH + (32 * wc + 16 * n + frow) * 256 + co);
                        acc[n] = __builtin_amdgcn_mfma_f32_16x16x32_bf16(bfr, af, acc[n], 0, 0, 0); }
                }
            }
            const int t = 16 * wr + frow;
#pragma unroll
            for (int n = 0; n < 2; ++n) { const int s0 = 32 * wc + 16 * n + 4 * fq; f32x4 v = acc[n];
                v.x = (s0 + 0 <= t) ? v.x : 0.f; v.y = (s0 + 1 <= t) ? v.y : 0.f; v.z = (s0 + 2 <= t) ? v.z : 0.f; v.w = (s0 + 3 <= t) ? v.w : 0.f;
                u32x2 w; w.x = pk2(v.x, v.y); w.y = pk2(v.z, v.w);
                *(u32x2*)(lds + H3_PP + t * 128 + ((((s0 >> 3)) ^ ((t >> 1) & 7)) << 4) + (s0 & 7) * 2) = w; }
        }
        __syncthreads();
        {
            const int wr = wid >> 2, wc = wid & 3;
            f32x4 acc[2][2];
#pragma unroll
            for (int m = 0; m < 2; ++m)
#pragma unroll
                for (int n = 0; n < 2; ++n) acc[m][n] = (f32x4){0.f, 0.f, 0.f, 0.f};
            const int sx = (frow >> 1) & 7;
#pragma unroll
            for (int ks = 0; ks < 2; ++ks) {
                const int co = ((ks * 4 + fq) ^ sx) << 4;
                bf16x8 af[2], bfr[2];
#pragma unroll
                for (int m = 0; m < 2; ++m) af[m] = *(const bf16x8*)(lds + H3_PP + (32 * wr + 16 * m + frow) * 128 + co);
#pragma unroll
                for (int n = 0; n < 2; ++n) bfr[n] = *(const bf16x8*)(lds + H3_VT + (32 * wc + 16 * n + frow) * 128 + co);
#pragma unroll
                for (int m = 0; m < 2; ++m)
#pragma unroll
                    for (int n = 0; n < 2; ++n) acc[m][n] = __builtin_amdgcn_mfma_f32_16x16x32_bf16(bfr[n], af[m], acc[m][n], 0, 0, 0);
            }
#pragma unroll
            for (int ks = 0; ks < 4; ++ks) {
                const int co = ((ks * 4 + fq) ^ frow) << 4;
                bf16x8 af[2], bfr[2];
#pragma unroll
                for (int m = 0; m < 2; ++m) af[m] = *(const bf16x8*)(lds + H3_QA + (32 * wr + 16 * m + frow) * 256 + co);
#pragma unroll
                for (int n = 0; n < 2; ++n) bfr[n] = *(const bf16x8*)(lds + H3_ST + (32 * wc + 16 * n + frow) * 256 + co);
#pragma unroll
                for (int m = 0; m < 2; ++m)
#pragma unroll
                    for (int n = 0; n < 2; ++n) acc[m][n] = __builtin_amdgcn_mfma_f32_16x16x32_bf16(bfr[n], af[m], acc[m][n], 0, 0, 0);
            }
#pragma unroll
            for (int m = 0; m < 2; ++m) { float ss = 0.f;
#pragma unroll
                for (int n = 0; n < 2; ++n) { const f32x4 v = acc[m][n]; ss += (v.x * v.x + v.y * v.y) + (v.z * v.z + v.w * v.w); }
                ss += __shfl_xor(ss, 16); ss += __shfl_xor(ss, 32);
                if (fq == 0) red[(32 * wr + 16 * m + frow) * 4 + wc] = ss; }
            __syncthreads();
#pragma unroll
            for (int m = 0; m < 2; ++m) { const int t = 32 * wr + 16 * m + frow; const f32x4 q4 = *(const f32x4*)(red + t * 4);
                const float rs = rsqrtf(((q4.x + q4.y) + (q4.z + q4.w)) * (1.f / 128.f) + RMS_EPS);
                const size_t row = (size_t)b * SEQ + c * 64 + t;
#pragma unroll
                for (int n = 0; n < 2; ++n) { const int v0 = 32 * wc + 16 * n + 4 * fq; const f32x4 gn = *(const f32x4*)(p.g_hn + v0);
                    const u32x2 gg = *(const u32x2*)((const bf16_t*)(p.ws + WS_HG) + row * 512 + h * 128 + v0);
                    const f32x4 o = acc[m][n];
                    u32x2 w; w.x = pk2(o.x * rs * gn.x * bflo(gg.x), o.y * rs * gn.y * bfhi(gg.x)); w.y = pk2(o.z * rs * gn.z * bflo(gg.y), o.w * rs * gn.w * bfhi(gg.y));
                    *(u32x2*)((bf16_t*)(p.ws + WS_R1) + row * 1024 + 512 + h * 128 + v0) = w; } }
        }
    }
}

DEV void phase_normalize(const Params& p, unsigned char* lds) {
    const int vb = vblock(), G = gridDim.x;
    unsigned char* ws = p.ws;
    __syncthreads();
    {
        float* tl = (float*)lds;
        for (int r = vb; r < 32 * 4 * 16; r += G) { const int e = r / 64, q = r % 64; SrcW13_4 s{p.w1 + (size_t)e * 1024 * 512, p.w3 + (size_t)e * 1024 * 512, p.ffn_g};
            convert_tile256(tl, s, (bf16_t*)(ws + WS_W13T) + (size_t)e * 1024 * 1024, 1024, (q / 16) * 256, (q % 16) * 64); }
    }
}

struct EpiOut8 { const Params& p; static constexpr bool MIDSCALE = true;
    DEV float rowscale(int row) const { return rsqrtf(((const float*)(p.ws + WS_ROWSS))[row] * (1.f / 512.f) + RMS_EPS); }
    DEV int midk() const { return 8; }
    DEV void operator()(const f32x4 (&acc)[2][2][4][2], const pg8::Unit& u, int wr, int wc, int fr, int fq) const {
#pragma unroll
        for (int ai = 0; ai < 2; ++ai)
#pragma unroll
            for (int m = 0; m < 4; ++m) { const size_t row = (size_t)u.pm * 256 + ai * 128 + wr * 64 + m * 16 + fr;
#pragma unroll
                for (int bj = 0; bj < 2; ++bj)
#pragma unroll
                    for (int n = 0; n < 2; ++n) { const int c = u.pn * 256 + 64 * wc + 32 * bj + 8 * fq + 4 * n; const f32x4 xv = *(const f32x4*)(p.x + row * DM + c); *(f32x4*)(p.out + row * DM + c) = xv + acc[ai][bj][m][n]; } }
    } };
DEV void phase_outproj(const Params& p, unsigned char* lds) {
    pg8::Gemm g{(const bf16_t*)(p.ws + WS_R1), (const bf16_t*)(p.ws + WS_WOUTT), NTOK, DM, DM};
    pg8::StaticOrder S; S.init(NTOK, DM, (int)gridDim.x, (int)blockIdx.x);
    EpiOut8 E{p};
    pg8::gemm_phase((PG8_LAS unsigned char*)lds, g, S, E);
}

constexpr int RT_W = 0, RT_LG = 49152, RT_RS = RT_LG + 128 * 49 * 4, RT_HIST = RT_RS + 512, RT_BASE = RT_HIST + 1024, RT_LDS = RT_BASE + 1024;
DEV void phase_router(const Params& p, unsigned char* lds) {
    const int tid = threadIdx.x, lane = tid & 63, wid = tid >> 6, frow = lane & 15, fq = lane >> 4;
    const int vb = vblock(), G = gridDim.x;
    unsigned char* ws = p.ws;
    float* lg = (float*)(lds + RT_LG); float* rsd = (float*)(lds + RT_RS);
    int* hist = (int*)(lds + RT_HIST); int* basep = (int*)(lds + RT_BASE);
    const bf16_t* rw = (const bf16_t*)(ws + WS_RW);
    for (int it = vb; it < NTOK / 128; it += G) {
        const size_t row0 = (size_t)it * 128;
        const size_t trow = row0 + 16 * wid + frow;
        const float* hrow = p.out + trow * DM + 8 * fq;
        bf16_t* hbrow = (bf16_t*)(ws + WS_R1) + trow * DM + 8 * fq;
        f32x4 acc[3]; float ss = 0.f;
#pragma unroll
        for (int nt = 0; nt < 3; ++nt) acc[nt] = (f32x4){0.f, 0.f, 0.f, 0.f};
        if (tid < 128) hist[tid] = 0;
        for (int kc = 0; kc < 4; ++kc) {
            __syncthreads();
#pragma unroll
            for (int i = 0; i < 6; ++i) { const int idx = tid + NT * i, r = idx >> 5, c = idx & 31;
                *(u32x4*)(lds + RT_W + r * 512 + ((c ^ (r & 15)) << 4)) = *(const u32x4*)(rw + (size_t)r * 1024 + kc * 256 + c * 8); }
            f32x4 xa[8][2];
#pragma unroll
            for (int ks = 0; ks < 8; ++ks) { xa[ks][0] = *(const f32x4*)(hrow + kc * 256 + 32 * ks); xa[ks][1] = *(const f32x4*)(hrow + kc * 256 + 32 * ks + 4); }
            __syncthreads();
#pragma unroll
            for (int ks = 0; ks < 8; ++ks) {
                const f32x4 a = xa[ks][0], b = xa[ks][1];
                ss += ((a.x * a.x + a.y * a.y) + (a.z * a.z + a.w * a.w)) + ((b.x * b.x + b.y * b.y) + (b.z * b.z + b.w * b.w));
                u32x4 hi; hi.x = pk2(a.x, a.y); hi.y = pk2(a.z, a.w); hi.z = pk2(b.x, b.y); hi.w = pk2(b.z, b.w);
                u32x4 lo; lo.x = pk2(a.x - bflo(hi.x), a.y - bfhi(hi.x)); lo.y = pk2(a.z - bflo(hi.y), a.w - bfhi(hi.y)); lo.z = pk2(b.x - bflo(hi.z), b.y - bfhi(hi.z)); lo.w = pk2(b.z - bflo(hi.w), b.w - bfhi(hi.w));
                *(u32x4*)(hbrow + kc * 256 + 32 * ks) = hi;
                const bf16x8 hh = __builtin_bit_cast(bf16x8, hi), hl = __builtin_bit_cast(bf16x8, lo);
                const int co = ((4 * ks + fq) ^ frow) << 4;
#pragma unroll
                for (int nt = 0; nt < 3; ++nt) {
                    const bf16x8 whi = *(const bf16x8*)(lds + RT_W + (16 * nt + frow) * 512 + co), wlo = *(const bf16x8*)(lds + RT_W + (48 + 16 * nt + frow) * 512 + co);
                    acc[nt] = __builtin_amdgcn_mfma_f32_16x16x32_bf16(whi, hh, acc[nt], 0, 0, 0);
                    acc[nt] = __builtin_amdgcn_mfma_f32_16x16x32_bf16(wlo, hh, acc[nt], 0, 0, 0);
                    acc[nt] = __builtin_amdgcn_mfma_f32_16x16x32_bf16(whi, hl, acc[nt], 0, 0, 0);
                }
            }
        }
        ss += __shfl_xor(ss, 16); ss += __shfl_xor(ss, 32);
        if (fq == 0) rsd[16 * wid + frow] = rsqrtf(ss * (1.f / DM) + RMS_EPS);
#pragma unroll
        for (int nt = 0; nt < 3; ++nt) { float* o = lg + (16 * wid + frow) * 49 + 16 * nt + 4 * fq; o[0] = acc[nt].x; o[1] = acc[nt].y; o[2] = acc[nt].z; o[3] = acc[nt].w; }
        __syncthreads();
        int bin = 0, slot = 0, ea = 0, eb = 0, sa = 0, sb = 0; float wa = 0.f, wb = 0.f;
        int* ehist = hist + 112; int* ebase = basep + 112;
        if (tid < 32) ehist[tid] = 0;
        __syncthreads();
        if (tid < 128) {
            const float rs = rsd[tid];
            ((float*)(ws + WS_RSTD2))[row0 + tid] = rs;
            float gl[4]; int gi = 0; float gm = -1e30f;
#pragma unroll
            for (int c = 0; c < 4; ++c) { gl[c] = lg[tid * 49 + c] * rs + p.b_group[c]; if (gl[c] > gm) { gm = gl[c]; gi = c; } }
            float gs = 0.f;
#pragma unroll
            for (int c = 0; c < 4; ++c) gs += __expf(gl[c] - gm);
            const float pg = 1.f / gs;
            float el[8]; int i0 = 0; float m0 = -1e30f;
#pragma unroll
            for (int c = 0; c < 8; ++c) { el[c] = lg[tid * 49 + 4 + gi * 8 + c] * rs + p.b_expert[gi * 8 + c]; if (el[c] > m0) { m0 = el[c]; i0 = c; } }
            int i1 = 0; float m1 = -1e30f;
#pragma unroll
            for (int c = 0; c < 8; ++c) if (c != i0 && el[c] > m1) { m1 = el[c]; i1 = c; }
            const float e1 = __expf(m1 - m0); const float w0 = pg / (1.f + e1), w1 = pg * e1 / (1.f + e1);
            const int a = min(i0, i1), bb = max(i0, i1);
            bin = gi * 28 + (7 * a - (a * (a - 1)) / 2) + (bb - a - 1);
            wa = (i0 < i1) ? w0 : w1; wb = (i0 < i1) ? w1 : w0; ea = gi * 8 + a; eb = gi * 8 + bb;
            slot = atomicAdd(&hist[bin], 1);
            sa = atomicAdd(&ehist[ea], 1); sb = atomicAdd(&ehist[eb], 1);
        }
        __syncthreads();
        if (tid < NBIN) { const int h = hist[tid]; basep[tid] = h ? atomicAdd((int*)(ws + WS_CTL) + tid, h) : 0; }
        else if (tid >= 128 && tid < 160) { const int e = tid - 128; const int h = ehist[e]; ebase[e] = h ? atomicAdd((int*)(ws + WS_CTL + 512) + e, h) : 0; }
        __syncthreads();
        if (tid < 128) {
            const int t = (int)(row0 + tid);
            ((int*)(ws + WS_BINL))[(size_t)bin * BINCAP + basep[bin] + slot] = t;
            sa += ebase[ea]; sb += ebase[eb];
            ((int*)(ws + WS_EL))[(size_t)ea * BINCAP + sa] = t; ((float*)(ws + WS_EW))[(size_t)ea * BINCAP + sa] = wa;
            ((int*)(ws + WS_EL))[(size_t)eb * BINCAP + sb] = t; ((float*)(ws + WS_EW))[(size_t)eb * BINCAP + sb] = wb;
            { const unsigned dpos = (unsigned)bin | ((unsigned)(basep[bin] + slot) << 7); ((unsigned*)(ws + WS_EDST))[(size_t)ea * BINCAP + sa] = dpos; ((unsigned*)(ws + WS_EDST))[(size_t)eb * BINCAP + sb] = dpos | (1u << 22); }
        }
        __syncthreads();
    }
}

constexpr int MOE_TS = pg8::STAGE_BYTES, MOE_TT = MOE_TS + 512, MOE_ES = MOE_TT + 1024, MOE_ET = MOE_ES + 256;
DEV void moe_tiles(const Params& p, unsigned char* lds) {
    int* tstart = (int*)(lds + MOE_TS); int* tiletab = (int*)(lds + MOE_TT); int* etstart = (int*)(lds + MOE_ES); int* etiletab = (int*)(lds + MOE_ET);
    const int tid = threadIdx.x;
    __syncthreads();
    if (tid == 0) { const int* cnt = (const int*)(p.ws + WS_CTL); int s = 0; for (int i = 0; i < NBIN; ++i) { tstart[i] = s; s += (cnt[i] + 255) >> 8; } tstart[NBIN] = s; }
    if (tid == 64) { const int* cnt = (const int*)(p.ws + WS_CTL + 512); int s = 0; for (int i = 0; i < 32; ++i) { etstart[i] = s; s += (cnt[i] + 255) >> 8; } etstart[32] = s; }
    __syncthreads();
    if (tid < NBIN) for (int t = tstart[tid]; t < tstart[tid + 1]; ++t) tiletab[t] = tid;
    if (tid >= 128 && tid < 160) for (int t = etstart[tid - 128]; t < etstart[tid - 127]; ++t) etiletab[t] = tid - 128;
    __syncthreads();
}
DEV void bin_experts(int bin, int& ea, int& eb) { const int gi = bin / 28; int pi = bin % 28, a = 0; while (pi >= 7 - a) { pi -= 7 - a; ++a; } ea = gi * 8 + a; eb = gi * 8 + a + 1 + pi; }
DEV void lane_rc(int i, int& R, int& C) { pg8::stage_rc((int)threadIdx.x * 16, R, C); R += 64 * i; }
struct MoeUnit { int tile, nt, bin, mt, n; };
struct PolMoe1 {
    typedef MoeUnit Unit;
    const Params& p; const int* etstart; const int* etiletab; int U, G, c;
    struct AddrA { unsigned off[2][2]; };
    struct AddrB { const char* base; };
    DEV int nk() const { return 16; }
    DEV bool next(int i, MoeUnit& u) const {
        const int L = i * G + c; if (L >= U) return false;
        u.tile = L >> 2; u.nt = L & 3;
        u.bin = __builtin_amdgcn_readfirstlane(etiletab[u.tile]);
        u.mt = u.tile - __builtin_amdgcn_readfirstlane(etstart[u.bin]);
        u.n = min(256, ((const int*)(p.ws + WS_CTL + 512))[u.bin] - u.mt * 256);
        return true;
    }
    DEV bool full(const MoeUnit& u) const { return u.n > 128; }
    DEV void addrA(const MoeUnit& u, AddrA& a) const {
        const int* list = (const int*)(p.ws + WS_EL) + (size_t)u.bin * BINCAP + u.mt * 256;
#pragma unroll
        for (int i = 0; i < 2; ++i) { int R, C; lane_rc(i, R, C);
#pragma unroll
            for (int h = 0; h < 2; ++h) { int r = h * 128 + R; if (r >= u.n) r = 0; a.off[h][i] = (unsigned)list[r] * 2048u + (unsigned)C * 2u; } }
    }
    DEV void addrB(const MoeUnit& u, AddrB& b) const { b.base = (const char*)(p.ws + WS_W13T) + ((size_t)u.bin * 1024 + u.nt * 256) * 2048; }
    DEV const char* pa(const AddrA& a, int h, int i, int kt) const { return (const char*)(p.ws + WS_R1) + a.off[h][i] + kt * 128; }
    DEV const char* pb(const AddrB& b, int h, int i, int kt) const { int R, C; lane_rc(i, R, C); return b.base + (size_t)h * (128 * 2048) + (unsigned)(R * 1024 + C) * 2u + kt * 128; }
};
struct EpiMoe1 { const Params& p; const int* tstart;
    DEV void operator()(const f32x4 (&acc)[2][2][4][2], const MoeUnit& u, int wr, int wc, int fr, int fq) const {
        const int* list = (const int*)(p.ws + WS_EL) + (size_t)u.bin * BINCAP + u.mt * 256;
        const float* wl = (const float*)(p.ws + WS_EW) + (size_t)u.bin * BINCAP + u.mt * 256;
        const unsigned* dl = (const unsigned*)(p.ws + WS_EDST) + (size_t)u.bin * BINCAP + u.mt * 256;
#pragma unroll
        for (int ai = 0; ai < 2; ++ai)
#pragma unroll
            for (int m = 0; m < 4; ++m) { const int r = ai * 128 + wr * 64 + m * 16 + fr; if (r >= u.n) continue;
                const float rs = ((const float*)(p.ws + WS_RSTD2))[list[r]]; const float w = wl[r]; const unsigned d = dl[r];
                bf16_t* hrow = (bf16_t*)(p.ws + WS_HBUF) + ((size_t)tstart[d & 127u] * 256 + ((d >> 7) & 32767u)) * 1024 + ((d >> 22) & 1u) * 512;
#pragma unroll
                for (int bj = 0; bj < 2; ++bj) { const f32x4 v0 = acc[ai][bj][m][0] * rs, v1 = acc[ai][bj][m][1] * rs; const int f = (u.nt * 256 + 128 * bj + 32 * wc + 8 * fq) >> 1;
                    u32x2 w2; w2.x = pk2(siluf_(v0.x) * v0.y * w, siluf_(v0.z) * v0.w * w); w2.y = pk2(siluf_(v1.x) * v1.y * w, siluf_(v1.z) * v1.w * w); *(u32x2*)(hrow + f) = w2; } }
    } };
DEV void phase_moe1(const Params& p, unsigned char* lds) {
    moe_tiles(p, lds);
    const int* etstart = (const int*)(lds + MOE_ES);
    PolMoe1 P{p, etstart, (const int*)(lds + MOE_ET), etstart[32] * 4, (int)gridDim.x, vblock()};
    EpiMoe1 E{p, (const int*)(lds + MOE_TS)};
    pg8::gemm_phase2(( PG8_LAS unsigned char*)lds, P, E);
}
struct PolMoe2 {
    typedef MoeUnit Unit;
    const Params& p; const int* tstart; const int* tiletab; int U, G, c;
    struct AddrA { const char* base; };
    struct AddrB { const char* ba; const char* bb; };
    DEV int nk() const { return 16; }
    DEV bool next(int i, MoeUnit& u) const {
        const int L = i * G + c; if (L >= U) return false;
        u.tile = L >> 2; u.nt = L & 3;
        u.bin = __builtin_amdgcn_readfirstlane(tiletab[u.tile]);
        u.mt = u.tile - __builtin_amdgcn_readfirstlane(tstart[u.bin]);
        u.n = min(256, ((const int*)(p.ws + WS_CTL))[u.bin] - u.mt * 256);
        return true;
    }
    DEV bool full(const MoeUnit& u) const { return u.n > 128; }
    DEV void addrA(const MoeUnit& u, AddrA& a) const { a.base = (const char*)(p.ws + WS_HBUF) + (size_t)u.tile * 256 * 2048; }
    DEV void addrB(const MoeUnit& u, AddrB& b) const {
        int ea, eb; bin_experts(u.bin, ea, eb);
        b.ba = (const char*)(p.ws + WS_W2T) + ((size_t)ea * 1024 + u.nt * 256) * 1024; b.bb = (const char*)(p.ws + WS_W2T) + ((size_t)eb * 1024 + u.nt * 256) * 1024;
    }
    DEV const char* pa(const AddrA& a, int h, int i, int kt) const { int R, C; lane_rc(i, R, C); return a.base + (size_t)h * (128 * 2048) + (unsigned)(R * 1024 + C) * 2u + kt * 128; }
    DEV const char* pb(const AddrB& b, int h, int i, int kt) const { int R, C; lane_rc(i, R, C); return (kt < 8 ? b.ba + kt * 128 : b.bb + (kt - 8) * 128) + (size_t)h * (128 * 1024) + (unsigned)(R * 512 + C) * 2u; }
};
struct EpiMoe2 { const Params& p;
    DEV void operator()(const f32x4 (&acc)[2][2][4][2], const MoeUnit& u, int wr, int wc, int fr, int fq) const {
        const int* list = (const int*)(p.ws + WS_BINL) + (size_t)u.bin * BINCAP + u.mt * 256;
#pragma unroll
        for (int ai = 0; ai < 2; ++ai)
#pragma unroll
            for (int m = 0; m < 4; ++m) { const int r = ai * 128 + wr * 64 + m * 16 + fr; if (r >= u.n) continue; const size_t t = list[r];
#pragma unroll
                for (int bj = 0; bj < 2; ++bj)
#pragma unroll
                    for (int n = 0; n < 2; ++n) { float* o = p.out + t * DM + u.nt * 256 + 128 * bj + 32 * wc + 16 * n + 4 * fq; *(f32x4*)o = *(const f32x4*)o + acc[ai][bj][m][n]; } }
    } };
DEV void phase_moe2(const Params& p, unsigned char* lds) {
    moe_tiles(p, lds);
    const int* tstart = (const int*)(lds + MOE_TS);
    PolMoe2 P{p, tstart, (const int*)(lds + MOE_TT), tstart[NBIN] * 4, (int)gridDim.x, vblock()};
    EpiMoe2 E{p};
    pg8::gemm_phase2((PG8_LAS unsigned char*)lds, P, E);
}

#define XB_TMO      128
#define XB_XCNT(j)  (256  + 64 * (j))
#define XB_XSUB(j)  (1280 + 64 * (j))
#define XB_XGEN(j)  (2304 + 64 * (j))
#define XB_TOP      3328
#define XB_TOPGEN   3392
#define XCD_BAR_WORDS 3456
#define XB_SPIN_CAP (1u << 20)
#define LAS __attribute__((address_space(3)))
constexpr size_t WS_BAR = WS_CTL + 4096;
DEV unsigned xb_ld(unsigned* p) { return __hip_atomic_load(p, __ATOMIC_RELAXED, __HIP_MEMORY_SCOPE_AGENT); }
DEV unsigned xb_add(unsigned* p, unsigned v) { return __hip_atomic_fetch_add(p, v, __ATOMIC_RELAXED, __HIP_MEMORY_SCOPE_AGENT); }
DEV unsigned xb_xcc_id() { return (unsigned)__builtin_amdgcn_s_getreg((3 << 11) | 20) & 0xFu; }
#define XB_SPIN(cond, bar) do { unsigned _sp = 0; while (cond) { __builtin_amdgcn_s_sleep(1); \
    if ((++_sp & 255u) == 0u) { if (xb_ld(&(bar)[XB_TMO])) break; if (_sp > XB_SPIN_CAP) { atomicAdd(&(bar)[XB_TMO], 1u); break; } } } } while (0)
struct XcdBarrier { unsigned* bar; unsigned x; volatile LAS unsigned* st; };
DEV XcdBarrier xcd_barrier_post(unsigned* bar, volatile LAS unsigned* st) {
    XcdBarrier b; b.bar = bar; b.x = xb_xcc_id(); b.st = st;
    if (threadIdx.x == 0) (void)xb_add(&bar[XB_XCNT(b.x)], 1u);
    return b;
}
DEV void xcd_barrier_complete(unsigned* bar, unsigned x, unsigned& nloc, unsigned& nx) {
    const unsigned G = gridDim.x * gridDim.y * gridDim.z;
    unsigned sum, cnt, mine, sp = 0u;
    for (;;) {
        sum = 0u; cnt = 0u; mine = 0u;
#pragma unroll
        for (unsigned j = 0; j < 16; ++j) { const unsigned c = xb_ld(&bar[XB_XCNT(j)]); sum += c; cnt += (c > 0u) ? 1u : 0u; mine = (j == x) ? c : mine; }
        if (sum == G) break;
        __builtin_amdgcn_s_sleep(1);
        if ((++sp & 255u) == 0u) { if (xb_ld(&bar[XB_TMO])) break; if (sp > XB_SPIN_CAP) { atomicAdd(&bar[XB_TMO], 1u); break; } }
    }
    nloc = mine > 0u ? mine : 1u; nx = cnt > 0u ? cnt : 1u;
}
DEV void xcd_barrier(const XcdBarrier& b) {
    asm volatile("s_waitcnt vmcnt(0)" ::: "memory");
    __syncthreads();
    if (threadIdx.x == 0) {
        unsigned* bar = b.bar;
        __builtin_amdgcn_s_waitcnt(0);
        unsigned nloc = b.st[0], nx = b.st[1];
        if (nloc == 0u) { xcd_barrier_complete(bar, b.x, nloc, nx); b.st[0] = nloc; b.st[1] = nx; }
        const unsigned old = xb_add(&bar[XB_XSUB(b.x)], 1u);
        const unsigned gen = old / nloc;
        if (old + 1u == (gen + 1u) * nloc) {
            __builtin_amdgcn_fence(__ATOMIC_RELEASE, "agent");
            asm volatile("s_waitcnt vmcnt(0)" ::: "memory");
            const unsigned og = xb_add(&bar[XB_TOP], 1u);
            const unsigned tg = og / nx;
            if (og + 1u == (tg + 1u) * nx) xb_add(&bar[XB_TOPGEN], 1u);
            else XB_SPIN(xb_ld(&bar[XB_TOPGEN]) == tg, bar);
            __builtin_amdgcn_fence(__ATOMIC_ACQUIRE, "agent");
            xb_add(&bar[XB_XGEN(b.x)], 1u);
            asm volatile("s_waitcnt vmcnt(0)" ::: "memory");
        } else {
            XB_SPIN(xb_ld(&bar[XB_XGEN(b.x)]) == gen, bar);
            __builtin_amdgcn_fence(__ATOMIC_ACQUIRE, "agent");
            asm volatile("s_waitcnt vmcnt(0)" ::: "memory");
        }
    }
    __syncthreads();
}

constexpr int LDS_BYTES = 144 * 1024;
constexpr int N_PHASES = 10;
__global__ void __launch_bounds__(NT) mega(Params p, int lo, int hi) {
    extern __shared__ __attribute__((aligned(16))) unsigned char lds[];
    volatile LAS unsigned* xst = (volatile LAS unsigned*)(lds + LDS_BYTES - 16);
    if (threadIdx.x < 4) xst[threadIdx.x] = 0u;
    __syncthreads();
    XcdBarrier xbar; xbar.bar = (unsigned*)(p.ws + WS_BAR); xbar.x = 0; xbar.st = xst;
    if (hi - lo > 1) xbar = xcd_barrier_post((unsigned*)(p.ws + WS_BAR), xst);
#define GRID_SYNC() xcd_barrier(xbar)
#ifndef PROBE_REPEAT
#define PROBE_REPEAT -1
#endif
#define RUN_PHASE(k, call) do { if (lo <= (k) && (k) < hi) { call; \
        if ((k) == PROBE_REPEAT) { GRID_SYNC(); \
            if ((k) == 5) { float* rz = (float*)(p.ws + WS_ROWSS); for (int i = blockIdx.x * NT + threadIdx.x; i < NTOK; i += gridDim.x * NT) rz[i] = 0.f; GRID_SYNC(); } \
            if ((k) == 8) { if (blockIdx.x == 0 && threadIdx.x < 128) ((int*)(p.ws + WS_CTL))[threadIdx.x] = 0; GRID_SYNC(); } \
            call; } \
        if ((k) + 1 < hi) GRID_SYNC(); } } while (0)
    RUN_PHASE(0, phase_prologue(p, lds));
    RUN_PHASE(1, phase_inproj(p, lds));
    RUN_PHASE(2, { phase_cmp_a(p, lds); const int G_ = (int)gridDim.x; if (G_ > 128) phase_hgrn_a1(p, lds, 64, G_ - 64); else phase_hgrn_a1(p, lds, 0, G_); });
    RUN_PHASE(3, { phase_cmp_b(p, lds); phase_hgrn_a2(p, lds); });
    RUN_PHASE(4, { phase_cmp_attn(p, lds); phase_hgrn_a3(p, lds); });
    RUN_PHASE(5, phase_flash(p, lds));
    RUN_PHASE(6, phase_normalize(p, lds));
    RUN_PHASE(7, phase_outproj(p, lds));
    RUN_PHASE(8, phase_router(p, lds));
    RUN_PHASE(9, phase_moe1(p, lds));
    RUN_PHASE(10, phase_moe2(p, lds));
#undef RUN_PHASE
}

extern "C" void kernel_launch(void* const* d_in, const int* in_sizes, int n_in, void* d_out, int out_size, void* d_ws, size_t ws_size, hipStream_t stream) {
    static int grid = 0;
    if (grid == 0) {
        int dev = 0, cus = 0, per_cu = 0;
        hipGetDevice(&dev);
        hipDeviceGetAttribute(&cus, hipDeviceAttributeMultiprocessorCount, dev);
        hipFuncSetAttribute((const void*)mega, hipFuncAttributeMaxDynamicSharedMemorySize, LDS_BYTES);
        hipOccupancyMaxActiveBlocksPerMultiprocessor(&per_cu, (const void*)mega, NT, LDS_BYTES);
        if (per_cu < 1) per_cu = 1;
        grid = cus;
        if (ws_size < WS_END) fprintf(stderr, "kernel_launch: workspace too small: %zu < %zu\n", ws_size, (size_t)WS_END);
        fprintf(stderr, "kernel_launch: cus %d per_cu %d grid %d ws %zu\n", cus, per_cu, grid, ws_size);
    }
    Params p{};
    const float** pp = (const float**)&p;
    for (int i = 0; i < 23; ++i) pp[i] = (const float*)d_in[i];
    p.out = (float*)d_out; p.ws = (unsigned char*)d_ws;
#if N_LAUNCH_MODE == 1
    (void)hipMemsetAsync((unsigned char*)d_ws + WS_BAR, 0, XCD_BAR_WORDS * 4, stream);
    int lo = 0, hi = N_PHASES + 1;
    void* args[] = {&p, &lo, &hi};
    hipError_t e = hipLaunchCooperativeKernel((const void*)mega, dim3(grid), dim3(NT), args, LDS_BYTES, stream);
    if (e != hipSuccess) fprintf(stderr, "cooperative launch failed: %s\n", hipGetErrorString(e));
#else
    for (int ph = 0; ph <= N_PHASES; ++ph) hipLaunchKernelGGL(mega, dim3(grid), dim3(NT), LDS_BYTES, stream, p, ph, ph + 1);
#endif
}
```

```cpp
#include <hip/hip_runtime.h>
#include <hip/hip_cooperative_groups.h>
#include <cstdio>
#include <cstdint>
#include <cstring>
namespace cg = cooperative_groups;

#ifndef N_LAUNCH_MODE
#define N_LAUNCH_MODE 1
#endif

#define DEV __device__ __forceinline__
typedef unsigned short bf16_t;
typedef short bf16x8 __attribute__((ext_vector_type(8)));
typedef float f32x4 __attribute__((ext_vector_type(4)));
typedef float f32x2 __attribute__((ext_vector_type(2)));
typedef float f32x16 __attribute__((ext_vector_type(16)));
typedef unsigned u32x4 __attribute__((ext_vector_type(4)));
typedef unsigned u32x2 __attribute__((ext_vector_type(2)));

constexpr int NT = 512;
constexpr int BATCH = 8, SEQ = 4096, DM = 1024, NTOK = BATCH * SEQ;
constexpr int IN_COLS = 3352, INP = 3584;
constexpr int NC = 255;
constexpr float RMS_EPS = 1e-6f;
constexpr float QSCALE = 0.125f * 1.4426950408889634f;
constexpr int NBIN = 112;
constexpr int BINCAP = NTOK;

constexpr size_t MiB = 1ull << 20;
constexpr size_t WS_CTL    = 0;
constexpr size_t WS_RSTD1  = 1 * MiB;
constexpr size_t WS_RSTD2  = WS_RSTD1 + 128 * 1024;
constexpr size_t WS_ROWSS  = WS_RSTD2 + 128 * 1024;
constexpr size_t WS_TOKW   = WS_ROWSS + 128 * 1024;
constexpr size_t WS_LB     = WS_TOKW + 256 * 1024;
constexpr size_t WS_CBIAS  = WS_LB + 4096;
constexpr size_t WS_SELM   = 2 * MiB;
constexpr size_t WS_GATES  = 3 * MiB;
constexpr size_t WS_KCMP   = 6 * MiB;
constexpr size_t WS_VCMP   = WS_KCMP + 512 * 1024;
constexpr size_t WS_CW2T   = 7 * MiB;
constexpr size_t WS_RW     = 7 * MiB + 128 * 1024;
constexpr size_t WS_HID    = 8 * MiB;
constexpr size_t WS_CW1T   = 12 * MiB;
constexpr size_t WS_WOUTT  = 14 * MiB;
constexpr size_t WS_WINT   = 16 * MiB;
constexpr size_t WS_R1     = 24 * MiB;
constexpr size_t WS_Q      = 88 * MiB;
constexpr size_t WS_KC     = 120 * MiB;
constexpr size_t WS_VC     = 128 * MiB;
constexpr size_t WS_KS     = 136 * MiB;
constexpr size_t WS_KW     = 144 * MiB;
constexpr size_t WS_VST    = 152 * MiB;
constexpr size_t WS_VWT    = 160 * MiB;
constexpr size_t WS_OC     = 168 * MiB;
constexpr size_t WS_W13T   = 200 * MiB;
constexpr size_t WS_W2T    = 264 * MiB;
constexpr size_t WS_HQ     = 296 * MiB;
constexpr size_t WS_HV     = 328 * MiB;
constexpr size_t WS_HG     = 360 * MiB;
constexpr size_t WS_HLOGF  = 392 * MiB;
constexpr size_t WS_DBUF   = 456 * MiB;
constexpr size_t WS_END    = 457 * MiB;
constexpr size_t WS_UBUF   = WS_W13T;
constexpr size_t WS_BINL   = WS_HQ;
constexpr size_t WS_HBUF   = WS_HQ + 16 * MiB;
constexpr size_t WS_EL     = WS_HQ + 136 * MiB;
constexpr size_t WS_EW     = WS_HQ + 140 * MiB;
constexpr size_t WS_EDST   = WS_HQ + 144 * MiB;

struct Params {
    const float *x, *attn_g, *ffn_g, *w_in, *w_out, *g_q, *g_k, *pos_k, *pos_v, *wk1, *wk2, *wv1, *wv2, *g_nsa, *lb_logits, *g_hn,
        *w_group, *b_group, *w_expert, *b_expert, *w1, *w3, *w2;
    float* out;
    unsigned char* ws;
};

typedef __bf16 bf16x2_t __attribute__((ext_vector_type(2)));
DEV unsigned pk2(float lo, float hi) { f32x2 f = {lo, hi}; return __builtin_bit_cast(unsigned, __builtin_convertvector(f, bf16x2_t)); }
DEV bf16_t f2bf(float f) { return (bf16_t)(pk2(f, 0.f) & 0xffffu); }
DEV float bf2f(bf16_t b) { return __uint_as_float(((unsigned)b) << 16); }
DEV float bflo(unsigned u) { return __uint_as_float(u << 16); }
DEV float bfhi(unsigned u) { return __uint_as_float(u & 0xffff0000u); }
DEV float sigmoidf_(float v) { return __builtin_amdgcn_rcpf(1.f + __builtin_amdgcn_exp2f(-1.4426950408889634f * v)); }
DEV float siluf_(float v) { return v * __builtin_amdgcn_rcpf(1.f + __builtin_amdgcn_exp2f(-1.4426950408889634f * v)); }
DEV float wave_sum(float v) {
#pragma unroll
    for (int o = 1; o < 64; o <<= 1) v += __shfl_xor(v, o);
    return v;
}
DEV float wave_max(float v) {
#pragma unroll
    for (int o = 1; o < 64; o <<= 1) v = fmaxf(v, __shfl_xor(v, o));
    return v;
}
DEV int vblock() { const int G = gridDim.x, b = blockIdx.x; return (G % 8 == 0) ? (b % 8) * (G / 8) + b / 8 : b; }

namespace pg8 {
#define PG8_LAS __attribute__((address_space(3)))
constexpr int BM = 256, BK = 64, HALF = 128, HTB = HALF * BK * 2, STAGE_BYTES = 8 * HTB, NXCD = 8, WGM = 8;
__host__ __device__ __forceinline__ int lds_byte(int r, int c) { const int st = (r >> 4) * 2 + (c >> 5), rr = r & 15, cc = c & 31, ob = rr * 64 + cc * 2; return st * 1024 + (ob ^ (((ob >> 9) & 1) << 5)); }
__host__ __device__ __forceinline__ void stage_rc(int b, int& R, int& C) { const int st = b / 1024, sb = b % 1024, swz = sb ^ (((sb >> 9) & 1) << 5); R = (st >> 1) * 16 + swz / 64; C = (st & 1) * 32 + (swz % 64) / 2; }
struct Unit { int pm, pn; };
struct Gemm { const bf16_t* A; const bf16_t* Bt; int M, N, K; };
struct StaticOrder {
    int nM, nN, nwg, G, c;
    __host__ __device__ void init(int M, int N, int G_, int c_) { nM = M / BM; nN = N / BM; nwg = nM * nN; G = G_; c = c_; }
    __host__ __device__ bool next(int i, Unit& u) const {
        const long L = (long)i * G + c; if (L >= nwg) return false;
        int wgid = (int)L; { const int q = nwg / NXCD, r = nwg % NXCD, xcd = wgid % NXCD, off = wgid / NXCD; wgid = (xcd < r ? xcd * (q + 1) : r * (q + 1) + (xcd - r) * q) + off; }
        const int nig = WGM * nN, gid = wgid / nig, fm = gid * WGM, gsz = (nM - fm) < WGM ? (nM - fm) : WGM;
        u.pm = fm + ((wgid % nig) % gsz); u.pn = (wgid % nig) / gsz; return true;
    }
};
template <class Epi, class Sched>
__device__ __forceinline__ void gemm_phase(PG8_LAS unsigned char* lds, const Gemm g, const Sched& S, const Epi& E) {
    const int tid = threadIdx.x, wid = __builtin_amdgcn_readfirstlane(tid >> 6), lane = tid & 63, wr = wid >> 2, wc = wid & 3, fr = lane & 15, fq = lane >> 4;
    const int K = g.K, nt = K / BK;
    unsigned voffA[2];
#pragma unroll
    for (int i = 0; i < 2; ++i) { int R, C; stage_rc(tid * 16 + i * 8192, R, C); voffA[i] = (unsigned)(R * K + C) * 2u; }
    const size_t kstep = (size_t)(BK * 2);
    const size_t hstep = (size_t)HALF * K * 2;
    const size_t tstep = 2 * hstep;
    const unsigned ldsw = (unsigned)wid * 1024u;
    const int aoff = lds_byte(wr * 64 + fr, fq * 8), boff = lds_byte(wc * 32 + fr, fq * 8);
#define PG8_SA(b, h) (((b) * 2 + (h)) * HTB)
#define PG8_SB(b, h) ((4 + (b) * 2 + (h)) * HTB)
#define PG8_STAGE(bufoff, gbase, voff) do { _Pragma("unroll") for (int _i = 0; _i < 2; ++_i) \
        __builtin_amdgcn_global_load_lds((const unsigned*)((const char*)(gbase) + (voff)[_i]), (PG8_LAS unsigned*)(lds + (bufoff) + ldsw + _i * 8192), 16, 0, 0); } while (0)
#define PG8_LDA(dst, b, h) do { _Pragma("unroll") for (int m = 0; m < 4; ++m) _Pragma("unroll") for (int k = 0; k < 2; ++k) dst[m][k] = *(const PG8_LAS bf16x8*)(lds + PG8_SA(b, h) + aoff + m * 2048 + k * 1024); } while (0)
#define PG8_LDB(dst, b, h) do { _Pragma("unroll") for (int n = 0; n < 2; ++n) _Pragma("unroll") for (int k = 0; k < 2; ++k) dst[n][k] = *(const PG8_LAS bf16x8*)(lds + PG8_SB(b, h) + boff + n * 2048 + k * 1024); } while (0)
#define PG8_MMA(ai, bj, At, Bt) do { __builtin_amdgcn_s_setprio(1); _Pragma("unroll") for (int m = 0; m < 4; ++m) _Pragma("unroll") for (int n = 0; n < 2; ++n) _Pragma("unroll") for (int k = 0; k < 2; ++k) \
        acc[ai][bj][m][n] = __builtin_amdgcn_mfma_f32_16x16x32_bf16(Bt[n][k], At[m][k], acc[ai][bj][m][n], 0, 0, 0); __builtin_amdgcn_s_setprio(0); } while (0)
#define PG8_WAIT_V(n) asm volatile("s_waitcnt vmcnt(" #n ")" ::: "memory")
#define PG8_WAIT_L(n) asm volatile("s_waitcnt lgkmcnt(" #n ")" ::: "memory")
#define PG8_BAR __builtin_amdgcn_s_barrier()
#define PG8_SCHED __builtin_amdgcn_sched_barrier(0)
    Unit cur, nxt; int ui = 0;
    if (!S.next(0, cur)) return;
    f32x4 acc[2][2][4][2];
#pragma unroll
    for (int a = 0; a < 2; ++a)
#pragma unroll
        for (int b = 0; b < 2; ++b)
#pragma unroll
            for (int m = 0; m < 4; ++m)
#pragma unroll
                for (int n = 0; n < 2; ++n) acc[a][b][m][n] = (f32x4){0.f, 0.f, 0.f, 0.f};
    bf16x8 At[4][2], B0[2][2], B1[2][2];
    const char* cA = (const char*)g.A + (size_t)cur.pm * tstep; const char* cB = (const char*)g.Bt + (size_t)cur.pn * tstep;
    PG8_STAGE(PG8_SB(0, 0), cB, voffA); PG8_STAGE(PG8_SA(0, 0), cA, voffA); PG8_STAGE(PG8_SB(0, 1), cB + hstep, voffA); PG8_STAGE(PG8_SA(0, 1), cA + hstep, voffA);
    if (wr == 1) PG8_BAR;
    PG8_WAIT_V(4); PG8_BAR;
    PG8_STAGE(PG8_SB(1, 0), cB + kstep, voffA); PG8_STAGE(PG8_SA(1, 0), cA + kstep, voffA); PG8_STAGE(PG8_SB(1, 1), cB + hstep + kstep, voffA);
    PG8_WAIT_V(6); PG8_BAR;
    for (;;) {
        const bool has_next = S.next(ui + 1, nxt);
        const char* nA = has_next ? (const char*)g.A + (size_t)nxt.pm * tstep : cA; const char* nB = has_next ? (const char*)g.Bt + (size_t)nxt.pn * tstep : cB;
        float midrs[2][4];
        if constexpr (Epi::MIDSCALE) {
#pragma unroll
            for (int a = 0; a < 2; ++a)
#pragma unroll
                for (int m = 0; m < 4; ++m) midrs[a][m] = E.rowscale(cur.pm * BM + a * HALF + wr * 64 + m * 16 + fr); }
        for (int t = 0; t < nt; t += 2) {
            const bool last = (t == nt - 2);
            if constexpr (Epi::MIDSCALE) { if (t == E.midk()) {
#pragma unroll
                for (int a = 0; a < 2; ++a)
#pragma unroll
                    for (int b = 0; b < 2; ++b)
#pragma unroll
                        for (int m = 0; m < 4; ++m)
#pragma unroll
                            for (int n = 0; n < 2; ++n) acc[a][b][m][n] = acc[a][b][m][n] * midrs[a][m]; } }
            const char* a1 = cA + (size_t)(t + 1) * kstep;
            const char* a2 = last ? nA : cA + (size_t)(t + 2) * kstep; const char* b2 = last ? nB : cB + (size_t)(t + 2) * kstep;
            const char* a3 = a2 + kstep; const char* b3 = b2 + kstep;
            PG8_LDB(B0, 0, 0); PG8_SCHED; PG8_LDA(At, 0, 0); PG8_STAGE(PG8_SA(1, 1), a1 + hstep, voffA);
            PG8_WAIT_L(8); PG8_BAR; PG8_WAIT_L(0); PG8_MMA(0, 0, At, B0); PG8_BAR; PG8_SCHED;
            PG8_LDB(B1, 0, 1); PG8_STAGE(PG8_SB(0, 0), b2, voffA);
            PG8_BAR; PG8_WAIT_L(0); PG8_MMA(0, 1, At, B1); PG8_BAR;
            PG8_LDA(At, 0, 1); PG8_STAGE(PG8_SA(0, 0), a2, voffA);
            PG8_BAR; PG8_WAIT_L(0); PG8_MMA(1, 0, At, B0); PG8_BAR; PG8_SCHED;
            PG8_STAGE(PG8_SB(0, 1), b2 + hstep, voffA);
            PG8_WAIT_V(6); PG8_BAR; PG8_MMA(1, 1, At, B1); PG8_BAR;
            PG8_LDB(B0, 1, 0); PG8_SCHED; PG8_LDA(At, 1, 0); PG8_STAGE(PG8_SA(0, 1), a2 + hstep, voffA);
            PG8_WAIT_L(8); PG8_BAR; PG8_WAIT_L(0); PG8_MMA(0, 0, At, B0); PG8_BAR; PG8_SCHED;
            PG8_LDB(B1, 1, 1); PG8_STAGE(PG8_SB(1, 0), b3, voffA);
            PG8_BAR; PG8_WAIT_L(0); PG8_MMA(0, 1, At, B1); PG8_BAR;
            PG8_LDA(At, 1, 1); PG8_STAGE(PG8_SA(1, 0), a3, voffA);
            PG8_BAR; PG8_WAIT_L(0); PG8_MMA(1, 0, At, B0); PG8_BAR; PG8_SCHED;
            PG8_STAGE(PG8_SB(1, 1), b3 + hstep, voffA);
            PG8_WAIT_V(6); PG8_BAR; PG8_MMA(1, 1, At, B1); PG8_BAR;
        }
        E(acc, cur, wr, wc, fr, fq);
        if (!has_next) break;
#pragma unroll
        for (int a = 0; a < 2; ++a)
#pragma unroll
            for (int b = 0; b < 2; ++b)
#pragma unroll
                for (int m = 0; m < 4; ++m)
#pragma unroll
                    for (int n = 0; n < 2; ++n) acc[a][b][m][n] = (f32x4){0.f, 0.f, 0.f, 0.f};
        cur = nxt; cA = nA; cB = nB; ++ui;
    }
    PG8_WAIT_V(0);
    if (wr == 0) PG8_BAR;
    PG8_BAR;
#undef PG8_SA
#undef PG8_SB
#undef PG8_STAGE
#undef PG8_LDA
#undef PG8_LDB
#undef PG8_MMA
#undef PG8_WAIT_V
#undef PG8_WAIT_L
#undef PG8_BAR
#undef PG8_SCHED
}
template <class Pol, class Epi>
__device__ __forceinline__ void gemm_phase2(PG8_LAS unsigned char* lds, const Pol& P, const Epi& E) {
    const int tid = threadIdx.x, wid = __builtin_amdgcn_readfirstlane(tid >> 6), lane = tid & 63, wr = wid >> 2, wc = wid & 3, fr = lane & 15, fq = lane >> 4;
    const int nt = P.nk();
    const unsigned ldsw = (unsigned)wid * 1024u;
    const int aoff = lds_byte(wr * 64 + fr, fq * 8), boff = lds_byte(wc * 32 + fr, fq * 8);
#define PG8_SA(b, h) (((b) * 2 + (h)) * HTB)
#define PG8_SB(b, h) ((4 + (b) * 2 + (h)) * HTB)
#define PG8_STAGE_A(bufoff, AS, h, kt) do { _Pragma("unroll") for (int _i = 0; _i < 2; ++_i) \
        __builtin_amdgcn_global_load_lds((const unsigned*)P.pa(AS, h, _i, kt), (PG8_LAS unsigned*)(lds + (bufoff) + ldsw + _i * 8192), 16, 0, 0); } while (0)
#define PG8_STAGE_B(bufoff, BS, h, kt) do { _Pragma("unroll") for (int _i = 0; _i < 2; ++_i) \
        __builtin_amdgcn_global_load_lds((const unsigned*)P.pb(BS, h, _i, kt), (PG8_LAS unsigned*)(lds + (bufoff) + ldsw + _i * 8192), 16, 0, 0); } while (0)
#define PG8_LDA(dst, b, h) do { _Pragma("unroll") for (int m = 0; m < 4; ++m) _Pragma("unroll") for (int k = 0; k < 2; ++k) dst[m][k] = *(const PG8_LAS bf16x8*)(lds + PG8_SA(b, h) + aoff + m * 2048 + k * 1024); } while (0)
#define PG8_LDB(dst, b, h) do { _Pragma("unroll") for (int n = 0; n < 2; ++n) _Pragma("unroll") for (int k = 0; k < 2; ++k) dst[n][k] = *(const PG8_LAS bf16x8*)(lds + PG8_SB(b, h) + boff + n * 2048 + k * 1024); } while (0)
#define PG8_MMA(ai, bj, At, Bt) do { __builtin_amdgcn_s_setprio(1); _Pragma("unroll") for (int m = 0; m < 4; ++m) _Pragma("unroll") for (int n = 0; n < 2; ++n) _Pragma("unroll") for (int k = 0; k < 2; ++k) \
        acc[ai][bj][m][n] = __builtin_amdgcn_mfma_f32_16x16x32_bf16(Bt[n][k], At[m][k], acc[ai][bj][m][n], 0, 0, 0); __builtin_amdgcn_s_setprio(0); } while (0)
#define PG8_STAGE_A2(bufoff, h, kt) do { _Pragma("unroll") for (int _i = 0; _i < 2; ++_i) \
        __builtin_amdgcn_global_load_lds((const unsigned*)P.pa(a2, h, _i, kt), (PG8_LAS unsigned*)(lds + (bufoff) + ldsw + _i * 8192), 16, 0, 0); } while (0)
#define PG8_STAGE_B2(bufoff, h, kt) do { _Pragma("unroll") for (int _i = 0; _i < 2; ++_i) \
        __builtin_amdgcn_global_load_lds((const unsigned*)P.pb(b2, h, _i, kt), (PG8_LAS unsigned*)(lds + (bufoff) + ldsw + _i * 8192), 16, 0, 0); } while (0)
#define PG8_WAIT_V(n) asm volatile("s_waitcnt vmcnt(" #n ")" ::: "memory")
#define PG8_WAIT_L(n) asm volatile("s_waitcnt lgkmcnt(" #n ")" ::: "memory")
#define PG8_BAR __builtin_amdgcn_s_barrier()
#define PG8_SCHED __builtin_amdgcn_sched_barrier(0)
    typename Pol::Unit cur, nxt; int ui = 0;
    if (!P.next(0, cur)) return;
    f32x4 acc[2][2][4][2];
#pragma unroll
    for (int a = 0; a < 2; ++a)
#pragma unroll
        for (int b = 0; b < 2; ++b)
#pragma unroll
            for (int m = 0; m < 4; ++m)
#pragma unroll
                for (int n = 0; n < 2; ++n) acc[a][b][m][n] = (f32x4){0.f, 0.f, 0.f, 0.f};
    bf16x8 At[4][2], B0[2][2], B1[2][2];
    typename Pol::AddrA aC, aN; typename Pol::AddrB bC, bN;
    P.addrA(cur, aC); P.addrB(cur, bC);
    PG8_STAGE_B(PG8_SB(0, 0), bC, 0, 0); PG8_STAGE_A(PG8_SA(0, 0), aC, 0, 0); PG8_STAGE_B(PG8_SB(0, 1), bC, 1, 0); PG8_STAGE_A(PG8_SA(0, 1), aC, 1, 0);
    if (wr == 1) PG8_BAR;
    PG8_WAIT_V(4); PG8_BAR;
    PG8_STAGE_B(PG8_SB(1, 0), bC, 0, 1); PG8_STAGE_A(PG8_SA(1, 0), aC, 0, 1); PG8_STAGE_B(PG8_SB(1, 1), bC, 1, 1);
    PG8_WAIT_V(6); PG8_BAR;
    for (;;) {
        const bool has_next = P.next(ui + 1, nxt);
        if (has_next) { P.addrA(nxt, aN); P.addrB(nxt, bN); } else { aN = aC; bN = bC; }
        const bool full = P.full(cur);
        for (int t = 0; t < nt; t += 2) {
            const bool last = (t == nt - 2);
            const typename Pol::AddrA a2 = last ? aN : aC; const typename Pol::AddrB b2 = last ? bN : bC;
            const int k2 = last ? 0 : t + 2, k3 = k2 + 1;
            PG8_LDB(B0, 0, 0); PG8_SCHED; PG8_LDA(At, 0, 0); PG8_STAGE_A(PG8_SA(1, 1), aC, 1, t + 1);
            PG8_WAIT_L(8); PG8_BAR; PG8_WAIT_L(0); PG8_MMA(0, 0, At, B0); PG8_BAR; PG8_SCHED;
            PG8_LDB(B1, 0, 1); PG8_STAGE_B2(PG8_SB(0, 0), 0, k2);
            PG8_BAR; PG8_WAIT_L(0); PG8_MMA(0, 1, At, B1); PG8_BAR;
            PG8_LDA(At, 0, 1); PG8_STAGE_A2(PG8_SA(0, 0), 0, k2);
            PG8_BAR; PG8_WAIT_L(0); if (full) PG8_MMA(1, 0, At, B0); PG8_BAR; PG8_SCHED;
            PG8_STAGE_B2(PG8_SB(0, 1), 1, k2);
            PG8_WAIT_V(6); PG8_BAR; if (full) PG8_MMA(1, 1, At, B1); PG8_BAR;
            PG8_LDB(B0, 1, 0); PG8_SCHED; PG8_LDA(At, 1, 0); PG8_STAGE_A2(PG8_SA(0, 1), 1, k2);
            PG8_WAIT_L(8); PG8_BAR; PG8_WAIT_L(0); PG8_MMA(0, 0, At, B0); PG8_BAR; PG8_SCHED;
            PG8_LDB(B1, 1, 1); PG8_STAGE_B2(PG8_SB(1, 0), 0, k3);
            PG8_BAR; PG8_WAIT_L(0); PG8_MMA(0, 1, At, B1); PG8_BAR;
            PG8_LDA(At, 1, 1); PG8_STAGE_A2(PG8_SA(1, 0), 0, k3);
            PG8_BAR; PG8_WAIT_L(0); if (full) PG8_MMA(1, 0, At, B0); PG8_BAR; PG8_SCHED;
            PG8_STAGE_B2(PG8_SB(1, 1), 1, k3);
            PG8_WAIT_V(6); PG8_BAR; if (full) PG8_MMA(1, 1, At, B1); PG8_BAR;
        }
        E(acc, cur, wr, wc, fr, fq);
        if (!has_next) break;
#pragma unroll
        for (int a = 0; a < 2; ++a)
#pragma unroll
            for (int b = 0; b < 2; ++b)
#pragma unroll
                for (int m = 0; m < 4; ++m)
#pragma unroll
                    for (int n = 0; n < 2; ++n) acc[a][b][m][n] = (f32x4){0.f, 0.f, 0.f, 0.f};
        cur = nxt; aC = aN; bC = bN; ++ui;
    }
    PG8_WAIT_V(0);
    if (wr == 0) PG8_BAR;
    PG8_BAR;
#undef PG8_SA
#undef PG8_SB
#undef PG8_STAGE_A
#undef PG8_STAGE_B
#undef PG8_STAGE_A2
#undef PG8_STAGE_B2
#undef PG8_LDA
#undef PG8_LDB
#undef PG8_MMA
#undef PG8_WAIT_V
#undef PG8_WAIT_L
#undef PG8_BAR
#undef PG8_SCHED
}
__host__ __device__ __forceinline__ int perm_lo(int x) { return (((x >> 2) & 3) << 3) | (((x >> 4) & 1) << 2) | (x & 3); }
__host__ __device__ __forceinline__ int inv_perm_lo(int y) { return (((y >> 2) & 1) << 4) | (((y >> 3) & 3) << 2) | (y & 3); }
__host__ __device__ __forceinline__ int logcol(int p) { return (p & ~255) + 64 * ((p >> 5) & 3) + 32 * ((p >> 7) & 1) + perm_lo(p & 31); }
}

template <class SRC>
DEV void convert_tile(float* tl, const SRC& src, bf16_t* dst, int ldd, int n0, int k0) {
    const int tid = threadIdx.x;
    {
        const int n = tid & 63;
#pragma unroll
        for (int i = 0; i < 8; ++i) { const int kk = (tid >> 6) + 8 * i; tl[kk * 65 + n] = src.get(n0 + n, k0 + kk); }
    }
    __syncthreads();
    {
        const int n = tid >> 3, kc = tid & 7;
        const float* s = tl + (kc * 8) * 65 + n;
        u32x4 o;
        o.x = pk2(s[0 * 65], s[1 * 65]); o.y = pk2(s[2 * 65], s[3 * 65]); o.z = pk2(s[4 * 65], s[5 * 65]); o.w = pk2(s[6 * 65], s[7 * 65]);
        *(u32x4*)(dst + (size_t)(n0 + n) * ldd + k0 + kc * 8) = o;
    }
    __syncthreads();
}
struct SrcWin { const float* w; const float* g;
    DEV float get(int np, int k) const { const int n = pg8::logcol(np); int col; if (n < 1280) col = n; else if (n < 3328) col = n + 24; else if (n < 3352) col = 1280 + (n - 3328); else return 0.f;
        return w[(size_t)k * IN_COLS + col] * g[k]; } };
struct SrcWout { const float* w; const float* g;
    DEV float get(int np, int k) const { const int n = pg8::logcol(np); const float v = w[(size_t)k * DM + n]; return k < 512 ? v * g[k] : v; } };
struct SrcPlain { const float* w; int ld;
    DEV float get(int n, int k) const { return w[(size_t)k * ld + n]; } };
struct SrcW13 { const float* w1; const float* w3; const float* g;
    DEV float get(int n, int k) const { const uintptr_t a = (uintptr_t)w1, b = (uintptr_t)w3; const float* w = (const float*)(a + ((b - a) & (uintptr_t)(0 - (long long)(n & 1))));
        return w[(size_t)k * 512 + (n >> 1)] * g[k]; } };

template <class SRC>
DEV void convert_tile256(float* tl, const SRC& src, bf16_t* dst, int ldd, int n0, int k0) {
    const int tid = threadIdx.x;
    {
        const int q = tid & 63;
        f32x4 v[8];
#pragma unroll
        for (int i = 0; i < 8; ++i) v[i] = src.quad(n0, q, k0 + (tid >> 6) + 8 * i);
#pragma unroll
        for (int i = 0; i < 8; ++i) { float* o = tl + ((tid >> 6) + 8 * i) * 257; o[src.drow(q, 0)] = v[i].x; o[src.drow(q, 1)] = v[i].y; o[src.drow(q, 2)] = v[i].z; o[src.drow(q, 3)] = v[i].w; }
    }
    __syncthreads();
#pragma unroll
    for (int i = 0; i < 4; ++i) {
        const int idx = tid + NT * i, n = idx >> 3, kc = idx & 7;
        const float* s = tl + (kc * 8) * 257 + n;
        u32x4 o;
        o.x = pk2(s[0 * 257], s[1 * 257]); o.y = pk2(s[2 * 257], s[3 * 257]); o.z = pk2(s[4 * 257], s[5 * 257]); o.w = pk2(s[6 * 257], s[7 * 257]);
        *(u32x4*)(dst + (size_t)(n0 + n) * ldd + k0 + kc * 8) = o;
    }
    __syncthreads();
}
struct SrcWin4 { const float* w; const float* g;
    DEV int drow(int q, int e) const { return 4 * q + e; }
    DEV f32x4 quad(int n0, int q, int k) const { const int n = pg8::logcol(n0 + 4 * q); int col; if (n < 1280) col = n; else if (n < 3328) col = n + 24; else if (n < 3352) col = 1280 + (n - 3328); else return (f32x4){0.f, 0.f, 0.f, 0.f};
        return *(const f32x4*)(w + (size_t)k * IN_COLS + col) * g[k]; } };
struct SrcWout4 { const float* w; const float* g;
    DEV int drow(int q, int e) const { return 4 * q + e; }
    DEV f32x4 quad(int n0, int q, int k) const { const f32x4 v = *(const f32x4*)(w + (size_t)k * DM + pg8::logcol(n0 + 4 * q)); return k < 512 ? v * g[k] : v; } };
struct SrcPlain4 { const float* w; int ld;
    DEV int drow(int q, int e) const { return 4 * q + e; }
    DEV f32x4 quad(int n0, int q, int k) const { return *(const f32x4*)(w + (size_t)k * ld + n0 + 4 * q); } };
struct SrcW13_4 { const float* w1; const float* w3; const float* g;
    DEV int drow(int q, int e) const { const int l = 8 * (q & 31) + 2 * e + (q >> 5); return (l & ~31) | pg8::inv_perm_lo(l & 31); }
    DEV f32x4 quad(int n0, int q, int k) const { const uintptr_t a = (uintptr_t)w1, b = (uintptr_t)w3; const float* w = (const float*)(a + ((b - a) & (uintptr_t)(0 - (long long)(q >> 5))));
        return *(const f32x4*)(w + (size_t)k * 512 + (n0 >> 1) + 4 * (q & 31)) * g[k]; } };

DEV void phase_prologue(const Params& p, unsigned char* lds) {
    float* tl = (float*)lds;
    const int tid = threadIdx.x, lane = tid & 63, wid = tid >> 6;
    const int vb = vblock(), G = gridDim.x;
    unsigned char* ws = p.ws;
    constexpr int I_WIN = (INP / 256) * (DM / 64);
    constexpr int I_WOUT = 4 * 16;
    constexpr int I_CW1 = 2 * 32;
    constexpr int I_W2 = 32 * 4 * 8;
    constexpr int I_CW2 = 2 * 1 * 4;
    constexpr int I_ALL = I_WIN + I_WOUT + I_CW1 + I_W2 + I_CW2;
    for (int it = vb; it < I_ALL; it += G) {
        int r = it;
        if (r < I_WIN) { SrcWin4 s{p.w_in, p.attn_g}; convert_tile256(tl, s, (bf16_t*)(ws + WS_WINT), DM, (r / 16) * 256, (r % 16) * 64); continue; } r -= I_WIN;
        if (r < I_WOUT) { SrcWout4 s{p.w_out, p.g_nsa}; convert_tile256(tl, s, (bf16_t*)(ws + WS_WOUTT), DM, (r / 16) * 256, (r % 16) * 64); continue; } r -= I_WOUT;
        if (r < I_CW1) { const int z = r / 32, q = r % 32; SrcPlain4 s{z ? p.wv1 : p.wk1, 256};
            convert_tile256(tl, s, (bf16_t*)(ws + WS_CW1T) + (size_t)z * 256 * 2048, 2048, 0, q * 64); continue; } r -= I_CW1;
        if (r < I_W2) { const int e = r / 32, q = r % 32; SrcPlain4 s{p.w2 + (size_t)e * 512 * 1024, 1024};
            convert_tile256(tl, s, (bf16_t*)(ws + WS_W2T) + (size_t)e * 1024 * 512, 512, (q / 8) * 256, (q % 8) * 64); continue; } r -= I_W2;
        { const int z = r / 4, q = r % 4; SrcPlain s{z ? p.wv2 : p.wk2, 64};
            convert_tile(tl, s, (bf16_t*)(ws + WS_CW2T) + (size_t)z * 64 * 256, 256, 0, q * 64); }
    }
    {
        bf16_t* xb = (bf16_t*)(ws + WS_R1); float* rstd1 = (float*)(ws + WS_RSTD1);
        const int gw = vb * 8 + wid, NGW = G * 8;
        for (int m = gw; m < NTOK; m += NGW) {
            const f32x4* xr = (const f32x4*)(p.x + (size_t)m * DM) + lane;
            f32x4 v[4]; float s = 0.f;
#pragma unroll
            for (int j = 0; j < 4; ++j) { v[j] = xr[64 * j]; s += (v[j].x * v[j].x + v[j].y * v[j].y) + (v[j].z * v[j].z + v[j].w * v[j].w); }
            s = wave_sum(s);
            if (lane == 0) rstd1[m] = rsqrtf(s * (1.f / DM) + RMS_EPS);
            u32x2* o = (u32x2*)(xb + (size_t)m * DM) + lane;
#pragma unroll
            for (int j = 0; j < 4; ++j) { u32x2 w; w.x = pk2(v[j].x, v[j].y); w.y = pk2(v[j].z, v[j].w); o[64 * j] = w; }
        }
    }
    {
        const int gt = vb * NT + tid, NG = G * NT;
        float* rowss = (float*)(ws + WS_ROWSS);
        for (int i = gt; i < NTOK; i += NG) rowss[i] = 0.f;
        int* bincnt = (int*)(ws + WS_CTL);
        if (gt < 128) bincnt[gt] = 0;
        if (gt < 32) ((int*)(ws + WS_CTL + 512))[gt] = 0;
        if (gt < 512) { const float l0 = p.lb_logits[gt], l1 = p.lb_logits[512 + gt]; ((float*)(ws + WS_LB))[gt] = 1.f / (1.f + __expf(l1 - l0)); }
        for (int i = gt; i < 48 * 1024; i += NG) { const int c = i >> 10, k = i & 1023;
            const float w = (c < 4 ? p.w_group[k * 4 + c] : (c < 36 ? p.w_expert[k * 32 + (c - 4)] : 0.f)) * p.ffn_g[k];
            const bf16_t hi = f2bf(w); const bf16_t lo = f2bf(w - bf2f(hi));
            ((bf16_t*)(ws + WS_RW))[i] = hi; ((bf16_t*)(ws + WS_RW))[48 * 1024 + i] = lo; }
        if (blockIdx.x == (unsigned)(G - 1)) {
            const int z = tid >> 8, j = tid & 255; const float* pos = z ? p.pos_v : p.pos_k; const float* w = z ? p.wv1 : p.wk1;
            float a = 0.f;
            for (int k = 0; k < 2048; ++k) a += pos[k] * w[(size_t)k * 256 + j];
            ((float*)(ws + WS_CBIAS))[z * 256 + j] = a;
        }
    }
}

constexpr int G_A_BYTES = 128 * 128, G_B_BYTES = 256 * 128, G_STAGE = G_A_BYTES + G_B_BYTES, G_LDS = 2 * G_STAGE;
DEV int swz(int row, int chunk) { return row * 128 + ((chunk ^ ((row >> 1) & 7)) << 4); }
template <class AL, class BL, class EP>
DEV void gemm_tile(unsigned char* lds, const AL& al, const BL& bl, int nk, const EP& ep) {
    const int tid = threadIdx.x, lane = tid & 63, wid = tid >> 6, wr = wid >> 2, wc = wid & 3;
    const int frow = lane & 15, fq = lane >> 4;
    const bf16_t* aptr[2]; int aoff[2], boff[4], brow[4];
#pragma unroll
    for (int i = 0; i < 2; ++i) { const int q = tid + NT * i, row = q >> 3, ch = q & 7; aptr[i] = al.row(row) + ch * 8; aoff[i] = swz(row, ch); }
#pragma unroll
    for (int i = 0; i < 4; ++i) { const int q = tid + NT * i, row = q >> 3, ch = q & 7; brow[i] = row; boff[i] = G_A_BYTES + swz(row, ch) ; }
    const int bch8 = (tid & 7) * 8;
    u32x4 ra[2], rb[4];
#pragma unroll
    for (int i = 0; i < 2; ++i) ra[i] = *(const u32x4*)(aptr[i]);
#pragma unroll
    for (int i = 0; i < 4; ++i) rb[i] = *(const u32x4*)(bl.ptr(brow[i], 0) + bch8);
#pragma unroll
    for (int i = 0; i < 2; ++i) *(u32x4*)(lds + aoff[i]) = ra[i];
#pragma unroll
    for (int i = 0; i < 4; ++i) *(u32x4*)(lds + boff[i]) = rb[i];
    __syncthreads();
    f32x4 acc[4][4];
#pragma unroll
    for (int m = 0; m < 4; ++m)
#pragma unroll
        for (int n = 0; n < 4; ++n) acc[m][n] = (f32x4){0.f, 0.f, 0.f, 0.f};
    const int sx = (frow >> 1) & 7;
    for (int kt = 0; kt < nk; ++kt) {
        const bool more = (kt + 1 < nk);
        if (more) {
#pragma unroll
            for (int i = 0; i < 2; ++i) ra[i] = *(const u32x4*)(aptr[i] + (kt + 1) * 64);
#pragma unroll
            for (int i = 0; i < 4; ++i) rb[i] = *(const u32x4*)(bl.ptr(brow[i], kt + 1) + bch8);
        }
        const unsigned char* base = lds + (kt & 1) * G_STAGE;
#pragma unroll
        for (int ks = 0; ks < 2; ++ks) {
            const int co = ((ks * 4 + fq) ^ sx) << 4;
            bf16x8 af[4], bfr[4];
#pragma unroll
            for (int m = 0; m < 4; ++m) af[m] = *(const bf16x8*)(base + (wr * 64 + m * 16 + frow) * 128 + co);
#pragma unroll
            for (int n = 0; n < 4; ++n) bfr[n] = *(const bf16x8*)(base + G_A_BYTES + (wc * 64 + n * 16 + frow) * 128 + co);
#pragma unroll
            for (int m = 0; m < 4; ++m)
#pragma unroll
                for (int n = 0; n < 4; ++n) acc[m][n] = __builtin_amdgcn_mfma_f32_16x16x32_bf16(bfr[n], af[m], acc[m][n], 0, 0, 0);
        }
        if (more) {
            unsigned char* nb = lds + ((kt + 1) & 1) * G_STAGE;
#pragma unroll
            for (int i = 0; i < 2; ++i) *(u32x4*)(nb + aoff[i]) = ra[i];
#pragma unroll
            for (int i = 0; i < 4; ++i) *(u32x4*)(nb + boff[i]) = rb[i];
        }
        __syncthreads();
    }
    ep(acc, wr, wc, lane);
}

struct ARows { const bf16_t* base; size_t ld; DEV const bf16_t* row(int r) const { return base + (size_t)r * ld; } };
struct BRows { const bf16_t* base; size_t ld; DEV const bf16_t* ptr(int n, int kt) const { return base + (size_t)n * ld + kt * 64; } };

DEV u32x4 pk8(const f32x4 a, const f32x4 b) { u32x4 w; w.x = pk2(a.x, a.y); w.y = pk2(a.z, a.w); w.z = pk2(b.x, b.y); w.w = pk2(b.z, b.w); return w; }
DEV void inproj_row(const Params& p, int seg, int row, f32x4 (&v)[2][2], int fq) {
    unsigned char* ws = p.ws;
    const float rs = ((const float*)(ws + WS_RSTD1))[row];
#pragma unroll
    for (int bj = 0; bj < 2; ++bj) { v[bj][0] = v[bj][0] * rs; v[bj][1] = v[bj][1] * rs; }
    const int b = row >> 12, s = row & 4095;
    const bool is_q = seg < 8, is_ks = (seg == 12 || seg == 13), is_kw = (seg == 16 || seg == 17);
    if (is_q || is_ks || is_kw) {
        const float* gw = is_q ? p.g_q : (is_ks ? p.g_k + 64 : p.g_k + 128);
        bf16_t* dst; int hh, nh;
        if (is_q) { dst = (bf16_t*)(ws + WS_Q); hh = seg; nh = 8; } else if (is_ks) { dst = (bf16_t*)(ws + WS_KS); hh = seg - 12; nh = 2; } else { dst = (bf16_t*)(ws + WS_KW); hh = seg - 16; nh = 2; }
        float ss = 0.f;
#pragma unroll
        for (int bj = 0; bj < 2; ++bj)
#pragma unroll
            for (int n = 0; n < 2; ++n) ss += (v[bj][n].x * v[bj][n].x + v[bj][n].y * v[bj][n].y) + (v[bj][n].z * v[bj][n].z + v[bj][n].w * v[bj][n].w);
        ss += __shfl_xor(ss, 16); ss += __shfl_xor(ss, 32);
        float r = rsqrtf(ss * (1.f / 64.f) + RMS_EPS); if (is_q) r *= QSCALE;
        bf16_t* o = dst + ((size_t)(b * nh + hh) * SEQ + s) * 64 + fq * 8;
#pragma unroll
        for (int bj = 0; bj < 2; ++bj) { const f32x4 g0 = *(const f32x4*)(gw + 32 * bj + 8 * fq), g1 = *(const f32x4*)(gw + 32 * bj + 8 * fq + 4);
            *(u32x4*)(o + 32 * bj) = pk8(v[bj][0] * g0 * r, v[bj][1] * g1 * r); }
        return;
    }
    if (seg >= 8 && seg < 12) {
        bf16_t* o = (bf16_t*)(ws + (seg < 10 ? WS_KC : WS_VC)) + ((size_t)(b * 2 + (seg & 1)) * SEQ + s) * 64 + fq * 8;
#pragma unroll
        for (int bj = 0; bj < 2; ++bj) *(u32x4*)(o + 32 * bj) = pk8(v[bj][0], v[bj][1]);
        return;
    }
    if (seg == 14 || seg == 15 || seg == 18 || seg == 19) {
        bf16_t* o = (bf16_t*)(ws + (seg < 16 ? WS_VST : WS_VWT)) + (size_t)(b * 2 + (seg & 1)) * 64 * SEQ + s;
#pragma unroll
        for (int bj = 0; bj < 2; ++bj)
#pragma unroll
            for (int n = 0; n < 2; ++n) { const int d = 32 * bj + 8 * fq + 4 * n; const f32x4 x = v[bj][n];
                o[(size_t)(d + 0) * SEQ] = f2bf(x.x); o[(size_t)(d + 1) * SEQ] = f2bf(x.y); o[(size_t)(d + 2) * SEQ] = f2bf(x.z); o[(size_t)(d + 3) * SEQ] = f2bf(x.w); }
        return;
    }
    if (seg < 52) {
        const int kind = (seg - 20) >> 3, cb = ((seg - 20) & 7) * 64 + fq * 8;
        if (kind == 1) {
            const float* lb = (const float*)(ws + WS_LB); float* dst = (float*)(ws + WS_HLOGF) + (size_t)row * 512;
#pragma unroll
            for (int bj = 0; bj < 2; ++bj)
#pragma unroll
                for (int n = 0; n < 2; ++n) { const int c = cb + 32 * bj + 4 * n; const f32x4 l = *(const f32x4*)(lb + c); const f32x4 x = v[bj][n]; f32x4 o;
                    o.x = __logf(l.x + (1.f - l.x) * sigmoidf_(x.x)); o.y = __logf(l.y + (1.f - l.y) * sigmoidf_(x.y));
                    o.z = __logf(l.z + (1.f - l.z) * sigmoidf_(x.z)); o.w = __logf(l.w + (1.f - l.w) * sigmoidf_(x.w));
                    *(f32x4*)(dst + c) = o; }
        } else {
            bf16_t* dst = (bf16_t*)(ws + (kind == 0 ? WS_HQ : (kind == 2 ? WS_HV : WS_HG))) + (size_t)row * 512 + cb;
#pragma unroll
            for (int bj = 0; bj < 2; ++bj) { f32x4 x0 = v[bj][0], x1 = v[bj][1];
                if (kind != 2) { x0.x = siluf_(x0.x); x0.y = siluf_(x0.y); x0.z = siluf_(x0.z); x0.w = siluf_(x0.w); x1.x = siluf_(x1.x); x1.y = siluf_(x1.y); x1.z = siluf_(x1.z); x1.w = siluf_(x1.w); }
                *(u32x4*)(dst + 32 * bj) = pk8(x0, x1); }
        }
        return;
    }
    {
        float* dst = (float*)(ws + WS_GATES) + (size_t)row * 24;
        if (fq < 3) {
#pragma unroll
            for (int n = 0; n < 2; ++n) { const f32x4 x = v[0][n]; f32x4 o; o.x = sigmoidf_(x.x); o.y = sigmoidf_(x.y); o.z = sigmoidf_(x.z); o.w = sigmoidf_(x.w); *(f32x4*)(dst + 8 * fq + 4 * n) = o; } }
    }
}
struct EpiInproj8 { const Params& p; static constexpr bool MIDSCALE = false; DEV float rowscale(int) const { return 1.f; } DEV int midk() const { return -1; }
    DEV void operator()(const f32x4 (&acc)[2][2][4][2], const pg8::Unit& u, int wr, int wc, int fr, int fq) const {
        const int seg = u.pn * 4 + wc;
        if (seg > 52) return;
#pragma unroll
        for (int ai = 0; ai < 2; ++ai)
#pragma unroll
            for (int m = 0; m < 4; ++m) { f32x4 v[2][2] = {{acc[ai][0][m][0], acc[ai][0][m][1]}, {acc[ai][1][m][0], acc[ai][1][m][1]}};
                inproj_row(p, seg, u.pm * 256 + ai * 128 + wr * 64 + m * 16 + fr, v, fq); }
    } };
DEV void phase_inproj(const Params& p, unsigned char* lds) {
    pg8::Gemm g{(const bf16_t*)(p.ws + WS_R1), (const bf16_t*)(p.ws + WS_WINT), NTOK, INP, DM};
    pg8::StaticOrder S; S.init(NTOK, INP, (int)gridDim.x, (int)blockIdx.x);
    EpiInproj8 E{p};
    pg8::gemm_phase(( PG8_LAS unsigned char*)lds, g, S, E);
}

struct ACmp { const bf16_t* src; int bg, c0;
    DEV const bf16_t* row(int r) const { int c = c0 + r; if (c > NC - 1) c = NC - 1; return src + ((size_t)bg * SEQ + 16 * c) * 64; } };
struct EpiCmpA { const Params& p; int z, rbase;
    DEV void operator()(f32x4 (&acc)[4][4], int wr, int wc, int lane) const {
        const int frow = lane & 15, fq = lane >> 4;
        const float* cb = (const float*)(p.ws + WS_CBIAS) + z * 256; bf16_t* hid = (bf16_t*)(p.ws + WS_HID) + (size_t)z * 4096 * 256;
#pragma unroll
        for (int m = 0; m < 4; ++m) { const int rr = rbase + wr * 64 + m * 16 + frow;
#pragma unroll
            for (int n = 0; n < 4; ++n) { const int c = wc * 64 + n * 16 + fq * 4; const f32x4 b = *(const f32x4*)(cb + c); f32x4 v = acc[m][n] + b;
                u32x2 w; w.x = pk2(siluf_(v.x), siluf_(v.y)); w.y = pk2(siluf_(v.z), siluf_(v.w)); *(u32x2*)(hid + (size_t)rr * 256 + c) = w; } }
    } };
DEV void phase_cmp_a(const Params& p, unsigned char* lds) {
    const int vb = vblock(), G = gridDim.x;
    for (int u = vb; u < 64; u += G) {
        const int z = u >> 5, rbase = (u & 31) * 128;
        ACmp al{(const bf16_t*)(p.ws + (z ? WS_VC : WS_KC)), (u & 31) >> 1, (u & 1) * 128};
        BRows bl{(const bf16_t*)(p.ws + WS_CW1T) + (size_t)z * 256 * 2048, 2048};
        EpiCmpA ep{p, z, rbase};
        gemm_tile(lds, al, bl, 2048 / 64, ep);
    }
}
struct BClamp64 { const bf16_t* base; size_t ld; DEV const bf16_t* ptr(int n, int kt) const { return base + (size_t)(n & 63) * ld + kt * 64; } };
struct EpiCmpB { const Params& p; int z, rbase;
    DEV void operator()(f32x4 (&acc)[4][4], int wr, int wc, int lane) const {
        if (wc != 0) return;
        const int frow = lane & 15, fq = lane >> 4;
        bf16_t* dst = (bf16_t*)(p.ws + (z ? WS_VCMP : WS_KCMP));
#pragma unroll
        for (int m = 0; m < 4; ++m) { const int rr = rbase + wr * 64 + m * 16 + frow;
            float r = 1.f;
            if (z == 0) { float ss = 0.f;
#pragma unroll
                for (int n = 0; n < 4; ++n) { const f32x4 v = acc[m][n]; ss += (v.x * v.x + v.y * v.y) + (v.z * v.z + v.w * v.w); }
                ss += __shfl_xor(ss, 16); ss += __shfl_xor(ss, 32); r = rsqrtf(ss * (1.f / 64.f) + RMS_EPS); }
            const int bg = rr >> 8, c = rr & 255;
            if (c < NC) {
#pragma unroll
                for (int n = 0; n < 4; ++n) { const int d = n * 16 + fq * 4; f32x4 v = acc[m][n] * r;
                    if (z == 0) { const f32x4 g = *(const f32x4*)(p.g_k + d); v = v * g;
                        u32x2 w; w.x = pk2(v.x, v.y); w.y = pk2(v.z, v.w); *(u32x2*)(dst + ((size_t)bg * 256 + c) * 64 + d) = w; }
                    else { bf16_t* o = dst + ((size_t)bg * 64 + d) * 256 + c; o[0] = f2bf(v.x); o[256] = f2bf(v.y); o[512] = f2bf(v.z); o[768] = f2bf(v.w); } } }
        }
    } };
DEV void phase_cmp_b(const Params& p, unsigned char* lds) {
    const int vb = vblock(), G = gridDim.x;
    for (int u = vb; u < 64; u += G) {
        const int z = u >> 5, rbase = (u & 31) * 128;
        ARows al{(const bf16_t*)(p.ws + WS_HID) + ((size_t)z * 4096 + rbase) * 256, 256};
        BClamp64 bl{(const bf16_t*)(p.ws + WS_CW2T) + (size_t)z * 64 * 256, 256};
        EpiCmpB ep{p, z, rbase};
        gemm_tile(lds, al, bl, 256 / 64, ep);
    }
}

constexpr int CM_K = 0, CM_V = 32768, CM_VSTR = 520, CM_IMP = CM_V + 64 * CM_VSTR, CM_LDS = CM_IMP + 4 * 16384 + 1024;
DEV void cm_scores(const unsigned char* kbase, int kt, const bf16x8 (&qf)[4], int r31, int hh, f32x16 (&sacc)[2]) {
#pragma unroll
    for (int kt2 = 0; kt2 < 2; ++kt2) {
#pragma unroll
        for (int i = 0; i < 16; ++i) sacc[kt2][i] = 0.f;
        const int row = 64 * kt + 32 * kt2 + r31; const int sx = (row >> 1) & 7;
#pragma unroll
        for (int s = 0; s < 4; ++s) { const bf16x8 kf = *(const bf16x8*)(kbase + row * 128 + (((2 * s + hh) ^ sx) << 4));
            sacc[kt2] = __builtin_amdgcn_mfma_f32_32x32x16_bf16(kf, qf[s], sacc[kt2], 0, 0, 0); }
    }
}
DEV void phase_cmp_attn(const Params& p, unsigned char* lds) {
    const int tid = threadIdx.x, lane = tid & 63, wid = tid >> 6;
    const int vb = vblock(), G = gridDim.x;
    unsigned char* ws = p.ws;
    const int r31 = lane & 31, hh = lane >> 5;
    float* impl = (float*)(lds + CM_IMP);
    for (int it = vb; it < 1024; it += G) {
        const int rnd = it / G, pos = it % G; int sidx = (rnd & 1) ? (rnd * G + (G - 1 - pos)) : (rnd * G + pos); if (G != 256) sidx = it;
        const int ci = 63 - (sidx >> 4), bg = sidx & 15, b = bg >> 1, g = bg & 1;
        const int nvis = min(NC, 4 * ci + 3), ntile = (nvis + 63) >> 6;
        const int head = g * 4 + (wid >> 1);
        const int tokl = (wid & 1) * 32 + r31, t = ci * 64 + tokl;
        const size_t tok = (size_t)b * SEQ + t;
        const int nv = t >= 31 ? min(NC, (t - 31) / 16 + 1) : 0;
        __syncthreads();
        {
            const bf16_t* kc = (const bf16_t*)(ws + WS_KCMP) + (size_t)bg * 256 * 64; const bf16_t* vt = (const bf16_t*)(ws + WS_VCMP) + (size_t)bg * 64 * 256;
            const int cpr = ntile * 8;
            u32x4 rk[4], rv[4];
#pragma unroll
            for (int i = 0; i < 4; ++i) if (i < ntile) { const int idx = tid + NT * i; rk[i] = *(const u32x4*)(kc + (idx >> 3) * 64 + (idx & 7) * 8); const int d = idx / cpr, ck = idx % cpr; rv[i] = *(const u32x4*)(vt + d * 256 + ck * 8); }
#pragma unroll
            for (int i = 0; i < 4; ++i) if (i < ntile) { const int idx = tid + NT * i; *(u32x4*)(lds + CM_K + swz(idx >> 3, idx & 7)) = rk[i];
                const int d = idx / cpr, ck = idx % cpr; u32x2 a, c2; a.x = rv[i].x; a.y = rv[i].y; c2.x = rv[i].z; c2.y = rv[i].w; unsigned char* o = lds + CM_V + d * CM_VSTR + ck * 16; *(u32x2*)o = a; *(u32x2*)(o + 8) = c2; }
        }
        bf16x8 qf[4];
        { const bf16_t* qp = (const bf16_t*)(ws + WS_Q) + ((size_t)(b * 8 + head) * SEQ + t) * 64 + 8 * hh;
#pragma unroll
            for (int s = 0; s < 4; ++s) qf[s] = *(const bf16x8*)(qp + 16 * s); }
        __syncthreads();
        float l_run = 0.f;
        f32x16 ot[2];
#pragma unroll
        for (int dt = 0; dt < 2; ++dt)
#pragma unroll
            for (int i = 0; i < 16; ++i) ot[dt][i] = 0.f;
        float carry = 0.f;
#pragma unroll
        for (int kt = 0; kt < 4; ++kt) if (kt < ntile) {
            f32x16 sacc[2];
            cm_scores(lds + CM_K, kt, qf, r31, hh, sacc);
#pragma unroll
            for (int kt2 = 0; kt2 < 2; ++kt2)
#pragma unroll
                for (int i = 0; i < 16; ++i) { const int c = 64 * kt + 32 * kt2 + (i & 3) + 8 * (i >> 2) + 4 * hh; const float e_ = (c < nv) ? __builtin_amdgcn_exp2f(sacc[kt2][i]) : 0.f; sacc[kt2][i] = e_; l_run += e_; }
            {
                float own[8], xs[8];
#pragma unroll
                for (int kt2 = 0; kt2 < 2; ++kt2)
#pragma unroll
                    for (int g4 = 0; g4 < 4; ++g4) { const float e3 = 0.5f * sacc[kt2][4 * g4 + 3];
                        own[4 * kt2 + g4] = (sacc[kt2][4 * g4] + sacc[kt2][4 * g4 + 1]) + (sacc[kt2][4 * g4 + 2] + e3); xs[4 * kt2 + g4] = __shfl_xor(e3, 32); }
                float* io = impl + (wid >> 1) * 4096 + tokl * 64 + 16 * kt + hh;
#pragma unroll
                for (int gi = 0; gi < 8; ++gi) io[2 * gi] = own[gi] + (hh ? xs[gi] : (gi > 0 ? xs[gi > 0 ? gi - 1 : 0] : carry));
                carry = xs[7];
            }
#pragma unroll
            for (int kt2 = 0; kt2 < 2; ++kt2)
#pragma unroll
                for (int s2 = 0; s2 < 2; ++s2) {
                    bf16x8 pf; { u32x4 w; w.x = pk2(sacc[kt2][8 * s2 + 0], sacc[kt2][8 * s2 + 1]); w.y = pk2(sacc[kt2][8 * s2 + 2], sacc[kt2][8 * s2 + 3]);
                        w.z = pk2(sacc[kt2][8 * s2 + 4], sacc[kt2][8 * s2 + 5]); w.w = pk2(sacc[kt2][8 * s2 + 6], sacc[kt2][8 * s2 + 7]); pf = __builtin_bit_cast(bf16x8, w); }
#pragma unroll
                    for (int dt = 0; dt < 2; ++dt) {
                        const unsigned char* va = lds + CM_V + (32 * dt + r31) * CM_VSTR + (64 * kt + 32 * kt2 + 16 * s2 + 4 * hh) * 2;
                        const u32x2 lo = *(const u32x2*)(va), hi = *(const u32x2*)(va + 16);
                        u32x4 w; w.x = lo.x; w.y = lo.y; w.z = hi.x; w.w = hi.y;
                        ot[dt] = __builtin_amdgcn_mfma_f32_32x32x16_bf16(__builtin_bit_cast(bf16x8, w), pf, ot[dt], 0, 0, 0);
                    }
                }
        }
        float invL; { const float L = l_run + __shfl_xor(l_run, 32); invL = L > 0.f ? 1.f / L : 0.f; }
        if (hh == 0) impl[16384 + (wid >> 1) * 64 + tokl] = invL;
        {
            const float sc = ((const float*)(ws + WS_GATES))[tok * 24 + head * 3 + 0] * invL;
            bf16_t* ocp = (bf16_t*)(ws + WS_OC) + tok * 512 + head * 64;
#pragma unroll
            for (int dt = 0; dt < 2; ++dt)
#pragma unroll
                for (int g4 = 0; g4 < 4; ++g4) { const int d0 = 32 * dt + 8 * g4 + 4 * hh;
                    u32x2 w; w.x = pk2(ot[dt][4 * g4 + 0] * sc, ot[dt][4 * g4 + 1] * sc); w.y = pk2(ot[dt][4 * g4 + 2] * sc, ot[dt][4 * g4 + 3] * sc); *(u32x2*)(ocp + d0) = w; }
        }
        __syncthreads();
        for (int tt = 0; tt < 8; ++tt) {
            const int tl = wid * 8 + tt, cur = ci;
            unsigned long long mask;
            if (cur < 16) mask = (2ull << cur) - 1ull;
            else {
                const bool valid = lane <= cur;
                const float imp = (impl[tl * 64 + lane] * impl[16384 + tl] + impl[4096 + tl * 64 + lane] * impl[16384 + 64 + tl]) + (impl[8192 + tl * 64 + lane] * impl[16384 + 128 + tl] + impl[12288 + tl * 64 + lane] * impl[16384 + 192 + tl]);
                const unsigned key = (lane == 0 || lane == cur) ? 0x7F800000u : __float_as_uint(imp);
                unsigned T = 0u;
                for (int bit = 30; bit >= 0; --bit) { const unsigned cand = T | (1u << bit); if (__popcll(__ballot(valid && key >= cand)) >= 16) T = cand; }
                const unsigned long long gt = __ballot(valid && key > T), eq = __ballot(valid && key == T);
                const int need = 16 - __popcll(gt);
                const int below = __popcll(eq & ((1ull << lane) - 1ull));
                mask = gt | __ballot(valid && key == T && below < need);
            }
            if (lane == 0) ((unsigned long long*)(ws + WS_SELM))[(size_t)bg * SEQ + ci * 64 + tl] = mask;
        }
    }
}

constexpr int FA_KB = 64 * 128, FA_VB = 64 * 136, FA_STAGE = FA_KB + FA_VB, FA_LDS = 2 * FA_STAGE + 1024;
template <bool SEL>
DEV void fa_branch(unsigned char* lds, const bf16_t* Kb, const bf16_t* VTb, int ci, int bg, const bf16x8 (&qf)[4], int t, unsigned long long mymask, unsigned long long need,
                   f32x16 (&ot)[2], float& m_run, float& l_run) {
    const int tid = threadIdx.x, lane = tid & 63;
    const int r31 = lane & 31, hh = lane >> 5;
    const int lrow = tid >> 3, lch = tid & 7;
    const bf16_t* kg = Kb + ((size_t)bg * SEQ + lrow) * 64 + lch * 8;
    const bf16_t* vg = VTb + ((size_t)bg * 64 + lrow) * SEQ + lch * 8;
    const int koff = lrow * 128 + ((lch ^ ((lrow >> 1) & 7)) << 4), voff = FA_KB + lrow * 136 + lch * 16;
    int jlo, jhi; unsigned long long todo;
    if (SEL) { todo = need; jlo = 0; jhi = ci; } else { jlo = ci >= 8 ? ci - 8 : 0; jhi = ci; todo = 0; }
    int j = jlo;
    if (SEL) { if (todo == 0) return; j = __builtin_ctzll(todo); todo &= todo - 1; }
    u32x4 rk = *(const u32x4*)(kg + (size_t)j * 64 * 64), rv = *(const u32x4*)(vg + (size_t)j * 64);
    __syncthreads();
    *(u32x4*)(lds + koff) = rk; { u32x2 a, b2; a.x = rv.x; a.y = rv.y; b2.x = rv.z; b2.y = rv.w; *(u32x2*)(lds + voff) = a; *(u32x2*)(lds + voff + 8) = b2; }
    __syncthreads();
    int st = 0; bool seen = false;
    for (;;) {
        int jn; bool more;
        if (SEL) { more = (todo != 0); jn = more ? __builtin_ctzll(todo) : 0; todo &= todo - 1; } else { jn = j + 1; more = (jn <= jhi); }
        if (more) { rk = *(const u32x4*)(kg + (size_t)jn * 64 * 64); rv = *(const u32x4*)(vg + (size_t)jn * 64); }
        const unsigned char* base = lds + st * FA_STAGE;
        const bool bit = SEL ? ((mymask >> j) & 1ull) != 0 : true;
        const float cinit = (SEL && !bit) ? -__builtin_inff() : -m_run;
        f32x16 sacc[2];
#pragma unroll
        for (int kt2 = 0; kt2 < 2; ++kt2) {
#pragma unroll
            for (int i = 0; i < 16; ++i) sacc[kt2][i] = cinit;
            const int row = 32 * kt2 + r31; const int sx = (row >> 1) & 7;
#pragma unroll
            for (int s = 0; s < 4; ++s) { const bf16x8 kf = *(const bf16x8*)(base + row * 128 + (((2 * s + hh) ^ sx) << 4));
                sacc[kt2] = __builtin_amdgcn_mfma_f32_32x32x16_bf16(kf, qf[s], sacc[kt2], 0, 0, 0); }
        }
        const bool boundary = SEL ? (j == ci) : (j == ci || j + 8 <= ci);
        float mx = -__builtin_inff();
        if (boundary) {
#pragma unroll
            for (int kt2 = 0; kt2 < 2; ++kt2)
#pragma unroll
                for (int i = 0; i < 16; ++i) { const int key = 64 * j + 32 * kt2 + (i & 3) + 8 * (i >> 2) + 4 * hh;
                    const bool ok = SEL ? (key <= t) : (key <= t && t - key < 512);
                    const float v = ok ? sacc[kt2][i] : -__builtin_inff(); sacc[kt2][i] = v; mx = fmaxf(mx, v); }
        } else {
#pragma unroll
            for (int kt2 = 0; kt2 < 2; ++kt2)
#pragma unroll
                for (int i = 0; i < 16; ++i) mx = fmaxf(mx, sacc[kt2][i]);
        }
        mx = fmaxf(mx, __shfl_xor(mx, 32));
        const bool live = mx > -__builtin_inff();
        const bool need = (mx > 8.f) || (!seen && live && mx < -8.f);
        if (__any(need)) {
            const float d = need ? mx : 0.f;
            const float alpha = d > 0.f ? __builtin_amdgcn_exp2f(-d) : 1.f;
            m_run += d; l_run *= alpha;
#pragma unroll
            for (int dt = 0; dt < 2; ++dt)
#pragma unroll
                for (int i = 0; i < 16; ++i) ot[dt][i] *= alpha;
#pragma unroll
            for (int kt2 = 0; kt2 < 2; ++kt2)
#pragma unroll
                for (int i = 0; i < 16; ++i) sacc[kt2][i] -= d;
        }
        seen = seen || live;
        float rs = 0.f;
#pragma unroll
        for (int kt2 = 0; kt2 < 2; ++kt2)
#pragma unroll
            for (int i = 0; i < 16; ++i) { const float e = __builtin_amdgcn_exp2f(sacc[kt2][i]); sacc[kt2][i] = e; rs += e; }
        l_run += rs;
#pragma unroll
        for (int kt2 = 0; kt2 < 2; ++kt2)
#pragma unroll
            for (int s2 = 0; s2 < 2; ++s2) {
                bf16x8 pf; { u32x4 w; w.x = pk2(sacc[kt2][8 * s2 + 0], sacc[kt2][8 * s2 + 1]); w.y = pk2(sacc[kt2][8 * s2 + 2], sacc[kt2][8 * s2 + 3]);
                    w.z = pk2(sacc[kt2][8 * s2 + 4], sacc[kt2][8 * s2 + 5]); w.w = pk2(sacc[kt2][8 * s2 + 6], sacc[kt2][8 * s2 + 7]); pf = __builtin_bit_cast(bf16x8, w); }
#pragma unroll
                for (int dt = 0; dt < 2; ++dt) {
                    const unsigned char* va = base + FA_KB + (32 * dt + r31) * 136 + (32 * kt2 + 16 * s2 + 4 * hh) * 2;
                    const u32x2 lo = *(const u32x2*)(va), hi = *(const u32x2*)(va + 16);
                    u32x4 w; w.x = lo.x; w.y = lo.y; w.z = hi.x; w.w = hi.y;
                    ot[dt] = __builtin_amdgcn_mfma_f32_32x32x16_bf16(__builtin_bit_cast(bf16x8, w), pf, ot[dt], 0, 0, 0);
                }
            }
        if (!more) break;
        { unsigned char* nb = lds + (st ^ 1) * FA_STAGE; *(u32x4*)(nb + koff) = rk; u32x2 a, b2; a.x = rv.x; a.y = rv.y; b2.x = rv.z; b2.y = rv.w; *(u32x2*)(nb + voff) = a; *(u32x2*)(nb + voff + 8) = b2; }
        __syncthreads();
        st ^= 1; j = jn;
    }
}
DEV void phase_flash(const Params& p, unsigned char* lds) {
    const int tid = threadIdx.x, lane = tid & 63, wid = tid >> 6;
    const int vb = vblock(), G = gridDim.x;
    unsigned char* ws = p.ws;
    const int r31 = lane & 31, hh = lane >> 5;
    unsigned long long* red = (unsigned long long*)(lds + 2 * FA_STAGE);
    for (int it = vb; it < 1024; it += G) {
        const int rnd = it / G, pos = it % G; int sidx = (rnd & 1) ? (rnd * G + (G - 1 - pos)) : (rnd * G + pos); if (G != 256) sidx = it;
        const int ci = 63 - (sidx >> 4), bg = sidx & 15, b = bg >> 1, g = bg & 1;
        const int head = g * 4 + (wid >> 1);
        const int t = ci * 64 + (wid & 1) * 32 + r31;
        const size_t tok = (size_t)b * SEQ + t;
        bf16x8 qf[4];
        { const bf16_t* qp = (const bf16_t*)(ws + WS_Q) + ((size_t)(b * 8 + head) * SEQ + t) * 64 + 8 * hh;
#pragma unroll
            for (int s = 0; s < 4; ++s) qf[s] = *(const bf16x8*)(qp + 16 * s); }
        const unsigned long long mymask = ((const unsigned long long*)(ws + WS_SELM))[(size_t)bg * SEQ + t];
        unsigned long long orm = mymask;
#pragma unroll
        for (int o = 1; o < 32; o <<= 1) { const unsigned lo = __shfl_xor((unsigned)orm, o), hi = __shfl_xor((unsigned)(orm >> 32), o); orm |= ((unsigned long long)hi << 32) | lo; }
        __syncthreads();
        if (wid < 2 && lane == 0) red[wid] = orm;
        __syncthreads();
        const unsigned long long need = red[0] | red[1];
        f32x16 oc[2];
        {
            f32x16 ot[2]; float m_run = 0.f, l_run = 0.f;
#pragma unroll
            for (int dt = 0; dt < 2; ++dt)
#pragma unroll
                for (int i = 0; i < 16; ++i) ot[dt][i] = 0.f;
            fa_branch<true>(lds, (const bf16_t*)(ws + WS_KS), (const bf16_t*)(ws + WS_VST), ci, bg, qf, t, mymask, need, ot, m_run, l_run);
            const float lt = l_run + __shfl_xor(l_run, 32);
            const float sc = ((const float*)(ws + WS_GATES))[tok * 24 + head * 3 + 1] / lt;
#pragma unroll
            for (int dt = 0; dt < 2; ++dt)
#pragma unroll
                for (int i = 0; i < 16; ++i) oc[dt][i] = ot[dt][i] * sc;
        }
        {
            f32x16 ot[2]; float m_run = 0.f, l_run = 0.f;
#pragma unroll
            for (int dt = 0; dt < 2; ++dt)
#pragma unroll
                for (int i = 0; i < 16; ++i) ot[dt][i] = 0.f;
            fa_branch<false>(lds, (const bf16_t*)(ws + WS_KW), (const bf16_t*)(ws + WS_VWT), ci, bg, qf, t, 0ull, 0ull, ot, m_run, l_run);
            const float lt = l_run + __shfl_xor(l_run, 32);
            const float sc = ((const float*)(ws + WS_GATES))[tok * 24 + head * 3 + 2] / lt;
#pragma unroll
            for (int dt = 0; dt < 2; ++dt)
#pragma unroll
                for (int i = 0; i < 16; ++i) oc[dt][i] += ot[dt][i] * sc;
        }
        {
            const bf16_t* ocp = (const bf16_t*)(ws + WS_OC) + tok * 512 + head * 64;
            bf16_t* mix = (bf16_t*)(ws + WS_R1) + tok * 1024 + head * 64;
            float ss = 0.f;
#pragma unroll
            for (int dt = 0; dt < 2; ++dt)
#pragma unroll
                for (int g4 = 0; g4 < 4; ++g4) { const int d0 = 32 * dt + 8 * g4 + 4 * hh; const u32x2 c = *(const u32x2*)(ocp + d0);
                    const float v0 = oc[dt][4 * g4 + 0] + bflo(c.x), v1 = oc[dt][4 * g4 + 1] + bfhi(c.x), v2 = oc[dt][4 * g4 + 2] + bflo(c.y), v3 = oc[dt][4 * g4 + 3] + bfhi(c.y);
                    ss += (v0 * v0 + v1 * v1) + (v2 * v2 + v3 * v3);
                    u32x2 w; w.x = pk2(v0, v1); w.y = pk2(v2, v3); *(u32x2*)(mix + d0) = w; }
            ss += __shfl_xor(ss, 32);
            if (hh == 0) atomicAdd((float*)(ws + WS_ROWSS) + tok, ss);
        }
    }
}

DEV int swz256(int row, int chunk) { return row * 256 + ((chunk ^ (row & 15)) << 4); }
DEV void hgrn_cumsum(const Params& p, int bh, int c, float* segs, f32x2 (&lf)[8], f32x2 (&a)[8], f32x2& r, f32x2& alast) {
    const int tid = threadIdx.x, k2 = tid & 63, tq = tid >> 6;
    const int b = bh >> 2, h = bh & 3;
    const float* HL = (const float*)(p.ws + WS_HLOGF) + ((size_t)b * SEQ + c * 64 + tq * 8) * 512 + h * 128 + 2 * k2;
#pragma unroll
    for (int i = 0; i < 8; ++i) lf[i] = *(const f32x2*)(HL + (size_t)i * 512);
    f32x2 run = (f32x2){0.f, 0.f};
#pragma unroll
    for (int i = 0; i < 8; ++i) { run = run + lf[i]; a[i] = run; }
    *(f32x2*)(segs + tq * 128 + 2 * k2) = run;
    __syncthreads();
    f32x2 off = (f32x2){0.f, 0.f}, tot = off, rr = off;
#pragma unroll
    for (int q = 0; q < 8; ++q) { const f32x2 s = *(const f32x2*)(segs + q * 128 + 2 * k2); if (q < tq) off = off + s; if (q < 4) rr = rr + s; tot = tot + s; }
#pragma unroll
    for (int i = 0; i < 8; ++i) a[i] = a[i] + off;
    r = rr; alast = tot;
}
DEV void hgrn_stage_vt(const Params& p, int bh, int c, unsigned char* vt) {
    const int tid = threadIdx.x, k2 = tid & 63, tq = tid >> 6;
    const int b = bh >> 2, h = bh & 3;
    const bf16_t* HV = (const bf16_t*)(p.ws + WS_HV) + ((size_t)b * SEQ + c * 64 + tq * 8) * 512 + h * 128 + 2 * k2;
    unsigned vv[8];
#pragma unroll
    for (int i = 0; i < 8; ++i) vv[i] = *(const unsigned*)(HV + (size_t)i * 512);
    u32x4 lo, hi;
    lo.x = (vv[0] & 0xffffu) | (vv[1] << 16); lo.y = (vv[2] & 0xffffu) | (vv[3] << 16); lo.z = (vv[4] & 0xffffu) | (vv[5] << 16); lo.w = (vv[6] & 0xffffu) | (vv[7] << 16);
    hi.x = (vv[0] >> 16) | (vv[1] & 0xffff0000u); hi.y = (vv[2] >> 16) | (vv[3] & 0xffff0000u); hi.z = (vv[4] >> 16) | (vv[5] & 0xffff0000u); hi.w = (vv[6] >> 16) | (vv[7] & 0xffff0000u);
    *(u32x4*)(vt + swz(2 * k2, tq)) = lo; *(u32x4*)(vt + swz(2 * k2 + 1, tq)) = hi;
}
constexpr int H1_KT = 0, H1_VT = 16384, H1_SEG = 32768, H1_EK = H1_SEG + 4096;
DEV void phase_hgrn_a1(const Params& p, unsigned char* lds, int vb0, int nb) {
    const int tid = threadIdx.x, lane = tid & 63, wid = tid >> 6, k2 = tid & 63, tq = tid >> 6;
    const int vb = vblock(), G = gridDim.x;
    const int frow = lane & 15, fq = lane >> 4, wr = wid >> 1, wc = wid & 1;
    float* segs = (float*)(lds + H1_SEG); float* ek = (float*)(lds + H1_EK);
    bf16_t* ubuf = (bf16_t*)(p.ws + WS_UBUF); float* dbuf = (float*)(p.ws + WS_DBUF);
    if (vb < vb0) return;
    for (int item = vb - vb0; item < 2048; item += nb) {
        const int bh = item >> 6, c = item & 63;
        __syncthreads();
        f32x2 lf[8], a[8], r, al;
        hgrn_cumsum(p, bh, c, segs, lf, a, r, al);
        {
            float kx[8], ky[8];
#pragma unroll
            for (int i = 0; i < 8; ++i) { kx[i] = (1.f - __expf(lf[i].x)) * __expf(fminf(r.x - a[i].x, 80.f)); ky[i] = (1.f - __expf(lf[i].y)) * __expf(fminf(r.y - a[i].y, 80.f)); }
            u32x4 w0, w1;
            w0.x = pk2(kx[0], kx[1]); w0.y = pk2(kx[2], kx[3]); w0.z = pk2(kx[4], kx[5]); w0.w = pk2(kx[6], kx[7]);
            w1.x = pk2(ky[0], ky[1]); w1.y = pk2(ky[2], ky[3]); w1.z = pk2(ky[4], ky[5]); w1.w = pk2(ky[6], ky[7]);
            *(u32x4*)(lds + H1_KT + swz(2 * k2, tq)) = w0; *(u32x4*)(lds + H1_KT + swz(2 * k2 + 1, tq)) = w1;
        }
        hgrn_stage_vt(p, bh, c, lds + H1_VT);
        if (tq == 7) { ek[2 * k2] = __expf(al.x - r.x); ek[2 * k2 + 1] = __expf(al.y - r.y); f32x2 d; d.x = __expf(al.x); d.y = __expf(al.y); *(f32x2*)(dbuf + (size_t)item * 128 + 2 * k2) = d; }
        __syncthreads();
        f32x4 acc[2][4];
#pragma unroll
        for (int m = 0; m < 2; ++m)
#pragma unroll
            for (int n = 0; n < 4; ++n) acc[m][n] = (f32x4){0.f, 0.f, 0.f, 0.f};
        const int sx = (frow >> 1) & 7;
#pragma unroll
        for (int ks = 0; ks < 2; ++ks) {
            const int co = ((ks * 4 + fq) ^ sx) << 4;
            bf16x8 af[2], bfr[4];
#pragma unroll
            for (int m = 0; m < 2; ++m) af[m] = *(const bf16x8*)(lds + H1_VT + (32 * wr + 16 * m + frow) * 128 + co);
#pragma unroll
            for (int n = 0; n < 4; ++n) bfr[n] = *(const bf16x8*)(lds + H1_KT + (64 * wc + 16 * n + frow) * 128 + co);
#pragma unroll
            for (int m = 0; m < 2; ++m)
#pragma unroll
                for (int n = 0; n < 4; ++n) acc[m][n] = __builtin_amdgcn_mfma_f32_16x16x32_bf16(bfr[n], af[m], acc[m][n], 0, 0, 0);
        }
#pragma unroll
        for (int m = 0; m < 2; ++m) { const int v = 32 * wr + 16 * m + frow;
#pragma unroll
            for (int n = 0; n < 4; ++n) { const int k0 = 64 * wc + 16 * n + 4 * fq; const f32x4 e = *(const f32x4*)(ek + k0); const f32x4 o = acc[m][n] * e;
                u32x2 w; w.x = pk2(o.x, o.y); w.y = pk2(o.z, o.w); *(u32x2*)(ubuf + ((size_t)item * 128 + v) * 128 + k0) = w; } }
    }
}
DEV void phase_hgrn_a2(const Params& p, unsigned char* lds) {
    const int G = gridDim.x;
    bf16_t* ubuf = (bf16_t*)(p.ws + WS_UBUF); const float* dbuf = (const float*)(p.ws + WS_DBUF);
    for (int gid = blockIdx.x * NT + threadIdx.x; gid < 131072; gid += G * NT) {
        const int bh = gid >> 12, v = (gid >> 5) & 127, k4 = gid & 31;
        bf16_t* u = ubuf + ((size_t)bh * 64 * 128 + v) * 128 + 4 * k4;
        const float* d = dbuf + (size_t)bh * 64 * 128 + 4 * k4;
        f32x4 S = (f32x4){0.f, 0.f, 0.f, 0.f};
        for (int c0 = 0; c0 < 64; c0 += 8) {
            u32x2 uu[8]; f32x4 dd[8];
#pragma unroll
            for (int j = 0; j < 8; ++j) { uu[j] = *(const u32x2*)(u + (size_t)(c0 + j) * 16384); dd[j] = *(const f32x4*)(d + (size_t)(c0 + j) * 128); }
#pragma unroll
            for (int j = 0; j < 8; ++j) { u32x2 w; w.x = pk2(S.x, S.y); w.y = pk2(S.z, S.w); *(u32x2*)(u + (size_t)(c0 + j) * 16384) = w;
                S.x = dd[j].x * S.x + bflo(uu[j].x); S.y = dd[j].y * S.y + bfhi(uu[j].x); S.z = dd[j].z * S.z + bflo(uu[j].y); S.w = dd[j].w * S.w + bfhi(uu[j].y); }
        }
    }
}
constexpr int H3_QH = 0, H3_QA = 16384, H3_KH = 32768, H3_VT = 49152, H3_PP = 65536, H3_ST = 73728, H3_SEG = 106496, H3_RED = 110592;
DEV void phase_hgrn_a3(const Params& p, unsigned char* lds) {
    const int tid = threadIdx.x, lane = tid & 63, wid = tid >> 6, k2 = tid & 63, tq = tid >> 6;
    const int vb = vblock(), G = gridDim.x;
    const int frow = lane & 15, fq = lane >> 4;
    float* segs = (float*)(lds + H3_SEG); float* red = (float*)(lds + H3_RED);
    const bf16_t* ubuf = (const bf16_t*)(p.ws + WS_UBUF);
    for (int item = vb; item < 2048; item += G) {
        const int bh = item >> 6, c = item & 63, b = bh >> 2, h = bh & 3;
        __syncthreads();
        f32x2 lf[8], a[8], r, al;
        hgrn_cumsum(p, bh, c, segs, lf, a, r, al);
        {
            const bf16_t* HQ = (const bf16_t*)(p.ws + WS_HQ) + ((size_t)b * SEQ + c * 64 + tq * 8) * 512 + h * 128 + 2 * k2;
            unsigned qq[8];
#pragma unroll
            for (int i = 0; i < 8; ++i) qq[i] = *(const unsigned*)(HQ + (size_t)i * 512);
#pragma unroll
            for (int i = 0; i < 8; ++i) { const int t = 8 * tq + i; const float q0 = bflo(qq[i]), q1 = bfhi(qq[i]);
                const int off = swz256(t, k2 >> 2) + (k2 & 3) * 4;
                *(unsigned*)(lds + H3_QH + off) = pk2(q0 * __expf(fminf(a[i].x - r.x, 80.f)), q1 * __expf(fminf(a[i].y - r.y, 80.f)));
                *(unsigned*)(lds + H3_QA + off) = pk2(q0 * __expf(a[i].x), q1 * __expf(a[i].y));
                *(unsigned*)(lds + H3_KH + off) = pk2((1.f - __expf(lf[i].x)) * __expf(fminf(r.x - a[i].x, 80.f)), (1.f - __expf(lf[i].y)) * __expf(fminf(r.y - a[i].y, 80.f))); }
        }
        hgrn_stage_vt(p, bh, c, lds + H3_VT);
        {
            const bf16_t* st = ubuf + (size_t)item * 16384;
#pragma unroll
            for (int i = 0; i < 4; ++i) { const int q = tid + NT * i, v = q >> 4, ch = q & 15; *(u32x4*)(lds + H3_ST + swz256(v, ch)) = *(const u32x4*)(st + v * 128 + ch * 8); }
        }
        __syncthreads();
        {
            const int wr = wid >> 1, wc = wid & 1;
            f32x4 acc[2];
            acc[0] = (f32x4){0.f, 0.f, 0.f, 0.f}; acc[1] = acc[0];
            if (32 * wc <= 16 * wr + 15) {
#pragma unroll
                for (int ks = 0; ks < 4; ++ks) {
                    const int co = ((ks * 4 + fq) ^ frow) << 4;
                    const bf16x8 af = *(const bf16x8*)(lds + H3_QH + (16 * wr + frow) * 256 + co);
#pragma unroll
                    for (int n = 0; n < 2; ++n) { const bf16x8 bfr = *(const bf16x8*)(lds + H3_KH + (32 * wc + 16 * n + frow) * 256 + co);
                        acc[n] = __builtin_amdgcn_mfma_f32_16x16x32_bf16(bfr, af, acc[n], 0, 0, 0); }
                }
            }
            const int t = 16 * wr + frow;
#pragma unroll
            for (int n = 0; n < 2; ++n) { const int s0 = 32 * wc + 16 * n + 4 * fq; f32x4 v = acc[n];
                v.x = (s0 + 0 <= t) ? v.x : 0.f; v.y = (s0 + 1 <= t) ? v.y : 0.f; v.z = (s0 + 2 <= t) ? v.z : 0.f; v.w = (s0 + 3 <= t) ? v.w : 0.f;
                u32x2 w; w.x = pk2(v.x, v.y); w.y = pk2(v.z, v.w);
                *(u32x2*)(lds + H3_PP + t * 128 + ((((s0 >> 3)) ^ ((t >> 1) & 7)) << 4) + (s0 & 7) * 2) = w; }
        }
        __syncthreads();
        {
            const int wr = wid >> 2, wc = wid & 3;
            f32x4 acc[2][2];
#pragma unroll
            for (int m = 0; m < 2; ++m)
#pragma unroll
                for (int n = 0; n < 2; ++n) acc[m][n] = (f32x4){0.f, 0.f, 0.f, 0.f};
            const int sx = (frow >> 1) & 7;
#pragma unroll
            for (int ks = 0; ks < 2; ++ks) {
                const int co = ((ks * 4 + fq) ^ sx) << 4;
                bf16x8 af[2], bfr[2];
#pragma unroll
                for (int m = 0; m < 2; ++m) af[m] = *(const bf16x8*)(lds + H3_PP + (32 * wr + 16 * m + frow) * 128 + co);
#pragma unroll
                for (int n = 0; n < 2; ++n) bfr[n] = *(const bf16x8*)(lds + H3_VT + (32 * wc + 16 * n + frow) * 128 + co);
#pragma unroll
                for (int m = 0; m < 2; ++m)
#pragma unroll
                    for (int n = 0; n < 2; ++n) acc[m][n] = __builtin_amdgcn_mfma_f32_16x16x32_bf16(bfr[n], af[m], acc[m][n], 0, 0, 0);
            }
#pragma unroll
            for (int ks = 0; ks < 4; ++ks) {
                const int co = ((ks * 4 + fq) ^ frow) << 4;
                bf16x8 af[2], bfr[2];
#pragma unroll
                for (int m = 0; m < 2; ++m) af[m] = *(const bf16x8*)(lds + H3_QA + (32 * wr + 16 * m + frow) * 256 + co);
#pragma unroll
                for (int n = 0; n < 2; ++n) bfr[n] = *(const bf16x8*)(lds + H3_ST + (32 * wc + 16 * n + frow) * 256 + co);
#pragma unroll
                for (int m = 0; m < 2; ++m)
#pragma unroll
                    for (int n = 0; n < 2; ++n) acc[m][n] = __builtin_amdgcn_mfma_f32_16x16x32_bf16(bfr[n], af[m], acc[m][n], 0, 0, 0);
            }
#pragma unroll
            for (int m = 0; m < 2; ++m) { float ss = 0.f;
#pragma unroll
                for (int n = 0; n < 2; ++n) { const f32x4 v = acc[m][n]; ss += (v.x * v.x + v.y * v.y) + (v.z * v.z + v.w * v.w); }
                ss += __shfl_xor(ss, 16); ss += __shfl_xor(ss, 32);
                if (fq == 0) red[(32 * wr + 16 * m + frow) * 4 + wc] = ss; }
            __syncthreads();
#pragma unroll
            for (int m = 0; m < 2; ++m) { const int t = 32 * wr + 16 * m + frow; const f32x4 q4 = *(const f32x4*)(red + t * 4);
                const float rs = rsqrtf(((q4.x + q4.y) + (q4.z + q4.w)) * (1.f / 128.f) + RMS_EPS);
                const size_t row = (size_t)b * SEQ + c * 64 + t;
#pragma unroll
                for (int n = 0; n < 2; ++n) { const int v0 = 32 * wc + 16 * n + 4 * fq; const f32x4 gn = *(const f32x4*)(p.g_hn + v0);
                    const u32x2 gg = *(const u32x2*)((const bf16_t*)(p.ws + WS_HG) + row * 512 + h * 128 + v0);
                    const f32x4 o = acc[m][n];
                    u32x2 w; w.x = pk2(o.x * rs * gn.x * bflo(gg.x), o.y * rs * gn.y * bfhi(gg.x)); w.y = pk2(o.z * rs * gn.z * bflo(gg.y), o.w * rs * gn.w * bfhi(gg.y));
                    *(u32x2*)((bf16_t*)(p.ws + WS_R1) + row * 1024 + 512 + h * 128 + v0) = w; } }
        }
    }
}

DEV void phase_normalize(const Params& p, unsigned char* lds) {
    const int vb = vblock(), G = gridDim.x;
    unsigned char* ws = p.ws;
    __syncthreads();
    {
        float* tl = (float*)lds;
        for (int r = vb; r < 32 * 4 * 16; r += G) { const int e = r / 64, q = r % 64; SrcW13_4 s{p.w1 + (size_t)e * 1024 * 512, p.w3 + (size_t)e * 1024 * 512, p.ffn_g};
            convert_tile256(tl, s, (bf16_t*)(ws + WS_W13T) + (size_t)e * 1024 * 1024, 1024, (q / 16) * 256, (q % 16) * 64); }
    }
}

struct EpiOut8 { const Params& p; static constexpr bool MIDSCALE = true;
    DEV float rowscale(int row) const { return rsqrtf(((const float*)(p.ws + WS_ROWSS))[row] * (1.f / 512.f) + RMS_EPS); }
    DEV int midk() const { return 8; }
    DEV void operator()(const f32x4 (&acc)[2][2][4][2], const pg8::Unit& u, int wr, int wc, int fr, int fq) const {
#pragma unroll
        for (int ai = 0; ai < 2; ++ai)
#pragma unroll
            for (int m = 0; m < 4; ++m) { const size_t row = (size_t)u.pm * 256 + ai * 128 + wr * 64 + m * 16 + fr;
#pragma unroll
                for (int bj = 0; bj < 2; ++bj)
#pragma unroll
                    for (int n = 0; n < 2; ++n) { const int c = u.pn * 256 + 64 * wc + 32 * bj + 8 * fq + 4 * n; const f32x4 xv = *(const f32x4*)(p.x + row * DM + c); *(f32x4*)(p.out + row * DM + c) = xv + acc[ai][bj][m][n]; } }
    } };
DEV void phase_outproj(const Params& p, unsigned char* lds) {
    pg8::Gemm g{(const bf16_t*)(p.ws + WS_R1), (const bf16_t*)(p.ws + WS_WOUTT), NTOK, DM, DM};
    pg8::StaticOrder S; S.init(NTOK, DM, (int)gridDim.x, (int)blockIdx.x);
    EpiOut8 E{p};
    pg8::gemm_phase((PG8_LAS unsigned char*)lds, g, S, E);
}

constexpr int RT_W = 0, RT_LG = 2 * 49152, RT_RS = RT_LG + 128 * 49 * 4, RT_HIST = RT_RS + 512, RT_BASE = RT_HIST + 1024, RT_LDS = RT_BASE + 1024;
DEV void phase_router(const Params& p, unsigned char* lds) {
    const int tid = threadIdx.x, lane = tid & 63, wid = tid >> 6, frow = lane & 15, fq = lane >> 4;
    const int vb = vblock(), G = gridDim.x;
    unsigned char* ws = p.ws;
    float* lg = (float*)(lds + RT_LG); float* rsd = (float*)(lds + RT_RS);
    int* hist = (int*)(lds + RT_HIST); int* basep = (int*)(lds + RT_BASE);
    const bf16_t* rw = (const bf16_t*)(ws + WS_RW);
    for (int it = vb; it < NTOK / 128; it += G) {
        const size_t row0 = (size_t)it * 128;
        const size_t trow = row0 + 16 * wid + frow;
        const float* hrow = p.out + trow * DM + 8 * fq;
        bf16_t* hbrow = (bf16_t*)(ws + WS_R1) + trow * DM + 8 * fq;
        f32x4 acc[3]; float ss = 0.f;
#pragma unroll
        for (int nt = 0; nt < 3; ++nt) acc[nt] = (f32x4){0.f, 0.f, 0.f, 0.f};
        if (tid < 128) hist[tid] = 0;
        u32x4 wreg[6]; f32x4 xa[4][2], xn[4][2];
#define RT_LOADW(kc_) do { _Pragma("unroll") for (int i = 0; i < 6; ++i) { const int idx = tid + NT * i, r = idx >> 5, c = idx & 31; wreg[i] = *(const u32x4*)(rw + (size_t)r * 1024 + (kc_) * 256 + c * 8); } } while (0)
#define RT_STOREW(buf_) do { _Pragma("unroll") for (int i = 0; i < 6; ++i) { const int idx = tid + NT * i, r = idx >> 5, c = idx & 31; *(u32x4*)(lds + RT_W + (buf_) * 49152 + r * 512 + ((c ^ (r & 15)) << 4)) = wreg[i]; } } while (0)
#define RT_LOADX(dst_, hc_) do { _Pragma("unroll") for (int ks = 0; ks < 4; ++ks) { dst_[ks][0] = *(const f32x4*)(hrow + (hc_) * 128 + 32 * ks); dst_[ks][1] = *(const f32x4*)(hrow + (hc_) * 128 + 32 * ks + 4); } } while (0)
        __syncthreads();
        RT_LOADW(0); RT_LOADX(xa, 0); RT_STOREW(0);
        __syncthreads();
#pragma unroll 1
        for (int hc = 0; hc < 8; ++hc) {
            if (hc < 7) RT_LOADX(xn, hc + 1);
            const unsigned char* wb = lds + RT_W + ((hc >> 1) & 1) * 49152;
#pragma unroll
            for (int ks = 0; ks < 4; ++ks) {
                const f32x4 a = xa[ks][0], b = xa[ks][1];
                ss += ((a.x * a.x + a.y * a.y) + (a.z * a.z + a.w * a.w)) + ((b.x * b.x + b.y * b.y) + (b.z * b.z + b.w * b.w));
                u32x4 hi; hi.x = pk2(a.x, a.y); hi.y = pk2(a.z, a.w); hi.z = pk2(b.x, b.y); hi.w = pk2(b.z, b.w);
                u32x4 lo; lo.x = pk2(a.x - bflo(hi.x), a.y - bfhi(hi.x)); lo.y = pk2(a.z - bflo(hi.y), a.w - bfhi(hi.y)); lo.z = pk2(b.x - bflo(hi.z), b.y - bfhi(hi.z)); lo.w = pk2(b.z - bflo(hi.w), b.w - bfhi(hi.w));
                *(u32x4*)(hbrow + hc * 128 + 32 * ks) = hi;
                const bf16x8 hh = __builtin_bit_cast(bf16x8, hi), hl = __builtin_bit_cast(bf16x8, lo);
                const int co = ((4 * (4 * (hc & 1) + ks) + fq) ^ frow) << 4;
#pragma unroll
                for (int nt = 0; nt < 3; ++nt) {
                    const bf16x8 whi = *(const bf16x8*)(wb + (16 * nt + frow) * 512 + co), wlo = *(const bf16x8*)(wb + (48 + 16 * nt + frow) * 512 + co);
                    acc[nt] = __builtin_amdgcn_mfma_f32_16x16x32_bf16(whi, hh, acc[nt], 0, 0, 0);
                    acc[nt] = __builtin_amdgcn_mfma_f32_16x16x32_bf16(wlo, hh, acc[nt], 0, 0, 0);
                    acc[nt] = __builtin_amdgcn_mfma_f32_16x16x32_bf16(whi, hl, acc[nt], 0, 0, 0);
                }
            }
            if ((hc & 1) == 0 && hc < 6) { RT_LOADW((hc >> 1) + 1); }
            if ((hc & 1) == 1 && hc < 7) { RT_STOREW(((hc >> 1) + 1) & 1); }
#pragma unroll
            for (int ks = 0; ks < 4; ++ks) { xa[ks][0] = xn[ks][0]; xa[ks][1] = xn[ks][1]; }
            if (hc & 1) __syncthreads();
        }
#undef RT_LOADW
#undef RT_STOREW
#undef RT_LOADX
        ss += __shfl_xor(ss, 16); ss += __shfl_xor(ss, 32);
        if (fq == 0) rsd[16 * wid + frow] = rsqrtf(ss * (1.f / DM) + RMS_EPS);
#pragma unroll
        for (int nt = 0; nt < 3; ++nt) { float* o = lg + (16 * wid + frow) * 49 + 16 * nt + 4 * fq; o[0] = acc[nt].x; o[1] = acc[nt].y; o[2] = acc[nt].z; o[3] = acc[nt].w; }
        __syncthreads();
        int bin = 0, slot = 0, ea = 0, eb = 0, sa = 0, sb = 0; float wa = 0.f, wb = 0.f;
        int* ehist = hist + 112; int* ebase = basep + 112;
        if (tid < 32) ehist[tid] = 0;
        __syncthreads();
        if (tid < 128) {
            const float rs = rsd[tid];
            ((float*)(ws + WS_RSTD2))[row0 + tid] = rs;
            float gl[4]; int gi = 0; float gm = -1e30f;
#pragma unroll
            for (int c = 0; c < 4; ++c) { gl[c] = lg[tid * 49 + c] * rs + p.b_group[c]; if (gl[c] > gm) { gm = gl[c]; gi = c; } }
            float gs = 0.f;
#pragma unroll
            for (int c = 0; c < 4; ++c) gs += __expf(gl[c] - gm);
            const float pg = 1.f / gs;
            float el[8]; int i0 = 0; float m0 = -1e30f;
#pragma unroll
            for (int c = 0; c < 8; ++c) { el[c] = lg[tid * 49 + 4 + gi * 8 + c] * rs + p.b_expert[gi * 8 + c]; if (el[c] > m0) { m0 = el[c]; i0 = c; } }
            int i1 = 0; float m1 = -1e30f;
#pragma unroll
            for (int c = 0; c < 8; ++c) if (c != i0 && el[c] > m1) { m1 = el[c]; i1 = c; }
            const float e1 = __expf(m1 - m0); const float w0 = pg / (1.f + e1), w1 = pg * e1 / (1.f + e1);
            const int a = min(i0, i1), bb = max(i0, i1);
            bin = gi * 28 + (7 * a - (a * (a - 1)) / 2) + (bb - a - 1);
            wa = (i0 < i1) ? w0 : w1; wb = (i0 < i1) ? w1 : w0; ea = gi * 8 + a; eb = gi * 8 + bb;
            slot = atomicAdd(&hist[bin], 1);
            sa = atomicAdd(&ehist[ea], 1); sb = atomicAdd(&ehist[eb], 1);
        }
        __syncthreads();
        if (tid < NBIN) { const int h = hist[tid]; basep[tid] = h ? atomicAdd((int*)(ws + WS_CTL) + tid, h) : 0; }
        else if (tid >= 128 && tid < 160) { const int e = tid - 128; const int h = ehist[e]; ebase[e] = h ? atomicAdd((int*)(ws + WS_CTL + 512) + e, h) : 0; }
        __syncthreads();
        if (tid < 128) {
            const int t = (int)(row0 + tid);
            ((int*)(ws + WS_BINL))[(size_t)bin * BINCAP + basep[bin] + slot] = t;
            sa += ebase[ea]; sb += ebase[eb];
            ((int*)(ws + WS_EL))[(size_t)ea * BINCAP + sa] = t; ((float*)(ws + WS_EW))[(size_t)ea * BINCAP + sa] = wa;
            ((int*)(ws + WS_EL))[(size_t)eb * BINCAP + sb] = t; ((float*)(ws + WS_EW))[(size_t)eb * BINCAP + sb] = wb;
            { const unsigned dpos = (unsigned)bin | ((unsigned)(basep[bin] + slot) << 7); ((unsigned*)(ws + WS_EDST))[(size_t)ea * BINCAP + sa] = dpos; ((unsigned*)(ws + WS_EDST))[(size_t)eb * BINCAP + sb] = dpos | (1u << 22); }
        }
        __syncthreads();
    }
}

constexpr int MOE_TS = pg8::STAGE_BYTES, MOE_TT = MOE_TS + 512, MOE_ES = MOE_TT + 1024, MOE_ET = MOE_ES + 256;
DEV void moe_tiles(const Params& p, unsigned char* lds) {
    int* tstart = (int*)(lds + MOE_TS); int* tiletab = (int*)(lds + MOE_TT); int* etstart = (int*)(lds + MOE_ES); int* etiletab = (int*)(lds + MOE_ET);
    const int tid = threadIdx.x;
    __syncthreads();
    if (tid == 0) { const int* cnt = (const int*)(p.ws + WS_CTL); int s = 0; for (int i = 0; i < NBIN; ++i) { tstart[i] = s; s += (cnt[i] + 255) >> 8; } tstart[NBIN] = s; }
    if (tid == 64) { const int* cnt = (const int*)(p.ws + WS_CTL + 512); int s = 0; for (int i = 0; i < 32; ++i) { etstart[i] = s; s += (cnt[i] + 255) >> 8; } etstart[32] = s; }
    __syncthreads();
    if (tid < NBIN) for (int t = tstart[tid]; t < tstart[tid + 1]; ++t) tiletab[t] = tid;
    if (tid >= 128 && tid < 160) for (int t = etstart[tid - 128]; t < etstart[tid - 127]; ++t) etiletab[t] = tid - 128;
    __syncthreads();
}
DEV void bin_experts(int bin, int& ea, int& eb) { const int gi = bin / 28; int pi = bin % 28, a = 0; while (pi >= 7 - a) { pi -= 7 - a; ++a; } ea = gi * 8 + a; eb = gi * 8 + a + 1 + pi; }
DEV void lane_rc(int i, int& R, int& C) { pg8::stage_rc((int)threadIdx.x * 16, R, C); R += 64 * i; }
struct MoeUnit { int tile, nt, bin, mt, n; };
struct PolMoe1 {
    typedef MoeUnit Unit;
    const Params& p; const int* etstart; const int* etiletab; int U, G, c;
    struct AddrA { unsigned off[2][2]; };
    struct AddrB { const char* base; };
    DEV int nk() const { return 16; }
    DEV bool next(int i, MoeUnit& u) const {
        const int L = i * G + c; if (L >= U) return false;
        u.tile = L >> 2; u.nt = L & 3;
        u.bin = __builtin_amdgcn_readfirstlane(etiletab[u.tile]);
        u.mt = u.tile - __builtin_amdgcn_readfirstlane(etstart[u.bin]);
        u.n = min(256, ((const int*)(p.ws + WS_CTL + 512))[u.bin] - u.mt * 256);
        return true;
    }
    DEV bool full(const MoeUnit& u) const { return u.n > 128; }
    DEV void addrA(const MoeUnit& u, AddrA& a) const {
        const int* list = (const int*)(p.ws + WS_EL) + (size_t)u.bin * BINCAP + u.mt * 256;
#pragma unroll
        for (int i = 0; i < 2; ++i) { int R, C; lane_rc(i, R, C);
#pragma unroll
            for (int h = 0; h < 2; ++h) { int r = h * 128 + R; if (r >= u.n) r = 0; a.off[h][i] = (unsigned)list[r] * 2048u + (unsigned)C * 2u; } }
    }
    DEV void addrB(const MoeUnit& u, AddrB& b) const { b.base = (const char*)(p.ws + WS_W13T) + ((size_t)u.bin * 1024 + u.nt * 256) * 2048; }
    DEV const char* pa(const AddrA& a, int h, int i, int kt) const { return (const char*)(p.ws + WS_R1) + a.off[h][i] + kt * 128; }
    DEV const char* pb(const AddrB& b, int h, int i, int kt) const { int R, C; lane_rc(i, R, C); return b.base + (size_t)h * (128 * 2048) + (unsigned)(R * 1024 + C) * 2u + kt * 128; }
};
struct EpiMoe1 { const Params& p; const int* tstart;
    DEV void operator()(const f32x4 (&acc)[2][2][4][2], const MoeUnit& u, int wr, int wc, int fr, int fq) const {
        const int* list = (const int*)(p.ws + WS_EL) + (size_t)u.bin * BINCAP + u.mt * 256;
        const float* wl = (const float*)(p.ws + WS_EW) + (size_t)u.bin * BINCAP + u.mt * 256;
        const unsigned* dl = (const unsigned*)(p.ws + WS_EDST) + (size_t)u.bin * BINCAP + u.mt * 256;
#pragma unroll
        for (int ai = 0; ai < 2; ++ai)
#pragma unroll
            for (int m = 0; m < 4; ++m) { const int r = ai * 128 + wr * 64 + m * 16 + fr; if (r >= u.n) continue;
                const float rs = ((const float*)(p.ws + WS_RSTD2))[list[r]]; const float w = wl[r]; const unsigned d = dl[r];
                bf16_t* hrow = (bf16_t*)(p.ws + WS_HBUF) + ((size_t)tstart[d & 127u] * 256 + ((d >> 7) & 32767u)) * 1024 + ((d >> 22) & 1u) * 512;
#pragma unroll
                for (int bj = 0; bj < 2; ++bj) { const f32x4 v0 = acc[ai][bj][m][0] * rs, v1 = acc[ai][bj][m][1] * rs; const int f = (u.nt * 256 + 128 * bj + 32 * wc + 8 * fq) >> 1;
                    u32x2 w2; w2.x = pk2(siluf_(v0.x) * v0.y * w, siluf_(v0.z) * v0.w * w); w2.y = pk2(siluf_(v1.x) * v1.y * w, siluf_(v1.z) * v1.w * w); *(u32x2*)(hrow + f) = w2; } }
    } };
DEV void phase_moe1(const Params& p, unsigned char* lds) {
    moe_tiles(p, lds);
    const int* etstart = (const int*)(lds + MOE_ES);
    PolMoe1 P{p, etstart, (const int*)(lds + MOE_ET), etstart[32] * 4, (int)gridDim.x, vblock()};
    EpiMoe1 E{p, (const int*)(lds + MOE_TS)};
    pg8::gemm_phase2(( PG8_LAS unsigned char*)lds, P, E);
}
struct PolMoe2 {
    typedef MoeUnit Unit;
    const Params& p; const int* tstart; const int* tiletab; int U, G, c;
    struct AddrA { const char* base; };
    struct AddrB { const char* ba; const char* bb; };
    DEV int nk() const { return 16; }
    DEV bool next(int i, MoeUnit& u) const {
        const int L = i * G + c; if (L >= U) return false;
        u.tile = L >> 2; u.nt = L & 3;
        u.bin = __builtin_amdgcn_readfirstlane(tiletab[u.tile]);
        u.mt = u.tile - __builtin_amdgcn_readfirstlane(tstart[u.bin]);
        u.n = min(256, ((const int*)(p.ws + WS_CTL))[u.bin] - u.mt * 256);
        return true;
    }
    DEV bool full(const MoeUnit& u) const { return u.n > 128; }
    DEV void addrA(const MoeUnit& u, AddrA& a) const { a.base = (const char*)(p.ws + WS_HBUF) + (size_t)u.tile * 256 * 2048; }
    DEV void addrB(const MoeUnit& u, AddrB& b) const {
        int ea, eb; bin_experts(u.bin, ea, eb);
        b.ba = (const char*)(p.ws + WS_W2T) + ((size_t)ea * 1024 + u.nt * 256) * 1024; b.bb = (const char*)(p.ws + WS_W2T) + ((size_t)eb * 1024 + u.nt * 256) * 1024;
    }
    DEV const char* pa(const AddrA& a, int h, int i, int kt) const { int R, C; lane_rc(i, R, C); return a.base + (size_t)h * (128 * 2048) + (unsigned)(R * 1024 + C) * 2u + kt * 128; }
    DEV const char* pb(const AddrB& b, int h, int i, int kt) const { int R, C; lane_rc(i, R, C); return (kt < 8 ? b.ba + kt * 128 : b.bb + (kt - 8) * 128) + (size_t)h * (128 * 1024) + (unsigned)(R * 512 + C) * 2u; }
};
struct EpiMoe2 { const Params& p;
    DEV void operator()(const f32x4 (&acc)[2][2][4][2], const MoeUnit& u, int wr, int wc, int fr, int fq) const {
        const int* list = (const int*)(p.ws + WS_BINL) + (size_t)u.bin * BINCAP + u.mt * 256;
#pragma unroll
        for (int ai = 0; ai < 2; ++ai)
#pragma unroll
            for (int m = 0; m < 4; ++m) { const int r = ai * 128 + wr * 64 + m * 16 + fr; if (r >= u.n) continue; const size_t t = list[r];
#pragma unroll
                for (int bj = 0; bj < 2; ++bj)
#pragma unroll
                    for (int n = 0; n < 2; ++n) { float* o = p.out + t * DM + u.nt * 256 + 128 * bj + 32 * wc + 16 * n + 4 * fq; *(f32x4*)o = *(const f32x4*)o + acc[ai][bj][m][n]; } }
    } };
DEV void phase_moe2(const Params& p, unsigned char* lds) {
    moe_tiles(p, lds);
    const int* tstart = (const int*)(lds + MOE_TS);
    PolMoe2 P{p, tstart, (const int*)(lds + MOE_TT), tstart[NBIN] * 4, (int)gridDim.x, vblock()};
    EpiMoe2 E{p};
    pg8::gemm_phase2((PG8_LAS unsigned char*)lds, P, E);
}

#define XB_TMO      128
#define XB_XCNT(j)  (256  + 64 * (j))
#define XB_XSUB(j)  (1280 + 64 * (j))
#define XB_XGEN(j)  (2304 + 64 * (j))
#define XB_TOP      3328
#define XB_TOPGEN   3392
#define XCD_BAR_WORDS 3456
#define XB_SPIN_CAP (1u << 20)
#define LAS __attribute__((address_space(3)))
constexpr size_t WS_BAR = WS_CTL + 4096;
DEV unsigned xb_ld(unsigned* p) { return __hip_atomic_load(p, __ATOMIC_RELAXED, __HIP_MEMORY_SCOPE_AGENT); }
DEV unsigned xb_add(unsigned* p, unsigned v) { return __hip_atomic_fetch_add(p, v, __ATOMIC_RELAXED, __HIP_MEMORY_SCOPE_AGENT); }
DEV unsigned xb_xcc_id() { return (unsigned)__builtin_amdgcn_s_getreg((3 << 11) | 20) & 0xFu; }
#define XB_SPIN(cond, bar) do { unsigned _sp = 0; while (cond) { __builtin_amdgcn_s_sleep(1); \
    if ((++_sp & 255u) == 0u) { if (xb_ld(&(bar)[XB_TMO])) break; if (_sp > XB_SPIN_CAP) { atomicAdd(&(bar)[XB_TMO], 1u); break; } } } } while (0)
struct XcdBarrier { unsigned* bar; unsigned x; volatile LAS unsigned* st; };
DEV XcdBarrier xcd_barrier_post(unsigned* bar, volatile LAS unsigned* st) {
    XcdBarrier b; b.bar = bar; b.x = xb_xcc_id(); b.st = st;
    if (threadIdx.x == 0) (void)xb_add(&bar[XB_XCNT(b.x)], 1u);
    return b;
}
DEV void xcd_barrier_complete(unsigned* bar, unsigned x, unsigned& nloc, unsigned& nx) {
    const unsigned G = gridDim.x * gridDim.y * gridDim.z;
    unsigned sum, cnt, mine, sp = 0u;
    for (;;) {
        sum = 0u; cnt = 0u; mine = 0u;
#pragma unroll
        for (unsigned j = 0; j < 16; ++j) { const unsigned c = xb_ld(&bar[XB_XCNT(j)]); sum += c; cnt += (c > 0u) ? 1u : 0u; mine = (j == x) ? c : mine; }
        if (sum == G) break;
        __builtin_amdgcn_s_sleep(1);
        if ((++sp & 255u) == 0u) { if (xb_ld(&bar[XB_TMO])) break; if (sp > XB_SPIN_CAP) { atomicAdd(&bar[XB_TMO], 1u); break; } }
    }
    nloc = mine > 0u ? mine : 1u; nx = cnt > 0u ? cnt : 1u;
}
DEV void xcd_barrier(const XcdBarrier& b) {
    asm volatile("s_waitcnt vmcnt(0)" ::: "memory");
    __syncthreads();
    if (threadIdx.x == 0) {
        unsigned* bar = b.bar;
        __builtin_amdgcn_s_waitcnt(0);
        unsigned nloc = b.st[0], nx = b.st[1];
        if (nloc == 0u) { xcd_barrier_complete(bar, b.x, nloc, nx); b.st[0] = nloc; b.st[1] = nx; }
        const unsigned old = xb_add(&bar[XB_XSUB(b.x)], 1u);
        const unsigned gen = old / nloc;
        if (old + 1u == (gen + 1u) * nloc) {
            __builtin_amdgcn_fence(__ATOMIC_RELEASE, "agent");
            asm volatile("s_waitcnt vmcnt(0)" ::: "memory");
            const unsigned og = xb_add(&bar[XB_TOP], 1u);
            const unsigned tg = og / nx;
            if (og + 1u == (tg + 1u) * nx) xb_add(&bar[XB_TOPGEN], 1u);
            else XB_SPIN(xb_ld(&bar[XB_TOPGEN]) == tg, bar);
            __builtin_amdgcn_fence(__ATOMIC_ACQUIRE, "agent");
            xb_add(&bar[XB_XGEN(b.x)], 1u);
            asm volatile("s_waitcnt vmcnt(0)" ::: "memory");
        } else {
            XB_SPIN(xb_ld(&bar[XB_XGEN(b.x)]) == gen, bar);
            __builtin_amdgcn_fence(__ATOMIC_ACQUIRE, "agent");
            asm volatile("s_waitcnt vmcnt(0)" ::: "memory");
        }
    }
    __syncthreads();
}

constexpr int LDS_BYTES = 144 * 1024;
constexpr int N_PHASES = 9;
__global__ void __launch_bounds__(NT) mega(Params p, int lo, int hi) {
    extern __shared__ __attribute__((aligned(16))) unsigned char lds[];
    volatile LAS unsigned* xst = (volatile LAS unsigned*)(lds + LDS_BYTES - 16);
    if (threadIdx.x < 4) xst[threadIdx.x] = 0u;
    __syncthreads();
    XcdBarrier xbar; xbar.bar = (unsigned*)(p.ws + WS_BAR); xbar.x = 0; xbar.st = xst;
    if (hi - lo > 1) xbar = xcd_barrier_post((unsigned*)(p.ws + WS_BAR), xst);
#define GRID_SYNC() xcd_barrier(xbar)
#ifndef PROBE_REPEAT
#define PROBE_REPEAT -1
#endif
#define RUN_PHASE(k, call) do { if (lo <= (k) && (k) < hi) { call; \
        if ((k) == PROBE_REPEAT) { GRID_SYNC(); \
            if ((k) == 5) { float* rz = (float*)(p.ws + WS_ROWSS); for (int i = blockIdx.x * NT + threadIdx.x; i < NTOK; i += gridDim.x * NT) rz[i] = 0.f; GRID_SYNC(); } \
            if ((k) == 7) { if (blockIdx.x == 0 && threadIdx.x < 128) ((int*)(p.ws + WS_CTL))[threadIdx.x] = 0; GRID_SYNC(); } \
            call; } \
        if ((k) + 1 < hi) GRID_SYNC(); } } while (0)
    RUN_PHASE(0, phase_prologue(p, lds));
    RUN_PHASE(1, phase_inproj(p, lds));
    RUN_PHASE(2, { phase_cmp_a(p, lds); const int G_ = (int)gridDim.x; if (G_ > 128) phase_hgrn_a1(p, lds, 64, G_ - 64); else phase_hgrn_a1(p, lds, 0, G_); });
    RUN_PHASE(3, { phase_cmp_b(p, lds); phase_hgrn_a2(p, lds); });
    RUN_PHASE(4, { phase_cmp_attn(p, lds); phase_hgrn_a3(p, lds); });
    RUN_PHASE(5, { phase_flash(p, lds); phase_normalize(p, lds); });
    RUN_PHASE(6, phase_outproj(p, lds));
    RUN_PHASE(7, phase_router(p, lds));
    RUN_PHASE(8, phase_moe1(p, lds));
    RUN_PHASE(9, phase_moe2(p, lds));
#undef RUN_PHASE
}

extern "C" void kernel_launch(void* const* d_in, const int* in_sizes, int n_in, void* d_out, int out_size, void* d_ws, size_t ws_size, hipStream_t stream) {
    static int grid = 0;
    if (grid == 0) {
        int dev = 0, cus = 0, per_cu = 0;
        hipGetDevice(&dev);
        hipDeviceGetAttribute(&cus, hipDeviceAttributeMultiprocessorCount, dev);
        hipFuncSetAttribute((const void*)mega, hipFuncAttributeMaxDynamicSharedMemorySize, LDS_BYTES);
        hipOccupancyMaxActiveBlocksPerMultiprocessor(&per_cu, (const void*)mega, NT, LDS_BYTES);
        if (per_cu < 1) per_cu = 1;
        grid = cus;
        if (ws_size < WS_END) fprintf(stderr, "kernel_launch: workspace too small: %zu < %zu\n", ws_size, (size_t)WS_END);
        fprintf(stderr, "kernel_launch: cus %d per_cu %d grid %d ws %zu\n", cus, per_cu, grid, ws_size);
    }
    Params p{};
    const float** pp = (const float**)&p;
    for (int i = 0; i < 23; ++i) pp[i] = (const float*)d_in[i];
    p.out = (float*)d_out; p.ws = (unsigned char*)d_ws;
#if N_LAUNCH_MODE == 1
    (void)hipMemsetAsync((unsigned char*)d_ws + WS_BAR, 0, XCD_BAR_WORDS * 4, stream);
    int lo = 0, hi = N_PHASES + 1;
    void* args[] = {&p, &lo, &hi};
    hipError_t e = hipLaunchCooperativeKernel((const void*)mega, dim3(grid), dim3(NT), args, LDS_BYTES, stream);
    if (e != hipSuccess) fprintf(stderr, "cooperative launch failed: %s\n", hipGetErrorString(e));
#else
    for (int ph = 0; ph <= N_PHASES; ++ph) hipLaunchKernelGGL(mega, dim3(grid), dim3(NT), LDS_BYTES, stream, p, ph, ph + 1);
#endif
}
```

```cpp
#include <hip/hip_runtime.h>
#include <hip/hip_cooperative_groups.h>
#include <cstdio>
#include <cstdint>
#include <cstring>
namespace cg = cooperative_groups;

#ifndef N_LAUNCH_MODE
#define N_LAUNCH_MODE 1
#endif

#define DEV __device__ __forceinline__
typedef unsigned short bf16_t;
typedef short bf16x8 __attribute__((ext_vector_type(8)));
typedef float f32x4 __attribute__((ext_vector_type(4)));
typedef float f32x2 __attribute__((ext_vector_type(2)));
typedef float f32x16 __attribute__((ext_vector_type(16)));
typedef unsigned u32x4 __attribute__((ext_vector_type(4)));
typedef unsigned u32x2 __attribute__((ext_vector_type(2)));

constexpr int NT = 512;
constexpr int BATCH = 8, SEQ = 4096, DM = 1024, NTOK = BATCH * SEQ;
constexpr int IN_COLS = 3352, INP = 3584;
constexpr int NC = 255;
constexpr float RMS_EPS = 1e-6f;
constexpr float QSCALE = 0.125f * 1.4426950408889634f;
constexpr int NBIN = 112;
constexpr int BINCAP = NTOK;

constexpr size_t MiB = 1ull << 20;
constexpr size_t WS_CTL    = 0;
constexpr size_t WS_RSTD1  = 1 * MiB;
constexpr size_t WS_RSTD2  = WS_RSTD1 + 128 * 1024;
constexpr size_t WS_ROWSS  = WS_RSTD2 + 128 * 1024;
constexpr size_t WS_TOKW   = WS_ROWSS + 128 * 1024;
constexpr size_t WS_LB     = WS_TOKW + 256 * 1024;
constexpr size_t WS_CBIAS  = WS_LB + 4096;
constexpr size_t WS_SELM   = 2 * MiB;
constexpr size_t WS_GATES  = 3 * MiB;
constexpr size_t WS_KCMP   = 6 * MiB;
constexpr size_t WS_VCMP   = WS_KCMP + 512 * 1024;
constexpr size_t WS_CW2T   = 7 * MiB;
constexpr size_t WS_RW     = 7 * MiB + 128 * 1024;
constexpr size_t WS_HID    = 8 * MiB;
constexpr size_t WS_CW1T   = 12 * MiB;
constexpr size_t WS_WOUTT  = 14 * MiB;
constexpr size_t WS_WINT   = 16 * MiB;
constexpr size_t WS_R1     = 24 * MiB;
constexpr size_t WS_Q      = 88 * MiB;
constexpr size_t WS_KC     = 120 * MiB;
constexpr size_t WS_VC     = 128 * MiB;
constexpr size_t WS_KS     = 136 * MiB;
constexpr size_t WS_KW     = 144 * MiB;
constexpr size_t WS_VST    = 152 * MiB;
constexpr size_t WS_VWT    = 160 * MiB;
constexpr size_t WS_OC     = 168 * MiB;
constexpr size_t WS_W13T   = 200 * MiB;
constexpr size_t WS_W2T    = 264 * MiB;
constexpr size_t WS_HQ     = 296 * MiB;
constexpr size_t WS_HV     = 328 * MiB;
constexpr size_t WS_HG     = 360 * MiB;
constexpr size_t WS_HLOGF  = 392 * MiB;
constexpr size_t WS_DBUF   = 456 * MiB;
constexpr size_t WS_END    = 457 * MiB;
constexpr size_t WS_UBUF   = WS_W13T;
constexpr size_t WS_BINL   = WS_HQ;
constexpr size_t WS_HBUF   = WS_HQ + 16 * MiB;
constexpr size_t WS_EL     = WS_HQ + 136 * MiB;
constexpr size_t WS_EW     = WS_HQ + 140 * MiB;
constexpr size_t WS_EDST   = WS_HQ + 144 * MiB;

struct Params {
    const float *x, *attn_g, *ffn_g, *w_in, *w_out, *g_q, *g_k, *pos_k, *pos_v, *wk1, *wk2, *wv1, *wv2, *g_nsa, *lb_logits, *g_hn,
        *w_group, *b_group, *w_expert, *b_expert, *w1, *w3, *w2;
    float* out;
    unsigned char* ws;
};

typedef __bf16 bf16x2_t __attribute__((ext_vector_type(2)));
DEV unsigned pk2(float lo, float hi) { f32x2 f = {lo, hi}; return __builtin_bit_cast(unsigned, __builtin_convertvector(f, bf16x2_t)); }
DEV bf16_t f2bf(float f) { return (bf16_t)(pk2(f, 0.f) & 0xffffu); }
DEV float bf2f(bf16_t b) { return __uint_as_float(((unsigned)b) << 16); }
DEV float bflo(unsigned u) { return __uint_as_float(u << 16); }
DEV float bfhi(unsigned u) { return __uint_as_float(u & 0xffff0000u); }
DEV float sigmoidf_(float v) { return __builtin_amdgcn_rcpf(1.f + __builtin_amdgcn_exp2f(-1.4426950408889634f * v)); }
DEV float siluf_(float v) { return v * __builtin_amdgcn_rcpf(1.f + __builtin_amdgcn_exp2f(-1.4426950408889634f * v)); }
DEV float wave_sum(float v) {
#pragma unroll
    for (int o = 1; o < 64; o <<= 1) v += __shfl_xor(v, o);
    return v;
}
DEV float wave_max(float v) {
#pragma unroll
    for (int o = 1; o < 64; o <<= 1) v = fmaxf(v, __shfl_xor(v, o));
    return v;
}
DEV int vblock() { const int G = gridDim.x, b = blockIdx.x; return (G % 8 == 0) ? (b % 8) * (G / 8) + b / 8 : b; }

namespace pg8 {
#define PG8_LAS __attribute__((address_space(3)))
constexpr int BM = 256, BK = 64, HALF = 128, HTB = HALF * BK * 2, STAGE_BYTES = 8 * HTB, NXCD = 8, WGM = 8;
__host__ __device__ __forceinline__ int lds_byte(int r, int c) { const int st = (r >> 4) * 2 + (c >> 5), rr = r & 15, cc = c & 31, ob = rr * 64 + cc * 2; return st * 1024 + (ob ^ (((ob >> 9) & 1) << 5)); }
__host__ __device__ __forceinline__ void stage_rc(int b, int& R, int& C) { const int st = b / 1024, sb = b % 1024, swz = sb ^ (((sb >> 9) & 1) << 5); R = (st >> 1) * 16 + swz / 64; C = (st & 1) * 32 + (swz % 64) / 2; }
struct Unit { int pm, pn; };
struct Gemm { const bf16_t* A; const bf16_t* Bt; int M, N, K; };
struct StaticOrder {
    int nM, nN, nwg, G, c;
    __host__ __device__ void init(int M, int N, int G_, int c_) { nM = M / BM; nN = N / BM; nwg = nM * nN; G = G_; c = c_; }
    __host__ __device__ bool next(int i, Unit& u) const {
        const long L = (long)i * G + c; if (L >= nwg) return false;
        int wgid = (int)L; { const int q = nwg / NXCD, r = nwg % NXCD, xcd = wgid % NXCD, off = wgid / NXCD; wgid = (xcd < r ? xcd * (q + 1) : r * (q + 1) + (xcd - r) * q) + off; }
        const int nig = WGM * nN, gid = wgid / nig, fm = gid * WGM, gsz = (nM - fm) < WGM ? (nM - fm) : WGM;
        u.pm = fm + ((wgid % nig) % gsz); u.pn = (wgid % nig) / gsz; return true;
    }
};
template <class Epi, class Sched>
__device__ __forceinline__ void gemm_phase(PG8_LAS unsigned char* lds, const Gemm g, const Sched& S, const Epi& E) {
    const int tid = threadIdx.x, wid = __builtin_amdgcn_readfirstlane(tid >> 6), lane = tid & 63, wr = wid >> 2, wc = wid & 3, fr = lane & 15, fq = lane >> 4;
    const int K = g.K, nt = K / BK;
    unsigned voffA[2];
#pragma unroll
    for (int i = 0; i < 2; ++i) { int R, C; stage_rc(tid * 16 + i * 8192, R, C); voffA[i] = (unsigned)(R * K + C) * 2u; }
    const size_t kstep = (size_t)(BK * 2);
    const size_t hstep = (size_t)HALF * K * 2;
    const size_t tstep = 2 * hstep;
    const unsigned ldsw = (unsigned)wid * 1024u;
    const int aoff = lds_byte(wr * 64 + fr, fq * 8), boff = lds_byte(wc * 32 + fr, fq * 8);
#define PG8_SA(b, h) (((b) * 2 + (h)) * HTB)
#define PG8_SB(b, h) ((4 + (b) * 2 + (h)) * HTB)
#define PG8_STAGE(bufoff, gbase, voff) do { _Pragma("unroll") for (int _i = 0; _i < 2; ++_i) \
        __builtin_amdgcn_global_load_lds((const unsigned*)((const char*)(gbase) + (voff)[_i]), (PG8_LAS unsigned*)(lds + (bufoff) + ldsw + _i * 8192), 16, 0, 0); } while (0)
#define PG8_LDA(dst, b, h) do { _Pragma("unroll") for (int m = 0; m < 4; ++m) _Pragma("unroll") for (int k = 0; k < 2; ++k) dst[m][k] = *(const PG8_LAS bf16x8*)(lds + PG8_SA(b, h) + aoff + m * 2048 + k * 1024); } while (0)
#define PG8_LDB(dst, b, h) do { _Pragma("unroll") for (int n = 0; n < 2; ++n) _Pragma("unroll") for (int k = 0; k < 2; ++k) dst[n][k] = *(const PG8_LAS bf16x8*)(lds + PG8_SB(b, h) + boff + n * 2048 + k * 1024); } while (0)
#define PG8_MMA(ai, bj, At, Bt) do { __builtin_amdgcn_s_setprio(1); _Pragma("unroll") for (int m = 0; m < 4; ++m) _Pragma("unroll") for (int n = 0; n < 2; ++n) _Pragma("unroll") for (int k = 0; k < 2; ++k) \
        acc[ai][bj][m][n] = __builtin_amdgcn_mfma_f32_16x16x32_bf16(Bt[n][k], At[m][k], acc[ai][bj][m][n], 0, 0, 0); __builtin_amdgcn_s_setprio(0); } while (0)
#define PG8_WAIT_V(n) asm volatile("s_waitcnt vmcnt(" #n ")" ::: "memory")
#define PG8_WAIT_L(n) asm volatile("s_waitcnt lgkmcnt(" #n ")" ::: "memory")
#define PG8_BAR __builtin_amdgcn_s_barrier()
#define PG8_SCHED __builtin_amdgcn_sched_barrier(0)
    Unit cur, nxt; int ui = 0;
    if (!S.next(0, cur)) return;
    f32x4 acc[2][2][4][2];
#pragma unroll
    for (int a = 0; a < 2; ++a)
#pragma unroll
        for (int b = 0; b < 2; ++b)
#pragma unroll
            for (int m = 0; m < 4; ++m)
#pragma unroll
                for (int n = 0; n < 2; ++n) acc[a][b][m][n] = (f32x4){0.f, 0.f, 0.f, 0.f};
    bf16x8 At[4][2], B0[2][2], B1[2][2];
    const char* cA = (const char*)g.A + (size_t)cur.pm * tstep; const char* cB = (const char*)g.Bt + (size_t)cur.pn * tstep;
    PG8_STAGE(PG8_SB(0, 0), cB, voffA); PG8_STAGE(PG8_SA(0, 0), cA, voffA); PG8_STAGE(PG8_SB(0, 1), cB + hstep, voffA); PG8_STAGE(PG8_SA(0, 1), cA + hstep, voffA);
    if (wr == 1) PG8_BAR;
    PG8_WAIT_V(4); PG8_BAR;
    PG8_STAGE(PG8_SB(1, 0), cB + kstep, voffA); PG8_STAGE(PG8_SA(1, 0), cA + kstep, voffA); PG8_STAGE(PG8_SB(1, 1), cB + hstep + kstep, voffA);
    PG8_WAIT_V(6); PG8_BAR;
    for (;;) {
        const bool has_next = S.next(ui + 1, nxt);
        const char* nA = has_next ? (const char*)g.A + (size_t)nxt.pm * tstep : cA; const char* nB = has_next ? (const char*)g.Bt + (size_t)nxt.pn * tstep : cB;
        float midrs[2][4];
        if constexpr (Epi::MIDSCALE) {
#pragma unroll
            for (int a = 0; a < 2; ++a)
#pragma unroll
                for (int m = 0; m < 4; ++m) midrs[a][m] = E.rowscale(cur.pm * BM + a * HALF + wr * 64 + m * 16 + fr); }
        for (int t = 0; t < nt; t += 2) {
            const bool last = (t == nt - 2);
            if constexpr (Epi::MIDSCALE) { if (t == E.midk()) {
#pragma unroll
                for (int a = 0; a < 2; ++a)
#pragma unroll
                    for (int b = 0; b < 2; ++b)
#pragma unroll
                        for (int m = 0; m < 4; ++m)
#pragma unroll
                            for (int n = 0; n < 2; ++n) acc[a][b][m][n] = acc[a][b][m][n] * midrs[a][m]; } }
            const char* a1 = cA + (size_t)(t + 1) * kstep;
            const char* a2 = last ? nA : cA + (size_t)(t + 2) * kstep; const char* b2 = last ? nB : cB + (size_t)(t + 2) * kstep;
            const char* a3 = a2 + kstep; const char* b3 = b2 + kstep;
            PG8_LDB(B0, 0, 0); PG8_SCHED; PG8_LDA(At, 0, 0); PG8_STAGE(PG8_SA(1, 1), a1 + hstep, voffA);
            PG8_WAIT_L(8); PG8_BAR; PG8_WAIT_L(0); PG8_MMA(0, 0, At, B0); PG8_BAR; PG8_SCHED;
            PG8_LDB(B1, 0, 1); PG8_STAGE(PG8_SB(0, 0), b2, voffA);
            PG8_BAR; PG8_WAIT_L(0); PG8_MMA(0, 1, At, B1); PG8_BAR;
            PG8_LDA(At, 0, 1); PG8_STAGE(PG8_SA(0, 0), a2, voffA);
            PG8_BAR; PG8_WAIT_L(0); PG8_MMA(1, 0, At, B0); PG8_BAR; PG8_SCHED;
            PG8_STAGE(PG8_SB(0, 1), b2 + hstep, voffA);
            PG8_WAIT_V(6); PG8_BAR; PG8_MMA(1, 1, At, B1); PG8_BAR;
            PG8_LDB(B0, 1, 0); PG8_SCHED; PG8_LDA(At, 1, 0); PG8_STAGE(PG8_SA(0, 1), a2 + hstep, voffA);
            PG8_WAIT_L(8); PG8_BAR; PG8_WAIT_L(0); PG8_MMA(0, 0, At, B0); PG8_BAR; PG8_SCHED;
            PG8_LDB(B1, 1, 1); PG8_STAGE(PG8_SB(1, 0), b3, voffA);
            PG8_BAR; PG8_WAIT_L(0); PG8_MMA(0, 1, At, B1); PG8_BAR;
            PG8_LDA(At, 1, 1); PG8_STAGE(PG8_SA(1, 0), a3, voffA);
            PG8_BAR; PG8_WAIT_L(0); PG8_MMA(1, 0, At, B0); PG8_BAR; PG8_SCHED;
            PG8_STAGE(PG8_SB(1, 1), b3 + hstep, voffA);
            PG8_WAIT_V(6); PG8_BAR; PG8_MMA(1, 1, At, B1); PG8_BAR;
        }
        E(acc, cur, wr, wc, fr, fq);
        if (!has_next) break;
#pragma unroll
        for (int a = 0; a < 2; ++a)
#pragma unroll
            for (int b = 0; b < 2; ++b)
#pragma unroll
                for (int m = 0; m < 4; ++m)
#pragma unroll
                    for (int n = 0; n < 2; ++n) acc[a][b][m][n] = (f32x4){0.f, 0.f, 0.f, 0.f};
        cur = nxt; cA = nA; cB = nB; ++ui;
    }
    PG8_WAIT_V(0);
    if (wr == 0) PG8_BAR;
    PG8_BAR;
#undef PG8_SA
#undef PG8_SB
#undef PG8_STAGE
#undef PG8_LDA
#undef PG8_LDB
#undef PG8_MMA
#undef PG8_WAIT_V
#undef PG8_WAIT_L
#undef PG8_BAR
#undef PG8_SCHED
}
template <class Pol, class Epi>
__device__ __forceinline__ void gemm_phase2(PG8_LAS unsigned char* lds, const Pol& P, const Epi& E) {
    const int tid = threadIdx.x, wid = __builtin_amdgcn_readfirstlane(tid >> 6), lane = tid & 63, wr = wid >> 2, wc = wid & 3, fr = lane & 15, fq = lane >> 4;
    const int nt = P.nk();
    const unsigned ldsw = (unsigned)wid * 1024u;
    const int aoff = lds_byte(wr * 64 + fr, fq * 8), boff = lds_byte(wc * 32 + fr, fq * 8);
#define PG8_SA(b, h) (((b) * 2 + (h)) * HTB)
#define PG8_SB(b, h) ((4 + (b) * 2 + (h)) * HTB)
#define PG8_STAGE_A(bufoff, AS, h, kt) do { _Pragma("unroll") for (int _i = 0; _i < 2; ++_i) \
        __builtin_amdgcn_global_load_lds((const unsigned*)P.pa(AS, h, _i, kt), (PG8_LAS unsigned*)(lds + (bufoff) + ldsw + _i * 8192), 16, 0, 0); } while (0)
#define PG8_STAGE_B(bufoff, BS, h, kt) do { _Pragma("unroll") for (int _i = 0; _i < 2; ++_i) \
        __builtin_amdgcn_global_load_lds((const unsigned*)P.pb(BS, h, _i, kt), (PG8_LAS unsigned*)(lds + (bufoff) + ldsw + _i * 8192), 16, 0, 0); } while (0)
#define PG8_LDA(dst, b, h) do { _Pragma("unroll") for (int m = 0; m < 4; ++m) _Pragma("unroll") for (int k = 0; k < 2; ++k) dst[m][k] = *(const PG8_LAS bf16x8*)(lds + PG8_SA(b, h) + aoff + m * 2048 + k * 1024); } while (0)
#define PG8_LDB(dst, b, h) do { _Pragma("unroll") for (int n = 0; n < 2; ++n) _Pragma("unroll") for (int k = 0; k < 2; ++k) dst[n][k] = *(const PG8_LAS bf16x8*)(lds + PG8_SB(b, h) + boff + n * 2048 + k * 1024); } while (0)
#define PG8_MMA(ai, bj, At, Bt) do { __builtin_amdgcn_s_setprio(1); _Pragma("unroll") for (int m = 0; m < 4; ++m) _Pragma("unroll") for (int n = 0; n < 2; ++n) _Pragma("unroll") for (int k = 0; k < 2; ++k) \
        acc[ai][bj][m][n] = __builtin_amdgcn_mfma_f32_16x16x32_bf16(Bt[n][k], At[m][k], acc[ai][bj][m][n], 0, 0, 0); __builtin_amdgcn_s_setprio(0); } while (0)
#define PG8_STAGE_A2(bufoff, h, kt) do { _Pragma("unroll") for (int _i = 0; _i < 2; ++_i) \
        __builtin_amdgcn_global_load_lds((const unsigned*)P.pa(a2, h, _i, kt), (PG8_LAS unsigned*)(lds + (bufoff) + ldsw + _i * 8192), 16, 0, 0); } while (0)
#define PG8_STAGE_B2(bufoff, h, kt) do { _Pragma("unroll") for (int _i = 0; _i < 2; ++_i) \
        __builtin_amdgcn_global_load_lds((const unsigned*)P.pb(b2, h, _i, kt), (PG8_LAS unsigned*)(lds + (bufoff) + ldsw + _i * 8192), 16, 0, 0); } while (0)
#define PG8_WAIT_V(n) asm volatile("s_waitcnt vmcnt(" #n ")" ::: "memory")
#define PG8_WAIT_L(n) asm volatile("s_waitcnt lgkmcnt(" #n ")" ::: "memory")
#define PG8_BAR __builtin_amdgcn_s_barrier()
#define PG8_SCHED __builtin_amdgcn_sched_barrier(0)
    typename Pol::Unit cur, nxt; int ui = 0;
    if (!P.next(0, cur)) return;
    f32x4 acc[2][2][4][2];
#pragma unroll
    for (int a = 0; a < 2; ++a)
#pragma unroll
        for (int b = 0; b < 2; ++b)
#pragma unroll
            for (int m = 0; m < 4; ++m)
#pragma unroll
                for (int n = 0; n < 2; ++n) acc[a][b][m][n] = (f32x4){0.f, 0.f, 0.f, 0.f};
    bf16x8 At[4][2], B0[2][2], B1[2][2];
    typename Pol::AddrA aC, aN; typename Pol::AddrB bC, bN;
    P.addrA(cur, aC); P.addrB(cur, bC);
    PG8_STAGE_B(PG8_SB(0, 0), bC, 0, 0); PG8_STAGE_A(PG8_SA(0, 0), aC, 0, 0); PG8_STAGE_B(PG8_SB(0, 1), bC, 1, 0); PG8_STAGE_A(PG8_SA(0, 1), aC, 1, 0);
    if (wr == 1) PG8_BAR;
    PG8_WAIT_V(4); PG8_BAR;
    PG8_STAGE_B(PG8_SB(1, 0), bC, 0, 1); PG8_STAGE_A(PG8_SA(1, 0), aC, 0, 1); PG8_STAGE_B(PG8_SB(1, 1), bC, 1, 1);
    PG8_WAIT_V(6); PG8_BAR;
    for (;;) {
        const bool has_next = P.next(ui + 1, nxt);
        if (has_next) { P.addrA(nxt, aN); P.addrB(nxt, bN); } else { aN = aC; bN = bC; }
        const bool full = P.full(cur);
        for (int t = 0; t < nt; t += 2) {
            const bool last = (t == nt - 2);
            const typename Pol::AddrA a2 = last ? aN : aC; const typename Pol::AddrB b2 = last ? bN : bC;
            const int k2 = last ? 0 : t + 2, k3 = k2 + 1;
            PG8_LDB(B0, 0, 0); PG8_SCHED; PG8_LDA(At, 0, 0); PG8_STAGE_A(PG8_SA(1, 1), aC, 1, t + 1);
            PG8_WAIT_L(8); PG8_BAR; PG8_WAIT_L(0); PG8_MMA(0, 0, At, B0); PG8_BAR; PG8_SCHED;
            PG8_LDB(B1, 0, 1); PG8_STAGE_B2(PG8_SB(0, 0), 0, k2);
            PG8_BAR; PG8_WAIT_L(0); PG8_MMA(0, 1, At, B1); PG8_BAR;
            PG8_LDA(At, 0, 1); PG8_STAGE_A2(PG8_SA(0, 0), 0, k2);
            PG8_BAR; PG8_WAIT_L(0); if (full) PG8_MMA(1, 0, At, B0); PG8_BAR; PG8_SCHED;
            PG8_STAGE_B2(PG8_SB(0, 1), 1, k2);
            PG8_WAIT_V(6); PG8_BAR; if (full) PG8_MMA(1, 1, At, B1); PG8_BAR;
            PG8_LDB(B0, 1, 0); PG8_SCHED; PG8_LDA(At, 1, 0); PG8_STAGE_A2(PG8_SA(0, 1), 1, k2);
            PG8_WAIT_L(8); PG8_BAR; PG8_WAIT_L(0); PG8_MMA(0, 0, At, B0); PG8_BAR; PG8_SCHED;
            PG8_LDB(B1, 1, 1); PG8_STAGE_B2(PG8_SB(1, 0), 0, k3);
            PG8_BAR; PG8_WAIT_L(0); PG8_MMA(0, 1, At, B1); PG8_BAR;
            PG8_LDA(At, 1, 1); PG8_STAGE_A2(PG8_SA(1, 0), 0, k3);
            PG8_BAR; PG8_WAIT_L(0); if (full) PG8_MMA(1, 0, At, B0); PG8_BAR; PG8_SCHED;
            PG8_STAGE_B2(PG8_SB(1, 1), 1, k3);
            PG8_WAIT_V(6); PG8_BAR; if (full) PG8_MMA(1, 1, At, B1); PG8_BAR;
        }
        E(acc, cur, wr, wc, fr, fq);
        if (!has_next) break;
#pragma unroll
        for (int a = 0; a < 2; ++a)
#pragma unroll
            for (int b = 0; b < 2; ++b)
#pragma unroll
                for (int m = 0; m < 4; ++m)
#pragma unroll
                    for (int n = 0; n < 2; ++n) acc[a][b][m][n] = (f32x4){0.f, 0.f, 0.f, 0.f};
        cur = nxt; aC = aN; bC = bN; ++ui;
    }
    PG8_WAIT_V(0);
    if (wr == 0) PG8_BAR;
    PG8_BAR;
#undef PG8_SA
#undef PG8_SB
#undef PG8_STAGE_A
#undef PG8_STAGE_B
#undef PG8_STAGE_A2
#undef PG8_STAGE_B2
#undef PG8_LDA
#undef PG8_LDB
#undef PG8_MMA
#undef PG8_WAIT_V
#undef PG8_WAIT_L
#undef PG8_BAR
#undef PG8_SCHED
}
__host__ __device__ __forceinline__ int perm_lo(int x) { return (((x >> 2) & 3) << 3) | (((x >> 4) & 1) << 2) | (x & 3); }
__host__ __device__ __forceinline__ int inv_perm_lo(int y) { return (((y >> 2) & 1) << 4) | (((y >> 3) & 3) << 2) | (y & 3); }
__host__ __device__ __forceinline__ int logcol(int p) { return (p & ~255) + 64 * ((p >> 5) & 3) + 32 * ((p >> 7) & 1) + perm_lo(p & 31); }
}

template <class SRC>
DEV void convert_tile(float* tl, const SRC& src, bf16_t* dst, int ldd, int n0, int k0) {
    const int tid = threadIdx.x;
    {
        const int n = tid & 63;
#pragma unroll
        for (int i = 0; i < 8; ++i) { const int kk = (tid >> 6) + 8 * i; tl[kk * 65 + n] = src.get(n0 + n, k0 + kk); }
    }
    __syncthreads();
    {
        const int n = tid >> 3, kc = tid & 7;
        const float* s = tl + (kc * 8) * 65 + n;
        u32x4 o;
        o.x = pk2(s[0 * 65], s[1 * 65]); o.y = pk2(s[2 * 65], s[3 * 65]); o.z = pk2(s[4 * 65], s[5 * 65]); o.w = pk2(s[6 * 65], s[7 * 65]);
        *(u32x4*)(dst + (size_t)(n0 + n) * ldd + k0 + kc * 8) = o;
    }
    __syncthreads();
}
struct SrcWin { const float* w; const float* g;
    DEV float get(int np, int k) const { const int n = pg8::logcol(np); int col; if (n < 1280) col = n; else if (n < 3328) col = n + 24; else if (n < 3352) col = 1280 + (n - 3328); else return 0.f;
        return w[(size_t)k * IN_COLS + col] * g[k]; } };
struct SrcWout { const float* w; const float* g;
    DEV float get(int np, int k) const { const int n = pg8::logcol(np); const float v = w[(size_t)k * DM + n]; return k < 512 ? v * g[k] : v; } };
struct SrcPlain { const float* w; int ld;
    DEV float get(int n, int k) const { return w[(size_t)k * ld + n]; } };
struct SrcW13 { const float* w1; const float* w3; const float* g;
    DEV float get(int n, int k) const { const uintptr_t a = (uintptr_t)w1, b = (uintptr_t)w3; const float* w = (const float*)(a + ((b - a) & (uintptr_t)(0 - (long long)(n & 1))));
        return w[(size_t)k * 512 + (n >> 1)] * g[k]; } };

template <class SRC>
DEV void convert_tile256(float* tl, const SRC& src, bf16_t* dst, int ldd, int n0, int k0) {
    const int tid = threadIdx.x;
    {
        const int q = tid & 63;
        f32x4 v[8];
#pragma unroll
        for (int i = 0; i < 8; ++i) v[i] = src.quad(n0, q, k0 + (tid >> 6) + 8 * i);
#pragma unroll
        for (int i = 0; i < 8; ++i) { float* o = tl + ((tid >> 6) + 8 * i) * 257; o[src.drow(q, 0)] = v[i].x; o[src.drow(q, 1)] = v[i].y; o[src.drow(q, 2)] = v[i].z; o[src.drow(q, 3)] = v[i].w; }
    }
    __syncthreads();
#pragma unroll
    for (int i = 0; i < 4; ++i) {
        const int idx = tid + NT * i, n = idx >> 3, kc = idx & 7;
        const float* s = tl + (kc * 8) * 257 + n;
        u32x4 o;
        o.x = pk2(s[0 * 257], s[1 * 257]); o.y = pk2(s[2 * 257], s[3 * 257]); o.z = pk2(s[4 * 257], s[5 * 257]); o.w = pk2(s[6 * 257], s[7 * 257]);
        *(u32x4*)(dst + (size_t)(n0 + n) * ldd + k0 + kc * 8) = o;
    }
    __syncthreads();
}
struct SrcWin4 { const float* w; const float* g;
    DEV int drow(int q, int e) const { return 4 * q + e; }
    DEV f32x4 quad(int n0, int q, int k) const { const int n = pg8::logcol(n0 + 4 * q); int col; if (n < 1280) col = n; else if (n < 3328) col = n + 24; else if (n < 3352) col = 1280 + (n - 3328); else return (f32x4){0.f, 0.f, 0.f, 0.f};
        return *(const f32x4*)(w + (size_t)k * IN_COLS + col) * g[k]; } };
struct SrcWout4 { const float* w; const float* g;
    DEV int drow(int q, int e) const { return 4 * q + e; }
    DEV f32x4 quad(int n0, int q, int k) const { const f32x4 v = *(const f32x4*)(w + (size_t)k * DM + pg8::logcol(n0 + 4 * q)); return k < 512 ? v * g[k] : v; } };
struct SrcPlain4 { const float* w; int ld;
    DEV int drow(int q, int e) const { return 4 * q + e; }
    DEV f32x4 quad(int n0, int q, int k) const { return *(const f32x4*)(w + (size_t)k * ld + n0 + 4 * q); } };
struct SrcW13_4 { const float* w1; const float* w3; const float* g;
    DEV int drow(int q, int e) const { const int l = 8 * (q & 31) + 2 * e + (q >> 5); return (l & ~31) | pg8::inv_perm_lo(l & 31); }
    DEV f32x4 quad(int n0, int q, int k) const { const uintptr_t a = (uintptr_t)w1, b = (uintptr_t)w3; const float* w = (const float*)(a + ((b - a) & (uintptr_t)(0 - (long long)(q >> 5))));
        return *(const f32x4*)(w + (size_t)k * 512 + (n0 >> 1) + 4 * (q & 31)) * g[k]; } };

DEV void phase_prologue(const Params& p, unsigned char* lds) {
    float* tl = (float*)lds;
    const int tid = threadIdx.x, lane = tid & 63, wid = tid >> 6;
    const int vb = vblock(), G = gridDim.x;
    unsigned char* ws = p.ws;
    constexpr int I_WIN = (INP / 256) * (DM / 64);
    constexpr int I_WOUT = 4 * 16;
    constexpr int I_CW1 = 2 * 32;
    constexpr int I_W2 = 32 * 4 * 8;
    constexpr int I_CW2 = 2 * 1 * 4;
    constexpr int I_ALL = I_WIN + I_WOUT + I_CW1 + I_W2 + I_CW2;
    for (int it = vb; it < I_ALL; it += G) {
        int r = it;
        if (r < I_WIN) { SrcWin4 s{p.w_in, p.attn_g}; convert_tile256(tl, s, (bf16_t*)(ws + WS_WINT), DM, (r / 16) * 256, (r % 16) * 64); continue; } r -= I_WIN;
        if (r < I_WOUT) { SrcWout4 s{p.w_out, p.g_nsa}; convert_tile256(tl, s, (bf16_t*)(ws + WS_WOUTT), DM, (r / 16) * 256, (r % 16) * 64); continue; } r -= I_WOUT;
        if (r < I_CW1) { const int z = r / 32, q = r % 32; SrcPlain4 s{z ? p.wv1 : p.wk1, 256};
            convert_tile256(tl, s, (bf16_t*)(ws + WS_CW1T) + (size_t)z * 256 * 2048, 2048, 0, q * 64); continue; } r -= I_CW1;
        if (r < I_W2) { const int e = r / 32, q = r % 32; SrcPlain4 s{p.w2 + (size_t)e * 512 * 1024, 1024};
            convert_tile256(tl, s, (bf16_t*)(ws + WS_W2T) + (size_t)e * 1024 * 512, 512, (q / 8) * 256, (q % 8) * 64); continue; } r -= I_W2;
        { const int z = r / 4, q = r % 4; SrcPlain s{z ? p.wv2 : p.wk2, 64};
            convert_tile(tl, s, (bf16_t*)(ws + WS_CW2T) + (size_t)z * 64 * 256, 256, 0, q * 64); }
    }
    {
        bf16_t* xb = (bf16_t*)(ws + WS_R1); float* rstd1 = (float*)(ws + WS_RSTD1);
        const int gw = vb * 8 + wid, NGW = G * 8;
        for (int m = gw; m < NTOK; m += NGW) {
            const f32x4* xr = (const f32x4*)(p.x + (size_t)m * DM) + lane;
            f32x4 v[4]; float s = 0.f;
#pragma unroll
            for (int j = 0; j < 4; ++j) { v[j] = xr[64 * j]; s += (v[j].x * v[j].x + v[j].y * v[j].y) + (v[j].z * v[j].z + v[j].w * v[j].w); }
            s = wave_sum(s);
            if (lane == 0) rstd1[m] = rsqrtf(s * (1.f / DM) + RMS_EPS);
            u32x2* o = (u32x2*)(xb + (size_t)m * DM) + lane;
#pragma unroll
            for (int j = 0; j < 4; ++j) { u32x2 w; w.x = pk2(v[j].x, v[j].y); w.y = pk2(v[j].z, v[j].w); o[64 * j] = w; }
        }
    }
    {
        const int gt = vb * NT + tid, NG = G * NT;
        float* rowss = (float*)(ws + WS_ROWSS);
        for (int i = gt; i < NTOK; i += NG) rowss[i] = 0.f;
        int* bincnt = (int*)(ws + WS_CTL);
        if (gt < 128) bincnt[gt] = 0;
        if (gt < 32) ((int*)(ws + WS_CTL + 512))[gt] = 0;
        if (gt < 512) { const float l0 = p.lb_logits[gt], l1 = p.lb_logits[512 + gt]; ((float*)(ws + WS_LB))[gt] = 1.f / (1.f + __expf(l1 - l0)); }
        for (int i = gt; i < 48 * 1024; i += NG) { const int c = i >> 10, k = i & 1023;
            const float w = (c < 4 ? p.w_group[k * 4 + c] : (c < 36 ? p.w_expert[k * 32 + (c - 4)] : 0.f)) * p.ffn_g[k];
            const bf16_t hi = f2bf(w); const bf16_t lo = f2bf(w - bf2f(hi));
            ((bf16_t*)(ws + WS_RW))[i] = hi; ((bf16_t*)(ws + WS_RW))[48 * 1024 + i] = lo; }
        if (blockIdx.x == (unsigned)(G - 1)) {
            const int z = tid >> 8, j = tid & 255; const float* pos = z ? p.pos_v : p.pos_k; const float* w = z ? p.wv1 : p.wk1;
            float a = 0.f;
            for (int k = 0; k < 2048; ++k) a += pos[k] * w[(size_t)k * 256 + j];
            ((float*)(ws + WS_CBIAS))[z * 256 + j] = a;
        }
    }
}

constexpr int G_A_BYTES = 128 * 128, G_B_BYTES = 256 * 128, G_STAGE = G_A_BYTES + G_B_BYTES, G_LDS = 2 * G_STAGE;
DEV int swz(int row, int chunk) { return row * 128 + ((chunk ^ ((row >> 1) & 7)) << 4); }
template <class AL, class BL, class EP>
DEV void gemm_tile(unsigned char* lds, const AL& al, const BL& bl, int nk, const EP& ep) {
    const int tid = threadIdx.x, lane = tid & 63, wid = tid >> 6, wr = wid >> 2, wc = wid & 3;
    const int frow = lane & 15, fq = lane >> 4;
    const bf16_t* aptr[2]; int aoff[2], boff[4], brow[4];
#pragma unroll
    for (int i = 0; i < 2; ++i) { const int q = tid + NT * i, row = q >> 3, ch = q & 7; aptr[i] = al.row(row) + ch * 8; aoff[i] = swz(row, ch); }
#pragma unroll
    for (int i = 0; i < 4; ++i) { const int q = tid + NT * i, row = q >> 3, ch = q & 7; brow[i] = row; boff[i] = G_A_BYTES + swz(row, ch) ; }
    const int bch8 = (tid & 7) * 8;
    u32x4 ra[2], rb[4];
#pragma unroll
    for (int i = 0; i < 2; ++i) ra[i] = *(const u32x4*)(aptr[i]);
#pragma unroll
    for (int i = 0; i < 4; ++i) rb[i] = *(const u32x4*)(bl.ptr(brow[i], 0) + bch8);
#pragma unroll
    for (int i = 0; i < 2; ++i) *(u32x4*)(lds + aoff[i]) = ra[i];
#pragma unroll
    for (int i = 0; i < 4; ++i) *(u32x4*)(lds + boff[i]) = rb[i];
    __syncthreads();
    f32x4 acc[4][4];
#pragma unroll
    for (int m = 0; m < 4; ++m)
#pragma unroll
        for (int n = 0; n < 4; ++n) acc[m][n] = (f32x4){0.f, 0.f, 0.f, 0.f};
    const int sx = (frow >> 1) & 7;
    for (int kt = 0; kt < nk; ++kt) {
        const bool more = (kt + 1 < nk);
        if (more) {
#pragma unroll
            for (int i = 0; i < 2; ++i) ra[i] = *(const u32x4*)(aptr[i] + (kt + 1) * 64);
#pragma unroll
            for (int i = 0; i < 4; ++i) rb[i] = *(const u32x4*)(bl.ptr(brow[i], kt + 1) + bch8);
        }
        const unsigned char* base = lds + (kt & 1) * G_STAGE;
#pragma unroll
        for (int ks = 0; ks < 2; ++ks) {
            const int co = ((ks * 4 + fq) ^ sx) << 4;
            bf16x8 af[4], bfr[4];
#pragma unroll
            for (int m = 0; m < 4; ++m) af[m] = *(const bf16x8*)(base + (wr * 64 + m * 16 + frow) * 128 + co);
#pragma unroll
            for (int n = 0; n < 4; ++n) bfr[n] = *(const bf16x8*)(base + G_A_BYTES + (wc * 64 + n * 16 + frow) * 128 + co);
#pragma unroll
            for (int m = 0; m < 4; ++m)
#pragma unroll
                for (int n = 0; n < 4; ++n) acc[m][n] = __builtin_amdgcn_mfma_f32_16x16x32_bf16(bfr[n], af[m], acc[m][n], 0, 0, 0);
        }
        if (more) {
            unsigned char* nb = lds + ((kt + 1) & 1) * G_STAGE;
#pragma unroll
            for (int i = 0; i < 2; ++i) *(u32x4*)(nb + aoff[i]) = ra[i];
#pragma unroll
            for (int i = 0; i < 4; ++i) *(u32x4*)(nb + boff[i]) = rb[i];
        }
        __syncthreads();
    }
    ep(acc, wr, wc, lane);
}

struct ARows { const bf16_t* base; size_t ld; DEV const bf16_t* row(int r) const { return base + (size_t)r * ld; } };
struct BRows { const bf16_t* base; size_t ld; DEV const bf16_t* ptr(int n, int kt) const { return base + (size_t)n * ld + kt * 64; } };

DEV u32x4 pk8(const f32x4 a, const f32x4 b) { u32x4 w; w.x = pk2(a.x, a.y); w.y = pk2(a.z, a.w); w.z = pk2(b.x, b.y); w.w = pk2(b.z, b.w); return w; }
DEV void inproj_row(const Params& p, int seg, int row, f32x4 (&v)[2][2], int fq) {
    unsigned char* ws = p.ws;
    const float rs = ((const float*)(ws + WS_RSTD1))[row];
#pragma unroll
    for (int bj = 0; bj < 2; ++bj) { v[bj][0] = v[bj][0] * rs; v[bj][1] = v[bj][1] * rs; }
    const int b = row >> 12, s = row & 4095;
    const bool is_q = seg < 8, is_ks = (seg == 12 || seg == 13), is_kw = (seg == 16 || seg == 17);
    if (is_q || is_ks || is_kw) {
        const float* gw = is_q ? p.g_q : (is_ks ? p.g_k + 64 : p.g_k + 128);
        bf16_t* dst; int hh, nh;
        if (is_q) { dst = (bf16_t*)(ws + WS_Q); hh = seg; nh = 8; } else if (is_ks) { dst = (bf16_t*)(ws + WS_KS); hh = seg - 12; nh = 2; } else { dst = (bf16_t*)(ws + WS_KW); hh = seg - 16; nh = 2; }
        float ss = 0.f;
#pragma unroll
        for (int bj = 0; bj < 2; ++bj)
#pragma unroll
            for (int n = 0; n < 2; ++n) ss += (v[bj][n].x * v[bj][n].x + v[bj][n].y * v[bj][n].y) + (v[bj][n].z * v[bj][n].z + v[bj][n].w * v[bj][n].w);
        ss += __shfl_xor(ss, 16); ss += __shfl_xor(ss, 32);
        float r = rsqrtf(ss * (1.f / 64.f) + RMS_EPS); if (is_q) r *= QSCALE;
        bf16_t* o = dst + ((size_t)(b * nh + hh) * SEQ + s) * 64 + fq * 8;
#pragma unroll
        for (int bj = 0; bj < 2; ++bj) { const f32x4 g0 = *(const f32x4*)(gw + 32 * bj + 8 * fq), g1 = *(const f32x4*)(gw + 32 * bj + 8 * fq + 4);
            *(u32x4*)(o + 32 * bj) = pk8(v[bj][0] * g0 * r, v[bj][1] * g1 * r); }
        return;
    }
    if (seg >= 8 && seg < 12) {
        bf16_t* o = (bf16_t*)(ws + (seg < 10 ? WS_KC : WS_VC)) + ((size_t)(b * 2 + (seg & 1)) * SEQ + s) * 64 + fq * 8;
#pragma unroll
        for (int bj = 0; bj < 2; ++bj) *(u32x4*)(o + 32 * bj) = pk8(v[bj][0], v[bj][1]);
        return;
    }
    if (seg == 14 || seg == 15 || seg == 18 || seg == 19) {
        bf16_t* o = (bf16_t*)(ws + (seg < 16 ? WS_VST : WS_VWT)) + (size_t)(b * 2 + (seg & 1)) * 64 * SEQ + s;
#pragma unroll
        for (int bj = 0; bj < 2; ++bj)
#pragma unroll
            for (int n = 0; n < 2; ++n) { const int d = 32 * bj + 8 * fq + 4 * n; const f32x4 x = v[bj][n];
                o[(size_t)(d + 0) * SEQ] = f2bf(x.x); o[(size_t)(d + 1) * SEQ] = f2bf(x.y); o[(size_t)(d + 2) * SEQ] = f2bf(x.z); o[(size_t)(d + 3) * SEQ] = f2bf(x.w); }
        return;
    }
    if (seg < 52) {
        const int kind = (seg - 20) >> 3, cb = ((seg - 20) & 7) * 64 + fq * 8;
        if (kind == 1) {
            const float* lb = (const float*)(ws + WS_LB); float* dst = (float*)(ws + WS_HLOGF) + (size_t)row * 512;
#pragma unroll
            for (int bj = 0; bj < 2; ++bj)
#pragma unroll
                for (int n = 0; n < 2; ++n) { const int c = cb + 32 * bj + 4 * n; const f32x4 l = *(const f32x4*)(lb + c); const f32x4 x = v[bj][n]; f32x4 o;
                    o.x = __logf(l.x + (1.f - l.x) * sigmoidf_(x.x)); o.y = __logf(l.y + (1.f - l.y) * sigmoidf_(x.y));
                    o.z = __logf(l.z + (1.f - l.z) * sigmoidf_(x.z)); o.w = __logf(l.w + (1.f - l.w) * sigmoidf_(x.w));
                    *(f32x4*)(dst + c) = o; }
        } else {
            bf16_t* dst = (bf16_t*)(ws + (kind == 0 ? WS_HQ : (kind == 2 ? WS_HV : WS_HG))) + (size_t)row * 512 + cb;
#pragma unroll
            for (int bj = 0; bj < 2; ++bj) { f32x4 x0 = v[bj][0], x1 = v[bj][1];
                if (kind != 2) { x0.x = siluf_(x0.x); x0.y = siluf_(x0.y); x0.z = siluf_(x0.z); x0.w = siluf_(x0.w); x1.x = siluf_(x1.x); x1.y = siluf_(x1.y); x1.z = siluf_(x1.z); x1.w = siluf_(x1.w); }
                *(u32x4*)(dst + 32 * bj) = pk8(x0, x1); }
        }
        return;
    }
    {
        float* dst = (float*)(ws + WS_GATES) + (size_t)row * 24;
        if (fq < 3) {
#pragma unroll
            for (int n = 0; n < 2; ++n) { const f32x4 x = v[0][n]; f32x4 o; o.x = sigmoidf_(x.x); o.y = sigmoidf_(x.y); o.z = sigmoidf_(x.z); o.w = sigmoidf_(x.w); *(f32x4*)(dst + 8 * fq + 4 * n) = o; } }
    }
}
struct EpiInproj8 { const Params& p; static constexpr bool MIDSCALE = false; DEV float rowscale(int) const { return 1.f; } DEV int midk() const { return -1; }
    DEV void operator()(const f32x4 (&acc)[2][2][4][2], const pg8::Unit& u, int wr, int wc, int fr, int fq) const {
        const int seg = u.pn * 4 + wc;
        if (seg > 52) return;
#pragma unroll
        for (int ai = 0; ai < 2; ++ai)
#pragma unroll
            for (int m = 0; m < 4; ++m) { f32x4 v[2][2] = {{acc[ai][0][m][0], acc[ai][0][m][1]}, {acc[ai][1][m][0], acc[ai][1][m][1]}};
                inproj_row(p, seg, u.pm * 256 + ai * 128 + wr * 64 + m * 16 + fr, v, fq); }
    } };
DEV void phase_inproj(const Params& p, unsigned char* lds) {
    pg8::Gemm g{(const bf16_t*)(p.ws + WS_R1), (const bf16_t*)(p.ws + WS_WINT), NTOK, INP, DM};
    pg8::StaticOrder S; S.init(NTOK, INP, (int)gridDim.x, (int)blockIdx.x);
    EpiInproj8 E{p};
    pg8::gemm_phase(( PG8_LAS unsigned char*)lds, g, S, E);
}

struct ACmp { const bf16_t* src; int bg, c0;
    DEV const bf16_t* row(int r) const { int c = c0 + r; if (c > NC - 1) c = NC - 1; return src + ((size_t)bg * SEQ + 16 * c) * 64; } };
struct EpiCmpA { const Params& p; int z, rbase;
    DEV void operator()(f32x4 (&acc)[4][4], int wr, int wc, int lane) const {
        const int frow = lane & 15, fq = lane >> 4;
        const float* cb = (const float*)(p.ws + WS_CBIAS) + z * 256; bf16_t* hid = (bf16_t*)(p.ws + WS_HID) + (size_t)z * 4096 * 256;
#pragma unroll
        for (int m = 0; m < 4; ++m) { const int rr = rbase + wr * 64 + m * 16 + frow;
#pragma unroll
            for (int n = 0; n < 4; ++n) { const int c = wc * 64 + n * 16 + fq * 4; const f32x4 b = *(const f32x4*)(cb + c); f32x4 v = acc[m][n] + b;
                u32x2 w; w.x = pk2(siluf_(v.x), siluf_(v.y)); w.y = pk2(siluf_(v.z), siluf_(v.w)); *(u32x2*)(hid + (size_t)rr * 256 + c) = w; } }
    } };
DEV void phase_cmp_a(const Params& p, unsigned char* lds) {
    const int vb = vblock(), G = gridDim.x;
    for (int u = vb; u < 64; u += G) {
        const int z = u >> 5, rbase = (u & 31) * 128;
        ACmp al{(const bf16_t*)(p.ws + (z ? WS_VC : WS_KC)), (u & 31) >> 1, (u & 1) * 128};
        BRows bl{(const bf16_t*)(p.ws + WS_CW1T) + (size_t)z * 256 * 2048, 2048};
        EpiCmpA ep{p, z, rbase};
        gemm_tile(lds, al, bl, 2048 / 64, ep);
    }
}
struct BClamp64 { const bf16_t* base; size_t ld; DEV const bf16_t* ptr(int n, int kt) const { return base + (size_t)(n & 63) * ld + kt * 64; } };
struct EpiCmpB { const Params& p; int z, rbase;
    DEV void operator()(f32x4 (&acc)[4][4], int wr, int wc, int lane) const {
        if (wc != 0) return;
        const int frow = lane & 15, fq = lane >> 4;
        bf16_t* dst = (bf16_t*)(p.ws + (z ? WS_VCMP : WS_KCMP));
#pragma unroll
        for (int m = 0; m < 4; ++m) { const int rr = rbase + wr * 64 + m * 16 + frow;
            float r = 1.f;
            if (z == 0) { float ss = 0.f;
#pragma unroll
                for (int n = 0; n < 4; ++n) { const f32x4 v = acc[m][n]; ss += (v.x * v.x + v.y * v.y) + (v.z * v.z + v.w * v.w); }
                ss += __shfl_xor(ss, 16); ss += __shfl_xor(ss, 32); r = rsqrtf(ss * (1.f / 64.f) + RMS_EPS); }
            const int bg = rr >> 8, c = rr & 255;
            if (c < NC) {
#pragma unroll
                for (int n = 0; n < 4; ++n) { const int d = n * 16 + fq * 4; f32x4 v = acc[m][n] * r;
                    if (z == 0) { const f32x4 g = *(const f32x4*)(p.g_k + d); v = v * g;
                        u32x2 w; w.x = pk2(v.x, v.y); w.y = pk2(v.z, v.w); *(u32x2*)(dst + ((size_t)bg * 256 + c) * 64 + d) = w; }
                    else { bf16_t* o = dst + ((size_t)bg * 64 + d) * 256 + c; o[0] = f2bf(v.x); o[256] = f2bf(v.y); o[512] = f2bf(v.z); o[768] = f2bf(v.w); } } }
        }
    } };
DEV void phase_cmp_b(const Params& p, unsigned char* lds) {
    const int vb = vblock(), G = gridDim.x;
    for (int u = vb; u < 64; u += G) {
        const int z = u >> 5, rbase = (u & 31) * 128;
        ARows al{(const bf16_t*)(p.ws + WS_HID) + ((size_t)z * 4096 + rbase) * 256, 256};
        BClamp64 bl{(const bf16_t*)(p.ws + WS_CW2T) + (size_t)z * 64 * 256, 256};
        EpiCmpB ep{p, z, rbase};
        gemm_tile(lds, al, bl, 256 / 64, ep);
    }
}

constexpr int CM_K = 0, CM_V = 32768, CM_VSTR = 520, CM_IMP = CM_V + 64 * CM_VSTR, CM_LDS = CM_IMP + 4 * 16384 + 1024;
DEV void cm_scores(const unsigned char* kbase, int kt, const bf16x8 (&qf)[4], int r31, int hh, f32x16 (&sacc)[2]) {
#pragma unroll
    for (int kt2 = 0; kt2 < 2; ++kt2) {
#pragma unroll
        for (int i = 0; i < 16; ++i) sacc[kt2][i] = 0.f;
        const int row = 64 * kt + 32 * kt2 + r31; const int sx = (row >> 1) & 7;
#pragma unroll
        for (int s = 0; s < 4; ++s) { const bf16x8 kf = *(const bf16x8*)(kbase + row * 128 + (((2 * s + hh) ^ sx) << 4));
            sacc[kt2] = __builtin_amdgcn_mfma_f32_32x32x16_bf16(kf, qf[s], sacc[kt2], 0, 0, 0); }
    }
}
DEV void phase_cmp_attn(const Params& p, unsigned char* lds) {
    const int tid = threadIdx.x, lane = tid & 63, wid = tid >> 6;
    const int vb = vblock(), G = gridDim.x;
    unsigned char* ws = p.ws;
    const int r31 = lane & 31, hh = lane >> 5;
    float* impl = (float*)(lds + CM_IMP);
    for (int it = vb; it < 1024; it += G) {
        int ci, bg;
        if (G == 256) { const int x = vb >> 5, jb = vb & 31, rnd = it / G, i = rnd * 32 + ((rnd & 1) ? 31 - jb : jb); ci = 63 - (i >> 1); bg = 2 * x + (i & 1); }
        else { ci = 63 - (it >> 4); bg = it & 15; }
        const int b = bg >> 1, g = bg & 1;
        const int nvis = min(NC, 4 * ci + 3), ntile = (nvis + 63) >> 6;
        const int head = g * 4 + (wid >> 1);
        const int tokl = (wid & 1) * 32 + r31, t = ci * 64 + tokl;
        const size_t tok = (size_t)b * SEQ + t;
        const int nv = t >= 31 ? min(NC, (t - 31) / 16 + 1) : 0;
        __syncthreads();
        {
            const bf16_t* kc = (const bf16_t*)(ws + WS_KCMP) + (size_t)bg * 256 * 64; const bf16_t* vt = (const bf16_t*)(ws + WS_VCMP) + (size_t)bg * 64 * 256;
            const int cpr = ntile * 8;
            u32x4 rk[4], rv[4];
#pragma unroll
            for (int i = 0; i < 4; ++i) if (i < ntile) { const int idx = tid + NT * i; rk[i] = *(const u32x4*)(kc + (idx >> 3) * 64 + (idx & 7) * 8); const int d = idx / cpr, ck = idx % cpr; rv[i] = *(const u32x4*)(vt + d * 256 + ck * 8); }
#pragma unroll
            for (int i = 0; i < 4; ++i) if (i < ntile) { const int idx = tid + NT * i; *(u32x4*)(lds + CM_K + swz(idx >> 3, idx & 7)) = rk[i];
                const int d = idx / cpr, ck = idx % cpr; u32x2 a, c2; a.x = rv[i].x; a.y = rv[i].y; c2.x = rv[i].z; c2.y = rv[i].w; unsigned char* o = lds + CM_V + d * CM_VSTR + ck * 16; *(u32x2*)o = a; *(u32x2*)(o + 8) = c2; }
        }
        bf16x8 qf[4];
        { const bf16_t* qp = (const bf16_t*)(ws + WS_Q) + ((size_t)(b * 8 + head) * SEQ + t) * 64 + 8 * hh;
#pragma unroll
            for (int s = 0; s < 4; ++s) qf[s] = *(const bf16x8*)(qp + 16 * s); }
        __syncthreads();
        float l_run = 0.f;
        f32x16 ot[2];
#pragma unroll
        for (int dt = 0; dt < 2; ++dt)
#pragma unroll
            for (int i = 0; i < 16; ++i) ot[dt][i] = 0.f;
        float carry = 0.f;
#pragma unroll
        for (int kt = 0; kt < 4; ++kt) if (kt < ntile) {
            f32x16 sacc[2];
            cm_scores(lds + CM_K, kt, qf, r31, hh, sacc);
#pragma unroll
            for (int kt2 = 0; kt2 < 2; ++kt2)
#pragma unroll
                for (int i = 0; i < 16; ++i) { const int c = 64 * kt + 32 * kt2 + (i & 3) + 8 * (i >> 2) + 4 * hh; const float e_ = (c < nv) ? __builtin_amdgcn_exp2f(sacc[kt2][i]) : 0.f; sacc[kt2][i] = e_; l_run += e_; }
            {
                float own[8], xs[8];
#pragma unroll
                for (int kt2 = 0; kt2 < 2; ++kt2)
#pragma unroll
                    for (int g4 = 0; g4 < 4; ++g4) { const float e3 = 0.5f * sacc[kt2][4 * g4 + 3];
                        own[4 * kt2 + g4] = (sacc[kt2][4 * g4] + sacc[kt2][4 * g4 + 1]) + (sacc[kt2][4 * g4 + 2] + e3); xs[4 * kt2 + g4] = __shfl_xor(e3, 32); }
                float* io = impl + (wid >> 1) * 4096 + tokl * 64 + 16 * kt + hh;
#pragma unroll
                for (int gi = 0; gi < 8; ++gi) io[2 * gi] = own[gi] + (hh ? xs[gi] : (gi > 0 ? xs[gi > 0 ? gi - 1 : 0] : carry));
                carry = xs[7];
            }
#pragma unroll
            for (int kt2 = 0; kt2 < 2; ++kt2)
#pragma unroll
                for (int s2 = 0; s2 < 2; ++s2) {
                    bf16x8 pf; { u32x4 w; w.x = pk2(sacc[kt2][8 * s2 + 0], sacc[kt2][8 * s2 + 1]); w.y = pk2(sacc[kt2][8 * s2 + 2], sacc[kt2][8 * s2 + 3]);
                        w.z = pk2(sacc[kt2][8 * s2 + 4], sacc[kt2][8 * s2 + 5]); w.w = pk2(sacc[kt2][8 * s2 + 6], sacc[kt2][8 * s2 + 7]); pf = __builtin_bit_cast(bf16x8, w); }
#pragma unroll
                    for (int dt = 0; dt < 2; ++dt) {
                        const unsigned char* va = lds + CM_V + (32 * dt + r31) * CM_VSTR + (64 * kt + 32 * kt2 + 16 * s2 + 4 * hh) * 2;
                        const u32x2 lo = *(const u32x2*)(va), hi = *(const u32x2*)(va + 16);
                        u32x4 w; w.x = lo.x; w.y = lo.y; w.z = hi.x; w.w = hi.y;
                        ot[dt] = __builtin_amdgcn_mfma_f32_32x32x16_bf16(__builtin_bit_cast(bf16x8, w), pf, ot[dt], 0, 0, 0);
                    }
                }
        }
        float invL; { const float L = l_run + __shfl_xor(l_run, 32); invL = L > 0.f ? 1.f / L : 0.f; }
        if (hh == 0) impl[16384 + (wid >> 1) * 64 + tokl] = invL;
        {
            const float sc = ((const float*)(ws + WS_GATES))[tok * 24 + head * 3 + 0] * invL;
            bf16_t* ocp = (bf16_t*)(ws + WS_OC) + tok * 512 + head * 64;
#pragma unroll
            for (int dt = 0; dt < 2; ++dt)
#pragma unroll
                for (int g4 = 0; g4 < 4; ++g4) { const int d0 = 32 * dt + 8 * g4 + 4 * hh;
                    u32x2 w; w.x = pk2(ot[dt][4 * g4 + 0] * sc, ot[dt][4 * g4 + 1] * sc); w.y = pk2(ot[dt][4 * g4 + 2] * sc, ot[dt][4 * g4 + 3] * sc); *(u32x2*)(ocp + d0) = w; }
        }
        __syncthreads();
        for (int tt = 0; tt < 8; ++tt) {
            const int tl = wid * 8 + tt, cur = ci;
            unsigned long long mask;
            if (cur < 16) mask = (2ull << cur) - 1ull;
            else {
                const bool valid = lane <= cur;
                const float imp = (impl[tl * 64 + lane] * impl[16384 + tl] + impl[4096 + tl * 64 + lane] * impl[16384 + 64 + tl]) + (impl[8192 + tl * 64 + lane] * impl[16384 + 128 + tl] + impl[12288 + tl * 64 + lane] * impl[16384 + 192 + tl]);
                const unsigned key = (lane == 0 || lane == cur) ? 0x7F800000u : __float_as_uint(imp);
                unsigned T = 0u;
                for (int bit = 30; bit >= 0; --bit) { const unsigned cand = T | (1u << bit); if (__popcll(__ballot(valid && key >= cand)) >= 16) T = cand; }
                const unsigned long long gt = __ballot(valid && key > T), eq = __ballot(valid && key == T);
                const int need = 16 - __popcll(gt);
                const int below = __popcll(eq & ((1ull << lane) - 1ull));
                mask = gt | __ballot(valid && key == T && below < need);
            }
            if (lane == 0) ((unsigned long long*)(ws + WS_SELM))[(size_t)bg * SEQ + ci * 64 + tl] = mask;
        }
    }
}

constexpr int FA_KB = 64 * 128, FA_VB = 64 * 136, FA_STAGE = FA_KB + FA_VB, FA_LDS = 2 * FA_STAGE + 1024;
template <bool SEL>
DEV void fa_branch(unsigned char* lds, const bf16_t* Kb, const bf16_t* VTb, int ci, int bg, const bf16x8 (&qf)[4], int t, unsigned long long mymask, unsigned long long need,
                   f32x16 (&ot)[2], float& m_run, float& l_run) {
    const int tid = threadIdx.x, lane = tid & 63;
    const int r31 = lane & 31, hh = lane >> 5;
    const int lrow = tid >> 3, lch = tid & 7;
    const bf16_t* kg = Kb + ((size_t)bg * SEQ + lrow) * 64 + lch * 8;
    const bf16_t* vg = VTb + ((size_t)bg * 64 + lrow) * SEQ + lch * 8;
    const int koff = lrow * 128 + ((lch ^ ((lrow >> 1) & 7)) << 4), voff = FA_KB + lrow * 136 + lch * 16;
    int jlo, jhi; unsigned long long todo;
    if (SEL) { todo = need; jlo = 0; jhi = ci; } else { jlo = ci >= 8 ? ci - 8 : 0; jhi = ci; todo = 0; }
    int j = jlo;
    if (SEL) { if (todo == 0) return; j = __builtin_ctzll(todo); todo &= todo - 1; }
    u32x4 rk = *(const u32x4*)(kg + (size_t)j * 64 * 64), rv = *(const u32x4*)(vg + (size_t)j * 64);
    __syncthreads();
    *(u32x4*)(lds + koff) = rk; { u32x2 a, b2; a.x = rv.x; a.y = rv.y; b2.x = rv.z; b2.y = rv.w; *(u32x2*)(lds + voff) = a; *(u32x2*)(lds + voff + 8) = b2; }
    __syncthreads();
    int st = 0; bool seen = false;
    for (;;) {
        int jn; bool more;
        if (SEL) { more = (todo != 0); jn = more ? __builtin_ctzll(todo) : 0; todo &= todo - 1; } else { jn = j + 1; more = (jn <= jhi); }
        if (more) { rk = *(const u32x4*)(kg + (size_t)jn * 64 * 64); rv = *(const u32x4*)(vg + (size_t)jn * 64); }
        const unsigned char* base = lds + st * FA_STAGE;
        const bool bit = SEL ? ((mymask >> j) & 1ull) != 0 : true;
        const float cinit = (SEL && !bit) ? -__builtin_inff() : -m_run;
        f32x16 sacc[2];
#pragma unroll
        for (int kt2 = 0; kt2 < 2; ++kt2) {
#pragma unroll
            for (int i = 0; i < 16; ++i) sacc[kt2][i] = cinit;
            const int row = 32 * kt2 + r31; const int sx = (row >> 1) & 7;
#pragma unroll
            for (int s = 0; s < 4; ++s) { const bf16x8 kf = *(const bf16x8*)(base + row * 128 + (((2 * s + hh) ^ sx) << 4));
                sacc[kt2] = __builtin_amdgcn_mfma_f32_32x32x16_bf16(kf, qf[s], sacc[kt2], 0, 0, 0); }
        }
        const bool boundary = SEL ? (j == ci) : (j == ci || j + 8 <= ci);
        float mx = -__builtin_inff();
        if (boundary) {
#pragma unroll
            for (int kt2 = 0; kt2 < 2; ++kt2)
#pragma unroll
                for (int i = 0; i < 16; ++i) { const int key = 64 * j + 32 * kt2 + (i & 3) + 8 * (i >> 2) + 4 * hh;
                    const bool ok = SEL ? (key <= t) : (key <= t && t - key < 512);
                    const float v = ok ? sacc[kt2][i] : -__builtin_inff(); sacc[kt2][i] = v; mx = fmaxf(mx, v); }
        } else {
#pragma unroll
            for (int kt2 = 0; kt2 < 2; ++kt2)
#pragma unroll
                for (int i = 0; i < 16; ++i) mx = fmaxf(mx, sacc[kt2][i]);
        }
        mx = fmaxf(mx, __shfl_xor(mx, 32));
        const bool live = mx > -__builtin_inff();
        const bool need = (mx > 8.f) || (!seen && live && mx < -8.f);
        if (__any(need)) {
            const float d = need ? mx : 0.f;
            const float alpha = d > 0.f ? __builtin_amdgcn_exp2f(-d) : 1.f;
            m_run += d; l_run *= alpha;
#pragma unroll
            for (int dt = 0; dt < 2; ++dt)
#pragma unroll
                for (int i = 0; i < 16; ++i) ot[dt][i] *= alpha;
#pragma unroll
            for (int kt2 = 0; kt2 < 2; ++kt2)
#pragma unroll
                for (int i = 0; i < 16; ++i) sacc[kt2][i] -= d;
        }
        seen = seen || live;
        float rs = 0.f;
#pragma unroll
        for (int kt2 = 0; kt2 < 2; ++kt2)
#pragma unroll
            for (int i = 0; i < 16; ++i) { const float e = __builtin_amdgcn_exp2f(sacc[kt2][i]); sacc[kt2][i] = e; rs += e; }
        l_run += rs;
#pragma unroll
        for (int kt2 = 0; kt2 < 2; ++kt2)
#pragma unroll
            for (int s2 = 0; s2 < 2; ++s2) {
                bf16x8 pf; { u32x4 w; w.x = pk2(sacc[kt2][8 * s2 + 0], sacc[kt2][8 * s2 + 1]); w.y = pk2(sacc[kt2][8 * s2 + 2], sacc[kt2][8 * s2 + 3]);
                    w.z = pk2(sacc[kt2][8 * s2 + 4], sacc[kt2][8 * s2 + 5]); w.w = pk2(sacc[kt2][8 * s2 + 6], sacc[kt2][8 * s2 + 7]); pf = __builtin_bit_cast(bf16x8, w); }
#pragma unroll
                for (int dt = 0; dt < 2; ++dt) {
                    const unsigned char* va = base + FA_KB + (32 * dt + r31) * 136 + (32 * kt2 + 16 * s2 + 4 * hh) * 2;
                    const u32x2 lo = *(const u32x2*)(va), hi = *(const u32x2*)(va + 16);
                    u32x4 w; w.x = lo.x; w.y = lo.y; w.z = hi.x; w.w = hi.y;
                    ot[dt] = __builtin_amdgcn_mfma_f32_32x32x16_bf16(__builtin_bit_cast(bf16x8, w), pf, ot[dt], 0, 0, 0);
                }
            }
        if (!more) break;
        { unsigned char* nb = lds + (st ^ 1) * FA_STAGE; *(u32x4*)(nb + koff) = rk; u32x2 a, b2; a.x = rv.x; a.y = rv.y; b2.x = rv.z; b2.y = rv.w; *(u32x2*)(nb + voff) = a; *(u32x2*)(nb + voff + 8) = b2; }
        __syncthreads();
        st ^= 1; j = jn;
    }
}
DEV void phase_flash(const Params& p, unsigned char* lds) {
    const int tid = threadIdx.x, lane = tid & 63, wid = tid >> 6;
    const int vb = vblock(), G = gridDim.x;
    unsigned char* ws = p.ws;
    const int r31 = lane & 31, hh = lane >> 5;
    unsigned long long* red = (unsigned long long*)(lds + 2 * FA_STAGE);
    for (int it = vb; it < 1024; it += G) {
        int ci, bg;
        if (G == 256) { const int x = vb >> 5, jb = vb & 31, rnd = it / G, i = rnd * 32 + ((rnd & 1) ? 31 - jb : jb); ci = 63 - (i >> 1); bg = 2 * x + (i & 1); }
        else { ci = 63 - (it >> 4); bg = it & 15; }
        const int b = bg >> 1, g = bg & 1;
        const int head = g * 4 + (wid >> 1);
        const int t = ci * 64 + (wid & 1) * 32 + r31;
        const size_t tok = (size_t)b * SEQ + t;
        bf16x8 qf[4];
        { const bf16_t* qp = (const bf16_t*)(ws + WS_Q) + ((size_t)(b * 8 + head) * SEQ + t) * 64 + 8 * hh;
#pragma unroll
            for (int s = 0; s < 4; ++s) qf[s] = *(const bf16x8*)(qp + 16 * s); }
        const unsigned long long mymask = ((const unsigned long long*)(ws + WS_SELM))[(size_t)bg * SEQ + t];
        unsigned long long orm = mymask;
#pragma unroll
        for (int o = 1; o < 32; o <<= 1) { const unsigned lo = __shfl_xor((unsigned)orm, o), hi = __shfl_xor((unsigned)(orm >> 32), o); orm |= ((unsigned long long)hi << 32) | lo; }
        __syncthreads();
        if (wid < 2 && lane == 0) red[wid] = orm;
        __syncthreads();
        const unsigned long long need = red[0] | red[1];
        f32x16 oc[2];
        {
            f32x16 ot[2]; float m_run = 0.f, l_run = 0.f;
#pragma unroll
            for (int dt = 0; dt < 2; ++dt)
#pragma unroll
                for (int i = 0; i < 16; ++i) ot[dt][i] = 0.f;
            fa_branch<true>(lds, (const bf16_t*)(ws + WS_KS), (const bf16_t*)(ws + WS_VST), ci, bg, qf, t, mymask, need, ot, m_run, l_run);
            const float lt = l_run + __shfl_xor(l_run, 32);
            const float sc = ((const float*)(ws + WS_GATES))[tok * 24 + head * 3 + 1] / lt;
#pragma unroll
            for (int dt = 0; dt < 2; ++dt)
#pragma unroll
                for (int i = 0; i < 16; ++i) oc[dt][i] = ot[dt][i] * sc;
        }
        {
            f32x16 ot[2]; float m_run = 0.f, l_run = 0.f;
#pragma unroll
            for (int dt = 0; dt < 2; ++dt)
#pragma unroll
                for (int i = 0; i < 16; ++i) ot[dt][i] = 0.f;
            fa_branch<false>(lds, (const bf16_t*)(ws + WS_KW), (const bf16_t*)(ws + WS_VWT), ci, bg, qf, t, 0ull, 0ull, ot, m_run, l_run);
            const float lt = l_run + __shfl_xor(l_run, 32);
            const float sc = ((const float*)(ws + WS_GATES))[tok * 24 + head * 3 + 2] / lt;
#pragma unroll
            for (int dt = 0; dt < 2; ++dt)
#pragma unroll
                for (int i = 0; i < 16; ++i) oc[dt][i] += ot[dt][i] * sc;
        }
        {
            const bf16_t* ocp = (const bf16_t*)(ws + WS_OC) + tok * 512 + head * 64;
            bf16_t* mix = (bf16_t*)(ws + WS_R1) + tok * 1024 + head * 64;
            float ss = 0.f;
#pragma unroll
            for (int dt = 0; dt < 2; ++dt)
#pragma unroll
                for (int g4 = 0; g4 < 4; ++g4) { const int d0 = 32 * dt + 8 * g4 + 4 * hh; const u32x2 c = *(const u32x2*)(ocp + d0);
                    const float v0 = oc[dt][4 * g4 + 0] + bflo(c.x), v1 = oc[dt][4 * g4 + 1] + bfhi(c.x), v2 = oc[dt][4 * g4 + 2] + bflo(c.y), v3 = oc[dt][4 * g4 + 3] + bfhi(c.y);
                    ss += (v0 * v0 + v1 * v1) + (v2 * v2 + v3 * v3);
                    u32x2 w; w.x = pk2(v0, v1); w.y = pk2(v2, v3); *(u32x2*)(mix + d0) = w; }
            ss += __shfl_xor(ss, 32);
            if (hh == 0) atomicAdd((float*)(ws + WS_ROWSS) + tok, ss);
        }
    }
}

DEV int swz256(int row, int chunk) { return row * 256 + ((chunk ^ (row & 15)) << 4); }
DEV void hgrn_cumsum(const Params& p, int bh, int c, float* segs, f32x2 (&lf)[8], f32x2 (&a)[8], f32x2& r, f32x2& alast) {
    const int tid = threadIdx.x, k2 = tid & 63, tq = tid >> 6;
    const int b = bh >> 2, h = bh & 3;
    const float* HL = (const float*)(p.ws + WS_HLOGF) + ((size_t)b * SEQ + c * 64 + tq * 8) * 512 + h * 128 + 2 * k2;
#pragma unroll
    for (int i = 0; i < 8; ++i) lf[i] = *(const f32x2*)(HL + (size_t)i * 512);
    f32x2 run = (f32x2){0.f, 0.f};
#pragma unroll
    for (int i = 0; i < 8; ++i) { run = run + lf[i]; a[i] = run; }
    *(f32x2*)(segs + tq * 128 + 2 * k2) = run;
    __syncthreads();
    f32x2 off = (f32x2){0.f, 0.f}, tot = off, rr = off;
#pragma unroll
    for (int q = 0; q < 8; ++q) { const f32x2 s = *(const f32x2*)(segs + q * 128 + 2 * k2); if (q < tq) off = off + s; if (q < 4) rr = rr + s; tot = tot + s; }
#pragma unroll
    for (int i = 0; i < 8; ++i) a[i] = a[i] + off;
    r = rr; alast = tot;
}
DEV void hgrn_stage_vt(const Params& p, int bh, int c, unsigned char* vt) {
    const int tid = threadIdx.x, k2 = tid & 63, tq = tid >> 6;
    const int b = bh >> 2, h = bh & 3;
    const bf16_t* HV = (const bf16_t*)(p.ws + WS_HV) + ((size_t)b * SEQ + c * 64 + tq * 8) * 512 + h * 128 + 2 * k2;
    unsigned vv[8];
#pragma unroll
    for (int i = 0; i < 8; ++i) vv[i] = *(const unsigned*)(HV + (size_t)i * 512);
    u32x4 lo, hi;
    lo.x = (vv[0] & 0xffffu) | (vv[1] << 16); lo.y = (vv[2] & 0xffffu) | (vv[3] << 16); lo.z = (vv[4] & 0xffffu) | (vv[5] << 16); lo.w = (vv[6] & 0xffffu) | (vv[7] << 16);
    hi.x = (vv[0] >> 16) | (vv[1] & 0xffff0000u); hi.y = (vv[2] >> 16) | (vv[3] & 0xffff0000u); hi.z = (vv[4] >> 16) | (vv[5] & 0xffff0000u); hi.w = (vv[6] >> 16) | (vv[7] & 0xffff0000u);
    *(u32x4*)(vt + swz(2 * k2, tq)) = lo; *(u32x4*)(vt + swz(2 * k2 + 1, tq)) = hi;
}
constexpr int H1_KT = 0, H1_VT = 16384, H1_SEG = 32768, H1_EK = H1_SEG + 4096;
DEV void phase_hgrn_a1(const Params& p, unsigned char* lds, int vb0, int nb) {
    const int tid = threadIdx.x, lane = tid & 63, wid = tid >> 6, k2 = tid & 63, tq = tid >> 6;
    const int vb = vblock(), G = gridDim.x;
    const int frow = lane & 15, fq = lane >> 4, wr = wid >> 1, wc = wid & 1;
    float* segs = (float*)(lds + H1_SEG); float* ek = (float*)(lds + H1_EK);
    bf16_t* ubuf = (bf16_t*)(p.ws + WS_UBUF); float* dbuf = (float*)(p.ws + WS_DBUF);
    if (vb < vb0) return;
    for (int item = vb - vb0; item < 2048; item += nb) {
        const int bh = item >> 6, c = item & 63;
        __syncthreads();
        f32x2 lf[8], a[8], r, al;
        hgrn_cumsum(p, bh, c, segs, lf, a, r, al);
        {
            float kx[8], ky[8];
#pragma unroll
            for (int i = 0; i < 8; ++i) { kx[i] = (1.f - __expf(lf[i].x)) * __expf(fminf(r.x - a[i].x, 80.f)); ky[i] = (1.f - __expf(lf[i].y)) * __expf(fminf(r.y - a[i].y, 80.f)); }
            u32x4 w0, w1;
            w0.x = pk2(kx[0], kx[1]); w0.y = pk2(kx[2], kx[3]); w0.z = pk2(kx[4], kx[5]); w0.w = pk2(kx[6], kx[7]);
            w1.x = pk2(ky[0], ky[1]); w1.y = pk2(ky[2], ky[3]); w1.z = pk2(ky[4], ky[5]); w1.w = pk2(ky[6], ky[7]);
            *(u32x4*)(lds + H1_KT + swz(2 * k2, tq)) = w0; *(u32x4*)(lds + H1_KT + swz(2 * k2 + 1, tq)) = w1;
        }
        hgrn_stage_vt(p, bh, c, lds + H1_VT);
        if (tq == 7) { ek[2 * k2] = __expf(al.x - r.x); ek[2 * k2 + 1] = __expf(al.y - r.y); f32x2 d; d.x = __expf(al.x); d.y = __expf(al.y); *(f32x2*)(dbuf + (size_t)item * 128 + 2 * k2) = d; }
        __syncthreads();
        f32x4 acc[2][4];
#pragma unroll
        for (int m = 0; m < 2; ++m)
#pragma unroll
            for (int n = 0; n < 4; ++n) acc[m][n] = (f32x4){0.f, 0.f, 0.f, 0.f};
        const int sx = (frow >> 1) & 7;
#pragma unroll
        for (int ks = 0; ks < 2; ++ks) {
            const int co = ((ks * 4 + fq) ^ sx) << 4;
            bf16x8 af[2], bfr[4];
#pragma unroll
            for (int m = 0; m < 2; ++m) af[m] = *(const bf16x8*)(lds + H1_VT + (32 * wr + 16 * m + frow) * 128 + co);
#pragma unroll
            for (int n = 0; n < 4; ++n) bfr[n] = *(const bf16x8*)(lds + H1_KT + (64 * wc + 16 * n + frow) * 128 + co);
#pragma unroll
            for (int m = 0; m < 2; ++m)
#pragma unroll
                for (int n = 0; n < 4; ++n) acc[m][n] = __builtin_amdgcn_mfma_f32_16x16x32_bf16(bfr[n], af[m], acc[m][n], 0, 0, 0);
        }
#pragma unroll
        for (int m = 0; m < 2; ++m) { const int v = 32 * wr + 16 * m + frow;
#pragma unroll
            for (int n = 0; n < 4; ++n) { const int k0 = 64 * wc + 16 * n + 4 * fq; const f32x4 e = *(const f32x4*)(ek + k0); const f32x4 o = acc[m][n] * e;
                u32x2 w; w.x = pk2(o.x, o.y); w.y = pk2(o.z, o.w); *(u32x2*)(ubuf + ((size_t)item * 128 + v) * 128 + k0) = w; } }
    }
}
DEV void phase_hgrn_a2(const Params& p, unsigned char* lds) {
    const int G = gridDim.x;
    bf16_t* ubuf = (bf16_t*)(p.ws + WS_UBUF); const float* dbuf = (const float*)(p.ws + WS_DBUF);
    for (int gid = blockIdx.x * NT + threadIdx.x; gid < 131072; gid += G * NT) {
        const int bh = gid >> 12, v = (gid >> 5) & 127, k4 = gid & 31;
        bf16_t* u = ubuf + ((size_t)bh * 64 * 128 + v) * 128 + 4 * k4;
        const float* d = dbuf + (size_t)bh * 64 * 128 + 4 * k4;
        f32x4 S = (f32x4){0.f, 0.f, 0.f, 0.f};
        for (int c0 = 0; c0 < 64; c0 += 8) {
            u32x2 uu[8]; f32x4 dd[8];
#pragma unroll
            for (int j = 0; j < 8; ++j) { uu[j] = *(const u32x2*)(u + (size_t)(c0 + j) * 16384); dd[j] = *(const f32x4*)(d + (size_t)(c0 + j) * 128); }
#pragma unroll
            for (int j = 0; j < 8; ++j) { u32x2 w; w.x = pk2(S.x, S.y); w.y = pk2(S.z, S.w); *(u32x2*)(u + (size_t)(c0 + j) * 16384) = w;
                S.x = dd[j].x * S.x + bflo(uu[j].x); S.y = dd[j].y * S.y + bfhi(uu[j].x); S.z = dd[j].z * S.z + bflo(uu[j].y); S.w = dd[j].w * S.w + bfhi(uu[j].y); }
        }
    }
}
constexpr int H3_QH = 0, H3_QA = 16384, H3_KH = 32768, H3_VT = 49152, H3_PP = 65536, H3_ST = 73728, H3_SEG = 106496, H3_RED = 110592;
DEV void phase_hgrn_a3(const Params& p, unsigned char* lds) {
    const int tid = threadIdx.x, lane = tid & 63, wid = tid >> 6, k2 = tid & 63, tq = tid >> 6;
    const int vb = vblock(), G = gridDim.x;
    const int frow = lane & 15, fq = lane >> 4;
    float* segs = (float*)(lds + H3_SEG); float* red = (float*)(lds + H3_RED);
    const bf16_t* ubuf = (const bf16_t*)(p.ws + WS_UBUF);
    for (int item = vb; item < 2048; item += G) {
        const int bh = item >> 6, c = item & 63, b = bh >> 2, h = bh & 3;
        __syncthreads();
        f32x2 lf[8], a[8], r, al;
        hgrn_cumsum(p, bh, c, segs, lf, a, r, al);
        {
            const bf16_t* HQ = (const bf16_t*)(p.ws + WS_HQ) + ((size_t)b * SEQ + c * 64 + tq * 8) * 512 + h * 128 + 2 * k2;
            unsigned qq[8];
#pragma unroll
            for (int i = 0; i < 8; ++i) qq[i] = *(const unsigned*)(HQ + (size_t)i * 512);
#pragma unroll
            for (int i = 0; i < 8; ++i) { const int t = 8 * tq + i; const float q0 = bflo(qq[i]), q1 = bfhi(qq[i]);
                const int off = swz256(t, k2 >> 2) + (k2 & 3) * 4;
                *(unsigned*)(lds + H3_QH + off) = pk2(q0 * __expf(fminf(a[i].x - r.x, 80.f)), q1 * __expf(fminf(a[i].y - r.y, 80.f)));
                *(unsigned*)(lds + H3_QA + off) = pk2(q0 * __expf(a[i].x), q1 * __expf(a[i].y));
                *(unsigned*)(lds + H3_KH + off) = pk2((1.f - __expf(lf[i].x)) * __expf(fminf(r.x - a[i].x, 80.f)), (1.f - __expf(lf[i].y)) * __expf(fminf(r.y - a[i].y, 80.f))); }
        }
        hgrn_stage_vt(p, bh, c, lds + H3_VT);
        {
            const bf16_t* st = ubuf + (size_t)item * 16384;
#pragma unroll
            for (int i = 0; i < 4; ++i) { const int q = tid + NT * i, v = q >> 4, ch = q & 15; *(u32x4*)(lds + H3_ST + swz256(v, ch)) = *(const u32x4*)(st + v * 128 + ch * 8); }
        }
        __syncthreads();
        {
            const int wr = wid >> 1, wc = wid & 1;
            f32x4 acc[2];
            acc[0] = (f32x4){0.f, 0.f, 0.f, 0.f}; acc[1] = acc[0];
            if (32 * wc <= 16 * wr + 15) {
#pragma unroll
                for (int ks = 0; ks < 4; ++ks) {
                    const int co = ((ks * 4 + fq) ^ frow) << 4;
                    const bf16x8 af = *(const bf16x8*)(lds + H3_QH + (16 * wr + frow) * 256 + co);
#pragma unroll
                    for (int n = 0; n < 2; ++n) { const bf16x8 bfr = *(const bf16x8*)(lds + H3_KH + (32 * wc + 16 * n + frow) * 256 + co);
                        acc[n] = __builtin_amdgcn_mfma_f32_16x16x32_bf16(bfr, af, acc[n], 0, 0, 0); }
                }
            }
            const int t = 16 * wr + frow;
#pragma unroll
            for (int n = 0; n < 2; ++n) { const int s0 = 32 * wc + 16 * n + 4 * fq; f32x4 v = acc[n];
                v.x = (s0 + 0 <= t) ? v.x : 0.f; v.y = (s0 + 1 <= t) ? v.y : 0.f; v.z = (s0 + 2 <= t) ? v.z : 0.f; v.w = (s0 + 3 <= t) ? v.w : 0.f;
                u32x2 w; w.x = pk2(v.x, v.y); w.y = pk2(v.z, v.w);
                *(u32x2*)(lds + H3_PP + t * 128 + ((((s0 >> 3)) ^ ((t >> 1) & 7)) << 4) + (s0 & 7) * 2) = w; }
        }
        __syncthreads();
        {
            const int wr = wid >> 2, wc = wid & 3;
            f32x4 acc[2][2];
#pragma unroll
            for (int m = 0; m < 2; ++m)
#pragma unroll
                for (int n = 0; n < 2; ++n) acc[m][n] = (f32x4){0.f, 0.f, 0.f, 0.f};
            const int sx = (frow >> 1) & 7;
#pragma unroll
            for (int ks = 0; ks < 2; ++ks) {
                const int co = ((ks * 4 + fq) ^ sx) << 4;
                bf16x8 af[2], bfr[2];
#pragma unroll
                for (int m = 0; m < 2; ++m) af[m] = *(const bf16x8*)(lds + H3_PP + (32 * wr + 16 * m + frow) * 128 + co);
#pragma unroll
                for (int n = 0; n < 2; ++n) bfr[n] = *(const bf16x8*)(lds + H3_VT + (32 * wc + 16 * n + frow) * 128 + co);
#pragma unroll
                for (int m = 0; m < 2; ++m)
#pragma unroll
                    for (int n = 0; n < 2; ++n) acc[m][n] = __builtin_amdgcn_mfma_f32_16x16x32_bf16(bfr[n], af[m], acc[m][n], 0, 0, 0);
            }
#pragma unroll
            for (int ks = 0; ks < 4; ++ks) {
                const int co = ((ks * 4 + fq) ^ frow) << 4;
                bf16x8 af[2], bfr[2];
#pragma unroll
                for (int m = 0; m < 2; ++m) af[m] = *(const bf16x8*)(lds + H3_QA + (32 * wr + 16 * m + frow) * 256 + co);
#pragma unroll
                for (int n = 0; n < 2; ++n) bfr[n] = *(const bf16x8*)(lds + H3_ST + (32 * wc + 16 * n + frow) * 256 + co);
#pragma unroll
                for (int m = 0; m < 2; ++m)
#pragma unroll
                    for (int n = 0; n < 2; ++n) acc[m][n] = __builtin_amdgcn_mfma_f32_16x16x32_bf16(bfr[n], af[m], acc[m][n], 0, 0, 0);
            }
#pragma unroll
            for (int m = 0; m < 2; ++m) { float ss = 0.f;
#pragma unroll
                for (int n = 0; n < 2; ++n) { const f32x4 v = acc[m][n]; ss += (v.x * v.x + v.y * v.y) + (v.z * v.z + v.w * v.w); }
                ss += __shfl_xor(ss, 16); ss += __shfl_xor(ss, 32);
                if (fq == 0) red[(32 * wr + 16 * m + frow) * 4 + wc] = ss; }
            __syncthreads();
#pragma unroll
            for (int m = 0; m < 2; ++m) { const int t = 32 * wr + 16 * m + frow; const f32x4 q4 = *(const f32x4*)(red + t * 4);
                const float rs = rsqrtf(((q4.x + q4.y) + (q4.z + q4.w)) * (1.f / 128.f) + RMS_EPS);
                const size_t row = (size_t)b * SEQ + c * 64 + t;
#pragma unroll
                for (int n = 0; n < 2; ++n) { const int v0 = 32 * wc + 16 * n + 4 * fq; const f32x4 gn = *(const f32x4*)(p.g_hn + v0);
                    const u32x2 gg = *(const u32x2*)((const bf16_t*)(p.ws + WS_HG) + row * 512 + h * 128 + v0);
                    const f32x4 o = acc[m][n];
                    u32x2 w; w.x = pk2(o.x * rs * gn.x * bflo(gg.x), o.y * rs * gn.y * bfhi(gg.x)); w.y = pk2(o.z * rs * gn.z * bflo(gg.y), o.w * rs * gn.w * bfhi(gg.y));
                    *(u32x2*)((bf16_t*)(p.ws + WS_R1) + row * 1024 + 512 + h * 128 + v0) = w; } }
        }
    }
}

DEV void phase_normalize(const Params& p, unsigned char* lds) {
    const int vb = vblock(), G = gridDim.x;
    unsigned char* ws = p.ws;
    __syncthreads();
    {
        float* tl = (float*)lds;
        for (int r = vb; r < 32 * 4 * 16; r += G) { const int e = r / 64, q = r % 64; SrcW13_4 s{p.w1 + (size_t)e * 1024 * 512, p.w3 + (size_t)e * 1024 * 512, p.ffn_g};
            convert_tile256(tl, s, (bf16_t*)(ws + WS_W13T) + (size_t)e * 1024 * 1024, 1024, (q / 16) * 256, (q % 16) * 64); }
    }
}

struct EpiOut8 { const Params& p; static constexpr bool MIDSCALE = true;
    DEV float rowscale(int row) const { return rsqrtf(((const float*)(p.ws + WS_ROWSS))[row] * (1.f / 512.f) + RMS_EPS); }
    DEV int midk() const { return 8; }
    DEV void operator()(const f32x4 (&acc)[2][2][4][2], const pg8::Unit& u, int wr, int wc, int fr, int fq) const {
#pragma unroll
        for (int ai = 0; ai < 2; ++ai)
#pragma unroll
            for (int m = 0; m < 4; ++m) { const size_t row = (size_t)u.pm * 256 + ai * 128 + wr * 64 + m * 16 + fr;
#pragma unroll
                for (int bj = 0; bj < 2; ++bj)
#pragma unroll
                    for (int n = 0; n < 2; ++n) { const int c = u.pn * 256 + 64 * wc + 32 * bj + 8 * fq + 4 * n; const f32x4 xv = *(const f32x4*)(p.x + row * DM + c); *(f32x4*)(p.out + row * DM + c) = xv + acc[ai][bj][m][n]; } }
    } };
DEV void phase_outproj(const Params& p, unsigned char* lds) {
    pg8::Gemm g{(const bf16_t*)(p.ws + WS_R1), (const bf16_t*)(p.ws + WS_WOUTT), NTOK, DM, DM};
    pg8::StaticOrder S; S.init(NTOK, DM, (int)gridDim.x, (int)blockIdx.x);
    EpiOut8 E{p};
    pg8::gemm_phase((PG8_LAS unsigned char*)lds, g, S, E);
}

constexpr int RT_W = 0, RT_LG = 2 * 49152, RT_RS = RT_LG + 128 * 49 * 4, RT_HIST = RT_RS + 512, RT_BASE = RT_HIST + 1024, RT_LDS = RT_BASE + 1024;
DEV void phase_router(const Params& p, unsigned char* lds) {
    const int tid = threadIdx.x, lane = tid & 63, wid = tid >> 6, frow = lane & 15, fq = lane >> 4;
    const int vb = vblock(), G = gridDim.x;
    unsigned char* ws = p.ws;
    float* lg = (float*)(lds + RT_LG); float* rsd = (float*)(lds + RT_RS);
    int* hist = (int*)(lds + RT_HIST); int* basep = (int*)(lds + RT_BASE);
    const bf16_t* rw = (const bf16_t*)(ws + WS_RW);
    for (int it = vb; it < NTOK / 128; it += G) {
        const size_t row0 = (size_t)it * 128;
        const size_t trow = row0 + 16 * wid + frow;
        const float* hrow = p.out + trow * DM + 8 * fq;
        bf16_t* hbrow = (bf16_t*)(ws + WS_R1) + trow * DM + 8 * fq;
        f32x4 acc[3]; float ss = 0.f;
#pragma unroll
        for (int nt = 0; nt < 3; ++nt) acc[nt] = (f32x4){0.f, 0.f, 0.f, 0.f};
        if (tid < 128) hist[tid] = 0;
        u32x4 wreg[6]; f32x4 xa[4][2], xn[4][2];
#define RT_LOADW(kc_) do { _Pragma("unroll") for (int i = 0; i < 6; ++i) { const int idx = tid + NT * i, r = idx >> 5, c = idx & 31; wreg[i] = *(const u32x4*)(rw + (size_t)r * 1024 + (kc_) * 256 + c * 8); } } while (0)
#define RT_STOREW(buf_) do { _Pragma("unroll") for (int i = 0; i < 6; ++i) { const int idx = tid + NT * i, r = idx >> 5, c = idx & 31; *(u32x4*)(lds + RT_W + (buf_) * 49152 + r * 512 + ((c ^ (r & 15)) << 4)) = wreg[i]; } } while (0)
#define RT_LOADX(dst_, hc_) do { _Pragma("unroll") for (int ks = 0; ks < 4; ++ks) { dst_[ks][0] = *(const f32x4*)(hrow + (hc_) * 128 + 32 * ks); dst_[ks][1] = *(const f32x4*)(hrow + (hc_) * 128 + 32 * ks + 4); } } while (0)
        __syncthreads();
        RT_LOADW(0); RT_LOADX(xa, 0); RT_STOREW(0);
        __syncthreads();
#pragma unroll 1
        for (int hc = 0; hc < 8; ++hc) {
            if (hc < 7) RT_LOADX(xn, hc + 1);
            const unsigned char* wb = lds + RT_W + ((hc >> 1) & 1) * 49152;
#pragma unroll
            for (int ks = 0; ks < 4; ++ks) {
                const f32x4 a = xa[ks][0], b = xa[ks][1];
                ss += ((a.x * a.x + a.y * a.y) + (a.z * a.z + a.w * a.w)) + ((b.x * b.x + b.y * b.y) + (b.z * b.z + b.w * b.w));
                u32x4 hi; hi.x = pk2(a.x, a.y); hi.y = pk2(a.z, a.w); hi.z = pk2(b.x, b.y); hi.w = pk2(b.z, b.w);
                u32x4 lo; lo.x = pk2(a.x - bflo(hi.x), a.y - bfhi(hi.x)); lo.y = pk2(a.z - bflo(hi.y), a.w - bfhi(hi.y)); lo.z = pk2(b.x - bflo(hi.z), b.y - bfhi(hi.z)); lo.w = pk2(b.z - bflo(hi.w), b.w - bfhi(hi.w));
                *(u32x4*)(hbrow + hc * 128 + 32 * ks) = hi;
                const bf16x8 hh = __builtin_bit_cast(bf16x8, hi), hl = __builtin_bit_cast(bf16x8, lo);
                const int co = ((4 * (4 * (hc & 1) + ks) + fq) ^ frow) << 4;
#pragma unroll
                for (int nt = 0; nt < 3; ++nt) {
                    const bf16x8 whi = *(const bf16x8*)(wb + (16 * nt + frow) * 512 + co), wlo = *(const bf16x8*)(wb + (48 + 16 * nt + frow) * 512 + co);
                    acc[nt] = __builtin_amdgcn_mfma_f32_16x16x32_bf16(whi, hh, acc[nt], 0, 0, 0);
                    acc[nt] = __builtin_amdgcn_mfma_f32_16x16x32_bf16(wlo, hh, acc[nt], 0, 0, 0);
                    acc[nt] = __builtin_amdgcn_mfma_f32_16x16x32_bf16(whi, hl, acc[nt], 0, 0, 0);
                }
            }
            if ((hc & 1) == 0 && hc < 6) { RT_LOADW((hc >> 1) + 1); }
            if ((hc & 1) == 1 && hc < 7) { RT_STOREW(((hc >> 1) + 1) & 1); }
#pragma unroll
            for (int ks = 0; ks < 4; ++ks) { xa[ks][0] = xn[ks][0]; xa[ks][1] = xn[ks][1]; }
            if (hc & 1) __syncthreads();
        }
#undef RT_LOADW
#undef RT_STOREW
#undef RT_LOADX
        ss += __shfl_xor(ss, 16); ss += __shfl_xor(ss, 32);
        if (fq == 0) rsd[16 * wid + frow] = rsqrtf(ss * (1.f / DM) + RMS_EPS);
#pragma unroll
        for (int nt = 0; nt < 3; ++nt) { float* o = lg + (16 * wid + frow) * 49 + 16 * nt + 4 * fq; o[0] = acc[nt].x; o[1] = acc[nt].y; o[2] = acc[nt].z; o[3] = acc[nt].w; }
        __syncthreads();
        int bin = 0, slot = 0, ea = 0, eb = 0, sa = 0, sb = 0; float wa = 0.f, wb = 0.f;
        int* ehist = hist + 112; int* ebase = basep + 112;
        if (tid < 32) ehist[tid] = 0;
        __syncthreads();
        if (tid < 128) {
            const float rs = rsd[tid];
            ((float*)(ws + WS_RSTD2))[row0 + tid] = rs;
            float gl[4]; int gi = 0; float gm = -1e30f;
#pragma unroll
            for (int c = 0; c < 4; ++c) { gl[c] = lg[tid * 49 + c] * rs + p.b_group[c]; if (gl[c] > gm) { gm = gl[c]; gi = c; } }
            float gs = 0.f;
#pragma unroll
            for (int c = 0; c < 4; ++c) gs += __expf(gl[c] - gm);
            const float pg = 1.f / gs;
            float el[8]; int i0 = 0; float m0 = -1e30f;
#pragma unroll
            for (int c = 0; c < 8; ++c) { el[c] = lg[tid * 49 + 4 + gi * 8 + c] * rs + p.b_expert[gi * 8 + c]; if (el[c] > m0) { m0 = el[c]; i0 = c; } }
            int i1 = 0; float m1 = -1e30f;
#pragma unroll
            for (int c = 0; c < 8; ++c) if (c != i0 && el[c] > m1) { m1 = el[c]; i1 = c; }
            const float e1 = __expf(m1 - m0); const float w0 = pg / (1.f + e1), w1 = pg * e1 / (1.f + e1);
            const int a = min(i0, i1), bb = max(i0, i1);
            bin = gi * 28 + (7 * a - (a * (a - 1)) / 2) + (bb - a - 1);
            wa = (i0 < i1) ? w0 : w1; wb = (i0 < i1) ? w1 : w0; ea = gi * 8 + a; eb = gi * 8 + bb;
            slot = atomicAdd(&hist[bin], 1);
            sa = atomicAdd(&ehist[ea], 1); sb = atomicAdd(&ehist[eb], 1);
        }
        __syncthreads();
        if (tid < NBIN) { const int h = hist[tid]; basep[tid] = h ? atomicAdd((int*)(ws + WS_CTL) + tid, h) : 0; }
        else if (tid >= 128 && tid < 160) { const int e = tid - 128; const int h = ehist[e]; ebase[e] = h ? atomicAdd((int*)(ws + WS_CTL + 512) + e, h) : 0; }
        __syncthreads();
        if (tid < 128) {
            const int t = (int)(row0 + tid);
            ((int*)(ws + WS_BINL))[(size_t)bin * BINCAP + basep[bin] + slot] = t;
            sa += ebase[ea]; sb += ebase[eb];
            ((int*)(ws + WS_EL))[(size_t)ea * BINCAP + sa] = t; ((float*)(ws + WS_EW))[(size_t)ea * BINCAP + sa] = wa;
            ((int*)(ws + WS_EL))[(size_t)eb * BINCAP + sb] = t; ((float*)(ws + WS_EW))[(size_t)eb * BINCAP + sb] = wb;
            { const unsigned dpos = (unsigned)bin | ((unsigned)(basep[bin] + slot) << 7); ((unsigned*)(ws + WS_EDST))[(size_t)ea * BINCAP + sa] = dpos; ((unsigned*)(ws + WS_EDST))[(size_t)eb * BINCAP + sb] = dpos | (1u << 22); }
        }
        __syncthreads();
    }
}

constexpr int MOE_TS = pg8::STAGE_BYTES, MOE_TT = MOE_TS + 512, MOE_ES = MOE_TT + 1024, MOE_ET = MOE_ES + 256;
DEV void moe_tiles(const Params& p, unsigned char* lds) {
    int* tstart = (int*)(lds + MOE_TS); int* tiletab = (int*)(lds + MOE_TT); int* etstart = (int*)(lds + MOE_ES); int* etiletab = (int*)(lds + MOE_ET);
    const int tid = threadIdx.x;
    __syncthreads();
    if (tid == 0) { const int* cnt = (const int*)(p.ws + WS_CTL); int s = 0; for (int i = 0; i < NBIN; ++i) { tstart[i] = s; s += (cnt[i] + 255) >> 8; } tstart[NBIN] = s; }
    if (tid == 64) { const int* cnt = (const int*)(p.ws + WS_CTL + 512); int s = 0; for (int i = 0; i < 32; ++i) { etstart[i] = s; s += (cnt[i] + 255) >> 8; } etstart[32] = s; }
    __syncthreads();
    if (tid < NBIN) for (int t = tstart[tid]; t < tstart[tid + 1]; ++t) tiletab[t] = tid;
    if (tid >= 128 && tid < 160) for (int t = etstart[tid - 128]; t < etstart[tid - 127]; ++t) etiletab[t] = tid - 128;
    __syncthreads();
}
DEV void bin_experts(int bin, int& ea, int& eb) { const int gi = bin / 28; int pi = bin % 28, a = 0; while (pi >= 7 - a) { pi -= 7 - a; ++a; } ea = gi * 8 + a; eb = gi * 8 + a + 1 + pi; }
DEV void lane_rc(int i, int& R, int& C) { pg8::stage_rc((int)threadIdx.x * 16, R, C); R += 64 * i; }
struct MoeUnit { int tile, nt, bin, mt, n; };
struct PolMoe1 {
    typedef MoeUnit Unit;
    const Params& p; const int* etstart; const int* etiletab; int U, G, c;
    struct AddrA { unsigned off[2][2]; };
    struct AddrB { const char* base; };
    DEV int nk() const { return 16; }
    DEV bool next(int i, MoeUnit& u) const {
        const int L = i * G + c; if (L >= U) return false;
        u.tile = L >> 2; u.nt = L & 3;
        u.bin = __builtin_amdgcn_readfirstlane(etiletab[u.tile]);
        u.mt = u.tile - __builtin_amdgcn_readfirstlane(etstart[u.bin]);
        u.n = min(256, ((const int*)(p.ws + WS_CTL + 512))[u.bin] - u.mt * 256);
        return true;
    }
    DEV bool full(const MoeUnit& u) const { return u.n > 128; }
    DEV void addrA(const MoeUnit& u, AddrA& a) const {
        const int* list = (const int*)(p.ws + WS_EL) + (size_t)u.bin * BINCAP + u.mt * 256;
#pragma unroll
        for (int i = 0; i < 2; ++i) { int R, C; lane_rc(i, R, C);
#pragma unroll
            for (int h = 0; h < 2; ++h) { int r = h * 128 + R; if (r >= u.n) r = 0; a.off[h][i] = (unsigned)list[r] * 2048u + (unsigned)C * 2u; } }
    }
    DEV void addrB(const MoeUnit& u, AddrB& b) const { b.base = (const char*)(p.ws + WS_W13T) + ((size_t)u.bin * 1024 + u.nt * 256) * 2048; }
    DEV const char* pa(const AddrA& a, int h, int i, int kt) const { return (const char*)(p.ws + WS_R1) + a.off[h][i] + kt * 128; }
    DEV const char* pb(const AddrB& b, int h, int i, int kt) const { int R, C; lane_rc(i, R, C); return b.base + (size_t)h * (128 * 2048) + (unsigned)(R * 1024 + C) * 2u + kt * 128; }
};
struct EpiMoe1 { const Params& p; const int* tstart;
    DEV void operator()(const f32x4 (&acc)[2][2][4][2], const MoeUnit& u, int wr, int wc, int fr, int fq) const {
        const int* list = (const int*)(p.ws + WS_EL) + (size_t)u.bin * BINCAP + u.mt * 256;
        const float* wl = (const float*)(p.ws + WS_EW) + (size_t)u.bin * BINCAP + u.mt * 256;
        const unsigned* dl = (const unsigned*)(p.ws + WS_EDST) + (size_t)u.bin * BINCAP + u.mt * 256;
#pragma unroll
        for (int ai = 0; ai < 2; ++ai)
#pragma unroll
            for (int m = 0; m < 4; ++m) { const int r = ai * 128 + wr * 64 + m * 16 + fr; if (r >= u.n) continue;
                const float rs = ((const float*)(p.ws + WS_RSTD2))[list[r]]; const float w = wl[r]; const unsigned d = dl[r];
                bf16_t* hrow = (bf16_t*)(p.ws + WS_HBUF) + ((size_t)tstart[d & 127u] * 256 + ((d >> 7) & 32767u)) * 1024 + ((d >> 22) & 1u) * 512;
#pragma unroll
                for (int bj = 0; bj < 2; ++bj) { const f32x4 v0 = acc[ai][bj][m][0] * rs, v1 = acc[ai][bj][m][1] * rs; const int f = (u.nt * 256 + 128 * bj + 32 * wc + 8 * fq) >> 1;
                    u32x2 w2; w2.x = pk2(siluf_(v0.x) * v0.y * w, siluf_(v0.z) * v0.w * w); w2.y = pk2(siluf_(v1.x) * v1.y * w, siluf_(v1.z) * v1.w * w); *(u32x2*)(hrow + f) = w2; } }
    } };
DEV void phase_moe1(const Params& p, unsigned char* lds) {
    moe_tiles(p, lds);
    const int* etstart = (const int*)(lds + MOE_ES);
    PolMoe1 P{p, etstart, (const int*)(lds + MOE_ET), etstart[32] * 4, (int)gridDim.x, vblock()};
    EpiMoe1 E{p, (const int*)(lds + MOE_TS)};
    pg8::gemm_phase2(( PG8_LAS unsigned char*)lds, P, E);
}
struct PolMoe2 {
    typedef MoeUnit Unit;
    const Params& p; const int* tstart; const int* tiletab; int U, G, c;
    struct AddrA { const char* base; };
    struct AddrB { const char* ba; const char* bb; };
    DEV int nk() const { return 16; }
    DEV bool next(int i, MoeUnit& u) const {
        const int L = i * G + c; if (L >= U) return false;
        u.tile = L >> 2; u.nt = L & 3;
        u.bin = __builtin_amdgcn_readfirstlane(tiletab[u.tile]);
        u.mt = u.tile - __builtin_amdgcn_readfirstlane(tstart[u.bin]);
        u.n = min(256, ((const int*)(p.ws + WS_CTL))[u.bin] - u.mt * 256);
        return true;
    }
    DEV bool full(const MoeUnit& u) const { return u.n > 128; }
    DEV void addrA(const MoeUnit& u, AddrA& a) const { a.base = (const char*)(p.ws + WS_HBUF) + (size_t)u.tile * 256 * 2048; }
    DEV void addrB(const MoeUnit& u, AddrB& b) const {
        int ea, eb; bin_experts(u.bin, ea, eb);
        b.ba = (const char*)(p.ws + WS_W2T) + ((size_t)ea * 1024 + u.nt * 256) * 1024; b.bb = (const char*)(p.ws + WS_W2T) + ((size_t)eb * 1024 + u.nt * 256) * 1024;
    }
    DEV const char* pa(const AddrA& a, int h, int i, int kt) const { int R, C; lane_rc(i, R, C); return a.base + (size_t)h * (128 * 2048) + (unsigned)(R * 1024 + C) * 2u + kt * 128; }
    DEV const char* pb(const AddrB& b, int h, int i, int kt) const { int R, C; lane_rc(i, R, C); return (kt < 8 ? b.ba + kt * 128 : b.bb + (kt - 8) * 128) + (size_t)h * (128 * 1024) + (unsigned)(R * 512 + C) * 2u; }
};
struct EpiMoe2 { const Params& p;
    DEV void operator()(const f32x4 (&acc)[2][2][4][2], const MoeUnit& u, int wr, int wc, int fr, int fq) const {
        const int* list = (const int*)(p.ws + WS_BINL) + (size_t)u.bin * BINCAP + u.mt * 256;
#pragma unroll
        for (int ai = 0; ai < 2; ++ai)
#pragma unroll
            for (int m = 0; m < 4; ++m) { const int r = ai * 128 + wr * 64 + m * 16 + fr; if (r >= u.n) continue; const size_t t = list[r];
#pragma unroll
                for (int bj = 0; bj < 2; ++bj)
#pragma unroll
                    for (int n = 0; n < 2; ++n) { float* o = p.out + t * DM + u.nt * 256 + 128 * bj + 32 * wc + 16 * n + 4 * fq; *(f32x4*)o = *(const f32x4*)o + acc[ai][bj][m][n]; } }
    } };
DEV void phase_moe2(const Params& p, unsigned char* lds) {
    moe_tiles(p, lds);
    const int* tstart = (const int*)(lds + MOE_TS);
    PolMoe2 P{p, tstart, (const int*)(lds + MOE_TT), tstart[NBIN] * 4, (int)gridDim.x, vblock()};
    EpiMoe2 E{p};
    pg8::gemm_phase2((PG8_LAS unsigned char*)lds, P, E);
}

#define XB_TMO      128
#define XB_XCNT(j)  (256  + 64 * (j))
#define XB_XSUB(j)  (1280 + 64 * (j))
#define XB_XGEN(j)  (2304 + 64 * (j))
#define XB_TOP      3328
#define XB_TOPGEN   3392
#define XCD_BAR_WORDS 3456
#define XB_SPIN_CAP (1u << 20)
#define LAS __attribute__((address_space(3)))
constexpr size_t WS_BAR = WS_CTL + 4096;
DEV unsigned xb_ld(unsigned* p) { return __hip_atomic_load(p, __ATOMIC_RELAXED, __HIP_MEMORY_SCOPE_AGENT); }
DEV unsigned xb_add(unsigned* p, unsigned v) { return __hip_atomic_fetch_add(p, v, __ATOMIC_RELAXED, __HIP_MEMORY_SCOPE_AGENT); }
DEV unsigned xb_xcc_id() { return (unsigned)__builtin_amdgcn_s_getreg((3 << 11) | 20) & 0xFu; }
#define XB_SPIN(cond, bar) do { unsigned _sp = 0; while (cond) { __builtin_amdgcn_s_sleep(1); \
    if ((++_sp & 255u) == 0u) { if (xb_ld(&(bar)[XB_TMO])) break; if (_sp > XB_SPIN_CAP) { atomicAdd(&(bar)[XB_TMO], 1u); break; } } } } while (0)
struct XcdBarrier { unsigned* bar; unsigned x; volatile LAS unsigned* st; };
DEV XcdBarrier xcd_barrier_post(unsigned* bar, volatile LAS unsigned* st) {
    XcdBarrier b; b.bar = bar; b.x = xb_xcc_id(); b.st = st;
    if (threadIdx.x == 0) (void)xb_add(&bar[XB_XCNT(b.x)], 1u);
    return b;
}
DEV void xcd_barrier_complete(unsigned* bar, unsigned x, unsigned& nloc, unsigned& nx) {
    const unsigned G = gridDim.x * gridDim.y * gridDim.z;
    unsigned sum, cnt, mine, sp = 0u;
    for (;;) {
        sum = 0u; cnt = 0u; mine = 0u;
#pragma unroll
        for (unsigned j = 0; j < 16; ++j) { const unsigned c = xb_ld(&bar[XB_XCNT(j)]); sum += c; cnt += (c > 0u) ? 1u : 0u; mine = (j == x) ? c : mine; }
        if (sum == G) break;
        __builtin_amdgcn_s_sleep(1);
        if ((++sp & 255u) == 0u) { if (xb_ld(&bar[XB_TMO])) break; if (sp > XB_SPIN_CAP) { atomicAdd(&bar[XB_TMO], 1u); break; } }
    }
    nloc = mine > 0u ? mine : 1u; nx = cnt > 0u ? cnt : 1u;
}
DEV void xcd_barrier(const XcdBarrier& b) {
    asm volatile("s_waitcnt vmcnt(0)" ::: "memory");
    __syncthreads();
    if (threadIdx.x == 0) {
        unsigned* bar = b.bar;
        __builtin_amdgcn_s_waitcnt(0);
        unsigned nloc = b.st[0], nx = b.st[1];
        if (nloc == 0u) { xcd_barrier_complete(bar, b.x, nloc, nx); b.st[0] = nloc; b.st[1] = nx; }
        const unsigned old = xb_add(&bar[XB_XSUB(b.x)], 1u);
        const unsigned gen = old / nloc;
        if (old + 1u == (gen + 1u) * nloc) {
            __builtin_amdgcn_fence(__ATOMIC_RELEASE, "agent");
            asm volatile("s_waitcnt vmcnt(0)" ::: "memory");
            const unsigned og = xb_add(&bar[XB_TOP], 1u);
            const unsigned tg = og / nx;
            if (og + 1u == (tg + 1u) * nx) xb_add(&bar[XB_TOPGEN], 1u);
            else XB_SPIN(xb_ld(&bar[XB_TOPGEN]) == tg, bar);
            __builtin_amdgcn_fence(__ATOMIC_ACQUIRE, "agent");
            xb_add(&bar[XB_XGEN(b.x)], 1u);
            asm volatile("s_waitcnt vmcnt(0)" ::: "memory");
        } else {
            XB_SPIN(xb_ld(&bar[XB_XGEN(b.x)]) == gen, bar);
            __builtin_amdgcn_fence(__ATOMIC_ACQUIRE, "agent");
            asm volatile("s_waitcnt vmcnt(0)" ::: "memory");
        }
    }
    __syncthreads();
}

constexpr int LDS_BYTES = 144 * 1024;
constexpr int N_PHASES = 9;
__global__ void __launch_bounds__(NT) mega(Params p, int lo, int hi) {
    extern __shared__ __attribute__((aligned(16))) unsigned char lds[];
    volatile LAS unsigned* xst = (volatile LAS unsigned*)(lds + LDS_BYTES - 16);
    if (threadIdx.x < 4) xst[threadIdx.x] = 0u;
    __syncthreads();
    XcdBarrier xbar; xbar.bar = (unsigned*)(p.ws + WS_BAR); xbar.x = 0; xbar.st = xst;
    if (hi - lo > 1) xbar = xcd_barrier_post((unsigned*)(p.ws + WS_BAR), xst);
#define GRID_SYNC() xcd_barrier(xbar)
#ifndef PROBE_REPEAT
#define PROBE_REPEAT -1
#endif
#define RUN_PHASE(k, call) do { if (lo <= (k) && (k) < hi) { call; \
        if ((k) == PROBE_REPEAT) { GRID_SYNC(); \
            if ((k) == 5) { float* rz = (float*)(p.ws + WS_ROWSS); for (int i = blockIdx.x * NT + threadIdx.x; i < NTOK; i += gridDim.x * NT) rz[i] = 0.f; GRID_SYNC(); } \
            if ((k) == 7) { if (blockIdx.x == 0 && threadIdx.x < 128) ((int*)(p.ws + WS_CTL))[threadIdx.x] = 0; GRID_SYNC(); } \
            call; } \
        if ((k) + 1 < hi) GRID_SYNC(); } } while (0)
    RUN_PHASE(0, phase_prologue(p, lds));
    RUN_PHASE(1, phase_inproj(p, lds));
    RUN_PHASE(2, { phase_cmp_a(p, lds); const int G_ = (int)gridDim.x; if (G_ > 128) phase_hgrn_a1(p, lds, 64, G_ - 64); else phase_hgrn_a1(p, lds, 0, G_); });
    RUN_PHASE(3, { phase_cmp_b(p, lds); phase_hgrn_a2(p, lds); });
    RUN_PHASE(4, { phase_cmp_attn(p, lds); phase_hgrn_a3(p, lds); });
    RUN_PHASE(5, { phase_flash(p, lds); phase_normalize(p, lds); });
    RUN_PHASE(6, phase_outproj(p, lds));
    RUN_PHASE(7, phase_router(p, lds));
    RUN_PHASE(8, phase_moe1(p, lds));
    RUN_PHASE(9, phase_moe2(p, lds));
#undef RUN_PHASE
}

extern "C" void kernel_launch(void* const* d_in, const int* in_sizes, int n_in, void* d_out, int out_size, void* d_ws, size_t ws_size, hipStream_t stream) {
    static int grid = 0;
    if (grid == 0) {
        int dev = 0, cus = 0, per_cu = 0;
        hipGetDevice(&dev);
        hipDeviceGetAttribute(&cus, hipDeviceAttributeMultiprocessorCount, dev);
        hipFuncSetAttribute((const void*)mega, hipFuncAttributeMaxDynamicSharedMemorySize, LDS_BYTES);
        hipOccupancyMaxActiveBlocksPerMultiprocessor(&per_cu, (const void*)mega, NT, LDS_BYTES);
        if (per_cu < 1) per_cu = 1;
        grid = cus;
        if (ws_size < WS_END) fprintf(stderr, "kernel_launch: workspace too small: %zu < %zu\n", ws_size, (size_t)WS_END);
        fprintf(stderr, "kernel_launch: cus %d per_cu %d grid %d ws %zu\n", cus, per_cu, grid, ws_size);
    }
    Params p{};
    const float** pp = (const float**)&p;
    for (int i = 0; i < 23; ++i) pp[i] = (const float*)d_in[i];
    p.out = (float*)d_out; p.ws = (unsigned char*)d_ws;
#if N_LAUNCH_MODE == 1
    (void)hipMemsetAsync((unsigned char*)d_ws + WS_BAR, 0, XCD_BAR_WORDS * 4, stream);
    int lo = 0, hi = N_PHASES + 1;
    void* args[] = {&p, &lo, &hi};
    hipError_t e = hipLaunchCooperativeKernel((const void*)mega, dim3(grid), dim3(NT), args, LDS_BYTES, stream);
    if (e != hipSuccess) fprintf(stderr, "cooperative launch failed: %s\n", hipGetErrorString(e));
#else
    for (int ph = 0; ph <= N_PHASES; ++ph) hipLaunchKernelGGL(mega, dim3(grid), dim3(NT), LDS_BYTES, stream, p, ph, ph + 1);
#endif
}
```

```cpp
#include <hip/hip_runtime.h>
#include <hip/hip_cooperative_groups.h>
#include <cstdio>
#include <cstdint>
#include <cstring>
namespace cg = cooperative_groups;

#ifndef N_LAUNCH_MODE
#define N_LAUNCH_MODE 1
#endif

#define DEV __device__ __forceinline__
typedef unsigned short bf16_t;
typedef short bf16x8 __attribute__((ext_vector_type(8)));
typedef float f32x4 __attribute__((ext_vector_type(4)));
typedef float f32x2 __attribute__((ext_vector_type(2)));
typedef float f32x16 __attribute__((ext_vector_type(16)));
typedef unsigned u32x4 __attribute__((ext_vector_type(4)));
typedef unsigned u32x2 __attribute__((ext_vector_type(2)));

constexpr int NT = 512;
constexpr int BATCH = 8, SEQ = 4096, DM = 1024, NTOK = BATCH * SEQ;
constexpr int IN_COLS = 3352, INP = 3584;
constexpr int NC = 255;
constexpr float RMS_EPS = 1e-6f;
constexpr float QSCALE = 0.125f * 1.4426950408889634f;
constexpr int NBIN = 112;
constexpr int BINCAP = NTOK;

constexpr size_t MiB = 1ull << 20;
constexpr size_t WS_CTL    = 0;
constexpr size_t WS_RSTD1  = 1 * MiB;
constexpr size_t WS_RSTD2  = WS_RSTD1 + 128 * 1024;
constexpr size_t WS_ROWSS  = WS_RSTD2 + 128 * 1024;
constexpr size_t WS_TOKW   = WS_ROWSS + 128 * 1024;
constexpr size_t WS_LB     = WS_TOKW + 256 * 1024;
constexpr size_t WS_CBIAS  = WS_LB + 4096;
constexpr size_t WS_SELM   = 2 * MiB;
constexpr size_t WS_GATES  = 3 * MiB;
constexpr size_t WS_KCMP   = 6 * MiB;
constexpr size_t WS_VCMP   = WS_KCMP + 512 * 1024;
constexpr size_t WS_CW2T   = 7 * MiB;
constexpr size_t WS_RW     = 7 * MiB + 128 * 1024;
constexpr size_t WS_HID    = 8 * MiB;
constexpr size_t WS_CW1T   = 12 * MiB;
constexpr size_t WS_WOUTT  = 14 * MiB;
constexpr size_t WS_WINT   = 16 * MiB;
constexpr size_t WS_R1     = 24 * MiB;
constexpr size_t WS_Q      = 88 * MiB;
constexpr size_t WS_KC     = 120 * MiB;
constexpr size_t WS_VC     = 128 * MiB;
constexpr size_t WS_KS     = 136 * MiB;
constexpr size_t WS_KW     = 144 * MiB;
constexpr size_t WS_VST    = 152 * MiB;
constexpr size_t WS_VWT    = 160 * MiB;
constexpr size_t WS_OC     = 168 * MiB;
constexpr size_t WS_W13T   = 200 * MiB;
constexpr size_t WS_W2T    = 264 * MiB;
constexpr size_t WS_HQ     = 296 * MiB;
constexpr size_t WS_HV     = 328 * MiB;
constexpr size_t WS_HG     = 360 * MiB;
constexpr size_t WS_HLOGF  = 392 * MiB;
constexpr size_t WS_DBUF   = 456 * MiB;
constexpr size_t WS_END    = 457 * MiB;
constexpr size_t WS_UBUF   = WS_W13T;
constexpr size_t WS_BINL   = WS_HQ;
constexpr size_t WS_HBUF   = WS_HQ + 16 * MiB;
constexpr size_t WS_EL     = WS_HQ + 136 * MiB;
constexpr size_t WS_EW     = WS_HQ + 140 * MiB;
constexpr size_t WS_EDST   = WS_HQ + 144 * MiB;

struct Params {
    const float *x, *attn_g, *ffn_g, *w_in, *w_out, *g_q, *g_k, *pos_k, *pos_v, *wk1, *wk2, *wv1, *wv2, *g_nsa, *lb_logits, *g_hn,
        *w_group, *b_group, *w_expert, *b_expert, *w1, *w3, *w2;
    float* out;
    unsigned char* ws;
};

typedef __bf16 bf16x2_t __attribute__((ext_vector_type(2)));
DEV unsigned pk2(float lo, float hi) { f32x2 f = {lo, hi}; return __builtin_bit_cast(unsigned, __builtin_convertvector(f, bf16x2_t)); }
DEV bf16_t f2bf(float f) { return (bf16_t)(pk2(f, 0.f) & 0xffffu); }
DEV float bf2f(bf16_t b) { return __uint_as_float(((unsigned)b) << 16); }
DEV float bflo(unsigned u) { return __uint_as_float(u << 16); }
DEV float bfhi(unsigned u) { return __uint_as_float(u & 0xffff0000u); }
DEV float sigmoidf_(float v) { return __builtin_amdgcn_rcpf(1.f + __builtin_amdgcn_exp2f(-1.4426950408889634f * v)); }
DEV float siluf_(float v) { return v * __builtin_amdgcn_rcpf(1.f + __builtin_amdgcn_exp2f(-1.4426950408889634f * v)); }
DEV float wave_sum(float v) {
#pragma unroll
    for (int o = 1; o < 64; o <<= 1) v += __shfl_xor(v, o);
    return v;
}
DEV float wave_max(float v) {
#pragma unroll
    for (int o = 1; o < 64; o <<= 1) v = fmaxf(v, __shfl_xor(v, o));
    return v;
}
DEV int vblock() { const int G = gridDim.x, b = blockIdx.x; return (G % 8 == 0) ? (b % 8) * (G / 8) + b / 8 : b; }

namespace pg8 {
#define PG8_LAS __attribute__((address_space(3)))
constexpr int BM = 256, BK = 64, HALF = 128, HTB = HALF * BK * 2, STAGE_BYTES = 8 * HTB, NXCD = 8, WGM = 8;
__host__ __device__ __forceinline__ int lds_byte(int r, int c) { const int st = (r >> 4) * 2 + (c >> 5), rr = r & 15, cc = c & 31, ob = rr * 64 + cc * 2; return st * 1024 + (ob ^ (((ob >> 9) & 1) << 5)); }
__host__ __device__ __forceinline__ void stage_rc(int b, int& R, int& C) { const int st = b / 1024, sb = b % 1024, swz = sb ^ (((sb >> 9) & 1) << 5); R = (st >> 1) * 16 + swz / 64; C = (st & 1) * 32 + (swz % 64) / 2; }
struct Unit { int pm, pn; };
struct Gemm { const bf16_t* A; const bf16_t* Bt; int M, N, K; };
struct StaticOrder {
    int nM, nN, nwg, G, c;
    __host__ __device__ void init(int M, int N, int G_, int c_) { nM = M / BM; nN = N / BM; nwg = nM * nN; G = G_; c = c_; }
    __host__ __device__ bool next(int i, Unit& u) const {
        const long L = (long)i * G + c; if (L >= nwg) return false;
        int wgid = (int)L; { const int q = nwg / NXCD, r = nwg % NXCD, xcd = wgid % NXCD, off = wgid / NXCD; wgid = (xcd < r ? xcd * (q + 1) : r * (q + 1) + (xcd - r) * q) + off; }
        const int nig = WGM * nN, gid = wgid / nig, fm = gid * WGM, gsz = (nM - fm) < WGM ? (nM - fm) : WGM;
        u.pm = fm + ((wgid % nig) % gsz); u.pn = (wgid % nig) / gsz; return true;
    }
};
template <class Epi, class Sched>
__device__ __forceinline__ void gemm_phase(PG8_LAS unsigned char* lds, const Gemm g, const Sched& S, const Epi& E) {
    const int tid = threadIdx.x, wid = __builtin_amdgcn_readfirstlane(tid >> 6), lane = tid & 63, wr = wid >> 2, wc = wid & 3, fr = lane & 15, fq = lane >> 4;
    const int K = g.K, nt = K / BK;
    unsigned voffA[2];
#pragma unroll
    for (int i = 0; i < 2; ++i) { int R, C; stage_rc(tid * 16 + i * 8192, R, C); voffA[i] = (unsigned)(R * K + C) * 2u; }
    const size_t kstep = (size_t)(BK * 2);
    const size_t hstep = (size_t)HALF * K * 2;
    const size_t tstep = 2 * hstep;
    const unsigned ldsw = (unsigned)wid * 1024u;
    const int aoff = lds_byte(wr * 64 + fr, fq * 8), boff = lds_byte(wc * 32 + fr, fq * 8);
#define PG8_SA(b, h) (((b) * 2 + (h)) * HTB)
#define PG8_SB(b, h) ((4 + (b) * 2 + (h)) * HTB)
#define PG8_STAGE(bufoff, gbase, voff) do { _Pragma("unroll") for (int _i = 0; _i < 2; ++_i) \
        __builtin_amdgcn_global_load_lds((const unsigned*)((const char*)(gbase) + (voff)[_i]), (PG8_LAS unsigned*)(lds + (bufoff) + ldsw + _i * 8192), 16, 0, 0); } while (0)
#define PG8_LDA(dst, b, h) do { _Pragma("unroll") for (int m = 0; m < 4; ++m) _Pragma("unroll") for (int k = 0; k < 2; ++k) dst[m][k] = *(const PG8_LAS bf16x8*)(lds + PG8_SA(b, h) + aoff + m * 2048 + k * 1024); } while (0)
#define PG8_LDB(dst, b, h) do { _Pragma("unroll") for (int n = 0; n < 2; ++n) _Pragma("unroll") for (int k = 0; k < 2; ++k) dst[n][k] = *(const PG8_LAS bf16x8*)(lds + PG8_SB(b, h) + boff + n * 2048 + k * 1024); } while (0)
#define PG8_MMA(ai, bj, At, Bt) do { __builtin_amdgcn_s_setprio(1); _Pragma("unroll") for (int m = 0; m < 4; ++m) _Pragma("unroll") for (int n = 0; n < 2; ++n) _Pragma("unroll") for (int k = 0; k < 2; ++k) \
        acc[ai][bj][m][n] = __builtin_amdgcn_mfma_f32_16x16x32_bf16(Bt[n][k], At[m][k], acc[ai][bj][m][n], 0, 0, 0); __builtin_amdgcn_s_setprio(0); } while (0)
#define PG8_WAIT_V(n) asm volatile("s_waitcnt vmcnt(" #n ")" ::: "memory")
#define PG8_WAIT_L(n) asm volatile("s_waitcnt lgkmcnt(" #n ")" ::: "memory")
#define PG8_BAR __builtin_amdgcn_s_barrier()
#define PG8_SCHED __builtin_amdgcn_sched_barrier(0)
    Unit cur, nxt; int ui = 0;
    if (!S.next(0, cur)) return;
    f32x4 acc[2][2][4][2];
#pragma unroll
    for (int a = 0; a < 2; ++a)
#pragma unroll
        for (int b = 0; b < 2; ++b)
#pragma unroll
            for (int m = 0; m < 4; ++m)
#pragma unroll
                for (int n = 0; n < 2; ++n) acc[a][b][m][n] = (f32x4){0.f, 0.f, 0.f, 0.f};
    bf16x8 At[4][2], B0[2][2], B1[2][2];
    const char* cA = (const char*)g.A + (size_t)cur.pm * tstep; const char* cB = (const char*)g.Bt + (size_t)cur.pn * tstep;
    PG8_STAGE(PG8_SB(0, 0), cB, voffA); PG8_STAGE(PG8_SA(0, 0), cA, voffA); PG8_STAGE(PG8_SB(0, 1), cB + hstep, voffA); PG8_STAGE(PG8_SA(0, 1), cA + hstep, voffA);
    if (wr == 1) PG8_BAR;
    PG8_WAIT_V(4); PG8_BAR;
    PG8_STAGE(PG8_SB(1, 0), cB + kstep, voffA); PG8_STAGE(PG8_SA(1, 0), cA + kstep, voffA); PG8_STAGE(PG8_SB(1, 1), cB + hstep + kstep, voffA);
    PG8_WAIT_V(6); PG8_BAR;
    for (;;) {
        const bool has_next = S.next(ui + 1, nxt);
        const char* nA = has_next ? (const char*)g.A + (size_t)nxt.pm * tstep : cA; const char* nB = has_next ? (const char*)g.Bt + (size_t)nxt.pn * tstep : cB;
        float midrs[2][4];
        if constexpr (Epi::MIDSCALE) {
#pragma unroll
            for (int a = 0; a < 2; ++a)
#pragma unroll
                for (int m = 0; m < 4; ++m) midrs[a][m] = E.rowscale(cur.pm * BM + a * HALF + wr * 64 + m * 16 + fr); }
        for (int t = 0; t < nt; t += 2) {
            const bool last = (t == nt - 2);
            if constexpr (Epi::MIDSCALE) { if (t == E.midk()) {
#pragma unroll
                for (int a = 0; a < 2; ++a)
#pragma unroll
                    for (int b = 0; b < 2; ++b)
#pragma unroll
                        for (int m = 0; m < 4; ++m)
#pragma unroll
                            for (int n = 0; n < 2; ++n) acc[a][b][m][n] = acc[a][b][m][n] * midrs[a][m]; } }
            const char* a1 = cA + (size_t)(t + 1) * kstep;
            const char* a2 = last ? nA : cA + (size_t)(t + 2) * kstep; const char* b2 = last ? nB : cB + (size_t)(t + 2) * kstep;
            const char* a3 = a2 + kstep; const char* b3 = b2 + kstep;
            PG8_LDB(B0, 0, 0); PG8_SCHED; PG8_LDA(At, 0, 0); PG8_STAGE(PG8_SA(1, 1), a1 + hstep, voffA);
            PG8_WAIT_L(8); PG8_BAR; PG8_WAIT_L(0); PG8_MMA(0, 0, At, B0); PG8_BAR; PG8_SCHED;
            PG8_LDB(B1, 0, 1); PG8_STAGE(PG8_SB(0, 0), b2, voffA);
            PG8_BAR; PG8_WAIT_L(0); PG8_MMA(0, 1, At, B1); PG8_BAR;
            PG8_LDA(At, 0, 1); PG8_STAGE(PG8_SA(0, 0), a2, voffA);
            PG8_BAR; PG8_WAIT_L(0); PG8_MMA(1, 0, At, B0); PG8_BAR; PG8_SCHED;
            PG8_STAGE(PG8_SB(0, 1), b2 + hstep, voffA);
            PG8_WAIT_V(6); PG8_BAR; PG8_MMA(1, 1, At, B1); PG8_BAR;
            PG8_LDB(B0, 1, 0); PG8_SCHED; PG8_LDA(At, 1, 0); PG8_STAGE(PG8_SA(0, 1), a2 + hstep, voffA);
            PG8_WAIT_L(8); PG8_BAR; PG8_WAIT_L(0); PG8_MMA(0, 0, At, B0); PG8_BAR; PG8_SCHED;
            PG8_LDB(B1, 1, 1); PG8_STAGE(PG8_SB(1, 0), b3, voffA);
            PG8_BAR; PG8_WAIT_L(0); PG8_MMA(0, 1, At, B1); PG8_BAR;
            PG8_LDA(At, 1, 1); PG8_STAGE(PG8_SA(1, 0), a3, voffA);
            PG8_BAR; PG8_WAIT_L(0); PG8_MMA(1, 0, At, B0); PG8_BAR; PG8_SCHED;
            PG8_STAGE(PG8_SB(1, 1), b3 + hstep, voffA);
            PG8_WAIT_V(6); PG8_BAR; PG8_MMA(1, 1, At, B1); PG8_BAR;
        }
        E(acc, cur, wr, wc, fr, fq);
        if (!has_next) break;
#pragma unroll
        for (int a = 0; a < 2; ++a)
#pragma unroll
            for (int b = 0; b < 2; ++b)
#pragma unroll
                for (int m = 0; m < 4; ++m)
#pragma unroll
                    for (int n = 0; n < 2; ++n) acc[a][b][m][n] = (f32x4){0.f, 0.f, 0.f, 0.f};
        cur = nxt; cA = nA; cB = nB; ++ui;
    }
    PG8_WAIT_V(0);
    if (wr == 0) PG8_BAR;
    PG8_BAR;
#undef PG8_SA
#undef PG8_SB
#undef PG8_STAGE
#undef PG8_LDA
#undef PG8_LDB
#undef PG8_MMA
#undef PG8_WAIT_V
#undef PG8_WAIT_L
#undef PG8_BAR
#undef PG8_SCHED
}
template <class Pol, class Epi>
__device__ __forceinline__ void gemm_phase2(PG8_LAS unsigned char* lds, const Pol& P, const Epi& E) {
    const int tid = threadIdx.x, wid = __builtin_amdgcn_readfirstlane(tid >> 6), lane = tid & 63, wr = wid >> 2, wc = wid & 3, fr = lane & 15, fq = lane >> 4;
    const int nt = P.nk();
    const unsigned ldsw = (unsigned)wid * 1024u;
    const int aoff = lds_byte(wr * 64 + fr, fq * 8), boff = lds_byte(wc * 32 + fr, fq * 8);
#define PG8_SA(b, h) (((b) * 2 + (h)) * HTB)
#define PG8_SB(b, h) ((4 + (b) * 2 + (h)) * HTB)
#define PG8_STAGE_A(bufoff, AS, h, kt) do { _Pragma("unroll") for (int _i = 0; _i < 2; ++_i) \
        __builtin_amdgcn_global_load_lds((const unsigned*)P.pa(AS, h, _i, kt), (PG8_LAS unsigned*)(lds + (bufoff) + ldsw + _i * 8192), 16, 0, 0); } while (0)
#define PG8_STAGE_B(bufoff, BS, h, kt) do { _Pragma("unroll") for (int _i = 0; _i < 2; ++_i) \
        __builtin_amdgcn_global_load_lds((const unsigned*)P.pb(BS, h, _i, kt), (PG8_LAS unsigned*)(lds + (bufoff) + ldsw + _i * 8192), 16, 0, 0); } while (0)
#define PG8_LDA(dst, b, h) do { _Pragma("unroll") for (int m = 0; m < 4; ++m) _Pragma("unroll") for (int k = 0; k < 2; ++k) dst[m][k] = *(const PG8_LAS bf16x8*)(lds + PG8_SA(b, h) + aoff + m * 2048 + k * 1024); } while (0)
#define PG8_LDB(dst, b, h) do { _Pragma("unroll") for (int n = 0; n < 2; ++n) _Pragma("unroll") for (int k = 0; k < 2; ++k) dst[n][k] = *(const PG8_LAS bf16x8*)(lds + PG8_SB(b, h) + boff + n * 2048 + k * 1024); } while (0)
#define PG8_MMA(ai, bj, At, Bt) do { __builtin_amdgcn_s_setprio(1); _Pragma("unroll") for (int m = 0; m < 4; ++m) _Pragma("unroll") for (int n = 0; n < 2; ++n) _Pragma("unroll") for (int k = 0; k < 2; ++k) \
        acc[ai][bj][m][n] = __builtin_amdgcn_mfma_f32_16x16x32_bf16(Bt[n][k], At[m][k], acc[ai][bj][m][n], 0, 0, 0); __builtin_amdgcn_s_setprio(0); } while (0)
#define PG8_STAGE_A2(bufoff, h, kt) do { _Pragma("unroll") for (int _i = 0; _i < 2; ++_i) \
        __builtin_amdgcn_global_load_lds((const unsigned*)P.pa(a2, h, _i, kt), (PG8_LAS unsigned*)(lds + (bufoff) + ldsw + _i * 8192), 16, 0, 0); } while (0)
#define PG8_STAGE_B2(bufoff, h, kt) do { _Pragma("unroll") for (int _i = 0; _i < 2; ++_i) \
        __builtin_amdgcn_global_load_lds((const unsigned*)P.pb(b2, h, _i, kt), (PG8_LAS unsigned*)(lds + (bufoff) + ldsw + _i * 8192), 16, 0, 0); } while (0)
#define PG8_WAIT_V(n) asm volatile("s_waitcnt vmcnt(" #n ")" ::: "memory")
#define PG8_WAIT_L(n) asm volatile("s_waitcnt lgkmcnt(" #n ")" ::: "memory")
#define PG8_BAR __builtin_amdgcn_s_barrier()
#define PG8_SCHED __builtin_amdgcn_sched_barrier(0)
    typename Pol::Unit cur, nxt; int ui = 0;
    if (!P.next(0, cur)) return;
    f32x4 acc[2][2][4][2];
#pragma unroll
    for (int a = 0; a < 2; ++a)
#pragma unroll
        for (int b = 0; b < 2; ++b)
#pragma unroll
            for (int m = 0; m < 4; ++m)
#pragma unroll
                for (int n = 0; n < 2; ++n) acc[a][b][m][n] = (f32x4){0.f, 0.f, 0.f, 0.f};
    bf16x8 At[4][2], B0[2][2], B1[2][2];
    typename Pol::AddrA aC, aN; typename Pol::AddrB bC, bN;
    P.addrA(cur, aC); P.addrB(cur, bC);
    PG8_STAGE_B(PG8_SB(0, 0), bC, 0, 0); PG8_STAGE_A(PG8_SA(0, 0), aC, 0, 0); PG8_STAGE_B(PG8_SB(0, 1), bC, 1, 0); PG8_STAGE_A(PG8_SA(0, 1), aC, 1, 0);
    if (wr == 1) PG8_BAR;
    PG8_WAIT_V(4); PG8_BAR;
    PG8_STAGE_B(PG8_SB(1, 0), bC, 0, 1); PG8_STAGE_A(PG8_SA(1, 0), aC, 0, 1); PG8_STAGE_B(PG8_SB(1, 1), bC, 1, 1);
    PG8_WAIT_V(6); PG8_BAR;
    for (;;) {
        const bool has_next = P.next(ui + 1, nxt);
        if (has_next) { P.addrA(nxt, aN); P.addrB(nxt, bN); } else { aN = aC; bN = bC; }
        const bool full = P.full(cur);
        for (int t = 0; t < nt; t += 2) {
            const bool last = (t == nt - 2);
            const typename Pol::AddrA a2 = last ? aN : aC; const typename Pol::AddrB b2 = last ? bN : bC;
            const int k2 = last ? 0 : t + 2, k3 = k2 + 1;
            PG8_LDB(B0, 0, 0); PG8_SCHED; PG8_LDA(At, 0, 0); PG8_STAGE_A(PG8_SA(1, 1), aC, 1, t + 1);
            PG8_WAIT_L(8); PG8_BAR; PG8_WAIT_L(0); PG8_MMA(0, 0, At, B0); PG8_BAR; PG8_SCHED;
            PG8_LDB(B1, 0, 1); PG8_STAGE_B2(PG8_SB(0, 0), 0, k2);
            PG8_BAR; PG8_WAIT_L(0); PG8_MMA(0, 1, At, B1); PG8_BAR;
            PG8_LDA(At, 0, 1); PG8_STAGE_A2(PG8_SA(0, 0), 0, k2);
            PG8_BAR; PG8_WAIT_L(0); if (full) PG8_MMA(1, 0, At, B0); PG8_BAR; PG8_SCHED;
            PG8_STAGE_B2(PG8_SB(0, 1), 1, k2);
            PG8_WAIT_V(6); PG8_BAR; if (full) PG8_MMA(1, 1, At, B1); PG8_BAR;
            PG8_LDB(B0, 1, 0); PG8_SCHED; PG8_LDA(At, 1, 0); PG8_STAGE_A2(PG8_SA(0, 1), 1, k2);
            PG8_WAIT_L(8); PG8_BAR; PG8_WAIT_L(0); PG8_MMA(0, 0, At, B0); PG8_BAR; PG8_SCHED;
            PG8_LDB(B1, 1, 1); PG8_STAGE_B2(PG8_SB(1, 0), 0, k3);
            PG8_BAR; PG8_WAIT_L(0); PG8_MMA(0, 1, At, B1); PG8_BAR;
            PG8_LDA(At, 1, 1); PG8_STAGE_A2(PG8_SA(1, 0), 0, k3);
            PG8_BAR; PG8_WAIT_L(0); if (full) PG8_MMA(1, 0, At, B0); PG8_BAR; PG8_SCHED;
            PG8_STAGE_B2(PG8_SB(1, 1), 1, k3);
            PG8_WAIT_V(6); PG8_BAR; if (full) PG8_MMA(1, 1, At, B1); PG8_BAR;
        }
        E(acc, cur, wr, wc, fr, fq);
        if (!has_next) break;
#pragma unroll
        for (int a = 0; a < 2; ++a)
#pragma unroll
            for (int b = 0; b < 2; ++b)
#pragma unroll
                for (int m = 0; m < 4; ++m)
#pragma unroll
                    for (int n = 0; n < 2; ++n) acc[a][b][m][n] = (f32x4){0.f, 0.f, 0.f, 0.f};
        cur = nxt; aC = aN; bC = bN; ++ui;
    }
    PG8_WAIT_V(0);
    if (wr == 0) PG8_BAR;
    PG8_BAR;
#undef PG8_SA
#undef PG8_SB
#undef PG8_STAGE_A
#undef PG8_STAGE_B
#undef PG8_STAGE_A2
#undef PG8_STAGE_B2
#undef PG8_LDA
#undef PG8_LDB
#undef PG8_MMA
#undef PG8_WAIT_V
#undef PG8_WAIT_L
#undef PG8_BAR
#undef PG8_SCHED
}
__host__ __device__ __forceinline__ int perm_lo(int x) { return (((x >> 2) & 3) << 3) | (((x >> 4) & 1) << 2) | (x & 3); }
__host__ __device__ __forceinline__ int inv_perm_lo(int y) { return (((y >> 2) & 1) << 4) | (((y >> 3) & 3) << 2) | (y & 3); }
__host__ __device__ __forceinline__ int logcol(int p) { return (p & ~255) + 64 * ((p >> 5) & 3) + 32 * ((p >> 7) & 1) + perm_lo(p & 31); }
}

template <class SRC>
DEV void convert_tile(float* tl, const SRC& src, bf16_t* dst, int ldd, int n0, int k0) {
    const int tid = threadIdx.x;
    {
        const int n = tid & 63;
#pragma unroll
        for (int i = 0; i < 8; ++i) { const int kk = (tid >> 6) + 8 * i; tl[kk * 65 + n] = src.get(n0 + n, k0 + kk); }
    }
    __syncthreads();
    {
        const int n = tid >> 3, kc = tid & 7;
        const float* s = tl + (kc * 8) * 65 + n;
        u32x4 o;
        o.x = pk2(s[0 * 65], s[1 * 65]); o.y = pk2(s[2 * 65], s[3 * 65]); o.z = pk2(s[4 * 65], s[5 * 65]); o.w = pk2(s[6 * 65], s[7 * 65]);
        *(u32x4*)(dst + (size_t)(n0 + n) * ldd + k0 + kc * 8) = o;
    }
    __syncthreads();
}
struct SrcWin { const float* w; const float* g;
    DEV float get(int np, int k) const { const int n = pg8::logcol(np); int col; if (n < 1280) col = n; else if (n < 3328) col = n + 24; else if (n < 3352) col = 1280 + (n - 3328); else return 0.f;
        return w[(size_t)k * IN_COLS + col] * g[k]; } };
struct SrcWout { const float* w; const float* g;
    DEV float get(int np, int k) const { const int n = pg8::logcol(np); const float v = w[(size_t)k * DM + n]; return k < 512 ? v * g[k] : v; } };
struct SrcPlain { const float* w; int ld;
    DEV float get(int n, int k) const { return w[(size_t)k * ld + n]; } };
struct SrcW13 { const float* w1; const float* w3; const float* g;
    DEV float get(int n, int k) const { const uintptr_t a = (uintptr_t)w1, b = (uintptr_t)w3; const float* w = (const float*)(a + ((b - a) & (uintptr_t)(0 - (long long)(n & 1))));
        return w[(size_t)k * 512 + (n >> 1)] * g[k]; } };

template <class SRC>
DEV void convert_tile256(float* tl, const SRC& src, bf16_t* dst, int ldd, int n0, int k0) {
    const int tid = threadIdx.x;
    {
        const int q = tid & 63;
        f32x4 v[8];
#pragma unroll
        for (int i = 0; i < 8; ++i) v[i] = src.quad(n0, q, k0 + (tid >> 6) + 8 * i);
#pragma unroll
        for (int i = 0; i < 8; ++i) { float* o = tl + ((tid >> 6) + 8 * i) * 257; o[src.drow(q, 0)] = v[i].x; o[src.drow(q, 1)] = v[i].y; o[src.drow(q, 2)] = v[i].z; o[src.drow(q, 3)] = v[i].w; }
    }
    __syncthreads();
#pragma unroll
    for (int i = 0; i < 4; ++i) {
        const int idx = tid + NT * i, n = idx >> 3, kc = idx & 7;
        const float* s = tl + (kc * 8) * 257 + n;
        u32x4 o;
        o.x = pk2(s[0 * 257], s[1 * 257]); o.y = pk2(s[2 * 257], s[3 * 257]); o.z = pk2(s[4 * 257], s[5 * 257]); o.w = pk2(s[6 * 257], s[7 * 257]);
        *(u32x4*)(dst + (size_t)(n0 + n) * ldd + k0 + kc * 8) = o;
    }
    __syncthreads();
}
struct SrcWin4 { const float* w; const float* g;
    DEV int drow(int q, int e) const { return 4 * q + e; }
    DEV f32x4 quad(int n0, int q, int k) const { const int n = pg8::logcol(n0 + 4 * q); int col; if (n < 1280) col = n; else if (n < 3328) col = n + 24; else if (n < 3352) col = 1280 + (n - 3328); else return (f32x4){0.f, 0.f, 0.f, 0.f};
        return *(const f32x4*)(w + (size_t)k * IN_COLS + col) * g[k]; } };
struct SrcWout4 { const float* w; const float* g;
    DEV int drow(int q, int e) const { return 4 * q + e; }
    DEV f32x4 quad(int n0, int q, int k) const { const f32x4 v = *(const f32x4*)(w + (size_t)k * DM + pg8::logcol(n0 + 4 * q)); return k < 512 ? v * g[k] : v; } };
struct SrcPlain4 { const float* w; int ld;
    DEV int drow(int q, int e) const { return 4 * q + e; }
    DEV f32x4 quad(int n0, int q, int k) const { return *(const f32x4*)(w + (size_t)k * ld + n0 + 4 * q); } };
struct SrcW13_4 { const float* w1; const float* w3; const float* g;
    DEV int drow(int q, int e) const { const int l = 8 * (q & 31) + 2 * e + (q >> 5); return (l & ~31) | pg8::inv_perm_lo(l & 31); }
    DEV f32x4 quad(int n0, int q, int k) const { const uintptr_t a = (uintptr_t)w1, b = (uintptr_t)w3; const float* w = (const float*)(a + ((b - a) & (uintptr_t)(0 - (long long)(q >> 5))));
        return *(const f32x4*)(w + (size_t)k * 512 + (n0 >> 1) + 4 * (q & 31)) * g[k]; } };

DEV void phase_prologue(const Params& p, unsigned char* lds) {
    float* tl = (float*)lds;
    const int tid = threadIdx.x, lane = tid & 63, wid = tid >> 6;
    const int vb = vblock(), G = gridDim.x;
    unsigned char* ws = p.ws;
    constexpr int I_WIN = (INP / 256) * (DM / 64);
    constexpr int I_WOUT = 4 * 16;
    constexpr int I_CW1 = 2 * 32;
    constexpr int I_W2 = 32 * 4 * 8;
    constexpr int I_CW2 = 2 * 1 * 4;
    constexpr int I_ALL = I_WIN + I_WOUT + I_CW1 + I_W2 + I_CW2;
    for (int it = vb; it < I_ALL; it += G) {
        int r = it;
        if (r < I_WIN) { SrcWin4 s{p.w_in, p.attn_g}; convert_tile256(tl, s, (bf16_t*)(ws + WS_WINT), DM, (r / 16) * 256, (r % 16) * 64); continue; } r -= I_WIN;
        if (r < I_WOUT) { SrcWout4 s{p.w_out, p.g_nsa}; convert_tile256(tl, s, (bf16_t*)(ws + WS_WOUTT), DM, (r / 16) * 256, (r % 16) * 64); continue; } r -= I_WOUT;
        if (r < I_CW1) { const int z = r / 32, q = r % 32; SrcPlain4 s{z ? p.wv1 : p.wk1, 256};
            convert_tile256(tl, s, (bf16_t*)(ws + WS_CW1T) + (size_t)z * 256 * 2048, 2048, 0, q * 64); continue; } r -= I_CW1;
        if (r < I_W2) { const int e = r / 32, q = r % 32; SrcPlain4 s{p.w2 + (size_t)e * 512 * 1024, 1024};
            convert_tile256(tl, s, (bf16_t*)(ws + WS_W2T) + (size_t)e * 1024 * 512, 512, (q / 8) * 256, (q % 8) * 64); continue; } r -= I_W2;
        { const int z = r / 4, q = r % 4; SrcPlain s{z ? p.wv2 : p.wk2, 64};
            convert_tile(tl, s, (bf16_t*)(ws + WS_CW2T) + (size_t)z * 64 * 256, 256, 0, q * 64); }
    }
    {
        bf16_t* xb = (bf16_t*)(ws + WS_R1); float* rstd1 = (float*)(ws + WS_RSTD1);
        const int gw = vb * 8 + wid, NGW = G * 8;
        for (int m = gw; m < NTOK; m += NGW) {
            const f32x4* xr = (const f32x4*)(p.x + (size_t)m * DM) + lane;
            f32x4 v[4]; float s = 0.f;
#pragma unroll
            for (int j = 0; j < 4; ++j) { v[j] = xr[64 * j]; s += (v[j].x * v[j].x + v[j].y * v[j].y) + (v[j].z * v[j].z + v[j].w * v[j].w); }
            s = wave_sum(s);
            if (lane == 0) rstd1[m] = rsqrtf(s * (1.f / DM) + RMS_EPS);
            u32x2* o = (u32x2*)(xb + (size_t)m * DM) + lane;
#pragma unroll
            for (int j = 0; j < 4; ++j) { u32x2 w; w.x = pk2(v[j].x, v[j].y); w.y = pk2(v[j].z, v[j].w); o[64 * j] = w; }
        }
    }
    {
        const int gt = vb * NT + tid, NG = G * NT;
        float* rowss = (float*)(ws + WS_ROWSS);
        for (int i = gt; i < NTOK; i += NG) rowss[i] = 0.f;
        int* bincnt = (int*)(ws + WS_CTL);
        if (gt < 128) bincnt[gt] = 0;
        if (gt < 32) ((int*)(ws + WS_CTL + 512))[gt] = 0;
        if (gt < 512) { const float l0 = p.lb_logits[gt], l1 = p.lb_logits[512 + gt]; ((float*)(ws + WS_LB))[gt] = 1.f / (1.f + __expf(l1 - l0)); }
        for (int i = gt; i < 48 * 1024; i += NG) { const int c = i >> 10, k = i & 1023;
            const float w = (c < 4 ? p.w_group[k * 4 + c] : (c < 36 ? p.w_expert[k * 32 + (c - 4)] : 0.f)) * p.ffn_g[k];
            const bf16_t hi = f2bf(w); const bf16_t lo = f2bf(w - bf2f(hi));
            ((bf16_t*)(ws + WS_RW))[i] = hi; ((bf16_t*)(ws + WS_RW))[48 * 1024 + i] = lo; }
        if (blockIdx.x == (unsigned)(G - 1)) {
            const int z = tid >> 8, j = tid & 255; const float* pos = z ? p.pos_v : p.pos_k; const float* w = z ? p.wv1 : p.wk1;
            float a = 0.f;
            for (int k = 0; k < 2048; ++k) a += pos[k] * w[(size_t)k * 256 + j];
            ((float*)(ws + WS_CBIAS))[z * 256 + j] = a;
        }
    }
}

constexpr int G_A_BYTES = 128 * 128, G_B_BYTES = 256 * 128, G_STAGE = G_A_BYTES + G_B_BYTES, G_LDS = 2 * G_STAGE;
DEV int swz(int row, int chunk) { return row * 128 + ((chunk ^ ((row >> 1) & 7)) << 4); }
template <class AL, class BL, class EP>
DEV void gemm_tile(unsigned char* lds, const AL& al, const BL& bl, int nk, const EP& ep) {
    const int tid = threadIdx.x, lane = tid & 63, wid = tid >> 6, wr = wid >> 2, wc = wid & 3;
    const int frow = lane & 15, fq = lane >> 4;
    const bf16_t* aptr[2]; int aoff[2], boff[4], brow[4];
#pragma unroll
    for (int i = 0; i < 2; ++i) { const int q = tid + NT * i, row = q >> 3, ch = q & 7; aptr[i] = al.row(row) + ch * 8; aoff[i] = swz(row, ch); }
#pragma unroll
    for (int i = 0; i < 4; ++i) { const int q = tid + NT * i, row = q >> 3, ch = q & 7; brow[i] = row; boff[i] = G_A_BYTES + swz(row, ch) ; }
    const int bch8 = (tid & 7) * 8;
    u32x4 ra[2], rb[4];
#pragma unroll
    for (int i = 0; i < 2; ++i) ra[i] = *(const u32x4*)(aptr[i]);
#pragma unroll
    for (int i = 0; i < 4; ++i) rb[i] = *(const u32x4*)(bl.ptr(brow[i], 0) + bch8);
#pragma unroll
    for (int i = 0; i < 2; ++i) *(u32x4*)(lds + aoff[i]) = ra[i];
#pragma unroll
    for (int i = 0; i < 4; ++i) *(u32x4*)(lds + boff[i]) = rb[i];
    __syncthreads();
    f32x4 acc[4][4];
#pragma unroll
    for (int m = 0; m < 4; ++m)
#pragma unroll
        for (int n = 0; n < 4; ++n) acc[m][n] = (f32x4){0.f, 0.f, 0.f, 0.f};
    const int sx = (frow >> 1) & 7;
    for (int kt = 0; kt < nk; ++kt) {
        const bool more = (kt + 1 < nk);
        if (more) {
#pragma unroll
            for (int i = 0; i < 2; ++i) ra[i] = *(const u32x4*)(aptr[i] + (kt + 1) * 64);
#pragma unroll
            for (int i = 0; i < 4; ++i) rb[i] = *(const u32x4*)(bl.ptr(brow[i], kt + 1) + bch8);
        }
        const unsigned char* base = lds + (kt & 1) * G_STAGE;
#pragma unroll
        for (int ks = 0; ks < 2; ++ks) {
            const int co = ((ks * 4 + fq) ^ sx) << 4;
            bf16x8 af[4], bfr[4];
#pragma unroll
            for (int m = 0; m < 4; ++m) af[m] = *(const bf16x8*)(base + (wr * 64 + m * 16 + frow) * 128 + co);
#pragma unroll
            for (int n = 0; n < 4; ++n) bfr[n] = *(const bf16x8*)(base + G_A_BYTES + (wc * 64 + n * 16 + frow) * 128 + co);
#pragma unroll
            for (int m = 0; m < 4; ++m)
#pragma unroll
                for (int n = 0; n < 4; ++n) acc[m][n] = __builtin_amdgcn_mfma_f32_16x16x32_bf16(bfr[n], af[m], acc[m][n], 0, 0, 0);
        }
        if (more) {
            unsigned char* nb = lds + ((kt + 1) & 1) * G_STAGE;
#pragma unroll
            for (int i = 0; i < 2; ++i) *(u32x4*)(nb + aoff[i]) = ra[i];
#pragma unroll
            for (int i = 0; i < 4; ++i) *(u32x4*)(nb + boff[i]) = rb[i];
        }
        __syncthreads();
    }
    ep(acc, wr, wc, lane);
}

struct ARows { const bf16_t* base; size_t ld; DEV const bf16_t* row(int r) const { return base + (size_t)r * ld; } };
struct BRows { const bf16_t* base; size_t ld; DEV const bf16_t* ptr(int n, int kt) const { return base + (size_t)n * ld + kt * 64; } };

DEV u32x4 pk8(const f32x4 a, const f32x4 b) { u32x4 w; w.x = pk2(a.x, a.y); w.y = pk2(a.z, a.w); w.z = pk2(b.x, b.y); w.w = pk2(b.z, b.w); return w; }
DEV void inproj_row(const Params& p, int seg, int row, f32x4 (&v)[2][2], int fq) {
    unsigned char* ws = p.ws;
    const float rs = ((const float*)(ws + WS_RSTD1))[row];
#pragma unroll
    for (int bj = 0; bj < 2; ++bj) { v[bj][0] = v[bj][0] * rs; v[bj][1] = v[bj][1] * rs; }
    const int b = row >> 12, s = row & 4095;
    const bool is_q = seg < 8, is_ks = (seg == 12 || seg == 13), is_kw = (seg == 16 || seg == 17);
    if (is_q || is_ks || is_kw) {
        const float* gw = is_q ? p.g_q : (is_ks ? p.g_k + 64 : p.g_k + 128);
        bf16_t* dst; int hh, nh;
        if (is_q) { dst = (bf16_t*)(ws + WS_Q); hh = seg; nh = 8; } else if (is_ks) { dst = (bf16_t*)(ws + WS_KS); hh = seg - 12; nh = 2; } else { dst = (bf16_t*)(ws + WS_KW); hh = seg - 16; nh = 2; }
        float ss = 0.f;
#pragma unroll
        for (int bj = 0; bj < 2; ++bj)
#pragma unroll
            for (int n = 0; n < 2; ++n) ss += (v[bj][n].x * v[bj][n].x + v[bj][n].y * v[bj][n].y) + (v[bj][n].z * v[bj][n].z + v[bj][n].w * v[bj][n].w);
        ss += __shfl_xor(ss, 16); ss += __shfl_xor(ss, 32);
        float r = rsqrtf(ss * (1.f / 64.f) + RMS_EPS); if (is_q) r *= QSCALE;
        bf16_t* o = dst + ((size_t)(b * nh + hh) * SEQ + s) * 64 + fq * 8;
#pragma unroll
        for (int bj = 0; bj < 2; ++bj) { const f32x4 g0 = *(const f32x4*)(gw + 32 * bj + 8 * fq), g1 = *(const f32x4*)(gw + 32 * bj + 8 * fq + 4);
            *(u32x4*)(o + 32 * bj) = pk8(v[bj][0] * g0 * r, v[bj][1] * g1 * r); }
        return;
    }
    if (seg >= 8 && seg < 12) {
        bf16_t* o = (bf16_t*)(ws + (seg < 10 ? WS_KC : WS_VC)) + ((size_t)(b * 2 + (seg & 1)) * SEQ + s) * 64 + fq * 8;
#pragma unroll
        for (int bj = 0; bj < 2; ++bj) *(u32x4*)(o + 32 * bj) = pk8(v[bj][0], v[bj][1]);
        return;
    }
    if (seg == 14 || seg == 15 || seg == 18 || seg == 19) {
        bf16_t* o = (bf16_t*)(ws + (seg < 16 ? WS_VST : WS_VWT)) + (size_t)(b * 2 + (seg & 1)) * 64 * SEQ + s;
#pragma unroll
        for (int bj = 0; bj < 2; ++bj)
#pragma unroll
            for (int n = 0; n < 2; ++n) { const int d = 32 * bj + 8 * fq + 4 * n; const f32x4 x = v[bj][n];
                o[(size_t)(d + 0) * SEQ] = f2bf(x.x); o[(size_t)(d + 1) * SEQ] = f2bf(x.y); o[(size_t)(d + 2) * SEQ] = f2bf(x.z); o[(size_t)(d + 3) * SEQ] = f2bf(x.w); }
        return;
    }
    if (seg < 52) {
        const int kind = (seg - 20) >> 3, cb = ((seg - 20) & 7) * 64 + fq * 8;
        if (kind == 1) {
            const float* lb = (const float*)(ws + WS_LB); bf16_t* dst = (bf16_t*)(ws + WS_HLOGF) + (size_t)row * 512 + cb;
#pragma unroll
            for (int bj = 0; bj < 2; ++bj) { f32x4 o[2];
#pragma unroll
                for (int n = 0; n < 2; ++n) { const f32x4 l = *(const f32x4*)(lb + cb + 32 * bj + 4 * n); const f32x4 x = v[bj][n];
                    o[n].x = __logf(l.x + (1.f - l.x) * sigmoidf_(x.x)); o[n].y = __logf(l.y + (1.f - l.y) * sigmoidf_(x.y));
                    o[n].z = __logf(l.z + (1.f - l.z) * sigmoidf_(x.z)); o[n].w = __logf(l.w + (1.f - l.w) * sigmoidf_(x.w)); }
                *(u32x4*)(dst + 32 * bj) = pk8(o[0], o[1]); }
        } else {
            bf16_t* dst = (bf16_t*)(ws + (kind == 0 ? WS_HQ : (kind == 2 ? WS_HV : WS_HG))) + (size_t)row * 512 + cb;
#pragma unroll
            for (int bj = 0; bj < 2; ++bj) { f32x4 x0 = v[bj][0], x1 = v[bj][1];
                if (kind != 2) { x0.x = siluf_(x0.x); x0.y = siluf_(x0.y); x0.z = siluf_(x0.z); x0.w = siluf_(x0.w); x1.x = siluf_(x1.x); x1.y = siluf_(x1.y); x1.z = siluf_(x1.z); x1.w = siluf_(x1.w); }
                *(u32x4*)(dst + 32 * bj) = pk8(x0, x1); }
        }
        return;
    }
    {
        float* dst = (float*)(ws + WS_GATES) + (size_t)row * 24;
        if (fq < 3) {
#pragma unroll
            for (int n = 0; n < 2; ++n) { const f32x4 x = v[0][n]; f32x4 o; o.x = sigmoidf_(x.x); o.y = sigmoidf_(x.y); o.z = sigmoidf_(x.z); o.w = sigmoidf_(x.w); *(f32x4*)(dst + 8 * fq + 4 * n) = o; } }
    }
}
struct EpiInproj8 { const Params& p; static constexpr bool MIDSCALE = false; DEV float rowscale(int) const { return 1.f; } DEV int midk() const { return -1; }
    DEV void operator()(const f32x4 (&acc)[2][2][4][2], const pg8::Unit& u, int wr, int wc, int fr, int fq) const {
        const int seg = u.pn * 4 + wc;
        if (seg > 52) return;
#pragma unroll
        for (int ai = 0; ai < 2; ++ai)
#pragma unroll
            for (int m = 0; m < 4; ++m) { f32x4 v[2][2] = {{acc[ai][0][m][0], acc[ai][0][m][1]}, {acc[ai][1][m][0], acc[ai][1][m][1]}};
                inproj_row(p, seg, u.pm * 256 + ai * 128 + wr * 64 + m * 16 + fr, v, fq); }
    } };
DEV void phase_inproj(const Params& p, unsigned char* lds) {
    pg8::Gemm g{(const bf16_t*)(p.ws + WS_R1), (const bf16_t*)(p.ws + WS_WINT), NTOK, INP, DM};
    pg8::StaticOrder S; S.init(NTOK, INP, (int)gridDim.x, (int)blockIdx.x);
    EpiInproj8 E{p};
    pg8::gemm_phase(( PG8_LAS unsigned char*)lds, g, S, E);
}

struct ACmp { const bf16_t* src; int bg, c0;
    DEV const bf16_t* row(int r) const { int c = c0 + r; if (c > NC - 1) c = NC - 1; return src + ((size_t)bg * SEQ + 16 * c) * 64; } };
struct EpiCmpA { const Params& p; int z, rbase;
    DEV void operator()(f32x4 (&acc)[4][4], int wr, int wc, int lane) const {
        const int frow = lane & 15, fq = lane >> 4;
        const float* cb = (const float*)(p.ws + WS_CBIAS) + z * 256; bf16_t* hid = (bf16_t*)(p.ws + WS_HID) + (size_t)z * 4096 * 256;
#pragma unroll
        for (int m = 0; m < 4; ++m) { const int rr = rbase + wr * 64 + m * 16 + frow;
#pragma unroll
            for (int n = 0; n < 4; ++n) { const int c = wc * 64 + n * 16 + fq * 4; const f32x4 b = *(const f32x4*)(cb + c); f32x4 v = acc[m][n] + b;
                u32x2 w; w.x = pk2(siluf_(v.x), siluf_(v.y)); w.y = pk2(siluf_(v.z), siluf_(v.w)); *(u32x2*)(hid + (size_t)rr * 256 + c) = w; } }
    } };
DEV void phase_cmp_a(const Params& p, unsigned char* lds) {
    const int vb = vblock(), G = gridDim.x;
    for (int u = vb; u < 64; u += G) {
        const int z = u >> 5, rbase = (u & 31) * 128;
        ACmp al{(const bf16_t*)(p.ws + (z ? WS_VC : WS_KC)), (u & 31) >> 1, (u & 1) * 128};
        BRows bl{(const bf16_t*)(p.ws + WS_CW1T) + (size_t)z * 256 * 2048, 2048};
        EpiCmpA ep{p, z, rbase};
        gemm_tile(lds, al, bl, 2048 / 64, ep);
    }
}
struct BClamp64 { const bf16_t* base; size_t ld; DEV const bf16_t* ptr(int n, int kt) const { return base + (size_t)(n & 63) * ld + kt * 64; } };
struct EpiCmpB { const Params& p; int z, rbase;
    DEV void operator()(f32x4 (&acc)[4][4], int wr, int wc, int lane) const {
        if (wc != 0) return;
        const int frow = lane & 15, fq = lane >> 4;
        bf16_t* dst = (bf16_t*)(p.ws + (z ? WS_VCMP : WS_KCMP));
#pragma unroll
        for (int m = 0; m < 4; ++m) { const int rr = rbase + wr * 64 + m * 16 + frow;
            float r = 1.f;
            if (z == 0) { float ss = 0.f;
#pragma unroll
                for (int n = 0; n < 4; ++n) { const f32x4 v = acc[m][n]; ss += (v.x * v.x + v.y * v.y) + (v.z * v.z + v.w * v.w); }
                ss += __shfl_xor(ss, 16); ss += __shfl_xor(ss, 32); r = rsqrtf(ss * (1.f / 64.f) + RMS_EPS); }
            const int bg = rr >> 8, c = rr & 255;
            if (c < NC) {
#pragma unroll
                for (int n = 0; n < 4; ++n) { const int d = n * 16 + fq * 4; f32x4 v = acc[m][n] * r;
                    if (z == 0) { const f32x4 g = *(const f32x4*)(p.g_k + d); v = v * g;
                        u32x2 w; w.x = pk2(v.x, v.y); w.y = pk2(v.z, v.w); *(u32x2*)(dst + ((size_t)bg * 256 + c) * 64 + d) = w; }
                    else { bf16_t* o = dst + ((size_t)bg * 64 + d) * 256 + c; o[0] = f2bf(v.x); o[256] = f2bf(v.y); o[512] = f2bf(v.z); o[768] = f2bf(v.w); } } }
        }
    } };
DEV void phase_cmp_b(const Params& p, unsigned char* lds) {
    const int vb = vblock(), G = gridDim.x;
    for (int u = vb; u < 64; u += G) {
        const int z = u >> 5, rbase = (u & 31) * 128;
        ARows al{(const bf16_t*)(p.ws + WS_HID) + ((size_t)z * 4096 + rbase) * 256, 256};
        BClamp64 bl{(const bf16_t*)(p.ws + WS_CW2T) + (size_t)z * 64 * 256, 256};
        EpiCmpB ep{p, z, rbase};
        gemm_tile(lds, al, bl, 256 / 64, ep);
    }
}

constexpr int CM_K = 0, CM_V = 32768, CM_VSTR = 520, CM_IMP = CM_V + 64 * CM_VSTR, CM_LDS = CM_IMP + 4 * 16384 + 1024;
DEV void cm_scores(const unsigned char* kbase, int kt, const bf16x8 (&qf)[4], int r31, int hh, f32x16 (&sacc)[2]) {
#pragma unroll
    for (int kt2 = 0; kt2 < 2; ++kt2) {
#pragma unroll
        for (int i = 0; i < 16; ++i) sacc[kt2][i] = 0.f;
        const int row = 64 * kt + 32 * kt2 + r31; const int sx = (row >> 1) & 7;
#pragma unroll
        for (int s = 0; s < 4; ++s) { const bf16x8 kf = *(const bf16x8*)(kbase + row * 128 + (((2 * s + hh) ^ sx) << 4));
            sacc[kt2] = __builtin_amdgcn_mfma_f32_32x32x16_bf16(kf, qf[s], sacc[kt2], 0, 0, 0); }
    }
}
DEV void phase_cmp_attn(const Params& p, unsigned char* lds) {
    const int tid = threadIdx.x, lane = tid & 63, wid = tid >> 6;
    const int vb = vblock(), G = gridDim.x;
    unsigned char* ws = p.ws;
    const int r31 = lane & 31, hh = lane >> 5;
    float* impl = (float*)(lds + CM_IMP);
    for (int it = vb; it < 1024; it += G) {
        int ci, bg;
        if (G == 256) { const int x = vb >> 5, jb = vb & 31, rnd = it / G, i = rnd * 32 + ((rnd & 1) ? 31 - jb : jb); ci = 63 - (i >> 1); bg = 2 * x + (i & 1); }
        else { ci = 63 - (it >> 4); bg = it & 15; }
        const int b = bg >> 1, g = bg & 1;
        const int nvis = min(NC, 4 * ci + 3), ntile = (nvis + 63) >> 6;
        const int head = g * 4 + (wid >> 1);
        const int tokl = (wid & 1) * 32 + r31, t = ci * 64 + tokl;
        const size_t tok = (size_t)b * SEQ + t;
        const int nv = t >= 31 ? min(NC, (t - 31) / 16 + 1) : 0;
        __syncthreads();
        {
            const bf16_t* kc = (const bf16_t*)(ws + WS_KCMP) + (size_t)bg * 256 * 64; const bf16_t* vt = (const bf16_t*)(ws + WS_VCMP) + (size_t)bg * 64 * 256;
            const int cpr = ntile * 8;
            u32x4 rk[4], rv[4];
#pragma unroll
            for (int i = 0; i < 4; ++i) if (i < ntile) { const int idx = tid + NT * i; rk[i] = *(const u32x4*)(kc + (idx >> 3) * 64 + (idx & 7) * 8); const int d = idx / cpr, ck = idx % cpr; rv[i] = *(const u32x4*)(vt + d * 256 + ck * 8); }
#pragma unroll
            for (int i = 0; i < 4; ++i) if (i < ntile) { const int idx = tid + NT * i; *(u32x4*)(lds + CM_K + swz(idx >> 3, idx & 7)) = rk[i];
                const int d = idx / cpr, ck = idx % cpr; u32x2 a, c2; a.x = rv[i].x; a.y = rv[i].y; c2.x = rv[i].z; c2.y = rv[i].w; unsigned char* o = lds + CM_V + d * CM_VSTR + ck * 16; *(u32x2*)o = a; *(u32x2*)(o + 8) = c2; }
        }
        bf16x8 qf[4];
        { const bf16_t* qp = (const bf16_t*)(ws + WS_Q) + ((size_t)(b * 8 + head) * SEQ + t) * 64 + 8 * hh;
#pragma unroll
            for (int s = 0; s < 4; ++s) qf[s] = *(const bf16x8*)(qp + 16 * s); }
        __syncthreads();
        float l_run = 0.f;
        f32x16 ot[2];
#pragma unroll
        for (int dt = 0; dt < 2; ++dt)
#pragma unroll
            for (int i = 0; i < 16; ++i) ot[dt][i] = 0.f;
        float carry = 0.f;
#pragma unroll
        for (int kt = 0; kt < 4; ++kt) if (kt < ntile) {
            f32x16 sacc[2];
            cm_scores(lds + CM_K, kt, qf, r31, hh, sacc);
#pragma unroll
            for (int kt2 = 0; kt2 < 2; ++kt2)
#pragma unroll
                for (int i = 0; i < 16; ++i) { const int c = 64 * kt + 32 * kt2 + (i & 3) + 8 * (i >> 2) + 4 * hh; const float e_ = (c < nv) ? __builtin_amdgcn_exp2f(sacc[kt2][i]) : 0.f; sacc[kt2][i] = e_; l_run += e_; }
            {
                float own[8], xs[8];
#pragma unroll
                for (int kt2 = 0; kt2 < 2; ++kt2)
#pragma unroll
                    for (int g4 = 0; g4 < 4; ++g4) { const float e3 = 0.5f * sacc[kt2][4 * g4 + 3];
                        own[4 * kt2 + g4] = (sacc[kt2][4 * g4] + sacc[kt2][4 * g4 + 1]) + (sacc[kt2][4 * g4 + 2] + e3); xs[4 * kt2 + g4] = __shfl_xor(e3, 32); }
                float* io = impl + (wid >> 1) * 4096 + tokl * 64 + 16 * kt + hh;
#pragma unroll
                for (int gi = 0; gi < 8; ++gi) io[2 * gi] = own[gi] + (hh ? xs[gi] : (gi > 0 ? xs[gi > 0 ? gi - 1 : 0] : carry));
                carry = xs[7];
            }
#pragma unroll
            for (int kt2 = 0; kt2 < 2; ++kt2)
#pragma unroll
                for (int s2 = 0; s2 < 2; ++s2) {
                    bf16x8 pf; { u32x4 w; w.x = pk2(sacc[kt2][8 * s2 + 0], sacc[kt2][8 * s2 + 1]); w.y = pk2(sacc[kt2][8 * s2 + 2], sacc[kt2][8 * s2 + 3]);
                        w.z = pk2(sacc[kt2][8 * s2 + 4], sacc[kt2][8 * s2 + 5]); w.w = pk2(sacc[kt2][8 * s2 + 6], sacc[kt2][8 * s2 + 7]); pf = __builtin_bit_cast(bf16x8, w); }
#pragma unroll
                    for (int dt = 0; dt < 2; ++dt) {
                        const unsigned char* va = lds + CM_V + (32 * dt + r31) * CM_VSTR + (64 * kt + 32 * kt2 + 16 * s2 + 4 * hh) * 2;
                        const u32x2 lo = *(const u32x2*)(va), hi = *(const u32x2*)(va + 16);
                        u32x4 w; w.x = lo.x; w.y = lo.y; w.z = hi.x; w.w = hi.y;
                        ot[dt] = __builtin_amdgcn_mfma_f32_32x32x16_bf16(__builtin_bit_cast(bf16x8, w), pf, ot[dt], 0, 0, 0);
                    }
                }
        }
        float invL; { const float L = l_run + __shfl_xor(l_run, 32); invL = L > 0.f ? 1.f / L : 0.f; }
        if (hh == 0) impl[16384 + (wid >> 1) * 64 + tokl] = invL;
        {
            const float sc = ((const float*)(ws + WS_GATES))[tok * 24 + head * 3 + 0] * invL;
            bf16_t* ocp = (bf16_t*)(ws + WS_OC) + tok * 512 + head * 64;
#pragma unroll
            for (int dt = 0; dt < 2; ++dt)
#pragma unroll
                for (int g4 = 0; g4 < 4; ++g4) { const int d0 = 32 * dt + 8 * g4 + 4 * hh;
                    u32x2 w; w.x = pk2(ot[dt][4 * g4 + 0] * sc, ot[dt][4 * g4 + 1] * sc); w.y = pk2(ot[dt][4 * g4 + 2] * sc, ot[dt][4 * g4 + 3] * sc); *(u32x2*)(ocp + d0) = w; }
        }
        __syncthreads();
        for (int tt = 0; tt < 8; ++tt) {
            const int tl = wid * 8 + tt, cur = ci;
            unsigned long long mask;
            if (cur < 16) mask = (2ull << cur) - 1ull;
            else {
                const bool valid = lane <= cur;
                const float imp = (impl[tl * 64 + lane] * impl[16384 + tl] + impl[4096 + tl * 64 + lane] * impl[16384 + 64 + tl]) + (impl[8192 + tl * 64 + lane] * impl[16384 + 128 + tl] + impl[12288 + tl * 64 + lane] * impl[16384 + 192 + tl]);
                const unsigned key = (lane == 0 || lane == cur) ? 0x7F800000u : __float_as_uint(imp);
                unsigned T = 0u;
                for (int bit = 30; bit >= 0; --bit) { const unsigned cand = T | (1u << bit); if (__popcll(__ballot(valid && key >= cand)) >= 16) T = cand; }
                const unsigned long long gt = __ballot(valid && key > T), eq = __ballot(valid && key == T);
                const int need = 16 - __popcll(gt);
                const int below = __popcll(eq & ((1ull << lane) - 1ull));
                mask = gt | __ballot(valid && key == T && below < need);
            }
            if (lane == 0) ((unsigned long long*)(ws + WS_SELM))[(size_t)bg * SEQ + ci * 64 + tl] = mask;
        }
    }
}

constexpr int FA_KB = 64 * 128, FA_VB = 64 * 136, FA_STAGE = FA_KB + FA_VB, FA_LDS = 2 * FA_STAGE + 1024;
template <bool SEL>
DEV void fa_branch(unsigned char* lds, const bf16_t* Kb, const bf16_t* VTb, int ci, int bg, const bf16x8 (&qf)[4], int t, unsigned long long mymask, unsigned long long need,
                   f32x16 (&ot)[2], float& m_run, float& l_run) {
    const int tid = threadIdx.x, lane = tid & 63;
    const int r31 = lane & 31, hh = lane >> 5;
    const int lrow = tid >> 3, lch = tid & 7;
    const bf16_t* kg = Kb + ((size_t)bg * SEQ + lrow) * 64 + lch * 8;
    const bf16_t* vg = VTb + ((size_t)bg * 64 + lrow) * SEQ + lch * 8;
    const int koff = lrow * 128 + ((lch ^ ((lrow >> 1) & 7)) << 4), voff = FA_KB + lrow * 136 + lch * 16;
    int jlo, jhi; unsigned long long todo;
    if (SEL) { todo = need; jlo = 0; jhi = ci; } else { jlo = ci >= 8 ? ci - 8 : 0; jhi = ci; todo = 0; }
    int j = jlo;
    if (SEL) { if (todo == 0) return; j = __builtin_ctzll(todo); todo &= todo - 1; }
    u32x4 rk = *(const u32x4*)(kg + (size_t)j * 64 * 64), rv = *(const u32x4*)(vg + (size_t)j * 64);
    __syncthreads();
    *(u32x4*)(lds + koff) = rk; { u32x2 a, b2; a.x = rv.x; a.y = rv.y; b2.x = rv.z; b2.y = rv.w; *(u32x2*)(lds + voff) = a; *(u32x2*)(lds + voff + 8) = b2; }
    __syncthreads();
    int st = 0; bool seen = false;
    for (;;) {
        int jn; bool more;
        if (SEL) { more = (todo != 0); jn = more ? __builtin_ctzll(todo) : 0; todo &= todo - 1; } else { jn = j + 1; more = (jn <= jhi); }
        if (more) { rk = *(const u32x4*)(kg + (size_t)jn * 64 * 64); rv = *(const u32x4*)(vg + (size_t)jn * 64); }
        const unsigned char* base = lds + st * FA_STAGE;
        const bool bit = SEL ? ((mymask >> j) & 1ull) != 0 : true;
        const float cinit = (SEL && !bit) ? -__builtin_inff() : -m_run;
        f32x16 sacc[2];
#pragma unroll
        for (int kt2 = 0; kt2 < 2; ++kt2) {
#pragma unroll
            for (int i = 0; i < 16; ++i) sacc[kt2][i] = cinit;
            const int row = 32 * kt2 + r31; const int sx = (row >> 1) & 7;
#pragma unroll
            for (int s = 0; s < 4; ++s) { const bf16x8 kf = *(const bf16x8*)(base + row * 128 + (((2 * s + hh) ^ sx) << 4));
                sacc[kt2] = __builtin_amdgcn_mfma_f32_32x32x16_bf16(kf, qf[s], sacc[kt2], 0, 0, 0); }
        }
        const bool boundary = SEL ? (j == ci) : (j == ci || j + 8 <= ci);
        float mx = -__builtin_inff();
        if (boundary) {
#pragma unroll
            for (int kt2 = 0; kt2 < 2; ++kt2)
#pragma unroll
                for (int i = 0; i < 16; ++i) { const int key = 64 * j + 32 * kt2 + (i & 3) + 8 * (i >> 2) + 4 * hh;
                    const bool ok = SEL ? (key <= t) : (key <= t && t - key < 512);
                    const float v = ok ? sacc[kt2][i] : -__builtin_inff(); sacc[kt2][i] = v; mx = fmaxf(mx, v); }
        } else {
#pragma unroll
            for (int kt2 = 0; kt2 < 2; ++kt2)
#pragma unroll
                for (int i = 0; i < 16; ++i) mx = fmaxf(mx, sacc[kt2][i]);
        }
        mx = fmaxf(mx, __shfl_xor(mx, 32));
        const bool live = mx > -__builtin_inff();
        const bool need = (mx > 8.f) || (!seen && live && mx < -8.f);
        if (__any(need)) {
            const float d = need ? mx : 0.f;
            const float alpha = d > 0.f ? __builtin_amdgcn_exp2f(-d) : 1.f;
            m_run += d; l_run *= alpha;
#pragma unroll
            for (int dt = 0; dt < 2; ++dt)
#pragma unroll
                for (int i = 0; i < 16; ++i) ot[dt][i] *= alpha;
#pragma unroll
            for (int kt2 = 0; kt2 < 2; ++kt2)
#pragma unroll
                for (int i = 0; i < 16; ++i) sacc[kt2][i] -= d;
        }
        seen = seen || live;
        float rs = 0.f;
#pragma unroll
        for (int kt2 = 0; kt2 < 2; ++kt2)
#pragma unroll
            for (int i = 0; i < 16; ++i) { const float e = __builtin_amdgcn_exp2f(sacc[kt2][i]); sacc[kt2][i] = e; rs += e; }
        l_run += rs;
#pragma unroll
        for (int kt2 = 0; kt2 < 2; ++kt2)
#pragma unroll
            for (int s2 = 0; s2 < 2; ++s2) {
                bf16x8 pf; { u32x4 w; w.x = pk2(sacc[kt2][8 * s2 + 0], sacc[kt2][8 * s2 + 1]); w.y = pk2(sacc[kt2][8 * s2 + 2], sacc[kt2][8 * s2 + 3]);
                    w.z = pk2(sacc[kt2][8 * s2 + 4], sacc[kt2][8 * s2 + 5]); w.w = pk2(sacc[kt2][8 * s2 + 6], sacc[kt2][8 * s2 + 7]); pf = __builtin_bit_cast(bf16x8, w); }
#pragma unroll
                for (int dt = 0; dt < 2; ++dt) {
                    const unsigned char* va = base + FA_KB + (32 * dt + r31) * 136 + (32 * kt2 + 16 * s2 + 4 * hh) * 2;
                    const u32x2 lo = *(const u32x2*)(va), hi = *(const u32x2*)(va + 16);
                    u32x4 w; w.x = lo.x; w.y = lo.y; w.z = hi.x; w.w = hi.y;
                    ot[dt] = __builtin_amdgcn_mfma_f32_32x32x16_bf16(__builtin_bit_cast(bf16x8, w), pf, ot[dt], 0, 0, 0);
                }
            }
        if (!more) break;
        { unsigned char* nb = lds + (st ^ 1) * FA_STAGE; *(u32x4*)(nb + koff) = rk; u32x2 a, b2; a.x = rv.x; a.y = rv.y; b2.x = rv.z; b2.y = rv.w; *(u32x2*)(nb + voff) = a; *(u32x2*)(nb + voff + 8) = b2; }
        __syncthreads();
        st ^= 1; j = jn;
    }
}
DEV void phase_flash(const Params& p, unsigned char* lds) {
    const int tid = threadIdx.x, lane = tid & 63, wid = tid >> 6;
    const int vb = vblock(), G = gridDim.x;
    unsigned char* ws = p.ws;
    const int r31 = lane & 31, hh = lane >> 5;
    unsigned long long* red = (unsigned long long*)(lds + 2 * FA_STAGE);
    for (int it = vb; it < 1024; it += G) {
        int ci, bg;
        if (G == 256) { const int x = vb >> 5, jb = vb & 31, rnd = it / G, i = rnd * 32 + ((rnd & 1) ? 31 - jb : jb); ci = 63 - (i >> 1); bg = 2 * x + (i & 1); }
        else { ci = 63 - (it >> 4); bg = it & 15; }
        const int b = bg >> 1, g = bg & 1;
        const int head = g * 4 + (wid >> 1);
        const int t = ci * 64 + (wid & 1) * 32 + r31;
        const size_t tok = (size_t)b * SEQ + t;
        bf16x8 qf[4];
        { const bf16_t* qp = (const bf16_t*)(ws + WS_Q) + ((size_t)(b * 8 + head) * SEQ + t) * 64 + 8 * hh;
#pragma unroll
            for (int s = 0; s < 4; ++s) qf[s] = *(const bf16x8*)(qp + 16 * s); }
        const unsigned long long mymask = ((const unsigned long long*)(ws + WS_SELM))[(size_t)bg * SEQ + t];
        unsigned long long orm = mymask;
#pragma unroll
        for (int o = 1; o < 32; o <<= 1) { const unsigned lo = __shfl_xor((unsigned)orm, o), hi = __shfl_xor((unsigned)(orm >> 32), o); orm |= ((unsigned long long)hi << 32) | lo; }
        __syncthreads();
        if (wid < 2 && lane == 0) red[wid] = orm;
        __syncthreads();
        const unsigned long long need = red[0] | red[1];
        f32x16 oc[2];
        {
            f32x16 ot[2]; float m_run = 0.f, l_run = 0.f;
#pragma unroll
            for (int dt = 0; dt < 2; ++dt)
#pragma unroll
                for (int i = 0; i < 16; ++i) ot[dt][i] = 0.f;
            fa_branch<true>(lds, (const bf16_t*)(ws + WS_KS), (const bf16_t*)(ws + WS_VST), ci, bg, qf, t, mymask, need, ot, m_run, l_run);
            const float lt = l_run + __shfl_xor(l_run, 32);
            const float sc = ((const float*)(ws + WS_GATES))[tok * 24 + head * 3 + 1] / lt;
#pragma unroll
            for (int dt = 0; dt < 2; ++dt)
#pragma unroll
                for (int i = 0; i < 16; ++i) oc[dt][i] = ot[dt][i] * sc;
        }
        {
            f32x16 ot[2]; float m_run = 0.f, l_run = 0.f;
#pragma unroll
            for (int dt = 0; dt < 2; ++dt)
#pragma unroll
                for (int i = 0; i < 16; ++i) ot[dt][i] = 0.f;
            fa_branch<false>(lds, (const bf16_t*)(ws + WS_KW), (const bf16_t*)(ws + WS_VWT), ci, bg, qf, t, 0ull, 0ull, ot, m_run, l_run);
            const float lt = l_run + __shfl_xor(l_run, 32);
            const float sc = ((const float*)(ws + WS_GATES))[tok * 24 + head * 3 + 2] / lt;
#pragma unroll
            for (int dt = 0; dt < 2; ++dt)
#pragma unroll
                for (int i = 0; i < 16; ++i) oc[dt][i] += ot[dt][i] * sc;
        }
        {
            const bf16_t* ocp = (const bf16_t*)(ws + WS_OC) + tok * 512 + head * 64;
            bf16_t* mix = (bf16_t*)(ws + WS_R1) + tok * 1024 + head * 64;
            float ss = 0.f;
#pragma unroll
            for (int dt = 0; dt < 2; ++dt)
#pragma unroll
                for (int g4 = 0; g4 < 4; ++g4) { const int d0 = 32 * dt + 8 * g4 + 4 * hh; const u32x2 c = *(const u32x2*)(ocp + d0);
                    const float v0 = oc[dt][4 * g4 + 0] + bflo(c.x), v1 = oc[dt][4 * g4 + 1] + bfhi(c.x), v2 = oc[dt][4 * g4 + 2] + bflo(c.y), v3 = oc[dt][4 * g4 + 3] + bfhi(c.y);
                    ss += (v0 * v0 + v1 * v1) + (v2 * v2 + v3 * v3);
                    u32x2 w; w.x = pk2(v0, v1); w.y = pk2(v2, v3); *(u32x2*)(mix + d0) = w; }
            ss += __shfl_xor(ss, 32);
            if (hh == 0) atomicAdd((float*)(ws + WS_ROWSS) + tok, ss);
        }
    }
}

DEV int swz256(int row, int chunk) { return row * 256 + ((chunk ^ (row & 15)) << 4); }
DEV void hgrn_cumsum(const Params& p, int bh, int c, float* segs, f32x2 (&lf)[8], f32x2 (&a)[8], f32x2& r, f32x2& alast) {
    const int tid = threadIdx.x, k2 = tid & 63, tq = tid >> 6;
    const int b = bh >> 2, h = bh & 3;
    const bf16_t* HL = (const bf16_t*)(p.ws + WS_HLOGF) + ((size_t)b * SEQ + c * 64 + tq * 8) * 512 + h * 128 + 2 * k2;
#pragma unroll
    for (int i = 0; i < 8; ++i) { const unsigned w = *(const unsigned*)(HL + (size_t)i * 512); lf[i] = (f32x2){bflo(w), bfhi(w)}; }
    f32x2 run = (f32x2){0.f, 0.f};
#pragma unroll
    for (int i = 0; i < 8; ++i) { run = run + lf[i]; a[i] = run; }
    *(f32x2*)(segs + tq * 128 + 2 * k2) = run;
    __syncthreads();
    f32x2 off = (f32x2){0.f, 0.f}, tot = off, rr = off;
#pragma unroll
    for (int q = 0; q < 8; ++q) { const f32x2 s = *(const f32x2*)(segs + q * 128 + 2 * k2); if (q < tq) off = off + s; if (q < 4) rr = rr + s; tot = tot + s; }
#pragma unroll
    for (int i = 0; i < 8; ++i) a[i] = a[i] + off;
    r = rr; alast = tot;
}
DEV void hgrn_stage_vt(const Params& p, int bh, int c, unsigned char* vt) {
    const int tid = threadIdx.x, k2 = tid & 63, tq = tid >> 6;
    const int b = bh >> 2, h = bh & 3;
    const bf16_t* HV = (const bf16_t*)(p.ws + WS_HV) + ((size_t)b * SEQ + c * 64 + tq * 8) * 512 + h * 128 + 2 * k2;
    unsigned vv[8];
#pragma unroll
    for (int i = 0; i < 8; ++i) vv[i] = *(const unsigned*)(HV + (size_t)i * 512);
    u32x4 lo, hi;
    lo.x = (vv[0] & 0xffffu) | (vv[1] << 16); lo.y = (vv[2] & 0xffffu) | (vv[3] << 16); lo.z = (vv[4] & 0xffffu) | (vv[5] << 16); lo.w = (vv[6] & 0xffffu) | (vv[7] << 16);
    hi.x = (vv[0] >> 16) | (vv[1] & 0xffff0000u); hi.y = (vv[2] >> 16) | (vv[3] & 0xffff0000u); hi.z = (vv[4] >> 16) | (vv[5] & 0xffff0000u); hi.w = (vv[6] >> 16) | (vv[7] & 0xffff0000u);
    *(u32x4*)(vt + swz(2 * k2, tq)) = lo; *(u32x4*)(vt + swz(2 * k2 + 1, tq)) = hi;
}
constexpr int H1_KT = 0, H1_VT = 16384, H1_SEG = 32768, H1_EK = H1_SEG + 4096;
DEV void phase_hgrn_a1(const Params& p, unsigned char* lds, int vb0, int nb) {
    const int tid = threadIdx.x, lane = tid & 63, wid = tid >> 6, k2 = tid & 63, tq = tid >> 6;
    const int vb = vblock(), G = gridDim.x;
    const int frow = lane & 15, fq = lane >> 4, wr = wid >> 1, wc = wid & 1;
    float* segs = (float*)(lds + H1_SEG); float* ek = (float*)(lds + H1_EK);
    bf16_t* ubuf = (bf16_t*)(p.ws + WS_UBUF); float* dbuf = (float*)(p.ws + WS_DBUF);
    if (vb < vb0) return;
    for (int item = vb - vb0; item < 2048; item += nb) {
        const int bh = item >> 6, c = item & 63;
        __syncthreads();
        f32x2 lf[8], a[8], r, al;
        hgrn_cumsum(p, bh, c, segs, lf, a, r, al);
        {
            float kx[8], ky[8];
#pragma unroll
            for (int i = 0; i < 8; ++i) { kx[i] = (1.f - __expf(lf[i].x)) * __expf(fminf(r.x - a[i].x, 80.f)); ky[i] = (1.f - __expf(lf[i].y)) * __expf(fminf(r.y - a[i].y, 80.f)); }
            u32x4 w0, w1;
            w0.x = pk2(kx[0], kx[1]); w0.y = pk2(kx[2], kx[3]); w0.z = pk2(kx[4], kx[5]); w0.w = pk2(kx[6], kx[7]);
            w1.x = pk2(ky[0], ky[1]); w1.y = pk2(ky[2], ky[3]); w1.z = pk2(ky[4], ky[5]); w1.w = pk2(ky[6], ky[7]);
            *(u32x4*)(lds + H1_KT + swz(2 * k2, tq)) = w0; *(u32x4*)(lds + H1_KT + swz(2 * k2 + 1, tq)) = w1;
        }
        hgrn_stage_vt(p, bh, c, lds + H1_VT);
        if (tq == 7) { ek[2 * k2] = __expf(al.x - r.x); ek[2 * k2 + 1] = __expf(al.y - r.y); f32x2 d; d.x = __expf(al.x); d.y = __expf(al.y); *(f32x2*)(dbuf + (size_t)item * 128 + 2 * k2) = d; }
        __syncthreads();
        f32x4 acc[2][4];
#pragma unroll
        for (int m = 0; m < 2; ++m)
#pragma unroll
            for (int n = 0; n < 4; ++n) acc[m][n] = (f32x4){0.f, 0.f, 0.f, 0.f};
        const int sx = (frow >> 1) & 7;
#pragma unroll
        for (int ks = 0; ks < 2; ++ks) {
            const int co = ((ks * 4 + fq) ^ sx) << 4;
            bf16x8 af[2], bfr[4];
#pragma unroll
            for (int m = 0; m < 2; ++m) af[m] = *(const bf16x8*)(lds + H1_VT + (32 * wr + 16 * m + frow) * 128 + co);
#pragma unroll
            for (int n = 0; n < 4; ++n) bfr[n] = *(const bf16x8*)(lds + H1_KT + (64 * wc + 16 * n + frow) * 128 + co);
#pragma unroll
            for (int m = 0; m < 2; ++m)
#pragma unroll
                for (int n = 0; n < 4; ++n) acc[m][n] = __builtin_amdgcn_mfma_f32_16x16x32_bf16(bfr[n], af[m], acc[m][n], 0, 0, 0);
        }
#pragma unroll
        for (int m = 0; m < 2; ++m) { const int v = 32 * wr + 16 * m + frow;
#pragma unroll
            for (int n = 0; n < 4; ++n) { const int k0 = 64 * wc + 16 * n + 4 * fq; const f32x4 e = *(const f32x4*)(ek + k0); const f32x4 o = acc[m][n] * e;
                u32x2 w; w.x = pk2(o.x, o.y); w.y = pk2(o.z, o.w); *(u32x2*)(ubuf + ((size_t)item * 128 + v) * 128 + k0) = w; } }
    }
}
DEV void phase_hgrn_a2(const Params& p, unsigned char* lds) {
    const int G = gridDim.x;
    bf16_t* ubuf = (bf16_t*)(p.ws + WS_UBUF); const float* dbuf = (const float*)(p.ws + WS_DBUF);
    for (int gid = blockIdx.x * NT + threadIdx.x; gid < 131072; gid += G * NT) {
        const int bh = gid >> 12, v = (gid >> 5) & 127, k4 = gid & 31;
        bf16_t* u = ubuf + ((size_t)bh * 64 * 128 + v) * 128 + 4 * k4;
        const float* d = dbuf + (size_t)bh * 64 * 128 + 4 * k4;
        f32x4 S = (f32x4){0.f, 0.f, 0.f, 0.f};
        for (int c0 = 0; c0 < 64; c0 += 8) {
            u32x2 uu[8]; f32x4 dd[8];
#pragma unroll
            for (int j = 0; j < 8; ++j) { uu[j] = *(const u32x2*)(u + (size_t)(c0 + j) * 16384); dd[j] = *(const f32x4*)(d + (size_t)(c0 + j) * 128); }
#pragma unroll
            for (int j = 0; j < 8; ++j) { u32x2 w; w.x = pk2(S.x, S.y); w.y = pk2(S.z, S.w); *(u32x2*)(u + (size_t)(c0 + j) * 16384) = w;
                S.x = dd[j].x * S.x + bflo(uu[j].x); S.y = dd[j].y * S.y + bfhi(uu[j].x); S.z = dd[j].z * S.z + bflo(uu[j].y); S.w = dd[j].w * S.w + bfhi(uu[j].y); }
        }
    }
}
constexpr int H3_QH = 0, H3_QA = 16384, H3_KH = 32768, H3_VT = 49152, H3_PP = 65536, H3_ST = 73728, H3_SEG = 106496, H3_RED = 110592;
DEV void phase_hgrn_a3(const Params& p, unsigned char* lds) {
    const int tid = threadIdx.x, lane = tid & 63, wid = tid >> 6, k2 = tid & 63, tq = tid >> 6;
    const int vb = vblock(), G = gridDim.x;
    const int frow = lane & 15, fq = lane >> 4;
    float* segs = (float*)(lds + H3_SEG); float* red = (float*)(lds + H3_RED);
    const bf16_t* ubuf = (const bf16_t*)(p.ws + WS_UBUF);
    for (int item = vb; item < 2048; item += G) {
        const int bh = item >> 6, c = item & 63, b = bh >> 2, h = bh & 3;
        __syncthreads();
        f32x2 lf[8], a[8], r, al;
        hgrn_cumsum(p, bh, c, segs, lf, a, r, al);
        {
            const bf16_t* HQ = (const bf16_t*)(p.ws + WS_HQ) + ((size_t)b * SEQ + c * 64 + tq * 8) * 512 + h * 128 + 2 * k2;
            unsigned qq[8];
#pragma unroll
            for (int i = 0; i < 8; ++i) qq[i] = *(const unsigned*)(HQ + (size_t)i * 512);
#pragma unroll
            for (int i = 0; i < 8; ++i) { const int t = 8 * tq + i; const float q0 = bflo(qq[i]), q1 = bfhi(qq[i]);
                const int off = swz256(t, k2 >> 2) + (k2 & 3) * 4;
                *(unsigned*)(lds + H3_QH + off) = pk2(q0 * __expf(fminf(a[i].x - r.x, 80.f)), q1 * __expf(fminf(a[i].y - r.y, 80.f)));
                *(unsigned*)(lds + H3_QA + off) = pk2(q0 * __expf(a[i].x), q1 * __expf(a[i].y));
                *(unsigned*)(lds + H3_KH + off) = pk2((1.f - __expf(lf[i].x)) * __expf(fminf(r.x - a[i].x, 80.f)), (1.f - __expf(lf[i].y)) * __expf(fminf(r.y - a[i].y, 80.f))); }
        }
        hgrn_stage_vt(p, bh, c, lds + H3_VT);
        {
            const bf16_t* st = ubuf + (size_t)item * 16384;
#pragma unroll
            for (int i = 0; i < 4; ++i) { const int q = tid + NT * i, v = q >> 4, ch = q & 15; *(u32x4*)(lds + H3_ST + swz256(v, ch)) = *(const u32x4*)(st + v * 128 + ch * 8); }
        }
        __syncthreads();
        {
            const int wr = wid >> 1, wc = wid & 1;
            f32x4 acc[2];
            acc[0] = (f32x4){0.f, 0.f, 0.f, 0.f}; acc[1] = acc[0];
            if (32 * wc <= 16 * wr + 15) {
#pragma unroll
                for (int ks = 0; ks < 4; ++ks) {
                    const int co = ((ks * 4 + fq) ^ frow) << 4;
                    const bf16x8 af = *(const bf16x8*)(lds + H3_QH + (16 * wr + frow) * 256 + co);
#pragma unroll
                    for (int n = 0; n < 2; ++n) { const bf16x8 bfr = *(const bf16x8*)(lds + H3_KH + (32 * wc + 16 * n + frow) * 256 + co);
                        acc[n] = __builtin_amdgcn_mfma_f32_16x16x32_bf16(bfr, af, acc[n], 0, 0, 0); }
                }
            }
            const int t = 16 * wr + frow;
#pragma unroll
            for (int n = 0; n < 2; ++n) { const int s0 = 32 * wc + 16 * n + 4 * fq; f32x4 v = acc[n];
                v.x = (s0 + 0 <= t) ? v.x : 0.f; v.y = (s0 + 1 <= t) ? v.y : 0.f; v.z = (s0 + 2 <= t) ? v.z : 0.f; v.w = (s0 + 3 <= t) ? v.w : 0.f;
                u32x2 w; w.x = pk2(v.x, v.y); w.y = pk2(v.z, v.w);
                *(u32x2*)(lds + H3_PP + t * 128 + ((((s0 >> 3)) ^ ((t >> 1) & 7)) << 4) + (s0 & 7) * 2) = w; }
        }
        __syncthreads();
        {
            const int wr = wid >> 2, wc = wid & 3;
            f32x4 acc[2][2];
#pragma unroll
            for (int m = 0; m < 2; ++m)
#pragma unroll
                for (int n = 0; n < 2; ++n) acc[m][n] = (f32x4){0.f, 0.f, 0.f, 0.f};
            const int sx = (frow >> 1) & 7;
#pragma unroll
            for (int ks = 0; ks < 2; ++ks) {
                const int co = ((ks * 4 + fq) ^ sx) << 4;
                bf16x8 af[2], bfr[2];
#pragma unroll
                for (int m = 0; m < 2; ++m) af[m] = *(const bf16x8*)(lds + H3_PP + (32 * wr + 16 * m + frow) * 128 + co);
#pragma unroll
                for (int n = 0; n < 2; ++n) bfr[n] = *(const bf16x8*)(lds + H3_VT + (32 * wc + 16 * n + frow) * 128 + co);
#pragma unroll
                for (int m = 0; m < 2; ++m)
#pragma unroll
                    for (int n = 0; n < 2; ++n) acc[m][n] = __builtin_amdgcn_mfma_f32_16x16x32_bf16(bfr[n], af[m], acc[m][n], 0, 0, 0);
            }
#pragma unroll
            for (int ks = 0; ks < 4; ++ks) {
                const int co = ((ks * 4 + fq) ^ frow) << 4;
                bf16x8 af[2], bfr[2];
#pragma unroll
                for (int m = 0; m < 2; ++m) af[m] = *(const bf16x8*)(lds + H3_QA + (32 * wr + 16 * m + frow) * 256 + co);
#pragma unroll
                for (int n = 0; n < 2; ++n) bfr[n] = *(const bf16x8*)(lds + H3_ST + (32 * wc + 16 * n + frow) * 256 + co);
#pragma unroll
                for (int m = 0; m < 2; ++m)
#pragma unroll
                    for (int n = 0; n < 2; ++n) acc[m][n] = __builtin_amdgcn_mfma_f32_16x16x32_bf16(bfr[n], af[m], acc[m][n], 0, 0, 0);
            }
#pragma unroll
            for (int m = 0; m < 2; ++m) { float ss = 0.f;
#pragma unroll
                for (int n = 0; n < 2; ++n) { const f32x4 v = acc[m][n]; ss += (v.x * v.x + v.y * v.y) + (v.z * v.z + v.w * v.w); }
                ss += __shfl_xor(ss, 16); ss += __shfl_xor(ss, 32);
                if (fq == 0) red[(32 * wr + 16 * m + frow) * 4 + wc] = ss; }
            __syncthreads();
#pragma unroll
            for (int m = 0; m < 2; ++m) { const int t = 32 * wr + 16 * m + frow; const f32x4 q4 = *(const f32x4*)(red + t * 4);
                const float rs = rsqrtf(((q4.x + q4.y) + (q4.z + q4.w)) * (1.f / 128.f) + RMS_EPS);
                const size_t row = (size_t)b * SEQ + c * 64 + t;
#pragma unroll
                for (int n = 0; n < 2; ++n) { const int v0 = 32 * wc + 16 * n + 4 * fq; const f32x4 gn = *(const f32x4*)(p.g_hn + v0);
                    const u32x2 gg = *(const u32x2*)((const bf16_t*)(p.ws + WS_HG) + row * 512 + h * 128 + v0);
                    const f32x4 o = acc[m][n];
                    u32x2 w; w.x = pk2(o.x * rs * gn.x * bflo(gg.x), o.y * rs * gn.y * bfhi(gg.x)); w.y = pk2(o.z * rs * gn.z * bflo(gg.y), o.w * rs * gn.w * bfhi(gg.y));
                    *(u32x2*)((bf16_t*)(p.ws + WS_R1) + row * 1024 + 512 + h * 128 + v0) = w; } }
        }
    }
}

DEV void phase_normalize(const Params& p, unsigned char* lds) {
    const int vb = vblock(), G = gridDim.x;
    unsigned char* ws = p.ws;
    __syncthreads();
    {
        float* tl = (float*)lds;
        for (int r = vb; r < 32 * 4 * 16; r += G) { const int e = r / 64, q = r % 64; SrcW13_4 s{p.w1 + (size_t)e * 1024 * 512, p.w3 + (size_t)e * 1024 * 512, p.ffn_g};
            convert_tile256(tl, s, (bf16_t*)(ws + WS_W13T) + (size_t)e * 1024 * 1024, 1024, (q / 16) * 256, (q % 16) * 64); }
    }
}

struct EpiOut8 { const Params& p; static constexpr bool MIDSCALE = true;
    DEV float rowscale(int row) const { return rsqrtf(((const float*)(p.ws + WS_ROWSS))[row] * (1.f / 512.f) + RMS_EPS); }
    DEV int midk() const { return 8; }
    DEV void operator()(const f32x4 (&acc)[2][2][4][2], const pg8::Unit& u, int wr, int wc, int fr, int fq) const {
#pragma unroll
        for (int ai = 0; ai < 2; ++ai)
#pragma unroll
            for (int m = 0; m < 4; ++m) { const size_t row = (size_t)u.pm * 256 + ai * 128 + wr * 64 + m * 16 + fr;
#pragma unroll
                for (int bj = 0; bj < 2; ++bj)
#pragma unroll
                    for (int n = 0; n < 2; ++n) { const int c = u.pn * 256 + 64 * wc + 32 * bj + 8 * fq + 4 * n; const f32x4 xv = *(const f32x4*)(p.x + row * DM + c); *(f32x4*)(p.out + row * DM + c) = xv + acc[ai][bj][m][n]; } }
    } };
DEV void phase_outproj(const Params& p, unsigned char* lds) {
    pg8::Gemm g{(const bf16_t*)(p.ws + WS_R1), (const bf16_t*)(p.ws + WS_WOUTT), NTOK, DM, DM};
    pg8::StaticOrder S; S.init(NTOK, DM, (int)gridDim.x, (int)blockIdx.x);
    EpiOut8 E{p};
    pg8::gemm_phase((PG8_LAS unsigned char*)lds, g, S, E);
}

constexpr int RT_W = 0, RT_LG = 2 * 49152, RT_RS = RT_LG + 128 * 49 * 4, RT_HIST = RT_RS + 512, RT_BASE = RT_HIST + 1024, RT_LDS = RT_BASE + 1024;
DEV void phase_router(const Params& p, unsigned char* lds) {
    const int tid = threadIdx.x, lane = tid & 63, wid = tid >> 6, frow = lane & 15, fq = lane >> 4;
    const int vb = vblock(), G = gridDim.x;
    unsigned char* ws = p.ws;
    float* lg = (float*)(lds + RT_LG); float* rsd = (float*)(lds + RT_RS);
    int* hist = (int*)(lds + RT_HIST); int* basep = (int*)(lds + RT_BASE);
    const bf16_t* rw = (const bf16_t*)(ws + WS_RW);
    for (int it = vb; it < NTOK / 128; it += G) {
        const size_t row0 = (size_t)it * 128;
        const size_t trow = row0 + 16 * wid + frow;
        const float* hrow = p.out + trow * DM + 8 * fq;
        bf16_t* hbrow = (bf16_t*)(ws + WS_R1) + trow * DM + 8 * fq;
        f32x4 acc[3]; float ss = 0.f;
#pragma unroll
        for (int nt = 0; nt < 3; ++nt) acc[nt] = (f32x4){0.f, 0.f, 0.f, 0.f};
        if (tid < 128) hist[tid] = 0;
        u32x4 wreg[6]; f32x4 xa[4][2], xn[4][2];
#define RT_LOADW(kc_) do { _Pragma("unroll") for (int i = 0; i < 6; ++i) { const int idx = tid + NT * i, r = idx >> 5, c = idx & 31; wreg[i] = *(const u32x4*)(rw + (size_t)r * 1024 + (kc_) * 256 + c * 8); } } while (0)
#define RT_STOREW(buf_) do { _Pragma("unroll") for (int i = 0; i < 6; ++i) { const int idx = tid + NT * i, r = idx >> 5, c = idx & 31; *(u32x4*)(lds + RT_W + (buf_) * 49152 + r * 512 + ((c ^ (r & 15)) << 4)) = wreg[i]; } } while (0)
#define RT_LOADX(dst_, hc_) do { _Pragma("unroll") for (int ks = 0; ks < 4; ++ks) { dst_[ks][0] = *(const f32x4*)(hrow + (hc_) * 128 + 32 * ks); dst_[ks][1] = *(const f32x4*)(hrow + (hc_) * 128 + 32 * ks + 4); } } while (0)
        __syncthreads();
        RT_LOADW(0); RT_LOADX(xa, 0); RT_STOREW(0);
        __syncthreads();
#pragma unroll 1
        for (int hc = 0; hc < 8; ++hc) {
            if (hc < 7) RT_LOADX(xn, hc + 1);
            const unsigned char* wb = lds + RT_W + ((hc >> 1) & 1) * 49152;
#pragma unroll
            for (int ks = 0; ks < 4; ++ks) {
                const f32x4 a = xa[ks][0], b = xa[ks][1];
                ss += ((a.x * a.x + a.y * a.y) + (a.z * a.z + a.w * a.w)) + ((b.x * b.x + b.y * b.y) + (b.z * b.z + b.w * b.w));
                u32x4 hi; hi.x = pk2(a.x, a.y); hi.y = pk2(a.z, a.w); hi.z = pk2(b.x, b.y); hi.w = pk2(b.z, b.w);
                u32x4 lo; lo.x = pk2(a.x - bflo(hi.x), a.y - bfhi(hi.x)); lo.y = pk2(a.z - bflo(hi.y), a.w - bfhi(hi.y)); lo.z = pk2(b.x - bflo(hi.z), b.y - bfhi(hi.z)); lo.w = pk2(b.z - bflo(hi.w), b.w - bfhi(hi.w));
                *(u32x4*)(hbrow + hc * 128 + 32 * ks) = hi;
                const bf16x8 hh = __builtin_bit_cast(bf16x8, hi), hl = __builtin_bit_cast(bf16x8, lo);
                const int co = ((4 * (4 * (hc & 1) + ks) + fq) ^ frow) << 4;
#pragma unroll
                for (int nt = 0; nt < 3; ++nt) {
                    const bf16x8 whi = *(const bf16x8*)(wb + (16 * nt + frow) * 512 + co), wlo = *(const bf16x8*)(wb + (48 + 16 * nt + frow) * 512 + co);
                    acc[nt] = __builtin_amdgcn_mfma_f32_16x16x32_bf16(whi, hh, acc[nt], 0, 0, 0);
                    acc[nt] = __builtin_amdgcn_mfma_f32_16x16x32_bf16(wlo, hh, acc[nt], 0, 0, 0);
                    acc[nt] = __builtin_amdgcn_mfma_f32_16x16x32_bf16(whi, hl, acc[nt], 0, 0, 0);
                }
            }
            if ((hc & 1) == 0 && hc < 6) { RT_LOADW((hc >> 1) + 1); }
            if ((hc & 1) == 1 && hc < 7) { RT_STOREW(((hc >> 1) + 1) & 1); }
#pragma unroll
            for (int ks = 0; ks < 4; ++ks) { xa[ks][0] = xn[ks][0]; xa[ks][1] = xn[ks][1]; }
            if (hc & 1) __syncthreads();
        }
#undef RT_LOADW
#undef RT_STOREW
#undef RT_LOADX
        ss += __shfl_xor(ss, 16); ss += __shfl_xor(ss, 32);
        if (fq == 0) rsd[16 * wid + frow] = rsqrtf(ss * (1.f / DM) + RMS_EPS);
#pragma unroll
        for (int nt = 0; nt < 3; ++nt) { float* o = lg + (16 * wid + frow) * 49 + 16 * nt + 4 * fq; o[0] = acc[nt].x; o[1] = acc[nt].y; o[2] = acc[nt].z; o[3] = acc[nt].w; }
        __syncthreads();
        int bin = 0, slot = 0, ea = 0, eb = 0, sa = 0, sb = 0; float wa = 0.f, wb = 0.f;
        int* ehist = hist + 112; int* ebase = basep + 112;
        if (tid < 32) ehist[tid] = 0;
        __syncthreads();
        if (tid < 128) {
            const float rs = rsd[tid];
            ((float*)(ws + WS_RSTD2))[row0 + tid] = rs;
            float gl[4]; int gi = 0; float gm = -1e30f;
#pragma unroll
            for (int c = 0; c < 4; ++c) { gl[c] = lg[tid * 49 + c] * rs + p.b_group[c]; if (gl[c] > gm) { gm = gl[c]; gi = c; } }
            float gs = 0.f;
#pragma unroll
            for (int c = 0; c < 4; ++c) gs += __expf(gl[c] - gm);
            const float pg = 1.f / gs;
            float el[8]; int i0 = 0; float m0 = -1e30f;
#pragma unroll
            for (int c = 0; c < 8; ++c) { el[c] = lg[tid * 49 + 4 + gi * 8 + c] * rs + p.b_expert[gi * 8 + c]; if (el[c] > m0) { m0 = el[c]; i0 = c; } }
            int i1 = 0; float m1 = -1e30f;
#pragma unroll
            for (int c = 0; c < 8; ++c) if (c != i0 && el[c] > m1) { m1 = el[c]; i1 = c; }
            const float e1 = __expf(m1 - m0); const float w0 = pg / (1.f + e1), w1 = pg * e1 / (1.f + e1);
            const int a = min(i0, i1), bb = max(i0, i1);
            bin = gi * 28 + (7 * a - (a * (a - 1)) / 2) + (bb - a - 1);
            wa = (i0 < i1) ? w0 : w1; wb = (i0 < i1) ? w1 : w0; ea = gi * 8 + a; eb = gi * 8 + bb;
            slot = atomicAdd(&hist[bin], 1);
            sa = atomicAdd(&ehist[ea], 1); sb = atomicAdd(&ehist[eb], 1);
        }
        __syncthreads();
        if (tid < NBIN) { const int h = hist[tid]; basep[tid] = h ? atomicAdd((int*)(ws + WS_CTL) + tid, h) : 0; }
        else if (tid >= 128 && tid < 160) { const int e = tid - 128; const int h = ehist[e]; ebase[e] = h ? atomicAdd((int*)(ws + WS_CTL + 512) + e, h) : 0; }
        __syncthreads();
        if (tid < 128) {
            const int t = (int)(row0 + tid);
            ((int*)(ws + WS_BINL))[(size_t)bin * BINCAP + basep[bin] + slot] = t;
            sa += ebase[ea]; sb += ebase[eb];
            ((int*)(ws + WS_EL))[(size_t)ea * BINCAP + sa] = t; ((float*)(ws + WS_EW))[(size_t)ea * BINCAP + sa] = wa;
            ((int*)(ws + WS_EL))[(size_t)eb * BINCAP + sb] = t; ((float*)(ws + WS_EW))[(size_t)eb * BINCAP + sb] = wb;
            { const unsigned dpos = (unsigned)bin | ((unsigned)(basep[bin] + slot) << 7); ((unsigned*)(ws + WS_EDST))[(size_t)ea * BINCAP + sa] = dpos; ((unsigned*)(ws + WS_EDST))[(size_t)eb * BINCAP + sb] = dpos | (1u << 22); }
        }
        __syncthreads();
    }
}

constexpr int MOE_TS = pg8::STAGE_BYTES, MOE_TT = MOE_TS + 512, MOE_ES = MOE_TT + 1024, MOE_ET = MOE_ES + 256;
DEV void moe_tiles(const Params& p, unsigned char* lds) {
    int* tstart = (int*)(lds + MOE_TS); int* tiletab = (int*)(lds + MOE_TT); int* etstart = (int*)(lds + MOE_ES); int* etiletab = (int*)(lds + MOE_ET);
    const int tid = threadIdx.x;
    __syncthreads();
    if (tid == 0) { const int* cnt = (const int*)(p.ws + WS_CTL); int s = 0; for (int i = 0; i < NBIN; ++i) { tstart[i] = s; s += (cnt[i] + 255) >> 8; } tstart[NBIN] = s; }
    if (tid == 64) { const int* cnt = (const int*)(p.ws + WS_CTL + 512); int s = 0; for (int i = 0; i < 32; ++i) { etstart[i] = s; s += (cnt[i] + 255) >> 8; } etstart[32] = s; }
    __syncthreads();
    if (tid < NBIN) for (int t = tstart[tid]; t < tstart[tid + 1]; ++t) tiletab[t] = tid;
    if (tid >= 128 && tid < 160) for (int t = etstart[tid - 128]; t < etstart[tid - 127]; ++t) etiletab[t] = tid - 128;
    __syncthreads();
}
DEV void bin_experts(int bin, int& ea, int& eb) { const int gi = bin / 28; int pi = bin % 28, a = 0; while (pi >= 7 - a) { pi -= 7 - a; ++a; } ea = gi * 8 + a; eb = gi * 8 + a + 1 + pi; }
DEV void lane_rc(int i, int& R, int& C) { pg8::stage_rc((int)threadIdx.x * 16, R, C); R += 64 * i; }
struct MoeUnit { int tile, nt, bin, mt, n; };
struct PolMoe1 {
    typedef MoeUnit Unit;
    const Params& p; const int* etstart; const int* etiletab; int U, G, c;
    struct AddrA { unsigned off[2][2]; };
    struct AddrB { const char* base; };
    DEV int nk() const { return 16; }
    DEV bool next(int i, MoeUnit& u) const {
        const int L = i * G + c; if (L >= U) return false;
        u.tile = L >> 2; u.nt = L & 3;
        u.bin = __builtin_amdgcn_readfirstlane(etiletab[u.tile]);
        u.mt = u.tile - __builtin_amdgcn_readfirstlane(etstart[u.bin]);
        u.n = min(256, ((const int*)(p.ws + WS_CTL + 512))[u.bin] - u.mt * 256);
        return true;
    }
    DEV bool full(const MoeUnit& u) const { return u.n > 128; }
    DEV void addrA(const MoeUnit& u, AddrA& a) const {
        const int* list = (const int*)(p.ws + WS_EL) + (size_t)u.bin * BINCAP + u.mt * 256;
#pragma unroll
        for (int i = 0; i < 2; ++i) { int R, C; lane_rc(i, R, C);
#pragma unroll
            for (int h = 0; h < 2; ++h) { int r = h * 128 + R; if (r >= u.n) r = 0; a.off[h][i] = (unsigned)list[r] * 2048u + (unsigned)C * 2u; } }
    }
    DEV void addrB(const MoeUnit& u, AddrB& b) const { b.base = (const char*)(p.ws + WS_W13T) + ((size_t)u.bin * 1024 + u.nt * 256) * 2048; }
    DEV const char* pa(const AddrA& a, int h, int i, int kt) const { return (const char*)(p.ws + WS_R1) + a.off[h][i] + kt * 128; }
    DEV const char* pb(const AddrB& b, int h, int i, int kt) const { int R, C; lane_rc(i, R, C); return b.base + (size_t)h * (128 * 2048) + (unsigned)(R * 1024 + C) * 2u + kt * 128; }
};
struct EpiMoe1 { const Params& p; const int* tstart;
    DEV void operator()(const f32x4 (&acc)[2][2][4][2], const MoeUnit& u, int wr, int wc, int fr, int fq) const {
        const int* list = (const int*)(p.ws + WS_EL) + (size_t)u.bin * BINCAP + u.mt * 256;
        const float* wl = (const float*)(p.ws + WS_EW) + (size_t)u.bin * BINCAP + u.mt * 256;
        const unsigned* dl = (const unsigned*)(p.ws + WS_EDST) + (size_t)u.bin * BINCAP + u.mt * 256;
#pragma unroll
        for (int ai = 0; ai < 2; ++ai)
#pragma unroll
            for (int m = 0; m < 4; ++m) { const int r = ai * 128 + wr * 64 + m * 16 + fr; if (r >= u.n) continue;
                const float rs = ((const float*)(p.ws + WS_RSTD2))[list[r]]; const float w = wl[r]; const unsigned d = dl[r];
                bf16_t* hrow = (bf16_t*)(p.ws + WS_HBUF) + ((size_t)tstart[d & 127u] * 256 + ((d >> 7) & 32767u)) * 1024 + ((d >> 22) & 1u) * 512;
#pragma unroll
                for (int bj = 0; bj < 2; ++bj) { const f32x4 v0 = acc[ai][bj][m][0] * rs, v1 = acc[ai][bj][m][1] * rs; const int f = (u.nt * 256 + 128 * bj + 32 * wc + 8 * fq) >> 1;
                    u32x2 w2; w2.x = pk2(siluf_(v0.x) * v0.y * w, siluf_(v0.z) * v0.w * w); w2.y = pk2(siluf_(v1.x) * v1.y * w, siluf_(v1.z) * v1.w * w); *(u32x2*)(hrow + f) = w2; } }
    } };
DEV void phase_moe1(const Params& p, unsigned char* lds) {
    moe_tiles(p, lds);
    const int* etstart = (const int*)(lds + MOE_ES);
    PolMoe1 P{p, etstart, (const int*)(lds + MOE_ET), etstart[32] * 4, (int)gridDim.x, vblock()};
    EpiMoe1 E{p, (const int*)(lds + MOE_TS)};
    pg8::gemm_phase2(( PG8_LAS unsigned char*)lds, P, E);
}
struct PolMoe2 {
    typedef MoeUnit Unit;
    const Params& p; const int* tstart; const int* tiletab; int U, G, c;
    struct AddrA { const char* base; };
    struct AddrB { const char* ba; const char* bb; };
    DEV int nk() const { return 16; }
    DEV bool next(int i, MoeUnit& u) const {
        const int L = i * G + c; if (L >= U) return false;
        u.tile = L >> 2; u.nt = L & 3;
        u.bin = __builtin_amdgcn_readfirstlane(tiletab[u.tile]);
        u.mt = u.tile - __builtin_amdgcn_readfirstlane(tstart[u.bin]);
        u.n = min(256, ((const int*)(p.ws + WS_CTL))[u.bin] - u.mt * 256);
        return true;
    }
    DEV bool full(const MoeUnit& u) const { return u.n > 128; }
    DEV void addrA(const MoeUnit& u, AddrA& a) const { a.base = (const char*)(p.ws + WS_HBUF) + (size_t)u.tile * 256 * 2048; }
    DEV void addrB(const MoeUnit& u, AddrB& b) const {
        int ea, eb; bin_experts(u.bin, ea, eb);
        b.ba = (const char*)(p.ws + WS_W2T) + ((size_t)ea * 1024 + u.nt * 256) * 1024; b.bb = (const char*)(p.ws + WS_W2T) + ((size_t)eb * 1024 + u.nt * 256) * 1024;
    }
    DEV const char* pa(const AddrA& a, int h, int i, int kt) const { int R, C; lane_rc(i, R, C); return a.base + (size_t)h * (128 * 2048) + (unsigned)(R * 1024 + C) * 2u + kt * 128; }
    DEV const char* pb(const AddrB& b, int h, int i, int kt) const { int R, C; lane_rc(i, R, C); return (kt < 8 ? b.ba + kt * 128 : b.bb + (kt - 8) * 128) + (size_t)h * (128 * 1024) + (unsigned)(R * 512 + C) * 2u; }
};
struct EpiMoe2 { const Params& p;
    DEV void operator()(const f32x4 (&acc)[2][2][4][2], const MoeUnit& u, int wr, int wc, int fr, int fq) const {
        const int* list = (const int*)(p.ws + WS_BINL) + (size_t)u.bin * BINCAP + u.mt * 256;
#pragma unroll
        for (int ai = 0; ai < 2; ++ai)
#pragma unroll
            for (int m = 0; m < 4; ++m) { const int r = ai * 128 + wr * 64 + m * 16 + fr; if (r >= u.n) continue; const size_t t = list[r];
#pragma unroll
                for (int bj = 0; bj < 2; ++bj)
#pragma unroll
                    for (int n = 0; n < 2; ++n) { float* o = p.out + t * DM + u.nt * 256 + 128 * bj + 32 * wc + 16 * n + 4 * fq; *(f32x4*)o = *(const f32x4*)o + acc[ai][bj][m][n]; } }
    } };
DEV void phase_moe2(const Params& p, unsigned char* lds) {
    moe_tiles(p, lds);
    const int* tstart = (const int*)(lds + MOE_TS);
    PolMoe2 P{p, tstart, (const int*)(lds + MOE_TT), tstart[NBIN] * 4, (int)gridDim.x, vblock()};
    EpiMoe2 E{p};
    pg8::gemm_phase2((PG8_LAS unsigned char*)lds, P, E);
}

#define XB_TMO      128
#define XB_XCNT(j)  (256  + 64 * (j))
#define XB_XSUB(j)  (1280 + 64 * (j))
#define XB_XGEN(j)  (2304 + 64 * (j))
#define XB_TOP      3328
#define XB_TOPGEN   3392
#define XCD_BAR_WORDS 3456
#define XB_SPIN_CAP (1u << 20)
#define LAS __attribute__((address_space(3)))
constexpr size_t WS_BAR = WS_CTL + 4096;
DEV unsigned xb_ld(unsigned* p) { return __hip_atomic_load(p, __ATOMIC_RELAXED, __HIP_MEMORY_SCOPE_AGENT); }
DEV unsigned xb_add(unsigned* p, unsigned v) { return __hip_atomic_fetch_add(p, v, __ATOMIC_RELAXED, __HIP_MEMORY_SCOPE_AGENT); }
DEV unsigned xb_xcc_id() { return (unsigned)__builtin_amdgcn_s_getreg((3 << 11) | 20) & 0xFu; }
#define XB_SPIN(cond, bar) do { unsigned _sp = 0; while (cond) { __builtin_amdgcn_s_sleep(1); \
    if ((++_sp & 255u) == 0u) { if (xb_ld(&(bar)[XB_TMO])) break; if (_sp > XB_SPIN_CAP) { atomicAdd(&(bar)[XB_TMO], 1u); break; } } } } while (0)
struct XcdBarrier { unsigned* bar; unsigned x; volatile LAS unsigned* st; };
DEV XcdBarrier xcd_barrier_post(unsigned* bar, volatile LAS unsigned* st) {
    XcdBarrier b; b.bar = bar; b.x = xb_xcc_id(); b.st = st;
    if (threadIdx.x == 0) (void)xb_add(&bar[XB_XCNT(b.x)], 1u);
    return b;
}
DEV void xcd_barrier_complete(unsigned* bar, unsigned x, unsigned& nloc, unsigned& nx) {
    const unsigned G = gridDim.x * gridDim.y * gridDim.z;
    unsigned sum, cnt, mine, sp = 0u;
    for (;;) {
        sum = 0u; cnt = 0u; mine = 0u;
#pragma unroll
        for (unsigned j = 0; j < 16; ++j) { const unsigned c = xb_ld(&bar[XB_XCNT(j)]); sum += c; cnt += (c > 0u) ? 1u : 0u; mine = (j == x) ? c : mine; }
        if (sum == G) break;
        __builtin_amdgcn_s_sleep(1);
        if ((++sp & 255u) == 0u) { if (xb_ld(&bar[XB_TMO])) break; if (sp > XB_SPIN_CAP) { atomicAdd(&bar[XB_TMO], 1u); break; } }
    }
    nloc = mine > 0u ? mine : 1u; nx = cnt > 0u ? cnt : 1u;
}
DEV void xcd_barrier(const XcdBarrier& b) {
    asm volatile("s_waitcnt vmcnt(0)" ::: "memory");
    __syncthreads();
    if (threadIdx.x == 0) {
        unsigned* bar = b.bar;
        __builtin_amdgcn_s_waitcnt(0);
        unsigned nloc = b.st[0], nx = b.st[1];
        if (nloc == 0u) { xcd_barrier_complete(bar, b.x, nloc, nx); b.st[0] = nloc; b.st[1] = nx; }
        const unsigned old = xb_add(&bar[XB_XSUB(b.x)], 1u);
        const unsigned gen = old / nloc;
        if (old + 1u == (gen + 1u) * nloc) {
            __builtin_amdgcn_fence(__ATOMIC_RELEASE, "agent");
            asm volatile("s_waitcnt vmcnt(0)" ::: "memory");
            const unsigned og = xb_add(&bar[XB_TOP], 1u);
            const unsigned tg = og / nx;
            if (og + 1u == (tg + 1u) * nx) xb_add(&bar[XB_TOPGEN], 1u);
            else XB_SPIN(xb_ld(&bar[XB_TOPGEN]) == tg, bar);
            __builtin_amdgcn_fence(__ATOMIC_ACQUIRE, "agent");
            xb_add(&bar[XB_XGEN(b.x)], 1u);
            asm volatile("s_waitcnt vmcnt(0)" ::: "memory");
        } else {
            XB_SPIN(xb_ld(&bar[XB_XGEN(b.x)]) == gen, bar);
            __builtin_amdgcn_fence(__ATOMIC_ACQUIRE, "agent");
            asm volatile("s_waitcnt vmcnt(0)" ::: "memory");
        }
    }
    __syncthreads();
}

constexpr int LDS_BYTES = 144 * 1024;
constexpr int N_PHASES = 9;
__global__ void __launch_bounds__(NT) mega(Params p, int lo, int hi) {
    extern __shared__ __attribute__((aligned(16))) unsigned char lds[];
    volatile LAS unsigned* xst = (volatile LAS unsigned*)(lds + LDS_BYTES - 16);
    if (threadIdx.x < 4) xst[threadIdx.x] = 0u;
    __syncthreads();
    XcdBarrier xbar; xbar.bar = (unsigned*)(p.ws + WS_BAR); xbar.x = 0; xbar.st = xst;
    if (hi - lo > 1) xbar = xcd_barrier_post((unsigned*)(p.ws + WS_BAR), xst);
#define GRID_SYNC() xcd_barrier(xbar)
#ifndef PROBE_REPEAT
#define PROBE_REPEAT -1
#endif
#define RUN_PHASE(k, call) do { if (lo <= (k) && (k) < hi) { call; \
        if ((k) == PROBE_REPEAT) { GRID_SYNC(); \
            if ((k) == 5) { float* rz = (float*)(p.ws + WS_ROWSS); for (int i = blockIdx.x * NT + threadIdx.x; i < NTOK; i += gridDim.x * NT) rz[i] = 0.f; GRID_SYNC(); } \
            if ((k) == 7) { if (blockIdx.x == 0 && threadIdx.x < 128) ((int*)(p.ws + WS_CTL))[threadIdx.x] = 0; GRID_SYNC(); } \
            call; } \
        if ((k) + 1 < hi) GRID_SYNC(); } } while (0)
    RUN_PHASE(0, phase_prologue(p, lds));
    RUN_PHASE(1, phase_inproj(p, lds));
    RUN_PHASE(2, { phase_cmp_a(p, lds); const int G_ = (int)gridDim.x; if (G_ > 128) phase_hgrn_a1(p, lds, 64, G_ - 64); else phase_hgrn_a1(p, lds, 0, G_); });
    RUN_PHASE(3, { phase_cmp_b(p, lds); phase_hgrn_a2(p, lds); });
    RUN_PHASE(4, { phase_cmp_attn(p, lds); phase_hgrn_a3(p, lds); });
    RUN_PHASE(5, { phase_flash(p, lds); phase_normalize(p, lds); });
    RUN_PHASE(6, phase_outproj(p, lds));
    RUN_PHASE(7, phase_router(p, lds));
    RUN_PHASE(8, phase_moe1(p, lds));
    RUN_PHASE(9, phase_moe2(p, lds));
#undef RUN_PHASE
}

extern "C" void kernel_launch(void* const* d_in, const int* in_sizes, int n_in, void* d_out, int out_size, void* d_ws, size_t ws_size, hipStream_t stream) {
    static int grid = 0;
    if (grid == 0) {
        int dev = 0, cus = 0, per_cu = 0;
        hipGetDevice(&dev);
        hipDeviceGetAttribute(&cus, hipDeviceAttributeMultiprocessorCount, dev);
        hipFuncSetAttribute((const void*)mega, hipFuncAttributeMaxDynamicSharedMemorySize, LDS_BYTES);
        hipOccupancyMaxActiveBlocksPerMultiprocessor(&per_cu, (const void*)mega, NT, LDS_BYTES);
        if (per_cu < 1) per_cu = 1;
        grid = cus;
        if (ws_size < WS_END) fprintf(stderr, "kernel_launch: workspace too small: %zu < %zu\n", ws_size, (size_t)WS_END);
        fprintf(stderr, "kernel_launch: cus %d per_cu %d grid %d ws %zu\n", cus, per_cu, grid, ws_size);
    }
    Params p{};
    const float** pp = (const float**)&p;
    for (int i = 0; i < 23; ++i) pp[i] = (const float*)d_in[i];
    p.out = (float*)d_out; p.ws = (unsigned char*)d_ws;
#if N_LAUNCH_MODE == 1
    (void)hipMemsetAsync((unsigned char*)d_ws + WS_BAR, 0, XCD_BAR_WORDS * 4, stream);
    int lo = 0, hi = N_PHASES + 1;
    void* args[] = {&p, &lo, &hi};
    hipError_t e = hipLaunchCooperativeKernel((const void*)mega, dim3(grid), dim3(NT), args, LDS_BYTES, stream);
    if (e != hipSuccess) fprintf(stderr, "cooperative launch failed: %s\n", hipGetErrorString(e));
#else
    for (int ph = 0; ph <= N_PHASES; ++ph) hipLaunchKernelGGL(mega, dim3(grid), dim3(NT), LDS_BYTES, stream, p, ph, ph + 1);
#endif
}
```

```cpp
#include <hip/hip_runtime.h>
#include <hip/hip_cooperative_groups.h>
#include <cstdio>
#include <cstdint>
#include <cstring>
namespace cg = cooperative_groups;

#ifndef N_LAUNCH_MODE
#define N_LAUNCH_MODE 1
#endif

#define DEV __device__ __forceinline__
typedef unsigned short bf16_t;
typedef short bf16x8 __attribute__((ext_vector_type(8)));
typedef float f32x4 __attribute__((ext_vector_type(4)));
typedef float f32x2 __attribute__((ext_vector_type(2)));
typedef float f32x16 __attribute__((ext_vector_type(16)));
typedef unsigned u32x4 __attribute__((ext_vector_type(4)));
typedef unsigned u32x2 __attribute__((ext_vector_type(2)));

constexpr int NT = 512;
constexpr int BATCH = 8, SEQ = 4096, DM = 1024, NTOK = BATCH * SEQ;
constexpr int IN_COLS = 3352, INP = 3584;
constexpr int NC = 255;
constexpr float RMS_EPS = 1e-6f;
constexpr float QSCALE = 0.125f * 1.4426950408889634f;
constexpr int NBIN = 112;
constexpr int BINCAP = NTOK;

constexpr size_t MiB = 1ull << 20;
constexpr size_t WS_CTL    = 0;
constexpr size_t WS_RSTD1  = 1 * MiB;
constexpr size_t WS_RSTD2  = WS_RSTD1 + 128 * 1024;
constexpr size_t WS_ROWSS  = WS_RSTD2 + 128 * 1024;
constexpr size_t WS_TOKW   = WS_ROWSS + 128 * 1024;
constexpr size_t WS_LB     = WS_TOKW + 256 * 1024;
constexpr size_t WS_CBIAS  = WS_LB + 4096;
constexpr size_t WS_SELM   = 2 * MiB;
constexpr size_t WS_GATES  = 3 * MiB;
constexpr size_t WS_KCMP   = 6 * MiB;
constexpr size_t WS_VCMP   = WS_KCMP + 512 * 1024;
constexpr size_t WS_CW2T   = 7 * MiB;
constexpr size_t WS_RW     = 7 * MiB + 128 * 1024;
constexpr size_t WS_HID    = 8 * MiB;
constexpr size_t WS_CW1T   = 12 * MiB;
constexpr size_t WS_WOUTT  = 14 * MiB;
constexpr size_t WS_WINT   = 16 * MiB;
constexpr size_t WS_R1     = 24 * MiB;
constexpr size_t WS_Q      = 88 * MiB;
constexpr size_t WS_KC     = 120 * MiB;
constexpr size_t WS_VC     = 128 * MiB;
constexpr size_t WS_KS     = 136 * MiB;
constexpr size_t WS_KW     = 144 * MiB;
constexpr size_t WS_VST    = 152 * MiB;
constexpr size_t WS_VWT    = 160 * MiB;
constexpr size_t WS_OC     = 168 * MiB;
constexpr size_t WS_W13T   = 200 * MiB;
constexpr size_t WS_W2T    = 264 * MiB;
constexpr size_t WS_HQ     = 296 * MiB;
constexpr size_t WS_HV     = 328 * MiB;
constexpr size_t WS_HG     = 360 * MiB;
constexpr size_t WS_HLOGF  = 392 * MiB;
constexpr size_t WS_DBUF   = 456 * MiB;
constexpr size_t WS_END    = 457 * MiB;
constexpr size_t WS_UBUF   = WS_W13T;
constexpr size_t WS_BINL   = WS_HQ;
constexpr size_t WS_HBUF   = WS_HQ + 16 * MiB;
constexpr size_t WS_EL     = WS_HQ + 136 * MiB;
constexpr size_t WS_EW     = WS_HQ + 140 * MiB;
constexpr size_t WS_EDST   = WS_HQ + 144 * MiB;

struct Params {
    const float *x, *attn_g, *ffn_g, *w_in, *w_out, *g_q, *g_k, *pos_k, *pos_v, *wk1, *wk2, *wv1, *wv2, *g_nsa, *lb_logits, *g_hn,
        *w_group, *b_group, *w_expert, *b_expert, *w1, *w3, *w2;
    float* out;
    unsigned char* ws;
};

typedef __bf16 bf16x2_t __attribute__((ext_vector_type(2)));
DEV unsigned pk2(float lo, float hi) { f32x2 f = {lo, hi}; return __builtin_bit_cast(unsigned, __builtin_convertvector(f, bf16x2_t)); }
DEV bf16_t f2bf(float f) { return (bf16_t)(pk2(f, 0.f) & 0xffffu); }
DEV float bf2f(bf16_t b) { return __uint_as_float(((unsigned)b) << 16); }
DEV float bflo(unsigned u) { return __uint_as_float(u << 16); }
DEV float bfhi(unsigned u) { return __uint_as_float(u & 0xffff0000u); }
DEV float sigmoidf_(float v) { return __builtin_amdgcn_rcpf(1.f + __builtin_amdgcn_exp2f(-1.4426950408889634f * v)); }
DEV float siluf_(float v) { return v * __builtin_amdgcn_rcpf(1.f + __builtin_amdgcn_exp2f(-1.4426950408889634f * v)); }
DEV float wave_sum(float v) {
#pragma unroll
    for (int o = 1; o < 64; o <<= 1) v += __shfl_xor(v, o);
    return v;
}
DEV float wave_max(float v) {
#pragma unroll
    for (int o = 1; o < 64; o <<= 1) v = fmaxf(v, __shfl_xor(v, o));
    return v;
}
DEV int vblock() { const int G = gridDim.x, b = blockIdx.x; return (G % 8 == 0) ? (b % 8) * (G / 8) + b / 8 : b; }

namespace pg8 {
#define PG8_LAS __attribute__((address_space(3)))
constexpr int BM = 256, BK = 64, HALF = 128, HTB = HALF * BK * 2, STAGE_BYTES = 8 * HTB, NXCD = 8, WGM = 1;
__host__ __device__ __forceinline__ int lds_byte(int r, int c) { const int st = (r >> 4) * 2 + (c >> 5), rr = r & 15, cc = c & 31, ob = rr * 64 + cc * 2; return st * 1024 + (ob ^ (((ob >> 9) & 1) << 5)); }
__host__ __device__ __forceinline__ void stage_rc(int b, int& R, int& C) { const int st = b / 1024, sb = b % 1024, swz = sb ^ (((sb >> 9) & 1) << 5); R = (st >> 1) * 16 + swz / 64; C = (st & 1) * 32 + (swz % 64) / 2; }
struct Unit { int pm, pn; };
struct Gemm { const bf16_t* A; const bf16_t* Bt; int M, N, K; };
struct StaticOrder {
    int nM, nN, nwg, G, c;
    __host__ __device__ void init(int M, int N, int G_, int c_) { nM = M / BM; nN = N / BM; nwg = nM * nN; G = G_; c = c_; }
    __host__ __device__ bool next(int i, Unit& u) const {
        const long L = (long)i * G + c; if (L >= nwg) return false;
        int wgid = (int)L; { const int q = nwg / NXCD, r = nwg % NXCD, xcd = wgid % NXCD, off = wgid / NXCD; wgid = (xcd < r ? xcd * (q + 1) : r * (q + 1) + (xcd - r) * q) + off; }
        const int nig = WGM * nN, gid = wgid / nig, fm = gid * WGM, gsz = (nM - fm) < WGM ? (nM - fm) : WGM;
        u.pm = fm + ((wgid % nig) % gsz); u.pn = (wgid % nig) / gsz; return true;
    }
};
template <class Epi, class Sched>
__device__ __forceinline__ void gemm_phase(PG8_LAS unsigned char* lds, const Gemm g, const Sched& S, const Epi& E) {
    const int tid = threadIdx.x, wid = __builtin_amdgcn_readfirstlane(tid >> 6), lane = tid & 63, wr = wid >> 2, wc = wid & 3, fr = lane & 15, fq = lane >> 4;
    const int K = g.K, nt = K / BK;
    unsigned voffA[2];
#pragma unroll
    for (int i = 0; i < 2; ++i) { int R, C; stage_rc(tid * 16 + i * 8192, R, C); voffA[i] = (unsigned)(R * K + C) * 2u; }
    const size_t kstep = (size_t)(BK * 2);
    const size_t hstep = (size_t)HALF * K * 2;
    const size_t tstep = 2 * hstep;
    const unsigned ldsw = (unsigned)wid * 1024u;
    const int aoff = lds_byte(wr * 64 + fr, fq * 8), boff = lds_byte(wc * 32 + fr, fq * 8);
#define PG8_SA(b, h) (((b) * 2 + (h)) * HTB)
#define PG8_SB(b, h) ((4 + (b) * 2 + (h)) * HTB)
#define PG8_STAGE(bufoff, gbase, voff) do { _Pragma("unroll") for (int _i = 0; _i < 2; ++_i) \
        __builtin_amdgcn_global_load_lds((const unsigned*)((const char*)(gbase) + (voff)[_i]), (PG8_LAS unsigned*)(lds + (bufoff) + ldsw + _i * 8192), 16, 0, 0); } while (0)
#define PG8_LDA(dst, b, h) do { _Pragma("unroll") for (int m = 0; m < 4; ++m) _Pragma("unroll") for (int k = 0; k < 2; ++k) dst[m][k] = *(const PG8_LAS bf16x8*)(lds + PG8_SA(b, h) + aoff + m * 2048 + k * 1024); } while (0)
#define PG8_LDB(dst, b, h) do { _Pragma("unroll") for (int n = 0; n < 2; ++n) _Pragma("unroll") for (int k = 0; k < 2; ++k) dst[n][k] = *(const PG8_LAS bf16x8*)(lds + PG8_SB(b, h) + boff + n * 2048 + k * 1024); } while (0)
#define PG8_MMA(ai, bj, At, Bt) do { __builtin_amdgcn_s_setprio(1); _Pragma("unroll") for (int m = 0; m < 4; ++m) _Pragma("unroll") for (int n = 0; n < 2; ++n) _Pragma("unroll") for (int k = 0; k < 2; ++k) \
        acc[ai][bj][m][n] = __builtin_amdgcn_mfma_f32_16x16x32_bf16(Bt[n][k], At[m][k], acc[ai][bj][m][n], 0, 0, 0); __builtin_amdgcn_s_setprio(0); } while (0)
#define PG8_WAIT_V(n) asm volatile("s_waitcnt vmcnt(" #n ")" ::: "memory")
#define PG8_WAIT_L(n) asm volatile("s_waitcnt lgkmcnt(" #n ")" ::: "memory")
#define PG8_BAR __builtin_amdgcn_s_barrier()
#define PG8_SCHED __builtin_amdgcn_sched_barrier(0)
    Unit cur, nxt; int ui = 0;
    if (!S.next(0, cur)) return;
    f32x4 acc[2][2][4][2];
#pragma unroll
    for (int a = 0; a < 2; ++a)
#pragma unroll
        for (int b = 0; b < 2; ++b)
#pragma unroll
            for (int m = 0; m < 4; ++m)
#pragma unroll
                for (int n = 0; n < 2; ++n) acc[a][b][m][n] = (f32x4){0.f, 0.f, 0.f, 0.f};
    bf16x8 At[4][2], B0[2][2], B1[2][2];
    const char* cA = (const char*)g.A + (size_t)cur.pm * tstep; const char* cB = (const char*)g.Bt + (size_t)cur.pn * tstep;
    PG8_STAGE(PG8_SB(0, 0), cB, voffA); PG8_STAGE(PG8_SA(0, 0), cA, voffA); PG8_STAGE(PG8_SB(0, 1), cB + hstep, voffA); PG8_STAGE(PG8_SA(0, 1), cA + hstep, voffA);
    if (wr == 1) PG8_BAR;
    PG8_WAIT_V(4); PG8_BAR;
    PG8_STAGE(PG8_SB(1, 0), cB + kstep, voffA); PG8_STAGE(PG8_SA(1, 0), cA + kstep, voffA); PG8_STAGE(PG8_SB(1, 1), cB + hstep + kstep, voffA);
    PG8_WAIT_V(6); PG8_BAR;
    for (;;) {
        const bool has_next = S.next(ui + 1, nxt);
        const char* nA = has_next ? (const char*)g.A + (size_t)nxt.pm * tstep : cA; const char* nB = has_next ? (const char*)g.Bt + (size_t)nxt.pn * tstep : cB;
        float midrs[2][4];
        if constexpr (Epi::MIDSCALE) {
#pragma unroll
            for (int a = 0; a < 2; ++a)
#pragma unroll
                for (int m = 0; m < 4; ++m) midrs[a][m] = E.rowscale(cur.pm * BM + a * HALF + wr * 64 + m * 16 + fr); }
        for (int t = 0; t < nt; t += 2) {
            const bool last = (t == nt - 2);
            if constexpr (Epi::MIDSCALE) { if (t == E.midk()) {
#pragma unroll
                for (int a = 0; a < 2; ++a)
#pragma unroll
                    for (int b = 0; b < 2; ++b)
#pragma unroll
                        for (int m = 0; m < 4; ++m)
#pragma unroll
                            for (int n = 0; n < 2; ++n) acc[a][b][m][n] = acc[a][b][m][n] * midrs[a][m]; } }
            const char* a1 = cA + (size_t)(t + 1) * kstep;
            const char* a2 = last ? nA : cA + (size_t)(t + 2) * kstep; const char* b2 = last ? nB : cB + (size_t)(t + 2) * kstep;
            const char* a3 = a2 + kstep; const char* b3 = b2 + kstep;
            PG8_LDB(B0, 0, 0); PG8_SCHED; PG8_LDA(At, 0, 0); PG8_STAGE(PG8_SA(1, 1), a1 + hstep, voffA);
            PG8_WAIT_L(8); PG8_BAR; PG8_WAIT_L(0); PG8_MMA(0, 0, At, B0); PG8_BAR; PG8_SCHED;
            PG8_LDB(B1, 0, 1); PG8_STAGE(PG8_SB(0, 0), b2, voffA);
            PG8_BAR; PG8_WAIT_L(0); PG8_MMA(0, 1, At, B1); PG8_BAR;
            PG8_LDA(At, 0, 1); PG8_STAGE(PG8_SA(0, 0), a2, voffA);
            PG8_BAR; PG8_WAIT_L(0); PG8_MMA(1, 0, At, B0); PG8_BAR; PG8_SCHED;
            PG8_STAGE(PG8_SB(0, 1), b2 + hstep, voffA);
            PG8_WAIT_V(6); PG8_BAR; PG8_MMA(1, 1, At, B1); PG8_BAR;
            PG8_LDB(B0, 1, 0); PG8_SCHED; PG8_LDA(At, 1, 0); PG8_STAGE(PG8_SA(0, 1), a2 + hstep, voffA);
            PG8_WAIT_L(8); PG8_BAR; PG8_WAIT_L(0); PG8_MMA(0, 0, At, B0); PG8_BAR; PG8_SCHED;
            PG8_LDB(B1, 1, 1); PG8_STAGE(PG8_SB(1, 0), b3, voffA);
            PG8_BAR; PG8_WAIT_L(0); PG8_MMA(0, 1, At, B1); PG8_BAR;
            PG8_LDA(At, 1, 1); PG8_STAGE(PG8_SA(1, 0), a3, voffA);
            PG8_BAR; PG8_WAIT_L(0); PG8_MMA(1, 0, At, B0); PG8_BAR; PG8_SCHED;
            PG8_STAGE(PG8_SB(1, 1), b3 + hstep, voffA);
            PG8_WAIT_V(6); PG8_BAR; PG8_MMA(1, 1, At, B1); PG8_BAR;
        }
        E(acc, cur, wr, wc, fr, fq);
        if (!has_next) break;
#pragma unroll
        for (int a = 0; a < 2; ++a)
#pragma unroll
            for (int b = 0; b < 2; ++b)
#pragma unroll
                for (int m = 0; m < 4; ++m)
#pragma unroll
                    for (int n = 0; n < 2; ++n) acc[a][b][m][n] = (f32x4){0.f, 0.f, 0.f, 0.f};
        cur = nxt; cA = nA; cB = nB; ++ui;
    }
    PG8_WAIT_V(0);
    if (wr == 0) PG8_BAR;
    PG8_BAR;
#undef PG8_SA
#undef PG8_SB
#undef PG8_STAGE
#undef PG8_LDA
#undef PG8_LDB
#undef PG8_MMA
#undef PG8_WAIT_V
#undef PG8_WAIT_L
#undef PG8_BAR
#undef PG8_SCHED
}
template <class Pol, class Epi>
__device__ __forceinline__ void gemm_phase2(PG8_LAS unsigned char* lds, const Pol& P, const Epi& E) {
    const int tid = threadIdx.x, wid = __builtin_amdgcn_readfirstlane(tid >> 6), lane = tid & 63, wr = wid >> 2, wc = wid & 3, fr = lane & 15, fq = lane >> 4;
    const int nt = P.nk();
    const unsigned ldsw = (unsigned)wid * 1024u;
    const int aoff = lds_byte(wr * 64 + fr, fq * 8), boff = lds_byte(wc * 32 + fr, fq * 8);
#define PG8_SA(b, h) (((b) * 2 + (h)) * HTB)
#define PG8_SB(b, h) ((4 + (b) * 2 + (h)) * HTB)
#define PG8_STAGE_A(bufoff, AS, h, kt) do { _Pragma("unroll") for (int _i = 0; _i < 2; ++_i) \
        __builtin_amdgcn_global_load_lds((const unsigned*)P.pa(AS, h, _i, kt), (PG8_LAS unsigned*)(lds + (bufoff) + ldsw + _i * 8192), 16, 0, 0); } while (0)
#define PG8_STAGE_B(bufoff, BS, h, kt) do { _Pragma("unroll") for (int _i = 0; _i < 2; ++_i) \
        __builtin_amdgcn_global_load_lds((const unsigned*)P.pb(BS, h, _i, kt), (PG8_LAS unsigned*)(lds + (bufoff) + ldsw + _i * 8192), 16, 0, 0); } while (0)
#define PG8_LDA(dst, b, h) do { _Pragma("unroll") for (int m = 0; m < 4; ++m) _Pragma("unroll") for (int k = 0; k < 2; ++k) dst[m][k] = *(const PG8_LAS bf16x8*)(lds + PG8_SA(b, h) + aoff + m * 2048 + k * 1024); } while (0)
#define PG8_LDB(dst, b, h) do { _Pragma("unroll") for (int n = 0; n < 2; ++n) _Pragma("unroll") for (int k = 0; k < 2; ++k) dst[n][k] = *(const PG8_LAS bf16x8*)(lds + PG8_SB(b, h) + boff + n * 2048 + k * 1024); } while (0)
#define PG8_MMA(ai, bj, At, Bt) do { __builtin_amdgcn_s_setprio(1); _Pragma("unroll") for (int m = 0; m < 4; ++m) _Pragma("unroll") for (int n = 0; n < 2; ++n) _Pragma("unroll") for (int k = 0; k < 2; ++k) \
        acc[ai][bj][m][n] = __builtin_amdgcn_mfma_f32_16x16x32_bf16(Bt[n][k], At[m][k], acc[ai][bj][m][n], 0, 0, 0); __builtin_amdgcn_s_setprio(0); } while (0)
#define PG8_STAGE_A2(bufoff, h, kt) do { _Pragma("unroll") for (int _i = 0; _i < 2; ++_i) \
        __builtin_amdgcn_global_load_lds((const unsigned*)P.pa(a2, h, _i, kt), (PG8_LAS unsigned*)(lds + (bufoff) + ldsw + _i * 8192), 16, 0, 0); } while (0)
#define PG8_STAGE_B2(bufoff, h, kt) do { _Pragma("unroll") for (int _i = 0; _i < 2; ++_i) \
        __builtin_amdgcn_global_load_lds((const unsigned*)P.pb(b2, h, _i, kt), (PG8_LAS unsigned*)(lds + (bufoff) + ldsw + _i * 8192), 16, 0, 0); } while (0)
#define PG8_WAIT_V(n) asm volatile("s_waitcnt vmcnt(" #n ")" ::: "memory")
#define PG8_WAIT_L(n) asm volatile("s_waitcnt lgkmcnt(" #n ")" ::: "memory")
#define PG8_BAR __builtin_amdgcn_s_barrier()
#define PG8_SCHED __builtin_amdgcn_sched_barrier(0)
    typename Pol::Unit cur, nxt; int ui = 0;
    if (!P.next(0, cur)) return;
    f32x4 acc[2][2][4][2];
#pragma unroll
    for (int a = 0; a < 2; ++a)
#pragma unroll
        for (int b = 0; b < 2; ++b)
#pragma unroll
            for (int m = 0; m < 4; ++m)
#pragma unroll
                for (int n = 0; n < 2; ++n) acc[a][b][m][n] = (f32x4){0.f, 0.f, 0.f, 0.f};
    bf16x8 At[4][2], B0[2][2], B1[2][2];
    typename Pol::AddrA aC, aN; typename Pol::AddrB bC, bN;
    P.addrA(cur, aC); P.addrB(cur, bC);
    PG8_STAGE_B(PG8_SB(0, 0), bC, 0, 0); PG8_STAGE_A(PG8_SA(0, 0), aC, 0, 0); PG8_STAGE_B(PG8_SB(0, 1), bC, 1, 0); PG8_STAGE_A(PG8_SA(0, 1), aC, 1, 0);
    if (wr == 1) PG8_BAR;
    PG8_WAIT_V(4); PG8_BAR;
    PG8_STAGE_B(PG8_SB(1, 0), bC, 0, 1); PG8_STAGE_A(PG8_SA(1, 0), aC, 0, 1); PG8_STAGE_B(PG8_SB(1, 1), bC, 1, 1);
    PG8_WAIT_V(6); PG8_BAR;
    for (;;) {
        const bool has_next = P.next(ui + 1, nxt);
        if (has_next) { P.addrA(nxt, aN); P.addrB(nxt, bN); } else { aN = aC; bN = bC; }
        const bool full = P.full(cur);
        for (int t = 0; t < nt; t += 2) {
            const bool last = (t == nt - 2);
            const typename Pol::AddrA a2 = last ? aN : aC; const typename Pol::AddrB b2 = last ? bN : bC;
            const int k2 = last ? 0 : t + 2, k3 = k2 + 1;
            PG8_LDB(B0, 0, 0); PG8_SCHED; PG8_LDA(At, 0, 0); PG8_STAGE_A(PG8_SA(1, 1), aC, 1, t + 1);
            PG8_WAIT_L(8); PG8_BAR; PG8_WAIT_L(0); PG8_MMA(0, 0, At, B0); PG8_BAR; PG8_SCHED;
            PG8_LDB(B1, 0, 1); PG8_STAGE_B2(PG8_SB(0, 0), 0, k2);
            PG8_BAR; PG8_WAIT_L(0); PG8_MMA(0, 1, At, B1); PG8_BAR;
            PG8_LDA(At, 0, 1); PG8_STAGE_A2(PG8_SA(0, 0), 0, k2);
            PG8_BAR; PG8_WAIT_L(0); if (full) PG8_MMA(1, 0, At, B0); PG8_BAR; PG8_SCHED;
            PG8_STAGE_B2(PG8_SB(0, 1), 1, k2);
            PG8_WAIT_V(6); PG8_BAR; if (full) PG8_MMA(1, 1, At, B1); PG8_BAR;
            PG8_LDB(B0, 1, 0); PG8_SCHED; PG8_LDA(At, 1, 0); PG8_STAGE_A2(PG8_SA(0, 1), 1, k2);
            PG8_WAIT_L(8); PG8_BAR; PG8_WAIT_L(0); PG8_MMA(0, 0, At, B0); PG8_BAR; PG8_SCHED;
            PG8_LDB(B1, 1, 1); PG8_STAGE_B2(PG8_SB(1, 0), 0, k3);
            PG8_BAR; PG8_WAIT_L(0); PG8_MMA(0, 1, At, B1); PG8_BAR;
            PG8_LDA(At, 1, 1); PG8_STAGE_A2(PG8_SA(1, 0), 0, k3);
            PG8_BAR; PG8_WAIT_L(0); if (full) PG8_MMA(1, 0, At, B0); PG8_BAR; PG8_SCHED;
            PG8_STAGE_B2(PG8_SB(1, 1), 1, k3);
            PG8_WAIT_V(6); PG8_BAR; if (full) PG8_MMA(1, 1, At, B1); PG8_BAR;
        }
        E(acc, cur, wr, wc, fr, fq);
        if (!has_next) break;
#pragma unroll
        for (int a = 0; a < 2; ++a)
#pragma unroll
            for (int b = 0; b < 2; ++b)
#pragma unroll
                for (int m = 0; m < 4; ++m)
#pragma unroll
                    for (int n = 0; n < 2; ++n) acc[a][b][m][n] = (f32x4){0.f, 0.f, 0.f, 0.f};
        cur = nxt; aC = aN; bC = bN; ++ui;
    }
    PG8_WAIT_V(0);
    if (wr == 0) PG8_BAR;
    PG8_BAR;
#undef PG8_SA
#undef PG8_SB
#undef PG8_STAGE_A
#undef PG8_STAGE_B
#undef PG8_STAGE_A2
#undef PG8_STAGE_B2
#undef PG8_LDA
#undef PG8_LDB
#undef PG8_MMA
#undef PG8_WAIT_V
#undef PG8_WAIT_L
#undef PG8_BAR
#undef PG8_SCHED
}
__host__ __device__ __forceinline__ int perm_lo(int x) { return (((x >> 2) & 3) << 3) | (((x >> 4) & 1) << 2) | (x & 3); }
__host__ __device__ __forceinline__ int inv_perm_lo(int y) { return (((y >> 2) & 1) << 4) | (((y >> 3) & 3) << 2) | (y & 3); }
__host__ __device__ __forceinline__ int logcol(int p) { return (p & ~255) + 64 * ((p >> 5) & 3) + 32 * ((p >> 7) & 1) + perm_lo(p & 31); }
}

template <class SRC>
DEV void convert_tile(float* tl, const SRC& src, bf16_t* dst, int ldd, int n0, int k0) {
    const int tid = threadIdx.x;
    {
        const int n = tid & 63;
#pragma unroll
        for (int i = 0; i < 8; ++i) { const int kk = (tid >> 6) + 8 * i; tl[kk * 65 + n] = src.get(n0 + n, k0 + kk); }
    }
    __syncthreads();
    {
        const int n = tid >> 3, kc = tid & 7;
        const float* s = tl + (kc * 8) * 65 + n;
        u32x4 o;
        o.x = pk2(s[0 * 65], s[1 * 65]); o.y = pk2(s[2 * 65], s[3 * 65]); o.z = pk2(s[4 * 65], s[5 * 65]); o.w = pk2(s[6 * 65], s[7 * 65]);
        *(u32x4*)(dst + (size_t)(n0 + n) * ldd + k0 + kc * 8) = o;
    }
    __syncthreads();
}
struct SrcWin { const float* w; const float* g;
    DEV float get(int np, int k) const { const int n = pg8::logcol(np); int col; if (n < 1280) col = n; else if (n < 3328) col = n + 24; else if (n < 3352) col = 1280 + (n - 3328); else return 0.f;
        return w[(size_t)k * IN_COLS + col] * g[k]; } };
struct SrcWout { const float* w; const float* g;
    DEV float get(int np, int k) const { const int n = pg8::logcol(np); const float v = w[(size_t)k * DM + n]; return k < 512 ? v * g[k] : v; } };
struct SrcPlain { const float* w; int ld;
    DEV float get(int n, int k) const { return w[(size_t)k * ld + n]; } };
struct SrcW13 { const float* w1; const float* w3; const float* g;
    DEV float get(int n, int k) const { const uintptr_t a = (uintptr_t)w1, b = (uintptr_t)w3; const float* w = (const float*)(a + ((b - a) & (uintptr_t)(0 - (long long)(n & 1))));
        return w[(size_t)k * 512 + (n >> 1)] * g[k]; } };

template <class SRC>
DEV void convert_tile256(float* tl, const SRC& src, bf16_t* dst, int ldd, int n0, int k0) {
    const int tid = threadIdx.x;
    {
        const int q = tid & 63;
        f32x4 v[8];
#pragma unroll
        for (int i = 0; i < 8; ++i) v[i] = src.quad(n0, q, k0 + (tid >> 6) + 8 * i);
#pragma unroll
        for (int i = 0; i < 8; ++i) { float* o = tl + ((tid >> 6) + 8 * i) * 257; o[src.drow(q, 0)] = v[i].x; o[src.drow(q, 1)] = v[i].y; o[src.drow(q, 2)] = v[i].z; o[src.drow(q, 3)] = v[i].w; }
    }
    __syncthreads();
#pragma unroll
    for (int i = 0; i < 4; ++i) {
        const int idx = tid + NT * i, n = idx >> 3, kc = idx & 7;
        const float* s = tl + (kc * 8) * 257 + n;
        u32x4 o;
        o.x = pk2(s[0 * 257], s[1 * 257]); o.y = pk2(s[2 * 257], s[3 * 257]); o.z = pk2(s[4 * 257], s[5 * 257]); o.w = pk2(s[6 * 257], s[7 * 257]);
        *(u32x4*)(dst + (size_t)(n0 + n) * ldd + k0 + kc * 8) = o;
    }
    __syncthreads();
}
struct SrcWin4 { const float* w; const float* g;
    DEV int drow(int q, int e) const { return 4 * q + e; }
    DEV f32x4 quad(int n0, int q, int k) const { const int n = pg8::logcol(n0 + 4 * q); int col; if (n < 1280) col = n; else if (n < 3328) col = n + 24; else if (n < 3352) col = 1280 + (n - 3328); else return (f32x4){0.f, 0.f, 0.f, 0.f};
        return *(const f32x4*)(w + (size_t)k * IN_COLS + col) * g[k]; } };
struct SrcWout4 { const float* w; const float* g;
    DEV int drow(int q, int e) const { return 4 * q + e; }
    DEV f32x4 quad(int n0, int q, int k) const { const f32x4 v = *(const f32x4*)(w + (size_t)k * DM + pg8::logcol(n0 + 4 * q)); return k < 512 ? v * g[k] : v; } };
struct SrcPlain4 { const float* w; int ld;
    DEV int drow(int q, int e) const { return 4 * q + e; }
    DEV f32x4 quad(int n0, int q, int k) const { return *(const f32x4*)(w + (size_t)k * ld + n0 + 4 * q); } };
struct SrcW13_4 { const float* w1; const float* w3; const float* g;
    DEV int drow(int q, int e) const { const int l = 8 * (q & 31) + 2 * e + (q >> 5); return (l & ~31) | pg8::inv_perm_lo(l & 31); }
    DEV f32x4 quad(int n0, int q, int k) const { const uintptr_t a = (uintptr_t)w1, b = (uintptr_t)w3; const float* w = (const float*)(a + ((b - a) & (uintptr_t)(0 - (long long)(q >> 5))));
        return *(const f32x4*)(w + (size_t)k * 512 + (n0 >> 1) + 4 * (q & 31)) * g[k]; } };

DEV void phase_prologue(const Params& p, unsigned char* lds) {
    float* tl = (float*)lds;
    const int tid = threadIdx.x, lane = tid & 63, wid = tid >> 6;
    const int vb = vblock(), G = gridDim.x;
    unsigned char* ws = p.ws;
    constexpr int I_WIN = (INP / 256) * (DM / 64);
    constexpr int I_WOUT = 4 * 16;
    constexpr int I_CW1 = 2 * 32;
    constexpr int I_W2 = 32 * 4 * 8;
    constexpr int I_CW2 = 2 * 1 * 4;
    constexpr int I_ALL = I_WIN + I_WOUT + I_CW1 + I_W2 + I_CW2;
    for (int it = vb; it < I_ALL; it += G) {
        int r = it;
        if (r < I_WIN) { SrcWin4 s{p.w_in, p.attn_g}; convert_tile256(tl, s, (bf16_t*)(ws + WS_WINT), DM, (r / 16) * 256, (r % 16) * 64); continue; } r -= I_WIN;
        if (r < I_WOUT) { SrcWout4 s{p.w_out, p.g_nsa}; convert_tile256(tl, s, (bf16_t*)(ws + WS_WOUTT), DM, (r / 16) * 256, (r % 16) * 64); continue; } r -= I_WOUT;
        if (r < I_CW1) { const int z = r / 32, q = r % 32; SrcPlain4 s{z ? p.wv1 : p.wk1, 256};
            convert_tile256(tl, s, (bf16_t*)(ws + WS_CW1T) + (size_t)z * 256 * 2048, 2048, 0, q * 64); continue; } r -= I_CW1;
        if (r < I_W2) { const int e = r / 32, q = r % 32; SrcPlain4 s{p.w2 + (size_t)e * 512 * 1024, 1024};
            convert_tile256(tl, s, (bf16_t*)(ws + WS_W2T) + (size_t)e * 1024 * 512, 512, (q / 8) * 256, (q % 8) * 64); continue; } r -= I_W2;
        { const int z = r / 4, q = r % 4; SrcPlain s{z ? p.wv2 : p.wk2, 64};
            convert_tile(tl, s, (bf16_t*)(ws + WS_CW2T) + (size_t)z * 64 * 256, 256, 0, q * 64); }
    }
    {
        bf16_t* xb = (bf16_t*)(ws + WS_R1); float* rstd1 = (float*)(ws + WS_RSTD1);
        const int gw = vb * 8 + wid, NGW = G * 8;
        for (int m = gw; m < NTOK; m += NGW) {
            const f32x4* xr = (const f32x4*)(p.x + (size_t)m * DM) + lane;
            f32x4 v[4]; float s = 0.f;
#pragma unroll
            for (int j = 0; j < 4; ++j) { v[j] = xr[64 * j]; s += (v[j].x * v[j].x + v[j].y * v[j].y) + (v[j].z * v[j].z + v[j].w * v[j].w); }
            s = wave_sum(s);
            if (lane == 0) rstd1[m] = rsqrtf(s * (1.f / DM) + RMS_EPS);
            u32x2* o = (u32x2*)(xb + (size_t)m * DM) + lane;
#pragma unroll
            for (int j = 0; j < 4; ++j) { u32x2 w; w.x = pk2(v[j].x, v[j].y); w.y = pk2(v[j].z, v[j].w); o[64 * j] = w; }
        }
    }
    {
        const int gt = vb * NT + tid, NG = G * NT;
        float* rowss = (float*)(ws + WS_ROWSS);
        for (int i = gt; i < NTOK; i += NG) rowss[i] = 0.f;
        int* bincnt = (int*)(ws + WS_CTL);
        if (gt < 128) bincnt[gt] = 0;
        if (gt < 32) ((int*)(ws + WS_CTL + 512))[gt] = 0;
        if (gt < 512) { const float l0 = p.lb_logits[gt], l1 = p.lb_logits[512 + gt]; ((float*)(ws + WS_LB))[gt] = 1.f / (1.f + __expf(l1 - l0)); }
        for (int i = gt; i < 48 * 1024; i += NG) { const int c = i >> 10, k = i & 1023;
            const float w = (c < 4 ? p.w_group[k * 4 + c] : (c < 36 ? p.w_expert[k * 32 + (c - 4)] : 0.f)) * p.ffn_g[k];
            const bf16_t hi = f2bf(w); const bf16_t lo = f2bf(w - bf2f(hi));
            ((bf16_t*)(ws + WS_RW))[i] = hi; ((bf16_t*)(ws + WS_RW))[48 * 1024 + i] = lo; }
        if (blockIdx.x == (unsigned)(G - 1)) {
            const int z = tid >> 8, j = tid & 255; const float* pos = z ? p.pos_v : p.pos_k; const float* w = z ? p.wv1 : p.wk1;
            float a = 0.f;
            for (int k = 0; k < 2048; ++k) a += pos[k] * w[(size_t)k * 256 + j];
            ((float*)(ws + WS_CBIAS))[z * 256 + j] = a;
        }
    }
}

constexpr int G_A_BYTES = 128 * 128, G_B_BYTES = 256 * 128, G_STAGE = G_A_BYTES + G_B_BYTES, G_LDS = 2 * G_STAGE;
DEV int swz(int row, int chunk) { return row * 128 + ((chunk ^ ((row >> 1) & 7)) << 4); }
template <class AL, class BL, class EP>
DEV void gemm_tile(unsigned char* lds, const AL& al, const BL& bl, int nk, const EP& ep) {
    const int tid = threadIdx.x, lane = tid & 63, wid = tid >> 6, wr = wid >> 2, wc = wid & 3;
    const int frow = lane & 15, fq = lane >> 4;
    const bf16_t* aptr[2]; int aoff[2], boff[4], brow[4];
#pragma unroll
    for (int i = 0; i < 2; ++i) { const int q = tid + NT * i, row = q >> 3, ch = q & 7; aptr[i] = al.row(row) + ch * 8; aoff[i] = swz(row, ch); }
#pragma unroll
    for (int i = 0; i < 4; ++i) { const int q = tid + NT * i, row = q >> 3, ch = q & 7; brow[i] = row; boff[i] = G_A_BYTES + swz(row, ch) ; }
    const int bch8 = (tid & 7) * 8;
    u32x4 ra[2], rb[4];
#pragma unroll
    for (int i = 0; i < 2; ++i) ra[i] = *(const u32x4*)(aptr[i]);
#pragma unroll
    for (int i = 0; i < 4; ++i) rb[i] = *(const u32x4*)(bl.ptr(brow[i], 0) + bch8);
#pragma unroll
    for (int i = 0; i < 2; ++i) *(u32x4*)(lds + aoff[i]) = ra[i];
#pragma unroll
    for (int i = 0; i < 4; ++i) *(u32x4*)(lds + boff[i]) = rb[i];
    __syncthreads();
    f32x4 acc[4][4];
#pragma unroll
    for (int m = 0; m < 4; ++m)
#pragma unroll
        for (int n = 0; n < 4; ++n) acc[m][n] = (f32x4){0.f, 0.f, 0.f, 0.f};
    const int sx = (frow >> 1) & 7;
    for (int kt = 0; kt < nk; ++kt) {
        const bool more = (kt + 1 < nk);
        if (more) {
#pragma unroll
            for (int i = 0; i < 2; ++i) ra[i] = *(const u32x4*)(aptr[i] + (kt + 1) * 64);
#pragma unroll
            for (int i = 0; i < 4; ++i) rb[i] = *(const u32x4*)(bl.ptr(brow[i], kt + 1) + bch8);
        }
        const unsigned char* base = lds + (kt & 1) * G_STAGE;
#pragma unroll
        for (int ks = 0; ks < 2; ++ks) {
            const int co = ((ks * 4 + fq) ^ sx) << 4;
            bf16x8 af[4], bfr[4];
#pragma unroll
            for (int m = 0; m < 4; ++m) af[m] = *(const bf16x8*)(base + (wr * 64 + m * 16 + frow) * 128 + co);
#pragma unroll
            for (int n = 0; n < 4; ++n) bfr[n] = *(const bf16x8*)(base + G_A_BYTES + (wc * 64 + n * 16 + frow) * 128 + co);
#pragma unroll
            for (int m = 0; m < 4; ++m)
#pragma unroll
                for (int n = 0; n < 4; ++n) acc[m][n] = __builtin_amdgcn_mfma_f32_16x16x32_bf16(bfr[n], af[m], acc[m][n], 0, 0, 0);
        }
        if (more) {
            unsigned char* nb = lds + ((kt + 1) & 1) * G_STAGE;
#pragma unroll
            for (int i = 0; i < 2; ++i) *(u32x4*)(nb + aoff[i]) = ra[i];
#pragma unroll
            for (int i = 0; i < 4; ++i) *(u32x4*)(nb + boff[i]) = rb[i];
        }
        __syncthreads();
    }
    ep(acc, wr, wc, lane);
}

struct ARows { const bf16_t* base; size_t ld; DEV const bf16_t* row(int r) const { return base + (size_t)r * ld; } };
struct BRows { const bf16_t* base; size_t ld; DEV const bf16_t* ptr(int n, int kt) const { return base + (size_t)n * ld + kt * 64; } };

DEV u32x4 pk8(const f32x4 a, const f32x4 b) { u32x4 w; w.x = pk2(a.x, a.y); w.y = pk2(a.z, a.w); w.z = pk2(b.x, b.y); w.w = pk2(b.z, b.w); return w; }
DEV void inproj_row(const Params& p, int seg, int row, f32x4 (&v)[2][2], int fq) {
    unsigned char* ws = p.ws;
    const float rs = ((const float*)(ws + WS_RSTD1))[row];
#pragma unroll
    for (int bj = 0; bj < 2; ++bj) { v[bj][0] = v[bj][0] * rs; v[bj][1] = v[bj][1] * rs; }
    const int b = row >> 12, s = row & 4095;
    const bool is_q = seg < 8, is_ks = (seg == 12 || seg == 13), is_kw = (seg == 16 || seg == 17);
    if (is_q || is_ks || is_kw) {
        const float* gw = is_q ? p.g_q : (is_ks ? p.g_k + 64 : p.g_k + 128);
        bf16_t* dst; int hh, nh;
        if (is_q) { dst = (bf16_t*)(ws + WS_Q); hh = seg; nh = 8; } else if (is_ks) { dst = (bf16_t*)(ws + WS_KS); hh = seg - 12; nh = 2; } else { dst = (bf16_t*)(ws + WS_KW); hh = seg - 16; nh = 2; }
        float ss = 0.f;
#pragma unroll
        for (int bj = 0; bj < 2; ++bj)
#pragma unroll
            for (int n = 0; n < 2; ++n) ss += (v[bj][n].x * v[bj][n].x + v[bj][n].y * v[bj][n].y) + (v[bj][n].z * v[bj][n].z + v[bj][n].w * v[bj][n].w);
        ss += __shfl_xor(ss, 16); ss += __shfl_xor(ss, 32);
        float r = rsqrtf(ss * (1.f / 64.f) + RMS_EPS); if (is_q) r *= QSCALE;
        bf16_t* o = dst + ((size_t)(b * nh + hh) * SEQ + s) * 64 + fq * 8;
#pragma unroll
        for (int bj = 0; bj < 2; ++bj) { const f32x4 g0 = *(const f32x4*)(gw + 32 * bj + 8 * fq), g1 = *(const f32x4*)(gw + 32 * bj + 8 * fq + 4);
            *(u32x4*)(o + 32 * bj) = pk8(v[bj][0] * g0 * r, v[bj][1] * g1 * r); }
        return;
    }
    if (seg >= 8 && seg < 12) {
        bf16_t* o = (bf16_t*)(ws + (seg < 10 ? WS_KC : WS_VC)) + ((size_t)(b * 2 + (seg & 1)) * SEQ + s) * 64 + fq * 8;
#pragma unroll
        for (int bj = 0; bj < 2; ++bj) *(u32x4*)(o + 32 * bj) = pk8(v[bj][0], v[bj][1]);
        return;
    }
    if (seg == 14 || seg == 15 || seg == 18 || seg == 19) {
        bf16_t* o = (bf16_t*)(ws + (seg < 16 ? WS_VST : WS_VWT)) + (size_t)(b * 2 + (seg & 1)) * 64 * SEQ + s;
#pragma unroll
        for (int bj = 0; bj < 2; ++bj)
#pragma unroll
            for (int n = 0; n < 2; ++n) { const int d = 32 * bj + 8 * fq + 4 * n; const f32x4 x = v[bj][n];
                o[(size_t)(d + 0) * SEQ] = f2bf(x.x); o[(size_t)(d + 1) * SEQ] = f2bf(x.y); o[(size_t)(d + 2) * SEQ] = f2bf(x.z); o[(size_t)(d + 3) * SEQ] = f2bf(x.w); }
        return;
    }
    if (seg < 52) {
        const int kind = (seg - 20) >> 3, cb = ((seg - 20) & 7) * 64 + fq * 8;
        if (kind == 1) {
            const float* lb = (const float*)(ws + WS_LB); bf16_t* dst = (bf16_t*)(ws + WS_HLOGF) + (size_t)row * 512 + cb;
#pragma unroll
            for (int bj = 0; bj < 2; ++bj) { f32x4 o[2];
#pragma unroll
                for (int n = 0; n < 2; ++n) { const f32x4 l = *(const f32x4*)(lb + cb + 32 * bj + 4 * n); const f32x4 x = v[bj][n];
                    o[n].x = __logf(l.x + (1.f - l.x) * sigmoidf_(x.x)); o[n].y = __logf(l.y + (1.f - l.y) * sigmoidf_(x.y));
                    o[n].z = __logf(l.z + (1.f - l.z) * sigmoidf_(x.z)); o[n].w = __logf(l.w + (1.f - l.w) * sigmoidf_(x.w)); }
                *(u32x4*)(dst + 32 * bj) = pk8(o[0], o[1]); }
        } else {
            bf16_t* dst = (bf16_t*)(ws + (kind == 0 ? WS_HQ : (kind == 2 ? WS_HV : WS_HG))) + (size_t)row * 512 + cb;
#pragma unroll
            for (int bj = 0; bj < 2; ++bj) { f32x4 x0 = v[bj][0], x1 = v[bj][1];
                if (kind != 2) { x0.x = siluf_(x0.x); x0.y = siluf_(x0.y); x0.z = siluf_(x0.z); x0.w = siluf_(x0.w); x1.x = siluf_(x1.x); x1.y = siluf_(x1.y); x1.z = siluf_(x1.z); x1.w = siluf_(x1.w); }
                *(u32x4*)(dst + 32 * bj) = pk8(x0, x1); }
        }
        return;
    }
    {
        float* dst = (float*)(ws + WS_GATES) + (size_t)row * 24;
        if (fq < 3) {
#pragma unroll
            for (int n = 0; n < 2; ++n) { const f32x4 x = v[0][n]; f32x4 o; o.x = sigmoidf_(x.x); o.y = sigmoidf_(x.y); o.z = sigmoidf_(x.z); o.w = sigmoidf_(x.w); *(f32x4*)(dst + 8 * fq + 4 * n) = o; } }
    }
}
struct EpiInproj8 { const Params& p; static constexpr bool MIDSCALE = false; DEV float rowscale(int) const { return 1.f; } DEV int midk() const { return -1; }
    DEV void operator()(const f32x4 (&acc)[2][2][4][2], const pg8::Unit& u, int wr, int wc, int fr, int fq) const {
        const int seg = u.pn * 4 + wc;
        if (seg > 52) return;
#pragma unroll
        for (int ai = 0; ai < 2; ++ai)
#pragma unroll
            for (int m = 0; m < 4; ++m) { f32x4 v[2][2] = {{acc[ai][0][m][0], acc[ai][0][m][1]}, {acc[ai][1][m][0], acc[ai][1][m][1]}};
                inproj_row(p, seg, u.pm * 256 + ai * 128 + wr * 64 + m * 16 + fr, v, fq); }
    } };
DEV void phase_inproj(const Params& p, unsigned char* lds) {
    pg8::Gemm g{(const bf16_t*)(p.ws + WS_R1), (const bf16_t*)(p.ws + WS_WINT), NTOK, INP, DM};
    pg8::StaticOrder S; S.init(NTOK, INP, (int)gridDim.x, (int)blockIdx.x);
    EpiInproj8 E{p};
    pg8::gemm_phase(( PG8_LAS unsigned char*)lds, g, S, E);
}

struct ACmp { const bf16_t* src; int bg, c0;
    DEV const bf16_t* row(int r) const { int c = c0 + r; if (c > NC - 1) c = NC - 1; return src + ((size_t)bg * SEQ + 16 * c) * 64; } };
struct EpiCmpA { const Params& p; int z, rbase;
    DEV void operator()(f32x4 (&acc)[4][4], int wr, int wc, int lane) const {
        const int frow = lane & 15, fq = lane >> 4;
        const float* cb = (const float*)(p.ws + WS_CBIAS) + z * 256; bf16_t* hid = (bf16_t*)(p.ws + WS_HID) + (size_t)z * 4096 * 256;
#pragma unroll
        for (int m = 0; m < 4; ++m) { const int rr = rbase + wr * 64 + m * 16 + frow;
#pragma unroll
            for (int n = 0; n < 4; ++n) { const int c = wc * 64 + n * 16 + fq * 4; const f32x4 b = *(const f32x4*)(cb + c); f32x4 v = acc[m][n] + b;
                u32x2 w; w.x = pk2(siluf_(v.x), siluf_(v.y)); w.y = pk2(siluf_(v.z), siluf_(v.w)); *(u32x2*)(hid + (size_t)rr * 256 + c) = w; } }
    } };
DEV void phase_cmp_a(const Params& p, unsigned char* lds) {
    const int vb = vblock(), G = gridDim.x;
    for (int u = vb; u < 64; u += G) {
        const int z = u >> 5, rbase = (u & 31) * 128;
        ACmp al{(const bf16_t*)(p.ws + (z ? WS_VC : WS_KC)), (u & 31) >> 1, (u & 1) * 128};
        BRows bl{(const bf16_t*)(p.ws + WS_CW1T) + (size_t)z * 256 * 2048, 2048};
        EpiCmpA ep{p, z, rbase};
        gemm_tile(lds, al, bl, 2048 / 64, ep);
    }
}
struct BClamp64 { const bf16_t* base; size_t ld; DEV const bf16_t* ptr(int n, int kt) const { return base + (size_t)(n & 63) * ld + kt * 64; } };
struct EpiCmpB { const Params& p; int z, rbase;
    DEV void operator()(f32x4 (&acc)[4][4], int wr, int wc, int lane) const {
        if (wc != 0) return;
        const int frow = lane & 15, fq = lane >> 4;
        bf16_t* dst = (bf16_t*)(p.ws + (z ? WS_VCMP : WS_KCMP));
#pragma unroll
        for (int m = 0; m < 4; ++m) { const int rr = rbase + wr * 64 + m * 16 + frow;
            float r = 1.f;
            if (z == 0) { float ss = 0.f;
#pragma unroll
                for (int n = 0; n < 4; ++n) { const f32x4 v = acc[m][n]; ss += (v.x * v.x + v.y * v.y) + (v.z * v.z + v.w * v.w); }
                ss += __shfl_xor(ss, 16); ss += __shfl_xor(ss, 32); r = rsqrtf(ss * (1.f / 64.f) + RMS_EPS); }
            const int bg = rr >> 8, c = rr & 255;
            if (c < NC) {
#pragma unroll
                for (int n = 0; n < 4; ++n) { const int d = n * 16 + fq * 4; f32x4 v = acc[m][n] * r;
                    if (z == 0) { const f32x4 g = *(const f32x4*)(p.g_k + d); v = v * g;
                        u32x2 w; w.x = pk2(v.x, v.y); w.y = pk2(v.z, v.w); *(u32x2*)(dst + ((size_t)bg * 256 + c) * 64 + d) = w; }
                    else { bf16_t* o = dst + ((size_t)bg * 64 + d) * 256 + c; o[0] = f2bf(v.x); o[256] = f2bf(v.y); o[512] = f2bf(v.z); o[768] = f2bf(v.w); } } }
        }
    } };
DEV void phase_cmp_b(const Params& p, unsigned char* lds) {
    const int vb = vblock(), G = gridDim.x;
    for (int u = vb; u < 64; u += G) {
        const int z = u >> 5, rbase = (u & 31) * 128;
        ARows al{(const bf16_t*)(p.ws + WS_HID) + ((size_t)z * 4096 + rbase) * 256, 256};
        BClamp64 bl{(const bf16_t*)(p.ws + WS_CW2T) + (size_t)z * 64 * 256, 256};
        EpiCmpB ep{p, z, rbase};
        gemm_tile(lds, al, bl, 256 / 64, ep);
    }
}

constexpr int CM_K = 0, CM_V = 32768, CM_VSTR = 520, CM_IMP = CM_V + 64 * CM_VSTR, CM_LDS = CM_IMP + 4 * 16384 + 1024;
DEV void cm_scores(const unsigned char* kbase, int kt, const bf16x8 (&qf)[4], int r31, int hh, f32x16 (&sacc)[2]) {
#pragma unroll
    for (int kt2 = 0; kt2 < 2; ++kt2) {
#pragma unroll
        for (int i = 0; i < 16; ++i) sacc[kt2][i] = 0.f;
        const int row = 64 * kt + 32 * kt2 + r31; const int sx = (row >> 1) & 7;
#pragma unroll
        for (int s = 0; s < 4; ++s) { const bf16x8 kf = *(const bf16x8*)(kbase + row * 128 + (((2 * s + hh) ^ sx) << 4));
            sacc[kt2] = __builtin_amdgcn_mfma_f32_32x32x16_bf16(kf, qf[s], sacc[kt2], 0, 0, 0); }
    }
}
DEV void phase_cmp_attn(const Params& p, unsigned char* lds) {
    const int tid = threadIdx.x, lane = tid & 63, wid = tid >> 6;
    const int vb = vblock(), G = gridDim.x;
    unsigned char* ws = p.ws;
    const int r31 = lane & 31, hh = lane >> 5;
    float* impl = (float*)(lds + CM_IMP);
    for (int it = vb; it < 1024; it += G) {
        int ci, bg;
        if (G == 256) { const int x = vb >> 5, jb = vb & 31, rnd = it / G, i = rnd * 32 + ((rnd & 1) ? 31 - jb : jb); ci = 63 - (i >> 1); bg = 2 * x + (i & 1); }
        else { ci = 63 - (it >> 4); bg = it & 15; }
        const int b = bg >> 1, g = bg & 1;
        const int nvis = min(NC, 4 * ci + 3), ntile = (nvis + 63) >> 6;
        const int head = g * 4 + (wid >> 1);
        const int tokl = (wid & 1) * 32 + r31, t = ci * 64 + tokl;
        const size_t tok = (size_t)b * SEQ + t;
        const int nv = t >= 31 ? min(NC, (t - 31) / 16 + 1) : 0;
        __syncthreads();
        {
            const bf16_t* kc = (const bf16_t*)(ws + WS_KCMP) + (size_t)bg * 256 * 64; const bf16_t* vt = (const bf16_t*)(ws + WS_VCMP) + (size_t)bg * 64 * 256;
            const int cpr = ntile * 8;
            u32x4 rk[4], rv[4];
#pragma unroll
            for (int i = 0; i < 4; ++i) if (i < ntile) { const int idx = tid + NT * i; rk[i] = *(const u32x4*)(kc + (idx >> 3) * 64 + (idx & 7) * 8); const int d = idx / cpr, ck = idx % cpr; rv[i] = *(const u32x4*)(vt + d * 256 + ck * 8); }
#pragma unroll
            for (int i = 0; i < 4; ++i) if (i < ntile) { const int idx = tid + NT * i; *(u32x4*)(lds + CM_K + swz(idx >> 3, idx & 7)) = rk[i];
                const int d = idx / cpr, ck = idx % cpr; u32x2 a, c2; a.x = rv[i].x; a.y = rv[i].y; c2.x = rv[i].z; c2.y = rv[i].w; unsigned char* o = lds + CM_V + d * CM_VSTR + ck * 16; *(u32x2*)o = a; *(u32x2*)(o + 8) = c2; }
        }
        bf16x8 qf[4];
        { const bf16_t* qp = (const bf16_t*)(ws + WS_Q) + ((size_t)(b * 8 + head) * SEQ + t) * 64 + 8 * hh;
#pragma unroll
            for (int s = 0; s < 4; ++s) qf[s] = *(const bf16x8*)(qp + 16 * s); }
        __syncthreads();
        float l_run = 0.f;
        f32x16 ot[2];
#pragma unroll
        for (int dt = 0; dt < 2; ++dt)
#pragma unroll
            for (int i = 0; i < 16; ++i) ot[dt][i] = 0.f;
        float carry = 0.f;
#pragma unroll
        for (int kt = 0; kt < 4; ++kt) if (kt < ntile) {
            f32x16 sacc[2];
            cm_scores(lds + CM_K, kt, qf, r31, hh, sacc);
#pragma unroll
            for (int kt2 = 0; kt2 < 2; ++kt2)
#pragma unroll
                for (int i = 0; i < 16; ++i) { const int c = 64 * kt + 32 * kt2 + (i & 3) + 8 * (i >> 2) + 4 * hh; const float e_ = (c < nv) ? __builtin_amdgcn_exp2f(sacc[kt2][i]) : 0.f; sacc[kt2][i] = e_; l_run += e_; }
            {
                float own[8], xs[8];
#pragma unroll
                for (int kt2 = 0; kt2 < 2; ++kt2)
#pragma unroll
                    for (int g4 = 0; g4 < 4; ++g4) { const float e3 = 0.5f * sacc[kt2][4 * g4 + 3];
                        own[4 * kt2 + g4] = (sacc[kt2][4 * g4] + sacc[kt2][4 * g4 + 1]) + (sacc[kt2][4 * g4 + 2] + e3); xs[4 * kt2 + g4] = __shfl_xor(e3, 32); }
                float* io = impl + (wid >> 1) * 4096 + tokl * 64 + 16 * kt + hh;
#pragma unroll
                for (int gi = 0; gi < 8; ++gi) io[2 * gi] = own[gi] + (hh ? xs[gi] : (gi > 0 ? xs[gi > 0 ? gi - 1 : 0] : carry));
                carry = xs[7];
            }
#pragma unroll
            for (int kt2 = 0; kt2 < 2; ++kt2)
#pragma unroll
                for (int s2 = 0; s2 < 2; ++s2) {
                    bf16x8 pf; { u32x4 w; w.x = pk2(sacc[kt2][8 * s2 + 0], sacc[kt2][8 * s2 + 1]); w.y = pk2(sacc[kt2][8 * s2 + 2], sacc[kt2][8 * s2 + 3]);
                        w.z = pk2(sacc[kt2][8 * s2 + 4], sacc[kt2][8 * s2 + 5]); w.w = pk2(sacc[kt2][8 * s2 + 6], sacc[kt2][8 * s2 + 7]); pf = __builtin_bit_cast(bf16x8, w); }
#pragma unroll
                    for (int dt = 0; dt < 2; ++dt) {
                        const unsigned char* va = lds + CM_V + (32 * dt + r31) * CM_VSTR + (64 * kt + 32 * kt2 + 16 * s2 + 4 * hh) * 2;
                        const u32x2 lo = *(const u32x2*)(va), hi = *(const u32x2*)(va + 16);
                        u32x4 w; w.x = lo.x; w.y = lo.y; w.z = hi.x; w.w = hi.y;
                        ot[dt] = __builtin_amdgcn_mfma_f32_32x32x16_bf16(__builtin_bit_cast(bf16x8, w), pf, ot[dt], 0, 0, 0);
                    }
                }
        }
        float invL; { const float L = l_run + __shfl_xor(l_run, 32); invL = L > 0.f ? 1.f / L : 0.f; }
        if (hh == 0) impl[16384 + (wid >> 1) * 64 + tokl] = invL;
        {
            const float sc = ((const float*)(ws + WS_GATES))[tok * 24 + head * 3 + 0] * invL;
            bf16_t* ocp = (bf16_t*)(ws + WS_OC) + tok * 512 + head * 64;
#pragma unroll
            for (int dt = 0; dt < 2; ++dt)
#pragma unroll
                for (int g4 = 0; g4 < 4; ++g4) { const int d0 = 32 * dt + 8 * g4 + 4 * hh;
                    u32x2 w; w.x = pk2(ot[dt][4 * g4 + 0] * sc, ot[dt][4 * g4 + 1] * sc); w.y = pk2(ot[dt][4 * g4 + 2] * sc, ot[dt][4 * g4 + 3] * sc); *(u32x2*)(ocp + d0) = w; }
        }
        __syncthreads();
        for (int tt = 0; tt < 8; ++tt) {
            const int tl = wid * 8 + tt, cur = ci;
            unsigned long long mask;
            if (cur < 16) mask = (2ull << cur) - 1ull;
            else {
                const bool valid = lane <= cur;
                const float imp = (impl[tl * 64 + lane] * impl[16384 + tl] + impl[4096 + tl * 64 + lane] * impl[16384 + 64 + tl]) + (impl[8192 + tl * 64 + lane] * impl[16384 + 128 + tl] + impl[12288 + tl * 64 + lane] * impl[16384 + 192 + tl]);
                const unsigned key = (lane == 0 || lane == cur) ? 0x7F800000u : __float_as_uint(imp);
                unsigned T = 0u;
                for (int bit = 30; bit >= 0; --bit) { const unsigned cand = T | (1u << bit); if (__popcll(__ballot(valid && key >= cand)) >= 16) T = cand; }
                const unsigned long long gt = __ballot(valid && key > T), eq = __ballot(valid && key == T);
                const int need = 16 - __popcll(gt);
                const int below = __popcll(eq & ((1ull << lane) - 1ull));
                mask = gt | __ballot(valid && key == T && below < need);
            }
            if (lane == 0) ((unsigned long long*)(ws + WS_SELM))[(size_t)bg * SEQ + ci * 64 + tl] = mask;
        }
    }
}

constexpr int FA_KB = 64 * 128, FA_VB = 64 * 136, FA_STAGE = FA_KB + FA_VB, FA_LDS = 2 * FA_STAGE + 1024;
template <bool SEL>
DEV void fa_branch(unsigned char* lds, const bf16_t* Kb, const bf16_t* VTb, int ci, int bg, const bf16x8 (&qf)[4], int t, unsigned long long mymask, unsigned long long need,
                   f32x16 (&ot)[2], float& m_run, float& l_run) {
    const int tid = threadIdx.x, lane = tid & 63;
    const int r31 = lane & 31, hh = lane >> 5;
    const int lrow = tid >> 3, lch = tid & 7;
    const bf16_t* kg = Kb + ((size_t)bg * SEQ + lrow) * 64 + lch * 8;
    const bf16_t* vg = VTb + ((size_t)bg * 64 + lrow) * SEQ + lch * 8;
    const int koff = lrow * 128 + ((lch ^ ((lrow >> 1) & 7)) << 4), voff = FA_KB + lrow * 136 + lch * 16;
    int jlo, jhi; unsigned long long todo;
    if (SEL) { todo = need; jlo = 0; jhi = ci; } else { jlo = ci >= 8 ? ci - 8 : 0; jhi = ci; todo = 0; }
    int j = jlo;
    if (SEL) { if (todo == 0) return; j = __builtin_ctzll(todo); todo &= todo - 1; }
    u32x4 rk = *(const u32x4*)(kg + (size_t)j * 64 * 64), rv = *(const u32x4*)(vg + (size_t)j * 64);
    __syncthreads();
    *(u32x4*)(lds + koff) = rk; { u32x2 a, b2; a.x = rv.x; a.y = rv.y; b2.x = rv.z; b2.y = rv.w; *(u32x2*)(lds + voff) = a; *(u32x2*)(lds + voff + 8) = b2; }
    __syncthreads();
    int st = 0; bool seen = false;
    for (;;) {
        int jn; bool more;
        if (SEL) { more = (todo != 0); jn = more ? __builtin_ctzll(todo) : 0; todo &= todo - 1; } else { jn = j + 1; more = (jn <= jhi); }
        if (more) { rk = *(const u32x4*)(kg + (size_t)jn * 64 * 64); rv = *(const u32x4*)(vg + (size_t)jn * 64); }
        const unsigned char* base = lds + st * FA_STAGE;
        const bool bit = SEL ? ((mymask >> j) & 1ull) != 0 : true;
        const float cinit = (SEL && !bit) ? -__builtin_inff() : -m_run;
        f32x16 sacc[2];
#pragma unroll
        for (int kt2 = 0; kt2 < 2; ++kt2) {
#pragma unroll
            for (int i = 0; i < 16; ++i) sacc[kt2][i] = cinit;
            const int row = 32 * kt2 + r31; const int sx = (row >> 1) & 7;
#pragma unroll
            for (int s = 0; s < 4; ++s) { const bf16x8 kf = *(const bf16x8*)(base + row * 128 + (((2 * s + hh) ^ sx) << 4));
                sacc[kt2] = __builtin_amdgcn_mfma_f32_32x32x16_bf16(kf, qf[s], sacc[kt2], 0, 0, 0); }
        }
        const bool boundary = SEL ? (j == ci) : (j == ci || j + 8 <= ci);
        float mx = -__builtin_inff();
        if (boundary) {
#pragma unroll
            for (int kt2 = 0; kt2 < 2; ++kt2)
#pragma unroll
                for (int i = 0; i < 16; ++i) { const int key = 64 * j + 32 * kt2 + (i & 3) + 8 * (i >> 2) + 4 * hh;
                    const bool ok = SEL ? (key <= t) : (key <= t && t - key < 512);
                    const float v = ok ? sacc[kt2][i] : -__builtin_inff(); sacc[kt2][i] = v; mx = fmaxf(mx, v); }
        } else {
#pragma unroll
            for (int kt2 = 0; kt2 < 2; ++kt2)
#pragma unroll
                for (int i = 0; i < 16; ++i) mx = fmaxf(mx, sacc[kt2][i]);
        }
        mx = fmaxf(mx, __shfl_xor(mx, 32));
        const bool live = mx > -__builtin_inff();
        const bool need = (mx > 8.f) || (!seen && live && mx < -8.f);
        if (__any(need)) {
            const float d = need ? mx : 0.f;
            const float alpha = d > 0.f ? __builtin_amdgcn_exp2f(-d) : 1.f;
            m_run += d; l_run *= alpha;
#pragma unroll
            for (int dt = 0; dt < 2; ++dt)
#pragma unroll
                for (int i = 0; i < 16; ++i) ot[dt][i] *= alpha;
#pragma unroll
            for (int kt2 = 0; kt2 < 2; ++kt2)
#pragma unroll
                for (int i = 0; i < 16; ++i) sacc[kt2][i] -= d;
        }
        seen = seen || live;
        float rs = 0.f;
#pragma unroll
        for (int kt2 = 0; kt2 < 2; ++kt2)
#pragma unroll
            for (int i = 0; i < 16; ++i) { const float e = __builtin_amdgcn_exp2f(sacc[kt2][i]); sacc[kt2][i] = e; rs += e; }
        l_run += rs;
#pragma unroll
        for (int kt2 = 0; kt2 < 2; ++kt2)
#pragma unroll
            for (int s2 = 0; s2 < 2; ++s2) {
                bf16x8 pf; { u32x4 w; w.x = pk2(sacc[kt2][8 * s2 + 0], sacc[kt2][8 * s2 + 1]); w.y = pk2(sacc[kt2][8 * s2 + 2], sacc[kt2][8 * s2 + 3]);
                    w.z = pk2(sacc[kt2][8 * s2 + 4], sacc[kt2][8 * s2 + 5]); w.w = pk2(sacc[kt2][8 * s2 + 6], sacc[kt2][8 * s2 + 7]); pf = __builtin_bit_cast(bf16x8, w); }
#pragma unroll
                for (int dt = 0; dt < 2; ++dt) {
                    const unsigned char* va = base + FA_KB + (32 * dt + r31) * 136 + (32 * kt2 + 16 * s2 + 4 * hh) * 2;
                    const u32x2 lo = *(const u32x2*)(va), hi = *(const u32x2*)(va + 16);
                    u32x4 w; w.x = lo.x; w.y = lo.y; w.z = hi.x; w.w = hi.y;
                    ot[dt] = __builtin_amdgcn_mfma_f32_32x32x16_bf16(__builtin_bit_cast(bf16x8, w), pf, ot[dt], 0, 0, 0);
                }
            }
        if (!more) break;
        { unsigned char* nb = lds + (st ^ 1) * FA_STAGE; *(u32x4*)(nb + koff) = rk; u32x2 a, b2; a.x = rv.x; a.y = rv.y; b2.x = rv.z; b2.y = rv.w; *(u32x2*)(nb + voff) = a; *(u32x2*)(nb + voff + 8) = b2; }
        __syncthreads();
        st ^= 1; j = jn;
    }
}
DEV void phase_flash(const Params& p, unsigned char* lds) {
    const int tid = threadIdx.x, lane = tid & 63, wid = tid >> 6;
    const int vb = vblock(), G = gridDim.x;
    unsigned char* ws = p.ws;
    const int r31 = lane & 31, hh = lane >> 5;
    unsigned long long* red = (unsigned long long*)(lds + 2 * FA_STAGE);
    for (int it = vb; it < 1024; it += G) {
        int ci, bg;
        if (G == 256) { const int x = vb >> 5, jb = vb & 31, rnd = it / G, i = rnd * 32 + ((rnd & 1) ? 31 - jb : jb); ci = 63 - (i >> 1); bg = 2 * x + (i & 1); }
        else { ci = 63 - (it >> 4); bg = it & 15; }
        const int b = bg >> 1, g = bg & 1;
        const int head = g * 4 + (wid >> 1);
        const int t = ci * 64 + (wid & 1) * 32 + r31;
        const size_t tok = (size_t)b * SEQ + t;
        bf16x8 qf[4];
        { const bf16_t* qp = (const bf16_t*)(ws + WS_Q) + ((size_t)(b * 8 + head) * SEQ + t) * 64 + 8 * hh;
#pragma unroll
            for (int s = 0; s < 4; ++s) qf[s] = *(const bf16x8*)(qp + 16 * s); }
        const unsigned long long mymask = ((const unsigned long long*)(ws + WS_SELM))[(size_t)bg * SEQ + t];
        unsigned long long orm = mymask;
#pragma unroll
        for (int o = 1; o < 32; o <<= 1) { const unsigned lo = __shfl_xor((unsigned)orm, o), hi = __shfl_xor((unsigned)(orm >> 32), o); orm |= ((unsigned long long)hi << 32) | lo; }
        __syncthreads();
        if (wid < 2 && lane == 0) red[wid] = orm;
        __syncthreads();
        const unsigned long long need = red[0] | red[1];
        f32x16 oc[2];
        {
            f32x16 ot[2]; float m_run = 0.f, l_run = 0.f;
#pragma unroll
            for (int dt = 0; dt < 2; ++dt)
#pragma unroll
                for (int i = 0; i < 16; ++i) ot[dt][i] = 0.f;
            fa_branch<true>(lds, (const bf16_t*)(ws + WS_KS), (const bf16_t*)(ws + WS_VST), ci, bg, qf, t, mymask, need, ot, m_run, l_run);
            const float lt = l_run + __shfl_xor(l_run, 32);
            const float sc = ((const float*)(ws + WS_GATES))[tok * 24 + head * 3 + 1] / lt;
#pragma unroll
            for (int dt = 0; dt < 2; ++dt)
#pragma unroll
                for (int i = 0; i < 16; ++i) oc[dt][i] = ot[dt][i] * sc;
        }
        {
            f32x16 ot[2]; float m_run = 0.f, l_run = 0.f;
#pragma unroll
            for (int dt = 0; dt < 2; ++dt)
#pragma unroll
                for (int i = 0; i < 16; ++i) ot[dt][i] = 0.f;
            fa_branch<false>(lds, (const bf16_t*)(ws + WS_KW), (const bf16_t*)(ws + WS_VWT), ci, bg, qf, t, 0ull, 0ull, ot, m_run, l_run);
            const float lt = l_run + __shfl_xor(l_run, 32);
            const float sc = ((const float*)(ws + WS_GATES))[tok * 24 + head * 3 + 2] / lt;
#pragma unroll
            for (int dt = 0; dt < 2; ++dt)
#pragma unroll
                for (int i = 0; i < 16; ++i) oc[dt][i] += ot[dt][i] * sc;
        }
        {
            const bf16_t* ocp = (const bf16_t*)(ws + WS_OC) + tok * 512 + head * 64;
            bf16_t* mix = (bf16_t*)(ws + WS_R1) + tok * 1024 + head * 64;
            float ss = 0.f;
#pragma unroll
            for (int dt = 0; dt < 2; ++dt)
#pragma unroll
                for (int g4 = 0; g4 < 4; ++g4) { const int d0 = 32 * dt + 8 * g4 + 4 * hh; const u32x2 c = *(const u32x2*)(ocp + d0);
                    const float v0 = oc[dt][4 * g4 + 0] + bflo(c.x), v1 = oc[dt][4 * g4 + 1] + bfhi(c.x), v2 = oc[dt][4 * g4 + 2] + bflo(c.y), v3 = oc[dt][4 * g4 + 3] + bfhi(c.y);
                    ss += (v0 * v0 + v1 * v1) + (v2 * v2 + v3 * v3);
                    u32x2 w; w.x = pk2(v0, v1); w.y = pk2(v2, v3); *(u32x2*)(mix + d0) = w; }
            ss += __shfl_xor(ss, 32);
            if (hh == 0) atomicAdd((float*)(ws + WS_ROWSS) + tok, ss);
        }
    }
}

DEV int swz256(int row, int chunk) { return row * 256 + ((chunk ^ (row & 15)) << 4); }
DEV void hgrn_cumsum(const Params& p, int bh, int c, float* segs, f32x2 (&lf)[8], f32x2 (&a)[8], f32x2& r, f32x2& alast) {
    const int tid = threadIdx.x, k2 = tid & 63, tq = tid >> 6;
    const int b = bh >> 2, h = bh & 3;
    const bf16_t* HL = (const bf16_t*)(p.ws + WS_HLOGF) + ((size_t)b * SEQ + c * 64 + tq * 8) * 512 + h * 128 + 2 * k2;
#pragma unroll
    for (int i = 0; i < 8; ++i) { const unsigned w = *(const unsigned*)(HL + (size_t)i * 512); lf[i] = (f32x2){bflo(w), bfhi(w)}; }
    f32x2 run = (f32x2){0.f, 0.f};
#pragma unroll
    for (int i = 0; i < 8; ++i) { run = run + lf[i]; a[i] = run; }
    *(f32x2*)(segs + tq * 128 + 2 * k2) = run;
    __syncthreads();
    f32x2 off = (f32x2){0.f, 0.f}, tot = off, rr = off;
#pragma unroll
    for (int q = 0; q < 8; ++q) { const f32x2 s = *(const f32x2*)(segs + q * 128 + 2 * k2); if (q < tq) off = off + s; if (q < 4) rr = rr + s; tot = tot + s; }
#pragma unroll
    for (int i = 0; i < 8; ++i) a[i] = a[i] + off;
    r = rr; alast = tot;
}
DEV void hgrn_stage_vt(const Params& p, int bh, int c, unsigned char* vt) {
    const int tid = threadIdx.x, k2 = tid & 63, tq = tid >> 6;
    const int b = bh >> 2, h = bh & 3;
    const bf16_t* HV = (const bf16_t*)(p.ws + WS_HV) + ((size_t)b * SEQ + c * 64 + tq * 8) * 512 + h * 128 + 2 * k2;
    unsigned vv[8];
#pragma unroll
    for (int i = 0; i < 8; ++i) vv[i] = *(const unsigned*)(HV + (size_t)i * 512);
    u32x4 lo, hi;
    lo.x = (vv[0] & 0xffffu) | (vv[1] << 16); lo.y = (vv[2] & 0xffffu) | (vv[3] << 16); lo.z = (vv[4] & 0xffffu) | (vv[5] << 16); lo.w = (vv[6] & 0xffffu) | (vv[7] << 16);
    hi.x = (vv[0] >> 16) | (vv[1] & 0xffff0000u); hi.y = (vv[2] >> 16) | (vv[3] & 0xffff0000u); hi.z = (vv[4] >> 16) | (vv[5] & 0xffff0000u); hi.w = (vv[6] >> 16) | (vv[7] & 0xffff0000u);
    *(u32x4*)(vt + swz(2 * k2, tq)) = lo; *(u32x4*)(vt + swz(2 * k2 + 1, tq)) = hi;
}
constexpr int H1_KT = 0, H1_VT = 16384, H1_SEG = 32768, H1_EK = H1_SEG + 4096;
DEV void phase_hgrn_a1(const Params& p, unsigned char* lds, int vb0, int nb) {
    const int tid = threadIdx.x, lane = tid & 63, wid = tid >> 6, k2 = tid & 63, tq = tid >> 6;
    const int vb = vblock(), G = gridDim.x;
    const int frow = lane & 15, fq = lane >> 4, wr = wid >> 1, wc = wid & 1;
    float* segs = (float*)(lds + H1_SEG); float* ek = (float*)(lds + H1_EK);
    bf16_t* ubuf = (bf16_t*)(p.ws + WS_UBUF); float* dbuf = (float*)(p.ws + WS_DBUF);
    if (vb < vb0) return;
    for (int item = vb - vb0; item < 2048; item += nb) {
        const int bh = item >> 6, c = item & 63;
        __syncthreads();
        f32x2 lf[8], a[8], r, al;
        hgrn_cumsum(p, bh, c, segs, lf, a, r, al);
        {
            float kx[8], ky[8];
#pragma unroll
            for (int i = 0; i < 8; ++i) { kx[i] = (1.f - __expf(lf[i].x)) * __expf(fminf(r.x - a[i].x, 80.f)); ky[i] = (1.f - __expf(lf[i].y)) * __expf(fminf(r.y - a[i].y, 80.f)); }
            u32x4 w0, w1;
            w0.x = pk2(kx[0], kx[1]); w0.y = pk2(kx[2], kx[3]); w0.z = pk2(kx[4], kx[5]); w0.w = pk2(kx[6], kx[7]);
            w1.x = pk2(ky[0], ky[1]); w1.y = pk2(ky[2], ky[3]); w1.z = pk2(ky[4], ky[5]); w1.w = pk2(ky[6], ky[7]);
            *(u32x4*)(lds + H1_KT + swz(2 * k2, tq)) = w0; *(u32x4*)(lds + H1_KT + swz(2 * k2 + 1, tq)) = w1;
        }
        hgrn_stage_vt(p, bh, c, lds + H1_VT);
        if (tq == 7) { ek[2 * k2] = __expf(al.x - r.x); ek[2 * k2 + 1] = __expf(al.y - r.y); f32x2 d; d.x = __expf(al.x); d.y = __expf(al.y); *(f32x2*)(dbuf + (size_t)item * 128 + 2 * k2) = d; }
        __syncthreads();
        f32x4 acc[2][4];
#pragma unroll
        for (int m = 0; m < 2; ++m)
#pragma unroll
            for (int n = 0; n < 4; ++n) acc[m][n] = (f32x4){0.f, 0.f, 0.f, 0.f};
        const int sx = (frow >> 1) & 7;
#pragma unroll
        for (int ks = 0; ks < 2; ++ks) {
            const int co = ((ks * 4 + fq) ^ sx) << 4;
            bf16x8 af[2], bfr[4];
#pragma unroll
            for (int m = 0; m < 2; ++m) af[m] = *(const bf16x8*)(lds + H1_VT + (32 * wr + 16 * m + frow) * 128 + co);
#pragma unroll
            for (int n = 0; n < 4; ++n) bfr[n] = *(const bf16x8*)(lds + H1_KT + (64 * wc + 16 * n + frow) * 128 + co);
#pragma unroll
            for (int m = 0; m < 2; ++m)
#pragma unroll
                for (int n = 0; n < 4; ++n) acc[m][n] = __builtin_amdgcn_mfma_f32_16x16x32_bf16(bfr[n], af[m], acc[m][n], 0, 0, 0);
        }
#pragma unroll
        for (int m = 0; m < 2; ++m) { const int v = 32 * wr + 16 * m + frow;
#pragma unroll
            for (int n = 0; n < 4; ++n) { const int k0 = 64 * wc + 16 * n + 4 * fq; const f32x4 e = *(const f32x4*)(ek + k0); const f32x4 o = acc[m][n] * e;
                u32x2 w; w.x = pk2(o.x, o.y); w.y = pk2(o.z, o.w); *(u32x2*)(ubuf + ((size_t)item * 128 + v) * 128 + k0) = w; } }
    }
}
DEV void phase_hgrn_a2(const Params& p, unsigned char* lds) {
    const int G = gridDim.x;
    bf16_t* ubuf = (bf16_t*)(p.ws + WS_UBUF); const float* dbuf = (const float*)(p.ws + WS_DBUF);
    for (int gid = blockIdx.x * NT + threadIdx.x; gid < 131072; gid += G * NT) {
        const int bh = gid >> 12, v = (gid >> 5) & 127, k4 = gid & 31;
        bf16_t* u = ubuf + ((size_t)bh * 64 * 128 + v) * 128 + 4 * k4;
        const float* d = dbuf + (size_t)bh * 64 * 128 + 4 * k4;
        f32x4 S = (f32x4){0.f, 0.f, 0.f, 0.f};
        for (int c0 = 0; c0 < 64; c0 += 8) {
            u32x2 uu[8]; f32x4 dd[8];
#pragma unroll
            for (int j = 0; j < 8; ++j) { uu[j] = *(const u32x2*)(u + (size_t)(c0 + j) * 16384); dd[j] = *(const f32x4*)(d + (size_t)(c0 + j) * 128); }
#pragma unroll
            for (int j = 0; j < 8; ++j) { u32x2 w; w.x = pk2(S.x, S.y); w.y = pk2(S.z, S.w); *(u32x2*)(u + (size_t)(c0 + j) * 16384) = w;
                S.x = dd[j].x * S.x + bflo(uu[j].x); S.y = dd[j].y * S.y + bfhi(uu[j].x); S.z = dd[j].z * S.z + bflo(uu[j].y); S.w = dd[j].w * S.w + bfhi(uu[j].y); }
        }
    }
}
constexpr int H3_QH = 0, H3_QA = 16384, H3_KH = 32768, H3_VT = 49152, H3_PP = 65536, H3_ST = 73728, H3_SEG = 106496, H3_RED = 110592;
DEV void phase_hgrn_a3(const Params& p, unsigned char* lds) {
    const int tid = threadIdx.x, lane = tid & 63, wid = tid >> 6, k2 = tid & 63, tq = tid >> 6;
    const int vb = vblock(), G = gridDim.x;
    const int frow = lane & 15, fq = lane >> 4;
    float* segs = (float*)(lds + H3_SEG); float* red = (float*)(lds + H3_RED);
    const bf16_t* ubuf = (const bf16_t*)(p.ws + WS_UBUF);
    for (int item = vb; item < 2048; item += G) {
        const int bh = item >> 6, c = item & 63, b = bh >> 2, h = bh & 3;
        __syncthreads();
        f32x2 lf[8], a[8], r, al;
        hgrn_cumsum(p, bh, c, segs, lf, a, r, al);
        {
            const bf16_t* HQ = (const bf16_t*)(p.ws + WS_HQ) + ((size_t)b * SEQ + c * 64 + tq * 8) * 512 + h * 128 + 2 * k2;
            unsigned qq[8];
#pragma unroll
            for (int i = 0; i < 8; ++i) qq[i] = *(const unsigned*)(HQ + (size_t)i * 512);
#pragma unroll
            for (int i = 0; i < 8; ++i) { const int t = 8 * tq + i; const float q0 = bflo(qq[i]), q1 = bfhi(qq[i]);
                const int off = swz256(t, k2 >> 2) + (k2 & 3) * 4;
                *(unsigned*)(lds + H3_QH + off) = pk2(q0 * __expf(fminf(a[i].x - r.x, 80.f)), q1 * __expf(fminf(a[i].y - r.y, 80.f)));
                *(unsigned*)(lds + H3_QA + off) = pk2(q0 * __expf(a[i].x), q1 * __expf(a[i].y));
                *(unsigned*)(lds + H3_KH + off) = pk2((1.f - __expf(lf[i].x)) * __expf(fminf(r.x - a[i].x, 80.f)), (1.f - __expf(lf[i].y)) * __expf(fminf(r.y - a[i].y, 80.f))); }
        }
        hgrn_stage_vt(p, bh, c, lds + H3_VT);
        {
            const bf16_t* st = ubuf + (size_t)item * 16384;
#pragma unroll
            for (int i = 0; i < 4; ++i) { const int q = tid + NT * i, v = q >> 4, ch = q & 15; *(u32x4*)(lds + H3_ST + swz256(v, ch)) = *(const u32x4*)(st + v * 128 + ch * 8); }
        }
        __syncthreads();
        {
            const int wr = wid >> 1, wc = wid & 1;
            f32x4 acc[2];
            acc[0] = (f32x4){0.f, 0.f, 0.f, 0.f}; acc[1] = acc[0];
            if (32 * wc <= 16 * wr + 15) {
#pragma unroll
                for (int ks = 0; ks < 4; ++ks) {
                    const int co = ((ks * 4 + fq) ^ frow) << 4;
                    const bf16x8 af = *(const bf16x8*)(lds + H3_QH + (16 * wr + frow) * 256 + co);
#pragma unroll
                    for (int n = 0; n < 2; ++n) { const bf16x8 bfr = *(const bf16x8*)(lds + H3_KH + (32 * wc + 16 * n + frow) * 256 + co);
                        acc[n] = __builtin_amdgcn_mfma_f32_16x16x32_bf16(bfr, af, acc[n], 0, 0, 0); }
                }
            }
            const int t = 16 * wr + frow;
#pragma unroll
            for (int n = 0; n < 2; ++n) { const int s0 = 32 * wc + 16 * n + 4 * fq; f32x4 v = acc[n];
                v.x = (s0 + 0 <= t) ? v.x : 0.f; v.y = (s0 + 1 <= t) ? v.y : 0.f; v.z = (s0 + 2 <= t) ? v.z : 0.f; v.w = (s0 + 3 <= t) ? v.w : 0.f;
                u32x2 w; w.x = pk2(v.x, v.y); w.y = pk2(v.z, v.w);
                *(u32x2*)(lds + H3_PP + t * 128 + ((((s0 >> 3)) ^ ((t >> 1) & 7)) << 4) + (s0 & 7) * 2) = w; }
        }
        __syncthreads();
        {
            const int wr = wid >> 2, wc = wid & 3;
            f32x4 acc[2][2];
#pragma unroll
            for (int m = 0; m < 2; ++m)
#pragma unroll
                for (int n = 0; n < 2; ++n) acc[m][n] = (f32x4){0.f, 0.f, 0.f, 0.f};
            const int sx = (frow >> 1) & 7;
#pragma unroll
            for (int ks = 0; ks < 2; ++ks) {
                const int co = ((ks * 4 + fq) ^ sx) << 4;
                bf16x8 af[2], bfr[2];
#pragma unroll
                for (int m = 0; m < 2; ++m) af[m] = *(const bf16x8*)(lds + H3_PP + (32 * wr + 16 * m + frow) * 128 + co);
#pragma unroll
                for (int n = 0; n < 2; ++n) bfr[n] = *(const bf16x8*)(lds + H3_VT + (32 * wc + 16 * n + frow) * 128 + co);
#pragma unroll
                for (int m = 0; m < 2; ++m)
#pragma unroll
                    for (int n = 0; n < 2; ++n) acc[m][n] = __builtin_amdgcn_mfma_f32_16x16x32_bf16(bfr[n], af[m], acc[m][n], 0, 0, 0);
            }
#pragma unroll
            for (int ks = 0; ks < 4; ++ks) {
                const int co = ((ks * 4 + fq) ^ frow) << 4;
                bf16x8 af[2], bfr[2];
#pragma unroll
                for (int m = 0; m < 2; ++m) af[m] = *(const bf16x8*)(lds + H3_QA + (32 * wr + 16 * m + frow) * 256 + co);
#pragma unroll
                for (int n = 0; n < 2; ++n) bfr[n] = *(const bf16x8*)(lds + H3_ST + (32 * wc + 16 * n + frow) * 256 + co);
#pragma unroll
                for (int m = 0; m < 2; ++m)
#pragma unroll
                    for (int n = 0; n < 2; ++n) acc[m][n] = __builtin_amdgcn_mfma_f32_16x16x32_bf16(bfr[n], af[m], acc[m][n], 0, 0, 0);
            }
#pragma unroll
            for (int m = 0; m < 2; ++m) { float ss = 0.f;
#pragma unroll
                for (int n = 0; n < 2; ++n) { const f32x4 v = acc[m][n]; ss += (v.x * v.x + v.y * v.y) + (v.z * v.z + v.w * v.w); }
                ss += __shfl_xor(ss, 16); ss += __shfl_xor(ss, 32);
                if (fq == 0) red[(32 * wr + 16 * m + frow) * 4 + wc] = ss; }
            __syncthreads();
#pragma unroll
            for (int m = 0; m < 2; ++m) { const int t = 32 * wr + 16 * m + frow; const f32x4 q4 = *(const f32x4*)(red + t * 4);
                const float rs = rsqrtf(((q4.x + q4.y) + (q4.z + q4.w)) * (1.f / 128.f) + RMS_EPS);
                const size_t row = (size_t)b * SEQ + c * 64 + t;
#pragma unroll
                for (int n = 0; n < 2; ++n) { const int v0 = 32 * wc + 16 * n + 4 * fq; const f32x4 gn = *(const f32x4*)(p.g_hn + v0);
                    const u32x2 gg = *(const u32x2*)((const bf16_t*)(p.ws + WS_HG) + row * 512 + h * 128 + v0);
                    const f32x4 o = acc[m][n];
                    u32x2 w; w.x = pk2(o.x * rs * gn.x * bflo(gg.x), o.y * rs * gn.y * bfhi(gg.x)); w.y = pk2(o.z * rs * gn.z * bflo(gg.y), o.w * rs * gn.w * bfhi(gg.y));
                    *(u32x2*)((bf16_t*)(p.ws + WS_R1) + row * 1024 + 512 + h * 128 + v0) = w; } }
        }
    }
}

DEV void phase_normalize(const Params& p, unsigned char* lds) {
    const int vb = vblock(), G = gridDim.x;
    unsigned char* ws = p.ws;
    __syncthreads();
    {
        float* tl = (float*)lds;
        for (int r = vb; r < 32 * 4 * 16; r += G) { const int e = r / 64, q = r % 64; SrcW13_4 s{p.w1 + (size_t)e * 1024 * 512, p.w3 + (size_t)e * 1024 * 512, p.ffn_g};
            convert_tile256(tl, s, (bf16_t*)(ws + WS_W13T) + (size_t)e * 1024 * 1024, 1024, (q / 16) * 256, (q % 16) * 64); }
    }
}

struct EpiOut8 { const Params& p; static constexpr bool MIDSCALE = true;
    DEV float rowscale(int row) const { return rsqrtf(((const float*)(p.ws + WS_ROWSS))[row] * (1.f / 512.f) + RMS_EPS); }
    DEV int midk() const { return 8; }
    DEV void operator()(const f32x4 (&acc)[2][2][4][2], const pg8::Unit& u, int wr, int wc, int fr, int fq) const {
#pragma unroll
        for (int ai = 0; ai < 2; ++ai)
#pragma unroll
            for (int m = 0; m < 4; ++m) { const size_t row = (size_t)u.pm * 256 + ai * 128 + wr * 64 + m * 16 + fr;
#pragma unroll
                for (int bj = 0; bj < 2; ++bj)
#pragma unroll
                    for (int n = 0; n < 2; ++n) { const int c = u.pn * 256 + 64 * wc + 32 * bj + 8 * fq + 4 * n; const f32x4 xv = *(const f32x4*)(p.x + row * DM + c); *(f32x4*)(p.out + row * DM + c) = xv + acc[ai][bj][m][n]; } }
    } };
DEV void phase_outproj(const Params& p, unsigned char* lds) {
    pg8::Gemm g{(const bf16_t*)(p.ws + WS_R1), (const bf16_t*)(p.ws + WS_WOUTT), NTOK, DM, DM};
    pg8::StaticOrder S; S.init(NTOK, DM, (int)gridDim.x, (int)blockIdx.x);
    EpiOut8 E{p};
    pg8::gemm_phase((PG8_LAS unsigned char*)lds, g, S, E);
}

constexpr int RT_W = 0, RT_LG = 2 * 49152, RT_RS = RT_LG + 128 * 49 * 4, RT_HIST = RT_RS + 512, RT_BASE = RT_HIST + 1024, RT_LDS = RT_BASE + 1024;
DEV void phase_router(const Params& p, unsigned char* lds) {
    const int tid = threadIdx.x, lane = tid & 63, wid = tid >> 6, frow = lane & 15, fq = lane >> 4;
    const int vb = vblock(), G = gridDim.x;
    unsigned char* ws = p.ws;
    float* lg = (float*)(lds + RT_LG); float* rsd = (float*)(lds + RT_RS);
    int* hist = (int*)(lds + RT_HIST); int* basep = (int*)(lds + RT_BASE);
    const bf16_t* rw = (const bf16_t*)(ws + WS_RW);
    for (int it = vb; it < NTOK / 128; it += G) {
        const size_t row0 = (size_t)it * 128;
        const size_t trow = row0 + 16 * wid + frow;
        const float* hrow = p.out + trow * DM + 8 * fq;
        bf16_t* hbrow = (bf16_t*)(ws + WS_R1) + trow * DM + 8 * fq;
        f32x4 acc[3]; float ss = 0.f;
#pragma unroll
        for (int nt = 0; nt < 3; ++nt) acc[nt] = (f32x4){0.f, 0.f, 0.f, 0.f};
        if (tid < 128) hist[tid] = 0;
        u32x4 wreg[6]; f32x4 xa[4][2], xn[4][2];
#define RT_LOADW(kc_) do { _Pragma("unroll") for (int i = 0; i < 6; ++i) { const int idx = tid + NT * i, r = idx >> 5, c = idx & 31; wreg[i] = *(const u32x4*)(rw + (size_t)r * 1024 + (kc_) * 256 + c * 8); } } while (0)
#define RT_STOREW(buf_) do { _Pragma("unroll") for (int i = 0; i < 6; ++i) { const int idx = tid + NT * i, r = idx >> 5, c = idx & 31; *(u32x4*)(lds + RT_W + (buf_) * 49152 + r * 512 + ((c ^ (r & 15)) << 4)) = wreg[i]; } } while (0)
#define RT_LOADX(dst_, hc_) do { _Pragma("unroll") for (int ks = 0; ks < 4; ++ks) { dst_[ks][0] = *(const f32x4*)(hrow + (hc_) * 128 + 32 * ks); dst_[ks][1] = *(const f32x4*)(hrow + (hc_) * 128 + 32 * ks + 4); } } while (0)
        __syncthreads();
        RT_LOADW(0); RT_LOADX(xa, 0); RT_STOREW(0);
        __syncthreads();
#pragma unroll 1
        for (int hc = 0; hc < 8; ++hc) {
            if (hc < 7) RT_LOADX(xn, hc + 1);
            const unsigned char* wb = lds + RT_W + ((hc >> 1) & 1) * 49152;
#pragma unroll
            for (int ks = 0; ks < 4; ++ks) {
                const f32x4 a = xa[ks][0], b = xa[ks][1];
                ss += ((a.x * a.x + a.y * a.y) + (a.z * a.z + a.w * a.w)) + ((b.x * b.x + b.y * b.y) + (b.z * b.z + b.w * b.w));
                u32x4 hi; hi.x = pk2(a.x, a.y); hi.y = pk2(a.z, a.w); hi.z = pk2(b.x, b.y); hi.w = pk2(b.z, b.w);
                u32x4 lo; lo.x = pk2(a.x - bflo(hi.x), a.y - bfhi(hi.x)); lo.y = pk2(a.z - bflo(hi.y), a.w - bfhi(hi.y)); lo.z = pk2(b.x - bflo(hi.z), b.y - bfhi(hi.z)); lo.w = pk2(b.z - bflo(hi.w), b.w - bfhi(hi.w));
                *(u32x4*)(hbrow + hc * 128 + 32 * ks) = hi;
                const bf16x8 hh = __builtin_bit_cast(bf16x8, hi), hl = __builtin_bit_cast(bf16x8, lo);
                const int co = ((4 * (4 * (hc & 1) + ks) + fq) ^ frow) << 4;
#pragma unroll
                for (int nt = 0; nt < 3; ++nt) {
                    const bf16x8 whi = *(const bf16x8*)(wb + (16 * nt + frow) * 512 + co), wlo = *(const bf16x8*)(wb + (48 + 16 * nt + frow) * 512 + co);
                    acc[nt] = __builtin_amdgcn_mfma_f32_16x16x32_bf16(whi, hh, acc[nt], 0, 0, 0);
                    acc[nt] = __builtin_amdgcn_mfma_f32_16x16x32_bf16(wlo, hh, acc[nt], 0, 0, 0);
                    acc[nt] = __builtin_amdgcn_mfma_f32_16x16x32_bf16(whi, hl, acc[nt], 0, 0, 0);
                }
            }
            if ((hc & 1) == 0 && hc < 6) { RT_LOADW((hc >> 1) + 1); }
            if ((hc & 1) == 1 && hc < 7) { RT_STOREW(((hc >> 1) + 1) & 1); }
#pragma unroll
            for (int ks = 0; ks < 4; ++ks) { xa[ks][0] = xn[ks][0]; xa[ks][1] = xn[ks][1]; }
            if (hc & 1) __syncthreads();
        }
#undef RT_LOADW
#undef RT_STOREW
#undef RT_LOADX
        ss += __shfl_xor(ss, 16); ss += __shfl_xor(ss, 32);
        if (fq == 0) rsd[16 * wid + frow] = rsqrtf(ss * (1.f / DM) + RMS_EPS);
#pragma unroll
        for (int nt = 0; nt < 3; ++nt) { float* o = lg + (16 * wid + frow) * 49 + 16 * nt + 4 * fq; o[0] = acc[nt].x; o[1] = acc[nt].y; o[2] = acc[nt].z; o[3] = acc[nt].w; }
        __syncthreads();
        int bin = 0, slot = 0, ea = 0, eb = 0, sa = 0, sb = 0; float wa = 0.f, wb = 0.f;
        int* ehist = hist + 112; int* ebase = basep + 112;
        if (tid < 32) ehist[tid] = 0;
        __syncthreads();
        if (tid < 128) {
            const float rs = rsd[tid];
            ((float*)(ws + WS_RSTD2))[row0 + tid] = rs;
            float gl[4]; int gi = 0; float gm = -1e30f;
#pragma unroll
            for (int c = 0; c < 4; ++c) { gl[c] = lg[tid * 49 + c] * rs + p.b_group[c]; if (gl[c] > gm) { gm = gl[c]; gi = c; } }
            float gs = 0.f;
#pragma unroll
            for (int c = 0; c < 4; ++c) gs += __expf(gl[c] - gm);
            const float pg = 1.f / gs;
            float el[8]; int i0 = 0; float m0 = -1e30f;
#pragma unroll
            for (int c = 0; c < 8; ++c) { el[c] = lg[tid * 49 + 4 + gi * 8 + c] * rs + p.b_expert[gi * 8 + c]; if (el[c] > m0) { m0 = el[c]; i0 = c; } }
            int i1 = 0; float m1 = -1e30f;
#pragma unroll
            for (int c = 0; c < 8; ++c) if (c != i0 && el[c] > m1) { m1 = el[c]; i1 = c; }
            const float e1 = __expf(m1 - m0); const float w0 = pg / (1.f + e1), w1 = pg * e1 / (1.f + e1);
            const int a = min(i0, i1), bb = max(i0, i1);
            bin = gi * 28 + (7 * a - (a * (a - 1)) / 2) + (bb - a - 1);
            wa = (i0 < i1) ? w0 : w1; wb = (i0 < i1) ? w1 : w0; ea = gi * 8 + a; eb = gi * 8 + bb;
            slot = atomicAdd(&hist[bin], 1);
            sa = atomicAdd(&ehist[ea], 1); sb = atomicAdd(&ehist[eb], 1);
        }
        __syncthreads();
        if (tid < NBIN) { const int h = hist[tid]; basep[tid] = h ? atomicAdd((int*)(ws + WS_CTL) + tid, h) : 0; }
        else if (tid >= 128 && tid < 160) { const int e = tid - 128; const int h = ehist[e]; ebase[e] = h ? atomicAdd((int*)(ws + WS_CTL + 512) + e, h) : 0; }
        __syncthreads();
        if (tid < 128) {
            const int t = (int)(row0 + tid);
            ((int*)(ws + WS_BINL))[(size_t)bin * BINCAP + basep[bin] + slot] = t;
            sa += ebase[ea]; sb += ebase[eb];
            ((int*)(ws + WS_EL))[(size_t)ea * BINCAP + sa] = t; ((float*)(ws + WS_EW))[(size_t)ea * BINCAP + sa] = wa;
            ((int*)(ws + WS_EL))[(size_t)eb * BINCAP + sb] = t; ((float*)(ws + WS_EW))[(size_t)eb * BINCAP + sb] = wb;
            { const unsigned dpos = (unsigned)bin | ((unsigned)(basep[bin] + slot) << 7); ((unsigned*)(ws + WS_EDST))[(size_t)ea * BINCAP + sa] = dpos; ((unsigned*)(ws + WS_EDST))[(size_t)eb * BINCAP + sb] = dpos | (1u << 22); }
        }
        __syncthreads();
    }
}

constexpr int MOE_TS = pg8::STAGE_BYTES, MOE_TT = MOE_TS + 512, MOE_ES = MOE_TT + 1024, MOE_ET = MOE_ES + 256;
DEV void moe_tiles(const Params& p, unsigned char* lds) {
    int* tstart = (int*)(lds + MOE_TS); int* tiletab = (int*)(lds + MOE_TT); int* etstart = (int*)(lds + MOE_ES); int* etiletab = (int*)(lds + MOE_ET);
    const int tid = threadIdx.x;
    __syncthreads();
    if (tid == 0) { const int* cnt = (const int*)(p.ws + WS_CTL); int s = 0; for (int i = 0; i < NBIN; ++i) { tstart[i] = s; s += (cnt[i] + 255) >> 8; } tstart[NBIN] = s; }
    if (tid == 64) { const int* cnt = (const int*)(p.ws + WS_CTL + 512); int s = 0; for (int i = 0; i < 32; ++i) { etstart[i] = s; s += (cnt[i] + 255) >> 8; } etstart[32] = s; }
    __syncthreads();
    if (tid < NBIN) for (int t = tstart[tid]; t < tstart[tid + 1]; ++t) tiletab[t] = tid;
    if (tid >= 128 && tid < 160) for (int t = etstart[tid - 128]; t < etstart[tid - 127]; ++t) etiletab[t] = tid - 128;
    __syncthreads();
}
DEV void bin_experts(int bin, int& ea, int& eb) { const int gi = bin / 28; int pi = bin % 28, a = 0; while (pi >= 7 - a) { pi -= 7 - a; ++a; } ea = gi * 8 + a; eb = gi * 8 + a + 1 + pi; }
DEV void lane_rc(int i, int& R, int& C) { pg8::stage_rc((int)threadIdx.x * 16, R, C); R += 64 * i; }
struct MoeUnit { int tile, nt, bin, mt, n; };
struct PolMoe1 {
    typedef MoeUnit Unit;
    const Params& p; const int* etstart; const int* etiletab; int U, G, c;
    struct AddrA { unsigned off[2][2]; };
    struct AddrB { const char* base; };
    DEV int nk() const { return 16; }
    DEV bool next(int i, MoeUnit& u) const {
        const int L = i * G + c; if (L >= U) return false;
        u.tile = L >> 2; u.nt = L & 3;
        u.bin = __builtin_amdgcn_readfirstlane(etiletab[u.tile]);
        u.mt = u.tile - __builtin_amdgcn_readfirstlane(etstart[u.bin]);
        u.n = min(256, ((const int*)(p.ws + WS_CTL + 512))[u.bin] - u.mt * 256);
        return true;
    }
    DEV bool full(const MoeUnit& u) const { return u.n > 128; }
    DEV void addrA(const MoeUnit& u, AddrA& a) const {
        const int* list = (const int*)(p.ws + WS_EL) + (size_t)u.bin * BINCAP + u.mt * 256;
#pragma unroll
        for (int i = 0; i < 2; ++i) { int R, C; lane_rc(i, R, C);
#pragma unroll
            for (int h = 0; h < 2; ++h) { int r = h * 128 + R; if (r >= u.n) r = 0; a.off[h][i] = (unsigned)list[r] * 2048u + (unsigned)C * 2u; } }
    }
    DEV void addrB(const MoeUnit& u, AddrB& b) const { b.base = (const char*)(p.ws + WS_W13T) + ((size_t)u.bin * 1024 + u.nt * 256) * 2048; }
    DEV const char* pa(const AddrA& a, int h, int i, int kt) const { return (const char*)(p.ws + WS_R1) + a.off[h][i] + kt * 128; }
    DEV const char* pb(const AddrB& b, int h, int i, int kt) const { int R, C; lane_rc(i, R, C); return b.base + (size_t)h * (128 * 2048) + (unsigned)(R * 1024 + C) * 2u + kt * 128; }
};
struct EpiMoe1 { const Params& p; const int* tstart;
    DEV void operator()(const f32x4 (&acc)[2][2][4][2], const MoeUnit& u, int wr, int wc, int fr, int fq) const {
        const int* list = (const int*)(p.ws + WS_EL) + (size_t)u.bin * BINCAP + u.mt * 256;
        const float* wl = (const float*)(p.ws + WS_EW) + (size_t)u.bin * BINCAP + u.mt * 256;
        const unsigned* dl = (const unsigned*)(p.ws + WS_EDST) + (size_t)u.bin * BINCAP + u.mt * 256;
#pragma unroll
        for (int ai = 0; ai < 2; ++ai)
#pragma unroll
            for (int m = 0; m < 4; ++m) { const int r = ai * 128 + wr * 64 + m * 16 + fr; if (r >= u.n) continue;
                const float rs = ((const float*)(p.ws + WS_RSTD2))[list[r]]; const float w = wl[r]; const unsigned d = dl[r];
                bf16_t* hrow = (bf16_t*)(p.ws + WS_HBUF) + ((size_t)tstart[d & 127u] * 256 + ((d >> 7) & 32767u)) * 1024 + ((d >> 22) & 1u) * 512;
#pragma unroll
                for (int bj = 0; bj < 2; ++bj) { const f32x4 v0 = acc[ai][bj][m][0] * rs, v1 = acc[ai][bj][m][1] * rs; const int f = (u.nt * 256 + 128 * bj + 32 * wc + 8 * fq) >> 1;
                    u32x2 w2; w2.x = pk2(siluf_(v0.x) * v0.y * w, siluf_(v0.z) * v0.w * w); w2.y = pk2(siluf_(v1.x) * v1.y * w, siluf_(v1.z) * v1.w * w); *(u32x2*)(hrow + f) = w2; } }
    } };
DEV void phase_moe1(const Params& p, unsigned char* lds) {
    moe_tiles(p, lds);
    const int* etstart = (const int*)(lds + MOE_ES);
    PolMoe1 P{p, etstart, (const int*)(lds + MOE_ET), etstart[32] * 4, (int)gridDim.x, vblock()};
    EpiMoe1 E{p, (const int*)(lds + MOE_TS)};
    pg8::gemm_phase2(( PG8_LAS unsigned char*)lds, P, E);
}
struct PolMoe2 {
    typedef MoeUnit Unit;
    const Params& p; const int* tstart; const int* tiletab; int U, G, c;
    struct AddrA { const char* base; };
    struct AddrB { const char* ba; const char* bb; };
    DEV int nk() const { return 16; }
    DEV bool next(int i, MoeUnit& u) const {
        const int L = i * G + c; if (L >= U) return false;
        u.tile = L >> 2; u.nt = L & 3;
        u.bin = __builtin_amdgcn_readfirstlane(tiletab[u.tile]);
        u.mt = u.tile - __builtin_amdgcn_readfirstlane(tstart[u.bin]);
        u.n = min(256, ((const int*)(p.ws + WS_CTL))[u.bin] - u.mt * 256);
        return true;
    }
    DEV bool full(const MoeUnit& u) const { return u.n > 128; }
    DEV void addrA(const MoeUnit& u, AddrA& a) const { a.base = (const char*)(p.ws + WS_HBUF) + (size_t)u.tile * 256 * 2048; }
    DEV void addrB(const MoeUnit& u, AddrB& b) const {
        int ea, eb; bin_experts(u.bin, ea, eb);
        b.ba = (const char*)(p.ws + WS_W2T) + ((size_t)ea * 1024 + u.nt * 256) * 1024; b.bb = (const char*)(p.ws + WS_W2T) + ((size_t)eb * 1024 + u.nt * 256) * 1024;
    }
    DEV const char* pa(const AddrA& a, int h, int i, int kt) const { int R, C; lane_rc(i, R, C); return a.base + (size_t)h * (128 * 2048) + (unsigned)(R * 1024 + C) * 2u + kt * 128; }
    DEV const char* pb(const AddrB& b, int h, int i, int kt) const { int R, C; lane_rc(i, R, C); return (kt < 8 ? b.ba + kt * 128 : b.bb + (kt - 8) * 128) + (size_t)h * (128 * 1024) + (unsigned)(R * 512 + C) * 2u; }
};
struct EpiMoe2 { const Params& p;
    DEV void operator()(const f32x4 (&acc)[2][2][4][2], const MoeUnit& u, int wr, int wc, int fr, int fq) const {
        const int* list = (const int*)(p.ws + WS_BINL) + (size_t)u.bin * BINCAP + u.mt * 256;
#pragma unroll
        for (int ai = 0; ai < 2; ++ai)
#pragma unroll
            for (int m = 0; m < 4; ++m) { const int r = ai * 128 + wr * 64 + m * 16 + fr; if (r >= u.n) continue; const size_t t = list[r];
#pragma unroll
                for (int bj = 0; bj < 2; ++bj)
#pragma unroll
                    for (int n = 0; n < 2; ++n) { float* o = p.out + t * DM + u.nt * 256 + 128 * bj + 32 * wc + 16 * n + 4 * fq; *(f32x4*)o = *(const f32x4*)o + acc[ai][bj][m][n]; } }
    } };
DEV void phase_moe2(const Params& p, unsigned char* lds) {
    moe_tiles(p, lds);
    const int* tstart = (const int*)(lds + MOE_TS);
    PolMoe2 P{p, tstart, (const int*)(lds + MOE_TT), tstart[NBIN] * 4, (int)gridDim.x, vblock()};
    EpiMoe2 E{p};
    pg8::gemm_phase2((PG8_LAS unsigned char*)lds, P, E);
}

#define XB_TMO      128
#define XB_XCNT(j)  (256  + 64 * (j))
#define XB_XSUB(j)  (1280 + 64 * (j))
#define XB_XGEN(j)  (2304 + 64 * (j))
#define XB_TOP      3328
#define XB_TOPGEN   3392
#define XCD_BAR_WORDS 3456
#define XB_SPIN_CAP (1u << 20)
#define LAS __attribute__((address_space(3)))
constexpr size_t WS_BAR = WS_CTL + 4096;
DEV unsigned xb_ld(unsigned* p) { return __hip_atomic_load(p, __ATOMIC_RELAXED, __HIP_MEMORY_SCOPE_AGENT); }
DEV unsigned xb_add(unsigned* p, unsigned v) { return __hip_atomic_fetch_add(p, v, __ATOMIC_RELAXED, __HIP_MEMORY_SCOPE_AGENT); }
DEV unsigned xb_xcc_id() { return (unsigned)__builtin_amdgcn_s_getreg((3 << 11) | 20) & 0xFu; }
#define XB_SPIN(cond, bar) do { unsigned _sp = 0; while (cond) { __builtin_amdgcn_s_sleep(1); \
    if ((++_sp & 255u) == 0u) { if (xb_ld(&(bar)[XB_TMO])) break; if (_sp > XB_SPIN_CAP) { atomicAdd(&(bar)[XB_TMO], 1u); break; } } } } while (0)
struct XcdBarrier { unsigned* bar; unsigned x; volatile LAS unsigned* st; };
DEV XcdBarrier xcd_barrier_post(unsigned* bar, volatile LAS unsigned* st) {
    XcdBarrier b; b.bar = bar; b.x = xb_xcc_id(); b.st = st;
    if (threadIdx.x == 0) (void)xb_add(&bar[XB_XCNT(b.x)], 1u);
    return b;
}
DEV void xcd_barrier_complete(unsigned* bar, unsigned x, unsigned& nloc, unsigned& nx) {
    const unsigned G = gridDim.x * gridDim.y * gridDim.z;
    unsigned sum, cnt, mine, sp = 0u;
    for (;;) {
        sum = 0u; cnt = 0u; mine = 0u;
#pragma unroll
        for (unsigned j = 0; j < 16; ++j) { const unsigned c = xb_ld(&bar[XB_XCNT(j)]); sum += c; cnt += (c > 0u) ? 1u : 0u; mine = (j == x) ? c : mine; }
        if (sum == G) break;
        __builtin_amdgcn_s_sleep(1);
        if ((++sp & 255u) == 0u) { if (xb_ld(&bar[XB_TMO])) break; if (sp > XB_SPIN_CAP) { atomicAdd(&bar[XB_TMO], 1u); break; } }
    }
    nloc = mine > 0u ? mine : 1u; nx = cnt > 0u ? cnt : 1u;
}
DEV void xcd_barrier(const XcdBarrier& b) {
    asm volatile("s_waitcnt vmcnt(0)" ::: "memory");
    __syncthreads();
    if (threadIdx.x == 0) {
        unsigned* bar = b.bar;
        __builtin_amdgcn_s_waitcnt(0);
        unsigned nloc = b.st[0], nx = b.st[1];
        if (nloc == 0u) { xcd_barrier_complete(bar, b.x, nloc, nx); b.st[0] = nloc; b.st[1] = nx; }
        const unsigned old = xb_add(&bar[XB_XSUB(b.x)], 1u);
        const unsigned gen = old / nloc;
        if (old + 1u == (gen + 1u) * nloc) {
            __builtin_amdgcn_fence(__ATOMIC_RELEASE, "agent");
            asm volatile("s_waitcnt vmcnt(0)" ::: "memory");
            const unsigned og = xb_add(&bar[XB_TOP], 1u);
            const unsigned tg = og / nx;
            if (og + 1u == (tg + 1u) * nx) xb_add(&bar[XB_TOPGEN], 1u);
            else XB_SPIN(xb_ld(&bar[XB_TOPGEN]) == tg, bar);
            __builtin_amdgcn_fence(__ATOMIC_ACQUIRE, "agent");
            xb_add(&bar[XB_XGEN(b.x)], 1u);
            asm volatile("s_waitcnt vmcnt(0)" ::: "memory");
        } else {
            XB_SPIN(xb_ld(&bar[XB_XGEN(b.x)]) == gen, bar);
            __builtin_amdgcn_fence(__ATOMIC_ACQUIRE, "agent");
            asm volatile("s_waitcnt vmcnt(0)" ::: "memory");
        }
    }
    __syncthreads();
}

constexpr int LDS_BYTES = 144 * 1024;
constexpr int N_PHASES = 9;
__global__ void __launch_bounds__(NT) mega(Params p, int lo, int hi) {
    extern __shared__ __attribute__((aligned(16))) unsigned char lds[];
    volatile LAS unsigned* xst = (volatile LAS unsigned*)(lds + LDS_BYTES - 16);
    if (threadIdx.x < 4) xst[threadIdx.x] = 0u;
    __syncthreads();
    XcdBarrier xbar; xbar.bar = (unsigned*)(p.ws + WS_BAR); xbar.x = 0; xbar.st = xst;
    if (hi - lo > 1) xbar = xcd_barrier_post((unsigned*)(p.ws + WS_BAR), xst);
#define GRID_SYNC() xcd_barrier(xbar)
#ifndef PROBE_REPEAT
#define PROBE_REPEAT -1
#endif
#define RUN_PHASE(k, call) do { if (lo <= (k) && (k) < hi) { call; \
        if ((k) == PROBE_REPEAT) { GRID_SYNC(); \
            if ((k) == 5) { float* rz = (float*)(p.ws + WS_ROWSS); for (int i = blockIdx.x * NT + threadIdx.x; i < NTOK; i += gridDim.x * NT) rz[i] = 0.f; GRID_SYNC(); } \
            if ((k) == 7) { if (blockIdx.x == 0 && threadIdx.x < 128) ((int*)(p.ws + WS_CTL))[threadIdx.x] = 0; GRID_SYNC(); } \
            call; } \
        if ((k) + 1 < hi) GRID_SYNC(); } } while (0)
    RUN_PHASE(0, phase_prologue(p, lds));
    RUN_PHASE(1, phase_inproj(p, lds));
    RUN_PHASE(2, { phase_cmp_a(p, lds); const int G_ = (int)gridDim.x; if (G_ > 128) phase_hgrn_a1(p, lds, 64, G_ - 64); else phase_hgrn_a1(p, lds, 0, G_); });
    RUN_PHASE(3, { phase_cmp_b(p, lds); phase_hgrn_a2(p, lds); });
    RUN_PHASE(4, { phase_cmp_attn(p, lds); phase_hgrn_a3(p, lds); });
    RUN_PHASE(5, { phase_flash(p, lds); phase_normalize(p, lds); });
    RUN_PHASE(6, phase_outproj(p, lds));
    RUN_PHASE(7, phase_router(p, lds));
    RUN_PHASE(8, phase_moe1(p, lds));
    RUN_PHASE(9, phase_moe2(p, lds));
#undef RUN_PHASE
}

extern "C" void kernel_launch(void* const* d_in, const int* in_sizes, int n_in, void* d_out, int out_size, void* d_ws, size_t ws_size, hipStream_t stream) {
    static int grid = 0;
    if (grid == 0) {
        int dev = 0, cus = 0, per_cu = 0;
        hipGetDevice(&dev);
        hipDeviceGetAttribute(&cus, hipDeviceAttributeMultiprocessorCount, dev);
        hipFuncSetAttribute((const void*)mega, hipFuncAttributeMaxDynamicSharedMemorySize, LDS_BYTES);
        hipOccupancyMaxActiveBlocksPerMultiprocessor(&per_cu, (const void*)mega, NT, LDS_BYTES);
        if (per_cu < 1) per_cu = 1;
        grid = cus;
        if (ws_size < WS_END) fprintf(stderr, "kernel_launch: workspace too small: %zu < %zu\n", ws_size, (size_t)WS_END);
        fprintf(stderr, "kernel_launch: cus %d per_cu %d grid %d ws %zu\n", cus, per_cu, grid, ws_size);
    }
    Params p{};
    const float** pp = (const float**)&p;
    for (int i = 0; i < 23; ++i) pp[i] = (const float*)d_in[i];
    p.out = (float*)d_out; p.ws = (unsigned char*)d_ws;
#if N_LAUNCH_MODE == 1
    (void)hipMemsetAsync((unsigned char*)d_ws + WS_BAR, 0, XCD_BAR_WORDS * 4, stream);
    int lo = 0, hi = N_PHASES + 1;
    void* args[] = {&p, &lo, &hi};
    hipError_t e = hipLaunchCooperativeKernel((const void*)mega, dim3(grid), dim3(NT), args, LDS_BYTES, stream);
    if (e != hipSuccess) fprintf(stderr, "cooperative launch failed: %s\n", hipGetErrorString(e));
#else
    for (int ph = 0; ph <= N_PHASES; ++ph) hipLaunchKernelGGL(mega, dim3(grid), dim3(NT), LDS_BYTES, stream, p, ph, ph + 1);
#endif
}
```

```cpp
#include <hip/hip_runtime.h>
#include <hip/hip_cooperative_groups.h>
#include <cstdio>
#include <cstdint>
#include <cstring>
namespace cg = cooperative_groups;

#ifndef N_LAUNCH_MODE
#define N_LAUNCH_MODE 1
#endif

#define DEV __device__ __forceinline__
typedef unsigned short bf16_t;
typedef short bf16x8 __attribute__((ext_vector_type(8)));
typedef float f32x4 __attribute__((ext_vector_type(4)));
typedef float f32x2 __attribute__((ext_vector_type(2)));
typedef float f32x16 __attribute__((ext_vector_type(16)));
typedef unsigned u32x4 __attribute__((ext_vector_type(4)));
typedef unsigned u32x2 __attribute__((ext_vector_type(2)));

constexpr int NT = 512;
constexpr int BATCH = 8, SEQ = 4096, DM = 1024, NTOK = BATCH * SEQ;
constexpr int IN_COLS = 3352, INP = 3584;
constexpr int NC = 255;
constexpr float RMS_EPS = 1e-6f;
constexpr float QSCALE = 0.125f * 1.4426950408889634f;
constexpr int NBIN = 112;
constexpr int BINCAP = NTOK;

constexpr size_t MiB = 1ull << 20;
constexpr size_t WS_CTL    = 0;
constexpr size_t WS_RSTD1  = 1 * MiB;
constexpr size_t WS_RSTD2  = WS_RSTD1 + 128 * 1024;
constexpr size_t WS_ROWSS  = WS_RSTD2 + 128 * 1024;
constexpr size_t WS_TOKW   = WS_ROWSS + 128 * 1024;
constexpr size_t WS_LB     = WS_TOKW + 256 * 1024;
constexpr size_t WS_CBIAS  = WS_LB + 4096;
constexpr size_t WS_SELM   = 2 * MiB;
constexpr size_t WS_GATES  = 3 * MiB;
constexpr size_t WS_KCMP   = 6 * MiB;
constexpr size_t WS_VCMP   = WS_KCMP + 512 * 1024;
constexpr size_t WS_CW2T   = 7 * MiB;
constexpr size_t WS_RW     = 7 * MiB + 128 * 1024;
constexpr size_t WS_HID    = 8 * MiB;
constexpr size_t WS_CW1T   = 12 * MiB;
constexpr size_t WS_WOUTT  = 14 * MiB;
constexpr size_t WS_WINT   = 16 * MiB;
constexpr size_t WS_R1     = 24 * MiB;
constexpr size_t WS_Q      = 88 * MiB;
constexpr size_t WS_KC     = 120 * MiB;
constexpr size_t WS_VC     = 128 * MiB;
constexpr size_t WS_KS     = 136 * MiB;
constexpr size_t WS_KW     = 144 * MiB;
constexpr size_t WS_VST    = 152 * MiB;
constexpr size_t WS_VWT    = 160 * MiB;
constexpr size_t WS_OC     = 168 * MiB;
constexpr size_t WS_W13T   = 200 * MiB;
constexpr size_t WS_W2T    = 264 * MiB;
constexpr size_t WS_HQ     = 296 * MiB;
constexpr size_t WS_HV     = 328 * MiB;
constexpr size_t WS_HG     = 360 * MiB;
constexpr size_t WS_HLOGF  = 392 * MiB;
constexpr size_t WS_DBUF   = 456 * MiB;
constexpr size_t WS_END    = 457 * MiB;
constexpr size_t WS_UBUF   = WS_W13T;
constexpr size_t WS_BINL   = WS_HQ;
constexpr size_t WS_HBUF   = WS_HQ + 16 * MiB;
constexpr size_t WS_EL     = WS_HQ + 136 * MiB;
constexpr size_t WS_EW     = WS_HQ + 140 * MiB;
constexpr size_t WS_EDST   = WS_HQ + 144 * MiB;

struct Params {
    const float *x, *attn_g, *ffn_g, *w_in, *w_out, *g_q, *g_k, *pos_k, *pos_v, *wk1, *wk2, *wv1, *wv2, *g_nsa, *lb_logits, *g_hn,
        *w_group, *b_group, *w_expert, *b_expert, *w1, *w3, *w2;
    float* out;
    unsigned char* ws;
};

typedef __bf16 bf16x2_t __attribute__((ext_vector_type(2)));
DEV unsigned pk2(float lo, float hi) { f32x2 f = {lo, hi}; return __builtin_bit_cast(unsigned, __builtin_convertvector(f, bf16x2_t)); }
DEV bf16_t f2bf(float f) { return (bf16_t)(pk2(f, 0.f) & 0xffffu); }
DEV float bf2f(bf16_t b) { return __uint_as_float(((unsigned)b) << 16); }
DEV float bflo(unsigned u) { return __uint_as_float(u << 16); }
DEV float bfhi(unsigned u) { return __uint_as_float(u & 0xffff0000u); }
DEV float sigmoidf_(float v) { return __builtin_amdgcn_rcpf(1.f + __builtin_amdgcn_exp2f(-1.4426950408889634f * v)); }
DEV float siluf_(float v) { return v * __builtin_amdgcn_rcpf(1.f + __builtin_amdgcn_exp2f(-1.4426950408889634f * v)); }
DEV float wave_sum(float v) {
#pragma unroll
    for (int o = 1; o < 64; o <<= 1) v += __shfl_xor(v, o);
    return v;
}
DEV float wave_max(float v) {
#pragma unroll
    for (int o = 1; o < 64; o <<= 1) v = fmaxf(v, __shfl_xor(v, o));
    return v;
}
DEV int vblock() { const int G = gridDim.x, b = blockIdx.x; return (G % 8 == 0) ? (b % 8) * (G / 8) + b / 8 : b; }

namespace pg8 {
#define PG8_LAS __attribute__((address_space(3)))
constexpr int BM = 256, BK = 64, HALF = 128, HTB = HALF * BK * 2, STAGE_BYTES = 8 * HTB, NXCD = 8, WGM = 1;
__host__ __device__ __forceinline__ int lds_byte(int r, int c) { const int st = (r >> 4) * 2 + (c >> 5), rr = r & 15, cc = c & 31, ob = rr * 64 + cc * 2; return st * 1024 + (ob ^ (((ob >> 9) & 1) << 5)); }
__host__ __device__ __forceinline__ void stage_rc(int b, int& R, int& C) { const int st = b / 1024, sb = b % 1024, swz = sb ^ (((sb >> 9) & 1) << 5); R = (st >> 1) * 16 + swz / 64; C = (st & 1) * 32 + (swz % 64) / 2; }
struct Unit { int pm, pn; };
struct Gemm { const bf16_t* A; const bf16_t* Bt; int M, N, K; };
struct StaticOrder {
    int nM, nN, nwg, G, c;
    __host__ __device__ void init(int M, int N, int G_, int c_) { nM = M / BM; nN = N / BM; nwg = nM * nN; G = G_; c = c_; }
    __host__ __device__ bool next(int i, Unit& u) const {
        const long L = (long)i * G + c; if (L >= nwg) return false;
        int wgid = (int)L; { const int q = nwg / NXCD, r = nwg % NXCD, xcd = wgid % NXCD, off = wgid / NXCD; wgid = (xcd < r ? xcd * (q + 1) : r * (q + 1) + (xcd - r) * q) + off; }
        const int nig = WGM * nN, gid = wgid / nig, fm = gid * WGM, gsz = (nM - fm) < WGM ? (nM - fm) : WGM;
        u.pm = fm + ((wgid % nig) % gsz); u.pn = (wgid % nig) / gsz; return true;
    }
};
template <class Epi, class Sched>
__device__ __forceinline__ void gemm_phase(PG8_LAS unsigned char* lds, const Gemm g, const Sched& S, const Epi& E) {
    const int tid = threadIdx.x, wid = __builtin_amdgcn_readfirstlane(tid >> 6), lane = tid & 63, wr = wid >> 2, wc = wid & 3, fr = lane & 15, fq = lane >> 4;
    const int K = g.K, nt = K / BK;
    unsigned voffA[2];
#pragma unroll
    for (int i = 0; i < 2; ++i) { int R, C; stage_rc(tid * 16 + i * 8192, R, C); voffA[i] = (unsigned)(R * K + C) * 2u; }
    const size_t kstep = (size_t)(BK * 2);
    const size_t hstep = (size_t)HALF * K * 2;
    const size_t tstep = 2 * hstep;
    const unsigned ldsw = (unsigned)wid * 1024u;
    const int aoff = lds_byte(wr * 64 + fr, fq * 8), boff = lds_byte(wc * 32 + fr, fq * 8);
#define PG8_SA(b, h) (((b) * 2 + (h)) * HTB)
#define PG8_SB(b, h) ((4 + (b) * 2 + (h)) * HTB)
#define PG8_STAGE(bufoff, gbase, voff) do { _Pragma("unroll") for (int _i = 0; _i < 2; ++_i) \
        __builtin_amdgcn_global_load_lds((const unsigned*)((const char*)(gbase) + (voff)[_i]), (PG8_LAS unsigned*)(lds + (bufoff) + ldsw + _i * 8192), 16, 0, 0); } while (0)
#define PG8_LDA(dst, b, h) do { _Pragma("unroll") for (int m = 0; m < 4; ++m) _Pragma("unroll") for (int k = 0; k < 2; ++k) dst[m][k] = *(const PG8_LAS bf16x8*)(lds + PG8_SA(b, h) + aoff + m * 2048 + k * 1024); } while (0)
#define PG8_LDB(dst, b, h) do { _Pragma("unroll") for (int n = 0; n < 2; ++n) _Pragma("unroll") for (int k = 0; k < 2; ++k) dst[n][k] = *(const PG8_LAS bf16x8*)(lds + PG8_SB(b, h) + boff + n * 2048 + k * 1024); } while (0)
#define PG8_MMA(ai, bj, At, Bt) do { __builtin_amdgcn_s_setprio(1); _Pragma("unroll") for (int m = 0; m < 4; ++m) _Pragma("unroll") for (int n = 0; n < 2; ++n) _Pragma("unroll") for (int k = 0; k < 2; ++k) \
        acc[ai][bj][m][n] = __builtin_amdgcn_mfma_f32_16x16x32_bf16(Bt[n][k], At[m][k], acc[ai][bj][m][n], 0, 0, 0); __builtin_amdgcn_s_setprio(0); } while (0)
#define PG8_WAIT_V(n) asm volatile("s_waitcnt vmcnt(" #n ")" ::: "memory")
#define PG8_WAIT_L(n) asm volatile("s_waitcnt lgkmcnt(" #n ")" ::: "memory")
#define PG8_BAR __builtin_amdgcn_s_barrier()
#define PG8_SCHED __builtin_amdgcn_sched_barrier(0)
    Unit cur, nxt; int ui = 0;
    if (!S.next(0, cur)) return;
    f32x4 acc[2][2][4][2];
#pragma unroll
    for (int a = 0; a < 2; ++a)
#pragma unroll
        for (int b = 0; b < 2; ++b)
#pragma unroll
            for (int m = 0; m < 4; ++m)
#pragma unroll
                for (int n = 0; n < 2; ++n) acc[a][b][m][n] = (f32x4){0.f, 0.f, 0.f, 0.f};
    bf16x8 At[4][2], B0[2][2], B1[2][2];
    const char* cA = (const char*)g.A + (size_t)cur.pm * tstep; const char* cB = (const char*)g.Bt + (size_t)cur.pn * tstep;
    PG8_STAGE(PG8_SB(0, 0), cB, voffA); PG8_STAGE(PG8_SA(0, 0), cA, voffA); PG8_STAGE(PG8_SB(0, 1), cB + hstep, voffA); PG8_STAGE(PG8_SA(0, 1), cA + hstep, voffA);
    if (wr == 1) PG8_BAR;
    PG8_WAIT_V(4); PG8_BAR;
    PG8_STAGE(PG8_SB(1, 0), cB + kstep, voffA); PG8_STAGE(PG8_SA(1, 0), cA + kstep, voffA); PG8_STAGE(PG8_SB(1, 1), cB + hstep + kstep, voffA);
    PG8_WAIT_V(6); PG8_BAR;
    for (;;) {
        const bool has_next = S.next(ui + 1, nxt);
        const char* nA = has_next ? (const char*)g.A + (size_t)nxt.pm * tstep : cA; const char* nB = has_next ? (const char*)g.Bt + (size_t)nxt.pn * tstep : cB;
        float midrs[2][4];
        if constexpr (Epi::MIDSCALE) {
#pragma unroll
            for (int a = 0; a < 2; ++a)
#pragma unroll
                for (int m = 0; m < 4; ++m) midrs[a][m] = E.rowscale(cur.pm * BM + a * HALF + wr * 64 + m * 16 + fr); }
        for (int t = 0; t < nt; t += 2) {
            const bool last = (t == nt - 2);
            if constexpr (Epi::MIDSCALE) { if (t == E.midk()) {
#pragma unroll
                for (int a = 0; a < 2; ++a)
#pragma unroll
                    for (int b = 0; b < 2; ++b)
#pragma unroll
                        for (int m = 0; m < 4; ++m)
#pragma unroll
                            for (int n = 0; n < 2; ++n) acc[a][b][m][n] = acc[a][b][m][n] * midrs[a][m]; } }
            const char* a1 = cA + (size_t)(t + 1) * kstep;
            const char* a2 = last ? nA : cA + (size_t)(t + 2) * kstep; const char* b2 = last ? nB : cB + (size_t)(t + 2) * kstep;
            const char* a3 = a2 + kstep; const char* b3 = b2 + kstep;
            PG8_LDB(B0, 0, 0); PG8_SCHED; PG8_LDA(At, 0, 0); PG8_STAGE(PG8_SA(1, 1), a1 + hstep, voffA);
            PG8_WAIT_L(8); PG8_BAR; PG8_WAIT_L(0); PG8_MMA(0, 0, At, B0); PG8_BAR; PG8_SCHED;
            PG8_LDB(B1, 0, 1); PG8_STAGE(PG8_SB(0, 0), b2, voffA);
            PG8_BAR; PG8_WAIT_L(0); PG8_MMA(0, 1, At, B1); PG8_BAR;
            PG8_LDA(At, 0, 1); PG8_STAGE(PG8_SA(0, 0), a2, voffA);
            PG8_BAR; PG8_WAIT_L(0); PG8_MMA(1, 0, At, B0); PG8_BAR; PG8_SCHED;
            PG8_STAGE(PG8_SB(0, 1), b2 + hstep, voffA);
            PG8_WAIT_V(6); PG8_BAR; PG8_MMA(1, 1, At, B1); PG8_BAR;
            PG8_LDB(B0, 1, 0); PG8_SCHED; PG8_LDA(At, 1, 0); PG8_STAGE(PG8_SA(0, 1), a2 + hstep, voffA);
            PG8_WAIT_L(8); PG8_BAR; PG8_WAIT_L(0); PG8_MMA(0, 0, At, B0); PG8_BAR; PG8_SCHED;
            PG8_LDB(B1, 1, 1); PG8_STAGE(PG8_SB(1, 0), b3, voffA);
            PG8_BAR; PG8_WAIT_L(0); PG8_MMA(0, 1, At, B1); PG8_BAR;
            PG8_LDA(At, 1, 1); PG8_STAGE(PG8_SA(1, 0), a3, voffA);
            PG8_BAR; PG8_WAIT_L(0); PG8_MMA(1, 0, At, B0); PG8_BAR; PG8_SCHED;
            PG8_STAGE(PG8_SB(1, 1), b3 + hstep, voffA);
            PG8_WAIT_V(6); PG8_BAR; PG8_MMA(1, 1, At, B1); PG8_BAR;
        }
        E(acc, cur, wr, wc, fr, fq);
        if (!has_next) break;
#pragma unroll
        for (int a = 0; a < 2; ++a)
#pragma unroll
            for (int b = 0; b < 2; ++b)
#pragma unroll
                for (int m = 0; m < 4; ++m)
#pragma unroll
                    for (int n = 0; n < 2; ++n) acc[a][b][m][n] = (f32x4){0.f, 0.f, 0.f, 0.f};
        cur = nxt; cA = nA; cB = nB; ++ui;
    }
    PG8_WAIT_V(0);
    if (wr == 0) PG8_BAR;
    PG8_BAR;
#undef PG8_SA
#undef PG8_SB
#undef PG8_STAGE
#undef PG8_LDA
#undef PG8_LDB
#undef PG8_MMA
#undef PG8_WAIT_V
#undef PG8_WAIT_L
#undef PG8_BAR
#undef PG8_SCHED
}
template <class Pol, class Epi>
__device__ __forceinline__ void gemm_phase2(PG8_LAS unsigned char* lds, const Pol& P, const Epi& E) {
    const int tid = threadIdx.x, wid = __builtin_amdgcn_readfirstlane(tid >> 6), lane = tid & 63, wr = wid >> 2, wc = wid & 3, fr = lane & 15, fq = lane >> 4;
    const int nt = P.nk();
    const unsigned ldsw = (unsigned)wid * 1024u;
    const int aoff = lds_byte(wr * 64 + fr, fq * 8), boff = lds_byte(wc * 32 + fr, fq * 8);
#define PG8_SA(b, h) (((b) * 2 + (h)) * HTB)
#define PG8_SB(b, h) ((4 + (b) * 2 + (h)) * HTB)
#define PG8_STAGE_A(bufoff, AS, h, kt) do { _Pragma("unroll") for (int _i = 0; _i < 2; ++_i) \
        __builtin_amdgcn_global_load_lds((const unsigned*)P.pa(AS, h, _i, kt), (PG8_LAS unsigned*)(lds + (bufoff) + ldsw + _i * 8192), 16, 0, 0); } while (0)
#define PG8_STAGE_B(bufoff, BS, h, kt) do { _Pragma("unroll") for (int _i = 0; _i < 2; ++_i) \
        __builtin_amdgcn_global_load_lds((const unsigned*)P.pb(BS, h, _i, kt), (PG8_LAS unsigned*)(lds + (bufoff) + ldsw + _i * 8192), 16, 0, 0); } while (0)
#define PG8_LDA(dst, b, h) do { _Pragma("unroll") for (int m = 0; m < 4; ++m) _Pragma("unroll") for (int k = 0; k < 2; ++k) dst[m][k] = *(const PG8_LAS bf16x8*)(lds + PG8_SA(b, h) + aoff + m * 2048 + k * 1024); } while (0)
#define PG8_LDB(dst, b, h) do { _Pragma("unroll") for (int n = 0; n < 2; ++n) _Pragma("unroll") for (int k = 0; k < 2; ++k) dst[n][k] = *(const PG8_LAS bf16x8*)(lds + PG8_SB(b, h) + boff + n * 2048 + k * 1024); } while (0)
#define PG8_MMA(ai, bj, At, Bt) do { __builtin_amdgcn_s_setprio(1); _Pragma("unroll") for (int m = 0; m < 4; ++m) _Pragma("unroll") for (int n = 0; n < 2; ++n) _Pragma("unroll") for (int k = 0; k < 2; ++k) \
        acc[ai][bj][m][n] = __builtin_amdgcn_mfma_f32_16x16x32_bf16(Bt[n][k], At[m][k], acc[ai][bj][m][n], 0, 0, 0); __builtin_amdgcn_s_setprio(0); } while (0)
#define PG8_STAGE_A2(bufoff, h, kt) do { _Pragma("unroll") for (int _i = 0; _i < 2; ++_i) \
        __builtin_amdgcn_global_load_lds((const unsigned*)P.pa(a2, h, _i, kt), (PG8_LAS unsigned*)(lds + (bufoff) + ldsw + _i * 8192), 16, 0, 0); } while (0)
#define PG8_STAGE_B2(bufoff, h, kt) do { _Pragma("unroll") for (int _i = 0; _i < 2; ++_i) \
        __builtin_amdgcn_global_load_lds((const unsigned*)P.pb(b2, h, _i, kt), (PG8_LAS unsigned*)(lds + (bufoff) + ldsw + _i * 8192), 16, 0, 0); } while (0)
#define PG8_WAIT_V(n) asm volatile("s_waitcnt vmcnt(" #n ")" ::: "memory")
#define PG8_WAIT_L(n) asm volatile("s_waitcnt lgkmcnt(" #n ")" ::: "memory")
#define PG8_BAR __builtin_amdgcn_s_barrier()
#define PG8_SCHED __builtin_amdgcn_sched_barrier(0)
    typename Pol::Unit cur, nxt; int ui = 0;
    if (!P.next(0, cur)) return;
    f32x4 acc[2][2][4][2];
#pragma unroll
    for (int a = 0; a < 2; ++a)
#pragma unroll
        for (int b = 0; b < 2; ++b)
#pragma unroll
            for (int m = 0; m < 4; ++m)
#pragma unroll
                for (int n = 0; n < 2; ++n) acc[a][b][m][n] = (f32x4){0.f, 0.f, 0.f, 0.f};
    bf16x8 At[4][2], B0[2][2], B1[2][2];
    typename Pol::AddrA aC, aN; typename Pol::AddrB bC, bN;
    P.addrA(cur, aC); P.addrB(cur, bC);
    PG8_STAGE_B(PG8_SB(0, 0), bC, 0, 0); PG8_STAGE_A(PG8_SA(0, 0), aC, 0, 0); PG8_STAGE_B(PG8_SB(0, 1), bC, 1, 0); PG8_STAGE_A(PG8_SA(0, 1), aC, 1, 0);
    if (wr == 1) PG8_BAR;
    PG8_WAIT_V(4); PG8_BAR;
    PG8_STAGE_B(PG8_SB(1, 0), bC, 0, 1); PG8_STAGE_A(PG8_SA(1, 0), aC, 0, 1); PG8_STAGE_B(PG8_SB(1, 1), bC, 1, 1);
    PG8_WAIT_V(6); PG8_BAR;
    for (;;) {
        const bool has_next = P.next(ui + 1, nxt);
        if (has_next) { P.addrA(nxt, aN); P.addrB(nxt, bN); } else { aN = aC; bN = bC; }
        const bool full = P.full(cur);
        for (int t = 0; t < nt; t += 2) {
            const bool last = (t == nt - 2);
            const typename Pol::AddrA a2 = last ? aN : aC; const typename Pol::AddrB b2 = last ? bN : bC;
            const int k2 = last ? 0 : t + 2, k3 = k2 + 1;
            PG8_LDB(B0, 0, 0); PG8_SCHED; PG8_LDA(At, 0, 0); PG8_STAGE_A(PG8_SA(1, 1), aC, 1, t + 1);
            PG8_WAIT_L(8); PG8_BAR; PG8_WAIT_L(0); PG8_MMA(0, 0, At, B0); PG8_BAR; PG8_SCHED;
            PG8_LDB(B1, 0, 1); PG8_STAGE_B2(PG8_SB(0, 0), 0, k2);
            PG8_BAR; PG8_WAIT_L(0); PG8_MMA(0, 1, At, B1); PG8_BAR;
            PG8_LDA(At, 0, 1); PG8_STAGE_A2(PG8_SA(0, 0), 0, k2);
            PG8_BAR; PG8_WAIT_L(0); if (full) PG8_MMA(1, 0, At, B0); PG8_BAR; PG8_SCHED;
            PG8_STAGE_B2(PG8_SB(0, 1), 1, k2);
            PG8_WAIT_V(6); PG8_BAR; if (full) PG8_MMA(1, 1, At, B1); PG8_BAR;
            PG8_LDB(B0, 1, 0); PG8_SCHED; PG8_LDA(At, 1, 0); PG8_STAGE_A2(PG8_SA(0, 1), 1, k2);
            PG8_WAIT_L(8); PG8_BAR; PG8_WAIT_L(0); PG8_MMA(0, 0, At, B0); PG8_BAR; PG8_SCHED;
            PG8_LDB(B1, 1, 1); PG8_STAGE_B2(PG8_SB(1, 0), 0, k3);
            PG8_BAR; PG8_WAIT_L(0); PG8_MMA(0, 1, At, B1); PG8_BAR;
            PG8_LDA(At, 1, 1); PG8_STAGE_A2(PG8_SA(1, 0), 0, k3);
            PG8_BAR; PG8_WAIT_L(0); if (full) PG8_MMA(1, 0, At, B0); PG8_BAR; PG8_SCHED;
            PG8_STAGE_B2(PG8_SB(1, 1), 1, k3);
            PG8_WAIT_V(6); PG8_BAR; if (full) PG8_MMA(1, 1, At, B1); PG8_BAR;
        }
        E(acc, cur, wr, wc, fr, fq);
        if (!has_next) break;
#pragma unroll
        for (int a = 0; a < 2; ++a)
#pragma unroll
            for (int b = 0; b < 2; ++b)
#pragma unroll
                for (int m = 0; m < 4; ++m)
#pragma unroll
                    for (int n = 0; n < 2; ++n) acc[a][b][m][n] = (f32x4){0.f, 0.f, 0.f, 0.f};
        cur = nxt; aC = aN; bC = bN; ++ui;
    }
    PG8_WAIT_V(0);
    if (wr == 0) PG8_BAR;
    PG8_BAR;
#undef PG8_SA
#undef PG8_SB
#undef PG8_STAGE_A
#undef PG8_STAGE_B
#undef PG8_STAGE_A2
#undef PG8_STAGE_B2
#undef PG8_LDA
#undef PG8_LDB
#undef PG8_MMA
#undef PG8_WAIT_V
#undef PG8_WAIT_L
#undef PG8_BAR
#undef PG8_SCHED
}
__host__ __device__ __forceinline__ int perm_lo(int x) { return (((x >> 2) & 3) << 3) | (((x >> 4) & 1) << 2) | (x & 3); }
__host__ __device__ __forceinline__ int inv_perm_lo(int y) { return (((y >> 2) & 1) << 4) | (((y >> 3) & 3) << 2) | (y & 3); }
__host__ __device__ __forceinline__ int logcol(int p) { return (p & ~255) + 64 * ((p >> 5) & 3) + 32 * ((p >> 7) & 1) + perm_lo(p & 31); }
}

template <class SRC>
DEV void convert_tile(float* tl, const SRC& src, bf16_t* dst, int ldd, int n0, int k0) {
    const int tid = threadIdx.x;
    {
        const int n = tid & 63;
#pragma unroll
        for (int i = 0; i < 8; ++i) { const int kk = (tid >> 6) + 8 * i; tl[kk * 65 + n] = src.get(n0 + n, k0 + kk); }
    }
    __syncthreads();
    {
        const int n = tid >> 3, kc = tid & 7;
        const float* s = tl + (kc * 8) * 65 + n;
        u32x4 o;
        o.x = pk2(s[0 * 65], s[1 * 65]); o.y = pk2(s[2 * 65], s[3 * 65]); o.z = pk2(s[4 * 65], s[5 * 65]); o.w = pk2(s[6 * 65], s[7 * 65]);
        *(u32x4*)(dst + (size_t)(n0 + n) * ldd + k0 + kc * 8) = o;
    }
    __syncthreads();
}
struct SrcWin { const float* w; const float* g;
    DEV float get(int np, int k) const { const int n = pg8::logcol(np); int col; if (n < 1280) col = n; else if (n < 3328) col = n + 24; else if (n < 3352) col = 1280 + (n - 3328); else return 0.f;
        return w[(size_t)k * IN_COLS + col] * g[k]; } };
struct SrcWout { const float* w; const float* g;
    DEV float get(int np, int k) const { const int n = pg8::logcol(np); const float v = w[(size_t)k * DM + n]; return k < 512 ? v * g[k] : v; } };
struct SrcPlain { const float* w; int ld;
    DEV float get(int n, int k) const { return w[(size_t)k * ld + n]; } };
struct SrcW13 { const float* w1; const float* w3; const float* g;
    DEV float get(int n, int k) const { const uintptr_t a = (uintptr_t)w1, b = (uintptr_t)w3; const float* w = (const float*)(a + ((b - a) & (uintptr_t)(0 - (long long)(n & 1))));
        return w[(size_t)k * 512 + (n >> 1)] * g[k]; } };

template <class SRC>
DEV void convert_tile256(float* tl, const SRC& src, bf16_t* dst, int ldd, int n0, int k0) {
    const int tid = threadIdx.x;
    {
        const int q = tid & 63;
        f32x4 v[8];
#pragma unroll
        for (int i = 0; i < 8; ++i) v[i] = src.quad(n0, q, k0 + (tid >> 6) + 8 * i);
#pragma unroll
        for (int i = 0; i < 8; ++i) { float* o = tl + ((tid >> 6) + 8 * i) * 257; o[src.drow(q, 0)] = v[i].x; o[src.drow(q, 1)] = v[i].y; o[src.drow(q, 2)] = v[i].z; o[src.drow(q, 3)] = v[i].w; }
    }
    __syncthreads();
#pragma unroll
    for (int i = 0; i < 4; ++i) {
        const int idx = tid + NT * i, n = idx >> 3, kc = idx & 7;
        const float* s = tl + (kc * 8) * 257 + n;
        u32x4 o;
        o.x = pk2(s[0 * 257], s[1 * 257]); o.y = pk2(s[2 * 257], s[3 * 257]); o.z = pk2(s[4 * 257], s[5 * 257]); o.w = pk2(s[6 * 257], s[7 * 257]);
        *(u32x4*)(dst + (size_t)(n0 + n) * ldd + k0 + kc * 8) = o;
    }
    __syncthreads();
}
struct SrcWin4 { const float* w; const float* g;
    DEV int drow(int q, int e) const { return 4 * q + e; }
    DEV f32x4 quad(int n0, int q, int k) const { const int n = pg8::logcol(n0 + 4 * q); int col; if (n < 1280) col = n; else if (n < 3328) col = n + 24; else if (n < 3352) col = 1280 + (n - 3328); else return (f32x4){0.f, 0.f, 0.f, 0.f};
        return *(const f32x4*)(w + (size_t)k * IN_COLS + col) * g[k]; } };
struct SrcWout4 { const float* w; const float* g;
    DEV int drow(int q, int e) const { return 4 * q + e; }
    DEV f32x4 quad(int n0, int q, int k) const { const f32x4 v = *(const f32x4*)(w + (size_t)k * DM + pg8::logcol(n0 + 4 * q)); return k < 512 ? v * g[k] : v; } };
struct SrcPlain4 { const float* w; int ld;
    DEV int drow(int q, int e) const { return 4 * q + e; }
    DEV f32x4 quad(int n0, int q, int k) const { return *(const f32x4*)(w + (size_t)k * ld + n0 + 4 * q); } };
struct SrcW13_4 { const float* w1; const float* w3; const float* g;
    DEV int drow(int q, int e) const { const int l = 8 * (q & 31) + 2 * e + (q >> 5); return (l & ~31) | pg8::inv_perm_lo(l & 31); }
    DEV f32x4 quad(int n0, int q, int k) const { const uintptr_t a = (uintptr_t)w1, b = (uintptr_t)w3; const float* w = (const float*)(a + ((b - a) & (uintptr_t)(0 - (long long)(q >> 5))));
        return *(const f32x4*)(w + (size_t)k * 512 + (n0 >> 1) + 4 * (q & 31)) * g[k]; } };

DEV void phase_prologue(const Params& p, unsigned char* lds) {
    float* tl = (float*)lds;
    const int tid = threadIdx.x, lane = tid & 63, wid = tid >> 6;
    const int vb = vblock(), G = gridDim.x;
    unsigned char* ws = p.ws;
    constexpr int I_WIN = (INP / 256) * (DM / 64);
    constexpr int I_WOUT = 4 * 16;
    constexpr int I_CW1 = 2 * 32;
    constexpr int I_W2 = 32 * 4 * 8;
    constexpr int I_CW2 = 2 * 1 * 4;
    constexpr int I_ALL = I_WIN + I_WOUT + I_CW1 + I_W2 + I_CW2;
    for (int it = vb; it < I_ALL; it += G) {
        int r = it;
        if (r < I_WIN) { SrcWin4 s{p.w_in, p.attn_g}; convert_tile256(tl, s, (bf16_t*)(ws + WS_WINT), DM, (r / 16) * 256, (r % 16) * 64); continue; } r -= I_WIN;
        if (r < I_WOUT) { SrcWout4 s{p.w_out, p.g_nsa}; convert_tile256(tl, s, (bf16_t*)(ws + WS_WOUTT), DM, (r / 16) * 256, (r % 16) * 64); continue; } r -= I_WOUT;
        if (r < I_CW1) { const int z = r / 32, q = r % 32; SrcPlain4 s{z ? p.wv1 : p.wk1, 256};
            convert_tile256(tl, s, (bf16_t*)(ws + WS_CW1T) + (size_t)z * 256 * 2048, 2048, 0, q * 64); continue; } r -= I_CW1;
        if (r < I_W2) { const int e = r / 32, q = r % 32; SrcPlain4 s{p.w2 + (size_t)e * 512 * 1024, 1024};
            convert_tile256(tl, s, (bf16_t*)(ws + WS_W2T) + (size_t)e * 1024 * 512, 512, (q / 8) * 256, (q % 8) * 64); continue; } r -= I_W2;
        { const int z = r / 4, q = r % 4; SrcPlain s{z ? p.wv2 : p.wk2, 64};
            convert_tile(tl, s, (bf16_t*)(ws + WS_CW2T) + (size_t)z * 64 * 256, 256, 0, q * 64); }
    }
    {
        bf16_t* xb = (bf16_t*)(ws + WS_R1); float* rstd1 = (float*)(ws + WS_RSTD1);
        const int gw = vb * 8 + wid, NGW = G * 8;
        for (int m = gw; m < NTOK; m += NGW) {
            const f32x4* xr = (const f32x4*)(p.x + (size_t)m * DM) + lane;
            f32x4 v[4]; float s = 0.f;
#pragma unroll
            for (int j = 0; j < 4; ++j) { v[j] = xr[64 * j]; s += (v[j].x * v[j].x + v[j].y * v[j].y) + (v[j].z * v[j].z + v[j].w * v[j].w); }
            s = wave_sum(s);
            if (lane == 0) rstd1[m] = rsqrtf(s * (1.f / DM) + RMS_EPS);
            u32x2* o = (u32x2*)(xb + (size_t)m * DM) + lane;
#pragma unroll
            for (int j = 0; j < 4; ++j) { u32x2 w; w.x = pk2(v[j].x, v[j].y); w.y = pk2(v[j].z, v[j].w); o[64 * j] = w; }
        }
    }
    {
        const int gt = vb * NT + tid, NG = G * NT;
        float* rowss = (float*)(ws + WS_ROWSS);
        for (int i = gt; i < NTOK; i += NG) rowss[i] = 0.f;
        int* bincnt = (int*)(ws + WS_CTL);
        if (gt < 128) bincnt[gt] = 0;
        if (gt < 32) ((int*)(ws + WS_CTL + 512))[gt] = 0;
        if (gt < 512) { const float l0 = p.lb_logits[gt], l1 = p.lb_logits[512 + gt]; ((float*)(ws + WS_LB))[gt] = 1.f / (1.f + __expf(l1 - l0)); }
        for (int i = gt; i < 48 * 1024; i += NG) { const int c = i >> 10, k = i & 1023;
            const float w = (c < 4 ? p.w_group[k * 4 + c] : (c < 36 ? p.w_expert[k * 32 + (c - 4)] : 0.f)) * p.ffn_g[k];
            const bf16_t hi = f2bf(w); const bf16_t lo = f2bf(w - bf2f(hi));
            ((bf16_t*)(ws + WS_RW))[i] = hi; ((bf16_t*)(ws + WS_RW))[48 * 1024 + i] = lo; }
        if (blockIdx.x == (unsigned)(G - 1)) {
            const int z = tid >> 8, j = tid & 255; const float* pos = z ? p.pos_v : p.pos_k; const float* w = z ? p.wv1 : p.wk1;
            float a = 0.f;
            for (int k = 0; k < 2048; ++k) a += pos[k] * w[(size_t)k * 256 + j];
            ((float*)(ws + WS_CBIAS))[z * 256 + j] = a;
        }
    }
}

constexpr int G_A_BYTES = 128 * 128, G_B_BYTES = 256 * 128, G_STAGE = G_A_BYTES + G_B_BYTES, G_LDS = 2 * G_STAGE;
DEV int swz(int row, int chunk) { return row * 128 + ((chunk ^ ((row >> 1) & 7)) << 4); }
template <class AL, class BL, class EP>
DEV void gemm_tile(unsigned char* lds, const AL& al, const BL& bl, int nk, const EP& ep) {
    const int tid = threadIdx.x, lane = tid & 63, wid = tid >> 6, wr = wid >> 2, wc = wid & 3;
    const int frow = lane & 15, fq = lane >> 4;
    const bf16_t* aptr[2]; int aoff[2], boff[4], brow[4];
#pragma unroll
    for (int i = 0; i < 2; ++i) { const int q = tid + NT * i, row = q >> 3, ch = q & 7; aptr[i] = al.row(row) + ch * 8; aoff[i] = swz(row, ch); }
#pragma unroll
    for (int i = 0; i < 4; ++i) { const int q = tid + NT * i, row = q >> 3, ch = q & 7; brow[i] = row; boff[i] = G_A_BYTES + swz(row, ch) ; }
    const int bch8 = (tid & 7) * 8;
    u32x4 ra[2], rb[4];
#pragma unroll
    for (int i = 0; i < 2; ++i) ra[i] = *(const u32x4*)(aptr[i]);
#pragma unroll
    for (int i = 0; i < 4; ++i) rb[i] = *(const u32x4*)(bl.ptr(brow[i], 0) + bch8);
#pragma unroll
    for (int i = 0; i < 2; ++i) *(u32x4*)(lds + aoff[i]) = ra[i];
#pragma unroll
    for (int i = 0; i < 4; ++i) *(u32x4*)(lds + boff[i]) = rb[i];
    __syncthreads();
    f32x4 acc[4][4];
#pragma unroll
    for (int m = 0; m < 4; ++m)
#pragma unroll
        for (int n = 0; n < 4; ++n) acc[m][n] = (f32x4){0.f, 0.f, 0.f, 0.f};
    const int sx = (frow >> 1) & 7;
    for (int kt = 0; kt < nk; ++kt) {
        const bool more = (kt + 1 < nk);
        if (more) {
#pragma unroll
            for (int i = 0; i < 2; ++i) ra[i] = *(const u32x4*)(aptr[i] + (kt + 1) * 64);
#pragma unroll
            for (int i = 0; i < 4; ++i) rb[i] = *(const u32x4*)(bl.ptr(brow[i], kt + 1) + bch8);
        }
        const unsigned char* base = lds + (kt & 1) * G_STAGE;
#pragma unroll
        for (int ks = 0; ks < 2; ++ks) {
            const int co = ((ks * 4 + fq) ^ sx) << 4;
            bf16x8 af[4], bfr[4];
#pragma unroll
            for (int m = 0; m < 4; ++m) af[m] = *(const bf16x8*)(base + (wr * 64 + m * 16 + frow) * 128 + co);
#pragma unroll
            for (int n = 0; n < 4; ++n) bfr[n] = *(const bf16x8*)(base + G_A_BYTES + (wc * 64 + n * 16 + frow) * 128 + co);
#pragma unroll
            for (int m = 0; m < 4; ++m)
#pragma unroll
                for (int n = 0; n < 4; ++n) acc[m][n] = __builtin_amdgcn_mfma_f32_16x16x32_bf16(bfr[n], af[m], acc[m][n], 0, 0, 0);
        }
        if (more) {
            unsigned char* nb = lds + ((kt + 1) & 1) * G_STAGE;
#pragma unroll
            for (int i = 0; i < 2; ++i) *(u32x4*)(nb + aoff[i]) = ra[i];
#pragma unroll
            for (int i = 0; i < 4; ++i) *(u32x4*)(nb + boff[i]) = rb[i];
        }
        __syncthreads();
    }
    ep(acc, wr, wc, lane);
}

struct ARows { const bf16_t* base; size_t ld; DEV const bf16_t* row(int r) const { return base + (size_t)r * ld; } };
struct BRows { const bf16_t* base; size_t ld; DEV const bf16_t* ptr(int n, int kt) const { return base + (size_t)n * ld + kt * 64; } };

DEV u32x4 pk8(const f32x4 a, const f32x4 b) { u32x4 w; w.x = pk2(a.x, a.y); w.y = pk2(a.z, a.w); w.z = pk2(b.x, b.y); w.w = pk2(b.z, b.w); return w; }
struct EpiInproj8 { const Params& p; static constexpr bool MIDSCALE = false; DEV float rowscale(int) const { return 1.f; } DEV int midk() const { return -1; }
    DEV void operator()(const f32x4 (&acc)[2][2][4][2], const pg8::Unit& u, int wr, int wc, int fr, int fq) const {
        const int seg = u.pn * 4 + wc;
        if (seg > 52) return;
        unsigned char* ws = p.ws;
        const int row0 = u.pm * 256 + wr * 64 + fr;
        const int b = row0 >> 12, s0 = row0 & 4095;
        float rs[2][4];
#pragma unroll
        for (int ai = 0; ai < 2; ++ai)
#pragma unroll
            for (int m = 0; m < 4; ++m) rs[ai][m] = ((const float*)(ws + WS_RSTD1))[row0 + 128 * ai + 16 * m];
        const bool is_q = seg < 8, is_ks = (seg == 12 || seg == 13), is_kw = (seg == 16 || seg == 17);
        if (is_q || is_ks || is_kw) {
            const float* gw = (is_q ? p.g_q : (is_ks ? p.g_k + 64 : p.g_k + 128)) + 8 * fq;
            const f32x4 g00 = *(const f32x4*)(gw), g01 = *(const f32x4*)(gw + 4), g10 = *(const f32x4*)(gw + 32), g11 = *(const f32x4*)(gw + 36);
            bf16_t* dst; int hh, nh;
            if (is_q) { dst = (bf16_t*)(ws + WS_Q); hh = seg; nh = 8; } else if (is_ks) { dst = (bf16_t*)(ws + WS_KS); hh = seg - 12; nh = 2; } else { dst = (bf16_t*)(ws + WS_KW); hh = seg - 16; nh = 2; }
            bf16_t* o0 = dst + ((size_t)(b * nh + hh) * SEQ + s0) * 64 + fq * 8;
            const float qs = is_q ? QSCALE : 1.f;
#pragma unroll
            for (int ai = 0; ai < 2; ++ai)
#pragma unroll
                for (int m = 0; m < 4; ++m) {
                    const f32x4 a0 = acc[ai][0][m][0], a1 = acc[ai][0][m][1], a2 = acc[ai][1][m][0], a3 = acc[ai][1][m][1];
                    float ss = ((a0.x * a0.x + a0.y * a0.y) + (a0.z * a0.z + a0.w * a0.w)) + ((a1.x * a1.x + a1.y * a1.y) + (a1.z * a1.z + a1.w * a1.w))
                             + ((a2.x * a2.x + a2.y * a2.y) + (a2.z * a2.z + a2.w * a2.w)) + ((a3.x * a3.x + a3.y * a3.y) + (a3.z * a3.z + a3.w * a3.w));
                    ss += __shfl_xor(ss, 16); ss += __shfl_xor(ss, 32);
                    const float rr = rs[ai][m];
                    const float r = rr * rsqrtf(ss * rr * rr * (1.f / 64.f) + RMS_EPS) * qs;
                    bf16_t* o = o0 + (size_t)(128 * ai + 16 * m) * 64;
                    *(u32x4*)(o) = pk8(a0 * g00 * r, a1 * g01 * r); *(u32x4*)(o + 32) = pk8(a2 * g10 * r, a3 * g11 * r);
                }
            return;
        }
        if (seg >= 8 && seg < 12) {
            bf16_t* o0 = (bf16_t*)(ws + (seg < 10 ? WS_KC : WS_VC)) + ((size_t)(b * 2 + (seg & 1)) * SEQ + s0) * 64 + fq * 8;
#pragma unroll
            for (int ai = 0; ai < 2; ++ai)
#pragma unroll
                for (int m = 0; m < 4; ++m) { const float r = rs[ai][m]; bf16_t* o = o0 + (size_t)(128 * ai + 16 * m) * 64;
                    *(u32x4*)(o) = pk8(acc[ai][0][m][0] * r, acc[ai][0][m][1] * r); *(u32x4*)(o + 32) = pk8(acc[ai][1][m][0] * r, acc[ai][1][m][1] * r); }
            return;
        }
        if (seg == 14 || seg == 15 || seg == 18 || seg == 19) {
            bf16_t* o0 = (bf16_t*)(ws + (seg < 16 ? WS_VST : WS_VWT)) + (size_t)(b * 2 + (seg & 1)) * 64 * SEQ + s0;
#pragma unroll
            for (int ai = 0; ai < 2; ++ai)
#pragma unroll
                for (int m = 0; m < 4; ++m) { const float r = rs[ai][m]; bf16_t* o = o0 + 128 * ai + 16 * m;
#pragma unroll
                    for (int bj = 0; bj < 2; ++bj)
#pragma unroll
                        for (int n = 0; n < 2; ++n) { const int d = 32 * bj + 8 * fq + 4 * n; const f32x4 x = acc[ai][bj][m][n] * r;
                            o[(size_t)(d + 0) * SEQ] = f2bf(x.x); o[(size_t)(d + 1) * SEQ] = f2bf(x.y); o[(size_t)(d + 2) * SEQ] = f2bf(x.z); o[(size_t)(d + 3) * SEQ] = f2bf(x.w); } }
            return;
        }
        if (seg < 52) {
            const int kind = (seg - 20) >> 3, cb = ((seg - 20) & 7) * 64 + fq * 8;
            if (kind == 1) {
                const float* lb = (const float*)(ws + WS_LB) + cb;
                const f32x4 l00 = *(const f32x4*)(lb), l01 = *(const f32x4*)(lb + 4), l10 = *(const f32x4*)(lb + 32), l11 = *(const f32x4*)(lb + 36);
                bf16_t* o0 = (bf16_t*)(ws + WS_HLOGF) + (size_t)row0 * 512 + cb;
#define LOGF4(L_, X_) (f32x4){__logf(L_.x + (1.f - L_.x) * sigmoidf_(X_.x)), __logf(L_.y + (1.f - L_.y) * sigmoidf_(X_.y)), __logf(L_.z + (1.f - L_.z) * sigmoidf_(X_.z)), __logf(L_.w + (1.f - L_.w) * sigmoidf_(X_.w))}
#pragma unroll
                for (int ai = 0; ai < 2; ++ai)
#pragma unroll
                    for (int m = 0; m < 4; ++m) { const float r = rs[ai][m]; bf16_t* o = o0 + (size_t)(128 * ai + 16 * m) * 512;
                        const f32x4 x0 = acc[ai][0][m][0] * r, x1 = acc[ai][0][m][1] * r, x2 = acc[ai][1][m][0] * r, x3 = acc[ai][1][m][1] * r;
                        *(u32x4*)(o) = pk8(LOGF4(l00, x0), LOGF4(l01, x1)); *(u32x4*)(o + 32) = pk8(LOGF4(l10, x2), LOGF4(l11, x3)); }
#undef LOGF4
            } else {
                bf16_t* o0 = (bf16_t*)(ws + (kind == 0 ? WS_HQ : (kind == 2 ? WS_HV : WS_HG))) + (size_t)row0 * 512 + cb;
#define SILU4(X_) (f32x4){siluf_(X_.x), siluf_(X_.y), siluf_(X_.z), siluf_(X_.w)}
#pragma unroll
                for (int ai = 0; ai < 2; ++ai)
#pragma unroll
                    for (int m = 0; m < 4; ++m) { const float r = rs[ai][m]; bf16_t* o = o0 + (size_t)(128 * ai + 16 * m) * 512;
                        f32x4 x0 = acc[ai][0][m][0] * r, x1 = acc[ai][0][m][1] * r, x2 = acc[ai][1][m][0] * r, x3 = acc[ai][1][m][1] * r;
                        if (kind != 2) { x0 = SILU4(x0); x1 = SILU4(x1); x2 = SILU4(x2); x3 = SILU4(x3); }
                        *(u32x4*)(o) = pk8(x0, x1); *(u32x4*)(o + 32) = pk8(x2, x3); }
#undef SILU4
            }
            return;
        }
        if (fq < 3) {
            float* o0 = (float*)(ws + WS_GATES) + (size_t)row0 * 24 + 8 * fq;
#pragma unroll
            for (int ai = 0; ai < 2; ++ai)
#pragma unroll
                for (int m = 0; m < 4; ++m) { const float r = rs[ai][m]; float* o = o0 + (size_t)(128 * ai + 16 * m) * 24;
#pragma unroll
                    for (int n = 0; n < 2; ++n) { const f32x4 x = acc[ai][0][m][n] * r; *(f32x4*)(o + 4 * n) = (f32x4){sigmoidf_(x.x), sigmoidf_(x.y), sigmoidf_(x.z), sigmoidf_(x.w)}; } }
        }
    } };
DEV void phase_inproj(const Params& p, unsigned char* lds) {
    pg8::Gemm g{(const bf16_t*)(p.ws + WS_R1), (const bf16_t*)(p.ws + WS_WINT), NTOK, INP, DM};
    pg8::StaticOrder S; S.init(NTOK, INP, (int)gridDim.x, (int)blockIdx.x);
    EpiInproj8 E{p};
    pg8::gemm_phase(( PG8_LAS unsigned char*)lds, g, S, E);
}

struct ACmp { const bf16_t* src; int bg, c0;
    DEV const bf16_t* row(int r) const { int c = c0 + r; if (c > NC - 1) c = NC - 1; return src + ((size_t)bg * SEQ + 16 * c) * 64; } };
struct EpiCmpA { const Params& p; int z, rbase;
    DEV void operator()(f32x4 (&acc)[4][4], int wr, int wc, int lane) const {
        const int frow = lane & 15, fq = lane >> 4;
        const float* cb = (const float*)(p.ws + WS_CBIAS) + z * 256; bf16_t* hid = (bf16_t*)(p.ws + WS_HID) + (size_t)z * 4096 * 256;
#pragma unroll
        for (int m = 0; m < 4; ++m) { const int rr = rbase + wr * 64 + m * 16 + frow;
#pragma unroll
            for (int n = 0; n < 4; ++n) { const int c = wc * 64 + n * 16 + fq * 4; const f32x4 b = *(const f32x4*)(cb + c); f32x4 v = acc[m][n] + b;
                u32x2 w; w.x = pk2(siluf_(v.x), siluf_(v.y)); w.y = pk2(siluf_(v.z), siluf_(v.w)); *(u32x2*)(hid + (size_t)rr * 256 + c) = w; } }
    } };
DEV void phase_cmp_a(const Params& p, unsigned char* lds) {
    const int vb = vblock(), G = gridDim.x;
    for (int u = vb; u < 64; u += G) {
        const int z = u >> 5, rbase = (u & 31) * 128;
        ACmp al{(const bf16_t*)(p.ws + (z ? WS_VC : WS_KC)), (u & 31) >> 1, (u & 1) * 128};
        BRows bl{(const bf16_t*)(p.ws + WS_CW1T) + (size_t)z * 256 * 2048, 2048};
        EpiCmpA ep{p, z, rbase};
        gemm_tile(lds, al, bl, 2048 / 64, ep);
    }
}
struct BClamp64 { const bf16_t* base; size_t ld; DEV const bf16_t* ptr(int n, int kt) const { return base + (size_t)(n & 63) * ld + kt * 64; } };
struct EpiCmpB { const Params& p; int z, rbase;
    DEV void operator()(f32x4 (&acc)[4][4], int wr, int wc, int lane) const {
        if (wc != 0) return;
        const int frow = lane & 15, fq = lane >> 4;
        bf16_t* dst = (bf16_t*)(p.ws + (z ? WS_VCMP : WS_KCMP));
#pragma unroll
        for (int m = 0; m < 4; ++m) { const int rr = rbase + wr * 64 + m * 16 + frow;
            float r = 1.f;
            if (z == 0) { float ss = 0.f;
#pragma unroll
                for (int n = 0; n < 4; ++n) { const f32x4 v = acc[m][n]; ss += (v.x * v.x + v.y * v.y) + (v.z * v.z + v.w * v.w); }
                ss += __shfl_xor(ss, 16); ss += __shfl_xor(ss, 32); r = rsqrtf(ss * (1.f / 64.f) + RMS_EPS); }
            const int bg = rr >> 8, c = rr & 255;
            if (c < NC) {
#pragma unroll
                for (int n = 0; n < 4; ++n) { const int d = n * 16 + fq * 4; f32x4 v = acc[m][n] * r;
                    if (z == 0) { const f32x4 g = *(const f32x4*)(p.g_k + d); v = v * g;
                        u32x2 w; w.x = pk2(v.x, v.y); w.y = pk2(v.z, v.w); *(u32x2*)(dst + ((size_t)bg * 256 + c) * 64 + d) = w; }
                    else { bf16_t* o = dst + ((size_t)bg * 64 + d) * 256 + c; o[0] = f2bf(v.x); o[256] = f2bf(v.y); o[512] = f2bf(v.z); o[768] = f2bf(v.w); } } }
        }
    } };
DEV void phase_cmp_b(const Params& p, unsigned char* lds) {
    const int vb = vblock(), G = gridDim.x;
    for (int u = vb; u < 64; u += G) {
        const int z = u >> 5, rbase = (u & 31) * 128;
        ARows al{(const bf16_t*)(p.ws + WS_HID) + ((size_t)z * 4096 + rbase) * 256, 256};
        BClamp64 bl{(const bf16_t*)(p.ws + WS_CW2T) + (size_t)z * 64 * 256, 256};
        EpiCmpB ep{p, z, rbase};
        gemm_tile(lds, al, bl, 256 / 64, ep);
    }
}

constexpr int CM_K = 0, CM_V = 32768, CM_VSTR = 520, CM_IMP = CM_V + 64 * CM_VSTR, CM_LDS = CM_IMP + 4 * 16384 + 1024;
DEV void cm_scores(const unsigned char* kbase, int kt, const bf16x8 (&qf)[4], int r31, int hh, f32x16 (&sacc)[2]) {
#pragma unroll
    for (int kt2 = 0; kt2 < 2; ++kt2) {
#pragma unroll
        for (int i = 0; i < 16; ++i) sacc[kt2][i] = 0.f;
        const int row = 64 * kt + 32 * kt2 + r31; const int sx = (row >> 1) & 7;
#pragma unroll
        for (int s = 0; s < 4; ++s) { const bf16x8 kf = *(const bf16x8*)(kbase + row * 128 + (((2 * s + hh) ^ sx) << 4));
            sacc[kt2] = __builtin_amdgcn_mfma_f32_32x32x16_bf16(kf, qf[s], sacc[kt2], 0, 0, 0); }
    }
}
DEV void phase_cmp_attn(const Params& p, unsigned char* lds) {
    const int tid = threadIdx.x, lane = tid & 63, wid = tid >> 6;
    const int vb = vblock(), G = gridDim.x;
    unsigned char* ws = p.ws;
    const int r31 = lane & 31, hh = lane >> 5;
    float* impl = (float*)(lds + CM_IMP);
    for (int it = vb; it < 1024; it += G) {
        int ci, bg;
        if (G == 256) { const int x = vb >> 5, jb = vb & 31, rnd = it / G, i = rnd * 32 + ((rnd & 1) ? 31 - jb : jb); ci = 63 - (i >> 1); bg = 2 * x + (i & 1); }
        else { ci = 63 - (it >> 4); bg = it & 15; }
        const int b = bg >> 1, g = bg & 1;
        const int nvis = min(NC, 4 * ci + 3), ntile = (nvis + 63) >> 6;
        const int head = g * 4 + (wid >> 1);
        const int tokl = (wid & 1) * 32 + r31, t = ci * 64 + tokl;
        const size_t tok = (size_t)b * SEQ + t;
        const int nv = t >= 31 ? min(NC, (t - 31) / 16 + 1) : 0;
        __syncthreads();
        {
            const bf16_t* kc = (const bf16_t*)(ws + WS_KCMP) + (size_t)bg * 256 * 64; const bf16_t* vt = (const bf16_t*)(ws + WS_VCMP) + (size_t)bg * 64 * 256;
            const int cpr = ntile * 8;
            u32x4 rk[4], rv[4];
#pragma unroll
            for (int i = 0; i < 4; ++i) if (i < ntile) { const int idx = tid + NT * i; rk[i] = *(const u32x4*)(kc + (idx >> 3) * 64 + (idx & 7) * 8); const int d = idx / cpr, ck = idx % cpr; rv[i] = *(const u32x4*)(vt + d * 256 + ck * 8); }
#pragma unroll
            for (int i = 0; i < 4; ++i) if (i < ntile) { const int idx = tid + NT * i; *(u32x4*)(lds + CM_K + swz(idx >> 3, idx & 7)) = rk[i];
                const int d = idx / cpr, ck = idx % cpr; u32x2 a, c2; a.x = rv[i].x; a.y = rv[i].y; c2.x = rv[i].z; c2.y = rv[i].w; unsigned char* o = lds + CM_V + d * CM_VSTR + ck * 16; *(u32x2*)o = a; *(u32x2*)(o + 8) = c2; }
        }
        bf16x8 qf[4];
        { const bf16_t* qp = (const bf16_t*)(ws + WS_Q) + ((size_t)(b * 8 + head) * SEQ + t) * 64 + 8 * hh;
#pragma unroll
            for (int s = 0; s < 4; ++s) qf[s] = *(const bf16x8*)(qp + 16 * s); }
        __syncthreads();
        float l_run = 0.f;
        f32x16 ot[2];
#pragma unroll
        for (int dt = 0; dt < 2; ++dt)
#pragma unroll
            for (int i = 0; i < 16; ++i) ot[dt][i] = 0.f;
        float carry = 0.f;
#pragma unroll
        for (int kt = 0; kt < 4; ++kt) if (kt < ntile) {
            f32x16 sacc[2];
            cm_scores(lds + CM_K, kt, qf, r31, hh, sacc);
#pragma unroll
            for (int kt2 = 0; kt2 < 2; ++kt2)
#pragma unroll
                for (int i = 0; i < 16; ++i) { const int c = 64 * kt + 32 * kt2 + (i & 3) + 8 * (i >> 2) + 4 * hh; const float e_ = (c < nv) ? __builtin_amdgcn_exp2f(sacc[kt2][i]) : 0.f; sacc[kt2][i] = e_; l_run += e_; }
            {
                float own[8], xs[8];
#pragma unroll
                for (int kt2 = 0; kt2 < 2; ++kt2)
#pragma unroll
                    for (int g4 = 0; g4 < 4; ++g4) { const float e3 = 0.5f * sacc[kt2][4 * g4 + 3];
                        own[4 * kt2 + g4] = (sacc[kt2][4 * g4] + sacc[kt2][4 * g4 + 1]) + (sacc[kt2][4 * g4 + 2] + e3); xs[4 * kt2 + g4] = __shfl_xor(e3, 32); }
                float* io = impl + (wid >> 1) * 4096 + tokl * 64 + 16 * kt + hh;
#pragma unroll
                for (int gi = 0; gi < 8; ++gi) io[2 * gi] = own[gi] + (hh ? xs[gi] : (gi > 0 ? xs[gi > 0 ? gi - 1 : 0] : carry));
                carry = xs[7];
            }
#pragma unroll
            for (int kt2 = 0; kt2 < 2; ++kt2)
#pragma unroll
                for (int s2 = 0; s2 < 2; ++s2) {
                    bf16x8 pf; { u32x4 w; w.x = pk2(sacc[kt2][8 * s2 + 0], sacc[kt2][8 * s2 + 1]); w.y = pk2(sacc[kt2][8 * s2 + 2], sacc[kt2][8 * s2 + 3]);
                        w.z = pk2(sacc[kt2][8 * s2 + 4], sacc[kt2][8 * s2 + 5]); w.w = pk2(sacc[kt2][8 * s2 + 6], sacc[kt2][8 * s2 + 7]); pf = __builtin_bit_cast(bf16x8, w); }
#pragma unroll
                    for (int dt = 0; dt < 2; ++dt) {
                        const unsigned char* va = lds + CM_V + (32 * dt + r31) * CM_VSTR + (64 * kt + 32 * kt2 + 16 * s2 + 4 * hh) * 2;
                        const u32x2 lo = *(const u32x2*)(va), hi = *(const u32x2*)(va + 16);
                        u32x4 w; w.x = lo.x; w.y = lo.y; w.z = hi.x; w.w = hi.y;
                        ot[dt] = __builtin_amdgcn_mfma_f32_32x32x16_bf16(__builtin_bit_cast(bf16x8, w), pf, ot[dt], 0, 0, 0);
                    }
                }
        }
        float invL; { const float L = l_run + __shfl_xor(l_run, 32); invL = L > 0.f ? 1.f / L : 0.f; }
        if (hh == 0) impl[16384 + (wid >> 1) * 64 + tokl] = invL;
        {
            const float sc = ((const float*)(ws + WS_GATES))[tok * 24 + head * 3 + 0] * invL;
            bf16_t* ocp = (bf16_t*)(ws + WS_OC) + tok * 512 + head * 64;
#pragma unroll
            for (int dt = 0; dt < 2; ++dt)
#pragma unroll
                for (int g4 = 0; g4 < 4; ++g4) { const int d0 = 32 * dt + 8 * g4 + 4 * hh;
                    u32x2 w; w.x = pk2(ot[dt][4 * g4 + 0] * sc, ot[dt][4 * g4 + 1] * sc); w.y = pk2(ot[dt][4 * g4 + 2] * sc, ot[dt][4 * g4 + 3] * sc); *(u32x2*)(ocp + d0) = w; }
        }
        __syncthreads();
        for (int tt = 0; tt < 8; ++tt) {
            const int tl = wid * 8 + tt, cur = ci;
            unsigned long long mask;
            if (cur < 16) mask = (2ull << cur) - 1ull;
            else {
                const bool valid = lane <= cur;
                const float imp = (impl[tl * 64 + lane] * impl[16384 + tl] + impl[4096 + tl * 64 + lane] * impl[16384 + 64 + tl]) + (impl[8192 + tl * 64 + lane] * impl[16384 + 128 + tl] + impl[12288 + tl * 64 + lane] * impl[16384 + 192 + tl]);
                const unsigned key = (lane == 0 || lane == cur) ? 0x7F800000u : __float_as_uint(imp);
                unsigned T = 0u;
                for (int bit = 30; bit >= 0; --bit) { const unsigned cand = T | (1u << bit); if (__popcll(__ballot(valid && key >= cand)) >= 16) T = cand; }
                const unsigned long long gt = __ballot(valid && key > T), eq = __ballot(valid && key == T);
                const int need = 16 - __popcll(gt);
                const int below = __popcll(eq & ((1ull << lane) - 1ull));
                mask = gt | __ballot(valid && key == T && below < need);
            }
            if (lane == 0) ((unsigned long long*)(ws + WS_SELM))[(size_t)bg * SEQ + ci * 64 + tl] = mask;
        }
    }
}

constexpr int FA_KB = 64 * 128, FA_VB = 64 * 136, FA_STAGE = FA_KB + FA_VB, FA_LDS = 2 * FA_STAGE + 1024;
template <bool SEL>
DEV void fa_branch(unsigned char* lds, const bf16_t* Kb, const bf16_t* VTb, int ci, int bg, const bf16x8 (&qf)[4], int t, unsigned long long mymask, unsigned long long need,
                   f32x16 (&ot)[2], float& m_run, float& l_run) {
    const int tid = threadIdx.x, lane = tid & 63;
    const int r31 = lane & 31, hh = lane >> 5;
    const int lrow = tid >> 3, lch = tid & 7;
    const bf16_t* kg = Kb + ((size_t)bg * SEQ + lrow) * 64 + lch * 8;
    const bf16_t* vg = VTb + ((size_t)bg * 64 + lrow) * SEQ + lch * 8;
    const int koff = lrow * 128 + ((lch ^ ((lrow >> 1) & 7)) << 4), voff = FA_KB + lrow * 136 + lch * 16;
    int jlo, jhi; unsigned long long todo;
    if (SEL) { todo = need; jlo = 0; jhi = ci; } else { jlo = ci >= 8 ? ci - 8 : 0; jhi = ci; todo = 0; }
    int j = jlo;
    if (SEL) { if (todo == 0) return; j = __builtin_ctzll(todo); todo &= todo - 1; }
    u32x4 rk = *(const u32x4*)(kg + (size_t)j * 64 * 64), rv = *(const u32x4*)(vg + (size_t)j * 64);
    __syncthreads();
    *(u32x4*)(lds + koff) = rk; { u32x2 a, b2; a.x = rv.x; a.y = rv.y; b2.x = rv.z; b2.y = rv.w; *(u32x2*)(lds + voff) = a; *(u32x2*)(lds + voff + 8) = b2; }
    __syncthreads();
    int st = 0; bool seen = false;
    for (;;) {
        int jn; bool more;
        if (SEL) { more = (todo != 0); jn = more ? __builtin_ctzll(todo) : 0; todo &= todo - 1; } else { jn = j + 1; more = (jn <= jhi); }
        if (more) { rk = *(const u32x4*)(kg + (size_t)jn * 64 * 64); rv = *(const u32x4*)(vg + (size_t)jn * 64); }
        const unsigned char* base = lds + st * FA_STAGE;
        const bool bit = SEL ? ((mymask >> j) & 1ull) != 0 : true;
        const float cinit = (SEL && !bit) ? -__builtin_inff() : -m_run;
        f32x16 sacc[2];
#pragma unroll
        for (int kt2 = 0; kt2 < 2; ++kt2) {
#pragma unroll
            for (int i = 0; i < 16; ++i) sacc[kt2][i] = cinit;
            const int row = 32 * kt2 + r31; const int sx = (row >> 1) & 7;
#pragma unroll
            for (int s = 0; s < 4; ++s) { const bf16x8 kf = *(const bf16x8*)(base + row * 128 + (((2 * s + hh) ^ sx) << 4));
                sacc[kt2] = __builtin_amdgcn_mfma_f32_32x32x16_bf16(kf, qf[s], sacc[kt2], 0, 0, 0); }
        }
        const bool boundary = SEL ? (j == ci) : (j == ci || j + 8 <= ci);
        float mx = -__builtin_inff();
        if (boundary) {
#pragma unroll
            for (int kt2 = 0; kt2 < 2; ++kt2)
#pragma unroll
                for (int i = 0; i < 16; ++i) { const int key = 64 * j + 32 * kt2 + (i & 3) + 8 * (i >> 2) + 4 * hh;
                    const bool ok = SEL ? (key <= t) : (key <= t && t - key < 512);
                    const float v = ok ? sacc[kt2][i] : -__builtin_inff(); sacc[kt2][i] = v; mx = fmaxf(mx, v); }
        } else {
#pragma unroll
            for (int kt2 = 0; kt2 < 2; ++kt2)
#pragma unroll
                for (int i = 0; i < 16; ++i) mx = fmaxf(mx, sacc[kt2][i]);
        }
        mx = fmaxf(mx, __shfl_xor(mx, 32));
        const bool live = mx > -__builtin_inff();
        const bool need = (mx > 8.f) || (!seen && live && mx < -8.f);
        if (__any(need)) {
            const float d = need ? mx : 0.f;
            const float alpha = d > 0.f ? __builtin_amdgcn_exp2f(-d) : 1.f;
            m_run += d; l_run *= alpha;
#pragma unroll
            for (int dt = 0; dt < 2; ++dt)
#pragma unroll
                for (int i = 0; i < 16; ++i) ot[dt][i] *= alpha;
#pragma unroll
            for (int kt2 = 0; kt2 < 2; ++kt2)
#pragma unroll
                for (int i = 0; i < 16; ++i) sacc[kt2][i] -= d;
        }
        seen = seen || live;
        float rs = 0.f;
#pragma unroll
        for (int kt2 = 0; kt2 < 2; ++kt2)
#pragma unroll
            for (int i = 0; i < 16; ++i) { const float e = __builtin_amdgcn_exp2f(sacc[kt2][i]); sacc[kt2][i] = e; rs += e; }
        l_run += rs;
#pragma unroll
        for (int kt2 = 0; kt2 < 2; ++kt2)
#pragma unroll
            for (int s2 = 0; s2 < 2; ++s2) {
                bf16x8 pf; { u32x4 w; w.x = pk2(sacc[kt2][8 * s2 + 0], sacc[kt2][8 * s2 + 1]); w.y = pk2(sacc[kt2][8 * s2 + 2], sacc[kt2][8 * s2 + 3]);
                    w.z = pk2(sacc[kt2][8 * s2 + 4], sacc[kt2][8 * s2 + 5]); w.w = pk2(sacc[kt2][8 * s2 + 6], sacc[kt2][8 * s2 + 7]); pf = __builtin_bit_cast(bf16x8, w); }
#pragma unroll
                for (int dt = 0; dt < 2; ++dt) {
                    const unsigned char* va = base + FA_KB + (32 * dt + r31) * 136 + (32 * kt2 + 16 * s2 + 4 * hh) * 2;
                    const u32x2 lo = *(const u32x2*)(va), hi = *(const u32x2*)(va + 16);
                    u32x4 w; w.x = lo.x; w.y = lo.y; w.z = hi.x; w.w = hi.y;
                    ot[dt] = __builtin_amdgcn_mfma_f32_32x32x16_bf16(__builtin_bit_cast(bf16x8, w), pf, ot[dt], 0, 0, 0);
                }
            }
        if (!more) break;
        { unsigned char* nb = lds + (st ^ 1) * FA_STAGE; *(u32x4*)(nb + koff) = rk; u32x2 a, b2; a.x = rv.x; a.y = rv.y; b2.x = rv.z; b2.y = rv.w; *(u32x2*)(nb + voff) = a; *(u32x2*)(nb + voff + 8) = b2; }
        __syncthreads();
        st ^= 1; j = jn;
    }
}
DEV void phase_flash(const Params& p, unsigned char* lds) {
    const int tid = threadIdx.x, lane = tid & 63, wid = tid >> 6;
    const int vb = vblock(), G = gridDim.x;
    unsigned char* ws = p.ws;
    const int r31 = lane & 31, hh = lane >> 5;
    unsigned long long* red = (unsigned long long*)(lds + 2 * FA_STAGE);
    for (int it = vb; it < 1024; it += G) {
        int ci, bg;
        if (G == 256) { const int x = vb >> 5, jb = vb & 31, rnd = it / G, i = rnd * 32 + ((rnd & 1) ? 31 - jb : jb); ci = 63 - (i >> 1); bg = 2 * x + (i & 1); }
        else { ci = 63 - (it >> 4); bg = it & 15; }
        const int b = bg >> 1, g = bg & 1;
        const int head = g * 4 + (wid >> 1);
        const int t = ci * 64 + (wid & 1) * 32 + r31;
        const size_t tok = (size_t)b * SEQ + t;
        bf16x8 qf[4];
        { const bf16_t* qp = (const bf16_t*)(ws + WS_Q) + ((size_t)(b * 8 + head) * SEQ + t) * 64 + 8 * hh;
#pragma unroll
            for (int s = 0; s < 4; ++s) qf[s] = *(const bf16x8*)(qp + 16 * s); }
        const unsigned long long mymask = ((const unsigned long long*)(ws + WS_SELM))[(size_t)bg * SEQ + t];
        unsigned long long orm = mymask;
#pragma unroll
        for (int o = 1; o < 32; o <<= 1) { const unsigned lo = __shfl_xor((unsigned)orm, o), hi = __shfl_xor((unsigned)(orm >> 32), o); orm |= ((unsigned long long)hi << 32) | lo; }
        __syncthreads();
        if (wid < 2 && lane == 0) red[wid] = orm;
        __syncthreads();
        const unsigned long long need = red[0] | red[1];
        f32x16 oc[2];
        {
            f32x16 ot[2]; float m_run = 0.f, l_run = 0.f;
#pragma unroll
            for (int dt = 0; dt < 2; ++dt)
#pragma unroll
                for (int i = 0; i < 16; ++i) ot[dt][i] = 0.f;
            fa_branch<true>(lds, (const bf16_t*)(ws + WS_KS), (const bf16_t*)(ws + WS_VST), ci, bg, qf, t, mymask, need, ot, m_run, l_run);
            const float lt = l_run + __shfl_xor(l_run, 32);
            const float sc = ((const float*)(ws + WS_GATES))[tok * 24 + head * 3 + 1] / lt;
#pragma unroll
            for (int dt = 0; dt < 2; ++dt)
#pragma unroll
                for (int i = 0; i < 16; ++i) oc[dt][i] = ot[dt][i] * sc;
        }
        {
            f32x16 ot[2]; float m_run = 0.f, l_run = 0.f;
#pragma unroll
            for (int dt = 0; dt < 2; ++dt)
#pragma unroll
                for (int i = 0; i < 16; ++i) ot[dt][i] = 0.f;
            fa_branch<false>(lds, (const bf16_t*)(ws + WS_KW), (const bf16_t*)(ws + WS_VWT), ci, bg, qf, t, 0ull, 0ull, ot, m_run, l_run);
            const float lt = l_run + __shfl_xor(l_run, 32);
            const float sc = ((const float*)(ws + WS_GATES))[tok * 24 + head * 3 + 2] / lt;
#pragma unroll
            for (int dt = 0; dt < 2; ++dt)
#pragma unroll
                for (int i = 0; i < 16; ++i) oc[dt][i] += ot[dt][i] * sc;
        }
        {
            const bf16_t* ocp = (const bf16_t*)(ws + WS_OC) + tok * 512 + head * 64;
            bf16_t* mix = (bf16_t*)(ws + WS_R1) + tok * 1024 + head * 64;
            float ss = 0.f;
#pragma unroll
            for (int dt = 0; dt < 2; ++dt)
#pragma unroll
                for (int g4 = 0; g4 < 4; ++g4) { const int d0 = 32 * dt + 8 * g4 + 4 * hh; const u32x2 c = *(const u32x2*)(ocp + d0);
                    const float v0 = oc[dt][4 * g4 + 0] + bflo(c.x), v1 = oc[dt][4 * g4 + 1] + bfhi(c.x), v2 = oc[dt][4 * g4 + 2] + bflo(c.y), v3 = oc[dt][4 * g4 + 3] + bfhi(c.y);
                    ss += (v0 * v0 + v1 * v1) + (v2 * v2 + v3 * v3);
                    u32x2 w; w.x = pk2(v0, v1); w.y = pk2(v2, v3); *(u32x2*)(mix + d0) = w; }
            ss += __shfl_xor(ss, 32);
            if (hh == 0) atomicAdd((float*)(ws + WS_ROWSS) + tok, ss);
        }
    }
}

DEV int swz256(int row, int chunk) { return row * 256 + ((chunk ^ (row & 15)) << 4); }
DEV void hgrn_cumsum(const Params& p, int bh, int c, float* segs, f32x2 (&lf)[8], f32x2 (&a)[8], f32x2& r, f32x2& alast) {
    const int tid = threadIdx.x, k2 = tid & 63, tq = tid >> 6;
    const int b = bh >> 2, h = bh & 3;
    const bf16_t* HL = (const bf16_t*)(p.ws + WS_HLOGF) + ((size_t)b * SEQ + c * 64 + tq * 8) * 512 + h * 128 + 2 * k2;
#pragma unroll
    for (int i = 0; i < 8; ++i) { const unsigned w = *(const unsigned*)(HL + (size_t)i * 512); lf[i] = (f32x2){bflo(w), bfhi(w)}; }
    f32x2 run = (f32x2){0.f, 0.f};
#pragma unroll
    for (int i = 0; i < 8; ++i) { run = run + lf[i]; a[i] = run; }
    *(f32x2*)(segs + tq * 128 + 2 * k2) = run;
    __syncthreads();
    f32x2 off = (f32x2){0.f, 0.f}, tot = off, rr = off;
#pragma unroll
    for (int q = 0; q < 8; ++q) { const f32x2 s = *(const f32x2*)(segs + q * 128 + 2 * k2); if (q < tq) off = off + s; if (q < 4) rr = rr + s; tot = tot + s; }
#pragma unroll
    for (int i = 0; i < 8; ++i) a[i] = a[i] + off;
    r = rr; alast = tot;
}
DEV void hgrn_stage_vt(const Params& p, int bh, int c, unsigned char* vt) {
    const int tid = threadIdx.x, k2 = tid & 63, tq = tid >> 6;
    const int b = bh >> 2, h = bh & 3;
    const bf16_t* HV = (const bf16_t*)(p.ws + WS_HV) + ((size_t)b * SEQ + c * 64 + tq * 8) * 512 + h * 128 + 2 * k2;
    unsigned vv[8];
#pragma unroll
    for (int i = 0; i < 8; ++i) vv[i] = *(const unsigned*)(HV + (size_t)i * 512);
    u32x4 lo, hi;
    lo.x = (vv[0] & 0xffffu) | (vv[1] << 16); lo.y = (vv[2] & 0xffffu) | (vv[3] << 16); lo.z = (vv[4] & 0xffffu) | (vv[5] << 16); lo.w = (vv[6] & 0xffffu) | (vv[7] << 16);
    hi.x = (vv[0] >> 16) | (vv[1] & 0xffff0000u); hi.y = (vv[2] >> 16) | (vv[3] & 0xffff0000u); hi.z = (vv[4] >> 16) | (vv[5] & 0xffff0000u); hi.w = (vv[6] >> 16) | (vv[7] & 0xffff0000u);
    *(u32x4*)(vt + swz(2 * k2, tq)) = lo; *(u32x4*)(vt + swz(2 * k2 + 1, tq)) = hi;
}
constexpr int H1_KT = 0, H1_VT = 16384, H1_SEG = 32768, H1_EK = H1_SEG + 4096;
DEV void phase_hgrn_a1(const Params& p, unsigned char* lds, int vb0, int nb) {
    const int tid = threadIdx.x, lane = tid & 63, wid = tid >> 6, k2 = tid & 63, tq = tid >> 6;
    const int vb = vblock(), G = gridDim.x;
    const int frow = lane & 15, fq = lane >> 4, wr = wid >> 1, wc = wid & 1;
    float* segs = (float*)(lds + H1_SEG); float* ek = (float*)(lds + H1_EK);
    bf16_t* ubuf = (bf16_t*)(p.ws + WS_UBUF); float* dbuf = (float*)(p.ws + WS_DBUF);
    if (vb < vb0) return;
    for (int item = vb - vb0; item < 2048; item += nb) {
        const int bh = item >> 6, c = item & 63;
        __syncthreads();
        f32x2 lf[8], a[8], r, al;
        hgrn_cumsum(p, bh, c, segs, lf, a, r, al);
        {
            float kx[8], ky[8];
#pragma unroll
            for (int i = 0; i < 8; ++i) { kx[i] = (1.f - __expf(lf[i].x)) * __expf(fminf(r.x - a[i].x, 80.f)); ky[i] = (1.f - __expf(lf[i].y)) * __expf(fminf(r.y - a[i].y, 80.f)); }
            u32x4 w0, w1;
            w0.x = pk2(kx[0], kx[1]); w0.y = pk2(kx[2], kx[3]); w0.z = pk2(kx[4], kx[5]); w0.w = pk2(kx[6], kx[7]);
            w1.x = pk2(ky[0], ky[1]); w1.y = pk2(ky[2], ky[3]); w1.z = pk2(ky[4], ky[5]); w1.w = pk2(ky[6], ky[7]);
            *(u32x4*)(lds + H1_KT + swz(2 * k2, tq)) = w0; *(u32x4*)(lds + H1_KT + swz(2 * k2 + 1, tq)) = w1;
        }
        hgrn_stage_vt(p, bh, c, lds + H1_VT);
        if (tq == 7) { ek[2 * k2] = __expf(al.x - r.x); ek[2 * k2 + 1] = __expf(al.y - r.y); f32x2 d; d.x = __expf(al.x); d.y = __expf(al.y); *(f32x2*)(dbuf + (size_t)item * 128 + 2 * k2) = d; }
        __syncthreads();
        f32x4 acc[2][4];
#pragma unroll
        for (int m = 0; m < 2; ++m)
#pragma unroll
            for (int n = 0; n < 4; ++n) acc[m][n] = (f32x4){0.f, 0.f, 0.f, 0.f};
        const int sx = (frow >> 1) & 7;
#pragma unroll
        for (int ks = 0; ks < 2; ++ks) {
            const int co = ((ks * 4 + fq) ^ sx) << 4;
            bf16x8 af[2], bfr[4];
#pragma unroll
            for (int m = 0; m < 2; ++m) af[m] = *(const bf16x8*)(lds + H1_VT + (32 * wr + 16 * m + frow) * 128 + co);
#pragma unroll
            for (int n = 0; n < 4; ++n) bfr[n] = *(const bf16x8*)(lds + H1_KT + (64 * wc + 16 * n + frow) * 128 + co);
#pragma unroll
            for (int m = 0; m < 2; ++m)
#pragma unroll
                for (int n = 0; n < 4; ++n) acc[m][n] = __builtin_amdgcn_mfma_f32_16x16x32_bf16(bfr[n], af[m], acc[m][n], 0, 0, 0);
        }
#pragma unroll
        for (int m = 0; m < 2; ++m) { const int v = 32 * wr + 16 * m + frow;
#pragma unroll
            for (int n = 0; n < 4; ++n) { const int k0 = 64 * wc + 16 * n + 4 * fq; const f32x4 e = *(const f32x4*)(ek + k0); const f32x4 o = acc[m][n] * e;
                u32x2 w; w.x = pk2(o.x, o.y); w.y = pk2(o.z, o.w); *(u32x2*)(ubuf + ((size_t)item * 128 + v) * 128 + k0) = w; } }
    }
}
DEV void phase_hgrn_a2(const Params& p, unsigned char* lds) {
    const int G = gridDim.x;
    bf16_t* ubuf = (bf16_t*)(p.ws + WS_UBUF); const float* dbuf = (const float*)(p.ws + WS_DBUF);
    for (int gid = blockIdx.x * NT + threadIdx.x; gid < 131072; gid += G * NT) {
        const int bh = gid >> 12, v = (gid >> 5) & 127, k4 = gid & 31;
        bf16_t* u = ubuf + ((size_t)bh * 64 * 128 + v) * 128 + 4 * k4;
        const float* d = dbuf + (size_t)bh * 64 * 128 + 4 * k4;
        f32x4 S = (f32x4){0.f, 0.f, 0.f, 0.f};
        for (int c0 = 0; c0 < 64; c0 += 8) {
            u32x2 uu[8]; f32x4 dd[8];
#pragma unroll
            for (int j = 0; j < 8; ++j) { uu[j] = *(const u32x2*)(u + (size_t)(c0 + j) * 16384); dd[j] = *(const f32x4*)(d + (size_t)(c0 + j) * 128); }
#pragma unroll
            for (int j = 0; j < 8; ++j) { u32x2 w; w.x = pk2(S.x, S.y); w.y = pk2(S.z, S.w); *(u32x2*)(u + (size_t)(c0 + j) * 16384) = w;
                S.x = dd[j].x * S.x + bflo(uu[j].x); S.y = dd[j].y * S.y + bfhi(uu[j].x); S.z = dd[j].z * S.z + bflo(uu[j].y); S.w = dd[j].w * S.w + bfhi(uu[j].y); }
        }
    }
}
constexpr int H3_QH = 0, H3_QA = 16384, H3_KH = 32768, H3_VT = 49152, H3_PP = 65536, H3_ST = 73728, H3_SEG = 106496, H3_RED = 110592;
DEV void phase_hgrn_a3(const Params& p, unsigned char* lds) {
    const int tid = threadIdx.x, lane = tid & 63, wid = tid >> 6, k2 = tid & 63, tq = tid >> 6;
    const int vb = vblock(), G = gridDim.x;
    const int frow = lane & 15, fq = lane >> 4;
    float* segs = (float*)(lds + H3_SEG); float* red = (float*)(lds + H3_RED);
    const bf16_t* ubuf = (const bf16_t*)(p.ws + WS_UBUF);
    for (int item = vb; item < 2048; item += G) {
        const int bh = item >> 6, c = item & 63, b = bh >> 2, h = bh & 3;
        __syncthreads();
        f32x2 lf[8], a[8], r, al;
        hgrn_cumsum(p, bh, c, segs, lf, a, r, al);
        {
            const bf16_t* HQ = (const bf16_t*)(p.ws + WS_HQ) + ((size_t)b * SEQ + c * 64 + tq * 8) * 512 + h * 128 + 2 * k2;
            unsigned qq[8];
#pragma unroll
            for (int i = 0; i < 8; ++i) qq[i] = *(const unsigned*)(HQ + (size_t)i * 512);
#pragma unroll
            for (int i = 0; i < 8; ++i) { const int t = 8 * tq + i; const float q0 = bflo(qq[i]), q1 = bfhi(qq[i]);
                const int off = swz256(t, k2 >> 2) + (k2 & 3) * 4;
                *(unsigned*)(lds + H3_QH + off) = pk2(q0 * __expf(fminf(a[i].x - r.x, 80.f)), q1 * __expf(fminf(a[i].y - r.y, 80.f)));
                *(unsigned*)(lds + H3_QA + off) = pk2(q0 * __expf(a[i].x), q1 * __expf(a[i].y));
                *(unsigned*)(lds + H3_KH + off) = pk2((1.f - __expf(lf[i].x)) * __expf(fminf(r.x - a[i].x, 80.f)), (1.f - __expf(lf[i].y)) * __expf(fminf(r.y - a[i].y, 80.f))); }
        }
        hgrn_stage_vt(p, bh, c, lds + H3_VT);
        {
            const bf16_t* st = ubuf + (size_t)item * 16384;
#pragma unroll
            for (int i = 0; i < 4; ++i) { const int q = tid + NT * i, v = q >> 4, ch = q & 15; *(u32x4*)(lds + H3_ST + swz256(v, ch)) = *(const u32x4*)(st + v * 128 + ch * 8); }
        }
        __syncthreads();
        {
            const int wr = wid >> 1, wc = wid & 1;
            f32x4 acc[2];
            acc[0] = (f32x4){0.f, 0.f, 0.f, 0.f}; acc[1] = acc[0];
            if (32 * wc <= 16 * wr + 15) {
#pragma unroll
                for (int ks = 0; ks < 4; ++ks) {
                    const int co = ((ks * 4 + fq) ^ frow) << 4;
                    const bf16x8 af = *(const bf16x8*)(lds + H3_QH + (16 * wr + frow) * 256 + co);
#pragma unroll
                    for (int n = 0; n < 2; ++n) { const bf16x8 bfr = *(const bf16x8*)(lds + H3_KH + (32 * wc + 16 * n + frow) * 256 + co);
                        acc[n] = __builtin_amdgcn_mfma_f32_16x16x32_bf16(bfr, af, acc[n], 0, 0, 0); }
                }
            }
            const int t = 16 * wr + frow;
#pragma unroll
            for (int n = 0; n < 2; ++n) { const int s0 = 32 * wc + 16 * n + 4 * fq; f32x4 v = acc[n];
                v.x = (s0 + 0 <= t) ? v.x : 0.f; v.y = (s0 + 1 <= t) ? v.y : 0.f; v.z = (s0 + 2 <= t) ? v.z : 0.f; v.w = (s0 + 3 <= t) ? v.w : 0.f;
                u32x2 w; w.x = pk2(v.x, v.y); w.y = pk2(v.z, v.w);
                *(u32x2*)(lds + H3_PP + t * 128 + ((((s0 >> 3)) ^ ((t >> 1) & 7)) << 4) + (s0 & 7) * 2) = w; }
        }
        __syncthreads();
        {
            const int wr = wid >> 2, wc = wid & 3;
            f32x4 acc[2][2];
#pragma unroll
            for (int m = 0; m < 2; ++m)
#pragma unroll
                for (int n = 0; n < 2; ++n) acc[m][n] = (f32x4){0.f, 0.f, 0.f, 0.f};
            const int sx = (frow >> 1) & 7;
#pragma unroll
            for (int ks = 0; ks < 2; ++ks) {
                const int co = ((ks * 4 + fq) ^ sx) << 4;
                bf16x8 af[2], bfr[2];
#pragma unroll
                for (int m = 0; m < 2; ++m) af[m] = *(const bf16x8*)(lds + H3_PP + (32 * wr + 16 * m + frow) * 128 + co);
#pragma unroll
                for (int n = 0; n < 2; ++n) bfr[n] = *(const bf16x8*)(lds + H3_VT + (32 * wc + 16 * n + frow) * 128 + co);
#pragma unroll
                for (int m = 0; m < 2; ++m)
#pragma unroll
                    for (int n = 0; n < 2; ++n) acc[m][n] = __builtin_amdgcn_mfma_f32_16x16x32_bf16(bfr[n], af[m], acc[m][n], 0, 0, 0);
            }
#pragma unroll
            for (int ks = 0; ks < 4; ++ks) {
                const int co = ((ks * 4 + fq) ^ frow) << 4;
                bf16x8 af[2], bfr[2];
#pragma unroll
                for (int m = 0; m < 2; ++m) af[m] = *(const bf16x8*)(lds + H3_QA + (32 * wr + 16 * m + frow) * 256 + co);
#pragma unroll
                for (int n = 0; n < 2; ++n) bfr[n] = *(const bf16x8*)(lds + H3_ST + (32 * wc + 16 * n + frow) * 256 + co);
#pragma unroll
                for (int m = 0; m < 2; ++m)
#pragma unroll
                    for (int n = 0; n < 2; ++n) acc[m][n] = __builtin_amdgcn_mfma_f32_16x16x32_bf16(bfr[n], af[m], acc[m][n], 0, 0, 0);
            }
            f32x4 gnv[2]; u32x2 ggv[2][2];
#pragma unroll
            for (int n = 0; n < 2; ++n) gnv[n] = *(const f32x4*)(p.g_hn + 32 * wc + 16 * n + 4 * fq);
#pragma unroll
            for (int m = 0; m < 2; ++m)
#pragma unroll
                for (int n = 0; n < 2; ++n) ggv[m][n] = *(const u32x2*)((const bf16_t*)(p.ws + WS_HG) + ((size_t)b * SEQ + c * 64 + 32 * wr + 16 * m + frow) * 512 + h * 128 + 32 * wc + 16 * n + 4 * fq);
#pragma unroll
            for (int m = 0; m < 2; ++m) { float ss = 0.f;
#pragma unroll
                for (int n = 0; n < 2; ++n) { const f32x4 v = acc[m][n]; ss += (v.x * v.x + v.y * v.y) + (v.z * v.z + v.w * v.w); }
                ss += __shfl_xor(ss, 16); ss += __shfl_xor(ss, 32);
                if (fq == 0) red[(32 * wr + 16 * m + frow) * 4 + wc] = ss; }
            __syncthreads();
#pragma unroll
            for (int m = 0; m < 2; ++m) { const int t = 32 * wr + 16 * m + frow; const f32x4 q4 = *(const f32x4*)(red + t * 4);
                const float rs = rsqrtf(((q4.x + q4.y) + (q4.z + q4.w)) * (1.f / 128.f) + RMS_EPS);
                const size_t row = (size_t)b * SEQ + c * 64 + t;
#pragma unroll
                for (int n = 0; n < 2; ++n) { const int v0 = 32 * wc + 16 * n + 4 * fq; const f32x4 gn = gnv[n]; const u32x2 gg = ggv[m][n];
                    const f32x4 o = acc[m][n];
                    u32x2 w; w.x = pk2(o.x * rs * gn.x * bflo(gg.x), o.y * rs * gn.y * bfhi(gg.x)); w.y = pk2(o.z * rs * gn.z * bflo(gg.y), o.w * rs * gn.w * bfhi(gg.y));
                    *(u32x2*)((bf16_t*)(p.ws + WS_R1) + row * 1024 + 512 + h * 128 + v0) = w; } }
        }
    }
}

DEV void phase_normalize(const Params& p, unsigned char* lds) {
    const int vb = vblock(), G = gridDim.x;
    unsigned char* ws = p.ws;
    __syncthreads();
    {
        float* tl = (float*)lds;
        for (int r = vb; r < 32 * 4 * 16; r += G) { const int e = r / 64, q = r % 64; SrcW13_4 s{p.w1 + (size_t)e * 1024 * 512, p.w3 + (size_t)e * 1024 * 512, p.ffn_g};
            convert_tile256(tl, s, (bf16_t*)(ws + WS_W13T) + (size_t)e * 1024 * 1024, 1024, (q / 16) * 256, (q % 16) * 64); }
    }
}

struct EpiOut8 { const Params& p; static constexpr bool MIDSCALE = true;
    DEV float rowscale(int row) const { return rsqrtf(((const float*)(p.ws + WS_ROWSS))[row] * (1.f / 512.f) + RMS_EPS); }
    DEV int midk() const { return 8; }
    DEV void operator()(const f32x4 (&acc)[2][2][4][2], const pg8::Unit& u, int wr, int wc, int fr, int fq) const {
#pragma unroll
        for (int ai = 0; ai < 2; ++ai)
#pragma unroll
            for (int m = 0; m < 4; ++m) { const size_t row = (size_t)u.pm * 256 + ai * 128 + wr * 64 + m * 16 + fr;
#pragma unroll
                for (int bj = 0; bj < 2; ++bj)
#pragma unroll
                    for (int n = 0; n < 2; ++n) { const int c = u.pn * 256 + 64 * wc + 32 * bj + 8 * fq + 4 * n; const f32x4 xv = *(const f32x4*)(p.x + row * DM + c); *(f32x4*)(p.out + row * DM + c) = xv + acc[ai][bj][m][n]; } }
    } };
DEV void phase_outproj(const Params& p, unsigned char* lds) {
    pg8::Gemm g{(const bf16_t*)(p.ws + WS_R1), (const bf16_t*)(p.ws + WS_WOUTT), NTOK, DM, DM};
    pg8::StaticOrder S; S.init(NTOK, DM, (int)gridDim.x, (int)blockIdx.x);
    EpiOut8 E{p};
    pg8::gemm_phase((PG8_LAS unsigned char*)lds, g, S, E);
}

constexpr int RT_W = 0, RT_LG = 2 * 49152, RT_RS = RT_LG + 128 * 49 * 4, RT_HIST = RT_RS + 512, RT_BASE = RT_HIST + 1024, RT_LDS = RT_BASE + 1024;
DEV void phase_router(const Params& p, unsigned char* lds) {
    const int tid = threadIdx.x, lane = tid & 63, wid = tid >> 6, frow = lane & 15, fq = lane >> 4;
    const int vb = vblock(), G = gridDim.x;
    unsigned char* ws = p.ws;
    float* lg = (float*)(lds + RT_LG); float* rsd = (float*)(lds + RT_RS);
    int* hist = (int*)(lds + RT_HIST); int* basep = (int*)(lds + RT_BASE);
    const bf16_t* rw = (const bf16_t*)(ws + WS_RW);
    for (int it = vb; it < NTOK / 128; it += G) {
        const size_t row0 = (size_t)it * 128;
        const size_t trow = row0 + 16 * wid + frow;
        const float* hrow = p.out + trow * DM + 8 * fq;
        bf16_t* hbrow = (bf16_t*)(ws + WS_R1) + trow * DM + 8 * fq;
        f32x4 acc[3]; float ss = 0.f;
#pragma unroll
        for (int nt = 0; nt < 3; ++nt) acc[nt] = (f32x4){0.f, 0.f, 0.f, 0.f};
        if (tid < 128) hist[tid] = 0;
        u32x4 wreg[6]; f32x4 xa[4][2], xn[4][2];
#define RT_LOADW(kc_) do { _Pragma("unroll") for (int i = 0; i < 6; ++i) { const int idx = tid + NT * i, r = idx >> 5, c = idx & 31; wreg[i] = *(const u32x4*)(rw + (size_t)r * 1024 + (kc_) * 256 + c * 8); } } while (0)
#define RT_STOREW(buf_) do { _Pragma("unroll") for (int i = 0; i < 6; ++i) { const int idx = tid + NT * i, r = idx >> 5, c = idx & 31; *(u32x4*)(lds + RT_W + (buf_) * 49152 + r * 512 + ((c ^ (r & 15)) << 4)) = wreg[i]; } } while (0)
#define RT_LOADX(dst_, hc_) do { _Pragma("unroll") for (int ks = 0; ks < 4; ++ks) { dst_[ks][0] = *(const f32x4*)(hrow + (hc_) * 128 + 32 * ks); dst_[ks][1] = *(const f32x4*)(hrow + (hc_) * 128 + 32 * ks + 4); } } while (0)
        __syncthreads();
        RT_LOADW(0); RT_LOADX(xa, 0); RT_STOREW(0);
        __syncthreads();
#pragma unroll 1
        for (int hc = 0; hc < 8; ++hc) {
            if (hc < 7) RT_LOADX(xn, hc + 1);
            const unsigned char* wb = lds + RT_W + ((hc >> 1) & 1) * 49152;
#pragma unroll
            for (int ks = 0; ks < 4; ++ks) {
                const f32x4 a = xa[ks][0], b = xa[ks][1];
                ss += ((a.x * a.x + a.y * a.y) + (a.z * a.z + a.w * a.w)) + ((b.x * b.x + b.y * b.y) + (b.z * b.z + b.w * b.w));
                u32x4 hi; hi.x = pk2(a.x, a.y); hi.y = pk2(a.z, a.w); hi.z = pk2(b.x, b.y); hi.w = pk2(b.z, b.w);
                u32x4 lo; lo.x = pk2(a.x - bflo(hi.x), a.y - bfhi(hi.x)); lo.y = pk2(a.z - bflo(hi.y), a.w - bfhi(hi.y)); lo.z = pk2(b.x - bflo(hi.z), b.y - bfhi(hi.z)); lo.w = pk2(b.z - bflo(hi.w), b.w - bfhi(hi.w));
                *(u32x4*)(hbrow + hc * 128 + 32 * ks) = hi;
                const bf16x8 hh = __builtin_bit_cast(bf16x8, hi), hl = __builtin_bit_cast(bf16x8, lo);
                const int co = ((4 * (4 * (hc & 1) + ks) + fq) ^ frow) << 4;
#pragma unroll
                for (int nt = 0; nt < 3; ++nt) {
                    const bf16x8 whi = *(const bf16x8*)(wb + (16 * nt + frow) * 512 + co), wlo = *(const bf16x8*)(wb + (48 + 16 * nt + frow) * 512 + co);
                    acc[nt] = __builtin_amdgcn_mfma_f32_16x16x32_bf16(whi, hh, acc[nt], 0, 0, 0);
                    acc[nt] = __builtin_amdgcn_mfma_f32_16x16x32_bf16(wlo, hh, acc[nt], 0, 0, 0);
                    acc[nt] = __builtin_amdgcn_mfma_f32_16x16x32_bf16(whi, hl, acc[nt], 0, 0, 0);
                }
            }
            if ((hc & 1) == 0 && hc < 6) { RT_LOADW((hc >> 1) + 1); }
            if ((hc & 1) == 1 && hc < 7) { RT_STOREW(((hc >> 1) + 1) & 1); }
#pragma unroll
            for (int ks = 0; ks < 4; ++ks) { xa[ks][0] = xn[ks][0]; xa[ks][1] = xn[ks][1]; }
            if (hc & 1) __syncthreads();
        }
#undef RT_LOADW
#undef RT_STOREW
#undef RT_LOADX
        ss += __shfl_xor(ss, 16); ss += __shfl_xor(ss, 32);
        if (fq == 0) rsd[16 * wid + frow] = rsqrtf(ss * (1.f / DM) + RMS_EPS);
#pragma unroll
        for (int nt = 0; nt < 3; ++nt) { float* o = lg + (16 * wid + frow) * 49 + 16 * nt + 4 * fq; o[0] = acc[nt].x; o[1] = acc[nt].y; o[2] = acc[nt].z; o[3] = acc[nt].w; }
        __syncthreads();
        int bin = 0, slot = 0, ea = 0, eb = 0, sa = 0, sb = 0; float wa = 0.f, wb = 0.f;
        int* ehist = hist + 112; int* ebase = basep + 112;
        if (tid < 32) ehist[tid] = 0;
        __syncthreads();
        if (tid < 128) {
            const float rs = rsd[tid];
            ((float*)(ws + WS_RSTD2))[row0 + tid] = rs;
            float gl[4]; int gi = 0; float gm = -1e30f;
#pragma unroll
            for (int c = 0; c < 4; ++c) { gl[c] = lg[tid * 49 + c] * rs + p.b_group[c]; if (gl[c] > gm) { gm = gl[c]; gi = c; } }
            float gs = 0.f;
#pragma unroll
            for (int c = 0; c < 4; ++c) gs += __expf(gl[c] - gm);
            const float pg = 1.f / gs;
            float el[8]; int i0 = 0; float m0 = -1e30f;
#pragma unroll
            for (int c = 0; c < 8; ++c) { el[c] = lg[tid * 49 + 4 + gi * 8 + c] * rs + p.b_expert[gi * 8 + c]; if (el[c] > m0) { m0 = el[c]; i0 = c; } }
            int i1 = 0; float m1 = -1e30f;
#pragma unroll
            for (int c = 0; c < 8; ++c) if (c != i0 && el[c] > m1) { m1 = el[c]; i1 = c; }
            const float e1 = __expf(m1 - m0); const float w0 = pg / (1.f + e1), w1 = pg * e1 / (1.f + e1);
            const int a = min(i0, i1), bb = max(i0, i1);
            bin = gi * 28 + (7 * a - (a * (a - 1)) / 2) + (bb - a - 1);
            wa = (i0 < i1) ? w0 : w1; wb = (i0 < i1) ? w1 : w0; ea = gi * 8 + a; eb = gi * 8 + bb;
            slot = atomicAdd(&hist[bin], 1);
            sa = atomicAdd(&ehist[ea], 1); sb = atomicAdd(&ehist[eb], 1);
        }
        __syncthreads();
        if (tid < NBIN) { const int h = hist[tid]; basep[tid] = h ? atomicAdd((int*)(ws + WS_CTL) + tid, h) : 0; }
        else if (tid >= 128 && tid < 160) { const int e = tid - 128; const int h = ehist[e]; ebase[e] = h ? atomicAdd((int*)(ws + WS_CTL + 512) + e, h) : 0; }
        __syncthreads();
        if (tid < 128) {
            const int t = (int)(row0 + tid);
            ((int*)(ws + WS_BINL))[(size_t)bin * BINCAP + basep[bin] + slot] = t;
            sa += ebase[ea]; sb += ebase[eb];
            ((int*)(ws + WS_EL))[(size_t)ea * BINCAP + sa] = t; ((float*)(ws + WS_EW))[(size_t)ea * BINCAP + sa] = wa;
            ((int*)(ws + WS_EL))[(size_t)eb * BINCAP + sb] = t; ((float*)(ws + WS_EW))[(size_t)eb * BINCAP + sb] = wb;
            { const unsigned dpos = (unsigned)bin | ((unsigned)(basep[bin] + slot) << 7); ((unsigned*)(ws + WS_EDST))[(size_t)ea * BINCAP + sa] = dpos; ((unsigned*)(ws + WS_EDST))[(size_t)eb * BINCAP + sb] = dpos | (1u << 22); }
        }
        __syncthreads();
    }
}

constexpr int MOE_TS = pg8::STAGE_BYTES, MOE_TT = MOE_TS + 512, MOE_ES = MOE_TT + 1024, MOE_ET = MOE_ES + 256;
DEV void moe_tiles(const Params& p, unsigned char* lds) {
    int* tstart = (int*)(lds + MOE_TS); int* tiletab = (int*)(lds + MOE_TT); int* etstart = (int*)(lds + MOE_ES); int* etiletab = (int*)(lds + MOE_ET);
    const int tid = threadIdx.x;
    __syncthreads();
    if (tid == 0) { const int* cnt = (const int*)(p.ws + WS_CTL); int s = 0; for (int i = 0; i < NBIN; ++i) { tstart[i] = s; s += (cnt[i] + 255) >> 8; } tstart[NBIN] = s; }
    if (tid == 64) { const int* cnt = (const int*)(p.ws + WS_CTL + 512); int s = 0; for (int i = 0; i < 32; ++i) { etstart[i] = s; s += (cnt[i] + 255) >> 8; } etstart[32] = s; }
    __syncthreads();
    if (tid < NBIN) for (int t = tstart[tid]; t < tstart[tid + 1]; ++t) tiletab[t] = tid;
    if (tid >= 128 && tid < 160) for (int t = etstart[tid - 128]; t < etstart[tid - 127]; ++t) etiletab[t] = tid - 128;
    __syncthreads();
}
DEV void bin_experts(int bin, int& ea, int& eb) { const int gi = bin / 28; int pi = bin % 28, a = 0; while (pi >= 7 - a) { pi -= 7 - a; ++a; } ea = gi * 8 + a; eb = gi * 8 + a + 1 + pi; }
DEV void lane_rc(int i, int& R, int& C) { pg8::stage_rc((int)threadIdx.x * 16, R, C); R += 64 * i; }
struct MoeUnit { int tile, nt, bin, mt, n; };
struct PolMoe1 {
    typedef MoeUnit Unit;
    const Params& p; const int* etstart; const int* etiletab; int U, G, c;
    struct AddrA { unsigned off[2][2]; };
    struct AddrB { const char* base; };
    DEV int nk() const { return 16; }
    DEV bool next(int i, MoeUnit& u) const {
        const int L = i * G + c; if (L >= U) return false;
        u.tile = L >> 2; u.nt = L & 3;
        u.bin = __builtin_amdgcn_readfirstlane(etiletab[u.tile]);
        u.mt = u.tile - __builtin_amdgcn_readfirstlane(etstart[u.bin]);
        u.n = min(256, ((const int*)(p.ws + WS_CTL + 512))[u.bin] - u.mt * 256);
        return true;
    }
    DEV bool full(const MoeUnit& u) const { return u.n > 128; }
    DEV void addrA(const MoeUnit& u, AddrA& a) const {
        const int* list = (const int*)(p.ws + WS_EL) + (size_t)u.bin * BINCAP + u.mt * 256;
#pragma unroll
        for (int i = 0; i < 2; ++i) { int R, C; lane_rc(i, R, C);
#pragma unroll
            for (int h = 0; h < 2; ++h) { int r = h * 128 + R; if (r >= u.n) r = 0; a.off[h][i] = (unsigned)list[r] * 2048u + (unsigned)C * 2u; } }
    }
    DEV void addrB(const MoeUnit& u, AddrB& b) const { b.base = (const char*)(p.ws + WS_W13T) + ((size_t)u.bin * 1024 + u.nt * 256) * 2048; }
    DEV const char* pa(const AddrA& a, int h, int i, int kt) const { return (const char*)(p.ws + WS_R1) + a.off[h][i] + kt * 128; }
    DEV const char* pb(const AddrB& b, int h, int i, int kt) const { int R, C; lane_rc(i, R, C); return b.base + (size_t)h * (128 * 2048) + (unsigned)(R * 1024 + C) * 2u + kt * 128; }
};
struct EpiMoe1 { const Params& p; const int* tstart;
    DEV void operator()(const f32x4 (&acc)[2][2][4][2], const MoeUnit& u, int wr, int wc, int fr, int fq) const {
        const int* list = (const int*)(p.ws + WS_EL) + (size_t)u.bin * BINCAP + u.mt * 256;
        const float* wl = (const float*)(p.ws + WS_EW) + (size_t)u.bin * BINCAP + u.mt * 256;
        const unsigned* dl = (const unsigned*)(p.ws + WS_EDST) + (size_t)u.bin * BINCAP + u.mt * 256;
        const int r0 = wr * 64 + fr;
        int tk[2][4]; float ww[2][4]; unsigned dd[2][4];
#pragma unroll
        for (int ai = 0; ai < 2; ++ai)
#pragma unroll
            for (int m = 0; m < 4; ++m) { int r = r0 + ai * 128 + m * 16; if (r >= u.n) r = 0; tk[ai][m] = list[r]; ww[ai][m] = wl[r]; dd[ai][m] = dl[r]; }
        float rsv[2][4];
#pragma unroll
        for (int ai = 0; ai < 2; ++ai)
#pragma unroll
            for (int m = 0; m < 4; ++m) rsv[ai][m] = ((const float*)(p.ws + WS_RSTD2))[tk[ai][m]];
        const int f = (u.nt * 256 + 32 * wc + 8 * fq) >> 1;
#pragma unroll
        for (int ai = 0; ai < 2; ++ai)
#pragma unroll
            for (int m = 0; m < 4; ++m) { if (r0 + ai * 128 + m * 16 >= u.n) continue;
                const float rs = rsv[ai][m], w = ww[ai][m]; const unsigned d = dd[ai][m];
                bf16_t* hrow = (bf16_t*)(p.ws + WS_HBUF) + ((size_t)tstart[d & 127u] * 256 + ((d >> 7) & 32767u)) * 1024 + ((d >> 22) & 1u) * 512 + f;
#pragma unroll
                for (int bj = 0; bj < 2; ++bj) { const f32x4 v0 = acc[ai][bj][m][0] * rs, v1 = acc[ai][bj][m][1] * rs;
                    u32x2 w2; w2.x = pk2(siluf_(v0.x) * v0.y * w, siluf_(v0.z) * v0.w * w); w2.y = pk2(siluf_(v1.x) * v1.y * w, siluf_(v1.z) * v1.w * w); *(u32x2*)(hrow + 64 * bj) = w2; } }
    } };
DEV void phase_moe1(const Params& p, unsigned char* lds) {
    moe_tiles(p, lds);
    const int* etstart = (const int*)(lds + MOE_ES);
    PolMoe1 P{p, etstart, (const int*)(lds + MOE_ET), etstart[32] * 4, (int)gridDim.x, vblock()};
    EpiMoe1 E{p, (const int*)(lds + MOE_TS)};
    pg8::gemm_phase2(( PG8_LAS unsigned char*)lds, P, E);
}
struct PolMoe2 {
    typedef MoeUnit Unit;
    const Params& p; const int* tstart; const int* tiletab; int U, G, c;
    struct AddrA { const char* base; };
    struct AddrB { const char* ba; const char* bb; };
    DEV int nk() const { return 16; }
    DEV bool next(int i, MoeUnit& u) const {
        const int L = i * G + c; if (L >= U) return false;
        u.tile = L >> 2; u.nt = L & 3;
        u.bin = __builtin_amdgcn_readfirstlane(tiletab[u.tile]);
        u.mt = u.tile - __builtin_amdgcn_readfirstlane(tstart[u.bin]);
        u.n = min(256, ((const int*)(p.ws + WS_CTL))[u.bin] - u.mt * 256);
        return true;
    }
    DEV bool full(const MoeUnit& u) const { return u.n > 128; }
    DEV void addrA(const MoeUnit& u, AddrA& a) const { a.base = (const char*)(p.ws + WS_HBUF) + (size_t)u.tile * 256 * 2048; }
    DEV void addrB(const MoeUnit& u, AddrB& b) const {
        int ea, eb; bin_experts(u.bin, ea, eb);
        b.ba = (const char*)(p.ws + WS_W2T) + ((size_t)ea * 1024 + u.nt * 256) * 1024; b.bb = (const char*)(p.ws + WS_W2T) + ((size_t)eb * 1024 + u.nt * 256) * 1024;
    }
    DEV const char* pa(const AddrA& a, int h, int i, int kt) const { int R, C; lane_rc(i, R, C); return a.base + (size_t)h * (128 * 2048) + (unsigned)(R * 1024 + C) * 2u + kt * 128; }
    DEV const char* pb(const AddrB& b, int h, int i, int kt) const { int R, C; lane_rc(i, R, C); return (kt < 8 ? b.ba + kt * 128 : b.bb + (kt - 8) * 128) + (size_t)h * (128 * 1024) + (unsigned)(R * 512 + C) * 2u; }
};
struct EpiMoe2 { const Params& p;
    DEV void operator()(const f32x4 (&acc)[2][2][4][2], const MoeUnit& u, int wr, int wc, int fr, int fq) const {
        const int* list = (const int*)(p.ws + WS_BINL) + (size_t)u.bin * BINCAP + u.mt * 256;
        const int r0 = wr * 64 + fr;
        int tk[2][4];
#pragma unroll
        for (int ai = 0; ai < 2; ++ai)
#pragma unroll
            for (int m = 0; m < 4; ++m) { int r = r0 + ai * 128 + m * 16; if (r >= u.n) r = 0; tk[ai][m] = list[r]; }
        const int c0 = u.nt * 256 + 32 * wc + 4 * fq;
#pragma unroll
        for (int ai = 0; ai < 2; ++ai)
#pragma unroll
            for (int m = 0; m < 4; ++m) { if (r0 + ai * 128 + m * 16 >= u.n) continue;
                float* o = p.out + (size_t)tk[ai][m] * DM + c0;
                const f32x4 h0 = *(const f32x4*)(o), h1 = *(const f32x4*)(o + 16), h2 = *(const f32x4*)(o + 128), h3 = *(const f32x4*)(o + 144);
                *(f32x4*)(o) = h0 + acc[ai][0][m][0]; *(f32x4*)(o + 16) = h1 + acc[ai][0][m][1]; *(f32x4*)(o + 128) = h2 + acc[ai][1][m][0]; *(f32x4*)(o + 144) = h3 + acc[ai][1][m][1]; }
    } };
DEV void phase_moe2(const Params& p, unsigned char* lds) {
    moe_tiles(p, lds);
    const int* tstart = (const int*)(lds + MOE_TS);
    PolMoe2 P{p, tstart, (const int*)(lds + MOE_TT), tstart[NBIN] * 4, (int)gridDim.x, vblock()};
    EpiMoe2 E{p};
    pg8::gemm_phase2((PG8_LAS unsigned char*)lds, P, E);
}

#define XB_TMO      128
#define XB_XCNT(j)  (256  + 64 * (j))
#define XB_XSUB(j)  (1280 + 64 * (j))
#define XB_XGEN(j)  (2304 + 64 * (j))
#define XB_TOP      3328
#define XB_TOPGEN   3392
#define XCD_BAR_WORDS 3456
#define XB_SPIN_CAP (1u << 20)
#define LAS __attribute__((address_space(3)))
constexpr size_t WS_BAR = WS_CTL + 4096;
DEV unsigned xb_ld(unsigned* p) { return __hip_atomic_load(p, __ATOMIC_RELAXED, __HIP_MEMORY_SCOPE_AGENT); }
DEV unsigned xb_add(unsigned* p, unsigned v) { return __hip_atomic_fetch_add(p, v, __ATOMIC_RELAXED, __HIP_MEMORY_SCOPE_AGENT); }
DEV unsigned xb_xcc_id() { return (unsigned)__builtin_amdgcn_s_getreg((3 << 11) | 20) & 0xFu; }
#define XB_SPIN(cond, bar) do { unsigned _sp = 0; while (cond) { __builtin_amdgcn_s_sleep(1); \
    if ((++_sp & 255u) == 0u) { if (xb_ld(&(bar)[XB_TMO])) break; if (_sp > XB_SPIN_CAP) { atomicAdd(&(bar)[XB_TMO], 1u); break; } } } } while (0)
struct XcdBarrier { unsigned* bar; unsigned x; volatile LAS unsigned* st; };
DEV XcdBarrier xcd_barrier_post(unsigned* bar, volatile LAS unsigned* st) {
    XcdBarrier b; b.bar = bar; b.x = xb_xcc_id(); b.st = st;
    if (threadIdx.x == 0) (void)xb_add(&bar[XB_XCNT(b.x)], 1u);
    return b;
}
DEV void xcd_barrier_complete(unsigned* bar, unsigned x, unsigned& nloc, unsigned& nx) {
    const unsigned G = gridDim.x * gridDim.y * gridDim.z;
    unsigned sum, cnt, mine, sp = 0u;
    for (;;) {
        sum = 0u; cnt = 0u; mine = 0u;
#pragma unroll
        for (unsigned j = 0; j < 16; ++j) { const unsigned c = xb_ld(&bar[XB_XCNT(j)]); sum += c; cnt += (c > 0u) ? 1u : 0u; mine = (j == x) ? c : mine; }
        if (sum == G) break;
        __builtin_amdgcn_s_sleep(1);
        if ((++sp & 255u) == 0u) { if (xb_ld(&bar[XB_TMO])) break; if (sp > XB_SPIN_CAP) { atomicAdd(&bar[XB_TMO], 1u); break; } }
    }
    nloc = mine > 0u ? mine : 1u; nx = cnt > 0u ? cnt : 1u;
}
DEV void xcd_barrier(const XcdBarrier& b) {
    asm volatile("s_waitcnt vmcnt(0)" ::: "memory");
    __syncthreads();
    if (threadIdx.x == 0) {
        unsigned* bar = b.bar;
        __builtin_amdgcn_s_waitcnt(0);
        unsigned nloc = b.st[0], nx = b.st[1];
        if (nloc == 0u) { xcd_barrier_complete(bar, b.x, nloc, nx); b.st[0] = nloc; b.st[1] = nx; }
        const unsigned old = xb_add(&bar[XB_XSUB(b.x)], 1u);
        const unsigned gen = old / nloc;
        if (old + 1u == (gen + 1u) * nloc) {
            __builtin_amdgcn_fence(__ATOMIC_RELEASE, "agent");
            asm volatile("s_waitcnt vmcnt(0)" ::: "memory");
            const unsigned og = xb_add(&bar[XB_TOP], 1u);
            const unsigned tg = og / nx;
            if (og + 1u == (tg + 1u) * nx) xb_add(&bar[XB_TOPGEN], 1u);
            else XB_SPIN(xb_ld(&bar[XB_TOPGEN]) == tg, bar);
            __builtin_amdgcn_fence(__ATOMIC_ACQUIRE, "agent");
            xb_add(&bar[XB_XGEN(b.x)], 1u);
            asm volatile("s_waitcnt vmcnt(0)" ::: "memory");
        } else {
            XB_SPIN(xb_ld(&bar[XB_XGEN(b.x)]) == gen, bar);
            __builtin_amdgcn_fence(__ATOMIC_ACQUIRE, "agent");
            asm volatile("s_waitcnt vmcnt(0)" ::: "memory");
        }
    }
    __syncthreads();
}

constexpr int LDS_BYTES = 144 * 1024;
constexpr int N_PHASES = 9;
__global__ void __launch_bounds__(NT) mega(Params p, int lo, int hi) {
    extern __shared__ __attribute__((aligned(16))) unsigned char lds[];
    volatile LAS unsigned* xst = (volatile LAS unsigned*)(lds + LDS_BYTES - 16);
    if (threadIdx.x < 4) xst[threadIdx.x] = 0u;
    __syncthreads();
    XcdBarrier xbar; xbar.bar = (unsigned*)(p.ws + WS_BAR); xbar.x = 0; xbar.st = xst;
    if (hi - lo > 1) xbar = xcd_barrier_post((unsigned*)(p.ws + WS_BAR), xst);
#define GRID_SYNC() xcd_barrier(xbar)
#ifndef PROBE_REPEAT
#define PROBE_REPEAT -1
#endif
#define RUN_PHASE(k, call) do { if (lo <= (k) && (k) < hi) { call; \
        if ((k) == PROBE_REPEAT) { GRID_SYNC(); \
            if ((k) == 5) { float* rz = (float*)(p.ws + WS_ROWSS); for (int i = blockIdx.x * NT + threadIdx.x; i < NTOK; i += gridDim.x * NT) rz[i] = 0.f; GRID_SYNC(); } \
            if ((k) == 7) { if (blockIdx.x == 0 && threadIdx.x < 128) ((int*)(p.ws + WS_CTL))[threadIdx.x] = 0; GRID_SYNC(); } \
            call; } \
        if ((k) + 1 < hi) GRID_SYNC(); } } while (0)
    RUN_PHASE(0, phase_prologue(p, lds));
    RUN_PHASE(1, phase_inproj(p, lds));
    RUN_PHASE(2, { phase_cmp_a(p, lds); const int G_ = (int)gridDim.x; if (G_ > 128) phase_hgrn_a1(p, lds, 64, G_ - 64); else phase_hgrn_a1(p, lds, 0, G_); });
    RUN_PHASE(3, { phase_cmp_b(p, lds); phase_hgrn_a2(p, lds); });
    RUN_PHASE(4, { phase_cmp_attn(p, lds); phase_hgrn_a3(p, lds); });
    RUN_PHASE(5, { phase_flash(p, lds); phase_normalize(p, lds); });
    RUN_PHASE(6, phase_outproj(p, lds));
    RUN_PHASE(7, phase_router(p, lds));
    RUN_PHASE(8, phase_moe1(p, lds));
    RUN_PHASE(9, phase_moe2(p, lds));
#undef RUN_PHASE
}

extern "C" void kernel_launch(void* const* d_in, const int* in_sizes, int n_in, void* d_out, int out_size, void* d_ws, size_t ws_size, hipStream_t stream) {
    static int grid = 0;
    if (grid == 0) {
        int dev = 0, cus = 0, per_cu = 0;
        hipGetDevice(&dev);
        hipDeviceGetAttribute(&cus, hipDeviceAttributeMultiprocessorCount, dev);
        hipFuncSetAttribute((const void*)mega, hipFuncAttributeMaxDynamicSharedMemorySize, LDS_BYTES);
        hipOccupancyMaxActiveBlocksPerMultiprocessor(&per_cu, (const void*)mega, NT, LDS_BYTES);
        if (per_cu < 1) per_cu = 1;
        grid = cus;
        if (ws_size < WS_END) fprintf(stderr, "kernel_launch: workspace too small: %zu < %zu\n", ws_size, (size_t)WS_END);
        fprintf(stderr, "kernel_launch: cus %d per_cu %d grid %d ws %zu\n", cus, per_cu, grid, ws_size);
    }
    Params p{};
    const float** pp = (const float**)&p;
    for (int i = 0; i < 23; ++i) pp[i] = (const float*)d_in[i];
    p.out = (float*)d_out; p.ws = (unsigned char*)d_ws;
#if N_LAUNCH_MODE == 1
    (void)hipMemsetAsync((unsigned char*)d_ws + WS_BAR, 0, XCD_BAR_WORDS * 4, stream);
    int lo = 0, hi = N_PHASES + 1;
    void* args[] = {&p, &lo, &hi};
    hipError_t e = hipLaunchCooperativeKernel((const void*)mega, dim3(grid), dim3(NT), args, LDS_BYTES, stream);
    if (e != hipSuccess) fprintf(stderr, "cooperative launch failed: %s\n", hipGetErrorString(e));
#else
    for (int ph = 0; ph <= N_PHASES; ++ph) hipLaunchKernelGGL(mega, dim3(grid), dim3(NT), LDS_BYTES, stream, p, ph, ph + 1);
#endif
}
```

```cpp
#include <hip/hip_runtime.h>
#include <hip/hip_cooperative_groups.h>
#include <cstdio>
#include <cstdint>
#include <cstring>
namespace cg = cooperative_groups;

#ifndef N_LAUNCH_MODE
#define N_LAUNCH_MODE 1
#endif

#define DEV __device__ __forceinline__
typedef unsigned short bf16_t;
typedef short bf16x8 __attribute__((ext_vector_type(8)));
typedef float f32x4 __attribute__((ext_vector_type(4)));
typedef float f32x2 __attribute__((ext_vector_type(2)));
typedef float f32x16 __attribute__((ext_vector_type(16)));
typedef unsigned u32x4 __attribute__((ext_vector_type(4)));
typedef unsigned u32x2 __attribute__((ext_vector_type(2)));

constexpr int NT = 512;
constexpr int BATCH = 8, SEQ = 4096, DM = 1024, NTOK = BATCH * SEQ;
constexpr int IN_COLS = 3352, INP = 3584;
constexpr int NC = 255;
constexpr float RMS_EPS = 1e-6f;
constexpr float QSCALE = 0.125f * 1.4426950408889634f;
constexpr int NBIN = 112;
constexpr int BINCAP = NTOK;

constexpr size_t MiB = 1ull << 20;
constexpr size_t WS_CTL    = 0;
constexpr size_t WS_RSTD1  = 1 * MiB;
constexpr size_t WS_RSTD2  = WS_RSTD1 + 128 * 1024;
constexpr size_t WS_ROWSS  = WS_RSTD2 + 128 * 1024;
constexpr size_t WS_TOKW   = WS_ROWSS + 128 * 1024;
constexpr size_t WS_LB     = WS_TOKW + 256 * 1024;
constexpr size_t WS_CBIAS  = WS_LB + 4096;
constexpr size_t WS_SELM   = 2 * MiB;
constexpr size_t WS_GATES  = 3 * MiB;
constexpr size_t WS_KCMP   = 6 * MiB;
constexpr size_t WS_VCMP   = WS_KCMP + 512 * 1024;
constexpr size_t WS_CW2T   = 7 * MiB;
constexpr size_t WS_RW     = 7 * MiB + 128 * 1024;
constexpr size_t WS_HID    = 8 * MiB;
constexpr size_t WS_CW1T   = 12 * MiB;
constexpr size_t WS_WOUTT  = 14 * MiB;
constexpr size_t WS_WINT   = 16 * MiB;
constexpr size_t WS_R1     = 24 * MiB;
constexpr size_t WS_Q      = 88 * MiB;
constexpr size_t WS_KC     = 120 * MiB;
constexpr size_t WS_VC     = 128 * MiB;
constexpr size_t WS_KS     = 136 * MiB;
constexpr size_t WS_KW     = 144 * MiB;
constexpr size_t WS_VST    = 152 * MiB;
constexpr size_t WS_VWT    = 160 * MiB;
constexpr size_t WS_OC     = 168 * MiB;
constexpr size_t WS_W13T   = 200 * MiB;
constexpr size_t WS_W2T    = 264 * MiB;
constexpr size_t WS_HQ     = 296 * MiB;
constexpr size_t WS_HV     = 328 * MiB;
constexpr size_t WS_HG     = 360 * MiB;
constexpr size_t WS_HLOGF  = 392 * MiB;
constexpr size_t WS_DBUF   = 456 * MiB;
constexpr size_t WS_END    = 457 * MiB;
constexpr size_t WS_UBUF   = WS_W13T;
constexpr size_t WS_BINL   = WS_HQ;
constexpr size_t WS_HBUF   = WS_HQ + 16 * MiB;
constexpr size_t WS_EL     = WS_HQ + 136 * MiB;
constexpr size_t WS_EW     = WS_HQ + 140 * MiB;
constexpr size_t WS_EDST   = WS_HQ + 144 * MiB;

struct Params {
    const float *x, *attn_g, *ffn_g, *w_in, *w_out, *g_q, *g_k, *pos_k, *pos_v, *wk1, *wk2, *wv1, *wv2, *g_nsa, *lb_logits, *g_hn,
        *w_group, *b_group, *w_expert, *b_expert, *w1, *w3, *w2;
    float* out;
    unsigned char* ws;
};

typedef __bf16 bf16x2_t __attribute__((ext_vector_type(2)));
DEV unsigned pk2(float lo, float hi) { f32x2 f = {lo, hi}; return __builtin_bit_cast(unsigned, __builtin_convertvector(f, bf16x2_t)); }
DEV bf16_t f2bf(float f) { return (bf16_t)(pk2(f, 0.f) & 0xffffu); }
DEV float bf2f(bf16_t b) { return __uint_as_float(((unsigned)b) << 16); }
DEV float bflo(unsigned u) { return __uint_as_float(u << 16); }
DEV float bfhi(unsigned u) { return __uint_as_float(u & 0xffff0000u); }
DEV float sigmoidf_(float v) { return __builtin_amdgcn_rcpf(1.f + __builtin_amdgcn_exp2f(-1.4426950408889634f * v)); }
DEV float siluf_(float v) { return v * __builtin_amdgcn_rcpf(1.f + __builtin_amdgcn_exp2f(-1.4426950408889634f * v)); }
DEV float wave_sum(float v) {
#pragma unroll
    for (int o = 1; o < 64; o <<= 1) v += __shfl_xor(v, o);
    return v;
}
DEV float wave_max(float v) {
#pragma unroll
    for (int o = 1; o < 64; o <<= 1) v = fmaxf(v, __shfl_xor(v, o));
    return v;
}
DEV int vblock() { const int G = gridDim.x, b = blockIdx.x; return (G % 8 == 0) ? (b % 8) * (G / 8) + b / 8 : b; }

namespace pg8 {
#define PG8_LAS __attribute__((address_space(3)))
constexpr int BM = 256, BK = 64, HALF = 128, HTB = HALF * BK * 2, STAGE_BYTES = 8 * HTB, NXCD = 8, WGM = 1;
__host__ __device__ __forceinline__ int lds_byte(int r, int c) { const int st = (r >> 4) * 2 + (c >> 5), rr = r & 15, cc = c & 31, ob = rr * 64 + cc * 2; return st * 1024 + (ob ^ (((ob >> 9) & 1) << 5)); }
__host__ __device__ __forceinline__ void stage_rc(int b, int& R, int& C) { const int st = b / 1024, sb = b % 1024, swz = sb ^ (((sb >> 9) & 1) << 5); R = (st >> 1) * 16 + swz / 64; C = (st & 1) * 32 + (swz % 64) / 2; }
struct Unit { int pm, pn; };
struct Gemm { const bf16_t* A; const bf16_t* Bt; int M, N, K; };
struct StaticOrder {
    int nM, nN, nwg, G, c;
    __host__ __device__ void init(int M, int N, int G_, int c_) { nM = M / BM; nN = N / BM; nwg = nM * nN; G = G_; c = c_; }
    __host__ __device__ bool next(int i, Unit& u) const {
        const long L = (long)i * G + c; if (L >= nwg) return false;
        int wgid = (int)L; { const int q = nwg / NXCD, r = nwg % NXCD, xcd = wgid % NXCD, off = wgid / NXCD; wgid = (xcd < r ? xcd * (q + 1) : r * (q + 1) + (xcd - r) * q) + off; }
        const int nig = WGM * nN, gid = wgid / nig, fm = gid * WGM, gsz = (nM - fm) < WGM ? (nM - fm) : WGM;
        u.pm = fm + ((wgid % nig) % gsz); u.pn = (wgid % nig) / gsz; return true;
    }
};
template <class Epi, class Sched>
__device__ __forceinline__ void gemm_phase(PG8_LAS unsigned char* lds, const Gemm g, const Sched& S, const Epi& E) {
    const int tid = threadIdx.x, wid = __builtin_amdgcn_readfirstlane(tid >> 6), lane = tid & 63, wr = wid >> 2, wc = wid & 3, fr = lane & 15, fq = lane >> 4;
    const int K = g.K, nt = K / BK;
    unsigned voffA[2];
#pragma unroll
    for (int i = 0; i < 2; ++i) { int R, C; stage_rc(tid * 16 + i * 8192, R, C); voffA[i] = (unsigned)(R * K + C) * 2u; }
    const size_t kstep = (size_t)(BK * 2);
    const size_t hstep = (size_t)HALF * K * 2;
    const size_t tstep = 2 * hstep;
    const unsigned ldsw = (unsigned)wid * 1024u;
    const int aoff = lds_byte(wr * 64 + fr, fq * 8), boff = lds_byte(wc * 32 + fr, fq * 8);
#define PG8_SA(b, h) (((b) * 2 + (h)) * HTB)
#define PG8_SB(b, h) ((4 + (b) * 2 + (h)) * HTB)
#define PG8_STAGE(bufoff, gbase, voff) do { _Pragma("unroll") for (int _i = 0; _i < 2; ++_i) \
        __builtin_amdgcn_global_load_lds((const unsigned*)((const char*)(gbase) + (voff)[_i]), (PG8_LAS unsigned*)(lds + (bufoff) + ldsw + _i * 8192), 16, 0, 0); } while (0)
#define PG8_LDA(dst, b, h) do { _Pragma("unroll") for (int m = 0; m < 4; ++m) _Pragma("unroll") for (int k = 0; k < 2; ++k) dst[m][k] = *(const PG8_LAS bf16x8*)(lds + PG8_SA(b, h) + aoff + m * 2048 + k * 1024); } while (0)
#define PG8_LDB(dst, b, h) do { _Pragma("unroll") for (int n = 0; n < 2; ++n) _Pragma("unroll") for (int k = 0; k < 2; ++k) dst[n][k] = *(const PG8_LAS bf16x8*)(lds + PG8_SB(b, h) + boff + n * 2048 + k * 1024); } while (0)
#define PG8_MMA(ai, bj, At, Bt) do { __builtin_amdgcn_s_setprio(1); _Pragma("unroll") for (int m = 0; m < 4; ++m) _Pragma("unroll") for (int n = 0; n < 2; ++n) _Pragma("unroll") for (int k = 0; k < 2; ++k) \
        acc[ai][bj][m][n] = __builtin_amdgcn_mfma_f32_16x16x32_bf16(Bt[n][k], At[m][k], acc[ai][bj][m][n], 0, 0, 0); __builtin_amdgcn_s_setprio(0); } while (0)
#define PG8_WAIT_V(n) asm volatile("s_waitcnt vmcnt(" #n ")" ::: "memory")
#define PG8_WAIT_L(n) asm volatile("s_waitcnt lgkmcnt(" #n ")" ::: "memory")
#define PG8_BAR __builtin_amdgcn_s_barrier()
#define PG8_SCHED __builtin_amdgcn_sched_barrier(0)
    Unit cur, nxt; int ui = 0;
    if (!S.next(0, cur)) return;
    f32x4 acc[2][2][4][2];
#pragma unroll
    for (int a = 0; a < 2; ++a)
#pragma unroll
        for (int b = 0; b < 2; ++b)
#pragma unroll
            for (int m = 0; m < 4; ++m)
#pragma unroll
                for (int n = 0; n < 2; ++n) acc[a][b][m][n] = (f32x4){0.f, 0.f, 0.f, 0.f};
    bf16x8 At[4][2], B0[2][2], B1[2][2];
    const char* cA = (const char*)g.A + (size_t)cur.pm * tstep; const char* cB = (const char*)g.Bt + (size_t)cur.pn * tstep;
    PG8_STAGE(PG8_SB(0, 0), cB, voffA); PG8_STAGE(PG8_SA(0, 0), cA, voffA); PG8_STAGE(PG8_SB(0, 1), cB + hstep, voffA); PG8_STAGE(PG8_SA(0, 1), cA + hstep, voffA);
    if (wr == 1) PG8_BAR;
    PG8_WAIT_V(4); PG8_BAR;
    PG8_STAGE(PG8_SB(1, 0), cB + kstep, voffA); PG8_STAGE(PG8_SA(1, 0), cA + kstep, voffA); PG8_STAGE(PG8_SB(1, 1), cB + hstep + kstep, voffA);
    PG8_WAIT_V(6); PG8_BAR;
    for (;;) {
        const bool has_next = S.next(ui + 1, nxt);
        const char* nA = has_next ? (const char*)g.A + (size_t)nxt.pm * tstep : cA; const char* nB = has_next ? (const char*)g.Bt + (size_t)nxt.pn * tstep : cB;
        float midrs[2][4];
        if constexpr (Epi::MIDSCALE) {
#pragma unroll
            for (int a = 0; a < 2; ++a)
#pragma unroll
                for (int m = 0; m < 4; ++m) midrs[a][m] = E.rowscale(cur.pm * BM + a * HALF + wr * 64 + m * 16 + fr); }
        for (int t = 0; t < nt; t += 2) {
            const bool last = (t == nt - 2);
            if constexpr (Epi::MIDSCALE) { if (t == E.midk()) {
#pragma unroll
                for (int a = 0; a < 2; ++a)
#pragma unroll
                    for (int b = 0; b < 2; ++b)
#pragma unroll
                        for (int m = 0; m < 4; ++m)
#pragma unroll
                            for (int n = 0; n < 2; ++n) acc[a][b][m][n] = acc[a][b][m][n] * midrs[a][m]; } }
            const char* a1 = cA + (size_t)(t + 1) * kstep;
            const char* a2 = last ? nA : cA + (size_t)(t + 2) * kstep; const char* b2 = last ? nB : cB + (size_t)(t + 2) * kstep;
            const char* a3 = a2 + kstep; const char* b3 = b2 + kstep;
            PG8_LDB(B0, 0, 0); PG8_SCHED; PG8_LDA(At, 0, 0); PG8_STAGE(PG8_SA(1, 1), a1 + hstep, voffA);
            PG8_WAIT_L(8); PG8_BAR; PG8_WAIT_L(0); PG8_MMA(0, 0, At, B0); PG8_BAR; PG8_SCHED;
            PG8_LDB(B1, 0, 1); PG8_STAGE(PG8_SB(0, 0), b2, voffA);
            PG8_BAR; PG8_WAIT_L(0); PG8_MMA(0, 1, At, B1); PG8_BAR;
            PG8_LDA(At, 0, 1); PG8_STAGE(PG8_SA(0, 0), a2, voffA);
            PG8_BAR; PG8_WAIT_L(0); PG8_MMA(1, 0, At, B0); PG8_BAR; PG8_SCHED;
            PG8_STAGE(PG8_SB(0, 1), b2 + hstep, voffA);
            PG8_WAIT_V(6); PG8_BAR; PG8_MMA(1, 1, At, B1); PG8_BAR;
            PG8_LDB(B0, 1, 0); PG8_SCHED; PG8_LDA(At, 1, 0); PG8_STAGE(PG8_SA(0, 1), a2 + hstep, voffA);
            PG8_WAIT_L(8); PG8_BAR; PG8_WAIT_L(0); PG8_MMA(0, 0, At, B0); PG8_BAR; PG8_SCHED;
            PG8_LDB(B1, 1, 1); PG8_STAGE(PG8_SB(1, 0), b3, voffA);
            PG8_BAR; PG8_WAIT_L(0); PG8_MMA(0, 1, At, B1); PG8_BAR;
            PG8_LDA(At, 1, 1); PG8_STAGE(PG8_SA(1, 0), a3, voffA);
            PG8_BAR; PG8_WAIT_L(0); PG8_MMA(1, 0, At, B0); PG8_BAR; PG8_SCHED;
            PG8_STAGE(PG8_SB(1, 1), b3 + hstep, voffA);
            PG8_WAIT_V(6); PG8_BAR; PG8_MMA(1, 1, At, B1); PG8_BAR;
        }
        E(acc, cur, wr, wc, fr, fq);
        if (!has_next) break;
#pragma unroll
        for (int a = 0; a < 2; ++a)
#pragma unroll
            for (int b = 0; b < 2; ++b)
#pragma unroll
                for (int m = 0; m < 4; ++m)
#pragma unroll
                    for (int n = 0; n < 2; ++n) acc[a][b][m][n] = (f32x4){0.f, 0.f, 0.f, 0.f};
        cur = nxt; cA = nA; cB = nB; ++ui;
    }
    PG8_WAIT_V(0);
    if (wr == 0) PG8_BAR;
    PG8_BAR;
#undef PG8_SA
#undef PG8_SB
#undef PG8_STAGE
#undef PG8_LDA
#undef PG8_LDB
#undef PG8_MMA
#undef PG8_WAIT_V
#undef PG8_WAIT_L
#undef PG8_BAR
#undef PG8_SCHED
}
template <class Pol, class Epi>
__device__ __forceinline__ void gemm_phase2(PG8_LAS unsigned char* lds, const Pol& P, const Epi& E) {
    const int tid = threadIdx.x, wid = __builtin_amdgcn_readfirstlane(tid >> 6), lane = tid & 63, wr = wid >> 2, wc = wid & 3, fr = lane & 15, fq = lane >> 4;
    const int nt = P.nk();
    const unsigned ldsw = (unsigned)wid * 1024u;
    const int aoff = lds_byte(wr * 64 + fr, fq * 8), boff = lds_byte(wc * 32 + fr, fq * 8);
#define PG8_SA(b, h) (((b) * 2 + (h)) * HTB)
#define PG8_SB(b, h) ((4 + (b) * 2 + (h)) * HTB)
#define PG8_STAGE_A(bufoff, AS, h, kt) do { _Pragma("unroll") for (int _i = 0; _i < 2; ++_i) \
        __builtin_amdgcn_global_load_lds((const unsigned*)P.pa(AS, h, _i, kt), (PG8_LAS unsigned*)(lds + (bufoff) + ldsw + _i * 8192), 16, 0, 0); } while (0)
#define PG8_STAGE_B(bufoff, BS, h, kt) do { _Pragma("unroll") for (int _i = 0; _i < 2; ++_i) \
        __builtin_amdgcn_global_load_lds((const unsigned*)P.pb(BS, h, _i, kt), (PG8_LAS unsigned*)(lds + (bufoff) + ldsw + _i * 8192), 16, 0, 0); } while (0)
#define PG8_LDA(dst, b, h) do { _Pragma("unroll") for (int m = 0; m < 4; ++m) _Pragma("unroll") for (int k = 0; k < 2; ++k) dst[m][k] = *(const PG8_LAS bf16x8*)(lds + PG8_SA(b, h) + aoff + m * 2048 + k * 1024); } while (0)
#define PG8_LDB(dst, b, h) do { _Pragma("unroll") for (int n = 0; n < 2; ++n) _Pragma("unroll") for (int k = 0; k < 2; ++k) dst[n][k] = *(const PG8_LAS bf16x8*)(lds + PG8_SB(b, h) + boff + n * 2048 + k * 1024); } while (0)
#define PG8_MMA(ai, bj, At, Bt) do { __builtin_amdgcn_s_setprio(1); _Pragma("unroll") for (int m = 0; m < 4; ++m) _Pragma("unroll") for (int n = 0; n < 2; ++n) _Pragma("unroll") for (int k = 0; k < 2; ++k) \
        acc[ai][bj][m][n] = __builtin_amdgcn_mfma_f32_16x16x32_bf16(Bt[n][k], At[m][k], acc[ai][bj][m][n], 0, 0, 0); __builtin_amdgcn_s_setprio(0); } while (0)
#define PG8_STAGE_A2(bufoff, h, kt) do { _Pragma("unroll") for (int _i = 0; _i < 2; ++_i) \
        __builtin_amdgcn_global_load_lds((const unsigned*)P.pa(a2, h, _i, kt), (PG8_LAS unsigned*)(lds + (bufoff) + ldsw + _i * 8192), 16, 0, 0); } while (0)
#define PG8_STAGE_B2(bufoff, h, kt) do { _Pragma("unroll") for (int _i = 0; _i < 2; ++_i) \
        __builtin_amdgcn_global_load_lds((const unsigned*)P.pb(b2, h, _i, kt), (PG8_LAS unsigned*)(lds + (bufoff) + ldsw + _i * 8192), 16, 0, 0); } while (0)
#define PG8_WAIT_V(n) asm volatile("s_waitcnt vmcnt(" #n ")" ::: "memory")
#define PG8_WAIT_L(n) asm volatile("s_waitcnt lgkmcnt(" #n ")" ::: "memory")
#define PG8_BAR __builtin_amdgcn_s_barrier()
#define PG8_SCHED __builtin_amdgcn_sched_barrier(0)
    typename Pol::Unit cur, nxt; int ui = 0;
    if (!P.next(0, cur)) return;
    f32x4 acc[2][2][4][2];
#pragma unroll
    for (int a = 0; a < 2; ++a)
#pragma unroll
        for (int b = 0; b < 2; ++b)
#pragma unroll
            for (int m = 0; m < 4; ++m)
#pragma unroll
                for (int n = 0; n < 2; ++n) acc[a][b][m][n] = (f32x4){0.f, 0.f, 0.f, 0.f};
    bf16x8 At[4][2], B0[2][2], B1[2][2];
    typename Pol::AddrA aC, aN; typename Pol::AddrB bC, bN;
    P.addrA(cur, aC); P.addrB(cur, bC);
    PG8_STAGE_B(PG8_SB(0, 0), bC, 0, 0); PG8_STAGE_A(PG8_SA(0, 0), aC, 0, 0); PG8_STAGE_B(PG8_SB(0, 1), bC, 1, 0); PG8_STAGE_A(PG8_SA(0, 1), aC, 1, 0);
    if (wr == 1) PG8_BAR;
    PG8_WAIT_V(4); PG8_BAR;
    PG8_STAGE_B(PG8_SB(1, 0), bC, 0, 1); PG8_STAGE_A(PG8_SA(1, 0), aC, 0, 1); PG8_STAGE_B(PG8_SB(1, 1), bC, 1, 1);
    PG8_WAIT_V(6); PG8_BAR;
    for (;;) {
        const bool has_next = P.next(ui + 1, nxt);
        if (has_next) { P.addrA(nxt, aN); P.addrB(nxt, bN); } else { aN = aC; bN = bC; }
        const bool full = P.full(cur);
        for (int t = 0; t < nt; t += 2) {
            const bool last = (t == nt - 2);
            const typename Pol::AddrA a2 = last ? aN : aC; const typename Pol::AddrB b2 = last ? bN : bC;
            const int k2 = last ? 0 : t + 2, k3 = k2 + 1;
            PG8_LDB(B0, 0, 0); PG8_SCHED; PG8_LDA(At, 0, 0); PG8_STAGE_A(PG8_SA(1, 1), aC, 1, t + 1);
            PG8_WAIT_L(8); PG8_BAR; PG8_WAIT_L(0); PG8_MMA(0, 0, At, B0); PG8_BAR; PG8_SCHED;
            PG8_LDB(B1, 0, 1); PG8_STAGE_B2(PG8_SB(0, 0), 0, k2);
            PG8_BAR; PG8_WAIT_L(0); PG8_MMA(0, 1, At, B1); PG8_BAR;
            PG8_LDA(At, 0, 1); PG8_STAGE_A2(PG8_SA(0, 0), 0, k2);
            PG8_BAR; PG8_WAIT_L(0); if (full) PG8_MMA(1, 0, At, B0); PG8_BAR; PG8_SCHED;
            PG8_STAGE_B2(PG8_SB(0, 1), 1, k2);
            PG8_WAIT_V(6); PG8_BAR; if (full) PG8_MMA(1, 1, At, B1); PG8_BAR;
            PG8_LDB(B0, 1, 0); PG8_SCHED; PG8_LDA(At, 1, 0); PG8_STAGE_A2(PG8_SA(0, 1), 1, k2);
            PG8_WAIT_L(8); PG8_BAR; PG8_WAIT_L(0); PG8_MMA(0, 0, At, B0); PG8_BAR; PG8_SCHED;
            PG8_LDB(B1, 1, 1); PG8_STAGE_B2(PG8_SB(1, 0), 0, k3);
            PG8_BAR; PG8_WAIT_L(0); PG8_MMA(0, 1, At, B1); PG8_BAR;
            PG8_LDA(At, 1, 1); PG8_STAGE_A2(PG8_SA(1, 0), 0, k3);
            PG8_BAR; PG8_WAIT_L(0); if (full) PG8_MMA(1, 0, At, B0); PG8_BAR; PG8_SCHED;
            PG8_STAGE_B2(PG8_SB(1, 1), 1, k3);
            PG8_WAIT_V(6); PG8_BAR; if (full) PG8_MMA(1, 1, At, B1); PG8_BAR;
        }
        E(acc, cur, wr, wc, fr, fq);
        if (!has_next) break;
#pragma unroll
        for (int a = 0; a < 2; ++a)
#pragma unroll
            for (int b = 0; b < 2; ++b)
#pragma unroll
                for (int m = 0; m < 4; ++m)
#pragma unroll
                    for (int n = 0; n < 2; ++n) acc[a][b][m][n] = (f32x4){0.f, 0.f, 0.f, 0.f};
        cur = nxt; aC = aN; bC = bN; ++ui;
    }
    PG8_WAIT_V(0);
    if (wr == 0) PG8_BAR;
    PG8_BAR;
#undef PG8_SA
#undef PG8_SB
#undef PG8_STAGE_A
#undef PG8_STAGE_B
#undef PG8_STAGE_A2
#undef PG8_STAGE_B2
#undef PG8_LDA
#undef PG8_LDB
#undef PG8_MMA
#undef PG8_WAIT_V
#undef PG8_WAIT_L
#undef PG8_BAR
#undef PG8_SCHED
}
__host__ __device__ __forceinline__ int perm_lo(int x) { return (((x >> 2) & 3) << 3) | (((x >> 4) & 1) << 2) | (x & 3); }
__host__ __device__ __forceinline__ int inv_perm_lo(int y) { return (((y >> 2) & 1) << 4) | (((y >> 3) & 3) << 2) | (y & 3); }
__host__ __device__ __forceinline__ int logcol(int p) { return (p & ~255) + 64 * ((p >> 5) & 3) + 32 * ((p >> 7) & 1) + perm_lo(p & 31); }
}

template <class SRC>
DEV void convert_tile(float* tl, const SRC& src, bf16_t* dst, int ldd, int n0, int k0) {
    const int tid = threadIdx.x;
    {
        const int n = tid & 63;
#pragma unroll
        for (int i = 0; i < 8; ++i) { const int kk = (tid >> 6) + 8 * i; tl[kk * 65 + n] = src.get(n0 + n, k0 + kk); }
    }
    __syncthreads();
    {
        const int n = tid >> 3, kc = tid & 7;
        const float* s = tl + (kc * 8) * 65 + n;
        u32x4 o;
        o.x = pk2(s[0 * 65], s[1 * 65]); o.y = pk2(s[2 * 65], s[3 * 65]); o.z = pk2(s[4 * 65], s[5 * 65]); o.w = pk2(s[6 * 65], s[7 * 65]);
        *(u32x4*)(dst + (size_t)(n0 + n) * ldd + k0 + kc * 8) = o;
    }
    __syncthreads();
}
struct SrcWin { const float* w; const float* g;
    DEV float get(int np, int k) const { const int n = pg8::logcol(np); int col; if (n < 1280) col = n; else if (n < 3328) col = n + 24; else if (n < 3352) col = 1280 + (n - 3328); else return 0.f;
        return w[(size_t)k * IN_COLS + col] * g[k]; } };
struct SrcWout { const float* w; const float* g;
    DEV float get(int np, int k) const { const int n = pg8::logcol(np); const float v = w[(size_t)k * DM + n]; return k < 512 ? v * g[k] : v; } };
struct SrcPlain { const float* w; int ld;
    DEV float get(int n, int k) const { return w[(size_t)k * ld + n]; } };
struct SrcW13 { const float* w1; const float* w3; const float* g;
    DEV float get(int n, int k) const { const uintptr_t a = (uintptr_t)w1, b = (uintptr_t)w3; const float* w = (const float*)(a + ((b - a) & (uintptr_t)(0 - (long long)(n & 1))));
        return w[(size_t)k * 512 + (n >> 1)] * g[k]; } };

template <class SRC>
DEV void convert_tile256(float* tl, const SRC& src, bf16_t* dst, int ldd, int n0, int k0) {
    const int tid = threadIdx.x;
    {
        const int q = tid & 63;
        f32x4 v[8];
#pragma unroll
        for (int i = 0; i < 8; ++i) v[i] = src.quad(n0, q, k0 + (tid >> 6) + 8 * i);
#pragma unroll
        for (int i = 0; i < 8; ++i) { float* o = tl + ((tid >> 6) + 8 * i) * 257; o[src.drow(q, 0)] = v[i].x; o[src.drow(q, 1)] = v[i].y; o[src.drow(q, 2)] = v[i].z; o[src.drow(q, 3)] = v[i].w; }
    }
    __syncthreads();
#pragma unroll
    for (int i = 0; i < 4; ++i) {
        const int idx = tid + NT * i, n = idx >> 3, kc = idx & 7;
        const float* s = tl + (kc * 8) * 257 + n;
        u32x4 o;
        o.x = pk2(s[0 * 257], s[1 * 257]); o.y = pk2(s[2 * 257], s[3 * 257]); o.z = pk2(s[4 * 257], s[5 * 257]); o.w = pk2(s[6 * 257], s[7 * 257]);
        *(u32x4*)(dst + (size_t)(n0 + n) * ldd + k0 + kc * 8) = o;
    }
    __syncthreads();
}
struct SrcWin4 { const float* w; const float* g;
    DEV int drow(int q, int e) const { return 4 * q + e; }
    DEV f32x4 quad(int n0, int q, int k) const { const int n = pg8::logcol(n0 + 4 * q); int col; if (n < 1280) col = n; else if (n < 3328) col = n + 24; else if (n < 3352) col = 1280 + (n - 3328); else return (f32x4){0.f, 0.f, 0.f, 0.f};
        return *(const f32x4*)(w + (size_t)k * IN_COLS + col) * g[k]; } };
struct SrcWout4 { const float* w; const float* g;
    DEV int drow(int q, int e) const { return 4 * q + e; }
    DEV f32x4 quad(int n0, int q, int k) const { const f32x4 v = *(const f32x4*)(w + (size_t)k * DM + pg8::logcol(n0 + 4 * q)); return k < 512 ? v * g[k] : v; } };
struct SrcPlain4 { const float* w; int ld;
    DEV int drow(int q, int e) const { return 4 * q + e; }
    DEV f32x4 quad(int n0, int q, int k) const { return *(const f32x4*)(w + (size_t)k * ld + n0 + 4 * q); } };
struct SrcW13_4 { const float* w1; const float* w3; const float* g;
    DEV int drow(int q, int e) const { const int l = 8 * (q & 31) + 2 * e + (q >> 5); return (l & ~31) | pg8::inv_perm_lo(l & 31); }
    DEV f32x4 quad(int n0, int q, int k) const { const uintptr_t a = (uintptr_t)w1, b = (uintptr_t)w3; const float* w = (const float*)(a + ((b - a) & (uintptr_t)(0 - (long long)(q >> 5))));
        return *(const f32x4*)(w + (size_t)k * 512 + (n0 >> 1) + 4 * (q & 31)) * g[k]; } };

DEV void phase_prologue(const Params& p, unsigned char* lds) {
    float* tl = (float*)lds;
    const int tid = threadIdx.x, lane = tid & 63, wid = tid >> 6;
    const int vb = vblock(), G = gridDim.x;
    unsigned char* ws = p.ws;
    constexpr int I_WIN = (INP / 256) * (DM / 64);
    constexpr int I_WOUT = 4 * 16;
    constexpr int I_CW1 = 2 * 32;
    constexpr int I_W2 = 32 * 4 * 8;
    constexpr int I_CW2 = 2 * 1 * 4;
    constexpr int I_ALL = I_WIN + I_WOUT + I_CW1 + I_W2 + I_CW2;
    for (int it = vb; it < I_ALL; it += G) {
        int r = it;
        if (r < I_WIN) { SrcWin4 s{p.w_in, p.attn_g}; convert_tile256(tl, s, (bf16_t*)(ws + WS_WINT), DM, (r / 16) * 256, (r % 16) * 64); continue; } r -= I_WIN;
        if (r < I_WOUT) { SrcWout4 s{p.w_out, p.g_nsa}; convert_tile256(tl, s, (bf16_t*)(ws + WS_WOUTT), DM, (r / 16) * 256, (r % 16) * 64); continue; } r -= I_WOUT;
        if (r < I_CW1) { const int z = r / 32, q = r % 32; SrcPlain4 s{z ? p.wv1 : p.wk1, 256};
            convert_tile256(tl, s, (bf16_t*)(ws + WS_CW1T) + (size_t)z * 256 * 2048, 2048, 0, q * 64); continue; } r -= I_CW1;
        if (r < I_W2) { const int e = r / 32, q = r % 32; SrcPlain4 s{p.w2 + (size_t)e * 512 * 1024, 1024};
            convert_tile256(tl, s, (bf16_t*)(ws + WS_W2T) + (size_t)e * 1024 * 512, 512, (q / 8) * 256, (q % 8) * 64); continue; } r -= I_W2;
        { const int z = r / 4, q = r % 4; SrcPlain s{z ? p.wv2 : p.wk2, 64};
            convert_tile(tl, s, (bf16_t*)(ws + WS_CW2T) + (size_t)z * 64 * 256, 256, 0, q * 64); }
    }
    {
        bf16_t* xb = (bf16_t*)(ws + WS_R1); float* rstd1 = (float*)(ws + WS_RSTD1);
        const int gw = vb * 8 + wid, NGW = G * 8;
        for (int m = gw; m < NTOK; m += NGW) {
            const f32x4* xr = (const f32x4*)(p.x + (size_t)m * DM) + lane;
            f32x4 v[4]; float s = 0.f;
#pragma unroll
            for (int j = 0; j < 4; ++j) { v[j] = xr[64 * j]; s += (v[j].x * v[j].x + v[j].y * v[j].y) + (v[j].z * v[j].z + v[j].w * v[j].w); }
            s = wave_sum(s);
            if (lane == 0) rstd1[m] = rsqrtf(s * (1.f / DM) + RMS_EPS);
            u32x2* o = (u32x2*)(xb + (size_t)m * DM) + lane;
#pragma unroll
            for (int j = 0; j < 4; ++j) { u32x2 w; w.x = pk2(v[j].x, v[j].y); w.y = pk2(v[j].z, v[j].w); o[64 * j] = w; }
        }
    }
    {
        const int gt = vb * NT + tid, NG = G * NT;
        float* rowss = (float*)(ws + WS_ROWSS);
        for (int i = gt; i < NTOK; i += NG) rowss[i] = 0.f;
        int* bincnt = (int*)(ws + WS_CTL);
        if (gt < 128) bincnt[gt] = 0;
        if (gt < 32) ((int*)(ws + WS_CTL + 512))[gt] = 0;
        if (gt < 512) { const float l0 = p.lb_logits[gt], l1 = p.lb_logits[512 + gt]; ((float*)(ws + WS_LB))[gt] = 1.f / (1.f + __expf(l1 - l0)); }
        for (int i = gt; i < 48 * 1024; i += NG) { const int c = i >> 10, k = i & 1023;
            const float w = (c < 4 ? p.w_group[k * 4 + c] : (c < 36 ? p.w_expert[k * 32 + (c - 4)] : 0.f)) * p.ffn_g[k];
            const bf16_t hi = f2bf(w); const bf16_t lo = f2bf(w - bf2f(hi));
            ((bf16_t*)(ws + WS_RW))[i] = hi; ((bf16_t*)(ws + WS_RW))[48 * 1024 + i] = lo; }
        {
            const int ob = (vb * 8 + wid) * 4;
            if (ob < 512) { const int z = ob >> 8, j0 = ob & 255; const float* pos = z ? p.pos_v : p.pos_k; const float* w = (z ? p.wv1 : p.wk1) + j0;
                f32x4 a = (f32x4){0.f, 0.f, 0.f, 0.f};
#pragma unroll 8
                for (int k = lane; k < 2048; k += 64) a = a + *(const f32x4*)(w + (size_t)k * 256) * pos[k];
                a.x = wave_sum(a.x); a.y = wave_sum(a.y); a.z = wave_sum(a.z); a.w = wave_sum(a.w);
                if (lane == 0) *(f32x4*)((float*)(ws + WS_CBIAS) + ob) = a; }
        }
    }
}

constexpr int G_A_BYTES = 128 * 128, G_B_BYTES = 256 * 128, G_STAGE = G_A_BYTES + G_B_BYTES, G_LDS = 2 * G_STAGE;
DEV int swz(int row, int chunk) { return row * 128 + ((chunk ^ ((row >> 1) & 7)) << 4); }
template <class AL, class BL, class EP>
DEV void gemm_tile(unsigned char* lds, const AL& al, const BL& bl, int nk, const EP& ep) {
    const int tid = threadIdx.x, lane = tid & 63, wid = tid >> 6, wr = wid >> 2, wc = wid & 3;
    const int frow = lane & 15, fq = lane >> 4;
    const bf16_t* aptr[2]; int aoff[2], boff[4], brow[4];
#pragma unroll
    for (int i = 0; i < 2; ++i) { const int q = tid + NT * i, row = q >> 3, ch = q & 7; aptr[i] = al.row(row) + ch * 8; aoff[i] = swz(row, ch); }
#pragma unroll
    for (int i = 0; i < 4; ++i) { const int q = tid + NT * i, row = q >> 3, ch = q & 7; brow[i] = row; boff[i] = G_A_BYTES + swz(row, ch) ; }
    const int bch8 = (tid & 7) * 8;
    u32x4 ra[2], rb[4];
#pragma unroll
    for (int i = 0; i < 2; ++i) ra[i] = *(const u32x4*)(aptr[i]);
#pragma unroll
    for (int i = 0; i < 4; ++i) rb[i] = *(const u32x4*)(bl.ptr(brow[i], 0) + bch8);
#pragma unroll
    for (int i = 0; i < 2; ++i) *(u32x4*)(lds + aoff[i]) = ra[i];
#pragma unroll
    for (int i = 0; i < 4; ++i) *(u32x4*)(lds + boff[i]) = rb[i];
    __syncthreads();
    f32x4 acc[4][4];
#pragma unroll
    for (int m = 0; m < 4; ++m)
#pragma unroll
        for (int n = 0; n < 4; ++n) acc[m][n] = (f32x4){0.f, 0.f, 0.f, 0.f};
    const int sx = (frow >> 1) & 7;
    for (int kt = 0; kt < nk; ++kt) {
        const bool more = (kt + 1 < nk);
        if (more) {
#pragma unroll
            for (int i = 0; i < 2; ++i) ra[i] = *(const u32x4*)(aptr[i] + (kt + 1) * 64);
#pragma unroll
            for (int i = 0; i < 4; ++i) rb[i] = *(const u32x4*)(bl.ptr(brow[i], kt + 1) + bch8);
        }
        const unsigned char* base = lds + (kt & 1) * G_STAGE;
#pragma unroll
        for (int ks = 0; ks < 2; ++ks) {
            const int co = ((ks * 4 + fq) ^ sx) << 4;
            bf16x8 af[4], bfr[4];
#pragma unroll
            for (int m = 0; m < 4; ++m) af[m] = *(const bf16x8*)(base + (wr * 64 + m * 16 + frow) * 128 + co);
#pragma unroll
            for (int n = 0; n < 4; ++n) bfr[n] = *(const bf16x8*)(base + G_A_BYTES + (wc * 64 + n * 16 + frow) * 128 + co);
#pragma unroll
            for (int m = 0; m < 4; ++m)
#pragma unroll
                for (int n = 0; n < 4; ++n) acc[m][n] = __builtin_amdgcn_mfma_f32_16x16x32_bf16(bfr[n], af[m], acc[m][n], 0, 0, 0);
        }
        if (more) {
            unsigned char* nb = lds + ((kt + 1) & 1) * G_STAGE;
#pragma unroll
            for (int i = 0; i < 2; ++i) *(u32x4*)(nb + aoff[i]) = ra[i];
#pragma unroll
            for (int i = 0; i < 4; ++i) *(u32x4*)(nb + boff[i]) = rb[i];
        }
        __syncthreads();
    }
    ep(acc, wr, wc, lane);
}

struct ARows { const bf16_t* base; size_t ld; DEV const bf16_t* row(int r) const { return base + (size_t)r * ld; } };
struct BRows { const bf16_t* base; size_t ld; DEV const bf16_t* ptr(int n, int kt) const { return base + (size_t)n * ld + kt * 64; } };

DEV u32x4 pk8(const f32x4 a, const f32x4 b) { u32x4 w; w.x = pk2(a.x, a.y); w.y = pk2(a.z, a.w); w.z = pk2(b.x, b.y); w.w = pk2(b.z, b.w); return w; }
struct EpiInproj8 { const Params& p; static constexpr bool MIDSCALE = false; DEV float rowscale(int) const { return 1.f; } DEV int midk() const { return -1; }
    DEV void operator()(const f32x4 (&acc)[2][2][4][2], const pg8::Unit& u, int wr, int wc, int fr, int fq) const {
        const int seg = u.pn * 4 + wc;
        if (seg > 52) return;
        unsigned char* ws = p.ws;
        const int row0 = u.pm * 256 + wr * 64 + fr;
        const int b = row0 >> 12, s0 = row0 & 4095;
        float rs[2][4];
#pragma unroll
        for (int ai = 0; ai < 2; ++ai)
#pragma unroll
            for (int m = 0; m < 4; ++m) rs[ai][m] = ((const float*)(ws + WS_RSTD1))[row0 + 128 * ai + 16 * m];
        const bool is_q = seg < 8, is_ks = (seg == 12 || seg == 13), is_kw = (seg == 16 || seg == 17);
        if (is_q || is_ks || is_kw) {
            const float* gw = (is_q ? p.g_q : (is_ks ? p.g_k + 64 : p.g_k + 128)) + 8 * fq;
            const f32x4 g00 = *(const f32x4*)(gw), g01 = *(const f32x4*)(gw + 4), g10 = *(const f32x4*)(gw + 32), g11 = *(const f32x4*)(gw + 36);
            bf16_t* dst; int hh, nh;
            if (is_q) { dst = (bf16_t*)(ws + WS_Q); hh = seg; nh = 8; } else if (is_ks) { dst = (bf16_t*)(ws + WS_KS); hh = seg - 12; nh = 2; } else { dst = (bf16_t*)(ws + WS_KW); hh = seg - 16; nh = 2; }
            bf16_t* o0 = dst + ((size_t)(b * nh + hh) * SEQ + s0) * 64 + fq * 8;
            const float qs = is_q ? QSCALE : 1.f;
#pragma unroll
            for (int ai = 0; ai < 2; ++ai)
#pragma unroll
                for (int m = 0; m < 4; ++m) {
                    const f32x4 a0 = acc[ai][0][m][0], a1 = acc[ai][0][m][1], a2 = acc[ai][1][m][0], a3 = acc[ai][1][m][1];
                    float ss = ((a0.x * a0.x + a0.y * a0.y) + (a0.z * a0.z + a0.w * a0.w)) + ((a1.x * a1.x + a1.y * a1.y) + (a1.z * a1.z + a1.w * a1.w))
                             + ((a2.x * a2.x + a2.y * a2.y) + (a2.z * a2.z + a2.w * a2.w)) + ((a3.x * a3.x + a3.y * a3.y) + (a3.z * a3.z + a3.w * a3.w));
                    ss += __shfl_xor(ss, 16); ss += __shfl_xor(ss, 32);
                    const float rr = rs[ai][m];
                    const float r = rr * rsqrtf(ss * rr * rr * (1.f / 64.f) + RMS_EPS) * qs;
                    bf16_t* o = o0 + (size_t)(128 * ai + 16 * m) * 64;
                    *(u32x4*)(o) = pk8(a0 * g00 * r, a1 * g01 * r); *(u32x4*)(o + 32) = pk8(a2 * g10 * r, a3 * g11 * r);
                }
            return;
        }
        if (seg >= 8 && seg < 12) {
            bf16_t* o0 = (bf16_t*)(ws + (seg < 10 ? WS_KC : WS_VC)) + ((size_t)(b * 2 + (seg & 1)) * SEQ + s0) * 64 + fq * 8;
#pragma unroll
            for (int ai = 0; ai < 2; ++ai)
#pragma unroll
                for (int m = 0; m < 4; ++m) { const float r = rs[ai][m]; bf16_t* o = o0 + (size_t)(128 * ai + 16 * m) * 64;
                    *(u32x4*)(o) = pk8(acc[ai][0][m][0] * r, acc[ai][0][m][1] * r); *(u32x4*)(o + 32) = pk8(acc[ai][1][m][0] * r, acc[ai][1][m][1] * r); }
            return;
        }
        if (seg == 14 || seg == 15 || seg == 18 || seg == 19) {
            bf16_t* o0 = (bf16_t*)(ws + (seg < 16 ? WS_VST : WS_VWT)) + (size_t)(b * 2 + (seg & 1)) * 64 * SEQ + s0;
#pragma unroll
            for (int ai = 0; ai < 2; ++ai)
#pragma unroll
                for (int m = 0; m < 4; ++m) { const float r = rs[ai][m]; bf16_t* o = o0 + 128 * ai + 16 * m;
#pragma unroll
                    for (int bj = 0; bj < 2; ++bj)
#pragma unroll
                        for (int n = 0; n < 2; ++n) { const int d = 32 * bj + 8 * fq + 4 * n; const f32x4 x = acc[ai][bj][m][n] * r;
                            o[(size_t)(d + 0) * SEQ] = f2bf(x.x); o[(size_t)(d + 1) * SEQ] = f2bf(x.y); o[(size_t)(d + 2) * SEQ] = f2bf(x.z); o[(size_t)(d + 3) * SEQ] = f2bf(x.w); } }
            return;
        }
        if (seg < 52) {
            const int kind = (seg - 20) >> 3, cb = ((seg - 20) & 7) * 64 + fq * 8;
            if (kind == 1) {
                const float* lb = (const float*)(ws + WS_LB) + cb;
                const f32x4 l00 = *(const f32x4*)(lb), l01 = *(const f32x4*)(lb + 4), l10 = *(const f32x4*)(lb + 32), l11 = *(const f32x4*)(lb + 36);
                bf16_t* o0 = (bf16_t*)(ws + WS_HLOGF) + (size_t)row0 * 512 + cb;
#define LOGF4(L_, X_) (f32x4){__logf(L_.x + (1.f - L_.x) * sigmoidf_(X_.x)), __logf(L_.y + (1.f - L_.y) * sigmoidf_(X_.y)), __logf(L_.z + (1.f - L_.z) * sigmoidf_(X_.z)), __logf(L_.w + (1.f - L_.w) * sigmoidf_(X_.w))}
#pragma unroll
                for (int ai = 0; ai < 2; ++ai)
#pragma unroll
                    for (int m = 0; m < 4; ++m) { const float r = rs[ai][m]; bf16_t* o = o0 + (size_t)(128 * ai + 16 * m) * 512;
                        const f32x4 x0 = acc[ai][0][m][0] * r, x1 = acc[ai][0][m][1] * r, x2 = acc[ai][1][m][0] * r, x3 = acc[ai][1][m][1] * r;
                        *(u32x4*)(o) = pk8(LOGF4(l00, x0), LOGF4(l01, x1)); *(u32x4*)(o + 32) = pk8(LOGF4(l10, x2), LOGF4(l11, x3)); }
#undef LOGF4
            } else {
                bf16_t* o0 = (bf16_t*)(ws + (kind == 0 ? WS_HQ : (kind == 2 ? WS_HV : WS_HG))) + (size_t)row0 * 512 + cb;
#define SILU4(X_) (f32x4){siluf_(X_.x), siluf_(X_.y), siluf_(X_.z), siluf_(X_.w)}
#pragma unroll
                for (int ai = 0; ai < 2; ++ai)
#pragma unroll
                    for (int m = 0; m < 4; ++m) { const float r = rs[ai][m]; bf16_t* o = o0 + (size_t)(128 * ai + 16 * m) * 512;
                        f32x4 x0 = acc[ai][0][m][0] * r, x1 = acc[ai][0][m][1] * r, x2 = acc[ai][1][m][0] * r, x3 = acc[ai][1][m][1] * r;
                        if (kind != 2) { x0 = SILU4(x0); x1 = SILU4(x1); x2 = SILU4(x2); x3 = SILU4(x3); }
                        *(u32x4*)(o) = pk8(x0, x1); *(u32x4*)(o + 32) = pk8(x2, x3); }
#undef SILU4
            }
            return;
        }
        if (fq < 3) {
            float* o0 = (float*)(ws + WS_GATES) + (size_t)row0 * 24 + 8 * fq;
#pragma unroll
            for (int ai = 0; ai < 2; ++ai)
#pragma unroll
                for (int m = 0; m < 4; ++m) { const float r = rs[ai][m]; float* o = o0 + (size_t)(128 * ai + 16 * m) * 24;
#pragma unroll
                    for (int n = 0; n < 2; ++n) { const f32x4 x = acc[ai][0][m][n] * r; *(f32x4*)(o + 4 * n) = (f32x4){sigmoidf_(x.x), sigmoidf_(x.y), sigmoidf_(x.z), sigmoidf_(x.w)}; } }
        }
    } };
DEV void phase_inproj(const Params& p, unsigned char* lds) {
    pg8::Gemm g{(const bf16_t*)(p.ws + WS_R1), (const bf16_t*)(p.ws + WS_WINT), NTOK, INP, DM};
    pg8::StaticOrder S; S.init(NTOK, INP, (int)gridDim.x, (int)blockIdx.x);
    EpiInproj8 E{p};
    pg8::gemm_phase(( PG8_LAS unsigned char*)lds, g, S, E);
}

struct ACmp { const bf16_t* src; int bg, c0;
    DEV const bf16_t* row(int r) const { int c = c0 + r; if (c > NC - 1) c = NC - 1; return src + ((size_t)bg * SEQ + 16 * c) * 64; } };
struct EpiCmpA { const Params& p; int z, rbase;
    DEV void operator()(f32x4 (&acc)[4][4], int wr, int wc, int lane) const {
        const int frow = lane & 15, fq = lane >> 4;
        const float* cb = (const float*)(p.ws + WS_CBIAS) + z * 256; bf16_t* hid = (bf16_t*)(p.ws + WS_HID) + (size_t)z * 4096 * 256;
#pragma unroll
        for (int m = 0; m < 4; ++m) { const int rr = rbase + wr * 64 + m * 16 + frow;
#pragma unroll
            for (int n = 0; n < 4; ++n) { const int c = wc * 64 + n * 16 + fq * 4; const f32x4 b = *(const f32x4*)(cb + c); f32x4 v = acc[m][n] + b;
                u32x2 w; w.x = pk2(siluf_(v.x), siluf_(v.y)); w.y = pk2(siluf_(v.z), siluf_(v.w)); *(u32x2*)(hid + (size_t)rr * 256 + c) = w; } }
    } };
DEV void phase_cmp_a(const Params& p, unsigned char* lds) {
    const int vb = vblock(), G = gridDim.x;
    for (int u = vb; u < 64; u += G) {
        const int z = u >> 5, rbase = (u & 31) * 128;
        ACmp al{(const bf16_t*)(p.ws + (z ? WS_VC : WS_KC)), (u & 31) >> 1, (u & 1) * 128};
        BRows bl{(const bf16_t*)(p.ws + WS_CW1T) + (size_t)z * 256 * 2048, 2048};
        EpiCmpA ep{p, z, rbase};
        gemm_tile(lds, al, bl, 2048 / 64, ep);
    }
}
struct BClamp64 { const bf16_t* base; size_t ld; DEV const bf16_t* ptr(int n, int kt) const { return base + (size_t)(n & 63) * ld + kt * 64; } };
struct EpiCmpB { const Params& p; int z, rbase;
    DEV void operator()(f32x4 (&acc)[4][4], int wr, int wc, int lane) const {
        if (wc != 0) return;
        const int frow = lane & 15, fq = lane >> 4;
        bf16_t* dst = (bf16_t*)(p.ws + (z ? WS_VCMP : WS_KCMP));
#pragma unroll
        for (int m = 0; m < 4; ++m) { const int rr = rbase + wr * 64 + m * 16 + frow;
            float r = 1.f;
            if (z == 0) { float ss = 0.f;
#pragma unroll
                for (int n = 0; n < 4; ++n) { const f32x4 v = acc[m][n]; ss += (v.x * v.x + v.y * v.y) + (v.z * v.z + v.w * v.w); }
                ss += __shfl_xor(ss, 16); ss += __shfl_xor(ss, 32); r = rsqrtf(ss * (1.f / 64.f) + RMS_EPS); }
            const int bg = rr >> 8, c = rr & 255;
            if (c < NC) {
#pragma unroll
                for (int n = 0; n < 4; ++n) { const int d = n * 16 + fq * 4; f32x4 v = acc[m][n] * r;
                    if (z == 0) { const f32x4 g = *(const f32x4*)(p.g_k + d); v = v * g;
                        u32x2 w; w.x = pk2(v.x, v.y); w.y = pk2(v.z, v.w); *(u32x2*)(dst + ((size_t)bg * 256 + c) * 64 + d) = w; }
                    else { bf16_t* o = dst + ((size_t)bg * 64 + d) * 256 + c; o[0] = f2bf(v.x); o[256] = f2bf(v.y); o[512] = f2bf(v.z); o[768] = f2bf(v.w); } } }
        }
    } };
DEV void phase_cmp_b(const Params& p, unsigned char* lds) {
    const int vb = vblock(), G = gridDim.x;
    for (int u = vb; u < 64; u += G) {
        const int z = u >> 5, rbase = (u & 31) * 128;
        ARows al{(const bf16_t*)(p.ws + WS_HID) + ((size_t)z * 4096 + rbase) * 256, 256};
        BClamp64 bl{(const bf16_t*)(p.ws + WS_CW2T) + (size_t)z * 64 * 256, 256};
        EpiCmpB ep{p, z, rbase};
        gemm_tile(lds, al, bl, 256 / 64, ep);
    }
}

constexpr int CM_K = 0, CM_V = 32768, CM_VSTR = 520, CM_IMP = CM_V + 64 * CM_VSTR, CM_LDS = CM_IMP + 4 * 16384 + 1024;
DEV void cm_scores(const unsigned char* kbase, int kt, const bf16x8 (&qf)[4], int r31, int hh, f32x16 (&sacc)[2]) {
#pragma unroll
    for (int kt2 = 0; kt2 < 2; ++kt2) {
#pragma unroll
        for (int i = 0; i < 16; ++i) sacc[kt2][i] = 0.f;
        const int row = 64 * kt + 32 * kt2 + r31; const int sx = (row >> 1) & 7;
#pragma unroll
        for (int s = 0; s < 4; ++s) { const bf16x8 kf = *(const bf16x8*)(kbase + row * 128 + (((2 * s + hh) ^ sx) << 4));
            sacc[kt2] = __builtin_amdgcn_mfma_f32_32x32x16_bf16(kf, qf[s], sacc[kt2], 0, 0, 0); }
    }
}
DEV void phase_cmp_attn(const Params& p, unsigned char* lds) {
    const int tid = threadIdx.x, lane = tid & 63, wid = tid >> 6;
    const int vb = vblock(), G = gridDim.x;
    unsigned char* ws = p.ws;
    const int r31 = lane & 31, hh = lane >> 5;
    float* impl = (float*)(lds + CM_IMP);
    for (int it = vb; it < 1024; it += G) {
        int ci, bg;
        if (G == 256) { const int x = vb >> 5, jb = vb & 31, rnd = it / G, i = rnd * 32 + ((rnd & 1) ? 31 - jb : jb); ci = 63 - (i >> 1); bg = 2 * x + (i & 1); }
        else { ci = 63 - (it >> 4); bg = it & 15; }
        const int b = bg >> 1, g = bg & 1;
        const int nvis = min(NC, 4 * ci + 3), ntile = (nvis + 63) >> 6;
        const int head = g * 4 + (wid >> 1);
        const int tokl = (wid & 1) * 32 + r31, t = ci * 64 + tokl;
        const size_t tok = (size_t)b * SEQ + t;
        const int nv = t >= 31 ? min(NC, (t - 31) / 16 + 1) : 0;
        const float gate_c = ((const float*)(ws + WS_GATES))[tok * 24 + head * 3 + 0];
        __syncthreads();
        {
            const bf16_t* kc = (const bf16_t*)(ws + WS_KCMP) + (size_t)bg * 256 * 64; const bf16_t* vt = (const bf16_t*)(ws + WS_VCMP) + (size_t)bg * 64 * 256;
            const int cpr = ntile * 8;
            u32x4 rk[4], rv[4];
#pragma unroll
            for (int i = 0; i < 4; ++i) if (i < ntile) { const int idx = tid + NT * i; rk[i] = *(const u32x4*)(kc + (idx >> 3) * 64 + (idx & 7) * 8); const int d = idx / cpr, ck = idx % cpr; rv[i] = *(const u32x4*)(vt + d * 256 + ck * 8); }
#pragma unroll
            for (int i = 0; i < 4; ++i) if (i < ntile) { const int idx = tid + NT * i; *(u32x4*)(lds + CM_K + swz(idx >> 3, idx & 7)) = rk[i];
                const int d = idx / cpr, ck = idx % cpr; u32x2 a, c2; a.x = rv[i].x; a.y = rv[i].y; c2.x = rv[i].z; c2.y = rv[i].w; unsigned char* o = lds + CM_V + d * CM_VSTR + ck * 16; *(u32x2*)o = a; *(u32x2*)(o + 8) = c2; }
        }
        bf16x8 qf[4];
        { const bf16_t* qp = (const bf16_t*)(ws + WS_Q) + ((size_t)(b * 8 + head) * SEQ + t) * 64 + 8 * hh;
#pragma unroll
            for (int s = 0; s < 4; ++s) qf[s] = *(const bf16x8*)(qp + 16 * s); }
        __syncthreads();
        float l_run = 0.f;
        f32x16 ot[2];
#pragma unroll
        for (int dt = 0; dt < 2; ++dt)
#pragma unroll
            for (int i = 0; i < 16; ++i) ot[dt][i] = 0.f;
        float carry = 0.f;
#pragma unroll
        for (int kt = 0; kt < 4; ++kt) if (kt < ntile) {
            f32x16 sacc[2];
            cm_scores(lds + CM_K, kt, qf, r31, hh, sacc);
#pragma unroll
            for (int kt2 = 0; kt2 < 2; ++kt2)
#pragma unroll
                for (int i = 0; i < 16; ++i) { const int c = 64 * kt + 32 * kt2 + (i & 3) + 8 * (i >> 2) + 4 * hh; const float e_ = (c < nv) ? __builtin_amdgcn_exp2f(sacc[kt2][i]) : 0.f; sacc[kt2][i] = e_; l_run += e_; }
            {
                float own[8], xs[8];
#pragma unroll
                for (int kt2 = 0; kt2 < 2; ++kt2)
#pragma unroll
                    for (int g4 = 0; g4 < 4; ++g4) { const float e3 = 0.5f * sacc[kt2][4 * g4 + 3];
                        own[4 * kt2 + g4] = (sacc[kt2][4 * g4] + sacc[kt2][4 * g4 + 1]) + (sacc[kt2][4 * g4 + 2] + e3); xs[4 * kt2 + g4] = __shfl_xor(e3, 32); }
                float* io = impl + (wid >> 1) * 4096 + tokl * 64 + 16 * kt + hh;
#pragma unroll
                for (int gi = 0; gi < 8; ++gi) io[2 * gi] = own[gi] + (hh ? xs[gi] : (gi > 0 ? xs[gi > 0 ? gi - 1 : 0] : carry));
                carry = xs[7];
            }
#pragma unroll
            for (int kt2 = 0; kt2 < 2; ++kt2)
#pragma unroll
                for (int s2 = 0; s2 < 2; ++s2) {
                    bf16x8 pf; { u32x4 w; w.x = pk2(sacc[kt2][8 * s2 + 0], sacc[kt2][8 * s2 + 1]); w.y = pk2(sacc[kt2][8 * s2 + 2], sacc[kt2][8 * s2 + 3]);
                        w.z = pk2(sacc[kt2][8 * s2 + 4], sacc[kt2][8 * s2 + 5]); w.w = pk2(sacc[kt2][8 * s2 + 6], sacc[kt2][8 * s2 + 7]); pf = __builtin_bit_cast(bf16x8, w); }
#pragma unroll
                    for (int dt = 0; dt < 2; ++dt) {
                        const unsigned char* va = lds + CM_V + (32 * dt + r31) * CM_VSTR + (64 * kt + 32 * kt2 + 16 * s2 + 4 * hh) * 2;
                        const u32x2 lo = *(const u32x2*)(va), hi = *(const u32x2*)(va + 16);
                        u32x4 w; w.x = lo.x; w.y = lo.y; w.z = hi.x; w.w = hi.y;
                        ot[dt] = __builtin_amdgcn_mfma_f32_32x32x16_bf16(__builtin_bit_cast(bf16x8, w), pf, ot[dt], 0, 0, 0);
                    }
                }
        }
        float invL; { const float L = l_run + __shfl_xor(l_run, 32); invL = L > 0.f ? 1.f / L : 0.f; }
        if (hh == 0) impl[16384 + (wid >> 1) * 64 + tokl] = invL;
        {
            const float sc = gate_c * invL;
            bf16_t* ocp = (bf16_t*)(ws + WS_OC) + tok * 512 + head * 64;
#pragma unroll
            for (int dt = 0; dt < 2; ++dt)
#pragma unroll
                for (int g4 = 0; g4 < 4; ++g4) { const int d0 = 32 * dt + 8 * g4 + 4 * hh;
                    u32x2 w; w.x = pk2(ot[dt][4 * g4 + 0] * sc, ot[dt][4 * g4 + 1] * sc); w.y = pk2(ot[dt][4 * g4 + 2] * sc, ot[dt][4 * g4 + 3] * sc); *(u32x2*)(ocp + d0) = w; }
        }
        __syncthreads();
        for (int tt = 0; tt < 8; ++tt) {
            const int tl = wid * 8 + tt, cur = ci;
            unsigned long long mask;
            if (cur < 16) mask = (2ull << cur) - 1ull;
            else {
                const bool valid = lane <= cur;
                const float imp = (impl[tl * 64 + lane] * impl[16384 + tl] + impl[4096 + tl * 64 + lane] * impl[16384 + 64 + tl]) + (impl[8192 + tl * 64 + lane] * impl[16384 + 128 + tl] + impl[12288 + tl * 64 + lane] * impl[16384 + 192 + tl]);
                const unsigned key = (lane == 0 || lane == cur) ? 0x7F800000u : __float_as_uint(imp);
                unsigned T = 0u;
                for (int bit = 30; bit >= 0; --bit) { const unsigned cand = T | (1u << bit); if (__popcll(__ballot(valid && key >= cand)) >= 16) T = cand; }
                const unsigned long long gt = __ballot(valid && key > T), eq = __ballot(valid && key == T);
                const int need = 16 - __popcll(gt);
                const int below = __popcll(eq & ((1ull << lane) - 1ull));
                mask = gt | __ballot(valid && key == T && below < need);
            }
            if (lane == 0) ((unsigned long long*)(ws + WS_SELM))[(size_t)bg * SEQ + ci * 64 + tl] = mask;
        }
    }
}

constexpr int FA_KB = 64 * 128, FA_VB = 64 * 136, FA_STAGE = FA_KB + FA_VB, FA_LDS = 2 * FA_STAGE + 1024;
template <bool SEL>
DEV void fa_branch(unsigned char* lds, const bf16_t* Kb, const bf16_t* VTb, int ci, int bg, const bf16x8 (&qf)[4], int t, unsigned long long mymask, unsigned long long need,
                   f32x16 (&ot)[2], float& m_run, float& l_run) {
    const int tid = threadIdx.x, lane = tid & 63;
    const int r31 = lane & 31, hh = lane >> 5;
    const int lrow = tid >> 3, lch = tid & 7;
    const bf16_t* kg = Kb + ((size_t)bg * SEQ + lrow) * 64 + lch * 8;
    const bf16_t* vg = VTb + ((size_t)bg * 64 + lrow) * SEQ + lch * 8;
    const int koff = lrow * 128 + ((lch ^ ((lrow >> 1) & 7)) << 4), voff = FA_KB + lrow * 136 + lch * 16;
    int jlo, jhi; unsigned long long todo;
    if (SEL) { todo = need; jlo = 0; jhi = ci; } else { jlo = ci >= 8 ? ci - 8 : 0; jhi = ci; todo = 0; }
    int j = jlo;
    if (SEL) { if (todo == 0) return; j = __builtin_ctzll(todo); todo &= todo - 1; }
    u32x4 rk = *(const u32x4*)(kg + (size_t)j * 64 * 64), rv = *(const u32x4*)(vg + (size_t)j * 64);
    __syncthreads();
    *(u32x4*)(lds + koff) = rk; { u32x2 a, b2; a.x = rv.x; a.y = rv.y; b2.x = rv.z; b2.y = rv.w; *(u32x2*)(lds + voff) = a; *(u32x2*)(lds + voff + 8) = b2; }
    __syncthreads();
    int st = 0; bool seen = false;
    for (;;) {
        int jn; bool more;
        if (SEL) { more = (todo != 0); jn = more ? __builtin_ctzll(todo) : 0; todo &= todo - 1; } else { jn = j + 1; more = (jn <= jhi); }
        if (more) { rk = *(const u32x4*)(kg + (size_t)jn * 64 * 64); rv = *(const u32x4*)(vg + (size_t)jn * 64); }
        const unsigned char* base = lds + st * FA_STAGE;
        const bool bit = SEL ? ((mymask >> j) & 1ull) != 0 : true;
        const float cinit = (SEL && !bit) ? -__builtin_inff() : -m_run;
        f32x16 sacc[2];
#pragma unroll
        for (int kt2 = 0; kt2 < 2; ++kt2) {
#pragma unroll
            for (int i = 0; i < 16; ++i) sacc[kt2][i] = cinit;
            const int row = 32 * kt2 + r31; const int sx = (row >> 1) & 7;
#pragma unroll
            for (int s = 0; s < 4; ++s) { const bf16x8 kf = *(const bf16x8*)(base + row * 128 + (((2 * s + hh) ^ sx) << 4));
                sacc[kt2] = __builtin_amdgcn_mfma_f32_32x32x16_bf16(kf, qf[s], sacc[kt2], 0, 0, 0); }
        }
        const bool boundary = SEL ? (j == ci) : (j == ci || j + 8 <= ci);
        float mx = -__builtin_inff();
        if (boundary) {
#pragma unroll
            for (int kt2 = 0; kt2 < 2; ++kt2)
#pragma unroll
                for (int i = 0; i < 16; ++i) { const int key = 64 * j + 32 * kt2 + (i & 3) + 8 * (i >> 2) + 4 * hh;
                    const bool ok = SEL ? (key <= t) : (key <= t && t - key < 512);
                    const float v = ok ? sacc[kt2][i] : -__builtin_inff(); sacc[kt2][i] = v; mx = fmaxf(mx, v); }
        } else {
#pragma unroll
            for (int kt2 = 0; kt2 < 2; ++kt2)
#pragma unroll
                for (int i = 0; i < 16; ++i) mx = fmaxf(mx, sacc[kt2][i]);
        }
        mx = fmaxf(mx, __shfl_xor(mx, 32));
        const bool live = mx > -__builtin_inff();
        const bool need = (mx > 8.f) || (!seen && live && mx < -8.f);
        if (__any(need)) {
            const float d = need ? mx : 0.f;
            const float alpha = d > 0.f ? __builtin_amdgcn_exp2f(-d) : 1.f;
            m_run += d; l_run *= alpha;
#pragma unroll
            for (int dt = 0; dt < 2; ++dt)
#pragma unroll
                for (int i = 0; i < 16; ++i) ot[dt][i] *= alpha;
#pragma unroll
            for (int kt2 = 0; kt2 < 2; ++kt2)
#pragma unroll
                for (int i = 0; i < 16; ++i) sacc[kt2][i] -= d;
        }
        seen = seen || live;
        float rs = 0.f;
#pragma unroll
        for (int kt2 = 0; kt2 < 2; ++kt2)
#pragma unroll
            for (int i = 0; i < 16; ++i) { const float e = __builtin_amdgcn_exp2f(sacc[kt2][i]); sacc[kt2][i] = e; rs += e; }
        l_run += rs;
#pragma unroll
        for (int kt2 = 0; kt2 < 2; ++kt2)
#pragma unroll
            for (int s2 = 0; s2 < 2; ++s2) {
                bf16x8 pf; { u32x4 w; w.x = pk2(sacc[kt2][8 * s2 + 0], sacc[kt2][8 * s2 + 1]); w.y = pk2(sacc[kt2][8 * s2 + 2], sacc[kt2][8 * s2 + 3]);
                    w.z = pk2(sacc[kt2][8 * s2 + 4], sacc[kt2][8 * s2 + 5]); w.w = pk2(sacc[kt2][8 * s2 + 6], sacc[kt2][8 * s2 + 7]); pf = __builtin_bit_cast(bf16x8, w); }
#pragma unroll
                for (int dt = 0; dt < 2; ++dt) {
                    const unsigned char* va = base + FA_KB + (32 * dt + r31) * 136 + (32 * kt2 + 16 * s2 + 4 * hh) * 2;
                    const u32x2 lo = *(const u32x2*)(va), hi = *(const u32x2*)(va + 16);
                    u32x4 w; w.x = lo.x; w.y = lo.y; w.z = hi.x; w.w = hi.y;
                    ot[dt] = __builtin_amdgcn_mfma_f32_32x32x16_bf16(__builtin_bit_cast(bf16x8, w), pf, ot[dt], 0, 0, 0);
                }
            }
        if (!more) break;
        { unsigned char* nb = lds + (st ^ 1) * FA_STAGE; *(u32x4*)(nb + koff) = rk; u32x2 a, b2; a.x = rv.x; a.y = rv.y; b2.x = rv.z; b2.y = rv.w; *(u32x2*)(nb + voff) = a; *(u32x2*)(nb + voff + 8) = b2; }
        __syncthreads();
        st ^= 1; j = jn;
    }
}
DEV void phase_flash(const Params& p, unsigned char* lds) {
    const int tid = threadIdx.x, lane = tid & 63, wid = tid >> 6;
    const int vb = vblock(), G = gridDim.x;
    unsigned char* ws = p.ws;
    const int r31 = lane & 31, hh = lane >> 5;
    unsigned long long* red = (unsigned long long*)(lds + 2 * FA_STAGE);
    for (int it = vb; it < 1024; it += G) {
        int ci, bg;
        if (G == 256) { const int x = vb >> 5, jb = vb & 31, rnd = it / G, i = rnd * 32 + ((rnd & 1) ? 31 - jb : jb); ci = 63 - (i >> 1); bg = 2 * x + (i & 1); }
        else { ci = 63 - (it >> 4); bg = it & 15; }
        const int b = bg >> 1, g = bg & 1;
        const int head = g * 4 + (wid >> 1);
        const int t = ci * 64 + (wid & 1) * 32 + r31;
        const size_t tok = (size_t)b * SEQ + t;
        bf16x8 qf[4];
        { const bf16_t* qp = (const bf16_t*)(ws + WS_Q) + ((size_t)(b * 8 + head) * SEQ + t) * 64 + 8 * hh;
#pragma unroll
            for (int s = 0; s < 4; ++s) qf[s] = *(const bf16x8*)(qp + 16 * s); }
        const unsigned long long mymask = ((const unsigned long long*)(ws + WS_SELM))[(size_t)bg * SEQ + t];
        const float gate_s = ((const float*)(ws + WS_GATES))[tok * 24 + head * 3 + 1], gate_w = ((const float*)(ws + WS_GATES))[tok * 24 + head * 3 + 2];
        u32x2 ocv[2][4];
#pragma unroll
        for (int dt = 0; dt < 2; ++dt)
#pragma unroll
            for (int g4 = 0; g4 < 4; ++g4) ocv[dt][g4] = *(const u32x2*)((const bf16_t*)(ws + WS_OC) + tok * 512 + head * 64 + 32 * dt + 8 * g4 + 4 * hh);
        unsigned long long orm = mymask;
#pragma unroll
        for (int o = 1; o < 32; o <<= 1) { const unsigned lo = __shfl_xor((unsigned)orm, o), hi = __shfl_xor((unsigned)(orm >> 32), o); orm |= ((unsigned long long)hi << 32) | lo; }
        __syncthreads();
        if (wid < 2 && lane == 0) red[wid] = orm;
        __syncthreads();
        const unsigned long long need = red[0] | red[1];
        f32x16 oc[2];
        {
            f32x16 ot[2]; float m_run = 0.f, l_run = 0.f;
#pragma unroll
            for (int dt = 0; dt < 2; ++dt)
#pragma unroll
                for (int i = 0; i < 16; ++i) ot[dt][i] = 0.f;
            fa_branch<true>(lds, (const bf16_t*)(ws + WS_KS), (const bf16_t*)(ws + WS_VST), ci, bg, qf, t, mymask, need, ot, m_run, l_run);
            const float lt = l_run + __shfl_xor(l_run, 32);
            const float sc = gate_s / lt;
#pragma unroll
            for (int dt = 0; dt < 2; ++dt)
#pragma unroll
                for (int i = 0; i < 16; ++i) oc[dt][i] = ot[dt][i] * sc;
        }
        {
            f32x16 ot[2]; float m_run = 0.f, l_run = 0.f;
#pragma unroll
            for (int dt = 0; dt < 2; ++dt)
#pragma unroll
                for (int i = 0; i < 16; ++i) ot[dt][i] = 0.f;
            fa_branch<false>(lds, (const bf16_t*)(ws + WS_KW), (const bf16_t*)(ws + WS_VWT), ci, bg, qf, t, 0ull, 0ull, ot, m_run, l_run);
            const float lt = l_run + __shfl_xor(l_run, 32);
            const float sc = gate_w / lt;
#pragma unroll
            for (int dt = 0; dt < 2; ++dt)
#pragma unroll
                for (int i = 0; i < 16; ++i) oc[dt][i] += ot[dt][i] * sc;
        }
        {
            bf16_t* mix = (bf16_t*)(ws + WS_R1) + tok * 1024 + head * 64;
            float ss = 0.f;
#pragma unroll
            for (int dt = 0; dt < 2; ++dt)
#pragma unroll
                for (int g4 = 0; g4 < 4; ++g4) { const int d0 = 32 * dt + 8 * g4 + 4 * hh; const u32x2 c = ocv[dt][g4];
                    const float v0 = oc[dt][4 * g4 + 0] + bflo(c.x), v1 = oc[dt][4 * g4 + 1] + bfhi(c.x), v2 = oc[dt][4 * g4 + 2] + bflo(c.y), v3 = oc[dt][4 * g4 + 3] + bfhi(c.y);
                    ss += (v0 * v0 + v1 * v1) + (v2 * v2 + v3 * v3);
                    u32x2 w; w.x = pk2(v0, v1); w.y = pk2(v2, v3); *(u32x2*)(mix + d0) = w; }
            ss += __shfl_xor(ss, 32);
            if (hh == 0) atomicAdd((float*)(ws + WS_ROWSS) + tok, ss);
        }
    }
}

DEV int swz256(int row, int chunk) { return row * 256 + ((chunk ^ (row & 15)) << 4); }
DEV void hgrn_cumsum(const Params& p, int bh, int c, float* segs, f32x2 (&lf)[8], f32x2 (&a)[8], f32x2& r, f32x2& alast) {
    const int tid = threadIdx.x, k2 = tid & 63, tq = tid >> 6;
    const int b = bh >> 2, h = bh & 3;
    const bf16_t* HL = (const bf16_t*)(p.ws + WS_HLOGF) + ((size_t)b * SEQ + c * 64 + tq * 8) * 512 + h * 128 + 2 * k2;
#pragma unroll
    for (int i = 0; i < 8; ++i) { const unsigned w = *(const unsigned*)(HL + (size_t)i * 512); lf[i] = (f32x2){bflo(w), bfhi(w)}; }
    f32x2 run = (f32x2){0.f, 0.f};
#pragma unroll
    for (int i = 0; i < 8; ++i) { run = run + lf[i]; a[i] = run; }
    *(f32x2*)(segs + tq * 128 + 2 * k2) = run;
    __syncthreads();
    f32x2 off = (f32x2){0.f, 0.f}, tot = off, rr = off;
#pragma unroll
    for (int q = 0; q < 8; ++q) { const f32x2 s = *(const f32x2*)(segs + q * 128 + 2 * k2); if (q < tq) off = off + s; if (q < 4) rr = rr + s; tot = tot + s; }
#pragma unroll
    for (int i = 0; i < 8; ++i) a[i] = a[i] + off;
    r = rr; alast = tot;
}
DEV void hgrn_stage_vt(const Params& p, int bh, int c, unsigned char* vt) {
    const int tid = threadIdx.x, k2 = tid & 63, tq = tid >> 6;
    const int b = bh >> 2, h = bh & 3;
    const bf16_t* HV = (const bf16_t*)(p.ws + WS_HV) + ((size_t)b * SEQ + c * 64 + tq * 8) * 512 + h * 128 + 2 * k2;
    unsigned vv[8];
#pragma unroll
    for (int i = 0; i < 8; ++i) vv[i] = *(const unsigned*)(HV + (size_t)i * 512);
    u32x4 lo, hi;
    lo.x = (vv[0] & 0xffffu) | (vv[1] << 16); lo.y = (vv[2] & 0xffffu) | (vv[3] << 16); lo.z = (vv[4] & 0xffffu) | (vv[5] << 16); lo.w = (vv[6] & 0xffffu) | (vv[7] << 16);
    hi.x = (vv[0] >> 16) | (vv[1] & 0xffff0000u); hi.y = (vv[2] >> 16) | (vv[3] & 0xffff0000u); hi.z = (vv[4] >> 16) | (vv[5] & 0xffff0000u); hi.w = (vv[6] >> 16) | (vv[7] & 0xffff0000u);
    *(u32x4*)(vt + swz(2 * k2, tq)) = lo; *(u32x4*)(vt + swz(2 * k2 + 1, tq)) = hi;
}
constexpr int H1_KT = 0, H1_VT = 16384, H1_SEG = 32768, H1_EK = H1_SEG + 4096;
DEV void phase_hgrn_a1(const Params& p, unsigned char* lds, int vb0, int nb) {
    const int tid = threadIdx.x, lane = tid & 63, wid = tid >> 6, k2 = tid & 63, tq = tid >> 6;
    const int vb = vblock(), G = gridDim.x;
    const int frow = lane & 15, fq = lane >> 4, wr = wid >> 1, wc = wid & 1;
    float* segs = (float*)(lds + H1_SEG); float* ek = (float*)(lds + H1_EK);
    bf16_t* ubuf = (bf16_t*)(p.ws + WS_UBUF); float* dbuf = (float*)(p.ws + WS_DBUF);
    if (vb < vb0) return;
    for (int item = vb - vb0; item < 2048; item += nb) {
        const int bh = item >> 6, c = item & 63;
        __syncthreads();
        f32x2 lf[8], a[8], r, al;
        hgrn_cumsum(p, bh, c, segs, lf, a, r, al);
        {
            float kx[8], ky[8];
#pragma unroll
            for (int i = 0; i < 8; ++i) { kx[i] = (1.f - __expf(lf[i].x)) * __expf(fminf(r.x - a[i].x, 80.f)); ky[i] = (1.f - __expf(lf[i].y)) * __expf(fminf(r.y - a[i].y, 80.f)); }
            u32x4 w0, w1;
            w0.x = pk2(kx[0], kx[1]); w0.y = pk2(kx[2], kx[3]); w0.z = pk2(kx[4], kx[5]); w0.w = pk2(kx[6], kx[7]);
            w1.x = pk2(ky[0], ky[1]); w1.y = pk2(ky[2], ky[3]); w1.z = pk2(ky[4], ky[5]); w1.w = pk2(ky[6], ky[7]);
            *(u32x4*)(lds + H1_KT + swz(2 * k2, tq)) = w0; *(u32x4*)(lds + H1_KT + swz(2 * k2 + 1, tq)) = w1;
        }
        hgrn_stage_vt(p, bh, c, lds + H1_VT);
        if (tq == 7) { ek[2 * k2] = __expf(al.x - r.x); ek[2 * k2 + 1] = __expf(al.y - r.y); f32x2 d; d.x = __expf(al.x); d.y = __expf(al.y); *(f32x2*)(dbuf + (size_t)item * 128 + 2 * k2) = d; }
        __syncthreads();
        f32x4 acc[2][4];
#pragma unroll
        for (int m = 0; m < 2; ++m)
#pragma unroll
            for (int n = 0; n < 4; ++n) acc[m][n] = (f32x4){0.f, 0.f, 0.f, 0.f};
        const int sx = (frow >> 1) & 7;
#pragma unroll
        for (int ks = 0; ks < 2; ++ks) {
            const int co = ((ks * 4 + fq) ^ sx) << 4;
            bf16x8 af[2], bfr[4];
#pragma unroll
            for (int m = 0; m < 2; ++m) af[m] = *(const bf16x8*)(lds + H1_VT + (32 * wr + 16 * m + frow) * 128 + co);
#pragma unroll
            for (int n = 0; n < 4; ++n) bfr[n] = *(const bf16x8*)(lds + H1_KT + (64 * wc + 16 * n + frow) * 128 + co);
#pragma unroll
            for (int m = 0; m < 2; ++m)
#pragma unroll
                for (int n = 0; n < 4; ++n) acc[m][n] = __builtin_amdgcn_mfma_f32_16x16x32_bf16(bfr[n], af[m], acc[m][n], 0, 0, 0);
        }
#pragma unroll
        for (int m = 0; m < 2; ++m) { const int v = 32 * wr + 16 * m + frow;
#pragma unroll
            for (int n = 0; n < 4; ++n) { const int k0 = 64 * wc + 16 * n + 4 * fq; const f32x4 e = *(const f32x4*)(ek + k0); const f32x4 o = acc[m][n] * e;
                u32x2 w; w.x = pk2(o.x, o.y); w.y = pk2(o.z, o.w); *(u32x2*)(ubuf + ((size_t)item * 128 + v) * 128 + k0) = w; } }
    }
}
DEV void phase_hgrn_a2(const Params& p, unsigned char* lds) {
    const int G = gridDim.x;
    bf16_t* ubuf = (bf16_t*)(p.ws + WS_UBUF); const float* dbuf = (const float*)(p.ws + WS_DBUF);
    for (int gid = blockIdx.x * NT + threadIdx.x; gid < 131072; gid += G * NT) {
        const int bh = gid >> 12, v = (gid >> 5) & 127, k4 = gid & 31;
        bf16_t* u = ubuf + ((size_t)bh * 64 * 128 + v) * 128 + 4 * k4;
        const float* d = dbuf + (size_t)bh * 64 * 128 + 4 * k4;
        f32x4 S = (f32x4){0.f, 0.f, 0.f, 0.f};
        for (int c0 = 0; c0 < 64; c0 += 8) {
            u32x2 uu[8]; f32x4 dd[8];
#pragma unroll
            for (int j = 0; j < 8; ++j) { uu[j] = *(const u32x2*)(u + (size_t)(c0 + j) * 16384); dd[j] = *(const f32x4*)(d + (size_t)(c0 + j) * 128); }
#pragma unroll
            for (int j = 0; j < 8; ++j) { u32x2 w; w.x = pk2(S.x, S.y); w.y = pk2(S.z, S.w); *(u32x2*)(u + (size_t)(c0 + j) * 16384) = w;
                S.x = dd[j].x * S.x + bflo(uu[j].x); S.y = dd[j].y * S.y + bfhi(uu[j].x); S.z = dd[j].z * S.z + bflo(uu[j].y); S.w = dd[j].w * S.w + bfhi(uu[j].y); }
        }
    }
}
constexpr int H3_QH = 0, H3_QA = 16384, H3_KH = 32768, H3_VT = 49152, H3_PP = 65536, H3_ST = 73728, H3_SEG = 106496, H3_RED = 110592;
DEV void phase_hgrn_a3(const Params& p, unsigned char* lds) {
    const int tid = threadIdx.x, lane = tid & 63, wid = tid >> 6, k2 = tid & 63, tq = tid >> 6;
    const int vb = vblock(), G = gridDim.x;
    const int frow = lane & 15, fq = lane >> 4;
    float* segs = (float*)(lds + H3_SEG); float* red = (float*)(lds + H3_RED);
    const bf16_t* ubuf = (const bf16_t*)(p.ws + WS_UBUF);
    for (int item = vb; item < 2048; item += G) {
        const int bh = item >> 6, c = item & 63, b = bh >> 2, h = bh & 3;
        __syncthreads();
        f32x2 lf[8], a[8], r, al;
        hgrn_cumsum(p, bh, c, segs, lf, a, r, al);
        {
            const bf16_t* HQ = (const bf16_t*)(p.ws + WS_HQ) + ((size_t)b * SEQ + c * 64 + tq * 8) * 512 + h * 128 + 2 * k2;
            unsigned qq[8];
#pragma unroll
            for (int i = 0; i < 8; ++i) qq[i] = *(const unsigned*)(HQ + (size_t)i * 512);
#pragma unroll
            for (int i = 0; i < 8; ++i) { const int t = 8 * tq + i; const float q0 = bflo(qq[i]), q1 = bfhi(qq[i]);
                const int off = swz256(t, k2 >> 2) + (k2 & 3) * 4;
                *(unsigned*)(lds + H3_QH + off) = pk2(q0 * __expf(fminf(a[i].x - r.x, 80.f)), q1 * __expf(fminf(a[i].y - r.y, 80.f)));
                *(unsigned*)(lds + H3_QA + off) = pk2(q0 * __expf(a[i].x), q1 * __expf(a[i].y));
                *(unsigned*)(lds + H3_KH + off) = pk2((1.f - __expf(lf[i].x)) * __expf(fminf(r.x - a[i].x, 80.f)), (1.f - __expf(lf[i].y)) * __expf(fminf(r.y - a[i].y, 80.f))); }
        }
        hgrn_stage_vt(p, bh, c, lds + H3_VT);
        {
            const bf16_t* st = ubuf + (size_t)item * 16384;
#pragma unroll
            for (int i = 0; i < 4; ++i) { const int q = tid + NT * i, v = q >> 4, ch = q & 15; *(u32x4*)(lds + H3_ST + swz256(v, ch)) = *(const u32x4*)(st + v * 128 + ch * 8); }
        }
        __syncthreads();
        {
            const int wr = wid >> 1, wc = wid & 1;
            f32x4 acc[2];
            acc[0] = (f32x4){0.f, 0.f, 0.f, 0.f}; acc[1] = acc[0];
            if (32 * wc <= 16 * wr + 15) {
#pragma unroll
                for (int ks = 0; ks < 4; ++ks) {
                    const int co = ((ks * 4 + fq) ^ frow) << 4;
                    const bf16x8 af = *(const bf16x8*)(lds + H3_QH + (16 * wr + frow) * 256 + co);
#pragma unroll
                    for (int n = 0; n < 2; ++n) { const bf16x8 bfr = *(const bf16x8*)(lds + H3_KH + (32 * wc + 16 * n + frow) * 256 + co);
                        acc[n] = __builtin_amdgcn_mfma_f32_16x16x32_bf16(bfr, af, acc[n], 0, 0, 0); }
                }
            }
            const int t = 16 * wr + frow;
#pragma unroll
            for (int n = 0; n < 2; ++n) { const int s0 = 32 * wc + 16 * n + 4 * fq; f32x4 v = acc[n];
                v.x = (s0 + 0 <= t) ? v.x : 0.f; v.y = (s0 + 1 <= t) ? v.y : 0.f; v.z = (s0 + 2 <= t) ? v.z : 0.f; v.w = (s0 + 3 <= t) ? v.w : 0.f;
                u32x2 w; w.x = pk2(v.x, v.y); w.y = pk2(v.z, v.w);
                *(u32x2*)(lds + H3_PP + t * 128 + ((((s0 >> 3)) ^ ((t >> 1) & 7)) << 4) + (s0 & 7) * 2) = w; }
        }
        __syncthreads();
        {
            const int wr = wid >> 2, wc = wid & 3;
            f32x4 acc[2][2];
#pragma unroll
            for (int m = 0; m < 2; ++m)
#pragma unroll
                for (int n = 0; n < 2; ++n) acc[m][n] = (f32x4){0.f, 0.f, 0.f, 0.f};
            const int sx = (frow >> 1) & 7;
#pragma unroll
            for (int ks = 0; ks < 2; ++ks) {
                const int co = ((ks * 4 + fq) ^ sx) << 4;
                bf16x8 af[2], bfr[2];
#pragma unroll
                for (int m = 0; m < 2; ++m) af[m] = *(const bf16x8*)(lds + H3_PP + (32 * wr + 16 * m + frow) * 128 + co);
#pragma unroll
                for (int n = 0; n < 2; ++n) bfr[n] = *(const bf16x8*)(lds + H3_VT + (32 * wc + 16 * n + frow) * 128 + co);
#pragma unroll
                for (int m = 0; m < 2; ++m)
#pragma unroll
                    for (int n = 0; n < 2; ++n) acc[m][n] = __builtin_amdgcn_mfma_f32_16x16x32_bf16(bfr[n], af[m], acc[m][n], 0, 0, 0);
            }
#pragma unroll
            for (int ks = 0; ks < 4; ++ks) {
                const int co = ((ks * 4 + fq) ^ frow) << 4;
                bf16x8 af[2], bfr[2];
#pragma unroll
                for (int m = 0; m < 2; ++m) af[m] = *(const bf16x8*)(lds + H3_QA + (32 * wr + 16 * m + frow) * 256 + co);
#pragma unroll
                for (int n = 0; n < 2; ++n) bfr[n] = *(const bf16x8*)(lds + H3_ST + (32 * wc + 16 * n + frow) * 256 + co);
#pragma unroll
                for (int m = 0; m < 2; ++m)
#pragma unroll
                    for (int n = 0; n < 2; ++n) acc[m][n] = __builtin_amdgcn_mfma_f32_16x16x32_bf16(bfr[n], af[m], acc[m][n], 0, 0, 0);
            }
            f32x4 gnv[2]; u32x2 ggv[2][2];
#pragma unroll
            for (int n = 0; n < 2; ++n) gnv[n] = *(const f32x4*)(p.g_hn + 32 * wc + 16 * n + 4 * fq);
#pragma unroll
            for (int m = 0; m < 2; ++m)
#pragma unroll
                for (int n = 0; n < 2; ++n) ggv[m][n] = *(const u32x2*)((const bf16_t*)(p.ws + WS_HG) + ((size_t)b * SEQ + c * 64 + 32 * wr + 16 * m + frow) * 512 + h * 128 + 32 * wc + 16 * n + 4 * fq);
#pragma unroll
            for (int m = 0; m < 2; ++m) { float ss = 0.f;
#pragma unroll
                for (int n = 0; n < 2; ++n) { const f32x4 v = acc[m][n]; ss += (v.x * v.x + v.y * v.y) + (v.z * v.z + v.w * v.w); }
                ss += __shfl_xor(ss, 16); ss += __shfl_xor(ss, 32);
                if (fq == 0) red[(32 * wr + 16 * m + frow) * 4 + wc] = ss; }
            __syncthreads();
#pragma unroll
            for (int m = 0; m < 2; ++m) { const int t = 32 * wr + 16 * m + frow; const f32x4 q4 = *(const f32x4*)(red + t * 4);
                const float rs = rsqrtf(((q4.x + q4.y) + (q4.z + q4.w)) * (1.f / 128.f) + RMS_EPS);
                const size_t row = (size_t)b * SEQ + c * 64 + t;
#pragma unroll
                for (int n = 0; n < 2; ++n) { const int v0 = 32 * wc + 16 * n + 4 * fq; const f32x4 gn = gnv[n]; const u32x2 gg = ggv[m][n];
                    const f32x4 o = acc[m][n];
                    u32x2 w; w.x = pk2(o.x * rs * gn.x * bflo(gg.x), o.y * rs * gn.y * bfhi(gg.x)); w.y = pk2(o.z * rs * gn.z * bflo(gg.y), o.w * rs * gn.w * bfhi(gg.y));
                    *(u32x2*)((bf16_t*)(p.ws + WS_R1) + row * 1024 + 512 + h * 128 + v0) = w; } }
        }
    }
}

DEV void phase_normalize(const Params& p, unsigned char* lds) {
    const int vb = vblock(), G = gridDim.x;
    unsigned char* ws = p.ws;
    __syncthreads();
    {
        float* tl = (float*)lds;
        for (int r = vb; r < 32 * 4 * 16; r += G) { const int e = r / 64, q = r % 64; SrcW13_4 s{p.w1 + (size_t)e * 1024 * 512, p.w3 + (size_t)e * 1024 * 512, p.ffn_g};
            convert_tile256(tl, s, (bf16_t*)(ws + WS_W13T) + (size_t)e * 1024 * 1024, 1024, (q / 16) * 256, (q % 16) * 64); }
    }
}

struct EpiOut8 { const Params& p; static constexpr bool MIDSCALE = true;
    DEV float rowscale(int row) const { return rsqrtf(((const float*)(p.ws + WS_ROWSS))[row] * (1.f / 512.f) + RMS_EPS); }
    DEV int midk() const { return 8; }
    DEV void operator()(const f32x4 (&acc)[2][2][4][2], const pg8::Unit& u, int wr, int wc, int fr, int fq) const {
#pragma unroll
        for (int ai = 0; ai < 2; ++ai)
#pragma unroll
            for (int m = 0; m < 4; ++m) { const size_t row = (size_t)u.pm * 256 + ai * 128 + wr * 64 + m * 16 + fr;
#pragma unroll
                for (int bj = 0; bj < 2; ++bj)
#pragma unroll
                    for (int n = 0; n < 2; ++n) { const int c = u.pn * 256 + 64 * wc + 32 * bj + 8 * fq + 4 * n; const f32x4 xv = *(const f32x4*)(p.x + row * DM + c); *(f32x4*)(p.out + row * DM + c) = xv + acc[ai][bj][m][n]; } }
    } };
DEV void phase_outproj(const Params& p, unsigned char* lds) {
    pg8::Gemm g{(const bf16_t*)(p.ws + WS_R1), (const bf16_t*)(p.ws + WS_WOUTT), NTOK, DM, DM};
    pg8::StaticOrder S; S.init(NTOK, DM, (int)gridDim.x, (int)blockIdx.x);
    EpiOut8 E{p};
    pg8::gemm_phase((PG8_LAS unsigned char*)lds, g, S, E);
}

constexpr int RT_W = 0, RT_LG = 2 * 49152, RT_RS = RT_LG + 128 * 49 * 4, RT_HIST = RT_RS + 512, RT_BASE = RT_HIST + 1024, RT_LDS = RT_BASE + 1024;
DEV void phase_router(const Params& p, unsigned char* lds) {
    const int tid = threadIdx.x, lane = tid & 63, wid = tid >> 6, frow = lane & 15, fq = lane >> 4;
    const int vb = vblock(), G = gridDim.x;
    unsigned char* ws = p.ws;
    float* lg = (float*)(lds + RT_LG); float* rsd = (float*)(lds + RT_RS);
    int* hist = (int*)(lds + RT_HIST); int* basep = (int*)(lds + RT_BASE);
    const bf16_t* rw = (const bf16_t*)(ws + WS_RW);
    for (int it = vb; it < NTOK / 128; it += G) {
        const size_t row0 = (size_t)it * 128;
        const size_t trow = row0 + 16 * wid + frow;
        const float* hrow = p.out + trow * DM + 8 * fq;
        bf16_t* hbrow = (bf16_t*)(ws + WS_R1) + trow * DM + 8 * fq;
        f32x4 acc[3]; float ss = 0.f;
#pragma unroll
        for (int nt = 0; nt < 3; ++nt) acc[nt] = (f32x4){0.f, 0.f, 0.f, 0.f};
        if (tid < 128) hist[tid] = 0;
        u32x4 wreg[6]; f32x4 xa[4][2], xn[4][2];
#define RT_LOADW(kc_) do { _Pragma("unroll") for (int i = 0; i < 6; ++i) { const int idx = tid + NT * i, r = idx >> 5, c = idx & 31; wreg[i] = *(const u32x4*)(rw + (size_t)r * 1024 + (kc_) * 256 + c * 8); } } while (0)
#define RT_STOREW(buf_) do { _Pragma("unroll") for (int i = 0; i < 6; ++i) { const int idx = tid + NT * i, r = idx >> 5, c = idx & 31; *(u32x4*)(lds + RT_W + (buf_) * 49152 + r * 512 + ((c ^ (r & 15)) << 4)) = wreg[i]; } } while (0)
#define RT_LOADX(dst_, hc_) do { _Pragma("unroll") for (int ks = 0; ks < 4; ++ks) { dst_[ks][0] = *(const f32x4*)(hrow + (hc_) * 128 + 32 * ks); dst_[ks][1] = *(const f32x4*)(hrow + (hc_) * 128 + 32 * ks + 4); } } while (0)
        __syncthreads();
        RT_LOADW(0); RT_LOADX(xa, 0); RT_STOREW(0);
        __syncthreads();
#pragma unroll 1
        for (int hc = 0; hc < 8; ++hc) {
            if (hc < 7) RT_LOADX(xn, hc + 1);
            const unsigned char* wb = lds + RT_W + ((hc >> 1) & 1) * 49152;
#pragma unroll
            for (int ks = 0; ks < 4; ++ks) {
                const f32x4 a = xa[ks][0], b = xa[ks][1];
                ss += ((a.x * a.x + a.y * a.y) + (a.z * a.z + a.w * a.w)) + ((b.x * b.x + b.y * b.y) + (b.z * b.z + b.w * b.w));
                u32x4 hi; hi.x = pk2(a.x, a.y); hi.y = pk2(a.z, a.w); hi.z = pk2(b.x, b.y); hi.w = pk2(b.z, b.w);
                u32x4 lo; lo.x = pk2(a.x - bflo(hi.x), a.y - bfhi(hi.x)); lo.y = pk2(a.z - bflo(hi.y), a.w - bfhi(hi.y)); lo.z = pk2(b.x - bflo(hi.z), b.y - bfhi(hi.z)); lo.w = pk2(b.z - bflo(hi.w), b.w - bfhi(hi.w));
                *(u32x4*)(hbrow + hc * 128 + 32 * ks) = hi;
                const bf16x8 hh = __builtin_bit_cast(bf16x8, hi), hl = __builtin_bit_cast(bf16x8, lo);
                const int co = ((4 * (4 * (hc & 1) + ks) + fq) ^ frow) << 4;
#pragma unroll
                for (int nt = 0; nt < 3; ++nt) {
                    const bf16x8 whi = *(const bf16x8*)(wb + (16 * nt + frow) * 512 + co), wlo = *(const bf16x8*)(wb + (48 + 16 * nt + frow) * 512 + co);
                    acc[nt] = __builtin_amdgcn_mfma_f32_16x16x32_bf16(whi, hh, acc[nt], 0, 0, 0);
                    acc[nt] = __builtin_amdgcn_mfma_f32_16x16x32_bf16(wlo, hh, acc[nt], 0, 0, 0);
                    acc[nt] = __builtin_amdgcn_mfma_f32_16x16x32_bf16(whi, hl, acc[nt], 0, 0, 0);
                }
            }
            if ((hc & 1) == 0 && hc < 6) { RT_LOADW((hc >> 1) + 1); }
            if ((hc & 1) == 1 && hc < 7) { RT_STOREW(((hc >> 1) + 1) & 1); }
#pragma unroll
            for (int ks = 0; ks < 4; ++ks) { xa[ks][0] = xn[ks][0]; xa[ks][1] = xn[ks][1]; }
            if (hc & 1) __syncthreads();
        }
#undef RT_LOADW
#undef RT_STOREW
#undef RT_LOADX
        ss += __shfl_xor(ss, 16); ss += __shfl_xor(ss, 32);
        if (fq == 0) rsd[16 * wid + frow] = rsqrtf(ss * (1.f / DM) + RMS_EPS);
#pragma unroll
        for (int nt = 0; nt < 3; ++nt) { float* o = lg + (16 * wid + frow) * 49 + 16 * nt + 4 * fq; o[0] = acc[nt].x; o[1] = acc[nt].y; o[2] = acc[nt].z; o[3] = acc[nt].w; }
        __syncthreads();
        int bin = 0, slot = 0, ea = 0, eb = 0, sa = 0, sb = 0; float wa = 0.f, wb = 0.f;
        int* ehist = hist + 112; int* ebase = basep + 112;
        if (tid < 32) ehist[tid] = 0;
        __syncthreads();
        if (tid < 128) {
            const float rs = rsd[tid];
            ((float*)(ws + WS_RSTD2))[row0 + tid] = rs;
            float gl[4]; int gi = 0; float gm = -1e30f;
#pragma unroll
            for (int c = 0; c < 4; ++c) { gl[c] = lg[tid * 49 + c] * rs + p.b_group[c]; if (gl[c] > gm) { gm = gl[c]; gi = c; } }
            float gs = 0.f;
#pragma unroll
            for (int c = 0; c < 4; ++c) gs += __expf(gl[c] - gm);
            const float pg = 1.f / gs;
            float el[8]; int i0 = 0; float m0 = -1e30f;
#pragma unroll
            for (int c = 0; c < 8; ++c) { el[c] = lg[tid * 49 + 4 + gi * 8 + c] * rs + p.b_expert[gi * 8 + c]; if (el[c] > m0) { m0 = el[c]; i0 = c; } }
            int i1 = 0; float m1 = -1e30f;
#pragma unroll
            for (int c = 0; c < 8; ++c) if (c != i0 && el[c] > m1) { m1 = el[c]; i1 = c; }
            const float e1 = __expf(m1 - m0); const float w0 = pg / (1.f + e1), w1 = pg * e1 / (1.f + e1);
            const int a = min(i0, i1), bb = max(i0, i1);
            bin = gi * 28 + (7 * a - (a * (a - 1)) / 2) + (bb - a - 1);
            wa = (i0 < i1) ? w0 : w1; wb = (i0 < i1) ? w1 : w0; ea = gi * 8 + a; eb = gi * 8 + bb;
            slot = atomicAdd(&hist[bin], 1);
            sa = atomicAdd(&ehist[ea], 1); sb = atomicAdd(&ehist[eb], 1);
        }
        __syncthreads();
        if (tid < NBIN) { const int h = hist[tid]; basep[tid] = h ? atomicAdd((int*)(ws + WS_CTL) + tid, h) : 0; }
        else if (tid >= 128 && tid < 160) { const int e = tid - 128; const int h = ehist[e]; ebase[e] = h ? atomicAdd((int*)(ws + WS_CTL + 512) + e, h) : 0; }
        __syncthreads();
        if (tid < 128) {
            const int t = (int)(row0 + tid);
            ((int*)(ws + WS_BINL))[(size_t)bin * BINCAP + basep[bin] + slot] = t;
            sa += ebase[ea]; sb += ebase[eb];
            ((int*)(ws + WS_EL))[(size_t)ea * BINCAP + sa] = t; ((float*)(ws + WS_EW))[(size_t)ea * BINCAP + sa] = wa;
            ((int*)(ws + WS_EL))[(size_t)eb * BINCAP + sb] = t; ((float*)(ws + WS_EW))[(size_t)eb * BINCAP + sb] = wb;
            { const unsigned dpos = (unsigned)bin | ((unsigned)(basep[bin] + slot) << 7); ((unsigned*)(ws + WS_EDST))[(size_t)ea * BINCAP + sa] = dpos; ((unsigned*)(ws + WS_EDST))[(size_t)eb * BINCAP + sb] = dpos | (1u << 22); }
        }
        __syncthreads();
    }
}

constexpr int MOE_TS = pg8::STAGE_BYTES, MOE_TT = MOE_TS + 512, MOE_ES = MOE_TT + 1024, MOE_ET = MOE_ES + 256;
DEV void moe_tiles(const Params& p, unsigned char* lds) {
    int* tstart = (int*)(lds + MOE_TS); int* tiletab = (int*)(lds + MOE_TT); int* etstart = (int*)(lds + MOE_ES); int* etiletab = (int*)(lds + MOE_ET);
    const int tid = threadIdx.x, lane = tid & 63, wid = tid >> 6;
    __syncthreads();
    if (wid < 2) {
        const int i = wid * 64 + lane; const int t = i < NBIN ? (((const int*)(p.ws + WS_CTL))[i] + 255) >> 8 : 0;
        int s = t;
#pragma unroll
        for (int o = 1; o < 64; o <<= 1) { const int v = __shfl_up(s, o); if (lane >= o) s += v; }
        if (wid == 0 && lane == 63) tstart[128] = s;
        if (i < NBIN) tstart[i] = s - t;
        if (i == NBIN - 1) tstart[129] = s;
    } else if (wid == 2) {
        const int t = lane < 32 ? (((const int*)(p.ws + WS_CTL + 512))[lane] + 255) >> 8 : 0;
        int s = t;
#pragma unroll
        for (int o = 1; o < 32; o <<= 1) { const int v = __shfl_up(s, o); if (lane >= o) s += v; }
        if (lane < 32) etstart[lane] = s - t;
        if (lane == 31) etstart[32] = s;
    }
    __syncthreads();
    if (tid >= 64 && tid < NBIN) tstart[tid] += tstart[128];
    if (tid == 0) tstart[NBIN] = tstart[128] + tstart[129];
    __syncthreads();
    if (tid < NBIN) for (int t = tstart[tid]; t < tstart[tid + 1]; ++t) tiletab[t] = tid;
    if (tid >= 128 && tid < 160) for (int t = etstart[tid - 128]; t < etstart[tid - 127]; ++t) etiletab[t] = tid - 128;
    __syncthreads();
}
DEV void bin_experts(int bin, int& ea, int& eb) { const int gi = bin / 28; int pi = bin % 28, a = 0; while (pi >= 7 - a) { pi -= 7 - a; ++a; } ea = gi * 8 + a; eb = gi * 8 + a + 1 + pi; }
DEV void lane_rc(int i, int& R, int& C) { pg8::stage_rc((int)threadIdx.x * 16, R, C); R += 64 * i; }
struct MoeUnit { int tile, nt, bin, mt, n; };
struct PolMoe1 {
    typedef MoeUnit Unit;
    const Params& p; const int* etstart; const int* etiletab; int U, G, c;
    struct AddrA { unsigned off[2][2]; };
    struct AddrB { const char* base; };
    DEV int nk() const { return 16; }
    DEV bool next(int i, MoeUnit& u) const {
        const int L = i * G + c; if (L >= U) return false;
        u.tile = L >> 2; u.nt = L & 3;
        u.bin = __builtin_amdgcn_readfirstlane(etiletab[u.tile]);
        u.mt = u.tile - __builtin_amdgcn_readfirstlane(etstart[u.bin]);
        u.n = min(256, ((const int*)(p.ws + WS_CTL + 512))[u.bin] - u.mt * 256);
        return true;
    }
    DEV bool full(const MoeUnit& u) const { return u.n > 128; }
    DEV void addrA(const MoeUnit& u, AddrA& a) const {
        const int* list = (const int*)(p.ws + WS_EL) + (size_t)u.bin * BINCAP + u.mt * 256;
#pragma unroll
        for (int i = 0; i < 2; ++i) { int R, C; lane_rc(i, R, C);
#pragma unroll
            for (int h = 0; h < 2; ++h) { int r = h * 128 + R; if (r >= u.n) r = 0; a.off[h][i] = (unsigned)list[r] * 2048u + (unsigned)C * 2u; } }
    }
    DEV void addrB(const MoeUnit& u, AddrB& b) const { b.base = (const char*)(p.ws + WS_W13T) + ((size_t)u.bin * 1024 + u.nt * 256) * 2048; }
    DEV const char* pa(const AddrA& a, int h, int i, int kt) const { return (const char*)(p.ws + WS_R1) + a.off[h][i] + kt * 128; }
    DEV const char* pb(const AddrB& b, int h, int i, int kt) const { int R, C; lane_rc(i, R, C); return b.base + (size_t)h * (128 * 2048) + (unsigned)(R * 1024 + C) * 2u + kt * 128; }
};
struct EpiMoe1 { const Params& p; const int* tstart;
    DEV void operator()(const f32x4 (&acc)[2][2][4][2], const MoeUnit& u, int wr, int wc, int fr, int fq) const {
        const int* list = (const int*)(p.ws + WS_EL) + (size_t)u.bin * BINCAP + u.mt * 256;
        const float* wl = (const float*)(p.ws + WS_EW) + (size_t)u.bin * BINCAP + u.mt * 256;
        const unsigned* dl = (const unsigned*)(p.ws + WS_EDST) + (size_t)u.bin * BINCAP + u.mt * 256;
        const int r0 = wr * 64 + fr;
        int tk[2][4]; float ww[2][4]; unsigned dd[2][4];
#pragma unroll
        for (int ai = 0; ai < 2; ++ai)
#pragma unroll
            for (int m = 0; m < 4; ++m) { int r = r0 + ai * 128 + m * 16; if (r >= u.n) r = 0; tk[ai][m] = list[r]; ww[ai][m] = wl[r]; dd[ai][m] = dl[r]; }
        float rsv[2][4];
#pragma unroll
        for (int ai = 0; ai < 2; ++ai)
#pragma unroll
            for (int m = 0; m < 4; ++m) rsv[ai][m] = ((const float*)(p.ws + WS_RSTD2))[tk[ai][m]];
        const int f = (u.nt * 256 + 32 * wc + 8 * fq) >> 1;
#pragma unroll
        for (int ai = 0; ai < 2; ++ai)
#pragma unroll
            for (int m = 0; m < 4; ++m) { if (r0 + ai * 128 + m * 16 >= u.n) continue;
                const float rs = rsv[ai][m], w = ww[ai][m]; const unsigned d = dd[ai][m];
                bf16_t* hrow = (bf16_t*)(p.ws + WS_HBUF) + ((size_t)tstart[d & 127u] * 256 + ((d >> 7) & 32767u)) * 1024 + ((d >> 22) & 1u) * 512 + f;
#pragma unroll
                for (int bj = 0; bj < 2; ++bj) { const f32x4 v0 = acc[ai][bj][m][0] * rs, v1 = acc[ai][bj][m][1] * rs;
                    u32x2 w2; w2.x = pk2(siluf_(v0.x) * v0.y * w, siluf_(v0.z) * v0.w * w); w2.y = pk2(siluf_(v1.x) * v1.y * w, siluf_(v1.z) * v1.w * w); *(u32x2*)(hrow + 64 * bj) = w2; } }
    } };
DEV void phase_moe1(const Params& p, unsigned char* lds) {
    moe_tiles(p, lds);
    const int* etstart = (const int*)(lds + MOE_ES);
    PolMoe1 P{p, etstart, (const int*)(lds + MOE_ET), etstart[32] * 4, (int)gridDim.x, vblock()};
    EpiMoe1 E{p, (const int*)(lds + MOE_TS)};
    pg8::gemm_phase2(( PG8_LAS unsigned char*)lds, P, E);
}
struct PolMoe2 {
    typedef MoeUnit Unit;
    const Params& p; const int* tstart; const int* tiletab; int U, G, c;
    struct AddrA { const char* base; };
    struct AddrB { const char* ba; const char* bb; };
    DEV int nk() const { return 16; }
    DEV bool next(int i, MoeUnit& u) const {
        const int L = i * G + c; if (L >= U) return false;
        u.tile = L >> 2; u.nt = L & 3;
        u.bin = __builtin_amdgcn_readfirstlane(tiletab[u.tile]);
        u.mt = u.tile - __builtin_amdgcn_readfirstlane(tstart[u.bin]);
        u.n = min(256, ((const int*)(p.ws + WS_CTL))[u.bin] - u.mt * 256);
        return true;
    }
    DEV bool full(const MoeUnit& u) const { return u.n > 128; }
    DEV void addrA(const MoeUnit& u, AddrA& a) const { a.base = (const char*)(p.ws + WS_HBUF) + (size_t)u.tile * 256 * 2048; }
    DEV void addrB(const MoeUnit& u, AddrB& b) const {
        int ea, eb; bin_experts(u.bin, ea, eb);
        b.ba = (const char*)(p.ws + WS_W2T) + ((size_t)ea * 1024 + u.nt * 256) * 1024; b.bb = (const char*)(p.ws + WS_W2T) + ((size_t)eb * 1024 + u.nt * 256) * 1024;
    }
    DEV const char* pa(const AddrA& a, int h, int i, int kt) const { int R, C; lane_rc(i, R, C); return a.base + (size_t)h * (128 * 2048) + (unsigned)(R * 1024 + C) * 2u + kt * 128; }
    DEV const char* pb(const AddrB& b, int h, int i, int kt) const { int R, C; lane_rc(i, R, C); return (kt < 8 ? b.ba + kt * 128 : b.bb + (kt - 8) * 128) + (size_t)h * (128 * 1024) + (unsigned)(R * 512 + C) * 2u; }
};
struct EpiMoe2 { const Params& p;
    DEV void operator()(const f32x4 (&acc)[2][2][4][2], const MoeUnit& u, int wr, int wc, int fr, int fq) const {
        const int* list = (const int*)(p.ws + WS_BINL) + (size_t)u.bin * BINCAP + u.mt * 256;
        const int r0 = wr * 64 + fr;
        int tk[2][4];
#pragma unroll
        for (int ai = 0; ai < 2; ++ai)
#pragma unroll
            for (int m = 0; m < 4; ++m) { int r = r0 + ai * 128 + m * 16; if (r >= u.n) r = 0; tk[ai][m] = list[r]; }
        const int c0 = u.nt * 256 + 32 * wc + 4 * fq;
#pragma unroll
        for (int ai = 0; ai < 2; ++ai)
#pragma unroll
            for (int m = 0; m < 4; ++m) { if (r0 + ai * 128 + m * 16 >= u.n) continue;
                float* o = p.out + (size_t)tk[ai][m] * DM + c0;
                const f32x4 h0 = *(const f32x4*)(o), h1 = *(const f32x4*)(o + 16), h2 = *(const f32x4*)(o + 128), h3 = *(const f32x4*)(o + 144);
                *(f32x4*)(o) = h0 + acc[ai][0][m][0]; *(f32x4*)(o + 16) = h1 + acc[ai][0][m][1]; *(f32x4*)(o + 128) = h2 + acc[ai][1][m][0]; *(f32x4*)(o + 144) = h3 + acc[ai][1][m][1]; }
    } };
DEV void phase_moe2(const Params& p, unsigned char* lds) {
    moe_tiles(p, lds);
    const int* tstart = (const int*)(lds + MOE_TS);
    PolMoe2 P{p, tstart, (const int*)(lds + MOE_TT), tstart[NBIN] * 4, (int)gridDim.x, vblock()};
    EpiMoe2 E{p};
    pg8::gemm_phase2((PG8_LAS unsigned char*)lds, P, E);
}

#define XB_TMO      128
#define XB_XCNT(j)  (256  + 64 * (j))
#define XB_XSUB(j)  (1280 + 64 * (j))
#define XB_XGEN(j)  (2304 + 64 * (j))
#define XB_TOP      3328
#define XB_TOPGEN   3392
#define XCD_BAR_WORDS 3456
#define XB_SPIN_CAP (1u << 20)
#define LAS __attribute__((address_space(3)))
constexpr size_t WS_BAR = WS_CTL + 4096;
DEV unsigned xb_ld(unsigned* p) { return __hip_atomic_load(p, __ATOMIC_RELAXED, __HIP_MEMORY_SCOPE_AGENT); }
DEV unsigned xb_add(unsigned* p, unsigned v) { return __hip_atomic_fetch_add(p, v, __ATOMIC_RELAXED, __HIP_MEMORY_SCOPE_AGENT); }
DEV unsigned xb_xcc_id() { return (unsigned)__builtin_amdgcn_s_getreg((3 << 11) | 20) & 0xFu; }
#define XB_SPIN(cond, bar) do { unsigned _sp = 0; while (cond) { __builtin_amdgcn_s_sleep(1); \
    if ((++_sp & 255u) == 0u) { if (xb_ld(&(bar)[XB_TMO])) break; if (_sp > XB_SPIN_CAP) { atomicAdd(&(bar)[XB_TMO], 1u); break; } } } } while (0)
struct XcdBarrier { unsigned* bar; unsigned x; volatile LAS unsigned* st; };
DEV XcdBarrier xcd_barrier_post(unsigned* bar, volatile LAS unsigned* st) {
    XcdBarrier b; b.bar = bar; b.x = xb_xcc_id(); b.st = st;
    if (threadIdx.x == 0) (void)xb_add(&bar[XB_XCNT(b.x)], 1u);
    return b;
}
DEV void xcd_barrier_complete(unsigned* bar, unsigned x, unsigned& nloc, unsigned& nx) {
    const unsigned G = gridDim.x * gridDim.y * gridDim.z;
    unsigned sum, cnt, mine, sp = 0u;
    for (;;) {
        sum = 0u; cnt = 0u; mine = 0u;
#pragma unroll
        for (unsigned j = 0; j < 16; ++j) { const unsigned c = xb_ld(&bar[XB_XCNT(j)]); sum += c; cnt += (c > 0u) ? 1u : 0u; mine = (j == x) ? c : mine; }
        if (sum == G) break;
        __builtin_amdgcn_s_sleep(1);
        if ((++sp & 255u) == 0u) { if (xb_ld(&bar[XB_TMO])) break; if (sp > XB_SPIN_CAP) { atomicAdd(&bar[XB_TMO], 1u); break; } }
    }
    nloc = mine > 0u ? mine : 1u; nx = cnt > 0u ? cnt : 1u;
}
DEV void xcd_barrier(const XcdBarrier& b) {
    asm volatile("s_waitcnt vmcnt(0)" ::: "memory");
    __syncthreads();
    if (threadIdx.x == 0) {
        unsigned* bar = b.bar;
        __builtin_amdgcn_s_waitcnt(0);
        unsigned nloc = b.st[0], nx = b.st[1];
        if (nloc == 0u) { xcd_barrier_complete(bar, b.x, nloc, nx); b.st[0] = nloc; b.st[1] = nx; }
        const unsigned old = xb_add(&bar[XB_XSUB(b.x)], 1u);
        const unsigned gen = old / nloc;
        if (old + 1u == (gen + 1u) * nloc) {
            __builtin_amdgcn_fence(__ATOMIC_RELEASE, "agent");
            asm volatile("s_waitcnt vmcnt(0)" ::: "memory");
            const unsigned og = xb_add(&bar[XB_TOP], 1u);
            const unsigned tg = og / nx;
            if (og + 1u == (tg + 1u) * nx) xb_add(&bar[XB_TOPGEN], 1u);
            else XB_SPIN(xb_ld(&bar[XB_TOPGEN]) == tg, bar);
            __builtin_amdgcn_fence(__ATOMIC_ACQUIRE, "agent");
            xb_add(&bar[XB_XGEN(b.x)], 1u);
            asm volatile("s_waitcnt vmcnt(0)" ::: "memory");
        } else {
            XB_SPIN(xb_ld(&bar[XB_XGEN(b.x)]) == gen, bar);
            __builtin_amdgcn_fence(__ATOMIC_ACQUIRE, "agent");
            asm volatile("s_waitcnt vmcnt(0)" ::: "memory");
        }
    }
    __syncthreads();
}

constexpr int LDS_BYTES = 144 * 1024;
constexpr int N_PHASES = 9;
__global__ void __launch_bounds__(NT) mega(Params p, int lo, int hi) {
    extern __shared__ __attribute__((aligned(16))) unsigned char lds[];
    volatile LAS unsigned* xst = (volatile LAS unsigned*)(lds + LDS_BYTES - 16);
    if (threadIdx.x < 4) xst[threadIdx.x] = 0u;
    __syncthreads();
    XcdBarrier xbar; xbar.bar = (unsigned*)(p.ws + WS_BAR); xbar.x = 0; xbar.st = xst;
    if (hi - lo > 1) xbar = xcd_barrier_post((unsigned*)(p.ws + WS_BAR), xst);
#define GRID_SYNC() xcd_barrier(xbar)
#ifndef PROBE_REPEAT
#define PROBE_REPEAT -1
#endif
#define RUN_PHASE(k, call) do { if (lo <= (k) && (k) < hi) { call; \
        if ((k) == PROBE_REPEAT) { GRID_SYNC(); \
            if ((k) == 5) { float* rz = (float*)(p.ws + WS_ROWSS); for (int i = blockIdx.x * NT + threadIdx.x; i < NTOK; i += gridDim.x * NT) rz[i] = 0.f; GRID_SYNC(); } \
            if ((k) == 7) { if (blockIdx.x == 0 && threadIdx.x < 128) ((int*)(p.ws + WS_CTL))[threadIdx.x] = 0; GRID_SYNC(); } \
            call; } \
        if ((k) + 1 < hi) GRID_SYNC(); } } while (0)
    RUN_PHASE(0, phase_prologue(p, lds));
    RUN_PHASE(1, phase_inproj(p, lds));
    RUN_PHASE(2, { phase_cmp_a(p, lds); const int G_ = (int)gridDim.x; if (G_ > 128) phase_hgrn_a1(p, lds, 64, G_ - 64); else phase_hgrn_a1(p, lds, 0, G_); });
    RUN_PHASE(3, { phase_cmp_b(p, lds); phase_hgrn_a2(p, lds); });
    RUN_PHASE(4, { phase_cmp_attn(p, lds); phase_hgrn_a3(p, lds); });
    RUN_PHASE(5, { phase_flash(p, lds); phase_normalize(p, lds); });
    RUN_PHASE(6, phase_outproj(p, lds));
    RUN_PHASE(7, phase_router(p, lds));
    RUN_PHASE(8, phase_moe1(p, lds));
    RUN_PHASE(9, phase_moe2(p, lds));
#undef RUN_PHASE
}

extern "C" void kernel_launch(void* const* d_in, const int* in_sizes, int n_in, void* d_out, int out_size, void* d_ws, size_t ws_size, hipStream_t stream) {
    static int grid = 0;
    if (grid == 0) {
        int dev = 0, cus = 0, per_cu = 0;
        hipGetDevice(&dev);
        hipDeviceGetAttribute(&cus, hipDeviceAttributeMultiprocessorCount, dev);
        hipFuncSetAttribute((const void*)mega, hipFuncAttributeMaxDynamicSharedMemorySize, LDS_BYTES);
        hipOccupancyMaxActiveBlocksPerMultiprocessor(&per_cu, (const void*)mega, NT, LDS_BYTES);
        if (per_cu < 1) per_cu = 1;
        grid = cus;
        if (ws_size < WS_END) fprintf(stderr, "kernel_launch: workspace too small: %zu < %zu\n", ws_size, (size_t)WS_END);
        fprintf(stderr, "kernel_launch: cus %d per_cu %d grid %d ws %zu\n", cus, per_cu, grid, ws_size);
    }
    Params p{};
    const float** pp = (const float**)&p;
    for (int i = 0; i < 23; ++i) pp[i] = (const float*)d_in[i];
    p.out = (float*)d_out; p.ws = (unsigned char*)d_ws;
#if N_LAUNCH_MODE == 1
    (void)hipMemsetAsync((unsigned char*)d_ws + WS_BAR, 0, XCD_BAR_WORDS * 4, stream);
    int lo = 0, hi = N_PHASES + 1;
    void* args[] = {&p, &lo, &hi};
    hipError_t e = hipLaunchCooperativeKernel((const void*)mega, dim3(grid), dim3(NT), args, LDS_BYTES, stream);
    if (e != hipSuccess) fprintf(stderr, "cooperative launch failed: %s\n", hipGetErrorString(e));
#else
    for (int ph = 0; ph <= N_PHASES; ++ph) hipLaunchKernelGGL(mega, dim3(grid), dim3(NT), LDS_BYTES, stream, p, ph, ph + 1);
#endif
}
```

```cpp
#include <hip/hip_runtime.h>
#include <hip/hip_cooperative_groups.h>
#include <cstdio>
#include <cstdint>
#include <cstring>
namespace cg = cooperative_groups;

#ifndef N_LAUNCH_MODE
#define N_LAUNCH_MODE 1
#endif

#define DEV __device__ __forceinline__
typedef unsigned short bf16_t;
typedef short bf16x8 __attribute__((ext_vector_type(8)));
typedef float f32x4 __attribute__((ext_vector_type(4)));
typedef float f32x2 __attribute__((ext_vector_type(2)));
typedef float f32x16 __attribute__((ext_vector_type(16)));
typedef unsigned u32x4 __attribute__((ext_vector_type(4)));
typedef unsigned u32x2 __attribute__((ext_vector_type(2)));

constexpr int NT = 512;
constexpr int BATCH = 8, SEQ = 4096, DM = 1024, NTOK = BATCH * SEQ;
constexpr int IN_COLS = 3352, INP = 3584;
constexpr int NC = 255;
constexpr float RMS_EPS = 1e-6f;
constexpr float QSCALE = 0.125f * 1.4426950408889634f;
constexpr int NBIN = 112;
constexpr int BINCAP = NTOK;

constexpr size_t MiB = 1ull << 20;
constexpr size_t WS_CTL    = 0;
constexpr size_t WS_RSTD1  = 1 * MiB;
constexpr size_t WS_RSTD2  = WS_RSTD1 + 128 * 1024;
constexpr size_t WS_ROWSS  = WS_RSTD2 + 128 * 1024;
constexpr size_t WS_TOKW   = WS_ROWSS + 128 * 1024;
constexpr size_t WS_LB     = WS_TOKW + 256 * 1024;
constexpr size_t WS_CBIAS  = WS_LB + 4096;
constexpr size_t WS_SELM   = 2 * MiB;
constexpr size_t WS_GATES  = 3 * MiB;
constexpr size_t WS_KCMP   = 6 * MiB;
constexpr size_t WS_VCMP   = WS_KCMP + 512 * 1024;
constexpr size_t WS_CW2T   = 7 * MiB;
constexpr size_t WS_RW     = 7 * MiB + 128 * 1024;
constexpr size_t WS_HID    = 8 * MiB;
constexpr size_t WS_CW1T   = 12 * MiB;
constexpr size_t WS_WOUTT  = 14 * MiB;
constexpr size_t WS_WINT   = 16 * MiB;
constexpr size_t WS_R1     = 24 * MiB;
constexpr size_t WS_Q      = 88 * MiB;
constexpr size_t WS_KC     = 120 * MiB;
constexpr size_t WS_VC     = 128 * MiB;
constexpr size_t WS_KS     = 136 * MiB;
constexpr size_t WS_KW     = 144 * MiB;
constexpr size_t WS_VST    = 152 * MiB;
constexpr size_t WS_VWT    = 160 * MiB;
constexpr size_t WS_OC     = 168 * MiB;
constexpr size_t WS_W13T   = 200 * MiB;
constexpr size_t WS_W2T    = 264 * MiB;
constexpr size_t WS_HQ     = 296 * MiB;
constexpr size_t WS_HV     = 328 * MiB;
constexpr size_t WS_HG     = 360 * MiB;
constexpr size_t WS_HLOGF  = 392 * MiB;
constexpr size_t WS_XB     = 424 * MiB;
constexpr size_t WS_DBUF   = 488 * MiB;
constexpr size_t WS_END    = 489 * MiB;
constexpr size_t WS_UBUF   = WS_W13T;
constexpr size_t WS_BINL   = WS_HQ;
constexpr size_t WS_HBUF   = WS_HQ + 16 * MiB;
constexpr size_t WS_EL     = WS_HQ + 136 * MiB;
constexpr size_t WS_EW     = WS_HQ + 140 * MiB;
constexpr size_t WS_EDST   = WS_HQ + 144 * MiB;

struct Params {
    const float *x, *attn_g, *ffn_g, *w_in, *w_out, *g_q, *g_k, *pos_k, *pos_v, *wk1, *wk2, *wv1, *wv2, *g_nsa, *lb_logits, *g_hn,
        *w_group, *b_group, *w_expert, *b_expert, *w1, *w3, *w2;
    float* out;
    unsigned char* ws;
};

typedef __bf16 bf16x2_t __attribute__((ext_vector_type(2)));
DEV unsigned pk2(float lo, float hi) { f32x2 f = {lo, hi}; return __builtin_bit_cast(unsigned, __builtin_convertvector(f, bf16x2_t)); }
DEV bf16_t f2bf(float f) { return (bf16_t)(pk2(f, 0.f) & 0xffffu); }
DEV float bf2f(bf16_t b) { return __uint_as_float(((unsigned)b) << 16); }
DEV float bflo(unsigned u) { return __uint_as_float(u << 16); }
DEV float bfhi(unsigned u) { return __uint_as_float(u & 0xffff0000u); }
DEV float sigmoidf_(float v) { return __builtin_amdgcn_rcpf(1.f + __builtin_amdgcn_exp2f(-1.4426950408889634f * v)); }
DEV float siluf_(float v) { return v * __builtin_amdgcn_rcpf(1.f + __builtin_amdgcn_exp2f(-1.4426950408889634f * v)); }
DEV float wave_sum(float v) {
#pragma unroll
    for (int o = 1; o < 64; o <<= 1) v += __shfl_xor(v, o);
    return v;
}
DEV float wave_max(float v) {
#pragma unroll
    for (int o = 1; o < 64; o <<= 1) v = fmaxf(v, __shfl_xor(v, o));
    return v;
}
DEV int vblock() { const int G = gridDim.x, b = blockIdx.x; return (G % 8 == 0) ? (b % 8) * (G / 8) + b / 8 : b; }

namespace pg8 {
#define PG8_LAS __attribute__((address_space(3)))
constexpr int BM = 256, BK = 64, HALF = 128, HTB = HALF * BK * 2, STAGE_BYTES = 8 * HTB, NXCD = 8, WGM = 1;
__host__ __device__ __forceinline__ int lds_byte(int r, int c) { const int st = (r >> 4) * 2 + (c >> 5), rr = r & 15, cc = c & 31, ob = rr * 64 + cc * 2; return st * 1024 + (ob ^ (((ob >> 9) & 1) << 5)); }
__host__ __device__ __forceinline__ void stage_rc(int b, int& R, int& C) { const int st = b / 1024, sb = b % 1024, swz = sb ^ (((sb >> 9) & 1) << 5); R = (st >> 1) * 16 + swz / 64; C = (st & 1) * 32 + (swz % 64) / 2; }
struct Unit { int pm, pn; };
struct Gemm { const bf16_t* A; const bf16_t* Bt; int M, N, K; };
struct StaticOrder {
    int nM, nN, nwg, G, c;
    __host__ __device__ void init(int M, int N, int G_, int c_) { nM = M / BM; nN = N / BM; nwg = nM * nN; G = G_; c = c_; }
    __host__ __device__ bool next(int i, Unit& u) const {
        const long L = (long)i * G + c; if (L >= nwg) return false;
        int wgid = (int)L; { const int q = nwg / NXCD, r = nwg % NXCD, xcd = wgid % NXCD, off = wgid / NXCD; wgid = (xcd < r ? xcd * (q + 1) : r * (q + 1) + (xcd - r) * q) + off; }
        const int nig = WGM * nN, gid = wgid / nig, fm = gid * WGM, gsz = (nM - fm) < WGM ? (nM - fm) : WGM;
        u.pm = fm + ((wgid % nig) % gsz); u.pn = (wgid % nig) / gsz; return true;
    }
};
template <class Epi, class Sched>
__device__ __forceinline__ void gemm_phase(PG8_LAS unsigned char* lds, const Gemm g, const Sched& S, const Epi& E) {
    const int tid = threadIdx.x, wid = __builtin_amdgcn_readfirstlane(tid >> 6), lane = tid & 63, wr = wid >> 2, wc = wid & 3, fr = lane & 15, fq = lane >> 4;
    const int K = g.K, nt = K / BK;
    unsigned voffA[2];
#pragma unroll
    for (int i = 0; i < 2; ++i) { int R, C; stage_rc(tid * 16 + i * 8192, R, C); voffA[i] = (unsigned)(R * K + C) * 2u; }
    const size_t kstep = (size_t)(BK * 2);
    const size_t hstep = (size_t)HALF * K * 2;
    const size_t tstep = 2 * hstep;
    const unsigned ldsw = (unsigned)wid * 1024u;
    const int aoff = lds_byte(wr * 64 + fr, fq * 8), boff = lds_byte(wc * 32 + fr, fq * 8);
#define PG8_SA(b, h) (((b) * 2 + (h)) * HTB)
#define PG8_SB(b, h) ((4 + (b) * 2 + (h)) * HTB)
#define PG8_STAGE(bufoff, gbase, voff) do { _Pragma("unroll") for (int _i = 0; _i < 2; ++_i) \
        __builtin_amdgcn_global_load_lds((const unsigned*)((const char*)(gbase) + (voff)[_i]), (PG8_LAS unsigned*)(lds + (bufoff) + ldsw + _i * 8192), 16, 0, 0); } while (0)
#define PG8_LDA(dst, b, h) do { _Pragma("unroll") for (int m = 0; m < 4; ++m) _Pragma("unroll") for (int k = 0; k < 2; ++k) dst[m][k] = *(const PG8_LAS bf16x8*)(lds + PG8_SA(b, h) + aoff + m * 2048 + k * 1024); } while (0)
#define PG8_LDB(dst, b, h) do { _Pragma("unroll") for (int n = 0; n < 2; ++n) _Pragma("unroll") for (int k = 0; k < 2; ++k) dst[n][k] = *(const PG8_LAS bf16x8*)(lds + PG8_SB(b, h) + boff + n * 2048 + k * 1024); } while (0)
#define PG8_MMA(ai, bj, At, Bt) do { __builtin_amdgcn_s_setprio(1); _Pragma("unroll") for (int m = 0; m < 4; ++m) _Pragma("unroll") for (int n = 0; n < 2; ++n) _Pragma("unroll") for (int k = 0; k < 2; ++k) \
        acc[ai][bj][m][n] = __builtin_amdgcn_mfma_f32_16x16x32_bf16(Bt[n][k], At[m][k], acc[ai][bj][m][n], 0, 0, 0); __builtin_amdgcn_s_setprio(0); } while (0)
#define PG8_WAIT_V(n) asm volatile("s_waitcnt vmcnt(" #n ")" ::: "memory")
#define PG8_WAIT_L(n) asm volatile("s_waitcnt lgkmcnt(" #n ")" ::: "memory")
#define PG8_BAR __builtin_amdgcn_s_barrier()
#define PG8_SCHED __builtin_amdgcn_sched_barrier(0)
    Unit cur, nxt; int ui = 0;
    if (!S.next(0, cur)) return;
    f32x4 acc[2][2][4][2];
#pragma unroll
    for (int a = 0; a < 2; ++a)
#pragma unroll
        for (int b = 0; b < 2; ++b)
#pragma unroll
            for (int m = 0; m < 4; ++m)
#pragma unroll
                for (int n = 0; n < 2; ++n) acc[a][b][m][n] = (f32x4){0.f, 0.f, 0.f, 0.f};
    bf16x8 At[4][2], B0[2][2], B1[2][2];
    const char* cA = (const char*)g.A + (size_t)cur.pm * tstep; const char* cB = (const char*)g.Bt + (size_t)cur.pn * tstep;
    PG8_STAGE(PG8_SB(0, 0), cB, voffA); PG8_STAGE(PG8_SA(0, 0), cA, voffA); PG8_STAGE(PG8_SB(0, 1), cB + hstep, voffA); PG8_STAGE(PG8_SA(0, 1), cA + hstep, voffA);
    if (wr == 1) PG8_BAR;
    PG8_WAIT_V(4); PG8_BAR;
    PG8_STAGE(PG8_SB(1, 0), cB + kstep, voffA); PG8_STAGE(PG8_SA(1, 0), cA + kstep, voffA); PG8_STAGE(PG8_SB(1, 1), cB + hstep + kstep, voffA);
    PG8_WAIT_V(6); PG8_BAR;
    for (;;) {
        const bool has_next = S.next(ui + 1, nxt);
        const char* nA = has_next ? (const char*)g.A + (size_t)nxt.pm * tstep : cA; const char* nB = has_next ? (const char*)g.Bt + (size_t)nxt.pn * tstep : cB;
        float midrs[2][4];
        if constexpr (Epi::MIDSCALE) {
#pragma unroll
            for (int a = 0; a < 2; ++a)
#pragma unroll
                for (int m = 0; m < 4; ++m) midrs[a][m] = E.rowscale(cur.pm * BM + a * HALF + wr * 64 + m * 16 + fr); }
        for (int t = 0; t < nt; t += 2) {
            const bool last = (t == nt - 2);
            if constexpr (Epi::MIDSCALE) { if (t == E.midk()) {
#pragma unroll
                for (int a = 0; a < 2; ++a)
#pragma unroll
                    for (int b = 0; b < 2; ++b)
#pragma unroll
                        for (int m = 0; m < 4; ++m)
#pragma unroll
                            for (int n = 0; n < 2; ++n) acc[a][b][m][n] = acc[a][b][m][n] * midrs[a][m]; } }
            const char* a1 = cA + (size_t)(t + 1) * kstep;
            const char* a2 = last ? nA : cA + (size_t)(t + 2) * kstep; const char* b2 = last ? nB : cB + (size_t)(t + 2) * kstep;
            const char* a3 = a2 + kstep; const char* b3 = b2 + kstep;
            PG8_LDB(B0, 0, 0); PG8_SCHED; PG8_LDA(At, 0, 0); PG8_STAGE(PG8_SA(1, 1), a1 + hstep, voffA);
            PG8_WAIT_L(8); PG8_BAR; PG8_WAIT_L(0); PG8_MMA(0, 0, At, B0); PG8_BAR; PG8_SCHED;
            PG8_LDB(B1, 0, 1); PG8_STAGE(PG8_SB(0, 0), b2, voffA);
            PG8_BAR; PG8_WAIT_L(0); PG8_MMA(0, 1, At, B1); PG8_BAR;
            PG8_LDA(At, 0, 1); PG8_STAGE(PG8_SA(0, 0), a2, voffA);
            PG8_BAR; PG8_WAIT_L(0); PG8_MMA(1, 0, At, B0); PG8_BAR; PG8_SCHED;
            PG8_STAGE(PG8_SB(0, 1), b2 + hstep, voffA);
            PG8_WAIT_V(6); PG8_BAR; PG8_MMA(1, 1, At, B1); PG8_BAR;
            PG8_LDB(B0, 1, 0); PG8_SCHED; PG8_LDA(At, 1, 0); PG8_STAGE(PG8_SA(0, 1), a2 + hstep, voffA);
            PG8_WAIT_L(8); PG8_BAR; PG8_WAIT_L(0); PG8_MMA(0, 0, At, B0); PG8_BAR; PG8_SCHED;
            PG8_LDB(B1, 1, 1); PG8_STAGE(PG8_SB(1, 0), b3, voffA);
            PG8_BAR; PG8_WAIT_L(0); PG8_MMA(0, 1, At, B1); PG8_BAR;
            PG8_LDA(At, 1, 1); PG8_STAGE(PG8_SA(1, 0), a3, voffA);
            PG8_BAR; PG8_WAIT_L(0); PG8_MMA(1, 0, At, B0); PG8_BAR; PG8_SCHED;
            PG8_STAGE(PG8_SB(1, 1), b3 + hstep, voffA);
            PG8_WAIT_V(6); PG8_BAR; PG8_MMA(1, 1, At, B1); PG8_BAR;
        }
        E(acc, cur, wr, wc, fr, fq);
        if (!has_next) break;
#pragma unroll
        for (int a = 0; a < 2; ++a)
#pragma unroll
            for (int b = 0; b < 2; ++b)
#pragma unroll
                for (int m = 0; m < 4; ++m)
#pragma unroll
                    for (int n = 0; n < 2; ++n) acc[a][b][m][n] = (f32x4){0.f, 0.f, 0.f, 0.f};
        cur = nxt; cA = nA; cB = nB; ++ui;
    }
    PG8_WAIT_V(0);
    if (wr == 0) PG8_BAR;
    PG8_BAR;
#undef PG8_SA
#undef PG8_SB
#undef PG8_STAGE
#undef PG8_LDA
#undef PG8_LDB
#undef PG8_MMA
#undef PG8_WAIT_V
#undef PG8_WAIT_L
#undef PG8_BAR
#undef PG8_SCHED
}
template <class Pol, class Epi>
__device__ __forceinline__ void gemm_phase2(PG8_LAS unsigned char* lds, const Pol& P, const Epi& E) {
    const int tid = threadIdx.x, wid = __builtin_amdgcn_readfirstlane(tid >> 6), lane = tid & 63, wr = wid >> 2, wc = wid & 3, fr = lane & 15, fq = lane >> 4;
    const int nt = P.nk();
    const unsigned ldsw = (unsigned)wid * 1024u;
    const int aoff = lds_byte(wr * 64 + fr, fq * 8), boff = lds_byte(wc * 32 + fr, fq * 8);
#define PG8_SA(b, h) (((b) * 2 + (h)) * HTB)
#define PG8_SB(b, h) ((4 + (b) * 2 + (h)) * HTB)
#define PG8_STAGE_A(bufoff, AS, h, kt) do { _Pragma("unroll") for (int _i = 0; _i < 2; ++_i) \
        __builtin_amdgcn_global_load_lds((const unsigned*)P.pa(AS, h, _i, kt), (PG8_LAS unsigned*)(lds + (bufoff) + ldsw + _i * 8192), 16, 0, 0); } while (0)
#define PG8_STAGE_B(bufoff, BS, h, kt) do { _Pragma("unroll") for (int _i = 0; _i < 2; ++_i) \
        __builtin_amdgcn_global_load_lds((const unsigned*)P.pb(BS, h, _i, kt), (PG8_LAS unsigned*)(lds + (bufoff) + ldsw + _i * 8192), 16, 0, 0); } while (0)
#define PG8_LDA(dst, b, h) do { _Pragma("unroll") for (int m = 0; m < 4; ++m) _Pragma("unroll") for (int k = 0; k < 2; ++k) dst[m][k] = *(const PG8_LAS bf16x8*)(lds + PG8_SA(b, h) + aoff + m * 2048 + k * 1024); } while (0)
#define PG8_LDB(dst, b, h) do { _Pragma("unroll") for (int n = 0; n < 2; ++n) _Pragma("unroll") for (int k = 0; k < 2; ++k) dst[n][k] = *(const PG8_LAS bf16x8*)(lds + PG8_SB(b, h) + boff + n * 2048 + k * 1024); } while (0)
#define PG8_MMA(ai, bj, At, Bt) do { __builtin_amdgcn_s_setprio(1); _Pragma("unroll") for (int m = 0; m < 4; ++m) _Pragma("unroll") for (int n = 0; n < 2; ++n) _Pragma("unroll") for (int k = 0; k < 2; ++k) \
        acc[ai][bj][m][n] = __builtin_amdgcn_mfma_f32_16x16x32_bf16(Bt[n][k], At[m][k], acc[ai][bj][m][n], 0, 0, 0); __builtin_amdgcn_s_setprio(0); } while (0)
#define PG8_STAGE_A2(bufoff, h, kt) do { _Pragma("unroll") for (int _i = 0; _i < 2; ++_i) \
        __builtin_amdgcn_global_load_lds((const unsigned*)P.pa(a2, h, _i, kt), (PG8_LAS unsigned*)(lds + (bufoff) + ldsw + _i * 8192), 16, 0, 0); } while (0)
#define PG8_STAGE_B2(bufoff, h, kt) do { _Pragma("unroll") for (int _i = 0; _i < 2; ++_i) \
        __builtin_amdgcn_global_load_lds((const unsigned*)P.pb(b2, h, _i, kt), (PG8_LAS unsigned*)(lds + (bufoff) + ldsw + _i * 8192), 16, 0, 0); } while (0)
#define PG8_WAIT_V(n) asm volatile("s_waitcnt vmcnt(" #n ")" ::: "memory")
#define PG8_WAIT_L(n) asm volatile("s_waitcnt lgkmcnt(" #n ")" ::: "memory")
#define PG8_BAR __builtin_amdgcn_s_barrier()
#define PG8_SCHED __builtin_amdgcn_sched_barrier(0)
    typename Pol::Unit cur, nxt; int ui = 0;
    if (!P.next(0, cur)) return;
    f32x4 acc[2][2][4][2];
#pragma unroll
    for (int a = 0; a < 2; ++a)
#pragma unroll
        for (int b = 0; b < 2; ++b)
#pragma unroll
            for (int m = 0; m < 4; ++m)
#pragma unroll
                for (int n = 0; n < 2; ++n) acc[a][b][m][n] = (f32x4){0.f, 0.f, 0.f, 0.f};
    bf16x8 At[4][2], B0[2][2], B1[2][2];
    typename Pol::AddrA aC, aN; typename Pol::AddrB bC, bN;
    P.addrA(cur, aC); P.addrB(cur, bC);
    PG8_STAGE_B(PG8_SB(0, 0), bC, 0, 0); PG8_STAGE_A(PG8_SA(0, 0), aC, 0, 0); PG8_STAGE_B(PG8_SB(0, 1), bC, 1, 0); PG8_STAGE_A(PG8_SA(0, 1), aC, 1, 0);
    if (wr == 1) PG8_BAR;
    PG8_WAIT_V(4); PG8_BAR;
    PG8_STAGE_B(PG8_SB(1, 0), bC, 0, 1); PG8_STAGE_A(PG8_SA(1, 0), aC, 0, 1); PG8_STAGE_B(PG8_SB(1, 1), bC, 1, 1);
    PG8_WAIT_V(6); PG8_BAR;
    for (;;) {
        const bool has_next = P.next(ui + 1, nxt);
        if (has_next) { P.addrA(nxt, aN); P.addrB(nxt, bN); } else { aN = aC; bN = bC; }
        const bool full = P.full(cur);
        for (int t = 0; t < nt; t += 2) {
            const bool last = (t == nt - 2);
            const typename Pol::AddrA a2 = last ? aN : aC; const typename Pol::AddrB b2 = last ? bN : bC;
            const int k2 = last ? 0 : t + 2, k3 = k2 + 1;
            PG8_LDB(B0, 0, 0); PG8_SCHED; PG8_LDA(At, 0, 0); PG8_STAGE_A(PG8_SA(1, 1), aC, 1, t + 1);
            PG8_WAIT_L(8); PG8_BAR; PG8_WAIT_L(0); PG8_MMA(0, 0, At, B0); PG8_BAR; PG8_SCHED;
            PG8_LDB(B1, 0, 1); PG8_STAGE_B2(PG8_SB(0, 0), 0, k2);
            PG8_BAR; PG8_WAIT_L(0); PG8_MMA(0, 1, At, B1); PG8_BAR;
            PG8_LDA(At, 0, 1); PG8_STAGE_A2(PG8_SA(0, 0), 0, k2);
            PG8_BAR; PG8_WAIT_L(0); if (full) PG8_MMA(1, 0, At, B0); PG8_BAR; PG8_SCHED;
            PG8_STAGE_B2(PG8_SB(0, 1), 1, k2);
            PG8_WAIT_V(6); PG8_BAR; if (full) PG8_MMA(1, 1, At, B1); PG8_BAR;
            PG8_LDB(B0, 1, 0); PG8_SCHED; PG8_LDA(At, 1, 0); PG8_STAGE_A2(PG8_SA(0, 1), 1, k2);
            PG8_WAIT_L(8); PG8_BAR; PG8_WAIT_L(0); PG8_MMA(0, 0, At, B0); PG8_BAR; PG8_SCHED;
            PG8_LDB(B1, 1, 1); PG8_STAGE_B2(PG8_SB(1, 0), 0, k3);
            PG8_BAR; PG8_WAIT_L(0); PG8_MMA(0, 1, At, B1); PG8_BAR;
            PG8_LDA(At, 1, 1); PG8_STAGE_A2(PG8_SA(1, 0), 0, k3);
            PG8_BAR; PG8_WAIT_L(0); if (full) PG8_MMA(1, 0, At, B0); PG8_BAR; PG8_SCHED;
            PG8_STAGE_B2(PG8_SB(1, 1), 1, k3);
            PG8_WAIT_V(6); PG8_BAR; if (full) PG8_MMA(1, 1, At, B1); PG8_BAR;
        }
        E(acc, cur, wr, wc, fr, fq);
        if (!has_next) break;
#pragma unroll
        for (int a = 0; a < 2; ++a)
#pragma unroll
            for (int b = 0; b < 2; ++b)
#pragma unroll
                for (int m = 0; m < 4; ++m)
#pragma unroll
                    for (int n = 0; n < 2; ++n) acc[a][b][m][n] = (f32x4){0.f, 0.f, 0.f, 0.f};
        cur = nxt; aC = aN; bC = bN; ++ui;
    }
    PG8_WAIT_V(0);
    if (wr == 0) PG8_BAR;
    PG8_BAR;
#undef PG8_SA
#undef PG8_SB
#undef PG8_STAGE_A
#undef PG8_STAGE_B
#undef PG8_STAGE_A2
#undef PG8_STAGE_B2
#undef PG8_LDA
#undef PG8_LDB
#undef PG8_MMA
#undef PG8_WAIT_V
#undef PG8_WAIT_L
#undef PG8_BAR
#undef PG8_SCHED
}
__host__ __device__ __forceinline__ int perm_lo(int x) { return (((x >> 2) & 3) << 3) | (((x >> 4) & 1) << 2) | (x & 3); }
__host__ __device__ __forceinline__ int inv_perm_lo(int y) { return (((y >> 2) & 1) << 4) | (((y >> 3) & 3) << 2) | (y & 3); }
__host__ __device__ __forceinline__ int logcol(int p) { return (p & ~255) + 64 * ((p >> 5) & 3) + 32 * ((p >> 7) & 1) + perm_lo(p & 31); }
}

template <class SRC>
DEV void convert_tile(float* tl, const SRC& src, bf16_t* dst, int ldd, int n0, int k0) {
    const int tid = threadIdx.x;
    {
        const int n = tid & 63;
#pragma unroll
        for (int i = 0; i < 8; ++i) { const int kk = (tid >> 6) + 8 * i; tl[kk * 65 + n] = src.get(n0 + n, k0 + kk); }
    }
    __syncthreads();
    {
        const int n = tid >> 3, kc = tid & 7;
        const float* s = tl + (kc * 8) * 65 + n;
        u32x4 o;
        o.x = pk2(s[0 * 65], s[1 * 65]); o.y = pk2(s[2 * 65], s[3 * 65]); o.z = pk2(s[4 * 65], s[5 * 65]); o.w = pk2(s[6 * 65], s[7 * 65]);
        *(u32x4*)(dst + (size_t)(n0 + n) * ldd + k0 + kc * 8) = o;
    }
    __syncthreads();
}
struct SrcWin { const float* w; const float* g;
    DEV float get(int np, int k) const { const int n = pg8::logcol(np); int col; if (n < 1280) col = n; else if (n < 3328) col = n + 24; else if (n < 3352) col = 1280 + (n - 3328); else return 0.f;
        return w[(size_t)k * IN_COLS + col] * g[k]; } };
struct SrcWout { const float* w; const float* g;
    DEV float get(int np, int k) const { const int n = pg8::logcol(np); const float v = w[(size_t)k * DM + n]; return k < 512 ? v * g[k] : v; } };
struct SrcPlain { const float* w; int ld;
    DEV float get(int n, int k) const { return w[(size_t)k * ld + n]; } };
struct SrcW13 { const float* w1; const float* w3; const float* g;
    DEV float get(int n, int k) const { const uintptr_t a = (uintptr_t)w1, b = (uintptr_t)w3; const float* w = (const float*)(a + ((b - a) & (uintptr_t)(0 - (long long)(n & 1))));
        return w[(size_t)k * 512 + (n >> 1)] * g[k]; } };

template <class SRC>
DEV void convert_tile256(float* tl, const SRC& src, bf16_t* dst, int ldd, int n0, int k0) {
    const int tid = threadIdx.x;
    {
        const int q = tid & 63;
        f32x4 v[8];
#pragma unroll
        for (int i = 0; i < 8; ++i) v[i] = src.quad(n0, q, k0 + (tid >> 6) + 8 * i);
#pragma unroll
        for (int i = 0; i < 8; ++i) { float* o = tl + ((tid >> 6) + 8 * i) * 257; o[src.drow(q, 0)] = v[i].x; o[src.drow(q, 1)] = v[i].y; o[src.drow(q, 2)] = v[i].z; o[src.drow(q, 3)] = v[i].w; }
    }
    __syncthreads();
#pragma unroll
    for (int i = 0; i < 4; ++i) {
        const int idx = tid + NT * i, n = idx >> 3, kc = idx & 7;
        const float* s = tl + (kc * 8) * 257 + n;
        u32x4 o;
        o.x = pk2(s[0 * 257], s[1 * 257]); o.y = pk2(s[2 * 257], s[3 * 257]); o.z = pk2(s[4 * 257], s[5 * 257]); o.w = pk2(s[6 * 257], s[7 * 257]);
        *(u32x4*)(dst + (size_t)(n0 + n) * ldd + k0 + kc * 8) = o;
    }
    __syncthreads();
}
struct SrcWin4 { const float* w; const float* g;
    DEV int drow(int q, int e) const { return 4 * q + e; }
    DEV f32x4 quad(int n0, int q, int k) const { const int n = pg8::logcol(n0 + 4 * q); int col; if (n < 1280) col = n; else if (n < 3328) col = n + 24; else if (n < 3352) col = 1280 + (n - 3328); else return (f32x4){0.f, 0.f, 0.f, 0.f};
        return *(const f32x4*)(w + (size_t)k * IN_COLS + col) * g[k]; } };
struct SrcWout4 { const float* w; const float* g;
    DEV int drow(int q, int e) const { return 4 * q + e; }
    DEV f32x4 quad(int n0, int q, int k) const { const f32x4 v = *(const f32x4*)(w + (size_t)k * DM + pg8::logcol(n0 + 4 * q)); return k < 512 ? v * g[k] : v; } };
struct SrcPlain4 { const float* w; int ld;
    DEV int drow(int q, int e) const { return 4 * q + e; }
    DEV f32x4 quad(int n0, int q, int k) const { return *(const f32x4*)(w + (size_t)k * ld + n0 + 4 * q); } };
struct SrcW13_4 { const float* w1; const float* w3; const float* g;
    DEV int drow(int q, int e) const { const int l = 8 * (q & 31) + 2 * e + (q >> 5); return (l & ~31) | pg8::inv_perm_lo(l & 31); }
    DEV f32x4 quad(int n0, int q, int k) const { const uintptr_t a = (uintptr_t)w1, b = (uintptr_t)w3; const float* w = (const float*)(a + ((b - a) & (uintptr_t)(0 - (long long)(q >> 5))));
        return *(const f32x4*)(w + (size_t)k * 512 + (n0 >> 1) + 4 * (q & 31)) * g[k]; } };

DEV void phase_prologue(const Params& p, unsigned char* lds) {
    float* tl = (float*)lds;
    const int tid = threadIdx.x, lane = tid & 63, wid = tid >> 6;
    const int vb = vblock(), G = gridDim.x;
    unsigned char* ws = p.ws;
    constexpr int I_WIN = (INP / 256) * (DM / 64);
    constexpr int I_WOUT = 4 * 16;
    constexpr int I_CW1 = 2 * 32;
    constexpr int I_W2 = 32 * 4 * 8;
    constexpr int I_CW2 = 2 * 1 * 4;
    constexpr int I_ALL = I_WIN + I_WOUT + I_CW1 + I_W2 + I_CW2;
    for (int it = vb; it < I_ALL; it += G) {
        int r = it;
        if (r < I_WIN) { SrcWin4 s{p.w_in, p.attn_g}; convert_tile256(tl, s, (bf16_t*)(ws + WS_WINT), DM, (r / 16) * 256, (r % 16) * 64); continue; } r -= I_WIN;
        if (r < I_WOUT) { SrcWout4 s{p.w_out, p.g_nsa}; convert_tile256(tl, s, (bf16_t*)(ws + WS_WOUTT), DM, (r / 16) * 256, (r % 16) * 64); continue; } r -= I_WOUT;
        if (r < I_CW1) { const int z = r / 32, q = r % 32; SrcPlain4 s{z ? p.wv1 : p.wk1, 256};
            convert_tile256(tl, s, (bf16_t*)(ws + WS_CW1T) + (size_t)z * 256 * 2048, 2048, 0, q * 64); continue; } r -= I_CW1;
        if (r < I_W2) { const int e = r / 32, q = r % 32; SrcPlain4 s{p.w2 + (size_t)e * 512 * 1024, 1024};
            convert_tile256(tl, s, (bf16_t*)(ws + WS_W2T) + (size_t)e * 1024 * 512, 512, (q / 8) * 256, (q % 8) * 64); continue; } r -= I_W2;
        { const int z = r / 4, q = r % 4; SrcPlain s{z ? p.wv2 : p.wk2, 64};
            convert_tile(tl, s, (bf16_t*)(ws + WS_CW2T) + (size_t)z * 64 * 256, 256, 0, q * 64); }
    }
    {
        bf16_t* xb = (bf16_t*)(ws + WS_XB); float* rstd1 = (float*)(ws + WS_RSTD1);
        const int gw = vb * 8 + wid, NGW = G * 8;
        for (int m = gw; m < NTOK; m += NGW) {
            const f32x4* xr = (const f32x4*)(p.x + (size_t)m * DM) + lane;
            f32x4 v[4]; float s = 0.f;
#pragma unroll
            for (int j = 0; j < 4; ++j) { v[j] = xr[64 * j]; s += (v[j].x * v[j].x + v[j].y * v[j].y) + (v[j].z * v[j].z + v[j].w * v[j].w); }
            s = wave_sum(s);
            if (lane == 0) rstd1[m] = rsqrtf(s * (1.f / DM) + RMS_EPS);
            u32x2* o = (u32x2*)(xb + (size_t)m * DM) + lane;
#pragma unroll
            for (int j = 0; j < 4; ++j) { u32x2 w; w.x = pk2(v[j].x, v[j].y); w.y = pk2(v[j].z, v[j].w); o[64 * j] = w; }
        }
    }
    {
        const int gt = vb * NT + tid, NG = G * NT;
        float* rowss = (float*)(ws + WS_ROWSS);
        for (int i = gt; i < NTOK; i += NG) rowss[i] = 0.f;
        int* bincnt = (int*)(ws + WS_CTL);
        if (gt < 128) bincnt[gt] = 0;
        if (gt < 32) ((int*)(ws + WS_CTL + 512))[gt] = 0;
        if (gt < 512) { const float l0 = p.lb_logits[gt], l1 = p.lb_logits[512 + gt]; ((float*)(ws + WS_LB))[gt] = 1.f / (1.f + __expf(l1 - l0)); }
        for (int i = gt; i < 48 * 1024; i += NG) { const int c = i >> 10, k = i & 1023;
            const float w = (c < 4 ? p.w_group[k * 4 + c] : (c < 36 ? p.w_expert[k * 32 + (c - 4)] : 0.f)) * p.ffn_g[k];
            const bf16_t hi = f2bf(w); const bf16_t lo = f2bf(w - bf2f(hi));
            ((bf16_t*)(ws + WS_RW))[i] = hi; ((bf16_t*)(ws + WS_RW))[48 * 1024 + i] = lo; }
        {
            const int ob = (vb * 8 + wid) * 4;
            if (ob < 512) { const int z = ob >> 8, j0 = ob & 255; const float* pos = z ? p.pos_v : p.pos_k; const float* w = (z ? p.wv1 : p.wk1) + j0;
                f32x4 a = (f32x4){0.f, 0.f, 0.f, 0.f};
#pragma unroll 8
                for (int k = lane; k < 2048; k += 64) a = a + *(const f32x4*)(w + (size_t)k * 256) * pos[k];
                a.x = wave_sum(a.x); a.y = wave_sum(a.y); a.z = wave_sum(a.z); a.w = wave_sum(a.w);
                if (lane == 0) *(f32x4*)((float*)(ws + WS_CBIAS) + ob) = a; }
        }
    }
}

constexpr int G_A_BYTES = 128 * 128, G_B_BYTES = 256 * 128, G_STAGE = G_A_BYTES + G_B_BYTES, G_LDS = 2 * G_STAGE;
DEV int swz(int row, int chunk) { return row * 128 + ((chunk ^ ((row >> 1) & 7)) << 4); }
template <class AL, class BL, class EP>
DEV void gemm_tile(unsigned char* lds, const AL& al, const BL& bl, int nk, const EP& ep) {
    const int tid = threadIdx.x, lane = tid & 63, wid = tid >> 6, wr = wid >> 2, wc = wid & 3;
    const int frow = lane & 15, fq = lane >> 4;
    const bf16_t* aptr[2]; int aoff[2], boff[4], brow[4];
#pragma unroll
    for (int i = 0; i < 2; ++i) { const int q = tid + NT * i, row = q >> 3, ch = q & 7; aptr[i] = al.row(row) + ch * 8; aoff[i] = swz(row, ch); }
#pragma unroll
    for (int i = 0; i < 4; ++i) { const int q = tid + NT * i, row = q >> 3, ch = q & 7; brow[i] = row; boff[i] = G_A_BYTES + swz(row, ch) ; }
    const int bch8 = (tid & 7) * 8;
    u32x4 ra[2], rb[4];
#pragma unroll
    for (int i = 0; i < 2; ++i) ra[i] = *(const u32x4*)(aptr[i]);
#pragma unroll
    for (int i = 0; i < 4; ++i) rb[i] = *(const u32x4*)(bl.ptr(brow[i], 0) + bch8);
#pragma unroll
    for (int i = 0; i < 2; ++i) *(u32x4*)(lds + aoff[i]) = ra[i];
#pragma unroll
    for (int i = 0; i < 4; ++i) *(u32x4*)(lds + boff[i]) = rb[i];
    __syncthreads();
    f32x4 acc[4][4];
#pragma unroll
    for (int m = 0; m < 4; ++m)
#pragma unroll
        for (int n = 0; n < 4; ++n) acc[m][n] = (f32x4){0.f, 0.f, 0.f, 0.f};
    const int sx = (frow >> 1) & 7;
    for (int kt = 0; kt < nk; ++kt) {
        const bool more = (kt + 1 < nk);
        if (more) {
#pragma unroll
            for (int i = 0; i < 2; ++i) ra[i] = *(const u32x4*)(aptr[i] + (kt + 1) * 64);
#pragma unroll
            for (int i = 0; i < 4; ++i) rb[i] = *(const u32x4*)(bl.ptr(brow[i], kt + 1) + bch8);
        }
        const unsigned char* base = lds + (kt & 1) * G_STAGE;
#pragma unroll
        for (int ks = 0; ks < 2; ++ks) {
            const int co = ((ks * 4 + fq) ^ sx) << 4;
            bf16x8 af[4], bfr[4];
#pragma unroll
            for (int m = 0; m < 4; ++m) af[m] = *(const bf16x8*)(base + (wr * 64 + m * 16 + frow) * 128 + co);
#pragma unroll
            for (int n = 0; n < 4; ++n) bfr[n] = *(const bf16x8*)(base + G_A_BYTES + (wc * 64 + n * 16 + frow) * 128 + co);
#pragma unroll
            for (int m = 0; m < 4; ++m)
#pragma unroll
                for (int n = 0; n < 4; ++n) acc[m][n] = __builtin_amdgcn_mfma_f32_16x16x32_bf16(bfr[n], af[m], acc[m][n], 0, 0, 0);
        }
        if (more) {
            unsigned char* nb = lds + ((kt + 1) & 1) * G_STAGE;
#pragma unroll
            for (int i = 0; i < 2; ++i) *(u32x4*)(nb + aoff[i]) = ra[i];
#pragma unroll
            for (int i = 0; i < 4; ++i) *(u32x4*)(nb + boff[i]) = rb[i];
        }
        __syncthreads();
    }
    ep(acc, wr, wc, lane);
}

struct ARows { const bf16_t* base; size_t ld; DEV const bf16_t* row(int r) const { return base + (size_t)r * ld; } };
struct BRows { const bf16_t* base; size_t ld; DEV const bf16_t* ptr(int n, int kt) const { return base + (size_t)n * ld + kt * 64; } };

DEV u32x4 pk8(const f32x4 a, const f32x4 b) { u32x4 w; w.x = pk2(a.x, a.y); w.y = pk2(a.z, a.w); w.z = pk2(b.x, b.y); w.w = pk2(b.z, b.w); return w; }
struct EpiInproj8 { const Params& p; static constexpr bool MIDSCALE = false; DEV float rowscale(int) const { return 1.f; } DEV int midk() const { return -1; }
    DEV void operator()(const f32x4 (&acc)[2][2][4][2], const pg8::Unit& u, int wr, int wc, int fr, int fq) const {
        const int seg = u.pn * 4 + wc;
        if (seg > 52) return;
        unsigned char* ws = p.ws;
        const int row0 = u.pm * 256 + wr * 64 + fr;
        const int b = row0 >> 12, s0 = row0 & 4095;
        float rs[2][4];
#pragma unroll
        for (int ai = 0; ai < 2; ++ai)
#pragma unroll
            for (int m = 0; m < 4; ++m) rs[ai][m] = ((const float*)(ws + WS_RSTD1))[row0 + 128 * ai + 16 * m];
        const bool is_q = seg < 8, is_ks = (seg == 12 || seg == 13), is_kw = (seg == 16 || seg == 17);
        if (is_q || is_ks || is_kw) {
            const float* gw = (is_q ? p.g_q : (is_ks ? p.g_k + 64 : p.g_k + 128)) + 8 * fq;
            const f32x4 g00 = *(const f32x4*)(gw), g01 = *(const f32x4*)(gw + 4), g10 = *(const f32x4*)(gw + 32), g11 = *(const f32x4*)(gw + 36);
            bf16_t* dst; int hh, nh;
            if (is_q) { dst = (bf16_t*)(ws + WS_Q); hh = seg; nh = 8; } else if (is_ks) { dst = (bf16_t*)(ws + WS_KS); hh = seg - 12; nh = 2; } else { dst = (bf16_t*)(ws + WS_KW); hh = seg - 16; nh = 2; }
            bf16_t* o0 = dst + ((size_t)(b * nh + hh) * SEQ + s0) * 64 + fq * 8;
            const float qs = is_q ? QSCALE : 1.f;
#pragma unroll
            for (int ai = 0; ai < 2; ++ai)
#pragma unroll
                for (int m = 0; m < 4; ++m) {
                    const f32x4 a0 = acc[ai][0][m][0], a1 = acc[ai][0][m][1], a2 = acc[ai][1][m][0], a3 = acc[ai][1][m][1];
                    float ss = ((a0.x * a0.x + a0.y * a0.y) + (a0.z * a0.z + a0.w * a0.w)) + ((a1.x * a1.x + a1.y * a1.y) + (a1.z * a1.z + a1.w * a1.w))
                             + ((a2.x * a2.x + a2.y * a2.y) + (a2.z * a2.z + a2.w * a2.w)) + ((a3.x * a3.x + a3.y * a3.y) + (a3.z * a3.z + a3.w * a3.w));
                    ss += __shfl_xor(ss, 16); ss += __shfl_xor(ss, 32);
                    const float rr = rs[ai][m];
                    const float r = rr * rsqrtf(ss * rr * rr * (1.f / 64.f) + RMS_EPS) * qs;
                    bf16_t* o = o0 + (size_t)(128 * ai + 16 * m) * 64;
                    *(u32x4*)(o) = pk8(a0 * g00 * r, a1 * g01 * r); *(u32x4*)(o + 32) = pk8(a2 * g10 * r, a3 * g11 * r);
                }
            return;
        }
        if (seg >= 8 && seg < 12) {
            bf16_t* o0 = (bf16_t*)(ws + (seg < 10 ? WS_KC : WS_VC)) + ((size_t)(b * 2 + (seg & 1)) * SEQ + s0) * 64 + fq * 8;
#pragma unroll
            for (int ai = 0; ai < 2; ++ai)
#pragma unroll
                for (int m = 0; m < 4; ++m) { const float r = rs[ai][m]; bf16_t* o = o0 + (size_t)(128 * ai + 16 * m) * 64;
                    *(u32x4*)(o) = pk8(acc[ai][0][m][0] * r, acc[ai][0][m][1] * r); *(u32x4*)(o + 32) = pk8(acc[ai][1][m][0] * r, acc[ai][1][m][1] * r); }
            return;
        }
        if (seg == 14 || seg == 15 || seg == 18 || seg == 19) {
            bf16_t* o0 = (bf16_t*)(ws + (seg < 16 ? WS_VST : WS_VWT)) + (size_t)(b * 2 + (seg & 1)) * 64 * SEQ + s0;
#pragma unroll
            for (int ai = 0; ai < 2; ++ai)
#pragma unroll
                for (int m = 0; m < 4; ++m) { const float r = rs[ai][m]; bf16_t* o = o0 + 128 * ai + 16 * m;
#pragma unroll
                    for (int bj = 0; bj < 2; ++bj)
#pragma unroll
                        for (int n = 0; n < 2; ++n) { const int d = 32 * bj + 8 * fq + 4 * n; const f32x4 x = acc[ai][bj][m][n] * r;
                            o[(size_t)(d + 0) * SEQ] = f2bf(x.x); o[(size_t)(d + 1) * SEQ] = f2bf(x.y); o[(size_t)(d + 2) * SEQ] = f2bf(x.z); o[(size_t)(d + 3) * SEQ] = f2bf(x.w); } }
            return;
        }
        if (seg < 52) {
            const int kind = (seg - 20) >> 3, cb = ((seg - 20) & 7) * 64 + fq * 8;
            if (kind == 1) {
                const float* lb = (const float*)(ws + WS_LB) + cb;
                const f32x4 l00 = *(const f32x4*)(lb), l01 = *(const f32x4*)(lb + 4), l10 = *(const f32x4*)(lb + 32), l11 = *(const f32x4*)(lb + 36);
                bf16_t* o0 = (bf16_t*)(ws + WS_HLOGF) + (size_t)row0 * 512 + cb;
#define LOGF4(L_, X_) (f32x4){__logf(L_.x + (1.f - L_.x) * sigmoidf_(X_.x)), __logf(L_.y + (1.f - L_.y) * sigmoidf_(X_.y)), __logf(L_.z + (1.f - L_.z) * sigmoidf_(X_.z)), __logf(L_.w + (1.f - L_.w) * sigmoidf_(X_.w))}
#pragma unroll
                for (int ai = 0; ai < 2; ++ai)
#pragma unroll
                    for (int m = 0; m < 4; ++m) { const float r = rs[ai][m]; bf16_t* o = o0 + (size_t)(128 * ai + 16 * m) * 512;
                        const f32x4 x0 = acc[ai][0][m][0] * r, x1 = acc[ai][0][m][1] * r, x2 = acc[ai][1][m][0] * r, x3 = acc[ai][1][m][1] * r;
                        *(u32x4*)(o) = pk8(LOGF4(l00, x0), LOGF4(l01, x1)); *(u32x4*)(o + 32) = pk8(LOGF4(l10, x2), LOGF4(l11, x3)); }
#undef LOGF4
            } else {
                bf16_t* o0 = (bf16_t*)(ws + (kind == 0 ? WS_HQ : (kind == 2 ? WS_HV : WS_HG))) + (size_t)row0 * 512 + cb;
#define SILU4(X_) (f32x4){siluf_(X_.x), siluf_(X_.y), siluf_(X_.z), siluf_(X_.w)}
#pragma unroll
                for (int ai = 0; ai < 2; ++ai)
#pragma unroll
                    for (int m = 0; m < 4; ++m) { const float r = rs[ai][m]; bf16_t* o = o0 + (size_t)(128 * ai + 16 * m) * 512;
                        f32x4 x0 = acc[ai][0][m][0] * r, x1 = acc[ai][0][m][1] * r, x2 = acc[ai][1][m][0] * r, x3 = acc[ai][1][m][1] * r;
                        if (kind != 2) { x0 = SILU4(x0); x1 = SILU4(x1); x2 = SILU4(x2); x3 = SILU4(x3); }
                        *(u32x4*)(o) = pk8(x0, x1); *(u32x4*)(o + 32) = pk8(x2, x3); }
#undef SILU4
            }
            return;
        }
        if (fq < 3) {
            float* o0 = (float*)(ws + WS_GATES) + (size_t)row0 * 24 + 8 * fq;
#pragma unroll
            for (int ai = 0; ai < 2; ++ai)
#pragma unroll
                for (int m = 0; m < 4; ++m) { const float r = rs[ai][m]; float* o = o0 + (size_t)(128 * ai + 16 * m) * 24;
#pragma unroll
                    for (int n = 0; n < 2; ++n) { const f32x4 x = acc[ai][0][m][n] * r; *(f32x4*)(o + 4 * n) = (f32x4){sigmoidf_(x.x), sigmoidf_(x.y), sigmoidf_(x.z), sigmoidf_(x.w)}; } }
        }
    } };
DEV void phase_inproj(const Params& p, unsigned char* lds) {
    pg8::Gemm g{(const bf16_t*)(p.ws + WS_XB), (const bf16_t*)(p.ws + WS_WINT), NTOK, INP, DM};
    pg8::StaticOrder S; S.init(NTOK, INP, (int)gridDim.x, (int)blockIdx.x);
    EpiInproj8 E{p};
    pg8::gemm_phase(( PG8_LAS unsigned char*)lds, g, S, E);
}

struct ACmp { const bf16_t* src; int bg, c0;
    DEV const bf16_t* row(int r) const { int c = c0 + r; if (c > NC - 1) c = NC - 1; return src + ((size_t)bg * SEQ + 16 * c) * 64; } };
struct EpiCmpA { const Params& p; int z, rbase;
    DEV void operator()(f32x4 (&acc)[4][4], int wr, int wc, int lane) const {
        const int frow = lane & 15, fq = lane >> 4;
        const float* cb = (const float*)(p.ws + WS_CBIAS) + z * 256; bf16_t* hid = (bf16_t*)(p.ws + WS_HID) + (size_t)z * 4096 * 256;
#pragma unroll
        for (int m = 0; m < 4; ++m) { const int rr = rbase + wr * 64 + m * 16 + frow;
#pragma unroll
            for (int n = 0; n < 4; ++n) { const int c = wc * 64 + n * 16 + fq * 4; const f32x4 b = *(const f32x4*)(cb + c); f32x4 v = acc[m][n] + b;
                u32x2 w; w.x = pk2(siluf_(v.x), siluf_(v.y)); w.y = pk2(siluf_(v.z), siluf_(v.w)); *(u32x2*)(hid + (size_t)rr * 256 + c) = w; } }
    } };
DEV void phase_cmp_a(const Params& p, unsigned char* lds) {
    const int vb = vblock(), G = gridDim.x;
    for (int u = vb; u < 64; u += G) {
        const int z = u >> 5, rbase = (u & 31) * 128;
        ACmp al{(const bf16_t*)(p.ws + (z ? WS_VC : WS_KC)), (u & 31) >> 1, (u & 1) * 128};
        BRows bl{(const bf16_t*)(p.ws + WS_CW1T) + (size_t)z * 256 * 2048, 2048};
        EpiCmpA ep{p, z, rbase};
        gemm_tile(lds, al, bl, 2048 / 64, ep);
    }
}
struct BClamp64 { const bf16_t* base; size_t ld; DEV const bf16_t* ptr(int n, int kt) const { return base + (size_t)(n & 63) * ld + kt * 64; } };
struct EpiCmpB { const Params& p; int z, rbase;
    DEV void operator()(f32x4 (&acc)[4][4], int wr, int wc, int lane) const {
        if (wc != 0) return;
        const int frow = lane & 15, fq = lane >> 4;
        bf16_t* dst = (bf16_t*)(p.ws + (z ? WS_VCMP : WS_KCMP));
#pragma unroll
        for (int m = 0; m < 4; ++m) { const int rr = rbase + wr * 64 + m * 16 + frow;
            float r = 1.f;
            if (z == 0) { float ss = 0.f;
#pragma unroll
                for (int n = 0; n < 4; ++n) { const f32x4 v = acc[m][n]; ss += (v.x * v.x + v.y * v.y) + (v.z * v.z + v.w * v.w); }
                ss += __shfl_xor(ss, 16); ss += __shfl_xor(ss, 32); r = rsqrtf(ss * (1.f / 64.f) + RMS_EPS); }
            const int bg = rr >> 8, c = rr & 255;
            if (c < NC) {
#pragma unroll
                for (int n = 0; n < 4; ++n) { const int d = n * 16 + fq * 4; f32x4 v = acc[m][n] * r;
                    if (z == 0) { const f32x4 g = *(const f32x4*)(p.g_k + d); v = v * g;
                        u32x2 w; w.x = pk2(v.x, v.y); w.y = pk2(v.z, v.w); *(u32x2*)(dst + ((size_t)bg * 256 + c) * 64 + d) = w; }
                    else { bf16_t* o = dst + ((size_t)bg * 64 + d) * 256 + c; o[0] = f2bf(v.x); o[256] = f2bf(v.y); o[512] = f2bf(v.z); o[768] = f2bf(v.w); } } }
        }
    } };
DEV void phase_cmp_b(const Params& p, unsigned char* lds) {
    const int vb = vblock(), G = gridDim.x;
    for (int u = vb; u < 64; u += G) {
        const int z = u >> 5, rbase = (u & 31) * 128;
        ARows al{(const bf16_t*)(p.ws + WS_HID) + ((size_t)z * 4096 + rbase) * 256, 256};
        BClamp64 bl{(const bf16_t*)(p.ws + WS_CW2T) + (size_t)z * 64 * 256, 256};
        EpiCmpB ep{p, z, rbase};
        gemm_tile(lds, al, bl, 256 / 64, ep);
    }
}

constexpr int CM_K = 0, CM_V = 32768, CM_VSTR = 520, CM_IMP = CM_V + 64 * CM_VSTR, CM_LDS = CM_IMP + 4 * 16384 + 1024;
DEV void cm_scores(const unsigned char* kbase, int kt, const bf16x8 (&qf)[4], int r31, int hh, f32x16 (&sacc)[2]) {
#pragma unroll
    for (int kt2 = 0; kt2 < 2; ++kt2) {
#pragma unroll
        for (int i = 0; i < 16; ++i) sacc[kt2][i] = 0.f;
        const int row = 64 * kt + 32 * kt2 + r31; const int sx = (row >> 1) & 7;
#pragma unroll
        for (int s = 0; s < 4; ++s) { const bf16x8 kf = *(const bf16x8*)(kbase + row * 128 + (((2 * s + hh) ^ sx) << 4));
            sacc[kt2] = __builtin_amdgcn_mfma_f32_32x32x16_bf16(kf, qf[s], sacc[kt2], 0, 0, 0); }
    }
}
DEV void phase_cmp_attn(const Params& p, unsigned char* lds) {
    const int tid = threadIdx.x, lane = tid & 63, wid = tid >> 6;
    const int vb = vblock(), G = gridDim.x;
    unsigned char* ws = p.ws;
    const int r31 = lane & 31, hh = lane >> 5;
    float* impl = (float*)(lds + CM_IMP);
    for (int it = vb; it < 1024; it += G) {
        int ci, bg;
        if (G == 256) { const int x = vb >> 5, jb = vb & 31, rnd = it / G, i = rnd * 32 + ((rnd & 1) ? 31 - jb : jb); ci = 63 - (i >> 1); bg = 2 * x + (i & 1); }
        else { ci = 63 - (it >> 4); bg = it & 15; }
        const int b = bg >> 1, g = bg & 1;
        const int nvis = min(NC, 4 * ci + 3), ntile = (nvis + 63) >> 6;
        const int head = g * 4 + (wid >> 1);
        const int tokl = (wid & 1) * 32 + r31, t = ci * 64 + tokl;
        const size_t tok = (size_t)b * SEQ + t;
        const int nv = t >= 31 ? min(NC, (t - 31) / 16 + 1) : 0;
        const float gate_c = ((const float*)(ws + WS_GATES))[tok * 24 + head * 3 + 0];
        __syncthreads();
        {
            const bf16_t* kc = (const bf16_t*)(ws + WS_KCMP) + (size_t)bg * 256 * 64; const bf16_t* vt = (const bf16_t*)(ws + WS_VCMP) + (size_t)bg * 64 * 256;
            const int cpr = ntile * 8;
            u32x4 rk[4], rv[4];
#pragma unroll
            for (int i = 0; i < 4; ++i) if (i < ntile) { const int idx = tid + NT * i; rk[i] = *(const u32x4*)(kc + (idx >> 3) * 64 + (idx & 7) * 8); const int d = idx / cpr, ck = idx % cpr; rv[i] = *(const u32x4*)(vt + d * 256 + ck * 8); }
#pragma unroll
            for (int i = 0; i < 4; ++i) if (i < ntile) { const int idx = tid + NT * i; *(u32x4*)(lds + CM_K + swz(idx >> 3, idx & 7)) = rk[i];
                const int d = idx / cpr, ck = idx % cpr; u32x2 a, c2; a.x = rv[i].x; a.y = rv[i].y; c2.x = rv[i].z; c2.y = rv[i].w; unsigned char* o = lds + CM_V + d * CM_VSTR + ck * 16; *(u32x2*)o = a; *(u32x2*)(o + 8) = c2; }
        }
        bf16x8 qf[4];
        { const bf16_t* qp = (const bf16_t*)(ws + WS_Q) + ((size_t)(b * 8 + head) * SEQ + t) * 64 + 8 * hh;
#pragma unroll
            for (int s = 0; s < 4; ++s) qf[s] = *(const bf16x8*)(qp + 16 * s); }
        __syncthreads();
        float l_run = 0.f;
        f32x16 ot[2];
#pragma unroll
        for (int dt = 0; dt < 2; ++dt)
#pragma unroll
            for (int i = 0; i < 16; ++i) ot[dt][i] = 0.f;
        float carry = 0.f;
#pragma unroll
        for (int kt = 0; kt < 4; ++kt) if (kt < ntile) {
            f32x16 sacc[2];
            cm_scores(lds + CM_K, kt, qf, r31, hh, sacc);
#pragma unroll
            for (int kt2 = 0; kt2 < 2; ++kt2)
#pragma unroll
                for (int i = 0; i < 16; ++i) { const int c = 64 * kt + 32 * kt2 + (i & 3) + 8 * (i >> 2) + 4 * hh; const float e_ = (c < nv) ? __builtin_amdgcn_exp2f(sacc[kt2][i]) : 0.f; sacc[kt2][i] = e_; l_run += e_; }
            {
                float own[8], xs[8];
#pragma unroll
                for (int kt2 = 0; kt2 < 2; ++kt2)
#pragma unroll
                    for (int g4 = 0; g4 < 4; ++g4) { const float e3 = 0.5f * sacc[kt2][4 * g4 + 3];
                        own[4 * kt2 + g4] = (sacc[kt2][4 * g4] + sacc[kt2][4 * g4 + 1]) + (sacc[kt2][4 * g4 + 2] + e3); xs[4 * kt2 + g4] = __shfl_xor(e3, 32); }
                float* io = impl + (wid >> 1) * 4096 + tokl * 64 + 16 * kt + hh;
#pragma unroll
                for (int gi = 0; gi < 8; ++gi) io[2 * gi] = own[gi] + (hh ? xs[gi] : (gi > 0 ? xs[gi > 0 ? gi - 1 : 0] : carry));
                carry = xs[7];
            }
#pragma unroll
            for (int kt2 = 0; kt2 < 2; ++kt2)
#pragma unroll
                for (int s2 = 0; s2 < 2; ++s2) {
                    bf16x8 pf; { u32x4 w; w.x = pk2(sacc[kt2][8 * s2 + 0], sacc[kt2][8 * s2 + 1]); w.y = pk2(sacc[kt2][8 * s2 + 2], sacc[kt2][8 * s2 + 3]);
                        w.z = pk2(sacc[kt2][8 * s2 + 4], sacc[kt2][8 * s2 + 5]); w.w = pk2(sacc[kt2][8 * s2 + 6], sacc[kt2][8 * s2 + 7]); pf = __builtin_bit_cast(bf16x8, w); }
#pragma unroll
                    for (int dt = 0; dt < 2; ++dt) {
                        const unsigned char* va = lds + CM_V + (32 * dt + r31) * CM_VSTR + (64 * kt + 32 * kt2 + 16 * s2 + 4 * hh) * 2;
                        const u32x2 lo = *(const u32x2*)(va), hi = *(const u32x2*)(va + 16);
                        u32x4 w; w.x = lo.x; w.y = lo.y; w.z = hi.x; w.w = hi.y;
                        ot[dt] = __builtin_amdgcn_mfma_f32_32x32x16_bf16(__builtin_bit_cast(bf16x8, w), pf, ot[dt], 0, 0, 0);
                    }
                }
        }
        float invL; { const float L = l_run + __shfl_xor(l_run, 32); invL = L > 0.f ? 1.f / L : 0.f; }
        if (hh == 0) impl[16384 + (wid >> 1) * 64 + tokl] = invL;
        {
            const float sc = gate_c * invL;
            bf16_t* ocp = (bf16_t*)(ws + WS_OC) + tok * 512 + head * 64;
#pragma unroll
            for (int dt = 0; dt < 2; ++dt)
#pragma unroll
                for (int g4 = 0; g4 < 4; ++g4) { const int d0 = 32 * dt + 8 * g4 + 4 * hh;
                    u32x2 w; w.x = pk2(ot[dt][4 * g4 + 0] * sc, ot[dt][4 * g4 + 1] * sc); w.y = pk2(ot[dt][4 * g4 + 2] * sc, ot[dt][4 * g4 + 3] * sc); *(u32x2*)(ocp + d0) = w; }
        }
        __syncthreads();
        for (int tt = 0; tt < 8; ++tt) {
            const int tl = wid * 8 + tt, cur = ci;
            unsigned long long mask;
            if (cur < 16) mask = (2ull << cur) - 1ull;
            else {
                const bool valid = lane <= cur;
                const float imp = (impl[tl * 64 + lane] * impl[16384 + tl] + impl[4096 + tl * 64 + lane] * impl[16384 + 64 + tl]) + (impl[8192 + tl * 64 + lane] * impl[16384 + 128 + tl] + impl[12288 + tl * 64 + lane] * impl[16384 + 192 + tl]);
                const unsigned key = (lane == 0 || lane == cur) ? 0x7F800000u : __float_as_uint(imp);
                unsigned T = 0u;
                for (int bit = 30; bit >= 0; --bit) { const unsigned cand = T | (1u << bit); if (__popcll(__ballot(valid && key >= cand)) >= 16) T = cand; }
                const unsigned long long gt = __ballot(valid && key > T), eq = __ballot(valid && key == T);
                const int need = 16 - __popcll(gt);
                const int below = __popcll(eq & ((1ull << lane) - 1ull));
                mask = gt | __ballot(valid && key == T && below < need);
            }
            if (lane == 0) ((unsigned long long*)(ws + WS_SELM))[(size_t)bg * SEQ + ci * 64 + tl] = mask;
        }
    }
}

constexpr int FA_KB = 64 * 128, FA_VB = 64 * 136, FA_STAGE = FA_KB + FA_VB, FA_LDS = 2 * FA_STAGE + 1024;
template <bool SEL>
DEV void fa_branch(unsigned char* lds, const bf16_t* Kb, const bf16_t* VTb, int ci, int bg, const bf16x8 (&qf)[4], int t, unsigned long long mymask, unsigned long long need,
                   f32x16 (&ot)[2], float& m_run, float& l_run) {
    const int tid = threadIdx.x, lane = tid & 63;
    const int r31 = lane & 31, hh = lane >> 5;
    const int lrow = tid >> 3, lch = tid & 7;
    const bf16_t* kg = Kb + ((size_t)bg * SEQ + lrow) * 64 + lch * 8;
    const bf16_t* vg = VTb + ((size_t)bg * 64 + lrow) * SEQ + lch * 8;
    const int koff = lrow * 128 + ((lch ^ ((lrow >> 1) & 7)) << 4), voff = FA_KB + lrow * 136 + lch * 16;
    int jlo, jhi; unsigned long long todo;
    if (SEL) { todo = need; jlo = 0; jhi = ci; } else { jlo = ci >= 8 ? ci - 8 : 0; jhi = ci; todo = 0; }
    int j = jlo;
    if (SEL) { if (todo == 0) return; j = __builtin_ctzll(todo); todo &= todo - 1; }
    u32x4 rk = *(const u32x4*)(kg + (size_t)j * 64 * 64), rv = *(const u32x4*)(vg + (size_t)j * 64);
    __syncthreads();
    *(u32x4*)(lds + koff) = rk; { u32x2 a, b2; a.x = rv.x; a.y = rv.y; b2.x = rv.z; b2.y = rv.w; *(u32x2*)(lds + voff) = a; *(u32x2*)(lds + voff + 8) = b2; }
    __syncthreads();
    int st = 0; bool seen = false;
    for (;;) {
        int jn; bool more;
        if (SEL) { more = (todo != 0); jn = more ? __builtin_ctzll(todo) : 0; todo &= todo - 1; } else { jn = j + 1; more = (jn <= jhi); }
        if (more) { rk = *(const u32x4*)(kg + (size_t)jn * 64 * 64); rv = *(const u32x4*)(vg + (size_t)jn * 64); }
        const unsigned char* base = lds + st * FA_STAGE;
        const bool bit = SEL ? ((mymask >> j) & 1ull) != 0 : true;
        const float cinit = (SEL && !bit) ? -__builtin_inff() : -m_run;
        f32x16 sacc[2];
#pragma unroll
        for (int kt2 = 0; kt2 < 2; ++kt2) {
#pragma unroll
            for (int i = 0; i < 16; ++i) sacc[kt2][i] = cinit;
            const int row = 32 * kt2 + r31; const int sx = (row >> 1) & 7;
#pragma unroll
            for (int s = 0; s < 4; ++s) { const bf16x8 kf = *(const bf16x8*)(base + row * 128 + (((2 * s + hh) ^ sx) << 4));
                sacc[kt2] = __builtin_amdgcn_mfma_f32_32x32x16_bf16(kf, qf[s], sacc[kt2], 0, 0, 0); }
        }
        const bool boundary = SEL ? (j == ci) : (j == ci || j + 8 <= ci);
        float mx = -__builtin_inff();
        if (boundary) {
#pragma unroll
            for (int kt2 = 0; kt2 < 2; ++kt2)
#pragma unroll
                for (int i = 0; i < 16; ++i) { const int key = 64 * j + 32 * kt2 + (i & 3) + 8 * (i >> 2) + 4 * hh;
                    const bool ok = SEL ? (key <= t) : (key <= t && t - key < 512);
                    const float v = ok ? sacc[kt2][i] : -__builtin_inff(); sacc[kt2][i] = v; mx = fmaxf(mx, v); }
        } else {
#pragma unroll
            for (int kt2 = 0; kt2 < 2; ++kt2)
#pragma unroll
                for (int i = 0; i < 16; ++i) mx = fmaxf(mx, sacc[kt2][i]);
        }
        mx = fmaxf(mx, __shfl_xor(mx, 32));
        const bool live = mx > -__builtin_inff();
        const bool need = (mx > 8.f) || (!seen && live && mx < -8.f);
        if (__any(need)) {
            const float d = need ? mx : 0.f;
            const float alpha = d > 0.f ? __builtin_amdgcn_exp2f(-d) : 1.f;
            m_run += d; l_run *= alpha;
#pragma unroll
            for (int dt = 0; dt < 2; ++dt)
#pragma unroll
                for (int i = 0; i < 16; ++i) ot[dt][i] *= alpha;
#pragma unroll
            for (int kt2 = 0; kt2 < 2; ++kt2)
#pragma unroll
                for (int i = 0; i < 16; ++i) sacc[kt2][i] -= d;
        }
        seen = seen || live;
        float rs = 0.f;
#pragma unroll
        for (int kt2 = 0; kt2 < 2; ++kt2)
#pragma unroll
            for (int i = 0; i < 16; ++i) { const float e = __builtin_amdgcn_exp2f(sacc[kt2][i]); sacc[kt2][i] = e; rs += e; }
        l_run += rs;
#pragma unroll
        for (int kt2 = 0; kt2 < 2; ++kt2)
#pragma unroll
            for (int s2 = 0; s2 < 2; ++s2) {
                bf16x8 pf; { u32x4 w; w.x = pk2(sacc[kt2][8 * s2 + 0], sacc[kt2][8 * s2 + 1]); w.y = pk2(sacc[kt2][8 * s2 + 2], sacc[kt2][8 * s2 + 3]);
                    w.z = pk2(sacc[kt2][8 * s2 + 4], sacc[kt2][8 * s2 + 5]); w.w = pk2(sacc[kt2][8 * s2 + 6], sacc[kt2][8 * s2 + 7]); pf = __builtin_bit_cast(bf16x8, w); }
#pragma unroll
                for (int dt = 0; dt < 2; ++dt) {
                    const unsigned char* va = base + FA_KB + (32 * dt + r31) * 136 + (32 * kt2 + 16 * s2 + 4 * hh) * 2;
                    const u32x2 lo = *(const u32x2*)(va), hi = *(const u32x2*)(va + 16);
                    u32x4 w; w.x = lo.x; w.y = lo.y; w.z = hi.x; w.w = hi.y;
                    ot[dt] = __builtin_amdgcn_mfma_f32_32x32x16_bf16(__builtin_bit_cast(bf16x8, w), pf, ot[dt], 0, 0, 0);
                }
            }
        if (!more) break;
        { unsigned char* nb = lds + (st ^ 1) * FA_STAGE; *(u32x4*)(nb + koff) = rk; u32x2 a, b2; a.x = rv.x; a.y = rv.y; b2.x = rv.z; b2.y = rv.w; *(u32x2*)(nb + voff) = a; *(u32x2*)(nb + voff + 8) = b2; }
        __syncthreads();
        st ^= 1; j = jn;
    }
}
DEV void phase_flash(const Params& p, unsigned char* lds) {
    const int tid = threadIdx.x, lane = tid & 63, wid = tid >> 6;
    const int vb = vblock(), G = gridDim.x;
    unsigned char* ws = p.ws;
    const int r31 = lane & 31, hh = lane >> 5;
    unsigned long long* red = (unsigned long long*)(lds + 2 * FA_STAGE);
    for (int it = vb; it < 1024; it += G) {
        int ci, bg;
        if (G == 256) { const int x = vb >> 5, jb = vb & 31, rnd = it / G, i = rnd * 32 + ((rnd & 1) ? 31 - jb : jb); ci = 63 - (i >> 1); bg = 2 * x + (i & 1); }
        else { ci = 63 - (it >> 4); bg = it & 15; }
        const int b = bg >> 1, g = bg & 1;
        const int head = g * 4 + (wid >> 1);
        const int t = ci * 64 + (wid & 1) * 32 + r31;
        const size_t tok = (size_t)b * SEQ + t;
        bf16x8 qf[4];
        { const bf16_t* qp = (const bf16_t*)(ws + WS_Q) + ((size_t)(b * 8 + head) * SEQ + t) * 64 + 8 * hh;
#pragma unroll
            for (int s = 0; s < 4; ++s) qf[s] = *(const bf16x8*)(qp + 16 * s); }
        const unsigned long long mymask = ((const unsigned long long*)(ws + WS_SELM))[(size_t)bg * SEQ + t];
        const float gate_s = ((const float*)(ws + WS_GATES))[tok * 24 + head * 3 + 1], gate_w = ((const float*)(ws + WS_GATES))[tok * 24 + head * 3 + 2];
        u32x2 ocv[2][4];
#pragma unroll
        for (int dt = 0; dt < 2; ++dt)
#pragma unroll
            for (int g4 = 0; g4 < 4; ++g4) ocv[dt][g4] = *(const u32x2*)((const bf16_t*)(ws + WS_OC) + tok * 512 + head * 64 + 32 * dt + 8 * g4 + 4 * hh);
        unsigned long long orm = mymask;
#pragma unroll
        for (int o = 1; o < 32; o <<= 1) { const unsigned lo = __shfl_xor((unsigned)orm, o), hi = __shfl_xor((unsigned)(orm >> 32), o); orm |= ((unsigned long long)hi << 32) | lo; }
        __syncthreads();
        if (wid < 2 && lane == 0) red[wid] = orm;
        __syncthreads();
        const unsigned long long need = red[0] | red[1];
        f32x16 oc[2];
        {
            f32x16 ot[2]; float m_run = 0.f, l_run = 0.f;
#pragma unroll
            for (int dt = 0; dt < 2; ++dt)
#pragma unroll
                for (int i = 0; i < 16; ++i) ot[dt][i] = 0.f;
            fa_branch<true>(lds, (const bf16_t*)(ws + WS_KS), (const bf16_t*)(ws + WS_VST), ci, bg, qf, t, mymask, need, ot, m_run, l_run);
            const float lt = l_run + __shfl_xor(l_run, 32);
            const float sc = gate_s / lt;
#pragma unroll
            for (int dt = 0; dt < 2; ++dt)
#pragma unroll
                for (int i = 0; i < 16; ++i) oc[dt][i] = ot[dt][i] * sc;
        }
        {
            f32x16 ot[2]; float m_run = 0.f, l_run = 0.f;
#pragma unroll
            for (int dt = 0; dt < 2; ++dt)
#pragma unroll
                for (int i = 0; i < 16; ++i) ot[dt][i] = 0.f;
            fa_branch<false>(lds, (const bf16_t*)(ws + WS_KW), (const bf16_t*)(ws + WS_VWT), ci, bg, qf, t, 0ull, 0ull, ot, m_run, l_run);
            const float lt = l_run + __shfl_xor(l_run, 32);
            const float sc = gate_w / lt;
#pragma unroll
            for (int dt = 0; dt < 2; ++dt)
#pragma unroll
                for (int i = 0; i < 16; ++i) oc[dt][i] += ot[dt][i] * sc;
        }
        {
            bf16_t* mix = (bf16_t*)(ws + WS_R1) + tok * 1024 + head * 64;
            float ss = 0.f;
#pragma unroll
            for (int dt = 0; dt < 2; ++dt)
#pragma unroll
                for (int g4 = 0; g4 < 4; ++g4) { const int d0 = 32 * dt + 8 * g4 + 4 * hh; const u32x2 c = ocv[dt][g4];
                    const float v0 = oc[dt][4 * g4 + 0] + bflo(c.x), v1 = oc[dt][4 * g4 + 1] + bfhi(c.x), v2 = oc[dt][4 * g4 + 2] + bflo(c.y), v3 = oc[dt][4 * g4 + 3] + bfhi(c.y);
                    ss += (v0 * v0 + v1 * v1) + (v2 * v2 + v3 * v3);
                    u32x2 w; w.x = pk2(v0, v1); w.y = pk2(v2, v3); *(u32x2*)(mix + d0) = w; }
            ss += __shfl_xor(ss, 32);
            if (hh == 0) atomicAdd((float*)(ws + WS_ROWSS) + tok, ss);
        }
    }
}

DEV int swz256(int row, int chunk) { return row * 256 + ((chunk ^ (row & 15)) << 4); }
DEV void hgrn_cumsum(const Params& p, int bh, int c, float* segs, f32x2 (&lf)[8], f32x2 (&a)[8], f32x2& r, f32x2& alast) {
    const int tid = threadIdx.x, k2 = tid & 63, tq = tid >> 6;
    const int b = bh >> 2, h = bh & 3;
    const bf16_t* HL = (const bf16_t*)(p.ws + WS_HLOGF) + ((size_t)b * SEQ + c * 64 + tq * 8) * 512 + h * 128 + 2 * k2;
#pragma unroll
    for (int i = 0; i < 8; ++i) { const unsigned w = *(const unsigned*)(HL + (size_t)i * 512); lf[i] = (f32x2){bflo(w), bfhi(w)}; }
    f32x2 run = (f32x2){0.f, 0.f};
#pragma unroll
    for (int i = 0; i < 8; ++i) { run = run + lf[i]; a[i] = run; }
    *(f32x2*)(segs + tq * 128 + 2 * k2) = run;
    __syncthreads();
    f32x2 off = (f32x2){0.f, 0.f}, tot = off, rr = off;
#pragma unroll
    for (int q = 0; q < 8; ++q) { const f32x2 s = *(const f32x2*)(segs + q * 128 + 2 * k2); if (q < tq) off = off + s; if (q < 4) rr = rr + s; tot = tot + s; }
#pragma unroll
    for (int i = 0; i < 8; ++i) a[i] = a[i] + off;
    r = rr; alast = tot;
}
DEV void hgrn_stage_vt(const Params& p, int bh, int c, unsigned char* vt) {
    const int tid = threadIdx.x, k2 = tid & 63, tq = tid >> 6;
    const int b = bh >> 2, h = bh & 3;
    const bf16_t* HV = (const bf16_t*)(p.ws + WS_HV) + ((size_t)b * SEQ + c * 64 + tq * 8) * 512 + h * 128 + 2 * k2;
    unsigned vv[8];
#pragma unroll
    for (int i = 0; i < 8; ++i) vv[i] = *(const unsigned*)(HV + (size_t)i * 512);
    u32x4 lo, hi;
    lo.x = (vv[0] & 0xffffu) | (vv[1] << 16); lo.y = (vv[2] & 0xffffu) | (vv[3] << 16); lo.z = (vv[4] & 0xffffu) | (vv[5] << 16); lo.w = (vv[6] & 0xffffu) | (vv[7] << 16);
    hi.x = (vv[0] >> 16) | (vv[1] & 0xffff0000u); hi.y = (vv[2] >> 16) | (vv[3] & 0xffff0000u); hi.z = (vv[4] >> 16) | (vv[5] & 0xffff0000u); hi.w = (vv[6] >> 16) | (vv[7] & 0xffff0000u);
    *(u32x4*)(vt + swz(2 * k2, tq)) = lo; *(u32x4*)(vt + swz(2 * k2 + 1, tq)) = hi;
}
constexpr int H1_KT = 0, H1_VT = 16384, H1_SEG = 32768, H1_EK = H1_SEG + 4096;
DEV void phase_hgrn_a1(const Params& p, unsigned char* lds, int vb0, int nb) {
    const int tid = threadIdx.x, lane = tid & 63, wid = tid >> 6, k2 = tid & 63, tq = tid >> 6;
    const int vb = vblock(), G = gridDim.x;
    const int frow = lane & 15, fq = lane >> 4, wr = wid >> 1, wc = wid & 1;
    float* segs = (float*)(lds + H1_SEG); float* ek = (float*)(lds + H1_EK);
    bf16_t* ubuf = (bf16_t*)(p.ws + WS_UBUF); float* dbuf = (float*)(p.ws + WS_DBUF);
    if (vb < vb0) return;
    for (int item = vb - vb0; item < 2048; item += nb) {
        const int bh = item >> 6, c = item & 63;
        __syncthreads();
        f32x2 lf[8], a[8], r, al;
        hgrn_cumsum(p, bh, c, segs, lf, a, r, al);
        {
            float kx[8], ky[8];
#pragma unroll
            for (int i = 0; i < 8; ++i) { kx[i] = (1.f - __expf(lf[i].x)) * __expf(fminf(r.x - a[i].x, 80.f)); ky[i] = (1.f - __expf(lf[i].y)) * __expf(fminf(r.y - a[i].y, 80.f)); }
            u32x4 w0, w1;
            w0.x = pk2(kx[0], kx[1]); w0.y = pk2(kx[2], kx[3]); w0.z = pk2(kx[4], kx[5]); w0.w = pk2(kx[6], kx[7]);
            w1.x = pk2(ky[0], ky[1]); w1.y = pk2(ky[2], ky[3]); w1.z = pk2(ky[4], ky[5]); w1.w = pk2(ky[6], ky[7]);
            *(u32x4*)(lds + H1_KT + swz(2 * k2, tq)) = w0; *(u32x4*)(lds + H1_KT + swz(2 * k2 + 1, tq)) = w1;
        }
        hgrn_stage_vt(p, bh, c, lds + H1_VT);
        if (tq == 7) { ek[2 * k2] = __expf(al.x - r.x); ek[2 * k2 + 1] = __expf(al.y - r.y); f32x2 d; d.x = __expf(al.x); d.y = __expf(al.y); *(f32x2*)(dbuf + (size_t)item * 128 + 2 * k2) = d; }
        __syncthreads();
        f32x4 acc[2][4];
#pragma unroll
        for (int m = 0; m < 2; ++m)
#pragma unroll
            for (int n = 0; n < 4; ++n) acc[m][n] = (f32x4){0.f, 0.f, 0.f, 0.f};
        const int sx = (frow >> 1) & 7;
#pragma unroll
        for (int ks = 0; ks < 2; ++ks) {
            const int co = ((ks * 4 + fq) ^ sx) << 4;
            bf16x8 af[2], bfr[4];
#pragma unroll
            for (int m = 0; m < 2; ++m) af[m] = *(const bf16x8*)(lds + H1_VT + (32 * wr + 16 * m + frow) * 128 + co);
#pragma unroll
            for (int n = 0; n < 4; ++n) bfr[n] = *(const bf16x8*)(lds + H1_KT + (64 * wc + 16 * n + frow) * 128 + co);
#pragma unroll
            for (int m = 0; m < 2; ++m)
#pragma unroll
                for (int n = 0; n < 4; ++n) acc[m][n] = __builtin_amdgcn_mfma_f32_16x16x32_bf16(bfr[n], af[m], acc[m][n], 0, 0, 0);
        }
#pragma unroll
        for (int m = 0; m < 2; ++m) { const int v = 32 * wr + 16 * m + frow;
#pragma unroll
            for (int n = 0; n < 4; ++n) { const int k0 = 64 * wc + 16 * n + 4 * fq; const f32x4 e = *(const f32x4*)(ek + k0); const f32x4 o = acc[m][n] * e;
                u32x2 w; w.x = pk2(o.x, o.y); w.y = pk2(o.z, o.w); *(u32x2*)(ubuf + ((size_t)item * 128 + v) * 128 + k0) = w; } }
    }
}
DEV void phase_hgrn_a2(const Params& p, unsigned char* lds) {
    const int G = gridDim.x;
    bf16_t* ubuf = (bf16_t*)(p.ws + WS_UBUF); const float* dbuf = (const float*)(p.ws + WS_DBUF);
    for (int gid = blockIdx.x * NT + threadIdx.x; gid < 131072; gid += G * NT) {
        const int bh = gid >> 12, v = (gid >> 5) & 127, k4 = gid & 31;
        bf16_t* u = ubuf + ((size_t)bh * 64 * 128 + v) * 128 + 4 * k4;
        const float* d = dbuf + (size_t)bh * 64 * 128 + 4 * k4;
        f32x4 S = (f32x4){0.f, 0.f, 0.f, 0.f};
        for (int c0 = 0; c0 < 64; c0 += 8) {
            u32x2 uu[8]; f32x4 dd[8];
#pragma unroll
            for (int j = 0; j < 8; ++j) { uu[j] = *(const u32x2*)(u + (size_t)(c0 + j) * 16384); dd[j] = *(const f32x4*)(d + (size_t)(c0 + j) * 128); }
#pragma unroll
            for (int j = 0; j < 8; ++j) { u32x2 w; w.x = pk2(S.x, S.y); w.y = pk2(S.z, S.w); *(u32x2*)(u + (size_t)(c0 + j) * 16384) = w;
                S.x = dd[j].x * S.x + bflo(uu[j].x); S.y = dd[j].y * S.y + bfhi(uu[j].x); S.z = dd[j].z * S.z + bflo(uu[j].y); S.w = dd[j].w * S.w + bfhi(uu[j].y); }
        }
    }
}
constexpr int H3_QH = 0, H3_QA = 16384, H3_KH = 32768, H3_VT = 49152, H3_PP = 65536, H3_ST = 73728, H3_SEG = 106496, H3_RED = 110592;
DEV void phase_hgrn_a3(const Params& p, unsigned char* lds) {
    const int tid = threadIdx.x, lane = tid & 63, wid = tid >> 6, k2 = tid & 63, tq = tid >> 6;
    const int vb = vblock(), G = gridDim.x;
    const int frow = lane & 15, fq = lane >> 4;
    float* segs = (float*)(lds + H3_SEG); float* red = (float*)(lds + H3_RED);
    const bf16_t* ubuf = (const bf16_t*)(p.ws + WS_UBUF);
    for (int item = vb; item < 2048; item += G) {
        const int bh = item >> 6, c = item & 63, b = bh >> 2, h = bh & 3;
        __syncthreads();
        f32x2 lf[8], a[8], r, al;
        hgrn_cumsum(p, bh, c, segs, lf, a, r, al);
        {
            const bf16_t* HQ = (const bf16_t*)(p.ws + WS_HQ) + ((size_t)b * SEQ + c * 64 + tq * 8) * 512 + h * 128 + 2 * k2;
            unsigned qq[8];
#pragma unroll
            for (int i = 0; i < 8; ++i) qq[i] = *(const unsigned*)(HQ + (size_t)i * 512);
#pragma unroll
            for (int i = 0; i < 8; ++i) { const int t = 8 * tq + i; const float q0 = bflo(qq[i]), q1 = bfhi(qq[i]);
                const int off = swz256(t, k2 >> 2) + (k2 & 3) * 4;
                *(unsigned*)(lds + H3_QH + off) = pk2(q0 * __expf(fminf(a[i].x - r.x, 80.f)), q1 * __expf(fminf(a[i].y - r.y, 80.f)));
                *(unsigned*)(lds + H3_QA + off) = pk2(q0 * __expf(a[i].x), q1 * __expf(a[i].y));
                *(unsigned*)(lds + H3_KH + off) = pk2((1.f - __expf(lf[i].x)) * __expf(fminf(r.x - a[i].x, 80.f)), (1.f - __expf(lf[i].y)) * __expf(fminf(r.y - a[i].y, 80.f))); }
        }
        hgrn_stage_vt(p, bh, c, lds + H3_VT);
        {
            const bf16_t* st = ubuf + (size_t)item * 16384;
#pragma unroll
            for (int i = 0; i < 4; ++i) { const int q = tid + NT * i, v = q >> 4, ch = q & 15; *(u32x4*)(lds + H3_ST + swz256(v, ch)) = *(const u32x4*)(st + v * 128 + ch * 8); }
        }
        __syncthreads();
        {
            const int wr = wid >> 1, wc = wid & 1;
            f32x4 acc[2];
            acc[0] = (f32x4){0.f, 0.f, 0.f, 0.f}; acc[1] = acc[0];
            if (32 * wc <= 16 * wr + 15) {
#pragma unroll
                for (int ks = 0; ks < 4; ++ks) {
                    const int co = ((ks * 4 + fq) ^ frow) << 4;
                    const bf16x8 af = *(const bf16x8*)(lds + H3_QH + (16 * wr + frow) * 256 + co);
#pragma unroll
                    for (int n = 0; n < 2; ++n) { const bf16x8 bfr = *(const bf16x8*)(lds + H3_KH + (32 * wc + 16 * n + frow) * 256 + co);
                        acc[n] = __builtin_amdgcn_mfma_f32_16x16x32_bf16(bfr, af, acc[n], 0, 0, 0); }
                }
            }
            const int t = 16 * wr + frow;
#pragma unroll
            for (int n = 0; n < 2; ++n) { const int s0 = 32 * wc + 16 * n + 4 * fq; f32x4 v = acc[n];
                v.x = (s0 + 0 <= t) ? v.x : 0.f; v.y = (s0 + 1 <= t) ? v.y : 0.f; v.z = (s0 + 2 <= t) ? v.z : 0.f; v.w = (s0 + 3 <= t) ? v.w : 0.f;
                u32x2 w; w.x = pk2(v.x, v.y); w.y = pk2(v.z, v.w);
                *(u32x2*)(lds + H3_PP + t * 128 + ((((s0 >> 3)) ^ ((t >> 1) & 7)) << 4) + (s0 & 7) * 2) = w; }
        }
        __syncthreads();
        {
            const int wr = wid >> 2, wc = wid & 3;
            f32x4 acc[2][2];
#pragma unroll
            for (int m = 0; m < 2; ++m)
#pragma unroll
                for (int n = 0; n < 2; ++n) acc[m][n] = (f32x4){0.f, 0.f, 0.f, 0.f};
            const int sx = (frow >> 1) & 7;
#pragma unroll
            for (int ks = 0; ks < 2; ++ks) {
                const int co = ((ks * 4 + fq) ^ sx) << 4;
                bf16x8 af[2], bfr[2];
#pragma unroll
                for (int m = 0; m < 2; ++m) af[m] = *(const bf16x8*)(lds + H3_PP + (32 * wr + 16 * m + frow) * 128 + co);
#pragma unroll
                for (int n = 0; n < 2; ++n) bfr[n] = *(const bf16x8*)(lds + H3_VT + (32 * wc + 16 * n + frow) * 128 + co);
#pragma unroll
                for (int m = 0; m < 2; ++m)
#pragma unroll
                    for (int n = 0; n < 2; ++n) acc[m][n] = __builtin_amdgcn_mfma_f32_16x16x32_bf16(bfr[n], af[m], acc[m][n], 0, 0, 0);
            }
#pragma unroll
            for (int ks = 0; ks < 4; ++ks) {
                const int co = ((ks * 4 + fq) ^ frow) << 4;
                bf16x8 af[2], bfr[2];
#pragma unroll
                for (int m = 0; m < 2; ++m) af[m] = *(const bf16x8*)(lds + H3_QA + (32 * wr + 16 * m + frow) * 256 + co);
#pragma unroll
                for (int n = 0; n < 2; ++n) bfr[n] = *(const bf16x8*)(lds + H3_ST + (32 * wc + 16 * n + frow) * 256 + co);
#pragma unroll
                for (int m = 0; m < 2; ++m)
#pragma unroll
                    for (int n = 0; n < 2; ++n) acc[m][n] = __builtin_amdgcn_mfma_f32_16x16x32_bf16(bfr[n], af[m], acc[m][n], 0, 0, 0);
            }
            f32x4 gnv[2]; u32x2 ggv[2][2];
#pragma unroll
            for (int n = 0; n < 2; ++n) gnv[n] = *(const f32x4*)(p.g_hn + 32 * wc + 16 * n + 4 * fq);
#pragma unroll
            for (int m = 0; m < 2; ++m)
#pragma unroll
                for (int n = 0; n < 2; ++n) ggv[m][n] = *(const u32x2*)((const bf16_t*)(p.ws + WS_HG) + ((size_t)b * SEQ + c * 64 + 32 * wr + 16 * m + frow) * 512 + h * 128 + 32 * wc + 16 * n + 4 * fq);
#pragma unroll
            for (int m = 0; m < 2; ++m) { float ss = 0.f;
#pragma unroll
                for (int n = 0; n < 2; ++n) { const f32x4 v = acc[m][n]; ss += (v.x * v.x + v.y * v.y) + (v.z * v.z + v.w * v.w); }
                ss += __shfl_xor(ss, 16); ss += __shfl_xor(ss, 32);
                if (fq == 0) red[(32 * wr + 16 * m + frow) * 4 + wc] = ss; }
            __syncthreads();
#pragma unroll
            for (int m = 0; m < 2; ++m) { const int t = 32 * wr + 16 * m + frow; const f32x4 q4 = *(const f32x4*)(red + t * 4);
                const float rs = rsqrtf(((q4.x + q4.y) + (q4.z + q4.w)) * (1.f / 128.f) + RMS_EPS);
                const size_t row = (size_t)b * SEQ + c * 64 + t;
#pragma unroll
                for (int n = 0; n < 2; ++n) { const int v0 = 32 * wc + 16 * n + 4 * fq; const f32x4 gn = gnv[n]; const u32x2 gg = ggv[m][n];
                    const f32x4 o = acc[m][n];
                    u32x2 w; w.x = pk2(o.x * rs * gn.x * bflo(gg.x), o.y * rs * gn.y * bfhi(gg.x)); w.y = pk2(o.z * rs * gn.z * bflo(gg.y), o.w * rs * gn.w * bfhi(gg.y));
                    *(u32x2*)((bf16_t*)(p.ws + WS_R1) + row * 1024 + 512 + h * 128 + v0) = w; } }
        }
    }
}

DEV void phase_normalize(const Params& p, unsigned char* lds) {
    const int vb = vblock(), G = gridDim.x;
    unsigned char* ws = p.ws;
    __syncthreads();
    {
        float* tl = (float*)lds;
        for (int r = vb; r < 32 * 4 * 16; r += G) { const int e = r / 64, q = r % 64; SrcW13_4 s{p.w1 + (size_t)e * 1024 * 512, p.w3 + (size_t)e * 1024 * 512, p.ffn_g};
            convert_tile256(tl, s, (bf16_t*)(ws + WS_W13T) + (size_t)e * 1024 * 1024, 1024, (q / 16) * 256, (q % 16) * 64); }
    }
}

struct EpiOut8 { const Params& p; static constexpr bool MIDSCALE = true;
    DEV float rowscale(int row) const { return rsqrtf(((const float*)(p.ws + WS_ROWSS))[row] * (1.f / 512.f) + RMS_EPS); }
    DEV int midk() const { return 8; }
    DEV void operator()(const f32x4 (&acc)[2][2][4][2], const pg8::Unit& u, int wr, int wc, int fr, int fq) const {
        const size_t off0 = ((size_t)u.pm * 256 + wr * 64 + fr) * DM + u.pn * 256 + 64 * wc + 8 * fq;
        const bf16_t* xb = (const bf16_t*)(p.ws + WS_XB);
        u32x4 xr[2][4][2];
#pragma unroll
        for (int ai = 0; ai < 2; ++ai)
#pragma unroll
            for (int m = 0; m < 4; ++m)
#pragma unroll
                for (int bj = 0; bj < 2; ++bj) xr[ai][m][bj] = *(const u32x4*)(xb + off0 + (size_t)(128 * ai + 16 * m) * DM + 32 * bj);
#pragma unroll
        for (int ai = 0; ai < 2; ++ai)
#pragma unroll
            for (int m = 0; m < 4; ++m)
#pragma unroll
                for (int bj = 0; bj < 2; ++bj) { const u32x4 w = xr[ai][m][bj]; float* o = p.out + off0 + (size_t)(128 * ai + 16 * m) * DM + 32 * bj;
                    *(f32x4*)(o) = (f32x4){bflo(w.x), bfhi(w.x), bflo(w.y), bfhi(w.y)} + acc[ai][bj][m][0]; *(f32x4*)(o + 4) = (f32x4){bflo(w.z), bfhi(w.z), bflo(w.w), bfhi(w.w)} + acc[ai][bj][m][1]; }
    } };
DEV void phase_outproj(const Params& p, unsigned char* lds) {
    pg8::Gemm g{(const bf16_t*)(p.ws + WS_R1), (const bf16_t*)(p.ws + WS_WOUTT), NTOK, DM, DM};
    pg8::StaticOrder S; S.init(NTOK, DM, (int)gridDim.x, (int)blockIdx.x);
    EpiOut8 E{p};
    pg8::gemm_phase((PG8_LAS unsigned char*)lds, g, S, E);
}

constexpr int RT_W = 0, RT_LG = 2 * 49152, RT_RS = RT_LG + 128 * 49 * 4, RT_HIST = RT_RS + 512, RT_BASE = RT_HIST + 1024, RT_LDS = RT_BASE + 1024;
DEV void phase_router(const Params& p, unsigned char* lds) {
    const int tid = threadIdx.x, lane = tid & 63, wid = tid >> 6, frow = lane & 15, fq = lane >> 4;
    const int vb = vblock(), G = gridDim.x;
    unsigned char* ws = p.ws;
    float* lg = (float*)(lds + RT_LG); float* rsd = (float*)(lds + RT_RS);
    int* hist = (int*)(lds + RT_HIST); int* basep = (int*)(lds + RT_BASE);
    const bf16_t* rw = (const bf16_t*)(ws + WS_RW);
    for (int it = vb; it < NTOK / 128; it += G) {
        const size_t row0 = (size_t)it * 128;
        const size_t trow = row0 + 16 * wid + frow;
        const float* hrow = p.out + trow * DM + 8 * fq;
        bf16_t* hbrow = (bf16_t*)(ws + WS_R1) + trow * DM + 8 * fq;
        f32x4 acc[3]; float ss = 0.f;
#pragma unroll
        for (int nt = 0; nt < 3; ++nt) acc[nt] = (f32x4){0.f, 0.f, 0.f, 0.f};
        if (tid < 128) hist[tid] = 0;
        u32x4 wreg[6]; f32x4 xa[4][2], xn[4][2];
#define RT_LOADW(kc_) do { _Pragma("unroll") for (int i = 0; i < 6; ++i) { const int idx = tid + NT * i, r = idx >> 5, c = idx & 31; wreg[i] = *(const u32x4*)(rw + (size_t)r * 1024 + (kc_) * 256 + c * 8); } } while (0)
#define RT_STOREW(buf_) do { _Pragma("unroll") for (int i = 0; i < 6; ++i) { const int idx = tid + NT * i, r = idx >> 5, c = idx & 31; *(u32x4*)(lds + RT_W + (buf_) * 49152 + r * 512 + ((c ^ (r & 15)) << 4)) = wreg[i]; } } while (0)
#define RT_LOADX(dst_, hc_) do { _Pragma("unroll") for (int ks = 0; ks < 4; ++ks) { dst_[ks][0] = *(const f32x4*)(hrow + (hc_) * 128 + 32 * ks); dst_[ks][1] = *(const f32x4*)(hrow + (hc_) * 128 + 32 * ks + 4); } } while (0)
        __syncthreads();
        RT_LOADW(0); RT_LOADX(xa, 0); RT_STOREW(0);
        __syncthreads();
#pragma unroll 1
        for (int hc = 0; hc < 8; ++hc) {
            if (hc < 7) RT_LOADX(xn, hc + 1);
            const unsigned char* wb = lds + RT_W + ((hc >> 1) & 1) * 49152;
#pragma unroll
            for (int ks = 0; ks < 4; ++ks) {
                const f32x4 a = xa[ks][0], b = xa[ks][1];
                ss += ((a.x * a.x + a.y * a.y) + (a.z * a.z + a.w * a.w)) + ((b.x * b.x + b.y * b.y) + (b.z * b.z + b.w * b.w));
                u32x4 hi; hi.x = pk2(a.x, a.y); hi.y = pk2(a.z, a.w); hi.z = pk2(b.x, b.y); hi.w = pk2(b.z, b.w);
                u32x4 lo; lo.x = pk2(a.x - bflo(hi.x), a.y - bfhi(hi.x)); lo.y = pk2(a.z - bflo(hi.y), a.w - bfhi(hi.y)); lo.z = pk2(b.x - bflo(hi.z), b.y - bfhi(hi.z)); lo.w = pk2(b.z - bflo(hi.w), b.w - bfhi(hi.w));
                *(u32x4*)(hbrow + hc * 128 + 32 * ks) = hi;
                const bf16x8 hh = __builtin_bit_cast(bf16x8, hi), hl = __builtin_bit_cast(bf16x8, lo);
                const int co = ((4 * (4 * (hc & 1) + ks) + fq) ^ frow) << 4;
#pragma unroll
                for (int nt = 0; nt < 3; ++nt) {
                    const bf16x8 whi = *(const bf16x8*)(wb + (16 * nt + frow) * 512 + co), wlo = *(const bf16x8*)(wb + (48 + 16 * nt + frow) * 512 + co);
                    acc[nt] = __builtin_amdgcn_mfma_f32_16x16x32_bf16(whi, hh, acc[nt], 0, 0, 0);
                    acc[nt] = __builtin_amdgcn_mfma_f32_16x16x32_bf16(wlo, hh, acc[nt], 0, 0, 0);
                    acc[nt] = __builtin_amdgcn_mfma_f32_16x16x32_bf16(whi, hl, acc[nt], 0, 0, 0);
                }
            }
            if ((hc & 1) == 0 && hc < 6) { RT_LOADW((hc >> 1) + 1); }
            if ((hc & 1) == 1 && hc < 7) { RT_STOREW(((hc >> 1) + 1) & 1); }
#pragma unroll
            for (int ks = 0; ks < 4; ++ks) { xa[ks][0] = xn[ks][0]; xa[ks][1] = xn[ks][1]; }
            if (hc & 1) __syncthreads();
        }
#undef RT_LOADW
#undef RT_STOREW
#undef RT_LOADX
        ss += __shfl_xor(ss, 16); ss += __shfl_xor(ss, 32);
        if (fq == 0) rsd[16 * wid + frow] = rsqrtf(ss * (1.f / DM) + RMS_EPS);
#pragma unroll
        for (int nt = 0; nt < 3; ++nt) { float* o = lg + (16 * wid + frow) * 49 + 16 * nt + 4 * fq; o[0] = acc[nt].x; o[1] = acc[nt].y; o[2] = acc[nt].z; o[3] = acc[nt].w; }
        __syncthreads();
        int bin = 0, slot = 0, ea = 0, eb = 0, sa = 0, sb = 0; float wa = 0.f, wb = 0.f;
        int* ehist = hist + 112; int* ebase = basep + 112;
        if (tid < 32) ehist[tid] = 0;
        __syncthreads();
        if (tid < 128) {
            const float rs = rsd[tid];
            ((float*)(ws + WS_RSTD2))[row0 + tid] = rs;
            float gl[4]; int gi = 0; float gm = -1e30f;
#pragma unroll
            for (int c = 0; c < 4; ++c) { gl[c] = lg[tid * 49 + c] * rs + p.b_group[c]; if (gl[c] > gm) { gm = gl[c]; gi = c; } }
            float gs = 0.f;
#pragma unroll
            for (int c = 0; c < 4; ++c) gs += __expf(gl[c] - gm);
            const float pg = 1.f / gs;
            float el[8]; int i0 = 0; float m0 = -1e30f;
#pragma unroll
            for (int c = 0; c < 8; ++c) { el[c] = lg[tid * 49 + 4 + gi * 8 + c] * rs + p.b_expert[gi * 8 + c]; if (el[c] > m0) { m0 = el[c]; i0 = c; } }
            int i1 = 0; float m1 = -1e30f;
#pragma unroll
            for (int c = 0; c < 8; ++c) if (c != i0 && el[c] > m1) { m1 = el[c]; i1 = c; }
            const float e1 = __expf(m1 - m0); const float w0 = pg / (1.f + e1), w1 = pg * e1 / (1.f + e1);
            const int a = min(i0, i1), bb = max(i0, i1);
            bin = gi * 28 + (7 * a - (a * (a - 1)) / 2) + (bb - a - 1);
            wa = (i0 < i1) ? w0 : w1; wb = (i0 < i1) ? w1 : w0; ea = gi * 8 + a; eb = gi * 8 + bb;
            slot = atomicAdd(&hist[bin], 1);
            sa = atomicAdd(&ehist[ea], 1); sb = atomicAdd(&ehist[eb], 1);
        }
        __syncthreads();
        if (tid < NBIN) { const int h = hist[tid]; basep[tid] = h ? atomicAdd((int*)(ws + WS_CTL) + tid, h) : 0; }
        else if (tid >= 128 && tid < 160) { const int e = tid - 128; const int h = ehist[e]; ebase[e] = h ? atomicAdd((int*)(ws + WS_CTL + 512) + e, h) : 0; }
        __syncthreads();
        if (tid < 128) {
            const int t = (int)(row0 + tid);
            ((int*)(ws + WS_BINL))[(size_t)bin * BINCAP + basep[bin] + slot] = t;
            sa += ebase[ea]; sb += ebase[eb];
            ((int*)(ws + WS_EL))[(size_t)ea * BINCAP + sa] = t; ((float*)(ws + WS_EW))[(size_t)ea * BINCAP + sa] = wa;
            ((int*)(ws + WS_EL))[(size_t)eb * BINCAP + sb] = t; ((float*)(ws + WS_EW))[(size_t)eb * BINCAP + sb] = wb;
            { const unsigned dpos = (unsigned)bin | ((unsigned)(basep[bin] + slot) << 7); ((unsigned*)(ws + WS_EDST))[(size_t)ea * BINCAP + sa] = dpos; ((unsigned*)(ws + WS_EDST))[(size_t)eb * BINCAP + sb] = dpos | (1u << 22); }
        }
        __syncthreads();
    }
}

constexpr int MOE_TS = pg8::STAGE_BYTES, MOE_TT = MOE_TS + 512, MOE_ES = MOE_TT + 1024, MOE_ET = MOE_ES + 256;
DEV void moe_tiles(const Params& p, unsigned char* lds) {
    int* tstart = (int*)(lds + MOE_TS); int* tiletab = (int*)(lds + MOE_TT); int* etstart = (int*)(lds + MOE_ES); int* etiletab = (int*)(lds + MOE_ET);
    const int tid = threadIdx.x, lane = tid & 63, wid = tid >> 6;
    __syncthreads();
    if (wid < 2) {
        const int i = wid * 64 + lane; const int t = i < NBIN ? (((const int*)(p.ws + WS_CTL))[i] + 255) >> 8 : 0;
        int s = t;
#pragma unroll
        for (int o = 1; o < 64; o <<= 1) { const int v = __shfl_up(s, o); if (lane >= o) s += v; }
        if (wid == 0 && lane == 63) tstart[128] = s;
        if (i < NBIN) tstart[i] = s - t;
        if (i == NBIN - 1) tstart[129] = s;
    } else if (wid == 2) {
        const int t = lane < 32 ? (((const int*)(p.ws + WS_CTL + 512))[lane] + 255) >> 8 : 0;
        int s = t;
#pragma unroll
        for (int o = 1; o < 32; o <<= 1) { const int v = __shfl_up(s, o); if (lane >= o) s += v; }
        if (lane < 32) etstart[lane] = s - t;
        if (lane == 31) etstart[32] = s;
    }
    __syncthreads();
    if (tid >= 64 && tid < NBIN) tstart[tid] += tstart[128];
    if (tid == 0) tstart[NBIN] = tstart[128] + tstart[129];
    __syncthreads();
    if (tid < NBIN) for (int t = tstart[tid]; t < tstart[tid + 1]; ++t) tiletab[t] = tid;
    if (tid >= 128 && tid < 160) for (int t = etstart[tid - 128]; t < etstart[tid - 127]; ++t) etiletab[t] = tid - 128;
    __syncthreads();
}
DEV void bin_experts(int bin, int& ea, int& eb) { const int gi = bin / 28; int pi = bin % 28, a = 0; while (pi >= 7 - a) { pi -= 7 - a; ++a; } ea = gi * 8 + a; eb = gi * 8 + a + 1 + pi; }
DEV void lane_rc(int i, int& R, int& C) { pg8::stage_rc((int)threadIdx.x * 16, R, C); R += 64 * i; }
struct MoeUnit { int tile, nt, bin, mt, n; };
struct PolMoe1 {
    typedef MoeUnit Unit;
    const Params& p; const int* etstart; const int* etiletab; int U, G, c;
    struct AddrA { unsigned off[2][2]; };
    struct AddrB { const char* base; };
    DEV int nk() const { return 16; }
    DEV bool next(int i, MoeUnit& u) const {
        const int L = i * G + c; if (L >= U) return false;
        u.tile = L >> 2; u.nt = L & 3;
        u.bin = __builtin_amdgcn_readfirstlane(etiletab[u.tile]);
        u.mt = u.tile - __builtin_amdgcn_readfirstlane(etstart[u.bin]);
        u.n = min(256, ((const int*)(p.ws + WS_CTL + 512))[u.bin] - u.mt * 256);
        return true;
    }
    DEV bool full(const MoeUnit& u) const { return u.n > 128; }
    DEV void addrA(const MoeUnit& u, AddrA& a) const {
        const int* list = (const int*)(p.ws + WS_EL) + (size_t)u.bin * BINCAP + u.mt * 256;
#pragma unroll
        for (int i = 0; i < 2; ++i) { int R, C; lane_rc(i, R, C);
#pragma unroll
            for (int h = 0; h < 2; ++h) { int r = h * 128 + R; if (r >= u.n) r = 0; a.off[h][i] = (unsigned)list[r] * 2048u + (unsigned)C * 2u; } }
    }
    DEV void addrB(const MoeUnit& u, AddrB& b) const { b.base = (const char*)(p.ws + WS_W13T) + ((size_t)u.bin * 1024 + u.nt * 256) * 2048; }
    DEV const char* pa(const AddrA& a, int h, int i, int kt) const { return (const char*)(p.ws + WS_R1) + a.off[h][i] + kt * 128; }
    DEV const char* pb(const AddrB& b, int h, int i, int kt) const { int R, C; lane_rc(i, R, C); return b.base + (size_t)h * (128 * 2048) + (unsigned)(R * 1024 + C) * 2u + kt * 128; }
};
struct EpiMoe1 { const Params& p; const int* tstart;
    DEV void operator()(const f32x4 (&acc)[2][2][4][2], const MoeUnit& u, int wr, int wc, int fr, int fq) const {
        const int* list = (const int*)(p.ws + WS_EL) + (size_t)u.bin * BINCAP + u.mt * 256;
        const float* wl = (const float*)(p.ws + WS_EW) + (size_t)u.bin * BINCAP + u.mt * 256;
        const unsigned* dl = (const unsigned*)(p.ws + WS_EDST) + (size_t)u.bin * BINCAP + u.mt * 256;
        const int r0 = wr * 64 + fr;
        int tk[2][4]; float ww[2][4]; unsigned dd[2][4];
#pragma unroll
        for (int ai = 0; ai < 2; ++ai)
#pragma unroll
            for (int m = 0; m < 4; ++m) { int r = r0 + ai * 128 + m * 16; if (r >= u.n) r = 0; tk[ai][m] = list[r]; ww[ai][m] = wl[r]; dd[ai][m] = dl[r]; }
        float rsv[2][4];
#pragma unroll
        for (int ai = 0; ai < 2; ++ai)
#pragma unroll
            for (int m = 0; m < 4; ++m) rsv[ai][m] = ((const float*)(p.ws + WS_RSTD2))[tk[ai][m]];
        const int f = (u.nt * 256 + 32 * wc + 8 * fq) >> 1;
#pragma unroll
        for (int ai = 0; ai < 2; ++ai)
#pragma unroll
            for (int m = 0; m < 4; ++m) { if (r0 + ai * 128 + m * 16 >= u.n) continue;
                const float rs = rsv[ai][m], w = ww[ai][m]; const unsigned d = dd[ai][m];
                bf16_t* hrow = (bf16_t*)(p.ws + WS_HBUF) + ((size_t)tstart[d & 127u] * 256 + ((d >> 7) & 32767u)) * 1024 + ((d >> 22) & 1u) * 512 + f;
#pragma unroll
                for (int bj = 0; bj < 2; ++bj) { const f32x4 v0 = acc[ai][bj][m][0] * rs, v1 = acc[ai][bj][m][1] * rs;
                    u32x2 w2; w2.x = pk2(siluf_(v0.x) * v0.y * w, siluf_(v0.z) * v0.w * w); w2.y = pk2(siluf_(v1.x) * v1.y * w, siluf_(v1.z) * v1.w * w); *(u32x2*)(hrow + 64 * bj) = w2; } }
    } };
DEV void phase_moe1(const Params& p, unsigned char* lds) {
    moe_tiles(p, lds);
    const int* etstart = (const int*)(lds + MOE_ES);
    PolMoe1 P{p, etstart, (const int*)(lds + MOE_ET), etstart[32] * 4, (int)gridDim.x, vblock()};
    EpiMoe1 E{p, (const int*)(lds + MOE_TS)};
    pg8::gemm_phase2(( PG8_LAS unsigned char*)lds, P, E);
}
struct PolMoe2 {
    typedef MoeUnit Unit;
    const Params& p; const int* tstart; const int* tiletab; int U, G, c;
    struct AddrA { const char* base; };
    struct AddrB { const char* ba; const char* bb; };
    DEV int nk() const { return 16; }
    DEV bool next(int i, MoeUnit& u) const {
        const int L = i * G + c; if (L >= U) return false;
        u.tile = L >> 2; u.nt = L & 3;
        u.bin = __builtin_amdgcn_readfirstlane(tiletab[u.tile]);
        u.mt = u.tile - __builtin_amdgcn_readfirstlane(tstart[u.bin]);
        u.n = min(256, ((const int*)(p.ws + WS_CTL))[u.bin] - u.mt * 256);
        return true;
    }
    DEV bool full(const MoeUnit& u) const { return u.n > 128; }
    DEV void addrA(const MoeUnit& u, AddrA& a) const { a.base = (const char*)(p.ws + WS_HBUF) + (size_t)u.tile * 256 * 2048; }
    DEV void addrB(const MoeUnit& u, AddrB& b) const {
        int ea, eb; bin_experts(u.bin, ea, eb);
        b.ba = (const char*)(p.ws + WS_W2T) + ((size_t)ea * 1024 + u.nt * 256) * 1024; b.bb = (const char*)(p.ws + WS_W2T) + ((size_t)eb * 1024 + u.nt * 256) * 1024;
    }
    DEV const char* pa(const AddrA& a, int h, int i, int kt) const { int R, C; lane_rc(i, R, C); return a.base + (size_t)h * (128 * 2048) + (unsigned)(R * 1024 + C) * 2u + kt * 128; }
    DEV const char* pb(const AddrB& b, int h, int i, int kt) const { int R, C; lane_rc(i, R, C); return (kt < 8 ? b.ba + kt * 128 : b.bb + (kt - 8) * 128) + (size_t)h * (128 * 1024) + (unsigned)(R * 512 + C) * 2u; }
};
struct EpiMoe2 { const Params& p;
    DEV void operator()(const f32x4 (&acc)[2][2][4][2], const MoeUnit& u, int wr, int wc, int fr, int fq) const {
        const int* list = (const int*)(p.ws + WS_BINL) + (size_t)u.bin * BINCAP + u.mt * 256;
        const int r0 = wr * 64 + fr;
        int tk[2][4];
#pragma unroll
        for (int ai = 0; ai < 2; ++ai)
#pragma unroll
            for (int m = 0; m < 4; ++m) { int r = r0 + ai * 128 + m * 16; if (r >= u.n) r = 0; tk[ai][m] = list[r]; }
        const int c0 = u.nt * 256 + 32 * wc + 4 * fq;
#pragma unroll
        for (int ai = 0; ai < 2; ++ai)
#pragma unroll
            for (int m = 0; m < 4; ++m) { if (r0 + ai * 128 + m * 16 >= u.n) continue;
                float* o = p.out + (size_t)tk[ai][m] * DM + c0;
                const f32x4 h0 = *(const f32x4*)(o), h1 = *(const f32x4*)(o + 16), h2 = *(const f32x4*)(o + 128), h3 = *(const f32x4*)(o + 144);
                *(f32x4*)(o) = h0 + acc[ai][0][m][0]; *(f32x4*)(o + 16) = h1 + acc[ai][0][m][1]; *(f32x4*)(o + 128) = h2 + acc[ai][1][m][0]; *(f32x4*)(o + 144) = h3 + acc[ai][1][m][1]; }
    } };
DEV void phase_moe2(const Params& p, unsigned char* lds) {
    moe_tiles(p, lds);
    const int* tstart = (const int*)(lds + MOE_TS);
    PolMoe2 P{p, tstart, (const int*)(lds + MOE_TT), tstart[NBIN] * 4, (int)gridDim.x, vblock()};
    EpiMoe2 E{p};
    pg8::gemm_phase2((PG8_LAS unsigned char*)lds, P, E);
}

#define XB_TMO      128
#define XB_XCNT(j)  (256  + 64 * (j))
#define XB_XSUB(j)  (1280 + 64 * (j))
#define XB_XGEN(j)  (2304 + 64 * (j))
#define XB_TOP      3328
#define XB_TOPGEN   3392
#define XCD_BAR_WORDS 3456
#define XB_SPIN_CAP (1u << 20)
#define LAS __attribute__((address_space(3)))
constexpr size_t WS_BAR = WS_CTL + 4096;
DEV unsigned xb_ld(unsigned* p) { return __hip_atomic_load(p, __ATOMIC_RELAXED, __HIP_MEMORY_SCOPE_AGENT); }
DEV unsigned xb_add(unsigned* p, unsigned v) { return __hip_atomic_fetch_add(p, v, __ATOMIC_RELAXED, __HIP_MEMORY_SCOPE_AGENT); }
DEV unsigned xb_xcc_id() { return (unsigned)__builtin_amdgcn_s_getreg((3 << 11) | 20) & 0xFu; }
#define XB_SPIN(cond, bar) do { unsigned _sp = 0; while (cond) { __builtin_amdgcn_s_sleep(1); \
    if ((++_sp & 255u) == 0u) { if (xb_ld(&(bar)[XB_TMO])) break; if (_sp > XB_SPIN_CAP) { atomicAdd(&(bar)[XB_TMO], 1u); break; } } } } while (0)
struct XcdBarrier { unsigned* bar; unsigned x; volatile LAS unsigned* st; };
DEV XcdBarrier xcd_barrier_post(unsigned* bar, volatile LAS unsigned* st) {
    XcdBarrier b; b.bar = bar; b.x = xb_xcc_id(); b.st = st;
    if (threadIdx.x == 0) (void)xb_add(&bar[XB_XCNT(b.x)], 1u);
    return b;
}
DEV void xcd_barrier_complete(unsigned* bar, unsigned x, unsigned& nloc, unsigned& nx) {
    const unsigned G = gridDim.x * gridDim.y * gridDim.z;
    unsigned sum, cnt, mine, sp = 0u;
    for (;;) {
        sum = 0u; cnt = 0u; mine = 0u;
#pragma unroll
        for (unsigned j = 0; j < 16; ++j) { const unsigned c = xb_ld(&bar[XB_XCNT(j)]); sum += c; cnt += (c > 0u) ? 1u : 0u; mine = (j == x) ? c : mine; }
        if (sum == G) break;
        __builtin_amdgcn_s_sleep(1);
        if ((++sp & 255u) == 0u) { if (xb_ld(&bar[XB_TMO])) break; if (sp > XB_SPIN_CAP) { atomicAdd(&bar[XB_TMO], 1u); break; } }
    }
    nloc = mine > 0u ? mine : 1u; nx = cnt > 0u ? cnt : 1u;
}
DEV void xcd_barrier(const XcdBarrier& b) {
    asm volatile("s_waitcnt vmcnt(0)" ::: "memory");
    __syncthreads();
    if (threadIdx.x == 0) {
        unsigned* bar = b.bar;
        __builtin_amdgcn_s_waitcnt(0);
        unsigned nloc = b.st[0], nx = b.st[1];
        if (nloc == 0u) { xcd_barrier_complete(bar, b.x, nloc, nx); b.st[0] = nloc; b.st[1] = nx; }
        const unsigned old = xb_add(&bar[XB_XSUB(b.x)], 1u);
        const unsigned gen = old / nloc;
        if (old + 1u == (gen + 1u) * nloc) {
            __builtin_amdgcn_fence(__ATOMIC_RELEASE, "agent");
            asm volatile("s_waitcnt vmcnt(0)" ::: "memory");
            const unsigned og = xb_add(&bar[XB_TOP], 1u);
            const unsigned tg = og / nx;
            if (og + 1u == (tg + 1u) * nx) xb_add(&bar[XB_TOPGEN], 1u);
            else XB_SPIN(xb_ld(&bar[XB_TOPGEN]) == tg, bar);
            __builtin_amdgcn_fence(__ATOMIC_ACQUIRE, "agent");
            xb_add(&bar[XB_XGEN(b.x)], 1u);
            asm volatile("s_waitcnt vmcnt(0)" ::: "memory");
        } else {
            XB_SPIN(xb_ld(&bar[XB_XGEN(b.x)]) == gen, bar);
            __builtin_amdgcn_fence(__ATOMIC_ACQUIRE, "agent");
            asm volatile("s_waitcnt vmcnt(0)" ::: "memory");
        }
    }
    __syncthreads();
}

constexpr int LDS_BYTES = 144 * 1024;
constexpr int N_PHASES = 9;
__global__ void __launch_bounds__(NT) mega(Params p, int lo, int hi) {
    extern __shared__ __attribute__((aligned(16))) unsigned char lds[];
    volatile LAS unsigned* xst = (volatile LAS unsigned*)(lds + LDS_BYTES - 16);
    if (threadIdx.x < 4) xst[threadIdx.x] = 0u;
    __syncthreads();
    XcdBarrier xbar; xbar.bar = (unsigned*)(p.ws + WS_BAR); xbar.x = 0; xbar.st = xst;
    if (hi - lo > 1) xbar = xcd_barrier_post((unsigned*)(p.ws + WS_BAR), xst);
#define GRID_SYNC() xcd_barrier(xbar)
#ifndef PROBE_REPEAT
#define PROBE_REPEAT -1
#endif
#define RUN_PHASE(k, call) do { if (lo <= (k) && (k) < hi) { call; \
        if ((k) == PROBE_REPEAT) { GRID_SYNC(); \
            if ((k) == 5) { float* rz = (float*)(p.ws + WS_ROWSS); for (int i = blockIdx.x * NT + threadIdx.x; i < NTOK; i += gridDim.x * NT) rz[i] = 0.f; GRID_SYNC(); } \
            if ((k) == 7) { if (blockIdx.x == 0 && threadIdx.x < 128) ((int*)(p.ws + WS_CTL))[threadIdx.x] = 0; GRID_SYNC(); } \
            call; } \
        if ((k) + 1 < hi) GRID_SYNC(); } } while (0)
    RUN_PHASE(0, phase_prologue(p, lds));
    RUN_PHASE(1, phase_inproj(p, lds));
    RUN_PHASE(2, { phase_cmp_a(p, lds); const int G_ = (int)gridDim.x; if (G_ > 128) phase_hgrn_a1(p, lds, 64, G_ - 64); else phase_hgrn_a1(p, lds, 0, G_); });
    RUN_PHASE(3, { phase_cmp_b(p, lds); phase_hgrn_a2(p, lds); });
    RUN_PHASE(4, { phase_cmp_attn(p, lds); phase_hgrn_a3(p, lds); });
    RUN_PHASE(5, { phase_flash(p, lds); phase_normalize(p, lds); });
    RUN_PHASE(6, phase_outproj(p, lds));
    RUN_PHASE(7, phase_router(p, lds));
    RUN_PHASE(8, phase_moe1(p, lds));
    RUN_PHASE(9, phase_moe2(p, lds));
#undef RUN_PHASE
}

extern "C" void kernel_launch(void* const* d_in, const int* in_sizes, int n_in, void* d_out, int out_size, void* d_ws, size_t ws_size, hipStream_t stream) {
    static int grid = 0;
    if (grid == 0) {
        int dev = 0, cus = 0, per_cu = 0;
        hipGetDevice(&dev);
        hipDeviceGetAttribute(&cus, hipDeviceAttributeMultiprocessorCount, dev);
        hipFuncSetAttribute((const void*)mega, hipFuncAttributeMaxDynamicSharedMemorySize, LDS_BYTES);
        hipOccupancyMaxActiveBlocksPerMultiprocessor(&per_cu, (const void*)mega, NT, LDS_BYTES);
        if (per_cu < 1) per_cu = 1;
        grid = cus;
        if (ws_size < WS_END) fprintf(stderr, "kernel_launch: workspace too small: %zu < %zu\n", ws_size, (size_t)WS_END);
        fprintf(stderr, "kernel_launch: cus %d per_cu %d grid %d ws %zu\n", cus, per_cu, grid, ws_size);
    }
    Params p{};
    const float** pp = (const float**)&p;
    for (int i = 0; i < 23; ++i) pp[i] = (const float*)d_in[i];
    p.out = (float*)d_out; p.ws = (unsigned char*)d_ws;
#if N_LAUNCH_MODE == 1
    (void)hipMemsetAsync((unsigned char*)d_ws + WS_BAR, 0, XCD_BAR_WORDS * 4, stream);
    int lo = 0, hi = N_PHASES + 1;
    void* args[] = {&p, &lo, &hi};
    hipError_t e = hipLaunchCooperativeKernel((const void*)mega, dim3(grid), dim3(NT), args, LDS_BYTES, stream);
    if (e != hipSuccess) fprintf(stderr, "cooperative launch failed: %s\n", hipGetErrorString(e));
#else
    for (int ph = 0; ph <= N_PHASES; ++ph) hipLaunchKernelGGL(mega, dim3(grid), dim3(NT), LDS_BYTES, stream, p, ph, ph + 1);
#endif
}
```

```cpp
#include <hip/hip_runtime.h>
#include <hip/hip_cooperative_groups.h>
#include <cstdio>
#include <cstdint>
#include <cstring>
namespace cg = cooperative_groups;

#ifndef N_LAUNCH_MODE
#define N_LAUNCH_MODE 1
#endif

#define DEV __device__ __forceinline__
typedef unsigned short bf16_t;
typedef short bf16x8 __attribute__((ext_vector_type(8)));
typedef float f32x4 __attribute__((ext_vector_type(4)));
typedef float f32x2 __attribute__((ext_vector_type(2)));
typedef float f32x16 __attribute__((ext_vector_type(16)));
typedef unsigned u32x4 __attribute__((ext_vector_type(4)));
typedef unsigned u32x2 __attribute__((ext_vector_type(2)));

constexpr int NT = 512;
constexpr int BATCH = 8, SEQ = 4096, DM = 1024, NTOK = BATCH * SEQ;
constexpr int IN_COLS = 3352, INP = 3584;
constexpr int NC = 255;
constexpr float RMS_EPS = 1e-6f;
constexpr float QSCALE = 0.125f * 1.4426950408889634f;
constexpr int NBIN = 112;
constexpr int BINCAP = NTOK;

constexpr size_t MiB = 1ull << 20;
constexpr size_t WS_CTL    = 0;
constexpr size_t WS_RSTD1  = 1 * MiB;
constexpr size_t WS_RSTD2  = WS_RSTD1 + 128 * 1024;
constexpr size_t WS_ROWSS  = WS_RSTD2 + 128 * 1024;
constexpr size_t WS_TOKW   = WS_ROWSS + 128 * 1024;
constexpr size_t WS_LB     = WS_TOKW + 256 * 1024;
constexpr size_t WS_CBIAS  = WS_LB + 4096;
constexpr size_t WS_SELM   = 2 * MiB;
constexpr size_t WS_GATES  = 3 * MiB;
constexpr size_t WS_KCMP   = 6 * MiB;
constexpr size_t WS_VCMP   = WS_KCMP + 512 * 1024;
constexpr size_t WS_CW2T   = 7 * MiB;
constexpr size_t WS_RW     = 7 * MiB + 128 * 1024;
constexpr size_t WS_HID    = 8 * MiB;
constexpr size_t WS_CW1T   = 12 * MiB;
constexpr size_t WS_WOUTT  = 14 * MiB;
constexpr size_t WS_WINT   = 16 * MiB;
constexpr size_t WS_R1     = 24 * MiB;
constexpr size_t WS_Q      = 88 * MiB;
constexpr size_t WS_KC     = 120 * MiB;
constexpr size_t WS_VC     = 128 * MiB;
constexpr size_t WS_KS     = 136 * MiB;
constexpr size_t WS_KW     = 144 * MiB;
constexpr size_t WS_VST    = 152 * MiB;
constexpr size_t WS_VWT    = 160 * MiB;
constexpr size_t WS_OC     = 168 * MiB;
constexpr size_t WS_W13T   = 200 * MiB;
constexpr size_t WS_W2T    = 264 * MiB;
constexpr size_t WS_HQ     = 296 * MiB;
constexpr size_t WS_HV     = 328 * MiB;
constexpr size_t WS_HG     = 360 * MiB;
constexpr size_t WS_HLOGF  = 392 * MiB;
constexpr size_t WS_XB     = 424 * MiB;
constexpr size_t WS_DBUF   = 488 * MiB;
constexpr size_t WS_END    = 489 * MiB;
constexpr size_t WS_UBUF   = WS_W13T;
constexpr size_t WS_BINL   = WS_HQ;
constexpr size_t WS_HBUF   = WS_HQ + 16 * MiB;
constexpr size_t WS_EL     = WS_HQ + 136 * MiB;
constexpr size_t WS_EW     = WS_HQ + 140 * MiB;
constexpr size_t WS_EDST   = WS_HQ + 144 * MiB;

struct Params {
    const float *x, *attn_g, *ffn_g, *w_in, *w_out, *g_q, *g_k, *pos_k, *pos_v, *wk1, *wk2, *wv1, *wv2, *g_nsa, *lb_logits, *g_hn,
        *w_group, *b_group, *w_expert, *b_expert, *w1, *w3, *w2;
    float* out;
    unsigned char* ws;
};

typedef __bf16 bf16x2_t __attribute__((ext_vector_type(2)));
DEV unsigned pk2(float lo, float hi) { f32x2 f = {lo, hi}; return __builtin_bit_cast(unsigned, __builtin_convertvector(f, bf16x2_t)); }
DEV bf16_t f2bf(float f) { return (bf16_t)(pk2(f, 0.f) & 0xffffu); }
DEV float bf2f(bf16_t b) { return __uint_as_float(((unsigned)b) << 16); }
DEV float bflo(unsigned u) { return __uint_as_float(u << 16); }
DEV float bfhi(unsigned u) { return __uint_as_float(u & 0xffff0000u); }
DEV float sigmoidf_(float v) { return __builtin_amdgcn_rcpf(1.f + __builtin_amdgcn_exp2f(-1.4426950408889634f * v)); }
DEV float siluf_(float v) { return v * __builtin_amdgcn_rcpf(1.f + __builtin_amdgcn_exp2f(-1.4426950408889634f * v)); }
DEV float wave_sum(float v) {
#pragma unroll
    for (int o = 1; o < 64; o <<= 1) v += __shfl_xor(v, o);
    return v;
}
DEV float wave_max(float v) {
#pragma unroll
    for (int o = 1; o < 64; o <<= 1) v = fmaxf(v, __shfl_xor(v, o));
    return v;
}
DEV int vblock() { const int G = gridDim.x, b = blockIdx.x; return (G % 8 == 0) ? (b % 8) * (G / 8) + b / 8 : b; }

namespace pg8 {
#define PG8_LAS __attribute__((address_space(3)))
constexpr int BM = 256, BK = 64, HALF = 128, HTB = HALF * BK * 2, STAGE_BYTES = 8 * HTB, NXCD = 8, WGM = 1;
__host__ __device__ __forceinline__ int lds_byte(int r, int c) { const int st = (r >> 4) * 2 + (c >> 5), rr = r & 15, cc = c & 31, ob = rr * 64 + cc * 2; return st * 1024 + (ob ^ (((ob >> 9) & 1) << 5)); }
__host__ __device__ __forceinline__ void stage_rc(int b, int& R, int& C) { const int st = b / 1024, sb = b % 1024, swz = sb ^ (((sb >> 9) & 1) << 5); R = (st >> 1) * 16 + swz / 64; C = (st & 1) * 32 + (swz % 64) / 2; }
struct Unit { int pm, pn; };
struct Gemm { const bf16_t* A; const bf16_t* Bt; int M, N, K; };
struct StaticOrder {
    int nM, nN, nwg, G, c;
    __host__ __device__ void init(int M, int N, int G_, int c_) { nM = M / BM; nN = N / BM; nwg = nM * nN; G = G_; c = c_; }
    __host__ __device__ bool next(int i, Unit& u) const {
        const long L = (long)i * G + c; if (L >= nwg) return false;
        int wgid = (int)L; { const int q = nwg / NXCD, r = nwg % NXCD, xcd = wgid % NXCD, off = wgid / NXCD; wgid = (xcd < r ? xcd * (q + 1) : r * (q + 1) + (xcd - r) * q) + off; }
        const int nig = WGM * nN, gid = wgid / nig, fm = gid * WGM, gsz = (nM - fm) < WGM ? (nM - fm) : WGM;
        u.pm = fm + ((wgid % nig) % gsz); u.pn = (wgid % nig) / gsz; return true;
    }
};
template <class Epi, class Sched>
__device__ __forceinline__ void gemm_phase(PG8_LAS unsigned char* lds, const Gemm g, const Sched& S, const Epi& E) {
    const int tid = threadIdx.x, wid = __builtin_amdgcn_readfirstlane(tid >> 6), lane = tid & 63, wr = wid >> 2, wc = wid & 3, fr = lane & 15, fq = lane >> 4;
    const int K = g.K, nt = K / BK;
    unsigned voffA[2];
#pragma unroll
    for (int i = 0; i < 2; ++i) { int R, C; stage_rc(tid * 16 + i * 8192, R, C); voffA[i] = (unsigned)(R * K + C) * 2u; }
    const size_t kstep = (size_t)(BK * 2);
    const size_t hstep = (size_t)HALF * K * 2;
    const size_t tstep = 2 * hstep;
    const unsigned ldsw = (unsigned)wid * 1024u;
    const int aoff = lds_byte(wr * 64 + fr, fq * 8), boff = lds_byte(wc * 32 + fr, fq * 8);
#define PG8_SA(b, h) (((b) * 2 + (h)) * HTB)
#define PG8_SB(b, h) ((4 + (b) * 2 + (h)) * HTB)
#define PG8_STAGE(bufoff, gbase, voff) do { _Pragma("unroll") for (int _i = 0; _i < 2; ++_i) \
        __builtin_amdgcn_global_load_lds((const unsigned*)((const char*)(gbase) + (voff)[_i]), (PG8_LAS unsigned*)(lds + (bufoff) + ldsw + _i * 8192), 16, 0, 0); } while (0)
#define PG8_LDA(dst, b, h) do { _Pragma("unroll") for (int m = 0; m < 4; ++m) _Pragma("unroll") for (int k = 0; k < 2; ++k) dst[m][k] = *(const PG8_LAS bf16x8*)(lds + PG8_SA(b, h) + aoff + m * 2048 + k * 1024); } while (0)
#define PG8_LDB(dst, b, h) do { _Pragma("unroll") for (int n = 0; n < 2; ++n) _Pragma("unroll") for (int k = 0; k < 2; ++k) dst[n][k] = *(const PG8_LAS bf16x8*)(lds + PG8_SB(b, h) + boff + n * 2048 + k * 1024); } while (0)
#define PG8_MMA(ai, bj, At, Bt) do { __builtin_amdgcn_s_setprio(1); _Pragma("unroll") for (int m = 0; m < 4; ++m) _Pragma("unroll") for (int n = 0; n < 2; ++n) _Pragma("unroll") for (int k = 0; k < 2; ++k) \
        acc[ai][bj][m][n] = __builtin_amdgcn_mfma_f32_16x16x32_bf16(Bt[n][k], At[m][k], acc[ai][bj][m][n], 0, 0, 0); __builtin_amdgcn_s_setprio(0); } while (0)
#define PG8_WAIT_V(n) asm volatile("s_waitcnt vmcnt(" #n ")" ::: "memory")
#define PG8_WAIT_L(n) asm volatile("s_waitcnt lgkmcnt(" #n ")" ::: "memory")
#define PG8_BAR __builtin_amdgcn_s_barrier()
#define PG8_SCHED __builtin_amdgcn_sched_barrier(0)
    Unit cur, nxt; int ui = 0;
    if (!S.next(0, cur)) return;
    f32x4 acc[2][2][4][2];
#pragma unroll
    for (int a = 0; a < 2; ++a)
#pragma unroll
        for (int b = 0; b < 2; ++b)
#pragma unroll
            for (int m = 0; m < 4; ++m)
#pragma unroll
                for (int n = 0; n < 2; ++n) acc[a][b][m][n] = (f32x4){0.f, 0.f, 0.f, 0.f};
    bf16x8 At[4][2], B0[2][2], B1[2][2];
    const char* cA = (const char*)g.A + (size_t)cur.pm * tstep; const char* cB = (const char*)g.Bt + (size_t)cur.pn * tstep;
    PG8_STAGE(PG8_SB(0, 0), cB, voffA); PG8_STAGE(PG8_SA(0, 0), cA, voffA); PG8_STAGE(PG8_SB(0, 1), cB + hstep, voffA); PG8_STAGE(PG8_SA(0, 1), cA + hstep, voffA);
    if (wr == 1) PG8_BAR;
    PG8_WAIT_V(4); PG8_BAR;
    PG8_STAGE(PG8_SB(1, 0), cB + kstep, voffA); PG8_STAGE(PG8_SA(1, 0), cA + kstep, voffA); PG8_STAGE(PG8_SB(1, 1), cB + hstep + kstep, voffA);
    PG8_WAIT_V(6); PG8_BAR;
    for (;;) {
        const bool has_next = S.next(ui + 1, nxt);
        const char* nA = has_next ? (const char*)g.A + (size_t)nxt.pm * tstep : cA; const char* nB = has_next ? (const char*)g.Bt + (size_t)nxt.pn * tstep : cB;
        float midrs[2][4];
        if constexpr (Epi::MIDSCALE) {
#pragma unroll
            for (int a = 0; a < 2; ++a)
#pragma unroll
                for (int m = 0; m < 4; ++m) midrs[a][m] = E.rowscale(cur.pm * BM + a * HALF + wr * 64 + m * 16 + fr); }
        for (int t = 0; t < nt; t += 2) {
            const bool last = (t == nt - 2);
            if constexpr (Epi::MIDSCALE) { if (t == E.midk()) {
#pragma unroll
                for (int a = 0; a < 2; ++a)
#pragma unroll
                    for (int b = 0; b < 2; ++b)
#pragma unroll
                        for (int m = 0; m < 4; ++m)
#pragma unroll
                            for (int n = 0; n < 2; ++n) acc[a][b][m][n] = acc[a][b][m][n] * midrs[a][m]; } }
            const char* a1 = cA + (size_t)(t + 1) * kstep;
            const char* a2 = last ? nA : cA + (size_t)(t + 2) * kstep; const char* b2 = last ? nB : cB + (size_t)(t + 2) * kstep;
            const char* a3 = a2 + kstep; const char* b3 = b2 + kstep;
            PG8_LDB(B0, 0, 0); PG8_SCHED; PG8_LDA(At, 0, 0); PG8_STAGE(PG8_SA(1, 1), a1 + hstep, voffA);
            PG8_WAIT_L(8); PG8_BAR; PG8_WAIT_L(0); PG8_MMA(0, 0, At, B0); PG8_BAR; PG8_SCHED;
            PG8_LDB(B1, 0, 1); PG8_STAGE(PG8_SB(0, 0), b2, voffA);
            PG8_BAR; PG8_WAIT_L(0); PG8_MMA(0, 1, At, B1); PG8_BAR;
            PG8_LDA(At, 0, 1); PG8_STAGE(PG8_SA(0, 0), a2, voffA);
            PG8_BAR; PG8_WAIT_L(0); PG8_MMA(1, 0, At, B0); PG8_BAR; PG8_SCHED;
            PG8_STAGE(PG8_SB(0, 1), b2 + hstep, voffA);
            PG8_WAIT_V(6); PG8_BAR; PG8_MMA(1, 1, At, B1); PG8_BAR;
            PG8_LDB(B0, 1, 0); PG8_SCHED; PG8_LDA(At, 1, 0); PG8_STAGE(PG8_SA(0, 1), a2 + hstep, voffA);
            PG8_WAIT_L(8); PG8_BAR; PG8_WAIT_L(0); PG8_MMA(0, 0, At, B0); PG8_BAR; PG8_SCHED;
            PG8_LDB(B1, 1, 1); PG8_STAGE(PG8_SB(1, 0), b3, voffA);
            PG8_BAR; PG8_WAIT_L(0); PG8_MMA(0, 1, At, B1); PG8_BAR;
            PG8_LDA(At, 1, 1); PG8_STAGE(PG8_SA(1, 0), a3, voffA);
            PG8_BAR; PG8_WAIT_L(0); PG8_MMA(1, 0, At, B0); PG8_BAR; PG8_SCHED;
            PG8_STAGE(PG8_SB(1, 1), b3 + hstep, voffA);
            PG8_WAIT_V(6); PG8_BAR; PG8_MMA(1, 1, At, B1); PG8_BAR;
        }
        E(acc, cur, wr, wc, fr, fq);
        if (!has_next) break;
#pragma unroll
        for (int a = 0; a < 2; ++a)
#pragma unroll
            for (int b = 0; b < 2; ++b)
#pragma unroll
                for (int m = 0; m < 4; ++m)
#pragma unroll
                    for (int n = 0; n < 2; ++n) acc[a][b][m][n] = (f32x4){0.f, 0.f, 0.f, 0.f};
        cur = nxt; cA = nA; cB = nB; ++ui;
    }
    PG8_WAIT_V(0);
    if (wr == 0) PG8_BAR;
    PG8_BAR;
#undef PG8_SA
#undef PG8_SB
#undef PG8_STAGE
#undef PG8_LDA
#undef PG8_LDB
#undef PG8_MMA
#undef PG8_WAIT_V
#undef PG8_WAIT_L
#undef PG8_BAR
#undef PG8_SCHED
}
template <class Pol, class Epi>
__device__ __forceinline__ void gemm_phase2(PG8_LAS unsigned char* lds, const Pol& P, const Epi& E) {
    const int tid = threadIdx.x, wid = __builtin_amdgcn_readfirstlane(tid >> 6), lane = tid & 63, wr = wid >> 2, wc = wid & 3, fr = lane & 15, fq = lane >> 4;
    const int nt = P.nk();
    const unsigned ldsw = (unsigned)wid * 1024u;
    const int aoff = lds_byte(wr * 64 + fr, fq * 8), boff = lds_byte(wc * 32 + fr, fq * 8);
#define PG8_SA(b, h) (((b) * 2 + (h)) * HTB)
#define PG8_SB(b, h) ((4 + (b) * 2 + (h)) * HTB)
#define PG8_STAGE_A(bufoff, AS, h, kt) do { _Pragma("unroll") for (int _i = 0; _i < 2; ++_i) \
        __builtin_amdgcn_global_load_lds((const unsigned*)P.pa(AS, h, _i, kt), (PG8_LAS unsigned*)(lds + (bufoff) + ldsw + _i * 8192), 16, 0, 0); } while (0)
#define PG8_STAGE_B(bufoff, BS, h, kt) do { _Pragma("unroll") for (int _i = 0; _i < 2; ++_i) \
        __builtin_amdgcn_global_load_lds((const unsigned*)P.pb(BS, h, _i, kt), (PG8_LAS unsigned*)(lds + (bufoff) + ldsw + _i * 8192), 16, 0, 0); } while (0)
#define PG8_LDA(dst, b, h) do { _Pragma("unroll") for (int m = 0; m < 4; ++m) _Pragma("unroll") for (int k = 0; k < 2; ++k) dst[m][k] = *(const PG8_LAS bf16x8*)(lds + PG8_SA(b, h) + aoff + m * 2048 + k * 1024); } while (0)
#define PG8_LDB(dst, b, h) do { _Pragma("unroll") for (int n = 0; n < 2; ++n) _Pragma("unroll") for (int k = 0; k < 2; ++k) dst[n][k] = *(const PG8_LAS bf16x8*)(lds + PG8_SB(b, h) + boff + n * 2048 + k * 1024); } while (0)
#define PG8_MMA(ai, bj, At, Bt) do { __builtin_amdgcn_s_setprio(1); _Pragma("unroll") for (int m = 0; m < 4; ++m) _Pragma("unroll") for (int n = 0; n < 2; ++n) _Pragma("unroll") for (int k = 0; k < 2; ++k) \
        acc[ai][bj][m][n] = __builtin_amdgcn_mfma_f32_16x16x32_bf16(Bt[n][k], At[m][k], acc[ai][bj][m][n], 0, 0, 0); __builtin_amdgcn_s_setprio(0); } while (0)
#define PG8_STAGE_A2(bufoff, h, kt) do { _Pragma("unroll") for (int _i = 0; _i < 2; ++_i) \
        __builtin_amdgcn_global_load_lds((const unsigned*)P.pa(a2, h, _i, kt), (PG8_LAS unsigned*)(lds + (bufoff) + ldsw + _i * 8192), 16, 0, 0); } while (0)
#define PG8_STAGE_B2(bufoff, h, kt) do { _Pragma("unroll") for (int _i = 0; _i < 2; ++_i) \
        __builtin_amdgcn_global_load_lds((const unsigned*)P.pb(b2, h, _i, kt), (PG8_LAS unsigned*)(lds + (bufoff) + ldsw + _i * 8192), 16, 0, 0); } while (0)
#define PG8_WAIT_V(n) asm volatile("s_waitcnt vmcnt(" #n ")" ::: "memory")
#define PG8_WAIT_L(n) asm volatile("s_waitcnt lgkmcnt(" #n ")" ::: "memory")
#define PG8_BAR __builtin_amdgcn_s_barrier()
#define PG8_SCHED __builtin_amdgcn_sched_barrier(0)
    typename Pol::Unit cur, nxt; int ui = 0;
    if (!P.next(0, cur)) return;
    f32x4 acc[2][2][4][2];
#pragma unroll
    for (int a = 0; a < 2; ++a)
#pragma unroll
        for (int b = 0; b < 2; ++b)
#pragma unroll
            for (int m = 0; m < 4; ++m)
#pragma unroll
                for (int n = 0; n < 2; ++n) acc[a][b][m][n] = (f32x4){0.f, 0.f, 0.f, 0.f};
    bf16x8 At[4][2], B0[2][2], B1[2][2];
    typename Pol::AddrA aC, aN; typename Pol::AddrB bC, bN;
    P.addrA(cur, aC); P.addrB(cur, bC);
    PG8_STAGE_B(PG8_SB(0, 0), bC, 0, 0); PG8_STAGE_A(PG8_SA(0, 0), aC, 0, 0); PG8_STAGE_B(PG8_SB(0, 1), bC, 1, 0); PG8_STAGE_A(PG8_SA(0, 1), aC, 1, 0);
    if (wr == 1) PG8_BAR;
    PG8_WAIT_V(4); PG8_BAR;
    PG8_STAGE_B(PG8_SB(1, 0), bC, 0, 1); PG8_STAGE_A(PG8_SA(1, 0), aC, 0, 1); PG8_STAGE_B(PG8_SB(1, 1), bC, 1, 1);
    PG8_WAIT_V(6); PG8_BAR;
    for (;;) {
        const bool has_next = P.next(ui + 1, nxt);
        if (has_next) { P.addrA(nxt, aN); P.addrB(nxt, bN); } else { aN = aC; bN = bC; }
        const bool full = P.full(cur);
        for (int t = 0; t < nt; t += 2) {
            const bool last = (t == nt - 2);
            const typename Pol::AddrA a2 = last ? aN : aC; const typename Pol::AddrB b2 = last ? bN : bC;
            const int k2 = last ? 0 : t + 2, k3 = k2 + 1;
            PG8_LDB(B0, 0, 0); PG8_SCHED; PG8_LDA(At, 0, 0); PG8_STAGE_A(PG8_SA(1, 1), aC, 1, t + 1);
            PG8_WAIT_L(8); PG8_BAR; PG8_WAIT_L(0); PG8_MMA(0, 0, At, B0); PG8_BAR; PG8_SCHED;
            PG8_LDB(B1, 0, 1); PG8_STAGE_B2(PG8_SB(0, 0), 0, k2);
            PG8_BAR; PG8_WAIT_L(0); PG8_MMA(0, 1, At, B1); PG8_BAR;
            PG8_LDA(At, 0, 1); PG8_STAGE_A2(PG8_SA(0, 0), 0, k2);
            PG8_BAR; PG8_WAIT_L(0); if (full) PG8_MMA(1, 0, At, B0); PG8_BAR; PG8_SCHED;
            PG8_STAGE_B2(PG8_SB(0, 1), 1, k2);
            PG8_WAIT_V(6); PG8_BAR; if (full) PG8_MMA(1, 1, At, B1); PG8_BAR;
            PG8_LDB(B0, 1, 0); PG8_SCHED; PG8_LDA(At, 1, 0); PG8_STAGE_A2(PG8_SA(0, 1), 1, k2);
            PG8_WAIT_L(8); PG8_BAR; PG8_WAIT_L(0); PG8_MMA(0, 0, At, B0); PG8_BAR; PG8_SCHED;
            PG8_LDB(B1, 1, 1); PG8_STAGE_B2(PG8_SB(1, 0), 0, k3);
            PG8_BAR; PG8_WAIT_L(0); PG8_MMA(0, 1, At, B1); PG8_BAR;
            PG8_LDA(At, 1, 1); PG8_STAGE_A2(PG8_SA(1, 0), 0, k3);
            PG8_BAR; PG8_WAIT_L(0); if (full) PG8_MMA(1, 0, At, B0); PG8_BAR; PG8_SCHED;
            PG8_STAGE_B2(PG8_SB(1, 1), 1, k3);
            PG8_WAIT_V(6); PG8_BAR; if (full) PG8_MMA(1, 1, At, B1); PG8_BAR;
        }
        E(acc, cur, wr, wc, fr, fq);
        if (!has_next) break;
#pragma unroll
        for (int a = 0; a < 2; ++a)
#pragma unroll
            for (int b = 0; b < 2; ++b)
#pragma unroll
                for (int m = 0; m < 4; ++m)
#pragma unroll
                    for (int n = 0; n < 2; ++n) acc[a][b][m][n] = (f32x4){0.f, 0.f, 0.f, 0.f};
        cur = nxt; aC = aN; bC = bN; ++ui;
    }
    PG8_WAIT_V(0);
    if (wr == 0) PG8_BAR;
    PG8_BAR;
#undef PG8_SA
#undef PG8_SB
#undef PG8_STAGE_A
#undef PG8_STAGE_B
#undef PG8_STAGE_A2
#undef PG8_STAGE_B2
#undef PG8_LDA
#undef PG8_LDB
#undef PG8_MMA
#undef PG8_WAIT_V
#undef PG8_WAIT_L
#undef PG8_BAR
#undef PG8_SCHED
}
__host__ __device__ __forceinline__ int perm_lo(int x) { return (((x >> 2) & 3) << 3) | (((x >> 4) & 1) << 2) | (x & 3); }
__host__ __device__ __forceinline__ int inv_perm_lo(int y) { return (((y >> 2) & 1) << 4) | (((y >> 3) & 3) << 2) | (y & 3); }
__host__ __device__ __forceinline__ int logcol(int p) { return (p & ~255) + 64 * ((p >> 5) & 3) + 32 * ((p >> 7) & 1) + perm_lo(p & 31); }
}

template <class SRC>
DEV void convert_tile(float* tl, const SRC& src, bf16_t* dst, int ldd, int n0, int k0) {
    const int tid = threadIdx.x;
    {
        const int n = tid & 63;
#pragma unroll
        for (int i = 0; i < 8; ++i) { const int kk = (tid >> 6) + 8 * i; tl[kk * 65 + n] = src.get(n0 + n, k0 + kk); }
    }
    __syncthreads();
    {
        const int n = tid >> 3, kc = tid & 7;
        const float* s = tl + (kc * 8) * 65 + n;
        u32x4 o;
        o.x = pk2(s[0 * 65], s[1 * 65]); o.y = pk2(s[2 * 65], s[3 * 65]); o.z = pk2(s[4 * 65], s[5 * 65]); o.w = pk2(s[6 * 65], s[7 * 65]);
        *(u32x4*)(dst + (size_t)(n0 + n) * ldd + k0 + kc * 8) = o;
    }
    __syncthreads();
}
struct SrcWin { const float* w; const float* g;
    DEV float get(int np, int k) const { const int n = pg8::logcol(np); int col; if (n < 1280) col = n; else if (n < 3328) col = n + 24; else if (n < 3352) col = 1280 + (n - 3328); else return 0.f;
        return w[(size_t)k * IN_COLS + col] * g[k]; } };
struct SrcWout { const float* w; const float* g;
    DEV float get(int np, int k) const { const int n = pg8::logcol(np); const float v = w[(size_t)k * DM + n]; return k < 512 ? v * g[k] : v; } };
struct SrcPlain { const float* w; int ld;
    DEV float get(int n, int k) const { return w[(size_t)k * ld + n]; } };
struct SrcW13 { const float* w1; const float* w3; const float* g;
    DEV float get(int n, int k) const { const uintptr_t a = (uintptr_t)w1, b = (uintptr_t)w3; const float* w = (const float*)(a + ((b - a) & (uintptr_t)(0 - (long long)(n & 1))));
        return w[(size_t)k * 512 + (n >> 1)] * g[k]; } };

template <class SRC>
DEV void convert_tile256(float* tl, const SRC& src, bf16_t* dst, int ldd, int n0, int k0) {
    const int tid = threadIdx.x;
    {
        const int q = tid & 63;
        f32x4 v[8];
#pragma unroll
        for (int i = 0; i < 8; ++i) v[i] = src.quad(n0, q, k0 + (tid >> 6) + 8 * i);
#pragma unroll
        for (int i = 0; i < 8; ++i) { float* o = tl + ((tid >> 6) + 8 * i) * 257; o[src.drow(q, 0)] = v[i].x; o[src.drow(q, 1)] = v[i].y; o[src.drow(q, 2)] = v[i].z; o[src.drow(q, 3)] = v[i].w; }
    }
    __syncthreads();
#pragma unroll
    for (int i = 0; i < 4; ++i) {
        const int idx = tid + NT * i, n = idx >> 3, kc = idx & 7;
        const float* s = tl + (kc * 8) * 257 + n;
        u32x4 o;
        o.x = pk2(s[0 * 257], s[1 * 257]); o.y = pk2(s[2 * 257], s[3 * 257]); o.z = pk2(s[4 * 257], s[5 * 257]); o.w = pk2(s[6 * 257], s[7 * 257]);
        *(u32x4*)(dst + (size_t)(n0 + n) * ldd + k0 + kc * 8) = o;
    }
    __syncthreads();
}
struct SrcWin4 { const float* w; const float* g;
    DEV int drow(int q, int e) const { return 4 * q + e; }
    DEV f32x4 quad(int n0, int q, int k) const { const int n = pg8::logcol(n0 + 4 * q); int col; if (n < 1280) col = n; else if (n < 3328) col = n + 24; else if (n < 3352) col = 1280 + (n - 3328); else return (f32x4){0.f, 0.f, 0.f, 0.f};
        return *(const f32x4*)(w + (size_t)k * IN_COLS + col) * g[k]; } };
struct SrcWout4 { const float* w; const float* g;
    DEV int drow(int q, int e) const { return 4 * q + e; }
    DEV f32x4 quad(int n0, int q, int k) const { const f32x4 v = *(const f32x4*)(w + (size_t)k * DM + pg8::logcol(n0 + 4 * q)); return k < 512 ? v * g[k] : v; } };
struct SrcPlain4 { const float* w; int ld;
    DEV int drow(int q, int e) const { return 4 * q + e; }
    DEV f32x4 quad(int n0, int q, int k) const { return *(const f32x4*)(w + (size_t)k * ld + n0 + 4 * q); } };
struct SrcW13_4 { const float* w1; const float* w3; const float* g;
    DEV int drow(int q, int e) const { const int l = 8 * (q & 31) + 2 * e + (q >> 5); return (l & ~31) | pg8::inv_perm_lo(l & 31); }
    DEV f32x4 quad(int n0, int q, int k) const { const uintptr_t a = (uintptr_t)w1, b = (uintptr_t)w3; const float* w = (const float*)(a + ((b - a) & (uintptr_t)(0 - (long long)(q >> 5))));
        return *(const f32x4*)(w + (size_t)k * 512 + (n0 >> 1) + 4 * (q & 31)) * g[k]; } };

constexpr int I_WIN = (INP / 256) * (DM / 64);
constexpr int I_WOUT = 4 * 16;
constexpr int I_CW1 = 2 * 32;
constexpr int I_W2 = 32 * 4 * 8;
constexpr int I_CW2 = 2 * 1 * 4;
constexpr int I_ALL = I_WIN + I_WOUT + I_CW1 + I_W2 + I_CW2;
DEV void convert_side(const Params& p, unsigned char* lds) {
    float* tl = (float*)lds; unsigned char* ws = p.ws; const int vb = vblock(), G = gridDim.x;
    __syncthreads();
    for (int it = vb; it < I_WOUT + I_CW1 + I_W2 + I_CW2; it += G) {
        int r = it;
        if (r < I_WOUT) { SrcWout4 s{p.w_out, p.g_nsa}; convert_tile256(tl, s, (bf16_t*)(ws + WS_WOUTT), DM, (r / 16) * 256, (r % 16) * 64); continue; } r -= I_WOUT;
        if (r < I_CW1) { const int z = r / 32, q = r % 32; SrcPlain4 s{z ? p.wv1 : p.wk1, 256};
            convert_tile256(tl, s, (bf16_t*)(ws + WS_CW1T) + (size_t)z * 256 * 2048, 2048, 0, q * 64); continue; } r -= I_CW1;
        if (r < I_W2) { const int e = r / 32, q = r % 32; SrcPlain4 s{p.w2 + (size_t)e * 512 * 1024, 1024};
            convert_tile256(tl, s, (bf16_t*)(ws + WS_W2T) + (size_t)e * 1024 * 512, 512, (q / 8) * 256, (q % 8) * 64); continue; } r -= I_W2;
        { const int z = r / 4, q = r % 4; SrcPlain s{z ? p.wv2 : p.wk2, 64};
            convert_tile(tl, s, (bf16_t*)(ws + WS_CW2T) + (size_t)z * 64 * 256, 256, 0, q * 64); }
    }
    __syncthreads();
}
DEV void phase_prologue(const Params& p, unsigned char* lds) {
    float* tl = (float*)lds;
    const int tid = threadIdx.x, lane = tid & 63, wid = tid >> 6;
    const int vb = vblock(), G = gridDim.x;
    unsigned char* ws = p.ws;
    for (int it = vb; it < I_WIN; it += G) { SrcWin4 s{p.w_in, p.attn_g}; convert_tile256(tl, s, (bf16_t*)(ws + WS_WINT), DM, (it / 16) * 256, (it % 16) * 64); }
    (void)I_ALL;
    {
        bf16_t* xb = (bf16_t*)(ws + WS_XB); float* rstd1 = (float*)(ws + WS_RSTD1);
        const int gw = vb * 8 + wid, NGW = G * 8;
        for (int m = gw; m < NTOK; m += NGW) {
            const f32x4* xr = (const f32x4*)(p.x + (size_t)m * DM) + lane;
            f32x4 v[4]; float s = 0.f;
#pragma unroll
            for (int j = 0; j < 4; ++j) { v[j] = xr[64 * j]; s += (v[j].x * v[j].x + v[j].y * v[j].y) + (v[j].z * v[j].z + v[j].w * v[j].w); }
            s = wave_sum(s);
            if (lane == 0) rstd1[m] = rsqrtf(s * (1.f / DM) + RMS_EPS);
            u32x2* o = (u32x2*)(xb + (size_t)m * DM) + lane;
#pragma unroll
            for (int j = 0; j < 4; ++j) { u32x2 w; w.x = pk2(v[j].x, v[j].y); w.y = pk2(v[j].z, v[j].w); o[64 * j] = w; }
        }
    }
    {
        const int gt = vb * NT + tid, NG = G * NT;
        float* rowss = (float*)(ws + WS_ROWSS);
        for (int i = gt; i < NTOK; i += NG) rowss[i] = 0.f;
        int* bincnt = (int*)(ws + WS_CTL);
        if (gt < 128) bincnt[gt] = 0;
        if (gt < 32) ((int*)(ws + WS_CTL + 512))[gt] = 0;
        if (gt < 512) { const float l0 = p.lb_logits[gt], l1 = p.lb_logits[512 + gt]; ((float*)(ws + WS_LB))[gt] = 1.f / (1.f + __expf(l1 - l0)); }
        for (int i = gt; i < 48 * 1024; i += NG) { const int c = i >> 10, k = i & 1023;
            const float w = (c < 4 ? p.w_group[k * 4 + c] : (c < 36 ? p.w_expert[k * 32 + (c - 4)] : 0.f)) * p.ffn_g[k];
            const bf16_t hi = f2bf(w); const bf16_t lo = f2bf(w - bf2f(hi));
            ((bf16_t*)(ws + WS_RW))[i] = hi; ((bf16_t*)(ws + WS_RW))[48 * 1024 + i] = lo; }
        {
            const int ob = (vb * 8 + wid) * 4;
            if (ob < 512) { const int z = ob >> 8, j0 = ob & 255; const float* pos = z ? p.pos_v : p.pos_k; const float* w = (z ? p.wv1 : p.wk1) + j0;
                f32x4 a = (f32x4){0.f, 0.f, 0.f, 0.f};
#pragma unroll 8
                for (int k = lane; k < 2048; k += 64) a = a + *(const f32x4*)(w + (size_t)k * 256) * pos[k];
                a.x = wave_sum(a.x); a.y = wave_sum(a.y); a.z = wave_sum(a.z); a.w = wave_sum(a.w);
                if (lane == 0) *(f32x4*)((float*)(ws + WS_CBIAS) + ob) = a; }
        }
    }
}

constexpr int G_A_BYTES = 128 * 128, G_B_BYTES = 256 * 128, G_STAGE = G_A_BYTES + G_B_BYTES, G_LDS = 2 * G_STAGE;
DEV int swz(int row, int chunk) { return row * 128 + ((chunk ^ ((row >> 1) & 7)) << 4); }
template <class AL, class BL, class EP>
DEV void gemm_tile(unsigned char* lds, const AL& al, const BL& bl, int nk, const EP& ep) {
    const int tid = threadIdx.x, lane = tid & 63, wid = tid >> 6, wr = wid >> 2, wc = wid & 3;
    const int frow = lane & 15, fq = lane >> 4;
    const bf16_t* aptr[2]; int aoff[2], boff[4], brow[4];
#pragma unroll
    for (int i = 0; i < 2; ++i) { const int q = tid + NT * i, row = q >> 3, ch = q & 7; aptr[i] = al.row(row) + ch * 8; aoff[i] = swz(row, ch); }
#pragma unroll
    for (int i = 0; i < 4; ++i) { const int q = tid + NT * i, row = q >> 3, ch = q & 7; brow[i] = row; boff[i] = G_A_BYTES + swz(row, ch) ; }
    const int bch8 = (tid & 7) * 8;
    u32x4 ra[2], rb[4];
#pragma unroll
    for (int i = 0; i < 2; ++i) ra[i] = *(const u32x4*)(aptr[i]);
#pragma unroll
    for (int i = 0; i < 4; ++i) rb[i] = *(const u32x4*)(bl.ptr(brow[i], 0) + bch8);
#pragma unroll
    for (int i = 0; i < 2; ++i) *(u32x4*)(lds + aoff[i]) = ra[i];
#pragma unroll
    for (int i = 0; i < 4; ++i) *(u32x4*)(lds + boff[i]) = rb[i];
    __syncthreads();
    f32x4 acc[4][4];
#pragma unroll
    for (int m = 0; m < 4; ++m)
#pragma unroll
        for (int n = 0; n < 4; ++n) acc[m][n] = (f32x4){0.f, 0.f, 0.f, 0.f};
    const int sx = (frow >> 1) & 7;
    for (int kt = 0; kt < nk; ++kt) {
        const bool more = (kt + 1 < nk);
        if (more) {
#pragma unroll
            for (int i = 0; i < 2; ++i) ra[i] = *(const u32x4*)(aptr[i] + (kt + 1) * 64);
#pragma unroll
            for (int i = 0; i < 4; ++i) rb[i] = *(const u32x4*)(bl.ptr(brow[i], kt + 1) + bch8);
        }
        const unsigned char* base = lds + (kt & 1) * G_STAGE;
#pragma unroll
        for (int ks = 0; ks < 2; ++ks) {
            const int co = ((ks * 4 + fq) ^ sx) << 4;
            bf16x8 af[4], bfr[4];
#pragma unroll
            for (int m = 0; m < 4; ++m) af[m] = *(const bf16x8*)(base + (wr * 64 + m * 16 + frow) * 128 + co);
#pragma unroll
            for (int n = 0; n < 4; ++n) bfr[n] = *(const bf16x8*)(base + G_A_BYTES + (wc * 64 + n * 16 + frow) * 128 + co);
#pragma unroll
            for (int m = 0; m < 4; ++m)
#pragma unroll
                for (int n = 0; n < 4; ++n) acc[m][n] = __builtin_amdgcn_mfma_f32_16x16x32_bf16(bfr[n], af[m], acc[m][n], 0, 0, 0);
        }
        if (more) {
            unsigned char* nb = lds + ((kt + 1) & 1) * G_STAGE;
#pragma unroll
            for (int i = 0; i < 2; ++i) *(u32x4*)(nb + aoff[i]) = ra[i];
#pragma unroll
            for (int i = 0; i < 4; ++i) *(u32x4*)(nb + boff[i]) = rb[i];
        }
        __syncthreads();
    }
    ep(acc, wr, wc, lane);
}

struct ARows { const bf16_t* base; size_t ld; DEV const bf16_t* row(int r) const { return base + (size_t)r * ld; } };
struct BRows { const bf16_t* base; size_t ld; DEV const bf16_t* ptr(int n, int kt) const { return base + (size_t)n * ld + kt * 64; } };

DEV u32x4 pk8(const f32x4 a, const f32x4 b) { u32x4 w; w.x = pk2(a.x, a.y); w.y = pk2(a.z, a.w); w.z = pk2(b.x, b.y); w.w = pk2(b.z, b.w); return w; }
struct EpiInproj8 { const Params& p; static constexpr bool MIDSCALE = false; DEV float rowscale(int) const { return 1.f; } DEV int midk() const { return -1; }
    DEV void operator()(const f32x4 (&acc)[2][2][4][2], const pg8::Unit& u, int wr, int wc, int fr, int fq) const {
        const int seg = u.pn * 4 + wc;
        if (seg > 52) return;
        unsigned char* ws = p.ws;
        const int row0 = u.pm * 256 + wr * 64 + fr;
        const int b = row0 >> 12, s0 = row0 & 4095;
        float rs[2][4];
#pragma unroll
        for (int ai = 0; ai < 2; ++ai)
#pragma unroll
            for (int m = 0; m < 4; ++m) rs[ai][m] = ((const float*)(ws + WS_RSTD1))[row0 + 128 * ai + 16 * m];
        const bool is_q = seg < 8, is_ks = (seg == 12 || seg == 13), is_kw = (seg == 16 || seg == 17);
        if (is_q || is_ks || is_kw) {
            const float* gw = (is_q ? p.g_q : (is_ks ? p.g_k + 64 : p.g_k + 128)) + 8 * fq;
            const f32x4 g00 = *(const f32x4*)(gw), g01 = *(const f32x4*)(gw + 4), g10 = *(const f32x4*)(gw + 32), g11 = *(const f32x4*)(gw + 36);
            bf16_t* dst; int hh, nh;
            if (is_q) { dst = (bf16_t*)(ws + WS_Q); hh = seg; nh = 8; } else if (is_ks) { dst = (bf16_t*)(ws + WS_KS); hh = seg - 12; nh = 2; } else { dst = (bf16_t*)(ws + WS_KW); hh = seg - 16; nh = 2; }
            bf16_t* o0 = dst + ((size_t)(b * nh + hh) * SEQ + s0) * 64 + fq * 8;
            const float qs = is_q ? QSCALE : 1.f;
#pragma unroll
            for (int ai = 0; ai < 2; ++ai)
#pragma unroll
                for (int m = 0; m < 4; ++m) {
                    const f32x4 a0 = acc[ai][0][m][0], a1 = acc[ai][0][m][1], a2 = acc[ai][1][m][0], a3 = acc[ai][1][m][1];
                    float ss = ((a0.x * a0.x + a0.y * a0.y) + (a0.z * a0.z + a0.w * a0.w)) + ((a1.x * a1.x + a1.y * a1.y) + (a1.z * a1.z + a1.w * a1.w))
                             + ((a2.x * a2.x + a2.y * a2.y) + (a2.z * a2.z + a2.w * a2.w)) + ((a3.x * a3.x + a3.y * a3.y) + (a3.z * a3.z + a3.w * a3.w));
                    ss += __shfl_xor(ss, 16); ss += __shfl_xor(ss, 32);
                    const float rr = rs[ai][m];
                    const float r = rr * rsqrtf(ss * rr * rr * (1.f / 64.f) + RMS_EPS) * qs;
                    bf16_t* o = o0 + (size_t)(128 * ai + 16 * m) * 64;
                    *(u32x4*)(o) = pk8(a0 * g00 * r, a1 * g01 * r); *(u32x4*)(o + 32) = pk8(a2 * g10 * r, a3 * g11 * r);
                }
            return;
        }
        if (seg >= 8 && seg < 12) {
            bf16_t* o0 = (bf16_t*)(ws + (seg < 10 ? WS_KC : WS_VC)) + ((size_t)(b * 2 + (seg & 1)) * SEQ + s0) * 64 + fq * 8;
#pragma unroll
            for (int ai = 0; ai < 2; ++ai)
#pragma unroll
                for (int m = 0; m < 4; ++m) { const float r = rs[ai][m]; bf16_t* o = o0 + (size_t)(128 * ai + 16 * m) * 64;
                    *(u32x4*)(o) = pk8(acc[ai][0][m][0] * r, acc[ai][0][m][1] * r); *(u32x4*)(o + 32) = pk8(acc[ai][1][m][0] * r, acc[ai][1][m][1] * r); }
            return;
        }
        if (seg == 14 || seg == 15 || seg == 18 || seg == 19) {
            bf16_t* o0 = (bf16_t*)(ws + (seg < 16 ? WS_VST : WS_VWT)) + (size_t)(b * 2 + (seg & 1)) * 64 * SEQ + s0;
#pragma unroll
            for (int ai = 0; ai < 2; ++ai)
#pragma unroll
                for (int m = 0; m < 4; ++m) { const float r = rs[ai][m]; bf16_t* o = o0 + 128 * ai + 16 * m;
#pragma unroll
                    for (int bj = 0; bj < 2; ++bj)
#pragma unroll
                        for (int n = 0; n < 2; ++n) { const int d = 32 * bj + 8 * fq + 4 * n; const f32x4 x = acc[ai][bj][m][n] * r;
                            o[(size_t)(d + 0) * SEQ] = f2bf(x.x); o[(size_t)(d + 1) * SEQ] = f2bf(x.y); o[(size_t)(d + 2) * SEQ] = f2bf(x.z); o[(size_t)(d + 3) * SEQ] = f2bf(x.w); } }
            return;
        }
        if (seg < 52) {
            const int kind = (seg - 20) >> 3, cb = ((seg - 20) & 7) * 64 + fq * 8;
            if (kind == 1) {
                const float* lb = (const float*)(ws + WS_LB) + cb;
                const f32x4 l00 = *(const f32x4*)(lb), l01 = *(const f32x4*)(lb + 4), l10 = *(const f32x4*)(lb + 32), l11 = *(const f32x4*)(lb + 36);
                bf16_t* o0 = (bf16_t*)(ws + WS_HLOGF) + (size_t)row0 * 512 + cb;
#define LOGF4(L_, X_) (f32x4){__logf(L_.x + (1.f - L_.x) * sigmoidf_(X_.x)), __logf(L_.y + (1.f - L_.y) * sigmoidf_(X_.y)), __logf(L_.z + (1.f - L_.z) * sigmoidf_(X_.z)), __logf(L_.w + (1.f - L_.w) * sigmoidf_(X_.w))}
#pragma unroll
                for (int ai = 0; ai < 2; ++ai)
#pragma unroll
                    for (int m = 0; m < 4; ++m) { const float r = rs[ai][m]; bf16_t* o = o0 + (size_t)(128 * ai + 16 * m) * 512;
                        const f32x4 x0 = acc[ai][0][m][0] * r, x1 = acc[ai][0][m][1] * r, x2 = acc[ai][1][m][0] * r, x3 = acc[ai][1][m][1] * r;
                        *(u32x4*)(o) = pk8(LOGF4(l00, x0), LOGF4(l01, x1)); *(u32x4*)(o + 32) = pk8(LOGF4(l10, x2), LOGF4(l11, x3)); }
#undef LOGF4
            } else {
                bf16_t* o0 = (bf16_t*)(ws + (kind == 0 ? WS_HQ : (kind == 2 ? WS_HV : WS_HG))) + (size_t)row0 * 512 + cb;
#define SILU4(X_) (f32x4){siluf_(X_.x), siluf_(X_.y), siluf_(X_.z), siluf_(X_.w)}
#pragma unroll
                for (int ai = 0; ai < 2; ++ai)
#pragma unroll
                    for (int m = 0; m < 4; ++m) { const float r = rs[ai][m]; bf16_t* o = o0 + (size_t)(128 * ai + 16 * m) * 512;
                        f32x4 x0 = acc[ai][0][m][0] * r, x1 = acc[ai][0][m][1] * r, x2 = acc[ai][1][m][0] * r, x3 = acc[ai][1][m][1] * r;
                        if (kind != 2) { x0 = SILU4(x0); x1 = SILU4(x1); x2 = SILU4(x2); x3 = SILU4(x3); }
                        *(u32x4*)(o) = pk8(x0, x1); *(u32x4*)(o + 32) = pk8(x2, x3); }
#undef SILU4
            }
            return;
        }
        if (fq < 3) {
            float* o0 = (float*)(ws + WS_GATES) + (size_t)row0 * 24 + 8 * fq;
#pragma unroll
            for (int ai = 0; ai < 2; ++ai)
#pragma unroll
                for (int m = 0; m < 4; ++m) { const float r = rs[ai][m]; float* o = o0 + (size_t)(128 * ai + 16 * m) * 24;
#pragma unroll
                    for (int n = 0; n < 2; ++n) { const f32x4 x = acc[ai][0][m][n] * r; *(f32x4*)(o + 4 * n) = (f32x4){sigmoidf_(x.x), sigmoidf_(x.y), sigmoidf_(x.z), sigmoidf_(x.w)}; } }
        }
    } };
DEV void phase_inproj(const Params& p, unsigned char* lds) {
    pg8::Gemm g{(const bf16_t*)(p.ws + WS_XB), (const bf16_t*)(p.ws + WS_WINT), NTOK, INP, DM};
    pg8::StaticOrder S; S.init(NTOK, INP, (int)gridDim.x, (int)blockIdx.x);
    EpiInproj8 E{p};
    const bool first = ((blockIdx.x >> 3) & 1) == 0;
    if (first) convert_side(p, lds);
    pg8::gemm_phase(( PG8_LAS unsigned char*)lds, g, S, E);
    if (!first) convert_side(p, lds);
}

struct ACmp { const bf16_t* src; int bg, c0;
    DEV const bf16_t* row(int r) const { int c = c0 + r; if (c > NC - 1) c = NC - 1; return src + ((size_t)bg * SEQ + 16 * c) * 64; } };
struct EpiCmpA { const Params& p; int z, rbase;
    DEV void operator()(f32x4 (&acc)[4][4], int wr, int wc, int lane) const {
        const int frow = lane & 15, fq = lane >> 4;
        const float* cb = (const float*)(p.ws + WS_CBIAS) + z * 256; bf16_t* hid = (bf16_t*)(p.ws + WS_HID) + (size_t)z * 4096 * 256;
#pragma unroll
        for (int m = 0; m < 4; ++m) { const int rr = rbase + wr * 64 + m * 16 + frow;
#pragma unroll
            for (int n = 0; n < 4; ++n) { const int c = wc * 64 + n * 16 + fq * 4; const f32x4 b = *(const f32x4*)(cb + c); f32x4 v = acc[m][n] + b;
                u32x2 w; w.x = pk2(siluf_(v.x), siluf_(v.y)); w.y = pk2(siluf_(v.z), siluf_(v.w)); *(u32x2*)(hid + (size_t)rr * 256 + c) = w; } }
    } };
DEV void phase_cmp_a(const Params& p, unsigned char* lds) {
    const int vb = vblock(), G = gridDim.x;
    for (int u = vb; u < 64; u += G) {
        const int z = u >> 5, rbase = (u & 31) * 128;
        ACmp al{(const bf16_t*)(p.ws + (z ? WS_VC : WS_KC)), (u & 31) >> 1, (u & 1) * 128};
        BRows bl{(const bf16_t*)(p.ws + WS_CW1T) + (size_t)z * 256 * 2048, 2048};
        EpiCmpA ep{p, z, rbase};
        gemm_tile(lds, al, bl, 2048 / 64, ep);
    }
}
struct BClamp64 { const bf16_t* base; size_t ld; DEV const bf16_t* ptr(int n, int kt) const { return base + (size_t)(n & 63) * ld + kt * 64; } };
struct EpiCmpB { const Params& p; int z, rbase;
    DEV void operator()(f32x4 (&acc)[4][4], int wr, int wc, int lane) const {
        if (wc != 0) return;
        const int frow = lane & 15, fq = lane >> 4;
        bf16_t* dst = (bf16_t*)(p.ws + (z ? WS_VCMP : WS_KCMP));
#pragma unroll
        for (int m = 0; m < 4; ++m) { const int rr = rbase + wr * 64 + m * 16 + frow;
            float r = 1.f;
            if (z == 0) { float ss = 0.f;
#pragma unroll
                for (int n = 0; n < 4; ++n) { const f32x4 v = acc[m][n]; ss += (v.x * v.x + v.y * v.y) + (v.z * v.z + v.w * v.w); }
                ss += __shfl_xor(ss, 16); ss += __shfl_xor(ss, 32); r = rsqrtf(ss * (1.f / 64.f) + RMS_EPS); }
            const int bg = rr >> 8, c = rr & 255;
            if (c < NC) {
#pragma unroll
                for (int n = 0; n < 4; ++n) { const int d = n * 16 + fq * 4; f32x4 v = acc[m][n] * r;
                    if (z == 0) { const f32x4 g = *(const f32x4*)(p.g_k + d); v = v * g;
                        u32x2 w; w.x = pk2(v.x, v.y); w.y = pk2(v.z, v.w); *(u32x2*)(dst + ((size_t)bg * 256 + c) * 64 + d) = w; }
                    else { bf16_t* o = dst + ((size_t)bg * 64 + d) * 256 + c; o[0] = f2bf(v.x); o[256] = f2bf(v.y); o[512] = f2bf(v.z); o[768] = f2bf(v.w); } } }
        }
    } };
DEV void phase_cmp_b(const Params& p, unsigned char* lds) {
    const int vb = vblock(), G = gridDim.x;
    for (int u = vb; u < 64; u += G) {
        const int z = u >> 5, rbase = (u & 31) * 128;
        ARows al{(const bf16_t*)(p.ws + WS_HID) + ((size_t)z * 4096 + rbase) * 256, 256};
        BClamp64 bl{(const bf16_t*)(p.ws + WS_CW2T) + (size_t)z * 64 * 256, 256};
        EpiCmpB ep{p, z, rbase};
        gemm_tile(lds, al, bl, 256 / 64, ep);
    }
}

constexpr int CM_K = 0, CM_V = 32768, CM_VSTR = 520, CM_IMP = CM_V + 64 * CM_VSTR, CM_LDS = CM_IMP + 4 * 16384 + 1024;
DEV void cm_scores(const unsigned char* kbase, int kt, const bf16x8 (&qf)[4], int r31, int hh, f32x16 (&sacc)[2]) {
#pragma unroll
    for (int kt2 = 0; kt2 < 2; ++kt2) {
#pragma unroll
        for (int i = 0; i < 16; ++i) sacc[kt2][i] = 0.f;
        const int row = 64 * kt + 32 * kt2 + r31; const int sx = (row >> 1) & 7;
#pragma unroll
        for (int s = 0; s < 4; ++s) { const bf16x8 kf = *(const bf16x8*)(kbase + row * 128 + (((2 * s + hh) ^ sx) << 4));
            sacc[kt2] = __builtin_amdgcn_mfma_f32_32x32x16_bf16(kf, qf[s], sacc[kt2], 0, 0, 0); }
    }
}
DEV void phase_cmp_attn(const Params& p, unsigned char* lds) {
    const int tid = threadIdx.x, lane = tid & 63, wid = tid >> 6;
    const int vb = vblock(), G = gridDim.x;
    unsigned char* ws = p.ws;
    const int r31 = lane & 31, hh = lane >> 5;
    float* impl = (float*)(lds + CM_IMP);
    for (int it = vb; it < 1024; it += G) {
        int ci, bg;
        if (G == 256) { const int x = vb >> 5, jb = vb & 31, rnd = it / G, i = rnd * 32 + ((rnd & 1) ? 31 - jb : jb); ci = 63 - (i >> 1); bg = 2 * x + (i & 1); }
        else { ci = 63 - (it >> 4); bg = it & 15; }
        const int b = bg >> 1, g = bg & 1;
        const int nvis = min(NC, 4 * ci + 3), ntile = (nvis + 63) >> 6;
        const int head = g * 4 + (wid >> 1);
        const int tokl = (wid & 1) * 32 + r31, t = ci * 64 + tokl;
        const size_t tok = (size_t)b * SEQ + t;
        const int nv = t >= 31 ? min(NC, (t - 31) / 16 + 1) : 0;
        const float gate_c = ((const float*)(ws + WS_GATES))[tok * 24 + head * 3 + 0];
        __syncthreads();
        {
            const bf16_t* kc = (const bf16_t*)(ws + WS_KCMP) + (size_t)bg * 256 * 64; const bf16_t* vt = (const bf16_t*)(ws + WS_VCMP) + (size_t)bg * 64 * 256;
            const int cpr = ntile * 8;
            u32x4 rk[4], rv[4];
#pragma unroll
            for (int i = 0; i < 4; ++i) if (i < ntile) { const int idx = tid + NT * i; rk[i] = *(const u32x4*)(kc + (idx >> 3) * 64 + (idx & 7) * 8); const int d = idx / cpr, ck = idx % cpr; rv[i] = *(const u32x4*)(vt + d * 256 + ck * 8); }
#pragma unroll
            for (int i = 0; i < 4; ++i) if (i < ntile) { const int idx = tid + NT * i; *(u32x4*)(lds + CM_K + swz(idx >> 3, idx & 7)) = rk[i];
                const int d = idx / cpr, ck = idx % cpr; u32x2 a, c2; a.x = rv[i].x; a.y = rv[i].y; c2.x = rv[i].z; c2.y = rv[i].w; unsigned char* o = lds + CM_V + d * CM_VSTR + ck * 16; *(u32x2*)o = a; *(u32x2*)(o + 8) = c2; }
        }
        bf16x8 qf[4];
        { const bf16_t* qp = (const bf16_t*)(ws + WS_Q) + ((size_t)(b * 8 + head) * SEQ + t) * 64 + 8 * hh;
#pragma unroll
            for (int s = 0; s < 4; ++s) qf[s] = *(const bf16x8*)(qp + 16 * s); }
        __syncthreads();
        float l_run = 0.f;
        f32x16 ot[2];
#pragma unroll
        for (int dt = 0; dt < 2; ++dt)
#pragma unroll
            for (int i = 0; i < 16; ++i) ot[dt][i] = 0.f;
        float carry = 0.f;
#pragma unroll
        for (int kt = 0; kt < 4; ++kt) if (kt < ntile) {
            f32x16 sacc[2];
            cm_scores(lds + CM_K, kt, qf, r31, hh, sacc);
#pragma unroll
            for (int kt2 = 0; kt2 < 2; ++kt2)
#pragma unroll
                for (int i = 0; i < 16; ++i) { const int c = 64 * kt + 32 * kt2 + (i & 3) + 8 * (i >> 2) + 4 * hh; const float e_ = (c < nv) ? __builtin_amdgcn_exp2f(sacc[kt2][i]) : 0.f; sacc[kt2][i] = e_; l_run += e_; }
            {
                float own[8], xs[8];
#pragma unroll
                for (int kt2 = 0; kt2 < 2; ++kt2)
#pragma unroll
                    for (int g4 = 0; g4 < 4; ++g4) { const float e3 = 0.5f * sacc[kt2][4 * g4 + 3];
                        own[4 * kt2 + g4] = (sacc[kt2][4 * g4] + sacc[kt2][4 * g4 + 1]) + (sacc[kt2][4 * g4 + 2] + e3); xs[4 * kt2 + g4] = __shfl_xor(e3, 32); }
                float* io = impl + (wid >> 1) * 4096 + tokl * 64 + 16 * kt + hh;
#pragma unroll
                for (int gi = 0; gi < 8; ++gi) io[2 * gi] = own[gi] + (hh ? xs[gi] : (gi > 0 ? xs[gi > 0 ? gi - 1 : 0] : carry));
                carry = xs[7];
            }
#pragma unroll
            for (int kt2 = 0; kt2 < 2; ++kt2)
#pragma unroll
                for (int s2 = 0; s2 < 2; ++s2) {
                    bf16x8 pf; { u32x4 w; w.x = pk2(sacc[kt2][8 * s2 + 0], sacc[kt2][8 * s2 + 1]); w.y = pk2(sacc[kt2][8 * s2 + 2], sacc[kt2][8 * s2 + 3]);
                        w.z = pk2(sacc[kt2][8 * s2 + 4], sacc[kt2][8 * s2 + 5]); w.w = pk2(sacc[kt2][8 * s2 + 6], sacc[kt2][8 * s2 + 7]); pf = __builtin_bit_cast(bf16x8, w); }
#pragma unroll
                    for (int dt = 0; dt < 2; ++dt) {
                        const unsigned char* va = lds + CM_V + (32 * dt + r31) * CM_VSTR + (64 * kt + 32 * kt2 + 16 * s2 + 4 * hh) * 2;
                        const u32x2 lo = *(const u32x2*)(va), hi = *(const u32x2*)(va + 16);
                        u32x4 w; w.x = lo.x; w.y = lo.y; w.z = hi.x; w.w = hi.y;
                        ot[dt] = __builtin_amdgcn_mfma_f32_32x32x16_bf16(__builtin_bit_cast(bf16x8, w), pf, ot[dt], 0, 0, 0);
                    }
                }
        }
        float invL; { const float L = l_run + __shfl_xor(l_run, 32); invL = L > 0.f ? 1.f / L : 0.f; }
        if (hh == 0) impl[16384 + (wid >> 1) * 64 + tokl] = invL;
        {
            const float sc = gate_c * invL;
            bf16_t* ocp = (bf16_t*)(ws + WS_OC) + tok * 512 + head * 64;
#pragma unroll
            for (int dt = 0; dt < 2; ++dt)
#pragma unroll
                for (int g4 = 0; g4 < 4; ++g4) { const int d0 = 32 * dt + 8 * g4 + 4 * hh;
                    u32x2 w; w.x = pk2(ot[dt][4 * g4 + 0] * sc, ot[dt][4 * g4 + 1] * sc); w.y = pk2(ot[dt][4 * g4 + 2] * sc, ot[dt][4 * g4 + 3] * sc); *(u32x2*)(ocp + d0) = w; }
        }
        __syncthreads();
        for (int tt = 0; tt < 8; ++tt) {
            const int tl = wid * 8 + tt, cur = ci;
            unsigned long long mask;
            if (cur < 16) mask = (2ull << cur) - 1ull;
            else {
                const bool valid = lane <= cur;
                const float imp = (impl[tl * 64 + lane] * impl[16384 + tl] + impl[4096 + tl * 64 + lane] * impl[16384 + 64 + tl]) + (impl[8192 + tl * 64 + lane] * impl[16384 + 128 + tl] + impl[12288 + tl * 64 + lane] * impl[16384 + 192 + tl]);
                const unsigned key = (lane == 0 || lane == cur) ? 0x7F800000u : __float_as_uint(imp);
                unsigned T = 0u;
                for (int bit = 30; bit >= 0; --bit) { const unsigned cand = T | (1u << bit); if (__popcll(__ballot(valid && key >= cand)) >= 16) T = cand; }
                const unsigned long long gt = __ballot(valid && key > T), eq = __ballot(valid && key == T);
                const int need = 16 - __popcll(gt);
                const int below = __popcll(eq & ((1ull << lane) - 1ull));
                mask = gt | __ballot(valid && key == T && below < need);
            }
            if (lane == 0) ((unsigned long long*)(ws + WS_SELM))[(size_t)bg * SEQ + ci * 64 + tl] = mask;
        }
    }
}

constexpr int FA_KB = 64 * 128, FA_VB = 64 * 136, FA_STAGE = FA_KB + FA_VB, FA_LDS = 2 * FA_STAGE + 1024;
template <bool SEL>
DEV void fa_branch(unsigned char* lds, const bf16_t* Kb, const bf16_t* VTb, int ci, int bg, const bf16x8 (&qf)[4], int t, unsigned long long mymask, unsigned long long need,
                   f32x16 (&ot)[2], float& m_run, float& l_run) {
    const int tid = threadIdx.x, lane = tid & 63;
    const int r31 = lane & 31, hh = lane >> 5;
    const int lrow = tid >> 3, lch = tid & 7;
    const bf16_t* kg = Kb + ((size_t)bg * SEQ + lrow) * 64 + lch * 8;
    const bf16_t* vg = VTb + ((size_t)bg * 64 + lrow) * SEQ + lch * 8;
    const int koff = lrow * 128 + ((lch ^ ((lrow >> 1) & 7)) << 4), voff = FA_KB + lrow * 136 + lch * 16;
    int jlo, jhi; unsigned long long todo;
    if (SEL) { todo = need; jlo = 0; jhi = ci; } else { jlo = ci >= 8 ? ci - 8 : 0; jhi = ci; todo = 0; }
    int j = jlo;
    if (SEL) { if (todo == 0) return; j = __builtin_ctzll(todo); todo &= todo - 1; }
    u32x4 rk = *(const u32x4*)(kg + (size_t)j * 64 * 64), rv = *(const u32x4*)(vg + (size_t)j * 64);
    __syncthreads();
    *(u32x4*)(lds + koff) = rk; { u32x2 a, b2; a.x = rv.x; a.y = rv.y; b2.x = rv.z; b2.y = rv.w; *(u32x2*)(lds + voff) = a; *(u32x2*)(lds + voff + 8) = b2; }
    __syncthreads();
    int st = 0; bool seen = false;
    for (;;) {
        int jn; bool more;
        if (SEL) { more = (todo != 0); jn = more ? __builtin_ctzll(todo) : 0; todo &= todo - 1; } else { jn = j + 1; more = (jn <= jhi); }
        if (more) { rk = *(const u32x4*)(kg + (size_t)jn * 64 * 64); rv = *(const u32x4*)(vg + (size_t)jn * 64); }
        const unsigned char* base = lds + st * FA_STAGE;
        const bool bit = SEL ? ((mymask >> j) & 1ull) != 0 : true;
        const float cinit = (SEL && !bit) ? -__builtin_inff() : -m_run;
        f32x16 sacc[2];
#pragma unroll
        for (int kt2 = 0; kt2 < 2; ++kt2) {
#pragma unroll
            for (int i = 0; i < 16; ++i) sacc[kt2][i] = cinit;
            const int row = 32 * kt2 + r31; const int sx = (row >> 1) & 7;
#pragma unroll
            for (int s = 0; s < 4; ++s) { const bf16x8 kf = *(const bf16x8*)(base + row * 128 + (((2 * s + hh) ^ sx) << 4));
                sacc[kt2] = __builtin_amdgcn_mfma_f32_32x32x16_bf16(kf, qf[s], sacc[kt2], 0, 0, 0); }
        }
        const bool boundary = SEL ? (j == ci) : (j == ci || j + 8 <= ci);
        float mx = -__builtin_inff();
        if (boundary) {
#pragma unroll
            for (int kt2 = 0; kt2 < 2; ++kt2)
#pragma unroll
                for (int i = 0; i < 16; ++i) { const int key = 64 * j + 32 * kt2 + (i & 3) + 8 * (i >> 2) + 4 * hh;
                    const bool ok = SEL ? (key <= t) : (key <= t && t - key < 512);
                    const float v = ok ? sacc[kt2][i] : -__builtin_inff(); sacc[kt2][i] = v; mx = fmaxf(mx, v); }
        } else {
#pragma unroll
            for (int kt2 = 0; kt2 < 2; ++kt2)
#pragma unroll
                for (int i = 0; i < 16; ++i) mx = fmaxf(mx, sacc[kt2][i]);
        }
        mx = fmaxf(mx, __shfl_xor(mx, 32));
        const bool live = mx > -__builtin_inff();
        const bool need = (mx > 8.f) || (!seen && live && mx < -8.f);
        if (__any(need)) {
            const float d = need ? mx : 0.f;
            const float alpha = d > 0.f ? __builtin_amdgcn_exp2f(-d) : 1.f;
            m_run += d; l_run *= alpha;
#pragma unroll
            for (int dt = 0; dt < 2; ++dt)
#pragma unroll
                for (int i = 0; i < 16; ++i) ot[dt][i] *= alpha;
#pragma unroll
            for (int kt2 = 0; kt2 < 2; ++kt2)
#pragma unroll
                for (int i = 0; i < 16; ++i) sacc[kt2][i] -= d;
        }
        seen = seen || live;
        float rs = 0.f;
#pragma unroll
        for (int kt2 = 0; kt2 < 2; ++kt2)
#pragma unroll
            for (int i = 0; i < 16; ++i) { const float e = __builtin_amdgcn_exp2f(sacc[kt2][i]); sacc[kt2][i] = e; rs += e; }
        l_run += rs;
#pragma unroll
        for (int kt2 = 0; kt2 < 2; ++kt2)
#pragma unroll
            for (int s2 = 0; s2 < 2; ++s2) {
                bf16x8 pf; { u32x4 w; w.x = pk2(sacc[kt2][8 * s2 + 0], sacc[kt2][8 * s2 + 1]); w.y = pk2(sacc[kt2][8 * s2 + 2], sacc[kt2][8 * s2 + 3]);
                    w.z = pk2(sacc[kt2][8 * s2 + 4], sacc[kt2][8 * s2 + 5]); w.w = pk2(sacc[kt2][8 * s2 + 6], sacc[kt2][8 * s2 + 7]); pf = __builtin_bit_cast(bf16x8, w); }
#pragma unroll
                for (int dt = 0; dt < 2; ++dt) {
                    const unsigned char* va = base + FA_KB + (32 * dt + r31) * 136 + (32 * kt2 + 16 * s2 + 4 * hh) * 2;
                    const u32x2 lo = *(const u32x2*)(va), hi = *(const u32x2*)(va + 16);
                    u32x4 w; w.x = lo.x; w.y = lo.y; w.z = hi.x; w.w = hi.y;
                    ot[dt] = __builtin_amdgcn_mfma_f32_32x32x16_bf16(__builtin_bit_cast(bf16x8, w), pf, ot[dt], 0, 0, 0);
                }
            }
        if (!more) break;
        { unsigned char* nb = lds + (st ^ 1) * FA_STAGE; *(u32x4*)(nb + koff) = rk; u32x2 a, b2; a.x = rv.x; a.y = rv.y; b2.x = rv.z; b2.y = rv.w; *(u32x2*)(nb + voff) = a; *(u32x2*)(nb + voff + 8) = b2; }
        __syncthreads();
        st ^= 1; j = jn;
    }
}
DEV void phase_flash(const Params& p, unsigned char* lds) {
    const int tid = threadIdx.x, lane = tid & 63, wid = tid >> 6;
    const int vb = vblock(), G = gridDim.x;
    unsigned char* ws = p.ws;
    const int r31 = lane & 31, hh = lane >> 5;
    unsigned long long* red = (unsigned long long*)(lds + 2 * FA_STAGE);
    for (int it = vb; it < 1024; it += G) {
        int ci, bg;
        if (G == 256) { const int x = vb >> 5, jb = vb & 31, rnd = it / G, i = rnd * 32 + ((rnd & 1) ? 31 - jb : jb); ci = 63 - (i >> 1); bg = 2 * x + (i & 1); }
        else { ci = 63 - (it >> 4); bg = it & 15; }
        const int b = bg >> 1, g = bg & 1;
        const int head = g * 4 + (wid >> 1);
        const int t = ci * 64 + (wid & 1) * 32 + r31;
        const size_t tok = (size_t)b * SEQ + t;
        bf16x8 qf[4];
        { const bf16_t* qp = (const bf16_t*)(ws + WS_Q) + ((size_t)(b * 8 + head) * SEQ + t) * 64 + 8 * hh;
#pragma unroll
            for (int s = 0; s < 4; ++s) qf[s] = *(const bf16x8*)(qp + 16 * s); }
        const unsigned long long mymask = ((const unsigned long long*)(ws + WS_SELM))[(size_t)bg * SEQ + t];
        const float gate_s = ((const float*)(ws + WS_GATES))[tok * 24 + head * 3 + 1], gate_w = ((const float*)(ws + WS_GATES))[tok * 24 + head * 3 + 2];
        u32x2 ocv[2][4];
#pragma unroll
        for (int dt = 0; dt < 2; ++dt)
#pragma unroll
            for (int g4 = 0; g4 < 4; ++g4) ocv[dt][g4] = *(const u32x2*)((const bf16_t*)(ws + WS_OC) + tok * 512 + head * 64 + 32 * dt + 8 * g4 + 4 * hh);
        unsigned long long orm = mymask;
#pragma unroll
        for (int o = 1; o < 32; o <<= 1) { const unsigned lo = __shfl_xor((unsigned)orm, o), hi = __shfl_xor((unsigned)(orm >> 32), o); orm |= ((unsigned long long)hi << 32) | lo; }
        __syncthreads();
        if (wid < 2 && lane == 0) red[wid] = orm;
        __syncthreads();
        const unsigned long long need = red[0] | red[1];
        f32x16 oc[2];
        {
            f32x16 ot[2]; float m_run = 0.f, l_run = 0.f;
#pragma unroll
            for (int dt = 0; dt < 2; ++dt)
#pragma unroll
                for (int i = 0; i < 16; ++i) ot[dt][i] = 0.f;
            fa_branch<true>(lds, (const bf16_t*)(ws + WS_KS), (const bf16_t*)(ws + WS_VST), ci, bg, qf, t, mymask, need, ot, m_run, l_run);
            const float lt = l_run + __shfl_xor(l_run, 32);
            const float sc = gate_s / lt;
#pragma unroll
            for (int dt = 0; dt < 2; ++dt)
#pragma unroll
                for (int i = 0; i < 16; ++i) oc[dt][i] = ot[dt][i] * sc;
        }
        {
            f32x16 ot[2]; float m_run = 0.f, l_run = 0.f;
#pragma unroll
            for (int dt = 0; dt < 2; ++dt)
#pragma unroll
                for (int i = 0; i < 16; ++i) ot[dt][i] = 0.f;
            fa_branch<false>(lds, (const bf16_t*)(ws + WS_KW), (const bf16_t*)(ws + WS_VWT), ci, bg, qf, t, 0ull, 0ull, ot, m_run, l_run);
            const float lt = l_run + __shfl_xor(l_run, 32);
            const float sc = gate_w / lt;
#pragma unroll
            for (int dt = 0; dt < 2; ++dt)
#pragma unroll
                for (int i = 0; i < 16; ++i) oc[dt][i] += ot[dt][i] * sc;
        }
        {
            bf16_t* mix = (bf16_t*)(ws + WS_R1) + tok * 1024 + head * 64;
            float ss = 0.f;
#pragma unroll
            for (int dt = 0; dt < 2; ++dt)
#pragma unroll
                for (int g4 = 0; g4 < 4; ++g4) { const int d0 = 32 * dt + 8 * g4 + 4 * hh; const u32x2 c = ocv[dt][g4];
                    const float v0 = oc[dt][4 * g4 + 0] + bflo(c.x), v1 = oc[dt][4 * g4 + 1] + bfhi(c.x), v2 = oc[dt][4 * g4 + 2] + bflo(c.y), v3 = oc[dt][4 * g4 + 3] + bfhi(c.y);
                    ss += (v0 * v0 + v1 * v1) + (v2 * v2 + v3 * v3);
                    u32x2 w; w.x = pk2(v0, v1); w.y = pk2(v2, v3); *(u32x2*)(mix + d0) = w; }
            ss += __shfl_xor(ss, 32);
            if (hh == 0) atomicAdd((float*)(ws + WS_ROWSS) + tok, ss);
        }
    }
}

DEV int swz256(int row, int chunk) { return row * 256 + ((chunk ^ (row & 15)) << 4); }
DEV void hgrn_cumsum(const Params& p, int bh, int c, float* segs, f32x2 (&lf)[8], f32x2 (&a)[8], f32x2& r, f32x2& alast) {
    const int tid = threadIdx.x, k2 = tid & 63, tq = tid >> 6;
    const int b = bh >> 2, h = bh & 3;
    const bf16_t* HL = (const bf16_t*)(p.ws + WS_HLOGF) + ((size_t)b * SEQ + c * 64 + tq * 8) * 512 + h * 128 + 2 * k2;
#pragma unroll
    for (int i = 0; i < 8; ++i) { const unsigned w = *(const unsigned*)(HL + (size_t)i * 512); lf[i] = (f32x2){bflo(w), bfhi(w)}; }
    f32x2 run = (f32x2){0.f, 0.f};
#pragma unroll
    for (int i = 0; i < 8; ++i) { run = run + lf[i]; a[i] = run; }
    *(f32x2*)(segs + tq * 128 + 2 * k2) = run;
    __syncthreads();
    f32x2 off = (f32x2){0.f, 0.f}, tot = off, rr = off;
#pragma unroll
    for (int q = 0; q < 8; ++q) { const f32x2 s = *(const f32x2*)(segs + q * 128 + 2 * k2); if (q < tq) off = off + s; if (q < 4) rr = rr + s; tot = tot + s; }
#pragma unroll
    for (int i = 0; i < 8; ++i) a[i] = a[i] + off;
    r = rr; alast = tot;
}
DEV void hgrn_stage_vt(const Params& p, int bh, int c, unsigned char* vt) {
    const int tid = threadIdx.x, k2 = tid & 63, tq = tid >> 6;
    const int b = bh >> 2, h = bh & 3;
    const bf16_t* HV = (const bf16_t*)(p.ws + WS_HV) + ((size_t)b * SEQ + c * 64 + tq * 8) * 512 + h * 128 + 2 * k2;
    unsigned vv[8];
#pragma unroll
    for (int i = 0; i < 8; ++i) vv[i] = *(const unsigned*)(HV + (size_t)i * 512);
    u32x4 lo, hi;
    lo.x = (vv[0] & 0xffffu) | (vv[1] << 16); lo.y = (vv[2] & 0xffffu) | (vv[3] << 16); lo.z = (vv[4] & 0xffffu) | (vv[5] << 16); lo.w = (vv[6] & 0xffffu) | (vv[7] << 16);
    hi.x = (vv[0] >> 16) | (vv[1] & 0xffff0000u); hi.y = (vv[2] >> 16) | (vv[3] & 0xffff0000u); hi.z = (vv[4] >> 16) | (vv[5] & 0xffff0000u); hi.w = (vv[6] >> 16) | (vv[7] & 0xffff0000u);
    *(u32x4*)(vt + swz(2 * k2, tq)) = lo; *(u32x4*)(vt + swz(2 * k2 + 1, tq)) = hi;
}
constexpr int H1_KT = 0, H1_VT = 16384, H1_SEG = 32768, H1_EK = H1_SEG + 4096;
DEV void phase_hgrn_a1(const Params& p, unsigned char* lds, int vb0, int nb) {
    const int tid = threadIdx.x, lane = tid & 63, wid = tid >> 6, k2 = tid & 63, tq = tid >> 6;
    const int vb = vblock(), G = gridDim.x;
    const int frow = lane & 15, fq = lane >> 4, wr = wid >> 1, wc = wid & 1;
    float* segs = (float*)(lds + H1_SEG); float* ek = (float*)(lds + H1_EK);
    bf16_t* ubuf = (bf16_t*)(p.ws + WS_UBUF); float* dbuf = (float*)(p.ws + WS_DBUF);
    if (vb < vb0) return;
    for (int item = vb - vb0; item < 2048; item += nb) {
        const int bh = item >> 6, c = item & 63;
        __syncthreads();
        f32x2 lf[8], a[8], r, al;
        hgrn_cumsum(p, bh, c, segs, lf, a, r, al);
        {
            float kx[8], ky[8];
#pragma unroll
            for (int i = 0; i < 8; ++i) { kx[i] = (1.f - __expf(lf[i].x)) * __expf(fminf(r.x - a[i].x, 80.f)); ky[i] = (1.f - __expf(lf[i].y)) * __expf(fminf(r.y - a[i].y, 80.f)); }
            u32x4 w0, w1;
            w0.x = pk2(kx[0], kx[1]); w0.y = pk2(kx[2], kx[3]); w0.z = pk2(kx[4], kx[5]); w0.w = pk2(kx[6], kx[7]);
            w1.x = pk2(ky[0], ky[1]); w1.y = pk2(ky[2], ky[3]); w1.z = pk2(ky[4], ky[5]); w1.w = pk2(ky[6], ky[7]);
            *(u32x4*)(lds + H1_KT + swz(2 * k2, tq)) = w0; *(u32x4*)(lds + H1_KT + swz(2 * k2 + 1, tq)) = w1;
        }
        hgrn_stage_vt(p, bh, c, lds + H1_VT);
        if (tq == 7) { ek[2 * k2] = __expf(al.x - r.x); ek[2 * k2 + 1] = __expf(al.y - r.y); f32x2 d; d.x = __expf(al.x); d.y = __expf(al.y); *(f32x2*)(dbuf + (size_t)item * 128 + 2 * k2) = d; }
        __syncthreads();
        f32x4 acc[2][4];
#pragma unroll
        for (int m = 0; m < 2; ++m)
#pragma unroll
            for (int n = 0; n < 4; ++n) acc[m][n] = (f32x4){0.f, 0.f, 0.f, 0.f};
        const int sx = (frow >> 1) & 7;
#pragma unroll
        for (int ks = 0; ks < 2; ++ks) {
            const int co = ((ks * 4 + fq) ^ sx) << 4;
            bf16x8 af[2], bfr[4];
#pragma unroll
            for (int m = 0; m < 2; ++m) af[m] = *(const bf16x8*)(lds + H1_VT + (32 * wr + 16 * m + frow) * 128 + co);
#pragma unroll
            for (int n = 0; n < 4; ++n) bfr[n] = *(const bf16x8*)(lds + H1_KT + (64 * wc + 16 * n + frow) * 128 + co);
#pragma unroll
            for (int m = 0; m < 2; ++m)
#pragma unroll
                for (int n = 0; n < 4; ++n) acc[m][n] = __builtin_amdgcn_mfma_f32_16x16x32_bf16(bfr[n], af[m], acc[m][n], 0, 0, 0);
        }
#pragma unroll
        for (int m = 0; m < 2; ++m) { const int v = 32 * wr + 16 * m + frow;
#pragma unroll
            for (int n = 0; n < 4; ++n) { const int k0 = 64 * wc + 16 * n + 4 * fq; const f32x4 e = *(const f32x4*)(ek + k0); const f32x4 o = acc[m][n] * e;
                u32x2 w; w.x = pk2(o.x, o.y); w.y = pk2(o.z, o.w); *(u32x2*)(ubuf + ((size_t)item * 128 + v) * 128 + k0) = w; } }
    }
}
DEV void phase_hgrn_a2(const Params& p, unsigned char* lds) {
    const int G = gridDim.x;
    bf16_t* ubuf = (bf16_t*)(p.ws + WS_UBUF); const float* dbuf = (const float*)(p.ws + WS_DBUF);
    for (int gid = blockIdx.x * NT + threadIdx.x; gid < 131072; gid += G * NT) {
        const int bh = gid >> 12, v = (gid >> 5) & 127, k4 = gid & 31;
        bf16_t* u = ubuf + ((size_t)bh * 64 * 128 + v) * 128 + 4 * k4;
        const float* d = dbuf + (size_t)bh * 64 * 128 + 4 * k4;
        f32x4 S = (f32x4){0.f, 0.f, 0.f, 0.f};
        for (int c0 = 0; c0 < 64; c0 += 8) {
            u32x2 uu[8]; f32x4 dd[8];
#pragma unroll
            for (int j = 0; j < 8; ++j) { uu[j] = *(const u32x2*)(u + (size_t)(c0 + j) * 16384); dd[j] = *(const f32x4*)(d + (size_t)(c0 + j) * 128); }
#pragma unroll
            for (int j = 0; j < 8; ++j) { u32x2 w; w.x = pk2(S.x, S.y); w.y = pk2(S.z, S.w); *(u32x2*)(u + (size_t)(c0 + j) * 16384) = w;
                S.x = dd[j].x * S.x + bflo(uu[j].x); S.y = dd[j].y * S.y + bfhi(uu[j].x); S.z = dd[j].z * S.z + bflo(uu[j].y); S.w = dd[j].w * S.w + bfhi(uu[j].y); }
        }
    }
}
constexpr int H3_QH = 0, H3_QA = 16384, H3_KH = 32768, H3_VT = 49152, H3_PP = 65536, H3_ST = 73728, H3_SEG = 106496, H3_RED = 110592;
DEV void phase_hgrn_a3(const Params& p, unsigned char* lds) {
    const int tid = threadIdx.x, lane = tid & 63, wid = tid >> 6, k2 = tid & 63, tq = tid >> 6;
    const int vb = vblock(), G = gridDim.x;
    const int frow = lane & 15, fq = lane >> 4;
    float* segs = (float*)(lds + H3_SEG); float* red = (float*)(lds + H3_RED);
    const bf16_t* ubuf = (const bf16_t*)(p.ws + WS_UBUF);
    for (int item = vb; item < 2048; item += G) {
        const int bh = item >> 6, c = item & 63, b = bh >> 2, h = bh & 3;
        __syncthreads();
        f32x2 lf[8], a[8], r, al;
        hgrn_cumsum(p, bh, c, segs, lf, a, r, al);
        {
            const bf16_t* HQ = (const bf16_t*)(p.ws + WS_HQ) + ((size_t)b * SEQ + c * 64 + tq * 8) * 512 + h * 128 + 2 * k2;
            unsigned qq[8];
#pragma unroll
            for (int i = 0; i < 8; ++i) qq[i] = *(const unsigned*)(HQ + (size_t)i * 512);
#pragma unroll
            for (int i = 0; i < 8; ++i) { const int t = 8 * tq + i; const float q0 = bflo(qq[i]), q1 = bfhi(qq[i]);
                const int off = swz256(t, k2 >> 2) + (k2 & 3) * 4;
                *(unsigned*)(lds + H3_QH + off) = pk2(q0 * __expf(fminf(a[i].x - r.x, 80.f)), q1 * __expf(fminf(a[i].y - r.y, 80.f)));
                *(unsigned*)(lds + H3_QA + off) = pk2(q0 * __expf(a[i].x), q1 * __expf(a[i].y));
                *(unsigned*)(lds + H3_KH + off) = pk2((1.f - __expf(lf[i].x)) * __expf(fminf(r.x - a[i].x, 80.f)), (1.f - __expf(lf[i].y)) * __expf(fminf(r.y - a[i].y, 80.f))); }
        }
        hgrn_stage_vt(p, bh, c, lds + H3_VT);
        {
            const bf16_t* st = ubuf + (size_t)item * 16384;
#pragma unroll
            for (int i = 0; i < 4; ++i) { const int q = tid + NT * i, v = q >> 4, ch = q & 15; *(u32x4*)(lds + H3_ST + swz256(v, ch)) = *(const u32x4*)(st + v * 128 + ch * 8); }
        }
        __syncthreads();
        {
            const int wr = wid >> 1, wc = wid & 1;
            f32x4 acc[2];
            acc[0] = (f32x4){0.f, 0.f, 0.f, 0.f}; acc[1] = acc[0];
            if (32 * wc <= 16 * wr + 15) {
#pragma unroll
                for (int ks = 0; ks < 4; ++ks) {
                    const int co = ((ks * 4 + fq) ^ frow) << 4;
                    const bf16x8 af = *(const bf16x8*)(lds + H3_QH + (16 * wr + frow) * 256 + co);
#pragma unroll
                    for (int n = 0; n < 2; ++n) { const bf16x8 bfr = *(const bf16x8*)(lds + H3_KH + (32 * wc + 16 * n + frow) * 256 + co);
                        acc[n] = __builtin_amdgcn_mfma_f32_16x16x32_bf16(bfr, af, acc[n], 0, 0, 0); }
                }
            }
            const int t = 16 * wr + frow;
#pragma unroll
            for (int n = 0; n < 2; ++n) { const int s0 = 32 * wc + 16 * n + 4 * fq; f32x4 v = acc[n];
                v.x = (s0 + 0 <= t) ? v.x : 0.f; v.y = (s0 + 1 <= t) ? v.y : 0.f; v.z = (s0 + 2 <= t) ? v.z : 0.f; v.w = (s0 + 3 <= t) ? v.w : 0.f;
                u32x2 w; w.x = pk2(v.x, v.y); w.y = pk2(v.z, v.w);
                *(u32x2*)(lds + H3_PP + t * 128 + ((((s0 >> 3)) ^ ((t >> 1) & 7)) << 4) + (s0 & 7) * 2) = w; }
        }
        __syncthreads();
        {
            const int wr = wid >> 2, wc = wid & 3;
            f32x4 acc[2][2];
#pragma unroll
            for (int m = 0; m < 2; ++m)
#pragma unroll
                for (int n = 0; n < 2; ++n) acc[m][n] = (f32x4){0.f, 0.f, 0.f, 0.f};
            const int sx = (frow >> 1) & 7;
#pragma unroll
            for (int ks = 0; ks < 2; ++ks) {
                const int co = ((ks * 4 + fq) ^ sx) << 4;
                bf16x8 af[2], bfr[2];
#pragma unroll
                for (int m = 0; m < 2; ++m) af[m] = *(const bf16x8*)(lds + H3_PP + (32 * wr + 16 * m + frow) * 128 + co);
#pragma unroll
                for (int n = 0; n < 2; ++n) bfr[n] = *(const bf16x8*)(lds + H3_VT + (32 * wc + 16 * n + frow) * 128 + co);
#pragma unroll
                for (int m = 0; m < 2; ++m)
#pragma unroll
                    for (int n = 0; n < 2; ++n) acc[m][n] = __builtin_amdgcn_mfma_f32_16x16x32_bf16(bfr[n], af[m], acc[m][n], 0, 0, 0);
            }
#pragma unroll
            for (int ks = 0; ks < 4; ++ks) {
                const int co = ((ks * 4 + fq) ^ frow) << 4;
                bf16x8 af[2], bfr[2];
#pragma unroll
                for (int m = 0; m < 2; ++m) af[m] = *(const bf16x8*)(lds + H3_QA + (32 * wr + 16 * m + frow) * 256 + co);
#pragma unroll
                for (int n = 0; n < 2; ++n) bfr[n] = *(const bf16x8*)(lds + H3_ST + (32 * wc + 16 * n + frow) * 256 + co);
#pragma unroll
                for (int m = 0; m < 2; ++m)
#pragma unroll
                    for (int n = 0; n < 2; ++n) acc[m][n] = __builtin_amdgcn_mfma_f32_16x16x32_bf16(bfr[n], af[m], acc[m][n], 0, 0, 0);
            }
            f32x4 gnv[2]; u32x2 ggv[2][2];
#pragma unroll
            for (int n = 0; n < 2; ++n) gnv[n] = *(const f32x4*)(p.g_hn + 32 * wc + 16 * n + 4 * fq);
#pragma unroll
            for (int m = 0; m < 2; ++m)
#pragma unroll
                for (int n = 0; n < 2; ++n) ggv[m][n] = *(const u32x2*)((const bf16_t*)(p.ws + WS_HG) + ((size_t)b * SEQ + c * 64 + 32 * wr + 16 * m + frow) * 512 + h * 128 + 32 * wc + 16 * n + 4 * fq);
#pragma unroll
            for (int m = 0; m < 2; ++m) { float ss = 0.f;
#pragma unroll
                for (int n = 0; n < 2; ++n) { const f32x4 v = acc[m][n]; ss += (v.x * v.x + v.y * v.y) + (v.z * v.z + v.w * v.w); }
                ss += __shfl_xor(ss, 16); ss += __shfl_xor(ss, 32);
                if (fq == 0) red[(32 * wr + 16 * m + frow) * 4 + wc] = ss; }
            __syncthreads();
#pragma unroll
            for (int m = 0; m < 2; ++m) { const int t = 32 * wr + 16 * m + frow; const f32x4 q4 = *(const f32x4*)(red + t * 4);
                const float rs = rsqrtf(((q4.x + q4.y) + (q4.z + q4.w)) * (1.f / 128.f) + RMS_EPS);
                const size_t row = (size_t)b * SEQ + c * 64 + t;
#pragma unroll
                for (int n = 0; n < 2; ++n) { const int v0 = 32 * wc + 16 * n + 4 * fq; const f32x4 gn = gnv[n]; const u32x2 gg = ggv[m][n];
                    const f32x4 o = acc[m][n];
                    u32x2 w; w.x = pk2(o.x * rs * gn.x * bflo(gg.x), o.y * rs * gn.y * bfhi(gg.x)); w.y = pk2(o.z * rs * gn.z * bflo(gg.y), o.w * rs * gn.w * bfhi(gg.y));
                    *(u32x2*)((bf16_t*)(p.ws + WS_R1) + row * 1024 + 512 + h * 128 + v0) = w; } }
        }
    }
}

DEV void phase_normalize(const Params& p, unsigned char* lds) {
    const int vb = vblock(), G = gridDim.x;
    unsigned char* ws = p.ws;
    __syncthreads();
    {
        float* tl = (float*)lds;
        for (int r = vb; r < 32 * 4 * 16; r += G) { const int e = r / 64, q = r % 64; SrcW13_4 s{p.w1 + (size_t)e * 1024 * 512, p.w3 + (size_t)e * 1024 * 512, p.ffn_g};
            convert_tile256(tl, s, (bf16_t*)(ws + WS_W13T) + (size_t)e * 1024 * 1024, 1024, (q / 16) * 256, (q % 16) * 64); }
    }
}

struct EpiOut8 { const Params& p; static constexpr bool MIDSCALE = true;
    DEV float rowscale(int row) const { return rsqrtf(((const float*)(p.ws + WS_ROWSS))[row] * (1.f / 512.f) + RMS_EPS); }
    DEV int midk() const { return 8; }
    DEV void operator()(const f32x4 (&acc)[2][2][4][2], const pg8::Unit& u, int wr, int wc, int fr, int fq) const {
        const size_t off0 = ((size_t)u.pm * 256 + wr * 64 + fr) * DM + u.pn * 256 + 64 * wc + 8 * fq;
        const bf16_t* xb = (const bf16_t*)(p.ws + WS_XB);
        u32x4 xr[2][4][2];
#pragma unroll
        for (int ai = 0; ai < 2; ++ai)
#pragma unroll
            for (int m = 0; m < 4; ++m)
#pragma unroll
                for (int bj = 0; bj < 2; ++bj) xr[ai][m][bj] = *(const u32x4*)(xb + off0 + (size_t)(128 * ai + 16 * m) * DM + 32 * bj);
#pragma unroll
        for (int ai = 0; ai < 2; ++ai)
#pragma unroll
            for (int m = 0; m < 4; ++m)
#pragma unroll
                for (int bj = 0; bj < 2; ++bj) { const u32x4 w = xr[ai][m][bj]; float* o = p.out + off0 + (size_t)(128 * ai + 16 * m) * DM + 32 * bj;
                    *(f32x4*)(o) = (f32x4){bflo(w.x), bfhi(w.x), bflo(w.y), bfhi(w.y)} + acc[ai][bj][m][0]; *(f32x4*)(o + 4) = (f32x4){bflo(w.z), bfhi(w.z), bflo(w.w), bfhi(w.w)} + acc[ai][bj][m][1]; }
    } };
DEV void phase_outproj(const Params& p, unsigned char* lds) {
    pg8::Gemm g{(const bf16_t*)(p.ws + WS_R1), (const bf16_t*)(p.ws + WS_WOUTT), NTOK, DM, DM};
    pg8::StaticOrder S; S.init(NTOK, DM, (int)gridDim.x, (int)blockIdx.x);
    EpiOut8 E{p};
    pg8::gemm_phase((PG8_LAS unsigned char*)lds, g, S, E);
}

constexpr int RT_W = 0, RT_LG = 2 * 49152, RT_RS = RT_LG + 128 * 49 * 4, RT_HIST = RT_RS + 512, RT_BASE = RT_HIST + 1024, RT_LDS = RT_BASE + 1024;
DEV void phase_router(const Params& p, unsigned char* lds) {
    const int tid = threadIdx.x, lane = tid & 63, wid = tid >> 6, frow = lane & 15, fq = lane >> 4;
    const int vb = vblock(), G = gridDim.x;
    unsigned char* ws = p.ws;
    float* lg = (float*)(lds + RT_LG); float* rsd = (float*)(lds + RT_RS);
    int* hist = (int*)(lds + RT_HIST); int* basep = (int*)(lds + RT_BASE);
    const bf16_t* rw = (const bf16_t*)(ws + WS_RW);
    for (int it = vb; it < NTOK / 128; it += G) {
        const size_t row0 = (size_t)it * 128;
        const size_t trow = row0 + 16 * wid + frow;
        const float* hrow = p.out + trow * DM + 8 * fq;
        bf16_t* hbrow = (bf16_t*)(ws + WS_R1) + trow * DM + 8 * fq;
        f32x4 acc[3]; float ss = 0.f;
#pragma unroll
        for (int nt = 0; nt < 3; ++nt) acc[nt] = (f32x4){0.f, 0.f, 0.f, 0.f};
        if (tid < 128) hist[tid] = 0;
        u32x4 wreg[6]; f32x4 xa[4][2], xn[4][2];
#define RT_LOADW(kc_) do { _Pragma("unroll") for (int i = 0; i < 6; ++i) { const int idx = tid + NT * i, r = idx >> 5, c = idx & 31; wreg[i] = *(const u32x4*)(rw + (size_t)r * 1024 + (kc_) * 256 + c * 8); } } while (0)
#define RT_STOREW(buf_) do { _Pragma("unroll") for (int i = 0; i < 6; ++i) { const int idx = tid + NT * i, r = idx >> 5, c = idx & 31; *(u32x4*)(lds + RT_W + (buf_) * 49152 + r * 512 + ((c ^ (r & 15)) << 4)) = wreg[i]; } } while (0)
#define RT_LOADX(dst_, hc_) do { _Pragma("unroll") for (int ks = 0; ks < 4; ++ks) { dst_[ks][0] = *(const f32x4*)(hrow + (hc_) * 128 + 32 * ks); dst_[ks][1] = *(const f32x4*)(hrow + (hc_) * 128 + 32 * ks + 4); } } while (0)
        __syncthreads();
        RT_LOADW(0); RT_LOADX(xa, 0); RT_STOREW(0);
        __syncthreads();
#pragma unroll 1
        for (int hc = 0; hc < 8; ++hc) {
            if (hc < 7) RT_LOADX(xn, hc + 1);
            const unsigned char* wb = lds + RT_W + ((hc >> 1) & 1) * 49152;
#pragma unroll
            for (int ks = 0; ks < 4; ++ks) {
                const f32x4 a = xa[ks][0], b = xa[ks][1];
                ss += ((a.x * a.x + a.y * a.y) + (a.z * a.z + a.w * a.w)) + ((b.x * b.x + b.y * b.y) + (b.z * b.z + b.w * b.w));
                u32x4 hi; hi.x = pk2(a.x, a.y); hi.y = pk2(a.z, a.w); hi.z = pk2(b.x, b.y); hi.w = pk2(b.z, b.w);
                u32x4 lo; lo.x = pk2(a.x - bflo(hi.x), a.y - bfhi(hi.x)); lo.y = pk2(a.z - bflo(hi.y), a.w - bfhi(hi.y)); lo.z = pk2(b.x - bflo(hi.z), b.y - bfhi(hi.z)); lo.w = pk2(b.z - bflo(hi.w), b.w - bfhi(hi.w));
                *(u32x4*)(hbrow + hc * 128 + 32 * ks) = hi;
                const bf16x8 hh = __builtin_bit_cast(bf16x8, hi), hl = __builtin_bit_cast(bf16x8, lo);
                const int co = ((4 * (4 * (hc & 1) + ks) + fq) ^ frow) << 4;
#pragma unroll
                for (int nt = 0; nt < 3; ++nt) {
                    const bf16x8 whi = *(const bf16x8*)(wb + (16 * nt + frow) * 512 + co), wlo = *(const bf16x8*)(wb + (48 + 16 * nt + frow) * 512 + co);
                    acc[nt] = __builtin_amdgcn_mfma_f32_16x16x32_bf16(whi, hh, acc[nt], 0, 0, 0);
                    acc[nt] = __builtin_amdgcn_mfma_f32_16x16x32_bf16(wlo, hh, acc[nt], 0, 0, 0);
                    acc[nt] = __builtin_amdgcn_mfma_f32_16x16x32_bf16(whi, hl, acc[nt], 0, 0, 0);
                }
            }
            if ((hc & 1) == 0 && hc < 6) { RT_LOADW((hc >> 1) + 1); }
            if ((hc & 1) == 1 && hc < 7) { RT_STOREW(((hc >> 1) + 1) & 1); }
#pragma unroll
            for (int ks = 0; ks < 4; ++ks) { xa[ks][0] = xn[ks][0]; xa[ks][1] = xn[ks][1]; }
            if (hc & 1) __syncthreads();
        }
#undef RT_LOADW
#undef RT_STOREW
#undef RT_LOADX
        ss += __shfl_xor(ss, 16); ss += __shfl_xor(ss, 32);
        if (fq == 0) rsd[16 * wid + frow] = rsqrtf(ss * (1.f / DM) + RMS_EPS);
#pragma unroll
        for (int nt = 0; nt < 3; ++nt) { float* o = lg + (16 * wid + frow) * 49 + 16 * nt + 4 * fq; o[0] = acc[nt].x; o[1] = acc[nt].y; o[2] = acc[nt].z; o[3] = acc[nt].w; }
        __syncthreads();
        int bin = 0, slot = 0, ea = 0, eb = 0, sa = 0, sb = 0; float wa = 0.f, wb = 0.f;
        int* ehist = hist + 112; int* ebase = basep + 112;
        if (tid < 32) ehist[tid] = 0;
        __syncthreads();
        if (tid < 128) {
            const float rs = rsd[tid];
            ((float*)(ws + WS_RSTD2))[row0 + tid] = rs;
            float gl[4]; int gi = 0; float gm = -1e30f;
#pragma unroll
            for (int c = 0; c < 4; ++c) { gl[c] = lg[tid * 49 + c] * rs + p.b_group[c]; if (gl[c] > gm) { gm = gl[c]; gi = c; } }
            float gs = 0.f;
#pragma unroll
            for (int c = 0; c < 4; ++c) gs += __expf(gl[c] - gm);
            const float pg = 1.f / gs;
            float el[8]; int i0 = 0; float m0 = -1e30f;
#pragma unroll
            for (int c = 0; c < 8; ++c) { el[c] = lg[tid * 49 + 4 + gi * 8 + c] * rs + p.b_expert[gi * 8 + c]; if (el[c] > m0) { m0 = el[c]; i0 = c; } }
            int i1 = 0; float m1 = -1e30f;
#pragma unroll
            for (int c = 0; c < 8; ++c) if (c != i0 && el[c] > m1) { m1 = el[c]; i1 = c; }
            const float e1 = __expf(m1 - m0); const float w0 = pg / (1.f + e1), w1 = pg * e1 / (1.f + e1);
            const int a = min(i0, i1), bb = max(i0, i1);
            bin = gi * 28 + (7 * a - (a * (a - 1)) / 2) + (bb - a - 1);
            wa = (i0 < i1) ? w0 : w1; wb = (i0 < i1) ? w1 : w0; ea = gi * 8 + a; eb = gi * 8 + bb;
            slot = atomicAdd(&hist[bin], 1);
            sa = atomicAdd(&ehist[ea], 1); sb = atomicAdd(&ehist[eb], 1);
        }
        __syncthreads();
        if (tid < NBIN) { const int h = hist[tid]; basep[tid] = h ? atomicAdd((int*)(ws + WS_CTL) + tid, h) : 0; }
        else if (tid >= 128 && tid < 160) { const int e = tid - 128; const int h = ehist[e]; ebase[e] = h ? atomicAdd((int*)(ws + WS_CTL + 512) + e, h) : 0; }
        __syncthreads();
        if (tid < 128) {
            const int t = (int)(row0 + tid);
            ((int*)(ws + WS_BINL))[(size_t)bin * BINCAP + basep[bin] + slot] = t;
            sa += ebase[ea]; sb += ebase[eb];
            ((int*)(ws + WS_EL))[(size_t)ea * BINCAP + sa] = t; ((float*)(ws + WS_EW))[(size_t)ea * BINCAP + sa] = wa;
            ((int*)(ws + WS_EL))[(size_t)eb * BINCAP + sb] = t; ((float*)(ws + WS_EW))[(size_t)eb * BINCAP + sb] = wb;
            { const unsigned dpos = (unsigned)bin | ((unsigned)(basep[bin] + slot) << 7); ((unsigned*)(ws + WS_EDST))[(size_t)ea * BINCAP + sa] = dpos; ((unsigned*)(ws + WS_EDST))[(size_t)eb * BINCAP + sb] = dpos | (1u << 22); }
        }
        __syncthreads();
    }
}

constexpr int MOE_TS = pg8::STAGE_BYTES, MOE_TT = MOE_TS + 512, MOE_ES = MOE_TT + 1024, MOE_ET = MOE_ES + 256, MOE_OT = MOE_ET + 1280;
DEV int wave_excl_scan(int v, int lane, int& total) {
    int s = v;
#pragma unroll
    for (int o = 1; o < 64; o <<= 1) { const int u = __shfl_up(s, o); if (lane >= o) s += u; }
    total = __shfl(s, 63);
    return s - v;
}
DEV void moe_tiles(const Params& p, unsigned char* lds) {
    int* tstart = (int*)(lds + MOE_TS); int* tiletab = (int*)(lds + MOE_TT); int* etstart = (int*)(lds + MOE_ES); int* etiletab = (int*)(lds + MOE_ET); int* ordtab = (int*)(lds + MOE_OT);
    const int tid = threadIdx.x, lane = tid & 63, wid = tid >> 6;
    __syncthreads();
    if (wid == 0) {
        const int b0 = 2 * lane, b1 = 2 * lane + 1;
        const int c0 = b0 < NBIN ? ((const int*)(p.ws + WS_CTL))[b0] : 0, c1 = b1 < NBIN ? ((const int*)(p.ws + WS_CTL))[b1] : 0;
        const int f0 = c0 >> 8, f1 = c1 >> 8, q0 = (c0 & 255) ? 1 : 0, q1 = (c1 & 255) ? 1 : 0;
        int T, TF, TP;
        const int st = wave_excl_scan(f0 + q0 + f1 + q1, lane, T), sf = wave_excl_scan(f0 + f1, lane, TF), sp = wave_excl_scan(q0 + q1, lane, TP);
        if (b0 < NBIN) { tstart[b0] = st; for (int i = 0; i < f0 + q0; ++i) tiletab[st + i] = b0; for (int i = 0; i < f0; ++i) ordtab[sf + i] = st + i; if (q0) ordtab[TF + sp] = st + f0; }
        if (b1 < NBIN) { const int s1 = st + f0 + q0; tstart[b1] = s1; for (int i = 0; i < f1 + q1; ++i) tiletab[s1 + i] = b1; for (int i = 0; i < f1; ++i) ordtab[sf + f0 + i] = s1 + i; if (q1) ordtab[TF + sp + q0] = s1 + f1; }
        if (lane == 0) tstart[NBIN] = T;
    } else if (wid == 2) {
        const int cn = lane < 32 ? ((const int*)(p.ws + WS_CTL + 512))[lane] : 0; const int t = (cn + 255) >> 8;
        int T; const int s = wave_excl_scan(t, lane, T);
        if (lane < 32) { etstart[lane] = s; for (int i = 0; i < t; ++i) etiletab[s + i] = lane; }
        if (lane == 0) etstart[32] = T;
    }
    __syncthreads();
}
DEV void bin_experts(int bin, int& ea, int& eb) { const int gi = bin / 28; int pi = bin % 28, a = 0; while (pi >= 7 - a) { pi -= 7 - a; ++a; } ea = gi * 8 + a; eb = gi * 8 + a + 1 + pi; }
DEV void lane_rc(int i, int& R, int& C) { pg8::stage_rc((int)threadIdx.x * 16, R, C); R += 64 * i; }
struct MoeUnit { int tile, nt, bin, mt, n; };
struct PolMoe1 {
    typedef MoeUnit Unit;
    const Params& p; const int* etstart; const int* etiletab; int U, G, c;
    struct AddrA { unsigned off[2][2]; };
    struct AddrB { const char* base; };
    DEV int nk() const { return 16; }
    DEV bool next(int i, MoeUnit& u) const {
        const int L = i * G + c; if (L >= U) return false;
        u.tile = L >> 2; u.nt = L & 3;
        u.bin = __builtin_amdgcn_readfirstlane(etiletab[u.tile]);
        u.mt = u.tile - __builtin_amdgcn_readfirstlane(etstart[u.bin]);
        u.n = min(256, ((const int*)(p.ws + WS_CTL + 512))[u.bin] - u.mt * 256);
        return true;
    }
    DEV bool full(const MoeUnit& u) const { return u.n > 128; }
    DEV void addrA(const MoeUnit& u, AddrA& a) const {
        const int* list = (const int*)(p.ws + WS_EL) + (size_t)u.bin * BINCAP + u.mt * 256;
#pragma unroll
        for (int i = 0; i < 2; ++i) { int R, C; lane_rc(i, R, C);
#pragma unroll
            for (int h = 0; h < 2; ++h) { int r = h * 128 + R; if (r >= u.n) r = 0; a.off[h][i] = (unsigned)list[r] * 2048u + (unsigned)C * 2u; } }
    }
    DEV void addrB(const MoeUnit& u, AddrB& b) const { b.base = (const char*)(p.ws + WS_W13T) + ((size_t)u.bin * 1024 + u.nt * 256) * 2048; }
    DEV const char* pa(const AddrA& a, int h, int i, int kt) const { return (const char*)(p.ws + WS_R1) + a.off[h][i] + kt * 128; }
    DEV const char* pb(const AddrB& b, int h, int i, int kt) const { int R, C; lane_rc(i, R, C); return b.base + (size_t)h * (128 * 2048) + (unsigned)(R * 1024 + C) * 2u + kt * 128; }
};
struct EpiMoe1 { const Params& p; const int* tstart;
    DEV void operator()(const f32x4 (&acc)[2][2][4][2], const MoeUnit& u, int wr, int wc, int fr, int fq) const {
        const int* list = (const int*)(p.ws + WS_EL) + (size_t)u.bin * BINCAP + u.mt * 256;
        const float* wl = (const float*)(p.ws + WS_EW) + (size_t)u.bin * BINCAP + u.mt * 256;
        const unsigned* dl = (const unsigned*)(p.ws + WS_EDST) + (size_t)u.bin * BINCAP + u.mt * 256;
        const int r0 = wr * 64 + fr;
        int tk[2][4]; float ww[2][4]; unsigned dd[2][4];
#pragma unroll
        for (int ai = 0; ai < 2; ++ai)
#pragma unroll
            for (int m = 0; m < 4; ++m) { int r = r0 + ai * 128 + m * 16; if (r >= u.n) r = 0; tk[ai][m] = list[r]; ww[ai][m] = wl[r]; dd[ai][m] = dl[r]; }
        float rsv[2][4];
#pragma unroll
        for (int ai = 0; ai < 2; ++ai)
#pragma unroll
            for (int m = 0; m < 4; ++m) rsv[ai][m] = ((const float*)(p.ws + WS_RSTD2))[tk[ai][m]];
        const int f = (u.nt * 256 + 32 * wc + 8 * fq) >> 1;
#pragma unroll
        for (int ai = 0; ai < 2; ++ai)
#pragma unroll
            for (int m = 0; m < 4; ++m) { if (r0 + ai * 128 + m * 16 >= u.n) continue;
                const float rs = rsv[ai][m], w = ww[ai][m]; const unsigned d = dd[ai][m];
                bf16_t* hrow = (bf16_t*)(p.ws + WS_HBUF) + ((size_t)tstart[d & 127u] * 256 + ((d >> 7) & 32767u)) * 1024 + ((d >> 22) & 1u) * 512 + f;
#pragma unroll
                for (int bj = 0; bj < 2; ++bj) { const f32x4 v0 = acc[ai][bj][m][0] * rs, v1 = acc[ai][bj][m][1] * rs;
                    u32x2 w2; w2.x = pk2(siluf_(v0.x) * v0.y * w, siluf_(v0.z) * v0.w * w); w2.y = pk2(siluf_(v1.x) * v1.y * w, siluf_(v1.z) * v1.w * w); *(u32x2*)(hrow + 64 * bj) = w2; } }
    } };
DEV void phase_moe1(const Params& p, unsigned char* lds) {
    moe_tiles(p, lds);
    const int* etstart = (const int*)(lds + MOE_ES);
    PolMoe1 P{p, etstart, (const int*)(lds + MOE_ET), etstart[32] * 4, (int)gridDim.x, vblock()};
    EpiMoe1 E{p, (const int*)(lds + MOE_TS)};
    pg8::gemm_phase2(( PG8_LAS unsigned char*)lds, P, E);
}
struct PolMoe2 {
    typedef MoeUnit Unit;
    const Params& p; const int* tstart; const int* tiletab; const int* ordtab; int U, G, c;
    struct AddrA { const char* base; };
    struct AddrB { const char* ba; const char* bb; };
    DEV int nk() const { return 16; }
    DEV bool next(int i, MoeUnit& u) const {
        const int L = i * G + c; if (L >= U) return false;
        u.tile = __builtin_amdgcn_readfirstlane(ordtab[L >> 2]); u.nt = L & 3;
        u.bin = __builtin_amdgcn_readfirstlane(tiletab[u.tile]);
        u.mt = u.tile - __builtin_amdgcn_readfirstlane(tstart[u.bin]);
        u.n = min(256, ((const int*)(p.ws + WS_CTL))[u.bin] - u.mt * 256);
        return true;
    }
    DEV bool full(const MoeUnit& u) const { return u.n > 128; }
    DEV void addrA(const MoeUnit& u, AddrA& a) const { a.base = (const char*)(p.ws + WS_HBUF) + (size_t)u.tile * 256 * 2048; }
    DEV void addrB(const MoeUnit& u, AddrB& b) const {
        int ea, eb; bin_experts(u.bin, ea, eb);
        b.ba = (const char*)(p.ws + WS_W2T) + ((size_t)ea * 1024 + u.nt * 256) * 1024; b.bb = (const char*)(p.ws + WS_W2T) + ((size_t)eb * 1024 + u.nt * 256) * 1024;
    }
    DEV const char* pa(const AddrA& a, int h, int i, int kt) const { int R, C; lane_rc(i, R, C); return a.base + (size_t)h * (128 * 2048) + (unsigned)(R * 1024 + C) * 2u + kt * 128; }
    DEV const char* pb(const AddrB& b, int h, int i, int kt) const { int R, C; lane_rc(i, R, C); return (kt < 8 ? b.ba + kt * 128 : b.bb + (kt - 8) * 128) + (size_t)h * (128 * 1024) + (unsigned)(R * 512 + C) * 2u; }
};
struct EpiMoe2 { const Params& p;
    DEV void operator()(const f32x4 (&acc)[2][2][4][2], const MoeUnit& u, int wr, int wc, int fr, int fq) const {
        const int* list = (const int*)(p.ws + WS_BINL) + (size_t)u.bin * BINCAP + u.mt * 256;
        const int r0 = wr * 64 + fr;
        int tk[2][4];
#pragma unroll
        for (int ai = 0; ai < 2; ++ai)
#pragma unroll
            for (int m = 0; m < 4; ++m) { int r = r0 + ai * 128 + m * 16; if (r >= u.n) r = 0; tk[ai][m] = list[r]; }
        const int c0 = u.nt * 256 + 32 * wc + 4 * fq;
#pragma unroll
        for (int ai = 0; ai < 2; ++ai)
#pragma unroll
            for (int m = 0; m < 4; ++m) { if (r0 + ai * 128 + m * 16 >= u.n) continue;
                float* o = p.out + (size_t)tk[ai][m] * DM + c0;
                const f32x4 h0 = *(const f32x4*)(o), h1 = *(const f32x4*)(o + 16), h2 = *(const f32x4*)(o + 128), h3 = *(const f32x4*)(o + 144);
                *(f32x4*)(o) = h0 + acc[ai][0][m][0]; *(f32x4*)(o + 16) = h1 + acc[ai][0][m][1]; *(f32x4*)(o + 128) = h2 + acc[ai][1][m][0]; *(f32x4*)(o + 144) = h3 + acc[ai][1][m][1]; }
    } };
DEV void phase_moe2(const Params& p, unsigned char* lds) {
    moe_tiles(p, lds);
    const int* tstart = (const int*)(lds + MOE_TS);
    PolMoe2 P{p, tstart, (const int*)(lds + MOE_TT), (const int*)(lds + MOE_OT), tstart[NBIN] * 4, (int)gridDim.x, vblock()};
    EpiMoe2 E{p};
    pg8::gemm_phase2((PG8_LAS unsigned char*)lds, P, E);
}

#define XB_TMO      128
#define XB_XCNT(j)  (256  + 64 * (j))
#define XB_XSUB(j)  (1280 + 64 * (j))
#define XB_XGEN(j)  (2304 + 64 * (j))
#define XB_TOP      3328
#define XB_TOPGEN   3392
#define XCD_BAR_WORDS 3456
#define XB_SPIN_CAP (1u << 20)
#define LAS __attribute__((address_space(3)))
constexpr size_t WS_BAR = WS_CTL + 4096;
DEV unsigned xb_ld(unsigned* p) { return __hip_atomic_load(p, __ATOMIC_RELAXED, __HIP_MEMORY_SCOPE_AGENT); }
DEV unsigned xb_add(unsigned* p, unsigned v) { return __hip_atomic_fetch_add(p, v, __ATOMIC_RELAXED, __HIP_MEMORY_SCOPE_AGENT); }
DEV unsigned xb_xcc_id() { return (unsigned)__builtin_amdgcn_s_getreg((3 << 11) | 20) & 0xFu; }
#define XB_SPIN(cond, bar) do { unsigned _sp = 0; while (cond) { __builtin_amdgcn_s_sleep(1); \
    if ((++_sp & 255u) == 0u) { if (xb_ld(&(bar)[XB_TMO])) break; if (_sp > XB_SPIN_CAP) { atomicAdd(&(bar)[XB_TMO], 1u); break; } } } } while (0)
struct XcdBarrier { unsigned* bar; unsigned x; volatile LAS unsigned* st; };
DEV XcdBarrier xcd_barrier_post(unsigned* bar, volatile LAS unsigned* st) {
    XcdBarrier b; b.bar = bar; b.x = xb_xcc_id(); b.st = st;
    if (threadIdx.x == 0) (void)xb_add(&bar[XB_XCNT(b.x)], 1u);
    return b;
}
DEV void xcd_barrier_complete(unsigned* bar, unsigned x, unsigned& nloc, unsigned& nx) {
    const unsigned G = gridDim.x * gridDim.y * gridDim.z;
    unsigned sum, cnt, mine, sp = 0u;
    for (;;) {
        sum = 0u; cnt = 0u; mine = 0u;
#pragma unroll
        for (unsigned j = 0; j < 16; ++j) { const unsigned c = xb_ld(&bar[XB_XCNT(j)]); sum += c; cnt += (c > 0u) ? 1u : 0u; mine = (j == x) ? c : mine; }
        if (sum == G) break;
        __builtin_amdgcn_s_sleep(1);
        if ((++sp & 255u) == 0u) { if (xb_ld(&bar[XB_TMO])) break; if (sp > XB_SPIN_CAP) { atomicAdd(&bar[XB_TMO], 1u); break; } }
    }
    nloc = mine > 0u ? mine : 1u; nx = cnt > 0u ? cnt : 1u;
}
DEV void xcd_barrier(const XcdBarrier& b) {
    asm volatile("s_waitcnt vmcnt(0)" ::: "memory");
    __syncthreads();
    if (threadIdx.x == 0) {
        unsigned* bar = b.bar;
        __builtin_amdgcn_s_waitcnt(0);
        unsigned nloc = b.st[0], nx = b.st[1];
        if (nloc == 0u) { xcd_barrier_complete(bar, b.x, nloc, nx); b.st[0] = nloc; b.st[1] = nx; }
        const unsigned old = xb_add(&bar[XB_XSUB(b.x)], 1u);
        const unsigned gen = old / nloc;
        if (old + 1u == (gen + 1u) * nloc) {
            __builtin_amdgcn_fence(__ATOMIC_RELEASE, "agent");
            asm volatile("s_waitcnt vmcnt(0)" ::: "memory");
            const unsigned og = xb_add(&bar[XB_TOP], 1u);
            const unsigned tg = og / nx;
            if (og + 1u == (tg + 1u) * nx) xb_add(&bar[XB_TOPGEN], 1u);
            else XB_SPIN(xb_ld(&bar[XB_TOPGEN]) == tg, bar);
            __builtin_amdgcn_fence(__ATOMIC_ACQUIRE, "agent");
            xb_add(&bar[XB_XGEN(b.x)], 1u);
            asm volatile("s_waitcnt vmcnt(0)" ::: "memory");
        } else {
            XB_SPIN(xb_ld(&bar[XB_XGEN(b.x)]) == gen, bar);
            __builtin_amdgcn_fence(__ATOMIC_ACQUIRE, "agent");
            asm volatile("s_waitcnt vmcnt(0)" ::: "memory");
        }
    }
    __syncthreads();
}

constexpr int LDS_BYTES = 144 * 1024;
constexpr int N_PHASES = 9;
__global__ void __launch_bounds__(NT) mega(Params p, int lo, int hi) {
    extern __shared__ __attribute__((aligned(16))) unsigned char lds[];
    volatile LAS unsigned* xst = (volatile LAS unsigned*)(lds + LDS_BYTES - 16);
    if (threadIdx.x < 4) xst[threadIdx.x] = 0u;
    __syncthreads();
    XcdBarrier xbar; xbar.bar = (unsigned*)(p.ws + WS_BAR); xbar.x = 0; xbar.st = xst;
    if (hi - lo > 1) xbar = xcd_barrier_post((unsigned*)(p.ws + WS_BAR), xst);
#define GRID_SYNC() xcd_barrier(xbar)
#ifndef PROBE_REPEAT
#define PROBE_REPEAT -1
#endif
#define RUN_PHASE(k, call) do { if (lo <= (k) && (k) < hi) { call; \
        if ((k) == PROBE_REPEAT) { GRID_SYNC(); \
            if ((k) == 5) { float* rz = (float*)(p.ws + WS_ROWSS); for (int i = blockIdx.x * NT + threadIdx.x; i < NTOK; i += gridDim.x * NT) rz[i] = 0.f; GRID_SYNC(); } \
            if ((k) == 7) { if (blockIdx.x == 0 && threadIdx.x < 128) ((int*)(p.ws + WS_CTL))[threadIdx.x] = 0; GRID_SYNC(); } \
            call; } \
        if ((k) + 1 < hi) GRID_SYNC(); } } while (0)
    RUN_PHASE(0, phase_prologue(p, lds));
    RUN_PHASE(1, phase_inproj(p, lds));
    RUN_PHASE(2, { phase_cmp_a(p, lds); const int G_ = (int)gridDim.x; if (G_ > 128) phase_hgrn_a1(p, lds, 64, G_ - 64); else phase_hgrn_a1(p, lds, 0, G_); });
    RUN_PHASE(3, { phase_cmp_b(p, lds); phase_hgrn_a2(p, lds); });
    RUN_PHASE(4, { phase_cmp_attn(p, lds); phase_hgrn_a3(p, lds); });
    RUN_PHASE(5, { phase_flash(p, lds); phase_normalize(p, lds); });
    RUN_PHASE(6, phase_outproj(p, lds));
    RUN_PHASE(7, phase_router(p, lds));
    RUN_PHASE(8, phase_moe1(p, lds));
    RUN_PHASE(9, phase_moe2(p, lds));
#undef RUN_PHASE
}

extern "C" void kernel_launch(void* const* d_in, const int* in_sizes, int n_in, void* d_out, int out_size, void* d_ws, size_t ws_size, hipStream_t stream) {
    static int grid = 0;
    if (grid == 0) {
        int dev = 0, cus = 0, per_cu = 0;
        hipGetDevice(&dev);
        hipDeviceGetAttribute(&cus, hipDeviceAttributeMultiprocessorCount, dev);
        hipFuncSetAttribute((const void*)mega, hipFuncAttributeMaxDynamicSharedMemorySize, LDS_BYTES);
        hipOccupancyMaxActiveBlocksPerMultiprocessor(&per_cu, (const void*)mega, NT, LDS_BYTES);
        if (per_cu < 1) per_cu = 1;
        grid = cus;
        if (ws_size < WS_END) fprintf(stderr, "kernel_launch: workspace too small: %zu < %zu\n", ws_size, (size_t)WS_END);
        fprintf(stderr, "kernel_launch: cus %d per_cu %d grid %d ws %zu\n", cus, per_cu, grid, ws_size);
    }
    Params p{};
    const float** pp = (const float**)&p;
    for (int i = 0; i < 23; ++i) pp[i] = (const float*)d_in[i];
    p.out = (float*)d_out; p.ws = (unsigned char*)d_ws;
#if N_LAUNCH_MODE == 1
    (void)hipMemsetAsync((unsigned char*)d_ws + WS_BAR, 0, XCD_BAR_WORDS * 4, stream);
    int lo = 0, hi = N_PHASES + 1;
    void* args[] = {&p, &lo, &hi};
    hipError_t e = hipLaunchCooperativeKernel((const void*)mega, dim3(grid), dim3(NT), args, LDS_BYTES, stream);
    if (e != hipSuccess) fprintf(stderr, "cooperative launch failed: %s\n", hipGetErrorString(e));
#else
    for (int ph = 0; ph <= N_PHASES; ++ph) hipLaunchKernelGGL(mega, dim3(grid), dim3(NT), LDS_BYTES, stream, p, ph, ph + 1);
#endif
}
```

```cpp
#include <hip/hip_runtime.h>
#include <hip/hip_cooperative_groups.h>
#include <cstdio>
#include <cstdint>
#include <cstring>
namespace cg = cooperative_groups;

#ifndef N_LAUNCH_MODE
#define N_LAUNCH_MODE 1
#endif

#define DEV __device__ __forceinline__
typedef unsigned short bf16_t;
typedef short bf16x8 __attribute__((ext_vector_type(8)));
typedef float f32x4 __attribute__((ext_vector_type(4)));
typedef float f32x2 __attribute__((ext_vector_type(2)));
typedef float f32x16 __attribute__((ext_vector_type(16)));
typedef unsigned u32x4 __attribute__((ext_vector_type(4)));
typedef unsigned u32x2 __attribute__((ext_vector_type(2)));

constexpr int NT = 512;
constexpr int BATCH = 8, SEQ = 4096, DM = 1024, NTOK = BATCH * SEQ;
constexpr int IN_COLS = 3352, INP = 3584;
constexpr int NC = 255;
constexpr float RMS_EPS = 1e-6f;
constexpr float QSCALE = 0.125f * 1.4426950408889634f;
constexpr int NBIN = 112;
constexpr int BINCAP = NTOK;

constexpr size_t MiB = 1ull << 20;
constexpr size_t WS_CTL    = 0;
constexpr size_t WS_RSTD1  = 1 * MiB;
constexpr size_t WS_RSTD2  = WS_RSTD1 + 128 * 1024;
constexpr size_t WS_ROWSS  = WS_RSTD2 + 128 * 1024;
constexpr size_t WS_TOKW   = WS_ROWSS + 128 * 1024;
constexpr size_t WS_LB     = WS_TOKW + 256 * 1024;
constexpr size_t WS_CBIAS  = WS_LB + 4096;
constexpr size_t WS_SELM   = 2 * MiB;
constexpr size_t WS_GATES  = 3 * MiB;
constexpr size_t WS_KCMP   = 6 * MiB;
constexpr size_t WS_VCMP   = WS_KCMP + 512 * 1024;
constexpr size_t WS_CW2T   = 7 * MiB;
constexpr size_t WS_RW     = 7 * MiB + 128 * 1024;
constexpr size_t WS_HID    = 8 * MiB;
constexpr size_t WS_CW1T   = 12 * MiB;
constexpr size_t WS_WOUTT  = 14 * MiB;
constexpr size_t WS_WINT   = 16 * MiB;
constexpr size_t WS_R1     = 24 * MiB;
constexpr size_t WS_Q      = 88 * MiB;
constexpr size_t WS_KC     = 120 * MiB;
constexpr size_t WS_VC     = 128 * MiB;
constexpr size_t WS_KS     = 136 * MiB;
constexpr size_t WS_KW     = 144 * MiB;
constexpr size_t WS_VST    = 152 * MiB;
constexpr size_t WS_VWT    = 160 * MiB;
constexpr size_t WS_OC     = 168 * MiB;
constexpr size_t WS_W13T   = 200 * MiB;
constexpr size_t WS_W2T    = 264 * MiB;
constexpr size_t WS_HQ     = 296 * MiB;
constexpr size_t WS_HV     = 328 * MiB;
constexpr size_t WS_HG     = 360 * MiB;
constexpr size_t WS_HLOGF  = 392 * MiB;
constexpr size_t WS_XB     = 424 * MiB;
constexpr size_t WS_DBUF   = 488 * MiB;
constexpr size_t WS_END    = 489 * MiB;
constexpr size_t WS_UBUF   = WS_W13T;
constexpr size_t WS_BINL   = WS_HQ;
constexpr size_t WS_HBUF   = WS_HQ + 16 * MiB;
constexpr size_t WS_EL     = WS_HQ + 136 * MiB;
constexpr size_t WS_EW     = WS_HQ + 140 * MiB;
constexpr size_t WS_EDST   = WS_HQ + 144 * MiB;

struct Params {
    const float *x, *attn_g, *ffn_g, *w_in, *w_out, *g_q, *g_k, *pos_k, *pos_v, *wk1, *wk2, *wv1, *wv2, *g_nsa, *lb_logits, *g_hn,
        *w_group, *b_group, *w_expert, *b_expert, *w1, *w3, *w2;
    float* out;
    unsigned char* ws;
};

typedef __bf16 bf16x2_t __attribute__((ext_vector_type(2)));
DEV unsigned pk2(float lo, float hi) { f32x2 f = {lo, hi}; return __builtin_bit_cast(unsigned, __builtin_convertvector(f, bf16x2_t)); }
DEV bf16_t f2bf(float f) { return (bf16_t)(pk2(f, 0.f) & 0xffffu); }
DEV float bf2f(bf16_t b) { return __uint_as_float(((unsigned)b) << 16); }
DEV float bflo(unsigned u) { return __uint_as_float(u << 16); }
DEV float bfhi(unsigned u) { return __uint_as_float(u & 0xffff0000u); }
DEV float sigmoidf_(float v) { return __builtin_amdgcn_rcpf(1.f + __builtin_amdgcn_exp2f(-1.4426950408889634f * v)); }
DEV float siluf_(float v) { return v * __builtin_amdgcn_rcpf(1.f + __builtin_amdgcn_exp2f(-1.4426950408889634f * v)); }
DEV float wave_sum(float v) {
#pragma unroll
    for (int o = 1; o < 64; o <<= 1) v += __shfl_xor(v, o);
    return v;
}
DEV float wave_max(float v) {
#pragma unroll
    for (int o = 1; o < 64; o <<= 1) v = fmaxf(v, __shfl_xor(v, o));
    return v;
}
DEV int vblock() { const int G = gridDim.x, b = blockIdx.x; return (G % 8 == 0) ? (b % 8) * (G / 8) + b / 8 : b; }

namespace pg8 {
#define PG8_LAS __attribute__((address_space(3)))
constexpr int BM = 256, BK = 64, HALF = 128, HTB = HALF * BK * 2, STAGE_BYTES = 8 * HTB, NXCD = 8, WGM = 1;
__host__ __device__ __forceinline__ int lds_byte(int r, int c) { const int st = (r >> 4) * 2 + (c >> 5), rr = r & 15, cc = c & 31, ob = rr * 64 + cc * 2; return st * 1024 + (ob ^ (((ob >> 9) & 1) << 5)); }
__host__ __device__ __forceinline__ void stage_rc(int b, int& R, int& C) { const int st = b / 1024, sb = b % 1024, swz = sb ^ (((sb >> 9) & 1) << 5); R = (st >> 1) * 16 + swz / 64; C = (st & 1) * 32 + (swz % 64) / 2; }
struct Unit { int pm, pn; };
struct Gemm { const bf16_t* A; const bf16_t* Bt; int M, N, K; };
struct StaticOrder {
    int nM, nN, nwg, G, c;
    __host__ __device__ void init(int M, int N, int G_, int c_) { nM = M / BM; nN = N / BM; nwg = nM * nN; G = G_; c = c_; }
    __host__ __device__ bool next(int i, Unit& u) const {
        const long L = (long)i * G + c; if (L >= nwg) return false;
        int wgid = (int)L; { const int q = nwg / NXCD, r = nwg % NXCD, xcd = wgid % NXCD, off = wgid / NXCD; wgid = (xcd < r ? xcd * (q + 1) : r * (q + 1) + (xcd - r) * q) + off; }
        const int nig = WGM * nN, gid = wgid / nig, fm = gid * WGM, gsz = (nM - fm) < WGM ? (nM - fm) : WGM;
        u.pm = fm + ((wgid % nig) % gsz); u.pn = (wgid % nig) / gsz; return true;
    }
};
template <class Epi, class Sched>
__device__ __forceinline__ void gemm_phase(PG8_LAS unsigned char* lds, const Gemm g, const Sched& S, const Epi& E) {
    const int tid = threadIdx.x, wid = __builtin_amdgcn_readfirstlane(tid >> 6), lane = tid & 63, wr = wid >> 2, wc = wid & 3, fr = lane & 15, fq = lane >> 4;
    const int K = g.K, nt = K / BK;
    unsigned voffA[2];
#pragma unroll
    for (int i = 0; i < 2; ++i) { int R, C; stage_rc(tid * 16 + i * 8192, R, C); voffA[i] = (unsigned)(R * K + C) * 2u; }
    const size_t kstep = (size_t)(BK * 2);
    const size_t hstep = (size_t)HALF * K * 2;
    const size_t tstep = 2 * hstep;
    const unsigned ldsw = (unsigned)wid * 1024u;
    const int aoff = lds_byte(wr * 64 + fr, fq * 8), boff = lds_byte(wc * 32 + fr, fq * 8);
#define PG8_SA(b, h) (((b) * 2 + (h)) * HTB)
#define PG8_SB(b, h) ((4 + (b) * 2 + (h)) * HTB)
#define PG8_STAGE(bufoff, gbase, voff) do { _Pragma("unroll") for (int _i = 0; _i < 2; ++_i) \
        __builtin_amdgcn_global_load_lds((const unsigned*)((const char*)(gbase) + (voff)[_i]), (PG8_LAS unsigned*)(lds + (bufoff) + ldsw + _i * 8192), 16, 0, 0); } while (0)
#define PG8_LDA(dst, b, h) do { _Pragma("unroll") for (int m = 0; m < 4; ++m) _Pragma("unroll") for (int k = 0; k < 2; ++k) dst[m][k] = *(const PG8_LAS bf16x8*)(lds + PG8_SA(b, h) + aoff + m * 2048 + k * 1024); } while (0)
#define PG8_LDB(dst, b, h) do { _Pragma("unroll") for (int n = 0; n < 2; ++n) _Pragma("unroll") for (int k = 0; k < 2; ++k) dst[n][k] = *(const PG8_LAS bf16x8*)(lds + PG8_SB(b, h) + boff + n * 2048 + k * 1024); } while (0)
#define PG8_MMA(ai, bj, At, Bt) do { __builtin_amdgcn_s_setprio(1); _Pragma("unroll") for (int m = 0; m < 4; ++m) _Pragma("unroll") for (int n = 0; n < 2; ++n) _Pragma("unroll") for (int k = 0; k < 2; ++k) \
        acc[ai][bj][m][n] = __builtin_amdgcn_mfma_f32_16x16x32_bf16(Bt[n][k], At[m][k], acc[ai][bj][m][n], 0, 0, 0); __builtin_amdgcn_s_setprio(0); } while (0)
#define PG8_WAIT_V(n) asm volatile("s_waitcnt vmcnt(" #n ")" ::: "memory")
#define PG8_WAIT_L(n) asm volatile("s_waitcnt lgkmcnt(" #n ")" ::: "memory")
#define PG8_BAR __builtin_amdgcn_s_barrier()
#define PG8_SCHED __builtin_amdgcn_sched_barrier(0)
    Unit cur, nxt; int ui = 0;
    if (!S.next(0, cur)) return;
    f32x4 acc[2][2][4][2];
#pragma unroll
    for (int a = 0; a < 2; ++a)
#pragma unroll
        for (int b = 0; b < 2; ++b)
#pragma unroll
            for (int m = 0; m < 4; ++m)
#pragma unroll
                for (int n = 0; n < 2; ++n) acc[a][b][m][n] = (f32x4){0.f, 0.f, 0.f, 0.f};
    bf16x8 At[4][2], B0[2][2], B1[2][2];
    const char* cA = (const char*)g.A + (size_t)cur.pm * tstep; const char* cB = (const char*)g.Bt + (size_t)cur.pn * tstep;
    PG8_STAGE(PG8_SB(0, 0), cB, voffA); PG8_STAGE(PG8_SA(0, 0), cA, voffA); PG8_STAGE(PG8_SB(0, 1), cB + hstep, voffA); PG8_STAGE(PG8_SA(0, 1), cA + hstep, voffA);
    if (wr == 1) PG8_BAR;
    PG8_WAIT_V(4); PG8_BAR;
    PG8_STAGE(PG8_SB(1, 0), cB + kstep, voffA); PG8_STAGE(PG8_SA(1, 0), cA + kstep, voffA); PG8_STAGE(PG8_SB(1, 1), cB + hstep + kstep, voffA);
    PG8_WAIT_V(6); PG8_BAR;
    for (;;) {
        const bool has_next = S.next(ui + 1, nxt);
        const char* nA = has_next ? (const char*)g.A + (size_t)nxt.pm * tstep : cA; const char* nB = has_next ? (const char*)g.Bt + (size_t)nxt.pn * tstep : cB;
        float midrs[2][4];
        if constexpr (Epi::MIDSCALE) {
#pragma unroll
            for (int a = 0; a < 2; ++a)
#pragma unroll
                for (int m = 0; m < 4; ++m) midrs[a][m] = E.rowscale(cur.pm * BM + a * HALF + wr * 64 + m * 16 + fr); }
        for (int t = 0; t < nt; t += 2) {
            const bool last = (t == nt - 2);
            if constexpr (Epi::MIDSCALE) { if (t == E.midk()) {
#pragma unroll
                for (int a = 0; a < 2; ++a)
#pragma unroll
                    for (int b = 0; b < 2; ++b)
#pragma unroll
                        for (int m = 0; m < 4; ++m)
#pragma unroll
                            for (int n = 0; n < 2; ++n) acc[a][b][m][n] = acc[a][b][m][n] * midrs[a][m]; } }
            const char* a1 = cA + (size_t)(t + 1) * kstep;
            const char* a2 = last ? nA : cA + (size_t)(t + 2) * kstep; const char* b2 = last ? nB : cB + (size_t)(t + 2) * kstep;
            const char* a3 = a2 + kstep; const char* b3 = b2 + kstep;
            PG8_LDB(B0, 0, 0); PG8_SCHED; PG8_LDA(At, 0, 0); PG8_STAGE(PG8_SA(1, 1), a1 + hstep, voffA);
            PG8_WAIT_L(8); PG8_BAR; PG8_WAIT_L(0); PG8_MMA(0, 0, At, B0); PG8_BAR; PG8_SCHED;
            PG8_LDB(B1, 0, 1); PG8_STAGE(PG8_SB(0, 0), b2, voffA);
            PG8_BAR; PG8_WAIT_L(0); PG8_MMA(0, 1, At, B1); PG8_BAR;
            PG8_LDA(At, 0, 1); PG8_STAGE(PG8_SA(0, 0), a2, voffA);
            PG8_BAR; PG8_WAIT_L(0); PG8_MMA(1, 0, At, B0); PG8_BAR; PG8_SCHED;
            PG8_STAGE(PG8_SB(0, 1), b2 + hstep, voffA);
            PG8_WAIT_V(6); PG8_BAR; PG8_MMA(1, 1, At, B1); PG8_BAR;
            PG8_LDB(B0, 1, 0); PG8_SCHED; PG8_LDA(At, 1, 0); PG8_STAGE(PG8_SA(0, 1), a2 + hstep, voffA);
            PG8_WAIT_L(8); PG8_BAR; PG8_WAIT_L(0); PG8_MMA(0, 0, At, B0); PG8_BAR; PG8_SCHED;
            PG8_LDB(B1, 1, 1); PG8_STAGE(PG8_SB(1, 0), b3, voffA);
            PG8_BAR; PG8_WAIT_L(0); PG8_MMA(0, 1, At, B1); PG8_BAR;
            PG8_LDA(At, 1, 1); PG8_STAGE(PG8_SA(1, 0), a3, voffA);
            PG8_BAR; PG8_WAIT_L(0); PG8_MMA(1, 0, At, B0); PG8_BAR; PG8_SCHED;
            PG8_STAGE(PG8_SB(1, 1), b3 + hstep, voffA);
            PG8_WAIT_V(6); PG8_BAR; PG8_MMA(1, 1, At, B1); PG8_BAR;
        }
        E(acc, cur, wr, wc, fr, fq);
        if (!has_next) break;
#pragma unroll
        for (int a = 0; a < 2; ++a)
#pragma unroll
            for (int b = 0; b < 2; ++b)
#pragma unroll
                for (int m = 0; m < 4; ++m)
#pragma unroll
                    for (int n = 0; n < 2; ++n) acc[a][b][m][n] = (f32x4){0.f, 0.f, 0.f, 0.f};
        cur = nxt; cA = nA; cB = nB; ++ui;
    }
    PG8_WAIT_V(0);
    if (wr == 0) PG8_BAR;
    PG8_BAR;
#undef PG8_SA
#undef PG8_SB
#undef PG8_STAGE
#undef PG8_LDA
#undef PG8_LDB
#undef PG8_MMA
#undef PG8_WAIT_V
#undef PG8_WAIT_L
#undef PG8_BAR
#undef PG8_SCHED
}
template <class Pol, class Epi>
__device__ __forceinline__ void gemm_phase2(PG8_LAS unsigned char* lds, const Pol& P, const Epi& E) {
    const int tid = threadIdx.x, wid = __builtin_amdgcn_readfirstlane(tid >> 6), lane = tid & 63, wr = wid >> 2, wc = wid & 3, fr = lane & 15, fq = lane >> 4;
    const int nt = P.nk();
    const unsigned ldsw = (unsigned)wid * 1024u;
    const int aoff = lds_byte(wr * 64 + fr, fq * 8), boff = lds_byte(wc * 32 + fr, fq * 8);
#define PG8_SA(b, h) (((b) * 2 + (h)) * HTB)
#define PG8_SB(b, h) ((4 + (b) * 2 + (h)) * HTB)
#define PG8_STAGE_A(bufoff, AS, h, kt) do { _Pragma("unroll") for (int _i = 0; _i < 2; ++_i) \
        __builtin_amdgcn_global_load_lds((const unsigned*)P.pa(AS, h, _i, kt), (PG8_LAS unsigned*)(lds + (bufoff) + ldsw + _i * 8192), 16, 0, 0); } while (0)
#define PG8_STAGE_B(bufoff, BS, h, kt) do { _Pragma("unroll") for (int _i = 0; _i < 2; ++_i) \
        __builtin_amdgcn_global_load_lds((const unsigned*)P.pb(BS, h, _i, kt), (PG8_LAS unsigned*)(lds + (bufoff) + ldsw + _i * 8192), 16, 0, 0); } while (0)
#define PG8_LDA(dst, b, h) do { _Pragma("unroll") for (int m = 0; m < 4; ++m) _Pragma("unroll") for (int k = 0; k < 2; ++k) dst[m][k] = *(const PG8_LAS bf16x8*)(lds + PG8_SA(b, h) + aoff + m * 2048 + k * 1024); } while (0)
#define PG8_LDB(dst, b, h) do { _Pragma("unroll") for (int n = 0; n < 2; ++n) _Pragma("unroll") for (int k = 0; k < 2; ++k) dst[n][k] = *(const PG8_LAS bf16x8*)(lds + PG8_SB(b, h) + boff + n * 2048 + k * 1024); } while (0)
#define PG8_MMA(ai, bj, At, Bt) do { __builtin_amdgcn_s_setprio(1); _Pragma("unroll") for (int m = 0; m < 4; ++m) _Pragma("unroll") for (int n = 0; n < 2; ++n) _Pragma("unroll") for (int k = 0; k < 2; ++k) \
        acc[ai][bj][m][n] = __builtin_amdgcn_mfma_f32_16x16x32_bf16(Bt[n][k], At[m][k], acc[ai][bj][m][n], 0, 0, 0); __builtin_amdgcn_s_setprio(0); } while (0)
#define PG8_STAGE_A2(bufoff, h, kt) do { _Pragma("unroll") for (int _i = 0; _i < 2; ++_i) \
        __builtin_amdgcn_global_load_lds((const unsigned*)P.pa(a2, h, _i, kt), (PG8_LAS unsigned*)(lds + (bufoff) + ldsw + _i * 8192), 16, 0, 0); } while (0)
#define PG8_STAGE_B2(bufoff, h, kt) do { _Pragma("unroll") for (int _i = 0; _i < 2; ++_i) \
        __builtin_amdgcn_global_load_lds((const unsigned*)P.pb(b2, h, _i, kt), (PG8_LAS unsigned*)(lds + (bufoff) + ldsw + _i * 8192), 16, 0, 0); } while (0)
#define PG8_WAIT_V(n) asm volatile("s_waitcnt vmcnt(" #n ")" ::: "memory")
#define PG8_WAIT_L(n) asm volatile("s_waitcnt lgkmcnt(" #n ")" ::: "memory")
#define PG8_BAR __builtin_amdgcn_s_barrier()
#define PG8_SCHED __builtin_amdgcn_sched_barrier(0)
    typename Pol::Unit cur, nxt; int ui = 0;
    if (!P.next(0, cur)) return;
    f32x4 acc[2][2][4][2];
#pragma unroll
    for (int a = 0; a < 2; ++a)
#pragma unroll
        for (int b = 0; b < 2; ++b)
#pragma unroll
            for (int m = 0; m < 4; ++m)
#pragma unroll
                for (int n = 0; n < 2; ++n) acc[a][b][m][n] = (f32x4){0.f, 0.f, 0.f, 0.f};
    bf16x8 At[4][2], B0[2][2], B1[2][2];
    typename Pol::AddrA aC, aN; typename Pol::AddrB bC, bN;
    P.addrA(cur, aC); P.addrB(cur, bC);
    PG8_STAGE_B(PG8_SB(0, 0), bC, 0, 0); PG8_STAGE_A(PG8_SA(0, 0), aC, 0, 0); PG8_STAGE_B(PG8_SB(0, 1), bC, 1, 0); PG8_STAGE_A(PG8_SA(0, 1), aC, 1, 0);
    if (wr == 1) PG8_BAR;
    PG8_WAIT_V(4); PG8_BAR;
    PG8_STAGE_B(PG8_SB(1, 0), bC, 0, 1); PG8_STAGE_A(PG8_SA(1, 0), aC, 0, 1); PG8_STAGE_B(PG8_SB(1, 1), bC, 1, 1);
    PG8_WAIT_V(6); PG8_BAR;
    for (;;) {
        const bool has_next = P.next(ui + 1, nxt);
        if (has_next) { P.addrA(nxt, aN); P.addrB(nxt, bN); } else { aN = aC; bN = bC; }
        const bool full = P.full(cur);
        for (int t = 0; t < nt; t += 2) {
            const bool last = (t == nt - 2);
            const typename Pol::AddrA a2 = last ? aN : aC; const typename Pol::AddrB b2 = last ? bN : bC;
            const int k2 = last ? 0 : t + 2, k3 = k2 + 1;
            PG8_LDB(B0, 0, 0); PG8_SCHED; PG8_LDA(At, 0, 0); PG8_STAGE_A(PG8_SA(1, 1), aC, 1, t + 1);
            PG8_WAIT_L(8); PG8_BAR; PG8_WAIT_L(0); PG8_MMA(0, 0, At, B0); PG8_BAR; PG8_SCHED;
            PG8_LDB(B1, 0, 1); PG8_STAGE_B2(PG8_SB(0, 0), 0, k2);
            PG8_BAR; PG8_WAIT_L(0); PG8_MMA(0, 1, At, B1); PG8_BAR;
            PG8_LDA(At, 0, 1); PG8_STAGE_A2(PG8_SA(0, 0), 0, k2);
            PG8_BAR; PG8_WAIT_L(0); if (full) PG8_MMA(1, 0, At, B0); PG8_BAR; PG8_SCHED;
            PG8_STAGE_B2(PG8_SB(0, 1), 1, k2);
            PG8_WAIT_V(6); PG8_BAR; if (full) PG8_MMA(1, 1, At, B1); PG8_BAR;
            PG8_LDB(B0, 1, 0); PG8_SCHED; PG8_LDA(At, 1, 0); PG8_STAGE_A2(PG8_SA(0, 1), 1, k2);
            PG8_WAIT_L(8); PG8_BAR; PG8_WAIT_L(0); PG8_MMA(0, 0, At, B0); PG8_BAR; PG8_SCHED;
            PG8_LDB(B1, 1, 1); PG8_STAGE_B2(PG8_SB(1, 0), 0, k3);
            PG8_BAR; PG8_WAIT_L(0); PG8_MMA(0, 1, At, B1); PG8_BAR;
            PG8_LDA(At, 1, 1); PG8_STAGE_A2(PG8_SA(1, 0), 0, k3);
            PG8_BAR; PG8_WAIT_L(0); if (full) PG8_MMA(1, 0, At, B0); PG8_BAR; PG8_SCHED;
            PG8_STAGE_B2(PG8_SB(1, 1), 1, k3);
            PG8_WAIT_V(6); PG8_BAR; if (full) PG8_MMA(1, 1, At, B1); PG8_BAR;
        }
        E(acc, cur, wr, wc, fr, fq);
        if (!has_next) break;
#pragma unroll
        for (int a = 0; a < 2; ++a)
#pragma unroll
            for (int b = 0; b < 2; ++b)
#pragma unroll
                for (int m = 0; m < 4; ++m)
#pragma unroll
                    for (int n = 0; n < 2; ++n) acc[a][b][m][n] = (f32x4){0.f, 0.f, 0.f, 0.f};
        cur = nxt; aC = aN; bC = bN; ++ui;
    }
    PG8_WAIT_V(0);
    if (wr == 0) PG8_BAR;
    PG8_BAR;
#undef PG8_SA
#undef PG8_SB
#undef PG8_STAGE_A
#undef PG8_STAGE_B
#undef PG8_STAGE_A2
#undef PG8_STAGE_B2
#undef PG8_LDA
#undef PG8_LDB
#undef PG8_MMA
#undef PG8_WAIT_V
#undef PG8_WAIT_L
#undef PG8_BAR
#undef PG8_SCHED
}
__host__ __device__ __forceinline__ int perm_lo(int x) { return (((x >> 2) & 3) << 3) | (((x >> 4) & 1) << 2) | (x & 3); }
__host__ __device__ __forceinline__ int inv_perm_lo(int y) { return (((y >> 2) & 1) << 4) | (((y >> 3) & 3) << 2) | (y & 3); }
__host__ __device__ __forceinline__ int logcol(int p) { return (p & ~255) + 64 * ((p >> 5) & 3) + 32 * ((p >> 7) & 1) + perm_lo(p & 31); }
}

template <class SRC>
DEV void convert_tile(float* tl, const SRC& src, bf16_t* dst, int ldd, int n0, int k0) {
    const int tid = threadIdx.x;
    {
        const int n = tid & 63;
#pragma unroll
        for (int i = 0; i < 8; ++i) { const int kk = (tid >> 6) + 8 * i; tl[kk * 65 + n] = src.get(n0 + n, k0 + kk); }
    }
    __syncthreads();
    {
        const int n = tid >> 3, kc = tid & 7;
        const float* s = tl + (kc * 8) * 65 + n;
        u32x4 o;
        o.x = pk2(s[0 * 65], s[1 * 65]); o.y = pk2(s[2 * 65], s[3 * 65]); o.z = pk2(s[4 * 65], s[5 * 65]); o.w = pk2(s[6 * 65], s[7 * 65]);
        *(u32x4*)(dst + (size_t)(n0 + n) * ldd + k0 + kc * 8) = o;
    }
    __syncthreads();
}
struct SrcWin { const float* w; const float* g;
    DEV float get(int np, int k) const { const int n = pg8::logcol(np); int col; if (n < 1280) col = n; else if (n < 3328) col = n + 24; else if (n < 3352) col = 1280 + (n - 3328); else return 0.f;
        return w[(size_t)k * IN_COLS + col] * g[k]; } };
struct SrcWout { const float* w; const float* g;
    DEV float get(int np, int k) const { const int n = pg8::logcol(np); const float v = w[(size_t)k * DM + n]; return k < 512 ? v * g[k] : v; } };
struct SrcPlain { const float* w; int ld;
    DEV float get(int n, int k) const { return w[(size_t)k * ld + n]; } };
struct SrcW13 { const float* w1; const float* w3; const float* g;
    DEV float get(int n, int k) const { const uintptr_t a = (uintptr_t)w1, b = (uintptr_t)w3; const float* w = (const float*)(a + ((b - a) & (uintptr_t)(0 - (long long)(n & 1))));
        return w[(size_t)k * 512 + (n >> 1)] * g[k]; } };

template <class SRC>
DEV void convert_tile256(float* tl, const SRC& src, bf16_t* dst, int ldd, int n0, int k0) {
    int tid = threadIdx.x; asm volatile("" : "+v"(tid));
    {
        const int q = tid & 63;
        f32x4 v[8];
#pragma unroll
        for (int i = 0; i < 8; ++i) v[i] = src.quad(n0, q, k0 + (tid >> 6) + 8 * i);
#pragma unroll
        for (int i = 0; i < 8; ++i) { float* o = tl + ((tid >> 6) + 8 * i) * 257; o[src.drow(q, 0)] = v[i].x; o[src.drow(q, 1)] = v[i].y; o[src.drow(q, 2)] = v[i].z; o[src.drow(q, 3)] = v[i].w; }
    }
    __syncthreads();
#pragma unroll
    for (int i = 0; i < 4; ++i) {
        const int idx = tid + NT * i, n = idx >> 3, kc = idx & 7;
        const float* s = tl + (kc * 8) * 257 + n;
        u32x4 o;
        o.x = pk2(s[0 * 257], s[1 * 257]); o.y = pk2(s[2 * 257], s[3 * 257]); o.z = pk2(s[4 * 257], s[5 * 257]); o.w = pk2(s[6 * 257], s[7 * 257]);
        *(u32x4*)(dst + (size_t)(n0 + n) * ldd + k0 + kc * 8) = o;
    }
    __syncthreads();
}
struct SrcWin4 { const float* w; const float* g;
    DEV int drow(int q, int e) const { return 4 * q + e; }
    DEV f32x4 quad(int n0, int q, int k) const { const int n = pg8::logcol(n0 + 4 * q); int col; if (n < 1280) col = n; else if (n < 3328) col = n + 24; else if (n < 3352) col = 1280 + (n - 3328); else return (f32x4){0.f, 0.f, 0.f, 0.f};
        return *(const f32x4*)(w + (size_t)k * IN_COLS + col) * g[k]; } };
struct SrcWout4 { const float* w; const float* g;
    DEV int drow(int q, int e) const { return 4 * q + e; }
    DEV f32x4 quad(int n0, int q, int k) const { const f32x4 v = *(const f32x4*)(w + (size_t)k * DM + pg8::logcol(n0 + 4 * q)); return k < 512 ? v * g[k] : v; } };
struct SrcPlain4 { const float* w; int ld;
    DEV int drow(int q, int e) const { return 4 * q + e; }
    DEV f32x4 quad(int n0, int q, int k) const { return *(const f32x4*)(w + (size_t)k * ld + n0 + 4 * q); } };
struct SrcW13_4 { const float* w1; const float* w3; const float* g;
    DEV int drow(int q, int e) const { const int l = 8 * (q & 31) + 2 * e + (q >> 5); return (l & ~31) | pg8::inv_perm_lo(l & 31); }
    DEV f32x4 quad(int n0, int q, int k) const { const uintptr_t a = (uintptr_t)w1, b = (uintptr_t)w3; const float* w = (const float*)(a + ((b - a) & (uintptr_t)(0 - (long long)(q >> 5))));
        return *(const f32x4*)(w + (size_t)k * 512 + (n0 >> 1) + 4 * (q & 31)) * g[k]; } };

constexpr int I_WIN = (INP / 256) * (DM / 64);
constexpr int I_WOUT = 4 * 16;
constexpr int I_CW1 = 2 * 32;
constexpr int I_W2 = 32 * 4 * 8;
constexpr int I_CW2 = 2 * 1 * 4;
constexpr int I_ALL = I_WIN + I_WOUT + I_CW1 + I_W2 + I_CW2;
DEV void convert_side(const Params& p, unsigned char* lds) {
    float* tl = (float*)lds; unsigned char* ws = p.ws; const int vb = vblock(), G = gridDim.x;
    __syncthreads();
    for (int it = vb; it < I_WOUT + I_CW1 + I_W2 + I_CW2; it += G) {
        int r = it;
        if (r < I_WOUT) { SrcWout4 s{p.w_out, p.g_nsa}; convert_tile256(tl, s, (bf16_t*)(ws + WS_WOUTT), DM, (r / 16) * 256, (r % 16) * 64); continue; } r -= I_WOUT;
        if (r < I_CW1) { const int z = r / 32, q = r % 32; SrcPlain4 s{z ? p.wv1 : p.wk1, 256};
            convert_tile256(tl, s, (bf16_t*)(ws + WS_CW1T) + (size_t)z * 256 * 2048, 2048, 0, q * 64); continue; } r -= I_CW1;
        if (r < I_W2) { const int e = r / 32, q = r % 32; SrcPlain4 s{p.w2 + (size_t)e * 512 * 1024, 1024};
            convert_tile256(tl, s, (bf16_t*)(ws + WS_W2T) + (size_t)e * 1024 * 512, 512, (q / 8) * 256, (q % 8) * 64); continue; } r -= I_W2;
        { const int z = r / 4, q = r % 4; SrcPlain s{z ? p.wv2 : p.wk2, 64};
            convert_tile(tl, s, (bf16_t*)(ws + WS_CW2T) + (size_t)z * 64 * 256, 256, 0, q * 64); }
    }
    __syncthreads();
}
DEV void phase_prologue(const Params& p, unsigned char* lds) {
    float* tl = (float*)lds;
    const int tid = threadIdx.x, lane = tid & 63, wid = tid >> 6;
    const int vb = vblock(), G = gridDim.x;
    unsigned char* ws = p.ws;
    for (int it = vb; it < I_WIN; it += G) { SrcWin4 s{p.w_in, p.attn_g}; convert_tile256(tl, s, (bf16_t*)(ws + WS_WINT), DM, (it / 16) * 256, (it % 16) * 64); }
    (void)I_ALL;
    {
        bf16_t* xb = (bf16_t*)(ws + WS_XB); float* rstd1 = (float*)(ws + WS_RSTD1);
        const int gw = vb * 8 + wid, NGW = G * 8;
        for (int m = gw; m < NTOK; m += NGW) {
            const f32x4* xr = (const f32x4*)(p.x + (size_t)m * DM) + lane;
            f32x4 v[4]; float s = 0.f;
#pragma unroll
            for (int j = 0; j < 4; ++j) { v[j] = xr[64 * j]; s += (v[j].x * v[j].x + v[j].y * v[j].y) + (v[j].z * v[j].z + v[j].w * v[j].w); }
            s = wave_sum(s);
            if (lane == 0) rstd1[m] = rsqrtf(s * (1.f / DM) + RMS_EPS);
            u32x2* o = (u32x2*)(xb + (size_t)m * DM) + lane;
#pragma unroll
            for (int j = 0; j < 4; ++j) { u32x2 w; w.x = pk2(v[j].x, v[j].y); w.y = pk2(v[j].z, v[j].w); o[64 * j] = w; }
        }
    }
    {
        const int gt = vb * NT + tid, NG = G * NT;
        float* rowss = (float*)(ws + WS_ROWSS);
        for (int i = gt; i < NTOK; i += NG) rowss[i] = 0.f;
        int* bincnt = (int*)(ws + WS_CTL);
        if (gt < 128) bincnt[gt] = 0;
        if (gt < 32) ((int*)(ws + WS_CTL + 512))[gt] = 0;
        if (gt < 512) { const float l0 = p.lb_logits[gt], l1 = p.lb_logits[512 + gt]; ((float*)(ws + WS_LB))[gt] = 1.f / (1.f + __expf(l1 - l0)); }
        for (int i = gt; i < 48 * 1024; i += NG) { const int c = i >> 10, k = i & 1023;
            const float w = (c < 4 ? p.w_group[k * 4 + c] : (c < 36 ? p.w_expert[k * 32 + (c - 4)] : 0.f)) * p.ffn_g[k];
            const bf16_t hi = f2bf(w); const bf16_t lo = f2bf(w - bf2f(hi));
            ((bf16_t*)(ws + WS_RW))[i] = hi; ((bf16_t*)(ws + WS_RW))[48 * 1024 + i] = lo; }
        {
            const int ob = (vb * 8 + wid) * 4;
            if (ob < 512) { const int z = ob >> 8, j0 = ob & 255; const float* pos = z ? p.pos_v : p.pos_k; const float* w = (z ? p.wv1 : p.wk1) + j0;
                f32x4 a = (f32x4){0.f, 0.f, 0.f, 0.f};
#pragma unroll 8
                for (int k = lane; k < 2048; k += 64) a = a + *(const f32x4*)(w + (size_t)k * 256) * pos[k];
                a.x = wave_sum(a.x); a.y = wave_sum(a.y); a.z = wave_sum(a.z); a.w = wave_sum(a.w);
                if (lane == 0) *(f32x4*)((float*)(ws + WS_CBIAS) + ob) = a; }
        }
    }
}

constexpr int G_A_BYTES = 128 * 128, G_B_BYTES = 256 * 128, G_STAGE = G_A_BYTES + G_B_BYTES, G_LDS = 2 * G_STAGE;
DEV int swz(int row, int chunk) { return row * 128 + ((chunk ^ ((row >> 1) & 7)) << 4); }
template <class AL, class BL, class EP>
DEV void gemm_tile(unsigned char* lds, const AL& al, const BL& bl, int nk, const EP& ep) {
    const int tid = threadIdx.x, lane = tid & 63, wid = tid >> 6, wr = wid >> 2, wc = wid & 3;
    const int frow = lane & 15, fq = lane >> 4;
    const bf16_t* aptr[2]; int aoff[2], boff[4], brow[4];
#pragma unroll
    for (int i = 0; i < 2; ++i) { const int q = tid + NT * i, row = q >> 3, ch = q & 7; aptr[i] = al.row(row) + ch * 8; aoff[i] = swz(row, ch); }
#pragma unroll
    for (int i = 0; i < 4; ++i) { const int q = tid + NT * i, row = q >> 3, ch = q & 7; brow[i] = row; boff[i] = G_A_BYTES + swz(row, ch) ; }
    const int bch8 = (tid & 7) * 8;
    u32x4 ra[2], rb[4];
#pragma unroll
    for (int i = 0; i < 2; ++i) ra[i] = *(const u32x4*)(aptr[i]);
#pragma unroll
    for (int i = 0; i < 4; ++i) rb[i] = *(const u32x4*)(bl.ptr(brow[i], 0) + bch8);
#pragma unroll
    for (int i = 0; i < 2; ++i) *(u32x4*)(lds + aoff[i]) = ra[i];
#pragma unroll
    for (int i = 0; i < 4; ++i) *(u32x4*)(lds + boff[i]) = rb[i];
    __syncthreads();
    f32x4 acc[4][4];
#pragma unroll
    for (int m = 0; m < 4; ++m)
#pragma unroll
        for (int n = 0; n < 4; ++n) acc[m][n] = (f32x4){0.f, 0.f, 0.f, 0.f};
    const int sx = (frow >> 1) & 7;
    for (int kt = 0; kt < nk; ++kt) {
        const bool more = (kt + 1 < nk);
        if (more) {
#pragma unroll
            for (int i = 0; i < 2; ++i) ra[i] = *(const u32x4*)(aptr[i] + (kt + 1) * 64);
#pragma unroll
            for (int i = 0; i < 4; ++i) rb[i] = *(const u32x4*)(bl.ptr(brow[i], kt + 1) + bch8);
        }
        const unsigned char* base = lds + (kt & 1) * G_STAGE;
#pragma unroll
        for (int ks = 0; ks < 2; ++ks) {
            const int co = ((ks * 4 + fq) ^ sx) << 4;
            bf16x8 af[4], bfr[4];
#pragma unroll
            for (int m = 0; m < 4; ++m) af[m] = *(const bf16x8*)(base + (wr * 64 + m * 16 + frow) * 128 + co);
#pragma unroll
            for (int n = 0; n < 4; ++n) bfr[n] = *(const bf16x8*)(base + G_A_BYTES + (wc * 64 + n * 16 + frow) * 128 + co);
#pragma unroll
            for (int m = 0; m < 4; ++m)
#pragma unroll
                for (int n = 0; n < 4; ++n) acc[m][n] = __builtin_amdgcn_mfma_f32_16x16x32_bf16(bfr[n], af[m], acc[m][n], 0, 0, 0);
        }
        if (more) {
            unsigned char* nb = lds + ((kt + 1) & 1) * G_STAGE;
#pragma unroll
            for (int i = 0; i < 2; ++i) *(u32x4*)(nb + aoff[i]) = ra[i];
#pragma unroll
            for (int i = 0; i < 4; ++i) *(u32x4*)(nb + boff[i]) = rb[i];
        }
        __syncthreads();
    }
    ep(acc, wr, wc, lane);
}

struct ARows { const bf16_t* base; size_t ld; DEV const bf16_t* row(int r) const { return base + (size_t)r * ld; } };
struct BRows { const bf16_t* base; size_t ld; DEV const bf16_t* ptr(int n, int kt) const { return base + (size_t)n * ld + kt * 64; } };

DEV u32x4 pk8(const f32x4 a, const f32x4 b) { u32x4 w; w.x = pk2(a.x, a.y); w.y = pk2(a.z, a.w); w.z = pk2(b.x, b.y); w.w = pk2(b.z, b.w); return w; }
struct EpiInproj8 { const Params& p; static constexpr bool MIDSCALE = false; DEV float rowscale(int) const { return 1.f; } DEV int midk() const { return -1; }
    DEV void operator()(const f32x4 (&acc)[2][2][4][2], const pg8::Unit& u, int wr, int wc, int fr, int fq) const {
        const int seg = u.pn * 4 + wc;
        if (seg > 52) return;
        unsigned char* ws = p.ws;
        const int row0 = u.pm * 256 + wr * 64 + fr;
        const int b = row0 >> 12, s0 = row0 & 4095;
        float rs[2][4];
#pragma unroll
        for (int ai = 0; ai < 2; ++ai)
#pragma unroll
            for (int m = 0; m < 4; ++m) rs[ai][m] = ((const float*)(ws + WS_RSTD1))[row0 + 128 * ai + 16 * m];
        const bool is_q = seg < 8, is_ks = (seg == 12 || seg == 13), is_kw = (seg == 16 || seg == 17);
        if (is_q || is_ks || is_kw) {
            const float* gw = (is_q ? p.g_q : (is_ks ? p.g_k + 64 : p.g_k + 128)) + 8 * fq;
            const f32x4 g00 = *(const f32x4*)(gw), g01 = *(const f32x4*)(gw + 4), g10 = *(const f32x4*)(gw + 32), g11 = *(const f32x4*)(gw + 36);
            bf16_t* dst; int hh, nh;
            if (is_q) { dst = (bf16_t*)(ws + WS_Q); hh = seg; nh = 8; } else if (is_ks) { dst = (bf16_t*)(ws + WS_KS); hh = seg - 12; nh = 2; } else { dst = (bf16_t*)(ws + WS_KW); hh = seg - 16; nh = 2; }
            bf16_t* o0 = dst + ((size_t)(b * nh + hh) * SEQ + s0) * 64 + fq * 8;
            const float qs = is_q ? QSCALE : 1.f;
#pragma unroll
            for (int ai = 0; ai < 2; ++ai)
#pragma unroll
                for (int m = 0; m < 4; ++m) {
                    const f32x4 a0 = acc[ai][0][m][0], a1 = acc[ai][0][m][1], a2 = acc[ai][1][m][0], a3 = acc[ai][1][m][1];
                    float ss = ((a0.x * a0.x + a0.y * a0.y) + (a0.z * a0.z + a0.w * a0.w)) + ((a1.x * a1.x + a1.y * a1.y) + (a1.z * a1.z + a1.w * a1.w))
                             + ((a2.x * a2.x + a2.y * a2.y) + (a2.z * a2.z + a2.w * a2.w)) + ((a3.x * a3.x + a3.y * a3.y) + (a3.z * a3.z + a3.w * a3.w));
                    ss += __shfl_xor(ss, 16); ss += __shfl_xor(ss, 32);
                    const float rr = rs[ai][m];
                    const float r = rr * rsqrtf(ss * rr * rr * (1.f / 64.f) + RMS_EPS) * qs;
                    bf16_t* o = o0 + (size_t)(128 * ai + 16 * m) * 64;
                    *(u32x4*)(o) = pk8(a0 * g00 * r, a1 * g01 * r); *(u32x4*)(o + 32) = pk8(a2 * g10 * r, a3 * g11 * r);
                }
            return;
        }
        if (seg >= 8 && seg < 12) {
            bf16_t* o0 = (bf16_t*)(ws + (seg < 10 ? WS_KC : WS_VC)) + ((size_t)(b * 2 + (seg & 1)) * SEQ + s0) * 64 + fq * 8;
#pragma unroll
            for (int ai = 0; ai < 2; ++ai)
#pragma unroll
                for (int m = 0; m < 4; ++m) { const float r = rs[ai][m]; bf16_t* o = o0 + (size_t)(128 * ai + 16 * m) * 64;
                    *(u32x4*)(o) = pk8(acc[ai][0][m][0] * r, acc[ai][0][m][1] * r); *(u32x4*)(o + 32) = pk8(acc[ai][1][m][0] * r, acc[ai][1][m][1] * r); }
            return;
        }
        if (seg == 14 || seg == 15 || seg == 18 || seg == 19) {
            bf16_t* o0 = (bf16_t*)(ws + (seg < 16 ? WS_VST : WS_VWT)) + (size_t)(b * 2 + (seg & 1)) * 64 * SEQ + s0;
#pragma unroll
            for (int ai = 0; ai < 2; ++ai)
#pragma unroll
                for (int m = 0; m < 4; ++m) { const float r = rs[ai][m]; bf16_t* o = o0 + 128 * ai + 16 * m;
#pragma unroll
                    for (int bj = 0; bj < 2; ++bj)
#pragma unroll
                        for (int n = 0; n < 2; ++n) { const int d = 32 * bj + 8 * fq + 4 * n; const f32x4 x = acc[ai][bj][m][n] * r;
                            o[(size_t)(d + 0) * SEQ] = f2bf(x.x); o[(size_t)(d + 1) * SEQ] = f2bf(x.y); o[(size_t)(d + 2) * SEQ] = f2bf(x.z); o[(size_t)(d + 3) * SEQ] = f2bf(x.w); } }
            return;
        }
        if (seg < 52) {
            const int kind = (seg - 20) >> 3, cb = ((seg - 20) & 7) * 64 + fq * 8;
            if (kind == 1) {
                const float* lb = (const float*)(ws + WS_LB) + cb;
                const f32x4 l00 = *(const f32x4*)(lb), l01 = *(const f32x4*)(lb + 4), l10 = *(const f32x4*)(lb + 32), l11 = *(const f32x4*)(lb + 36);
                bf16_t* o0 = (bf16_t*)(ws + WS_HLOGF) + (size_t)row0 * 512 + cb;
#define LOGF4(L_, X_) (f32x4){__logf(L_.x + (1.f - L_.x) * sigmoidf_(X_.x)), __logf(L_.y + (1.f - L_.y) * sigmoidf_(X_.y)), __logf(L_.z + (1.f - L_.z) * sigmoidf_(X_.z)), __logf(L_.w + (1.f - L_.w) * sigmoidf_(X_.w))}
#pragma unroll
                for (int ai = 0; ai < 2; ++ai)
#pragma unroll
                    for (int m = 0; m < 4; ++m) { const float r = rs[ai][m]; bf16_t* o = o0 + (size_t)(128 * ai + 16 * m) * 512;
                        const f32x4 x0 = acc[ai][0][m][0] * r, x1 = acc[ai][0][m][1] * r, x2 = acc[ai][1][m][0] * r, x3 = acc[ai][1][m][1] * r;
                        *(u32x4*)(o) = pk8(LOGF4(l00, x0), LOGF4(l01, x1)); *(u32x4*)(o + 32) = pk8(LOGF4(l10, x2), LOGF4(l11, x3)); }
#undef LOGF4
            } else {
                bf16_t* o0 = (bf16_t*)(ws + (kind == 0 ? WS_HQ : (kind == 2 ? WS_HV : WS_HG))) + (size_t)row0 * 512 + cb;
#define SILU4(X_) (f32x4){siluf_(X_.x), siluf_(X_.y), siluf_(X_.z), siluf_(X_.w)}
#pragma unroll
                for (int ai = 0; ai < 2; ++ai)
#pragma unroll
                    for (int m = 0; m < 4; ++m) { const float r = rs[ai][m]; bf16_t* o = o0 + (size_t)(128 * ai + 16 * m) * 512;
                        f32x4 x0 = acc[ai][0][m][0] * r, x1 = acc[ai][0][m][1] * r, x2 = acc[ai][1][m][0] * r, x3 = acc[ai][1][m][1] * r;
                        if (kind != 2) { x0 = SILU4(x0); x1 = SILU4(x1); x2 = SILU4(x2); x3 = SILU4(x3); }
                        *(u32x4*)(o) = pk8(x0, x1); *(u32x4*)(o + 32) = pk8(x2, x3); }
#undef SILU4
            }
            return;
        }
        if (fq < 3) {
            float* o0 = (float*)(ws + WS_GATES) + (size_t)row0 * 24 + 8 * fq;
#pragma unroll
            for (int ai = 0; ai < 2; ++ai)
#pragma unroll
                for (int m = 0; m < 4; ++m) { const float r = rs[ai][m]; float* o = o0 + (size_t)(128 * ai + 16 * m) * 24;
#pragma unroll
                    for (int n = 0; n < 2; ++n) { const f32x4 x = acc[ai][0][m][n] * r; *(f32x4*)(o + 4 * n) = (f32x4){sigmoidf_(x.x), sigmoidf_(x.y), sigmoidf_(x.z), sigmoidf_(x.w)}; } }
        }
    } };
DEV void phase_inproj(const Params& p, unsigned char* lds) {
    pg8::Gemm g{(const bf16_t*)(p.ws + WS_XB), (const bf16_t*)(p.ws + WS_WINT), NTOK, INP, DM};
    pg8::StaticOrder S; S.init(NTOK, INP, (int)gridDim.x, (int)blockIdx.x);
    EpiInproj8 E{p};
    const bool first = ((blockIdx.x >> 3) & 1) == 0;
    if (first) convert_side(p, lds);
    pg8::gemm_phase(( PG8_LAS unsigned char*)lds, g, S, E);
    if (!first) convert_side(p, lds);
}

struct ACmp { const bf16_t* src; int bg, c0;
    DEV const bf16_t* row(int r) const { int c = c0 + r; if (c > NC - 1) c = NC - 1; return src + ((size_t)bg * SEQ + 16 * c) * 64; } };
struct EpiCmpA { const Params& p; int z, rbase;
    DEV void operator()(f32x4 (&acc)[4][4], int wr, int wc, int lane) const {
        const int frow = lane & 15, fq = lane >> 4;
        const float* cb = (const float*)(p.ws + WS_CBIAS) + z * 256; bf16_t* hid = (bf16_t*)(p.ws + WS_HID) + (size_t)z * 4096 * 256;
#pragma unroll
        for (int m = 0; m < 4; ++m) { const int rr = rbase + wr * 64 + m * 16 + frow;
#pragma unroll
            for (int n = 0; n < 4; ++n) { const int c = wc * 64 + n * 16 + fq * 4; const f32x4 b = *(const f32x4*)(cb + c); f32x4 v = acc[m][n] + b;
                u32x2 w; w.x = pk2(siluf_(v.x), siluf_(v.y)); w.y = pk2(siluf_(v.z), siluf_(v.w)); *(u32x2*)(hid + (size_t)rr * 256 + c) = w; } }
    } };
DEV void phase_cmp_a(const Params& p, unsigned char* lds) {
    const int vb = vblock(), G = gridDim.x;
    for (int u = vb; u < 64; u += G) {
        const int z = u >> 5, rbase = (u & 31) * 128;
        ACmp al{(const bf16_t*)(p.ws + (z ? WS_VC : WS_KC)), (u & 31) >> 1, (u & 1) * 128};
        BRows bl{(const bf16_t*)(p.ws + WS_CW1T) + (size_t)z * 256 * 2048, 2048};
        EpiCmpA ep{p, z, rbase};
        gemm_tile(lds, al, bl, 2048 / 64, ep);
    }
}
struct BClamp64 { const bf16_t* base; size_t ld; DEV const bf16_t* ptr(int n, int kt) const { return base + (size_t)(n & 63) * ld + kt * 64; } };
struct EpiCmpB { const Params& p; int z, rbase;
    DEV void operator()(f32x4 (&acc)[4][4], int wr, int wc, int lane) const {
        if (wc != 0) return;
        const int frow = lane & 15, fq = lane >> 4;
        bf16_t* dst = (bf16_t*)(p.ws + (z ? WS_VCMP : WS_KCMP));
#pragma unroll
        for (int m = 0; m < 4; ++m) { const int rr = rbase + wr * 64 + m * 16 + frow;
            float r = 1.f;
            if (z == 0) { float ss = 0.f;
#pragma unroll
                for (int n = 0; n < 4; ++n) { const f32x4 v = acc[m][n]; ss += (v.x * v.x + v.y * v.y) + (v.z * v.z + v.w * v.w); }
                ss += __shfl_xor(ss, 16); ss += __shfl_xor(ss, 32); r = rsqrtf(ss * (1.f / 64.f) + RMS_EPS); }
            const int bg = rr >> 8, c = rr & 255;
            if (c < NC) {
#pragma unroll
                for (int n = 0; n < 4; ++n) { const int d = n * 16 + fq * 4; f32x4 v = acc[m][n] * r;
                    if (z == 0) { const f32x4 g = *(const f32x4*)(p.g_k + d); v = v * g;
                        u32x2 w; w.x = pk2(v.x, v.y); w.y = pk2(v.z, v.w); *(u32x2*)(dst + ((size_t)bg * 256 + c) * 64 + d) = w; }
                    else { bf16_t* o = dst + ((size_t)bg * 64 + d) * 256 + c; o[0] = f2bf(v.x); o[256] = f2bf(v.y); o[512] = f2bf(v.z); o[768] = f2bf(v.w); } } }
        }
    } };
DEV void phase_cmp_b(const Params& p, unsigned char* lds) {
    const int vb = vblock(), G = gridDim.x;
    for (int u = vb; u < 64; u += G) {
        const int z = u >> 5, rbase = (u & 31) * 128;
        ARows al{(const bf16_t*)(p.ws + WS_HID) + ((size_t)z * 4096 + rbase) * 256, 256};
        BClamp64 bl{(const bf16_t*)(p.ws + WS_CW2T) + (size_t)z * 64 * 256, 256};
        EpiCmpB ep{p, z, rbase};
        gemm_tile(lds, al, bl, 256 / 64, ep);
    }
}

constexpr int CM_K = 0, CM_V = 32768, CM_VSTR = 520, CM_IMP = CM_V + 64 * CM_VSTR, CM_LDS = CM_IMP + 4 * 16384 + 1024;
DEV void cm_scores(const unsigned char* kbase, int kt, const bf16x8 (&qf)[4], int r31, int hh, f32x16 (&sacc)[2]) {
#pragma unroll
    for (int kt2 = 0; kt2 < 2; ++kt2) {
#pragma unroll
        for (int i = 0; i < 16; ++i) sacc[kt2][i] = 0.f;
        const int row = 64 * kt + 32 * kt2 + r31; const int sx = (row >> 1) & 7;
#pragma unroll
        for (int s = 0; s < 4; ++s) { const bf16x8 kf = *(const bf16x8*)(kbase + row * 128 + (((2 * s + hh) ^ sx) << 4));
            sacc[kt2] = __builtin_amdgcn_mfma_f32_32x32x16_bf16(kf, qf[s], sacc[kt2], 0, 0, 0); }
    }
}
DEV void phase_cmp_attn(const Params& p, unsigned char* lds) {
    const int tid = threadIdx.x, lane = tid & 63, wid = tid >> 6;
    const int vb = vblock(), G = gridDim.x;
    unsigned char* ws = p.ws;
    const int r31 = lane & 31, hh = lane >> 5;
    float* impl = (float*)(lds + CM_IMP);
    for (int it = vb; it < 1024; it += G) {
        int ci, bg;
        if (G == 256) { const int x = vb >> 5, jb = vb & 31, rnd = it / G, i = rnd * 32 + ((rnd & 1) ? 31 - jb : jb); ci = 63 - (i >> 1); bg = 2 * x + (i & 1); }
        else { ci = 63 - (it >> 4); bg = it & 15; }
        const int b = bg >> 1, g = bg & 1;
        const int nvis = min(NC, 4 * ci + 3), ntile = (nvis + 63) >> 6;
        const int head = g * 4 + (wid >> 1);
        const int tokl = (wid & 1) * 32 + r31, t = ci * 64 + tokl;
        const size_t tok = (size_t)b * SEQ + t;
        const int nv = t >= 31 ? min(NC, (t - 31) / 16 + 1) : 0;
        const float gate_c = ((const float*)(ws + WS_GATES))[tok * 24 + head * 3 + 0];
        __syncthreads();
        {
            const bf16_t* kc = (const bf16_t*)(ws + WS_KCMP) + (size_t)bg * 256 * 64; const bf16_t* vt = (const bf16_t*)(ws + WS_VCMP) + (size_t)bg * 64 * 256;
            const int cpr = ntile * 8;
            u32x4 rk[4], rv[4];
#pragma unroll
            for (int i = 0; i < 4; ++i) if (i < ntile) { const int idx = tid + NT * i; rk[i] = *(const u32x4*)(kc + (idx >> 3) * 64 + (idx & 7) * 8); const int d = idx / cpr, ck = idx % cpr; rv[i] = *(const u32x4*)(vt + d * 256 + ck * 8); }
#pragma unroll
            for (int i = 0; i < 4; ++i) if (i < ntile) { const int idx = tid + NT * i; *(u32x4*)(lds + CM_K + swz(idx >> 3, idx & 7)) = rk[i];
                const int d = idx / cpr, ck = idx % cpr; u32x2 a, c2; a.x = rv[i].x; a.y = rv[i].y; c2.x = rv[i].z; c2.y = rv[i].w; unsigned char* o = lds + CM_V + d * CM_VSTR + ck * 16; *(u32x2*)o = a; *(u32x2*)(o + 8) = c2; }
        }
        bf16x8 qf[4];
        { const bf16_t* qp = (const bf16_t*)(ws + WS_Q) + ((size_t)(b * 8 + head) * SEQ + t) * 64 + 8 * hh;
#pragma unroll
            for (int s = 0; s < 4; ++s) qf[s] = *(const bf16x8*)(qp + 16 * s); }
        __syncthreads();
        float l_run = 0.f;
        f32x16 ot[2];
#pragma unroll
        for (int dt = 0; dt < 2; ++dt)
#pragma unroll
            for (int i = 0; i < 16; ++i) ot[dt][i] = 0.f;
        float carry = 0.f;
#pragma unroll
        for (int kt = 0; kt < 4; ++kt) if (kt < ntile) {
            f32x16 sacc[2];
            cm_scores(lds + CM_K, kt, qf, r31, hh, sacc);
#pragma unroll
            for (int kt2 = 0; kt2 < 2; ++kt2)
#pragma unroll
                for (int i = 0; i < 16; ++i) { const int c = 64 * kt + 32 * kt2 + (i & 3) + 8 * (i >> 2) + 4 * hh; const float e_ = (c < nv) ? __builtin_amdgcn_exp2f(sacc[kt2][i]) : 0.f; sacc[kt2][i] = e_; l_run += e_; }
            {
                float own[8], xs[8];
#pragma unroll
                for (int kt2 = 0; kt2 < 2; ++kt2)
#pragma unroll
                    for (int g4 = 0; g4 < 4; ++g4) { const float e3 = 0.5f * sacc[kt2][4 * g4 + 3];
                        own[4 * kt2 + g4] = (sacc[kt2][4 * g4] + sacc[kt2][4 * g4 + 1]) + (sacc[kt2][4 * g4 + 2] + e3); xs[4 * kt2 + g4] = __shfl_xor(e3, 32); }
                float* io = impl + (wid >> 1) * 4096 + tokl * 64 + 16 * kt + hh;
#pragma unroll
                for (int gi = 0; gi < 8; ++gi) io[2 * gi] = own[gi] + (hh ? xs[gi] : (gi > 0 ? xs[gi > 0 ? gi - 1 : 0] : carry));
                carry = xs[7];
            }
#pragma unroll
            for (int kt2 = 0; kt2 < 2; ++kt2)
#pragma unroll
                for (int s2 = 0; s2 < 2; ++s2) {
                    bf16x8 pf; { u32x4 w; w.x = pk2(sacc[kt2][8 * s2 + 0], sacc[kt2][8 * s2 + 1]); w.y = pk2(sacc[kt2][8 * s2 + 2], sacc[kt2][8 * s2 + 3]);
                        w.z = pk2(sacc[kt2][8 * s2 + 4], sacc[kt2][8 * s2 + 5]); w.w = pk2(sacc[kt2][8 * s2 + 6], sacc[kt2][8 * s2 + 7]); pf = __builtin_bit_cast(bf16x8, w); }
#pragma unroll
                    for (int dt = 0; dt < 2; ++dt) {
                        const unsigned char* va = lds + CM_V + (32 * dt + r31) * CM_VSTR + (64 * kt + 32 * kt2 + 16 * s2 + 4 * hh) * 2;
                        const u32x2 lo = *(const u32x2*)(va), hi = *(const u32x2*)(va + 16);
                        u32x4 w; w.x = lo.x; w.y = lo.y; w.z = hi.x; w.w = hi.y;
                        ot[dt] = __builtin_amdgcn_mfma_f32_32x32x16_bf16(__builtin_bit_cast(bf16x8, w), pf, ot[dt], 0, 0, 0);
                    }
                }
        }
        float invL; { const float L = l_run + __shfl_xor(l_run, 32); invL = L > 0.f ? 1.f / L : 0.f; }
        if (hh == 0) impl[16384 + (wid >> 1) * 64 + tokl] = invL;
        {
            const float sc = gate_c * invL;
            bf16_t* ocp = (bf16_t*)(ws + WS_OC) + tok * 512 + head * 64;
#pragma unroll
            for (int dt = 0; dt < 2; ++dt)
#pragma unroll
                for (int g4 = 0; g4 < 4; ++g4) { const int d0 = 32 * dt + 8 * g4 + 4 * hh;
                    u32x2 w; w.x = pk2(ot[dt][4 * g4 + 0] * sc, ot[dt][4 * g4 + 1] * sc); w.y = pk2(ot[dt][4 * g4 + 2] * sc, ot[dt][4 * g4 + 3] * sc); *(u32x2*)(ocp + d0) = w; }
        }
        __syncthreads();
        for (int tt = 0; tt < 8; ++tt) {
            const int tl = wid * 8 + tt, cur = ci;
            unsigned long long mask;
            if (cur < 16) mask = (2ull << cur) - 1ull;
            else {
                const bool valid = lane <= cur;
                const float imp = (impl[tl * 64 + lane] * impl[16384 + tl] + impl[4096 + tl * 64 + lane] * impl[16384 + 64 + tl]) + (impl[8192 + tl * 64 + lane] * impl[16384 + 128 + tl] + impl[12288 + tl * 64 + lane] * impl[16384 + 192 + tl]);
                const unsigned key = (lane == 0 || lane == cur) ? 0x7F800000u : __float_as_uint(imp);
                unsigned T = 0u;
                for (int bit = 30; bit >= 0; --bit) { const unsigned cand = T | (1u << bit); if (__popcll(__ballot(valid && key >= cand)) >= 16) T = cand; }
                const unsigned long long gt = __ballot(valid && key > T), eq = __ballot(valid && key == T);
                const int need = 16 - __popcll(gt);
                const int below = __popcll(eq & ((1ull << lane) - 1ull));
                mask = gt | __ballot(valid && key == T && below < need);
            }
            if (lane == 0) ((unsigned long long*)(ws + WS_SELM))[(size_t)bg * SEQ + ci * 64 + tl] = mask;
        }
    }
}

constexpr int FA_KB = 64 * 128, FA_VB = 64 * 136, FA_STAGE = FA_KB + FA_VB, FA_LDS = 2 * FA_STAGE + 1024;
template <bool SEL>
DEV void fa_branch(unsigned char* lds, const bf16_t* Kb, const bf16_t* VTb, int ci, int bg, const bf16x8 (&qf)[4], int t, unsigned long long mymask, unsigned long long need,
                   f32x16 (&ot)[2], float& m_run, float& l_run) {
    const int tid = threadIdx.x, lane = tid & 63;
    const int r31 = lane & 31, hh = lane >> 5;
    const int lrow = tid >> 3, lch = tid & 7;
    const bf16_t* kg = Kb + ((size_t)bg * SEQ + lrow) * 64 + lch * 8;
    const bf16_t* vg = VTb + ((size_t)bg * 64 + lrow) * SEQ + lch * 8;
    const int koff = lrow * 128 + ((lch ^ ((lrow >> 1) & 7)) << 4), voff = FA_KB + lrow * 136 + lch * 16;
    int jlo, jhi; unsigned long long todo;
    if (SEL) { todo = need; jlo = 0; jhi = ci; } else { jlo = ci >= 8 ? ci - 8 : 0; jhi = ci; todo = 0; }
    int j = jlo;
    if (SEL) { if (todo == 0) return; j = __builtin_ctzll(todo); todo &= todo - 1; }
    u32x4 rk = *(const u32x4*)(kg + (size_t)j * 64 * 64), rv = *(const u32x4*)(vg + (size_t)j * 64);
    __syncthreads();
    *(u32x4*)(lds + koff) = rk; { u32x2 a, b2; a.x = rv.x; a.y = rv.y; b2.x = rv.z; b2.y = rv.w; *(u32x2*)(lds + voff) = a; *(u32x2*)(lds + voff + 8) = b2; }
    __syncthreads();
    int st = 0; bool seen = false;
    for (;;) {
        int jn; bool more;
        if (SEL) { more = (todo != 0); jn = more ? __builtin_ctzll(todo) : 0; todo &= todo - 1; } else { jn = j + 1; more = (jn <= jhi); }
        if (more) { rk = *(const u32x4*)(kg + (size_t)jn * 64 * 64); rv = *(const u32x4*)(vg + (size_t)jn * 64); }
        const unsigned char* base = lds + st * FA_STAGE;
        const bool bit = SEL ? ((mymask >> j) & 1ull) != 0 : true;
        const float cinit = (SEL && !bit) ? -__builtin_inff() : -m_run;
        f32x16 sacc[2];
#pragma unroll
        for (int kt2 = 0; kt2 < 2; ++kt2) {
#pragma unroll
            for (int i = 0; i < 16; ++i) sacc[kt2][i] = cinit;
            const int row = 32 * kt2 + r31; const int sx = (row >> 1) & 7;
#pragma unroll
            for (int s = 0; s < 4; ++s) { const bf16x8 kf = *(const bf16x8*)(base + row * 128 + (((2 * s + hh) ^ sx) << 4));
                sacc[kt2] = __builtin_amdgcn_mfma_f32_32x32x16_bf16(kf, qf[s], sacc[kt2], 0, 0, 0); }
        }
        const bool boundary = SEL ? (j == ci) : (j == ci || j + 8 <= ci);
        float mx = -__builtin_inff();
        if (boundary) {
#pragma unroll
            for (int kt2 = 0; kt2 < 2; ++kt2)
#pragma unroll
                for (int i = 0; i < 16; ++i) { const int key = 64 * j + 32 * kt2 + (i & 3) + 8 * (i >> 2) + 4 * hh;
                    const bool ok = SEL ? (key <= t) : (key <= t && t - key < 512);
                    const float v = ok ? sacc[kt2][i] : -__builtin_inff(); sacc[kt2][i] = v; mx = fmaxf(mx, v); }
        } else {
#pragma unroll
            for (int kt2 = 0; kt2 < 2; ++kt2)
#pragma unroll
                for (int i = 0; i < 16; ++i) mx = fmaxf(mx, sacc[kt2][i]);
        }
        mx = fmaxf(mx, __shfl_xor(mx, 32));
        const bool live = mx > -__builtin_inff();
        const bool need = (mx > 8.f) || (!seen && live && mx < -8.f);
        if (__any(need)) {
            const float d = need ? mx : 0.f;
            const float alpha = d > 0.f ? __builtin_amdgcn_exp2f(-d) : 1.f;
            m_run += d; l_run *= alpha;
#pragma unroll
            for (int dt = 0; dt < 2; ++dt)
#pragma unroll
                for (int i = 0; i < 16; ++i) ot[dt][i] *= alpha;
#pragma unroll
            for (int kt2 = 0; kt2 < 2; ++kt2)
#pragma unroll
                for (int i = 0; i < 16; ++i) sacc[kt2][i] -= d;
        }
        seen = seen || live;
        float rs = 0.f;
#pragma unroll
        for (int kt2 = 0; kt2 < 2; ++kt2)
#pragma unroll
            for (int i = 0; i < 16; ++i) { const float e = __builtin_amdgcn_exp2f(sacc[kt2][i]); sacc[kt2][i] = e; rs += e; }
        l_run += rs;
#pragma unroll
        for (int kt2 = 0; kt2 < 2; ++kt2)
#pragma unroll
            for (int s2 = 0; s2 < 2; ++s2) {
                bf16x8 pf; { u32x4 w; w.x = pk2(sacc[kt2][8 * s2 + 0], sacc[kt2][8 * s2 + 1]); w.y = pk2(sacc[kt2][8 * s2 + 2], sacc[kt2][8 * s2 + 3]);
                    w.z = pk2(sacc[kt2][8 * s2 + 4], sacc[kt2][8 * s2 + 5]); w.w = pk2(sacc[kt2][8 * s2 + 6], sacc[kt2][8 * s2 + 7]); pf = __builtin_bit_cast(bf16x8, w); }
#pragma unroll
                for (int dt = 0; dt < 2; ++dt) {
                    const unsigned char* va = base + FA_KB + (32 * dt + r31) * 136 + (32 * kt2 + 16 * s2 + 4 * hh) * 2;
                    const u32x2 lo = *(const u32x2*)(va), hi = *(const u32x2*)(va + 16);
                    u32x4 w; w.x = lo.x; w.y = lo.y; w.z = hi.x; w.w = hi.y;
                    ot[dt] = __builtin_amdgcn_mfma_f32_32x32x16_bf16(__builtin_bit_cast(bf16x8, w), pf, ot[dt], 0, 0, 0);
                }
            }
        if (!more) break;
        { unsigned char* nb = lds + (st ^ 1) * FA_STAGE; *(u32x4*)(nb + koff) = rk; u32x2 a, b2; a.x = rv.x; a.y = rv.y; b2.x = rv.z; b2.y = rv.w; *(u32x2*)(nb + voff) = a; *(u32x2*)(nb + voff + 8) = b2; }
        __syncthreads();
        st ^= 1; j = jn;
    }
}
DEV void phase_flash(const Params& p, unsigned char* lds) {
    const int tid = threadIdx.x, lane = tid & 63, wid = tid >> 6;
    const int vb = vblock(), G = gridDim.x;
    unsigned char* ws = p.ws;
    const int r31 = lane & 31, hh = lane >> 5;
    unsigned long long* red = (unsigned long long*)(lds + 2 * FA_STAGE);
    for (int it = vb; it < 1024; it += G) {
        int ci, bg;
        if (G == 256) { const int x = vb >> 5, jb = vb & 31, rnd = it / G, i = rnd * 32 + ((rnd & 1) ? 31 - jb : jb); ci = 63 - (i >> 1); bg = 2 * x + (i & 1); }
        else { ci = 63 - (it >> 4); bg = it & 15; }
        const int b = bg >> 1, g = bg & 1;
        const int head = g * 4 + (wid >> 1);
        const int t = ci * 64 + (wid & 1) * 32 + r31;
        const size_t tok = (size_t)b * SEQ + t;
        bf16x8 qf[4];
        { const bf16_t* qp = (const bf16_t*)(ws + WS_Q) + ((size_t)(b * 8 + head) * SEQ + t) * 64 + 8 * hh;
#pragma unroll
            for (int s = 0; s < 4; ++s) qf[s] = *(const bf16x8*)(qp + 16 * s); }
        const unsigned long long mymask = ((const unsigned long long*)(ws + WS_SELM))[(size_t)bg * SEQ + t];
        const float gate_s = ((const float*)(ws + WS_GATES))[tok * 24 + head * 3 + 1], gate_w = ((const float*)(ws + WS_GATES))[tok * 24 + head * 3 + 2];
        u32x2 ocv[2][4];
#pragma unroll
        for (int dt = 0; dt < 2; ++dt)
#pragma unroll
            for (int g4 = 0; g4 < 4; ++g4) ocv[dt][g4] = *(const u32x2*)((const bf16_t*)(ws + WS_OC) + tok * 512 + head * 64 + 32 * dt + 8 * g4 + 4 * hh);
        unsigned long long orm = mymask;
#pragma unroll
        for (int o = 1; o < 32; o <<= 1) { const unsigned lo = __shfl_xor((unsigned)orm, o), hi = __shfl_xor((unsigned)(orm >> 32), o); orm |= ((unsigned long long)hi << 32) | lo; }
        __syncthreads();
        if (wid < 2 && lane == 0) red[wid] = orm;
        __syncthreads();
        const unsigned long long need = red[0] | red[1];
        f32x16 oc[2];
        {
            f32x16 ot[2]; float m_run = 0.f, l_run = 0.f;
#pragma unroll
            for (int dt = 0; dt < 2; ++dt)
#pragma unroll
                for (int i = 0; i < 16; ++i) ot[dt][i] = 0.f;
            fa_branch<true>(lds, (const bf16_t*)(ws + WS_KS), (const bf16_t*)(ws + WS_VST), ci, bg, qf, t, mymask, need, ot, m_run, l_run);
            const float lt = l_run + __shfl_xor(l_run, 32);
            const float sc = gate_s / lt;
#pragma unroll
            for (int dt = 0; dt < 2; ++dt)
#pragma unroll
                for (int i = 0; i < 16; ++i) oc[dt][i] = ot[dt][i] * sc;
        }
        {
            f32x16 ot[2]; float m_run = 0.f, l_run = 0.f;
#pragma unroll
            for (int dt = 0; dt < 2; ++dt)
#pragma unroll
                for (int i = 0; i < 16; ++i) ot[dt][i] = 0.f;
            fa_branch<false>(lds, (const bf16_t*)(ws + WS_KW), (const bf16_t*)(ws + WS_VWT), ci, bg, qf, t, 0ull, 0ull, ot, m_run, l_run);
            const float lt = l_run + __shfl_xor(l_run, 32);
            const float sc = gate_w / lt;
#pragma unroll
            for (int dt = 0; dt < 2; ++dt)
#pragma unroll
                for (int i = 0; i < 16; ++i) oc[dt][i] += ot[dt][i] * sc;
        }
        {
            bf16_t* mix = (bf16_t*)(ws + WS_R1) + tok * 1024 + head * 64;
            float ss = 0.f;
#pragma unroll
            for (int dt = 0; dt < 2; ++dt)
#pragma unroll
                for (int g4 = 0; g4 < 4; ++g4) { const int d0 = 32 * dt + 8 * g4 + 4 * hh; const u32x2 c = ocv[dt][g4];
                    const float v0 = oc[dt][4 * g4 + 0] + bflo(c.x), v1 = oc[dt][4 * g4 + 1] + bfhi(c.x), v2 = oc[dt][4 * g4 + 2] + bflo(c.y), v3 = oc[dt][4 * g4 + 3] + bfhi(c.y);
                    ss += (v0 * v0 + v1 * v1) + (v2 * v2 + v3 * v3);
                    u32x2 w; w.x = pk2(v0, v1); w.y = pk2(v2, v3); *(u32x2*)(mix + d0) = w; }
            ss += __shfl_xor(ss, 32);
            if (hh == 0) atomicAdd((float*)(ws + WS_ROWSS) + tok, ss);
        }
    }
}

DEV int swz256(int row, int chunk) { return row * 256 + ((chunk ^ (row & 15)) << 4); }
DEV void hgrn_cumsum(const Params& p, int bh, int c, float* segs, f32x2 (&lf)[8], f32x2 (&a)[8], f32x2& r, f32x2& alast) {
    const int tid = threadIdx.x, k2 = tid & 63, tq = tid >> 6;
    const int b = bh >> 2, h = bh & 3;
    const bf16_t* HL = (const bf16_t*)(p.ws + WS_HLOGF) + ((size_t)b * SEQ + c * 64 + tq * 8) * 512 + h * 128 + 2 * k2;
#pragma unroll
    for (int i = 0; i < 8; ++i) { const unsigned w = *(const unsigned*)(HL + (size_t)i * 512); lf[i] = (f32x2){bflo(w), bfhi(w)}; }
    f32x2 run = (f32x2){0.f, 0.f};
#pragma unroll
    for (int i = 0; i < 8; ++i) { run = run + lf[i]; a[i] = run; }
    *(f32x2*)(segs + tq * 128 + 2 * k2) = run;
    __syncthreads();
    f32x2 off = (f32x2){0.f, 0.f}, tot = off, rr = off;
#pragma unroll
    for (int q = 0; q < 8; ++q) { const f32x2 s = *(const f32x2*)(segs + q * 128 + 2 * k2); if (q < tq) off = off + s; if (q < 4) rr = rr + s; tot = tot + s; }
#pragma unroll
    for (int i = 0; i < 8; ++i) a[i] = a[i] + off;
    r = rr; alast = tot;
}
DEV void hgrn_stage_vt(const Params& p, int bh, int c, unsigned char* vt) {
    const int tid = threadIdx.x, k2 = tid & 63, tq = tid >> 6;
    const int b = bh >> 2, h = bh & 3;
    const bf16_t* HV = (const bf16_t*)(p.ws + WS_HV) + ((size_t)b * SEQ + c * 64 + tq * 8) * 512 + h * 128 + 2 * k2;
    unsigned vv[8];
#pragma unroll
    for (int i = 0; i < 8; ++i) vv[i] = *(const unsigned*)(HV + (size_t)i * 512);
    u32x4 lo, hi;
    lo.x = (vv[0] & 0xffffu) | (vv[1] << 16); lo.y = (vv[2] & 0xffffu) | (vv[3] << 16); lo.z = (vv[4] & 0xffffu) | (vv[5] << 16); lo.w = (vv[6] & 0xffffu) | (vv[7] << 16);
    hi.x = (vv[0] >> 16) | (vv[1] & 0xffff0000u); hi.y = (vv[2] >> 16) | (vv[3] & 0xffff0000u); hi.z = (vv[4] >> 16) | (vv[5] & 0xffff0000u); hi.w = (vv[6] >> 16) | (vv[7] & 0xffff0000u);
    *(u32x4*)(vt + swz(2 * k2, tq)) = lo; *(u32x4*)(vt + swz(2 * k2 + 1, tq)) = hi;
}
constexpr int H1_KT = 0, H1_VT = 16384, H1_SEG = 32768, H1_EK = H1_SEG + 4096;
DEV void phase_hgrn_a1(const Params& p, unsigned char* lds, int vb0, int nb) {
    const int tid = threadIdx.x, lane = tid & 63, wid = tid >> 6, k2 = tid & 63, tq = tid >> 6;
    const int vb = vblock(), G = gridDim.x;
    const int frow = lane & 15, fq = lane >> 4, wr = wid >> 1, wc = wid & 1;
    float* segs = (float*)(lds + H1_SEG); float* ek = (float*)(lds + H1_EK);
    bf16_t* ubuf = (bf16_t*)(p.ws + WS_UBUF); float* dbuf = (float*)(p.ws + WS_DBUF);
    if (vb < vb0) return;
    for (int item = vb - vb0; item < 2048; item += nb) {
        const int bh = item >> 6, c = item & 63;
        __syncthreads();
        f32x2 lf[8], a[8], r, al;
        hgrn_cumsum(p, bh, c, segs, lf, a, r, al);
        {
            float kx[8], ky[8];
#pragma unroll
            for (int i = 0; i < 8; ++i) { kx[i] = (1.f - __expf(lf[i].x)) * __expf(fminf(r.x - a[i].x, 80.f)); ky[i] = (1.f - __expf(lf[i].y)) * __expf(fminf(r.y - a[i].y, 80.f)); }
            u32x4 w0, w1;
            w0.x = pk2(kx[0], kx[1]); w0.y = pk2(kx[2], kx[3]); w0.z = pk2(kx[4], kx[5]); w0.w = pk2(kx[6], kx[7]);
            w1.x = pk2(ky[0], ky[1]); w1.y = pk2(ky[2], ky[3]); w1.z = pk2(ky[4], ky[5]); w1.w = pk2(ky[6], ky[7]);
            *(u32x4*)(lds + H1_KT + swz(2 * k2, tq)) = w0; *(u32x4*)(lds + H1_KT + swz(2 * k2 + 1, tq)) = w1;
        }
        hgrn_stage_vt(p, bh, c, lds + H1_VT);
        if (tq == 7) { ek[2 * k2] = __expf(al.x - r.x); ek[2 * k2 + 1] = __expf(al.y - r.y); f32x2 d; d.x = __expf(al.x); d.y = __expf(al.y); *(f32x2*)(dbuf + (size_t)item * 128 + 2 * k2) = d; }
        __syncthreads();
        f32x4 acc[2][4];
#pragma unroll
        for (int m = 0; m < 2; ++m)
#pragma unroll
            for (int n = 0; n < 4; ++n) acc[m][n] = (f32x4){0.f, 0.f, 0.f, 0.f};
        const int sx = (frow >> 1) & 7;
#pragma unroll
        for (int ks = 0; ks < 2; ++ks) {
            const int co = ((ks * 4 + fq) ^ sx) << 4;
            bf16x8 af[2], bfr[4];
#pragma unroll
            for (int m = 0; m < 2; ++m) af[m] = *(const bf16x8*)(lds + H1_VT + (32 * wr + 16 * m + frow) * 128 + co);
#pragma unroll
            for (int n = 0; n < 4; ++n) bfr[n] = *(const bf16x8*)(lds + H1_KT + (64 * wc + 16 * n + frow) * 128 + co);
#pragma unroll
            for (int m = 0; m < 2; ++m)
#pragma unroll
                for (int n = 0; n < 4; ++n) acc[m][n] = __builtin_amdgcn_mfma_f32_16x16x32_bf16(bfr[n], af[m], acc[m][n], 0, 0, 0);
        }
#pragma unroll
        for (int m = 0; m < 2; ++m) { const int v = 32 * wr + 16 * m + frow;
#pragma unroll
            for (int n = 0; n < 4; ++n) { const int k0 = 64 * wc + 16 * n + 4 * fq; const f32x4 e = *(const f32x4*)(ek + k0); const f32x4 o = acc[m][n] * e;
                u32x2 w; w.x = pk2(o.x, o.y); w.y = pk2(o.z, o.w); *(u32x2*)(ubuf + ((size_t)item * 128 + v) * 128 + k0) = w; } }
    }
}
DEV void phase_hgrn_a2(const Params& p, unsigned char* lds) {
    const int G = gridDim.x;
    bf16_t* ubuf = (bf16_t*)(p.ws + WS_UBUF); const float* dbuf = (const float*)(p.ws + WS_DBUF);
    for (int gid = blockIdx.x * NT + threadIdx.x; gid < 131072; gid += G * NT) {
        const int bh = gid >> 12, v = (gid >> 5) & 127, k4 = gid & 31;
        bf16_t* u = ubuf + ((size_t)bh * 64 * 128 + v) * 128 + 4 * k4;
        const float* d = dbuf + (size_t)bh * 64 * 128 + 4 * k4;
        f32x4 S = (f32x4){0.f, 0.f, 0.f, 0.f};
        for (int c0 = 0; c0 < 64; c0 += 8) {
            u32x2 uu[8]; f32x4 dd[8];
#pragma unroll
            for (int j = 0; j < 8; ++j) { uu[j] = *(const u32x2*)(u + (size_t)(c0 + j) * 16384); dd[j] = *(const f32x4*)(d + (size_t)(c0 + j) * 128); }
#pragma unroll
            for (int j = 0; j < 8; ++j) { u32x2 w; w.x = pk2(S.x, S.y); w.y = pk2(S.z, S.w); *(u32x2*)(u + (size_t)(c0 + j) * 16384) = w;
                S.x = dd[j].x * S.x + bflo(uu[j].x); S.y = dd[j].y * S.y + bfhi(uu[j].x); S.z = dd[j].z * S.z + bflo(uu[j].y); S.w = dd[j].w * S.w + bfhi(uu[j].y); }
        }
    }
}
constexpr int H3_QH = 0, H3_QA = 16384, H3_KH = 32768, H3_VT = 49152, H3_PP = 65536, H3_ST = 73728, H3_SEG = 106496, H3_RED = 110592;
DEV void phase_hgrn_a3(const Params& p, unsigned char* lds) {
    const int tid = threadIdx.x, lane = tid & 63, wid = tid >> 6, k2 = tid & 63, tq = tid >> 6;
    const int vb = vblock(), G = gridDim.x;
    const int frow = lane & 15, fq = lane >> 4;
    float* segs = (float*)(lds + H3_SEG); float* red = (float*)(lds + H3_RED);
    const bf16_t* ubuf = (const bf16_t*)(p.ws + WS_UBUF);
    for (int item = vb; item < 2048; item += G) {
        const int bh = item >> 6, c = item & 63, b = bh >> 2, h = bh & 3;
        __syncthreads();
        f32x2 lf[8], a[8], r, al;
        hgrn_cumsum(p, bh, c, segs, lf, a, r, al);
        {
            const bf16_t* HQ = (const bf16_t*)(p.ws + WS_HQ) + ((size_t)b * SEQ + c * 64 + tq * 8) * 512 + h * 128 + 2 * k2;
            unsigned qq[8];
#pragma unroll
            for (int i = 0; i < 8; ++i) qq[i] = *(const unsigned*)(HQ + (size_t)i * 512);
#pragma unroll
            for (int i = 0; i < 8; ++i) { const int t = 8 * tq + i; const float q0 = bflo(qq[i]), q1 = bfhi(qq[i]);
                const int off = swz256(t, k2 >> 2) + (k2 & 3) * 4;
                *(unsigned*)(lds + H3_QH + off) = pk2(q0 * __expf(fminf(a[i].x - r.x, 80.f)), q1 * __expf(fminf(a[i].y - r.y, 80.f)));
                *(unsigned*)(lds + H3_QA + off) = pk2(q0 * __expf(a[i].x), q1 * __expf(a[i].y));
                *(unsigned*)(lds + H3_KH + off) = pk2((1.f - __expf(lf[i].x)) * __expf(fminf(r.x - a[i].x, 80.f)), (1.f - __expf(lf[i].y)) * __expf(fminf(r.y - a[i].y, 80.f))); }
        }
        hgrn_stage_vt(p, bh, c, lds + H3_VT);
        {
            const bf16_t* st = ubuf + (size_t)item * 16384;
#pragma unroll
            for (int i = 0; i < 4; ++i) { const int q = tid + NT * i, v = q >> 4, ch = q & 15; *(u32x4*)(lds + H3_ST + swz256(v, ch)) = *(const u32x4*)(st + v * 128 + ch * 8); }
        }
        __syncthreads();
        {
            const int wr = wid >> 1, wc = wid & 1;
            f32x4 acc[2];
            acc[0] = (f32x4){0.f, 0.f, 0.f, 0.f}; acc[1] = acc[0];
            if (32 * wc <= 16 * wr + 15) {
#pragma unroll
                for (int ks = 0; ks < 4; ++ks) {
                    const int co = ((ks * 4 + fq) ^ frow) << 4;
                    const bf16x8 af = *(const bf16x8*)(lds + H3_QH + (16 * wr + frow) * 256 + co);
#pragma unroll
                    for (int n = 0; n < 2; ++n) { const bf16x8 bfr = *(const bf16x8*)(lds + H3_KH + (32 * wc + 16 * n + frow) * 256 + co);
                        acc[n] = __builtin_amdgcn_mfma_f32_16x16x32_bf16(bfr, af, acc[n], 0, 0, 0); }
                }
            }
            const int t = 16 * wr + frow;
#pragma unroll
            for (int n = 0; n < 2; ++n) { const int s0 = 32 * wc + 16 * n + 4 * fq; f32x4 v = acc[n];
                v.x = (s0 + 0 <= t) ? v.x : 0.f; v.y = (s0 + 1 <= t) ? v.y : 0.f; v.z = (s0 + 2 <= t) ? v.z : 0.f; v.w = (s0 + 3 <= t) ? v.w : 0.f;
                u32x2 w; w.x = pk2(v.x, v.y); w.y = pk2(v.z, v.w);
                *(u32x2*)(lds + H3_PP + t * 128 + ((((s0 >> 3)) ^ ((t >> 1) & 7)) << 4) + (s0 & 7) * 2) = w; }
        }
        __syncthreads();
        {
            const int wr = wid >> 2, wc = wid & 3;
            f32x4 acc[2][2];
#pragma unroll
            for (int m = 0; m < 2; ++m)
#pragma unroll
                for (int n = 0; n < 2; ++n) acc[m][n] = (f32x4){0.f, 0.f, 0.f, 0.f};
            const int sx = (frow >> 1) & 7;
#pragma unroll
            for (int ks = 0; ks < 2; ++ks) {
                const int co = ((ks * 4 + fq) ^ sx) << 4;
                bf16x8 af[2], bfr[2];
#pragma unroll
                for (int m = 0; m < 2; ++m) af[m] = *(const bf16x8*)(lds + H3_PP + (32 * wr + 16 * m + frow) * 128 + co);
#pragma unroll
                for (int n = 0; n < 2; ++n) bfr[n] = *(const bf16x8*)(lds + H3_VT + (32 * wc + 16 * n + frow) * 128 + co);
#pragma unroll
                for (int m = 0; m < 2; ++m)
#pragma unroll
                    for (int n = 0; n < 2; ++n) acc[m][n] = __builtin_amdgcn_mfma_f32_16x16x32_bf16(bfr[n], af[m], acc[m][n], 0, 0, 0);
            }
#pragma unroll
            for (int ks = 0; ks < 4; ++ks) {
                const int co = ((ks * 4 + fq) ^ frow) << 4;
                bf16x8 af[2], bfr[2];
#pragma unroll
                for (int m = 0; m < 2; ++m) af[m] = *(const bf16x8*)(lds + H3_QA + (32 * wr + 16 * m + frow) * 256 + co);
#pragma unroll
                for (int n = 0; n < 2; ++n) bfr[n] = *(const bf16x8*)(lds + H3_ST + (32 * wc + 16 * n + frow) * 256 + co);
#pragma unroll
                for (int m = 0; m < 2; ++m)
#pragma unroll
                    for (int n = 0; n < 2; ++n) acc[m][n] = __builtin_amdgcn_mfma_f32_16x16x32_bf16(bfr[n], af[m], acc[m][n], 0, 0, 0);
            }
            f32x4 gnv[2]; u32x2 ggv[2][2];
#pragma unroll
            for (int n = 0; n < 2; ++n) gnv[n] = *(const f32x4*)(p.g_hn + 32 * wc + 16 * n + 4 * fq);
#pragma unroll
            for (int m = 0; m < 2; ++m)
#pragma unroll
                for (int n = 0; n < 2; ++n) ggv[m][n] = *(const u32x2*)((const bf16_t*)(p.ws + WS_HG) + ((size_t)b * SEQ + c * 64 + 32 * wr + 16 * m + frow) * 512 + h * 128 + 32 * wc + 16 * n + 4 * fq);
#pragma unroll
            for (int m = 0; m < 2; ++m) { float ss = 0.f;
#pragma unroll
                for (int n = 0; n < 2; ++n) { const f32x4 v = acc[m][n]; ss += (v.x * v.x + v.y * v.y) + (v.z * v.z + v.w * v.w); }
                ss += __shfl_xor(ss, 16); ss += __shfl_xor(ss, 32);
                if (fq == 0) red[(32 * wr + 16 * m + frow) * 4 + wc] = ss; }
            __syncthreads();
#pragma unroll
            for (int m = 0; m < 2; ++m) { const int t = 32 * wr + 16 * m + frow; const f32x4 q4 = *(const f32x4*)(red + t * 4);
                const float rs = rsqrtf(((q4.x + q4.y) + (q4.z + q4.w)) * (1.f / 128.f) + RMS_EPS);
                const size_t row = (size_t)b * SEQ + c * 64 + t;
#pragma unroll
                for (int n = 0; n < 2; ++n) { const int v0 = 32 * wc + 16 * n + 4 * fq; const f32x4 gn = gnv[n]; const u32x2 gg = ggv[m][n];
                    const f32x4 o = acc[m][n];
                    u32x2 w; w.x = pk2(o.x * rs * gn.x * bflo(gg.x), o.y * rs * gn.y * bfhi(gg.x)); w.y = pk2(o.z * rs * gn.z * bflo(gg.y), o.w * rs * gn.w * bfhi(gg.y));
                    *(u32x2*)((bf16_t*)(p.ws + WS_R1) + row * 1024 + 512 + h * 128 + v0) = w; } }
        }
    }
}

DEV void phase_normalize(const Params& p, unsigned char* lds) {
    const int vb = vblock(), G = gridDim.x;
    unsigned char* ws = p.ws;
    __syncthreads();
    {
        float* tl = (float*)lds;
        for (int r = vb; r < 32 * 4 * 16; r += G) { const int e = r / 64, q = r % 64; SrcW13_4 s{p.w1 + (size_t)e * 1024 * 512, p.w3 + (size_t)e * 1024 * 512, p.ffn_g};
            convert_tile256(tl, s, (bf16_t*)(ws + WS_W13T) + (size_t)e * 1024 * 1024, 1024, (q / 16) * 256, (q % 16) * 64); }
    }
    __syncthreads();
}

struct EpiOut8 { const Params& p; static constexpr bool MIDSCALE = true;
    DEV float rowscale(int row) const { return rsqrtf(((const float*)(p.ws + WS_ROWSS))[row] * (1.f / 512.f) + RMS_EPS); }
    DEV int midk() const { return 8; }
    DEV void operator()(const f32x4 (&acc)[2][2][4][2], const pg8::Unit& u, int wr, int wc, int fr, int fq) const {
        const size_t off0 = ((size_t)u.pm * 256 + wr * 64 + fr) * DM + u.pn * 256 + 64 * wc + 8 * fq;
        const bf16_t* xb = (const bf16_t*)(p.ws + WS_XB);
        u32x4 xr[2][4][2];
#pragma unroll
        for (int ai = 0; ai < 2; ++ai)
#pragma unroll
            for (int m = 0; m < 4; ++m)
#pragma unroll
                for (int bj = 0; bj < 2; ++bj) xr[ai][m][bj] = *(const u32x4*)(xb + off0 + (size_t)(128 * ai + 16 * m) * DM + 32 * bj);
#pragma unroll
        for (int ai = 0; ai < 2; ++ai)
#pragma unroll
            for (int m = 0; m < 4; ++m)
#pragma unroll
                for (int bj = 0; bj < 2; ++bj) { const u32x4 w = xr[ai][m][bj]; float* o = p.out + off0 + (size_t)(128 * ai + 16 * m) * DM + 32 * bj;
                    *(f32x4*)(o) = (f32x4){bflo(w.x), bfhi(w.x), bflo(w.y), bfhi(w.y)} + acc[ai][bj][m][0]; *(f32x4*)(o + 4) = (f32x4){bflo(w.z), bfhi(w.z), bflo(w.w), bfhi(w.w)} + acc[ai][bj][m][1]; }
    } };
DEV void phase_outproj(const Params& p, unsigned char* lds) {
    pg8::Gemm g{(const bf16_t*)(p.ws + WS_R1), (const bf16_t*)(p.ws + WS_WOUTT), NTOK, DM, DM};
    pg8::StaticOrder S; S.init(NTOK, DM, (int)gridDim.x, (int)blockIdx.x);
    EpiOut8 E{p};
    if (((blockIdx.x >> 3) & 1) == 0) phase_normalize(p, lds);
    pg8::gemm_phase((PG8_LAS unsigned char*)lds, g, S, E);
    if (((blockIdx.x >> 3) & 1) != 0) phase_normalize(p, lds);
}

constexpr int RT_W = 0, RT_LG = 2 * 49152, RT_RS = RT_LG + 128 * 49 * 4, RT_HIST = RT_RS + 512, RT_BASE = RT_HIST + 1024, RT_LDS = RT_BASE + 1024;
DEV void phase_router(const Params& p, unsigned char* lds) {
    const int tid = threadIdx.x, lane = tid & 63, wid = tid >> 6, frow = lane & 15, fq = lane >> 4;
    const int vb = vblock(), G = gridDim.x;
    unsigned char* ws = p.ws;
    float* lg = (float*)(lds + RT_LG); float* rsd = (float*)(lds + RT_RS);
    int* hist = (int*)(lds + RT_HIST); int* basep = (int*)(lds + RT_BASE);
    const bf16_t* rw = (const bf16_t*)(ws + WS_RW);
    for (int it = vb; it < NTOK / 128; it += G) {
        const size_t row0 = (size_t)it * 128;
        const size_t trow = row0 + 16 * wid + frow;
        const float* hrow = p.out + trow * DM + 8 * fq;
        bf16_t* hbrow = (bf16_t*)(ws + WS_R1) + trow * DM + 8 * fq;
        f32x4 acc[3]; float ss = 0.f;
#pragma unroll
        for (int nt = 0; nt < 3; ++nt) acc[nt] = (f32x4){0.f, 0.f, 0.f, 0.f};
        if (tid < 128) hist[tid] = 0;
        u32x4 wreg[6]; f32x4 xa[4][2], xn[4][2];
#define RT_LOADW(kc_) do { _Pragma("unroll") for (int i = 0; i < 6; ++i) { const int idx = tid + NT * i, r = idx >> 5, c = idx & 31; wreg[i] = *(const u32x4*)(rw + (size_t)r * 1024 + (kc_) * 256 + c * 8); } } while (0)
#define RT_STOREW(buf_) do { _Pragma("unroll") for (int i = 0; i < 6; ++i) { const int idx = tid + NT * i, r = idx >> 5, c = idx & 31; *(u32x4*)(lds + RT_W + (buf_) * 49152 + r * 512 + ((c ^ (r & 15)) << 4)) = wreg[i]; } } while (0)
#define RT_LOADX(dst_, hc_) do { _Pragma("unroll") for (int ks = 0; ks < 4; ++ks) { dst_[ks][0] = *(const f32x4*)(hrow + (hc_) * 128 + 32 * ks); dst_[ks][1] = *(const f32x4*)(hrow + (hc_) * 128 + 32 * ks + 4); } } while (0)
        __syncthreads();
        RT_LOADW(0); RT_LOADX(xa, 0); RT_STOREW(0);
        __syncthreads();
#pragma unroll 1
        for (int hc = 0; hc < 8; ++hc) {
            if (hc < 7) RT_LOADX(xn, hc + 1);
            const unsigned char* wb = lds + RT_W + ((hc >> 1) & 1) * 49152;
#pragma unroll
            for (int ks = 0; ks < 4; ++ks) {
                const f32x4 a = xa[ks][0], b = xa[ks][1];
                ss += ((a.x * a.x + a.y * a.y) + (a.z * a.z + a.w * a.w)) + ((b.x * b.x + b.y * b.y) + (b.z * b.z + b.w * b.w));
                u32x4 hi; hi.x = pk2(a.x, a.y); hi.y = pk2(a.z, a.w); hi.z = pk2(b.x, b.y); hi.w = pk2(b.z, b.w);
                u32x4 lo; lo.x = pk2(a.x - bflo(hi.x), a.y - bfhi(hi.x)); lo.y = pk2(a.z - bflo(hi.y), a.w - bfhi(hi.y)); lo.z = pk2(b.x - bflo(hi.z), b.y - bfhi(hi.z)); lo.w = pk2(b.z - bflo(hi.w), b.w - bfhi(hi.w));
                *(u32x4*)(hbrow + hc * 128 + 32 * ks) = hi;
                const bf16x8 hh = __builtin_bit_cast(bf16x8, hi), hl = __builtin_bit_cast(bf16x8, lo);
                const int co = ((4 * (4 * (hc & 1) + ks) + fq) ^ frow) << 4;
#pragma unroll
                for (int nt = 0; nt < 3; ++nt) {
                    const bf16x8 whi = *(const bf16x8*)(wb + (16 * nt + frow) * 512 + co), wlo = *(const bf16x8*)(wb + (48 + 16 * nt + frow) * 512 + co);
                    acc[nt] = __builtin_amdgcn_mfma_f32_16x16x32_bf16(whi, hh, acc[nt], 0, 0, 0);
                    acc[nt] = __builtin_amdgcn_mfma_f32_16x16x32_bf16(wlo, hh, acc[nt], 0, 0, 0);
                    acc[nt] = __builtin_amdgcn_mfma_f32_16x16x32_bf16(whi, hl, acc[nt], 0, 0, 0);
                }
            }
            if ((hc & 1) == 0 && hc < 6) { RT_LOADW((hc >> 1) + 1); }
            if ((hc & 1) == 1 && hc < 7) { RT_STOREW(((hc >> 1) + 1) & 1); }
#pragma unroll
            for (int ks = 0; ks < 4; ++ks) { xa[ks][0] = xn[ks][0]; xa[ks][1] = xn[ks][1]; }
            if (hc & 1) __syncthreads();
        }
#undef RT_LOADW
#undef RT_STOREW
#undef RT_LOADX
        ss += __shfl_xor(ss, 16); ss += __shfl_xor(ss, 32);
        if (fq == 0) rsd[16 * wid + frow] = rsqrtf(ss * (1.f / DM) + RMS_EPS);
#pragma unroll
        for (int nt = 0; nt < 3; ++nt) { float* o = lg + (16 * wid + frow) * 49 + 16 * nt + 4 * fq; o[0] = acc[nt].x; o[1] = acc[nt].y; o[2] = acc[nt].z; o[3] = acc[nt].w; }
        __syncthreads();
        int bin = 0, slot = 0, ea = 0, eb = 0, sa = 0, sb = 0; float wa = 0.f, wb = 0.f;
        int* ehist = hist + 112; int* ebase = basep + 112;
        if (tid < 32) ehist[tid] = 0;
        __syncthreads();
        if (tid < 128) {
            const float rs = rsd[tid];
            ((float*)(ws + WS_RSTD2))[row0 + tid] = rs;
            float gl[4]; int gi = 0; float gm = -1e30f;
#pragma unroll
            for (int c = 0; c < 4; ++c) { gl[c] = lg[tid * 49 + c] * rs + p.b_group[c]; if (gl[c] > gm) { gm = gl[c]; gi = c; } }
            float gs = 0.f;
#pragma unroll
            for (int c = 0; c < 4; ++c) gs += __expf(gl[c] - gm);
            const float pg = 1.f / gs;
            float el[8]; int i0 = 0; float m0 = -1e30f;
#pragma unroll
            for (int c = 0; c < 8; ++c) { el[c] = lg[tid * 49 + 4 + gi * 8 + c] * rs + p.b_expert[gi * 8 + c]; if (el[c] > m0) { m0 = el[c]; i0 = c; } }
            int i1 = 0; float m1 = -1e30f;
#pragma unroll
            for (int c = 0; c < 8; ++c) if (c != i0 && el[c] > m1) { m1 = el[c]; i1 = c; }
            const float e1 = __expf(m1 - m0); const float w0 = pg / (1.f + e1), w1 = pg * e1 / (1.f + e1);
            const int a = min(i0, i1), bb = max(i0, i1);
            bin = gi * 28 + (7 * a - (a * (a - 1)) / 2) + (bb - a - 1);
            wa = (i0 < i1) ? w0 : w1; wb = (i0 < i1) ? w1 : w0; ea = gi * 8 + a; eb = gi * 8 + bb;
            slot = atomicAdd(&hist[bin], 1);
            sa = atomicAdd(&ehist[ea], 1); sb = atomicAdd(&ehist[eb], 1);
        }
        __syncthreads();
        if (tid < NBIN) { const int h = hist[tid]; basep[tid] = h ? atomicAdd((int*)(ws + WS_CTL) + tid, h) : 0; }
        else if (tid >= 128 && tid < 160) { const int e = tid - 128; const int h = ehist[e]; ebase[e] = h ? atomicAdd((int*)(ws + WS_CTL + 512) + e, h) : 0; }
        __syncthreads();
        if (tid < 128) {
            const int t = (int)(row0 + tid);
            ((int*)(ws + WS_BINL))[(size_t)bin * BINCAP + basep[bin] + slot] = t;
            sa += ebase[ea]; sb += ebase[eb];
            ((int*)(ws + WS_EL))[(size_t)ea * BINCAP + sa] = t; ((float*)(ws + WS_EW))[(size_t)ea * BINCAP + sa] = wa;
            ((int*)(ws + WS_EL))[(size_t)eb * BINCAP + sb] = t; ((float*)(ws + WS_EW))[(size_t)eb * BINCAP + sb] = wb;
            { const unsigned dpos = (unsigned)bin | ((unsigned)(basep[bin] + slot) << 7); ((unsigned*)(ws + WS_EDST))[(size_t)ea * BINCAP + sa] = dpos; ((unsigned*)(ws + WS_EDST))[(size_t)eb * BINCAP + sb] = dpos | (1u << 22); }
        }
        __syncthreads();
    }
}

constexpr int MOE_TS = pg8::STAGE_BYTES, MOE_TT = MOE_TS + 512, MOE_ES = MOE_TT + 1024, MOE_ET = MOE_ES + 256, MOE_OT = MOE_ET + 1280;
DEV int wave_excl_scan(int v, int lane, int& total) {
    int s = v;
#pragma unroll
    for (int o = 1; o < 64; o <<= 1) { const int u = __shfl_up(s, o); if (lane >= o) s += u; }
    total = __shfl(s, 63);
    return s - v;
}
DEV void moe_tiles(const Params& p, unsigned char* lds) {
    int* tstart = (int*)(lds + MOE_TS); int* tiletab = (int*)(lds + MOE_TT); int* etstart = (int*)(lds + MOE_ES); int* etiletab = (int*)(lds + MOE_ET); int* ordtab = (int*)(lds + MOE_OT);
    const int tid = threadIdx.x, lane = tid & 63, wid = tid >> 6;
    __syncthreads();
    if (wid == 0) {
        const int b0 = 2 * lane, b1 = 2 * lane + 1;
        const int c0 = b0 < NBIN ? ((const int*)(p.ws + WS_CTL))[b0] : 0, c1 = b1 < NBIN ? ((const int*)(p.ws + WS_CTL))[b1] : 0;
        const int f0 = c0 >> 8, f1 = c1 >> 8, q0 = (c0 & 255) ? 1 : 0, q1 = (c1 & 255) ? 1 : 0;
        int T, TF, TP;
        const int st = wave_excl_scan(f0 + q0 + f1 + q1, lane, T), sf = wave_excl_scan(f0 + f1, lane, TF), sp = wave_excl_scan(q0 + q1, lane, TP);
        if (b0 < NBIN) { tstart[b0] = st; for (int i = 0; i < f0 + q0; ++i) tiletab[st + i] = b0; for (int i = 0; i < f0; ++i) ordtab[sf + i] = st + i; if (q0) ordtab[TF + sp] = st + f0; }
        if (b1 < NBIN) { const int s1 = st + f0 + q0; tstart[b1] = s1; for (int i = 0; i < f1 + q1; ++i) tiletab[s1 + i] = b1; for (int i = 0; i < f1; ++i) ordtab[sf + f0 + i] = s1 + i; if (q1) ordtab[TF + sp + q0] = s1 + f1; }
        if (lane == 0) tstart[NBIN] = T;
    } else if (wid == 2) {
        const int cn = lane < 32 ? ((const int*)(p.ws + WS_CTL + 512))[lane] : 0; const int t = (cn + 255) >> 8;
        int T; const int s = wave_excl_scan(t, lane, T);
        if (lane < 32) { etstart[lane] = s; for (int i = 0; i < t; ++i) etiletab[s + i] = lane; }
        if (lane == 0) etstart[32] = T;
    }
    __syncthreads();
}
DEV void bin_experts(int bin, int& ea, int& eb) { const int gi = bin / 28; int pi = bin % 28, a = 0; while (pi >= 7 - a) { pi -= 7 - a; ++a; } ea = gi * 8 + a; eb = gi * 8 + a + 1 + pi; }
DEV void lane_rc(int i, int& R, int& C) { pg8::stage_rc((int)threadIdx.x * 16, R, C); R += 64 * i; }
struct MoeUnit { int tile, nt, bin, mt, n; };
struct PolMoe1 {
    typedef MoeUnit Unit;
    const Params& p; const int* etstart; const int* etiletab; int U, G, c;
    struct AddrA { unsigned off[2][2]; };
    struct AddrB { const char* base; };
    DEV int nk() const { return 16; }
    DEV bool next(int i, MoeUnit& u) const {
        const int L = i * G + c; if (L >= U) return false;
        u.tile = L >> 2; u.nt = L & 3;
        u.bin = __builtin_amdgcn_readfirstlane(etiletab[u.tile]);
        u.mt = u.tile - __builtin_amdgcn_readfirstlane(etstart[u.bin]);
        u.n = min(256, ((const int*)(p.ws + WS_CTL + 512))[u.bin] - u.mt * 256);
        return true;
    }
    DEV bool full(const MoeUnit& u) const { return u.n > 128; }
    DEV void addrA(const MoeUnit& u, AddrA& a) const {
        const int* list = (const int*)(p.ws + WS_EL) + (size_t)u.bin * BINCAP + u.mt * 256;
#pragma unroll
        for (int i = 0; i < 2; ++i) { int R, C; lane_rc(i, R, C);
#pragma unroll
            for (int h = 0; h < 2; ++h) { int r = h * 128 + R; if (r >= u.n) r = 0; a.off[h][i] = (unsigned)list[r] * 2048u + (unsigned)C * 2u; } }
    }
    DEV void addrB(const MoeUnit& u, AddrB& b) const { b.base = (const char*)(p.ws + WS_W13T) + ((size_t)u.bin * 1024 + u.nt * 256) * 2048; }
    DEV const char* pa(const AddrA& a, int h, int i, int kt) const { return (const char*)(p.ws + WS_R1) + a.off[h][i] + kt * 128; }
    DEV const char* pb(const AddrB& b, int h, int i, int kt) const { int R, C; lane_rc(i, R, C); return b.base + (size_t)h * (128 * 2048) + (unsigned)(R * 1024 + C) * 2u + kt * 128; }
};
struct EpiMoe1 { const Params& p; const int* tstart;
    DEV void operator()(const f32x4 (&acc)[2][2][4][2], const MoeUnit& u, int wr, int wc, int fr, int fq) const {
        const int* list = (const int*)(p.ws + WS_EL) + (size_t)u.bin * BINCAP + u.mt * 256;
        const float* wl = (const float*)(p.ws + WS_EW) + (size_t)u.bin * BINCAP + u.mt * 256;
        const unsigned* dl = (const unsigned*)(p.ws + WS_EDST) + (size_t)u.bin * BINCAP + u.mt * 256;
        const int r0 = wr * 64 + fr;
        int tk[2][4]; float ww[2][4]; unsigned dd[2][4];
#pragma unroll
        for (int ai = 0; ai < 2; ++ai)
#pragma unroll
            for (int m = 0; m < 4; ++m) { int r = r0 + ai * 128 + m * 16; if (r >= u.n) r = 0; tk[ai][m] = list[r]; ww[ai][m] = wl[r]; dd[ai][m] = dl[r]; }
        float rsv[2][4];
#pragma unroll
        for (int ai = 0; ai < 2; ++ai)
#pragma unroll
            for (int m = 0; m < 4; ++m) rsv[ai][m] = ((const float*)(p.ws + WS_RSTD2))[tk[ai][m]];
        const int f = (u.nt * 256 + 32 * wc + 8 * fq) >> 1;
#pragma unroll
        for (int ai = 0; ai < 2; ++ai)
#pragma unroll
            for (int m = 0; m < 4; ++m) { if (r0 + ai * 128 + m * 16 >= u.n) continue;
                const float rs = rsv[ai][m], w = ww[ai][m]; const unsigned d = dd[ai][m];
                bf16_t* hrow = (bf16_t*)(p.ws + WS_HBUF) + ((size_t)tstart[d & 127u] * 256 + ((d >> 7) & 32767u)) * 1024 + ((d >> 22) & 1u) * 512 + f;
#pragma unroll
                for (int bj = 0; bj < 2; ++bj) { const f32x4 v0 = acc[ai][bj][m][0] * rs, v1 = acc[ai][bj][m][1] * rs;
                    u32x2 w2; w2.x = pk2(siluf_(v0.x) * v0.y * w, siluf_(v0.z) * v0.w * w); w2.y = pk2(siluf_(v1.x) * v1.y * w, siluf_(v1.z) * v1.w * w); *(u32x2*)(hrow + 64 * bj) = w2; } }
    } };
DEV void phase_moe1(const Params& p, unsigned char* lds) {
    moe_tiles(p, lds);
    const int* etstart = (const int*)(lds + MOE_ES);
    PolMoe1 P{p, etstart, (const int*)(lds + MOE_ET), etstart[32] * 4, (int)gridDim.x, vblock()};
    EpiMoe1 E{p, (const int*)(lds + MOE_TS)};
    pg8::gemm_phase2(( PG8_LAS unsigned char*)lds, P, E);
}
struct PolMoe2 {
    typedef MoeUnit Unit;
    const Params& p; const int* tstart; const int* tiletab; const int* ordtab; int U, G, c;
    struct AddrA { const char* base; };
    struct AddrB { const char* ba; const char* bb; };
    DEV int nk() const { return 16; }
    DEV bool next(int i, MoeUnit& u) const {
        const int L = i * G + c; if (L >= U) return false;
        u.tile = __builtin_amdgcn_readfirstlane(ordtab[L >> 2]); u.nt = L & 3;
        u.bin = __builtin_amdgcn_readfirstlane(tiletab[u.tile]);
        u.mt = u.tile - __builtin_amdgcn_readfirstlane(tstart[u.bin]);
        u.n = min(256, ((const int*)(p.ws + WS_CTL))[u.bin] - u.mt * 256);
        return true;
    }
    DEV bool full(const MoeUnit& u) const { return u.n > 128; }
    DEV void addrA(const MoeUnit& u, AddrA& a) const { a.base = (const char*)(p.ws + WS_HBUF) + (size_t)u.tile * 256 * 2048; }
    DEV void addrB(const MoeUnit& u, AddrB& b) const {
        int ea, eb; bin_experts(u.bin, ea, eb);
        b.ba = (const char*)(p.ws + WS_W2T) + ((size_t)ea * 1024 + u.nt * 256) * 1024; b.bb = (const char*)(p.ws + WS_W2T) + ((size_t)eb * 1024 + u.nt * 256) * 1024;
    }
    DEV const char* pa(const AddrA& a, int h, int i, int kt) const { int R, C; lane_rc(i, R, C); return a.base + (size_t)h * (128 * 2048) + (unsigned)(R * 1024 + C) * 2u + kt * 128; }
    DEV const char* pb(const AddrB& b, int h, int i, int kt) const { int R, C; lane_rc(i, R, C); return (kt < 8 ? b.ba + kt * 128 : b.bb + (kt - 8) * 128) + (size_t)h * (128 * 1024) + (unsigned)(R * 512 + C) * 2u; }
};
struct EpiMoe2 { const Params& p;
    DEV void operator()(const f32x4 (&acc)[2][2][4][2], const MoeUnit& u, int wr, int wc, int fr, int fq) const {
        const int* list = (const int*)(p.ws + WS_BINL) + (size_t)u.bin * BINCAP + u.mt * 256;
        const int r0 = wr * 64 + fr;
        int tk[2][4];
#pragma unroll
        for (int ai = 0; ai < 2; ++ai)
#pragma unroll
            for (int m = 0; m < 4; ++m) { int r = r0 + ai * 128 + m * 16; if (r >= u.n) r = 0; tk[ai][m] = list[r]; }
        const int c0 = u.nt * 256 + 32 * wc + 4 * fq;
#pragma unroll
        for (int ai = 0; ai < 2; ++ai)
#pragma unroll
            for (int m = 0; m < 4; ++m) { if (r0 + ai * 128 + m * 16 >= u.n) continue;
                float* o = p.out + (size_t)tk[ai][m] * DM + c0;
                const f32x4 h0 = *(const f32x4*)(o), h1 = *(const f32x4*)(o + 16), h2 = *(const f32x4*)(o + 128), h3 = *(const f32x4*)(o + 144);
                *(f32x4*)(o) = h0 + acc[ai][0][m][0]; *(f32x4*)(o + 16) = h1 + acc[ai][0][m][1]; *(f32x4*)(o + 128) = h2 + acc[ai][1][m][0]; *(f32x4*)(o + 144) = h3 + acc[ai][1][m][1]; }
    } };
DEV void phase_moe2(const Params& p, unsigned char* lds) {
    moe_tiles(p, lds);
    const int* tstart = (const int*)(lds + MOE_TS);
    PolMoe2 P{p, tstart, (const int*)(lds + MOE_TT), (const int*)(lds + MOE_OT), tstart[NBIN] * 4, (int)gridDim.x, vblock()};
    EpiMoe2 E{p};
    pg8::gemm_phase2((PG8_LAS unsigned char*)lds, P, E);
}

#define XB_TMO      128
#define XB_XCNT(j)  (256  + 64 * (j))
#define XB_XSUB(j)  (1280 + 64 * (j))
#define XB_XGEN(j)  (2304 + 64 * (j))
#define XB_TOP      3328
#define XB_TOPGEN   3392
#define XCD_BAR_WORDS 3456
#define XB_SPIN_CAP (1u << 20)
#define LAS __attribute__((address_space(3)))
constexpr size_t WS_BAR = WS_CTL + 4096;
DEV unsigned xb_ld(unsigned* p) { return __hip_atomic_load(p, __ATOMIC_RELAXED, __HIP_MEMORY_SCOPE_AGENT); }
DEV unsigned xb_add(unsigned* p, unsigned v) { return __hip_atomic_fetch_add(p, v, __ATOMIC_RELAXED, __HIP_MEMORY_SCOPE_AGENT); }
DEV unsigned xb_xcc_id() { return (unsigned)__builtin_amdgcn_s_getreg((3 << 11) | 20) & 0xFu; }
#define XB_SPIN(cond, bar) do { unsigned _sp = 0; while (cond) { __builtin_amdgcn_s_sleep(1); \
    if ((++_sp & 255u) == 0u) { if (xb_ld(&(bar)[XB_TMO])) break; if (_sp > XB_SPIN_CAP) { atomicAdd(&(bar)[XB_TMO], 1u); break; } } } } while (0)
struct XcdBarrier { unsigned* bar; unsigned x; volatile LAS unsigned* st; };
DEV XcdBarrier xcd_barrier_post(unsigned* bar, volatile LAS unsigned* st) {
    XcdBarrier b; b.bar = bar; b.x = xb_xcc_id(); b.st = st;
    if (threadIdx.x == 0) (void)xb_add(&bar[XB_XCNT(b.x)], 1u);
    return b;
}
DEV void xcd_barrier_complete(unsigned* bar, unsigned x, unsigned& nloc, unsigned& nx) {
    const unsigned G = gridDim.x * gridDim.y * gridDim.z;
    unsigned sum, cnt, mine, sp = 0u;
    for (;;) {
        sum = 0u; cnt = 0u; mine = 0u;
#pragma unroll
        for (unsigned j = 0; j < 16; ++j) { const unsigned c = xb_ld(&bar[XB_XCNT(j)]); sum += c; cnt += (c > 0u) ? 1u : 0u; mine = (j == x) ? c : mine; }
        if (sum == G) break;
        __builtin_amdgcn_s_sleep(1);
        if ((++sp & 255u) == 0u) { if (xb_ld(&bar[XB_TMO])) break; if (sp > XB_SPIN_CAP) { atomicAdd(&bar[XB_TMO], 1u); break; } }
    }
    nloc = mine > 0u ? mine : 1u; nx = cnt > 0u ? cnt : 1u;
}
DEV void xcd_barrier(const XcdBarrier& b) {
    asm volatile("s_waitcnt vmcnt(0)" ::: "memory");
    __syncthreads();
    if (threadIdx.x == 0) {
        unsigned* bar = b.bar;
        __builtin_amdgcn_s_waitcnt(0);
        unsigned nloc = b.st[0], nx = b.st[1];
        if (nloc == 0u) { xcd_barrier_complete(bar, b.x, nloc, nx); b.st[0] = nloc; b.st[1] = nx; }
        const unsigned old = xb_add(&bar[XB_XSUB(b.x)], 1u);
        const unsigned gen = old / nloc;
        if (old + 1u == (gen + 1u) * nloc) {
            __builtin_amdgcn_fence(__ATOMIC_RELEASE, "agent");
            asm volatile("s_waitcnt vmcnt(0)" ::: "memory");
            const unsigned og = xb_add(&bar[XB_TOP], 1u);
            const unsigned tg = og / nx;
            if (og + 1u == (tg + 1u) * nx) xb_add(&bar[XB_TOPGEN], 1u);
            else XB_SPIN(xb_ld(&bar[XB_TOPGEN]) == tg, bar);
            __builtin_amdgcn_fence(__ATOMIC_ACQUIRE, "agent");
            xb_add(&bar[XB_XGEN(b.x)], 1u);
            asm volatile("s_waitcnt vmcnt(0)" ::: "memory");
        } else {
            XB_SPIN(xb_ld(&bar[XB_XGEN(b.x)]) == gen, bar);
            __builtin_amdgcn_fence(__ATOMIC_ACQUIRE, "agent");
            asm volatile("s_waitcnt vmcnt(0)" ::: "memory");
        }
    }
    __syncthreads();
}

constexpr int LDS_BYTES = 144 * 1024;
constexpr int N_PHASES = 9;
__global__ void __launch_bounds__(NT) mega(Params p, int lo, int hi) {
    extern __shared__ __attribute__((aligned(16))) unsigned char lds[];
    volatile LAS unsigned* xst = (volatile LAS unsigned*)(lds + LDS_BYTES - 16);
    if (threadIdx.x < 4) xst[threadIdx.x] = 0u;
    __syncthreads();
    XcdBarrier xbar; xbar.bar = (unsigned*)(p.ws + WS_BAR); xbar.x = 0; xbar.st = xst;
    if (hi - lo > 1) xbar = xcd_barrier_post((unsigned*)(p.ws + WS_BAR), xst);
#define GRID_SYNC() xcd_barrier(xbar)
#ifndef PROBE_REPEAT
#define PROBE_REPEAT -1
#endif
#define RUN_PHASE(k, call) do { if (lo <= (k) && (k) < hi) { call; \
        if ((k) == PROBE_REPEAT) { GRID_SYNC(); \
            if ((k) == 5) { float* rz = (float*)(p.ws + WS_ROWSS); for (int i = blockIdx.x * NT + threadIdx.x; i < NTOK; i += gridDim.x * NT) rz[i] = 0.f; GRID_SYNC(); } \
            if ((k) == 7) { if (blockIdx.x == 0 && threadIdx.x < 128) ((int*)(p.ws + WS_CTL))[threadIdx.x] = 0; GRID_SYNC(); } \
            call; } \
        if ((k) + 1 < hi) GRID_SYNC(); } } while (0)
    RUN_PHASE(0, phase_prologue(p, lds));
    RUN_PHASE(1, phase_inproj(p, lds));
    RUN_PHASE(2, { phase_cmp_a(p, lds); const int G_ = (int)gridDim.x; if (G_ > 128) phase_hgrn_a1(p, lds, 64, G_ - 64); else phase_hgrn_a1(p, lds, 0, G_); });
    RUN_PHASE(3, { phase_cmp_b(p, lds); phase_hgrn_a2(p, lds); });
    RUN_PHASE(4, { phase_cmp_attn(p, lds); phase_hgrn_a3(p, lds); });
    RUN_PHASE(5, phase_flash(p, lds));
    RUN_PHASE(6, phase_outproj(p, lds));
    RUN_PHASE(7, phase_router(p, lds));
    RUN_PHASE(8, phase_moe1(p, lds));
    RUN_PHASE(9, phase_moe2(p, lds));
#undef RUN_PHASE
}

extern "C" void kernel_launch(void* const* d_in, const int* in_sizes, int n_in, void* d_out, int out_size, void* d_ws, size_t ws_size, hipStream_t stream) {
    static int grid = 0;
    if (grid == 0) {
        int dev = 0, cus = 0, per_cu = 0;
        hipGetDevice(&dev);
        hipDeviceGetAttribute(&cus, hipDeviceAttributeMultiprocessorCount, dev);
        hipFuncSetAttribute((const void*)mega, hipFuncAttributeMaxDynamicSharedMemorySize, LDS_BYTES);
        hipOccupancyMaxActiveBlocksPerMultiprocessor(&per_cu, (const void*)mega, NT, LDS_BYTES);
        if (per_cu < 1) per_cu = 1;
        grid = cus;
        if (ws_size < WS_END) fprintf(stderr, "kernel_launch: workspace too small: %zu < %zu\n", ws_size, (size_t)WS_END);
        fprintf(stderr, "kernel_launch: cus %d per_cu %d grid %d ws %zu\n", cus, per_cu, grid, ws_size);
    }
    Params p{};
    const float** pp = (const float**)&p;
    for (int i = 0; i < 23; ++i) pp[i] = (const float*)d_in[i];
    p.out = (float*)d_out; p.ws = (unsigned char*)d_ws;
#if N_LAUNCH_MODE == 1
    (void)hipMemsetAsync((unsigned char*)d_ws + WS_BAR, 0, XCD_BAR_WORDS * 4, stream);
    int lo = 0, hi = N_PHASES + 1;
    void* args[] = {&p, &lo, &hi};
    hipError_t e = hipLaunchCooperativeKernel((const void*)mega, dim3(grid), dim3(NT), args, LDS_BYTES, stream);
    if (e != hipSuccess) fprintf(stderr, "cooperative launch failed: %s\n", hipGetErrorString(e));
#else
    for (int ph = 0; ph <= N_PHASES; ++ph) hipLaunchKernelGGL(mega, dim3(grid), dim3(NT), LDS_BYTES, stream, p, ph, ph + 1);
#endif
}
```

```cpp
#include <hip/hip_runtime.h>
#include <hip/hip_cooperative_groups.h>
#include <cstdio>
#include <cstdint>
#include <cstring>
namespace cg = cooperative_groups;

#ifndef N_LAUNCH_MODE
#define N_LAUNCH_MODE 1
#endif

#define DEV __device__ __forceinline__
typedef unsigned short bf16_t;
typedef short bf16x8 __attribute__((ext_vector_type(8)));
typedef float f32x4 __attribute__((ext_vector_type(4)));
typedef float f32x2 __attribute__((ext_vector_type(2)));
typedef float f32x16 __attribute__((ext_vector_type(16)));
typedef unsigned u32x4 __attribute__((ext_vector_type(4)));
typedef unsigned u32x2 __attribute__((ext_vector_type(2)));

constexpr int NT = 512;
constexpr int BATCH = 8, SEQ = 4096, DM = 1024, NTOK = BATCH * SEQ;
constexpr int IN_COLS = 3352, INP = 3584;
constexpr int NC = 255;
constexpr float RMS_EPS = 1e-6f;
constexpr float QSCALE = 0.125f * 1.4426950408889634f;
constexpr int NBIN = 112;
constexpr int BINCAP = NTOK;

constexpr size_t MiB = 1ull << 20;
constexpr size_t WS_CTL    = 0;
constexpr size_t WS_RSTD1  = 1 * MiB;
constexpr size_t WS_RSTD2  = WS_RSTD1 + 128 * 1024;
constexpr size_t WS_ROWSS  = WS_RSTD2 + 128 * 1024;
constexpr size_t WS_TOKW   = WS_ROWSS + 128 * 1024;
constexpr size_t WS_LB     = WS_TOKW + 256 * 1024;
constexpr size_t WS_CBIAS  = WS_LB + 4096;
constexpr size_t WS_SELM   = 2 * MiB;
constexpr size_t WS_GATES  = 3 * MiB;
constexpr size_t WS_KCMP   = 6 * MiB;
constexpr size_t WS_VCMP   = WS_KCMP + 512 * 1024;
constexpr size_t WS_CW2T   = 7 * MiB;
constexpr size_t WS_RW     = 7 * MiB + 128 * 1024;
constexpr size_t WS_HID    = 8 * MiB;
constexpr size_t WS_CW1T   = 12 * MiB;
constexpr size_t WS_WOUTT  = 14 * MiB;
constexpr size_t WS_WINT   = 16 * MiB;
constexpr size_t WS_R1     = 24 * MiB;
constexpr size_t WS_Q      = 88 * MiB;
constexpr size_t WS_KC     = 120 * MiB;
constexpr size_t WS_VC     = 128 * MiB;
constexpr size_t WS_KS     = 136 * MiB;
constexpr size_t WS_KW     = 144 * MiB;
constexpr size_t WS_VST    = 152 * MiB;
constexpr size_t WS_VWT    = 160 * MiB;
constexpr size_t WS_OC     = 168 * MiB;
constexpr size_t WS_W13T   = 200 * MiB;
constexpr size_t WS_W2T    = 264 * MiB;
constexpr size_t WS_HQ     = 296 * MiB;
constexpr size_t WS_HV     = 328 * MiB;
constexpr size_t WS_HG     = 360 * MiB;
constexpr size_t WS_HLOGF  = 392 * MiB;
constexpr size_t WS_XB     = 424 * MiB;
constexpr size_t WS_DBUF   = 488 * MiB;
constexpr size_t WS_END    = 489 * MiB;
constexpr size_t WS_UBUF   = WS_W13T;
constexpr size_t WS_BINL   = WS_HQ;
constexpr size_t WS_HBUF   = WS_HQ + 16 * MiB;
constexpr size_t WS_EL     = WS_HQ + 136 * MiB;
constexpr size_t WS_EW     = WS_HQ + 140 * MiB;
constexpr size_t WS_EDST   = WS_HQ + 144 * MiB;

struct Params {
    const float *x, *attn_g, *ffn_g, *w_in, *w_out, *g_q, *g_k, *pos_k, *pos_v, *wk1, *wk2, *wv1, *wv2, *g_nsa, *lb_logits, *g_hn,
        *w_group, *b_group, *w_expert, *b_expert, *w1, *w3, *w2;
    float* out;
    unsigned char* ws;
};

typedef __bf16 bf16x2_t __attribute__((ext_vector_type(2)));
DEV unsigned pk2(float lo, float hi) { f32x2 f = {lo, hi}; return __builtin_bit_cast(unsigned, __builtin_convertvector(f, bf16x2_t)); }
DEV bf16_t f2bf(float f) { return (bf16_t)(pk2(f, 0.f) & 0xffffu); }
DEV float bf2f(bf16_t b) { return __uint_as_float(((unsigned)b) << 16); }
DEV float bflo(unsigned u) { return __uint_as_float(u << 16); }
DEV float bfhi(unsigned u) { return __uint_as_float(u & 0xffff0000u); }
DEV float sigmoidf_(float v) { return __builtin_amdgcn_rcpf(1.f + __builtin_amdgcn_exp2f(-1.4426950408889634f * v)); }
DEV float siluf_(float v) { return v * __builtin_amdgcn_rcpf(1.f + __builtin_amdgcn_exp2f(-1.4426950408889634f * v)); }
DEV float wave_sum(float v) {
#pragma unroll
    for (int o = 1; o < 64; o <<= 1) v += __shfl_xor(v, o);
    return v;
}
DEV float wave_max(float v) {
#pragma unroll
    for (int o = 1; o < 64; o <<= 1) v = fmaxf(v, __shfl_xor(v, o));
    return v;
}
DEV int vblock() { const int G = gridDim.x, b = blockIdx.x; return (G % 8 == 0) ? (b % 8) * (G / 8) + b / 8 : b; }

namespace pg8 {
#define PG8_LAS __attribute__((address_space(3)))
constexpr int BM = 256, BK = 64, HALF = 128, HTB = HALF * BK * 2, STAGE_BYTES = 8 * HTB, NXCD = 8, WGM = 1;
__host__ __device__ __forceinline__ int lds_byte(int r, int c) { const int st = (r >> 4) * 2 + (c >> 5), rr = r & 15, cc = c & 31, ob = rr * 64 + cc * 2; return st * 1024 + (ob ^ (((ob >> 9) & 1) << 5)); }
__host__ __device__ __forceinline__ void stage_rc(int b, int& R, int& C) { const int st = b / 1024, sb = b % 1024, swz = sb ^ (((sb >> 9) & 1) << 5); R = (st >> 1) * 16 + swz / 64; C = (st & 1) * 32 + (swz % 64) / 2; }
struct Unit { int pm, pn; };
struct Gemm { const bf16_t* A; const bf16_t* Bt; int M, N, K; };
struct StaticOrder {
    int nM, nN, nwg, G, c;
    __host__ __device__ void init(int M, int N, int G_, int c_) { nM = M / BM; nN = N / BM; nwg = nM * nN; G = G_; c = c_; }
    __host__ __device__ bool next(int i, Unit& u) const {
        const long L = (long)i * G + c; if (L >= nwg) return false;
        int wgid = (int)L; { const int q = nwg / NXCD, r = nwg % NXCD, xcd = wgid % NXCD, off = wgid / NXCD; wgid = (xcd < r ? xcd * (q + 1) : r * (q + 1) + (xcd - r) * q) + off; }
        const int nig = WGM * nN, gid = wgid / nig, fm = gid * WGM, gsz = (nM - fm) < WGM ? (nM - fm) : WGM;
        u.pm = fm + ((wgid % nig) % gsz); u.pn = (wgid % nig) / gsz; return true;
    }
};
template <class Epi, class Sched>
__device__ __forceinline__ void gemm_phase(PG8_LAS unsigned char* lds, const Gemm g, const Sched& S, const Epi& E) {
    const int tid = threadIdx.x, wid = __builtin_amdgcn_readfirstlane(tid >> 6), lane = tid & 63, wr = wid >> 2, wc = wid & 3, fr = lane & 15, fq = lane >> 4;
    const int K = g.K, nt = K / BK;
    unsigned voffA[2];
#pragma unroll
    for (int i = 0; i < 2; ++i) { int R, C; stage_rc(tid * 16 + i * 8192, R, C); voffA[i] = (unsigned)(R * K + C) * 2u; }
    const size_t kstep = (size_t)(BK * 2);
    const size_t hstep = (size_t)HALF * K * 2;
    const size_t tstep = 2 * hstep;
    const unsigned ldsw = (unsigned)wid * 1024u;
    const int aoff = lds_byte(wr * 64 + fr, fq * 8), boff = lds_byte(wc * 32 + fr, fq * 8);
#define PG8_SA(b, h) (((b) * 2 + (h)) * HTB)
#define PG8_SB(b, h) ((4 + (b) * 2 + (h)) * HTB)
#define PG8_STAGE(bufoff, gbase, voff) do { _Pragma("unroll") for (int _i = 0; _i < 2; ++_i) \
        __builtin_amdgcn_global_load_lds((const unsigned*)((const char*)(gbase) + (voff)[_i]), (PG8_LAS unsigned*)(lds + (bufoff) + ldsw + _i * 8192), 16, 0, 0); } while (0)
#define PG8_LDA(dst, b, h) do { _Pragma("unroll") for (int m = 0; m < 4; ++m) _Pragma("unroll") for (int k = 0; k < 2; ++k) dst[m][k] = *(const PG8_LAS bf16x8*)(lds + PG8_SA(b, h) + aoff + m * 2048 + k * 1024); } while (0)
#define PG8_LDB(dst, b, h) do { _Pragma("unroll") for (int n = 0; n < 2; ++n) _Pragma("unroll") for (int k = 0; k < 2; ++k) dst[n][k] = *(const PG8_LAS bf16x8*)(lds + PG8_SB(b, h) + boff + n * 2048 + k * 1024); } while (0)
#define PG8_MMA(ai, bj, At, Bt) do { __builtin_amdgcn_s_setprio(1); _Pragma("unroll") for (int m = 0; m < 4; ++m) _Pragma("unroll") for (int n = 0; n < 2; ++n) _Pragma("unroll") for (int k = 0; k < 2; ++k) \
        acc[ai][bj][m][n] = __builtin_amdgcn_mfma_f32_16x16x32_bf16(Bt[n][k], At[m][k], acc[ai][bj][m][n], 0, 0, 0); __builtin_amdgcn_s_setprio(0); } while (0)
#define PG8_WAIT_V(n) asm volatile("s_waitcnt vmcnt(" #n ")" ::: "memory")
#define PG8_WAIT_L(n) asm volatile("s_waitcnt lgkmcnt(" #n ")" ::: "memory")
#define PG8_BAR __builtin_amdgcn_s_barrier()
#define PG8_SCHED __builtin_amdgcn_sched_barrier(0)
    Unit cur, nxt; int ui = 0;
    if (!S.next(0, cur)) return;
    f32x4 acc[2][2][4][2];
#pragma unroll
    for (int a = 0; a < 2; ++a)
#pragma unroll
        for (int b = 0; b < 2; ++b)
#pragma unroll
            for (int m = 0; m < 4; ++m)
#pragma unroll
                for (int n = 0; n < 2; ++n) acc[a][b][m][n] = (f32x4){0.f, 0.f, 0.f, 0.f};
    bf16x8 At[4][2], B0[2][2], B1[2][2];
    const char* cA = (const char*)g.A + (size_t)cur.pm * tstep; const char* cB = (const char*)g.Bt + (size_t)cur.pn * tstep;
    PG8_STAGE(PG8_SB(0, 0), cB, voffA); PG8_STAGE(PG8_SA(0, 0), cA, voffA); PG8_STAGE(PG8_SB(0, 1), cB + hstep, voffA); PG8_STAGE(PG8_SA(0, 1), cA + hstep, voffA);
    if (wr == 1) PG8_BAR;
    PG8_WAIT_V(4); PG8_BAR;
    PG8_STAGE(PG8_SB(1, 0), cB + kstep, voffA); PG8_STAGE(PG8_SA(1, 0), cA + kstep, voffA); PG8_STAGE(PG8_SB(1, 1), cB + hstep + kstep, voffA);
    PG8_WAIT_V(6); PG8_BAR;
    for (;;) {
        const bool has_next = S.next(ui + 1, nxt);
        const char* nA = has_next ? (const char*)g.A + (size_t)nxt.pm * tstep : cA; const char* nB = has_next ? (const char*)g.Bt + (size_t)nxt.pn * tstep : cB;
        float midrs[2][4];
        if constexpr (Epi::MIDSCALE) {
#pragma unroll
            for (int a = 0; a < 2; ++a)
#pragma unroll
                for (int m = 0; m < 4; ++m) midrs[a][m] = E.rowscale(cur.pm * BM + a * HALF + wr * 64 + m * 16 + fr); }
        for (int t = 0; t < nt; t += 2) {
            const bool last = (t == nt - 2);
            if constexpr (Epi::MIDSCALE) { if (t == E.midk()) {
#pragma unroll
                for (int a = 0; a < 2; ++a)
#pragma unroll
                    for (int b = 0; b < 2; ++b)
#pragma unroll
                        for (int m = 0; m < 4; ++m)
#pragma unroll
                            for (int n = 0; n < 2; ++n) acc[a][b][m][n] = acc[a][b][m][n] * midrs[a][m]; } }
            const char* a1 = cA + (size_t)(t + 1) * kstep;
            const char* a2 = last ? nA : cA + (size_t)(t + 2) * kstep; const char* b2 = last ? nB : cB + (size_t)(t + 2) * kstep;
            const char* a3 = a2 + kstep; const char* b3 = b2 + kstep;
            PG8_LDB(B0, 0, 0); PG8_SCHED; PG8_LDA(At, 0, 0); PG8_STAGE(PG8_SA(1, 1), a1 + hstep, voffA);
            PG8_WAIT_L(8); PG8_BAR; PG8_WAIT_L(0); PG8_MMA(0, 0, At, B0); PG8_BAR; PG8_SCHED;
            PG8_LDB(B1, 0, 1); PG8_STAGE(PG8_SB(0, 0), b2, voffA);
            PG8_BAR; PG8_WAIT_L(0); PG8_MMA(0, 1, At, B1); PG8_BAR;
            PG8_LDA(At, 0, 1); PG8_STAGE(PG8_SA(0, 0), a2, voffA);
            PG8_BAR; PG8_WAIT_L(0); PG8_MMA(1, 0, At, B0); PG8_BAR; PG8_SCHED;
            PG8_STAGE(PG8_SB(0, 1), b2 + hstep, voffA);
            PG8_WAIT_V(6); PG8_BAR; PG8_MMA(1, 1, At, B1); PG8_BAR;
            PG8_LDB(B0, 1, 0); PG8_SCHED; PG8_LDA(At, 1, 0); PG8_STAGE(PG8_SA(0, 1), a2 + hstep, voffA);
            PG8_WAIT_L(8); PG8_BAR; PG8_WAIT_L(0); PG8_MMA(0, 0, At, B0); PG8_BAR; PG8_SCHED;
            PG8_LDB(B1, 1, 1); PG8_STAGE(PG8_SB(1, 0), b3, voffA);
            PG8_BAR; PG8_WAIT_L(0); PG8_MMA(0, 1, At, B1); PG8_BAR;
            PG8_LDA(At, 1, 1); PG8_STAGE(PG8_SA(1, 0), a3, voffA);
            PG8_BAR; PG8_WAIT_L(0); PG8_MMA(1, 0, At, B0); PG8_BAR; PG8_SCHED;
            PG8_STAGE(PG8_SB(1, 1), b3 + hstep, voffA);
            PG8_WAIT_V(6); PG8_BAR; PG8_MMA(1, 1, At, B1); PG8_BAR;
        }
        E(acc, cur, wr, wc, fr, fq);
        if (!has_next) break;
#pragma unroll
        for (int a = 0; a < 2; ++a)
#pragma unroll
            for (int b = 0; b < 2; ++b)
#pragma unroll
                for (int m = 0; m < 4; ++m)
#pragma unroll
                    for (int n = 0; n < 2; ++n) acc[a][b][m][n] = (f32x4){0.f, 0.f, 0.f, 0.f};
        cur = nxt; cA = nA; cB = nB; ++ui;
    }
    PG8_WAIT_V(0);
    if (wr == 0) PG8_BAR;
    PG8_BAR;
#undef PG8_SA
#undef PG8_SB
#undef PG8_STAGE
#undef PG8_LDA
#undef PG8_LDB
#undef PG8_MMA
#undef PG8_WAIT_V
#undef PG8_WAIT_L
#undef PG8_BAR
#undef PG8_SCHED
}
template <class Pol, class Epi>
__device__ __forceinline__ void gemm_phase2(PG8_LAS unsigned char* lds, const Pol& P, const Epi& E) {
    const int tid = threadIdx.x, wid = __builtin_amdgcn_readfirstlane(tid >> 6), lane = tid & 63, wr = wid >> 2, wc = wid & 3, fr = lane & 15, fq = lane >> 4;
    const int nt = P.nk();
    const unsigned ldsw = (unsigned)wid * 1024u;
    const int aoff = lds_byte(wr * 64 + fr, fq * 8), boff = lds_byte(wc * 32 + fr, fq * 8);
#define PG8_SA(b, h) (((b) * 2 + (h)) * HTB)
#define PG8_SB(b, h) ((4 + (b) * 2 + (h)) * HTB)
#define PG8_STAGE_A(bufoff, AS, h, kt) do { _Pragma("unroll") for (int _i = 0; _i < 2; ++_i) \
        __builtin_amdgcn_global_load_lds((const unsigned*)P.pa(AS, h, _i, kt), (PG8_LAS unsigned*)(lds + (bufoff) + ldsw + _i * 8192), 16, 0, 0); } while (0)
#define PG8_STAGE_B(bufoff, BS, h, kt) do { _Pragma("unroll") for (int _i = 0; _i < 2; ++_i) \
        __builtin_amdgcn_global_load_lds((const unsigned*)P.pb(BS, h, _i, kt), (PG8_LAS unsigned*)(lds + (bufoff) + ldsw + _i * 8192), 16, 0, 0); } while (0)
#define PG8_LDA(dst, b, h) do { _Pragma("unroll") for (int m = 0; m < 4; ++m) _Pragma("unroll") for (int k = 0; k < 2; ++k) dst[m][k] = *(const PG8_LAS bf16x8*)(lds + PG8_SA(b, h) + aoff + m * 2048 + k * 1024); } while (0)
#define PG8_LDB(dst, b, h) do { _Pragma("unroll") for (int n = 0; n < 2; ++n) _Pragma("unroll") for (int k = 0; k < 2; ++k) dst[n][k] = *(const PG8_LAS bf16x8*)(lds + PG8_SB(b, h) + boff + n * 2048 + k * 1024); } while (0)
#define PG8_MMA(ai, bj, At, Bt) do { __builtin_amdgcn_s_setprio(1); _Pragma("unroll") for (int m = 0; m < 4; ++m) _Pragma("unroll") for (int n = 0; n < 2; ++n) _Pragma("unroll") for (int k = 0; k < 2; ++k) \
        acc[ai][bj][m][n] = __builtin_amdgcn_mfma_f32_16x16x32_bf16(Bt[n][k], At[m][k], acc[ai][bj][m][n], 0, 0, 0); __builtin_amdgcn_s_setprio(0); } while (0)
#define PG8_STAGE_A2(bufoff, h, kt) do { _Pragma("unroll") for (int _i = 0; _i < 2; ++_i) \
        __builtin_amdgcn_global_load_lds((const unsigned*)P.pa(a2, h, _i, kt), (PG8_LAS unsigned*)(lds + (bufoff) + ldsw + _i * 8192), 16, 0, 0); } while (0)
#define PG8_STAGE_B2(bufoff, h, kt) do { _Pragma("unroll") for (int _i = 0; _i < 2; ++_i) \
        __builtin_amdgcn_global_load_lds((const unsigned*)P.pb(b2, h, _i, kt), (PG8_LAS unsigned*)(lds + (bufoff) + ldsw + _i * 8192), 16, 0, 0); } while (0)
#define PG8_WAIT_V(n) asm volatile("s_waitcnt vmcnt(" #n ")" ::: "memory")
#define PG8_WAIT_L(n) asm volatile("s_waitcnt lgkmcnt(" #n ")" ::: "memory")
#define PG8_BAR __builtin_amdgcn_s_barrier()
#define PG8_SCHED __builtin_amdgcn_sched_barrier(0)
    typename Pol::Unit cur, nxt; int ui = 0;
    if (!P.next(0, cur)) return;
    f32x4 acc[2][2][4][2];
#pragma unroll
    for (int a = 0; a < 2; ++a)
#pragma unroll
        for (int b = 0; b < 2; ++b)
#pragma unroll
            for (int m = 0; m < 4; ++m)
#pragma unroll
                for (int n = 0; n < 2; ++n) acc[a][b][m][n] = (f32x4){0.f, 0.f, 0.f, 0.f};
    bf16x8 At[4][2], B0[2][2], B1[2][2];
    typename Pol::AddrA aC, aN; typename Pol::AddrB bC, bN;
    P.addrA(cur, aC); P.addrB(cur, bC);
    PG8_STAGE_B(PG8_SB(0, 0), bC, 0, 0); PG8_STAGE_A(PG8_SA(0, 0), aC, 0, 0); PG8_STAGE_B(PG8_SB(0, 1), bC, 1, 0); PG8_STAGE_A(PG8_SA(0, 1), aC, 1, 0);
    if (wr == 1) PG8_BAR;
    PG8_WAIT_V(4); PG8_BAR;
    PG8_STAGE_B(PG8_SB(1, 0), bC, 0, 1); PG8_STAGE_A(PG8_SA(1, 0), aC, 0, 1); PG8_STAGE_B(PG8_SB(1, 1), bC, 1, 1);
    PG8_WAIT_V(6); PG8_BAR;
    for (;;) {
        const bool has_next = P.next(ui + 1, nxt);
        if (has_next) { P.addrA(nxt, aN); P.addrB(nxt, bN); } else { aN = aC; bN = bC; }
        const bool full = P.full(cur);
        for (int t = 0; t < nt; t += 2) {
            const bool last = (t == nt - 2);
            const typename Pol::AddrA a2 = last ? aN : aC; const typename Pol::AddrB b2 = last ? bN : bC;
            const int k2 = last ? 0 : t + 2, k3 = k2 + 1;
            PG8_LDB(B0, 0, 0); PG8_SCHED; PG8_LDA(At, 0, 0); PG8_STAGE_A(PG8_SA(1, 1), aC, 1, t + 1);
            PG8_WAIT_L(8); PG8_BAR; PG8_WAIT_L(0); PG8_MMA(0, 0, At, B0); PG8_BAR; PG8_SCHED;
            PG8_LDB(B1, 0, 1); PG8_STAGE_B2(PG8_SB(0, 0), 0, k2);
            PG8_BAR; PG8_WAIT_L(0); PG8_MMA(0, 1, At, B1); PG8_BAR;
            PG8_LDA(At, 0, 1); PG8_STAGE_A2(PG8_SA(0, 0), 0, k2);
            PG8_BAR; PG8_WAIT_L(0); if (full) PG8_MMA(1, 0, At, B0); PG8_BAR; PG8_SCHED;
            PG8_STAGE_B2(PG8_SB(0, 1), 1, k2);
            PG8_WAIT_V(6); PG8_BAR; if (full) PG8_MMA(1, 1, At, B1); PG8_BAR;
            PG8_LDB(B0, 1, 0); PG8_SCHED; PG8_LDA(At, 1, 0); PG8_STAGE_A2(PG8_SA(0, 1), 1, k2);
            PG8_WAIT_L(8); PG8_BAR; PG8_WAIT_L(0); PG8_MMA(0, 0, At, B0); PG8_BAR; PG8_SCHED;
            PG8_LDB(B1, 1, 1); PG8_STAGE_B2(PG8_SB(1, 0), 0, k3);
            PG8_BAR; PG8_WAIT_L(0); PG8_MMA(0, 1, At, B1); PG8_BAR;
            PG8_LDA(At, 1, 1); PG8_STAGE_A2(PG8_SA(1, 0), 0, k3);
            PG8_BAR; PG8_WAIT_L(0); if (full) PG8_MMA(1, 0, At, B0); PG8_BAR; PG8_SCHED;
            PG8_STAGE_B2(PG8_SB(1, 1), 1, k3);
            PG8_WAIT_V(6); PG8_BAR; if (full) PG8_MMA(1, 1, At, B1); PG8_BAR;
        }
        E(acc, cur, wr, wc, fr, fq);
        if (!has_next) break;
#pragma unroll
        for (int a = 0; a < 2; ++a)
#pragma unroll
            for (int b = 0; b < 2; ++b)
#pragma unroll
                for (int m = 0; m < 4; ++m)
#pragma unroll
                    for (int n = 0; n < 2; ++n) acc[a][b][m][n] = (f32x4){0.f, 0.f, 0.f, 0.f};
        cur = nxt; aC = aN; bC = bN; ++ui;
    }
    PG8_WAIT_V(0);
    if (wr == 0) PG8_BAR;
    PG8_BAR;
#undef PG8_SA
#undef PG8_SB
#undef PG8_STAGE_A
#undef PG8_STAGE_B
#undef PG8_STAGE_A2
#undef PG8_STAGE_B2
#undef PG8_LDA
#undef PG8_LDB
#undef PG8_MMA
#undef PG8_WAIT_V
#undef PG8_WAIT_L
#undef PG8_BAR
#undef PG8_SCHED
}
__host__ __device__ __forceinline__ int perm_lo(int x) { return (((x >> 2) & 3) << 3) | (((x >> 4) & 1) << 2) | (x & 3); }
__host__ __device__ __forceinline__ int inv_perm_lo(int y) { return (((y >> 2) & 1) << 4) | (((y >> 3) & 3) << 2) | (y & 3); }
__host__ __device__ __forceinline__ int logcol(int p) { return (p & ~255) + 64 * ((p >> 5) & 3) + 32 * ((p >> 7) & 1) + perm_lo(p & 31); }
}

template <class SRC>
DEV void convert_tile(float* tl, const SRC& src, bf16_t* dst, int ldd, int n0, int k0) {
    const int tid = threadIdx.x;
    {
        const int n = tid & 63;
#pragma unroll
        for (int i = 0; i < 8; ++i) { const int kk = (tid >> 6) + 8 * i; tl[kk * 65 + n] = src.get(n0 + n, k0 + kk); }
    }
    __syncthreads();
    {
        const int n = tid >> 3, kc = tid & 7;
        const float* s = tl + (kc * 8) * 65 + n;
        u32x4 o;
        o.x = pk2(s[0 * 65], s[1 * 65]); o.y = pk2(s[2 * 65], s[3 * 65]); o.z = pk2(s[4 * 65], s[5 * 65]); o.w = pk2(s[6 * 65], s[7 * 65]);
        *(u32x4*)(dst + (size_t)(n0 + n) * ldd + k0 + kc * 8) = o;
    }
    __syncthreads();
}
struct SrcWin { const float* w; const float* g;
    DEV float get(int np, int k) const { const int n = pg8::logcol(np); int col; if (n < 1280) col = n; else if (n < 3328) col = n + 24; else if (n < 3352) col = 1280 + (n - 3328); else return 0.f;
        return w[(size_t)k * IN_COLS + col] * g[k]; } };
struct SrcWout { const float* w; const float* g;
    DEV float get(int np, int k) const { const int n = pg8::logcol(np); const float v = w[(size_t)k * DM + n]; return k < 512 ? v * g[k] : v; } };
struct SrcPlain { const float* w; int ld;
    DEV float get(int n, int k) const { return w[(size_t)k * ld + n]; } };
struct SrcW13 { const float* w1; const float* w3; const float* g;
    DEV float get(int n, int k) const { const uintptr_t a = (uintptr_t)w1, b = (uintptr_t)w3; const float* w = (const float*)(a + ((b - a) & (uintptr_t)(0 - (long long)(n & 1))));
        return w[(size_t)k * 512 + (n >> 1)] * g[k]; } };

template <class SRC>
DEV void convert_tile256(float* tl, const SRC& src, bf16_t* dst, int ldd, int n0, int k0) {
    int tid = threadIdx.x; asm volatile("" : "+v"(tid));
    {
        const int q = tid & 63;
        f32x4 v[8];
#pragma unroll
        for (int i = 0; i < 8; ++i) v[i] = src.quad(n0, q, k0 + (tid >> 6) + 8 * i);
#pragma unroll
        for (int i = 0; i < 8; ++i) { float* o = tl + ((tid >> 6) + 8 * i) * 257; o[src.drow(q, 0)] = v[i].x; o[src.drow(q, 1)] = v[i].y; o[src.drow(q, 2)] = v[i].z; o[src.drow(q, 3)] = v[i].w; }
    }
    __syncthreads();
#pragma unroll
    for (int i = 0; i < 4; ++i) {
        const int idx = tid + NT * i, n = idx >> 3, kc = idx & 7;
        const float* s = tl + (kc * 8) * 257 + n;
        u32x4 o;
        o.x = pk2(s[0 * 257], s[1 * 257]); o.y = pk2(s[2 * 257], s[3 * 257]); o.z = pk2(s[4 * 257], s[5 * 257]); o.w = pk2(s[6 * 257], s[7 * 257]);
        *(u32x4*)(dst + (size_t)(n0 + n) * ldd + k0 + kc * 8) = o;
    }
    __syncthreads();
}
struct SrcWin4 { const float* w; const float* g;
    DEV int drow(int q, int e) const { return 4 * q + e; }
    DEV f32x4 quad(int n0, int q, int k) const { const int n = pg8::logcol(n0 + 4 * q); int col; if (n < 1280) col = n; else if (n < 3328) col = n + 24; else if (n < 3352) col = 1280 + (n - 3328); else return (f32x4){0.f, 0.f, 0.f, 0.f};
        return *(const f32x4*)(w + (size_t)k * IN_COLS + col) * g[k]; } };
struct SrcWout4 { const float* w; const float* g;
    DEV int drow(int q, int e) const { return 4 * q + e; }
    DEV f32x4 quad(int n0, int q, int k) const { const f32x4 v = *(const f32x4*)(w + (size_t)k * DM + pg8::logcol(n0 + 4 * q)); return k < 512 ? v * g[k] : v; } };
struct SrcPlain4 { const float* w; int ld;
    DEV int drow(int q, int e) const { return 4 * q + e; }
    DEV f32x4 quad(int n0, int q, int k) const { return *(const f32x4*)(w + (size_t)k * ld + n0 + 4 * q); } };
struct SrcW13_4 { const float* w1; const float* w3; const float* g;
    DEV int drow(int q, int e) const { const int l = 8 * (q & 31) + 2 * e + (q >> 5); return (l & ~31) | pg8::inv_perm_lo(l & 31); }
    DEV f32x4 quad(int n0, int q, int k) const { const uintptr_t a = (uintptr_t)w1, b = (uintptr_t)w3; const float* w = (const float*)(a + ((b - a) & (uintptr_t)(0 - (long long)(q >> 5))));
        return *(const f32x4*)(w + (size_t)k * 512 + (n0 >> 1) + 4 * (q & 31)) * g[k]; } };

constexpr int I_WIN = (INP / 256) * (DM / 64);
constexpr int I_WOUT = 4 * 16;
constexpr int I_CW1 = 2 * 32;
constexpr int I_W2 = 32 * 4 * 8;
constexpr int I_CW2 = 2 * 1 * 4;
constexpr int I_ALL = I_WIN + I_WOUT + I_CW1 + I_W2 + I_CW2;
DEV void convert_side(const Params& p, unsigned char* lds) {
    float* tl = (float*)lds; unsigned char* ws = p.ws; const int vb = vblock(), G = gridDim.x;
    __syncthreads();
    for (int it = vb; it < I_WOUT + I_CW1 + I_W2 + I_CW2; it += G) {
        int r = it;
        if (r < I_WOUT) { SrcWout4 s{p.w_out, p.g_nsa}; convert_tile256(tl, s, (bf16_t*)(ws + WS_WOUTT), DM, (r / 16) * 256, (r % 16) * 64); continue; } r -= I_WOUT;
        if (r < I_CW1) { const int z = r / 32, q = r % 32; SrcPlain4 s{z ? p.wv1 : p.wk1, 256};
            convert_tile256(tl, s, (bf16_t*)(ws + WS_CW1T) + (size_t)z * 256 * 2048, 2048, 0, q * 64); continue; } r -= I_CW1;
        if (r < I_W2) { const int e = r / 32, q = r % 32; SrcPlain4 s{p.w2 + (size_t)e * 512 * 1024, 1024};
            convert_tile256(tl, s, (bf16_t*)(ws + WS_W2T) + (size_t)e * 1024 * 512, 512, (q / 8) * 256, (q % 8) * 64); continue; } r -= I_W2;
        { const int z = r / 4, q = r % 4; SrcPlain s{z ? p.wv2 : p.wk2, 64};
            convert_tile(tl, s, (bf16_t*)(ws + WS_CW2T) + (size_t)z * 64 * 256, 256, 0, q * 64); }
    }
    __syncthreads();
}
DEV void phase_prologue(const Params& p, unsigned char* lds) {
    float* tl = (float*)lds;
    const int tid = threadIdx.x, lane = tid & 63, wid = tid >> 6;
    const int vb = vblock(), G = gridDim.x;
    unsigned char* ws = p.ws;
    for (int it = vb; it < I_WIN; it += G) { SrcWin4 s{p.w_in, p.attn_g}; convert_tile256(tl, s, (bf16_t*)(ws + WS_WINT), DM, (it / 16) * 256, (it % 16) * 64); }
    (void)I_ALL;
    {
        bf16_t* xb = (bf16_t*)(ws + WS_XB); float* rstd1 = (float*)(ws + WS_RSTD1);
        const int gw = vb * 8 + wid, NGW = G * 8;
        for (int m = gw; m < NTOK; m += NGW) {
            const f32x4* xr = (const f32x4*)(p.x + (size_t)m * DM) + lane;
            f32x4 v[4]; float s = 0.f;
#pragma unroll
            for (int j = 0; j < 4; ++j) { v[j] = xr[64 * j]; s += (v[j].x * v[j].x + v[j].y * v[j].y) + (v[j].z * v[j].z + v[j].w * v[j].w); }
            s = wave_sum(s);
            if (lane == 0) rstd1[m] = rsqrtf(s * (1.f / DM) + RMS_EPS);
            u32x2* o = (u32x2*)(xb + (size_t)m * DM) + lane;
#pragma unroll
            for (int j = 0; j < 4; ++j) { u32x2 w; w.x = pk2(v[j].x, v[j].y); w.y = pk2(v[j].z, v[j].w); o[64 * j] = w; }
        }
    }
    {
        const int gt = vb * NT + tid, NG = G * NT;
        float* rowss = (float*)(ws + WS_ROWSS);
        for (int i = gt; i < NTOK; i += NG) rowss[i] = 0.f;
        int* bincnt = (int*)(ws + WS_CTL);
        if (gt < 128) bincnt[gt] = 0;
        if (gt < 32) ((int*)(ws + WS_CTL + 512))[gt] = 0;
        if (gt < 512) { const float l0 = p.lb_logits[gt], l1 = p.lb_logits[512 + gt]; ((float*)(ws + WS_LB))[gt] = 1.f / (1.f + __expf(l1 - l0)); }
        for (int i = gt; i < 48 * 1024; i += NG) { const int c = i >> 10, k = i & 1023;
            const float w = (c < 4 ? p.w_group[k * 4 + c] : (c < 36 ? p.w_expert[k * 32 + (c - 4)] : 0.f)) * p.ffn_g[k];
            const bf16_t hi = f2bf(w); const bf16_t lo = f2bf(w - bf2f(hi));
            ((bf16_t*)(ws + WS_RW))[i] = hi; ((bf16_t*)(ws + WS_RW))[48 * 1024 + i] = lo; }
        {
            const int ob = (vb * 8 + wid) * 4;
            if (ob < 512) { const int z = ob >> 8, j0 = ob & 255; const float* pos = z ? p.pos_v : p.pos_k; const float* w = (z ? p.wv1 : p.wk1) + j0;
                f32x4 a = (f32x4){0.f, 0.f, 0.f, 0.f};
#pragma unroll 8
                for (int k = lane; k < 2048; k += 64) a = a + *(const f32x4*)(w + (size_t)k * 256) * pos[k];
                a.x = wave_sum(a.x); a.y = wave_sum(a.y); a.z = wave_sum(a.z); a.w = wave_sum(a.w);
                if (lane == 0) *(f32x4*)((float*)(ws + WS_CBIAS) + ob) = a; }
        }
    }
}

constexpr int G_A_BYTES = 128 * 128, G_B_BYTES = 256 * 128, G_STAGE = G_A_BYTES + G_B_BYTES, G_LDS = 2 * G_STAGE;
DEV int swz(int row, int chunk) { return row * 128 + ((chunk ^ ((row >> 1) & 7)) << 4); }
template <class AL, class BL, class EP>
DEV void gemm_tile(unsigned char* lds, const AL& al, const BL& bl, int nk, const EP& ep) {
    const int tid = threadIdx.x, lane = tid & 63, wid = tid >> 6, wr = wid >> 2, wc = wid & 3;
    const int frow = lane & 15, fq = lane >> 4;
    const bf16_t* aptr[2]; int aoff[2], boff[4], brow[4];
#pragma unroll
    for (int i = 0; i < 2; ++i) { const int q = tid + NT * i, row = q >> 3, ch = q & 7; aptr[i] = al.row(row) + ch * 8; aoff[i] = swz(row, ch); }
#pragma unroll
    for (int i = 0; i < 4; ++i) { const int q = tid + NT * i, row = q >> 3, ch = q & 7; brow[i] = row; boff[i] = G_A_BYTES + swz(row, ch) ; }
    const int bch8 = (tid & 7) * 8;
    u32x4 ra[2], rb[4];
#pragma unroll
    for (int i = 0; i < 2; ++i) ra[i] = *(const u32x4*)(aptr[i]);
#pragma unroll
    for (int i = 0; i < 4; ++i) rb[i] = *(const u32x4*)(bl.ptr(brow[i], 0) + bch8);
#pragma unroll
    for (int i = 0; i < 2; ++i) *(u32x4*)(lds + aoff[i]) = ra[i];
#pragma unroll
    for (int i = 0; i < 4; ++i) *(u32x4*)(lds + boff[i]) = rb[i];
    __syncthreads();
    f32x4 acc[4][4];
#pragma unroll
    for (int m = 0; m < 4; ++m)
#pragma unroll
        for (int n = 0; n < 4; ++n) acc[m][n] = (f32x4){0.f, 0.f, 0.f, 0.f};
    const int sx = (frow >> 1) & 7;
    for (int kt = 0; kt < nk; ++kt) {
        const bool more = (kt + 1 < nk);
        if (more) {
#pragma unroll
            for (int i = 0; i < 2; ++i) ra[i] = *(const u32x4*)(aptr[i] + (kt + 1) * 64);
#pragma unroll
            for (int i = 0; i < 4; ++i) rb[i] = *(const u32x4*)(bl.ptr(brow[i], kt + 1) + bch8);
        }
        const unsigned char* base = lds + (kt & 1) * G_STAGE;
#pragma unroll
        for (int ks = 0; ks < 2; ++ks) {
            const int co = ((ks * 4 + fq) ^ sx) << 4;
            bf16x8 af[4], bfr[4];
#pragma unroll
            for (int m = 0; m < 4; ++m) af[m] = *(const bf16x8*)(base + (wr * 64 + m * 16 + frow) * 128 + co);
#pragma unroll
            for (int n = 0; n < 4; ++n) bfr[n] = *(const bf16x8*)(base + G_A_BYTES + (wc * 64 + n * 16 + frow) * 128 + co);
#pragma unroll
            for (int m = 0; m < 4; ++m)
#pragma unroll
                for (int n = 0; n < 4; ++n) acc[m][n] = __builtin_amdgcn_mfma_f32_16x16x32_bf16(bfr[n], af[m], acc[m][n], 0, 0, 0);
        }
        if (more) {
            unsigned char* nb = lds + ((kt + 1) & 1) * G_STAGE;
#pragma unroll
            for (int i = 0; i < 2; ++i) *(u32x4*)(nb + aoff[i]) = ra[i];
#pragma unroll
            for (int i = 0; i < 4; ++i) *(u32x4*)(nb + boff[i]) = rb[i];
        }
        __syncthreads();
    }
    ep(acc, wr, wc, lane);
}

struct ARows { const bf16_t* base; size_t ld; DEV const bf16_t* row(int r) const { return base + (size_t)r * ld; } };
struct BRows { const bf16_t* base; size_t ld; DEV const bf16_t* ptr(int n, int kt) const { return base + (size_t)n * ld + kt * 64; } };

DEV u32x4 pk8(const f32x4 a, const f32x4 b) { u32x4 w; w.x = pk2(a.x, a.y); w.y = pk2(a.z, a.w); w.z = pk2(b.x, b.y); w.w = pk2(b.z, b.w); return w; }
struct EpiInproj8 { const Params& p; static constexpr bool MIDSCALE = false; DEV float rowscale(int) const { return 1.f; } DEV int midk() const { return -1; }
    DEV void operator()(const f32x4 (&acc)[2][2][4][2], const pg8::Unit& u, int wr, int wc, int fr, int fq) const {
        const int seg = u.pn * 4 + wc;
        if (seg > 52) return;
        unsigned char* ws = p.ws;
        const int row0 = u.pm * 256 + wr * 64 + fr;
        const int b = row0 >> 12, s0 = row0 & 4095;
        float rs[2][4];
#pragma unroll
        for (int ai = 0; ai < 2; ++ai)
#pragma unroll
            for (int m = 0; m < 4; ++m) rs[ai][m] = ((const float*)(ws + WS_RSTD1))[row0 + 128 * ai + 16 * m];
        const bool is_q = seg < 8, is_ks = (seg == 12 || seg == 13), is_kw = (seg == 16 || seg == 17);
        if (is_q || is_ks || is_kw) {
            const float* gw = (is_q ? p.g_q : (is_ks ? p.g_k + 64 : p.g_k + 128)) + 8 * fq;
            const f32x4 g00 = *(const f32x4*)(gw), g01 = *(const f32x4*)(gw + 4), g10 = *(const f32x4*)(gw + 32), g11 = *(const f32x4*)(gw + 36);
            bf16_t* dst; int hh, nh;
            if (is_q) { dst = (bf16_t*)(ws + WS_Q); hh = seg; nh = 8; } else if (is_ks) { dst = (bf16_t*)(ws + WS_KS); hh = seg - 12; nh = 2; } else { dst = (bf16_t*)(ws + WS_KW); hh = seg - 16; nh = 2; }
            bf16_t* o0 = dst + ((size_t)(b * nh + hh) * SEQ + s0) * 64 + fq * 8;
            const float qs = is_q ? QSCALE : 1.f;
#pragma unroll
            for (int ai = 0; ai < 2; ++ai)
#pragma unroll
                for (int m = 0; m < 4; ++m) {
                    const f32x4 a0 = acc[ai][0][m][0], a1 = acc[ai][0][m][1], a2 = acc[ai][1][m][0], a3 = acc[ai][1][m][1];
                    float ss = ((a0.x * a0.x + a0.y * a0.y) + (a0.z * a0.z + a0.w * a0.w)) + ((a1.x * a1.x + a1.y * a1.y) + (a1.z * a1.z + a1.w * a1.w))
                             + ((a2.x * a2.x + a2.y * a2.y) + (a2.z * a2.z + a2.w * a2.w)) + ((a3.x * a3.x + a3.y * a3.y) + (a3.z * a3.z + a3.w * a3.w));
                    ss += __shfl_xor(ss, 16); ss += __shfl_xor(ss, 32);
                    const float rr = rs[ai][m];
                    const float r = rr * rsqrtf(ss * rr * rr * (1.f / 64.f) + RMS_EPS) * qs;
                    bf16_t* o = o0 + (size_t)(128 * ai + 16 * m) * 64;
                    *(u32x4*)(o) = pk8(a0 * g00 * r, a1 * g01 * r); *(u32x4*)(o + 32) = pk8(a2 * g10 * r, a3 * g11 * r);
                }
            return;
        }
        if (seg >= 8 && seg < 12) {
            bf16_t* o0 = (bf16_t*)(ws + (seg < 10 ? WS_KC : WS_VC)) + ((size_t)(b * 2 + (seg & 1)) * SEQ + s0) * 64 + fq * 8;
#pragma unroll
            for (int ai = 0; ai < 2; ++ai)
#pragma unroll
                for (int m = 0; m < 4; ++m) { const float r = rs[ai][m]; bf16_t* o = o0 + (size_t)(128 * ai + 16 * m) * 64;
                    *(u32x4*)(o) = pk8(acc[ai][0][m][0] * r, acc[ai][0][m][1] * r); *(u32x4*)(o + 32) = pk8(acc[ai][1][m][0] * r, acc[ai][1][m][1] * r); }
            return;
        }
        if (seg == 14 || seg == 15 || seg == 18 || seg == 19) {
            bf16_t* o0 = (bf16_t*)(ws + (seg < 16 ? WS_VST : WS_VWT)) + (size_t)(b * 2 + (seg & 1)) * 64 * SEQ + s0;
#pragma unroll
            for (int ai = 0; ai < 2; ++ai)
#pragma unroll
                for (int m = 0; m < 4; ++m) { const float r = rs[ai][m]; bf16_t* o = o0 + 128 * ai + 16 * m;
#pragma unroll
                    for (int bj = 0; bj < 2; ++bj)
#pragma unroll
                        for (int n = 0; n < 2; ++n) { const int d = 32 * bj + 8 * fq + 4 * n; const f32x4 x = acc[ai][bj][m][n] * r;
                            o[(size_t)(d + 0) * SEQ] = f2bf(x.x); o[(size_t)(d + 1) * SEQ] = f2bf(x.y); o[(size_t)(d + 2) * SEQ] = f2bf(x.z); o[(size_t)(d + 3) * SEQ] = f2bf(x.w); } }
            return;
        }
        if (seg < 52) {
            const int kind = (seg - 20) >> 3, cb = ((seg - 20) & 7) * 64 + fq * 8;
            if (kind == 1) {
                const float* lb = (const float*)(ws + WS_LB) + cb;
                const f32x4 l00 = *(const f32x4*)(lb), l01 = *(const f32x4*)(lb + 4), l10 = *(const f32x4*)(lb + 32), l11 = *(const f32x4*)(lb + 36);
                bf16_t* o0 = (bf16_t*)(ws + WS_HLOGF) + (size_t)row0 * 512 + cb;
#define LOGF4(L_, X_) (f32x4){__logf(L_.x + (1.f - L_.x) * sigmoidf_(X_.x)), __logf(L_.y + (1.f - L_.y) * sigmoidf_(X_.y)), __logf(L_.z + (1.f - L_.z) * sigmoidf_(X_.z)), __logf(L_.w + (1.f - L_.w) * sigmoidf_(X_.w))}
#pragma unroll
                for (int ai = 0; ai < 2; ++ai)
#pragma unroll
                    for (int m = 0; m < 4; ++m) { const float r = rs[ai][m]; bf16_t* o = o0 + (size_t)(128 * ai + 16 * m) * 512;
                        const f32x4 x0 = acc[ai][0][m][0] * r, x1 = acc[ai][0][m][1] * r, x2 = acc[ai][1][m][0] * r, x3 = acc[ai][1][m][1] * r;
                        *(u32x4*)(o) = pk8(LOGF4(l00, x0), LOGF4(l01, x1)); *(u32x4*)(o + 32) = pk8(LOGF4(l10, x2), LOGF4(l11, x3)); }
#undef LOGF4
            } else {
                bf16_t* o0 = (bf16_t*)(ws + (kind == 0 ? WS_HQ : (kind == 2 ? WS_HV : WS_HG))) + (size_t)row0 * 512 + cb;
#define SILU4(X_) (f32x4){siluf_(X_.x), siluf_(X_.y), siluf_(X_.z), siluf_(X_.w)}
#pragma unroll
                for (int ai = 0; ai < 2; ++ai)
#pragma unroll
                    for (int m = 0; m < 4; ++m) { const float r = rs[ai][m]; bf16_t* o = o0 + (size_t)(128 * ai + 16 * m) * 512;
                        f32x4 x0 = acc[ai][0][m][0] * r, x1 = acc[ai][0][m][1] * r, x2 = acc[ai][1][m][0] * r, x3 = acc[ai][1][m][1] * r;
                        if (kind != 2) { x0 = SILU4(x0); x1 = SILU4(x1); x2 = SILU4(x2); x3 = SILU4(x3); }
                        *(u32x4*)(o) = pk8(x0, x1); *(u32x4*)(o + 32) = pk8(x2, x3); }
#undef SILU4
            }
            return;
        }
        if (fq < 3) {
            float* o0 = (float*)(ws + WS_GATES) + (size_t)row0 * 24 + 8 * fq;
#pragma unroll
            for (int ai = 0; ai < 2; ++ai)
#pragma unroll
                for (int m = 0; m < 4; ++m) { const float r = rs[ai][m]; float* o = o0 + (size_t)(128 * ai + 16 * m) * 24;
#pragma unroll
                    for (int n = 0; n < 2; ++n) { const f32x4 x = acc[ai][0][m][n] * r; *(f32x4*)(o + 4 * n) = (f32x4){sigmoidf_(x.x), sigmoidf_(x.y), sigmoidf_(x.z), sigmoidf_(x.w)}; } }
        }
    } };
DEV void phase_inproj(const Params& p, unsigned char* lds) {
    pg8::Gemm g{(const bf16_t*)(p.ws + WS_XB), (const bf16_t*)(p.ws + WS_WINT), NTOK, INP, DM};
    pg8::StaticOrder S; S.init(NTOK, INP, (int)gridDim.x, (int)blockIdx.x);
    EpiInproj8 E{p};
    const bool first = ((blockIdx.x >> 3) & 1) == 0;
    if (first) convert_side(p, lds);
    pg8::gemm_phase(( PG8_LAS unsigned char*)lds, g, S, E);
    if (!first) convert_side(p, lds);
}

struct ACmp { const bf16_t* src; int bg, c0;
    DEV const bf16_t* row(int r) const { int c = c0 + r; if (c > NC - 1) c = NC - 1; return src + ((size_t)bg * SEQ + 16 * c) * 64; } };
struct EpiCmpA { const Params& p; int z, rbase;
    DEV void operator()(f32x4 (&acc)[4][4], int wr, int wc, int lane) const {
        const int frow = lane & 15, fq = lane >> 4;
        const float* cb = (const float*)(p.ws + WS_CBIAS) + z * 256; bf16_t* hid = (bf16_t*)(p.ws + WS_HID) + (size_t)z * 4096 * 256;
#pragma unroll
        for (int m = 0; m < 4; ++m) { const int rr = rbase + wr * 64 + m * 16 + frow;
#pragma unroll
            for (int n = 0; n < 4; ++n) { const int c = wc * 64 + n * 16 + fq * 4; const f32x4 b = *(const f32x4*)(cb + c); f32x4 v = acc[m][n] + b;
                u32x2 w; w.x = pk2(siluf_(v.x), siluf_(v.y)); w.y = pk2(siluf_(v.z), siluf_(v.w)); *(u32x2*)(hid + (size_t)rr * 256 + c) = w; } }
    } };
DEV void phase_cmp_a(const Params& p, unsigned char* lds) {
    const int vb = vblock(), G = gridDim.x;
    for (int u = vb; u < 64; u += G) {
        const int z = u >> 5, rbase = (u & 31) * 128;
        ACmp al{(const bf16_t*)(p.ws + (z ? WS_VC : WS_KC)), (u & 31) >> 1, (u & 1) * 128};
        BRows bl{(const bf16_t*)(p.ws + WS_CW1T) + (size_t)z * 256 * 2048, 2048};
        EpiCmpA ep{p, z, rbase};
        gemm_tile(lds, al, bl, 2048 / 64, ep);
    }
}
struct BClamp64 { const bf16_t* base; size_t ld; DEV const bf16_t* ptr(int n, int kt) const { return base + (size_t)(n & 63) * ld + kt * 64; } };
struct EpiCmpB { const Params& p; int z, rbase;
    DEV void operator()(f32x4 (&acc)[4][4], int wr, int wc, int lane) const {
        if (wc != 0) return;
        const int frow = lane & 15, fq = lane >> 4;
        bf16_t* dst = (bf16_t*)(p.ws + (z ? WS_VCMP : WS_KCMP));
#pragma unroll
        for (int m = 0; m < 4; ++m) { const int rr = rbase + wr * 64 + m * 16 + frow;
            float r = 1.f;
            if (z == 0) { float ss = 0.f;
#pragma unroll
                for (int n = 0; n < 4; ++n) { const f32x4 v = acc[m][n]; ss += (v.x * v.x + v.y * v.y) + (v.z * v.z + v.w * v.w); }
                ss += __shfl_xor(ss, 16); ss += __shfl_xor(ss, 32); r = rsqrtf(ss * (1.f / 64.f) + RMS_EPS); }
            const int bg = rr >> 8, c = rr & 255;
            if (c < NC) {
#pragma unroll
                for (int n = 0; n < 4; ++n) { const int d = n * 16 + fq * 4; f32x4 v = acc[m][n] * r;
                    if (z == 0) { const f32x4 g = *(const f32x4*)(p.g_k + d); v = v * g;
                        u32x2 w; w.x = pk2(v.x, v.y); w.y = pk2(v.z, v.w); *(u32x2*)(dst + ((size_t)bg * 256 + c) * 64 + d) = w; }
                    else { bf16_t* o = dst + ((size_t)bg * 64 + d) * 256 + c; o[0] = f2bf(v.x); o[256] = f2bf(v.y); o[512] = f2bf(v.z); o[768] = f2bf(v.w); } } }
        }
    } };
DEV void phase_cmp_b(const Params& p, unsigned char* lds) {
    const int vb = vblock(), G = gridDim.x;
    for (int u = vb; u < 64; u += G) {
        const int z = u >> 5, rbase = (u & 31) * 128;
        ARows al{(const bf16_t*)(p.ws + WS_HID) + ((size_t)z * 4096 + rbase) * 256, 256};
        BClamp64 bl{(const bf16_t*)(p.ws + WS_CW2T) + (size_t)z * 64 * 256, 256};
        EpiCmpB ep{p, z, rbase};
        gemm_tile(lds, al, bl, 256 / 64, ep);
    }
}

constexpr int CM_K = 0, CM_V = 32768, CM_VSTR = 520, CM_IMP = CM_V + 64 * CM_VSTR, CM_LDS = CM_IMP + 4 * 16384 + 1024;
DEV void cm_scores(const unsigned char* kbase, int kt, const bf16x8 (&qf)[4], int r31, int hh, f32x16 (&sacc)[2]) {
#pragma unroll
    for (int kt2 = 0; kt2 < 2; ++kt2) {
#pragma unroll
        for (int i = 0; i < 16; ++i) sacc[kt2][i] = 0.f;
        const int row = 64 * kt + 32 * kt2 + r31; const int sx = (row >> 1) & 7;
#pragma unroll
        for (int s = 0; s < 4; ++s) { const bf16x8 kf = *(const bf16x8*)(kbase + row * 128 + (((2 * s + hh) ^ sx) << 4));
            sacc[kt2] = __builtin_amdgcn_mfma_f32_32x32x16_bf16(kf, qf[s], sacc[kt2], 0, 0, 0); }
    }
}
DEV void phase_cmp_attn(const Params& p, unsigned char* lds) {
    const int tid = threadIdx.x, lane = tid & 63, wid = tid >> 6;
    const int vb = vblock(), G = gridDim.x;
    unsigned char* ws = p.ws;
    const int r31 = lane & 31, hh = lane >> 5;
    float* impl = (float*)(lds + CM_IMP);
    for (int it = vb; it < 1024; it += G) {
        int ci, bg;
        if (G == 256) { const int x = vb >> 5, jb = vb & 31, rnd = it / G, i = rnd * 32 + ((rnd & 1) ? 31 - jb : jb); ci = 63 - (i >> 1); bg = 2 * x + (i & 1); }
        else { ci = 63 - (it >> 4); bg = it & 15; }
        const int b = bg >> 1, g = bg & 1;
        const int nvis = min(NC, 4 * ci + 3), ntile = (nvis + 63) >> 6;
        const int head = g * 4 + (wid >> 1);
        const int tokl = (wid & 1) * 32 + r31, t = ci * 64 + tokl;
        const size_t tok = (size_t)b * SEQ + t;
        const int nv = t >= 31 ? min(NC, (t - 31) / 16 + 1) : 0;
        const float gate_c = ((const float*)(ws + WS_GATES))[tok * 24 + head * 3 + 0];
        __syncthreads();
        {
            const bf16_t* kc = (const bf16_t*)(ws + WS_KCMP) + (size_t)bg * 256 * 64; const bf16_t* vt = (const bf16_t*)(ws + WS_VCMP) + (size_t)bg * 64 * 256;
            const int cpr = ntile * 8;
            u32x4 rk[4], rv[4];
#pragma unroll
            for (int i = 0; i < 4; ++i) if (i < ntile) { const int idx = tid + NT * i; rk[i] = *(const u32x4*)(kc + (idx >> 3) * 64 + (idx & 7) * 8); const int d = idx / cpr, ck = idx % cpr; rv[i] = *(const u32x4*)(vt + d * 256 + ck * 8); }
#pragma unroll
            for (int i = 0; i < 4; ++i) if (i < ntile) { const int idx = tid + NT * i; *(u32x4*)(lds + CM_K + swz(idx >> 3, idx & 7)) = rk[i];
                const int d = idx / cpr, ck = idx % cpr; u32x2 a, c2; a.x = rv[i].x; a.y = rv[i].y; c2.x = rv[i].z; c2.y = rv[i].w; unsigned char* o = lds + CM_V + d * CM_VSTR + ck * 16; *(u32x2*)o = a; *(u32x2*)(o + 8) = c2; }
        }
        bf16x8 qf[4];
        { const bf16_t* qp = (const bf16_t*)(ws + WS_Q) + ((size_t)(b * 8 + head) * SEQ + t) * 64 + 8 * hh;
#pragma unroll
            for (int s = 0; s < 4; ++s) qf[s] = *(const bf16x8*)(qp + 16 * s); }
        __syncthreads();
        float l_run = 0.f;
        f32x16 ot[2];
#pragma unroll
        for (int dt = 0; dt < 2; ++dt)
#pragma unroll
            for (int i = 0; i < 16; ++i) ot[dt][i] = 0.f;
        float carry = 0.f;
#pragma unroll
        for (int kt = 0; kt < 4; ++kt) if (kt < ntile) {
            f32x16 sacc[2];
            cm_scores(lds + CM_K, kt, qf, r31, hh, sacc);
#pragma unroll
            for (int kt2 = 0; kt2 < 2; ++kt2)
#pragma unroll
                for (int i = 0; i < 16; ++i) { const int c = 64 * kt + 32 * kt2 + (i & 3) + 8 * (i >> 2) + 4 * hh; const float e_ = (c < nv) ? __builtin_amdgcn_exp2f(sacc[kt2][i]) : 0.f; sacc[kt2][i] = e_; l_run += e_; }
            {
                float own[8], xs[8];
#pragma unroll
                for (int kt2 = 0; kt2 < 2; ++kt2)
#pragma unroll
                    for (int g4 = 0; g4 < 4; ++g4) { const float e3 = 0.5f * sacc[kt2][4 * g4 + 3];
                        own[4 * kt2 + g4] = (sacc[kt2][4 * g4] + sacc[kt2][4 * g4 + 1]) + (sacc[kt2][4 * g4 + 2] + e3); xs[4 * kt2 + g4] = __shfl_xor(e3, 32); }
                float* io = impl + (wid >> 1) * 4096 + tokl * 64 + 16 * kt + hh;
#pragma unroll
                for (int gi = 0; gi < 8; ++gi) io[2 * gi] = own[gi] + (hh ? xs[gi] : (gi > 0 ? xs[gi > 0 ? gi - 1 : 0] : carry));
                carry = xs[7];
            }
#pragma unroll
            for (int kt2 = 0; kt2 < 2; ++kt2)
#pragma unroll
                for (int s2 = 0; s2 < 2; ++s2) {
                    bf16x8 pf; { u32x4 w; w.x = pk2(sacc[kt2][8 * s2 + 0], sacc[kt2][8 * s2 + 1]); w.y = pk2(sacc[kt2][8 * s2 + 2], sacc[kt2][8 * s2 + 3]);
                        w.z = pk2(sacc[kt2][8 * s2 + 4], sacc[kt2][8 * s2 + 5]); w.w = pk2(sacc[kt2][8 * s2 + 6], sacc[kt2][8 * s2 + 7]); pf = __builtin_bit_cast(bf16x8, w); }
#pragma unroll
                    for (int dt = 0; dt < 2; ++dt) {
                        const unsigned char* va = lds + CM_V + (32 * dt + r31) * CM_VSTR + (64 * kt + 32 * kt2 + 16 * s2 + 4 * hh) * 2;
                        const u32x2 lo = *(const u32x2*)(va), hi = *(const u32x2*)(va + 16);
                        u32x4 w; w.x = lo.x; w.y = lo.y; w.z = hi.x; w.w = hi.y;
                        ot[dt] = __builtin_amdgcn_mfma_f32_32x32x16_bf16(__builtin_bit_cast(bf16x8, w), pf, ot[dt], 0, 0, 0);
                    }
                }
        }
        float invL; { const float L = l_run + __shfl_xor(l_run, 32); invL = L > 0.f ? 1.f / L : 0.f; }
        if (hh == 0) impl[16384 + (wid >> 1) * 64 + tokl] = invL;
        {
            const float sc = gate_c * invL;
            bf16_t* ocp = (bf16_t*)(ws + WS_OC) + tok * 512 + head * 64;
#pragma unroll
            for (int dt = 0; dt < 2; ++dt)
#pragma unroll
                for (int g4 = 0; g4 < 4; ++g4) { const int d0 = 32 * dt + 8 * g4 + 4 * hh;
                    u32x2 w; w.x = pk2(ot[dt][4 * g4 + 0] * sc, ot[dt][4 * g4 + 1] * sc); w.y = pk2(ot[dt][4 * g4 + 2] * sc, ot[dt][4 * g4 + 3] * sc); *(u32x2*)(ocp + d0) = w; }
        }
        __syncthreads();
        for (int tt = 0; tt < 8; ++tt) {
            const int tl = wid * 8 + tt, cur = ci;
            unsigned long long mask;
            if (cur < 16) mask = (2ull << cur) - 1ull;
            else {
                const bool valid = lane <= cur;
                const float imp = (impl[tl * 64 + lane] * impl[16384 + tl] + impl[4096 + tl * 64 + lane] * impl[16384 + 64 + tl]) + (impl[8192 + tl * 64 + lane] * impl[16384 + 128 + tl] + impl[12288 + tl * 64 + lane] * impl[16384 + 192 + tl]);
                const unsigned key = (lane == 0 || lane == cur) ? 0x7F800000u : __float_as_uint(imp);
                unsigned T = 0u;
                for (int bit = 30; bit >= 0; --bit) { const unsigned cand = T | (1u << bit); if (__popcll(__ballot(valid && key >= cand)) >= 16) T = cand; }
                const unsigned long long gt = __ballot(valid && key > T), eq = __ballot(valid && key == T);
                const int need = 16 - __popcll(gt);
                const int below = __popcll(eq & ((1ull << lane) - 1ull));
                mask = gt | __ballot(valid && key == T && below < need);
            }
            if (lane == 0) ((unsigned long long*)(ws + WS_SELM))[(size_t)bg * SEQ + ci * 64 + tl] = mask;
        }
    }
}

constexpr int FA_KB = 64 * 128, FA_VB = 64 * 136, FA_STAGE = FA_KB + FA_VB, FA_LDS = 2 * FA_STAGE + 1024;
template <bool SEL, bool FAST>
DEV void fa_branch(unsigned char* lds, const bf16_t* Kb, const bf16_t* VTb, int ci, int bg, const bf16x8 (&qf)[4], int t, unsigned long long mymask, unsigned long long need,
                   f32x16 (&ot)[2], float& m_run, float& l_run) {
    const int tid = threadIdx.x, lane = tid & 63;
    const int r31 = lane & 31, hh = lane >> 5;
    const int lrow = tid >> 3, lch = tid & 7;
    const bf16_t* kg = Kb + ((size_t)bg * SEQ + lrow) * 64 + lch * 8;
    const bf16_t* vg = VTb + ((size_t)bg * 64 + lrow) * SEQ + lch * 8;
    const int koff = lrow * 128 + ((lch ^ ((lrow >> 1) & 7)) << 4), voff = FA_KB + lrow * 136 + lch * 16;
    int jlo, jhi; unsigned long long todo;
    if (SEL) { todo = need; jlo = 0; jhi = ci; } else { jlo = ci >= 8 ? ci - 8 : 0; jhi = ci; todo = 0; }
    int j = jlo;
    if (SEL) { if (todo == 0) return; j = __builtin_ctzll(todo); todo &= todo - 1; }
    u32x4 rk = *(const u32x4*)(kg + (size_t)j * 64 * 64), rv = *(const u32x4*)(vg + (size_t)j * 64);
    __syncthreads();
    *(u32x4*)(lds + koff) = rk; { u32x2 a, b2; a.x = rv.x; a.y = rv.y; b2.x = rv.z; b2.y = rv.w; *(u32x2*)(lds + voff) = a; *(u32x2*)(lds + voff + 8) = b2; }
    __syncthreads();
    int st = 0; bool seen = false;
    for (;;) {
        int jn; bool more;
        if (SEL) { more = (todo != 0); jn = more ? __builtin_ctzll(todo) : 0; todo &= todo - 1; } else { jn = j + 1; more = (jn <= jhi); }
        if (more) { rk = *(const u32x4*)(kg + (size_t)jn * 64 * 64); rv = *(const u32x4*)(vg + (size_t)jn * 64); }
        const unsigned char* base = lds + st * FA_STAGE;
        const bool bit = SEL ? ((mymask >> j) & 1ull) != 0 : true;
        const float cinit = FAST ? 0.f : ((SEL && !bit) ? -__builtin_inff() : -m_run);
        f32x16 sacc[2];
        bf16x8 kfr[2][4]; u32x4 vfr[2][2][2];
#pragma unroll
        for (int kt2 = 0; kt2 < 2; ++kt2) { const int row = 32 * kt2 + r31; const int sx = (row >> 1) & 7;
#pragma unroll
            for (int s = 0; s < 4; ++s) kfr[kt2][s] = *(const bf16x8*)(base + row * 128 + (((2 * s + hh) ^ sx) << 4)); }
        __builtin_amdgcn_sched_barrier(0);
#pragma unroll
        for (int kt2 = 0; kt2 < 2; ++kt2) {
#pragma unroll
            for (int i = 0; i < 16; ++i) sacc[kt2][i] = cinit;
#pragma unroll
            for (int s = 0; s < 4; ++s) sacc[kt2] = __builtin_amdgcn_mfma_f32_32x32x16_bf16(kfr[kt2][s], qf[s], sacc[kt2], 0, 0, 0);
        }
        __builtin_amdgcn_sched_barrier(0);
#pragma unroll
        for (int kt2 = 0; kt2 < 2; ++kt2)
#pragma unroll
            for (int s2 = 0; s2 < 2; ++s2)
#pragma unroll
                for (int dt = 0; dt < 2; ++dt) { const unsigned char* va = base + FA_KB + (32 * dt + r31) * 136 + (32 * kt2 + 16 * s2 + 4 * hh) * 2;
                    const u32x2 lo = *(const u32x2*)(va), hi = *(const u32x2*)(va + 16); u32x4 w; w.x = lo.x; w.y = lo.y; w.z = hi.x; w.w = hi.y; vfr[kt2][s2][dt] = w; }
        __builtin_amdgcn_sched_barrier(0);
        const bool boundary = SEL ? (j == ci) : (j == ci || j + 8 <= ci);
        if (FAST) {
            if (boundary) {
#pragma unroll
                for (int kt2 = 0; kt2 < 2; ++kt2)
#pragma unroll
                    for (int i = 0; i < 16; ++i) { const int key = 64 * j + 32 * kt2 + (i & 3) + 8 * (i >> 2) + 4 * hh;
                        const bool ok = SEL ? (key <= t) : (key <= t && t - key < 512);
                        sacc[kt2][i] = ok ? sacc[kt2][i] : -__builtin_inff(); }
            }
            f32x2 rs2[4];
#pragma unroll
            for (int c = 0; c < 4; ++c) rs2[c] = (f32x2){0.f, 0.f};
#pragma unroll
            for (int kt2 = 0; kt2 < 2; ++kt2)
#pragma unroll
                for (int i = 0; i < 16; i += 2) { const float e0 = __builtin_amdgcn_exp2f(sacc[kt2][i]), e1 = __builtin_amdgcn_exp2f(sacc[kt2][i + 1]); sacc[kt2][i] = e0; sacc[kt2][i + 1] = e1; rs2[(i >> 1) & 3] = rs2[(i >> 1) & 3] + (f32x2){e0, e1}; }
            const f32x2 rsum = (rs2[0] + rs2[1]) + (rs2[2] + rs2[3]);
            l_run += bit ? rsum.x + rsum.y : 0.f;
        } else {
            float mx = -__builtin_inff();
            if (boundary) {
    #pragma unroll
                for (int kt2 = 0; kt2 < 2; ++kt2)
    #pragma unroll
                    for (int i = 0; i < 16; ++i) { const int key = 64 * j + 32 * kt2 + (i & 3) + 8 * (i >> 2) + 4 * hh;
                        const bool ok = SEL ? (key <= t) : (key <= t && t - key < 512);
                        const float v = ok ? sacc[kt2][i] : -__builtin_inff(); sacc[kt2][i] = v; mx = fmaxf(mx, v); }
            } else {
    #pragma unroll
                for (int kt2 = 0; kt2 < 2; ++kt2)
    #pragma unroll
                    for (int i = 0; i < 16; ++i) mx = fmaxf(mx, sacc[kt2][i]);
            }
            mx = fmaxf(mx, __shfl_xor(mx, 32));
            const bool live = mx > -__builtin_inff();
            const bool need = (mx > 8.f) || (!seen && live && mx < -8.f);
            if (__any(need)) {
                const float d = need ? mx : 0.f;
                const float alpha = d > 0.f ? __builtin_amdgcn_exp2f(-d) : 1.f;
                m_run += d; l_run *= alpha;
    #pragma unroll
                for (int dt = 0; dt < 2; ++dt)
    #pragma unroll
                    for (int i = 0; i < 16; ++i) ot[dt][i] *= alpha;
    #pragma unroll
                for (int kt2 = 0; kt2 < 2; ++kt2)
    #pragma unroll
                    for (int i = 0; i < 16; ++i) sacc[kt2][i] -= d;
            }
            seen = seen || live;
            float rs = 0.f;
    #pragma unroll
            for (int kt2 = 0; kt2 < 2; ++kt2)
    #pragma unroll
                for (int i = 0; i < 16; ++i) { const float e = __builtin_amdgcn_exp2f(sacc[kt2][i]); sacc[kt2][i] = e; rs += e; }
            l_run += rs;
        }
#pragma unroll
        for (int kt2 = 0; kt2 < 2; ++kt2)
#pragma unroll
            for (int s2 = 0; s2 < 2; ++s2) {
                bf16x8 pf; { u32x4 w; w.x = pk2(sacc[kt2][8 * s2 + 0], sacc[kt2][8 * s2 + 1]); w.y = pk2(sacc[kt2][8 * s2 + 2], sacc[kt2][8 * s2 + 3]);
                    w.z = pk2(sacc[kt2][8 * s2 + 4], sacc[kt2][8 * s2 + 5]); w.w = pk2(sacc[kt2][8 * s2 + 6], sacc[kt2][8 * s2 + 7]);
                    if (FAST && SEL) { const unsigned bm = bit ? 0xffffffffu : 0u; w.x &= bm; w.y &= bm; w.z &= bm; w.w &= bm; }
                    pf = __builtin_bit_cast(bf16x8, w); }
#pragma unroll
                for (int dt = 0; dt < 2; ++dt) ot[dt] = __builtin_amdgcn_mfma_f32_32x32x16_bf16(__builtin_bit_cast(bf16x8, vfr[kt2][s2][dt]), pf, ot[dt], 0, 0, 0);
            }
        if (!more) break;
        { unsigned char* nb = lds + (st ^ 1) * FA_STAGE; *(u32x4*)(nb + koff) = rk; u32x2 a, b2; a.x = rv.x; a.y = rv.y; b2.x = rv.z; b2.y = rv.w; *(u32x2*)(nb + voff) = a; *(u32x2*)(nb + voff + 8) = b2; }
        __syncthreads();
        st ^= 1; j = jn;
    }
}
DEV void phase_flash(const Params& p, unsigned char* lds) {
    const int tid = threadIdx.x, lane = tid & 63, wid = tid >> 6;
    const int vb = vblock(), G = gridDim.x;
    unsigned char* ws = p.ws;
    const int r31 = lane & 31, hh = lane >> 5;
    unsigned long long* red = (unsigned long long*)(lds + 2 * FA_STAGE);
    bool fast_s, fast_w;
    { const float gq = wave_max(fabsf(p.g_q[lane])), gs = wave_max(fabsf(p.g_k[64 + lane])), gw = wave_max(fabsf(p.g_k[128 + lane]));
      fast_s = __builtin_amdgcn_readfirstlane((int)(11.6f * gq * gs <= 60.f)) != 0; fast_w = __builtin_amdgcn_readfirstlane((int)(11.6f * gq * gw <= 60.f)) != 0; }
    for (int it = vb; it < 1024; it += G) {
        int ci, bg;
        if (G == 256) { const int x = vb >> 5, jb = vb & 31, rnd = it / G, i = rnd * 32 + ((rnd & 1) ? 31 - jb : jb); ci = 63 - (i >> 1); bg = 2 * x + (i & 1); }
        else { ci = 63 - (it >> 4); bg = it & 15; }
        const int b = bg >> 1, g = bg & 1;
        const int head = g * 4 + (wid >> 1);
        const int t = ci * 64 + (wid & 1) * 32 + r31;
        const size_t tok = (size_t)b * SEQ + t;
        bf16x8 qf[4];
        { const bf16_t* qp = (const bf16_t*)(ws + WS_Q) + ((size_t)(b * 8 + head) * SEQ + t) * 64 + 8 * hh;
#pragma unroll
            for (int s = 0; s < 4; ++s) qf[s] = *(const bf16x8*)(qp + 16 * s); }
        const unsigned long long mymask = ((const unsigned long long*)(ws + WS_SELM))[(size_t)bg * SEQ + t];
        const float gate_s = ((const float*)(ws + WS_GATES))[tok * 24 + head * 3 + 1], gate_w = ((const float*)(ws + WS_GATES))[tok * 24 + head * 3 + 2];
        u32x2 ocv[2][4];
#pragma unroll
        for (int dt = 0; dt < 2; ++dt)
#pragma unroll
            for (int g4 = 0; g4 < 4; ++g4) ocv[dt][g4] = *(const u32x2*)((const bf16_t*)(ws + WS_OC) + tok * 512 + head * 64 + 32 * dt + 8 * g4 + 4 * hh);
        unsigned long long orm = mymask;
#pragma unroll
        for (int o = 1; o < 32; o <<= 1) { const unsigned lo = __shfl_xor((unsigned)orm, o), hi = __shfl_xor((unsigned)(orm >> 32), o); orm |= ((unsigned long long)hi << 32) | lo; }
        __syncthreads();
        if (wid < 2 && lane == 0) red[wid] = orm;
        __syncthreads();
        const unsigned long long need = red[0] | red[1];
        f32x16 oc[2];
        {
            f32x16 ot[2]; float m_run = 0.f, l_run = 0.f;
#pragma unroll
            for (int dt = 0; dt < 2; ++dt)
#pragma unroll
                for (int i = 0; i < 16; ++i) ot[dt][i] = 0.f;
            if (fast_s) fa_branch<true, true>(lds, (const bf16_t*)(ws + WS_KS), (const bf16_t*)(ws + WS_VST), ci, bg, qf, t, mymask, need, ot, m_run, l_run);
            else fa_branch<true, false>(lds, (const bf16_t*)(ws + WS_KS), (const bf16_t*)(ws + WS_VST), ci, bg, qf, t, mymask, need, ot, m_run, l_run);
            const float lt = l_run + __shfl_xor(l_run, 32);
            const float sc = gate_s / lt;
#pragma unroll
            for (int dt = 0; dt < 2; ++dt)
#pragma unroll
                for (int i = 0; i < 16; ++i) oc[dt][i] = ot[dt][i] * sc;
        }
        {
            f32x16 ot[2]; float m_run = 0.f, l_run = 0.f;
#pragma unroll
            for (int dt = 0; dt < 2; ++dt)
#pragma unroll
                for (int i = 0; i < 16; ++i) ot[dt][i] = 0.f;
            if (fast_w) fa_branch<false, true>(lds, (const bf16_t*)(ws + WS_KW), (const bf16_t*)(ws + WS_VWT), ci, bg, qf, t, 0ull, 0ull, ot, m_run, l_run);
            else fa_branch<false, false>(lds, (const bf16_t*)(ws + WS_KW), (const bf16_t*)(ws + WS_VWT), ci, bg, qf, t, 0ull, 0ull, ot, m_run, l_run);
            const float lt = l_run + __shfl_xor(l_run, 32);
            const float sc = gate_w / lt;
#pragma unroll
            for (int dt = 0; dt < 2; ++dt)
#pragma unroll
                for (int i = 0; i < 16; ++i) oc[dt][i] += ot[dt][i] * sc;
        }
        {
            bf16_t* mix = (bf16_t*)(ws + WS_R1) + tok * 1024 + head * 64;
            float ss = 0.f;
#pragma unroll
            for (int dt = 0; dt < 2; ++dt)
#pragma unroll
                for (int g4 = 0; g4 < 4; ++g4) { const int d0 = 32 * dt + 8 * g4 + 4 * hh; const u32x2 c = ocv[dt][g4];
                    const float v0 = oc[dt][4 * g4 + 0] + bflo(c.x), v1 = oc[dt][4 * g4 + 1] + bfhi(c.x), v2 = oc[dt][4 * g4 + 2] + bflo(c.y), v3 = oc[dt][4 * g4 + 3] + bfhi(c.y);
                    ss += (v0 * v0 + v1 * v1) + (v2 * v2 + v3 * v3);
                    u32x2 w; w.x = pk2(v0, v1); w.y = pk2(v2, v3); *(u32x2*)(mix + d0) = w; }
            ss += __shfl_xor(ss, 32);
            if (hh == 0) atomicAdd((float*)(ws + WS_ROWSS) + tok, ss);
        }
    }
}

DEV int swz256(int row, int chunk) { return row * 256 + ((chunk ^ (row & 15)) << 4); }
DEV void hgrn_cumsum(const Params& p, int bh, int c, float* segs, f32x2 (&lf)[8], f32x2 (&a)[8], f32x2& r, f32x2& alast) {
    const int tid = threadIdx.x, k2 = tid & 63, tq = tid >> 6;
    const int b = bh >> 2, h = bh & 3;
    const bf16_t* HL = (const bf16_t*)(p.ws + WS_HLOGF) + ((size_t)b * SEQ + c * 64 + tq * 8) * 512 + h * 128 + 2 * k2;
#pragma unroll
    for (int i = 0; i < 8; ++i) { const unsigned w = *(const unsigned*)(HL + (size_t)i * 512); lf[i] = (f32x2){bflo(w), bfhi(w)}; }
    f32x2 run = (f32x2){0.f, 0.f};
#pragma unroll
    for (int i = 0; i < 8; ++i) { run = run + lf[i]; a[i] = run; }
    *(f32x2*)(segs + tq * 128 + 2 * k2) = run;
    __syncthreads();
    f32x2 off = (f32x2){0.f, 0.f}, tot = off, rr = off;
#pragma unroll
    for (int q = 0; q < 8; ++q) { const f32x2 s = *(const f32x2*)(segs + q * 128 + 2 * k2); if (q < tq) off = off + s; if (q < 4) rr = rr + s; tot = tot + s; }
#pragma unroll
    for (int i = 0; i < 8; ++i) a[i] = a[i] + off;
    r = rr; alast = tot;
}
DEV void hgrn_stage_vt(const Params& p, int bh, int c, unsigned char* vt) {
    const int tid = threadIdx.x, k2 = tid & 63, tq = tid >> 6;
    const int b = bh >> 2, h = bh & 3;
    const bf16_t* HV = (const bf16_t*)(p.ws + WS_HV) + ((size_t)b * SEQ + c * 64 + tq * 8) * 512 + h * 128 + 2 * k2;
    unsigned vv[8];
#pragma unroll
    for (int i = 0; i < 8; ++i) vv[i] = *(const unsigned*)(HV + (size_t)i * 512);
    u32x4 lo, hi;
    lo.x = (vv[0] & 0xffffu) | (vv[1] << 16); lo.y = (vv[2] & 0xffffu) | (vv[3] << 16); lo.z = (vv[4] & 0xffffu) | (vv[5] << 16); lo.w = (vv[6] & 0xffffu) | (vv[7] << 16);
    hi.x = (vv[0] >> 16) | (vv[1] & 0xffff0000u); hi.y = (vv[2] >> 16) | (vv[3] & 0xffff0000u); hi.z = (vv[4] >> 16) | (vv[5] & 0xffff0000u); hi.w = (vv[6] >> 16) | (vv[7] & 0xffff0000u);
    *(u32x4*)(vt + swz(2 * k2, tq)) = lo; *(u32x4*)(vt + swz(2 * k2 + 1, tq)) = hi;
}
constexpr int H1_KT = 0, H1_VT = 16384, H1_SEG = 32768, H1_EK = H1_SEG + 4096;
DEV void phase_hgrn_a1(const Params& p, unsigned char* lds, int vb0, int nb) {
    const int tid = threadIdx.x, lane = tid & 63, wid = tid >> 6, k2 = tid & 63, tq = tid >> 6;
    const int vb = vblock(), G = gridDim.x;
    const int frow = lane & 15, fq = lane >> 4, wr = wid >> 1, wc = wid & 1;
    float* segs = (float*)(lds + H1_SEG); float* ek = (float*)(lds + H1_EK);
    bf16_t* ubuf = (bf16_t*)(p.ws + WS_UBUF); float* dbuf = (float*)(p.ws + WS_DBUF);
    if (vb < vb0) return;
    for (int item = vb - vb0; item < 2048; item += nb) {
        const int bh = item >> 6, c = item & 63;
        __syncthreads();
        f32x2 lf[8], a[8], r, al;
        hgrn_cumsum(p, bh, c, segs, lf, a, r, al);
        {
            float kx[8], ky[8];
#pragma unroll
            for (int i = 0; i < 8; ++i) { kx[i] = (1.f - __expf(lf[i].x)) * __expf(fminf(r.x - a[i].x, 80.f)); ky[i] = (1.f - __expf(lf[i].y)) * __expf(fminf(r.y - a[i].y, 80.f)); }
            u32x4 w0, w1;
            w0.x = pk2(kx[0], kx[1]); w0.y = pk2(kx[2], kx[3]); w0.z = pk2(kx[4], kx[5]); w0.w = pk2(kx[6], kx[7]);
            w1.x = pk2(ky[0], ky[1]); w1.y = pk2(ky[2], ky[3]); w1.z = pk2(ky[4], ky[5]); w1.w = pk2(ky[6], ky[7]);
            *(u32x4*)(lds + H1_KT + swz(2 * k2, tq)) = w0; *(u32x4*)(lds + H1_KT + swz(2 * k2 + 1, tq)) = w1;
        }
        hgrn_stage_vt(p, bh, c, lds + H1_VT);
        if (tq == 7) { ek[2 * k2] = __expf(al.x - r.x); ek[2 * k2 + 1] = __expf(al.y - r.y); f32x2 d; d.x = __expf(al.x); d.y = __expf(al.y); *(f32x2*)(dbuf + (size_t)item * 128 + 2 * k2) = d; }
        __syncthreads();
        f32x4 acc[2][4];
#pragma unroll
        for (int m = 0; m < 2; ++m)
#pragma unroll
            for (int n = 0; n < 4; ++n) acc[m][n] = (f32x4){0.f, 0.f, 0.f, 0.f};
        const int sx = (frow >> 1) & 7;
#pragma unroll
        for (int ks = 0; ks < 2; ++ks) {
            const int co = ((ks * 4 + fq) ^ sx) << 4;
            bf16x8 af[2], bfr[4];
#pragma unroll
            for (int m = 0; m < 2; ++m) af[m] = *(const bf16x8*)(lds + H1_VT + (32 * wr + 16 * m + frow) * 128 + co);
#pragma unroll
            for (int n = 0; n < 4; ++n) bfr[n] = *(const bf16x8*)(lds + H1_KT + (64 * wc + 16 * n + frow) * 128 + co);
#pragma unroll
            for (int m = 0; m < 2; ++m)
#pragma unroll
                for (int n = 0; n < 4; ++n) acc[m][n] = __builtin_amdgcn_mfma_f32_16x16x32_bf16(bfr[n], af[m], acc[m][n], 0, 0, 0);
        }
#pragma unroll
        for (int m = 0; m < 2; ++m) { const int v = 32 * wr + 16 * m + frow;
#pragma unroll
            for (int n = 0; n < 4; ++n) { const int k0 = 64 * wc + 16 * n + 4 * fq; const f32x4 e = *(const f32x4*)(ek + k0); const f32x4 o = acc[m][n] * e;
                u32x2 w; w.x = pk2(o.x, o.y); w.y = pk2(o.z, o.w); *(u32x2*)(ubuf + ((size_t)item * 128 + v) * 128 + k0) = w; } }
    }
}
DEV void phase_hgrn_a2(const Params& p, unsigned char* lds) {
    const int G = gridDim.x;
    bf16_t* ubuf = (bf16_t*)(p.ws + WS_UBUF); const float* dbuf = (const float*)(p.ws + WS_DBUF);
    for (int gid = blockIdx.x * NT + threadIdx.x; gid < 131072; gid += G * NT) {
        const int bh = gid >> 12, v = (gid >> 5) & 127, k4 = gid & 31;
        bf16_t* u = ubuf + ((size_t)bh * 64 * 128 + v) * 128 + 4 * k4;
        const float* d = dbuf + (size_t)bh * 64 * 128 + 4 * k4;
        f32x4 S = (f32x4){0.f, 0.f, 0.f, 0.f};
        for (int c0 = 0; c0 < 64; c0 += 8) {
            u32x2 uu[8]; f32x4 dd[8];
#pragma unroll
            for (int j = 0; j < 8; ++j) { uu[j] = *(const u32x2*)(u + (size_t)(c0 + j) * 16384); dd[j] = *(const f32x4*)(d + (size_t)(c0 + j) * 128); }
#pragma unroll
            for (int j = 0; j < 8; ++j) { u32x2 w; w.x = pk2(S.x, S.y); w.y = pk2(S.z, S.w); *(u32x2*)(u + (size_t)(c0 + j) * 16384) = w;
                S.x = dd[j].x * S.x + bflo(uu[j].x); S.y = dd[j].y * S.y + bfhi(uu[j].x); S.z = dd[j].z * S.z + bflo(uu[j].y); S.w = dd[j].w * S.w + bfhi(uu[j].y); }
        }
    }
}
constexpr int H3_QH = 0, H3_QA = 16384, H3_KH = 32768, H3_VT = 49152, H3_PP = 65536, H3_ST = 73728, H3_SEG = 106496, H3_RED = 110592;
DEV void phase_hgrn_a3(const Params& p, unsigned char* lds) {
    const int tid = threadIdx.x, lane = tid & 63, wid = tid >> 6, k2 = tid & 63, tq = tid >> 6;
    const int vb = vblock(), G = gridDim.x;
    const int frow = lane & 15, fq = lane >> 4;
    float* segs = (float*)(lds + H3_SEG); float* red = (float*)(lds + H3_RED);
    const bf16_t* ubuf = (const bf16_t*)(p.ws + WS_UBUF);
    for (int item = vb; item < 2048; item += G) {
        const int bh = item >> 6, c = item & 63, b = bh >> 2, h = bh & 3;
        __syncthreads();
        f32x2 lf[8], a[8], r, al;
        hgrn_cumsum(p, bh, c, segs, lf, a, r, al);
        {
            const bf16_t* HQ = (const bf16_t*)(p.ws + WS_HQ) + ((size_t)b * SEQ + c * 64 + tq * 8) * 512 + h * 128 + 2 * k2;
            unsigned qq[8];
#pragma unroll
            for (int i = 0; i < 8; ++i) qq[i] = *(const unsigned*)(HQ + (size_t)i * 512);
#pragma unroll
            for (int i = 0; i < 8; ++i) { const int t = 8 * tq + i; const float q0 = bflo(qq[i]), q1 = bfhi(qq[i]);
                const int off = swz256(t, k2 >> 2) + (k2 & 3) * 4;
                *(unsigned*)(lds + H3_QH + off) = pk2(q0 * __expf(fminf(a[i].x - r.x, 80.f)), q1 * __expf(fminf(a[i].y - r.y, 80.f)));
                *(unsigned*)(lds + H3_QA + off) = pk2(q0 * __expf(a[i].x), q1 * __expf(a[i].y));
                *(unsigned*)(lds + H3_KH + off) = pk2((1.f - __expf(lf[i].x)) * __expf(fminf(r.x - a[i].x, 80.f)), (1.f - __expf(lf[i].y)) * __expf(fminf(r.y - a[i].y, 80.f))); }
        }
        hgrn_stage_vt(p, bh, c, lds + H3_VT);
        {
            const bf16_t* st = ubuf + (size_t)item * 16384;
#pragma unroll
            for (int i = 0; i < 4; ++i) { const int q = tid + NT * i, v = q >> 4, ch = q & 15; *(u32x4*)(lds + H3_ST + swz256(v, ch)) = *(const u32x4*)(st + v * 128 + ch * 8); }
        }
        __syncthreads();
        {
            const int wr = wid >> 1, wc = wid & 1;
            f32x4 acc[2];
            acc[0] = (f32x4){0.f, 0.f, 0.f, 0.f}; acc[1] = acc[0];
            if (32 * wc <= 16 * wr + 15) {
#pragma unroll
                for (int ks = 0; ks < 4; ++ks) {
                    const int co = ((ks * 4 + fq) ^ frow) << 4;
                    const bf16x8 af = *(const bf16x8*)(lds + H3_QH + (16 * wr + frow) * 256 + co);
#pragma unroll
                    for (int n = 0; n < 2; ++n) { const bf16x8 bfr = *(const bf16x8*)(lds + H3_KH + (32 * wc + 16 * n + frow) * 256 + co);
                        acc[n] = __builtin_amdgcn_mfma_f32_16x16x32_bf16(bfr, af, acc[n], 0, 0, 0); }
                }
            }
            const int t = 16 * wr + frow;
#pragma unroll
            for (int n = 0; n < 2; ++n) { const int s0 = 32 * wc + 16 * n + 4 * fq; f32x4 v = acc[n];
                v.x = (s0 + 0 <= t) ? v.x : 0.f; v.y = (s0 + 1 <= t) ? v.y : 0.f; v.z = (s0 + 2 <= t) ? v.z : 0.f; v.w = (s0 + 3 <= t) ? v.w : 0.f;
                u32x2 w; w.x = pk2(v.x, v.y); w.y = pk2(v.z, v.w);
                *(u32x2*)(lds + H3_PP + t * 128 + ((((s0 >> 3)) ^ ((t >> 1) & 7)) << 4) + (s0 & 7) * 2) = w; }
        }
        __syncthreads();
        {
            const int wr = wid >> 2, wc = wid & 3;
            f32x4 acc[2][2];
#pragma unroll
            for (int m = 0; m < 2; ++m)
#pragma unroll
                for (int n = 0; n < 2; ++n) acc[m][n] = (f32x4){0.f, 0.f, 0.f, 0.f};
            const int sx = (frow >> 1) & 7;
#pragma unroll
            for (int ks = 0; ks < 2; ++ks) {
                const int co = ((ks * 4 + fq) ^ sx) << 4;
                bf16x8 af[2], bfr[2];
#pragma unroll
                for (int m = 0; m < 2; ++m) af[m] = *(const bf16x8*)(lds + H3_PP + (32 * wr + 16 * m + frow) * 128 + co);
#pragma unroll
                for (int n = 0; n < 2; ++n) bfr[n] = *(const bf16x8*)(lds + H3_VT + (32 * wc + 16 * n + frow) * 128 + co);
#pragma unroll
                for (int m = 0; m < 2; ++m)
#pragma unroll
                    for (int n = 0; n < 2; ++n) acc[m][n] = __builtin_amdgcn_mfma_f32_16x16x32_bf16(bfr[n], af[m], acc[m][n], 0, 0, 0);
            }
#pragma unroll
            for (int ks = 0; ks < 4; ++ks) {
                const int co = ((ks * 4 + fq) ^ frow) << 4;
                bf16x8 af[2], bfr[2];
#pragma unroll
                for (int m = 0; m < 2; ++m) af[m] = *(const bf16x8*)(lds + H3_QA + (32 * wr + 16 * m + frow) * 256 + co);
#pragma unroll
                for (int n = 0; n < 2; ++n) bfr[n] = *(const bf16x8*)(lds + H3_ST + (32 * wc + 16 * n + frow) * 256 + co);
#pragma unroll
                for (int m = 0; m < 2; ++m)
#pragma unroll
                    for (int n = 0; n < 2; ++n) acc[m][n] = __builtin_amdgcn_mfma_f32_16x16x32_bf16(bfr[n], af[m], acc[m][n], 0, 0, 0);
            }
            f32x4 gnv[2]; u32x2 ggv[2][2];
#pragma unroll
            for (int n = 0; n < 2; ++n) gnv[n] = *(const f32x4*)(p.g_hn + 32 * wc + 16 * n + 4 * fq);
#pragma unroll
            for (int m = 0; m < 2; ++m)
#pragma unroll
                for (int n = 0; n < 2; ++n) ggv[m][n] = *(const u32x2*)((const bf16_t*)(p.ws + WS_HG) + ((size_t)b * SEQ + c * 64 + 32 * wr + 16 * m + frow) * 512 + h * 128 + 32 * wc + 16 * n + 4 * fq);
#pragma unroll
            for (int m = 0; m < 2; ++m) { float ss = 0.f;
#pragma unroll
                for (int n = 0; n < 2; ++n) { const f32x4 v = acc[m][n]; ss += (v.x * v.x + v.y * v.y) + (v.z * v.z + v.w * v.w); }
                ss += __shfl_xor(ss, 16); ss += __shfl_xor(ss, 32);
                if (fq == 0) red[(32 * wr + 16 * m + frow) * 4 + wc] = ss; }
            __syncthreads();
#pragma unroll
            for (int m = 0; m < 2; ++m) { const int t = 32 * wr + 16 * m + frow; const f32x4 q4 = *(const f32x4*)(red + t * 4);
                const float rs = rsqrtf(((q4.x + q4.y) + (q4.z + q4.w)) * (1.f / 128.f) + RMS_EPS);
                const size_t row = (size_t)b * SEQ + c * 64 + t;
#pragma unroll
                for (int n = 0; n < 2; ++n) { const int v0 = 32 * wc + 16 * n + 4 * fq; const f32x4 gn = gnv[n]; const u32x2 gg = ggv[m][n];
                    const f32x4 o = acc[m][n];
                    u32x2 w; w.x = pk2(o.x * rs * gn.x * bflo(gg.x), o.y * rs * gn.y * bfhi(gg.x)); w.y = pk2(o.z * rs * gn.z * bflo(gg.y), o.w * rs * gn.w * bfhi(gg.y));
                    *(u32x2*)((bf16_t*)(p.ws + WS_R1) + row * 1024 + 512 + h * 128 + v0) = w; } }
        }
    }
}

DEV void phase_normalize(const Params& p, unsigned char* lds) {
    const int vb = vblock(), G = gridDim.x;
    unsigned char* ws = p.ws;
    __syncthreads();
    {
        float* tl = (float*)lds;
        for (int r = vb; r < 32 * 4 * 16; r += G) { const int e = r / 64, q = r % 64; SrcW13_4 s{p.w1 + (size_t)e * 1024 * 512, p.w3 + (size_t)e * 1024 * 512, p.ffn_g};
            convert_tile256(tl, s, (bf16_t*)(ws + WS_W13T) + (size_t)e * 1024 * 1024, 1024, (q / 16) * 256, (q % 16) * 64); }
    }
    __syncthreads();
}

struct EpiOut8 { const Params& p; static constexpr bool MIDSCALE = true;
    DEV float rowscale(int row) const { return rsqrtf(((const float*)(p.ws + WS_ROWSS))[row] * (1.f / 512.f) + RMS_EPS); }
    DEV int midk() const { return 8; }
    DEV void operator()(const f32x4 (&acc)[2][2][4][2], const pg8::Unit& u, int wr, int wc, int fr, int fq) const {
        const size_t off0 = ((size_t)u.pm * 256 + wr * 64 + fr) * DM + u.pn * 256 + 64 * wc + 8 * fq;
        const bf16_t* xb = (const bf16_t*)(p.ws + WS_XB);
        u32x4 xr[2][4][2];
#pragma unroll
        for (int ai = 0; ai < 2; ++ai)
#pragma unroll
            for (int m = 0; m < 4; ++m)
#pragma unroll
                for (int bj = 0; bj < 2; ++bj) xr[ai][m][bj] = *(const u32x4*)(xb + off0 + (size_t)(128 * ai + 16 * m) * DM + 32 * bj);
#pragma unroll
        for (int ai = 0; ai < 2; ++ai)
#pragma unroll
            for (int m = 0; m < 4; ++m)
#pragma unroll
                for (int bj = 0; bj < 2; ++bj) { const u32x4 w = xr[ai][m][bj]; float* o = p.out + off0 + (size_t)(128 * ai + 16 * m) * DM + 32 * bj;
                    *(f32x4*)(o) = (f32x4){bflo(w.x), bfhi(w.x), bflo(w.y), bfhi(w.y)} + acc[ai][bj][m][0]; *(f32x4*)(o + 4) = (f32x4){bflo(w.z), bfhi(w.z), bflo(w.w), bfhi(w.w)} + acc[ai][bj][m][1]; }
    } };
DEV void phase_outproj(const Params& p, unsigned char* lds) {
    pg8::Gemm g{(const bf16_t*)(p.ws + WS_R1), (const bf16_t*)(p.ws + WS_WOUTT), NTOK, DM, DM};
    pg8::StaticOrder S; S.init(NTOK, DM, (int)gridDim.x, (int)blockIdx.x);
    EpiOut8 E{p};
    if (((blockIdx.x >> 3) & 1) == 0) phase_normalize(p, lds);
    pg8::gemm_phase((PG8_LAS unsigned char*)lds, g, S, E);
    if (((blockIdx.x >> 3) & 1) != 0) phase_normalize(p, lds);
}

constexpr int RT_W = 0, RT_LG = 2 * 49152, RT_RS = RT_LG + 128 * 49 * 4, RT_HIST = RT_RS + 512, RT_BASE = RT_HIST + 1024, RT_LDS = RT_BASE + 1024;
DEV void phase_router(const Params& p, unsigned char* lds) {
    const int tid = threadIdx.x, lane = tid & 63, wid = tid >> 6, frow = lane & 15, fq = lane >> 4;
    const int vb = vblock(), G = gridDim.x;
    unsigned char* ws = p.ws;
    float* lg = (float*)(lds + RT_LG); float* rsd = (float*)(lds + RT_RS);
    int* hist = (int*)(lds + RT_HIST); int* basep = (int*)(lds + RT_BASE);
    const bf16_t* rw = (const bf16_t*)(ws + WS_RW);
    for (int it = vb; it < NTOK / 128; it += G) {
        const size_t row0 = (size_t)it * 128;
        const size_t trow = row0 + 16 * wid + frow;
        const float* hrow = p.out + trow * DM + 8 * fq;
        bf16_t* hbrow = (bf16_t*)(ws + WS_R1) + trow * DM + 8 * fq;
        f32x4 acc[3]; float ss = 0.f;
#pragma unroll
        for (int nt = 0; nt < 3; ++nt) acc[nt] = (f32x4){0.f, 0.f, 0.f, 0.f};
        if (tid < 128) hist[tid] = 0;
        u32x4 wreg[6]; f32x4 xa[4][2], xn[4][2];
#define RT_LOADW(kc_) do { _Pragma("unroll") for (int i = 0; i < 6; ++i) { const int idx = tid + NT * i, r = idx >> 5, c = idx & 31; wreg[i] = *(const u32x4*)(rw + (size_t)r * 1024 + (kc_) * 256 + c * 8); } } while (0)
#define RT_STOREW(buf_) do { _Pragma("unroll") for (int i = 0; i < 6; ++i) { const int idx = tid + NT * i, r = idx >> 5, c = idx & 31; *(u32x4*)(lds + RT_W + (buf_) * 49152 + r * 512 + ((c ^ (r & 15)) << 4)) = wreg[i]; } } while (0)
#define RT_LOADX(dst_, hc_) do { _Pragma("unroll") for (int ks = 0; ks < 4; ++ks) { dst_[ks][0] = *(const f32x4*)(hrow + (hc_) * 128 + 32 * ks); dst_[ks][1] = *(const f32x4*)(hrow + (hc_) * 128 + 32 * ks + 4); } } while (0)
        __syncthreads();
        RT_LOADW(0); RT_LOADX(xa, 0); RT_STOREW(0);
        __syncthreads();
#pragma unroll 1
        for (int hc = 0; hc < 8; ++hc) {
            if (hc < 7) RT_LOADX(xn, hc + 1);
            const unsigned char* wb = lds + RT_W + ((hc >> 1) & 1) * 49152;
#pragma unroll
            for (int ks = 0; ks < 4; ++ks) {
                const f32x4 a = xa[ks][0], b = xa[ks][1];
                ss += ((a.x * a.x + a.y * a.y) + (a.z * a.z + a.w * a.w)) + ((b.x * b.x + b.y * b.y) + (b.z * b.z + b.w * b.w));
                u32x4 hi; hi.x = pk2(a.x, a.y); hi.y = pk2(a.z, a.w); hi.z = pk2(b.x, b.y); hi.w = pk2(b.z, b.w);
                u32x4 lo; lo.x = pk2(a.x - bflo(hi.x), a.y - bfhi(hi.x)); lo.y = pk2(a.z - bflo(hi.y), a.w - bfhi(hi.y)); lo.z = pk2(b.x - bflo(hi.z), b.y - bfhi(hi.z)); lo.w = pk2(b.z - bflo(hi.w), b.w - bfhi(hi.w));
                *(u32x4*)(hbrow + hc * 128 + 32 * ks) = hi;
                const bf16x8 hh = __builtin_bit_cast(bf16x8, hi), hl = __builtin_bit_cast(bf16x8, lo);
                const int co = ((4 * (4 * (hc & 1) + ks) + fq) ^ frow) << 4;
#pragma unroll
                for (int nt = 0; nt < 3; ++nt) {
                    const bf16x8 whi = *(const bf16x8*)(wb + (16 * nt + frow) * 512 + co), wlo = *(const bf16x8*)(wb + (48 + 16 * nt + frow) * 512 + co);
                    acc[nt] = __builtin_amdgcn_mfma_f32_16x16x32_bf16(whi, hh, acc[nt], 0, 0, 0);
                    acc[nt] = __builtin_amdgcn_mfma_f32_16x16x32_bf16(wlo, hh, acc[nt], 0, 0, 0);
                    acc[nt] = __builtin_amdgcn_mfma_f32_16x16x32_bf16(whi, hl, acc[nt], 0, 0, 0);
                }
            }
            if ((hc & 1) == 0 && hc < 6) { RT_LOADW((hc >> 1) + 1); }
            if ((hc & 1) == 1 && hc < 7) { RT_STOREW(((hc >> 1) + 1) & 1); }
#pragma unroll
            for (int ks = 0; ks < 4; ++ks) { xa[ks][0] = xn[ks][0]; xa[ks][1] = xn[ks][1]; }
            if (hc & 1) __syncthreads();
        }
#undef RT_LOADW
#undef RT_STOREW
#undef RT_LOADX
        ss += __shfl_xor(ss, 16); ss += __shfl_xor(ss, 32);
        if (fq == 0) rsd[16 * wid + frow] = rsqrtf(ss * (1.f / DM) + RMS_EPS);
#pragma unroll
        for (int nt = 0; nt < 3; ++nt) { float* o = lg + (16 * wid + frow) * 49 + 16 * nt + 4 * fq; o[0] = acc[nt].x; o[1] = acc[nt].y; o[2] = acc[nt].z; o[3] = acc[nt].w; }
        __syncthreads();
        int bin = 0, slot = 0, ea = 0, eb = 0, sa = 0, sb = 0; float wa = 0.f, wb = 0.f;
        int* ehist = hist + 112; int* ebase = basep + 112;
        if (tid < 32) ehist[tid] = 0;
        __syncthreads();
        if (tid < 128) {
            const float rs = rsd[tid];
            ((float*)(ws + WS_RSTD2))[row0 + tid] = rs;
            float gl[4]; int gi = 0; float gm = -1e30f;
#pragma unroll
            for (int c = 0; c < 4; ++c) { gl[c] = lg[tid * 49 + c] * rs + p.b_group[c]; if (gl[c] > gm) { gm = gl[c]; gi = c; } }
            float gs = 0.f;
#pragma unroll
            for (int c = 0; c < 4; ++c) gs += __expf(gl[c] - gm);
            const float pg = 1.f / gs;
            float el[8]; int i0 = 0; float m0 = -1e30f;
#pragma unroll
            for (int c = 0; c < 8; ++c) { el[c] = lg[tid * 49 + 4 + gi * 8 + c] * rs + p.b_expert[gi * 8 + c]; if (el[c] > m0) { m0 = el[c]; i0 = c; } }
            int i1 = 0; float m1 = -1e30f;
#pragma unroll
            for (int c = 0; c < 8; ++c) if (c != i0 && el[c] > m1) { m1 = el[c]; i1 = c; }
            const float e1 = __expf(m1 - m0); const float w0 = pg / (1.f + e1), w1 = pg * e1 / (1.f + e1);
            const int a = min(i0, i1), bb = max(i0, i1);
            bin = gi * 28 + (7 * a - (a * (a - 1)) / 2) + (bb - a - 1);
            wa = (i0 < i1) ? w0 : w1; wb = (i0 < i1) ? w1 : w0; ea = gi * 8 + a; eb = gi * 8 + bb;
            slot = atomicAdd(&hist[bin], 1);
            sa = atomicAdd(&ehist[ea], 1); sb = atomicAdd(&ehist[eb], 1);
        }
        __syncthreads();
        if (tid < NBIN) { const int h = hist[tid]; basep[tid] = h ? atomicAdd((int*)(ws + WS_CTL) + tid, h) : 0; }
        else if (tid >= 128 && tid < 160) { const int e = tid - 128; const int h = ehist[e]; ebase[e] = h ? atomicAdd((int*)(ws + WS_CTL + 512) + e, h) : 0; }
        __syncthreads();
        if (tid < 128) {
            const int t = (int)(row0 + tid);
            ((int*)(ws + WS_BINL))[(size_t)bin * BINCAP + basep[bin] + slot] = t;
            sa += ebase[ea]; sb += ebase[eb];
            ((int*)(ws + WS_EL))[(size_t)ea * BINCAP + sa] = t; ((float*)(ws + WS_EW))[(size_t)ea * BINCAP + sa] = wa;
            ((int*)(ws + WS_EL))[(size_t)eb * BINCAP + sb] = t; ((float*)(ws + WS_EW))[(size_t)eb * BINCAP + sb] = wb;
            { const unsigned dpos = (unsigned)bin | ((unsigned)(basep[bin] + slot) << 7); ((unsigned*)(ws + WS_EDST))[(size_t)ea * BINCAP + sa] = dpos; ((unsigned*)(ws + WS_EDST))[(size_t)eb * BINCAP + sb] = dpos | (1u << 22); }
        }
        __syncthreads();
    }
}

constexpr int MOE_TS = pg8::STAGE_BYTES, MOE_TT = MOE_TS + 512, MOE_ES = MOE_TT + 1024, MOE_ET = MOE_ES + 256, MOE_OT = MOE_ET + 1280;
DEV int wave_excl_scan(int v, int lane, int& total) {
    int s = v;
#pragma unroll
    for (int o = 1; o < 64; o <<= 1) { const int u = __shfl_up(s, o); if (lane >= o) s += u; }
    total = __shfl(s, 63);
    return s - v;
}
DEV void moe_tiles(const Params& p, unsigned char* lds) {
    int* tstart = (int*)(lds + MOE_TS); int* tiletab = (int*)(lds + MOE_TT); int* etstart = (int*)(lds + MOE_ES); int* etiletab = (int*)(lds + MOE_ET); int* ordtab = (int*)(lds + MOE_OT);
    const int tid = threadIdx.x, lane = tid & 63, wid = tid >> 6;
    __syncthreads();
    if (wid == 0) {
        const int b0 = 2 * lane, b1 = 2 * lane + 1;
        const int c0 = b0 < NBIN ? ((const int*)(p.ws + WS_CTL))[b0] : 0, c1 = b1 < NBIN ? ((const int*)(p.ws + WS_CTL))[b1] : 0;
        const int f0 = c0 >> 8, f1 = c1 >> 8, q0 = (c0 & 255) ? 1 : 0, q1 = (c1 & 255) ? 1 : 0;
        int T, TF, TP;
        const int st = wave_excl_scan(f0 + q0 + f1 + q1, lane, T), sf = wave_excl_scan(f0 + f1, lane, TF), sp = wave_excl_scan(q0 + q1, lane, TP);
        if (b0 < NBIN) { tstart[b0] = st; for (int i = 0; i < f0 + q0; ++i) tiletab[st + i] = b0; for (int i = 0; i < f0; ++i) ordtab[sf + i] = st + i; if (q0) ordtab[TF + sp] = st + f0; }
        if (b1 < NBIN) { const int s1 = st + f0 + q0; tstart[b1] = s1; for (int i = 0; i < f1 + q1; ++i) tiletab[s1 + i] = b1; for (int i = 0; i < f1; ++i) ordtab[sf + f0 + i] = s1 + i; if (q1) ordtab[TF + sp + q0] = s1 + f1; }
        if (lane == 0) tstart[NBIN] = T;
    } else if (wid == 2) {
        const int cn = lane < 32 ? ((const int*)(p.ws + WS_CTL + 512))[lane] : 0; const int t = (cn + 255) >> 8;
        int T; const int s = wave_excl_scan(t, lane, T);
        if (lane < 32) { etstart[lane] = s; for (int i = 0; i < t; ++i) etiletab[s + i] = lane; }
        if (lane == 0) etstart[32] = T;
    }
    __syncthreads();
}
DEV void bin_experts(int bin, int& ea, int& eb) { const int gi = bin / 28; int pi = bin % 28, a = 0; while (pi >= 7 - a) { pi -= 7 - a; ++a; } ea = gi * 8 + a; eb = gi * 8 + a + 1 + pi; }
DEV void lane_rc(int i, int& R, int& C) { pg8::stage_rc((int)threadIdx.x * 16, R, C); R += 64 * i; }
struct MoeUnit { int tile, nt, bin, mt, n; };
struct PolMoe1 {
    typedef MoeUnit Unit;
    const Params& p; const int* etstart; const int* etiletab; int U, G, c;
    struct AddrA { unsigned off[2][2]; };
    struct AddrB { const char* base; };
    DEV int nk() const { return 16; }
    DEV bool next(int i, MoeUnit& u) const {
        const int L = i * G + c; if (L >= U) return false;
        u.tile = L >> 2; u.nt = L & 3;
        u.bin = __builtin_amdgcn_readfirstlane(etiletab[u.tile]);
        u.mt = u.tile - __builtin_amdgcn_readfirstlane(etstart[u.bin]);
        u.n = min(256, ((const int*)(p.ws + WS_CTL + 512))[u.bin] - u.mt * 256);
        return true;
    }
    DEV bool full(const MoeUnit& u) const { return u.n > 128; }
    DEV void addrA(const MoeUnit& u, AddrA& a) const {
        const int* list = (const int*)(p.ws + WS_EL) + (size_t)u.bin * BINCAP + u.mt * 256;
#pragma unroll
        for (int i = 0; i < 2; ++i) { int R, C; lane_rc(i, R, C);
#pragma unroll
            for (int h = 0; h < 2; ++h) { int r = h * 128 + R; if (r >= u.n) r = 0; a.off[h][i] = (unsigned)list[r] * 2048u + (unsigned)C * 2u; } }
    }
    DEV void addrB(const MoeUnit& u, AddrB& b) const { b.base = (const char*)(p.ws + WS_W13T) + ((size_t)u.bin * 1024 + u.nt * 256) * 2048; }
    DEV const char* pa(const AddrA& a, int h, int i, int kt) const { return (const char*)(p.ws + WS_R1) + a.off[h][i] + kt * 128; }
    DEV const char* pb(const AddrB& b, int h, int i, int kt) const { int R, C; lane_rc(i, R, C); return b.base + (size_t)h * (128 * 2048) + (unsigned)(R * 1024 + C) * 2u + kt * 128; }
};
struct EpiMoe1 { const Params& p; const int* tstart;
    DEV void operator()(const f32x4 (&acc)[2][2][4][2], const MoeUnit& u, int wr, int wc, int fr, int fq) const {
        const int* list = (const int*)(p.ws + WS_EL) + (size_t)u.bin * BINCAP + u.mt * 256;
        const float* wl = (const float*)(p.ws + WS_EW) + (size_t)u.bin * BINCAP + u.mt * 256;
        const unsigned* dl = (const unsigned*)(p.ws + WS_EDST) + (size_t)u.bin * BINCAP + u.mt * 256;
        const int r0 = wr * 64 + fr;
        int tk[2][4]; float ww[2][4]; unsigned dd[2][4];
#pragma unroll
        for (int ai = 0; ai < 2; ++ai)
#pragma unroll
            for (int m = 0; m < 4; ++m) { int r = r0 + ai * 128 + m * 16; if (r >= u.n) r = 0; tk[ai][m] = list[r]; ww[ai][m] = wl[r]; dd[ai][m] = dl[r]; }
        float rsv[2][4];
#pragma unroll
        for (int ai = 0; ai < 2; ++ai)
#pragma unroll
            for (int m = 0; m < 4; ++m) rsv[ai][m] = ((const float*)(p.ws + WS_RSTD2))[tk[ai][m]];
        const int f = (u.nt * 256 + 32 * wc + 8 * fq) >> 1;
#pragma unroll
        for (int ai = 0; ai < 2; ++ai)
#pragma unroll
            for (int m = 0; m < 4; ++m) { if (r0 + ai * 128 + m * 16 >= u.n) continue;
                const float rs = rsv[ai][m], w = ww[ai][m]; const unsigned d = dd[ai][m];
                bf16_t* hrow = (bf16_t*)(p.ws + WS_HBUF) + ((size_t)tstart[d & 127u] * 256 + ((d >> 7) & 32767u)) * 1024 + ((d >> 22) & 1u) * 512 + f;
#pragma unroll
                for (int bj = 0; bj < 2; ++bj) { const f32x4 v0 = acc[ai][bj][m][0] * rs, v1 = acc[ai][bj][m][1] * rs;
                    u32x2 w2; w2.x = pk2(siluf_(v0.x) * v0.y * w, siluf_(v0.z) * v0.w * w); w2.y = pk2(siluf_(v1.x) * v1.y * w, siluf_(v1.z) * v1.w * w); *(u32x2*)(hrow + 64 * bj) = w2; } }
    } };
DEV void phase_moe1(const Params& p, unsigned char* lds) {
    moe_tiles(p, lds);
    const int* etstart = (const int*)(lds + MOE_ES);
    PolMoe1 P{p, etstart, (const int*)(lds + MOE_ET), etstart[32] * 4, (int)gridDim.x, vblock()};
    EpiMoe1 E{p, (const int*)(lds + MOE_TS)};
    pg8::gemm_phase2(( PG8_LAS unsigned char*)lds, P, E);
}
struct PolMoe2 {
    typedef MoeUnit Unit;
    const Params& p; const int* tstart; const int* tiletab; const int* ordtab; int U, G, c;
    struct AddrA { const char* base; };
    struct AddrB { const char* ba; const char* bb; };
    DEV int nk() const { return 16; }
    DEV bool next(int i, MoeUnit& u) const {
        const int L = i * G + c; if (L >= U) return false;
        u.tile = __builtin_amdgcn_readfirstlane(ordtab[L >> 2]); u.nt = L & 3;
        u.bin = __builtin_amdgcn_readfirstlane(tiletab[u.tile]);
        u.mt = u.tile - __builtin_amdgcn_readfirstlane(tstart[u.bin]);
        u.n = min(256, ((const int*)(p.ws + WS_CTL))[u.bin] - u.mt * 256);
        return true;
    }
    DEV bool full(const MoeUnit& u) const { return u.n > 128; }
    DEV void addrA(const MoeUnit& u, AddrA& a) const { a.base = (const char*)(p.ws + WS_HBUF) + (size_t)u.tile * 256 * 2048; }
    DEV void addrB(const MoeUnit& u, AddrB& b) const {
        int ea, eb; bin_experts(u.bin, ea, eb);
        b.ba = (const char*)(p.ws + WS_W2T) + ((size_t)ea * 1024 + u.nt * 256) * 1024; b.bb = (const char*)(p.ws + WS_W2T) + ((size_t)eb * 1024 + u.nt * 256) * 1024;
    }
    DEV const char* pa(const AddrA& a, int h, int i, int kt) const { int R, C; lane_rc(i, R, C); return a.base + (size_t)h * (128 * 2048) + (unsigned)(R * 1024 + C) * 2u + kt * 128; }
    DEV const char* pb(const AddrB& b, int h, int i, int kt) const { int R, C; lane_rc(i, R, C); return (kt < 8 ? b.ba + kt * 128 : b.bb + (kt - 8) * 128) + (size_t)h * (128 * 1024) + (unsigned)(R * 512 + C) * 2u; }
};
struct EpiMoe2 { const Params& p;
    DEV void operator()(const f32x4 (&acc)[2][2][4][2], const MoeUnit& u, int wr, int wc, int fr, int fq) const {
        const int* list = (const int*)(p.ws + WS_BINL) + (size_t)u.bin * BINCAP + u.mt * 256;
        const int r0 = wr * 64 + fr;
        int tk[2][4];
#pragma unroll
        for (int ai = 0; ai < 2; ++ai)
#pragma unroll
            for (int m = 0; m < 4; ++m) { int r = r0 + ai * 128 + m * 16; if (r >= u.n) r = 0; tk[ai][m] = list[r]; }
        const int c0 = u.nt * 256 + 32 * wc + 4 * fq;
#pragma unroll
        for (int ai = 0; ai < 2; ++ai)
#pragma unroll
            for (int m = 0; m < 4; ++m) { if (r0 + ai * 128 + m * 16 >= u.n) continue;
                float* o = p.out + (size_t)tk[ai][m] * DM + c0;
                const f32x4 h0 = *(const f32x4*)(o), h1 = *(const f32x4*)(o + 16), h2 = *(const f32x4*)(o + 128), h3 = *(const f32x4*)(o + 144);
                *(f32x4*)(o) = h0 + acc[ai][0][m][0]; *(f32x4*)(o + 16) = h1 + acc[ai][0][m][1]; *(f32x4*)(o + 128) = h2 + acc[ai][1][m][0]; *(f32x4*)(o + 144) = h3 + acc[ai][1][m][1]; }
    } };
DEV void phase_moe2(const Params& p, unsigned char* lds) {
    moe_tiles(p, lds);
    const int* tstart = (const int*)(lds + MOE_TS);
    PolMoe2 P{p, tstart, (const int*)(lds + MOE_TT), (const int*)(lds + MOE_OT), tstart[NBIN] * 4, (int)gridDim.x, vblock()};
    EpiMoe2 E{p};
    pg8::gemm_phase2((PG8_LAS unsigned char*)lds, P, E);
}

#define XB_TMO      128
#define XB_XCNT(j)  (256  + 64 * (j))
#define XB_XSUB(j)  (1280 + 64 * (j))
#define XB_XGEN(j)  (2304 + 64 * (j))
#define XB_TOP      3328
#define XB_TOPGEN   3392
#define XCD_BAR_WORDS 3456
#define XB_SPIN_CAP (1u << 20)
#define LAS __attribute__((address_space(3)))
constexpr size_t WS_BAR = WS_CTL + 4096;
DEV unsigned xb_ld(unsigned* p) { return __hip_atomic_load(p, __ATOMIC_RELAXED, __HIP_MEMORY_SCOPE_AGENT); }
DEV unsigned xb_add(unsigned* p, unsigned v) { return __hip_atomic_fetch_add(p, v, __ATOMIC_RELAXED, __HIP_MEMORY_SCOPE_AGENT); }
DEV unsigned xb_xcc_id() { return (unsigned)__builtin_amdgcn_s_getreg((3 << 11) | 20) & 0xFu; }
#define XB_SPIN(cond, bar) do { unsigned _sp = 0; while (cond) { __builtin_amdgcn_s_sleep(1); \
    if ((++_sp & 255u) == 0u) { if (xb_ld(&(bar)[XB_TMO])) break; if (_sp > XB_SPIN_CAP) { atomicAdd(&(bar)[XB_TMO], 1u); break; } } } } while (0)
struct XcdBarrier { unsigned* bar; unsigned x; volatile LAS unsigned* st; };
DEV XcdBarrier xcd_barrier_post(unsigned* bar, volatile LAS unsigned* st) {
    XcdBarrier b; b.bar = bar; b.x = xb_xcc_id(); b.st = st;
    if (threadIdx.x == 0) (void)xb_add(&bar[XB_XCNT(b.x)], 1u);
    return b;
}
DEV void xcd_barrier_complete(unsigned* bar, unsigned x, unsigned& nloc, unsigned& nx) {
    const unsigned G = gridDim.x * gridDim.y * gridDim.z;
    unsigned sum, cnt, mine, sp = 0u;
    for (;;) {
        sum = 0u; cnt = 0u; mine = 0u;
#pragma unroll
        for (unsigned j = 0; j < 16; ++j) { const unsigned c = xb_ld(&bar[XB_XCNT(j)]); sum += c; cnt += (c > 0u) ? 1u : 0u; mine = (j == x) ? c : mine; }
        if (sum == G) break;
        __builtin_amdgcn_s_sleep(1);
        if ((++sp & 255u) == 0u) { if (xb_ld(&bar[XB_TMO])) break; if (sp > XB_SPIN_CAP) { atomicAdd(&bar[XB_TMO], 1u); break; } }
    }
    nloc = mine > 0u ? mine : 1u; nx = cnt > 0u ? cnt : 1u;
}
DEV void xcd_barrier(const XcdBarrier& b) {
    asm volatile("s_waitcnt vmcnt(0)" ::: "memory");
    __syncthreads();
    if (threadIdx.x == 0) {
        unsigned* bar = b.bar;
        __builtin_amdgcn_s_waitcnt(0);
        unsigned nloc = b.st[0], nx = b.st[1];
        if (nloc == 0u) { xcd_barrier_complete(bar, b.x, nloc, nx); b.st[0] = nloc; b.st[1] = nx; }
        const unsigned old = xb_add(&bar[XB_XSUB(b.x)], 1u);
        const unsigned gen = old / nloc;
        if (old + 1u == (gen + 1u) * nloc) {
            __builtin_amdgcn_fence(__ATOMIC_RELEASE, "agent");
            asm volatile("s_waitcnt vmcnt(0)" ::: "memory");
            const unsigned og = xb_add(&bar[XB_TOP], 1u);
            const unsigned tg = og / nx;
            if (og + 1u == (tg + 1u) * nx) xb_add(&bar[XB_TOPGEN], 1u);
            else XB_SPIN(xb_ld(&bar[XB_TOPGEN]) == tg, bar);
            __builtin_amdgcn_fence(__ATOMIC_ACQUIRE, "agent");
            xb_add(&bar[XB_XGEN(b.x)], 1u);
            asm volatile("s_waitcnt vmcnt(0)" ::: "memory");
        } else {
            XB_SPIN(xb_ld(&bar[XB_XGEN(b.x)]) == gen, bar);
            __builtin_amdgcn_fence(__ATOMIC_ACQUIRE, "agent");
            asm volatile("s_waitcnt vmcnt(0)" ::: "memory");
        }
    }
    __syncthreads();
}

constexpr int LDS_BYTES = 144 * 1024;
constexpr int N_PHASES = 9;
__global__ void __launch_bounds__(NT) mega(Params p, int lo, int hi) {
    extern __shared__ __attribute__((aligned(16))) unsigned char lds[];
    volatile LAS unsigned* xst = (volatile LAS unsigned*)(lds + LDS_BYTES - 16);
    if (threadIdx.x < 4) xst[threadIdx.x] = 0u;
    __syncthreads();
    XcdBarrier xbar; xbar.bar = (unsigned*)(p.ws + WS_BAR); xbar.x = 0; xbar.st = xst;
    if (hi - lo > 1) xbar = xcd_barrier_post((unsigned*)(p.ws + WS_BAR), xst);
#define GRID_SYNC() xcd_barrier(xbar)
#ifndef PROBE_REPEAT
#define PROBE_REPEAT -1
#endif
#define RUN_PHASE(k, call) do { if (lo <= (k) && (k) < hi) { call; \
        if ((k) == PROBE_REPEAT) { GRID_SYNC(); \
            if ((k) == 5) { float* rz = (float*)(p.ws + WS_ROWSS); for (int i = blockIdx.x * NT + threadIdx.x; i < NTOK; i += gridDim.x * NT) rz[i] = 0.f; GRID_SYNC(); } \
            if ((k) == 7) { if (blockIdx.x == 0 && threadIdx.x < 128) ((int*)(p.ws + WS_CTL))[threadIdx.x] = 0; GRID_SYNC(); } \
            call; } \
        if ((k) + 1 < hi) GRID_SYNC(); } } while (0)
    RUN_PHASE(0, phase_prologue(p, lds));
    RUN_PHASE(1, phase_inproj(p, lds));
    RUN_PHASE(2, { phase_cmp_a(p, lds); const int G_ = (int)gridDim.x; if (G_ > 128) phase_hgrn_a1(p, lds, 64, G_ - 64); else phase_hgrn_a1(p, lds, 0, G_); });
    RUN_PHASE(3, { phase_cmp_b(p, lds); phase_hgrn_a2(p, lds); });
    RUN_PHASE(4, { phase_cmp_attn(p, lds); phase_hgrn_a3(p, lds); });
    RUN_PHASE(5, phase_flash(p, lds));
    RUN_PHASE(6, phase_outproj(p, lds));
    RUN_PHASE(7, phase_router(p, lds));
    RUN_PHASE(8, phase_moe1(p, lds));
    RUN_PHASE(9, phase_moe2(p, lds));
#undef RUN_PHASE
}

extern "C" void kernel_launch(void* const* d_in, const int* in_sizes, int n_in, void* d_out, int out_size, void* d_ws, size_t ws_size, hipStream_t stream) {
    static int grid = 0;
    if (grid == 0) {
        int dev = 0, cus = 0, per_cu = 0;
        hipGetDevice(&dev);
        hipDeviceGetAttribute(&cus, hipDeviceAttributeMultiprocessorCount, dev);
        hipFuncSetAttribute((const void*)mega, hipFuncAttributeMaxDynamicSharedMemorySize, LDS_BYTES);
        hipOccupancyMaxActiveBlocksPerMultiprocessor(&per_cu, (const void*)mega, NT, LDS_BYTES);
        if (per_cu < 1) per_cu = 1;
        grid = cus;
        if (ws_size < WS_END) fprintf(stderr, "kernel_launch: workspace too small: %zu < %zu\n", ws_size, (size_t)WS_END);
        fprintf(stderr, "kernel_launch: cus %d per_cu %d grid %d ws %zu\n", cus, per_cu, grid, ws_size);
    }
    Params p{};
    const float** pp = (const float**)&p;
    for (int i = 0; i < 23; ++i) pp[i] = (const float*)d_in[i];
    p.out = (float*)d_out; p.ws = (unsigned char*)d_ws;
#if N_LAUNCH_MODE == 1
    (void)hipMemsetAsync((unsigned char*)d_ws + WS_BAR, 0, XCD_BAR_WORDS * 4, stream);
    int lo = 0, hi = N_PHASES + 1;
    void* args[] = {&p, &lo, &hi};
    hipError_t e = hipLaunchCooperativeKernel((const void*)mega, dim3(grid), dim3(NT), args, LDS_BYTES, stream);
    if (e != hipSuccess) fprintf(stderr, "cooperative launch failed: %s\n", hipGetErrorString(e));
#else
    for (int ph = 0; ph <= N_PHASES; ++ph) hipLaunchKernelGGL(mega, dim3(grid), dim3(NT), LDS_BYTES, stream, p, ph, ph + 1);
#endif
}
```

```cpp
#include <hip/hip_runtime.h>
#include <hip/hip_cooperative_groups.h>
#include <cstdio>
#include <cstdint>
#include <cstring>
namespace cg = cooperative_groups;

#ifndef N_LAUNCH_MODE
#define N_LAUNCH_MODE 1
#endif

#define DEV __device__ __forceinline__
typedef unsigned short bf16_t;
typedef short bf16x8 __attribute__((ext_vector_type(8)));
typedef float f32x4 __attribute__((ext_vector_type(4)));
typedef float f32x2 __attribute__((ext_vector_type(2)));
typedef float f32x16 __attribute__((ext_vector_type(16)));
typedef unsigned u32x4 __attribute__((ext_vector_type(4)));
typedef unsigned u32x2 __attribute__((ext_vector_type(2)));

constexpr int NT = 512;
constexpr int BATCH = 8, SEQ = 4096, DM = 1024, NTOK = BATCH * SEQ;
constexpr int IN_COLS = 3352, INP = 3584;
constexpr int NC = 255;
constexpr float RMS_EPS = 1e-6f;
constexpr float QSCALE = 0.125f * 1.4426950408889634f;
constexpr int NBIN = 112;
constexpr int BINCAP = NTOK;

constexpr size_t MiB = 1ull << 20;
constexpr size_t WS_CTL    = 0;
constexpr size_t WS_RSTD1  = 1 * MiB;
constexpr size_t WS_RSTD2  = WS_RSTD1 + 128 * 1024;
constexpr size_t WS_ROWSS  = WS_RSTD2 + 128 * 1024;
constexpr size_t WS_TOKW   = WS_ROWSS + 128 * 1024;
constexpr size_t WS_LB     = WS_TOKW + 256 * 1024;
constexpr size_t WS_CBIAS  = WS_LB + 4096;
constexpr size_t WS_SELM   = 2 * MiB;
constexpr size_t WS_GATES  = 3 * MiB;
constexpr size_t WS_KCMP   = 6 * MiB;
constexpr size_t WS_VCMP   = WS_KCMP + 512 * 1024;
constexpr size_t WS_CW2T   = 7 * MiB;
constexpr size_t WS_RW     = 7 * MiB + 128 * 1024;
constexpr size_t WS_HID    = 8 * MiB;
constexpr size_t WS_CW1T   = 12 * MiB;
constexpr size_t WS_WOUTT  = 14 * MiB;
constexpr size_t WS_WINT   = 16 * MiB;
constexpr size_t WS_R1     = 24 * MiB;
constexpr size_t WS_Q      = 88 * MiB;
constexpr size_t WS_KC     = 120 * MiB;
constexpr size_t WS_VC     = 128 * MiB;
constexpr size_t WS_KS     = 136 * MiB;
constexpr size_t WS_KW     = 144 * MiB;
constexpr size_t WS_VST    = 152 * MiB;
constexpr size_t WS_VWT    = 160 * MiB;
constexpr size_t WS_OC     = 168 * MiB;
constexpr size_t WS_W13T   = 200 * MiB;
constexpr size_t WS_W2T    = 264 * MiB;
constexpr size_t WS_HQ     = 296 * MiB;
constexpr size_t WS_HV     = 328 * MiB;
constexpr size_t WS_HG     = 360 * MiB;
constexpr size_t WS_HLOGF  = 392 * MiB;
constexpr size_t WS_XB     = 424 * MiB;
constexpr size_t WS_DBUF   = 488 * MiB;
constexpr size_t WS_END    = 489 * MiB;
constexpr size_t WS_UBUF   = WS_W13T;
constexpr size_t WS_BINL   = WS_HQ;
constexpr size_t WS_HBUF   = WS_HQ + 16 * MiB;
constexpr size_t WS_EL     = WS_HQ + 136 * MiB;
constexpr size_t WS_EW     = WS_HQ + 140 * MiB;
constexpr size_t WS_EDST   = WS_HQ + 144 * MiB;

struct Params {
    const float *x, *attn_g, *ffn_g, *w_in, *w_out, *g_q, *g_k, *pos_k, *pos_v, *wk1, *wk2, *wv1, *wv2, *g_nsa, *lb_logits, *g_hn,
        *w_group, *b_group, *w_expert, *b_expert, *w1, *w3, *w2;
    float* out;
    unsigned char* ws;
};

typedef __bf16 bf16x2_t __attribute__((ext_vector_type(2)));
DEV unsigned pk2(float lo, float hi) { f32x2 f = {lo, hi}; return __builtin_bit_cast(unsigned, __builtin_convertvector(f, bf16x2_t)); }
DEV bf16_t f2bf(float f) { return (bf16_t)(pk2(f, 0.f) & 0xffffu); }
DEV float bf2f(bf16_t b) { return __uint_as_float(((unsigned)b) << 16); }
DEV float bflo(unsigned u) { return __uint_as_float(u << 16); }
DEV float bfhi(unsigned u) { return __uint_as_float(u & 0xffff0000u); }
DEV float sigmoidf_(float v) { return __builtin_amdgcn_rcpf(1.f + __builtin_amdgcn_exp2f(-1.4426950408889634f * v)); }
DEV float siluf_(float v) { return v * __builtin_amdgcn_rcpf(1.f + __builtin_amdgcn_exp2f(-1.4426950408889634f * v)); }
DEV float wave_sum(float v) {
#pragma unroll
    for (int o = 1; o < 64; o <<= 1) v += __shfl_xor(v, o);
    return v;
}
DEV float wave_max(float v) {
#pragma unroll
    for (int o = 1; o < 64; o <<= 1) v = fmaxf(v, __shfl_xor(v, o));
    return v;
}
DEV int vblock() { const int G = gridDim.x, b = blockIdx.x; return (G % 8 == 0) ? (b % 8) * (G / 8) + b / 8 : b; }

namespace pg8 {
#define PG8_LAS __attribute__((address_space(3)))
constexpr int BM = 256, BK = 64, HALF = 128, HTB = HALF * BK * 2, STAGE_BYTES = 8 * HTB, NXCD = 8, WGM = 1;
__host__ __device__ __forceinline__ int lds_byte(int r, int c) { const int st = (r >> 4) * 2 + (c >> 5), rr = r & 15, cc = c & 31, ob = rr * 64 + cc * 2; return st * 1024 + (ob ^ (((ob >> 9) & 1) << 5)); }
__host__ __device__ __forceinline__ void stage_rc(int b, int& R, int& C) { const int st = b / 1024, sb = b % 1024, swz = sb ^ (((sb >> 9) & 1) << 5); R = (st >> 1) * 16 + swz / 64; C = (st & 1) * 32 + (swz % 64) / 2; }
struct Unit { int pm, pn; };
struct Gemm { const bf16_t* A; const bf16_t* Bt; int M, N, K; };
struct StaticOrder {
    int nM, nN, nwg, G, c;
    __host__ __device__ void init(int M, int N, int G_, int c_) { nM = M / BM; nN = N / BM; nwg = nM * nN; G = G_; c = c_; }
    __host__ __device__ bool next(int i, Unit& u) const {
        const long L = (long)i * G + c; if (L >= nwg) return false;
        int wgid = (int)L; { const int q = nwg / NXCD, r = nwg % NXCD, xcd = wgid % NXCD, off = wgid / NXCD; wgid = (xcd < r ? xcd * (q + 1) : r * (q + 1) + (xcd - r) * q) + off; }
        const int nig = WGM * nN, gid = wgid / nig, fm = gid * WGM, gsz = (nM - fm) < WGM ? (nM - fm) : WGM;
        u.pm = fm + ((wgid % nig) % gsz); u.pn = (wgid % nig) / gsz; return true;
    }
};
template <class Epi, class Sched>
__device__ __forceinline__ void gemm_phase(PG8_LAS unsigned char* lds, const Gemm g, const Sched& S, const Epi& E) {
    const int tid = threadIdx.x, wid = __builtin_amdgcn_readfirstlane(tid >> 6), lane = tid & 63, wr = wid >> 2, wc = wid & 3, fr = lane & 15, fq = lane >> 4;
    const int K = g.K, nt = K / BK;
    unsigned voffA[2];
#pragma unroll
    for (int i = 0; i < 2; ++i) { int R, C; stage_rc(tid * 16 + i * 8192, R, C); voffA[i] = (unsigned)(R * K + C) * 2u; }
    const size_t kstep = (size_t)(BK * 2);
    const size_t hstep = (size_t)HALF * K * 2;
    const size_t tstep = 2 * hstep;
    const unsigned ldsw = (unsigned)wid * 1024u;
    const int aoff = lds_byte(wr * 64 + fr, fq * 8), boff = lds_byte(wc * 32 + fr, fq * 8);
#define PG8_SA(b, h) (((b) * 2 + (h)) * HTB)
#define PG8_SB(b, h) ((4 + (b) * 2 + (h)) * HTB)
#define PG8_STAGE(bufoff, gbase, voff) do { _Pragma("unroll") for (int _i = 0; _i < 2; ++_i) \
        __builtin_amdgcn_global_load_lds((const unsigned*)((const char*)(gbase) + (voff)[_i]), (PG8_LAS unsigned*)(lds + (bufoff) + ldsw + _i * 8192), 16, 0, 0); } while (0)
#define PG8_LDA(dst, b, h) do { _Pragma("unroll") for (int m = 0; m < 4; ++m) _Pragma("unroll") for (int k = 0; k < 2; ++k) dst[m][k] = *(const PG8_LAS bf16x8*)(lds + PG8_SA(b, h) + aoff + m * 2048 + k * 1024); } while (0)
#define PG8_LDB(dst, b, h) do { _Pragma("unroll") for (int n = 0; n < 2; ++n) _Pragma("unroll") for (int k = 0; k < 2; ++k) dst[n][k] = *(const PG8_LAS bf16x8*)(lds + PG8_SB(b, h) + boff + n * 2048 + k * 1024); } while (0)
#define PG8_MMA(ai, bj, At, Bt) do { __builtin_amdgcn_s_setprio(1); _Pragma("unroll") for (int m = 0; m < 4; ++m) _Pragma("unroll") for (int n = 0; n < 2; ++n) _Pragma("unroll") for (int k = 0; k < 2; ++k) \
        acc[ai][bj][m][n] = __builtin_amdgcn_mfma_f32_16x16x32_bf16(Bt[n][k], At[m][k], acc[ai][bj][m][n], 0, 0, 0); __builtin_amdgcn_s_setprio(0); } while (0)
#define PG8_WAIT_V(n) asm volatile("s_waitcnt vmcnt(" #n ")" ::: "memory")
#define PG8_WAIT_L(n) asm volatile("s_waitcnt lgkmcnt(" #n ")" ::: "memory")
#define PG8_BAR __builtin_amdgcn_s_barrier()
#define PG8_SCHED __builtin_amdgcn_sched_barrier(0)
    Unit cur, nxt; int ui = 0;
    if (!S.next(0, cur)) return;
    f32x4 acc[2][2][4][2];
#pragma unroll
    for (int a = 0; a < 2; ++a)
#pragma unroll
        for (int b = 0; b < 2; ++b)
#pragma unroll
            for (int m = 0; m < 4; ++m)
#pragma unroll
                for (int n = 0; n < 2; ++n) acc[a][b][m][n] = (f32x4){0.f, 0.f, 0.f, 0.f};
    bf16x8 At[4][2], B0[2][2], B1[2][2];
    const char* cA = (const char*)g.A + (size_t)cur.pm * tstep; const char* cB = (const char*)g.Bt + (size_t)cur.pn * tstep;
    PG8_STAGE(PG8_SB(0, 0), cB, voffA); PG8_STAGE(PG8_SA(0, 0), cA, voffA); PG8_STAGE(PG8_SB(0, 1), cB + hstep, voffA); PG8_STAGE(PG8_SA(0, 1), cA + hstep, voffA);
    if (wr == 1) PG8_BAR;
    PG8_WAIT_V(4); PG8_BAR;
    PG8_STAGE(PG8_SB(1, 0), cB + kstep, voffA); PG8_STAGE(PG8_SA(1, 0), cA + kstep, voffA); PG8_STAGE(PG8_SB(1, 1), cB + hstep + kstep, voffA);
    PG8_WAIT_V(6); PG8_BAR;
    for (;;) {
        const bool has_next = S.next(ui + 1, nxt);
        const char* nA = has_next ? (const char*)g.A + (size_t)nxt.pm * tstep : cA; const char* nB = has_next ? (const char*)g.Bt + (size_t)nxt.pn * tstep : cB;
        float midrs[2][4];
        if constexpr (Epi::MIDSCALE) {
#pragma unroll
            for (int a = 0; a < 2; ++a)
#pragma unroll
                for (int m = 0; m < 4; ++m) midrs[a][m] = E.rowscale(cur.pm * BM + a * HALF + wr * 64 + m * 16 + fr); }
        for (int t = 0; t < nt; t += 2) {
            const bool last = (t == nt - 2);
            if constexpr (Epi::MIDSCALE) { if (t == E.midk()) {
#pragma unroll
                for (int a = 0; a < 2; ++a)
#pragma unroll
                    for (int b = 0; b < 2; ++b)
#pragma unroll
                        for (int m = 0; m < 4; ++m)
#pragma unroll
                            for (int n = 0; n < 2; ++n) acc[a][b][m][n] = acc[a][b][m][n] * midrs[a][m]; } }
            const char* a1 = cA + (size_t)(t + 1) * kstep;
            const char* a2 = last ? nA : cA + (size_t)(t + 2) * kstep; const char* b2 = last ? nB : cB + (size_t)(t + 2) * kstep;
            const char* a3 = a2 + kstep; const char* b3 = b2 + kstep;
            PG8_LDB(B0, 0, 0); PG8_SCHED; PG8_LDA(At, 0, 0); PG8_STAGE(PG8_SA(1, 1), a1 + hstep, voffA);
            PG8_WAIT_L(8); PG8_BAR; PG8_WAIT_L(0); PG8_MMA(0, 0, At, B0); PG8_BAR; PG8_SCHED;
            PG8_LDB(B1, 0, 1); PG8_STAGE(PG8_SB(0, 0), b2, voffA);
            PG8_BAR; PG8_WAIT_L(0); PG8_MMA(0, 1, At, B1); PG8_BAR;
            PG8_LDA(At, 0, 1); PG8_STAGE(PG8_SA(0, 0), a2, voffA);
            PG8_BAR; PG8_WAIT_L(0); PG8_MMA(1, 0, At, B0); PG8_BAR; PG8_SCHED;
            PG8_STAGE(PG8_SB(0, 1), b2 + hstep, voffA);
            PG8_WAIT_V(6); PG8_BAR; PG8_MMA(1, 1, At, B1); PG8_BAR;
            PG8_LDB(B0, 1, 0); PG8_SCHED; PG8_LDA(At, 1, 0); PG8_STAGE(PG8_SA(0, 1), a2 + hstep, voffA);
            PG8_WAIT_L(8); PG8_BAR; PG8_WAIT_L(0); PG8_MMA(0, 0, At, B0); PG8_BAR; PG8_SCHED;
            PG8_LDB(B1, 1, 1); PG8_STAGE(PG8_SB(1, 0), b3, voffA);
            PG8_BAR; PG8_WAIT_L(0); PG8_MMA(0, 1, At, B1); PG8_BAR;
            PG8_LDA(At, 1, 1); PG8_STAGE(PG8_SA(1, 0), a3, voffA);
            PG8_BAR; PG8_WAIT_L(0); PG8_MMA(1, 0, At, B0); PG8_BAR; PG8_SCHED;
            PG8_STAGE(PG8_SB(1, 1), b3 + hstep, voffA);
            PG8_WAIT_V(6); PG8_BAR; PG8_MMA(1, 1, At, B1); PG8_BAR;
        }
        E(acc, cur, wr, wc, fr, fq);
        if (!has_next) break;
#pragma unroll
        for (int a = 0; a < 2; ++a)
#pragma unroll
            for (int b = 0; b < 2; ++b)
#pragma unroll
                for (int m = 0; m < 4; ++m)
#pragma unroll
                    for (int n = 0; n < 2; ++n) acc[a][b][m][n] = (f32x4){0.f, 0.f, 0.f, 0.f};
        cur = nxt; cA = nA; cB = nB; ++ui;
    }
    PG8_WAIT_V(0);
    if (wr == 0) PG8_BAR;
    PG8_BAR;
#undef PG8_SA
#undef PG8_SB
#undef PG8_STAGE
#undef PG8_LDA
#undef PG8_LDB
#undef PG8_MMA
#undef PG8_WAIT_V
#undef PG8_WAIT_L
#undef PG8_BAR
#undef PG8_SCHED
}
template <class Pol, class Epi>
__device__ __forceinline__ void gemm_phase2(PG8_LAS unsigned char* lds, const Pol& P, const Epi& E) {
    const int tid = threadIdx.x, wid = __builtin_amdgcn_readfirstlane(tid >> 6), lane = tid & 63, wr = wid >> 2, wc = wid & 3, fr = lane & 15, fq = lane >> 4;
    const int nt = P.nk();
    const unsigned ldsw = (unsigned)wid * 1024u;
    const int aoff = lds_byte(wr * 64 + fr, fq * 8), boff = lds_byte(wc * 32 + fr, fq * 8);
#define PG8_SA(b, h) (((b) * 2 + (h)) * HTB)
#define PG8_SB(b, h) ((4 + (b) * 2 + (h)) * HTB)
#define PG8_STAGE_A(bufoff, AS, h, kt) do { _Pragma("unroll") for (int _i = 0; _i < 2; ++_i) \
        __builtin_amdgcn_global_load_lds((const unsigned*)P.pa(AS, h, _i, kt), (PG8_LAS unsigned*)(lds + (bufoff) + ldsw + _i * 8192), 16, 0, 0); } while (0)
#define PG8_STAGE_B(bufoff, BS, h, kt) do { _Pragma("unroll") for (int _i = 0; _i < 2; ++_i) \
        __builtin_amdgcn_global_load_lds((const unsigned*)P.pb(BS, h, _i, kt), (PG8_LAS unsigned*)(lds + (bufoff) + ldsw + _i * 8192), 16, 0, 0); } while (0)
#define PG8_LDA(dst, b, h) do { _Pragma("unroll") for (int m = 0; m < 4; ++m) _Pragma("unroll") for (int k = 0; k < 2; ++k) dst[m][k] = *(const PG8_LAS bf16x8*)(lds + PG8_SA(b, h) + aoff + m * 2048 + k * 1024); } while (0)
#define PG8_LDB(dst, b, h) do { _Pragma("unroll") for (int n = 0; n < 2; ++n) _Pragma("unroll") for (int k = 0; k < 2; ++k) dst[n][k] = *(const PG8_LAS bf16x8*)(lds + PG8_SB(b, h) + boff + n * 2048 + k * 1024); } while (0)
#define PG8_MMA(ai, bj, At, Bt) do { __builtin_amdgcn_s_setprio(1); _Pragma("unroll") for (int m = 0; m < 4; ++m) _Pragma("unroll") for (int n = 0; n < 2; ++n) _Pragma("unroll") for (int k = 0; k < 2; ++k) \
        acc[ai][bj][m][n] = __builtin_amdgcn_mfma_f32_16x16x32_bf16(Bt[n][k], At[m][k], acc[ai][bj][m][n], 0, 0, 0); __builtin_amdgcn_s_setprio(0); } while (0)
#define PG8_STAGE_A2(bufoff, h, kt) do { _Pragma("unroll") for (int _i = 0; _i < 2; ++_i) \
        __builtin_amdgcn_global_load_lds((const unsigned*)P.pa(a2, h, _i, kt), (PG8_LAS unsigned*)(lds + (bufoff) + ldsw + _i * 8192), 16, 0, 0); } while (0)
#define PG8_STAGE_B2(bufoff, h, kt) do { _Pragma("unroll") for (int _i = 0; _i < 2; ++_i) \
        __builtin_amdgcn_global_load_lds((const unsigned*)P.pb(b2, h, _i, kt), (PG8_LAS unsigned*)(lds + (bufoff) + ldsw + _i * 8192), 16, 0, 0); } while (0)
#define PG8_WAIT_V(n) asm volatile("s_waitcnt vmcnt(" #n ")" ::: "memory")
#define PG8_WAIT_L(n) asm volatile("s_waitcnt lgkmcnt(" #n ")" ::: "memory")
#define PG8_BAR __builtin_amdgcn_s_barrier()
#define PG8_SCHED __builtin_amdgcn_sched_barrier(0)
    typename Pol::Unit cur, nxt; int ui = 0;
    if (!P.next(0, cur)) return;
    f32x4 acc[2][2][4][2];
#pragma unroll
    for (int a = 0; a < 2; ++a)
#pragma unroll
        for (int b = 0; b < 2; ++b)
#pragma unroll
            for (int m = 0; m < 4; ++m)
#pragma unroll
                for (int n = 0; n < 2; ++n) acc[a][b][m][n] = (f32x4){0.f, 0.f, 0.f, 0.f};
    bf16x8 At[4][2], B0[2][2], B1[2][2];
    typename Pol::AddrA aC, aN; typename Pol::AddrB bC, bN;
    P.addrA(cur, aC); P.addrB(cur, bC);
    PG8_STAGE_B(PG8_SB(0, 0), bC, 0, 0); PG8_STAGE_A(PG8_SA(0, 0), aC, 0, 0); PG8_STAGE_B(PG8_SB(0, 1), bC, 1, 0); PG8_STAGE_A(PG8_SA(0, 1), aC, 1, 0);
    if (wr == 1) PG8_BAR;
    PG8_WAIT_V(4); PG8_BAR;
    PG8_STAGE_B(PG8_SB(1, 0), bC, 0, 1); PG8_STAGE_A(PG8_SA(1, 0), aC, 0, 1); PG8_STAGE_B(PG8_SB(1, 1), bC, 1, 1);
    PG8_WAIT_V(6); PG8_BAR;
    for (;;) {
        const bool has_next = P.next(ui + 1, nxt);
        if (has_next) { P.addrA(nxt, aN); P.addrB(nxt, bN); } else { aN = aC; bN = bC; }
        const bool full = P.full(cur);
        for (int t = 0; t < nt; t += 2) {
            const bool last = (t == nt - 2);
            const typename Pol::AddrA a2 = last ? aN : aC; const typename Pol::AddrB b2 = last ? bN : bC;
            const int k2 = last ? 0 : t + 2, k3 = k2 + 1;
            PG8_LDB(B0, 0, 0); PG8_SCHED; PG8_LDA(At, 0, 0); PG8_STAGE_A(PG8_SA(1, 1), aC, 1, t + 1);
            PG8_WAIT_L(8); PG8_BAR; PG8_WAIT_L(0); PG8_MMA(0, 0, At, B0); PG8_BAR; PG8_SCHED;
            PG8_LDB(B1, 0, 1); PG8_STAGE_B2(PG8_SB(0, 0), 0, k2);
            PG8_BAR; PG8_WAIT_L(0); PG8_MMA(0, 1, At, B1); PG8_BAR;
            PG8_LDA(At, 0, 1); PG8_STAGE_A2(PG8_SA(0, 0), 0, k2);
            PG8_BAR; PG8_WAIT_L(0); if (full) PG8_MMA(1, 0, At, B0); PG8_BAR; PG8_SCHED;
            PG8_STAGE_B2(PG8_SB(0, 1), 1, k2);
            PG8_WAIT_V(6); PG8_BAR; if (full) PG8_MMA(1, 1, At, B1); PG8_BAR;
            PG8_LDB(B0, 1, 0); PG8_SCHED; PG8_LDA(At, 1, 0); PG8_STAGE_A2(PG8_SA(0, 1), 1, k2);
            PG8_WAIT_L(8); PG8_BAR; PG8_WAIT_L(0); PG8_MMA(0, 0, At, B0); PG8_BAR; PG8_SCHED;
            PG8_LDB(B1, 1, 1); PG8_STAGE_B2(PG8_SB(1, 0), 0, k3);
            PG8_BAR; PG8_WAIT_L(0); PG8_MMA(0, 1, At, B1); PG8_BAR;
            PG8_LDA(At, 1, 1); PG8_STAGE_A2(PG8_SA(1, 0), 0, k3);
            PG8_BAR; PG8_WAIT_L(0); if (full) PG8_MMA(1, 0, At, B0); PG8_BAR; PG8_SCHED;
            PG8_STAGE_B2(PG8_SB(1, 1), 1, k3);
            PG8_WAIT_V(6); PG8_BAR; if (full) PG8_MMA(1, 1, At, B1); PG8_BAR;
        }
        E(acc, cur, wr, wc, fr, fq);
        if (!has_next) break;
#pragma unroll
        for (int a = 0; a < 2; ++a)
#pragma unroll
            for (int b = 0; b < 2; ++b)
#pragma unroll
                for (int m = 0; m < 4; ++m)
#pragma unroll
                    for (int n = 0; n < 2; ++n) acc[a][b][m][n] = (f32x4){0.f, 0.f, 0.f, 0.f};
        cur = nxt; aC = aN; bC = bN; ++ui;
    }
    PG8_WAIT_V(0);
    if (wr == 0) PG8_BAR;
    PG8_BAR;
#undef PG8_SA
#undef PG8_SB
#undef PG8_STAGE_A
#undef PG8_STAGE_B
#undef PG8_STAGE_A2
#undef PG8_STAGE_B2
#undef PG8_LDA
#undef PG8_LDB
#undef PG8_MMA
#undef PG8_WAIT_V
#undef PG8_WAIT_L
#undef PG8_BAR
#undef PG8_SCHED
}
__host__ __device__ __forceinline__ int perm_lo(int x) { return (((x >> 2) & 3) << 3) | (((x >> 4) & 1) << 2) | (x & 3); }
__host__ __device__ __forceinline__ int inv_perm_lo(int y) { return (((y >> 2) & 1) << 4) | (((y >> 3) & 3) << 2) | (y & 3); }
__host__ __device__ __forceinline__ int logcol(int p) { return (p & ~255) + 64 * ((p >> 5) & 3) + 32 * ((p >> 7) & 1) + perm_lo(p & 31); }
}

template <class SRC>
DEV void convert_tile(float* tl, const SRC& src, bf16_t* dst, int ldd, int n0, int k0) {
    const int tid = threadIdx.x;
    {
        const int n = tid & 63;
#pragma unroll
        for (int i = 0; i < 8; ++i) { const int kk = (tid >> 6) + 8 * i; tl[kk * 65 + n] = src.get(n0 + n, k0 + kk); }
    }
    __syncthreads();
    {
        const int n = tid >> 3, kc = tid & 7;
        const float* s = tl + (kc * 8) * 65 + n;
        u32x4 o;
        o.x = pk2(s[0 * 65], s[1 * 65]); o.y = pk2(s[2 * 65], s[3 * 65]); o.z = pk2(s[4 * 65], s[5 * 65]); o.w = pk2(s[6 * 65], s[7 * 65]);
        *(u32x4*)(dst + (size_t)(n0 + n) * ldd + k0 + kc * 8) = o;
    }
    __syncthreads();
}
struct SrcWin { const float* w; const float* g;
    DEV float get(int np, int k) const { const int n = pg8::logcol(np); int col; if (n < 1280) col = n; else if (n < 3328) col = n + 24; else if (n < 3352) col = 1280 + (n - 3328); else return 0.f;
        return w[(size_t)k * IN_COLS + col] * g[k]; } };
struct SrcWout { const float* w; const float* g;
    DEV float get(int np, int k) const { const int n = pg8::logcol(np); const float v = w[(size_t)k * DM + n]; return k < 512 ? v * g[k] : v; } };
struct SrcPlain { const float* w; int ld;
    DEV float get(int n, int k) const { return w[(size_t)k * ld + n]; } };
struct SrcW13 { const float* w1; const float* w3; const float* g;
    DEV float get(int n, int k) const { const uintptr_t a = (uintptr_t)w1, b = (uintptr_t)w3; const float* w = (const float*)(a + ((b - a) & (uintptr_t)(0 - (long long)(n & 1))));
        return w[(size_t)k * 512 + (n >> 1)] * g[k]; } };

template <class SRC>
DEV void convert_tile256(float* tl, const SRC& src, bf16_t* dst, int ldd, int n0, int k0) {
    int tid = threadIdx.x; asm volatile("" : "+v"(tid));
    {
        const int q = tid & 63;
        f32x4 v[8];
#pragma unroll
        for (int i = 0; i < 8; ++i) v[i] = src.quad(n0, q, k0 + (tid >> 6) + 8 * i);
#pragma unroll
        for (int i = 0; i < 8; ++i) { float* o = tl + ((tid >> 6) + 8 * i) * 257; o[src.drow(q, 0)] = v[i].x; o[src.drow(q, 1)] = v[i].y; o[src.drow(q, 2)] = v[i].z; o[src.drow(q, 3)] = v[i].w; }
    }
    __syncthreads();
#pragma unroll
    for (int i = 0; i < 4; ++i) {
        const int idx = tid + NT * i, n = idx >> 3, kc = idx & 7;
        const float* s = tl + (kc * 8) * 257 + n;
        u32x4 o;
        o.x = pk2(s[0 * 257], s[1 * 257]); o.y = pk2(s[2 * 257], s[3 * 257]); o.z = pk2(s[4 * 257], s[5 * 257]); o.w = pk2(s[6 * 257], s[7 * 257]);
        *(u32x4*)(dst + (size_t)(n0 + n) * ldd + k0 + kc * 8) = o;
    }
    __syncthreads();
}
struct SrcWin4 { const float* w; const float* g;
    DEV int drow(int q, int e) const { return 4 * q + e; }
    DEV f32x4 quad(int n0, int q, int k) const { const int n = pg8::logcol(n0 + 4 * q); int col; if (n < 1280) col = n; else if (n < 3328) col = n + 24; else if (n < 3352) col = 1280 + (n - 3328); else return (f32x4){0.f, 0.f, 0.f, 0.f};
        return *(const f32x4*)(w + (size_t)k * IN_COLS + col) * g[k]; } };
struct SrcWout4 { const float* w; const float* g;
    DEV int drow(int q, int e) const { return 4 * q + e; }
    DEV f32x4 quad(int n0, int q, int k) const { const f32x4 v = *(const f32x4*)(w + (size_t)k * DM + pg8::logcol(n0 + 4 * q)); return k < 512 ? v * g[k] : v; } };
struct SrcPlain4 { const float* w; int ld;
    DEV int drow(int q, int e) const { return 4 * q + e; }
    DEV f32x4 quad(int n0, int q, int k) const { return *(const f32x4*)(w + (size_t)k * ld + n0 + 4 * q); } };
struct SrcW13_4 { const float* w1; const float* w3; const float* g;
    DEV int drow(int q, int e) const { const int l = 8 * (q & 31) + 2 * e + (q >> 5); return (l & ~31) | pg8::inv_perm_lo(l & 31); }
    DEV f32x4 quad(int n0, int q, int k) const { const uintptr_t a = (uintptr_t)w1, b = (uintptr_t)w3; const float* w = (const float*)(a + ((b - a) & (uintptr_t)(0 - (long long)(q >> 5))));
        return *(const f32x4*)(w + (size_t)k * 512 + (n0 >> 1) + 4 * (q & 31)) * g[k]; } };

constexpr int I_WIN = (INP / 256) * (DM / 64);
constexpr int I_WOUT = 4 * 16;
constexpr int I_CW1 = 2 * 32;
constexpr int I_W2 = 32 * 4 * 8;
constexpr int I_CW2 = 2 * 1 * 4;
constexpr int I_ALL = I_WIN + I_WOUT + I_CW1 + I_W2 + I_CW2;
DEV void convert_side(const Params& p, unsigned char* lds) {
    float* tl = (float*)lds; unsigned char* ws = p.ws; const int vb = vblock(), G = gridDim.x;
    __syncthreads();
    for (int it = vb; it < I_WOUT + I_CW1 + I_W2 + I_CW2; it += G) {
        int r = it;
        if (r < I_WOUT) { SrcWout4 s{p.w_out, p.g_nsa}; convert_tile256(tl, s, (bf16_t*)(ws + WS_WOUTT), DM, (r / 16) * 256, (r % 16) * 64); continue; } r -= I_WOUT;
        if (r < I_CW1) { const int z = r / 32, q = r % 32; SrcPlain4 s{z ? p.wv1 : p.wk1, 256};
            convert_tile256(tl, s, (bf16_t*)(ws + WS_CW1T) + (size_t)z * 256 * 2048, 2048, 0, q * 64); continue; } r -= I_CW1;
        if (r < I_W2) { const int e = r / 32, q = r % 32; SrcPlain4 s{p.w2 + (size_t)e * 512 * 1024, 1024};
            convert_tile256(tl, s, (bf16_t*)(ws + WS_W2T) + (size_t)e * 1024 * 512, 512, (q / 8) * 256, (q % 8) * 64); continue; } r -= I_W2;
        { const int z = r / 4, q = r % 4; SrcPlain s{z ? p.wv2 : p.wk2, 64};
            convert_tile(tl, s, (bf16_t*)(ws + WS_CW2T) + (size_t)z * 64 * 256, 256, 0, q * 64); }
    }
    __syncthreads();
}
DEV void phase_prologue(const Params& p, unsigned char* lds) {
    float* tl = (float*)lds;
    const int tid = threadIdx.x, lane = tid & 63, wid = tid >> 6;
    const int vb = vblock(), G = gridDim.x;
    unsigned char* ws = p.ws;
    for (int it = vb; it < I_WIN; it += G) { SrcWin4 s{p.w_in, p.attn_g}; convert_tile256(tl, s, (bf16_t*)(ws + WS_WINT), DM, (it / 16) * 256, (it % 16) * 64); }
    (void)I_ALL;
    {
        bf16_t* xb = (bf16_t*)(ws + WS_XB); float* rstd1 = (float*)(ws + WS_RSTD1);
        const int gw = vb * 8 + wid, NGW = G * 8;
        for (int m = gw; m < NTOK; m += NGW) {
            const f32x4* xr = (const f32x4*)(p.x + (size_t)m * DM) + lane;
            f32x4 v[4]; float s = 0.f;
#pragma unroll
            for (int j = 0; j < 4; ++j) { v[j] = xr[64 * j]; s += (v[j].x * v[j].x + v[j].y * v[j].y) + (v[j].z * v[j].z + v[j].w * v[j].w); }
            s = wave_sum(s);
            if (lane == 0) rstd1[m] = rsqrtf(s * (1.f / DM) + RMS_EPS);
            u32x2* o = (u32x2*)(xb + (size_t)m * DM) + lane;
#pragma unroll
            for (int j = 0; j < 4; ++j) { u32x2 w; w.x = pk2(v[j].x, v[j].y); w.y = pk2(v[j].z, v[j].w); o[64 * j] = w; }
        }
    }
    {
        const int gt = vb * NT + tid, NG = G * NT;
        float* rowss = (float*)(ws + WS_ROWSS);
        for (int i = gt; i < NTOK; i += NG) rowss[i] = 0.f;
        int* bincnt = (int*)(ws + WS_CTL);
        if (gt < 128) bincnt[gt] = 0;
        if (gt < 32) ((int*)(ws + WS_CTL + 512))[gt] = 0;
        if (gt < 512) { const float l0 = p.lb_logits[gt], l1 = p.lb_logits[512 + gt]; ((float*)(ws + WS_LB))[gt] = 1.f / (1.f + __expf(l1 - l0)); }
        for (int i = gt; i < 48 * 1024; i += NG) { const int c = i >> 10, k = i & 1023;
            const float w = (c < 4 ? p.w_group[k * 4 + c] : (c < 36 ? p.w_expert[k * 32 + (c - 4)] : 0.f)) * p.ffn_g[k];
            const bf16_t hi = f2bf(w); const bf16_t lo = f2bf(w - bf2f(hi));
            ((bf16_t*)(ws + WS_RW))[i] = hi; ((bf16_t*)(ws + WS_RW))[48 * 1024 + i] = lo; }
        {
            const int ob = (vb * 8 + wid) * 4;
            if (ob < 512) { const int z = ob >> 8, j0 = ob & 255; const float* pos = z ? p.pos_v : p.pos_k; const float* w = (z ? p.wv1 : p.wk1) + j0;
                f32x4 a = (f32x4){0.f, 0.f, 0.f, 0.f};
#pragma unroll 8
                for (int k = lane; k < 2048; k += 64) a = a + *(const f32x4*)(w + (size_t)k * 256) * pos[k];
                a.x = wave_sum(a.x); a.y = wave_sum(a.y); a.z = wave_sum(a.z); a.w = wave_sum(a.w);
                if (lane == 0) *(f32x4*)((float*)(ws + WS_CBIAS) + ob) = a; }
        }
    }
}

constexpr int G_A_BYTES = 128 * 128, G_B_BYTES = 256 * 128, G_STAGE = G_A_BYTES + G_B_BYTES, G_LDS = 2 * G_STAGE;
DEV int swz(int row, int chunk) { return row * 128 + ((chunk ^ ((row >> 1) & 7)) << 4); }
template <class AL, class BL, class EP>
DEV void gemm_tile(unsigned char* lds, const AL& al, const BL& bl, int nk, const EP& ep) {
    const int tid = threadIdx.x, lane = tid & 63, wid = tid >> 6, wr = wid >> 2, wc = wid & 3;
    const int frow = lane & 15, fq = lane >> 4;
    const bf16_t* aptr[2]; int aoff[2], boff[4], brow[4];
#pragma unroll
    for (int i = 0; i < 2; ++i) { const int q = tid + NT * i, row = q >> 3, ch = q & 7; aptr[i] = al.row(row) + ch * 8; aoff[i] = swz(row, ch); }
#pragma unroll
    for (int i = 0; i < 4; ++i) { const int q = tid + NT * i, row = q >> 3, ch = q & 7; brow[i] = row; boff[i] = G_A_BYTES + swz(row, ch) ; }
    const int bch8 = (tid & 7) * 8;
    u32x4 ra[2], rb[4];
#pragma unroll
    for (int i = 0; i < 2; ++i) ra[i] = *(const u32x4*)(aptr[i]);
#pragma unroll
    for (int i = 0; i < 4; ++i) rb[i] = *(const u32x4*)(bl.ptr(brow[i], 0) + bch8);
#pragma unroll
    for (int i = 0; i < 2; ++i) *(u32x4*)(lds + aoff[i]) = ra[i];
#pragma unroll
    for (int i = 0; i < 4; ++i) *(u32x4*)(lds + boff[i]) = rb[i];
    __syncthreads();
    f32x4 acc[4][4];
#pragma unroll
    for (int m = 0; m < 4; ++m)
#pragma unroll
        for (int n = 0; n < 4; ++n) acc[m][n] = (f32x4){0.f, 0.f, 0.f, 0.f};
    const int sx = (frow >> 1) & 7;
    for (int kt = 0; kt < nk; ++kt) {
        const bool more = (kt + 1 < nk);
        if (more) {
#pragma unroll
            for (int i = 0; i < 2; ++i) ra[i] = *(const u32x4*)(aptr[i] + (kt + 1) * 64);
#pragma unroll
            for (int i = 0; i < 4; ++i) rb[i] = *(const u32x4*)(bl.ptr(brow[i], kt + 1) + bch8);
        }
        const unsigned char* base = lds + (kt & 1) * G_STAGE;
#pragma unroll
        for (int ks = 0; ks < 2; ++ks) {
            const int co = ((ks * 4 + fq) ^ sx) << 4;
            bf16x8 af[4], bfr[4];
#pragma unroll
            for (int m = 0; m < 4; ++m) af[m] = *(const bf16x8*)(base + (wr * 64 + m * 16 + frow) * 128 + co);
#pragma unroll
            for (int n = 0; n < 4; ++n) bfr[n] = *(const bf16x8*)(base + G_A_BYTES + (wc * 64 + n * 16 + frow) * 128 + co);
#pragma unroll
            for (int m = 0; m < 4; ++m)
#pragma unroll
                for (int n = 0; n < 4; ++n) acc[m][n] = __builtin_amdgcn_mfma_f32_16x16x32_bf16(bfr[n], af[m], acc[m][n], 0, 0, 0);
        }
        if (more) {
            unsigned char* nb = lds + ((kt + 1) & 1) * G_STAGE;
#pragma unroll
            for (int i = 0; i < 2; ++i) *(u32x4*)(nb + aoff[i]) = ra[i];
#pragma unroll
            for (int i = 0; i < 4; ++i) *(u32x4*)(nb + boff[i]) = rb[i];
        }
        __syncthreads();
    }
    ep(acc, wr, wc, lane);
}

struct ARows { const bf16_t* base; size_t ld; DEV const bf16_t* row(int r) const { return base + (size_t)r * ld; } };
struct BRows { const bf16_t* base; size_t ld; DEV const bf16_t* ptr(int n, int kt) const { return base + (size_t)n * ld + kt * 64; } };

DEV u32x4 pk8(const f32x4 a, const f32x4 b) { u32x4 w; w.x = pk2(a.x, a.y); w.y = pk2(a.z, a.w); w.z = pk2(b.x, b.y); w.w = pk2(b.z, b.w); return w; }
struct EpiInproj8 { const Params& p; static constexpr bool MIDSCALE = false; DEV float rowscale(int) const { return 1.f; } DEV int midk() const { return -1; }
    DEV void operator()(const f32x4 (&acc)[2][2][4][2], const pg8::Unit& u, int wr, int wc, int fr, int fq) const {
        const int seg = u.pn * 4 + wc;
        if (seg > 52) return;
        unsigned char* ws = p.ws;
        const int row0 = u.pm * 256 + wr * 64 + fr;
        const int b = row0 >> 12, s0 = row0 & 4095;
        float rs[2][4];
#pragma unroll
        for (int ai = 0; ai < 2; ++ai)
#pragma unroll
            for (int m = 0; m < 4; ++m) rs[ai][m] = ((const float*)(ws + WS_RSTD1))[row0 + 128 * ai + 16 * m];
        const bool is_q = seg < 8, is_ks = (seg == 12 || seg == 13), is_kw = (seg == 16 || seg == 17);
        if (is_q || is_ks || is_kw) {
            const float* gw = (is_q ? p.g_q : (is_ks ? p.g_k + 64 : p.g_k + 128)) + 8 * fq;
            const f32x4 g00 = *(const f32x4*)(gw), g01 = *(const f32x4*)(gw + 4), g10 = *(const f32x4*)(gw + 32), g11 = *(const f32x4*)(gw + 36);
            bf16_t* dst; int hh, nh;
            if (is_q) { dst = (bf16_t*)(ws + WS_Q); hh = seg; nh = 8; } else if (is_ks) { dst = (bf16_t*)(ws + WS_KS); hh = seg - 12; nh = 2; } else { dst = (bf16_t*)(ws + WS_KW); hh = seg - 16; nh = 2; }
            bf16_t* o0 = dst + ((size_t)(b * nh + hh) * SEQ + s0) * 64 + fq * 8;
            const float qs = is_q ? QSCALE : 1.f;
#pragma unroll
            for (int ai = 0; ai < 2; ++ai)
#pragma unroll
                for (int m = 0; m < 4; ++m) {
                    const f32x4 a0 = acc[ai][0][m][0], a1 = acc[ai][0][m][1], a2 = acc[ai][1][m][0], a3 = acc[ai][1][m][1];
                    float ss = ((a0.x * a0.x + a0.y * a0.y) + (a0.z * a0.z + a0.w * a0.w)) + ((a1.x * a1.x + a1.y * a1.y) + (a1.z * a1.z + a1.w * a1.w))
                             + ((a2.x * a2.x + a2.y * a2.y) + (a2.z * a2.z + a2.w * a2.w)) + ((a3.x * a3.x + a3.y * a3.y) + (a3.z * a3.z + a3.w * a3.w));
                    ss += __shfl_xor(ss, 16); ss += __shfl_xor(ss, 32);
                    const float rr = rs[ai][m];
                    const float r = rr * rsqrtf(ss * rr * rr * (1.f / 64.f) + RMS_EPS) * qs;
                    bf16_t* o = o0 + (size_t)(128 * ai + 16 * m) * 64;
                    *(u32x4*)(o) = pk8(a0 * g00 * r, a1 * g01 * r); *(u32x4*)(o + 32) = pk8(a2 * g10 * r, a3 * g11 * r);
                }
            return;
        }
        if (seg >= 8 && seg < 12) {
            bf16_t* o0 = (bf16_t*)(ws + (seg < 10 ? WS_KC : WS_VC)) + ((size_t)(b * 2 + (seg & 1)) * SEQ + s0) * 64 + fq * 8;
#pragma unroll
            for (int ai = 0; ai < 2; ++ai)
#pragma unroll
                for (int m = 0; m < 4; ++m) { const float r = rs[ai][m]; bf16_t* o = o0 + (size_t)(128 * ai + 16 * m) * 64;
                    *(u32x4*)(o) = pk8(acc[ai][0][m][0] * r, acc[ai][0][m][1] * r); *(u32x4*)(o + 32) = pk8(acc[ai][1][m][0] * r, acc[ai][1][m][1] * r); }
            return;
        }
        if (seg == 14 || seg == 15 || seg == 18 || seg == 19) {
            bf16_t* o0 = (bf16_t*)(ws + (seg < 16 ? WS_VST : WS_VWT)) + (size_t)(b * 2 + (seg & 1)) * 64 * SEQ + s0;
#pragma unroll
            for (int ai = 0; ai < 2; ++ai)
#pragma unroll
                for (int m = 0; m < 4; ++m) { const float r = rs[ai][m]; bf16_t* o = o0 + 128 * ai + 16 * m;
#pragma unroll
                    for (int bj = 0; bj < 2; ++bj)
#pragma unroll
                        for (int n = 0; n < 2; ++n) { const int d = 32 * bj + 8 * fq + 4 * n; const f32x4 x = acc[ai][bj][m][n] * r;
                            o[(size_t)(d + 0) * SEQ] = f2bf(x.x); o[(size_t)(d + 1) * SEQ] = f2bf(x.y); o[(size_t)(d + 2) * SEQ] = f2bf(x.z); o[(size_t)(d + 3) * SEQ] = f2bf(x.w); } }
            return;
        }
        if (seg < 52) {
            const int kind = (seg - 20) >> 3, cb = ((seg - 20) & 7) * 64 + fq * 8;
            if (kind == 1) {
                const float* lb = (const float*)(ws + WS_LB) + cb;
                const f32x4 l00 = *(const f32x4*)(lb), l01 = *(const f32x4*)(lb + 4), l10 = *(const f32x4*)(lb + 32), l11 = *(const f32x4*)(lb + 36);
                bf16_t* o0 = (bf16_t*)(ws + WS_HLOGF) + (size_t)row0 * 512 + cb;
#define LOGF4(L_, X_) (f32x4){__logf(L_.x + (1.f - L_.x) * sigmoidf_(X_.x)), __logf(L_.y + (1.f - L_.y) * sigmoidf_(X_.y)), __logf(L_.z + (1.f - L_.z) * sigmoidf_(X_.z)), __logf(L_.w + (1.f - L_.w) * sigmoidf_(X_.w))}
#pragma unroll
                for (int ai = 0; ai < 2; ++ai)
#pragma unroll
                    for (int m = 0; m < 4; ++m) { const float r = rs[ai][m]; bf16_t* o = o0 + (size_t)(128 * ai + 16 * m) * 512;
                        const f32x4 x0 = acc[ai][0][m][0] * r, x1 = acc[ai][0][m][1] * r, x2 = acc[ai][1][m][0] * r, x3 = acc[ai][1][m][1] * r;
                        *(u32x4*)(o) = pk8(LOGF4(l00, x0), LOGF4(l01, x1)); *(u32x4*)(o + 32) = pk8(LOGF4(l10, x2), LOGF4(l11, x3)); }
#undef LOGF4
            } else {
                bf16_t* o0 = (bf16_t*)(ws + (kind == 0 ? WS_HQ : (kind == 2 ? WS_HV : WS_HG))) + (size_t)row0 * 512 + cb;
#define SILU4(X_) (f32x4){siluf_(X_.x), siluf_(X_.y), siluf_(X_.z), siluf_(X_.w)}
#pragma unroll
                for (int ai = 0; ai < 2; ++ai)
#pragma unroll
                    for (int m = 0; m < 4; ++m) { const float r = rs[ai][m]; bf16_t* o = o0 + (size_t)(128 * ai + 16 * m) * 512;
                        f32x4 x0 = acc[ai][0][m][0] * r, x1 = acc[ai][0][m][1] * r, x2 = acc[ai][1][m][0] * r, x3 = acc[ai][1][m][1] * r;
                        if (kind != 2) { x0 = SILU4(x0); x1 = SILU4(x1); x2 = SILU4(x2); x3 = SILU4(x3); }
                        *(u32x4*)(o) = pk8(x0, x1); *(u32x4*)(o + 32) = pk8(x2, x3); }
#undef SILU4
            }
            return;
        }
        if (fq < 3) {
            float* o0 = (float*)(ws + WS_GATES) + (size_t)row0 * 24 + 8 * fq;
#pragma unroll
            for (int ai = 0; ai < 2; ++ai)
#pragma unroll
                for (int m = 0; m < 4; ++m) { const float r = rs[ai][m]; float* o = o0 + (size_t)(128 * ai + 16 * m) * 24;
#pragma unroll
                    for (int n = 0; n < 2; ++n) { const f32x4 x = acc[ai][0][m][n] * r; *(f32x4*)(o + 4 * n) = (f32x4){sigmoidf_(x.x), sigmoidf_(x.y), sigmoidf_(x.z), sigmoidf_(x.w)}; } }
        }
    } };
DEV void phase_inproj(const Params& p, unsigned char* lds) {
    pg8::Gemm g{(const bf16_t*)(p.ws + WS_XB), (const bf16_t*)(p.ws + WS_WINT), NTOK, INP, DM};
    pg8::StaticOrder S; S.init(NTOK, INP, (int)gridDim.x, (int)blockIdx.x);
    EpiInproj8 E{p};
    const bool first = ((blockIdx.x >> 3) & 1) == 0;
    if (first) convert_side(p, lds);
    pg8::gemm_phase(( PG8_LAS unsigned char*)lds, g, S, E);
    if (!first) convert_side(p, lds);
}

struct ACmp { const bf16_t* src; int bg, c0;
    DEV const bf16_t* row(int r) const { int c = c0 + r; if (c > NC - 1) c = NC - 1; return src + ((size_t)bg * SEQ + 16 * c) * 64; } };
struct EpiCmpA { const Params& p; int z, rbase;
    DEV void operator()(f32x4 (&acc)[4][4], int wr, int wc, int lane) const {
        const int frow = lane & 15, fq = lane >> 4;
        const float* cb = (const float*)(p.ws + WS_CBIAS) + z * 256; bf16_t* hid = (bf16_t*)(p.ws + WS_HID) + (size_t)z * 4096 * 256;
#pragma unroll
        for (int m = 0; m < 4; ++m) { const int rr = rbase + wr * 64 + m * 16 + frow;
#pragma unroll
            for (int n = 0; n < 4; ++n) { const int c = wc * 64 + n * 16 + fq * 4; const f32x4 b = *(const f32x4*)(cb + c); f32x4 v = acc[m][n] + b;
                u32x2 w; w.x = pk2(siluf_(v.x), siluf_(v.y)); w.y = pk2(siluf_(v.z), siluf_(v.w)); *(u32x2*)(hid + (size_t)rr * 256 + c) = w; } }
    } };
DEV void phase_cmp_a(const Params& p, unsigned char* lds) {
    const int vb = vblock(), G = gridDim.x;
    for (int u = vb; u < 64; u += G) {
        const int z = u >> 5, rbase = (u & 31) * 128;
        ACmp al{(const bf16_t*)(p.ws + (z ? WS_VC : WS_KC)), (u & 31) >> 1, (u & 1) * 128};
        BRows bl{(const bf16_t*)(p.ws + WS_CW1T) + (size_t)z * 256 * 2048, 2048};
        EpiCmpA ep{p, z, rbase};
        gemm_tile(lds, al, bl, 2048 / 64, ep);
    }
}
struct BClamp64 { const bf16_t* base; size_t ld; DEV const bf16_t* ptr(int n, int kt) const { return base + (size_t)(n & 63) * ld + kt * 64; } };
struct EpiCmpB { const Params& p; int z, rbase;
    DEV void operator()(f32x4 (&acc)[4][4], int wr, int wc, int lane) const {
        if (wc != 0) return;
        const int frow = lane & 15, fq = lane >> 4;
        bf16_t* dst = (bf16_t*)(p.ws + (z ? WS_VCMP : WS_KCMP));
#pragma unroll
        for (int m = 0; m < 4; ++m) { const int rr = rbase + wr * 64 + m * 16 + frow;
            float r = 1.f;
            if (z == 0) { float ss = 0.f;
#pragma unroll
                for (int n = 0; n < 4; ++n) { const f32x4 v = acc[m][n]; ss += (v.x * v.x + v.y * v.y) + (v.z * v.z + v.w * v.w); }
                ss += __shfl_xor(ss, 16); ss += __shfl_xor(ss, 32); r = rsqrtf(ss * (1.f / 64.f) + RMS_EPS); }
            const int bg = rr >> 8, c = rr & 255;
            if (c < NC) {
#pragma unroll
                for (int n = 0; n < 4; ++n) { const int d = n * 16 + fq * 4; f32x4 v = acc[m][n] * r;
                    if (z == 0) { const f32x4 g = *(const f32x4*)(p.g_k + d); v = v * g;
                        u32x2 w; w.x = pk2(v.x, v.y); w.y = pk2(v.z, v.w); *(u32x2*)(dst + ((size_t)bg * 256 + c) * 64 + d) = w; }
                    else { bf16_t* o = dst + ((size_t)bg * 64 + d) * 256 + c; o[0] = f2bf(v.x); o[256] = f2bf(v.y); o[512] = f2bf(v.z); o[768] = f2bf(v.w); } } }
        }
    } };
DEV void phase_cmp_b(const Params& p, unsigned char* lds) {
    const int vb = vblock(), G = gridDim.x;
    for (int u = vb; u < 64; u += G) {
        const int z = u >> 5, rbase = (u & 31) * 128;
        ARows al{(const bf16_t*)(p.ws + WS_HID) + ((size_t)z * 4096 + rbase) * 256, 256};
        BClamp64 bl{(const bf16_t*)(p.ws + WS_CW2T) + (size_t)z * 64 * 256, 256};
        EpiCmpB ep{p, z, rbase};
        gemm_tile(lds, al, bl, 256 / 64, ep);
    }
}

constexpr int CM_K = 0, CM_V = 32768, CM_VSTR = 520, CM_IMP = CM_V + 64 * CM_VSTR, CM_LDS = CM_IMP + 4 * 16384 + 1024;
DEV void cm_scores(const unsigned char* kbase, int kt, const bf16x8 (&qf)[4], int r31, int hh, f32x16 (&sacc)[2]) {
    bf16x8 kfr[2][4];
#pragma unroll
    for (int kt2 = 0; kt2 < 2; ++kt2) { const int row = 64 * kt + 32 * kt2 + r31; const int sx = (row >> 1) & 7;
#pragma unroll
        for (int s = 0; s < 4; ++s) kfr[kt2][s] = *(const bf16x8*)(kbase + row * 128 + (((2 * s + hh) ^ sx) << 4)); }
    __builtin_amdgcn_sched_barrier(0);
#pragma unroll
    for (int kt2 = 0; kt2 < 2; ++kt2) {
#pragma unroll
        for (int i = 0; i < 16; ++i) sacc[kt2][i] = 0.f;
#pragma unroll
        for (int s = 0; s < 4; ++s) sacc[kt2] = __builtin_amdgcn_mfma_f32_32x32x16_bf16(kfr[kt2][s], qf[s], sacc[kt2], 0, 0, 0);
    }
    __builtin_amdgcn_sched_barrier(0);
}
DEV void phase_cmp_attn(const Params& p, unsigned char* lds) {
    int tid_ = threadIdx.x; asm volatile("" : "+v"(tid_));
    const int tid = tid_, lane = tid & 63, wid = tid >> 6;
    const int vb = vblock(), G = gridDim.x;
    unsigned char* ws = p.ws;
    const int r31 = lane & 31, hh = lane >> 5;
    float* impl = (float*)(lds + CM_IMP);
    for (int it = vb; it < 1024; it += G) {
        int ci, bg;
        if (G == 256) { const int x = vb >> 5, jb = vb & 31, rnd = it / G, i = rnd * 32 + ((rnd & 1) ? 31 - jb : jb); ci = 63 - (i >> 1); bg = 2 * x + (i & 1); }
        else { ci = 63 - (it >> 4); bg = it & 15; }
        const int b = bg >> 1, g = bg & 1;
        const int nvis = min(NC, 4 * ci + 3), ntile = (nvis + 63) >> 6;
        const int head = g * 4 + (wid >> 1);
        const int tokl = (wid & 1) * 32 + r31, t = ci * 64 + tokl;
        const size_t tok = (size_t)b * SEQ + t;
        const int nv = t >= 31 ? min(NC, (t - 31) / 16 + 1) : 0;
        const float gate_c = ((const float*)(ws + WS_GATES))[tok * 24 + head * 3 + 0];
        __syncthreads();
        {
            const bf16_t* kc = (const bf16_t*)(ws + WS_KCMP) + (size_t)bg * 256 * 64; const bf16_t* vt = (const bf16_t*)(ws + WS_VCMP) + (size_t)bg * 64 * 256;
            const int cpr = ntile * 8;
            u32x4 rk[4], rv[4];
#pragma unroll
            for (int i = 0; i < 4; ++i) if (i < ntile) { const int idx = tid + NT * i; rk[i] = *(const u32x4*)(kc + (idx >> 3) * 64 + (idx & 7) * 8); const int d = idx / cpr, ck = idx % cpr; rv[i] = *(const u32x4*)(vt + d * 256 + ck * 8); }
#pragma unroll
            for (int i = 0; i < 4; ++i) if (i < ntile) { const int idx = tid + NT * i; *(u32x4*)(lds + CM_K + swz(idx >> 3, idx & 7)) = rk[i];
                const int d = idx / cpr, ck = idx % cpr; u32x2 a, c2; a.x = rv[i].x; a.y = rv[i].y; c2.x = rv[i].z; c2.y = rv[i].w; unsigned char* o = lds + CM_V + d * CM_VSTR + ck * 16; *(u32x2*)o = a; *(u32x2*)(o + 8) = c2; }
        }
        bf16x8 qf[4];
        { const bf16_t* qp = (const bf16_t*)(ws + WS_Q) + ((size_t)(b * 8 + head) * SEQ + t) * 64 + 8 * hh;
#pragma unroll
            for (int s = 0; s < 4; ++s) qf[s] = *(const bf16x8*)(qp + 16 * s); }
        __syncthreads();
        float l_run = 0.f;
        f32x16 ot[2];
#pragma unroll
        for (int dt = 0; dt < 2; ++dt)
#pragma unroll
            for (int i = 0; i < 16; ++i) ot[dt][i] = 0.f;
        float carry = 0.f;
#pragma unroll
        for (int kt = 0; kt < 4; ++kt) if (kt < ntile) {
            f32x16 sacc[2];
            cm_scores(lds + CM_K, kt, qf, r31, hh, sacc);
            u32x4 vfr[2][2][2];
#pragma unroll
            for (int kt2 = 0; kt2 < 2; ++kt2)
#pragma unroll
                for (int s2 = 0; s2 < 2; ++s2)
#pragma unroll
                    for (int dt = 0; dt < 2; ++dt) { const unsigned char* va = lds + CM_V + (32 * dt + r31) * CM_VSTR + (64 * kt + 32 * kt2 + 16 * s2 + 4 * hh) * 2;
                        const u32x2 lo = *(const u32x2*)(va), hi = *(const u32x2*)(va + 16); u32x4 w; w.x = lo.x; w.y = lo.y; w.z = hi.x; w.w = hi.y; vfr[kt2][s2][dt] = w; }
            __builtin_amdgcn_sched_barrier(0);
#pragma unroll
            for (int kt2 = 0; kt2 < 2; ++kt2)
#pragma unroll
                for (int i = 0; i < 16; ++i) { const int c = 64 * kt + 32 * kt2 + (i & 3) + 8 * (i >> 2) + 4 * hh; const float e_ = (c < nv) ? __builtin_amdgcn_exp2f(sacc[kt2][i]) : 0.f; sacc[kt2][i] = e_; l_run += e_; }
            {
                float own[8], xs[8];
#pragma unroll
                for (int kt2 = 0; kt2 < 2; ++kt2)
#pragma unroll
                    for (int g4 = 0; g4 < 4; ++g4) { const float e3 = 0.5f * sacc[kt2][4 * g4 + 3];
                        own[4 * kt2 + g4] = (sacc[kt2][4 * g4] + sacc[kt2][4 * g4 + 1]) + (sacc[kt2][4 * g4 + 2] + e3); xs[4 * kt2 + g4] = __shfl_xor(e3, 32); }
                float* io = impl + (wid >> 1) * 4096 + tokl * 64 + 16 * kt + hh;
#pragma unroll
                for (int gi = 0; gi < 8; ++gi) io[2 * gi] = own[gi] + (hh ? xs[gi] : (gi > 0 ? xs[gi > 0 ? gi - 1 : 0] : carry));
                carry = xs[7];
            }
#pragma unroll
            for (int kt2 = 0; kt2 < 2; ++kt2)
#pragma unroll
                for (int s2 = 0; s2 < 2; ++s2) {
                    bf16x8 pf; { u32x4 w; w.x = pk2(sacc[kt2][8 * s2 + 0], sacc[kt2][8 * s2 + 1]); w.y = pk2(sacc[kt2][8 * s2 + 2], sacc[kt2][8 * s2 + 3]);
                        w.z = pk2(sacc[kt2][8 * s2 + 4], sacc[kt2][8 * s2 + 5]); w.w = pk2(sacc[kt2][8 * s2 + 6], sacc[kt2][8 * s2 + 7]); pf = __builtin_bit_cast(bf16x8, w); }
#pragma unroll
                    for (int dt = 0; dt < 2; ++dt) ot[dt] = __builtin_amdgcn_mfma_f32_32x32x16_bf16(__builtin_bit_cast(bf16x8, vfr[kt2][s2][dt]), pf, ot[dt], 0, 0, 0);
                }
        }
        float invL; { const float L = l_run + __shfl_xor(l_run, 32); invL = L > 0.f ? 1.f / L : 0.f; }
        if (hh == 0) impl[16384 + (wid >> 1) * 64 + tokl] = invL;
        {
            const float sc = gate_c * invL;
            bf16_t* ocp = (bf16_t*)(ws + WS_OC) + tok * 512 + head * 64;
#pragma unroll
            for (int dt = 0; dt < 2; ++dt)
#pragma unroll
                for (int g4 = 0; g4 < 4; ++g4) { const int d0 = 32 * dt + 8 * g4 + 4 * hh;
                    u32x2 w; w.x = pk2(ot[dt][4 * g4 + 0] * sc, ot[dt][4 * g4 + 1] * sc); w.y = pk2(ot[dt][4 * g4 + 2] * sc, ot[dt][4 * g4 + 3] * sc); *(u32x2*)(ocp + d0) = w; }
        }
        __syncthreads();
        {
            const int cur = ci;
            if (cur < 16) { if (lane < 8) ((unsigned long long*)(ws + WS_SELM))[(size_t)bg * SEQ + ci * 64 + wid * 8 + lane] = (2ull << cur) - 1ull; }
            else {
                const bool valid = lane <= cur;
                const unsigned long long vmask = (2ull << cur) - 1ull;
#pragma unroll 1
                for (int t4 = 0; t4 < 2; ++t4) {
                    unsigned key[4], T[4];
#pragma unroll
                    for (int q = 0; q < 4; ++q) { const int tl = wid * 8 + t4 * 4 + q;
                        const float imp = (impl[tl * 64 + lane] * impl[16384 + tl] + impl[4096 + tl * 64 + lane] * impl[16384 + 64 + tl]) + (impl[8192 + tl * 64 + lane] * impl[16384 + 128 + tl] + impl[12288 + tl * 64 + lane] * impl[16384 + 192 + tl]);
                        key[q] = !valid ? 0u : ((lane == 0 || lane == cur) ? 0x7F800000u : __float_as_uint(imp)); T[q] = 0u; }
                    unsigned done = 0u;
                    for (int bit = 30; bit >= 0 && done != 0xfu; --bit) {
#pragma unroll
                        for (int q = 0; q < 4; ++q) { const unsigned cand = T[q] | (1u << bit); const int c = __popcll(__builtin_amdgcn_uicmp(key[q], cand, 35)); if (c >= 16) T[q] = cand; if (c == 16) done |= 1u << q; }
                    }
#pragma unroll
                    for (int q = 0; q < 4; ++q) {
                        const unsigned long long gt = __builtin_amdgcn_uicmp(key[q], T[q], 34) & vmask, eq = __builtin_amdgcn_uicmp(key[q], T[q], 32) & vmask;
                        const int need = 16 - __popcll(gt);
                        const int below = __popcll(eq & ((1ull << lane) - 1ull));
                        const unsigned long long mask = gt | (eq & __builtin_amdgcn_uicmp((unsigned)below, (unsigned)need, 36));
                        if (lane == 0) ((unsigned long long*)(ws + WS_SELM))[(size_t)bg * SEQ + ci * 64 + wid * 8 + t4 * 4 + q] = mask;
                    }
                }
            }
        }
    }
}

constexpr int FA_KB = 64 * 128, FA_VB = 64 * 136, FA_STAGE = FA_KB + FA_VB, FA_LDS = 2 * FA_STAGE + 1024;
template <bool SEL, bool FAST>
DEV void fa_branch(unsigned char* lds, const bf16_t* Kb, const bf16_t* VTb, int ci, int bg, const bf16x8 (&qf)[4], int t, unsigned long long mymask, unsigned long long need,
                   f32x16 (&ot)[2], float& m_run, float& l_run) {
    const int tid = threadIdx.x, lane = tid & 63;
    const int r31 = lane & 31, hh = lane >> 5;
    const int lrow = tid >> 3, lch = tid & 7;
    const bf16_t* kg = Kb + ((size_t)bg * SEQ + lrow) * 64 + lch * 8;
    const bf16_t* vg = VTb + ((size_t)bg * 64 + lrow) * SEQ + lch * 8;
    const int koff = lrow * 128 + ((lch ^ ((lrow >> 1) & 7)) << 4), voff = FA_KB + lrow * 136 + lch * 16;
    int jlo, jhi; unsigned long long todo;
    if (SEL) { todo = need; jlo = 0; jhi = ci; } else { jlo = ci >= 8 ? ci - 8 : 0; jhi = ci; todo = 0; }
    int j = jlo;
    if (SEL) { if (todo == 0) return; j = __builtin_ctzll(todo); todo &= todo - 1; }
    u32x4 rk = *(const u32x4*)(kg + (size_t)j * 64 * 64), rv = *(const u32x4*)(vg + (size_t)j * 64);
    __syncthreads();
    *(u32x4*)(lds + koff) = rk; { u32x2 a, b2; a.x = rv.x; a.y = rv.y; b2.x = rv.z; b2.y = rv.w; *(u32x2*)(lds + voff) = a; *(u32x2*)(lds + voff + 8) = b2; }
    __syncthreads();
    int st = 0; bool seen = false;
    for (;;) {
        int jn; bool more;
        if (SEL) { more = (todo != 0); jn = more ? __builtin_ctzll(todo) : 0; todo &= todo - 1; } else { jn = j + 1; more = (jn <= jhi); }
        if (more) { rk = *(const u32x4*)(kg + (size_t)jn * 64 * 64); rv = *(const u32x4*)(vg + (size_t)jn * 64); }
        const unsigned char* base = lds + st * FA_STAGE;
        const bool bit = SEL ? ((mymask >> j) & 1ull) != 0 : true;
        const float cinit = FAST ? 0.f : ((SEL && !bit) ? -__builtin_inff() : -m_run);
        f32x16 sacc[2];
        bf16x8 kfr[2][4]; u32x4 vfr[2][2][2];
#pragma unroll
        for (int kt2 = 0; kt2 < 2; ++kt2) { const int row = 32 * kt2 + r31; const int sx = (row >> 1) & 7;
#pragma unroll
            for (int s = 0; s < 4; ++s) kfr[kt2][s] = *(const bf16x8*)(base + row * 128 + (((2 * s + hh) ^ sx) << 4)); }
        __builtin_amdgcn_sched_barrier(0);
#pragma unroll
        for (int kt2 = 0; kt2 < 2; ++kt2) {
#pragma unroll
            for (int i = 0; i < 16; ++i) sacc[kt2][i] = cinit;
#pragma unroll
            for (int s = 0; s < 4; ++s) sacc[kt2] = __builtin_amdgcn_mfma_f32_32x32x16_bf16(kfr[kt2][s], qf[s], sacc[kt2], 0, 0, 0);
        }
        __builtin_amdgcn_sched_barrier(0);
#pragma unroll
        for (int kt2 = 0; kt2 < 2; ++kt2)
#pragma unroll
            for (int s2 = 0; s2 < 2; ++s2)
#pragma unroll
                for (int dt = 0; dt < 2; ++dt) { const unsigned char* va = base + FA_KB + (32 * dt + r31) * 136 + (32 * kt2 + 16 * s2 + 4 * hh) * 2;
                    const u32x2 lo = *(const u32x2*)(va), hi = *(const u32x2*)(va + 16); u32x4 w; w.x = lo.x; w.y = lo.y; w.z = hi.x; w.w = hi.y; vfr[kt2][s2][dt] = w; }
        __builtin_amdgcn_sched_barrier(0);
        const bool boundary = SEL ? (j == ci) : (j == ci || j + 8 <= ci);
        if (FAST) {
            if (boundary) {
#pragma unroll
                for (int kt2 = 0; kt2 < 2; ++kt2)
#pragma unroll
                    for (int i = 0; i < 16; ++i) { const int key = 64 * j + 32 * kt2 + (i & 3) + 8 * (i >> 2) + 4 * hh;
                        const bool ok = SEL ? (key <= t) : (key <= t && t - key < 512);
                        sacc[kt2][i] = ok ? sacc[kt2][i] : -__builtin_inff(); }
            }
            f32x2 rs2[4];
#pragma unroll
            for (int c = 0; c < 4; ++c) rs2[c] = (f32x2){0.f, 0.f};
#pragma unroll
            for (int kt2 = 0; kt2 < 2; ++kt2)
#pragma unroll
                for (int i = 0; i < 16; i += 2) { const float e0 = __builtin_amdgcn_exp2f(sacc[kt2][i]), e1 = __builtin_amdgcn_exp2f(sacc[kt2][i + 1]); sacc[kt2][i] = e0; sacc[kt2][i + 1] = e1; rs2[(i >> 1) & 3] = rs2[(i >> 1) & 3] + (f32x2){e0, e1}; }
            const f32x2 rsum = (rs2[0] + rs2[1]) + (rs2[2] + rs2[3]);
            l_run += bit ? rsum.x + rsum.y : 0.f;
        } else {
            float mx = -__builtin_inff();
            if (boundary) {
    #pragma unroll
                for (int kt2 = 0; kt2 < 2; ++kt2)
    #pragma unroll
                    for (int i = 0; i < 16; ++i) { const int key = 64 * j + 32 * kt2 + (i & 3) + 8 * (i >> 2) + 4 * hh;
                        const bool ok = SEL ? (key <= t) : (key <= t && t - key < 512);
                        const float v = ok ? sacc[kt2][i] : -__builtin_inff(); sacc[kt2][i] = v; mx = fmaxf(mx, v); }
            } else {
    #pragma unroll
                for (int kt2 = 0; kt2 < 2; ++kt2)
    #pragma unroll
                    for (int i = 0; i < 16; ++i) mx = fmaxf(mx, sacc[kt2][i]);
            }
            mx = fmaxf(mx, __shfl_xor(mx, 32));
            const bool live = mx > -__builtin_inff();
            const bool need = (mx > 8.f) || (!seen && live && mx < -8.f);
            if (__any(need)) {
                const float d = need ? mx : 0.f;
                const float alpha = d > 0.f ? __builtin_amdgcn_exp2f(-d) : 1.f;
                m_run += d; l_run *= alpha;
    #pragma unroll
                for (int dt = 0; dt < 2; ++dt)
    #pragma unroll
                    for (int i = 0; i < 16; ++i) ot[dt][i] *= alpha;
    #pragma unroll
                for (int kt2 = 0; kt2 < 2; ++kt2)
    #pragma unroll
                    for (int i = 0; i < 16; ++i) sacc[kt2][i] -= d;
            }
            seen = seen || live;
            float rs = 0.f;
    #pragma unroll
            for (int kt2 = 0; kt2 < 2; ++kt2)
    #pragma unroll
                for (int i = 0; i < 16; ++i) { const float e = __builtin_amdgcn_exp2f(sacc[kt2][i]); sacc[kt2][i] = e; rs += e; }
            l_run += rs;
        }
#pragma unroll
        for (int kt2 = 0; kt2 < 2; ++kt2)
#pragma unroll
            for (int s2 = 0; s2 < 2; ++s2) {
                bf16x8 pf; { u32x4 w; w.x = pk2(sacc[kt2][8 * s2 + 0], sacc[kt2][8 * s2 + 1]); w.y = pk2(sacc[kt2][8 * s2 + 2], sacc[kt2][8 * s2 + 3]);
                    w.z = pk2(sacc[kt2][8 * s2 + 4], sacc[kt2][8 * s2 + 5]); w.w = pk2(sacc[kt2][8 * s2 + 6], sacc[kt2][8 * s2 + 7]);
                    if (FAST && SEL) { const unsigned bm = bit ? 0xffffffffu : 0u; w.x &= bm; w.y &= bm; w.z &= bm; w.w &= bm; }
                    pf = __builtin_bit_cast(bf16x8, w); }
#pragma unroll
                for (int dt = 0; dt < 2; ++dt) ot[dt] = __builtin_amdgcn_mfma_f32_32x32x16_bf16(__builtin_bit_cast(bf16x8, vfr[kt2][s2][dt]), pf, ot[dt], 0, 0, 0);
            }
        if (!more) break;
        { unsigned char* nb = lds + (st ^ 1) * FA_STAGE; *(u32x4*)(nb + koff) = rk; u32x2 a, b2; a.x = rv.x; a.y = rv.y; b2.x = rv.z; b2.y = rv.w; *(u32x2*)(nb + voff) = a; *(u32x2*)(nb + voff + 8) = b2; }
        __syncthreads();
        st ^= 1; j = jn;
    }
}
DEV void phase_flash(const Params& p, unsigned char* lds) {
    const int tid = threadIdx.x, lane = tid & 63, wid = tid >> 6;
    const int vb = vblock(), G = gridDim.x;
    unsigned char* ws = p.ws;
    const int r31 = lane & 31, hh = lane >> 5;
    unsigned long long* red = (unsigned long long*)(lds + 2 * FA_STAGE);
    bool fast_s, fast_w;
    { const float gq = wave_max(fabsf(p.g_q[lane])), gs = wave_max(fabsf(p.g_k[64 + lane])), gw = wave_max(fabsf(p.g_k[128 + lane]));
      fast_s = __builtin_amdgcn_readfirstlane((int)(11.6f * gq * gs <= 60.f)) != 0; fast_w = __builtin_amdgcn_readfirstlane((int)(11.6f * gq * gw <= 60.f)) != 0; }
    for (int it = vb; it < 1024; it += G) {
        int ci, bg;
        if (G == 256) { const int x = vb >> 5, jb = vb & 31, rnd = it / G, i = rnd * 32 + ((rnd & 1) ? 31 - jb : jb); ci = 63 - (i >> 1); bg = 2 * x + (i & 1); }
        else { ci = 63 - (it >> 4); bg = it & 15; }
        const int b = bg >> 1, g = bg & 1;
        const int head = g * 4 + (wid >> 1);
        const int t = ci * 64 + (wid & 1) * 32 + r31;
        const size_t tok = (size_t)b * SEQ + t;
        bf16x8 qf[4];
        { const bf16_t* qp = (const bf16_t*)(ws + WS_Q) + ((size_t)(b * 8 + head) * SEQ + t) * 64 + 8 * hh;
#pragma unroll
            for (int s = 0; s < 4; ++s) qf[s] = *(const bf16x8*)(qp + 16 * s); }
        const unsigned long long mymask = ((const unsigned long long*)(ws + WS_SELM))[(size_t)bg * SEQ + t];
        const float gate_s = ((const float*)(ws + WS_GATES))[tok * 24 + head * 3 + 1], gate_w = ((const float*)(ws + WS_GATES))[tok * 24 + head * 3 + 2];
        u32x2 ocv[2][4];
#pragma unroll
        for (int dt = 0; dt < 2; ++dt)
#pragma unroll
            for (int g4 = 0; g4 < 4; ++g4) ocv[dt][g4] = *(const u32x2*)((const bf16_t*)(ws + WS_OC) + tok * 512 + head * 64 + 32 * dt + 8 * g4 + 4 * hh);
        unsigned long long orm = mymask;
#pragma unroll
        for (int o = 1; o < 32; o <<= 1) { const unsigned lo = __shfl_xor((unsigned)orm, o), hi = __shfl_xor((unsigned)(orm >> 32), o); orm |= ((unsigned long long)hi << 32) | lo; }
        __syncthreads();
        if (wid < 2 && lane == 0) red[wid] = orm;
        __syncthreads();
        const unsigned long long need = red[0] | red[1];
        f32x16 oc[2];
        {
            f32x16 ot[2]; float m_run = 0.f, l_run = 0.f;
#pragma unroll
            for (int dt = 0; dt < 2; ++dt)
#pragma unroll
                for (int i = 0; i < 16; ++i) ot[dt][i] = 0.f;
            if (fast_s) fa_branch<true, true>(lds, (const bf16_t*)(ws + WS_KS), (const bf16_t*)(ws + WS_VST), ci, bg, qf, t, mymask, need, ot, m_run, l_run);
            else fa_branch<true, false>(lds, (const bf16_t*)(ws + WS_KS), (const bf16_t*)(ws + WS_VST), ci, bg, qf, t, mymask, need, ot, m_run, l_run);
            const float lt = l_run + __shfl_xor(l_run, 32);
            const float sc = gate_s / lt;
#pragma unroll
            for (int dt = 0; dt < 2; ++dt)
#pragma unroll
                for (int i = 0; i < 16; ++i) oc[dt][i] = ot[dt][i] * sc;
        }
        {
            f32x16 ot[2]; float m_run = 0.f, l_run = 0.f;
#pragma unroll
            for (int dt = 0; dt < 2; ++dt)
#pragma unroll
                for (int i = 0; i < 16; ++i) ot[dt][i] = 0.f;
            if (fast_w) fa_branch<false, true>(lds, (const bf16_t*)(ws + WS_KW), (const bf16_t*)(ws + WS_VWT), ci, bg, qf, t, 0ull, 0ull, ot, m_run, l_run);
            else fa_branch<false, false>(lds, (const bf16_t*)(ws + WS_KW), (const bf16_t*)(ws + WS_VWT), ci, bg, qf, t, 0ull, 0ull, ot, m_run, l_run);
            const float lt = l_run + __shfl_xor(l_run, 32);
            const float sc = gate_w / lt;
#pragma unroll
            for (int dt = 0; dt < 2; ++dt)
#pragma unroll
                for (int i = 0; i < 16; ++i) oc[dt][i] += ot[dt][i] * sc;
        }
        {
            bf16_t* mix = (bf16_t*)(ws + WS_R1) + tok * 1024 + head * 64;
            float ss = 0.f;
#pragma unroll
            for (int dt = 0; dt < 2; ++dt)
#pragma unroll
                for (int g4 = 0; g4 < 4; ++g4) { const int d0 = 32 * dt + 8 * g4 + 4 * hh; const u32x2 c = ocv[dt][g4];
                    const float v0 = oc[dt][4 * g4 + 0] + bflo(c.x), v1 = oc[dt][4 * g4 + 1] + bfhi(c.x), v2 = oc[dt][4 * g4 + 2] + bflo(c.y), v3 = oc[dt][4 * g4 + 3] + bfhi(c.y);
                    ss += (v0 * v0 + v1 * v1) + (v2 * v2 + v3 * v3);
                    u32x2 w; w.x = pk2(v0, v1); w.y = pk2(v2, v3); *(u32x2*)(mix + d0) = w; }
            ss += __shfl_xor(ss, 32);
            if (hh == 0) atomicAdd((float*)(ws + WS_ROWSS) + tok, ss);
        }
    }
}

DEV int swz256(int row, int chunk) { return row * 256 + ((chunk ^ (row & 15)) << 4); }
DEV void hgrn_cumsum(const Params& p, int bh, int c, float* segs, f32x2 (&lf)[8], f32x2 (&a)[8], f32x2& r, f32x2& alast) {
    const int tid = threadIdx.x, k2 = tid & 63, tq = tid >> 6;
    const int b = bh >> 2, h = bh & 3;
    const bf16_t* HL = (const bf16_t*)(p.ws + WS_HLOGF) + ((size_t)b * SEQ + c * 64 + tq * 8) * 512 + h * 128 + 2 * k2;
#pragma unroll
    for (int i = 0; i < 8; ++i) { const unsigned w = *(const unsigned*)(HL + (size_t)i * 512); lf[i] = (f32x2){bflo(w), bfhi(w)}; }
    f32x2 run = (f32x2){0.f, 0.f};
#pragma unroll
    for (int i = 0; i < 8; ++i) { run = run + lf[i]; a[i] = run; }
    *(f32x2*)(segs + tq * 128 + 2 * k2) = run;
    __syncthreads();
    f32x2 off = (f32x2){0.f, 0.f}, tot = off, rr = off;
#pragma unroll
    for (int q = 0; q < 8; ++q) { const f32x2 s = *(const f32x2*)(segs + q * 128 + 2 * k2); if (q < tq) off = off + s; if (q < 4) rr = rr + s; tot = tot + s; }
#pragma unroll
    for (int i = 0; i < 8; ++i) a[i] = a[i] + off;
    r = rr; alast = tot;
}
DEV void hgrn_stage_vt(const Params& p, int bh, int c, unsigned char* vt) {
    const int tid = threadIdx.x, k2 = tid & 63, tq = tid >> 6;
    const int b = bh >> 2, h = bh & 3;
    const bf16_t* HV = (const bf16_t*)(p.ws + WS_HV) + ((size_t)b * SEQ + c * 64 + tq * 8) * 512 + h * 128 + 2 * k2;
    unsigned vv[8];
#pragma unroll
    for (int i = 0; i < 8; ++i) vv[i] = *(const unsigned*)(HV + (size_t)i * 512);
    u32x4 lo, hi;
    lo.x = (vv[0] & 0xffffu) | (vv[1] << 16); lo.y = (vv[2] & 0xffffu) | (vv[3] << 16); lo.z = (vv[4] & 0xffffu) | (vv[5] << 16); lo.w = (vv[6] & 0xffffu) | (vv[7] << 16);
    hi.x = (vv[0] >> 16) | (vv[1] & 0xffff0000u); hi.y = (vv[2] >> 16) | (vv[3] & 0xffff0000u); hi.z = (vv[4] >> 16) | (vv[5] & 0xffff0000u); hi.w = (vv[6] >> 16) | (vv[7] & 0xffff0000u);
    *(u32x4*)(vt + swz(2 * k2, tq)) = lo; *(u32x4*)(vt + swz(2 * k2 + 1, tq)) = hi;
}
constexpr int H1_KT = 0, H1_VT = 16384, H1_SEG = 32768, H1_EK = H1_SEG + 4096;
DEV void phase_hgrn_a1(const Params& p, unsigned char* lds, int vb0, int nb) {
    const int tid = threadIdx.x, lane = tid & 63, wid = tid >> 6, k2 = tid & 63, tq = tid >> 6;
    const int vb = vblock(), G = gridDim.x;
    const int frow = lane & 15, fq = lane >> 4, wr = wid >> 1, wc = wid & 1;
    float* segs = (float*)(lds + H1_SEG); float* ek = (float*)(lds + H1_EK);
    bf16_t* ubuf = (bf16_t*)(p.ws + WS_UBUF); float* dbuf = (float*)(p.ws + WS_DBUF);
    if (vb < vb0) return;
    for (int item = vb - vb0; item < 2048; item += nb) {
        const int bh = item >> 6, c = item & 63;
        __syncthreads();
        f32x2 lf[8], a[8], r, al;
        hgrn_cumsum(p, bh, c, segs, lf, a, r, al);
        {
            float kx[8], ky[8];
#pragma unroll
            for (int i = 0; i < 8; ++i) { kx[i] = (1.f - __expf(lf[i].x)) * __expf(fminf(r.x - a[i].x, 80.f)); ky[i] = (1.f - __expf(lf[i].y)) * __expf(fminf(r.y - a[i].y, 80.f)); }
            u32x4 w0, w1;
            w0.x = pk2(kx[0], kx[1]); w0.y = pk2(kx[2], kx[3]); w0.z = pk2(kx[4], kx[5]); w0.w = pk2(kx[6], kx[7]);
            w1.x = pk2(ky[0], ky[1]); w1.y = pk2(ky[2], ky[3]); w1.z = pk2(ky[4], ky[5]); w1.w = pk2(ky[6], ky[7]);
            *(u32x4*)(lds + H1_KT + swz(2 * k2, tq)) = w0; *(u32x4*)(lds + H1_KT + swz(2 * k2 + 1, tq)) = w1;
        }
        hgrn_stage_vt(p, bh, c, lds + H1_VT);
        if (tq == 7) { ek[2 * k2] = __expf(al.x - r.x); ek[2 * k2 + 1] = __expf(al.y - r.y); f32x2 d; d.x = __expf(al.x); d.y = __expf(al.y); *(f32x2*)(dbuf + (size_t)item * 128 + 2 * k2) = d; }
        __syncthreads();
        f32x4 acc[2][4];
#pragma unroll
        for (int m = 0; m < 2; ++m)
#pragma unroll
            for (int n = 0; n < 4; ++n) acc[m][n] = (f32x4){0.f, 0.f, 0.f, 0.f};
        const int sx = (frow >> 1) & 7;
#pragma unroll
        for (int ks = 0; ks < 2; ++ks) {
            const int co = ((ks * 4 + fq) ^ sx) << 4;
            bf16x8 af[2], bfr[4];
#pragma unroll
            for (int m = 0; m < 2; ++m) af[m] = *(const bf16x8*)(lds + H1_VT + (32 * wr + 16 * m + frow) * 128 + co);
#pragma unroll
            for (int n = 0; n < 4; ++n) bfr[n] = *(const bf16x8*)(lds + H1_KT + (64 * wc + 16 * n + frow) * 128 + co);
#pragma unroll
            for (int m = 0; m < 2; ++m)
#pragma unroll
                for (int n = 0; n < 4; ++n) acc[m][n] = __builtin_amdgcn_mfma_f32_16x16x32_bf16(bfr[n], af[m], acc[m][n], 0, 0, 0);
        }
#pragma unroll
        for (int m = 0; m < 2; ++m) { const int v = 32 * wr + 16 * m + frow;
#pragma unroll
            for (int n = 0; n < 4; ++n) { const int k0 = 64 * wc + 16 * n + 4 * fq; const f32x4 e = *(const f32x4*)(ek + k0); const f32x4 o = acc[m][n] * e;
                u32x2 w; w.x = pk2(o.x, o.y); w.y = pk2(o.z, o.w); *(u32x2*)(ubuf + ((size_t)item * 128 + v) * 128 + k0) = w; } }
    }
}
DEV void phase_hgrn_a2(const Params& p, unsigned char* lds) {
    const int G = gridDim.x;
    bf16_t* ubuf = (bf16_t*)(p.ws + WS_UBUF); const float* dbuf = (const float*)(p.ws + WS_DBUF);
    for (int gid = blockIdx.x * NT + threadIdx.x; gid < 131072; gid += G * NT) {
        const int bh = gid >> 12, v = (gid >> 5) & 127, k4 = gid & 31;
        bf16_t* u = ubuf + ((size_t)bh * 64 * 128 + v) * 128 + 4 * k4;
        const float* d = dbuf + (size_t)bh * 64 * 128 + 4 * k4;
        f32x4 S = (f32x4){0.f, 0.f, 0.f, 0.f};
        for (int c0 = 0; c0 < 64; c0 += 8) {
            u32x2 uu[8]; f32x4 dd[8];
#pragma unroll
            for (int j = 0; j < 8; ++j) { uu[j] = *(const u32x2*)(u + (size_t)(c0 + j) * 16384); dd[j] = *(const f32x4*)(d + (size_t)(c0 + j) * 128); }
#pragma unroll
            for (int j = 0; j < 8; ++j) { u32x2 w; w.x = pk2(S.x, S.y); w.y = pk2(S.z, S.w); *(u32x2*)(u + (size_t)(c0 + j) * 16384) = w;
                S.x = dd[j].x * S.x + bflo(uu[j].x); S.y = dd[j].y * S.y + bfhi(uu[j].x); S.z = dd[j].z * S.z + bflo(uu[j].y); S.w = dd[j].w * S.w + bfhi(uu[j].y); }
        }
    }
}
constexpr int H3_QH = 0, H3_QA = 16384, H3_KH = 32768, H3_VT = 49152, H3_PP = 65536, H3_ST = 73728, H3_SEG = 106496, H3_RED = 110592;
DEV void phase_hgrn_a3(const Params& p, unsigned char* lds) {
    const int tid = threadIdx.x, lane = tid & 63, wid = tid >> 6, k2 = tid & 63, tq = tid >> 6;
    const int vb = vblock(), G = gridDim.x;
    const int frow = lane & 15, fq = lane >> 4;
    float* segs = (float*)(lds + H3_SEG); float* red = (float*)(lds + H3_RED);
    const bf16_t* ubuf = (const bf16_t*)(p.ws + WS_UBUF);
    for (int item = vb; item < 2048; item += G) {
        const int bh = item >> 6, c = item & 63, b = bh >> 2, h = bh & 3;
        __syncthreads();
        f32x2 lf[8], a[8], r, al;
        hgrn_cumsum(p, bh, c, segs, lf, a, r, al);
        {
            const bf16_t* HQ = (const bf16_t*)(p.ws + WS_HQ) + ((size_t)b * SEQ + c * 64 + tq * 8) * 512 + h * 128 + 2 * k2;
            unsigned qq[8];
#pragma unroll
            for (int i = 0; i < 8; ++i) qq[i] = *(const unsigned*)(HQ + (size_t)i * 512);
#pragma unroll
            for (int i = 0; i < 8; ++i) { const int t = 8 * tq + i; const float q0 = bflo(qq[i]), q1 = bfhi(qq[i]);
                const int off = swz256(t, k2 >> 2) + (k2 & 3) * 4;
                *(unsigned*)(lds + H3_QH + off) = pk2(q0 * __expf(fminf(a[i].x - r.x, 80.f)), q1 * __expf(fminf(a[i].y - r.y, 80.f)));
                *(unsigned*)(lds + H3_QA + off) = pk2(q0 * __expf(a[i].x), q1 * __expf(a[i].y));
                *(unsigned*)(lds + H3_KH + off) = pk2((1.f - __expf(lf[i].x)) * __expf(fminf(r.x - a[i].x, 80.f)), (1.f - __expf(lf[i].y)) * __expf(fminf(r.y - a[i].y, 80.f))); }
        }
        hgrn_stage_vt(p, bh, c, lds + H3_VT);
        {
            const bf16_t* st = ubuf + (size_t)item * 16384;
#pragma unroll
            for (int i = 0; i < 4; ++i) { const int q = tid + NT * i, v = q >> 4, ch = q & 15; *(u32x4*)(lds + H3_ST + swz256(v, ch)) = *(const u32x4*)(st + v * 128 + ch * 8); }
        }
        __syncthreads();
        {
            const int wr = wid >> 1, wc = wid & 1;
            f32x4 acc[2];
            acc[0] = (f32x4){0.f, 0.f, 0.f, 0.f}; acc[1] = acc[0];
            if (32 * wc <= 16 * wr + 15) {
#pragma unroll
                for (int ks = 0; ks < 4; ++ks) {
                    const int co = ((ks * 4 + fq) ^ frow) << 4;
                    const bf16x8 af = *(const bf16x8*)(lds + H3_QH + (16 * wr + frow) * 256 + co);
#pragma unroll
                    for (int n = 0; n < 2; ++n) { const bf16x8 bfr = *(const bf16x8*)(lds + H3_KH + (32 * wc + 16 * n + frow) * 256 + co);
                        acc[n] = __builtin_amdgcn_mfma_f32_16x16x32_bf16(bfr, af, acc[n], 0, 0, 0); }
                }
            }
            const int t = 16 * wr + frow;
#pragma unroll
            for (int n = 0; n < 2; ++n) { const int s0 = 32 * wc + 16 * n + 4 * fq; f32x4 v = acc[n];
                v.x = (s0 + 0 <= t) ? v.x : 0.f; v.y = (s0 + 1 <= t) ? v.y : 0.f; v.z = (s0 + 2 <= t) ? v.z : 0.f; v.w = (s0 + 3 <= t) ? v.w : 0.f;
                u32x2 w; w.x = pk2(v.x, v.y); w.y = pk2(v.z, v.w);
                *(u32x2*)(lds + H3_PP + t * 128 + ((((s0 >> 3)) ^ ((t >> 1) & 7)) << 4) + (s0 & 7) * 2) = w; }
        }
        __syncthreads();
        {
            const int wr = wid >> 2, wc = wid & 3;
            f32x4 acc[2][2];
#pragma unroll
            for (int m = 0; m < 2; ++m)
#pragma unroll
                for (int n = 0; n < 2; ++n) acc[m][n] = (f32x4){0.f, 0.f, 0.f, 0.f};
            const int sx = (frow >> 1) & 7;
#pragma unroll
            for (int ks = 0; ks < 2; ++ks) {
                const int co = ((ks * 4 + fq) ^ sx) << 4;
                bf16x8 af[2], bfr[2];
#pragma unroll
                for (int m = 0; m < 2; ++m) af[m] = *(const bf16x8*)(lds + H3_PP + (32 * wr + 16 * m + frow) * 128 + co);
#pragma unroll
                for (int n = 0; n < 2; ++n) bfr[n] = *(const bf16x8*)(lds + H3_VT + (32 * wc + 16 * n + frow) * 128 + co);
#pragma unroll
                for (int m = 0; m < 2; ++m)
#pragma unroll
                    for (int n = 0; n < 2; ++n) acc[m][n] = __builtin_amdgcn_mfma_f32_16x16x32_bf16(bfr[n], af[m], acc[m][n], 0, 0, 0);
            }
#pragma unroll
            for (int ks = 0; ks < 4; ++ks) {
                const int co = ((ks * 4 + fq) ^ frow) << 4;
                bf16x8 af[2], bfr[2];
#pragma unroll
                for (int m = 0; m < 2; ++m) af[m] = *(const bf16x8*)(lds + H3_QA + (32 * wr + 16 * m + frow) * 256 + co);
#pragma unroll
                for (int n = 0; n < 2; ++n) bfr[n] = *(const bf16x8*)(lds + H3_ST + (32 * wc + 16 * n + frow) * 256 + co);
#pragma unroll
                for (int m = 0; m < 2; ++m)
#pragma unroll
                    for (int n = 0; n < 2; ++n) acc[m][n] = __builtin_amdgcn_mfma_f32_16x16x32_bf16(bfr[n], af[m], acc[m][n], 0, 0, 0);
            }
            f32x4 gnv[2]; u32x2 ggv[2][2];
#pragma unroll
            for (int n = 0; n < 2; ++n) gnv[n] = *(const f32x4*)(p.g_hn + 32 * wc + 16 * n + 4 * fq);
#pragma unroll
            for (int m = 0; m < 2; ++m)
#pragma unroll
                for (int n = 0; n < 2; ++n) ggv[m][n] = *(const u32x2*)((const bf16_t*)(p.ws + WS_HG) + ((size_t)b * SEQ + c * 64 + 32 * wr + 16 * m + frow) * 512 + h * 128 + 32 * wc + 16 * n + 4 * fq);
#pragma unroll
            for (int m = 0; m < 2; ++m) { float ss = 0.f;
#pragma unroll
                for (int n = 0; n < 2; ++n) { const f32x4 v = acc[m][n]; ss += (v.x * v.x + v.y * v.y) + (v.z * v.z + v.w * v.w); }
                ss += __shfl_xor(ss, 16); ss += __shfl_xor(ss, 32);
                if (fq == 0) red[(32 * wr + 16 * m + frow) * 4 + wc] = ss; }
            __syncthreads();
#pragma unroll
            for (int m = 0; m < 2; ++m) { const int t = 32 * wr + 16 * m + frow; const f32x4 q4 = *(const f32x4*)(red + t * 4);
                const float rs = rsqrtf(((q4.x + q4.y) + (q4.z + q4.w)) * (1.f / 128.f) + RMS_EPS);
                const size_t row = (size_t)b * SEQ + c * 64 + t;
#pragma unroll
                for (int n = 0; n < 2; ++n) { const int v0 = 32 * wc + 16 * n + 4 * fq; const f32x4 gn = gnv[n]; const u32x2 gg = ggv[m][n];
                    const f32x4 o = acc[m][n];
                    u32x2 w; w.x = pk2(o.x * rs * gn.x * bflo(gg.x), o.y * rs * gn.y * bfhi(gg.x)); w.y = pk2(o.z * rs * gn.z * bflo(gg.y), o.w * rs * gn.w * bfhi(gg.y));
                    *(u32x2*)((bf16_t*)(p.ws + WS_R1) + row * 1024 + 512 + h * 128 + v0) = w; } }
        }
    }
}

DEV void phase_normalize(const Params& p, unsigned char* lds) {
    const int vb = vblock(), G = gridDim.x;
    unsigned char* ws = p.ws;
    __syncthreads();
    {
        float* tl = (float*)lds;
        for (int r = vb; r < 32 * 4 * 16; r += G) { const int e = r / 64, q = r % 64; SrcW13_4 s{p.w1 + (size_t)e * 1024 * 512, p.w3 + (size_t)e * 1024 * 512, p.ffn_g};
            convert_tile256(tl, s, (bf16_t*)(ws + WS_W13T) + (size_t)e * 1024 * 1024, 1024, (q / 16) * 256, (q % 16) * 64); }
    }
    __syncthreads();
}

struct EpiOut8 { const Params& p; static constexpr bool MIDSCALE = true;
    DEV float rowscale(int row) const { return rsqrtf(((const float*)(p.ws + WS_ROWSS))[row] * (1.f / 512.f) + RMS_EPS); }
    DEV int midk() const { return 8; }
    DEV void operator()(const f32x4 (&acc)[2][2][4][2], const pg8::Unit& u, int wr, int wc, int fr, int fq) const {
        const size_t off0 = ((size_t)u.pm * 256 + wr * 64 + fr) * DM + u.pn * 256 + 64 * wc + 8 * fq;
        const bf16_t* xb = (const bf16_t*)(p.ws + WS_XB);
        u32x4 xr[2][4][2];
#pragma unroll
        for (int ai = 0; ai < 2; ++ai)
#pragma unroll
            for (int m = 0; m < 4; ++m)
#pragma unroll
                for (int bj = 0; bj < 2; ++bj) xr[ai][m][bj] = *(const u32x4*)(xb + off0 + (size_t)(128 * ai + 16 * m) * DM + 32 * bj);
#pragma unroll
        for (int ai = 0; ai < 2; ++ai)
#pragma unroll
            for (int m = 0; m < 4; ++m)
#pragma unroll
                for (int bj = 0; bj < 2; ++bj) { const u32x4 w = xr[ai][m][bj]; float* o = p.out + off0 + (size_t)(128 * ai + 16 * m) * DM + 32 * bj;
                    *(f32x4*)(o) = (f32x4){bflo(w.x), bfhi(w.x), bflo(w.y), bfhi(w.y)} + acc[ai][bj][m][0]; *(f32x4*)(o + 4) = (f32x4){bflo(w.z), bfhi(w.z), bflo(w.w), bfhi(w.w)} + acc[ai][bj][m][1]; }
    } };
DEV void phase_outproj(const Params& p, unsigned char* lds) {
    pg8::Gemm g{(const bf16_t*)(p.ws + WS_R1), (const bf16_t*)(p.ws + WS_WOUTT), NTOK, DM, DM};
    pg8::StaticOrder S; S.init(NTOK, DM, (int)gridDim.x, (int)blockIdx.x);
    EpiOut8 E{p};
    if (((blockIdx.x >> 3) & 1) == 0) phase_normalize(p, lds);
    pg8::gemm_phase((PG8_LAS unsigned char*)lds, g, S, E);
    if (((blockIdx.x >> 3) & 1) != 0) phase_normalize(p, lds);
}

constexpr int RT_W = 0, RT_LG = 2 * 49152, RT_RS = RT_LG + 128 * 49 * 4, RT_HIST = RT_RS + 512, RT_BASE = RT_HIST + 1024, RT_LDS = RT_BASE + 1024;
DEV void phase_router(const Params& p, unsigned char* lds) {
    const int tid = threadIdx.x, lane = tid & 63, wid = tid >> 6, frow = lane & 15, fq = lane >> 4;
    const int vb = vblock(), G = gridDim.x;
    unsigned char* ws = p.ws;
    float* lg = (float*)(lds + RT_LG); float* rsd = (float*)(lds + RT_RS);
    int* hist = (int*)(lds + RT_HIST); int* basep = (int*)(lds + RT_BASE);
    const bf16_t* rw = (const bf16_t*)(ws + WS_RW);
    for (int it = vb; it < NTOK / 128; it += G) {
        const size_t row0 = (size_t)it * 128;
        const size_t trow = row0 + 16 * wid + frow;
        const float* hrow = p.out + trow * DM + 8 * fq;
        bf16_t* hbrow = (bf16_t*)(ws + WS_R1) + trow * DM + 8 * fq;
        f32x4 acc[3]; float ss = 0.f;
#pragma unroll
        for (int nt = 0; nt < 3; ++nt) acc[nt] = (f32x4){0.f, 0.f, 0.f, 0.f};
        if (tid < 128) hist[tid] = 0;
        u32x4 wreg[6]; f32x4 xa[4][2], xn[4][2];
#define RT_LOADW(kc_) do { _Pragma("unroll") for (int i = 0; i < 6; ++i) { const int idx = tid + NT * i, r = idx >> 5, c = idx & 31; wreg[i] = *(const u32x4*)(rw + (size_t)r * 1024 + (kc_) * 256 + c * 8); } } while (0)
#define RT_STOREW(buf_) do { _Pragma("unroll") for (int i = 0; i < 6; ++i) { const int idx = tid + NT * i, r = idx >> 5, c = idx & 31; *(u32x4*)(lds + RT_W + (buf_) * 49152 + r * 512 + ((c ^ (r & 15)) << 4)) = wreg[i]; } } while (0)
#define RT_LOADX(dst_, hc_) do { _Pragma("unroll") for (int ks = 0; ks < 4; ++ks) { dst_[ks][0] = *(const f32x4*)(hrow + (hc_) * 128 + 32 * ks); dst_[ks][1] = *(const f32x4*)(hrow + (hc_) * 128 + 32 * ks + 4); } } while (0)
        __syncthreads();
        RT_LOADW(0); RT_LOADX(xa, 0); RT_STOREW(0);
        __syncthreads();
#pragma unroll 1
        for (int hc = 0; hc < 8; ++hc) {
            if (hc < 7) RT_LOADX(xn, hc + 1);
            const unsigned char* wb = lds + RT_W + ((hc >> 1) & 1) * 49152;
#pragma unroll
            for (int ks = 0; ks < 4; ++ks) {
                const f32x4 a = xa[ks][0], b = xa[ks][1];
                ss += ((a.x * a.x + a.y * a.y) + (a.z * a.z + a.w * a.w)) + ((b.x * b.x + b.y * b.y) + (b.z * b.z + b.w * b.w));
                u32x4 hi; hi.x = pk2(a.x, a.y); hi.y = pk2(a.z, a.w); hi.z = pk2(b.x, b.y); hi.w = pk2(b.z, b.w);
                u32x4 lo; lo.x = pk2(a.x - bflo(hi.x), a.y - bfhi(hi.x)); lo.y = pk2(a.z - bflo(hi.y), a.w - bfhi(hi.y)); lo.z = pk2(b.x - bflo(hi.z), b.y - bfhi(hi.z)); lo.w = pk2(b.z - bflo(hi.w), b.w - bfhi(hi.w));
                *(u32x4*)(hbrow + hc * 128 + 32 * ks) = hi;
                const bf16x8 hh = __builtin_bit_cast(bf16x8, hi), hl = __builtin_bit_cast(bf16x8, lo);
                const int co = ((4 * (4 * (hc & 1) + ks) + fq) ^ frow) << 4;
#pragma unroll
                for (int nt = 0; nt < 3; ++nt) {
                    const bf16x8 whi = *(const bf16x8*)(wb + (16 * nt + frow) * 512 + co), wlo = *(const bf16x8*)(wb + (48 + 16 * nt + frow) * 512 + co);
                    acc[nt] = __builtin_amdgcn_mfma_f32_16x16x32_bf16(whi, hh, acc[nt], 0, 0, 0);
                    acc[nt] = __builtin_amdgcn_mfma_f32_16x16x32_bf16(wlo, hh, acc[nt], 0, 0, 0);
                    acc[nt] = __builtin_amdgcn_mfma_f32_16x16x32_bf16(whi, hl, acc[nt], 0, 0, 0);
                }
            }
            if ((hc & 1) == 0 && hc < 6) { RT_LOADW((hc >> 1) + 1); }
            if ((hc & 1) == 1 && hc < 7) { RT_STOREW(((hc >> 1) + 1) & 1); }
#pragma unroll
            for (int ks = 0; ks < 4; ++ks) { xa[ks][0] = xn[ks][0]; xa[ks][1] = xn[ks][1]; }
            if (hc & 1) __syncthreads();
        }
#undef RT_LOADW
#undef RT_STOREW
#undef RT_LOADX
        ss += __shfl_xor(ss, 16); ss += __shfl_xor(ss, 32);
        if (fq == 0) rsd[16 * wid + frow] = rsqrtf(ss * (1.f / DM) + RMS_EPS);
#pragma unroll
        for (int nt = 0; nt < 3; ++nt) { float* o = lg + (16 * wid + frow) * 49 + 16 * nt + 4 * fq; o[0] = acc[nt].x; o[1] = acc[nt].y; o[2] = acc[nt].z; o[3] = acc[nt].w; }
        __syncthreads();
        int bin = 0, slot = 0, ea = 0, eb = 0, sa = 0, sb = 0; float wa = 0.f, wb = 0.f;
        int* ehist = hist + 112; int* ebase = basep + 112;
        if (tid < 32) ehist[tid] = 0;
        __syncthreads();
        if (tid < 128) {
            const float rs = rsd[tid];
            ((float*)(ws + WS_RSTD2))[row0 + tid] = rs;
            float gl[4]; int gi = 0; float gm = -1e30f;
#pragma unroll
            for (int c = 0; c < 4; ++c) { gl[c] = lg[tid * 49 + c] * rs + p.b_group[c]; if (gl[c] > gm) { gm = gl[c]; gi = c; } }
            float gs = 0.f;
#pragma unroll
            for (int c = 0; c < 4; ++c) gs += __expf(gl[c] - gm);
            const float pg = 1.f / gs;
            float el[8]; int i0 = 0; float m0 = -1e30f;
#pragma unroll
            for (int c = 0; c < 8; ++c) { el[c] = lg[tid * 49 + 4 + gi * 8 + c] * rs + p.b_expert[gi * 8 + c]; if (el[c] > m0) { m0 = el[c]; i0 = c; } }
            int i1 = 0; float m1 = -1e30f;
#pragma unroll
            for (int c = 0; c < 8; ++c) if (c != i0 && el[c] > m1) { m1 = el[c]; i1 = c; }
            const float e1 = __expf(m1 - m0); const float w0 = pg / (1.f + e1), w1 = pg * e1 / (1.f + e1);
            const int a = min(i0, i1), bb = max(i0, i1);
            bin = gi * 28 + (7 * a - (a * (a - 1)) / 2) + (bb - a - 1);
            wa = (i0 < i1) ? w0 : w1; wb = (i0 < i1) ? w1 : w0; ea = gi * 8 + a; eb = gi * 8 + bb;
            slot = atomicAdd(&hist[bin], 1);
            sa = atomicAdd(&ehist[ea], 1); sb = atomicAdd(&ehist[eb], 1);
        }
        __syncthreads();
        if (tid < NBIN) { const int h = hist[tid]; basep[tid] = h ? atomicAdd((int*)(ws + WS_CTL) + tid, h) : 0; }
        else if (tid >= 128 && tid < 160) { const int e = tid - 128; const int h = ehist[e]; ebase[e] = h ? atomicAdd((int*)(ws + WS_CTL + 512) + e, h) : 0; }
        __syncthreads();
        if (tid < 128) {
            const int t = (int)(row0 + tid);
            ((int*)(ws + WS_BINL))[(size_t)bin * BINCAP + basep[bin] + slot] = t;
            sa += ebase[ea]; sb += ebase[eb];
            ((int*)(ws + WS_EL))[(size_t)ea * BINCAP + sa] = t; ((float*)(ws + WS_EW))[(size_t)ea * BINCAP + sa] = wa;
            ((int*)(ws + WS_EL))[(size_t)eb * BINCAP + sb] = t; ((float*)(ws + WS_EW))[(size_t)eb * BINCAP + sb] = wb;
            { const unsigned dpos = (unsigned)bin | ((unsigned)(basep[bin] + slot) << 7); ((unsigned*)(ws + WS_EDST))[(size_t)ea * BINCAP + sa] = dpos; ((unsigned*)(ws + WS_EDST))[(size_t)eb * BINCAP + sb] = dpos | (1u << 22); }
        }
        __syncthreads();
    }
}

constexpr int MOE_TS = pg8::STAGE_BYTES, MOE_TT = MOE_TS + 512, MOE_ES = MOE_TT + 1024, MOE_ET = MOE_ES + 256, MOE_OT = MOE_ET + 1280;
DEV int wave_excl_scan(int v, int lane, int& total) {
    int s = v;
#pragma unroll
    for (int o = 1; o < 64; o <<= 1) { const int u = __shfl_up(s, o); if (lane >= o) s += u; }
    total = __shfl(s, 63);
    return s - v;
}
DEV void moe_tiles(const Params& p, unsigned char* lds) {
    int* tstart = (int*)(lds + MOE_TS); int* tiletab = (int*)(lds + MOE_TT); int* etstart = (int*)(lds + MOE_ES); int* etiletab = (int*)(lds + MOE_ET); int* ordtab = (int*)(lds + MOE_OT);
    const int tid = threadIdx.x, lane = tid & 63, wid = tid >> 6;
    __syncthreads();
    if (wid == 0) {
        const int b0 = 2 * lane, b1 = 2 * lane + 1;
        const int c0 = b0 < NBIN ? ((const int*)(p.ws + WS_CTL))[b0] : 0, c1 = b1 < NBIN ? ((const int*)(p.ws + WS_CTL))[b1] : 0;
        const int f0 = c0 >> 8, f1 = c1 >> 8, q0 = (c0 & 255) ? 1 : 0, q1 = (c1 & 255) ? 1 : 0;
        int T, TF, TP;
        const int st = wave_excl_scan(f0 + q0 + f1 + q1, lane, T), sf = wave_excl_scan(f0 + f1, lane, TF), sp = wave_excl_scan(q0 + q1, lane, TP);
        if (b0 < NBIN) { tstart[b0] = st; for (int i = 0; i < f0 + q0; ++i) tiletab[st + i] = b0; for (int i = 0; i < f0; ++i) ordtab[sf + i] = st + i; if (q0) ordtab[TF + sp] = st + f0; }
        if (b1 < NBIN) { const int s1 = st + f0 + q0; tstart[b1] = s1; for (int i = 0; i < f1 + q1; ++i) tiletab[s1 + i] = b1; for (int i = 0; i < f1; ++i) ordtab[sf + f0 + i] = s1 + i; if (q1) ordtab[TF + sp + q0] = s1 + f1; }
        if (lane == 0) tstart[NBIN] = T;
    } else if (wid == 2) {
        const int cn = lane < 32 ? ((const int*)(p.ws + WS_CTL + 512))[lane] : 0; const int t = (cn + 255) >> 8;
        int T; const int s = wave_excl_scan(t, lane, T);
        if (lane < 32) { etstart[lane] = s; for (int i = 0; i < t; ++i) etiletab[s + i] = lane; }
        if (lane == 0) etstart[32] = T;
    }
    __syncthreads();
}
DEV void bin_experts(int bin, int& ea, int& eb) { const int gi = bin / 28; int pi = bin % 28, a = 0; while (pi >= 7 - a) { pi -= 7 - a; ++a; } ea = gi * 8 + a; eb = gi * 8 + a + 1 + pi; }
DEV void lane_rc(int i, int& R, int& C) { pg8::stage_rc((int)threadIdx.x * 16, R, C); R += 64 * i; }
struct MoeUnit { int tile, nt, bin, mt, n, rb; };
struct PolMoe1 {
    typedef MoeUnit Unit;
    const Params& p; const int* etstart; const int* etiletab; int U, G, c;
    struct AddrA { unsigned off[2][2]; };
    struct AddrB { const char* base; };
    DEV int nk() const { return 16; }
    DEV bool next(int i, MoeUnit& u) const {
        const int nfull = U / G, F = nfull * G, R = U - F;
        int L, half = -1;
        if (i < nfull) L = i * G + c;
        else { const int k = (i - nfull) * G + c; if (k >= 2 * R) return false; L = F + (k >> 1); half = k & 1; }
        u.tile = L >> 2; u.nt = L & 3;
        u.bin = __builtin_amdgcn_readfirstlane(etiletab[u.tile]);
        u.mt = u.tile - __builtin_amdgcn_readfirstlane(etstart[u.bin]);
        const int cnt = ((const int*)(p.ws + WS_CTL + 512))[u.bin];
        if (half < 0) { u.rb = u.mt * 256; u.n = min(256, cnt - u.rb); } else { u.rb = u.mt * 256 + 128 * half; u.n = min(128, cnt - u.rb); if (u.n <= 0) { u.n = 0; u.rb = u.mt * 256; } }
        return true;
    }
    DEV bool full(const MoeUnit& u) const { return u.n > 128; }
    DEV void addrA(const MoeUnit& u, AddrA& a) const {
        const int* list = (const int*)(p.ws + WS_EL) + (size_t)u.bin * BINCAP + u.rb;
#pragma unroll
        for (int i = 0; i < 2; ++i) { int R, C; lane_rc(i, R, C);
#pragma unroll
            for (int h = 0; h < 2; ++h) { int r = h * 128 + R; if (r >= u.n) r = 0; a.off[h][i] = (unsigned)list[r] * 2048u + (unsigned)C * 2u; } }
    }
    DEV void addrB(const MoeUnit& u, AddrB& b) const { b.base = (const char*)(p.ws + WS_W13T) + ((size_t)u.bin * 1024 + u.nt * 256) * 2048; }
    DEV const char* pa(const AddrA& a, int h, int i, int kt) const { return (const char*)(p.ws + WS_R1) + a.off[h][i] + kt * 128; }
    DEV const char* pb(const AddrB& b, int h, int i, int kt) const { int R, C; lane_rc(i, R, C); return b.base + (size_t)h * (128 * 2048) + (unsigned)(R * 1024 + C) * 2u + kt * 128; }
};
struct EpiMoe1 { const Params& p; const int* tstart;
    DEV void operator()(const f32x4 (&acc)[2][2][4][2], const MoeUnit& u, int wr, int wc, int fr, int fq) const {
        const int* list = (const int*)(p.ws + WS_EL) + (size_t)u.bin * BINCAP + u.rb;
        const float* wl = (const float*)(p.ws + WS_EW) + (size_t)u.bin * BINCAP + u.rb;
        const unsigned* dl = (const unsigned*)(p.ws + WS_EDST) + (size_t)u.bin * BINCAP + u.rb;
        const int r0 = wr * 64 + fr;
        int tk[2][4]; float ww[2][4]; unsigned dd[2][4];
#pragma unroll
        for (int ai = 0; ai < 2; ++ai)
#pragma unroll
            for (int m = 0; m < 4; ++m) { int r = r0 + ai * 128 + m * 16; if (r >= u.n) r = 0; tk[ai][m] = list[r]; ww[ai][m] = wl[r]; dd[ai][m] = dl[r]; }
        float rsv[2][4];
#pragma unroll
        for (int ai = 0; ai < 2; ++ai)
#pragma unroll
            for (int m = 0; m < 4; ++m) rsv[ai][m] = ((const float*)(p.ws + WS_RSTD2))[tk[ai][m]];
        const int f = (u.nt * 256 + 32 * wc + 8 * fq) >> 1;
#pragma unroll
        for (int ai = 0; ai < 2; ++ai)
#pragma unroll
            for (int m = 0; m < 4; ++m) { if (r0 + ai * 128 + m * 16 >= u.n) continue;
                const float rs = rsv[ai][m], w = ww[ai][m]; const unsigned d = dd[ai][m];
                bf16_t* hrow = (bf16_t*)(p.ws + WS_HBUF) + ((size_t)tstart[d & 127u] * 256 + ((d >> 7) & 32767u)) * 1024 + ((d >> 22) & 1u) * 512 + f;
#pragma unroll
                for (int bj = 0; bj < 2; ++bj) { const f32x4 v0 = acc[ai][bj][m][0] * rs, v1 = acc[ai][bj][m][1] * rs;
                    u32x2 w2; w2.x = pk2(siluf_(v0.x) * v0.y * w, siluf_(v0.z) * v0.w * w); w2.y = pk2(siluf_(v1.x) * v1.y * w, siluf_(v1.z) * v1.w * w); *(u32x2*)(hrow + 64 * bj) = w2; } }
    } };
DEV void phase_moe1(const Params& p, unsigned char* lds) {
    moe_tiles(p, lds);
    const int* etstart = (const int*)(lds + MOE_ES);
    PolMoe1 P{p, etstart, (const int*)(lds + MOE_ET), etstart[32] * 4, (int)gridDim.x, vblock()};
    EpiMoe1 E{p, (const int*)(lds + MOE_TS)};
    pg8::gemm_phase2(( PG8_LAS unsigned char*)lds, P, E);
}
struct PolMoe2 {
    typedef MoeUnit Unit;
    const Params& p; const int* tstart; const int* tiletab; const int* ordtab; int U, G, c;
    struct AddrA { const char* base; };
    struct AddrB { const char* ba; const char* bb; };
    DEV int nk() const { return 16; }
    DEV bool next(int i, MoeUnit& u) const {
        const int L = i * G + c; if (L >= U) return false;
        u.tile = __builtin_amdgcn_readfirstlane(ordtab[L >> 2]); u.nt = L & 3;
        u.bin = __builtin_amdgcn_readfirstlane(tiletab[u.tile]);
        u.mt = u.tile - __builtin_amdgcn_readfirstlane(tstart[u.bin]);
        u.n = min(256, ((const int*)(p.ws + WS_CTL))[u.bin] - u.mt * 256); u.rb = u.mt * 256;
        return true;
    }
    DEV bool full(const MoeUnit& u) const { return u.n > 128; }
    DEV void addrA(const MoeUnit& u, AddrA& a) const { a.base = (const char*)(p.ws + WS_HBUF) + (size_t)u.tile * 256 * 2048; }
    DEV void addrB(const MoeUnit& u, AddrB& b) const {
        int ea, eb; bin_experts(u.bin, ea, eb);
        b.ba = (const char*)(p.ws + WS_W2T) + ((size_t)ea * 1024 + u.nt * 256) * 1024; b.bb = (const char*)(p.ws + WS_W2T) + ((size_t)eb * 1024 + u.nt * 256) * 1024;
    }
    DEV const char* pa(const AddrA& a, int h, int i, int kt) const { int R, C; lane_rc(i, R, C); return a.base + (size_t)h * (128 * 2048) + (unsigned)(R * 1024 + C) * 2u + kt * 128; }
    DEV const char* pb(const AddrB& b, int h, int i, int kt) const { int R, C; lane_rc(i, R, C); return (kt < 8 ? b.ba + kt * 128 : b.bb + (kt - 8) * 128) + (size_t)h * (128 * 1024) + (unsigned)(R * 512 + C) * 2u; }
};
struct EpiMoe2 { const Params& p;
    DEV void operator()(const f32x4 (&acc)[2][2][4][2], const MoeUnit& u, int wr, int wc, int fr, int fq) const {
        const int* list = (const int*)(p.ws + WS_BINL) + (size_t)u.bin * BINCAP + u.mt * 256;
        const int r0 = wr * 64 + fr;
        int tk[2][4];
#pragma unroll
        for (int ai = 0; ai < 2; ++ai)
#pragma unroll
            for (int m = 0; m < 4; ++m) { int r = r0 + ai * 128 + m * 16; if (r >= u.n) r = 0; tk[ai][m] = list[r]; }
        const int c0 = u.nt * 256 + 32 * wc + 4 * fq;
#pragma unroll
        for (int ai = 0; ai < 2; ++ai)
#pragma unroll
            for (int m = 0; m < 4; ++m) { if (r0 + ai * 128 + m * 16 >= u.n) continue;
                float* o = p.out + (size_t)tk[ai][m] * DM + c0;
                const f32x4 h0 = *(const f32x4*)(o), h1 = *(const f32x4*)(o + 16), h2 = *(const f32x4*)(o + 128), h3 = *(const f32x4*)(o + 144);
                *(f32x4*)(o) = h0 + acc[ai][0][m][0]; *(f32x4*)(o + 16) = h1 + acc[ai][0][m][1]; *(f32x4*)(o + 128) = h2 + acc[ai][1][m][0]; *(f32x4*)(o + 144) = h3 + acc[ai][1][m][1]; }
    } };
DEV void phase_moe2(const Params& p, unsigned char* lds) {
    moe_tiles(p, lds);
    const int* tstart = (const int*)(lds + MOE_TS);
    PolMoe2 P{p, tstart, (const int*)(lds + MOE_TT), (const int*)(lds + MOE_OT), tstart[NBIN] * 4, (int)gridDim.x, vblock()};
    EpiMoe2 E{p};
    pg8::gemm_phase2((PG8_LAS unsigned char*)lds, P, E);
}

#define XB_TMO      128
#define XB_XCNT(j)  (256  + 64 * (j))
#define XB_XSUB(j)  (1280 + 64 * (j))
#define XB_XGEN(j)  (2304 + 64 * (j))
#define XB_TOP      3328
#define XB_TOPGEN   3392
#define XCD_BAR_WORDS 3456
#define XB_SPIN_CAP (1u << 20)
#define LAS __attribute__((address_space(3)))
constexpr size_t WS_BAR = WS_CTL + 4096;
DEV unsigned xb_ld(unsigned* p) { return __hip_atomic_load(p, __ATOMIC_RELAXED, __HIP_MEMORY_SCOPE_AGENT); }
DEV unsigned xb_add(unsigned* p, unsigned v) { return __hip_atomic_fetch_add(p, v, __ATOMIC_RELAXED, __HIP_MEMORY_SCOPE_AGENT); }
DEV unsigned xb_xcc_id() { return (unsigned)__builtin_amdgcn_s_getreg((3 << 11) | 20) & 0xFu; }
#define XB_SPIN(cond, bar) do { unsigned _sp = 0; while (cond) { __builtin_amdgcn_s_sleep(1); \
    if ((++_sp & 255u) == 0u) { if (xb_ld(&(bar)[XB_TMO])) break; if (_sp > XB_SPIN_CAP) { atomicAdd(&(bar)[XB_TMO], 1u); break; } } } } while (0)
struct XcdBarrier { unsigned* bar; unsigned x; volatile LAS unsigned* st; };
DEV XcdBarrier xcd_barrier_post(unsigned* bar, volatile LAS unsigned* st) {
    XcdBarrier b; b.bar = bar; b.x = xb_xcc_id(); b.st = st;
    if (threadIdx.x == 0) (void)xb_add(&bar[XB_XCNT(b.x)], 1u);
    return b;
}
DEV void xcd_barrier_complete(unsigned* bar, unsigned x, unsigned& nloc, unsigned& nx) {
    const unsigned G = gridDim.x * gridDim.y * gridDim.z;
    unsigned sum, cnt, mine, sp = 0u;
    for (;;) {
        sum = 0u; cnt = 0u; mine = 0u;
#pragma unroll
        for (unsigned j = 0; j < 16; ++j) { const unsigned c = xb_ld(&bar[XB_XCNT(j)]); sum += c; cnt += (c > 0u) ? 1u : 0u; mine = (j == x) ? c : mine; }
        if (sum == G) break;
        __builtin_amdgcn_s_sleep(1);
        if ((++sp & 255u) == 0u) { if (xb_ld(&bar[XB_TMO])) break; if (sp > XB_SPIN_CAP) { atomicAdd(&bar[XB_TMO], 1u); break; } }
    }
    nloc = mine > 0u ? mine : 1u; nx = cnt > 0u ? cnt : 1u;
}
DEV void xcd_barrier(const XcdBarrier& b) {
    asm volatile("s_waitcnt vmcnt(0)" ::: "memory");
    __syncthreads();
    if (threadIdx.x == 0) {
        unsigned* bar = b.bar;
        __builtin_amdgcn_s_waitcnt(0);
        unsigned nloc = b.st[0], nx = b.st[1];
        if (nloc == 0u) { xcd_barrier_complete(bar, b.x, nloc, nx); b.st[0] = nloc; b.st[1] = nx; }
        const unsigned old = xb_add(&bar[XB_XSUB(b.x)], 1u);
        const unsigned gen = old / nloc;
        if (old + 1u == (gen + 1u) * nloc) {
            __builtin_amdgcn_fence(__ATOMIC_RELEASE, "agent");
            asm volatile("s_waitcnt vmcnt(0)" ::: "memory");
            const unsigned og = xb_add(&bar[XB_TOP], 1u);
            const unsigned tg = og / nx;
            if (og + 1u == (tg + 1u) * nx) xb_add(&bar[XB_TOPGEN], 1u);
            else XB_SPIN(xb_ld(&bar[XB_TOPGEN]) == tg, bar);
            __builtin_amdgcn_fence(__ATOMIC_ACQUIRE, "agent");
            xb_add(&bar[XB_XGEN(b.x)], 1u);
            asm volatile("s_waitcnt vmcnt(0)" ::: "memory");
        } else {
            XB_SPIN(xb_ld(&bar[XB_XGEN(b.x)]) == gen, bar);
            __builtin_amdgcn_fence(__ATOMIC_ACQUIRE, "agent");
            asm volatile("s_waitcnt vmcnt(0)" ::: "memory");
        }
    }
    __syncthreads();
}

constexpr int LDS_BYTES = 144 * 1024;
constexpr int N_PHASES = 9;
__global__ void __launch_bounds__(NT) mega(Params p, int lo, int hi) {
    extern __shared__ __attribute__((aligned(16))) unsigned char lds[];
    volatile LAS unsigned* xst = (volatile LAS unsigned*)(lds + LDS_BYTES - 16);
    if (threadIdx.x < 4) xst[threadIdx.x] = 0u;
    __syncthreads();
    XcdBarrier xbar; xbar.bar = (unsigned*)(p.ws + WS_BAR); xbar.x = 0; xbar.st = xst;
    if (hi - lo > 1) xbar = xcd_barrier_post((unsigned*)(p.ws + WS_BAR), xst);
#define GRID_SYNC() xcd_barrier(xbar)
#ifndef PROBE_REPEAT
#define PROBE_REPEAT -1
#endif
#define RUN_PHASE(k, call) do { if (lo <= (k) && (k) < hi) { call; \
        if ((k) == PROBE_REPEAT) { GRID_SYNC(); \
            if ((k) == 5) { float* rz = (float*)(p.ws + WS_ROWSS); for (int i = blockIdx.x * NT + threadIdx.x; i < NTOK; i += gridDim.x * NT) rz[i] = 0.f; GRID_SYNC(); } \
            if ((k) == 7) { if (blockIdx.x == 0 && threadIdx.x < 128) ((int*)(p.ws + WS_CTL))[threadIdx.x] = 0; GRID_SYNC(); } \
            call; } \
        if ((k) + 1 < hi) GRID_SYNC(); } } while (0)
    RUN_PHASE(0, phase_prologue(p, lds));
    RUN_PHASE(1, phase_inproj(p, lds));
    RUN_PHASE(2, { phase_cmp_a(p, lds); const int G_ = (int)gridDim.x; if (G_ > 128) phase_hgrn_a1(p, lds, 64, G_ - 64); else phase_hgrn_a1(p, lds, 0, G_); });
    RUN_PHASE(3, { phase_cmp_b(p, lds); phase_hgrn_a2(p, lds); });
    RUN_PHASE(4, { phase_cmp_attn(p, lds); phase_hgrn_a3(p, lds); });
    RUN_PHASE(5, phase_flash(p, lds));
    RUN_PHASE(6, phase_outproj(p, lds));
    RUN_PHASE(7, phase_router(p, lds));
    RUN_PHASE(8, phase_moe1(p, lds));
    RUN_PHASE(9, phase_moe2(p, lds));
#undef RUN_PHASE
}

extern "C" void kernel_launch(void* const* d_in, const int* in_sizes, int n_in, void* d_out, int out_size, void* d_ws, size_t ws_size, hipStream_t stream) {
    static int grid = 0;
    if (grid == 0) {
        int dev = 0, cus = 0, per_cu = 0;
        hipGetDevice(&dev);
        hipDeviceGetAttribute(&cus, hipDeviceAttributeMultiprocessorCount, dev);
        hipFuncSetAttribute((const void*)mega, hipFuncAttributeMaxDynamicSharedMemorySize, LDS_BYTES);
        hipOccupancyMaxActiveBlocksPerMultiprocessor(&per_cu, (const void*)mega, NT, LDS_BYTES);
        if (per_cu < 1) per_cu = 1;
        grid = cus;
        if (ws_size < WS_END) fprintf(stderr, "kernel_launch: workspace too small: %zu < %zu\n", ws_size, (size_t)WS_END);
        fprintf(stderr, "kernel_launch: cus %d per_cu %d grid %d ws %zu\n", cus, per_cu, grid, ws_size);
    }
    Params p{};
    const float** pp = (const float**)&p;
    for (int i = 0; i < 23; ++i) pp[i] = (const float*)d_in[i];
    p.out = (float*)d_out; p.ws = (unsigned char*)d_ws;
#if N_LAUNCH_MODE == 1
    (void)hipMemsetAsync((unsigned char*)d_ws + WS_BAR, 0, XCD_BAR_WORDS * 4, stream);
    int lo = 0, hi = N_PHASES + 1;
    void* args[] = {&p, &lo, &hi};
    hipError_t e = hipLaunchCooperativeKernel((const void*)mega, dim3(grid), dim3(NT), args, LDS_BYTES, stream);
    if (e != hipSuccess) fprintf(stderr, "cooperative launch failed: %s\n", hipGetErrorString(e));
#else
    for (int ph = 0; ph <= N_PHASES; ++ph) hipLaunchKernelGGL(mega, dim3(grid), dim3(NT), LDS_BYTES, stream, p, ph, ph + 1);
#endif
}
```
